# Optimizing an MI355X kernel written in HIP

```python
import math
import jax, jax.numpy as jnp
from jax import lax
import numpy as np

D_MODEL = 1024
BATCH = 8
SEQ = 2048
DEPTH = 1
DEC_BATCH = 128
DEC_SEQ = 8
PAST_LEN = 16384
PAGE_SIZE = 128

D_INNER = 2 * D_MODEL
HEAD_DIM = 64
N_HEADS = D_INNER // HEAD_DIM
N_GROUPS = 8
HEADS_PER_GROUP = N_HEADS // N_GROUPS
D_STATE = 128
CONV_W = 4
CONV_DIM = D_INNER + 2 * N_GROUPS * D_STATE
CHUNK = 128
POOL_DIM = D_MODEL
POOL_WINDOWS = (2, 4, 8, 16)
N_POOL_GROUPS = len(POOL_WINDOWS)
POOL_GC = POOL_DIM // N_POOL_GROUPS
POOL_BUF = max(POOL_WINDOWS) - 1
N_BRANCH = 2
IN_DIM = D_INNER + CONV_DIM + N_HEADS + POOL_DIM + N_BRANCH * D_MODEL
D_FF = 2816
PLE_DIM = 256
EPS = 1e-6

kernel_name = 'hybrid_ssd_pool_macaron_step'


def _rmsnorm(x, g):
    xf = x.astype(jnp.float32)
    y = xf * lax.rsqrt(jnp.mean(xf * xf, axis=-1, keepdims=True) + EPS)
    return (y * g.astype(jnp.float32)).astype(x.dtype)


def _swiglu(u, w_gu, w_down):
    gate, up = jnp.split(u @ w_gu, 2, axis=-1)
    return (jax.nn.silu(gate) * up) @ w_down


def _ssd(x, dt, A, Bm, Cm, h0):
    b, l = x.shape[:2]
    q = min(CHUNK, l)
    nc = -(-l // q)
    pad = nc * q - l
    if pad:
        padw = lambda a: jnp.pad(a, [(0, 0), (0, pad)] + [(0, 0)] * (a.ndim - 2))
        x, dt, Bm, Cm = padw(x), padw(dt), padw(Bm), padw(Cm)
    rs = lambda a: a.reshape((b, nc, q) + a.shape[2:])
    x, dt, Bm, Cm = rs(x), rs(dt), rs(Bm), rs(Cm)
    a_cs = jnp.cumsum(dt * A, axis=2)
    causal = jnp.tril(jnp.ones((q, q), dtype=bool))
    diff = a_cs[:, :, :, None] - a_cs[:, :, None, :]
    decay = jnp.exp(jnp.where(causal[:, :, None, None], diff, -jnp.inf))
    cb = jnp.einsum('bcqgn,bcsgn->bcqsg', Cm, Bm).astype(jnp.float32)
    w_in = cb[..., None] * decay * dt[:, :, None]
    y_diag = jnp.einsum('bcqsgr,bcsgrp->bcqgrp', w_in, x)
    decay_s = jnp.exp(a_cs[:, :, -1:] - a_cs)
    xw = (decay_s * dt)[..., None] * x
    st = jnp.einsum('bcsgn,bcsgrp->bcgrpn', Bm, xw).astype(jnp.float32)
    chunk_decay = jnp.exp(a_cs[:, :, -1])

    def step(h, inp):
        d, s = inp
        return d[..., None, None] * h + s, h

    h_last, h_prev = lax.scan(step, h0.astype(jnp.float32),
                              (jnp.moveaxis(chunk_decay, 1, 0), jnp.moveaxis(st, 1, 0)))
    y_off = jnp.einsum('bcqgn,cbgrpn->bcqgrp', Cm, h_prev) * jnp.exp(a_cs)[..., None]
    y = (y_diag + y_off).reshape((b, nc * q) + x.shape[3:])[:, :l]
    return y, h_last


def _pool(v, prev, pos0):
    l = v.shape[1]
    ext = jnp.concatenate([prev.astype(v.dtype), v], axis=1)
    cs = jnp.cumsum(ext.astype(jnp.float32), axis=1)
    cs = jnp.pad(cs, [(0, 0), (1, 0), (0, 0)])
    t = jnp.arange(l)
    outs = []
    for gi, w in enumerate(POOL_WINDOWS):
        sl = slice(gi * POOL_GC, (gi + 1) * POOL_GC)
        s = cs[:, POOL_BUF + 1:POOL_BUF + 1 + l, sl] - cs[:, POOL_BUF + 1 - w:POOL_BUF + 1 - w + l, sl]
        cnt = jnp.minimum(pos0 + t + 1, w).astype(jnp.float32)
        outs.append(s / cnt[None, :, None])
    mean = jnp.concatenate(outs, axis=-1)
    return (mean - v.astype(jnp.float32)).astype(v.dtype), ext[:, -POOL_BUF:]


def _layer(x, p, ssm0, conv0, pool0, pos0,
           norm_ffn1, w_ffn1_gu, w_ffn1_down, norm_mix, w_in, conv_w, conv_b,
           dt_bias, a_log, d_skip, norm_ssd, w_ssd_out, w_pool_group, pool_scale,
           w_pool_out, w_o, norm_ffn2, w_ffn2_gu, w_ffn2_down, norm_ple, w_ple_gate, w_ple):
    b, l, _ = x.shape
    h = x + 0.5 * _swiglu(_rmsnorm(x, norm_ffn1), w_ffn1_gu, w_ffn1_down)
    u = _rmsnorm(h, norm_mix)
    proj = u @ w_in
    cuts = np.cumsum([D_INNER, CONV_DIM, N_HEADS, POOL_DIM]).tolist()
    z, xbc, dt_raw, v, gates = jnp.split(proj, cuts, axis=-1)
    ext = jnp.concatenate([conv0.astype(xbc.dtype), xbc], axis=1)
    conv = conv_b + sum(ext[:, k:k + l] * conv_w[k] for k in range(CONV_W))
    new_conv = ext[:, -(CONV_W - 1):]
    xbc = jax.nn.silu(conv)
    xs, Bm, Cm = jnp.split(xbc, [D_INNER, D_INNER + N_GROUPS * D_STATE], axis=-1)
    xs = xs.reshape(b, l, N_GROUPS, HEADS_PER_GROUP, HEAD_DIM)
    Bm = Bm.reshape(b, l, N_GROUPS, D_STATE)
    Cm = Cm.reshape(b, l, N_GROUPS, D_STATE)
    dt = jax.nn.softplus(dt_raw.astype(jnp.float32) + dt_bias.astype(jnp.float32))
    dt = dt.reshape(b, l, N_GROUPS, HEADS_PER_GROUP)
    A = -jnp.exp(a_log.astype(jnp.float32)).reshape(N_GROUPS, HEADS_PER_GROUP)
    h0 = ssm0.reshape(b, N_GROUPS, HEADS_PER_GROUP, HEAD_DIM, D_STATE)
    y, h_last = _ssd(xs, dt, A, Bm, Cm, h0)
    y = y + d_skip.reshape(N_GROUPS, HEADS_PER_GROUP)[..., None] * xs
    y = y.reshape(b, l, D_INNER).astype(x.dtype) * jax.nn.silu(z)
    y = _rmsnorm(y.reshape(b, l, N_GROUPS, D_INNER // N_GROUPS),
                 norm_ssd.reshape(N_GROUPS, D_INNER // N_GROUPS)).reshape(b, l, D_INNER)
    a_branch = y @ w_ssd_out
    pooled, new_pool = _pool(v, pool0, pos0)
    pooled = jnp.einsum('blgc,gcd->blgd', pooled.reshape(b, l, N_POOL_GROUPS, POOL_GC), w_pool_group)
    b_branch = (pooled.reshape(b, l, POOL_DIM) * pool_scale) @ w_pool_out
    g = jax.nn.sigmoid(gates.astype(jnp.float32)).reshape(b, l, N_BRANCH, D_MODEL).astype(x.dtype)
    h = h + (g[:, :, 0] * a_branch + g[:, :, 1] * b_branch) @ w_o
    h = h + 0.5 * _swiglu(_rmsnorm(h, norm_ffn2), w_ffn2_gu, w_ffn2_down)
    pg = jax.nn.sigmoid((_rmsnorm(h, norm_ple) @ w_ple_gate).astype(jnp.float32)).astype(x.dtype)
    h = h + pg * (p @ w_ple)
    new_ssm = h_last.reshape(b, N_HEADS, HEAD_DIM, D_STATE).astype(ssm0.dtype)
    return h, new_ssm, new_conv, new_pool


def setup_inputs(seed: int = 0) -> dict:
    key = jax.random.key(seed)
    ks = iter(jax.random.split(key, 48))
    f32 = jnp.float32
    nrm = lambda shape, s: jax.random.normal(next(ks), shape, f32) * s
    gain = lambda shape: 1.0 + nrm(shape, 0.02)
    d = {}
    d['x_prompt'] = nrm((BATCH, SEQ, D_MODEL), 1.0)
    d['x_sample'] = nrm((DEC_BATCH, DEC_SEQ, D_MODEL), 1.0)
    d['state_ssm'] = nrm((DEPTH, DEC_BATCH, N_HEADS, HEAD_DIM, D_STATE), 0.1)
    d['state_conv'] = nrm((DEPTH, DEC_BATCH, CONV_W - 1, CONV_DIM), 1.0)
    d['state_pool'] = nrm((DEPTH, DEC_BATCH, POOL_BUF, POOL_DIM), 1.0)
    d['p_prompt'] = nrm((DEPTH, BATCH, SEQ, PLE_DIM), 1.0)
    d['p_sample'] = nrm((DEPTH, DEC_BATCH, DEC_SEQ, PLE_DIM), 1.0)
    d['norm_ffn1'] = gain((DEPTH, D_MODEL))
    d['w_ffn1_gu'] = nrm((DEPTH, D_MODEL, 2 * D_FF), D_MODEL ** -0.5)
    d['w_ffn1_down'] = nrm((DEPTH, D_FF, D_MODEL), D_FF ** -0.5)
    d['norm_mix'] = gain((DEPTH, D_MODEL))
    d['w_in'] = nrm((DEPTH, D_MODEL, IN_DIM), D_MODEL ** -0.5)
    d['conv_w'] = nrm((DEPTH, CONV_W, CONV_DIM), CONV_W ** -0.5)
    d['conv_b'] = nrm((DEPTH, CONV_DIM), 0.01)
    dt0 = jnp.exp(jax.random.uniform(next(ks), (DEPTH, N_HEADS), f32,
                                     minval=math.log(1e-3), maxval=math.log(1e-1)))
    d['dt_bias'] = dt0 + jnp.log(-jnp.expm1(-dt0))
    d['a_log'] = jnp.log(jax.random.uniform(next(ks), (DEPTH, N_HEADS), f32, minval=1.0, maxval=16.0))
    d['d_skip'] = gain((DEPTH, N_HEADS))
    d['norm_ssd'] = gain((DEPTH, D_INNER))
    d['w_ssd_out'] = nrm((DEPTH, D_INNER, D_MODEL), D_INNER ** -0.5)
    d['w_pool_group'] = nrm((DEPTH, N_POOL_GROUPS, POOL_GC, POOL_GC), POOL_GC ** -0.5)
    d['pool_scale'] = gain((DEPTH, POOL_DIM))
    d['w_pool_out'] = nrm((DEPTH, POOL_DIM, D_MODEL), POOL_DIM ** -0.5)
    d['w_o'] = nrm((DEPTH, D_MODEL, D_MODEL), D_MODEL ** -0.5)
    d['norm_ffn2'] = gain((DEPTH, D_MODEL))
    d['w_ffn2_gu'] = nrm((DEPTH, D_MODEL, 2 * D_FF), D_MODEL ** -0.5)
    d['w_ffn2_down'] = nrm((DEPTH, D_FF, D_MODEL), D_FF ** -0.5)
    d['norm_ple'] = gain((DEPTH, D_MODEL))
    d['w_ple_gate'] = nrm((DEPTH, D_MODEL, D_MODEL), D_MODEL ** -0.5)
    d['w_ple'] = nrm((DEPTH, PLE_DIM, D_MODEL), PLE_DIM ** -0.5)
    d['norm_final'] = gain((D_MODEL,))
    return d


def reference(x_prompt, x_sample, state_ssm, state_conv, state_pool, p_prompt, p_sample,
              norm_ffn1, w_ffn1_gu, w_ffn1_down, norm_mix, w_in, conv_w, conv_b,
              dt_bias, a_log, d_skip, norm_ssd, w_ssd_out, w_pool_group, pool_scale,
              w_pool_out, w_o, norm_ffn2, w_ffn2_gu, w_ffn2_down, norm_ple, w_ple_gate,
              w_ple, norm_final):
    hp, hs = x_prompt, x_sample
    ssm_p, conv_p, pool_p, ssm_s, conv_s, pool_s = [], [], [], [], [], []
    for i in range(DEPTH):
        w = (norm_ffn1[i], w_ffn1_gu[i], w_ffn1_down[i], norm_mix[i], w_in[i], conv_w[i], conv_b[i],
             dt_bias[i], a_log[i], d_skip[i], norm_ssd[i], w_ssd_out[i], w_pool_group[i],
             pool_scale[i], w_pool_out[i], w_o[i], norm_ffn2[i], w_ffn2_gu[i], w_ffn2_down[i],
             norm_ple[i], w_ple_gate[i], w_ple[i])
        z_ssm = jnp.zeros((BATCH, N_HEADS, HEAD_DIM, D_STATE), state_ssm.dtype)
        z_conv = jnp.zeros((BATCH, CONV_W - 1, CONV_DIM), hp.dtype)
        z_pool = jnp.zeros((BATCH, POOL_BUF, POOL_DIM), hp.dtype)
        hp, s1, c1, q1 = _layer(hp, p_prompt[i], z_ssm, z_conv, z_pool, 0, *w)
        hs, s2, c2, q2 = _layer(hs, p_sample[i], state_ssm[i], state_conv[i], state_pool[i], PAST_LEN, *w)
        ssm_p.append(s1); conv_p.append(c1); pool_p.append(q1)
        ssm_s.append(s2); conv_s.append(c2); pool_s.append(q2)
    y_prompt = _rmsnorm(hp, norm_final)
    y_sample = _rmsnorm(hs, norm_final)
    return (y_prompt, y_sample, jnp.stack(ssm_p), jnp.stack(conv_p), jnp.stack(pool_p),
            jnp.stack(ssm_s), jnp.stack(conv_s), jnp.stack(pool_s))
```

```cpp
#include <hip/hip_runtime.h>
#include <cstdio>
#include <cstdint>

#ifndef MK_MULTI_LAUNCH
#define MK_MULTI_LAUNCH 1
#endif

#define GAS __attribute__((address_space(1)))
#define LAS __attribute__((address_space(3)))
typedef unsigned short bf16_t;
typedef short bf16x8 __attribute__((ext_vector_type(8)));
typedef float f32x4 __attribute__((ext_vector_type(4)));
typedef float f32x2 __attribute__((ext_vector_type(2)));
typedef unsigned u32x4 __attribute__((ext_vector_type(4)));
typedef unsigned u32x2 __attribute__((ext_vector_type(2)));
typedef GAS unsigned gu32;

constexpr int DM = 1024, BATCH = 8, SEQ = 2048, DECB = 128, DECS = 8;
constexpr int MP = BATCH * SEQ, MS = DECB * DECS, M = MP + MS;
constexpr int DI = 2048, HD = 64, NH = 32, NG = 8, HPG = 4, DSTATE = 128, CD = 4096;
constexpr int PD = 1024, PBUF = 15, DFF = 2816, PLE = 256;
constexpr int IN_DIM = 9248, NIN = 9472;
constexpr float EPS = 1e-6f;
constexpr int NWAVES = 8, NTHREADS = 512;

constexpr size_t MiB = 1u << 20;
constexpr size_t WS_CTL = 0, CTL_ZERO_BYTES = 1 * MiB;
constexpr size_t WS_STATS_A = 2 * MiB, WS_STATS_B = 4 * MiB, WS_DT = 6 * MiB;
constexpr size_t WS_WGU1 = 10 * MiB, WS_WD1 = 21 * MiB, WS_WIN = 27 * MiB, WS_WSSO = 46 * MiB, WS_W2 = 50 * MiB, WS_WO = 52 * MiB,
                 WS_WGU2 = 54 * MiB, WS_WD2 = 65 * MiB, WS_WPG = 71 * MiB, WS_WPLE = 73 * MiB, WS_PB = 74 * MiB;
constexpr size_t WS_Z = 84 * MiB, WS_XBC = 152 * MiB, WS_V = 288 * MiB, WS_GATES = 322 * MiB, WS_HB = 390 * MiB, WS_POOLED = 424 * MiB, WS_END = 458 * MiB;
constexpr size_t WS_ACT = WS_XBC, WS_T1 = WS_XBC, WS_MERGED = WS_V, WS_Q = WS_GATES, WS_XB = WS_HB;
static_assert(WS_STATS_A + (size_t)M * 16 * 4 <= WS_STATS_B && WS_STATS_B + (size_t)M * 16 * 4 <= WS_DT && WS_DT + (size_t)M * 32 * 4 <= WS_WGU1, "ws map (small)");
static_assert(WS_WGU1 + (size_t)2 * DFF * DM * 2 <= WS_WD1 && WS_WD1 + (size_t)DM * DFF * 2 <= WS_WIN && WS_WIN + (size_t)NIN * DM * 2 <= WS_WSSO && WS_WSSO + (size_t)DM * DI * 2 <= WS_W2, "ws map (w1)");
static_assert(WS_WGU2 + (size_t)2 * DFF * DM * 2 <= WS_WD2 && WS_WD2 + (size_t)DM * DFF * 2 <= WS_WPG && WS_WPLE + (size_t)DM * PLE * 2 <= WS_PB && WS_PB + (size_t)M * PLE * 2 <= WS_Z, "ws map (w2)");
static_assert(WS_Z + (size_t)M * DI * 2 <= WS_XBC && WS_XBC + (size_t)M * CD * 2 <= WS_V && WS_V + (size_t)M * PD * 2 <= WS_GATES && WS_GATES + (size_t)M * 2 * DM * 2 <= WS_HB &&
              WS_HB + (size_t)M * DM * 2 <= WS_POOLED && WS_POOLED + (size_t)M * DM * 2 <= WS_END, "ws map (act)");
static_assert(WS_ACT + (size_t)M * DFF * 2 <= WS_V && WS_T1 + (size_t)M * DM * 4 <= WS_V, "ws overlays");
constexpr int CW_BAR = 4096;

constexpr size_t O_Y = 0, O_SSM_P = (size_t)M * DM, O_CONV_P = O_SSM_P + (size_t)BATCH * NH * HD * DSTATE, O_POOL_P = O_CONV_P + (size_t)BATCH * 3 * CD,
                 O_SSM_S = O_POOL_P + (size_t)BATCH * PBUF * PD, O_CONV_S = O_SSM_S + (size_t)DECB * NH * HD * DSTATE, O_POOL_S = O_CONV_S + (size_t)DECB * 3 * CD,
                 O_END = O_POOL_S + (size_t)DECB * PBUF * PD;

constexpr int RING_BYTES = 131072, LDSCTL_OFF = RING_BYTES, MISC_OFF = LDSCTL_OFF + 320, LDS_BYTES = 147456;

#define RLX_AGENT __ATOMIC_RELAXED, __HIP_MEMORY_SCOPE_AGENT
#define LDS_WAIT() asm volatile("s_waitcnt lgkmcnt(0)" ::: "memory")
#define VM_WAIT() asm volatile("s_waitcnt vmcnt(0)" ::: "memory")

__device__ __forceinline__ unsigned f2bf(float f) { unsigned u = __builtin_bit_cast(unsigned, f); return (u + 0x7fffu + ((u >> 16) & 1u)) >> 16; }
__device__ __forceinline__ unsigned pk2(float lo, float hi) { return f2bf(lo) | (f2bf(hi) << 16); }
__device__ __forceinline__ float bf2f(unsigned b) { return __builtin_bit_cast(float, b << 16); }
__device__ __forceinline__ float bflo(unsigned w) { return __builtin_bit_cast(float, w << 16); }
__device__ __forceinline__ float bfhi(unsigned w) { return __builtin_bit_cast(float, w & 0xffff0000u); }
__device__ __forceinline__ unsigned cvt_pk_bf16(float lo, float hi) { unsigned r; asm volatile("v_cvt_pk_bf16_f32 %0, %1, %2" : "=v"(r) : "v"(lo), "v"(hi)); return r; }
__device__ __forceinline__ float sigm_f(float x) { return 1.0f / (1.0f + __expf(-x)); }
__device__ __forceinline__ float silu_f(float x) { return x / (1.0f + __expf(-x)); }
__device__ __forceinline__ float wave_sum(float v) {
#pragma unroll
    for (int o = 1; o < 64; o <<= 1) v += __shfl_xor(v, o);
    return v;
}

struct Frame {
    LAS unsigned char* lds;
    volatile LAS unsigned* MISC;
    gu32* ctl;
    int tid, lane, wave, vcu, G;
    unsigned char* ws;
    float* out;
    const float* in[30];
};
enum { I_XP = 0, I_XS, I_SSM, I_CONV, I_POOL, I_PP, I_PS, I_NFFN1, I_WGU1, I_WD1, I_NMIX, I_WIN, I_CONVW, I_CONVB, I_DTB, I_ALOG, I_DSKIP, I_NSSD, I_WSSO, I_WPGRP, I_PSCALE,
       I_WPOUT, I_WO, I_NFFN2, I_WGU2, I_WD2, I_NPLE, I_WPG, I_WPLE, I_NFINAL };

namespace pg8 {
constexpr int BM = 256, BK = 64, HALF = 128, HTB = HALF * BK * 2, STAGE_BYTES = 8 * HTB, NXCD = 8, WGM = 8;
__host__ __device__ __forceinline__ int lds_byte(int r, int c) { const int st = (r >> 4) * 2 + (c >> 5), rr = r & 15, cc = c & 31, ob = rr * 64 + cc * 2; return st * 1024 + (ob ^ (((ob >> 9) & 1) << 5)); }
__host__ __device__ __forceinline__ void stage_rc(int b, int& R, int& C) { const int st = b / 1024, sb = b % 1024, swz = sb ^ (((sb >> 9) & 1) << 5); R = (st >> 1) * 16 + swz / 64; C = (st & 1) * 32 + (swz % 64) / 2; }
__host__ __device__ __forceinline__ int perm32(int rho) { const int n = rho >> 4, i = rho & 15; return 8 * (i >> 2) + 4 * n + (i & 3); }
struct Unit { int pm, pn; };
struct Gemm { const bf16_t* A; const bf16_t* Bt; int M, N, K; };
struct StaticOrder {
    int nM, nN, nwg, G, c;
    __host__ __device__ void init(int M_, int N_, int G_, int c_) { nM = M_ / BM; nN = N_ / BM; nwg = nM * nN; G = G_; c = c_; }
    __host__ __device__ bool next(int i, Unit& u) const {
        const long L = (long)i * G + c; if (L >= nwg) return false;
        int wgid = (int)L; { const int q = nwg / NXCD, r = nwg % NXCD, xcd = wgid % NXCD, off = wgid / NXCD; wgid = (xcd < r ? xcd * (q + 1) : r * (q + 1) + (xcd - r) * q) + off; }
        const int nig = WGM * nN, gid = wgid / nig, fm = gid * WGM, gsz = (nM - fm) < WGM ? (nM - fm) : WGM;
        u.pm = fm + ((wgid % nig) % gsz); u.pn = (wgid % nig) / gsz; return true;
    }
};

enum EpiKind { EK_GU = 1, EK_RES = 2, EK_WIN = 3, EK_T1 = 4, EK_MERGE = 5, EK_BF16 = 6, EK_PLE = 7 };
struct Epi {
    const float* stats_in;
    float* stats_out;
    bf16_t* obf;
    float* of32;
    const float* res_p; const float* res_s;
    const bf16_t* gates;
    const bf16_t* q;
    bf16_t *Z, *XBC, *V, *GATES; float* DT; const float* dt_bias; float *conv_p, *conv_s, *pool_p, *pool_s;
    int kind; int ldo; float coef; int pad;
};

__device__ __forceinline__ u32x4 pack8(const f32x4 a, const f32x4 b) { u32x4 w; w.x = cvt_pk_bf16(a[0], a[1]); w.y = cvt_pk_bf16(a[2], a[3]); w.z = cvt_pk_bf16(b[0], b[1]); w.w = cvt_pk_bf16(b[2], b[3]); return w; }
__device__ __forceinline__ void unpack8(const u32x4 w, f32x4& a, f32x4& b) { a = (f32x4){bflo(w.x), bfhi(w.x), bflo(w.y), bfhi(w.y)}; b = (f32x4){bflo(w.z), bfhi(w.z), bflo(w.w), bfhi(w.w)}; }

__device__ __forceinline__ float row_rs(const float* stats, int row) {
    if (!stats) return 1.0f;
    const GAS f32x4* sp = (const GAS f32x4*)(stats + (size_t)row * 16);
    const f32x4 a = sp[0], b = sp[1], c = sp[2], d = sp[3]; const f32x4 s = (a + b) + (c + d);
    return __builtin_amdgcn_rsqf(((s[0] + s[1]) + (s[2] + s[3])) * (1.0f / 1024.0f) + EPS);
}
__device__ __forceinline__ float softplus_f(float x) { const float e = __expf(-fabsf(x)); const float l = (e < 0.01f) ? e * (1.0f - e * (0.5f - e * (1.0f / 3.0f))) : __logf(1.0f + e); return fmaxf(x, 0.f) + l; }

__device__ __forceinline__ void epilogue(const Epi& E, const f32x4 (&acc)[2][2][4][2], const Unit& u, int wr, int wc, int fr, int fq) {
    const int rowb = u.pm * BM + wr * 64 + fr;
    const int cin = wc * 32 + 8 * fq;
    if (E.kind == EK_GU) {
#pragma unroll
        for (int ai = 0; ai < 2; ++ai)
#pragma unroll
            for (int m = 0; m < 4; ++m) { const int row = rowb + ai * HALF + m * 16; const float r = row_rs(E.stats_in, row);
                const f32x4 g0 = acc[ai][0][m][0] * r, u0 = acc[ai][1][m][0] * r, g1 = acc[ai][0][m][1] * r, u1 = acc[ai][1][m][1] * r;
                const f32x4 o0 = (f32x4){silu_f(g0[0]) * u0[0], silu_f(g0[1]) * u0[1], silu_f(g0[2]) * u0[2], silu_f(g0[3]) * u0[3]};
                const f32x4 o1 = (f32x4){silu_f(g1[0]) * u1[0], silu_f(g1[1]) * u1[1], silu_f(g1[2]) * u1[2], silu_f(g1[3]) * u1[3]};
                *(GAS u32x4*)(E.obf + (size_t)row * E.ldo + u.pn * HALF + cin) = pack8(o0, o1); }
    } else if (E.kind == EK_RES) {
#pragma unroll
        for (int ai = 0; ai < 2; ++ai)
#pragma unroll
            for (int m = 0; m < 4; ++m) { const int row = rowb + ai * HALF + m * 16;
                const float* rp = (row < MP) ? E.res_p + (size_t)row * DM : E.res_s + (size_t)(row - MP) * DM;
                float ss = 0.f;
#pragma unroll
                for (int bj = 0; bj < 2; ++bj) { const int col = u.pn * BM + bj * HALF + cin;
                    const f32x4 r0 = *(const GAS f32x4*)(rp + col), r1 = *(const GAS f32x4*)(rp + col + 4);
                    const f32x4 h0 = r0 + acc[ai][bj][m][0] * E.coef, h1 = r1 + acc[ai][bj][m][1] * E.coef;
                    *(GAS f32x4*)(E.of32 + (size_t)row * DM + col) = h0; *(GAS f32x4*)(E.of32 + (size_t)row * DM + col + 4) = h1;
                    *(GAS u32x4*)(E.obf + (size_t)row * DM + col) = pack8(h0, h1);
                    ss += (h0[0] * h0[0] + h0[1] * h0[1]) + (h0[2] * h0[2] + h0[3] * h0[3]) + (h1[0] * h1[0] + h1[1] * h1[1]) + (h1[2] * h1[2] + h1[3] * h1[3]); }
                ss += __shfl_xor(ss, 16); ss += __shfl_xor(ss, 32);
                if (fq == 0) *(GAS float*)(E.stats_out + (size_t)row * 16 + u.pn * 4 + wc) = ss; }
    } else if (E.kind == EK_WIN) {
        const int pn = u.pn;
        if (pn < 8 || (pn >= 28 && pn < 36)) {
            const bool isz = pn < 8; bf16_t* const O = isz ? E.Z : E.GATES; const int colt = (isz ? pn : pn - 28) * BM + cin;
#pragma unroll
            for (int ai = 0; ai < 2; ++ai)
#pragma unroll
                for (int m = 0; m < 4; ++m) { const int row = rowb + ai * HALF + m * 16; const float r = row_rs(E.stats_in, row);
#pragma unroll
                    for (int bj = 0; bj < 2; ++bj) { f32x4 v0 = acc[ai][bj][m][0] * r, v1 = acc[ai][bj][m][1] * r;
#pragma unroll
                        for (int j = 0; j < 4; ++j) { const float s0 = sigm_f(v0[j]), s1 = sigm_f(v1[j]); v0[j] = isz ? v0[j] * s0 : s0; v1[j] = isz ? v1[j] * s1 : s1; }
                        *(GAS u32x4*)(O + (size_t)row * (2 * DM) + colt + bj * HALF) = pack8(v0, v1); } }
        } else if (pn < 28) {
            const bool isx = pn < 24; bf16_t* const O = isx ? E.XBC : E.V; const int ldo = isx ? CD : PD; const int colt = (isx ? pn - 8 : pn - 24) * BM + cin;
            const int keep = isx ? 3 : PBUF;
#pragma unroll
            for (int ai = 0; ai < 2; ++ai)
#pragma unroll
                for (int m = 0; m < 4; ++m) { const int row = rowb + ai * HALF + m * 16; const float r = row_rs(E.stats_in, row);
                    float* sp = nullptr;
                    if (row < MP) { const int sb = row >> 11, st = row & (SEQ - 1); if (st >= SEQ - keep) sp = (isx ? E.conv_p : E.pool_p) + ((size_t)sb * keep + (st - (SEQ - keep))) * ldo + colt; }
                    else { const int sb = (row - MP) >> 3, st = (row - MP) & 7; const int si = st - (DECS - keep); if (si >= 0) sp = (isx ? E.conv_s : E.pool_s) + ((size_t)sb * keep + si) * ldo + colt; }
#pragma unroll
                    for (int bj = 0; bj < 2; ++bj) { const f32x4 v0 = acc[ai][bj][m][0] * r, v1 = acc[ai][bj][m][1] * r;
                        *(GAS u32x4*)(O + (size_t)row * ldo + colt + bj * HALF) = pack8(v0, v1);
                        if (sp) { *(GAS f32x4*)(sp + bj * HALF) = v0; *(GAS f32x4*)(sp + bj * HALF + 4) = v1; } } }
        } else if (wc == 0) {
            const f32x4 b0 = *(const GAS f32x4*)(E.dt_bias + 8 * fq), b1 = *(const GAS f32x4*)(E.dt_bias + 8 * fq + 4);
#pragma unroll
            for (int ai = 0; ai < 2; ++ai)
#pragma unroll
                for (int m = 0; m < 4; ++m) { const int row = rowb + ai * HALF + m * 16; const float r = row_rs(E.stats_in, row);
                    f32x4 v0 = acc[ai][0][m][0] * r + b0, v1 = acc[ai][0][m][1] * r + b1;
#pragma unroll
                    for (int j = 0; j < 4; ++j) { v0[j] = softplus_f(v0[j]); v1[j] = softplus_f(v1[j]); }
                    *(GAS f32x4*)(E.DT + (size_t)row * 32 + 8 * fq) = v0; *(GAS f32x4*)(E.DT + (size_t)row * 32 + 8 * fq + 4) = v1; }
        }
    } else if (E.kind == EK_T1) {
#pragma unroll
        for (int ai = 0; ai < 2; ++ai)
#pragma unroll
            for (int m = 0; m < 4; ++m) { const int row = rowb + ai * HALF + m * 16;
#pragma unroll
                for (int bj = 0; bj < 2; ++bj) { const int col = u.pn * BM + bj * HALF + cin;
                    f32x4 g0, g1; unpack8(*(const GAS u32x4*)(E.gates + (size_t)row * (2 * DM) + col), g0, g1);
                    *(GAS f32x4*)(E.of32 + (size_t)row * DM + col) = g0 * acc[ai][bj][m][0]; *(GAS f32x4*)(E.of32 + (size_t)row * DM + col + 4) = g1 * acc[ai][bj][m][1]; } }
    } else if (E.kind == EK_MERGE) {
#pragma unroll
        for (int ai = 0; ai < 2; ++ai)
#pragma unroll
            for (int m = 0; m < 4; ++m) { const int row = rowb + ai * HALF + m * 16;
#pragma unroll
                for (int bj = 0; bj < 2; ++bj) { const int col = u.pn * BM + bj * HALF + cin;
                    f32x4 g0, g1; unpack8(*(const GAS u32x4*)(E.gates + (size_t)row * (2 * DM) + DM + col), g0, g1);
                    const f32x4 t0 = *(const GAS f32x4*)(E.res_p + (size_t)row * DM + col), t1 = *(const GAS f32x4*)(E.res_p + (size_t)row * DM + col + 4);
                    *(GAS u32x4*)(E.obf + (size_t)row * DM + col) = pack8(t0 + g0 * acc[ai][bj][m][0], t1 + g1 * acc[ai][bj][m][1]); } }
    } else if (E.kind == EK_BF16) {
#pragma unroll
        for (int ai = 0; ai < 2; ++ai)
#pragma unroll
            for (int m = 0; m < 4; ++m) { const int row = rowb + ai * HALF + m * 16;
#pragma unroll
                for (int bj = 0; bj < 2; ++bj) { const int col = u.pn * BM + bj * HALF + cin;
                    *(GAS u32x4*)(E.obf + (size_t)row * E.ldo + col) = pack8(acc[ai][bj][m][0], acc[ai][bj][m][1]); } }
    } else if (E.kind == EK_PLE) {
#pragma unroll
        for (int ai = 0; ai < 2; ++ai)
#pragma unroll
            for (int m = 0; m < 4; ++m) { const int row = rowb + ai * HALF + m * 16; const float r = row_rs(E.stats_in, row);
                float ss = 0.f;
#pragma unroll
                for (int bj = 0; bj < 2; ++bj) { const int col = u.pn * BM + bj * HALF + cin;
                    f32x4 q0, q1; unpack8(*(const GAS u32x4*)(E.q + (size_t)row * DM + col), q0, q1);
                    const f32x4 r0 = *(const GAS f32x4*)(E.of32 + (size_t)row * DM + col), r1 = *(const GAS f32x4*)(E.of32 + (size_t)row * DM + col + 4);
                    f32x4 h0, h1;
#pragma unroll
                    for (int j = 0; j < 4; ++j) { h0[j] = r0[j] + sigm_f(acc[ai][bj][m][0][j] * r) * q0[j]; h1[j] = r1[j] + sigm_f(acc[ai][bj][m][1][j] * r) * q1[j]; }
                    *(GAS f32x4*)(E.of32 + (size_t)row * DM + col) = h0; *(GAS f32x4*)(E.of32 + (size_t)row * DM + col + 4) = h1;
                    ss += (h0[0] * h0[0] + h0[1] * h0[1]) + (h0[2] * h0[2] + h0[3] * h0[3]) + (h1[0] * h1[0] + h1[1] * h1[1]) + (h1[2] * h1[2] + h1[3] * h1[3]); }
                ss += __shfl_xor(ss, 16); ss += __shfl_xor(ss, 32);
                if (fq == 0) *(GAS float*)(E.stats_out + (size_t)row * 16 + u.pn * 4 + wc) = ss; }
    }
}

__device__ __forceinline__ void gemm_phase(LAS unsigned char* lds, const Gemm g, const StaticOrder& S, const Epi& E) {
    const int tid = threadIdx.x, wid = __builtin_amdgcn_readfirstlane(tid >> 6), lane = tid & 63, wr = wid >> 2, wc = wid & 3, fr = lane & 15, fq = lane >> 4;
    const int K = g.K, nt = K / BK;
    unsigned voffA[2], voffB[2];
#pragma unroll
    for (int i = 0; i < 2; ++i) { int R, C; stage_rc(tid * 16 + i * 8192, R, C); const int Rb = (R & ~31) + perm32(R & 31);
        voffA[i] = (unsigned)(R * K + C) * 2u; voffB[i] = (unsigned)(Rb * K + C) * 2u; }
    const size_t kstep = (size_t)(BK * 2);
    const size_t hstep = (size_t)HALF * K * 2;
    const size_t tstep = 2 * hstep;
    const unsigned ldsw = (unsigned)wid * 1024u;
    const int aoff = lds_byte(wr * 64 + fr, fq * 8), boff = lds_byte(wc * 32 + fr, fq * 8);
#define PG8_SA(b, h) (((b) * 2 + (h)) * HTB)
#define PG8_SB(b, h) ((4 + (b) * 2 + (h)) * HTB)
#define PG8_STAGE(bufoff, gbase, voff) do { _Pragma("unroll") for (int _i = 0; _i < 2; ++_i) \
        __builtin_amdgcn_global_load_lds((const unsigned*)((const char*)(gbase) + (voff)[_i]), (LAS unsigned*)(lds + (bufoff) + ldsw + _i * 8192), 16, 0, 0); } while (0)
#define PG8_LDA(dst, b, h) do { _Pragma("unroll") for (int m = 0; m < 4; ++m) _Pragma("unroll") for (int k = 0; k < 2; ++k) dst[m][k] = *(const LAS bf16x8*)(lds + PG8_SA(b, h) + aoff + m * 2048 + k * 1024); } while (0)
#define PG8_LDB(dst, b, h) do { _Pragma("unroll") for (int n = 0; n < 2; ++n) _Pragma("unroll") for (int k = 0; k < 2; ++k) dst[n][k] = *(const LAS bf16x8*)(lds + PG8_SB(b, h) + boff + n * 2048 + k * 1024); } while (0)
#define PG8_MMA(ai, bj, At, Bt) do { __builtin_amdgcn_s_setprio(1); _Pragma("unroll") for (int m = 0; m < 4; ++m) _Pragma("unroll") for (int n = 0; n < 2; ++n) _Pragma("unroll") for (int k = 0; k < 2; ++k) \
        acc[ai][bj][m][n] = __builtin_amdgcn_mfma_f32_16x16x32_bf16(Bt[n][k], At[m][k], acc[ai][bj][m][n], 0, 0, 0); __builtin_amdgcn_s_setprio(0); } while (0)
#define PG8_WAIT_V(n) asm volatile("s_waitcnt vmcnt(" #n ")" ::: "memory")
#define PG8_WAIT_L(n) asm volatile("s_waitcnt lgkmcnt(" #n ")" ::: "memory")
#define PG8_BAR __builtin_amdgcn_s_barrier()
#define PG8_SCHED __builtin_amdgcn_sched_barrier(0)
    Unit cur, nxt; int ui = 0;
    if (!S.next(0, cur)) return;
    f32x4 acc[2][2][4][2];
#pragma unroll
    for (int a = 0; a < 2; ++a)
#pragma unroll
        for (int b = 0; b < 2; ++b)
#pragma unroll
            for (int m = 0; m < 4; ++m)
#pragma unroll
                for (int n = 0; n < 2; ++n) acc[a][b][m][n] = (f32x4){0.f, 0.f, 0.f, 0.f};
    bf16x8 At[4][2], B0[2][2], B1[2][2];
    const char* cA = (const char*)g.A + (size_t)cur.pm * tstep; const char* cB = (const char*)g.Bt + (size_t)cur.pn * tstep;
    PG8_STAGE(PG8_SB(0, 0), cB, voffB); PG8_STAGE(PG8_SB(0, 1), cB + hstep, voffB); PG8_STAGE(PG8_SA(0, 0), cA, voffA); PG8_STAGE(PG8_SA(0, 1), cA + hstep, voffA);
    if (wr == 1) PG8_BAR;
    PG8_WAIT_V(2); PG8_BAR;
    PG8_STAGE(PG8_SB(1, 0), cB + kstep, voffB); PG8_STAGE(PG8_SA(1, 0), cA + kstep, voffA); PG8_STAGE(PG8_SB(1, 1), cB + hstep + kstep, voffB);
    PG8_WAIT_V(6); PG8_BAR;
    for (;;) {
        const bool has_next = S.next(ui + 1, nxt);
        const char* nA = has_next ? (const char*)g.A + (size_t)nxt.pm * tstep : cA; const char* nB = has_next ? (const char*)g.Bt + (size_t)nxt.pn * tstep : cB;
        for (int t = 0; t < nt; t += 2) {
            const bool last = (t == nt - 2);
            const char* a1 = cA + (size_t)(t + 1) * kstep;
            const char* a2 = last ? nA : cA + (size_t)(t + 2) * kstep; const char* b2 = last ? nB : cB + (size_t)(t + 2) * kstep;
            const char* a3 = a2 + kstep; const char* b3 = b2 + kstep;
            PG8_LDB(B0, 0, 0); PG8_LDB(B1, 0, 1); PG8_SCHED; PG8_LDA(At, 0, 0); PG8_STAGE(PG8_SA(1, 1), a1 + hstep, voffA);
            PG8_WAIT_V(8); PG8_WAIT_L(0); PG8_BAR; PG8_MMA(0, 0, At, B0); PG8_MMA(0, 1, At, B1); PG8_BAR; PG8_SCHED;
            PG8_LDA(At, 0, 1); PG8_STAGE(PG8_SB(0, 0), b2, voffB); PG8_STAGE(PG8_SB(0, 1), b2 + hstep, voffB); PG8_STAGE(PG8_SA(0, 0), a2, voffA);
            PG8_WAIT_V(8); PG8_WAIT_L(0); PG8_BAR; PG8_MMA(1, 0, At, B0); PG8_MMA(1, 1, At, B1); PG8_BAR; PG8_SCHED;
            PG8_LDB(B0, 1, 0); PG8_LDB(B1, 1, 1); PG8_SCHED; PG8_LDA(At, 1, 0); PG8_STAGE(PG8_SA(0, 1), a2 + hstep, voffA);
            PG8_WAIT_V(8); PG8_WAIT_L(0); PG8_BAR; PG8_MMA(0, 0, At, B0); PG8_MMA(0, 1, At, B1); PG8_BAR; PG8_SCHED;
            PG8_LDA(At, 1, 1); PG8_STAGE(PG8_SB(1, 0), b3, voffB); PG8_STAGE(PG8_SB(1, 1), b3 + hstep, voffB); PG8_STAGE(PG8_SA(1, 0), a3, voffA);
            PG8_WAIT_V(8); PG8_WAIT_L(0); PG8_BAR; PG8_MMA(1, 0, At, B0); PG8_MMA(1, 1, At, B1); PG8_BAR; PG8_SCHED;
        }
        if (wr == 0) PG8_BAR;
        epilogue(E, acc, cur, wr, wc, fr, fq);
        if (!has_next) break;
#pragma unroll
        for (int a = 0; a < 2; ++a)
#pragma unroll
            for (int b = 0; b < 2; ++b)
#pragma unroll
                for (int m = 0; m < 4; ++m)
#pragma unroll
                    for (int n = 0; n < 2; ++n) acc[a][b][m][n] = (f32x4){0.f, 0.f, 0.f, 0.f};
        cur = nxt; cA = nA; cB = nB; ++ui;
        if (wr == 1) PG8_BAR;
    }
    PG8_WAIT_V(0);
    PG8_BAR;
#undef PG8_SA
#undef PG8_SB
#undef PG8_STAGE
#undef PG8_LDA
#undef PG8_LDB
#undef PG8_MMA
#undef PG8_WAIT_V
#undef PG8_WAIT_L
#undef PG8_BAR
#undef PG8_SCHED
}
}

#define XB_TMO      128
#define XB_XCNT(j)  (256  + 64 * (j))
#define XB_XSUB(j)  (1280 + 64 * (j))
#define XB_XGEN(j)  (2304 + 64 * (j))
#define XB_TOP      3328
#define XB_TOPGEN   3392
#define XCD_BAR_WORDS 3456
#define XB_SPIN_CAP (1u << 18)
__device__ __forceinline__ unsigned xb_ld(unsigned* p)              { return __hip_atomic_load(p, __ATOMIC_RELAXED, __HIP_MEMORY_SCOPE_AGENT); }
__device__ __forceinline__ unsigned xb_add(unsigned* p, unsigned v) { return __hip_atomic_fetch_add(p, v, __ATOMIC_RELAXED, __HIP_MEMORY_SCOPE_AGENT); }
__device__ __forceinline__ unsigned xb_xcc_id() { return (unsigned)__builtin_amdgcn_s_getreg((3 << 11) | 20) & 0xFu; }
#define XB_SPIN(cond, bar) do { unsigned _sp = 0; while (cond) { __builtin_amdgcn_s_sleep(1); \
    if ((++_sp & 255u) == 0u) { if (xb_ld(&(bar)[XB_TMO])) break; if (_sp > XB_SPIN_CAP) { atomicAdd(&(bar)[XB_TMO], 1u); break; } } } } while (0)
struct XcdBarrier { unsigned* bar; unsigned x; volatile LAS unsigned* st; };
__device__ __forceinline__ XcdBarrier xcd_barrier_post(unsigned* bar, volatile LAS unsigned* st) {
    XcdBarrier b; b.bar = bar; b.x = xb_xcc_id(); b.st = st;
    if (threadIdx.x == 0) (void)xb_add(&bar[XB_XCNT(b.x)], 1u);
    return b;
}
__device__ __forceinline__ void xcd_barrier_complete(unsigned* bar, unsigned x, unsigned& nloc, unsigned& nx) {
    const unsigned G = gridDim.x * gridDim.y * gridDim.z;
    unsigned sum, cnt, mine, sp = 0u;
    for (;;) {
        sum = 0u; cnt = 0u; mine = 0u;
#pragma unroll
        for (unsigned j = 0; j < 16; ++j) { const unsigned c = xb_ld(&bar[XB_XCNT(j)]); sum += c; cnt += (c > 0u) ? 1u : 0u; mine = (j == x) ? c : mine; }
        if (sum == G) break;
        __builtin_amdgcn_s_sleep(1);
        if ((++sp & 255u) == 0u) { if (xb_ld(&bar[XB_TMO])) break; if (sp > XB_SPIN_CAP) { atomicAdd(&bar[XB_TMO], 1u); break; } }
    }
    nloc = mine > 0u ? mine : 1u; nx = cnt > 0u ? cnt : 1u;
}
__device__ __forceinline__ void xcd_barrier(const XcdBarrier& b) {
    asm volatile("s_waitcnt vmcnt(0)" ::: "memory");
    __syncthreads();
    if (threadIdx.x == 0) {
        unsigned* bar = b.bar;
        __builtin_amdgcn_s_waitcnt(0);
        unsigned nloc = b.st[0], nx = b.st[1];
        if (nloc == 0u) { xcd_barrier_complete(bar, b.x, nloc, nx); b.st[0] = nloc; b.st[1] = nx; }
        const unsigned old = xb_add(&bar[XB_XSUB(b.x)], 1u);
        const unsigned gen = old / nloc;
        if (old + 1u == (gen + 1u) * nloc) {
            __builtin_amdgcn_fence(__ATOMIC_RELEASE, "agent");
            asm volatile("s_waitcnt vmcnt(0)" ::: "memory");
            const unsigned og = xb_add(&bar[XB_TOP], 1u);
            const unsigned tg = og / nx;
            if (og + 1u == (tg + 1u) * nx) xb_add(&bar[XB_TOPGEN], 1u);
            else XB_SPIN(xb_ld(&bar[XB_TOPGEN]) == tg, bar);
            __builtin_amdgcn_fence(__ATOMIC_ACQUIRE, "agent");
            xb_add(&bar[XB_XGEN(b.x)], 1u);
            asm volatile("s_waitcnt vmcnt(0)" ::: "memory");
        } else {
            XB_SPIN(xb_ld(&bar[XB_XGEN(b.x)]) == gen, bar);
            __builtin_amdgcn_fence(__ATOMIC_ACQUIRE, "agent");
            asm volatile("s_waitcnt vmcnt(0)" ::: "memory");
        }
    }
    __syncthreads();
}

__device__ __forceinline__ void p0_transpose_item(const float* W, int K, int N, const float* gain, bf16_t* WT, int k0, int n0, int drow0, LAS float* scr, int lane) {
#pragma unroll 8
    for (int i = 0; i < 32; ++i) { const int kk = 2 * i + (lane >> 5); float v = *(const GAS float*)(W + (size_t)(k0 + kk) * N + n0 + (lane & 31));
        if (gain) v *= *(const GAS float*)(gain + k0 + kk);
        scr[kk * 33 + (lane & 31)] = v; }
    LDS_WAIT(); asm volatile("" ::: "memory");
    const int c = lane & 7;
#pragma unroll
    for (int j = 0; j < 4; ++j) { const int n = (lane >> 3) + 8 * j; const LAS float* s = scr + (8 * c) * 33 + n;
        u32x4 o; o.x = pk2(s[0 * 33], s[1 * 33]); o.y = pk2(s[2 * 33], s[3 * 33]); o.z = pk2(s[4 * 33], s[5 * 33]); o.w = pk2(s[6 * 33], s[7 * 33]);
        *(GAS u32x4*)(WT + (size_t)(drow0 + n) * K + k0 + 8 * c) = o; }
    LDS_WAIT(); asm volatile("" ::: "memory");
}
__device__ __forceinline__ int map_gu(int n0) { return n0 < DFF ? (n0 / 128) * 256 + (n0 % 128) : ((n0 - DFF) / 128) * 256 + 128 + ((n0 - DFF) % 128); }
__device__ __forceinline__ int map_win(int n0) { return n0 < 6144 ? n0 : (n0 < 6176 ? 9216 + (n0 - 6144) : n0 - 32); }

__device__ __forceinline__ void p0_prologue(Frame& F) {
    LAS float* scr = (LAS float*)(F.lds + F.wave * 16384);
    const int gw = F.vcu * NWAVES + F.wave, NGW = F.G * NWAVES, lane = F.lane;
    bf16_t* const wgu1 = (bf16_t*)(F.ws + WS_WGU1); bf16_t* const wd1 = (bf16_t*)(F.ws + WS_WD1); bf16_t* const win = (bf16_t*)(F.ws + WS_WIN);
    bf16_t* const wsso = (bf16_t*)(F.ws + WS_WSSO); bf16_t* const wo = (bf16_t*)(F.ws + WS_WO); bf16_t* const wgu2 = (bf16_t*)(F.ws + WS_WGU2);
    bf16_t* const wd2 = (bf16_t*)(F.ws + WS_WD2); bf16_t* const wpg = (bf16_t*)(F.ws + WS_WPG); bf16_t* const wple = (bf16_t*)(F.ws + WS_WPLE);
    constexpr int I_GU = (DM / 64) * (2 * DFF / 32), I_D = (DFF / 64) * (DM / 32), I_IN = (DM / 64) * (IN_DIM / 32), I_SSO = (DI / 64) * (DM / 32), I_SQ = (DM / 64) * (DM / 32), I_PLE = (PLE / 64) * (DM / 32);
    constexpr int NITEMS = 2 * I_GU + 2 * I_D + I_IN + I_SSO + 2 * I_SQ + I_PLE;
    for (int it = gw; it < NITEMS; it += NGW) {
        int r = it;
        if (r < I_GU) { const int nb = 2 * DFF / 32, kb = r / nb, n0 = (r % nb) * 32; p0_transpose_item(F.in[I_WGU1], DM, 2 * DFF, F.in[I_NFFN1], wgu1, kb * 64, n0, map_gu(n0), scr, lane); continue; } r -= I_GU;
        if (r < I_GU) { const int nb = 2 * DFF / 32, kb = r / nb, n0 = (r % nb) * 32; p0_transpose_item(F.in[I_WGU2], DM, 2 * DFF, F.in[I_NFFN2], wgu2, kb * 64, n0, map_gu(n0), scr, lane); continue; } r -= I_GU;
        if (r < I_D) { const int nb = DM / 32, kb = r / nb, n0 = (r % nb) * 32; p0_transpose_item(F.in[I_WD1], DFF, DM, nullptr, wd1, kb * 64, n0, n0, scr, lane); continue; } r -= I_D;
        if (r < I_D) { const int nb = DM / 32, kb = r / nb, n0 = (r % nb) * 32; p0_transpose_item(F.in[I_WD2], DFF, DM, nullptr, wd2, kb * 64, n0, n0, scr, lane); continue; } r -= I_D;
        if (r < I_IN) { const int nb = IN_DIM / 32, kb = r / nb, n0 = (r % nb) * 32; p0_transpose_item(F.in[I_WIN], DM, IN_DIM, F.in[I_NMIX], win, kb * 64, n0, map_win(n0), scr, lane); continue; } r -= I_IN;
        if (r < I_SSO) { const int nb = DM / 32, kb = r / nb, n0 = (r % nb) * 32; p0_transpose_item(F.in[I_WSSO], DI, DM, F.in[I_NSSD], wsso, kb * 64, n0, n0, scr, lane); continue; } r -= I_SSO;
        if (r < I_SQ) { const int nb = DM / 32, kb = r / nb, n0 = (r % nb) * 32; p0_transpose_item(F.in[I_WO], DM, DM, nullptr, wo, kb * 64, n0, n0, scr, lane); continue; } r -= I_SQ;
        if (r < I_SQ) { const int nb = DM / 32, kb = r / nb, n0 = (r % nb) * 32; p0_transpose_item(F.in[I_WPG], DM, DM, F.in[I_NPLE], wpg, kb * 64, n0, n0, scr, lane); continue; } r -= I_SQ;
        { const int nb = DM / 32, kb = r / nb, n0 = (r % nb) * 32; p0_transpose_item(F.in[I_WPLE], PLE, DM, nullptr, wple, kb * 64, n0, n0, scr, lane); }
    }
    {
        bf16_t* const w2 = (bf16_t*)(F.ws + WS_W2);
        const float* Wg = F.in[I_WPGRP]; const float* sc = F.in[I_PSCALE]; const float* Wpo = F.in[I_WPOUT];
        for (int it = F.vcu; it < 4 * 32; it += F.G) {
            const int g = it >> 5, c0 = (it & 31) * 8, n = F.tid;
            float a0[8], a1[8];
#pragma unroll
            for (int cc = 0; cc < 8; ++cc) { a0[cc] = 0.f; a1[cc] = 0.f; }
            for (int d = 0; d < 256; ++d) {
                const float s = *(const GAS float*)(sc + g * 256 + d);
                const float w0 = s * *(const GAS float*)(Wpo + (size_t)(g * 256 + d) * DM + n), w1 = s * *(const GAS float*)(Wpo + (size_t)(g * 256 + d) * DM + n + 512);
#pragma unroll
                for (int cc = 0; cc < 8; ++cc) { const float a = *(const GAS float*)(Wg + ((size_t)g * 256 + c0 + cc) * 256 + d); a0[cc] += a * w0; a1[cc] += a * w1; }
            }
            u32x4 o0, o1; o0.x = pk2(a0[0], a0[1]); o0.y = pk2(a0[2], a0[3]); o0.z = pk2(a0[4], a0[5]); o0.w = pk2(a0[6], a0[7]);
            o1.x = pk2(a1[0], a1[1]); o1.y = pk2(a1[2], a1[3]); o1.z = pk2(a1[4], a1[5]); o1.w = pk2(a1[6], a1[7]);
            *(GAS u32x4*)(w2 + (size_t)n * DM + g * 256 + c0) = o0; *(GAS u32x4*)(w2 + (size_t)(n + 512) * DM + g * 256 + c0) = o1;
        }
    }
    {
        bf16_t* const XB = (bf16_t*)(F.ws + WS_XB); bf16_t* const PB = (bf16_t*)(F.ws + WS_PB); float* const stA = (float*)(F.ws + WS_STATS_A);
        for (int m = gw; m < M; m += NGW) {
            const float* xrow = (m < MP) ? F.in[I_XP] + (size_t)m * DM : F.in[I_XS] + (size_t)(m - MP) * DM;
            const GAS f32x4* xr = (const GAS f32x4*)xrow + lane;
            f32x4 v[4]; float s = 0.f;
#pragma unroll
            for (int j = 0; j < 4; ++j) { v[j] = xr[64 * j]; s += (v[j].x * v[j].x + v[j].y * v[j].y) + (v[j].z * v[j].z + v[j].w * v[j].w); }
            s = wave_sum(s);
            GAS u32x2* o8 = (GAS u32x2*)(XB + (size_t)m * DM) + lane;
#pragma unroll
            for (int j = 0; j < 4; ++j) { u32x2 w; w.x = pk2(v[j].x, v[j].y); w.y = pk2(v[j].z, v[j].w); o8[64 * j] = w; }
            if (lane < 16) *(GAS float*)(stA + (size_t)m * 16 + lane) = (lane == 0) ? s : 0.f;
            const float* prow = (m < MP) ? F.in[I_PP] + (size_t)m * PLE : F.in[I_PS] + (size_t)(m - MP) * PLE;
            const f32x4 pv = *((const GAS f32x4*)prow + lane);
            u32x2 w; w.x = pk2(pv.x, pv.y); w.y = pk2(pv.z, pv.w); *((GAS u32x2*)(PB + (size_t)m * PLE) + lane) = w;
        }
    }
}

__device__ __forceinline__ void ssd_seq_phase(Frame& F) {
    const int half = F.wave >> 2, r = F.wave & 3, lane = F.lane, idx = r * 64 + lane;
    LAS float* const bc = (LAS float*)(F.lds + half * 57344);
    LAS float* const lxs = bc + 4096; LAS float* const lyg = bc + 8192; LAS float* const ldt = bc + 12288; LAS float* const ssq = bc + 12288 + 64;
    const bf16_t* const XBC = (const bf16_t*)(F.ws + WS_XBC); const bf16_t* const Zs = (const bf16_t*)(F.ws + WS_Z); bf16_t* const YN = (bf16_t*)(F.ws + WS_Z);
    const float* const DT = (const float*)(F.ws + WS_DT);
    const float* const convw = F.in[I_CONVW]; const float* const convb = F.in[I_CONVB];
    constexpr int NPI = (BATCH * NG) / 2, NSI = (DECB * NG) / 2;
    for (int it = F.vcu; it < NPI + NSI; it += F.G) {
        const bool prompt = it < NPI;
        const int item = (prompt ? it : it - NPI) * 2 + half, b = item >> 3, g = item & 7, head = g * HPG + r;
        const int T = prompt ? SEQ : DECS;
        const size_t row0 = prompt ? (size_t)b * SEQ : (size_t)MP + (size_t)b * DECS;
        const int xch = g * 256 + r * 64 + lane;
        const int bch = (idx < 128) ? (DI + g * DSTATE + idx) : (DI + NG * DSTATE + g * DSTATE + (idx - 128));
        float cwx[4], cwb[4];
#pragma unroll
        for (int k = 0; k < 4; ++k) { cwx[k] = *(const GAS float*)(convw + (size_t)k * CD + xch); cwb[k] = *(const GAS float*)(convw + (size_t)k * CD + bch); }
        const float cbx = *(const GAS float*)(convb + xch), cbb = *(const GAS float*)(convb + bch);
        const float Ah = -__expf(*(const GAS float*)(F.in[I_ALOG] + head)), Dh = *(const GAS float*)(F.in[I_DSKIP] + head);
        float x1 = 0.f, x2 = 0.f, x3 = 0.f, b1 = 0.f, b2 = 0.f, b3 = 0.f;
        float h[128];
        if (prompt) {
#pragma unroll
            for (int n = 0; n < 128; ++n) h[n] = 0.f;
        } else {
            const GAS f32x4* hp = (const GAS f32x4*)(F.in[I_SSM] + (((size_t)b * NH + head) * HD + lane) * DSTATE);
#pragma unroll
            for (int n = 0; n < 32; ++n) { const f32x4 v = hp[n]; h[4 * n] = v.x; h[4 * n + 1] = v.y; h[4 * n + 2] = v.z; h[4 * n + 3] = v.w; }
            const float* cs = F.in[I_CONV] + (size_t)b * 3 * CD;
            x3 = *(const GAS float*)(cs + xch); x2 = *(const GAS float*)(cs + CD + xch); x1 = *(const GAS float*)(cs + 2 * CD + xch);
            b3 = *(const GAS float*)(cs + bch); b2 = *(const GAS float*)(cs + CD + bch); b1 = *(const GAS float*)(cs + 2 * CD + bch);
        }
        for (int tb = 0; tb < T / 8; ++tb) {
            const int par = tb & 1;
            for (int j = 0; j < 8; ++j) {
                const size_t row = row0 + (size_t)tb * 8 + j;
                const float xr = bf2f(*(const GAS bf16_t*)(XBC + row * CD + xch)), br = bf2f(*(const GAS bf16_t*)(XBC + row * CD + bch));
                const float cx = cbx + cwx[0] * x3 + cwx[1] * x2 + cwx[2] * x1 + cwx[3] * xr; x3 = x2; x2 = x1; x1 = xr;
                const float cb_ = cbb + cwb[0] * b3 + cwb[1] * b2 + cwb[2] * b1 + cwb[3] * br; b3 = b2; b2 = b1; b1 = br;
                lxs[(par * 8 + j) * 256 + idx] = silu_f(cx);
                bc[(par * 8 + j) * 256 + idx] = silu_f(cb_);
                if (lane == 0) ldt[(par * 8 + j) * 4 + r] = *(const GAS float*)(DT + row * 32 + head);
            }
            __syncthreads();
            for (int j = 0; j < 8; ++j) {
                const size_t row = row0 + (size_t)tb * 8 + j;
                const float xsv = lxs[(par * 8 + j) * 256 + idx], dtv = ldt[(par * 8 + j) * 4 + r];
                const float dA = __expf(dtv * Ah), dx = dtv * xsv;
                const LAS f32x4* Bp = (const LAS f32x4*)(bc + (par * 8 + j) * 256); const LAS f32x4* Cp = Bp + 32;
                float y0 = 0.f, y1 = 0.f;
#pragma unroll
                for (int n8 = 0; n8 < 4; ++n8) {
#pragma unroll
                    for (int n = 8 * n8; n < 8 * n8 + 8; ++n) { const f32x4 Bv = Bp[n], Cv = Cp[n];
                        h[4 * n] = dA * h[4 * n] + dx * Bv.x; y0 += Cv.x * h[4 * n];
                        h[4 * n + 1] = dA * h[4 * n + 1] + dx * Bv.y; y1 += Cv.y * h[4 * n + 1];
                        h[4 * n + 2] = dA * h[4 * n + 2] + dx * Bv.z; y0 += Cv.z * h[4 * n + 2];
                        h[4 * n + 3] = dA * h[4 * n + 3] + dx * Bv.w; y1 += Cv.w * h[4 * n + 3]; }
                    asm volatile("" ::: "memory");
                }
                const float y = (y0 + y1) + Dh * xsv;
                const float zs = bf2f(*(const GAS bf16_t*)(Zs + row * DI + xch));
                const float ygv = y * zs;
                lyg[(par * 8 + j) * 256 + idx] = ygv;
                const float ss = wave_sum(ygv * ygv);
                if (lane == 0) ssq[(par * 8 + j) * 4 + r] = ss;
            }
            __syncthreads();
            for (int j = 0; j < 8; ++j) {
                const size_t row = row0 + (size_t)tb * 8 + j;
                const f32x4 s4 = *(const LAS f32x4*)(ssq + (par * 8 + j) * 4);
                const float rsn = __builtin_amdgcn_rsqf(((s4.x + s4.y) + (s4.z + s4.w)) * (1.0f / 256.0f) + EPS);
                *(GAS bf16_t*)(YN + row * DI + xch) = (bf16_t)f2bf(lyg[(par * 8 + j) * 256 + idx] * rsn);
            }
        }
        float* hout = (prompt ? F.out + O_SSM_P : F.out + O_SSM_S) + (((size_t)b * NH + head) * HD + lane) * DSTATE;
#pragma unroll
        for (int n = 0; n < 32; ++n) *((GAS f32x4*)hout + n) = (f32x4){h[4 * n], h[4 * n + 1], h[4 * n + 2], h[4 * n + 3]};
        __syncthreads();
    }
}
__device__ __forceinline__ void pool_phase(Frame& F) {
    const bf16_t* const V = (const bf16_t*)(F.ws + WS_V); bf16_t* const PO = (bf16_t*)(F.ws + WS_POOLED);
    const float* const sp = F.in[I_POOL];
    const int gt = F.vcu * NTHREADS + F.tid, NT = F.G * NTHREADS;
    for (int e = gt; e < M * 128; e += NT) {
        const int row = e >> 7, cv = (e & 127) * 8, w = 2 << (cv >> 8);
        float s[8];
#pragma unroll
        for (int j = 0; j < 8; ++j) s[j] = 0.f;
        f32x4 c0, c1; pg8::unpack8(*(const GAS u32x4*)(V + (size_t)row * PD + cv), c0, c1);
        float cnt;
        if (row < MP) {
            const int t = row & (SEQ - 1); const int nk = (t + 1 < w) ? t + 1 : w; cnt = (float)nk;
            for (int k = 0; k < nk; ++k) { f32x4 a0, a1; pg8::unpack8(*(const GAS u32x4*)(V + (size_t)(row - k) * PD + cv), a0, a1);
                s[0] += a0.x; s[1] += a0.y; s[2] += a0.z; s[3] += a0.w; s[4] += a1.x; s[5] += a1.y; s[6] += a1.z; s[7] += a1.w; }
        } else {
            const int rr = row - MP, b = rr >> 3, t = rr & 7; cnt = (float)w;
            for (int k = 0; k < w; ++k) { const int tt = t - k; f32x4 a0, a1;
                if (tt >= 0) pg8::unpack8(*(const GAS u32x4*)(V + (size_t)(row - k) * PD + cv), a0, a1);
                else { const float* p = sp + ((size_t)b * PBUF + (PBUF + tt)) * PD + cv; a0 = *(const GAS f32x4*)p; a1 = *(const GAS f32x4*)(p + 4); }
                s[0] += a0.x; s[1] += a0.y; s[2] += a0.z; s[3] += a0.w; s[4] += a1.x; s[5] += a1.y; s[6] += a1.z; s[7] += a1.w; }
        }
        const float ic = 1.0f / cnt;
        f32x4 o0 = (f32x4){s[0] * ic, s[1] * ic, s[2] * ic, s[3] * ic} - c0, o1 = (f32x4){s[4] * ic, s[5] * ic, s[6] * ic, s[7] * ic} - c1;
        u32x4 o; o.x = pk2(o0.x, o0.y); o.y = pk2(o0.z, o0.w); o.z = pk2(o1.x, o1.y); o.w = pk2(o1.z, o1.w);
        *(GAS u32x4*)(PO + (size_t)row * PD + cv) = o;
    }
    float* const ops = F.out + O_POOL_S;
    for (int e = gt; e < DECB * 7 * (PD / 4); e += NT) {
        const int c4 = e & 255, i = (e >> 8) % 7, b = (e >> 8) / 7;
        *(GAS f32x4*)(ops + ((size_t)b * PBUF + i) * PD + c4 * 4) = *(const GAS f32x4*)(sp + ((size_t)b * PBUF + 8 + i) * PD + c4 * 4);
    }
}
__device__ __forceinline__ void final_phase(Frame& F) {
    const int gw = F.vcu * NWAVES + F.wave, NGW = F.G * NWAVES, lane = F.lane;
    const float* const st = (const float*)(F.ws + WS_STATS_A); const float* const gf = F.in[I_NFINAL];
    f32x4 gv[4];
#pragma unroll
    for (int j = 0; j < 4; ++j) gv[j] = *((const GAS f32x4*)gf + lane + 64 * j);
    for (int m = gw; m < M; m += NGW) {
        const GAS f32x4* sp = (const GAS f32x4*)(st + (size_t)m * 16);
        const f32x4 a = sp[0], b = sp[1], c = sp[2], d = sp[3]; const f32x4 s = (a + b) + (c + d);
        const float rs = __builtin_amdgcn_rsqf(((s[0] + s[1]) + (s[2] + s[3])) * (1.0f / 1024.0f) + EPS);
        GAS f32x4* yr = (GAS f32x4*)(F.out + (size_t)m * DM) + lane;
#pragma unroll
        for (int j = 0; j < 4; ++j) yr[64 * j] = yr[64 * j] * rs * gv[j];
    }
}

constexpr int NPHASES = 13;
struct Args { const float* in[30]; float* out; unsigned char* ws; int ph_lo, ph_hi, li, pad; };
__global__ void __launch_bounds__(NTHREADS, 2) mk_fwd(Args args) {
    extern __shared__ __attribute__((aligned(16))) unsigned char lds[];
    Frame F;
    F.lds = (LAS unsigned char*)lds;
    F.MISC = (volatile LAS unsigned*)(F.lds + MISC_OFF);
    F.tid = threadIdx.x; F.lane = F.tid & 63; F.wave = __builtin_amdgcn_readfirstlane(F.tid >> 6);
    F.G = gridDim.x; { const int bx = blockIdx.x; F.vcu = (F.G % 8 == 0) ? (bx % 8) * (F.G / 8) + bx / 8 : bx; }
    F.ws = args.ws; F.out = args.out; F.ctl = (gu32*)(args.ws + WS_CTL);
#pragma unroll
    for (int i = 0; i < 30; ++i) F.in[i] = args.in[i];
    for (int u = F.tid; u < (LDS_BYTES - LDSCTL_OFF) / 4; u += NTHREADS) ((LAS unsigned*)(F.lds + LDSCTL_OFF))[u] = 0u;
    __syncthreads();
    const int lo = args.ph_lo, hi = args.ph_hi;
    XcdBarrier bar; bar.bar = (unsigned*)(F.ctl + CW_BAR); bar.x = 0; bar.st = nullptr;
    if (hi - lo > 1) bar = xcd_barrier_post((unsigned*)(F.ctl + CW_BAR), F.MISC + 8);
#ifndef PHMASK
#define PHMASK 0x1fff
#endif
#define IN(k) (((PHMASK >> (k)) & 1) && lo <= (k) && (k) < hi)
#define SEAM(k) do { if (IN(k) && IN((k) + 1)) xcd_barrier(bar); } while (0)

    bf16_t* const XB = (bf16_t*)(F.ws + WS_XB); bf16_t* const HB = (bf16_t*)(F.ws + WS_HB); bf16_t* const ACT = (bf16_t*)(F.ws + WS_ACT);
    bf16_t* const Zb = (bf16_t*)(F.ws + WS_Z); bf16_t* const XBCb = (bf16_t*)(F.ws + WS_XBC); bf16_t* const Vb = (bf16_t*)(F.ws + WS_V); bf16_t* const GATES = (bf16_t*)(F.ws + WS_GATES);
    bf16_t* const POOLED = (bf16_t*)(F.ws + WS_POOLED); bf16_t* const MERGED = (bf16_t*)(F.ws + WS_MERGED); bf16_t* const Qb = (bf16_t*)(F.ws + WS_Q); bf16_t* const PB = (bf16_t*)(F.ws + WS_PB);
    float* const T1 = (float*)(F.ws + WS_T1); float* const stA = (float*)(F.ws + WS_STATS_A); float* const stB = (float*)(F.ws + WS_STATS_B); float* const DTb = (float*)(F.ws + WS_DT);
    float* const H = F.out + O_Y;
    pg8::StaticOrder S;

    if (IN(0)) { p0_prologue(F); } SEAM(0);
    if (IN(1)) {
        pg8::Gemm g{XB, (const bf16_t*)(F.ws + WS_WGU1), M, 2 * DFF, DM}; S.init(M, 2 * DFF, F.G, (int)blockIdx.x);
        pg8::Epi E{}; E.kind = pg8::EK_GU; E.stats_in = stA; E.obf = ACT; E.ldo = DFF;
        pg8::gemm_phase(F.lds, g, S, E);
    } SEAM(1);
    if (IN(2)) {
        pg8::Gemm g{ACT, (const bf16_t*)(F.ws + WS_WD1), M, DM, DFF}; S.init(M, DM, F.G, (int)blockIdx.x);
        pg8::Epi E{}; E.kind = pg8::EK_RES; E.coef = 0.5f; E.res_p = F.in[I_XP]; E.res_s = F.in[I_XS]; E.of32 = H; E.obf = HB; E.stats_out = stB;
        pg8::gemm_phase(F.lds, g, S, E);
    } SEAM(2);
    if (IN(3)) {
        pg8::Gemm g{HB, (const bf16_t*)(F.ws + WS_WIN), M, NIN, DM}; S.init(M, NIN, F.G, (int)blockIdx.x);
        pg8::Epi E{}; E.kind = pg8::EK_WIN; E.stats_in = stB; E.Z = Zb; E.XBC = XBCb; E.V = Vb; E.GATES = GATES; E.DT = DTb; E.dt_bias = F.in[I_DTB];
        E.conv_p = F.out + O_CONV_P; E.conv_s = F.out + O_CONV_S; E.pool_p = F.out + O_POOL_P; E.pool_s = F.out + O_POOL_S;
        pg8::gemm_phase(F.lds, g, S, E);
    } SEAM(3);
    if (IN(4)) { ssd_seq_phase(F); pool_phase(F); } SEAM(4);
    if (IN(5)) {
        pg8::Gemm g{Zb, (const bf16_t*)(F.ws + WS_WSSO), M, DM, DI}; S.init(M, DM, F.G, (int)blockIdx.x);
        pg8::Epi E{}; E.kind = pg8::EK_T1; E.gates = GATES; E.of32 = T1;
        pg8::gemm_phase(F.lds, g, S, E);
    } SEAM(5);
    if (IN(6)) {
        pg8::Gemm g{POOLED, (const bf16_t*)(F.ws + WS_W2), M, DM, DM}; S.init(M, DM, F.G, (int)blockIdx.x);
        pg8::Epi E{}; E.kind = pg8::EK_MERGE; E.gates = GATES; E.res_p = T1; E.obf = MERGED;
        pg8::gemm_phase(F.lds, g, S, E);
    } SEAM(6);
    if (IN(7)) {
        pg8::Gemm g{MERGED, (const bf16_t*)(F.ws + WS_WO), M, DM, DM}; S.init(M, DM, F.G, (int)blockIdx.x);
        pg8::Epi E{}; E.kind = pg8::EK_RES; E.coef = 1.0f; E.res_p = H; E.res_s = H + (size_t)MP * DM; E.of32 = H; E.obf = HB; E.stats_out = stA;
        pg8::gemm_phase(F.lds, g, S, E);
    } SEAM(7);
    if (IN(8)) {
        pg8::Gemm g{HB, (const bf16_t*)(F.ws + WS_WGU2), M, 2 * DFF, DM}; S.init(M, 2 * DFF, F.G, (int)blockIdx.x);
        pg8::Epi E{}; E.kind = pg8::EK_GU; E.stats_in = stA; E.obf = ACT; E.ldo = DFF;
        pg8::gemm_phase(F.lds, g, S, E);
    } SEAM(8);
    if (IN(9)) {
        pg8::Gemm g{ACT, (const bf16_t*)(F.ws + WS_WD2), M, DM, DFF}; S.init(M, DM, F.G, (int)blockIdx.x);
        pg8::Epi E{}; E.kind = pg8::EK_RES; E.coef = 0.5f; E.res_p = H; E.res_s = H + (size_t)MP * DM; E.of32 = H; E.obf = HB; E.stats_out = stB;
        pg8::gemm_phase(F.lds, g, S, E);
    } SEAM(9);
    if (IN(10)) {
        pg8::Gemm g{PB, (const bf16_t*)(F.ws + WS_WPLE), M, DM, PLE}; S.init(M, DM, F.G, (int)blockIdx.x);
        pg8::Epi E{}; E.kind = pg8::EK_BF16; E.obf = Qb; E.ldo = DM;
        pg8::gemm_phase(F.lds, g, S, E);
    } SEAM(10);
    if (IN(11)) {
        pg8::Gemm g{HB, (const bf16_t*)(F.ws + WS_WPG), M, DM, DM}; S.init(M, DM, F.G, (int)blockIdx.x);
        pg8::Epi E{}; E.kind = pg8::EK_PLE; E.stats_in = stB; E.q = Qb; E.of32 = H; E.stats_out = stA;
        pg8::gemm_phase(F.lds, g, S, E);
    } SEAM(11);
    if (IN(12)) { final_phase(F); }
#undef IN
#undef SEAM
}

extern "C" void kernel_launch(void* const* d_in, const int* in_sizes, int n_in, void* d_out, int out_size, void* d_ws, size_t ws_size, hipStream_t stream) {
    static int grid = 0;
    if (grid == 0) {
        if (n_in != 30 || in_sizes[0] != MP * DM || (size_t)out_size != O_END || ws_size < WS_END) {
            fprintf(stderr, "kernel_launch: shape mismatch: n_in %d in0 %d out %d ws %zu (need %zu)\n", n_in, n_in > 0 ? in_sizes[0] : -1, out_size, ws_size, (size_t)WS_END); grid = -1; return; }
        int dev = 0, cus = 0, per_cu = 0;
        if (hipGetDevice(&dev) != hipSuccess || hipDeviceGetAttribute(&cus, hipDeviceAttributeMultiprocessorCount, dev) != hipSuccess) { grid = -1; return; }
        if (hipFuncSetAttribute((const void*)mk_fwd, hipFuncAttributeMaxDynamicSharedMemorySize, LDS_BYTES) != hipSuccess) { fprintf(stderr, "kernel_launch: hipFuncSetAttribute failed\n"); grid = -1; return; }
        if (hipOccupancyMaxActiveBlocksPerMultiprocessor(&per_cu, (const void*)mk_fwd, NTHREADS, LDS_BYTES) != hipSuccess || per_cu < 1)
            fprintf(stderr, "kernel_launch: occupancy query reports %d workgroups per CU\n", per_cu);
        (void)hipGetLastError();
        grid = cus;
    }
    if (grid < 0) return;
    if (hipMemsetAsync((char*)d_ws + WS_CTL, 0, CTL_ZERO_BYTES, stream) != hipSuccess) { fprintf(stderr, "kernel_launch: memset failed\n"); return; }
    Args a{};
    for (int i = 0; i < 30; ++i) a.in[i] = (const float*)d_in[i];
    a.out = (float*)d_out; a.ws = (unsigned char*)d_ws;
#if MK_MULTI_LAUNCH
    for (int ph = 0; ph < NPHASES; ++ph) { a.ph_lo = ph; a.ph_hi = ph + 1; a.li = ph;
        hipLaunchKernelGGL(mk_fwd, dim3(grid), dim3(NTHREADS), LDS_BYTES, stream, a); }
#else
    a.ph_lo = 0; a.ph_hi = NPHASES; a.li = 0;
    hipLaunchKernelGGL(mk_fwd, dim3(grid), dim3(NTHREADS), LDS_BYTES, stream, a);
#endif
}
```

```cpp
#include <hip/hip_runtime.h>
#include <cstdio>
#include <cstdint>

#ifndef MK_MULTI_LAUNCH
#define MK_MULTI_LAUNCH 0
#endif

#define GAS __attribute__((address_space(1)))
#define LAS __attribute__((address_space(3)))
typedef unsigned short bf16_t;
typedef short bf16x8 __attribute__((ext_vector_type(8)));
typedef float f32x4 __attribute__((ext_vector_type(4)));
typedef float f32x2 __attribute__((ext_vector_type(2)));
typedef unsigned u32x4 __attribute__((ext_vector_type(4)));
typedef unsigned u32x2 __attribute__((ext_vector_type(2)));
typedef GAS unsigned gu32;

constexpr int DM = 1024, BATCH = 8, SEQ = 2048, DECB = 128, DECS = 8;
constexpr int MP = BATCH * SEQ, MS = DECB * DECS, M = MP + MS;
constexpr int DI = 2048, HD = 64, NH = 32, NG = 8, HPG = 4, DSTATE = 128, CD = 4096;
constexpr int PD = 1024, PBUF = 15, DFF = 2816, PLE = 256;
constexpr int IN_DIM = 9248, NIN = 9472;
constexpr float EPS = 1e-6f;
constexpr int NWAVES = 8, NTHREADS = 512;

constexpr size_t MiB = 1u << 20;
constexpr size_t WS_CTL = 0, CTL_ZERO_BYTES = 1 * MiB;
constexpr size_t WS_STATS_A = 2 * MiB, WS_STATS_B = 4 * MiB, WS_DT = 6 * MiB;
constexpr size_t WS_WGU1 = 10 * MiB, WS_WD1 = 21 * MiB, WS_WIN = 27 * MiB, WS_WSSO = 46 * MiB, WS_W2 = 50 * MiB, WS_WO = 52 * MiB,
                 WS_WGU2 = 54 * MiB, WS_WD2 = 65 * MiB, WS_WPG = 71 * MiB, WS_WPLE = 73 * MiB, WS_PB = 74 * MiB;
constexpr size_t WS_Z = 84 * MiB, WS_XBC = 152 * MiB, WS_V = 288 * MiB, WS_GATES = 322 * MiB, WS_HB = 390 * MiB, WS_POOLED = 424 * MiB, WS_END = 458 * MiB;
constexpr size_t WS_ACT = WS_XBC, WS_T1 = WS_XBC, WS_MERGED = WS_V, WS_Q = WS_GATES, WS_XB = WS_HB;
static_assert(WS_STATS_A + (size_t)M * 16 * 4 <= WS_STATS_B && WS_STATS_B + (size_t)M * 16 * 4 <= WS_DT && WS_DT + (size_t)M * 32 * 4 <= WS_WGU1, "ws map (small)");
static_assert(WS_WGU1 + (size_t)2 * DFF * DM * 2 <= WS_WD1 && WS_WD1 + (size_t)DM * DFF * 2 <= WS_WIN && WS_WIN + (size_t)NIN * DM * 2 <= WS_WSSO && WS_WSSO + (size_t)DM * DI * 2 <= WS_W2, "ws map (w1)");
static_assert(WS_WGU2 + (size_t)2 * DFF * DM * 2 <= WS_WD2 && WS_WD2 + (size_t)DM * DFF * 2 <= WS_WPG && WS_WPLE + (size_t)DM * PLE * 2 <= WS_PB && WS_PB + (size_t)M * PLE * 2 <= WS_Z, "ws map (w2)");
static_assert(WS_Z + (size_t)M * DI * 2 <= WS_XBC && WS_XBC + (size_t)M * CD * 2 <= WS_V && WS_V + (size_t)M * PD * 2 <= WS_GATES && WS_GATES + (size_t)M * 2 * DM * 2 <= WS_HB &&
              WS_HB + (size_t)M * DM * 2 <= WS_POOLED && WS_POOLED + (size_t)M * DM * 2 <= WS_END, "ws map (act)");
static_assert(WS_ACT + (size_t)M * DFF * 2 <= WS_V && WS_T1 + (size_t)M * DM * 4 <= WS_V, "ws overlays");
constexpr int CW_BAR = 4096;

constexpr size_t O_Y = 0, O_SSM_P = (size_t)M * DM, O_CONV_P = O_SSM_P + (size_t)BATCH * NH * HD * DSTATE, O_POOL_P = O_CONV_P + (size_t)BATCH * 3 * CD,
                 O_SSM_S = O_POOL_P + (size_t)BATCH * PBUF * PD, O_CONV_S = O_SSM_S + (size_t)DECB * NH * HD * DSTATE, O_POOL_S = O_CONV_S + (size_t)DECB * 3 * CD,
                 O_END = O_POOL_S + (size_t)DECB * PBUF * PD;

constexpr int RING_BYTES = 131072, LDSCTL_OFF = RING_BYTES, MISC_OFF = LDSCTL_OFF + 320, LDS_BYTES = 147456;

#define RLX_AGENT __ATOMIC_RELAXED, __HIP_MEMORY_SCOPE_AGENT
#define LDS_WAIT() asm volatile("s_waitcnt lgkmcnt(0)" ::: "memory")
#define VM_WAIT() asm volatile("s_waitcnt vmcnt(0)" ::: "memory")

__device__ __forceinline__ unsigned f2bf(float f) { unsigned u = __builtin_bit_cast(unsigned, f); return (u + 0x7fffu + ((u >> 16) & 1u)) >> 16; }
__device__ __forceinline__ unsigned pk2(float lo, float hi) { return f2bf(lo) | (f2bf(hi) << 16); }
__device__ __forceinline__ float bf2f(unsigned b) { return __builtin_bit_cast(float, b << 16); }
__device__ __forceinline__ float bflo(unsigned w) { return __builtin_bit_cast(float, w << 16); }
__device__ __forceinline__ float bfhi(unsigned w) { return __builtin_bit_cast(float, w & 0xffff0000u); }
__device__ __forceinline__ unsigned cvt_pk_bf16(float lo, float hi) { unsigned r; asm volatile("v_cvt_pk_bf16_f32 %0, %1, %2" : "=v"(r) : "v"(lo), "v"(hi)); return r; }
__device__ __forceinline__ float sigm_f(float x) { return 1.0f / (1.0f + __expf(-x)); }
__device__ __forceinline__ float silu_f(float x) { return x / (1.0f + __expf(-x)); }
__device__ __forceinline__ float wave_sum(float v) {
#pragma unroll
    for (int o = 1; o < 64; o <<= 1) v += __shfl_xor(v, o);
    return v;
}

struct Frame {
    LAS unsigned char* lds;
    volatile LAS unsigned* MISC;
    gu32* ctl;
    int tid, lane, wave, vcu, G;
    unsigned char* ws;
    float* out;
    const float* in[30];
};
enum { I_XP = 0, I_XS, I_SSM, I_CONV, I_POOL, I_PP, I_PS, I_NFFN1, I_WGU1, I_WD1, I_NMIX, I_WIN, I_CONVW, I_CONVB, I_DTB, I_ALOG, I_DSKIP, I_NSSD, I_WSSO, I_WPGRP, I_PSCALE,
       I_WPOUT, I_WO, I_NFFN2, I_WGU2, I_WD2, I_NPLE, I_WPG, I_WPLE, I_NFINAL };

namespace pg8 {
constexpr int BM = 256, BK = 64, HALF = 128, HTB = HALF * BK * 2, STAGE_BYTES = 8 * HTB, NXCD = 8, WGM = 8;
__host__ __device__ __forceinline__ int lds_byte(int r, int c) { const int st = (r >> 4) * 2 + (c >> 5), rr = r & 15, cc = c & 31, ob = rr * 64 + cc * 2; return st * 1024 + (ob ^ (((ob >> 9) & 1) << 5)); }
__host__ __device__ __forceinline__ void stage_rc(int b, int& R, int& C) { const int st = b / 1024, sb = b % 1024, swz = sb ^ (((sb >> 9) & 1) << 5); R = (st >> 1) * 16 + swz / 64; C = (st & 1) * 32 + (swz % 64) / 2; }
__host__ __device__ __forceinline__ int perm32(int rho) { const int n = rho >> 4, i = rho & 15; return 8 * (i >> 2) + 4 * n + (i & 3); }
struct Unit { int pm, pn; };
struct Gemm { const bf16_t* A; const bf16_t* Bt; int M, N, K; };
struct StaticOrder {
    int nM, nN, nwg, G, c;
    __host__ __device__ void init(int M_, int N_, int G_, int c_) { nM = M_ / BM; nN = N_ / BM; nwg = nM * nN; G = G_; c = c_; }
    __host__ __device__ bool next(int i, Unit& u) const {
        const long L = (long)i * G + c; if (L >= nwg) return false;
        int wgid = (int)L; { const int q = nwg / NXCD, r = nwg % NXCD, xcd = wgid % NXCD, off = wgid / NXCD; wgid = (xcd < r ? xcd * (q + 1) : r * (q + 1) + (xcd - r) * q) + off; }
        const int nig = WGM * nN, gid = wgid / nig, fm = gid * WGM, gsz = (nM - fm) < WGM ? (nM - fm) : WGM;
        u.pm = fm + ((wgid % nig) % gsz); u.pn = (wgid % nig) / gsz; return true;
    }
};

enum EpiKind { EK_GU = 1, EK_RES = 2, EK_WIN = 3, EK_T1 = 4, EK_MERGE = 5, EK_BF16 = 6, EK_PLE = 7 };
struct Epi {
    const float* stats_in;
    float* stats_out;
    bf16_t* obf;
    float* of32;
    const float* res_p; const float* res_s;
    const bf16_t* gates;
    const bf16_t* q;
    bf16_t *Z, *XBC, *V, *GATES; float* DT; const float* dt_bias; float *conv_p, *conv_s, *pool_p, *pool_s;
    int kind; int ldo; float coef; int pad;
};

__device__ __forceinline__ u32x4 pack8(const f32x4 a, const f32x4 b) { u32x4 w; w.x = cvt_pk_bf16(a[0], a[1]); w.y = cvt_pk_bf16(a[2], a[3]); w.z = cvt_pk_bf16(b[0], b[1]); w.w = cvt_pk_bf16(b[2], b[3]); return w; }
__device__ __forceinline__ void unpack8(const u32x4 w, f32x4& a, f32x4& b) { a = (f32x4){bflo(w.x), bfhi(w.x), bflo(w.y), bfhi(w.y)}; b = (f32x4){bflo(w.z), bfhi(w.z), bflo(w.w), bfhi(w.w)}; }

__device__ __forceinline__ float row_rs(const float* stats, int row) {
    if (!stats) return 1.0f;
    const GAS f32x4* sp = (const GAS f32x4*)(stats + (size_t)row * 16);
    const f32x4 a = sp[0], b = sp[1], c = sp[2], d = sp[3]; const f32x4 s = (a + b) + (c + d);
    return __builtin_amdgcn_rsqf(((s[0] + s[1]) + (s[2] + s[3])) * (1.0f / 1024.0f) + EPS);
}
__device__ __forceinline__ float softplus_f(float x) { const float e = __expf(-fabsf(x)); const float l = (e < 0.01f) ? e * (1.0f - e * (0.5f - e * (1.0f / 3.0f))) : __logf(1.0f + e); return fmaxf(x, 0.f) + l; }

__device__ __forceinline__ void epilogue(const Epi& E, const f32x4 (&acc)[2][2][4][2], const Unit& u, int wr, int wc, int fr, int fq) {
    const int rowb = u.pm * BM + wr * 64 + fr;
    const int cin = wc * 32 + 8 * fq;
    if (E.kind == EK_GU) {
#pragma unroll
        for (int ai = 0; ai < 2; ++ai)
#pragma unroll
            for (int m = 0; m < 4; ++m) { const int row = rowb + ai * HALF + m * 16; const float r = row_rs(E.stats_in, row);
                const f32x4 g0 = acc[ai][0][m][0] * r, u0 = acc[ai][1][m][0] * r, g1 = acc[ai][0][m][1] * r, u1 = acc[ai][1][m][1] * r;
                const f32x4 o0 = (f32x4){silu_f(g0[0]) * u0[0], silu_f(g0[1]) * u0[1], silu_f(g0[2]) * u0[2], silu_f(g0[3]) * u0[3]};
                const f32x4 o1 = (f32x4){silu_f(g1[0]) * u1[0], silu_f(g1[1]) * u1[1], silu_f(g1[2]) * u1[2], silu_f(g1[3]) * u1[3]};
                *(GAS u32x4*)(E.obf + (size_t)row * E.ldo + u.pn * HALF + cin) = pack8(o0, o1); }
    } else if (E.kind == EK_RES) {
#pragma unroll
        for (int ai = 0; ai < 2; ++ai)
#pragma unroll
            for (int m = 0; m < 4; ++m) { const int row = rowb + ai * HALF + m * 16;
                const float* rp = (row < MP) ? E.res_p + (size_t)row * DM : E.res_s + (size_t)(row - MP) * DM;
                float ss = 0.f;
#pragma unroll
                for (int bj = 0; bj < 2; ++bj) { const int col = u.pn * BM + bj * HALF + cin;
                    const f32x4 r0 = *(const GAS f32x4*)(rp + col), r1 = *(const GAS f32x4*)(rp + col + 4);
                    const f32x4 h0 = r0 + acc[ai][bj][m][0] * E.coef, h1 = r1 + acc[ai][bj][m][1] * E.coef;
                    *(GAS f32x4*)(E.of32 + (size_t)row * DM + col) = h0; *(GAS f32x4*)(E.of32 + (size_t)row * DM + col + 4) = h1;
                    *(GAS u32x4*)(E.obf + (size_t)row * DM + col) = pack8(h0, h1);
                    ss += (h0[0] * h0[0] + h0[1] * h0[1]) + (h0[2] * h0[2] + h0[3] * h0[3]) + (h1[0] * h1[0] + h1[1] * h1[1]) + (h1[2] * h1[2] + h1[3] * h1[3]); }
                ss += __shfl_xor(ss, 16); ss += __shfl_xor(ss, 32);
                if (fq == 0) *(GAS float*)(E.stats_out + (size_t)row * 16 + u.pn * 4 + wc) = ss; }
    } else if (E.kind == EK_WIN) {
        const int pn = u.pn;
        if (pn < 8 || (pn >= 28 && pn < 36)) {
            const bool isz = pn < 8; bf16_t* const O = isz ? E.Z : E.GATES; const int colt = (isz ? pn : pn - 28) * BM + cin;
#pragma unroll
            for (int ai = 0; ai < 2; ++ai)
#pragma unroll
                for (int m = 0; m < 4; ++m) { const int row = rowb + ai * HALF + m * 16; const float r = row_rs(E.stats_in, row);
#pragma unroll
                    for (int bj = 0; bj < 2; ++bj) { f32x4 v0 = acc[ai][bj][m][0] * r, v1 = acc[ai][bj][m][1] * r;
#pragma unroll
                        for (int j = 0; j < 4; ++j) { const float s0 = sigm_f(v0[j]), s1 = sigm_f(v1[j]); v0[j] = isz ? v0[j] * s0 : s0; v1[j] = isz ? v1[j] * s1 : s1; }
                        *(GAS u32x4*)(O + (size_t)row * (2 * DM) + colt + bj * HALF) = pack8(v0, v1); } }
        } else if (pn < 28) {
            const bool isx = pn < 24; bf16_t* const O = isx ? E.XBC : E.V; const int ldo = isx ? CD : PD; const int colt = (isx ? pn - 8 : pn - 24) * BM + cin;
            const int keep = isx ? 3 : PBUF;
#pragma unroll
            for (int ai = 0; ai < 2; ++ai)
#pragma unroll
                for (int m = 0; m < 4; ++m) { const int row = rowb + ai * HALF + m * 16; const float r = row_rs(E.stats_in, row);
                    float* sp = nullptr;
                    if (row < MP) { const int sb = row >> 11, st = row & (SEQ - 1); if (st >= SEQ - keep) sp = (isx ? E.conv_p : E.pool_p) + ((size_t)sb * keep + (st - (SEQ - keep))) * ldo + colt; }
                    else { const int sb = (row - MP) >> 3, st = (row - MP) & 7; const int si = st - (DECS - keep); if (si >= 0) sp = (isx ? E.conv_s : E.pool_s) + ((size_t)sb * keep + si) * ldo + colt; }
#pragma unroll
                    for (int bj = 0; bj < 2; ++bj) { const f32x4 v0 = acc[ai][bj][m][0] * r, v1 = acc[ai][bj][m][1] * r;
                        *(GAS u32x4*)(O + (size_t)row * ldo + colt + bj * HALF) = pack8(v0, v1);
                        if (sp) { *(GAS f32x4*)(sp + bj * HALF) = v0; *(GAS f32x4*)(sp + bj * HALF + 4) = v1; } } }
        } else if (wc == 0) {
            const f32x4 b0 = *(const GAS f32x4*)(E.dt_bias + 8 * fq), b1 = *(const GAS f32x4*)(E.dt_bias + 8 * fq + 4);
#pragma unroll
            for (int ai = 0; ai < 2; ++ai)
#pragma unroll
                for (int m = 0; m < 4; ++m) { const int row = rowb + ai * HALF + m * 16; const float r = row_rs(E.stats_in, row);
                    f32x4 v0 = acc[ai][0][m][0] * r + b0, v1 = acc[ai][0][m][1] * r + b1;
#pragma unroll
                    for (int j = 0; j < 4; ++j) { v0[j] = softplus_f(v0[j]); v1[j] = softplus_f(v1[j]); }
                    *(GAS f32x4*)(E.DT + (size_t)row * 32 + 8 * fq) = v0; *(GAS f32x4*)(E.DT + (size_t)row * 32 + 8 * fq + 4) = v1; }
        }
    } else if (E.kind == EK_T1) {
#pragma unroll
        for (int ai = 0; ai < 2; ++ai)
#pragma unroll
            for (int m = 0; m < 4; ++m) { const int row = rowb + ai * HALF + m * 16;
#pragma unroll
                for (int bj = 0; bj < 2; ++bj) { const int col = u.pn * BM + bj * HALF + cin;
                    f32x4 g0, g1; unpack8(*(const GAS u32x4*)(E.gates + (size_t)row * (2 * DM) + col), g0, g1);
                    *(GAS f32x4*)(E.of32 + (size_t)row * DM + col) = g0 * acc[ai][bj][m][0]; *(GAS f32x4*)(E.of32 + (size_t)row * DM + col + 4) = g1 * acc[ai][bj][m][1]; } }
    } else if (E.kind == EK_MERGE) {
#pragma unroll
        for (int ai = 0; ai < 2; ++ai)
#pragma unroll
            for (int m = 0; m < 4; ++m) { const int row = rowb + ai * HALF + m * 16;
#pragma unroll
                for (int bj = 0; bj < 2; ++bj) { const int col = u.pn * BM + bj * HALF + cin;
                    f32x4 g0, g1; unpack8(*(const GAS u32x4*)(E.gates + (size_t)row * (2 * DM) + DM + col), g0, g1);
                    const f32x4 t0 = *(const GAS f32x4*)(E.res_p + (size_t)row * DM + col), t1 = *(const GAS f32x4*)(E.res_p + (size_t)row * DM + col + 4);
                    *(GAS u32x4*)(E.obf + (size_t)row * DM + col) = pack8(t0 + g0 * acc[ai][bj][m][0], t1 + g1 * acc[ai][bj][m][1]); } }
    } else if (E.kind == EK_BF16) {
#pragma unroll
        for (int ai = 0; ai < 2; ++ai)
#pragma unroll
            for (int m = 0; m < 4; ++m) { const int row = rowb + ai * HALF + m * 16;
#pragma unroll
                for (int bj = 0; bj < 2; ++bj) { const int col = u.pn * BM + bj * HALF + cin;
                    *(GAS u32x4*)(E.obf + (size_t)row * E.ldo + col) = pack8(acc[ai][bj][m][0], acc[ai][bj][m][1]); } }
    } else if (E.kind == EK_PLE) {
#pragma unroll
        for (int ai = 0; ai < 2; ++ai)
#pragma unroll
            for (int m = 0; m < 4; ++m) { const int row = rowb + ai * HALF + m * 16; const float r = row_rs(E.stats_in, row);
                float ss = 0.f;
#pragma unroll
                for (int bj = 0; bj < 2; ++bj) { const int col = u.pn * BM + bj * HALF + cin;
                    f32x4 q0, q1; unpack8(*(const GAS u32x4*)(E.q + (size_t)row * DM + col), q0, q1);
                    const f32x4 r0 = *(const GAS f32x4*)(E.of32 + (size_t)row * DM + col), r1 = *(const GAS f32x4*)(E.of32 + (size_t)row * DM + col + 4);
                    f32x4 h0, h1;
#pragma unroll
                    for (int j = 0; j < 4; ++j) { h0[j] = r0[j] + sigm_f(acc[ai][bj][m][0][j] * r) * q0[j]; h1[j] = r1[j] + sigm_f(acc[ai][bj][m][1][j] * r) * q1[j]; }
                    *(GAS f32x4*)(E.of32 + (size_t)row * DM + col) = h0; *(GAS f32x4*)(E.of32 + (size_t)row * DM + col + 4) = h1;
                    ss += (h0[0] * h0[0] + h0[1] * h0[1]) + (h0[2] * h0[2] + h0[3] * h0[3]) + (h1[0] * h1[0] + h1[1] * h1[1]) + (h1[2] * h1[2] + h1[3] * h1[3]); }
                ss += __shfl_xor(ss, 16); ss += __shfl_xor(ss, 32);
                if (fq == 0) *(GAS float*)(E.stats_out + (size_t)row * 16 + u.pn * 4 + wc) = ss; }
    }
}

__device__ __forceinline__ void gemm_phase(LAS unsigned char* lds, const Gemm g, const StaticOrder& S, const Epi& E) {
    const int tid = threadIdx.x, wid = __builtin_amdgcn_readfirstlane(tid >> 6), lane = tid & 63, wr = wid >> 2, wc = wid & 3, fr = lane & 15, fq = lane >> 4;
    const int K = g.K, nt = K / BK;
    unsigned voffA[2], voffB[2];
#pragma unroll
    for (int i = 0; i < 2; ++i) { int R, C; stage_rc(tid * 16 + i * 8192, R, C); const int Rb = (R & ~31) + perm32(R & 31);
        voffA[i] = (unsigned)(R * K + C) * 2u; voffB[i] = (unsigned)(Rb * K + C) * 2u; }
    const size_t kstep = (size_t)(BK * 2);
    const size_t hstep = (size_t)HALF * K * 2;
    const size_t tstep = 2 * hstep;
    const unsigned ldsw = (unsigned)wid * 1024u;
    const int aoff = lds_byte(wr * 64 + fr, fq * 8), boff = lds_byte(wc * 32 + fr, fq * 8);
#define PG8_SA(b, h) (((b) * 2 + (h)) * HTB)
#define PG8_SB(b, h) ((4 + (b) * 2 + (h)) * HTB)
#define PG8_STAGE(bufoff, gbase, voff) do { _Pragma("unroll") for (int _i = 0; _i < 2; ++_i) \
        __builtin_amdgcn_global_load_lds((const unsigned*)((const char*)(gbase) + (voff)[_i]), (LAS unsigned*)(lds + (bufoff) + ldsw + _i * 8192), 16, 0, 0); } while (0)
#define PG8_LDA(dst, b, h) do { _Pragma("unroll") for (int m = 0; m < 4; ++m) _Pragma("unroll") for (int k = 0; k < 2; ++k) dst[m][k] = *(const LAS bf16x8*)(lds + PG8_SA(b, h) + aoff + m * 2048 + k * 1024); } while (0)
#define PG8_LDB(dst, b, h) do { _Pragma("unroll") for (int n = 0; n < 2; ++n) _Pragma("unroll") for (int k = 0; k < 2; ++k) dst[n][k] = *(const LAS bf16x8*)(lds + PG8_SB(b, h) + boff + n * 2048 + k * 1024); } while (0)
#define PG8_MMA(ai, bj, At, Bt) do { __builtin_amdgcn_s_setprio(1); _Pragma("unroll") for (int m = 0; m < 4; ++m) _Pragma("unroll") for (int n = 0; n < 2; ++n) _Pragma("unroll") for (int k = 0; k < 2; ++k) \
        acc[ai][bj][m][n] = __builtin_amdgcn_mfma_f32_16x16x32_bf16(Bt[n][k], At[m][k], acc[ai][bj][m][n], 0, 0, 0); __builtin_amdgcn_s_setprio(0); } while (0)
#define PG8_WAIT_V(n) asm volatile("s_waitcnt vmcnt(" #n ")" ::: "memory")
#define PG8_WAIT_L(n) asm volatile("s_waitcnt lgkmcnt(" #n ")" ::: "memory")
#define PG8_BAR __builtin_amdgcn_s_barrier()
#define PG8_SCHED __builtin_amdgcn_sched_barrier(0)
    Unit cur, nxt; int ui = 0;
    if (!S.next(0, cur)) return;
    f32x4 acc[2][2][4][2];
#pragma unroll
    for (int a = 0; a < 2; ++a)
#pragma unroll
        for (int b = 0; b < 2; ++b)
#pragma unroll
            for (int m = 0; m < 4; ++m)
#pragma unroll
                for (int n = 0; n < 2; ++n) acc[a][b][m][n] = (f32x4){0.f, 0.f, 0.f, 0.f};
    bf16x8 At[4][2], B0[2][2], B1[2][2];
    const char* cA = (const char*)g.A + (size_t)cur.pm * tstep; const char* cB = (const char*)g.Bt + (size_t)cur.pn * tstep;
    PG8_STAGE(PG8_SB(0, 0), cB, voffB); PG8_STAGE(PG8_SB(0, 1), cB + hstep, voffB); PG8_STAGE(PG8_SA(0, 0), cA, voffA); PG8_STAGE(PG8_SA(0, 1), cA + hstep, voffA);
    if (wr == 1) PG8_BAR;
    PG8_WAIT_V(2); PG8_BAR;
    PG8_STAGE(PG8_SB(1, 0), cB + kstep, voffB); PG8_STAGE(PG8_SA(1, 0), cA + kstep, voffA); PG8_STAGE(PG8_SB(1, 1), cB + hstep + kstep, voffB);
    PG8_WAIT_V(6); PG8_BAR;
    for (;;) {
        const bool has_next = S.next(ui + 1, nxt);
        const char* nA = has_next ? (const char*)g.A + (size_t)nxt.pm * tstep : cA; const char* nB = has_next ? (const char*)g.Bt + (size_t)nxt.pn * tstep : cB;
        for (int t = 0; t < nt; t += 2) {
            const bool last = (t == nt - 2);
            const char* a1 = cA + (size_t)(t + 1) * kstep;
            const char* a2 = last ? nA : cA + (size_t)(t + 2) * kstep; const char* b2 = last ? nB : cB + (size_t)(t + 2) * kstep;
            const char* a3 = a2 + kstep; const char* b3 = b2 + kstep;
            PG8_LDB(B0, 0, 0); PG8_LDB(B1, 0, 1); PG8_SCHED; PG8_LDA(At, 0, 0); PG8_STAGE(PG8_SA(1, 1), a1 + hstep, voffA);
            PG8_WAIT_V(8); PG8_WAIT_L(0); PG8_BAR; PG8_MMA(0, 0, At, B0); PG8_MMA(0, 1, At, B1); PG8_BAR; PG8_SCHED;
            PG8_LDA(At, 0, 1); PG8_STAGE(PG8_SB(0, 0), b2, voffB); PG8_STAGE(PG8_SB(0, 1), b2 + hstep, voffB); PG8_STAGE(PG8_SA(0, 0), a2, voffA);
            PG8_WAIT_V(8); PG8_WAIT_L(0); PG8_BAR; PG8_MMA(1, 0, At, B0); PG8_MMA(1, 1, At, B1); PG8_BAR; PG8_SCHED;
            PG8_LDB(B0, 1, 0); PG8_LDB(B1, 1, 1); PG8_SCHED; PG8_LDA(At, 1, 0); PG8_STAGE(PG8_SA(0, 1), a2 + hstep, voffA);
            PG8_WAIT_V(8); PG8_WAIT_L(0); PG8_BAR; PG8_MMA(0, 0, At, B0); PG8_MMA(0, 1, At, B1); PG8_BAR; PG8_SCHED;
            PG8_LDA(At, 1, 1); PG8_STAGE(PG8_SB(1, 0), b3, voffB); PG8_STAGE(PG8_SB(1, 1), b3 + hstep, voffB); PG8_STAGE(PG8_SA(1, 0), a3, voffA);
            PG8_WAIT_V(8); PG8_WAIT_L(0); PG8_BAR; PG8_MMA(1, 0, At, B0); PG8_MMA(1, 1, At, B1); PG8_BAR; PG8_SCHED;
        }
        if (wr == 0) PG8_BAR;
        epilogue(E, acc, cur, wr, wc, fr, fq);
        if (!has_next) break;
#pragma unroll
        for (int a = 0; a < 2; ++a)
#pragma unroll
            for (int b = 0; b < 2; ++b)
#pragma unroll
                for (int m = 0; m < 4; ++m)
#pragma unroll
                    for (int n = 0; n < 2; ++n) acc[a][b][m][n] = (f32x4){0.f, 0.f, 0.f, 0.f};
        cur = nxt; cA = nA; cB = nB; ++ui;
        if (wr == 1) PG8_BAR;
    }
    PG8_WAIT_V(0);
    PG8_BAR;
#undef PG8_SA
#undef PG8_SB
#undef PG8_STAGE
#undef PG8_LDA
#undef PG8_LDB
#undef PG8_MMA
#undef PG8_WAIT_V
#undef PG8_WAIT_L
#undef PG8_BAR
#undef PG8_SCHED
}
}

#define XB_TMO      128
#define XB_XCNT(j)  (256  + 64 * (j))
#define XB_XSUB(j)  (1280 + 64 * (j))
#define XB_XGEN(j)  (2304 + 64 * (j))
#define XB_TOP      3328
#define XB_TOPGEN   3392
#define XCD_BAR_WORDS 3456
#define XB_SPIN_CAP (1u << 18)
__device__ __forceinline__ unsigned xb_ld(unsigned* p)              { return __hip_atomic_load(p, __ATOMIC_RELAXED, __HIP_MEMORY_SCOPE_AGENT); }
__device__ __forceinline__ unsigned xb_add(unsigned* p, unsigned v) { return __hip_atomic_fetch_add(p, v, __ATOMIC_RELAXED, __HIP_MEMORY_SCOPE_AGENT); }
__device__ __forceinline__ unsigned xb_xcc_id() { return (unsigned)__builtin_amdgcn_s_getreg((3 << 11) | 20) & 0xFu; }
#define XB_SPIN(cond, bar) do { unsigned _sp = 0; while (cond) { __builtin_amdgcn_s_sleep(1); \
    if ((++_sp & 255u) == 0u) { if (xb_ld(&(bar)[XB_TMO])) break; if (_sp > XB_SPIN_CAP) { atomicAdd(&(bar)[XB_TMO], 1u); break; } } } } while (0)
struct XcdBarrier { unsigned* bar; unsigned x; volatile LAS unsigned* st; };
__device__ __forceinline__ XcdBarrier xcd_barrier_post(unsigned* bar, volatile LAS unsigned* st) {
    XcdBarrier b; b.bar = bar; b.x = xb_xcc_id(); b.st = st;
    if (threadIdx.x == 0) (void)xb_add(&bar[XB_XCNT(b.x)], 1u);
    return b;
}
__device__ __forceinline__ void xcd_barrier_complete(unsigned* bar, unsigned x, unsigned& nloc, unsigned& nx) {
    const unsigned G = gridDim.x * gridDim.y * gridDim.z;
    unsigned sum, cnt, mine, sp = 0u;
    for (;;) {
        sum = 0u; cnt = 0u; mine = 0u;
#pragma unroll
        for (unsigned j = 0; j < 16; ++j) { const unsigned c = xb_ld(&bar[XB_XCNT(j)]); sum += c; cnt += (c > 0u) ? 1u : 0u; mine = (j == x) ? c : mine; }
        if (sum == G) break;
        __builtin_amdgcn_s_sleep(1);
        if ((++sp & 255u) == 0u) { if (xb_ld(&bar[XB_TMO])) break; if (sp > XB_SPIN_CAP) { atomicAdd(&bar[XB_TMO], 1u); break; } }
    }
    nloc = mine > 0u ? mine : 1u; nx = cnt > 0u ? cnt : 1u;
}
__device__ __forceinline__ void xcd_barrier(const XcdBarrier& b) {
    asm volatile("s_waitcnt vmcnt(0)" ::: "memory");
    __syncthreads();
    if (threadIdx.x == 0) {
        unsigned* bar = b.bar;
        __builtin_amdgcn_s_waitcnt(0);
        unsigned nloc = b.st[0], nx = b.st[1];
        if (nloc == 0u) { xcd_barrier_complete(bar, b.x, nloc, nx); b.st[0] = nloc; b.st[1] = nx; }
        const unsigned old = xb_add(&bar[XB_XSUB(b.x)], 1u);
        const unsigned gen = old / nloc;
        if (old + 1u == (gen + 1u) * nloc) {
            __builtin_amdgcn_fence(__ATOMIC_RELEASE, "agent");
            asm volatile("s_waitcnt vmcnt(0)" ::: "memory");
            const unsigned og = xb_add(&bar[XB_TOP], 1u);
            const unsigned tg = og / nx;
            if (og + 1u == (tg + 1u) * nx) xb_add(&bar[XB_TOPGEN], 1u);
            else XB_SPIN(xb_ld(&bar[XB_TOPGEN]) == tg, bar);
            __builtin_amdgcn_fence(__ATOMIC_ACQUIRE, "agent");
            xb_add(&bar[XB_XGEN(b.x)], 1u);
            asm volatile("s_waitcnt vmcnt(0)" ::: "memory");
        } else {
            XB_SPIN(xb_ld(&bar[XB_XGEN(b.x)]) == gen, bar);
            __builtin_amdgcn_fence(__ATOMIC_ACQUIRE, "agent");
            asm volatile("s_waitcnt vmcnt(0)" ::: "memory");
        }
    }
    __syncthreads();
}

__device__ __forceinline__ void p0_transpose_item(const float* W, int K, int N, const float* gain, bf16_t* WT, int k0, int n0, int drow0, LAS float* scr, int lane) {
#pragma unroll 8
    for (int i = 0; i < 32; ++i) { const int kk = 2 * i + (lane >> 5); float v = *(const GAS float*)(W + (size_t)(k0 + kk) * N + n0 + (lane & 31));
        if (gain) v *= *(const GAS float*)(gain + k0 + kk);
        scr[kk * 33 + (lane & 31)] = v; }
    LDS_WAIT(); asm volatile("" ::: "memory");
    const int c = lane & 7;
#pragma unroll
    for (int j = 0; j < 4; ++j) { const int n = (lane >> 3) + 8 * j; const LAS float* s = scr + (8 * c) * 33 + n;
        u32x4 o; o.x = pk2(s[0 * 33], s[1 * 33]); o.y = pk2(s[2 * 33], s[3 * 33]); o.z = pk2(s[4 * 33], s[5 * 33]); o.w = pk2(s[6 * 33], s[7 * 33]);
        *(GAS u32x4*)(WT + (size_t)(drow0 + n) * K + k0 + 8 * c) = o; }
    LDS_WAIT(); asm volatile("" ::: "memory");
}
__device__ __forceinline__ int map_gu(int n0) { return n0 < DFF ? (n0 / 128) * 256 + (n0 % 128) : ((n0 - DFF) / 128) * 256 + 128 + ((n0 - DFF) % 128); }
__device__ __forceinline__ int map_win(int n0) { return n0 < 6144 ? n0 : (n0 < 6176 ? 9216 + (n0 - 6144) : n0 - 32); }

__device__ __forceinline__ void p0_prologue(Frame& F) {
    LAS float* scr = (LAS float*)(F.lds + F.wave * 16384);
    const int gw = F.vcu * NWAVES + F.wave, NGW = F.G * NWAVES, lane = F.lane;
    bf16_t* const wgu1 = (bf16_t*)(F.ws + WS_WGU1); bf16_t* const wd1 = (bf16_t*)(F.ws + WS_WD1); bf16_t* const win = (bf16_t*)(F.ws + WS_WIN);
    bf16_t* const wsso = (bf16_t*)(F.ws + WS_WSSO); bf16_t* const wo = (bf16_t*)(F.ws + WS_WO); bf16_t* const wgu2 = (bf16_t*)(F.ws + WS_WGU2);
    bf16_t* const wd2 = (bf16_t*)(F.ws + WS_WD2); bf16_t* const wpg = (bf16_t*)(F.ws + WS_WPG); bf16_t* const wple = (bf16_t*)(F.ws + WS_WPLE);
    constexpr int I_GU = (DM / 64) * (2 * DFF / 32), I_D = (DFF / 64) * (DM / 32), I_IN = (DM / 64) * (IN_DIM / 32), I_SSO = (DI / 64) * (DM / 32), I_SQ = (DM / 64) * (DM / 32), I_PLE = (PLE / 64) * (DM / 32);
    constexpr int NITEMS = 2 * I_GU + 2 * I_D + I_IN + I_SSO + 2 * I_SQ + I_PLE;
    for (int it = gw; it < NITEMS; it += NGW) {
        int r = it;
        if (r < I_GU) { const int nb = 2 * DFF / 32, kb = r / nb, n0 = (r % nb) * 32; p0_transpose_item(F.in[I_WGU1], DM, 2 * DFF, F.in[I_NFFN1], wgu1, kb * 64, n0, map_gu(n0), scr, lane); continue; } r -= I_GU;
        if (r < I_GU) { const int nb = 2 * DFF / 32, kb = r / nb, n0 = (r % nb) * 32; p0_transpose_item(F.in[I_WGU2], DM, 2 * DFF, F.in[I_NFFN2], wgu2, kb * 64, n0, map_gu(n0), scr, lane); continue; } r -= I_GU;
        if (r < I_D) { const int nb = DM / 32, kb = r / nb, n0 = (r % nb) * 32; p0_transpose_item(F.in[I_WD1], DFF, DM, nullptr, wd1, kb * 64, n0, n0, scr, lane); continue; } r -= I_D;
        if (r < I_D) { const int nb = DM / 32, kb = r / nb, n0 = (r % nb) * 32; p0_transpose_item(F.in[I_WD2], DFF, DM, nullptr, wd2, kb * 64, n0, n0, scr, lane); continue; } r -= I_D;
        if (r < I_IN) { const int nb = IN_DIM / 32, kb = r / nb, n0 = (r % nb) * 32; p0_transpose_item(F.in[I_WIN], DM, IN_DIM, F.in[I_NMIX], win, kb * 64, n0, map_win(n0), scr, lane); continue; } r -= I_IN;
        if (r < I_SSO) { const int nb = DM / 32, kb = r / nb, n0 = (r % nb) * 32; p0_transpose_item(F.in[I_WSSO], DI, DM, F.in[I_NSSD], wsso, kb * 64, n0, n0, scr, lane); continue; } r -= I_SSO;
        if (r < I_SQ) { const int nb = DM / 32, kb = r / nb, n0 = (r % nb) * 32; p0_transpose_item(F.in[I_WO], DM, DM, nullptr, wo, kb * 64, n0, n0, scr, lane); continue; } r -= I_SQ;
        if (r < I_SQ) { const int nb = DM / 32, kb = r / nb, n0 = (r % nb) * 32; p0_transpose_item(F.in[I_WPG], DM, DM, F.in[I_NPLE], wpg, kb * 64, n0, n0, scr, lane); continue; } r -= I_SQ;
        { const int nb = DM / 32, kb = r / nb, n0 = (r % nb) * 32; p0_transpose_item(F.in[I_WPLE], PLE, DM, nullptr, wple, kb * 64, n0, n0, scr, lane); }
    }
    {
        bf16_t* const w2 = (bf16_t*)(F.ws + WS_W2);
        const float* Wg = F.in[I_WPGRP]; const float* sc = F.in[I_PSCALE]; const float* Wpo = F.in[I_WPOUT];
        for (int it = F.vcu; it < 4 * 32; it += F.G) {
            const int g = it >> 5, c0 = (it & 31) * 8, n = F.tid;
            float a0[8], a1[8];
#pragma unroll
            for (int cc = 0; cc < 8; ++cc) { a0[cc] = 0.f; a1[cc] = 0.f; }
            for (int d = 0; d < 256; ++d) {
                const float s = *(const GAS float*)(sc + g * 256 + d);
                const float w0 = s * *(const GAS float*)(Wpo + (size_t)(g * 256 + d) * DM + n), w1 = s * *(const GAS float*)(Wpo + (size_t)(g * 256 + d) * DM + n + 512);
#pragma unroll
                for (int cc = 0; cc < 8; ++cc) { const float a = *(const GAS float*)(Wg + ((size_t)g * 256 + c0 + cc) * 256 + d); a0[cc] += a * w0; a1[cc] += a * w1; }
            }
            u32x4 o0, o1; o0.x = pk2(a0[0], a0[1]); o0.y = pk2(a0[2], a0[3]); o0.z = pk2(a0[4], a0[5]); o0.w = pk2(a0[6], a0[7]);
            o1.x = pk2(a1[0], a1[1]); o1.y = pk2(a1[2], a1[3]); o1.z = pk2(a1[4], a1[5]); o1.w = pk2(a1[6], a1[7]);
            *(GAS u32x4*)(w2 + (size_t)n * DM + g * 256 + c0) = o0; *(GAS u32x4*)(w2 + (size_t)(n + 512) * DM + g * 256 + c0) = o1;
        }
    }
    {
        bf16_t* const XB = (bf16_t*)(F.ws + WS_XB); bf16_t* const PB = (bf16_t*)(F.ws + WS_PB); float* const stA = (float*)(F.ws + WS_STATS_A);
        for (int m = gw; m < M; m += NGW) {
            const float* xrow = (m < MP) ? F.in[I_XP] + (size_t)m * DM : F.in[I_XS] + (size_t)(m - MP) * DM;
            const GAS f32x4* xr = (const GAS f32x4*)xrow + lane;
            f32x4 v[4]; float s = 0.f;
#pragma unroll
            for (int j = 0; j < 4; ++j) { v[j] = xr[64 * j]; s += (v[j].x * v[j].x + v[j].y * v[j].y) + (v[j].z * v[j].z + v[j].w * v[j].w); }
            s = wave_sum(s);
            GAS u32x2* o8 = (GAS u32x2*)(XB + (size_t)m * DM) + lane;
#pragma unroll
            for (int j = 0; j < 4; ++j) { u32x2 w; w.x = pk2(v[j].x, v[j].y); w.y = pk2(v[j].z, v[j].w); o8[64 * j] = w; }
            if (lane < 16) *(GAS float*)(stA + (size_t)m * 16 + lane) = (lane == 0) ? s : 0.f;
            const float* prow = (m < MP) ? F.in[I_PP] + (size_t)m * PLE : F.in[I_PS] + (size_t)(m - MP) * PLE;
            const f32x4 pv = *((const GAS f32x4*)prow + lane);
            u32x2 w; w.x = pk2(pv.x, pv.y); w.y = pk2(pv.z, pv.w); *((GAS u32x2*)(PB + (size_t)m * PLE) + lane) = w;
        }
    }
}

__device__ __forceinline__ void ssd_seq_phase(Frame& F) {
    const int half = F.wave >> 2, r = F.wave & 3, lane = F.lane, idx = r * 64 + lane;
    LAS float* const bc = (LAS float*)(F.lds + half * 57344);
    LAS float* const lxs = bc + 4096; LAS float* const lyg = bc + 8192; LAS float* const ldt = bc + 12288; LAS float* const ssq = bc + 12288 + 64;
    const bf16_t* const XBC = (const bf16_t*)(F.ws + WS_XBC); const bf16_t* const Zs = (const bf16_t*)(F.ws + WS_Z); bf16_t* const YN = (bf16_t*)(F.ws + WS_Z);
    const float* const DT = (const float*)(F.ws + WS_DT);
    const float* const convw = F.in[I_CONVW]; const float* const convb = F.in[I_CONVB];
    constexpr int NPI = (BATCH * NG) / 2, NSI = (DECB * NG) / 2;
    for (int it = F.vcu; it < NPI + NSI; it += F.G) {
        const bool prompt = it < NPI;
        const int item = (prompt ? it : it - NPI) * 2 + half, b = item >> 3, g = item & 7, head = g * HPG + r;
        const int T = prompt ? SEQ : DECS;
        const size_t row0 = prompt ? (size_t)b * SEQ : (size_t)MP + (size_t)b * DECS;
        const int xch = g * 256 + r * 64 + lane;
        const int bch = (idx < 128) ? (DI + g * DSTATE + idx) : (DI + NG * DSTATE + g * DSTATE + (idx - 128));
        float cwx[4], cwb[4];
#pragma unroll
        for (int k = 0; k < 4; ++k) { cwx[k] = *(const GAS float*)(convw + (size_t)k * CD + xch); cwb[k] = *(const GAS float*)(convw + (size_t)k * CD + bch); }
        const float cbx = *(const GAS float*)(convb + xch), cbb = *(const GAS float*)(convb + bch);
        const float Ah = -__expf(*(const GAS float*)(F.in[I_ALOG] + head)), Dh = *(const GAS float*)(F.in[I_DSKIP] + head);
        float x1 = 0.f, x2 = 0.f, x3 = 0.f, b1 = 0.f, b2 = 0.f, b3 = 0.f;
        float h[128];
        if (prompt) {
#pragma unroll
            for (int n = 0; n < 128; ++n) h[n] = 0.f;
        } else {
            const GAS f32x4* hp = (const GAS f32x4*)(F.in[I_SSM] + (((size_t)b * NH + head) * HD + lane) * DSTATE);
#pragma unroll
            for (int n = 0; n < 32; ++n) { const f32x4 v = hp[n]; h[4 * n] = v.x; h[4 * n + 1] = v.y; h[4 * n + 2] = v.z; h[4 * n + 3] = v.w; }
            const float* cs = F.in[I_CONV] + (size_t)b * 3 * CD;
            x3 = *(const GAS float*)(cs + xch); x2 = *(const GAS float*)(cs + CD + xch); x1 = *(const GAS float*)(cs + 2 * CD + xch);
            b3 = *(const GAS float*)(cs + bch); b2 = *(const GAS float*)(cs + CD + bch); b1 = *(const GAS float*)(cs + 2 * CD + bch);
        }
        for (int tb = 0; tb < T / 8; ++tb) {
            const int par = tb & 1;
            for (int j = 0; j < 8; ++j) {
                const size_t row = row0 + (size_t)tb * 8 + j;
                const float xr = bf2f(*(const GAS bf16_t*)(XBC + row * CD + xch)), br = bf2f(*(const GAS bf16_t*)(XBC + row * CD + bch));
                const float cx = cbx + cwx[0] * x3 + cwx[1] * x2 + cwx[2] * x1 + cwx[3] * xr; x3 = x2; x2 = x1; x1 = xr;
                const float cb_ = cbb + cwb[0] * b3 + cwb[1] * b2 + cwb[2] * b1 + cwb[3] * br; b3 = b2; b2 = b1; b1 = br;
                lxs[(par * 8 + j) * 256 + idx] = silu_f(cx);
                bc[(par * 8 + j) * 256 + idx] = silu_f(cb_);
                if (lane == 0) ldt[(par * 8 + j) * 4 + r] = *(const GAS float*)(DT + row * 32 + head);
            }
            __syncthreads();
            for (int j = 0; j < 8; ++j) {
                const size_t row = row0 + (size_t)tb * 8 + j;
                const float xsv = lxs[(par * 8 + j) * 256 + idx], dtv = ldt[(par * 8 + j) * 4 + r];
                const float dA = __expf(dtv * Ah), dx = dtv * xsv;
                const LAS f32x4* Bp = (const LAS f32x4*)(bc + (par * 8 + j) * 256); const LAS f32x4* Cp = Bp + 32;
                float y0 = 0.f, y1 = 0.f;
#pragma unroll
                for (int n8 = 0; n8 < 4; ++n8) {
#pragma unroll
                    for (int n = 8 * n8; n < 8 * n8 + 8; ++n) { const f32x4 Bv = Bp[n], Cv = Cp[n];
                        h[4 * n] = dA * h[4 * n] + dx * Bv.x; y0 += Cv.x * h[4 * n];
                        h[4 * n + 1] = dA * h[4 * n + 1] + dx * Bv.y; y1 += Cv.y * h[4 * n + 1];
                        h[4 * n + 2] = dA * h[4 * n + 2] + dx * Bv.z; y0 += Cv.z * h[4 * n + 2];
                        h[4 * n + 3] = dA * h[4 * n + 3] + dx * Bv.w; y1 += Cv.w * h[4 * n + 3]; }
                    asm volatile("" ::: "memory");
                }
                const float y = (y0 + y1) + Dh * xsv;
                const float zs = bf2f(*(const GAS bf16_t*)(Zs + row * DI + xch));
                const float ygv = y * zs;
                lyg[(par * 8 + j) * 256 + idx] = ygv;
                const float ss = wave_sum(ygv * ygv);
                if (lane == 0) ssq[(par * 8 + j) * 4 + r] = ss;
            }
            __syncthreads();
            for (int j = 0; j < 8; ++j) {
                const size_t row = row0 + (size_t)tb * 8 + j;
                const f32x4 s4 = *(const LAS f32x4*)(ssq + (par * 8 + j) * 4);
                const float rsn = __builtin_amdgcn_rsqf(((s4.x + s4.y) + (s4.z + s4.w)) * (1.0f / 256.0f) + EPS);
                *(GAS bf16_t*)(YN + row * DI + xch) = (bf16_t)f2bf(lyg[(par * 8 + j) * 256 + idx] * rsn);
            }
        }
        float* hout = (prompt ? F.out + O_SSM_P : F.out + O_SSM_S) + (((size_t)b * NH + head) * HD + lane) * DSTATE;
#pragma unroll
        for (int n = 0; n < 32; ++n) *((GAS f32x4*)hout + n) = (f32x4){h[4 * n], h[4 * n + 1], h[4 * n + 2], h[4 * n + 3]};
        __syncthreads();
    }
}
__device__ __forceinline__ void pool_phase(Frame& F) {
    const bf16_t* const V = (const bf16_t*)(F.ws + WS_V); bf16_t* const PO = (bf16_t*)(F.ws + WS_POOLED);
    const float* const sp = F.in[I_POOL];
    const int gt = F.vcu * NTHREADS + F.tid, NT = F.G * NTHREADS;
    for (int e = gt; e < M * 128; e += NT) {
        const int row = e >> 7, cv = (e & 127) * 8, w = 2 << (cv >> 8);
        float s[8];
#pragma unroll
        for (int j = 0; j < 8; ++j) s[j] = 0.f;
        f32x4 c0, c1; pg8::unpack8(*(const GAS u32x4*)(V + (size_t)row * PD + cv), c0, c1);
        float cnt;
        if (row < MP) {
            const int t = row & (SEQ - 1); const int nk = (t + 1 < w) ? t + 1 : w; cnt = (float)nk;
            for (int k = 0; k < nk; ++k) { f32x4 a0, a1; pg8::unpack8(*(const GAS u32x4*)(V + (size_t)(row - k) * PD + cv), a0, a1);
                s[0] += a0.x; s[1] += a0.y; s[2] += a0.z; s[3] += a0.w; s[4] += a1.x; s[5] += a1.y; s[6] += a1.z; s[7] += a1.w; }
        } else {
            const int rr = row - MP, b = rr >> 3, t = rr & 7; cnt = (float)w;
            for (int k = 0; k < w; ++k) { const int tt = t - k; f32x4 a0, a1;
                if (tt >= 0) pg8::unpack8(*(const GAS u32x4*)(V + (size_t)(row - k) * PD + cv), a0, a1);
                else { const float* p = sp + ((size_t)b * PBUF + (PBUF + tt)) * PD + cv; a0 = *(const GAS f32x4*)p; a1 = *(const GAS f32x4*)(p + 4); }
                s[0] += a0.x; s[1] += a0.y; s[2] += a0.z; s[3] += a0.w; s[4] += a1.x; s[5] += a1.y; s[6] += a1.z; s[7] += a1.w; }
        }
        const float ic = 1.0f / cnt;
        f32x4 o0 = (f32x4){s[0] * ic, s[1] * ic, s[2] * ic, s[3] * ic} - c0, o1 = (f32x4){s[4] * ic, s[5] * ic, s[6] * ic, s[7] * ic} - c1;
        u32x4 o; o.x = pk2(o0.x, o0.y); o.y = pk2(o0.z, o0.w); o.z = pk2(o1.x, o1.y); o.w = pk2(o1.z, o1.w);
        *(GAS u32x4*)(PO + (size_t)row * PD + cv) = o;
    }
    float* const ops = F.out + O_POOL_S;
    for (int e = gt; e < DECB * 7 * (PD / 4); e += NT) {
        const int c4 = e & 255, i = (e >> 8) % 7, b = (e >> 8) / 7;
        *(GAS f32x4*)(ops + ((size_t)b * PBUF + i) * PD + c4 * 4) = *(const GAS f32x4*)(sp + ((size_t)b * PBUF + 8 + i) * PD + c4 * 4);
    }
}
__device__ __forceinline__ void final_phase(Frame& F) {
    const int gw = F.vcu * NWAVES + F.wave, NGW = F.G * NWAVES, lane = F.lane;
    const float* const st = (const float*)(F.ws + WS_STATS_A); const float* const gf = F.in[I_NFINAL];
    f32x4 gv[4];
#pragma unroll
    for (int j = 0; j < 4; ++j) gv[j] = *((const GAS f32x4*)gf + lane + 64 * j);
    for (int m = gw; m < M; m += NGW) {
        const GAS f32x4* sp = (const GAS f32x4*)(st + (size_t)m * 16);
        const f32x4 a = sp[0], b = sp[1], c = sp[2], d = sp[3]; const f32x4 s = (a + b) + (c + d);
        const float rs = __builtin_amdgcn_rsqf(((s[0] + s[1]) + (s[2] + s[3])) * (1.0f / 1024.0f) + EPS);
        GAS f32x4* yr = (GAS f32x4*)(F.out + (size_t)m * DM) + lane;
#pragma unroll
        for (int j = 0; j < 4; ++j) yr[64 * j] = yr[64 * j] * rs * gv[j];
    }
}

constexpr int NPHASES = 13;
struct Args { const float* in[30]; float* out; unsigned char* ws; int ph_lo, ph_hi, li, pad; };
__global__ void __launch_bounds__(NTHREADS, 2) mk_fwd(Args args) {
    extern __shared__ __attribute__((aligned(16))) unsigned char lds[];
    Frame F;
    F.lds = (LAS unsigned char*)lds;
    F.MISC = (volatile LAS unsigned*)(F.lds + MISC_OFF);
    F.tid = threadIdx.x; F.lane = F.tid & 63; F.wave = __builtin_amdgcn_readfirstlane(F.tid >> 6);
    F.G = gridDim.x; { const int bx = blockIdx.x; F.vcu = (F.G % 8 == 0) ? (bx % 8) * (F.G / 8) + bx / 8 : bx; }
    F.ws = args.ws; F.out = args.out; F.ctl = (gu32*)(args.ws + WS_CTL);
#pragma unroll
    for (int i = 0; i < 30; ++i) F.in[i] = args.in[i];
    for (int u = F.tid; u < (LDS_BYTES - LDSCTL_OFF) / 4; u += NTHREADS) ((LAS unsigned*)(F.lds + LDSCTL_OFF))[u] = 0u;
    __syncthreads();
    const int lo = args.ph_lo, hi = args.ph_hi;
    XcdBarrier bar; bar.bar = (unsigned*)(F.ctl + CW_BAR); bar.x = 0; bar.st = nullptr;
    if (hi - lo > 1) bar = xcd_barrier_post((unsigned*)(F.ctl + CW_BAR), F.MISC + 8);
#ifndef PHMASK
#define PHMASK 0x1fff
#endif
#define IN(k) (((PHMASK >> (k)) & 1) && lo <= (k) && (k) < hi)
#define SEAM(k) do { if (IN(k) && IN((k) + 1)) xcd_barrier(bar); } while (0)

    bf16_t* const XB = (bf16_t*)(F.ws + WS_XB); bf16_t* const HB = (bf16_t*)(F.ws + WS_HB); bf16_t* const ACT = (bf16_t*)(F.ws + WS_ACT);
    bf16_t* const Zb = (bf16_t*)(F.ws + WS_Z); bf16_t* const XBCb = (bf16_t*)(F.ws + WS_XBC); bf16_t* const Vb = (bf16_t*)(F.ws + WS_V); bf16_t* const GATES = (bf16_t*)(F.ws + WS_GATES);
    bf16_t* const POOLED = (bf16_t*)(F.ws + WS_POOLED); bf16_t* const MERGED = (bf16_t*)(F.ws + WS_MERGED); bf16_t* const Qb = (bf16_t*)(F.ws + WS_Q); bf16_t* const PB = (bf16_t*)(F.ws + WS_PB);
    float* const T1 = (float*)(F.ws + WS_T1); float* const stA = (float*)(F.ws + WS_STATS_A); float* const stB = (float*)(F.ws + WS_STATS_B); float* const DTb = (float*)(F.ws + WS_DT);
    float* const H = F.out + O_Y;
    pg8::StaticOrder S;

    if (IN(0)) { p0_prologue(F); } SEAM(0);
    if (IN(1)) {
        pg8::Gemm g{XB, (const bf16_t*)(F.ws + WS_WGU1), M, 2 * DFF, DM}; S.init(M, 2 * DFF, F.G, (int)blockIdx.x);
        pg8::Epi E{}; E.kind = pg8::EK_GU; E.stats_in = stA; E.obf = ACT; E.ldo = DFF;
        pg8::gemm_phase(F.lds, g, S, E);
    } SEAM(1);
    if (IN(2)) {
        pg8::Gemm g{ACT, (const bf16_t*)(F.ws + WS_WD1), M, DM, DFF}; S.init(M, DM, F.G, (int)blockIdx.x);
        pg8::Epi E{}; E.kind = pg8::EK_RES; E.coef = 0.5f; E.res_p = F.in[I_XP]; E.res_s = F.in[I_XS]; E.of32 = H; E.obf = HB; E.stats_out = stB;
        pg8::gemm_phase(F.lds, g, S, E);
    } SEAM(2);
    if (IN(3)) {
        pg8::Gemm g{HB, (const bf16_t*)(F.ws + WS_WIN), M, NIN, DM}; S.init(M, NIN, F.G, (int)blockIdx.x);
        pg8::Epi E{}; E.kind = pg8::EK_WIN; E.stats_in = stB; E.Z = Zb; E.XBC = XBCb; E.V = Vb; E.GATES = GATES; E.DT = DTb; E.dt_bias = F.in[I_DTB];
        E.conv_p = F.out + O_CONV_P; E.conv_s = F.out + O_CONV_S; E.pool_p = F.out + O_POOL_P; E.pool_s = F.out + O_POOL_S;
        pg8::gemm_phase(F.lds, g, S, E);
    } SEAM(3);
    if (IN(4)) { ssd_seq_phase(F); pool_phase(F); } SEAM(4);
    if (IN(5)) {
        pg8::Gemm g{Zb, (const bf16_t*)(F.ws + WS_WSSO), M, DM, DI}; S.init(M, DM, F.G, (int)blockIdx.x);
        pg8::Epi E{}; E.kind = pg8::EK_T1; E.gates = GATES; E.of32 = T1;
        pg8::gemm_phase(F.lds, g, S, E);
    } SEAM(5);
    if (IN(6)) {
        pg8::Gemm g{POOLED, (const bf16_t*)(F.ws + WS_W2), M, DM, DM}; S.init(M, DM, F.G, (int)blockIdx.x);
        pg8::Epi E{}; E.kind = pg8::EK_MERGE; E.gates = GATES; E.res_p = T1; E.obf = MERGED;
        pg8::gemm_phase(F.lds, g, S, E);
    } SEAM(6);
    if (IN(7)) {
        pg8::Gemm g{MERGED, (const bf16_t*)(F.ws + WS_WO), M, DM, DM}; S.init(M, DM, F.G, (int)blockIdx.x);
        pg8::Epi E{}; E.kind = pg8::EK_RES; E.coef = 1.0f; E.res_p = H; E.res_s = H + (size_t)MP * DM; E.of32 = H; E.obf = HB; E.stats_out = stA;
        pg8::gemm_phase(F.lds, g, S, E);
    } SEAM(7);
    if (IN(8)) {
        pg8::Gemm g{HB, (const bf16_t*)(F.ws + WS_WGU2), M, 2 * DFF, DM}; S.init(M, 2 * DFF, F.G, (int)blockIdx.x);
        pg8::Epi E{}; E.kind = pg8::EK_GU; E.stats_in = stA; E.obf = ACT; E.ldo = DFF;
        pg8::gemm_phase(F.lds, g, S, E);
    } SEAM(8);
    if (IN(9)) {
        pg8::Gemm g{ACT, (const bf16_t*)(F.ws + WS_WD2), M, DM, DFF}; S.init(M, DM, F.G, (int)blockIdx.x);
        pg8::Epi E{}; E.kind = pg8::EK_RES; E.coef = 0.5f; E.res_p = H; E.res_s = H + (size_t)MP * DM; E.of32 = H; E.obf = HB; E.stats_out = stB;
        pg8::gemm_phase(F.lds, g, S, E);
    } SEAM(9);
    if (IN(10)) {
        pg8::Gemm g{PB, (const bf16_t*)(F.ws + WS_WPLE), M, DM, PLE}; S.init(M, DM, F.G, (int)blockIdx.x);
        pg8::Epi E{}; E.kind = pg8::EK_BF16; E.obf = Qb; E.ldo = DM;
        pg8::gemm_phase(F.lds, g, S, E);
    } SEAM(10);
    if (IN(11)) {
        pg8::Gemm g{HB, (const bf16_t*)(F.ws + WS_WPG), M, DM, DM}; S.init(M, DM, F.G, (int)blockIdx.x);
        pg8::Epi E{}; E.kind = pg8::EK_PLE; E.stats_in = stB; E.q = Qb; E.of32 = H; E.stats_out = stA;
        pg8::gemm_phase(F.lds, g, S, E);
    } SEAM(11);
    if (IN(12)) { final_phase(F); }
#undef IN
#undef SEAM
}

extern "C" void kernel_launch(void* const* d_in, const int* in_sizes, int n_in, void* d_out, int out_size, void* d_ws, size_t ws_size, hipStream_t stream) {
    static int grid = 0;
    if (grid == 0) {
        if (n_in != 30 || in_sizes[0] != MP * DM || (size_t)out_size != O_END || ws_size < WS_END) {
            fprintf(stderr, "kernel_launch: shape mismatch: n_in %d in0 %d out %d ws %zu (need %zu)\n", n_in, n_in > 0 ? in_sizes[0] : -1, out_size, ws_size, (size_t)WS_END); grid = -1; return; }
        int dev = 0, cus = 0, per_cu = 0;
        if (hipGetDevice(&dev) != hipSuccess || hipDeviceGetAttribute(&cus, hipDeviceAttributeMultiprocessorCount, dev) != hipSuccess) { grid = -1; return; }
        if (hipFuncSetAttribute((const void*)mk_fwd, hipFuncAttributeMaxDynamicSharedMemorySize, LDS_BYTES) != hipSuccess) { fprintf(stderr, "kernel_launch: hipFuncSetAttribute failed\n"); grid = -1; return; }
        if (hipOccupancyMaxActiveBlocksPerMultiprocessor(&per_cu, (const void*)mk_fwd, NTHREADS, LDS_BYTES) != hipSuccess || per_cu < 1)
            fprintf(stderr, "kernel_launch: occupancy query reports %d workgroups per CU\n", per_cu);
        (void)hipGetLastError();
        grid = cus;
    }
    if (grid < 0) return;
    if (hipMemsetAsync((char*)d_ws + WS_CTL, 0, CTL_ZERO_BYTES, stream) != hipSuccess) { fprintf(stderr, "kernel_launch: memset failed\n"); return; }
    Args a{};
    for (int i = 0; i < 30; ++i) a.in[i] = (const float*)d_in[i];
    a.out = (float*)d_out; a.ws = (unsigned char*)d_ws;
#if MK_MULTI_LAUNCH
    for (int ph = 0; ph < NPHASES; ++ph) { a.ph_lo = ph; a.ph_hi = ph + 1; a.li = ph;
        hipLaunchKernelGGL(mk_fwd, dim3(grid), dim3(NTHREADS), LDS_BYTES, stream, a); }
#else
    a.ph_lo = 0; a.ph_hi = NPHASES; a.li = 0;
    hipLaunchKernelGGL(mk_fwd, dim3(grid), dim3(NTHREADS), LDS_BYTES, stream, a);
#endif
}
```

```cpp
#include <hip/hip_runtime.h>
#include <cstdio>
#include <cstdint>

#ifndef MK_MULTI_LAUNCH
#define MK_MULTI_LAUNCH 0
#endif

#define GAS __attribute__((address_space(1)))
#define LAS __attribute__((address_space(3)))
typedef unsigned short bf16_t;
typedef short bf16x8 __attribute__((ext_vector_type(8)));
typedef float f32x4 __attribute__((ext_vector_type(4)));
typedef float f32x2 __attribute__((ext_vector_type(2)));
typedef unsigned u32x4 __attribute__((ext_vector_type(4)));
typedef unsigned u32x2 __attribute__((ext_vector_type(2)));
typedef GAS unsigned gu32;

constexpr int DM = 1024, BATCH = 8, SEQ = 2048, DECB = 128, DECS = 8;
constexpr int MP = BATCH * SEQ, MS = DECB * DECS, M = MP + MS;
constexpr int DI = 2048, HD = 64, NH = 32, NG = 8, HPG = 4, DSTATE = 128, CD = 4096;
constexpr int PD = 1024, PBUF = 15, DFF = 2816, PLE = 256;
constexpr int IN_DIM = 9248, NIN = 9472;
constexpr float EPS = 1e-6f;
constexpr int NWAVES = 8, NTHREADS = 512;

constexpr size_t MiB = 1u << 20;
constexpr size_t WS_CTL = 0, CTL_ZERO_BYTES = 1 * MiB;
constexpr size_t WS_STATS_A = 2 * MiB, WS_STATS_B = 4 * MiB, WS_DT = 6 * MiB, WS_CDEC = 9 * MiB;
constexpr size_t WS_WGU1 = 10 * MiB, WS_WD1 = 21 * MiB, WS_WIN = 27 * MiB, WS_WSSO = 46 * MiB, WS_W2 = 50 * MiB, WS_WO = 52 * MiB,
                 WS_WGU2 = 54 * MiB, WS_WD2 = 65 * MiB, WS_WPG = 71 * MiB, WS_WPLE = 73 * MiB, WS_PB = 74 * MiB;
constexpr size_t WS_Z = 84 * MiB, WS_XBC = 152 * MiB, WS_V = 288 * MiB, WS_GATES = 322 * MiB, WS_HB = 390 * MiB, WS_HPREV = 424 * MiB, WS_END = 488 * MiB;
constexpr size_t WS_ACT = WS_XBC, WS_T1 = WS_XBC, WS_MERGED = WS_V, WS_Q = WS_GATES, WS_XB = WS_HB, WS_POOLED = WS_HB;
static_assert(WS_STATS_A + (size_t)M * 16 * 4 <= WS_STATS_B && WS_STATS_B + (size_t)M * 16 * 4 <= WS_DT && WS_DT + (size_t)M * 32 * 4 <= WS_WGU1, "ws map (small)");
static_assert(WS_WGU1 + (size_t)2 * DFF * DM * 2 <= WS_WD1 && WS_WD1 + (size_t)DM * DFF * 2 <= WS_WIN && WS_WIN + (size_t)NIN * DM * 2 <= WS_WSSO && WS_WSSO + (size_t)DM * DI * 2 <= WS_W2, "ws map (w1)");
static_assert(WS_WGU2 + (size_t)2 * DFF * DM * 2 <= WS_WD2 && WS_WD2 + (size_t)DM * DFF * 2 <= WS_WPG && WS_WPLE + (size_t)DM * PLE * 2 <= WS_PB && WS_PB + (size_t)M * PLE * 2 <= WS_Z, "ws map (w2)");
static_assert(WS_Z + (size_t)M * DI * 2 <= WS_XBC && WS_XBC + (size_t)M * CD * 2 <= WS_V && WS_V + (size_t)M * PD * 2 <= WS_GATES && WS_GATES + (size_t)M * 2 * DM * 2 <= WS_HB &&
              WS_HB + (size_t)M * DM * 2 <= WS_HPREV && WS_HPREV + (size_t)BATCH * 16 * NH * HD * DSTATE * 2 <= WS_END, "ws map (act)");
static_assert(WS_ACT + (size_t)M * DFF * 2 <= WS_V && WS_T1 + (size_t)M * DM * 4 <= WS_V, "ws overlays");
constexpr int CW_BAR = 4096;

constexpr size_t O_Y = 0, O_SSM_P = (size_t)M * DM, O_CONV_P = O_SSM_P + (size_t)BATCH * NH * HD * DSTATE, O_POOL_P = O_CONV_P + (size_t)BATCH * 3 * CD,
                 O_SSM_S = O_POOL_P + (size_t)BATCH * PBUF * PD, O_CONV_S = O_SSM_S + (size_t)DECB * NH * HD * DSTATE, O_POOL_S = O_CONV_S + (size_t)DECB * 3 * CD,
                 O_END = O_POOL_S + (size_t)DECB * PBUF * PD;

constexpr int RING_BYTES = 131072, LDSCTL_OFF = RING_BYTES, MISC_OFF = LDSCTL_OFF + 320, LDS_BYTES = 147456;

#define RLX_AGENT __ATOMIC_RELAXED, __HIP_MEMORY_SCOPE_AGENT
#define LDS_WAIT() asm volatile("s_waitcnt lgkmcnt(0)" ::: "memory")
#define VM_WAIT() asm volatile("s_waitcnt vmcnt(0)" ::: "memory")

__device__ __forceinline__ unsigned f2bf(float f) { unsigned u = __builtin_bit_cast(unsigned, f); return (u + 0x7fffu + ((u >> 16) & 1u)) >> 16; }
__device__ __forceinline__ unsigned pk2(float lo, float hi) { return f2bf(lo) | (f2bf(hi) << 16); }
__device__ __forceinline__ float bf2f(unsigned b) { return __builtin_bit_cast(float, b << 16); }
__device__ __forceinline__ float bflo(unsigned w) { return __builtin_bit_cast(float, w << 16); }
__device__ __forceinline__ float bfhi(unsigned w) { return __builtin_bit_cast(float, w & 0xffff0000u); }
__device__ __forceinline__ unsigned cvt_pk_bf16(float lo, float hi) { unsigned r; asm volatile("v_cvt_pk_bf16_f32 %0, %1, %2" : "=v"(r) : "v"(lo), "v"(hi)); return r; }
__device__ __forceinline__ float sigm_f(float x) { return 1.0f / (1.0f + __expf(-x)); }
__device__ __forceinline__ float silu_f(float x) { return x / (1.0f + __expf(-x)); }
__device__ __forceinline__ float wave_sum(float v) {
#pragma unroll
    for (int o = 1; o < 64; o <<= 1) v += __shfl_xor(v, o);
    return v;
}

struct Frame {
    LAS unsigned char* lds;
    volatile LAS unsigned* MISC;
    gu32* ctl;
    int tid, lane, wave, vcu, G;
    unsigned char* ws;
    float* out;
    const float* in[30];
};
enum { I_XP = 0, I_XS, I_SSM, I_CONV, I_POOL, I_PP, I_PS, I_NFFN1, I_WGU1, I_WD1, I_NMIX, I_WIN, I_CONVW, I_CONVB, I_DTB, I_ALOG, I_DSKIP, I_NSSD, I_WSSO, I_WPGRP, I_PSCALE,
       I_WPOUT, I_WO, I_NFFN2, I_WGU2, I_WD2, I_NPLE, I_WPG, I_WPLE, I_NFINAL };

namespace pg8 {
constexpr int BM = 256, BK = 64, HALF = 128, HTB = HALF * BK * 2, STAGE_BYTES = 8 * HTB, NXCD = 8, WGM = 8;
__host__ __device__ __forceinline__ int lds_byte(int r, int c) { const int st = (r >> 4) * 2 + (c >> 5), rr = r & 15, cc = c & 31, ob = rr * 64 + cc * 2; return st * 1024 + (ob ^ (((ob >> 9) & 1) << 5)); }
__host__ __device__ __forceinline__ void stage_rc(int b, int& R, int& C) { const int st = b / 1024, sb = b % 1024, swz = sb ^ (((sb >> 9) & 1) << 5); R = (st >> 1) * 16 + swz / 64; C = (st & 1) * 32 + (swz % 64) / 2; }
__host__ __device__ __forceinline__ int perm32(int rho) { const int n = rho >> 4, i = rho & 15; return 8 * (i >> 2) + 4 * n + (i & 3); }
struct Unit { int pm, pn; };
struct Gemm { const bf16_t* A; const bf16_t* Bt; int M, N, K; };
struct StaticOrder {
    int nM, nN, nwg, G, c;
    __host__ __device__ void init(int M_, int N_, int G_, int c_) { nM = M_ / BM; nN = N_ / BM; nwg = nM * nN; G = G_; c = c_; }
    __host__ __device__ bool next(int i, Unit& u) const {
        const long L = (long)i * G + c; if (L >= nwg) return false;
        int wgid = (int)L; { const int q = nwg / NXCD, r = nwg % NXCD, xcd = wgid % NXCD, off = wgid / NXCD; wgid = (xcd < r ? xcd * (q + 1) : r * (q + 1) + (xcd - r) * q) + off; }
        const int nig = WGM * nN, gid = wgid / nig, fm = gid * WGM, gsz = (nM - fm) < WGM ? (nM - fm) : WGM;
        u.pm = fm + ((wgid % nig) % gsz); u.pn = (wgid % nig) / gsz; return true;
    }
};

enum EpiKind { EK_GU = 1, EK_RES = 2, EK_WIN = 3, EK_T1 = 4, EK_MERGE = 5, EK_BF16 = 6, EK_PLE = 7 };
struct Epi {
    const float* stats_in;
    float* stats_out;
    bf16_t* obf;
    float* of32;
    const float* res_p; const float* res_s;
    const bf16_t* gates;
    const bf16_t* q;
    bf16_t *Z, *XBC, *V, *GATES; float* DT; const float* dt_bias; float *conv_p, *conv_s, *pool_p, *pool_s;
    int kind; int ldo; float coef; int pad;
};

__device__ __forceinline__ u32x4 pack8(const f32x4 a, const f32x4 b) { u32x4 w; w.x = cvt_pk_bf16(a[0], a[1]); w.y = cvt_pk_bf16(a[2], a[3]); w.z = cvt_pk_bf16(b[0], b[1]); w.w = cvt_pk_bf16(b[2], b[3]); return w; }
__device__ __forceinline__ void unpack8(const u32x4 w, f32x4& a, f32x4& b) { a = (f32x4){bflo(w.x), bfhi(w.x), bflo(w.y), bfhi(w.y)}; b = (f32x4){bflo(w.z), bfhi(w.z), bflo(w.w), bfhi(w.w)}; }

__device__ __forceinline__ float row_rs(const float* stats, int row) {
    if (!stats) return 1.0f;
    const GAS f32x4* sp = (const GAS f32x4*)(stats + (size_t)row * 16);
    const f32x4 a = sp[0], b = sp[1], c = sp[2], d = sp[3]; const f32x4 s = (a + b) + (c + d);
    return __builtin_amdgcn_rsqf(((s[0] + s[1]) + (s[2] + s[3])) * (1.0f / 1024.0f) + EPS);
}
__device__ __forceinline__ float softplus_f(float x) { const float e = __expf(-fabsf(x)); const float l = (e < 0.01f) ? e * (1.0f - e * (0.5f - e * (1.0f / 3.0f))) : __logf(1.0f + e); return fmaxf(x, 0.f) + l; }

__device__ __forceinline__ void epilogue(const Epi& E, const f32x4 (&acc)[2][2][4][2], const Unit& u, int wr, int wc, int fr, int fq) {
    const int rowb = u.pm * BM + wr * 64 + fr;
    const int cin = wc * 32 + 8 * fq;
    if (E.kind == EK_GU) {
#pragma unroll
        for (int ai = 0; ai < 2; ++ai)
#pragma unroll
            for (int m = 0; m < 4; ++m) { const int row = rowb + ai * HALF + m * 16; const float r = row_rs(E.stats_in, row);
                const f32x4 g0 = acc[ai][0][m][0] * r, u0 = acc[ai][1][m][0] * r, g1 = acc[ai][0][m][1] * r, u1 = acc[ai][1][m][1] * r;
                const f32x4 o0 = (f32x4){silu_f(g0[0]) * u0[0], silu_f(g0[1]) * u0[1], silu_f(g0[2]) * u0[2], silu_f(g0[3]) * u0[3]};
                const f32x4 o1 = (f32x4){silu_f(g1[0]) * u1[0], silu_f(g1[1]) * u1[1], silu_f(g1[2]) * u1[2], silu_f(g1[3]) * u1[3]};
                *(GAS u32x4*)(E.obf + (size_t)row * E.ldo + u.pn * HALF + cin) = pack8(o0, o1); }
    } else if (E.kind == EK_RES) {
#pragma unroll
        for (int ai = 0; ai < 2; ++ai)
#pragma unroll
            for (int m = 0; m < 4; ++m) { const int row = rowb + ai * HALF + m * 16;
                const float* rp = (row < MP) ? E.res_p + (size_t)row * DM : E.res_s + (size_t)(row - MP) * DM;
                float ss = 0.f;
#pragma unroll
                for (int bj = 0; bj < 2; ++bj) { const int col = u.pn * BM + bj * HALF + cin;
                    const f32x4 r0 = *(const GAS f32x4*)(rp + col), r1 = *(const GAS f32x4*)(rp + col + 4);
                    const f32x4 h0 = r0 + acc[ai][bj][m][0] * E.coef, h1 = r1 + acc[ai][bj][m][1] * E.coef;
                    *(GAS f32x4*)(E.of32 + (size_t)row * DM + col) = h0; *(GAS f32x4*)(E.of32 + (size_t)row * DM + col + 4) = h1;
                    *(GAS u32x4*)(E.obf + (size_t)row * DM + col) = pack8(h0, h1);
                    ss += (h0[0] * h0[0] + h0[1] * h0[1]) + (h0[2] * h0[2] + h0[3] * h0[3]) + (h1[0] * h1[0] + h1[1] * h1[1]) + (h1[2] * h1[2] + h1[3] * h1[3]); }
                ss += __shfl_xor(ss, 16); ss += __shfl_xor(ss, 32);
                if (fq == 0) *(GAS float*)(E.stats_out + (size_t)row * 16 + u.pn * 4 + wc) = ss; }
    } else if (E.kind == EK_WIN) {
        const int pn = u.pn;
        if (pn < 8 || (pn >= 28 && pn < 36)) {
            const bool isz = pn < 8; bf16_t* const O = isz ? E.Z : E.GATES; const int colt = (isz ? pn : pn - 28) * BM + cin;
#pragma unroll
            for (int ai = 0; ai < 2; ++ai)
#pragma unroll
                for (int m = 0; m < 4; ++m) { const int row = rowb + ai * HALF + m * 16; const float r = row_rs(E.stats_in, row);
#pragma unroll
                    for (int bj = 0; bj < 2; ++bj) { f32x4 v0 = acc[ai][bj][m][0] * r, v1 = acc[ai][bj][m][1] * r;
#pragma unroll
                        for (int j = 0; j < 4; ++j) { const float s0 = sigm_f(v0[j]), s1 = sigm_f(v1[j]); v0[j] = isz ? v0[j] * s0 : s0; v1[j] = isz ? v1[j] * s1 : s1; }
                        *(GAS u32x4*)(O + (size_t)row * (2 * DM) + colt + bj * HALF) = pack8(v0, v1); } }
        } else if (pn < 28) {
            const bool isx = pn < 24; bf16_t* const O = isx ? E.XBC : E.V; const int ldo = isx ? CD : PD; const int colt = (isx ? pn - 8 : pn - 24) * BM + cin;
            const int keep = isx ? 3 : PBUF;
#pragma unroll
            for (int ai = 0; ai < 2; ++ai)
#pragma unroll
                for (int m = 0; m < 4; ++m) { const int row = rowb + ai * HALF + m * 16; const float r = row_rs(E.stats_in, row);
                    float* sp = nullptr;
                    if (row < MP) { const int sb = row >> 11, st = row & (SEQ - 1); if (st >= SEQ - keep) sp = (isx ? E.conv_p : E.pool_p) + ((size_t)sb * keep + (st - (SEQ - keep))) * ldo + colt; }
                    else { const int sb = (row - MP) >> 3, st = (row - MP) & 7; const int si = st - (DECS - keep); if (si >= 0) sp = (isx ? E.conv_s : E.pool_s) + ((size_t)sb * keep + si) * ldo + colt; }
#pragma unroll
                    for (int bj = 0; bj < 2; ++bj) { const f32x4 v0 = acc[ai][bj][m][0] * r, v1 = acc[ai][bj][m][1] * r;
                        *(GAS u32x4*)(O + (size_t)row * ldo + colt + bj * HALF) = pack8(v0, v1);
                        if (sp) { *(GAS f32x4*)(sp + bj * HALF) = v0; *(GAS f32x4*)(sp + bj * HALF + 4) = v1; } } }
        } else if (wc == 0) {
            const f32x4 b0 = *(const GAS f32x4*)(E.dt_bias + 8 * fq), b1 = *(const GAS f32x4*)(E.dt_bias + 8 * fq + 4);
#pragma unroll
            for (int ai = 0; ai < 2; ++ai)
#pragma unroll
                for (int m = 0; m < 4; ++m) { const int row = rowb + ai * HALF + m * 16; const float r = row_rs(E.stats_in, row);
                    f32x4 v0 = acc[ai][0][m][0] * r + b0, v1 = acc[ai][0][m][1] * r + b1;
#pragma unroll
                    for (int j = 0; j < 4; ++j) { v0[j] = softplus_f(v0[j]); v1[j] = softplus_f(v1[j]); }
                    *(GAS f32x4*)(E.DT + (size_t)row * 32 + 8 * fq) = v0; *(GAS f32x4*)(E.DT + (size_t)row * 32 + 8 * fq + 4) = v1; }
        }
    } else if (E.kind == EK_T1) {
#pragma unroll
        for (int ai = 0; ai < 2; ++ai)
#pragma unroll
            for (int m = 0; m < 4; ++m) { const int row = rowb + ai * HALF + m * 16;
#pragma unroll
                for (int bj = 0; bj < 2; ++bj) { const int col = u.pn * BM + bj * HALF + cin;
                    f32x4 g0, g1; unpack8(*(const GAS u32x4*)(E.gates + (size_t)row * (2 * DM) + col), g0, g1);
                    *(GAS f32x4*)(E.of32 + (size_t)row * DM + col) = g0 * acc[ai][bj][m][0]; *(GAS f32x4*)(E.of32 + (size_t)row * DM + col + 4) = g1 * acc[ai][bj][m][1]; } }
    } else if (E.kind == EK_MERGE) {
#pragma unroll
        for (int ai = 0; ai < 2; ++ai)
#pragma unroll
            for (int m = 0; m < 4; ++m) { const int row = rowb + ai * HALF + m * 16;
#pragma unroll
                for (int bj = 0; bj < 2; ++bj) { const int col = u.pn * BM + bj * HALF + cin;
                    f32x4 g0, g1; unpack8(*(const GAS u32x4*)(E.gates + (size_t)row * (2 * DM) + DM + col), g0, g1);
                    const f32x4 t0 = *(const GAS f32x4*)(E.res_p + (size_t)row * DM + col), t1 = *(const GAS f32x4*)(E.res_p + (size_t)row * DM + col + 4);
                    *(GAS u32x4*)(E.obf + (size_t)row * DM + col) = pack8(t0 + g0 * acc[ai][bj][m][0], t1 + g1 * acc[ai][bj][m][1]); } }
    } else if (E.kind == EK_BF16) {
#pragma unroll
        for (int ai = 0; ai < 2; ++ai)
#pragma unroll
            for (int m = 0; m < 4; ++m) { const int row = rowb + ai * HALF + m * 16;
#pragma unroll
                for (int bj = 0; bj < 2; ++bj) { const int col = u.pn * BM + bj * HALF + cin;
                    *(GAS u32x4*)(E.obf + (size_t)row * E.ldo + col) = pack8(acc[ai][bj][m][0], acc[ai][bj][m][1]); } }
    } else if (E.kind == EK_PLE) {
#pragma unroll
        for (int ai = 0; ai < 2; ++ai)
#pragma unroll
            for (int m = 0; m < 4; ++m) { const int row = rowb + ai * HALF + m * 16; const float r = row_rs(E.stats_in, row);
                float ss = 0.f;
#pragma unroll
                for (int bj = 0; bj < 2; ++bj) { const int col = u.pn * BM + bj * HALF + cin;
                    f32x4 q0, q1; unpack8(*(const GAS u32x4*)(E.q + (size_t)row * DM + col), q0, q1);
                    const f32x4 r0 = *(const GAS f32x4*)(E.of32 + (size_t)row * DM + col), r1 = *(const GAS f32x4*)(E.of32 + (size_t)row * DM + col + 4);
                    f32x4 h0, h1;
#pragma unroll
                    for (int j = 0; j < 4; ++j) { h0[j] = r0[j] + sigm_f(acc[ai][bj][m][0][j] * r) * q0[j]; h1[j] = r1[j] + sigm_f(acc[ai][bj][m][1][j] * r) * q1[j]; }
                    *(GAS f32x4*)(E.of32 + (size_t)row * DM + col) = h0; *(GAS f32x4*)(E.of32 + (size_t)row * DM + col + 4) = h1;
                    ss += (h0[0] * h0[0] + h0[1] * h0[1]) + (h0[2] * h0[2] + h0[3] * h0[3]) + (h1[0] * h1[0] + h1[1] * h1[1]) + (h1[2] * h1[2] + h1[3] * h1[3]); }
                ss += __shfl_xor(ss, 16); ss += __shfl_xor(ss, 32);
                if (fq == 0) *(GAS float*)(E.stats_out + (size_t)row * 16 + u.pn * 4 + wc) = ss; }
    }
}

__device__ __forceinline__ void gemm_phase(LAS unsigned char* lds, const Gemm g, const StaticOrder& S, const Epi& E) {
    const int tid = threadIdx.x, wid = __builtin_amdgcn_readfirstlane(tid >> 6), lane = tid & 63, wr = wid >> 2, wc = wid & 3, fr = lane & 15, fq = lane >> 4;
    const int K = g.K, nt = K / BK;
    unsigned voffA[2], voffB[2];
#pragma unroll
    for (int i = 0; i < 2; ++i) { int R, C; stage_rc(tid * 16 + i * 8192, R, C); const int Rb = (R & ~31) + perm32(R & 31);
        voffA[i] = (unsigned)(R * K + C) * 2u; voffB[i] = (unsigned)(Rb * K + C) * 2u; }
    const size_t kstep = (size_t)(BK * 2);
    const size_t hstep = (size_t)HALF * K * 2;
    const size_t tstep = 2 * hstep;
    const unsigned ldsw = (unsigned)wid * 1024u;
    const int aoff = lds_byte(wr * 64 + fr, fq * 8), boff = lds_byte(wc * 32 + fr, fq * 8);
#define PG8_SA(b, h) (((b) * 2 + (h)) * HTB)
#define PG8_SB(b, h) ((4 + (b) * 2 + (h)) * HTB)
#define PG8_STAGE(bufoff, gbase, voff) do { _Pragma("unroll") for (int _i = 0; _i < 2; ++_i) \
        __builtin_amdgcn_global_load_lds((const unsigned*)((const char*)(gbase) + (voff)[_i]), (LAS unsigned*)(lds + (bufoff) + ldsw + _i * 8192), 16, 0, 0); } while (0)
#define PG8_LDA(dst, b, h) do { _Pragma("unroll") for (int m = 0; m < 4; ++m) _Pragma("unroll") for (int k = 0; k < 2; ++k) dst[m][k] = *(const LAS bf16x8*)(lds + PG8_SA(b, h) + aoff + m * 2048 + k * 1024); } while (0)
#define PG8_LDB(dst, b, h) do { _Pragma("unroll") for (int n = 0; n < 2; ++n) _Pragma("unroll") for (int k = 0; k < 2; ++k) dst[n][k] = *(const LAS bf16x8*)(lds + PG8_SB(b, h) + boff + n * 2048 + k * 1024); } while (0)
#define PG8_MMA(ai, bj, At, Bt) do { __builtin_amdgcn_s_setprio(1); _Pragma("unroll") for (int m = 0; m < 4; ++m) _Pragma("unroll") for (int n = 0; n < 2; ++n) _Pragma("unroll") for (int k = 0; k < 2; ++k) \
        acc[ai][bj][m][n] = __builtin_amdgcn_mfma_f32_16x16x32_bf16(Bt[n][k], At[m][k], acc[ai][bj][m][n], 0, 0, 0); __builtin_amdgcn_s_setprio(0); } while (0)
#define PG8_WAIT_V(n) asm volatile("s_waitcnt vmcnt(" #n ")" ::: "memory")
#define PG8_WAIT_L(n) asm volatile("s_waitcnt lgkmcnt(" #n ")" ::: "memory")
#define PG8_BAR __builtin_amdgcn_s_barrier()
#define PG8_SCHED __builtin_amdgcn_sched_barrier(0)
    Unit cur, nxt; int ui = 0;
    if (!S.next(0, cur)) return;
    f32x4 acc[2][2][4][2];
#pragma unroll
    for (int a = 0; a < 2; ++a)
#pragma unroll
        for (int b = 0; b < 2; ++b)
#pragma unroll
            for (int m = 0; m < 4; ++m)
#pragma unroll
                for (int n = 0; n < 2; ++n) acc[a][b][m][n] = (f32x4){0.f, 0.f, 0.f, 0.f};
    bf16x8 At[4][2], B0[2][2], B1[2][2];
    const char* cA = (const char*)g.A + (size_t)cur.pm * tstep; const char* cB = (const char*)g.Bt + (size_t)cur.pn * tstep;
    PG8_STAGE(PG8_SB(0, 0), cB, voffB); PG8_STAGE(PG8_SB(0, 1), cB + hstep, voffB); PG8_STAGE(PG8_SA(0, 0), cA, voffA); PG8_STAGE(PG8_SA(0, 1), cA + hstep, voffA);
    if (wr == 1) PG8_BAR;
    PG8_WAIT_V(2); PG8_BAR;
    PG8_STAGE(PG8_SB(1, 0), cB + kstep, voffB); PG8_STAGE(PG8_SA(1, 0), cA + kstep, voffA); PG8_STAGE(PG8_SB(1, 1), cB + hstep + kstep, voffB);
    PG8_WAIT_V(6); PG8_BAR;
    for (;;) {
        const bool has_next = S.next(ui + 1, nxt);
        const char* nA = has_next ? (const char*)g.A + (size_t)nxt.pm * tstep : cA; const char* nB = has_next ? (const char*)g.Bt + (size_t)nxt.pn * tstep : cB;
        for (int t = 0; t < nt; t += 2) {
            const bool last = (t == nt - 2);
            const char* a1 = cA + (size_t)(t + 1) * kstep;
            const char* a2 = last ? nA : cA + (size_t)(t + 2) * kstep; const char* b2 = last ? nB : cB + (size_t)(t + 2) * kstep;
            const char* a3 = a2 + kstep; const char* b3 = b2 + kstep;
            PG8_LDB(B0, 0, 0); PG8_LDB(B1, 0, 1); PG8_SCHED; PG8_LDA(At, 0, 0); PG8_STAGE(PG8_SA(1, 1), a1 + hstep, voffA);
            PG8_WAIT_V(8); PG8_WAIT_L(0); PG8_BAR; PG8_MMA(0, 0, At, B0); PG8_MMA(0, 1, At, B1); PG8_BAR; PG8_SCHED;
            PG8_LDA(At, 0, 1); PG8_STAGE(PG8_SB(0, 0), b2, voffB); PG8_STAGE(PG8_SB(0, 1), b2 + hstep, voffB); PG8_STAGE(PG8_SA(0, 0), a2, voffA);
            PG8_WAIT_V(8); PG8_WAIT_L(0); PG8_BAR; PG8_MMA(1, 0, At, B0); PG8_MMA(1, 1, At, B1); PG8_BAR; PG8_SCHED;
            PG8_LDB(B0, 1, 0); PG8_LDB(B1, 1, 1); PG8_SCHED; PG8_LDA(At, 1, 0); PG8_STAGE(PG8_SA(0, 1), a2 + hstep, voffA);
            PG8_WAIT_V(8); PG8_WAIT_L(0); PG8_BAR; PG8_MMA(0, 0, At, B0); PG8_MMA(0, 1, At, B1); PG8_BAR; PG8_SCHED;
            PG8_LDA(At, 1, 1); PG8_STAGE(PG8_SB(1, 0), b3, voffB); PG8_STAGE(PG8_SB(1, 1), b3 + hstep, voffB); PG8_STAGE(PG8_SA(1, 0), a3, voffA);
            PG8_WAIT_V(8); PG8_WAIT_L(0); PG8_BAR; PG8_MMA(1, 0, At, B0); PG8_MMA(1, 1, At, B1); PG8_BAR; PG8_SCHED;
        }
        if (wr == 0) PG8_BAR;
        epilogue(E, acc, cur, wr, wc, fr, fq);
        if (!has_next) break;
#pragma unroll
        for (int a = 0; a < 2; ++a)
#pragma unroll
            for (int b = 0; b < 2; ++b)
#pragma unroll
                for (int m = 0; m < 4; ++m)
#pragma unroll
                    for (int n = 0; n < 2; ++n) acc[a][b][m][n] = (f32x4){0.f, 0.f, 0.f, 0.f};
        cur = nxt; cA = nA; cB = nB; ++ui;
        if (wr == 1) PG8_BAR;
    }
    PG8_WAIT_V(0);
    PG8_BAR;
#undef PG8_SA
#undef PG8_SB
#undef PG8_STAGE
#undef PG8_LDA
#undef PG8_LDB
#undef PG8_MMA
#undef PG8_WAIT_V
#undef PG8_WAIT_L
#undef PG8_BAR
#undef PG8_SCHED
}
}

#define XB_TMO      128
#define XB_XCNT(j)  (256  + 64 * (j))
#define XB_XSUB(j)  (1280 + 64 * (j))
#define XB_XGEN(j)  (2304 + 64 * (j))
#define XB_TOP      3328
#define XB_TOPGEN   3392
#define XCD_BAR_WORDS 3456
#define XB_SPIN_CAP (1u << 18)
__device__ __forceinline__ unsigned xb_ld(unsigned* p)              { return __hip_atomic_load(p, __ATOMIC_RELAXED, __HIP_MEMORY_SCOPE_AGENT); }
__device__ __forceinline__ unsigned xb_add(unsigned* p, unsigned v) { return __hip_atomic_fetch_add(p, v, __ATOMIC_RELAXED, __HIP_MEMORY_SCOPE_AGENT); }
__device__ __forceinline__ unsigned xb_xcc_id() { return (unsigned)__builtin_amdgcn_s_getreg((3 << 11) | 20) & 0xFu; }
#define XB_SPIN(cond, bar) do { unsigned _sp = 0; while (cond) { __builtin_amdgcn_s_sleep(1); \
    if ((++_sp & 255u) == 0u) { if (xb_ld(&(bar)[XB_TMO])) break; if (_sp > XB_SPIN_CAP) { atomicAdd(&(bar)[XB_TMO], 1u); break; } } } } while (0)
struct XcdBarrier { unsigned* bar; unsigned x; volatile LAS unsigned* st; };
__device__ __forceinline__ XcdBarrier xcd_barrier_post(unsigned* bar, volatile LAS unsigned* st) {
    XcdBarrier b; b.bar = bar; b.x = xb_xcc_id(); b.st = st;
    if (threadIdx.x == 0) (void)xb_add(&bar[XB_XCNT(b.x)], 1u);
    return b;
}
__device__ __forceinline__ void xcd_barrier_complete(unsigned* bar, unsigned x, unsigned& nloc, unsigned& nx) {
    const unsigned G = gridDim.x * gridDim.y * gridDim.z;
    unsigned sum, cnt, mine, sp = 0u;
    for (;;) {
        sum = 0u; cnt = 0u; mine = 0u;
#pragma unroll
        for (unsigned j = 0; j < 16; ++j) { const unsigned c = xb_ld(&bar[XB_XCNT(j)]); sum += c; cnt += (c > 0u) ? 1u : 0u; mine = (j == x) ? c : mine; }
        if (sum == G) break;
        __builtin_amdgcn_s_sleep(1);
        if ((++sp & 255u) == 0u) { if (xb_ld(&bar[XB_TMO])) break; if (sp > XB_SPIN_CAP) { atomicAdd(&bar[XB_TMO], 1u); break; } }
    }
    nloc = mine > 0u ? mine : 1u; nx = cnt > 0u ? cnt : 1u;
}
__device__ __forceinline__ void xcd_barrier(const XcdBarrier& b) {
    asm volatile("s_waitcnt vmcnt(0)" ::: "memory");
    __syncthreads();
    if (threadIdx.x == 0) {
        unsigned* bar = b.bar;
        __builtin_amdgcn_s_waitcnt(0);
        unsigned nloc = b.st[0], nx = b.st[1];
        if (nloc == 0u) { xcd_barrier_complete(bar, b.x, nloc, nx); b.st[0] = nloc; b.st[1] = nx; }
        const unsigned old = xb_add(&bar[XB_XSUB(b.x)], 1u);
        const unsigned gen = old / nloc;
        if (old + 1u == (gen + 1u) * nloc) {
            __builtin_amdgcn_fence(__ATOMIC_RELEASE, "agent");
            asm volatile("s_waitcnt vmcnt(0)" ::: "memory");
            const unsigned og = xb_add(&bar[XB_TOP], 1u);
            const unsigned tg = og / nx;
            if (og + 1u == (tg + 1u) * nx) xb_add(&bar[XB_TOPGEN], 1u);
            else XB_SPIN(xb_ld(&bar[XB_TOPGEN]) == tg, bar);
            __builtin_amdgcn_fence(__ATOMIC_ACQUIRE, "agent");
            xb_add(&bar[XB_XGEN(b.x)], 1u);
            asm volatile("s_waitcnt vmcnt(0)" ::: "memory");
        } else {
            XB_SPIN(xb_ld(&bar[XB_XGEN(b.x)]) == gen, bar);
            __builtin_amdgcn_fence(__ATOMIC_ACQUIRE, "agent");
            asm volatile("s_waitcnt vmcnt(0)" ::: "memory");
        }
    }
    __syncthreads();
}

__device__ __forceinline__ void p0_transpose_item(const float* W, int K, int N, const float* gain, bf16_t* WT, int k0, int n0, int drow0, LAS float* scr, int lane) {
#pragma unroll 8
    for (int i = 0; i < 32; ++i) { const int kk = 2 * i + (lane >> 5); float v = *(const GAS float*)(W + (size_t)(k0 + kk) * N + n0 + (lane & 31));
        if (gain) v *= *(const GAS float*)(gain + k0 + kk);
        scr[kk * 33 + (lane & 31)] = v; }
    LDS_WAIT(); asm volatile("" ::: "memory");
    const int c = lane & 7;
#pragma unroll
    for (int j = 0; j < 4; ++j) { const int n = (lane >> 3) + 8 * j; const LAS float* s = scr + (8 * c) * 33 + n;
        u32x4 o; o.x = pk2(s[0 * 33], s[1 * 33]); o.y = pk2(s[2 * 33], s[3 * 33]); o.z = pk2(s[4 * 33], s[5 * 33]); o.w = pk2(s[6 * 33], s[7 * 33]);
        *(GAS u32x4*)(WT + (size_t)(drow0 + n) * K + k0 + 8 * c) = o; }
    LDS_WAIT(); asm volatile("" ::: "memory");
}
__device__ __forceinline__ int map_gu(int n0) { return n0 < DFF ? (n0 / 128) * 256 + (n0 % 128) : ((n0 - DFF) / 128) * 256 + 128 + ((n0 - DFF) % 128); }
__device__ __forceinline__ int map_win(int n0) { return n0 < 6144 ? n0 : (n0 < 6176 ? 9216 + (n0 - 6144) : n0 - 32); }

__device__ __forceinline__ void p0_prologue(Frame& F) {
    LAS float* scr = (LAS float*)(F.lds + F.wave * 16384);
    const int gw = F.vcu * NWAVES + F.wave, NGW = F.G * NWAVES, lane = F.lane;
    bf16_t* const wgu1 = (bf16_t*)(F.ws + WS_WGU1); bf16_t* const wd1 = (bf16_t*)(F.ws + WS_WD1); bf16_t* const win = (bf16_t*)(F.ws + WS_WIN);
    bf16_t* const wsso = (bf16_t*)(F.ws + WS_WSSO); bf16_t* const wo = (bf16_t*)(F.ws + WS_WO); bf16_t* const wgu2 = (bf16_t*)(F.ws + WS_WGU2);
    bf16_t* const wd2 = (bf16_t*)(F.ws + WS_WD2); bf16_t* const wpg = (bf16_t*)(F.ws + WS_WPG); bf16_t* const wple = (bf16_t*)(F.ws + WS_WPLE);
    constexpr int I_GU = (DM / 64) * (2 * DFF / 32), I_D = (DFF / 64) * (DM / 32), I_IN = (DM / 64) * (IN_DIM / 32), I_SSO = (DI / 64) * (DM / 32), I_SQ = (DM / 64) * (DM / 32), I_PLE = (PLE / 64) * (DM / 32);
    constexpr int NITEMS = 2 * I_GU + 2 * I_D + I_IN + I_SSO + 2 * I_SQ + I_PLE;
    for (int it = gw; it < NITEMS; it += NGW) {
        int r = it;
        if (r < I_GU) { const int nb = 2 * DFF / 32, kb = r / nb, n0 = (r % nb) * 32; p0_transpose_item(F.in[I_WGU1], DM, 2 * DFF, F.in[I_NFFN1], wgu1, kb * 64, n0, map_gu(n0), scr, lane); continue; } r -= I_GU;
        if (r < I_GU) { const int nb = 2 * DFF / 32, kb = r / nb, n0 = (r % nb) * 32; p0_transpose_item(F.in[I_WGU2], DM, 2 * DFF, F.in[I_NFFN2], wgu2, kb * 64, n0, map_gu(n0), scr, lane); continue; } r -= I_GU;
        if (r < I_D) { const int nb = DM / 32, kb = r / nb, n0 = (r % nb) * 32; p0_transpose_item(F.in[I_WD1], DFF, DM, nullptr, wd1, kb * 64, n0, n0, scr, lane); continue; } r -= I_D;
        if (r < I_D) { const int nb = DM / 32, kb = r / nb, n0 = (r % nb) * 32; p0_transpose_item(F.in[I_WD2], DFF, DM, nullptr, wd2, kb * 64, n0, n0, scr, lane); continue; } r -= I_D;
        if (r < I_IN) { const int nb = IN_DIM / 32, kb = r / nb, n0 = (r % nb) * 32; p0_transpose_item(F.in[I_WIN], DM, IN_DIM, F.in[I_NMIX], win, kb * 64, n0, map_win(n0), scr, lane); continue; } r -= I_IN;
        if (r < I_SSO) { const int nb = DM / 32, kb = r / nb, n0 = (r % nb) * 32; p0_transpose_item(F.in[I_WSSO], DI, DM, F.in[I_NSSD], wsso, kb * 64, n0, n0, scr, lane); continue; } r -= I_SSO;
        if (r < I_SQ) { const int nb = DM / 32, kb = r / nb, n0 = (r % nb) * 32; p0_transpose_item(F.in[I_WO], DM, DM, nullptr, wo, kb * 64, n0, n0, scr, lane); continue; } r -= I_SQ;
        if (r < I_SQ) { const int nb = DM / 32, kb = r / nb, n0 = (r % nb) * 32; p0_transpose_item(F.in[I_WPG], DM, DM, F.in[I_NPLE], wpg, kb * 64, n0, n0, scr, lane); continue; } r -= I_SQ;
        { const int nb = DM / 32, kb = r / nb, n0 = (r % nb) * 32; p0_transpose_item(F.in[I_WPLE], PLE, DM, nullptr, wple, kb * 64, n0, n0, scr, lane); }
    }
    {
        bf16_t* const w2 = (bf16_t*)(F.ws + WS_W2);
        const float* Wg = F.in[I_WPGRP]; const float* sc = F.in[I_PSCALE]; const float* Wpo = F.in[I_WPOUT];
        for (int it = F.vcu; it < 4 * 32; it += F.G) {
            const int g = it >> 5, c0 = (it & 31) * 8, n = F.tid;
            float a0[8], a1[8];
#pragma unroll
            for (int cc = 0; cc < 8; ++cc) { a0[cc] = 0.f; a1[cc] = 0.f; }
            for (int d = 0; d < 256; ++d) {
                const float s = *(const GAS float*)(sc + g * 256 + d);
                const float w0 = s * *(const GAS float*)(Wpo + (size_t)(g * 256 + d) * DM + n), w1 = s * *(const GAS float*)(Wpo + (size_t)(g * 256 + d) * DM + n + 512);
#pragma unroll
                for (int cc = 0; cc < 8; ++cc) { const float a = *(const GAS float*)(Wg + ((size_t)g * 256 + c0 + cc) * 256 + d); a0[cc] += a * w0; a1[cc] += a * w1; }
            }
            u32x4 o0, o1; o0.x = pk2(a0[0], a0[1]); o0.y = pk2(a0[2], a0[3]); o0.z = pk2(a0[4], a0[5]); o0.w = pk2(a0[6], a0[7]);
            o1.x = pk2(a1[0], a1[1]); o1.y = pk2(a1[2], a1[3]); o1.z = pk2(a1[4], a1[5]); o1.w = pk2(a1[6], a1[7]);
            *(GAS u32x4*)(w2 + (size_t)n * DM + g * 256 + c0) = o0; *(GAS u32x4*)(w2 + (size_t)(n + 512) * DM + g * 256 + c0) = o1;
        }
    }
    {
        bf16_t* const XB = (bf16_t*)(F.ws + WS_XB); bf16_t* const PB = (bf16_t*)(F.ws + WS_PB); float* const stA = (float*)(F.ws + WS_STATS_A);
        for (int m = gw; m < M; m += NGW) {
            const float* xrow = (m < MP) ? F.in[I_XP] + (size_t)m * DM : F.in[I_XS] + (size_t)(m - MP) * DM;
            const GAS f32x4* xr = (const GAS f32x4*)xrow + lane;
            f32x4 v[4]; float s = 0.f;
#pragma unroll
            for (int j = 0; j < 4; ++j) { v[j] = xr[64 * j]; s += (v[j].x * v[j].x + v[j].y * v[j].y) + (v[j].z * v[j].z + v[j].w * v[j].w); }
            s = wave_sum(s);
            GAS u32x2* o8 = (GAS u32x2*)(XB + (size_t)m * DM) + lane;
#pragma unroll
            for (int j = 0; j < 4; ++j) { u32x2 w; w.x = pk2(v[j].x, v[j].y); w.y = pk2(v[j].z, v[j].w); o8[64 * j] = w; }
            if (lane < 16) *(GAS float*)(stA + (size_t)m * 16 + lane) = (lane == 0) ? s : 0.f;
            const float* prow = (m < MP) ? F.in[I_PP] + (size_t)m * PLE : F.in[I_PS] + (size_t)(m - MP) * PLE;
            const f32x4 pv = *((const GAS f32x4*)prow + lane);
            u32x2 w; w.x = pk2(pv.x, pv.y); w.y = pk2(pv.z, pv.w); *((GAS u32x2*)(PB + (size_t)m * PLE) + lane) = w;
        }
    }
}


typedef short v4i16_t __attribute__((ext_vector_type(4)));
constexpr int IMG_B = 0, IMG_C = 32768, IMG_X = 65536, TAB_ACS = RING_BYTES + 1024, TAB_DT = TAB_ACS + 2048, TAB_SD = TAB_DT + 2048;
constexpr int NCHUNK = SEQ / 128;
template <bool XS> __device__ __forceinline__ int img_off(int row, int ch) { return XS ? 256 * row + 16 * (ch ^ ((row & 7) << 1)) : 256 * row + 16 * (ch ^ (((row & 3) << 2) | ((row >> 2) & 3))); }
__device__ __forceinline__ bf16x8 tr_pair(const LAS unsigned char* p0, const LAS unsigned char* p1) {
    const v4i16_t a = __builtin_amdgcn_ds_read_tr16_b64_v4i16((LAS v4i16_t*)p0), b = __builtin_amdgcn_ds_read_tr16_b64_v4i16((LAS v4i16_t*)p1);
    return (bf16x8){a[0], a[1], a[2], a[3], b[0], b[1], b[2], b[3]};
}
__device__ __forceinline__ void ssd_tables(Frame& F, size_t row0, int g) {
    LAS float* const acs = (LAS float*)(F.lds + TAB_ACS); LAS float* const dtl = (LAS float*)(F.lds + TAB_DT); LAS float* const sdec = (LAS float*)(F.lds + TAB_SD);
    const float* const DT = (const float*)(F.ws + WS_DT);
    if (F.wave < 4) {
        const int r = F.wave, lane = F.lane, head = g * HPG + r;
        const float Ah = -__expf(*(const GAS float*)(F.in[I_ALOG] + head));
        const float d0 = *(const GAS float*)(DT + (row0 + 2 * lane) * 32 + head), d1 = *(const GAS float*)(DT + (row0 + 2 * lane + 1) * 32 + head);
        const float a0 = d0 * Ah, a1 = d1 * Ah, loc = a0 + a1;
        float inc = loc;
#pragma unroll
        for (int o = 1; o < 64; o <<= 1) { const float t = __shfl_up(inc, o); if (lane >= o) inc += t; }
        const float exc = inc - loc;
        acs[(2 * lane) * 4 + r] = exc + a0; acs[(2 * lane + 1) * 4 + r] = inc;
        dtl[(2 * lane) * 4 + r] = d0; dtl[(2 * lane + 1) * 4 + r] = d1;
    }
    __syncthreads();
    { const int s = F.tid >> 2, r = F.tid & 3; sdec[s * 4 + r] = __expf(acs[127 * 4 + r] - acs[s * 4 + r]) * dtl[s * 4 + r]; }
    __syncthreads();
}
template <bool WITH_C, bool SCALE_X> __device__ __forceinline__ void ssd_fill(Frame& F, size_t row0, int c, int g) {
    const int t = F.tid;
    int kind, cc, run;
    if (t < 256) { kind = 0; cc = t & 31; run = t >> 5; } else if (t < 384) { kind = 1; cc = (t - 256) & 15; run = (t - 256) >> 4; } else { kind = 2; cc = (t - 384) & 15; run = (t - 384) >> 4; }
    if (!WITH_C && kind == 2) return;
    const int gch = (kind == 0 ? g * 256 : (kind == 1 ? DI + g * DSTATE : DI + NG * DSTATE + g * DSTATE)) + 8 * cc;
    const bf16_t* const XBC = (const bf16_t*)(F.ws + WS_XBC);
    const float* const convw = F.in[I_CONVW]; const float* const convb = F.in[I_CONVB];
    float cw[4][8], cb[8];
#pragma unroll
    for (int k = 0; k < 4; ++k) { const f32x4 a = *(const GAS f32x4*)(convw + (size_t)k * CD + gch), b = *(const GAS f32x4*)(convw + (size_t)k * CD + gch + 4);
        cw[k][0] = a.x; cw[k][1] = a.y; cw[k][2] = a.z; cw[k][3] = a.w; cw[k][4] = b.x; cw[k][5] = b.y; cw[k][6] = b.z; cw[k][7] = b.w; }
    { const f32x4 a = *(const GAS f32x4*)(convb + gch), b = *(const GAS f32x4*)(convb + gch + 4); cb[0] = a.x; cb[1] = a.y; cb[2] = a.z; cb[3] = a.w; cb[4] = b.x; cb[5] = b.y; cb[6] = b.z; cb[7] = b.w; }
    u32x4 raw[19];
    const bool first = (c == 0 && run == 0);
#pragma unroll
    for (int i = 0; i < 19; ++i) { if (i < 3 && first) raw[i] = (u32x4){0u, 0u, 0u, 0u}; else raw[i] = *(const GAS u32x4*)(XBC + (row0 + 16 * run + i - 3) * CD + gch); }
    LAS unsigned char* const img = F.lds + (kind == 0 ? IMG_X + (cc >> 4) * 32768 : (kind == 1 ? IMG_B : IMG_C));
    const LAS float* const sdec = (const LAS float*)(F.lds + TAB_SD);
    const int chl = cc & 15, hr = cc >> 3;
#pragma unroll
    for (int i = 0; i < 16; ++i) {
        const int s = 16 * run + i;
        float o[8];
#pragma unroll
        for (int j2 = 0; j2 < 4; ++j2) {
            const unsigned w0 = raw[i][j2], w1 = raw[i + 1][j2], w2 = raw[i + 2][j2], w3 = raw[i + 3][j2];
            const float lo = cb[2 * j2] + cw[0][2 * j2] * bflo(w0) + cw[1][2 * j2] * bflo(w1) + cw[2][2 * j2] * bflo(w2) + cw[3][2 * j2] * bflo(w3);
            const float hi = cb[2 * j2 + 1] + cw[0][2 * j2 + 1] * bfhi(w0) + cw[1][2 * j2 + 1] * bfhi(w1) + cw[2][2 * j2 + 1] * bfhi(w2) + cw[3][2 * j2 + 1] * bfhi(w3);
            o[2 * j2] = silu_f(lo); o[2 * j2 + 1] = silu_f(hi);
        }
        if (SCALE_X && kind == 0) { const float sc = sdec[s * 4 + hr];
#pragma unroll
            for (int j = 0; j < 8; ++j) o[j] *= sc; }
        u32x4 pk; pk.x = cvt_pk_bf16(o[0], o[1]); pk.y = cvt_pk_bf16(o[2], o[3]); pk.z = cvt_pk_bf16(o[4], o[5]); pk.w = cvt_pk_bf16(o[6], o[7]);
        const int off = (kind == 0 && !SCALE_X) ? img_off<true>(s, chl) : img_off<false>(s, chl);
        *(LAS u32x4*)(img + off) = pk;
    }
}
__device__ __forceinline__ void ssd_states_phase(Frame& F) {
    float* const ST = F.out + O_SSM_S;
    float* const CDEC = (float*)(F.ws + WS_CDEC);
    const int w = F.wave, lane = F.lane, ql = lane & 15, gq = lane >> 4, qq = ql >> 2, pp = ql & 3, r = w >> 1, nh = w & 1;
    for (int it = F.vcu; it < BATCH * NCHUNK * NG; it += F.G) {
        const int g = it & 7, c = (it >> 3) & (NCHUNK - 1), b = it >> 7;
        const size_t row0 = (size_t)b * SEQ + (size_t)c * 128;
        ssd_tables(F, row0, g);
        ssd_fill<false, true>(F, row0, c, g);
        __syncthreads();
        f32x4 acc[4][4];
#pragma unroll
        for (int i = 0; i < 4; ++i)
#pragma unroll
            for (int j = 0; j < 4; ++j) acc[i][j] = (f32x4){0.f, 0.f, 0.f, 0.f};
        const LAS unsigned char* const bimg = F.lds + IMG_B; const LAS unsigned char* const ximg = F.lds + IMG_X + (r >> 1) * 32768;
#pragma unroll
        for (int ks = 0; ks < 4; ++ks) {
            bf16x8 af[4], xf[4];
            const int rw0 = 32 * ks + 8 * gq + qq;
#pragma unroll
            for (int nf = 0; nf < 4; ++nf) { const int col = 64 * nh + 16 * nf + 4 * pp;
                af[nf] = tr_pair(bimg + img_off<false>(rw0, col >> 3) + 2 * (col & 7), bimg + img_off<false>(rw0 + 4, col >> 3) + 2 * (col & 7)); }
#pragma unroll
            for (int pf = 0; pf < 4; ++pf) { const int col = 64 * (r & 1) + 16 * pf + 4 * pp;
                xf[pf] = tr_pair(ximg + img_off<false>(rw0, col >> 3) + 2 * (col & 7), ximg + img_off<false>(rw0 + 4, col >> 3) + 2 * (col & 7)); }
#pragma unroll
            for (int nf = 0; nf < 4; ++nf)
#pragma unroll
                for (int pf = 0; pf < 4; ++pf) acc[nf][pf] = __builtin_amdgcn_mfma_f32_16x16x32_bf16(af[nf], xf[pf], acc[nf][pf], 0, 0, 0);
        }
        const int head = g * HPG + r;
        float* const stp = ST + ((((size_t)b * NCHUNK + c) * NH + head) * HD) * DSTATE;
#pragma unroll
        for (int pf = 0; pf < 4; ++pf)
#pragma unroll
            for (int nf = 0; nf < 4; ++nf) *(GAS f32x4*)(stp + (size_t)(16 * pf + ql) * DSTATE + 64 * nh + 16 * nf + 4 * gq) = acc[nf][pf];
        if (F.tid < 4) { const LAS float* acs = (const LAS float*)(F.lds + TAB_ACS); *(GAS float*)(CDEC + ((size_t)b * NCHUNK + c) * NH + g * HPG + F.tid) = __expf(acs[127 * 4 + F.tid]); }
        __syncthreads();
    }
}
__device__ __forceinline__ void ssd_scan_phase(Frame& F) {
    const float* const ST = F.out + O_SSM_S; const float* const CDEC = (const float*)(F.ws + WS_CDEC);
    bf16_t* const HP = (bf16_t*)(F.ws + WS_HPREV); float* const hout = F.out + O_SSM_P;
    const int gt = F.vcu * NTHREADS + F.tid, NT = F.G * NTHREADS;
    constexpr int PER = NH * HD * DSTATE / 4;
    for (int e = gt; e < BATCH * PER; e += NT) {
        const int b = e / PER, i4 = e % PER, head = i4 / (HD * DSTATE / 4);
        f32x4 h = (f32x4){0.f, 0.f, 0.f, 0.f};
        f32x4 stv[NCHUNK];
#pragma unroll
        for (int c = 0; c < NCHUNK; ++c) stv[c] = *(const GAS f32x4*)(ST + ((size_t)b * NCHUNK + c) * (size_t)(PER * 4) + (size_t)i4 * 4);
#pragma unroll
        for (int c = 0; c < NCHUNK; ++c) {
            if (c > 0) { u32x2 o; o.x = cvt_pk_bf16(h.x, h.y); o.y = cvt_pk_bf16(h.z, h.w); *(GAS u32x2*)(HP + ((size_t)b * NCHUNK + c) * (size_t)(PER * 4) + (size_t)i4 * 4) = o; }
            const float d = *(const GAS float*)(CDEC + ((size_t)b * NCHUNK + c) * NH + head);
            h = h * d + stv[c];
        }
        *(GAS f32x4*)(hout + (size_t)b * (PER * 4) + (size_t)i4 * 4) = h;
    }
}
__device__ __forceinline__ void ssd_out_phase(Frame& F) {
    const bf16_t* const HP = (const bf16_t*)(F.ws + WS_HPREV); bf16_t* const ZY = (bf16_t*)(F.ws + WS_Z);
    const int w = F.wave, lane = F.lane, ql = lane & 15, gq = lane >> 4, qq = ql >> 2, pp = ql & 3, q0 = 16 * w;
    const LAS float* const acs = (const LAS float*)(F.lds + TAB_ACS); const LAS float* const dtl = (const LAS float*)(F.lds + TAB_DT);
    int cfo[4], bbo[4], xbo[2][4];
#pragma unroll
    for (int ks = 0; ks < 4; ++ks) { cfo[ks] = IMG_C + img_off<false>(q0 + ql, 4 * ks + gq); bbo[ks] = IMG_B + img_off<false>(ql, 4 * ks + gq); }
#pragma unroll
    for (int rr = 0; rr < 2; ++rr)
#pragma unroll
        for (int pf = 0; pf < 4; ++pf) xbo[rr][pf] = IMG_X + img_off<true>(4 * gq + qq, 8 * rr + 2 * pf + (pp >> 1)) + 8 * (pp & 1);
    for (int it = F.vcu; it < BATCH * NCHUNK * NG; it += F.G) {
        const int g = it & 7, c = (it >> 3) & (NCHUNK - 1), b = it >> 7;
        const size_t row0 = (size_t)b * SEQ + (size_t)c * 128;
        ssd_tables(F, row0, g);
        ssd_fill<true, false>(F, row0, c, g);
        __syncthreads();
        bf16x8 cf[4];
#pragma unroll
        for (int ks = 0; ks < 4; ++ks) cf[ks] = *(const LAS bf16x8*)(F.lds + cfo[ks]);
        f32x4 cb[8];
#pragma unroll
        for (int sf = 0; sf < 8; ++sf) { cb[sf] = (f32x4){0.f, 0.f, 0.f, 0.f};
            if (sf <= w) {
#pragma unroll
                for (int ks = 0; ks < 4; ++ks) { const bf16x8 bfr = *(const LAS bf16x8*)(F.lds + bbo[ks] + 4096 * sf); cb[sf] = __builtin_amdgcn_mfma_f32_16x16x32_bf16(bfr, cf[ks], cb[sf], 0, 0, 0); } } }
        float yg[4][4][4]; float ssum = 0.f;
        bf16_t* const zp = ZY + (row0 + q0 + ql) * DI + g * 256 + 4 * gq;
        const bf16_t* const hpb = HP + ((((size_t)b * NCHUNK + c) * NH + g * HPG) * HD + ql) * DSTATE + 8 * gq;
        const LAS float* const acs_l = acs + 16 * gq; const LAS float* const dtl_l = dtl + 16 * gq;
#pragma unroll
        for (int r = 0; r < 4; ++r) {
            asm volatile("" ::: "memory");
            const float aq = acs[(q0 + ql) * 4 + r], Dh = *(const GAS float*)(F.in[I_DSKIP] + g * HPG + r);
            bf16x8 wf[4];
#pragma unroll
            for (int ks = 0; ks < 4; ++ks) {
                float v[8];
#pragma unroll
                for (int hf = 0; hf < 2; ++hf) { const int sf = 2 * ks + hf;
#pragma unroll
                    for (int rg = 0; rg < 4; ++rg) { const int sl = 4 * gq + rg;
                        float val = 0.f;
                        if (sf <= w) { const float as = acs_l[64 * sf + 4 * rg + r], d = dtl_l[64 * sf + 4 * rg + r];
                            val = cb[sf][rg] * __expf(aq - as) * d;
                            if (sf == w) { if (sl > ql) val = 0.f; else if (sl == ql) val += Dh; } }
                        v[4 * hf + rg] = val; } }
                u32x4 pk; pk.x = cvt_pk_bf16(v[0], v[1]); pk.y = cvt_pk_bf16(v[2], v[3]); pk.z = cvt_pk_bf16(v[4], v[5]); pk.w = cvt_pk_bf16(v[6], v[7]);
                wf[ks] = __builtin_bit_cast(bf16x8, pk);
            }
            const float eaq = __expf(aq);
#pragma unroll
            for (int pf = 0; pf < 4; ++pf) {
                asm volatile("" ::: "memory");
                f32x4 yd = (f32x4){0.f, 0.f, 0.f, 0.f}, yo = (f32x4){0.f, 0.f, 0.f, 0.f};
                const LAS unsigned char* const xb = F.lds + xbo[r & 1][pf] + (r >> 1) * 32768;
#pragma unroll
                for (int ks = 0; ks < 4; ++ks) if (2 * ks <= w) {
                    const bf16x8 xf = tr_pair(xb + 8192 * ks, xb + 8192 * ks + 4096);
                    yd = __builtin_amdgcn_mfma_f32_16x16x32_bf16(xf, wf[ks], yd, 0, 0, 0); }
                if (c > 0) {
#pragma unroll
                    for (int ks = 0; ks < 4; ++ks) { const bf16x8 hf_ = *(const GAS bf16x8*)(hpb + (size_t)(r * HD + 16 * pf) * DSTATE + 32 * ks); yo = __builtin_amdgcn_mfma_f32_16x16x32_bf16(hf_, cf[ks], yo, 0, 0, 0); } }
                const u32x2 zz = *(const GAS u32x2*)(zp + r * 64 + 16 * pf);
                const float z0 = bflo(zz.x), z1 = bfhi(zz.x), z2 = bflo(zz.y), z3 = bfhi(zz.y);
                const float y0 = (yd[0] + eaq * yo[0]) * z0, y1 = (yd[1] + eaq * yo[1]) * z1, y2 = (yd[2] + eaq * yo[2]) * z2, y3 = (yd[3] + eaq * yo[3]) * z3;
                yg[r][pf][0] = y0; yg[r][pf][1] = y1; yg[r][pf][2] = y2; yg[r][pf][3] = y3;
                ssum += (y0 * y0 + y1 * y1) + (y2 * y2 + y3 * y3);
            }
        }
        ssum += __shfl_xor(ssum, 16); ssum += __shfl_xor(ssum, 32);
        const float rsn = __builtin_amdgcn_rsqf(ssum * (1.0f / 256.0f) + EPS);
#pragma unroll
        for (int r = 0; r < 4; ++r)
#pragma unroll
            for (int pf = 0; pf < 4; ++pf) { u32x2 o; o.x = cvt_pk_bf16(yg[r][pf][0] * rsn, yg[r][pf][1] * rsn); o.y = cvt_pk_bf16(yg[r][pf][2] * rsn, yg[r][pf][3] * rsn);
                *(GAS u32x2*)(zp + r * 64 + 16 * pf) = o; }
        __syncthreads();
    }
}

__device__ __forceinline__ void ssd_seq_phase(Frame& F) {
    const int half = F.wave >> 2, r = F.wave & 3, lane = F.lane, idx = r * 64 + lane;
    LAS float* const bc = (LAS float*)(F.lds + half * 32768);
    LAS float* const lxs = bc + 2048; LAS float* const lyg = bc + 4096; LAS float* const ldt = bc + 6144; LAS float* const ssq = bc + 6144 + 32;
    const bf16_t* const XBC = (const bf16_t*)(F.ws + WS_XBC); const bf16_t* const Zs = (const bf16_t*)(F.ws + WS_Z); bf16_t* const YN = (bf16_t*)(F.ws + WS_Z);
    const float* const DT = (const float*)(F.ws + WS_DT);
    const float* const convw = F.in[I_CONVW]; const float* const convb = F.in[I_CONVB];
    constexpr int NSI = (DECB * NG) / 2;
    for (int it = F.vcu; it < NSI; it += F.G) {
        const int item = it * 2 + half, b = item >> 3, g = item & 7, head = g * HPG + r;
        const size_t row0 = (size_t)MP + (size_t)b * DECS;
        const int xch = g * 256 + r * 64 + lane;
        const int bch = (idx < 128) ? (DI + g * DSTATE + idx) : (DI + NG * DSTATE + g * DSTATE + (idx - 128));
        {
            float cwx[4], cwb[4];
#pragma unroll
            for (int k = 0; k < 4; ++k) { cwx[k] = *(const GAS float*)(convw + (size_t)k * CD + xch); cwb[k] = *(const GAS float*)(convw + (size_t)k * CD + bch); }
            const float cbx = *(const GAS float*)(convb + xch), cbb = *(const GAS float*)(convb + bch);
            const float* cs = F.in[I_CONV] + (size_t)b * 3 * CD;
            float x3 = *(const GAS float*)(cs + xch), x2 = *(const GAS float*)(cs + CD + xch), x1 = *(const GAS float*)(cs + 2 * CD + xch);
            float b3 = *(const GAS float*)(cs + bch), b2 = *(const GAS float*)(cs + CD + bch), b1 = *(const GAS float*)(cs + 2 * CD + bch);
#pragma unroll
            for (int j = 0; j < 8; ++j) {
                const size_t row = row0 + j;
                const float xr = bf2f(*(const GAS bf16_t*)(XBC + row * CD + xch)), br = bf2f(*(const GAS bf16_t*)(XBC + row * CD + bch));
                const float cx = cbx + cwx[0] * x3 + cwx[1] * x2 + cwx[2] * x1 + cwx[3] * xr; x3 = x2; x2 = x1; x1 = xr;
                const float cb_ = cbb + cwb[0] * b3 + cwb[1] * b2 + cwb[2] * b1 + cwb[3] * br; b3 = b2; b2 = b1; b1 = br;
                lxs[j * 256 + idx] = silu_f(cx);
                bc[j * 256 + idx] = silu_f(cb_);
                if (lane == 0) ldt[j * 4 + r] = *(const GAS float*)(DT + row * 32 + head);
            }
        }
        __syncthreads();
        {
            const float Ah = -__expf(*(const GAS float*)(F.in[I_ALOG] + head)), Dh = *(const GAS float*)(F.in[I_DSKIP] + head);
            float h[128];
            const GAS f32x4* hp = (const GAS f32x4*)(F.in[I_SSM] + (((size_t)b * NH + head) * HD + lane) * DSTATE);
#pragma unroll
            for (int n = 0; n < 32; ++n) { const f32x4 v = hp[n]; h[4 * n] = v.x; h[4 * n + 1] = v.y; h[4 * n + 2] = v.z; h[4 * n + 3] = v.w; }
            for (int j = 0; j < 8; ++j) {
                const size_t row = row0 + j;
                const float xsv = lxs[j * 256 + idx], dtv = ldt[j * 4 + r];
                const float dA = __expf(dtv * Ah), dx = dtv * xsv;
                const LAS f32x4* Bp = (const LAS f32x4*)(bc + j * 256); const LAS f32x4* Cp = Bp + 32;
                float y0 = 0.f, y1 = 0.f;
#pragma unroll
                for (int n8 = 0; n8 < 8; ++n8) {
#pragma unroll
                    for (int n = 4 * n8; n < 4 * n8 + 4; ++n) { const f32x4 Bv = Bp[n], Cv = Cp[n];
                        h[4 * n] = dA * h[4 * n] + dx * Bv.x; y0 += Cv.x * h[4 * n];
                        h[4 * n + 1] = dA * h[4 * n + 1] + dx * Bv.y; y1 += Cv.y * h[4 * n + 1];
                        h[4 * n + 2] = dA * h[4 * n + 2] + dx * Bv.z; y0 += Cv.z * h[4 * n + 2];
                        h[4 * n + 3] = dA * h[4 * n + 3] + dx * Bv.w; y1 += Cv.w * h[4 * n + 3]; }
                    asm volatile("" ::: "memory");
                }
                const float y = (y0 + y1) + Dh * xsv;
                const float zs = bf2f(*(const GAS bf16_t*)(Zs + row * DI + xch));
                const float ygv = y * zs;
                lyg[j * 256 + idx] = ygv;
                const float ss = wave_sum(ygv * ygv);
                if (lane == 0) ssq[j * 4 + r] = ss;
            }
            float* hout = F.out + O_SSM_S + (((size_t)b * NH + head) * HD + lane) * DSTATE;
#pragma unroll
            for (int n = 0; n < 32; ++n) *((GAS f32x4*)hout + n) = (f32x4){h[4 * n], h[4 * n + 1], h[4 * n + 2], h[4 * n + 3]};
        }
        __syncthreads();
#pragma unroll
        for (int j = 0; j < 8; ++j) {
            const size_t row = row0 + j;
            const f32x4 s4 = *(const LAS f32x4*)(ssq + j * 4);
            const float rsn = __builtin_amdgcn_rsqf(((s4.x + s4.y) + (s4.z + s4.w)) * (1.0f / 256.0f) + EPS);
            *(GAS bf16_t*)(YN + row * DI + xch) = (bf16_t)f2bf(lyg[j * 256 + idx] * rsn);
        }
        __syncthreads();
    }
}
__device__ __forceinline__ void pool_phase(Frame& F) {
    const bf16_t* const V = (const bf16_t*)(F.ws + WS_V); bf16_t* const PO = (bf16_t*)(F.ws + WS_POOLED);
    const float* const sp = F.in[I_POOL];
    const int gt = F.vcu * NTHREADS + F.tid, NT = F.G * NTHREADS;
    for (int e = gt; e < M * 128; e += NT) {
        const int row = e >> 7, cv = (e & 127) * 8, w = 2 << (cv >> 8);
        float s[8];
#pragma unroll
        for (int j = 0; j < 8; ++j) s[j] = 0.f;
        f32x4 c0, c1; pg8::unpack8(*(const GAS u32x4*)(V + (size_t)row * PD + cv), c0, c1);
        float cnt;
        if (row < MP) {
            const int t = row & (SEQ - 1); const int nk = (t + 1 < w) ? t + 1 : w; cnt = (float)nk;
            for (int k = 0; k < nk; ++k) { f32x4 a0, a1; pg8::unpack8(*(const GAS u32x4*)(V + (size_t)(row - k) * PD + cv), a0, a1);
                s[0] += a0.x; s[1] += a0.y; s[2] += a0.z; s[3] += a0.w; s[4] += a1.x; s[5] += a1.y; s[6] += a1.z; s[7] += a1.w; }
        } else {
            const int rr = row - MP, b = rr >> 3, t = rr & 7; cnt = (float)w;
            for (int k = 0; k < w; ++k) { const int tt = t - k; f32x4 a0, a1;
                if (tt >= 0) pg8::unpack8(*(const GAS u32x4*)(V + (size_t)(row - k) * PD + cv), a0, a1);
                else { const float* p = sp + ((size_t)b * PBUF + (PBUF + tt)) * PD + cv; a0 = *(const GAS f32x4*)p; a1 = *(const GAS f32x4*)(p + 4); }
                s[0] += a0.x; s[1] += a0.y; s[2] += a0.z; s[3] += a0.w; s[4] += a1.x; s[5] += a1.y; s[6] += a1.z; s[7] += a1.w; }
        }
        const float ic = 1.0f / cnt;
        f32x4 o0 = (f32x4){s[0] * ic, s[1] * ic, s[2] * ic, s[3] * ic} - c0, o1 = (f32x4){s[4] * ic, s[5] * ic, s[6] * ic, s[7] * ic} - c1;
        u32x4 o; o.x = pk2(o0.x, o0.y); o.y = pk2(o0.z, o0.w); o.z = pk2(o1.x, o1.y); o.w = pk2(o1.z, o1.w);
        *(GAS u32x4*)(PO + (size_t)row * PD + cv) = o;
    }
    float* const ops = F.out + O_POOL_S;
    for (int e = gt; e < DECB * 7 * (PD / 4); e += NT) {
        const int c4 = e & 255, i = (e >> 8) % 7, b = (e >> 8) / 7;
        *(GAS f32x4*)(ops + ((size_t)b * PBUF + i) * PD + c4 * 4) = *(const GAS f32x4*)(sp + ((size_t)b * PBUF + 8 + i) * PD + c4 * 4);
    }
}
__device__ __forceinline__ void final_phase(Frame& F) {
    const int gw = F.vcu * NWAVES + F.wave, NGW = F.G * NWAVES, lane = F.lane;
    const float* const st = (const float*)(F.ws + WS_STATS_A); const float* const gf = F.in[I_NFINAL];
    f32x4 gv[4];
#pragma unroll
    for (int j = 0; j < 4; ++j) gv[j] = *((const GAS f32x4*)gf + lane + 64 * j);
    for (int m = gw; m < M; m += NGW) {
        const GAS f32x4* sp = (const GAS f32x4*)(st + (size_t)m * 16);
        const f32x4 a = sp[0], b = sp[1], c = sp[2], d = sp[3]; const f32x4 s = (a + b) + (c + d);
        const float rs = __builtin_amdgcn_rsqf(((s[0] + s[1]) + (s[2] + s[3])) * (1.0f / 1024.0f) + EPS);
        GAS f32x4* yr = (GAS f32x4*)(F.out + (size_t)m * DM) + lane;
#pragma unroll
        for (int j = 0; j < 4; ++j) yr[64 * j] = yr[64 * j] * rs * gv[j];
    }
}

constexpr int NPHASES = 15;
struct Args { const float* in[30]; float* out; unsigned char* ws; int ph_lo, ph_hi, li, pad; };
__global__ void __launch_bounds__(NTHREADS, 2) mk_fwd(Args args) {
    extern __shared__ __attribute__((aligned(16))) unsigned char lds[];
    Frame F;
    F.lds = (LAS unsigned char*)lds;
    F.MISC = (volatile LAS unsigned*)(F.lds + MISC_OFF);
    F.tid = threadIdx.x; F.lane = F.tid & 63; F.wave = __builtin_amdgcn_readfirstlane(F.tid >> 6);
    F.G = gridDim.x; { const int bx = blockIdx.x; F.vcu = (F.G % 8 == 0) ? (bx % 8) * (F.G / 8) + bx / 8 : bx; }
    F.ws = args.ws; F.out = args.out; F.ctl = (gu32*)(args.ws + WS_CTL);
#pragma unroll
    for (int i = 0; i < 30; ++i) F.in[i] = args.in[i];
    for (int u = F.tid; u < (LDS_BYTES - LDSCTL_OFF) / 4; u += NTHREADS) ((LAS unsigned*)(F.lds + LDSCTL_OFF))[u] = 0u;
    __syncthreads();
    const int lo = args.ph_lo, hi = args.ph_hi;
    XcdBarrier bar; bar.bar = (unsigned*)(F.ctl + CW_BAR); bar.x = 0; bar.st = nullptr;
    if (hi - lo > 1) bar = xcd_barrier_post((unsigned*)(F.ctl + CW_BAR), F.MISC + 8);
#ifndef PHMASK
#define PHMASK 0x7fff
#endif
#define IN(k) (((PHMASK >> (k)) & 1) && lo <= (k) && (k) < hi)
#define SEAM(k) do { if (IN(k) && IN((k) + 1)) xcd_barrier(bar); } while (0)

    bf16_t* const XB = (bf16_t*)(F.ws + WS_XB); bf16_t* const HB = (bf16_t*)(F.ws + WS_HB); bf16_t* const ACT = (bf16_t*)(F.ws + WS_ACT);
    bf16_t* const Zb = (bf16_t*)(F.ws + WS_Z); bf16_t* const XBCb = (bf16_t*)(F.ws + WS_XBC); bf16_t* const Vb = (bf16_t*)(F.ws + WS_V); bf16_t* const GATES = (bf16_t*)(F.ws + WS_GATES);
    bf16_t* const POOLED = (bf16_t*)(F.ws + WS_POOLED); bf16_t* const MERGED = (bf16_t*)(F.ws + WS_MERGED); bf16_t* const Qb = (bf16_t*)(F.ws + WS_Q); bf16_t* const PB = (bf16_t*)(F.ws + WS_PB);
    float* const T1 = (float*)(F.ws + WS_T1); float* const stA = (float*)(F.ws + WS_STATS_A); float* const stB = (float*)(F.ws + WS_STATS_B); float* const DTb = (float*)(F.ws + WS_DT);
    float* const H = F.out + O_Y;
    pg8::StaticOrder S;

    if (IN(0)) { p0_prologue(F); } SEAM(0);
    if (IN(1)) {
        pg8::Gemm g{XB, (const bf16_t*)(F.ws + WS_WGU1), M, 2 * DFF, DM}; S.init(M, 2 * DFF, F.G, (int)blockIdx.x);
        pg8::Epi E{}; E.kind = pg8::EK_GU; E.stats_in = stA; E.obf = ACT; E.ldo = DFF;
        pg8::gemm_phase(F.lds, g, S, E);
    } SEAM(1);
    if (IN(2)) {
        pg8::Gemm g{ACT, (const bf16_t*)(F.ws + WS_WD1), M, DM, DFF}; S.init(M, DM, F.G, (int)blockIdx.x);
        pg8::Epi E{}; E.kind = pg8::EK_RES; E.coef = 0.5f; E.res_p = F.in[I_XP]; E.res_s = F.in[I_XS]; E.of32 = H; E.obf = HB; E.stats_out = stB;
        pg8::gemm_phase(F.lds, g, S, E);
    } SEAM(2);
    if (IN(3)) {
        pg8::Gemm g{HB, (const bf16_t*)(F.ws + WS_WIN), M, NIN, DM}; S.init(M, NIN, F.G, (int)blockIdx.x);
        pg8::Epi E{}; E.kind = pg8::EK_WIN; E.stats_in = stB; E.Z = Zb; E.XBC = XBCb; E.V = Vb; E.GATES = GATES; E.DT = DTb; E.dt_bias = F.in[I_DTB];
        E.conv_p = F.out + O_CONV_P; E.conv_s = F.out + O_CONV_S; E.pool_p = F.out + O_POOL_P; E.pool_s = F.out + O_POOL_S;
        pg8::gemm_phase(F.lds, g, S, E);
    } SEAM(3);
    if (IN(4)) { ssd_states_phase(F); pool_phase(F); } SEAM(4);
    if (IN(5)) { ssd_scan_phase(F); } SEAM(5);
    if (IN(6)) { ssd_out_phase(F); ssd_seq_phase(F); } SEAM(6);
    if (IN(7)) {
        pg8::Gemm g{Zb, (const bf16_t*)(F.ws + WS_WSSO), M, DM, DI}; S.init(M, DM, F.G, (int)blockIdx.x);
        pg8::Epi E{}; E.kind = pg8::EK_T1; E.gates = GATES; E.of32 = T1;
        pg8::gemm_phase(F.lds, g, S, E);
    } SEAM(7);
    if (IN(8)) {
        pg8::Gemm g{POOLED, (const bf16_t*)(F.ws + WS_W2), M, DM, DM}; S.init(M, DM, F.G, (int)blockIdx.x);
        pg8::Epi E{}; E.kind = pg8::EK_MERGE; E.gates = GATES; E.res_p = T1; E.obf = MERGED;
        pg8::gemm_phase(F.lds, g, S, E);
    } SEAM(8);
    if (IN(9)) {
        pg8::Gemm g{MERGED, (const bf16_t*)(F.ws + WS_WO), M, DM, DM}; S.init(M, DM, F.G, (int)blockIdx.x);
        pg8::Epi E{}; E.kind = pg8::EK_RES; E.coef = 1.0f; E.res_p = H; E.res_s = H + (size_t)MP * DM; E.of32 = H; E.obf = HB; E.stats_out = stA;
        pg8::gemm_phase(F.lds, g, S, E);
    } SEAM(9);
    if (IN(10)) {
        pg8::Gemm g{HB, (const bf16_t*)(F.ws + WS_WGU2), M, 2 * DFF, DM}; S.init(M, 2 * DFF, F.G, (int)blockIdx.x);
        pg8::Epi E{}; E.kind = pg8::EK_GU; E.stats_in = stA; E.obf = ACT; E.ldo = DFF;
        pg8::gemm_phase(F.lds, g, S, E);
    } SEAM(10);
    if (IN(11)) {
        pg8::Gemm g{ACT, (const bf16_t*)(F.ws + WS_WD2), M, DM, DFF}; S.init(M, DM, F.G, (int)blockIdx.x);
        pg8::Epi E{}; E.kind = pg8::EK_RES; E.coef = 0.5f; E.res_p = H; E.res_s = H + (size_t)MP * DM; E.of32 = H; E.obf = HB; E.stats_out = stB;
        pg8::gemm_phase(F.lds, g, S, E);
    } SEAM(11);
    if (IN(12)) {
        pg8::Gemm g{PB, (const bf16_t*)(F.ws + WS_WPLE), M, DM, PLE}; S.init(M, DM, F.G, (int)blockIdx.x);
        pg8::Epi E{}; E.kind = pg8::EK_BF16; E.obf = Qb; E.ldo = DM;
        pg8::gemm_phase(F.lds, g, S, E);
    } SEAM(12);
    if (IN(13)) {
        pg8::Gemm g{HB, (const bf16_t*)(F.ws + WS_WPG), M, DM, DM}; S.init(M, DM, F.G, (int)blockIdx.x);
        pg8::Epi E{}; E.kind = pg8::EK_PLE; E.stats_in = stB; E.q = Qb; E.of32 = H; E.stats_out = stA;
        pg8::gemm_phase(F.lds, g, S, E);
    } SEAM(13);
    if (IN(14)) { final_phase(F); }
#undef IN
#undef SEAM
}

extern "C" void kernel_launch(void* const* d_in, const int* in_sizes, int n_in, void* d_out, int out_size, void* d_ws, size_t ws_size, hipStream_t stream) {
    static int grid = 0;
    if (grid == 0) {
        if (n_in != 30 || in_sizes[0] != MP * DM || (size_t)out_size != O_END || ws_size < WS_END) {
            fprintf(stderr, "kernel_launch: shape mismatch: n_in %d in0 %d out %d ws %zu (need %zu)\n", n_in, n_in > 0 ? in_sizes[0] : -1, out_size, ws_size, (size_t)WS_END); grid = -1; return; }
        int dev = 0, cus = 0, per_cu = 0;
        if (hipGetDevice(&dev) != hipSuccess || hipDeviceGetAttribute(&cus, hipDeviceAttributeMultiprocessorCount, dev) != hipSuccess) { grid = -1; return; }
        if (hipFuncSetAttribute((const void*)mk_fwd, hipFuncAttributeMaxDynamicSharedMemorySize, LDS_BYTES) != hipSuccess) { fprintf(stderr, "kernel_launch: hipFuncSetAttribute failed\n"); grid = -1; return; }
        if (hipOccupancyMaxActiveBlocksPerMultiprocessor(&per_cu, (const void*)mk_fwd, NTHREADS, LDS_BYTES) != hipSuccess || per_cu < 1)
            fprintf(stderr, "kernel_launch: occupancy query reports %d workgroups per CU\n", per_cu);
        (void)hipGetLastError();
        grid = cus;
    }
    if (grid < 0) return;
    if (hipMemsetAsync((char*)d_ws + WS_CTL, 0, CTL_ZERO_BYTES, stream) != hipSuccess) { fprintf(stderr, "kernel_launch: memset failed\n"); return; }
    Args a{};
    for (int i = 0; i < 30; ++i) a.in[i] = (const float*)d_in[i];
    a.out = (float*)d_out; a.ws = (unsigned char*)d_ws;
#if MK_MULTI_LAUNCH
    for (int ph = 0; ph < NPHASES; ++ph) { a.ph_lo = ph; a.ph_hi = ph + 1; a.li = ph;
        hipLaunchKernelGGL(mk_fwd, dim3(grid), dim3(NTHREADS), LDS_BYTES, stream, a); }
#else
    a.ph_lo = 0; a.ph_hi = NPHASES; a.li = 0;
    hipLaunchKernelGGL(mk_fwd, dim3(grid), dim3(NTHREADS), LDS_BYTES, stream, a);
#endif
}
```

```cpp
#include <hip/hip_runtime.h>
#include <cstdio>
#include <cstdint>

#define REP_MASK 0x0
#ifndef MK_MULTI_LAUNCH
#define MK_MULTI_LAUNCH 0
#endif

#define GAS __attribute__((address_space(1)))
#define LAS __attribute__((address_space(3)))
typedef unsigned short bf16_t;
typedef short bf16x8 __attribute__((ext_vector_type(8)));
typedef float f32x4 __attribute__((ext_vector_type(4)));
typedef float f32x2 __attribute__((ext_vector_type(2)));
typedef unsigned u32x4 __attribute__((ext_vector_type(4)));
typedef unsigned u32x2 __attribute__((ext_vector_type(2)));
typedef GAS unsigned gu32;

constexpr int DM = 1024, BATCH = 8, SEQ = 2048, DECB = 128, DECS = 8;
constexpr int MP = BATCH * SEQ, MS = DECB * DECS, M = MP + MS;
constexpr int DI = 2048, HD = 64, NH = 32, NG = 8, HPG = 4, DSTATE = 128, CD = 4096;
constexpr int PD = 1024, PBUF = 15, DFF = 2816, PLE = 256;
constexpr int IN_DIM = 9248, NIN = 9472;
constexpr float EPS = 1e-6f;
constexpr int NWAVES = 8, NTHREADS = 512;

constexpr size_t MiB = 1u << 20;
constexpr size_t WS_CTL = 0, CTL_ZERO_BYTES = 1 * MiB;
constexpr size_t WS_STATS_A = 2 * MiB, WS_STATS_B = 4 * MiB, WS_DT = 6 * MiB, WS_CDEC = 9 * MiB;
constexpr size_t WS_WGU1 = 10 * MiB, WS_WD1 = 21 * MiB, WS_WIN = 27 * MiB, WS_WSSO = 46 * MiB, WS_W2 = 50 * MiB, WS_WO = 52 * MiB,
                 WS_WGU2 = 54 * MiB, WS_WD2 = 65 * MiB, WS_WPG = 71 * MiB, WS_WPLE = 73 * MiB, WS_PB = 74 * MiB, WS_WPOT = 480 * MiB, WS_WGRP = 483 * MiB;
constexpr size_t WS_Z = 84 * MiB, WS_XBC = 152 * MiB, WS_V = 288 * MiB, WS_GATES = 322 * MiB, WS_HB = 390 * MiB, WS_HPREV = 424 * MiB, WS_END = 488 * MiB;
constexpr size_t WS_ACT = WS_XBC, WS_T1 = WS_XBC, WS_MERGED = WS_V, WS_Q = WS_GATES, WS_XB = WS_HB, WS_POOLED = WS_HB;
static_assert(WS_STATS_A + (size_t)M * 16 * 4 <= WS_STATS_B && WS_STATS_B + (size_t)M * 16 * 4 <= WS_DT && WS_DT + (size_t)M * 32 * 4 <= WS_WGU1, "ws map (small)");
static_assert(WS_WGU1 + (size_t)2 * DFF * DM * 2 <= WS_WD1 && WS_WD1 + (size_t)DM * DFF * 2 <= WS_WIN && WS_WIN + (size_t)NIN * DM * 2 <= WS_WSSO && WS_WSSO + (size_t)DM * DI * 2 <= WS_W2, "ws map (w1)");
static_assert(WS_WGU2 + (size_t)2 * DFF * DM * 2 <= WS_WD2 && WS_WD2 + (size_t)DM * DFF * 2 <= WS_WPG && WS_WPLE + (size_t)DM * PLE * 2 <= WS_PB && WS_PB + (size_t)M * PLE * 2 <= WS_Z, "ws map (w2)");
static_assert(WS_Z + (size_t)M * DI * 2 <= WS_XBC && WS_XBC + (size_t)M * CD * 2 <= WS_V && WS_V + (size_t)M * PD * 2 <= WS_GATES && WS_GATES + (size_t)M * 2 * DM * 2 <= WS_HB &&
              WS_HB + (size_t)M * DM * 2 <= WS_HPREV && WS_HPREV + (size_t)BATCH * 16 * NH * HD * DSTATE * 2 <= WS_END, "ws map (act)");
static_assert(WS_ACT + (size_t)M * DFF * 2 <= WS_V && WS_T1 + (size_t)M * DM * 4 <= WS_V, "ws overlays");
constexpr int CW_BAR = 4096;

constexpr size_t O_Y = 0, O_SSM_P = (size_t)M * DM, O_CONV_P = O_SSM_P + (size_t)BATCH * NH * HD * DSTATE, O_POOL_P = O_CONV_P + (size_t)BATCH * 3 * CD,
                 O_SSM_S = O_POOL_P + (size_t)BATCH * PBUF * PD, O_CONV_S = O_SSM_S + (size_t)DECB * NH * HD * DSTATE, O_POOL_S = O_CONV_S + (size_t)DECB * 3 * CD,
                 O_END = O_POOL_S + (size_t)DECB * PBUF * PD;

constexpr int RING_BYTES = 131072, LDSCTL_OFF = RING_BYTES, MISC_OFF = LDSCTL_OFF + 320, LDS_BYTES = 147456;

#define RLX_AGENT __ATOMIC_RELAXED, __HIP_MEMORY_SCOPE_AGENT
#define LDS_WAIT() asm volatile("s_waitcnt lgkmcnt(0)" ::: "memory")
#define VM_WAIT() asm volatile("s_waitcnt vmcnt(0)" ::: "memory")

__device__ __forceinline__ unsigned f2bf(float f) { unsigned u = __builtin_bit_cast(unsigned, f); return (u + 0x7fffu + ((u >> 16) & 1u)) >> 16; }
__device__ __forceinline__ unsigned pk2(float lo, float hi) { return f2bf(lo) | (f2bf(hi) << 16); }
__device__ __forceinline__ float bf2f(unsigned b) { return __builtin_bit_cast(float, b << 16); }
__device__ __forceinline__ float bflo(unsigned w) { return __builtin_bit_cast(float, w << 16); }
__device__ __forceinline__ float bfhi(unsigned w) { return __builtin_bit_cast(float, w & 0xffff0000u); }
__device__ __forceinline__ unsigned cvt_pk_bf16(float lo, float hi) { unsigned r; asm volatile("v_cvt_pk_bf16_f32 %0, %1, %2" : "=v"(r) : "v"(lo), "v"(hi)); return r; }
__device__ __forceinline__ float sigm_f(float x) { return 1.0f / (1.0f + __expf(-x)); }
__device__ __forceinline__ float silu_f(float x) { return x / (1.0f + __expf(-x)); }
__device__ __forceinline__ float wave_sum(float v) {
#pragma unroll
    for (int o = 1; o < 64; o <<= 1) v += __shfl_xor(v, o);
    return v;
}

struct Frame {
    LAS unsigned char* lds;
    volatile LAS unsigned* MISC;
    gu32* ctl;
    int tid, lane, wave, vcu, G;
    unsigned char* ws;
    float* out;
    const float* in[30];
};
enum { I_XP = 0, I_XS, I_SSM, I_CONV, I_POOL, I_PP, I_PS, I_NFFN1, I_WGU1, I_WD1, I_NMIX, I_WIN, I_CONVW, I_CONVB, I_DTB, I_ALOG, I_DSKIP, I_NSSD, I_WSSO, I_WPGRP, I_PSCALE,
       I_WPOUT, I_WO, I_NFFN2, I_WGU2, I_WD2, I_NPLE, I_WPG, I_WPLE, I_NFINAL };

namespace pg8 {
constexpr int BM = 256, BK = 64, HALF = 128, HTB = HALF * BK * 2, STAGE_BYTES = 8 * HTB, NXCD = 8, WGM = 8;
__host__ __device__ __forceinline__ int lds_byte(int r, int c) { const int st = (r >> 4) * 2 + (c >> 5), rr = r & 15, cc = c & 31, ob = rr * 64 + cc * 2; return st * 1024 + (ob ^ (((ob >> 9) & 1) << 5)); }
__host__ __device__ __forceinline__ void stage_rc(int b, int& R, int& C) { const int st = b / 1024, sb = b % 1024, swz = sb ^ (((sb >> 9) & 1) << 5); R = (st >> 1) * 16 + swz / 64; C = (st & 1) * 32 + (swz % 64) / 2; }
__host__ __device__ __forceinline__ int perm32(int rho) { const int n = rho >> 4, i = rho & 15; return 8 * (i >> 2) + 4 * n + (i & 3); }
struct Unit { int pm, pn; };
struct Gemm { const bf16_t* A; const bf16_t* Bt; int M, N, K; int lda; int a_pn_step; };
struct StaticOrder {
    int nM, nN, nwg, G, c;
    __host__ __device__ void init(int M_, int N_, int G_, int c_) { nM = M_ / BM; nN = N_ / BM; nwg = nM * nN; G = G_; c = c_; }
    __host__ __device__ void init_tail(int M_, int N_, int G_, int c_) { init(M_, N_, G_, (G_ - 1) - c_); }
    __host__ __device__ bool next(int i, Unit& u) const {
        const long L = (long)i * G + c; if (L >= nwg) return false;
        int wgid = (int)L; { const int q = nwg / NXCD, r = nwg % NXCD, xcd = wgid % NXCD, off = wgid / NXCD; wgid = (xcd < r ? xcd * (q + 1) : r * (q + 1) + (xcd - r) * q) + off; }
        const int nig = WGM * nN, gid = wgid / nig, fm = gid * WGM, gsz = (nM - fm) < WGM ? (nM - fm) : WGM;
        u.pm = fm + ((wgid % nig) % gsz); u.pn = (wgid % nig) / gsz; return true;
    }
};

enum EpiKind { EK_GU = 1, EK_RES = 2, EK_WIN = 3, EK_T1 = 4, EK_MERGE = 5, EK_BF16 = 6, EK_PLE = 7 };
struct Epi {
    const float* stats_in;
    float* stats_out;
    bf16_t* obf;
    float* of32;
    const float* res_p; const float* res_s;
    const bf16_t* gates;
    const bf16_t* q;
    bf16_t *Z, *XBC, *V, *GATES; float* DT; const float* dt_bias; float *conv_p, *conv_s, *pool_p, *pool_s;
    int kind; int ldo; float coef; int pad;
};

__device__ __forceinline__ u32x4 pack8(const f32x4 a, const f32x4 b) { u32x4 w; w.x = cvt_pk_bf16(a[0], a[1]); w.y = cvt_pk_bf16(a[2], a[3]); w.z = cvt_pk_bf16(b[0], b[1]); w.w = cvt_pk_bf16(b[2], b[3]); return w; }
__device__ __forceinline__ void unpack8(const u32x4 w, f32x4& a, f32x4& b) { a = (f32x4){bflo(w.x), bfhi(w.x), bflo(w.y), bfhi(w.y)}; b = (f32x4){bflo(w.z), bfhi(w.z), bflo(w.w), bfhi(w.w)}; }

__device__ __forceinline__ float row_rs(const float* stats, int row) {
    if (!stats) return 1.0f;
    const GAS f32x4* sp = (const GAS f32x4*)(stats + (size_t)row * 16);
    const f32x4 a = sp[0], b = sp[1], c = sp[2], d = sp[3]; const f32x4 s = (a + b) + (c + d);
    return __builtin_amdgcn_rsqf(((s[0] + s[1]) + (s[2] + s[3])) * (1.0f / 1024.0f) + EPS);
}
__device__ __forceinline__ float softplus_f(float x) { const float e = __expf(-fabsf(x)); const float l = (e < 0.01f) ? e * (1.0f - e * (0.5f - e * (1.0f / 3.0f))) : __logf(1.0f + e); return fmaxf(x, 0.f) + l; }

__device__ __forceinline__ void epilogue(const Epi& E, const f32x4 (&acc)[2][2][4][2], const Unit& u, int wr, int wc, int fr, int fq) {
    const int rowb = u.pm * BM + wr * 64 + fr;
    const int cin = wc * 32 + 8 * fq;
    if (E.kind == EK_GU) {
#pragma unroll
        for (int ai = 0; ai < 2; ++ai)
#pragma unroll
            for (int m = 0; m < 4; ++m) { const int row = rowb + ai * HALF + m * 16; const float r = row_rs(E.stats_in, row);
                const f32x4 g0 = acc[ai][0][m][0] * r, u0 = acc[ai][1][m][0] * r, g1 = acc[ai][0][m][1] * r, u1 = acc[ai][1][m][1] * r;
                const f32x4 o0 = (f32x4){silu_f(g0[0]) * u0[0], silu_f(g0[1]) * u0[1], silu_f(g0[2]) * u0[2], silu_f(g0[3]) * u0[3]};
                const f32x4 o1 = (f32x4){silu_f(g1[0]) * u1[0], silu_f(g1[1]) * u1[1], silu_f(g1[2]) * u1[2], silu_f(g1[3]) * u1[3]};
                *(GAS u32x4*)(E.obf + (size_t)row * E.ldo + u.pn * HALF + cin) = pack8(o0, o1); }
    } else if (E.kind == EK_RES) {
#pragma unroll
        for (int ai = 0; ai < 2; ++ai)
#pragma unroll
            for (int m = 0; m < 4; ++m) { const int row = rowb + ai * HALF + m * 16;
                const float* rp = (row < MP) ? E.res_p + (size_t)row * DM : E.res_s + (size_t)(row - MP) * DM;
                float ss = 0.f;
#pragma unroll
                for (int bj = 0; bj < 2; ++bj) { const int col = u.pn * BM + bj * HALF + cin;
                    const f32x4 r0 = *(const GAS f32x4*)(rp + col), r1 = *(const GAS f32x4*)(rp + col + 4);
                    const f32x4 h0 = r0 + acc[ai][bj][m][0] * E.coef, h1 = r1 + acc[ai][bj][m][1] * E.coef;
                    *(GAS f32x4*)(E.of32 + (size_t)row * DM + col) = h0; *(GAS f32x4*)(E.of32 + (size_t)row * DM + col + 4) = h1;
                    *(GAS u32x4*)(E.obf + (size_t)row * DM + col) = pack8(h0, h1);
                    ss += (h0[0] * h0[0] + h0[1] * h0[1]) + (h0[2] * h0[2] + h0[3] * h0[3]) + (h1[0] * h1[0] + h1[1] * h1[1]) + (h1[2] * h1[2] + h1[3] * h1[3]); }
                ss += __shfl_xor(ss, 16); ss += __shfl_xor(ss, 32);
                if (fq == 0) *(GAS float*)(E.stats_out + (size_t)row * 16 + u.pn * 4 + wc) = ss; }
    } else if (E.kind == EK_WIN) {
        const int pn = u.pn;
        if (pn < 8 || (pn >= 28 && pn < 36)) {
            const bool isz = pn < 8; bf16_t* const O = isz ? E.Z : E.GATES; const int colt = (isz ? pn : pn - 28) * BM + cin;
#pragma unroll
            for (int ai = 0; ai < 2; ++ai)
#pragma unroll
                for (int m = 0; m < 4; ++m) { const int row = rowb + ai * HALF + m * 16; const float r = row_rs(E.stats_in, row);
#pragma unroll
                    for (int bj = 0; bj < 2; ++bj) { f32x4 v0 = acc[ai][bj][m][0] * r, v1 = acc[ai][bj][m][1] * r;
#pragma unroll
                        for (int j = 0; j < 4; ++j) { const float s0 = sigm_f(v0[j]), s1 = sigm_f(v1[j]); v0[j] = isz ? v0[j] * s0 : s0; v1[j] = isz ? v1[j] * s1 : s1; }
                        *(GAS u32x4*)(O + (size_t)row * (2 * DM) + colt + bj * HALF) = pack8(v0, v1); } }
        } else if (pn < 28) {
            const bool isx = pn < 24; bf16_t* const O = isx ? E.XBC : E.V; const int ldo = isx ? CD : PD; const int colt = (isx ? pn - 8 : pn - 24) * BM + cin;
            const int keep = isx ? 3 : PBUF;
#pragma unroll
            for (int ai = 0; ai < 2; ++ai)
#pragma unroll
                for (int m = 0; m < 4; ++m) { const int row = rowb + ai * HALF + m * 16; const float r = row_rs(E.stats_in, row);
                    float* sp = nullptr;
                    if (row < MP) { const int sb = row >> 11, st = row & (SEQ - 1); if (st >= SEQ - keep) sp = (isx ? E.conv_p : E.pool_p) + ((size_t)sb * keep + (st - (SEQ - keep))) * ldo + colt; }
                    else { const int sb = (row - MP) >> 3, st = (row - MP) & 7; const int si = st - (DECS - keep); if (si >= 0) sp = (isx ? E.conv_s : E.pool_s) + ((size_t)sb * keep + si) * ldo + colt; }
#pragma unroll
                    for (int bj = 0; bj < 2; ++bj) { const f32x4 v0 = acc[ai][bj][m][0] * r, v1 = acc[ai][bj][m][1] * r;
                        *(GAS u32x4*)(O + (size_t)row * ldo + colt + bj * HALF) = pack8(v0, v1);
                        if (sp) { *(GAS f32x4*)(sp + bj * HALF) = v0; *(GAS f32x4*)(sp + bj * HALF + 4) = v1; } } }
        } else if (wc == 0) {
            const f32x4 b0 = *(const GAS f32x4*)(E.dt_bias + 8 * fq), b1 = *(const GAS f32x4*)(E.dt_bias + 8 * fq + 4);
#pragma unroll
            for (int ai = 0; ai < 2; ++ai)
#pragma unroll
                for (int m = 0; m < 4; ++m) { const int row = rowb + ai * HALF + m * 16; const float r = row_rs(E.stats_in, row);
                    f32x4 v0 = acc[ai][0][m][0] * r + b0, v1 = acc[ai][0][m][1] * r + b1;
#pragma unroll
                    for (int j = 0; j < 4; ++j) { v0[j] = softplus_f(v0[j]); v1[j] = softplus_f(v1[j]); }
                    *(GAS f32x4*)(E.DT + (size_t)row * 32 + 8 * fq) = v0; *(GAS f32x4*)(E.DT + (size_t)row * 32 + 8 * fq + 4) = v1; }
        }
    } else if (E.kind == EK_T1) {
#pragma unroll
        for (int ai = 0; ai < 2; ++ai)
#pragma unroll
            for (int m = 0; m < 4; ++m) { const int row = rowb + ai * HALF + m * 16;
#pragma unroll
                for (int bj = 0; bj < 2; ++bj) { const int col = u.pn * BM + bj * HALF + cin;
                    f32x4 g0, g1; unpack8(*(const GAS u32x4*)(E.gates + (size_t)row * (2 * DM) + col), g0, g1);
                    *(GAS f32x4*)(E.of32 + (size_t)row * DM + col) = g0 * acc[ai][bj][m][0]; *(GAS f32x4*)(E.of32 + (size_t)row * DM + col + 4) = g1 * acc[ai][bj][m][1]; } }
    } else if (E.kind == EK_MERGE) {
#pragma unroll
        for (int ai = 0; ai < 2; ++ai)
#pragma unroll
            for (int m = 0; m < 4; ++m) { const int row = rowb + ai * HALF + m * 16;
#pragma unroll
                for (int bj = 0; bj < 2; ++bj) { const int col = u.pn * BM + bj * HALF + cin;
                    f32x4 g0, g1; unpack8(*(const GAS u32x4*)(E.gates + (size_t)row * (2 * DM) + DM + col), g0, g1);
                    const f32x4 t0 = *(const GAS f32x4*)(E.res_p + (size_t)row * DM + col), t1 = *(const GAS f32x4*)(E.res_p + (size_t)row * DM + col + 4);
                    *(GAS u32x4*)(E.obf + (size_t)row * DM + col) = pack8(t0 + g0 * acc[ai][bj][m][0], t1 + g1 * acc[ai][bj][m][1]); } }
    } else if (E.kind == EK_BF16) {
#pragma unroll
        for (int ai = 0; ai < 2; ++ai)
#pragma unroll
            for (int m = 0; m < 4; ++m) { const int row = rowb + ai * HALF + m * 16;
#pragma unroll
                for (int bj = 0; bj < 2; ++bj) { const int col = u.pn * BM + bj * HALF + cin;
                    *(GAS u32x4*)(E.obf + (size_t)row * E.ldo + col) = pack8(acc[ai][bj][m][0], acc[ai][bj][m][1]); } }
    } else if (E.kind == EK_PLE) {
#pragma unroll
        for (int ai = 0; ai < 2; ++ai)
#pragma unroll
            for (int m = 0; m < 4; ++m) { const int row = rowb + ai * HALF + m * 16; const float r = row_rs(E.stats_in, row);
                float ss = 0.f;
#pragma unroll
                for (int bj = 0; bj < 2; ++bj) { const int col = u.pn * BM + bj * HALF + cin;
                    f32x4 q0, q1; unpack8(*(const GAS u32x4*)(E.q + (size_t)row * DM + col), q0, q1);
                    const f32x4 r0 = *(const GAS f32x4*)(E.of32 + (size_t)row * DM + col), r1 = *(const GAS f32x4*)(E.of32 + (size_t)row * DM + col + 4);
                    f32x4 h0, h1;
#pragma unroll
                    for (int j = 0; j < 4; ++j) { h0[j] = r0[j] + sigm_f(acc[ai][bj][m][0][j] * r) * q0[j]; h1[j] = r1[j] + sigm_f(acc[ai][bj][m][1][j] * r) * q1[j]; }
                    *(GAS f32x4*)(E.of32 + (size_t)row * DM + col) = h0; *(GAS f32x4*)(E.of32 + (size_t)row * DM + col + 4) = h1;
                    ss += (h0[0] * h0[0] + h0[1] * h0[1]) + (h0[2] * h0[2] + h0[3] * h0[3]) + (h1[0] * h1[0] + h1[1] * h1[1]) + (h1[2] * h1[2] + h1[3] * h1[3]); }
                ss += __shfl_xor(ss, 16); ss += __shfl_xor(ss, 32);
                if (fq == 0) *(GAS float*)(E.stats_out + (size_t)row * 16 + u.pn * 4 + wc) = ss; }
    }
}


__device__ __forceinline__ void epi_seg(const Epi& E, int row, int col, f32x4 v0, f32x4 v1, int lane) {
    if (E.kind == EK_RES) {
        const float* rp = ((row < MP) ? E.res_p + (size_t)row * DM : E.res_s + (size_t)(row - MP) * DM) + col;
        const f32x4 h0 = *(const GAS f32x4*)rp + v0 * E.coef, h1 = *(const GAS f32x4*)(rp + 4) + v1 * E.coef;
        *(GAS f32x4*)(E.of32 + (size_t)row * DM + col) = h0; *(GAS f32x4*)(E.of32 + (size_t)row * DM + col + 4) = h1;
        *(GAS u32x4*)(E.obf + (size_t)row * DM + col) = pack8(h0, h1);
        float ss = (h0[0] * h0[0] + h0[1] * h0[1]) + (h0[2] * h0[2] + h0[3] * h0[3]) + (h1[0] * h1[0] + h1[1] * h1[1]) + (h1[2] * h1[2] + h1[3] * h1[3]);
        ss += __shfl_xor(ss, 1); ss += __shfl_xor(ss, 2); ss += __shfl_xor(ss, 4);
        if ((lane & 7) == 0) *(GAS float*)(E.stats_out + (size_t)row * 16 + (col >> 6)) = ss;
    } else if (E.kind == EK_T1) {
        f32x4 g0, g1; unpack8(*(const GAS u32x4*)(E.gates + (size_t)row * (2 * DM) + col), g0, g1);
        *(GAS f32x4*)(E.of32 + (size_t)row * DM + col) = g0 * v0; *(GAS f32x4*)(E.of32 + (size_t)row * DM + col + 4) = g1 * v1;
    } else if (E.kind == EK_MERGE) {
        f32x4 g0, g1; unpack8(*(const GAS u32x4*)(E.gates + (size_t)row * (2 * DM) + DM + col), g0, g1);
        const f32x4 t0 = *(const GAS f32x4*)(E.res_p + (size_t)row * DM + col), t1 = *(const GAS f32x4*)(E.res_p + (size_t)row * DM + col + 4);
        *(GAS u32x4*)(E.obf + (size_t)row * DM + col) = pack8(t0 + g0 * v0, t1 + g1 * v1);
    } else if (E.kind == EK_BF16) {
        *(GAS u32x4*)(E.obf + (size_t)row * E.ldo + col) = pack8(v0, v1);
    } else if (E.kind == EK_PLE) {
        const float r = row_rs(E.stats_in, row);
        f32x4 q0, q1; unpack8(*(const GAS u32x4*)(E.q + (size_t)row * DM + col), q0, q1);
        const f32x4 r0 = *(const GAS f32x4*)(E.of32 + (size_t)row * DM + col), r1 = *(const GAS f32x4*)(E.of32 + (size_t)row * DM + col + 4);
        f32x4 h0, h1;
#pragma unroll
        for (int j = 0; j < 4; ++j) { h0[j] = r0[j] + sigm_f(v0[j] * r) * q0[j]; h1[j] = r1[j] + sigm_f(v1[j] * r) * q1[j]; }
        *(GAS f32x4*)(E.of32 + (size_t)row * DM + col) = h0; *(GAS f32x4*)(E.of32 + (size_t)row * DM + col + 4) = h1;
        float ss = (h0[0] * h0[0] + h0[1] * h0[1]) + (h0[2] * h0[2] + h0[3] * h0[3]) + (h1[0] * h1[0] + h1[1] * h1[1]) + (h1[2] * h1[2] + h1[3] * h1[3]);
        ss += __shfl_xor(ss, 1); ss += __shfl_xor(ss, 2); ss += __shfl_xor(ss, 4);
        if ((lane & 7) == 0) *(GAS float*)(E.stats_out + (size_t)row * 16 + (col >> 6)) = ss;
    }
}
__device__ __forceinline__ void gemm_small(LAS unsigned char* lds, const Gemm g, const Epi& E, int row_base, int nrows, int G, int c) {
    const int tid = threadIdx.x, wid = __builtin_amdgcn_readfirstlane(tid >> 6), lane = tid & 63, ql = lane & 15, gq = lane >> 4;
    const int K = g.K, nkt = K / 64, ntn = g.N / 64, ntiles = (nrows / 64) * ntn;
    for (int v = c; v < ntiles; v += G) {
        const int r0 = row_base + 64 * (v / ntn), c0 = 64 * (v % ntn);
        f32x4 acc[4][4];
#pragma unroll
        for (int m = 0; m < 4; ++m)
#pragma unroll
            for (int n = 0; n < 4; ++n) acc[m][n] = (f32x4){0.f, 0.f, 0.f, 0.f};
        const bf16_t* const ap = g.A + (size_t)(r0 + ql) * g.lda + 8 * gq;
        const bf16_t* const bp = g.Bt + (size_t)(c0 + ql) * K + 8 * gq;
        bf16x8 af[4][2], bf[4][2];
        if (wid < nkt) {
#pragma unroll
            for (int m = 0; m < 4; ++m)
#pragma unroll
                for (int ks = 0; ks < 2; ++ks) { af[m][ks] = *(const GAS bf16x8*)(ap + (size_t)(16 * m) * g.lda + 64 * wid + 32 * ks); bf[m][ks] = *(const GAS bf16x8*)(bp + (size_t)(16 * m) * K + 64 * wid + 32 * ks); }
        }
        for (int kt = wid; kt < nkt; kt += 8) {
            bf16x8 an[4][2], bn[4][2];
            const int kn = (kt + 8 < nkt) ? kt + 8 : kt;
#pragma unroll
            for (int m = 0; m < 4; ++m)
#pragma unroll
                for (int ks = 0; ks < 2; ++ks) { an[m][ks] = *(const GAS bf16x8*)(ap + (size_t)(16 * m) * g.lda + 64 * kn + 32 * ks); bn[m][ks] = *(const GAS bf16x8*)(bp + (size_t)(16 * m) * K + 64 * kn + 32 * ks); }
#pragma unroll
            for (int ks = 0; ks < 2; ++ks)
#pragma unroll
                for (int m = 0; m < 4; ++m)
#pragma unroll
                    for (int n = 0; n < 4; ++n) acc[m][n] = __builtin_amdgcn_mfma_f32_16x16x32_bf16(bf[n][ks], af[m][ks], acc[m][n], 0, 0, 0);
#pragma unroll
            for (int m = 0; m < 4; ++m)
#pragma unroll
                for (int ks = 0; ks < 2; ++ks) { af[m][ks] = an[m][ks]; bf[m][ks] = bn[m][ks]; }
        }
        LAS f32x4* const slab = (LAS f32x4*)(lds + wid * 16384);
#pragma unroll
        for (int m = 0; m < 4; ++m)
#pragma unroll
            for (int n = 0; n < 4; ++n) slab[(16 * m + ql) * 16 + ((4 * n + gq) ^ ql)] = acc[m][n];
        __syncthreads();
        const int rr = 8 * wid + (lane >> 3), ch0 = 2 * (lane & 7);
        f32x4 v0 = (f32x4){0.f, 0.f, 0.f, 0.f}, v1 = v0;
#pragma unroll
        for (int s8 = 0; s8 < 8; ++s8) { const LAS f32x4* sl = (const LAS f32x4*)(lds + s8 * 16384) + rr * 16; v0 += sl[ch0 ^ (rr & 15)]; v1 += sl[(ch0 + 1) ^ (rr & 15)]; }
        epi_seg(E, r0 + rr, c0 + 8 * (lane & 7), v0, v1, lane);
        __syncthreads();
    }
}

__device__ __forceinline__ void gemm_phase(LAS unsigned char* lds, const Gemm g, const StaticOrder& S, const Epi& E) {
    const int tid = threadIdx.x, wid = __builtin_amdgcn_readfirstlane(tid >> 6), lane = tid & 63, wr = wid >> 2, wc = wid & 3, fr = lane & 15, fq = lane >> 4;
    const int K = g.K, nt = K / BK;
    unsigned voffA[2], voffB[2];
#pragma unroll
    for (int i = 0; i < 2; ++i) { int R, C; stage_rc(tid * 16 + i * 8192, R, C); const int Rb = (R & ~31) + perm32(R & 31);
        voffA[i] = (unsigned)(R * g.lda + C) * 2u; voffB[i] = (unsigned)(Rb * K + C) * 2u; }
    const size_t kstep = (size_t)(BK * 2);
    const size_t hstep = (size_t)HALF * K * 2, hstepA = (size_t)HALF * g.lda * 2;
    const size_t tstep = 2 * hstep, tstepA = 2 * hstepA, pnstepA = (size_t)g.a_pn_step * 2;
    const unsigned ldsw = (unsigned)wid * 1024u;
    const int aoff = lds_byte(wr * 64 + fr, fq * 8), boff = lds_byte(wc * 32 + fr, fq * 8);
#define PG8_SA(b, h) (((b) * 2 + (h)) * HTB)
#define PG8_SB(b, h) ((4 + (b) * 2 + (h)) * HTB)
#define PG8_STAGE(bufoff, gbase, voff) do { _Pragma("unroll") for (int _i = 0; _i < 2; ++_i) \
        __builtin_amdgcn_global_load_lds((const unsigned*)((const char*)(gbase) + (voff)[_i]), (LAS unsigned*)(lds + (bufoff) + ldsw + _i * 8192), 16, 0, 0); } while (0)
#define PG8_LDA(dst, b, h) do { _Pragma("unroll") for (int m = 0; m < 4; ++m) _Pragma("unroll") for (int k = 0; k < 2; ++k) dst[m][k] = *(const LAS bf16x8*)(lds + PG8_SA(b, h) + aoff + m * 2048 + k * 1024); } while (0)
#define PG8_LDB(dst, b, h) do { _Pragma("unroll") for (int n = 0; n < 2; ++n) _Pragma("unroll") for (int k = 0; k < 2; ++k) dst[n][k] = *(const LAS bf16x8*)(lds + PG8_SB(b, h) + boff + n * 2048 + k * 1024); } while (0)
#define PG8_MMA(ai, bj, At, Bt) do { __builtin_amdgcn_s_setprio(1); _Pragma("unroll") for (int m = 0; m < 4; ++m) _Pragma("unroll") for (int n = 0; n < 2; ++n) _Pragma("unroll") for (int k = 0; k < 2; ++k) \
        acc[ai][bj][m][n] = __builtin_amdgcn_mfma_f32_16x16x32_bf16(Bt[n][k], At[m][k], acc[ai][bj][m][n], 0, 0, 0); __builtin_amdgcn_s_setprio(0); } while (0)
#define PG8_WAIT_V(n) asm volatile("s_waitcnt vmcnt(" #n ")" ::: "memory")
#define PG8_WAIT_L(n) asm volatile("s_waitcnt lgkmcnt(" #n ")" ::: "memory")
#define PG8_BAR __builtin_amdgcn_s_barrier()
#define PG8_SCHED __builtin_amdgcn_sched_barrier(0)
    Unit cur, nxt; int ui = 0;
    if (!S.next(0, cur)) return;
    f32x4 acc[2][2][4][2];
#pragma unroll
    for (int a = 0; a < 2; ++a)
#pragma unroll
        for (int b = 0; b < 2; ++b)
#pragma unroll
            for (int m = 0; m < 4; ++m)
#pragma unroll
                for (int n = 0; n < 2; ++n) acc[a][b][m][n] = (f32x4){0.f, 0.f, 0.f, 0.f};
    bf16x8 At[4][2], B0[2][2], B1[2][2];
    const char* cA = (const char*)g.A + (size_t)cur.pm * tstepA + (size_t)cur.pn * pnstepA; const char* cB = (const char*)g.Bt + (size_t)cur.pn * tstep;
    PG8_STAGE(PG8_SB(0, 0), cB, voffB); PG8_STAGE(PG8_SB(0, 1), cB + hstep, voffB); PG8_STAGE(PG8_SA(0, 0), cA, voffA); PG8_STAGE(PG8_SA(0, 1), cA + hstepA, voffA);
    if (wr == 1) PG8_BAR;
    PG8_WAIT_V(2); PG8_BAR;
    PG8_STAGE(PG8_SB(1, 0), cB + kstep, voffB); PG8_STAGE(PG8_SA(1, 0), cA + kstep, voffA); PG8_STAGE(PG8_SB(1, 1), cB + hstep + kstep, voffB);
    PG8_WAIT_V(6); PG8_BAR;
    for (;;) {
        const bool has_next = S.next(ui + 1, nxt);
        const char* nA = has_next ? (const char*)g.A + (size_t)nxt.pm * tstepA + (size_t)nxt.pn * pnstepA : cA; const char* nB = has_next ? (const char*)g.Bt + (size_t)nxt.pn * tstep : cB;
        for (int t = 0; t < nt; t += 2) {
            const bool last = (t == nt - 2);
            const char* a1 = cA + (size_t)(t + 1) * kstep;
            const char* a2 = last ? nA : cA + (size_t)(t + 2) * kstep; const char* b2 = last ? nB : cB + (size_t)(t + 2) * kstep;
            const char* a3 = a2 + kstep; const char* b3 = b2 + kstep;
            PG8_LDB(B0, 0, 0); PG8_LDB(B1, 0, 1); PG8_SCHED; PG8_LDA(At, 0, 0); PG8_STAGE(PG8_SA(1, 1), a1 + hstepA, voffA);
            PG8_WAIT_V(8); PG8_WAIT_L(0); PG8_BAR; PG8_MMA(0, 0, At, B0); PG8_MMA(0, 1, At, B1); PG8_BAR; PG8_SCHED;
            PG8_LDA(At, 0, 1); PG8_STAGE(PG8_SB(0, 0), b2, voffB); PG8_STAGE(PG8_SB(0, 1), b2 + hstep, voffB); PG8_STAGE(PG8_SA(0, 0), a2, voffA);
            PG8_WAIT_V(8); PG8_WAIT_L(0); PG8_BAR; PG8_MMA(1, 0, At, B0); PG8_MMA(1, 1, At, B1); PG8_BAR; PG8_SCHED;
            PG8_LDB(B0, 1, 0); PG8_LDB(B1, 1, 1); PG8_SCHED; PG8_LDA(At, 1, 0); PG8_STAGE(PG8_SA(0, 1), a2 + hstepA, voffA);
            PG8_WAIT_V(8); PG8_WAIT_L(0); PG8_BAR; PG8_MMA(0, 0, At, B0); PG8_MMA(0, 1, At, B1); PG8_BAR; PG8_SCHED;
            PG8_LDA(At, 1, 1); PG8_STAGE(PG8_SB(1, 0), b3, voffB); PG8_STAGE(PG8_SB(1, 1), b3 + hstep, voffB); PG8_STAGE(PG8_SA(1, 0), a3, voffA);
            PG8_WAIT_V(8); PG8_WAIT_L(0); PG8_BAR; PG8_MMA(1, 0, At, B0); PG8_MMA(1, 1, At, B1); PG8_BAR; PG8_SCHED;
        }
        if (wr == 0) PG8_BAR;
        epilogue(E, acc, cur, wr, wc, fr, fq);
        if (!has_next) break;
#pragma unroll
        for (int a = 0; a < 2; ++a)
#pragma unroll
            for (int b = 0; b < 2; ++b)
#pragma unroll
                for (int m = 0; m < 4; ++m)
#pragma unroll
                    for (int n = 0; n < 2; ++n) acc[a][b][m][n] = (f32x4){0.f, 0.f, 0.f, 0.f};
        cur = nxt; cA = nA; cB = nB; ++ui;
        if (wr == 1) PG8_BAR;
    }
    PG8_WAIT_V(0);
    PG8_BAR;
#undef PG8_SA
#undef PG8_SB
#undef PG8_STAGE
#undef PG8_LDA
#undef PG8_LDB
#undef PG8_MMA
#undef PG8_WAIT_V
#undef PG8_WAIT_L
#undef PG8_BAR
#undef PG8_SCHED
}
}

#define XB_TMO      128
#define XB_XCNT(j)  (256  + 64 * (j))
#define XB_XSUB(j)  (1280 + 64 * (j))
#define XB_XGEN(j)  (2304 + 64 * (j))
#define XB_TOP      3328
#define XB_TOPGEN   3392
#define XCD_BAR_WORDS 3456
#define XB_SPIN_CAP (1u << 18)
__device__ __forceinline__ unsigned xb_ld(unsigned* p)              { return __hip_atomic_load(p, __ATOMIC_RELAXED, __HIP_MEMORY_SCOPE_AGENT); }
__device__ __forceinline__ unsigned xb_add(unsigned* p, unsigned v) { return __hip_atomic_fetch_add(p, v, __ATOMIC_RELAXED, __HIP_MEMORY_SCOPE_AGENT); }
__device__ __forceinline__ unsigned xb_xcc_id() { return (unsigned)__builtin_amdgcn_s_getreg((3 << 11) | 20) & 0xFu; }
#define XB_SPIN(cond, bar) do { unsigned _sp = 0; while (cond) { __builtin_amdgcn_s_sleep(1); \
    if ((++_sp & 255u) == 0u) { if (xb_ld(&(bar)[XB_TMO])) break; if (_sp > XB_SPIN_CAP) { atomicAdd(&(bar)[XB_TMO], 1u); break; } } } } while (0)
struct XcdBarrier { unsigned* bar; unsigned x; volatile LAS unsigned* st; };
__device__ __forceinline__ XcdBarrier xcd_barrier_post(unsigned* bar, volatile LAS unsigned* st) {
    XcdBarrier b; b.bar = bar; b.x = xb_xcc_id(); b.st = st;
    if (threadIdx.x == 0) (void)xb_add(&bar[XB_XCNT(b.x)], 1u);
    return b;
}
__device__ __forceinline__ void xcd_barrier_complete(unsigned* bar, unsigned x, unsigned& nloc, unsigned& nx) {
    const unsigned G = gridDim.x * gridDim.y * gridDim.z;
    unsigned sum, cnt, mine, sp = 0u;
    for (;;) {
        sum = 0u; cnt = 0u; mine = 0u;
#pragma unroll
        for (unsigned j = 0; j < 16; ++j) { const unsigned c = xb_ld(&bar[XB_XCNT(j)]); sum += c; cnt += (c > 0u) ? 1u : 0u; mine = (j == x) ? c : mine; }
        if (sum == G) break;
        __builtin_amdgcn_s_sleep(1);
        if ((++sp & 255u) == 0u) { if (xb_ld(&bar[XB_TMO])) break; if (sp > XB_SPIN_CAP) { atomicAdd(&bar[XB_TMO], 1u); break; } }
    }
    nloc = mine > 0u ? mine : 1u; nx = cnt > 0u ? cnt : 1u;
}
__device__ __forceinline__ void xcd_barrier(const XcdBarrier& b) {
    asm volatile("s_waitcnt vmcnt(0)" ::: "memory");
    __syncthreads();
    if (threadIdx.x == 0) {
        unsigned* bar = b.bar;
        __builtin_amdgcn_s_waitcnt(0);
        unsigned nloc = b.st[0], nx = b.st[1];
        if (nloc == 0u) { xcd_barrier_complete(bar, b.x, nloc, nx); b.st[0] = nloc; b.st[1] = nx; }
        const unsigned old = xb_add(&bar[XB_XSUB(b.x)], 1u);
        const unsigned gen = old / nloc;
        if (old + 1u == (gen + 1u) * nloc) {
            __builtin_amdgcn_fence(__ATOMIC_RELEASE, "agent");
            asm volatile("s_waitcnt vmcnt(0)" ::: "memory");
            const unsigned og = xb_add(&bar[XB_TOP], 1u);
            const unsigned tg = og / nx;
            if (og + 1u == (tg + 1u) * nx) xb_add(&bar[XB_TOPGEN], 1u);
            else XB_SPIN(xb_ld(&bar[XB_TOPGEN]) == tg, bar);
            __builtin_amdgcn_fence(__ATOMIC_ACQUIRE, "agent");
            xb_add(&bar[XB_XGEN(b.x)], 1u);
            asm volatile("s_waitcnt vmcnt(0)" ::: "memory");
        } else {
            XB_SPIN(xb_ld(&bar[XB_XGEN(b.x)]) == gen, bar);
            __builtin_amdgcn_fence(__ATOMIC_ACQUIRE, "agent");
            asm volatile("s_waitcnt vmcnt(0)" ::: "memory");
        }
    }
    __syncthreads();
}

__device__ __forceinline__ void p0_transpose_item(const float* W, int K, int N, const float* gain, bf16_t* WT, int k0, int n0, int drow0, LAS float* scr, int lane) {
#pragma unroll
    for (int i = 0; i < 8; ++i) { const int kk = 8 * i + (lane >> 3), nn = 4 * (lane & 7);
        f32x4 v = *(const GAS f32x4*)(W + (size_t)(k0 + kk) * N + n0 + nn);
        if (gain) v = v * *(const GAS float*)(gain + k0 + kk);
        scr[kk * 33 + nn] = v.x; scr[kk * 33 + nn + 1] = v.y; scr[kk * 33 + nn + 2] = v.z; scr[kk * 33 + nn + 3] = v.w; }
    LDS_WAIT(); asm volatile("" ::: "memory");
    const int c = lane & 7;
#pragma unroll
    for (int j = 0; j < 4; ++j) { const int n = (lane >> 3) + 8 * j; const LAS float* s = scr + (8 * c) * 33 + n;
        u32x4 o; o.x = pk2(s[0 * 33], s[1 * 33]); o.y = pk2(s[2 * 33], s[3 * 33]); o.z = pk2(s[4 * 33], s[5 * 33]); o.w = pk2(s[6 * 33], s[7 * 33]);
        *(GAS u32x4*)(WT + (size_t)(drow0 + n) * K + k0 + 8 * c) = o; }
    LDS_WAIT(); asm volatile("" ::: "memory");
}
__device__ __forceinline__ int map_gu(int n0) { return n0 < DFF ? (n0 / 128) * 256 + (n0 % 128) : ((n0 - DFF) / 128) * 256 + 128 + ((n0 - DFF) % 128); }
__device__ __forceinline__ int map_win(int n0) { return n0 < 6144 ? n0 : (n0 < 6176 ? 9216 + (n0 - 6144) : n0 - 32); }

__device__ __forceinline__ void p0_prologue(Frame& F) {
    LAS float* scr = (LAS float*)(F.lds + F.wave * 16384);
    const int gw = F.vcu * NWAVES + F.wave, NGW = F.G * NWAVES, lane = F.lane;
    bf16_t* const wgu1 = (bf16_t*)(F.ws + WS_WGU1); bf16_t* const wd1 = (bf16_t*)(F.ws + WS_WD1); bf16_t* const win = (bf16_t*)(F.ws + WS_WIN);
    bf16_t* const wsso = (bf16_t*)(F.ws + WS_WSSO); bf16_t* const wo = (bf16_t*)(F.ws + WS_WO); bf16_t* const wgu2 = (bf16_t*)(F.ws + WS_WGU2);
    bf16_t* const wd2 = (bf16_t*)(F.ws + WS_WD2); bf16_t* const wpg = (bf16_t*)(F.ws + WS_WPG); bf16_t* const wple = (bf16_t*)(F.ws + WS_WPLE);
    constexpr int I_GU = (DM / 64) * (2 * DFF / 32), I_D = (DFF / 64) * (DM / 32), I_IN = (DM / 64) * (IN_DIM / 32), I_SSO = (DI / 64) * (DM / 32), I_SQ = (DM / 64) * (DM / 32), I_PLE = (PLE / 64) * (DM / 32);
    constexpr int NITEMS = 2 * I_GU + 2 * I_D + I_IN + I_SSO + 3 * I_SQ + I_PLE;
    bf16_t* const wpot = (bf16_t*)(F.ws + WS_WPOT);
    for (int it = gw; it < NITEMS; it += NGW) {
        int r = it;
        if (r < I_GU) { const int nb = 2 * DFF / 32, kb = r / nb, n0 = (r % nb) * 32; p0_transpose_item(F.in[I_WGU1], DM, 2 * DFF, F.in[I_NFFN1], wgu1, kb * 64, n0, map_gu(n0), scr, lane); continue; } r -= I_GU;
        if (r < I_GU) { const int nb = 2 * DFF / 32, kb = r / nb, n0 = (r % nb) * 32; p0_transpose_item(F.in[I_WGU2], DM, 2 * DFF, F.in[I_NFFN2], wgu2, kb * 64, n0, map_gu(n0), scr, lane); continue; } r -= I_GU;
        if (r < I_D) { const int nb = DM / 32, kb = r / nb, n0 = (r % nb) * 32; p0_transpose_item(F.in[I_WD1], DFF, DM, nullptr, wd1, kb * 64, n0, n0, scr, lane); continue; } r -= I_D;
        if (r < I_D) { const int nb = DM / 32, kb = r / nb, n0 = (r % nb) * 32; p0_transpose_item(F.in[I_WD2], DFF, DM, nullptr, wd2, kb * 64, n0, n0, scr, lane); continue; } r -= I_D;
        if (r < I_IN) { const int nb = IN_DIM / 32, kb = r / nb, n0 = (r % nb) * 32; p0_transpose_item(F.in[I_WIN], DM, IN_DIM, F.in[I_NMIX], win, kb * 64, n0, map_win(n0), scr, lane); continue; } r -= I_IN;
        if (r < I_SSO) { const int nb = DM / 32, kb = r / nb, n0 = (r % nb) * 32; p0_transpose_item(F.in[I_WSSO], DI, DM, F.in[I_NSSD], wsso, kb * 64, n0, n0, scr, lane); continue; } r -= I_SSO;
        if (r < I_SQ) { const int nb = DM / 32, kb = r / nb, n0 = (r % nb) * 32; p0_transpose_item(F.in[I_WO], DM, DM, nullptr, wo, kb * 64, n0, n0, scr, lane); continue; } r -= I_SQ;
        if (r < I_SQ) { const int nb = DM / 32, kb = r / nb, n0 = (r % nb) * 32; p0_transpose_item(F.in[I_WPG], DM, DM, F.in[I_NPLE], wpg, kb * 64, n0, n0, scr, lane); continue; } r -= I_SQ;
        if (r < I_SQ) { const int nb = DM / 32, kb = r / nb, n0 = (r % nb) * 32; p0_transpose_item(F.in[I_WPOUT], PD, DM, F.in[I_PSCALE], wpot, kb * 64, n0, n0, scr, lane); continue; } r -= I_SQ;
        { const int nb = DM / 32, kb = r / nb, n0 = (r % nb) * 32; p0_transpose_item(F.in[I_WPLE], PLE, DM, nullptr, wple, kb * 64, n0, n0, scr, lane); }
    }
    {
        bf16_t* const wgrp = (bf16_t*)(F.ws + WS_WGRP); const float* Wg = F.in[I_WPGRP];
        for (int e = F.vcu * NTHREADS + F.tid; e < 4 * 256 * 256 / 8; e += F.G * NTHREADS) {
            const f32x4 a = *(const GAS f32x4*)(Wg + (size_t)e * 8), b = *(const GAS f32x4*)(Wg + (size_t)e * 8 + 4);
            u32x4 o; o.x = pk2(a.x, a.y); o.y = pk2(a.z, a.w); o.z = pk2(b.x, b.y); o.w = pk2(b.z, b.w);
            *(GAS u32x4*)(wgrp + (size_t)e * 8) = o; }
    }
    {
        bf16_t* const XB = (bf16_t*)(F.ws + WS_XB); bf16_t* const PB = (bf16_t*)(F.ws + WS_PB); float* const stA = (float*)(F.ws + WS_STATS_A);
        for (int m = gw; m < M; m += NGW) {
            const float* xrow = (m < MP) ? F.in[I_XP] + (size_t)m * DM : F.in[I_XS] + (size_t)(m - MP) * DM;
            const GAS f32x4* xr = (const GAS f32x4*)xrow + lane;
            f32x4 v[4]; float s = 0.f;
#pragma unroll
            for (int j = 0; j < 4; ++j) { v[j] = xr[64 * j]; s += (v[j].x * v[j].x + v[j].y * v[j].y) + (v[j].z * v[j].z + v[j].w * v[j].w); }
            s = wave_sum(s);
            GAS u32x2* o8 = (GAS u32x2*)(XB + (size_t)m * DM) + lane;
#pragma unroll
            for (int j = 0; j < 4; ++j) { u32x2 w; w.x = pk2(v[j].x, v[j].y); w.y = pk2(v[j].z, v[j].w); o8[64 * j] = w; }
            if (lane < 16) *(GAS float*)(stA + (size_t)m * 16 + lane) = (lane == 0) ? s : 0.f;
            const float* prow = (m < MP) ? F.in[I_PP] + (size_t)m * PLE : F.in[I_PS] + (size_t)(m - MP) * PLE;
            const f32x4 pv = *((const GAS f32x4*)prow + lane);
            u32x2 w; w.x = pk2(pv.x, pv.y); w.y = pk2(pv.z, pv.w); *((GAS u32x2*)(PB + (size_t)m * PLE) + lane) = w;
        }
    }
}


typedef short v4i16_t __attribute__((ext_vector_type(4)));
constexpr int IMG_B = 0, IMG_C = 32768, IMG_X = 65536, TAB_ACS = RING_BYTES + 1024, TAB_DT = TAB_ACS + 2048, TAB_SD = TAB_DT + 2048;
constexpr int NCHUNK = SEQ / 128;
template <bool XS> __device__ __forceinline__ int img_off(int row, int ch) { return XS ? 256 * row + 16 * (ch ^ ((row & 7) << 1)) : 256 * row + 16 * (ch ^ (((row & 3) << 2) | ((row >> 2) & 3))); }
__device__ __forceinline__ bf16x8 tr_pair(const LAS unsigned char* p0, const LAS unsigned char* p1) {
    const v4i16_t a = __builtin_amdgcn_ds_read_tr16_b64_v4i16((LAS v4i16_t*)p0), b = __builtin_amdgcn_ds_read_tr16_b64_v4i16((LAS v4i16_t*)p1);
    return (bf16x8){a[0], a[1], a[2], a[3], b[0], b[1], b[2], b[3]};
}
__device__ __forceinline__ void ssd_tables(Frame& F, size_t row0, int g) {
    LAS float* const acs = (LAS float*)(F.lds + TAB_ACS); LAS float* const dtl = (LAS float*)(F.lds + TAB_DT); LAS float* const sdec = (LAS float*)(F.lds + TAB_SD);
    const float* const DT = (const float*)(F.ws + WS_DT);
    if (F.wave < 4) {
        const int r = F.wave, lane = F.lane, head = g * HPG + r;
        const float Ah = -__expf(*(const GAS float*)(F.in[I_ALOG] + head));
        const float d0 = *(const GAS float*)(DT + (row0 + 2 * lane) * 32 + head), d1 = *(const GAS float*)(DT + (row0 + 2 * lane + 1) * 32 + head);
        const float a0 = d0 * Ah, a1 = d1 * Ah, loc = a0 + a1;
        float inc = loc;
#pragma unroll
        for (int o = 1; o < 64; o <<= 1) { const float t = __shfl_up(inc, o); if (lane >= o) inc += t; }
        const float exc = inc - loc;
        acs[(2 * lane) * 4 + r] = exc + a0; acs[(2 * lane + 1) * 4 + r] = inc;
        dtl[(2 * lane) * 4 + r] = d0; dtl[(2 * lane + 1) * 4 + r] = d1;
    }
    __syncthreads();
    { const int s = F.tid >> 2, r = F.tid & 3; sdec[s * 4 + r] = __expf(acs[127 * 4 + r] - acs[s * 4 + r]) * dtl[s * 4 + r]; }
    __syncthreads();
}
template <bool WITH_C, bool SCALE_X> __device__ __forceinline__ void ssd_fill(Frame& F, size_t row0, int c, int g) {
    const int t = F.tid;
    int kind, cc, run;
    if (t < 256) { kind = 0; cc = t & 31; run = t >> 5; } else if (t < 384) { kind = 1; cc = (t - 256) & 15; run = (t - 256) >> 4; } else { kind = 2; cc = (t - 384) & 15; run = (t - 384) >> 4; }
    if (!WITH_C && kind == 2) return;
    const int gch = (kind == 0 ? g * 256 : (kind == 1 ? DI + g * DSTATE : DI + NG * DSTATE + g * DSTATE)) + 8 * cc;
    const bf16_t* const XBC = (const bf16_t*)(F.ws + WS_XBC);
    const float* const convw = F.in[I_CONVW]; const float* const convb = F.in[I_CONVB];
    float cw[4][8], cb[8];
#pragma unroll
    for (int k = 0; k < 4; ++k) { const f32x4 a = *(const GAS f32x4*)(convw + (size_t)k * CD + gch), b = *(const GAS f32x4*)(convw + (size_t)k * CD + gch + 4);
        cw[k][0] = a.x; cw[k][1] = a.y; cw[k][2] = a.z; cw[k][3] = a.w; cw[k][4] = b.x; cw[k][5] = b.y; cw[k][6] = b.z; cw[k][7] = b.w; }
    { const f32x4 a = *(const GAS f32x4*)(convb + gch), b = *(const GAS f32x4*)(convb + gch + 4); cb[0] = a.x; cb[1] = a.y; cb[2] = a.z; cb[3] = a.w; cb[4] = b.x; cb[5] = b.y; cb[6] = b.z; cb[7] = b.w; }
    u32x4 raw[19];
    const bool first = (c == 0 && run == 0);
#pragma unroll
    for (int i = 0; i < 19; ++i) { if (i < 3 && first) raw[i] = (u32x4){0u, 0u, 0u, 0u}; else raw[i] = *(const GAS u32x4*)(XBC + (row0 + 16 * run + i - 3) * CD + gch); }
    LAS unsigned char* const img = F.lds + (kind == 0 ? IMG_X + (cc >> 4) * 32768 : (kind == 1 ? IMG_B : IMG_C));
    const LAS float* const sdec = (const LAS float*)(F.lds + TAB_SD);
    const int chl = cc & 15, hr = cc >> 3;
#pragma unroll
    for (int i = 0; i < 16; ++i) {
        const int s = 16 * run + i;
        float o[8];
#pragma unroll
        for (int j2 = 0; j2 < 4; ++j2) {
            const unsigned w0 = raw[i][j2], w1 = raw[i + 1][j2], w2 = raw[i + 2][j2], w3 = raw[i + 3][j2];
            const float lo = cb[2 * j2] + cw[0][2 * j2] * bflo(w0) + cw[1][2 * j2] * bflo(w1) + cw[2][2 * j2] * bflo(w2) + cw[3][2 * j2] * bflo(w3);
            const float hi = cb[2 * j2 + 1] + cw[0][2 * j2 + 1] * bfhi(w0) + cw[1][2 * j2 + 1] * bfhi(w1) + cw[2][2 * j2 + 1] * bfhi(w2) + cw[3][2 * j2 + 1] * bfhi(w3);
            o[2 * j2] = silu_f(lo); o[2 * j2 + 1] = silu_f(hi);
        }
        if (SCALE_X && kind == 0) { const float sc = sdec[s * 4 + hr];
#pragma unroll
            for (int j = 0; j < 8; ++j) o[j] *= sc; }
        u32x4 pk; pk.x = cvt_pk_bf16(o[0], o[1]); pk.y = cvt_pk_bf16(o[2], o[3]); pk.z = cvt_pk_bf16(o[4], o[5]); pk.w = cvt_pk_bf16(o[6], o[7]);
        const int off = (kind == 0 && !SCALE_X) ? img_off<true>(s, chl) : img_off<false>(s, chl);
        *(LAS u32x4*)(img + off) = pk;
    }
}
__device__ __forceinline__ void ssd_states_phase(Frame& F) {
    float* const ST = F.out + O_SSM_S;
    float* const CDEC = (float*)(F.ws + WS_CDEC);
    const int w = F.wave, lane = F.lane, ql = lane & 15, gq = lane >> 4, qq = ql >> 2, pp = ql & 3, r = w >> 1, nh = w & 1;
    for (int it = F.vcu; it < BATCH * NCHUNK * NG; it += F.G) {
        const int g = it & 7, c = (it >> 3) & (NCHUNK - 1), b = it >> 7;
        const size_t row0 = (size_t)b * SEQ + (size_t)c * 128;
        ssd_tables(F, row0, g);
        ssd_fill<false, true>(F, row0, c, g);
        __syncthreads();
        f32x4 acc[4][4];
#pragma unroll
        for (int i = 0; i < 4; ++i)
#pragma unroll
            for (int j = 0; j < 4; ++j) acc[i][j] = (f32x4){0.f, 0.f, 0.f, 0.f};
        const LAS unsigned char* const bimg = F.lds + IMG_B; const LAS unsigned char* const ximg = F.lds + IMG_X + (r >> 1) * 32768;
#pragma unroll
        for (int ks = 0; ks < 4; ++ks) {
            bf16x8 af[4], xf[4];
            const int rw0 = 32 * ks + 8 * gq + qq;
#pragma unroll
            for (int nf = 0; nf < 4; ++nf) { const int col = 64 * nh + 16 * nf + 4 * pp;
                af[nf] = tr_pair(bimg + img_off<false>(rw0, col >> 3) + 2 * (col & 7), bimg + img_off<false>(rw0 + 4, col >> 3) + 2 * (col & 7)); }
#pragma unroll
            for (int pf = 0; pf < 4; ++pf) { const int col = 64 * (r & 1) + 16 * pf + 4 * pp;
                xf[pf] = tr_pair(ximg + img_off<false>(rw0, col >> 3) + 2 * (col & 7), ximg + img_off<false>(rw0 + 4, col >> 3) + 2 * (col & 7)); }
#pragma unroll
            for (int nf = 0; nf < 4; ++nf)
#pragma unroll
                for (int pf = 0; pf < 4; ++pf) acc[nf][pf] = __builtin_amdgcn_mfma_f32_16x16x32_bf16(af[nf], xf[pf], acc[nf][pf], 0, 0, 0);
        }
        const int head = g * HPG + r;
        float* const stp = ST + ((((size_t)b * NCHUNK + c) * NH + head) * HD) * DSTATE;
#pragma unroll
        for (int pf = 0; pf < 4; ++pf)
#pragma unroll
            for (int nf = 0; nf < 4; ++nf) *(GAS f32x4*)(stp + (size_t)(16 * pf + ql) * DSTATE + 64 * nh + 16 * nf + 4 * gq) = acc[nf][pf];
        if (F.tid < 4) { const LAS float* acs = (const LAS float*)(F.lds + TAB_ACS); *(GAS float*)(CDEC + ((size_t)b * NCHUNK + c) * NH + g * HPG + F.tid) = __expf(acs[127 * 4 + F.tid]); }
        __syncthreads();
    }
}
__device__ __forceinline__ void ssd_scan_phase(Frame& F) {
    const float* const ST = F.out + O_SSM_S; const float* const CDEC = (const float*)(F.ws + WS_CDEC);
    bf16_t* const HP = (bf16_t*)(F.ws + WS_HPREV); float* const hout = F.out + O_SSM_P;
    const int gt = F.vcu * NTHREADS + F.tid, NT = F.G * NTHREADS;
    constexpr int PER = NH * HD * DSTATE / 4;
    for (int e = gt; e < BATCH * PER; e += NT) {
        const int b = e / PER, i4 = e % PER, head = i4 / (HD * DSTATE / 4);
        f32x4 h = (f32x4){0.f, 0.f, 0.f, 0.f};
        f32x4 stv[NCHUNK];
#pragma unroll
        for (int c = 0; c < NCHUNK; ++c) stv[c] = *(const GAS f32x4*)(ST + ((size_t)b * NCHUNK + c) * (size_t)(PER * 4) + (size_t)i4 * 4);
#pragma unroll
        for (int c = 0; c < NCHUNK; ++c) {
            if (c > 0) { u32x2 o; o.x = cvt_pk_bf16(h.x, h.y); o.y = cvt_pk_bf16(h.z, h.w); *(GAS u32x2*)(HP + ((size_t)b * NCHUNK + c) * (size_t)(PER * 4) + (size_t)i4 * 4) = o; }
            const float d = *(const GAS float*)(CDEC + ((size_t)b * NCHUNK + c) * NH + head);
            h = h * d + stv[c];
        }
        *(GAS f32x4*)(hout + (size_t)b * (PER * 4) + (size_t)i4 * 4) = h;
    }
}
__device__ __forceinline__ void ssd_out_phase(Frame& F) {
    const bf16_t* const HP = (const bf16_t*)(F.ws + WS_HPREV); bf16_t* const ZY = (bf16_t*)(F.ws + WS_Z);
    const int w = F.wave, lane = F.lane, ql = lane & 15, gq = lane >> 4, qq = ql >> 2, pp = ql & 3, q0 = 16 * w;
    const LAS float* const acs = (const LAS float*)(F.lds + TAB_ACS); const LAS float* const dtl = (const LAS float*)(F.lds + TAB_DT);
    int cfo[4], bbo[4], xbo[2][4];
#pragma unroll
    for (int ks = 0; ks < 4; ++ks) { cfo[ks] = IMG_C + img_off<false>(q0 + ql, 4 * ks + gq); bbo[ks] = IMG_B + img_off<false>(ql, 4 * ks + gq); }
#pragma unroll
    for (int rr = 0; rr < 2; ++rr)
#pragma unroll
        for (int pf = 0; pf < 4; ++pf) xbo[rr][pf] = IMG_X + img_off<true>(4 * gq + qq, 8 * rr + 2 * pf + (pp >> 1)) + 8 * (pp & 1);
    for (int it = F.vcu; it < BATCH * NCHUNK * NG; it += F.G) {
        const int g = it & 7, c = (it >> 3) & (NCHUNK - 1), b = it >> 7;
        const size_t row0 = (size_t)b * SEQ + (size_t)c * 128;
        ssd_tables(F, row0, g);
        ssd_fill<true, false>(F, row0, c, g);
        __syncthreads();
        bf16x8 cf[4];
#pragma unroll
        for (int ks = 0; ks < 4; ++ks) cf[ks] = *(const LAS bf16x8*)(F.lds + cfo[ks]);
        bf16_t* const zp = ZY + (row0 + q0 + ql) * DI + g * 256 + 4 * gq;
        const bf16_t* const hpb = HP + ((((size_t)b * NCHUNK + c) * NH + g * HPG) * HD + ql) * DSTATE + 8 * gq;
        const LAS float* const acs_l = acs + 16 * gq; const LAS float* const dtl_l = dtl + 16 * gq;
        f32x4 acc[4][4];
        float aq[4];
#pragma unroll
        for (int r = 0; r < 4; ++r) { aq[r] = acs[(q0 + ql) * 4 + r];
            const float eaq = __expf(aq[r]);
#pragma unroll
            for (int pf = 0; pf < 4; ++pf) { f32x4 yo = (f32x4){0.f, 0.f, 0.f, 0.f};
                if (c > 0) {
#pragma unroll
                    for (int ks = 0; ks < 4; ++ks) { const bf16x8 hf_ = *(const GAS bf16x8*)(hpb + (size_t)(r * HD + 16 * pf) * DSTATE + 32 * ks); yo = __builtin_amdgcn_mfma_f32_16x16x32_bf16(hf_, cf[ks], yo, 0, 0, 0); } }
                acc[r][pf] = yo * eaq; }
            asm volatile("" ::: "memory"); }
#pragma unroll
        for (int ks = 0; ks < 4; ++ks) if (2 * ks <= w) {
            f32x4 cb[2];
#pragma unroll
            for (int hf = 0; hf < 2; ++hf) { cb[hf] = (f32x4){0.f, 0.f, 0.f, 0.f};
                if (2 * ks + hf <= w) {
#pragma unroll
                    for (int kn = 0; kn < 4; ++kn) { const bf16x8 bfr = *(const LAS bf16x8*)(F.lds + bbo[kn] + 4096 * (2 * ks + hf)); cb[hf] = __builtin_amdgcn_mfma_f32_16x16x32_bf16(bfr, cf[kn], cb[hf], 0, 0, 0); } } }
#pragma unroll
            for (int r = 0; r < 4; ++r) {
                const float Dh = *(const GAS float*)(F.in[I_DSKIP] + g * HPG + r);
                float v[8];
#pragma unroll
                for (int hf = 0; hf < 2; ++hf) { const int sf = 2 * ks + hf;
#pragma unroll
                    for (int rg = 0; rg < 4; ++rg) { const int sl = 4 * gq + rg;
                        float val = 0.f;
                        if (sf <= w) { const float as = acs_l[64 * sf + 4 * rg + r], d = dtl_l[64 * sf + 4 * rg + r];
                            val = cb[hf][rg] * __expf(aq[r] - as) * d;
                            if (sf == w) { if (sl > ql) val = 0.f; else if (sl == ql) val += Dh; } }
                        v[4 * hf + rg] = val; } }
                u32x4 pk; pk.x = cvt_pk_bf16(v[0], v[1]); pk.y = cvt_pk_bf16(v[2], v[3]); pk.z = cvt_pk_bf16(v[4], v[5]); pk.w = cvt_pk_bf16(v[6], v[7]);
                const bf16x8 wf = __builtin_bit_cast(bf16x8, pk);
#pragma unroll
                for (int pf = 0; pf < 4; ++pf) {
                    const LAS unsigned char* const xb = F.lds + xbo[r & 1][pf] + (r >> 1) * 32768 + 8192 * ks;
                    const bf16x8 xf = tr_pair(xb, xb + 4096);
                    acc[r][pf] = __builtin_amdgcn_mfma_f32_16x16x32_bf16(xf, wf, acc[r][pf], 0, 0, 0); }
            }
        }
        float ssum = 0.f;
#pragma unroll
        for (int r = 0; r < 4; ++r)
#pragma unroll
            for (int pf = 0; pf < 4; ++pf) {
                const u32x2 zz = *(const GAS u32x2*)(zp + r * 64 + 16 * pf);
                const f32x4 y = acc[r][pf] * (f32x4){bflo(zz.x), bfhi(zz.x), bflo(zz.y), bfhi(zz.y)};
                acc[r][pf] = y; ssum += (y[0] * y[0] + y[1] * y[1]) + (y[2] * y[2] + y[3] * y[3]); }
        ssum += __shfl_xor(ssum, 16); ssum += __shfl_xor(ssum, 32);
        const float rsn = __builtin_amdgcn_rsqf(ssum * (1.0f / 256.0f) + EPS);
#pragma unroll
        for (int r = 0; r < 4; ++r)
#pragma unroll
            for (int pf = 0; pf < 4; ++pf) { u32x2 o; o.x = cvt_pk_bf16(acc[r][pf][0] * rsn, acc[r][pf][1] * rsn); o.y = cvt_pk_bf16(acc[r][pf][2] * rsn, acc[r][pf][3] * rsn);
                *(GAS u32x2*)(zp + r * 64 + 16 * pf) = o; }
        __syncthreads();
    }
}

__device__ __forceinline__ void ssd_seq_phase(Frame& F) {
    const int r = F.wave & 3, nh = F.wave >> 2, lane = F.lane, idx = r * 64 + lane;
    LAS float* const bc = (LAS float*)F.lds;
    LAS float* const lxs = bc + 2048;
    LAS float* const yp = bc + 4096;
    LAS float* const ldt = bc + 8192; LAS float* const ssq = bc + 8192 + 32;
    const bf16_t* const XBC = (const bf16_t*)(F.ws + WS_XBC); const bf16_t* const Zs = (const bf16_t*)(F.ws + WS_Z); bf16_t* const YN = (bf16_t*)(F.ws + WS_Z);
    const float* const DT = (const float*)(F.ws + WS_DT);
    const float* const convw = F.in[I_CONVW]; const float* const convb = F.in[I_CONVB];
    for (int it = F.vcu; it < DECB * NG; it += F.G) {
        const int b = it >> 3, g = it & 7, head = g * HPG + r;
        const size_t row0 = (size_t)MP + (size_t)b * DECS;
        const int xch = g * 256 + idx;
        {
            const int ch = (nh == 0) ? ((idx < 128) ? (DI + g * DSTATE + idx) : (DI + NG * DSTATE + g * DSTATE + (idx - 128))) : xch;
            float cw[4];
#pragma unroll
            for (int k = 0; k < 4; ++k) cw[k] = *(const GAS float*)(convw + (size_t)k * CD + ch);
            const float cbv = *(const GAS float*)(convb + ch);
            const float* cs = F.in[I_CONV] + (size_t)b * 3 * CD;
            float x3 = *(const GAS float*)(cs + ch), x2 = *(const GAS float*)(cs + CD + ch), x1 = *(const GAS float*)(cs + 2 * CD + ch);
            LAS float* const dst = (nh == 0) ? bc : lxs;
#pragma unroll
            for (int j = 0; j < 8; ++j) {
                const float xr = bf2f(*(const GAS bf16_t*)(XBC + (row0 + j) * CD + ch));
                const float cx = cbv + cw[0] * x3 + cw[1] * x2 + cw[2] * x1 + cw[3] * xr; x3 = x2; x2 = x1; x1 = xr;
                dst[j * 256 + idx] = silu_f(cx);
            }
            if (nh == 1 && lane < 8) ldt[lane * 4 + r] = *(const GAS float*)(DT + (row0 + lane) * 32 + head);
        }
        __syncthreads();
        {
            const float Ah = -__expf(*(const GAS float*)(F.in[I_ALOG] + head));
            float h[64];
            const GAS f32x4* hp = (const GAS f32x4*)(F.in[I_SSM] + (((size_t)b * NH + head) * HD + lane) * DSTATE + 64 * nh);
#pragma unroll
            for (int n = 0; n < 16; ++n) { const f32x4 v = hp[n]; h[4 * n] = v.x; h[4 * n + 1] = v.y; h[4 * n + 2] = v.z; h[4 * n + 3] = v.w; }
            for (int j = 0; j < 8; ++j) {
                const float xsv = lxs[j * 256 + idx], dtv = ldt[j * 4 + r];
                const float dA = __expf(dtv * Ah), dx = dtv * xsv;
                const LAS f32x4* Bp = (const LAS f32x4*)(bc + j * 256 + 64 * nh); const LAS f32x4* Cp = Bp + 32;
                float y0 = 0.f, y1 = 0.f;
#pragma unroll
                for (int n8 = 0; n8 < 4; ++n8) {
#pragma unroll
                    for (int n = 4 * n8; n < 4 * n8 + 4; ++n) { const f32x4 Bv = Bp[n], Cv = Cp[n];
                        h[4 * n] = dA * h[4 * n] + dx * Bv.x; y0 += Cv.x * h[4 * n];
                        h[4 * n + 1] = dA * h[4 * n + 1] + dx * Bv.y; y1 += Cv.y * h[4 * n + 1];
                        h[4 * n + 2] = dA * h[4 * n + 2] + dx * Bv.z; y0 += Cv.z * h[4 * n + 2];
                        h[4 * n + 3] = dA * h[4 * n + 3] + dx * Bv.w; y1 += Cv.w * h[4 * n + 3]; }
                    asm volatile("" ::: "memory");
                }
                yp[(j * 2 + nh) * 256 + idx] = y0 + y1;
            }
            float* hout = F.out + O_SSM_S + (((size_t)b * NH + head) * HD + lane) * DSTATE + 64 * nh;
#pragma unroll
            for (int n = 0; n < 16; ++n) *((GAS f32x4*)hout + n) = (f32x4){h[4 * n], h[4 * n + 1], h[4 * n + 2], h[4 * n + 3]};
        }
        __syncthreads();
        float ygv[4];
        {
            const float Dh = *(const GAS float*)(F.in[I_DSKIP] + head);
#pragma unroll
            for (int jj = 0; jj < 4; ++jj) { const int j = 4 * nh + jj;
                const float y = (yp[(j * 2) * 256 + idx] + yp[(j * 2 + 1) * 256 + idx]) + Dh * lxs[j * 256 + idx];
                ygv[jj] = y * bf2f(*(const GAS bf16_t*)(Zs + (row0 + j) * DI + xch));
                const float ss = wave_sum(ygv[jj] * ygv[jj]);
                if (lane == 0) ssq[j * 4 + r] = ss; }
        }
        __syncthreads();
#pragma unroll
        for (int jj = 0; jj < 4; ++jj) { const int j = 4 * nh + jj;
            const f32x4 s4 = *(const LAS f32x4*)(ssq + j * 4);
            const float rsn = __builtin_amdgcn_rsqf(((s4.x + s4.y) + (s4.z + s4.w)) * (1.0f / 256.0f) + EPS);
            *(GAS bf16_t*)(YN + (row0 + j) * DI + xch) = (bf16_t)f2bf(ygv[jj] * rsn); }
        __syncthreads();
    }
}
template <int W> __device__ __forceinline__ void pool_run(const bf16_t* V, bf16_t* PO, int run, int cv) {
    const int row0 = run * 16, t0 = row0 & (SEQ - 1);
    u32x4 raw[16 + W - 1];
#pragma unroll
    for (int e = 0; e < 16 + W - 1; ++e) {
        const int dt_ = e - (W - 1);
        if (t0 + dt_ >= 0) raw[e] = *(const GAS u32x4*)(V + (size_t)(row0 + dt_) * PD + cv); else raw[e] = (u32x4){0u, 0u, 0u, 0u};
    }
    f32x4 s0 = (f32x4){0.f, 0.f, 0.f, 0.f}, s1 = s0;
#pragma unroll
    for (int e = 0; e < W - 1; ++e) { f32x4 x0, x1; pg8::unpack8(raw[e], x0, x1); s0 += x0; s1 += x1; }
#pragma unroll
    for (int i = 0; i < 16; ++i) {
        f32x4 c0, c1; pg8::unpack8(raw[i + W - 1], c0, c1);
        s0 += c0; s1 += c1;
        const int t = t0 + i; const float ic = 1.0f / (float)((t + 1 < W) ? t + 1 : W);
        const f32x4 o0 = s0 * ic - c0, o1 = s1 * ic - c1;
        u32x4 o; o.x = pk2(o0.x, o0.y); o.y = pk2(o0.z, o0.w); o.z = pk2(o1.x, o1.y); o.w = pk2(o1.z, o1.w);
        *(GAS u32x4*)(PO + (size_t)(row0 + i) * PD + cv) = o;
        f32x4 x0, x1; pg8::unpack8(raw[i], x0, x1); s0 -= x0; s1 -= x1;
    }
}
__device__ __forceinline__ void pool_phase(Frame& F) {
    const bf16_t* const V = (const bf16_t*)(F.ws + WS_V); bf16_t* const PO = (bf16_t*)(F.ws + WS_POOLED);
    const float* const sp = F.in[I_POOL];
    const int gt = F.vcu * NTHREADS + F.tid, NT = F.G * NTHREADS;
    for (int e = gt; e < (MP / 16) * 128; e += NT) {
        const int c32 = e & 31, rl = (e >> 5) & 1, grp = (e >> 6) & 3, run = (e >> 8) * 2 + rl, cv = (grp * 32 + c32) * 8;
        if (grp == 0) pool_run<2>(V, PO, run, cv); else if (grp == 1) pool_run<4>(V, PO, run, cv); else if (grp == 2) pool_run<8>(V, PO, run, cv); else pool_run<16>(V, PO, run, cv);
    }
    for (int e = gt; e < MS * 128; e += NT) {
        const int row = MP + (e >> 7), cv = (e & 127) * 8, w = 2 << (cv >> 8);
        const int rr = row - MP, b = rr >> 3, t = rr & 7;
        float s[8];
#pragma unroll
        for (int j = 0; j < 8; ++j) s[j] = 0.f;
        f32x4 c0, c1; pg8::unpack8(*(const GAS u32x4*)(V + (size_t)row * PD + cv), c0, c1);
        for (int k = 0; k < w; ++k) { const int tt = t - k; f32x4 a0, a1;
            if (tt >= 0) pg8::unpack8(*(const GAS u32x4*)(V + (size_t)(row - k) * PD + cv), a0, a1);
            else { const float* p = sp + ((size_t)b * PBUF + (PBUF + tt)) * PD + cv; a0 = *(const GAS f32x4*)p; a1 = *(const GAS f32x4*)(p + 4); }
            s[0] += a0.x; s[1] += a0.y; s[2] += a0.z; s[3] += a0.w; s[4] += a1.x; s[5] += a1.y; s[6] += a1.z; s[7] += a1.w; }
        const float ic = 1.0f / (float)w;
        f32x4 o0 = (f32x4){s[0] * ic, s[1] * ic, s[2] * ic, s[3] * ic} - c0, o1 = (f32x4){s[4] * ic, s[5] * ic, s[6] * ic, s[7] * ic} - c1;
        u32x4 o; o.x = pk2(o0.x, o0.y); o.y = pk2(o0.z, o0.w); o.z = pk2(o1.x, o1.y); o.w = pk2(o1.z, o1.w);
        *(GAS u32x4*)(PO + (size_t)row * PD + cv) = o;
    }
    float* const ops = F.out + O_POOL_S;
    for (int e = gt; e < DECB * 7 * (PD / 4); e += NT) {
        const int c4 = e & 255, i = (e >> 8) % 7, b = (e >> 8) / 7;
        *(GAS f32x4*)(ops + ((size_t)b * PBUF + i) * PD + c4 * 4) = *(const GAS f32x4*)(sp + ((size_t)b * PBUF + 8 + i) * PD + c4 * 4);
    }
}
__device__ __forceinline__ void final_phase(Frame& F) {
    const int gw = F.vcu * NWAVES + F.wave, NGW = F.G * NWAVES, lane = F.lane;
    const float* const st = (const float*)(F.ws + WS_STATS_A); const float* const gf = F.in[I_NFINAL];
    f32x4 gv[4];
#pragma unroll
    for (int j = 0; j < 4; ++j) gv[j] = *((const GAS f32x4*)gf + lane + 64 * j);
    for (int m = gw; m < M; m += NGW) {
        const GAS f32x4* sp = (const GAS f32x4*)(st + (size_t)m * 16);
        const f32x4 a = sp[0], b = sp[1], c = sp[2], d = sp[3]; const f32x4 s = (a + b) + (c + d);
        const float rs = __builtin_amdgcn_rsqf(((s[0] + s[1]) + (s[2] + s[3])) * (1.0f / 1024.0f) + EPS);
        GAS f32x4* yr = (GAS f32x4*)(F.out + (size_t)m * DM) + lane;
#pragma unroll
        for (int j = 0; j < 4; ++j) yr[64 * j] = yr[64 * j] * rs * gv[j];
    }
}

constexpr int NPHASES = 15;
struct Args { const float* in[30]; float* out; unsigned char* ws; int ph_lo, ph_hi, li, pad; };
__global__ void __launch_bounds__(NTHREADS, 2) mk_fwd(Args args) {
    extern __shared__ __attribute__((aligned(16))) unsigned char lds[];
    Frame F;
    F.lds = (LAS unsigned char*)lds;
    F.MISC = (volatile LAS unsigned*)(F.lds + MISC_OFF);
    F.tid = threadIdx.x; F.lane = F.tid & 63; F.wave = __builtin_amdgcn_readfirstlane(F.tid >> 6);
    F.G = gridDim.x; { const int bx = blockIdx.x; F.vcu = (F.G % 8 == 0) ? (bx % 8) * (F.G / 8) + bx / 8 : bx; }
    F.ws = args.ws; F.out = args.out; F.ctl = (gu32*)(args.ws + WS_CTL);
#pragma unroll
    for (int i = 0; i < 30; ++i) F.in[i] = args.in[i];
    for (int u = F.tid; u < (LDS_BYTES - LDSCTL_OFF) / 4; u += NTHREADS) ((LAS unsigned*)(F.lds + LDSCTL_OFF))[u] = 0u;
    __syncthreads();
    const int lo = args.ph_lo, hi = args.ph_hi;
    XcdBarrier bar; bar.bar = (unsigned*)(F.ctl + CW_BAR); bar.x = 0; bar.st = nullptr;
    if (hi - lo > 1) bar = xcd_barrier_post((unsigned*)(F.ctl + CW_BAR), F.MISC + 8);
#ifndef PHMASK
#define PHMASK 0x7fff
#endif
#define IN(k) (((PHMASK >> (k)) & 1) && lo <= (k) && (k) < hi)
#define SEAM(k) do { if (IN(k) && IN((k) + 1)) xcd_barrier(bar); } while (0)
#define PH_BEGIN(k) if (IN(k)) { auto body_ = [&]() __attribute__((always_inline))
#define PH_END(k) ; body_(); if ((REP_MASK >> (k)) & 1) { xcd_barrier(bar); body_(); } } SEAM(k);

    bf16_t* const XB = (bf16_t*)(F.ws + WS_XB); bf16_t* const HB = (bf16_t*)(F.ws + WS_HB); bf16_t* const ACT = (bf16_t*)(F.ws + WS_ACT);
    bf16_t* const Zb = (bf16_t*)(F.ws + WS_Z); bf16_t* const XBCb = (bf16_t*)(F.ws + WS_XBC); bf16_t* const Vb = (bf16_t*)(F.ws + WS_V); bf16_t* const GATES = (bf16_t*)(F.ws + WS_GATES);
    bf16_t* const POOLED = (bf16_t*)(F.ws + WS_POOLED); bf16_t* const MERGED = (bf16_t*)(F.ws + WS_MERGED); bf16_t* const Qb = (bf16_t*)(F.ws + WS_Q); bf16_t* const PB = (bf16_t*)(F.ws + WS_PB);
    float* const T1 = (float*)(F.ws + WS_T1); float* const stA = (float*)(F.ws + WS_STATS_A); float* const stB = (float*)(F.ws + WS_STATS_B); float* const DTb = (float*)(F.ws + WS_DT);
    float* const H = F.out + O_Y;
    pg8::StaticOrder S;

    PH_BEGIN(0) { p0_prologue(F); } PH_END(0)
    PH_BEGIN(1) {
        pg8::Gemm g{XB, (const bf16_t*)(F.ws + WS_WGU1), M, 2 * DFF, DM, DM, 0}; S.init(M, 2 * DFF, F.G, (int)blockIdx.x);
        pg8::Epi E{}; E.kind = pg8::EK_GU; E.stats_in = stA; E.obf = ACT; E.ldo = DFF;
        pg8::gemm_phase(F.lds, g, S, E);
        pg8::Gemm g2{(const bf16_t*)(F.ws + WS_WPOT), (const bf16_t*)(F.ws + WS_WGRP), DM, DM, 256, DM, 256}; S.init_tail(DM, DM, F.G, (int)blockIdx.x);
        pg8::Epi E2{}; E2.kind = pg8::EK_BF16; E2.obf = (bf16_t*)(F.ws + WS_W2); E2.ldo = DM;
        pg8::gemm_phase(F.lds, g2, S, E2);
    } PH_END(1)
    PH_BEGIN(2) {
        pg8::Gemm g{ACT, (const bf16_t*)(F.ws + WS_WD1), M, DM, DFF, DFF, 0}; S.init(MP, DM, F.G, (int)blockIdx.x);
        pg8::Epi E{}; E.kind = pg8::EK_RES; E.coef = 0.5f; E.res_p = F.in[I_XP]; E.res_s = F.in[I_XS]; E.of32 = H; E.obf = HB; E.stats_out = stB;
        pg8::gemm_phase(F.lds, g, S, E);
        pg8::gemm_small(F.lds, g, E, MP, MS, F.G, (int)blockIdx.x);
    } PH_END(2)
    PH_BEGIN(3) {
        pg8::Gemm g{HB, (const bf16_t*)(F.ws + WS_WIN), M, NIN, DM, DM, 0}; S.init(M, NIN, F.G, (int)blockIdx.x);
        pg8::Epi E{}; E.kind = pg8::EK_WIN; E.stats_in = stB; E.Z = Zb; E.XBC = XBCb; E.V = Vb; E.GATES = GATES; E.DT = DTb; E.dt_bias = F.in[I_DTB];
        E.conv_p = F.out + O_CONV_P; E.conv_s = F.out + O_CONV_S; E.pool_p = F.out + O_POOL_P; E.pool_s = F.out + O_POOL_S;
        pg8::gemm_phase(F.lds, g, S, E);
    } PH_END(3)
    PH_BEGIN(4) { ssd_states_phase(F); pool_phase(F); } PH_END(4)
    PH_BEGIN(5) { ssd_scan_phase(F); } PH_END(5)
    PH_BEGIN(6) { ssd_out_phase(F); ssd_seq_phase(F); } PH_END(6)
    PH_BEGIN(7) {
        pg8::Gemm g{Zb, (const bf16_t*)(F.ws + WS_WSSO), M, DM, DI, DI, 0}; S.init(MP, DM, F.G, (int)blockIdx.x);
        pg8::Epi E{}; E.kind = pg8::EK_T1; E.gates = GATES; E.of32 = T1;
        pg8::gemm_phase(F.lds, g, S, E);
        pg8::gemm_small(F.lds, g, E, MP, MS, F.G, (int)blockIdx.x);
    } PH_END(7)
    PH_BEGIN(8) {
        pg8::Gemm g{POOLED, (const bf16_t*)(F.ws + WS_W2), M, DM, DM, DM, 0}; S.init(MP, DM, F.G, (int)blockIdx.x);
        pg8::Epi E{}; E.kind = pg8::EK_MERGE; E.gates = GATES; E.res_p = T1; E.obf = MERGED;
        pg8::gemm_phase(F.lds, g, S, E);
        pg8::gemm_small(F.lds, g, E, MP, MS, F.G, (int)blockIdx.x);
    } PH_END(8)
    PH_BEGIN(9) {
        pg8::Gemm g{MERGED, (const bf16_t*)(F.ws + WS_WO), M, DM, DM, DM, 0}; S.init(MP, DM, F.G, (int)blockIdx.x);
        pg8::Epi E{}; E.kind = pg8::EK_RES; E.coef = 1.0f; E.res_p = H; E.res_s = H + (size_t)MP * DM; E.of32 = H; E.obf = HB; E.stats_out = stA;
        pg8::gemm_phase(F.lds, g, S, E);
        pg8::gemm_small(F.lds, g, E, MP, MS, F.G, (int)blockIdx.x);
    } PH_END(9)
    PH_BEGIN(10) {
        pg8::Gemm g{HB, (const bf16_t*)(F.ws + WS_WGU2), M, 2 * DFF, DM, DM, 0}; S.init(M, 2 * DFF, F.G, (int)blockIdx.x);
        pg8::Epi E{}; E.kind = pg8::EK_GU; E.stats_in = stA; E.obf = ACT; E.ldo = DFF;
        pg8::gemm_phase(F.lds, g, S, E);
    } PH_END(10)
    PH_BEGIN(11) {
        pg8::Gemm g{ACT, (const bf16_t*)(F.ws + WS_WD2), M, DM, DFF, DFF, 0}; S.init(MP, DM, F.G, (int)blockIdx.x);
        pg8::Epi E{}; E.kind = pg8::EK_RES; E.coef = 0.5f; E.res_p = H; E.res_s = H + (size_t)MP * DM; E.of32 = H; E.obf = HB; E.stats_out = stB;
        pg8::gemm_phase(F.lds, g, S, E);
        pg8::gemm_small(F.lds, g, E, MP, MS, F.G, (int)blockIdx.x);
    } PH_END(11)
    PH_BEGIN(12) {
        pg8::Gemm g{PB, (const bf16_t*)(F.ws + WS_WPLE), M, DM, PLE, PLE, 0}; S.init(MP, DM, F.G, (int)blockIdx.x);
        pg8::Epi E{}; E.kind = pg8::EK_BF16; E.obf = Qb; E.ldo = DM;
        pg8::gemm_phase(F.lds, g, S, E);
        pg8::gemm_small(F.lds, g, E, MP, MS, F.G, (int)blockIdx.x);
    } PH_END(12)
    PH_BEGIN(13) {
        pg8::Gemm g{HB, (const bf16_t*)(F.ws + WS_WPG), M, DM, DM, DM, 0}; S.init(MP, DM, F.G, (int)blockIdx.x);
        pg8::Epi E{}; E.kind = pg8::EK_PLE; E.stats_in = stB; E.q = Qb; E.of32 = H; E.stats_out = stA;
        pg8::gemm_phase(F.lds, g, S, E);
        pg8::gemm_small(F.lds, g, E, MP, MS, F.G, (int)blockIdx.x);
    } PH_END(13)
    PH_BEGIN(14) { final_phase(F); } PH_END(14)
#undef IN
#undef SEAM
#undef PH_BEGIN
#undef PH_END
}

extern "C" void kernel_launch(void* const* d_in, const int* in_sizes, int n_in, void* d_out, int out_size, void* d_ws, size_t ws_size, hipStream_t stream) {
    static int grid = 0;
    if (grid == 0) {
        if (n_in != 30 || in_sizes[0] != MP * DM || (size_t)out_size != O_END || ws_size < WS_END) {
            fprintf(stderr, "kernel_launch: shape mismatch: n_in %d in0 %d out %d ws %zu (need %zu)\n", n_in, n_in > 0 ? in_sizes[0] : -1, out_size, ws_size, (size_t)WS_END); grid = -1; return; }
        int dev = 0, cus = 0, per_cu = 0;
        if (hipGetDevice(&dev) != hipSuccess || hipDeviceGetAttribute(&cus, hipDeviceAttributeMultiprocessorCount, dev) != hipSuccess) { grid = -1; return; }
        if (hipFuncSetAttribute((const void*)mk_fwd, hipFuncAttributeMaxDynamicSharedMemorySize, LDS_BYTES) != hipSuccess) { fprintf(stderr, "kernel_launch: hipFuncSetAttribute failed\n"); grid = -1; return; }
        if (hipOccupancyMaxActiveBlocksPerMultiprocessor(&per_cu, (const void*)mk_fwd, NTHREADS, LDS_BYTES) != hipSuccess || per_cu < 1)
            fprintf(stderr, "kernel_launch: occupancy query reports %d workgroups per CU\n", per_cu);
        (void)hipGetLastError();
        grid = cus;
    }
    if (grid < 0) return;
    if (hipMemsetAsync((char*)d_ws + WS_CTL, 0, CTL_ZERO_BYTES, stream) != hipSuccess) { fprintf(stderr, "kernel_launch: memset failed\n"); return; }
    Args a{};
    for (int i = 0; i < 30; ++i) a.in[i] = (const float*)d_in[i];
    a.out = (float*)d_out; a.ws = (unsigned char*)d_ws;
#if MK_MULTI_LAUNCH
    for (int ph = 0; ph < NPHASES; ++ph) { a.ph_lo = ph; a.ph_hi = ph + 1; a.li = ph;
        hipLaunchKernelGGL(mk_fwd, dim3(grid), dim3(NTHREADS), LDS_BYTES, stream, a); }
#else
    a.ph_lo = 0; a.ph_hi = NPHASES; a.li = 0;
    hipLaunchKernelGGL(mk_fwd, dim3(grid), dim3(NTHREADS), LDS_BYTES, stream, a);
#endif
}
```

```cpp
#include <hip/hip_runtime.h>
#include <cstdio>
#include <cstdint>

#define REP_MASK 0x0
#ifndef MK_MULTI_LAUNCH
#define MK_MULTI_LAUNCH 0
#endif

#define GAS __attribute__((address_space(1)))
#define LAS __attribute__((address_space(3)))
typedef unsigned short bf16_t;
typedef short bf16x8 __attribute__((ext_vector_type(8)));
typedef float f32x4 __attribute__((ext_vector_type(4)));
typedef float f32x2 __attribute__((ext_vector_type(2)));
typedef unsigned u32x4 __attribute__((ext_vector_type(4)));
typedef unsigned u32x2 __attribute__((ext_vector_type(2)));
typedef GAS unsigned gu32;

constexpr int DM = 1024, BATCH = 8, SEQ = 2048, DECB = 128, DECS = 8;
constexpr int MP = BATCH * SEQ, MS = DECB * DECS, M = MP + MS;
constexpr int DI = 2048, HD = 64, NH = 32, NG = 8, HPG = 4, DSTATE = 128, CD = 4096;
constexpr int PD = 1024, PBUF = 15, DFF = 2816, PLE = 256;
constexpr int IN_DIM = 9248, NIN = 9472;
constexpr float EPS = 1e-6f;
constexpr int NWAVES = 8, NTHREADS = 512;

constexpr size_t MiB = 1u << 20;
constexpr size_t WS_CTL = 0, CTL_ZERO_BYTES = 1 * MiB;
constexpr size_t WS_STATS_A = 2 * MiB, WS_STATS_B = 4 * MiB, WS_DT = 6 * MiB, WS_CDEC = 9 * MiB;
constexpr size_t WS_WGU1 = 10 * MiB, WS_WD1 = 21 * MiB, WS_WIN = 27 * MiB, WS_WSSO = 46 * MiB, WS_W2 = 50 * MiB, WS_WO = 52 * MiB,
                 WS_WGU2 = 54 * MiB, WS_WD2 = 65 * MiB, WS_WPG = 71 * MiB, WS_WPLE = 73 * MiB, WS_PB = 74 * MiB, WS_WPOT = 480 * MiB, WS_WGRP = 483 * MiB;
constexpr size_t WS_Z = 84 * MiB, WS_XBC = 152 * MiB, WS_V = 288 * MiB, WS_GATES = 322 * MiB, WS_HB = 390 * MiB, WS_HPREV = 424 * MiB, WS_HALO = 488 * MiB, WS_END = 492 * MiB;
constexpr size_t WS_ACT = WS_XBC, WS_T1 = WS_XBC, WS_MERGED = WS_V, WS_Q = WS_GATES, WS_XB = WS_HB, WS_POOLED = WS_HB;
static_assert(WS_STATS_A + (size_t)M * 16 * 4 <= WS_STATS_B && WS_STATS_B + (size_t)M * 16 * 4 <= WS_DT && WS_DT + (size_t)M * 32 * 4 <= WS_WGU1, "ws map (small)");
static_assert(WS_WGU1 + (size_t)2 * DFF * DM * 2 <= WS_WD1 && WS_WD1 + (size_t)DM * DFF * 2 <= WS_WIN && WS_WIN + (size_t)NIN * DM * 2 <= WS_WSSO && WS_WSSO + (size_t)DM * DI * 2 <= WS_W2, "ws map (w1)");
static_assert(WS_WGU2 + (size_t)2 * DFF * DM * 2 <= WS_WD2 && WS_WD2 + (size_t)DM * DFF * 2 <= WS_WPG && WS_WPLE + (size_t)DM * PLE * 2 <= WS_PB && WS_PB + (size_t)M * PLE * 2 <= WS_Z, "ws map (w2)");
static_assert(WS_Z + (size_t)M * DI * 2 <= WS_XBC && WS_XBC + (size_t)M * CD * 2 <= WS_V && WS_V + (size_t)M * PD * 2 <= WS_GATES && WS_GATES + (size_t)M * 2 * DM * 2 <= WS_HB &&
              WS_HB + (size_t)M * DM * 2 <= WS_HPREV && WS_HPREV + (size_t)BATCH * 16 * NH * HD * DSTATE * 2 <= WS_END, "ws map (act)");
static_assert(WS_ACT + (size_t)M * DFF * 2 <= WS_V && WS_T1 + (size_t)M * DM * 4 <= WS_V, "ws overlays");
constexpr int CW_BAR = 4096;

constexpr size_t O_Y = 0, O_SSM_P = (size_t)M * DM, O_CONV_P = O_SSM_P + (size_t)BATCH * NH * HD * DSTATE, O_POOL_P = O_CONV_P + (size_t)BATCH * 3 * CD,
                 O_SSM_S = O_POOL_P + (size_t)BATCH * PBUF * PD, O_CONV_S = O_SSM_S + (size_t)DECB * NH * HD * DSTATE, O_POOL_S = O_CONV_S + (size_t)DECB * 3 * CD,
                 O_END = O_POOL_S + (size_t)DECB * PBUF * PD;

constexpr int RING_BYTES = 131072, LDSCTL_OFF = RING_BYTES, MISC_OFF = LDSCTL_OFF + 320, LDS_BYTES = 147456;

#define RLX_AGENT __ATOMIC_RELAXED, __HIP_MEMORY_SCOPE_AGENT
#define LDS_WAIT() asm volatile("s_waitcnt lgkmcnt(0)" ::: "memory")
#define VM_WAIT() asm volatile("s_waitcnt vmcnt(0)" ::: "memory")

__device__ __forceinline__ unsigned f2bf(float f) { unsigned u = __builtin_bit_cast(unsigned, f); return (u + 0x7fffu + ((u >> 16) & 1u)) >> 16; }
__device__ __forceinline__ unsigned cvt_pk_bf16(float lo, float hi);
__device__ __forceinline__ unsigned pk2(float lo, float hi) { return cvt_pk_bf16(lo, hi); }
__device__ __forceinline__ float bf2f(unsigned b) { return __builtin_bit_cast(float, b << 16); }
__device__ __forceinline__ float bflo(unsigned w) { return __builtin_bit_cast(float, w << 16); }
__device__ __forceinline__ float bfhi(unsigned w) { return __builtin_bit_cast(float, w & 0xffff0000u); }
typedef __bf16 bf16x2_t __attribute__((ext_vector_type(2)));
__device__ __forceinline__ unsigned cvt_pk_bf16(float lo, float hi) { const bf16x2_t v = {(__bf16)lo, (__bf16)hi}; return __builtin_bit_cast(unsigned, v); }
__device__ __forceinline__ float sigm_f(float x) { return __builtin_amdgcn_rcpf(1.0f + __expf(-x)); }
__device__ __forceinline__ float silu_f(float x) { return x * __builtin_amdgcn_rcpf(1.0f + __expf(-x)); }
__device__ __forceinline__ float wave_sum(float v) {
#pragma unroll
    for (int o = 1; o < 64; o <<= 1) v += __shfl_xor(v, o);
    return v;
}

struct Frame {
    LAS unsigned char* lds;
    volatile LAS unsigned* MISC;
    gu32* ctl;
    int tid, lane, wave, vcu, G;
    unsigned char* ws;
    float* out;
    const float* in[30];
};
enum { I_XP = 0, I_XS, I_SSM, I_CONV, I_POOL, I_PP, I_PS, I_NFFN1, I_WGU1, I_WD1, I_NMIX, I_WIN, I_CONVW, I_CONVB, I_DTB, I_ALOG, I_DSKIP, I_NSSD, I_WSSO, I_WPGRP, I_PSCALE,
       I_WPOUT, I_WO, I_NFFN2, I_WGU2, I_WD2, I_NPLE, I_WPG, I_WPLE, I_NFINAL };

namespace pg8 {
constexpr int BM = 256, BK = 64, HALF = 128, HTB = HALF * BK * 2, STAGE_BYTES = 8 * HTB, NXCD = 8, WGM = 8;
__host__ __device__ __forceinline__ int lds_byte(int r, int c) { const int st = (r >> 4) * 2 + (c >> 5), rr = r & 15, cc = c & 31, ob = rr * 64 + cc * 2; return st * 1024 + (ob ^ (((ob >> 9) & 1) << 5)); }
__host__ __device__ __forceinline__ void stage_rc(int b, int& R, int& C) { const int st = b / 1024, sb = b % 1024, swz = sb ^ (((sb >> 9) & 1) << 5); R = (st >> 1) * 16 + swz / 64; C = (st & 1) * 32 + (swz % 64) / 2; }
__host__ __device__ __forceinline__ int perm32(int rho) { const int n = rho >> 4, i = rho & 15; return 8 * (i >> 2) + 4 * n + (i & 3); }
struct Unit { int pm, pn; };
struct Gemm { const bf16_t* A; const bf16_t* Bt; int M, N, K; int lda; int a_pn_step; };
struct StaticOrder {
    int nM, nN, nwg, G, c;
    __host__ __device__ void init(int M_, int N_, int G_, int c_) { nM = M_ / BM; nN = N_ / BM; nwg = nM * nN; G = G_; c = c_; }
    __host__ __device__ void init_tail(int M_, int N_, int G_, int c_) { init(M_, N_, G_, (G_ - 1) - c_); }
    __host__ __device__ bool next(int i, Unit& u) const {
        const long L = (long)i * G + c; if (L >= nwg) return false;
        int wgid = (int)L; { const int q = nwg / NXCD, r = nwg % NXCD, xcd = wgid % NXCD, off = wgid / NXCD; wgid = (xcd < r ? xcd * (q + 1) : r * (q + 1) + (xcd - r) * q) + off; }
        const int nig = WGM * nN, gid = wgid / nig, fm = gid * WGM, gsz = (nM - fm) < WGM ? (nM - fm) : WGM;
        u.pm = fm + ((wgid % nig) % gsz); u.pn = (wgid % nig) / gsz; return true;
    }
};

enum EpiKind { EK_GU = 1, EK_RES = 2, EK_WIN = 3, EK_T1 = 4, EK_MERGE = 5, EK_BF16 = 6, EK_PLE = 7 };
struct Epi {
    const float* stats_in;
    float* stats_out;
    bf16_t* obf;
    float* of32;
    const float* res_p; const float* res_s;
    const bf16_t* gates;
    const bf16_t* q;
    bf16_t *Z, *XBC, *V, *GATES, *HALO; float* DT; const float* dt_bias; float *conv_p, *conv_s, *pool_p, *pool_s;
    int kind; int ldo; float coef; int pad;
};

__device__ __forceinline__ u32x4 pack8(const f32x4 a, const f32x4 b) { u32x4 w; w.x = cvt_pk_bf16(a[0], a[1]); w.y = cvt_pk_bf16(a[2], a[3]); w.z = cvt_pk_bf16(b[0], b[1]); w.w = cvt_pk_bf16(b[2], b[3]); return w; }
__device__ __forceinline__ void unpack8(const u32x4 w, f32x4& a, f32x4& b) { a = (f32x4){bflo(w.x), bfhi(w.x), bflo(w.y), bfhi(w.y)}; b = (f32x4){bflo(w.z), bfhi(w.z), bflo(w.w), bfhi(w.w)}; }

__device__ __forceinline__ float row_rs(const float* stats, int row) {
    if (!stats) return 1.0f;
    const GAS f32x4* sp = (const GAS f32x4*)(stats + (size_t)row * 16);
    const f32x4 a = sp[0], b = sp[1], c = sp[2], d = sp[3]; const f32x4 s = (a + b) + (c + d);
    return __builtin_amdgcn_rsqf(((s[0] + s[1]) + (s[2] + s[3])) * (1.0f / 1024.0f) + EPS);
}
__device__ __forceinline__ float softplus_f(float x) { const float e = __expf(-fabsf(x)); const float l = (e < 0.01f) ? e * (1.0f - e * (0.5f - e * (1.0f / 3.0f))) : __logf(1.0f + e); return fmaxf(x, 0.f) + l; }

__device__ __forceinline__ void epilogue(const Epi& E, const f32x4 (&acc)[2][2][4][2], const Unit& u, int wr, int wc, int fr, int fq) {
    const int rowb = u.pm * BM + wr * 64 + fr;
    const int cin = wc * 32 + 8 * fq;
    if (E.kind == EK_GU) {
#pragma unroll
        for (int ai = 0; ai < 2; ++ai)
#pragma unroll
            for (int m = 0; m < 4; ++m) { const int row = rowb + ai * HALF + m * 16; const float r = row_rs(E.stats_in, row);
                const f32x4 g0 = acc[ai][0][m][0] * r, u0 = acc[ai][1][m][0] * r, g1 = acc[ai][0][m][1] * r, u1 = acc[ai][1][m][1] * r;
                const f32x4 o0 = (f32x4){silu_f(g0[0]) * u0[0], silu_f(g0[1]) * u0[1], silu_f(g0[2]) * u0[2], silu_f(g0[3]) * u0[3]};
                const f32x4 o1 = (f32x4){silu_f(g1[0]) * u1[0], silu_f(g1[1]) * u1[1], silu_f(g1[2]) * u1[2], silu_f(g1[3]) * u1[3]};
                *(GAS u32x4*)(E.obf + (size_t)row * E.ldo + u.pn * HALF + cin) = pack8(o0, o1); }
    } else if (E.kind == EK_RES) {
#pragma unroll
        for (int ai = 0; ai < 2; ++ai)
#pragma unroll
            for (int m = 0; m < 4; ++m) { const int row = rowb + ai * HALF + m * 16;
                const float* rp = (row < MP) ? E.res_p + (size_t)row * DM : E.res_s + (size_t)(row - MP) * DM;
                float ss = 0.f;
#pragma unroll
                for (int bj = 0; bj < 2; ++bj) { const int col = u.pn * BM + bj * HALF + cin;
                    const f32x4 r0 = *(const GAS f32x4*)(rp + col), r1 = *(const GAS f32x4*)(rp + col + 4);
                    const f32x4 h0 = r0 + acc[ai][bj][m][0] * E.coef, h1 = r1 + acc[ai][bj][m][1] * E.coef;
                    *(GAS f32x4*)(E.of32 + (size_t)row * DM + col) = h0; *(GAS f32x4*)(E.of32 + (size_t)row * DM + col + 4) = h1;
                    *(GAS u32x4*)(E.obf + (size_t)row * DM + col) = pack8(h0, h1);
                    ss += (h0[0] * h0[0] + h0[1] * h0[1]) + (h0[2] * h0[2] + h0[3] * h0[3]) + (h1[0] * h1[0] + h1[1] * h1[1]) + (h1[2] * h1[2] + h1[3] * h1[3]); }
                ss += __shfl_xor(ss, 16); ss += __shfl_xor(ss, 32);
                if (fq == 0) *(GAS float*)(E.stats_out + (size_t)row * 16 + u.pn * 4 + wc) = ss; }
    } else if (E.kind == EK_WIN) {
        const int pn = u.pn;
        if (pn < 8) {
            const int colt = pn * BM + cin;
#pragma unroll
            for (int ai = 0; ai < 2; ++ai)
#pragma unroll
                for (int m = 0; m < 4; ++m) { const int row = rowb + ai * HALF + m * 16; const float r = row_rs(E.stats_in, row);
#pragma unroll
                    for (int bj = 0; bj < 2; ++bj) { f32x4 v0 = acc[ai][bj][m][0] * r, v1 = acc[ai][bj][m][1] * r;
#pragma unroll
                        for (int j = 0; j < 4; ++j) { v0[j] = silu_f(v0[j]); v1[j] = silu_f(v1[j]); }
                        *(GAS u32x4*)(E.Z + (size_t)row * DI + colt + bj * HALF) = pack8(v0, v1); } }
        } else if (pn >= 28 && pn < 36) {
            const int colt = (pn - 28) * BM + cin;
#pragma unroll
            for (int ai = 0; ai < 2; ++ai)
#pragma unroll
                for (int m = 0; m < 4; ++m) { const int row = rowb + ai * HALF + m * 16; const float r = row_rs(E.stats_in, row);
#pragma unroll
                    for (int bj = 0; bj < 2; ++bj) { f32x4 v0 = acc[ai][bj][m][0] * r, v1 = acc[ai][bj][m][1] * r;
#pragma unroll
                        for (int j = 0; j < 4; ++j) { v0[j] = sigm_f(v0[j]); v1[j] = sigm_f(v1[j]); }
                        *(GAS u32x4*)(E.GATES + (size_t)row * (2 * DM) + colt + bj * HALF) = pack8(v0, v1); } }
        } else if (pn < 28) {
            const bool isx = pn < 24; bf16_t* const O = isx ? E.XBC : E.V; const int ldo = isx ? CD : PD; const int colt = (isx ? pn - 8 : pn - 24) * BM + cin;
            const int keep = isx ? 3 : PBUF;
#pragma unroll
            for (int ai = 0; ai < 2; ++ai)
#pragma unroll
                for (int m = 0; m < 4; ++m) { const int row = rowb + ai * HALF + m * 16; const float r = row_rs(E.stats_in, row);
                    float* sp = nullptr;
                    if (row < MP) { const int sb = row >> 11, st = row & (SEQ - 1); if (st >= SEQ - keep) sp = (isx ? E.conv_p : E.pool_p) + ((size_t)sb * keep + (st - (SEQ - keep))) * ldo + colt; }
                    else { const int sb = (row - MP) >> 3, st = (row - MP) & 7; const int si = st - (DECS - keep); if (si >= 0) sp = (isx ? E.conv_s : E.pool_s) + ((size_t)sb * keep + si) * ldo + colt; }
                    bf16_t* hp = nullptr;
                    if (isx && row < MP) { const int st = row & (SEQ - 1), tm = st & 127; if (tm >= 125 && st < SEQ - 3) hp = E.HALO + ((((size_t)(row >> 11) * 16 + (st >> 7) + 1) * 3 + (tm - 125)) * CD) + colt; }
#pragma unroll
                    for (int bj = 0; bj < 2; ++bj) { const f32x4 v0 = acc[ai][bj][m][0] * r, v1 = acc[ai][bj][m][1] * r;
                        const u32x4 pk = pack8(v0, v1);
                        *(GAS u32x4*)(O + (size_t)row * ldo + colt + bj * HALF) = pk;
                        if (hp) *(GAS u32x4*)(hp + bj * HALF) = pk;
                        if (sp) { *(GAS f32x4*)(sp + bj * HALF) = v0; *(GAS f32x4*)(sp + bj * HALF + 4) = v1; } } }
        } else if (wc == 0) {
            const f32x4 b0 = *(const GAS f32x4*)(E.dt_bias + 8 * fq), b1 = *(const GAS f32x4*)(E.dt_bias + 8 * fq + 4);
#pragma unroll
            for (int ai = 0; ai < 2; ++ai)
#pragma unroll
                for (int m = 0; m < 4; ++m) { const int row = rowb + ai * HALF + m * 16; const float r = row_rs(E.stats_in, row);
                    f32x4 v0 = acc[ai][0][m][0] * r + b0, v1 = acc[ai][0][m][1] * r + b1;
#pragma unroll
                    for (int j = 0; j < 4; ++j) { v0[j] = softplus_f(v0[j]); v1[j] = softplus_f(v1[j]); }
                    *(GAS f32x4*)(E.DT + (size_t)row * 32 + 8 * fq) = v0; *(GAS f32x4*)(E.DT + (size_t)row * 32 + 8 * fq + 4) = v1; }
        }
    } else if (E.kind == EK_T1) {
#pragma unroll
        for (int ai = 0; ai < 2; ++ai)
#pragma unroll
            for (int m = 0; m < 4; ++m) { const int row = rowb + ai * HALF + m * 16;
#pragma unroll
                for (int bj = 0; bj < 2; ++bj) { const int col = u.pn * BM + bj * HALF + cin;
                    f32x4 g0, g1; unpack8(*(const GAS u32x4*)(E.gates + (size_t)row * (2 * DM) + col), g0, g1);
                    *(GAS f32x4*)(E.of32 + (size_t)row * DM + col) = g0 * acc[ai][bj][m][0]; *(GAS f32x4*)(E.of32 + (size_t)row * DM + col + 4) = g1 * acc[ai][bj][m][1]; } }
    } else if (E.kind == EK_MERGE) {
#pragma unroll
        for (int ai = 0; ai < 2; ++ai)
#pragma unroll
            for (int m = 0; m < 4; ++m) { const int row = rowb + ai * HALF + m * 16;
#pragma unroll
                for (int bj = 0; bj < 2; ++bj) { const int col = u.pn * BM + bj * HALF + cin;
                    f32x4 g0, g1; unpack8(*(const GAS u32x4*)(E.gates + (size_t)row * (2 * DM) + DM + col), g0, g1);
                    const f32x4 t0 = *(const GAS f32x4*)(E.res_p + (size_t)row * DM + col), t1 = *(const GAS f32x4*)(E.res_p + (size_t)row * DM + col + 4);
                    *(GAS u32x4*)(E.obf + (size_t)row * DM + col) = pack8(t0 + g0 * acc[ai][bj][m][0], t1 + g1 * acc[ai][bj][m][1]); } }
    } else if (E.kind == EK_BF16) {
#pragma unroll
        for (int ai = 0; ai < 2; ++ai)
#pragma unroll
            for (int m = 0; m < 4; ++m) { const int row = rowb + ai * HALF + m * 16;
#pragma unroll
                for (int bj = 0; bj < 2; ++bj) { const int col = u.pn * BM + bj * HALF + cin;
                    *(GAS u32x4*)(E.obf + (size_t)row * E.ldo + col) = pack8(acc[ai][bj][m][0], acc[ai][bj][m][1]); } }
    } else if (E.kind == EK_PLE) {
#pragma unroll
        for (int ai = 0; ai < 2; ++ai)
#pragma unroll
            for (int m = 0; m < 4; ++m) { const int row = rowb + ai * HALF + m * 16; const float r = row_rs(E.stats_in, row);
                float ss = 0.f;
#pragma unroll
                for (int bj = 0; bj < 2; ++bj) { const int col = u.pn * BM + bj * HALF + cin;
                    f32x4 q0, q1; unpack8(*(const GAS u32x4*)(E.q + (size_t)row * DM + col), q0, q1);
                    const f32x4 r0 = *(const GAS f32x4*)(E.of32 + (size_t)row * DM + col), r1 = *(const GAS f32x4*)(E.of32 + (size_t)row * DM + col + 4);
                    f32x4 h0, h1;
#pragma unroll
                    for (int j = 0; j < 4; ++j) { h0[j] = r0[j] + sigm_f(acc[ai][bj][m][0][j] * r) * q0[j]; h1[j] = r1[j] + sigm_f(acc[ai][bj][m][1][j] * r) * q1[j]; }
                    *(GAS f32x4*)(E.of32 + (size_t)row * DM + col) = h0; *(GAS f32x4*)(E.of32 + (size_t)row * DM + col + 4) = h1;
                    ss += (h0[0] * h0[0] + h0[1] * h0[1]) + (h0[2] * h0[2] + h0[3] * h0[3]) + (h1[0] * h1[0] + h1[1] * h1[1]) + (h1[2] * h1[2] + h1[3] * h1[3]); }
                ss += __shfl_xor(ss, 16); ss += __shfl_xor(ss, 32);
                if (fq == 0) *(GAS float*)(E.stats_out + (size_t)row * 16 + u.pn * 4 + wc) = ss; }
    }
}


__device__ __forceinline__ void epi_seg(const Epi& E, int row, int col, f32x4 v0, f32x4 v1, int lane) {
    if (E.kind == EK_RES) {
        const float* rp = ((row < MP) ? E.res_p + (size_t)row * DM : E.res_s + (size_t)(row - MP) * DM) + col;
        const f32x4 h0 = *(const GAS f32x4*)rp + v0 * E.coef, h1 = *(const GAS f32x4*)(rp + 4) + v1 * E.coef;
        *(GAS f32x4*)(E.of32 + (size_t)row * DM + col) = h0; *(GAS f32x4*)(E.of32 + (size_t)row * DM + col + 4) = h1;
        *(GAS u32x4*)(E.obf + (size_t)row * DM + col) = pack8(h0, h1);
        float ss = (h0[0] * h0[0] + h0[1] * h0[1]) + (h0[2] * h0[2] + h0[3] * h0[3]) + (h1[0] * h1[0] + h1[1] * h1[1]) + (h1[2] * h1[2] + h1[3] * h1[3]);
        ss += __shfl_xor(ss, 1); ss += __shfl_xor(ss, 2); ss += __shfl_xor(ss, 4);
        if ((lane & 7) == 0) *(GAS float*)(E.stats_out + (size_t)row * 16 + (col >> 6)) = ss;
    } else if (E.kind == EK_T1) {
        f32x4 g0, g1; unpack8(*(const GAS u32x4*)(E.gates + (size_t)row * (2 * DM) + col), g0, g1);
        *(GAS f32x4*)(E.of32 + (size_t)row * DM + col) = g0 * v0; *(GAS f32x4*)(E.of32 + (size_t)row * DM + col + 4) = g1 * v1;
    } else if (E.kind == EK_MERGE) {
        f32x4 g0, g1; unpack8(*(const GAS u32x4*)(E.gates + (size_t)row * (2 * DM) + DM + col), g0, g1);
        const f32x4 t0 = *(const GAS f32x4*)(E.res_p + (size_t)row * DM + col), t1 = *(const GAS f32x4*)(E.res_p + (size_t)row * DM + col + 4);
        *(GAS u32x4*)(E.obf + (size_t)row * DM + col) = pack8(t0 + g0 * v0, t1 + g1 * v1);
    } else if (E.kind == EK_BF16) {
        *(GAS u32x4*)(E.obf + (size_t)row * E.ldo + col) = pack8(v0, v1);
    } else if (E.kind == EK_PLE) {
        const float r = row_rs(E.stats_in, row);
        f32x4 q0, q1; unpack8(*(const GAS u32x4*)(E.q + (size_t)row * DM + col), q0, q1);
        const f32x4 r0 = *(const GAS f32x4*)(E.of32 + (size_t)row * DM + col), r1 = *(const GAS f32x4*)(E.of32 + (size_t)row * DM + col + 4);
        f32x4 h0, h1;
#pragma unroll
        for (int j = 0; j < 4; ++j) { h0[j] = r0[j] + sigm_f(v0[j] * r) * q0[j]; h1[j] = r1[j] + sigm_f(v1[j] * r) * q1[j]; }
        *(GAS f32x4*)(E.of32 + (size_t)row * DM + col) = h0; *(GAS f32x4*)(E.of32 + (size_t)row * DM + col + 4) = h1;
        float ss = (h0[0] * h0[0] + h0[1] * h0[1]) + (h0[2] * h0[2] + h0[3] * h0[3]) + (h1[0] * h1[0] + h1[1] * h1[1]) + (h1[2] * h1[2] + h1[3] * h1[3]);
        ss += __shfl_xor(ss, 1); ss += __shfl_xor(ss, 2); ss += __shfl_xor(ss, 4);
        if ((lane & 7) == 0) *(GAS float*)(E.stats_out + (size_t)row * 16 + (col >> 6)) = ss;
    }
}
__device__ __forceinline__ void gemm_small(LAS unsigned char* lds, const Gemm g, const Epi& E, int row_base, int nrows, int G, int c) {
    const int tid = threadIdx.x, wid = __builtin_amdgcn_readfirstlane(tid >> 6), lane = tid & 63, ql = lane & 15, gq = lane >> 4;
    const int K = g.K, nkt = K / 64, ntn = g.N / 64, ntiles = (nrows / 64) * ntn;
    for (int v = c; v < ntiles; v += G) {
        const int r0 = row_base + 64 * (v / ntn), c0 = 64 * (v % ntn);
        f32x4 acc[4][4];
#pragma unroll
        for (int m = 0; m < 4; ++m)
#pragma unroll
            for (int n = 0; n < 4; ++n) acc[m][n] = (f32x4){0.f, 0.f, 0.f, 0.f};
        const bf16_t* const ap = g.A + (size_t)(r0 + ql) * g.lda + 8 * gq;
        const bf16_t* const bp = g.Bt + (size_t)(c0 + ql) * K + 8 * gq;
        bf16x8 af[4][2], bf[4][2];
        if (wid < nkt) {
#pragma unroll
            for (int m = 0; m < 4; ++m)
#pragma unroll
                for (int ks = 0; ks < 2; ++ks) { af[m][ks] = *(const GAS bf16x8*)(ap + (size_t)(16 * m) * g.lda + 64 * wid + 32 * ks); bf[m][ks] = *(const GAS bf16x8*)(bp + (size_t)(16 * m) * K + 64 * wid + 32 * ks); }
        }
        for (int kt = wid; kt < nkt; kt += 8) {
            bf16x8 an[4][2], bn[4][2];
            const int kn = (kt + 8 < nkt) ? kt + 8 : kt;
#pragma unroll
            for (int m = 0; m < 4; ++m)
#pragma unroll
                for (int ks = 0; ks < 2; ++ks) { an[m][ks] = *(const GAS bf16x8*)(ap + (size_t)(16 * m) * g.lda + 64 * kn + 32 * ks); bn[m][ks] = *(const GAS bf16x8*)(bp + (size_t)(16 * m) * K + 64 * kn + 32 * ks); }
#pragma unroll
            for (int ks = 0; ks < 2; ++ks)
#pragma unroll
                for (int m = 0; m < 4; ++m)
#pragma unroll
                    for (int n = 0; n < 4; ++n) acc[m][n] = __builtin_amdgcn_mfma_f32_16x16x32_bf16(bf[n][ks], af[m][ks], acc[m][n], 0, 0, 0);
#pragma unroll
            for (int m = 0; m < 4; ++m)
#pragma unroll
                for (int ks = 0; ks < 2; ++ks) { af[m][ks] = an[m][ks]; bf[m][ks] = bn[m][ks]; }
        }
        LAS f32x4* const slab = (LAS f32x4*)(lds + wid * 16384);
#pragma unroll
        for (int m = 0; m < 4; ++m)
#pragma unroll
            for (int n = 0; n < 4; ++n) slab[(16 * m + ql) * 16 + ((4 * n + gq) ^ ql)] = acc[m][n];
        __syncthreads();
        const int rr = 8 * wid + (lane >> 3), ch0 = 2 * (lane & 7);
        f32x4 v0 = (f32x4){0.f, 0.f, 0.f, 0.f}, v1 = v0;
#pragma unroll
        for (int s8 = 0; s8 < 8; ++s8) { const LAS f32x4* sl = (const LAS f32x4*)(lds + s8 * 16384) + rr * 16; v0 += sl[ch0 ^ (rr & 15)]; v1 += sl[(ch0 + 1) ^ (rr & 15)]; }
        epi_seg(E, r0 + rr, c0 + 8 * (lane & 7), v0, v1, lane);
        __syncthreads();
    }
}

__device__ __forceinline__ void gemm_phase(LAS unsigned char* lds, const Gemm g, const StaticOrder& S, const Epi& E) {
    const int tid = threadIdx.x, wid = __builtin_amdgcn_readfirstlane(tid >> 6), lane = tid & 63, wr = wid >> 2, wc = wid & 3, fr = lane & 15, fq = lane >> 4;
    const int K = g.K, nt = K / BK;
    unsigned voffA[2], voffB[2];
#pragma unroll
    for (int i = 0; i < 2; ++i) { int R, C; stage_rc(tid * 16 + i * 8192, R, C); const int Rb = (R & ~31) + perm32(R & 31);
        voffA[i] = (unsigned)(R * g.lda + C) * 2u; voffB[i] = (unsigned)(Rb * K + C) * 2u; }
    const size_t kstep = (size_t)(BK * 2);
    const size_t hstep = (size_t)HALF * K * 2, hstepA = (size_t)HALF * g.lda * 2;
    const size_t tstep = 2 * hstep, tstepA = 2 * hstepA, pnstepA = (size_t)g.a_pn_step * 2;
    const unsigned ldsw = (unsigned)wid * 1024u;
    const int aoff = lds_byte(wr * 64 + fr, fq * 8), boff = lds_byte(wc * 32 + fr, fq * 8);
#define PG8_SA(b, h) (((b) * 2 + (h)) * HTB)
#define PG8_SB(b, h) ((4 + (b) * 2 + (h)) * HTB)
#define PG8_STAGE(bufoff, gbase, voff) do { _Pragma("unroll") for (int _i = 0; _i < 2; ++_i) \
        __builtin_amdgcn_global_load_lds((const unsigned*)((const char*)(gbase) + (voff)[_i]), (LAS unsigned*)(lds + (bufoff) + ldsw + _i * 8192), 16, 0, 0); } while (0)
#define PG8_LDA(dst, b, h) do { _Pragma("unroll") for (int m = 0; m < 4; ++m) _Pragma("unroll") for (int k = 0; k < 2; ++k) dst[m][k] = *(const LAS bf16x8*)(lds + PG8_SA(b, h) + aoff + m * 2048 + k * 1024); } while (0)
#define PG8_LDB(dst, b, h) do { _Pragma("unroll") for (int n = 0; n < 2; ++n) _Pragma("unroll") for (int k = 0; k < 2; ++k) dst[n][k] = *(const LAS bf16x8*)(lds + PG8_SB(b, h) + boff + n * 2048 + k * 1024); } while (0)
#define PG8_MMA(ai, bj, At, Bt) do { __builtin_amdgcn_s_setprio(1); _Pragma("unroll") for (int m = 0; m < 4; ++m) _Pragma("unroll") for (int n = 0; n < 2; ++n) _Pragma("unroll") for (int k = 0; k < 2; ++k) \
        acc[ai][bj][m][n] = __builtin_amdgcn_mfma_f32_16x16x32_bf16(Bt[n][k], At[m][k], acc[ai][bj][m][n], 0, 0, 0); __builtin_amdgcn_s_setprio(0); } while (0)
#define PG8_WAIT_V(n) asm volatile("s_waitcnt vmcnt(" #n ")" ::: "memory")
#define PG8_WAIT_L(n) asm volatile("s_waitcnt lgkmcnt(" #n ")" ::: "memory")
#define PG8_BAR __builtin_amdgcn_s_barrier()
#define PG8_SCHED __builtin_amdgcn_sched_barrier(0)
    Unit cur, nxt; int ui = 0;
    if (!S.next(0, cur)) return;
    f32x4 acc[2][2][4][2];
#pragma unroll
    for (int a = 0; a < 2; ++a)
#pragma unroll
        for (int b = 0; b < 2; ++b)
#pragma unroll
            for (int m = 0; m < 4; ++m)
#pragma unroll
                for (int n = 0; n < 2; ++n) acc[a][b][m][n] = (f32x4){0.f, 0.f, 0.f, 0.f};
    bf16x8 At[4][2], B0[2][2], B1[2][2];
    const char* cA = (const char*)g.A + (size_t)cur.pm * tstepA + (size_t)cur.pn * pnstepA; const char* cB = (const char*)g.Bt + (size_t)cur.pn * tstep;
    PG8_STAGE(PG8_SB(0, 0), cB, voffB); PG8_STAGE(PG8_SB(0, 1), cB + hstep, voffB); PG8_STAGE(PG8_SA(0, 0), cA, voffA); PG8_STAGE(PG8_SA(0, 1), cA + hstepA, voffA);
    if (wr == 1) PG8_BAR;
    PG8_WAIT_V(2); PG8_BAR;
    PG8_STAGE(PG8_SB(1, 0), cB + kstep, voffB); PG8_STAGE(PG8_SA(1, 0), cA + kstep, voffA); PG8_STAGE(PG8_SB(1, 1), cB + hstep + kstep, voffB);
    PG8_WAIT_V(6); PG8_BAR;
    for (;;) {
        const bool has_next = S.next(ui + 1, nxt);
        const char* nA = has_next ? (const char*)g.A + (size_t)nxt.pm * tstepA + (size_t)nxt.pn * pnstepA : cA; const char* nB = has_next ? (const char*)g.Bt + (size_t)nxt.pn * tstep : cB;
        for (int t = 0; t < nt; t += 2) {
            const bool last = (t == nt - 2);
            const char* a1 = cA + (size_t)(t + 1) * kstep;
            const char* a2 = last ? nA : cA + (size_t)(t + 2) * kstep; const char* b2 = last ? nB : cB + (size_t)(t + 2) * kstep;
            const char* a3 = a2 + kstep; const char* b3 = b2 + kstep;
            PG8_LDB(B0, 0, 0); PG8_LDB(B1, 0, 1); PG8_SCHED; PG8_LDA(At, 0, 0); PG8_STAGE(PG8_SA(1, 1), a1 + hstepA, voffA);
            PG8_WAIT_V(8); PG8_WAIT_L(0); PG8_BAR; PG8_MMA(0, 0, At, B0); PG8_MMA(0, 1, At, B1); PG8_BAR; PG8_SCHED;
            PG8_LDA(At, 0, 1); PG8_STAGE(PG8_SB(0, 0), b2, voffB); PG8_STAGE(PG8_SB(0, 1), b2 + hstep, voffB); PG8_STAGE(PG8_SA(0, 0), a2, voffA);
            PG8_WAIT_V(8); PG8_WAIT_L(0); PG8_BAR; PG8_MMA(1, 0, At, B0); PG8_MMA(1, 1, At, B1); PG8_BAR; PG8_SCHED;
            PG8_LDB(B0, 1, 0); PG8_LDB(B1, 1, 1); PG8_SCHED; PG8_LDA(At, 1, 0); PG8_STAGE(PG8_SA(0, 1), a2 + hstepA, voffA);
            PG8_WAIT_V(8); PG8_WAIT_L(0); PG8_BAR; PG8_MMA(0, 0, At, B0); PG8_MMA(0, 1, At, B1); PG8_BAR; PG8_SCHED;
            PG8_LDA(At, 1, 1); PG8_STAGE(PG8_SB(1, 0), b3, voffB); PG8_STAGE(PG8_SB(1, 1), b3 + hstep, voffB); PG8_STAGE(PG8_SA(1, 0), a3, voffA);
            PG8_WAIT_V(8); PG8_WAIT_L(0); PG8_BAR; PG8_MMA(1, 0, At, B0); PG8_MMA(1, 1, At, B1); PG8_BAR; PG8_SCHED;
        }
        if (wr == 0) PG8_BAR;
        epilogue(E, acc, cur, wr, wc, fr, fq);
        if (!has_next) break;
#pragma unroll
        for (int a = 0; a < 2; ++a)
#pragma unroll
            for (int b = 0; b < 2; ++b)
#pragma unroll
                for (int m = 0; m < 4; ++m)
#pragma unroll
                    for (int n = 0; n < 2; ++n) acc[a][b][m][n] = (f32x4){0.f, 0.f, 0.f, 0.f};
        cur = nxt; cA = nA; cB = nB; ++ui;
        if (wr == 1) PG8_BAR;
    }
    PG8_WAIT_V(0);
    PG8_BAR;
#undef PG8_SA
#undef PG8_SB
#undef PG8_STAGE
#undef PG8_LDA
#undef PG8_LDB
#undef PG8_MMA
#undef PG8_WAIT_V
#undef PG8_WAIT_L
#undef PG8_BAR
#undef PG8_SCHED
}
}

#define XB_TMO      128
#define XB_XCNT(j)  (256  + 64 * (j))
#define XB_XSUB(j)  (1280 + 64 * (j))
#define XB_XGEN(j)  (2304 + 64 * (j))
#define XB_TOP      3328
#define XB_TOPGEN   3392
#define XCD_BAR_WORDS 3456
#define XB_SPIN_CAP (1u << 18)
__device__ __forceinline__ unsigned xb_ld(unsigned* p)              { return __hip_atomic_load(p, __ATOMIC_RELAXED, __HIP_MEMORY_SCOPE_AGENT); }
__device__ __forceinline__ unsigned xb_add(unsigned* p, unsigned v) { return __hip_atomic_fetch_add(p, v, __ATOMIC_RELAXED, __HIP_MEMORY_SCOPE_AGENT); }
__device__ __forceinline__ unsigned xb_xcc_id() { return (unsigned)__builtin_amdgcn_s_getreg((3 << 11) | 20) & 0xFu; }
#define XB_SPIN(cond, bar) do { unsigned _sp = 0; while (cond) { __builtin_amdgcn_s_sleep(1); \
    if ((++_sp & 255u) == 0u) { if (xb_ld(&(bar)[XB_TMO])) break; if (_sp > XB_SPIN_CAP) { atomicAdd(&(bar)[XB_TMO], 1u); break; } } } } while (0)
struct XcdBarrier { unsigned* bar; unsigned x; volatile LAS unsigned* st; };
__device__ __forceinline__ XcdBarrier xcd_barrier_post(unsigned* bar, volatile LAS unsigned* st) {
    XcdBarrier b; b.bar = bar; b.x = xb_xcc_id(); b.st = st;
    if (threadIdx.x == 0) (void)xb_add(&bar[XB_XCNT(b.x)], 1u);
    return b;
}
__device__ __forceinline__ void xcd_barrier_complete(unsigned* bar, unsigned x, unsigned& nloc, unsigned& nx) {
    const unsigned G = gridDim.x * gridDim.y * gridDim.z;
    unsigned sum, cnt, mine, sp = 0u;
    for (;;) {
        sum = 0u; cnt = 0u; mine = 0u;
#pragma unroll
        for (unsigned j = 0; j < 16; ++j) { const unsigned c = xb_ld(&bar[XB_XCNT(j)]); sum += c; cnt += (c > 0u) ? 1u : 0u; mine = (j == x) ? c : mine; }
        if (sum == G) break;
        __builtin_amdgcn_s_sleep(1);
        if ((++sp & 255u) == 0u) { if (xb_ld(&bar[XB_TMO])) break; if (sp > XB_SPIN_CAP) { atomicAdd(&bar[XB_TMO], 1u); break; } }
    }
    nloc = mine > 0u ? mine : 1u; nx = cnt > 0u ? cnt : 1u;
}
__device__ __forceinline__ void xcd_barrier(const XcdBarrier& b) {
    asm volatile("s_waitcnt vmcnt(0)" ::: "memory");
    __syncthreads();
    if (threadIdx.x == 0) {
        unsigned* bar = b.bar;
        __builtin_amdgcn_s_waitcnt(0);
        unsigned nloc = b.st[0], nx = b.st[1];
        if (nloc == 0u) { xcd_barrier_complete(bar, b.x, nloc, nx); b.st[0] = nloc; b.st[1] = nx; }
        const unsigned old = xb_add(&bar[XB_XSUB(b.x)], 1u);
        const unsigned gen = old / nloc;
        if (old + 1u == (gen + 1u) * nloc) {
            __builtin_amdgcn_fence(__ATOMIC_RELEASE, "agent");
            asm volatile("s_waitcnt vmcnt(0)" ::: "memory");
            const unsigned og = xb_add(&bar[XB_TOP], 1u);
            const unsigned tg = og / nx;
            if (og + 1u == (tg + 1u) * nx) xb_add(&bar[XB_TOPGEN], 1u);
            else XB_SPIN(xb_ld(&bar[XB_TOPGEN]) == tg, bar);
            __builtin_amdgcn_fence(__ATOMIC_ACQUIRE, "agent");
            xb_add(&bar[XB_XGEN(b.x)], 1u);
            asm volatile("s_waitcnt vmcnt(0)" ::: "memory");
        } else {
            XB_SPIN(xb_ld(&bar[XB_XGEN(b.x)]) == gen, bar);
            __builtin_amdgcn_fence(__ATOMIC_ACQUIRE, "agent");
            asm volatile("s_waitcnt vmcnt(0)" ::: "memory");
        }
    }
    __syncthreads();
}

__device__ __forceinline__ void p0_transpose_item(const float* W, int K, int N, const float* gain, bf16_t* WT, int k0, int n0, int drow0, LAS float* scr, int lane) {
#pragma unroll
    for (int i = 0; i < 8; ++i) { const int kk = 8 * i + (lane >> 3), nn = 4 * (lane & 7);
        f32x4 v = *(const GAS f32x4*)(W + (size_t)(k0 + kk) * N + n0 + nn);
        if (gain) v = v * *(const GAS float*)(gain + k0 + kk);
        scr[kk * 33 + nn] = v.x; scr[kk * 33 + nn + 1] = v.y; scr[kk * 33 + nn + 2] = v.z; scr[kk * 33 + nn + 3] = v.w; }
    LDS_WAIT(); asm volatile("" ::: "memory");
    const int c = lane & 7;
#pragma unroll
    for (int j = 0; j < 4; ++j) { const int n = (lane >> 3) + 8 * j; const LAS float* s = scr + (8 * c) * 33 + n;
        u32x4 o; o.x = pk2(s[0 * 33], s[1 * 33]); o.y = pk2(s[2 * 33], s[3 * 33]); o.z = pk2(s[4 * 33], s[5 * 33]); o.w = pk2(s[6 * 33], s[7 * 33]);
        *(GAS u32x4*)(WT + (size_t)(drow0 + n) * K + k0 + 8 * c) = o; }
    LDS_WAIT(); asm volatile("" ::: "memory");
}
__device__ __forceinline__ int map_gu(int n0) { return n0 < DFF ? (n0 / 128) * 256 + (n0 % 128) : ((n0 - DFF) / 128) * 256 + 128 + ((n0 - DFF) % 128); }
__device__ __forceinline__ int map_win(int n0) { return n0 < 6144 ? n0 : (n0 < 6176 ? 9216 + (n0 - 6144) : n0 - 32); }

__device__ __forceinline__ void p0_prologue(Frame& F) {
    LAS float* scr = (LAS float*)(F.lds + F.wave * 16384);
    const int gw = F.vcu * NWAVES + F.wave, NGW = F.G * NWAVES, lane = F.lane;
    bf16_t* const wgu1 = (bf16_t*)(F.ws + WS_WGU1); bf16_t* const wd1 = (bf16_t*)(F.ws + WS_WD1); bf16_t* const win = (bf16_t*)(F.ws + WS_WIN);
    bf16_t* const wsso = (bf16_t*)(F.ws + WS_WSSO); bf16_t* const wo = (bf16_t*)(F.ws + WS_WO); bf16_t* const wgu2 = (bf16_t*)(F.ws + WS_WGU2);
    bf16_t* const wd2 = (bf16_t*)(F.ws + WS_WD2); bf16_t* const wpg = (bf16_t*)(F.ws + WS_WPG); bf16_t* const wple = (bf16_t*)(F.ws + WS_WPLE);
    constexpr int I_GU = (DM / 64) * (2 * DFF / 32), I_D = (DFF / 64) * (DM / 32), I_IN = (DM / 64) * (IN_DIM / 32), I_SSO = (DI / 64) * (DM / 32), I_SQ = (DM / 64) * (DM / 32), I_PLE = (PLE / 64) * (DM / 32);
    constexpr int NITEMS = 2 * I_GU + 2 * I_D + I_IN + I_SSO + 3 * I_SQ + I_PLE;
    bf16_t* const wpot = (bf16_t*)(F.ws + WS_WPOT);
    for (int it = gw; it < NITEMS; it += NGW) {
        int r = it;
        if (r < I_GU) { const int nb = 2 * DFF / 32, kb = r / nb, n0 = (r % nb) * 32; p0_transpose_item(F.in[I_WGU1], DM, 2 * DFF, F.in[I_NFFN1], wgu1, kb * 64, n0, map_gu(n0), scr, lane); continue; } r -= I_GU;
        if (r < I_GU) { const int nb = 2 * DFF / 32, kb = r / nb, n0 = (r % nb) * 32; p0_transpose_item(F.in[I_WGU2], DM, 2 * DFF, F.in[I_NFFN2], wgu2, kb * 64, n0, map_gu(n0), scr, lane); continue; } r -= I_GU;
        if (r < I_D) { const int nb = DM / 32, kb = r / nb, n0 = (r % nb) * 32; p0_transpose_item(F.in[I_WD1], DFF, DM, nullptr, wd1, kb * 64, n0, n0, scr, lane); continue; } r -= I_D;
        if (r < I_D) { const int nb = DM / 32, kb = r / nb, n0 = (r % nb) * 32; p0_transpose_item(F.in[I_WD2], DFF, DM, nullptr, wd2, kb * 64, n0, n0, scr, lane); continue; } r -= I_D;
        if (r < I_IN) { const int nb = IN_DIM / 32, kb = r / nb, n0 = (r % nb) * 32; p0_transpose_item(F.in[I_WIN], DM, IN_DIM, F.in[I_NMIX], win, kb * 64, n0, map_win(n0), scr, lane); continue; } r -= I_IN;
        if (r < I_SSO) { const int nb = DM / 32, kb = r / nb, n0 = (r % nb) * 32; p0_transpose_item(F.in[I_WSSO], DI, DM, F.in[I_NSSD], wsso, kb * 64, n0, n0, scr, lane); continue; } r -= I_SSO;
        if (r < I_SQ) { const int nb = DM / 32, kb = r / nb, n0 = (r % nb) * 32; p0_transpose_item(F.in[I_WO], DM, DM, nullptr, wo, kb * 64, n0, n0, scr, lane); continue; } r -= I_SQ;
        if (r < I_SQ) { const int nb = DM / 32, kb = r / nb, n0 = (r % nb) * 32; p0_transpose_item(F.in[I_WPG], DM, DM, F.in[I_NPLE], wpg, kb * 64, n0, n0, scr, lane); continue; } r -= I_SQ;
        if (r < I_SQ) { const int nb = DM / 32, kb = r / nb, n0 = (r % nb) * 32; p0_transpose_item(F.in[I_WPOUT], PD, DM, F.in[I_PSCALE], wpot, kb * 64, n0, n0, scr, lane); continue; } r -= I_SQ;
        { const int nb = DM / 32, kb = r / nb, n0 = (r % nb) * 32; p0_transpose_item(F.in[I_WPLE], PLE, DM, nullptr, wple, kb * 64, n0, n0, scr, lane); }
    }
    {
        bf16_t* const wgrp = (bf16_t*)(F.ws + WS_WGRP); const float* Wg = F.in[I_WPGRP];
        for (int e = F.vcu * NTHREADS + F.tid; e < 4 * 256 * 256 / 8; e += F.G * NTHREADS) {
            const f32x4 a = *(const GAS f32x4*)(Wg + (size_t)e * 8), b = *(const GAS f32x4*)(Wg + (size_t)e * 8 + 4);
            u32x4 o; o.x = pk2(a.x, a.y); o.y = pk2(a.z, a.w); o.z = pk2(b.x, b.y); o.w = pk2(b.z, b.w);
            *(GAS u32x4*)(wgrp + (size_t)e * 8) = o; }
    }
    {
        bf16_t* const XB = (bf16_t*)(F.ws + WS_XB); bf16_t* const PB = (bf16_t*)(F.ws + WS_PB); float* const stA = (float*)(F.ws + WS_STATS_A);
        for (int m = gw; m < M; m += NGW) {
            const float* xrow = (m < MP) ? F.in[I_XP] + (size_t)m * DM : F.in[I_XS] + (size_t)(m - MP) * DM;
            const GAS f32x4* xr = (const GAS f32x4*)xrow + lane;
            f32x4 v[4]; float s = 0.f;
#pragma unroll
            for (int j = 0; j < 4; ++j) { v[j] = xr[64 * j]; s += (v[j].x * v[j].x + v[j].y * v[j].y) + (v[j].z * v[j].z + v[j].w * v[j].w); }
            s = wave_sum(s);
            GAS u32x2* o8 = (GAS u32x2*)(XB + (size_t)m * DM) + lane;
#pragma unroll
            for (int j = 0; j < 4; ++j) { u32x2 w; w.x = pk2(v[j].x, v[j].y); w.y = pk2(v[j].z, v[j].w); o8[64 * j] = w; }
            if (lane < 16) *(GAS float*)(stA + (size_t)m * 16 + lane) = (lane == 0) ? s : 0.f;
            const float* prow = (m < MP) ? F.in[I_PP] + (size_t)m * PLE : F.in[I_PS] + (size_t)(m - MP) * PLE;
            const f32x4 pv = *((const GAS f32x4*)prow + lane);
            u32x2 w; w.x = pk2(pv.x, pv.y); w.y = pk2(pv.z, pv.w); *((GAS u32x2*)(PB + (size_t)m * PLE) + lane) = w;
        }
    }
}


typedef short v4i16_t __attribute__((ext_vector_type(4)));
constexpr int IMG_B = 0, IMG_C = 32768, IMG_X = 65536, TAB_ACS = RING_BYTES + 1024, TAB_DT = TAB_ACS + 2048, TAB_SD = TAB_DT + 2048;
constexpr int NCHUNK = SEQ / 128;
template <bool XS> __device__ __forceinline__ int img_off(int row, int ch) { return XS ? 256 * row + 16 * (ch ^ ((row & 7) << 1)) : 256 * row + 16 * (ch ^ (((row & 3) << 2) | ((row >> 2) & 3))); }
__device__ __forceinline__ bf16x8 tr_pair(const LAS unsigned char* p0, const LAS unsigned char* p1) {
    const v4i16_t a = __builtin_amdgcn_ds_read_tr16_b64_v4i16((LAS v4i16_t*)p0), b = __builtin_amdgcn_ds_read_tr16_b64_v4i16((LAS v4i16_t*)p1);
    return (bf16x8){a[0], a[1], a[2], a[3], b[0], b[1], b[2], b[3]};
}
__device__ __forceinline__ void ssd_tables(Frame& F, size_t row0, int g) {
    LAS float* const acs = (LAS float*)(F.lds + TAB_ACS); LAS float* const dtl = (LAS float*)(F.lds + TAB_DT); LAS float* const sdec = (LAS float*)(F.lds + TAB_SD);
    const float* const DT = (const float*)(F.ws + WS_DT);
    if (F.wave < 4) {
        const int r = F.wave, lane = F.lane, head = g * HPG + r;
        const float Ah = -__expf(*(const GAS float*)(F.in[I_ALOG] + head));
        const float d0 = *(const GAS float*)(DT + (row0 + 2 * lane) * 32 + head), d1 = *(const GAS float*)(DT + (row0 + 2 * lane + 1) * 32 + head);
        const float a0 = d0 * Ah, a1 = d1 * Ah, loc = a0 + a1;
        float inc = loc;
#pragma unroll
        for (int o = 1; o < 64; o <<= 1) { const float t = __shfl_up(inc, o); if (lane >= o) inc += t; }
        const float exc = inc - loc;
        acs[(2 * lane) * 4 + r] = exc + a0; acs[(2 * lane + 1) * 4 + r] = inc;
        dtl[(2 * lane) * 4 + r] = d0; dtl[(2 * lane + 1) * 4 + r] = d1;
    }
    __syncthreads();
    { const int s = F.tid >> 2, r = F.tid & 3; sdec[s * 4 + r] = __expf(acs[127 * 4 + r] - acs[s * 4 + r]) * dtl[s * 4 + r]; }
    __syncthreads();
}
__device__ __forceinline__ void ssd_fill_conv(Frame& F, size_t row0, int b, int c, int g) {
    const int t = F.tid;
    int kind, cc, run;
    if (t < 256) { kind = 0; cc = t & 31; run = t >> 5; } else if (t < 384) { kind = 1; cc = (t - 256) & 15; run = (t - 256) >> 4; } else { kind = 2; cc = (t - 384) & 15; run = (t - 384) >> 4; }
    const int gch = (kind == 0 ? g * 256 : (kind == 1 ? DI + g * DSTATE : DI + NG * DSTATE + g * DSTATE)) + 8 * cc;
    bf16_t* const XBC = (bf16_t*)(F.ws + WS_XBC); const bf16_t* const HALO = (const bf16_t*)(F.ws + WS_HALO);
    const float* const convw = F.in[I_CONVW]; const float* const convb = F.in[I_CONVB];
    u32x4 raw[19];
#pragma unroll
    for (int i = 0; i < 19; ++i) {
        if (i < 3 && run == 0) { if (c == 0) raw[i] = (u32x4){0u, 0u, 0u, 0u}; else raw[i] = *(const GAS u32x4*)(HALO + ((((size_t)b * 16 + c) * 3 + i) * CD) + gch); }
        else raw[i] = *(const GAS u32x4*)(XBC + (row0 + 16 * run + i - 3) * CD + gch); }
    float cw[4][8], cb[8];
#pragma unroll
    for (int k = 0; k < 4; ++k) { const f32x4 a = *(const GAS f32x4*)(convw + (size_t)k * CD + gch), b_ = *(const GAS f32x4*)(convw + (size_t)k * CD + gch + 4);
        cw[k][0] = a.x; cw[k][1] = a.y; cw[k][2] = a.z; cw[k][3] = a.w; cw[k][4] = b_.x; cw[k][5] = b_.y; cw[k][6] = b_.z; cw[k][7] = b_.w; }
    { const f32x4 a = *(const GAS f32x4*)(convb + gch), b_ = *(const GAS f32x4*)(convb + gch + 4); cb[0] = a.x; cb[1] = a.y; cb[2] = a.z; cb[3] = a.w; cb[4] = b_.x; cb[5] = b_.y; cb[6] = b_.z; cb[7] = b_.w; }
    asm volatile("s_waitcnt vmcnt(0)" ::: "memory");
    __syncthreads();
    LAS unsigned char* const img = F.lds + (kind == 0 ? IMG_X + (cc >> 4) * 32768 : IMG_B);
    const LAS float* const sdec = (const LAS float*)(F.lds + TAB_SD);
    const int chl = cc & 15, hr = cc >> 3;
#pragma unroll
    for (int i = 0; i < 16; ++i) {
        const int s = 16 * run + i;
        float o[8];
#pragma unroll
        for (int j2 = 0; j2 < 4; ++j2) {
            const unsigned w0 = raw[i][j2], w1 = raw[i + 1][j2], w2 = raw[i + 2][j2], w3 = raw[i + 3][j2];
            const float lo = cb[2 * j2] + cw[0][2 * j2] * bflo(w0) + cw[1][2 * j2] * bflo(w1) + cw[2][2 * j2] * bflo(w2) + cw[3][2 * j2] * bflo(w3);
            const float hi = cb[2 * j2 + 1] + cw[0][2 * j2 + 1] * bfhi(w0) + cw[1][2 * j2 + 1] * bfhi(w1) + cw[2][2 * j2 + 1] * bfhi(w2) + cw[3][2 * j2 + 1] * bfhi(w3);
            o[2 * j2] = silu_f(lo); o[2 * j2 + 1] = silu_f(hi);
        }
        u32x4 pk; pk.x = cvt_pk_bf16(o[0], o[1]); pk.y = cvt_pk_bf16(o[2], o[3]); pk.z = cvt_pk_bf16(o[4], o[5]); pk.w = cvt_pk_bf16(o[6], o[7]);
        *(GAS u32x4*)(XBC + (row0 + s) * CD + gch) = pk;
        if (kind == 0) { const float sc = sdec[s * 4 + hr];
            pk.x = cvt_pk_bf16(o[0] * sc, o[1] * sc); pk.y = cvt_pk_bf16(o[2] * sc, o[3] * sc); pk.z = cvt_pk_bf16(o[4] * sc, o[5] * sc); pk.w = cvt_pk_bf16(o[6] * sc, o[7] * sc); }
        if (kind != 2) *(LAS u32x4*)(img + img_off<false>(s, chl)) = pk;
    }
}
__device__ __forceinline__ void ssd_fill_copy(Frame& F, size_t row0, int g) {
    const int t = F.tid;
    int kind, cc, run;
    if (t < 256) { kind = 0; cc = t & 31; run = t >> 5; } else if (t < 384) { kind = 1; cc = (t - 256) & 15; run = (t - 256) >> 4; } else { kind = 2; cc = (t - 384) & 15; run = (t - 384) >> 4; }
    const int gch = (kind == 0 ? g * 256 : (kind == 1 ? DI + g * DSTATE : DI + NG * DSTATE + g * DSTATE)) + 8 * cc;
    const bf16_t* const XBC = (const bf16_t*)(F.ws + WS_XBC);
    u32x4 raw[16];
#pragma unroll
    for (int i = 0; i < 16; ++i) raw[i] = *(const GAS u32x4*)(XBC + (row0 + 16 * run + i) * CD + gch);
    LAS unsigned char* const img = F.lds + (kind == 0 ? IMG_X + (cc >> 4) * 32768 : (kind == 1 ? IMG_B : IMG_C));
    const int chl = cc & 15;
#pragma unroll
    for (int i = 0; i < 16; ++i) { const int s = 16 * run + i; *(LAS u32x4*)(img + (kind == 0 ? img_off<true>(s, chl) : img_off<false>(s, chl))) = raw[i]; }
}
__device__ __forceinline__ void ssd_states_phase(Frame& F) {
    bf16_t* const ST = (bf16_t*)(F.ws + WS_HPREV);
    float* const CDEC = (float*)(F.ws + WS_CDEC);
    const int w = F.wave, lane = F.lane, ql = lane & 15, gq = lane >> 4, qq = ql >> 2, pp = ql & 3, r = w >> 1, nh = w & 1;
    for (int it = F.vcu; it < BATCH * NCHUNK * NG; it += F.G) {
        const int g = it & 7, c = (it >> 3) & (NCHUNK - 1), b = it >> 7;
        const size_t row0 = (size_t)b * SEQ + (size_t)c * 128;
        ssd_tables(F, row0, g);
        ssd_fill_conv(F, row0, b, c, g);
        __syncthreads();
        f32x4 acc[4][4];
#pragma unroll
        for (int i = 0; i < 4; ++i)
#pragma unroll
            for (int j = 0; j < 4; ++j) acc[i][j] = (f32x4){0.f, 0.f, 0.f, 0.f};
        const LAS unsigned char* const bimg = F.lds + IMG_B; const LAS unsigned char* const ximg = F.lds + IMG_X + (r >> 1) * 32768;
#pragma unroll
        for (int ks = 0; ks < 4; ++ks) {
            bf16x8 af[4], xf[4];
            const int rw0 = 32 * ks + 8 * gq + qq;
#pragma unroll
            for (int nf = 0; nf < 4; ++nf) { const int col = 64 * nh + 16 * nf + 4 * pp;
                af[nf] = tr_pair(bimg + img_off<false>(rw0, col >> 3) + 2 * (col & 7), bimg + img_off<false>(rw0 + 4, col >> 3) + 2 * (col & 7)); }
#pragma unroll
            for (int pf = 0; pf < 4; ++pf) { const int col = 64 * (r & 1) + 16 * pf + 4 * pp;
                xf[pf] = tr_pair(ximg + img_off<false>(rw0, col >> 3) + 2 * (col & 7), ximg + img_off<false>(rw0 + 4, col >> 3) + 2 * (col & 7)); }
#pragma unroll
            for (int nf = 0; nf < 4; ++nf)
#pragma unroll
                for (int pf = 0; pf < 4; ++pf) acc[nf][pf] = __builtin_amdgcn_mfma_f32_16x16x32_bf16(af[nf], xf[pf], acc[nf][pf], 0, 0, 0);
        }
        const int head = g * HPG + r;
        bf16_t* const stp = ST + ((((size_t)b * NCHUNK + c) * NH + head) * HD) * DSTATE;
#pragma unroll
        for (int pf = 0; pf < 4; ++pf)
#pragma unroll
            for (int nf = 0; nf < 4; ++nf) { u32x2 o; o.x = cvt_pk_bf16(acc[nf][pf][0], acc[nf][pf][1]); o.y = cvt_pk_bf16(acc[nf][pf][2], acc[nf][pf][3]);
                *(GAS u32x2*)(stp + (size_t)(16 * pf + ql) * DSTATE + 64 * nh + 16 * nf + 4 * gq) = o; }
        if (F.tid < 4) { const LAS float* acs = (const LAS float*)(F.lds + TAB_ACS); *(GAS float*)(CDEC + ((size_t)b * NCHUNK + c) * NH + g * HPG + F.tid) = __expf(acs[127 * 4 + F.tid]); }
        __syncthreads();
    }
}
__device__ __forceinline__ void ssd_scan_phase(Frame& F) {
    bf16_t* const HP = (bf16_t*)(F.ws + WS_HPREV); const float* const CDEC = (const float*)(F.ws + WS_CDEC); float* const hout = F.out + O_SSM_P;
    const int gt = F.vcu * NTHREADS + F.tid, NT = F.G * NTHREADS;
    constexpr int PER = NH * HD * DSTATE / 8;
    for (int e = gt; e < BATCH * PER; e += NT) {
        const int b = e / PER, i8 = e % PER, head = i8 / (HD * DSTATE / 8);
        u32x4 stv[NCHUNK];
#pragma unroll
        for (int c = 0; c < NCHUNK; ++c) stv[c] = *(const GAS u32x4*)(HP + (((size_t)b * NCHUNK + c) * (size_t)PER + i8) * 8);
        f32x4 h0 = (f32x4){0.f, 0.f, 0.f, 0.f}, h1 = h0;
#pragma unroll
        for (int c = 0; c < NCHUNK; ++c) {
            if (c > 0) *(GAS u32x4*)(HP + (((size_t)b * NCHUNK + c) * (size_t)PER + i8) * 8) = pg8::pack8(h0, h1);
            const float d = *(const GAS float*)(CDEC + ((size_t)b * NCHUNK + c) * NH + head);
            f32x4 s0, s1; pg8::unpack8(stv[c], s0, s1);
            h0 = h0 * d + s0; h1 = h1 * d + s1;
        }
        *(GAS f32x4*)(hout + ((size_t)b * PER + i8) * 8) = h0; *(GAS f32x4*)(hout + ((size_t)b * PER + i8) * 8 + 4) = h1;
    }
}
__device__ __forceinline__ void ssd_out_phase(Frame& F) {
    const bf16_t* const HP = (const bf16_t*)(F.ws + WS_HPREV); bf16_t* const ZY = (bf16_t*)(F.ws + WS_Z);
    const int w = F.wave, lane = F.lane, ql = lane & 15, gq = lane >> 4, qq = ql >> 2, pp = ql & 3, q0 = 16 * w;
    const LAS float* const acs = (const LAS float*)(F.lds + TAB_ACS); const LAS float* const dtl = (const LAS float*)(F.lds + TAB_DT);
    int cfo[4], bbo[4], hbo[4], xbo[2][4];
#pragma unroll
    for (int ks = 0; ks < 4; ++ks) { cfo[ks] = IMG_C + img_off<false>(q0 + ql, 4 * ks + gq); bbo[ks] = IMG_B + img_off<false>(ql, 4 * ks + gq); hbo[ks] = img_off<false>(ql, 4 * ks + gq); }
#pragma unroll
    for (int rr = 0; rr < 2; ++rr)
#pragma unroll
        for (int pf = 0; pf < 4; ++pf) xbo[rr][pf] = IMG_X + img_off<true>(4 * gq + qq, 8 * rr + 2 * pf + (pp >> 1)) + 8 * (pp & 1);
    for (int it = F.vcu; it < BATCH * NCHUNK * NG; it += F.G) {
        const int g = it & 7, c = (it >> 3) & (NCHUNK - 1), b = it >> 7;
        const size_t row0 = (size_t)b * SEQ + (size_t)c * 128;
        ssd_tables(F, row0, g);
        ssd_fill_copy(F, row0, g);
        __syncthreads();
        bf16x8 cf[4];
#pragma unroll
        for (int ks = 0; ks < 4; ++ks) cf[ks] = *(const LAS bf16x8*)(F.lds + cfo[ks]);
        bf16_t* const zp = ZY + (row0 + q0 + ql) * DI + g * 256 + 4 * gq;
        const LAS float* const acs_l = acs + 16 * gq; const LAS float* const dtl_l = dtl + 16 * gq;
        f32x4 acc[4][4];
        float aq[4];
#pragma unroll
        for (int r = 0; r < 4; ++r) { aq[r] = acs[(q0 + ql) * 4 + r];
#pragma unroll
            for (int pf = 0; pf < 4; ++pf) acc[r][pf] = (f32x4){0.f, 0.f, 0.f, 0.f}; }
        u32x4 hreg[8];
        if (c > 0) {
            const u32x4* hsrc = (const u32x4*)(HP + ((((size_t)b * NCHUNK + c) * NH + g * HPG) * HD) * DSTATE) + F.tid;
#pragma unroll
            for (int i = 0; i < 8; ++i) hreg[i] = *(const GAS u32x4*)(hsrc + 512 * i);
        }
#pragma unroll
        for (int ks = 0; ks < 4; ++ks) if (2 * ks <= w) {
            f32x4 cb[2];
#pragma unroll
            for (int hf = 0; hf < 2; ++hf) { cb[hf] = (f32x4){0.f, 0.f, 0.f, 0.f};
                if (2 * ks + hf <= w) {
#pragma unroll
                    for (int kn = 0; kn < 4; ++kn) { const bf16x8 bfr = *(const LAS bf16x8*)(F.lds + bbo[kn] + 4096 * (2 * ks + hf)); cb[hf] = __builtin_amdgcn_mfma_f32_16x16x32_bf16(bfr, cf[kn], cb[hf], 0, 0, 0); } } }
#pragma unroll
            for (int r = 0; r < 4; ++r) {
                const float Dh = *(const GAS float*)(F.in[I_DSKIP] + g * HPG + r);
                float v[8];
#pragma unroll
                for (int hf = 0; hf < 2; ++hf) { const int sf = 2 * ks + hf;
#pragma unroll
                    for (int rg = 0; rg < 4; ++rg) { const int sl = 4 * gq + rg;
                        float val = 0.f;
                        if (sf <= w) { const float as = acs_l[64 * sf + 4 * rg + r], d = dtl_l[64 * sf + 4 * rg + r];
                            val = cb[hf][rg] * __expf(aq[r] - as) * d;
                            if (sf == w) { if (sl > ql) val = 0.f; else if (sl == ql) val += Dh; } }
                        v[4 * hf + rg] = val; } }
                u32x4 pk; pk.x = cvt_pk_bf16(v[0], v[1]); pk.y = cvt_pk_bf16(v[2], v[3]); pk.z = cvt_pk_bf16(v[4], v[5]); pk.w = cvt_pk_bf16(v[6], v[7]);
                const bf16x8 wf = __builtin_bit_cast(bf16x8, pk);
#pragma unroll
                for (int pf = 0; pf < 4; ++pf) {
                    const LAS unsigned char* const xb = F.lds + xbo[r & 1][pf] + (r >> 1) * 32768 + 8192 * ks;
                    const bf16x8 xf = tr_pair(xb, xb + 4096);
                    acc[r][pf] = __builtin_amdgcn_mfma_f32_16x16x32_bf16(xf, wf, acc[r][pf], 0, 0, 0); }
            }
        }
        if (c > 0) {
            __syncthreads();
#pragma unroll
            for (int i = 0; i < 8; ++i) { const int e = F.tid + 512 * i, hr_ = e >> 10, p_ = (e >> 4) & 63, ch_ = e & 15;
                *(LAS u32x4*)(F.lds + IMG_X + hr_ * 16384 + img_off<false>(p_, ch_)) = hreg[i]; }
            __syncthreads();
#pragma unroll
            for (int r = 0; r < 4; ++r) { const float eaq = __expf(aq[r]);
#pragma unroll
                for (int pf = 0; pf < 4; ++pf) { f32x4 yo = (f32x4){0.f, 0.f, 0.f, 0.f};
#pragma unroll
                    for (int ks = 0; ks < 4; ++ks) { const bf16x8 hf_ = *(const LAS bf16x8*)(F.lds + IMG_X + r * 16384 + hbo[ks] + 4096 * pf); yo = __builtin_amdgcn_mfma_f32_16x16x32_bf16(hf_, cf[ks], yo, 0, 0, 0); }
                    acc[r][pf] += yo * eaq; } }
        }
        float ssum = 0.f;
#pragma unroll
        for (int r = 0; r < 4; ++r)
#pragma unroll
            for (int pf = 0; pf < 4; ++pf) {
                const u32x2 zz = *(const GAS u32x2*)(zp + r * 64 + 16 * pf);
                const f32x4 y = acc[r][pf] * (f32x4){bflo(zz.x), bfhi(zz.x), bflo(zz.y), bfhi(zz.y)};
                acc[r][pf] = y; ssum += (y[0] * y[0] + y[1] * y[1]) + (y[2] * y[2] + y[3] * y[3]); }
        ssum += __shfl_xor(ssum, 16); ssum += __shfl_xor(ssum, 32);
        const float rsn = __builtin_amdgcn_rsqf(ssum * (1.0f / 256.0f) + EPS);
#pragma unroll
        for (int r = 0; r < 4; ++r)
#pragma unroll
            for (int pf = 0; pf < 4; ++pf) { u32x2 o; o.x = cvt_pk_bf16(acc[r][pf][0] * rsn, acc[r][pf][1] * rsn); o.y = cvt_pk_bf16(acc[r][pf][2] * rsn, acc[r][pf][3] * rsn);
                *(GAS u32x2*)(zp + r * 64 + 16 * pf) = o; }
        __syncthreads();
    }
}

__device__ __forceinline__ void ssd_seq_phase(Frame& F) {
    const int r = F.wave & 3, nh = F.wave >> 2, lane = F.lane, idx = r * 64 + lane;
    LAS float* const bc = (LAS float*)F.lds;
    LAS float* const lxs = bc + 2048;
    LAS float* const yp = bc + 4096;
    LAS float* const ldt = bc + 8192; LAS float* const ssq = bc + 8192 + 32;
    const bf16_t* const XBC = (const bf16_t*)(F.ws + WS_XBC); const bf16_t* const Zs = (const bf16_t*)(F.ws + WS_Z); bf16_t* const YN = (bf16_t*)(F.ws + WS_Z);
    const float* const DT = (const float*)(F.ws + WS_DT);
    const float* const convw = F.in[I_CONVW]; const float* const convb = F.in[I_CONVB];
    for (int it = F.vcu; it < DECB * NG; it += F.G) {
        const int b = it >> 3, g = it & 7, head = g * HPG + r;
        const size_t row0 = (size_t)MP + (size_t)b * DECS;
        const int xch = g * 256 + idx;
        {
            const int ch = (nh == 0) ? ((idx < 128) ? (DI + g * DSTATE + idx) : (DI + NG * DSTATE + g * DSTATE + (idx - 128))) : xch;
            float cw[4];
#pragma unroll
            for (int k = 0; k < 4; ++k) cw[k] = *(const GAS float*)(convw + (size_t)k * CD + ch);
            const float cbv = *(const GAS float*)(convb + ch);
            const float* cs = F.in[I_CONV] + (size_t)b * 3 * CD;
            float x3 = *(const GAS float*)(cs + ch), x2 = *(const GAS float*)(cs + CD + ch), x1 = *(const GAS float*)(cs + 2 * CD + ch);
            LAS float* const dst = (nh == 0) ? bc : lxs;
#pragma unroll
            for (int j = 0; j < 8; ++j) {
                const float xr = bf2f(*(const GAS bf16_t*)(XBC + (row0 + j) * CD + ch));
                const float cx = cbv + cw[0] * x3 + cw[1] * x2 + cw[2] * x1 + cw[3] * xr; x3 = x2; x2 = x1; x1 = xr;
                dst[j * 256 + idx] = silu_f(cx);
            }
            if (nh == 1 && lane < 8) ldt[lane * 4 + r] = *(const GAS float*)(DT + (row0 + lane) * 32 + head);
        }
        __syncthreads();
        {
            const float Ah = -__expf(*(const GAS float*)(F.in[I_ALOG] + head));
            const int pg = lane >> 4, nc = lane & 15;
            f32x4 h[16];
            const float* const hin = F.in[I_SSM] + (((size_t)b * NH + head) * HD + 16 * pg) * DSTATE + 64 * nh + 4 * nc;
#pragma unroll
            for (int i = 0; i < 16; ++i) h[i] = *(const GAS f32x4*)(hin + (size_t)i * DSTATE);
            for (int j = 0; j < 8; ++j) {
                const float dtv = ldt[j * 4 + r], dA = __expf(dtv * Ah);
                const f32x4 Bv = *(const LAS f32x4*)(bc + j * 256 + 64 * nh + 4 * nc), Cv = *(const LAS f32x4*)(bc + j * 256 + 128 + 64 * nh + 4 * nc);
                float part[16];
#pragma unroll
                for (int i4 = 0; i4 < 4; ++i4) { const f32x4 xs4 = *(const LAS f32x4*)(lxs + j * 256 + r * 64 + 16 * pg + 4 * i4);
#pragma unroll
                    for (int k = 0; k < 4; ++k) { const int i = 4 * i4 + k; const float dx = dtv * xs4[k];
                        h[i] = h[i] * dA + Bv * dx;
                        part[i] = (Cv.x * h[i].x + Cv.y * h[i].y) + (Cv.z * h[i].z + Cv.w * h[i].w); } }
#pragma unroll
                for (int i = 0; i < 8; ++i) { const bool up = (nc & 8) != 0; const float keep = up ? part[i + 8] : part[i], send = up ? part[i] : part[i + 8]; part[i] = keep + __shfl_xor(send, 8); }
#pragma unroll
                for (int i = 0; i < 4; ++i) { const bool up = (nc & 4) != 0; const float keep = up ? part[i + 4] : part[i], send = up ? part[i] : part[i + 4]; part[i] = keep + __shfl_xor(send, 4); }
#pragma unroll
                for (int i = 0; i < 2; ++i) { const bool up = (nc & 2) != 0; const float keep = up ? part[i + 2] : part[i], send = up ? part[i] : part[i + 2]; part[i] = keep + __shfl_xor(send, 2); }
                { const bool up = (nc & 1) != 0; const float keep = up ? part[1] : part[0], send = up ? part[0] : part[1]; part[0] = keep + __shfl_xor(send, 1); }
                yp[(j * 2 + nh) * 256 + r * 64 + 16 * pg + nc] = part[0];
            }
            float* const hout = F.out + O_SSM_S + (((size_t)b * NH + head) * HD + 16 * pg) * DSTATE + 64 * nh + 4 * nc;
#pragma unroll
            for (int i = 0; i < 16; ++i) *(GAS f32x4*)(hout + (size_t)i * DSTATE) = h[i];
        }
        __syncthreads();
        float ygv[4];
        {
            const float Dh = *(const GAS float*)(F.in[I_DSKIP] + head);
#pragma unroll
            for (int jj = 0; jj < 4; ++jj) { const int j = 4 * nh + jj;
                const float y = (yp[(j * 2) * 256 + idx] + yp[(j * 2 + 1) * 256 + idx]) + Dh * lxs[j * 256 + idx];
                ygv[jj] = y * bf2f(*(const GAS bf16_t*)(Zs + (row0 + j) * DI + xch));
                const float ss = wave_sum(ygv[jj] * ygv[jj]);
                if (lane == 0) ssq[j * 4 + r] = ss; }
        }
        __syncthreads();
#pragma unroll
        for (int jj = 0; jj < 4; ++jj) { const int j = 4 * nh + jj;
            const f32x4 s4 = *(const LAS f32x4*)(ssq + j * 4);
            const float rsn = __builtin_amdgcn_rsqf(((s4.x + s4.y) + (s4.z + s4.w)) * (1.0f / 256.0f) + EPS);
            *(GAS bf16_t*)(YN + (row0 + j) * DI + xch) = (bf16_t)f2bf(ygv[jj] * rsn); }
        __syncthreads();
    }
}
template <int W> __device__ __forceinline__ void pool_run(const bf16_t* V, bf16_t* PO, int run, int cv) {
    const int row0 = run * 16, t0 = row0 & (SEQ - 1);
    u32x4 raw[16 + W - 1];
#pragma unroll
    for (int e = 0; e < 16 + W - 1; ++e) {
        const int dt_ = e - (W - 1);
        if (t0 + dt_ >= 0) raw[e] = *(const GAS u32x4*)(V + (size_t)(row0 + dt_) * PD + cv); else raw[e] = (u32x4){0u, 0u, 0u, 0u};
    }
    f32x4 s0 = (f32x4){0.f, 0.f, 0.f, 0.f}, s1 = s0;
#pragma unroll
    for (int e = 0; e < W - 1; ++e) { f32x4 x0, x1; pg8::unpack8(raw[e], x0, x1); s0 += x0; s1 += x1; }
#pragma unroll
    for (int i = 0; i < 16; ++i) {
        f32x4 c0, c1; pg8::unpack8(raw[i + W - 1], c0, c1);
        s0 += c0; s1 += c1;
        const int t = t0 + i; const float ic = 1.0f / (float)((t + 1 < W) ? t + 1 : W);
        const f32x4 o0 = s0 * ic - c0, o1 = s1 * ic - c1;
        u32x4 o; o.x = pk2(o0.x, o0.y); o.y = pk2(o0.z, o0.w); o.z = pk2(o1.x, o1.y); o.w = pk2(o1.z, o1.w);
        *(GAS u32x4*)(PO + (size_t)(row0 + i) * PD + cv) = o;
        f32x4 x0, x1; pg8::unpack8(raw[i], x0, x1); s0 -= x0; s1 -= x1;
    }
}
__device__ __forceinline__ void pool_phase(Frame& F) {
    const bf16_t* const V = (const bf16_t*)(F.ws + WS_V); bf16_t* const PO = (bf16_t*)(F.ws + WS_POOLED);
    const float* const sp = F.in[I_POOL];
    const int gt = F.vcu * NTHREADS + F.tid, NT = F.G * NTHREADS;
    for (int e = gt; e < (MP / 16) * 128; e += NT) {
        const int c32 = e & 31, rl = (e >> 5) & 1, grp = (e >> 6) & 3, run = (e >> 8) * 2 + rl, cv = (grp * 32 + c32) * 8;
        if (grp == 0) pool_run<2>(V, PO, run, cv); else if (grp == 1) pool_run<4>(V, PO, run, cv); else if (grp == 2) pool_run<8>(V, PO, run, cv); else pool_run<16>(V, PO, run, cv);
    }
    for (int e = gt; e < MS * 128; e += NT) {
        const int row = MP + (e >> 7), cv = (e & 127) * 8, w = 2 << (cv >> 8);
        const int rr = row - MP, b = rr >> 3, t = rr & 7;
        float s[8];
#pragma unroll
        for (int j = 0; j < 8; ++j) s[j] = 0.f;
        f32x4 c0, c1; pg8::unpack8(*(const GAS u32x4*)(V + (size_t)row * PD + cv), c0, c1);
        for (int k = 0; k < w; ++k) { const int tt = t - k; f32x4 a0, a1;
            if (tt >= 0) pg8::unpack8(*(const GAS u32x4*)(V + (size_t)(row - k) * PD + cv), a0, a1);
            else { const float* p = sp + ((size_t)b * PBUF + (PBUF + tt)) * PD + cv; a0 = *(const GAS f32x4*)p; a1 = *(const GAS f32x4*)(p + 4); }
            s[0] += a0.x; s[1] += a0.y; s[2] += a0.z; s[3] += a0.w; s[4] += a1.x; s[5] += a1.y; s[6] += a1.z; s[7] += a1.w; }
        const float ic = 1.0f / (float)w;
        f32x4 o0 = (f32x4){s[0] * ic, s[1] * ic, s[2] * ic, s[3] * ic} - c0, o1 = (f32x4){s[4] * ic, s[5] * ic, s[6] * ic, s[7] * ic} - c1;
        u32x4 o; o.x = pk2(o0.x, o0.y); o.y = pk2(o0.z, o0.w); o.z = pk2(o1.x, o1.y); o.w = pk2(o1.z, o1.w);
        *(GAS u32x4*)(PO + (size_t)row * PD + cv) = o;
    }
    float* const ops = F.out + O_POOL_S;
    for (int e = gt; e < DECB * 7 * (PD / 4); e += NT) {
        const int c4 = e & 255, i = (e >> 8) % 7, b = (e >> 8) / 7;
        *(GAS f32x4*)(ops + ((size_t)b * PBUF + i) * PD + c4 * 4) = *(const GAS f32x4*)(sp + ((size_t)b * PBUF + 8 + i) * PD + c4 * 4);
    }
}
__device__ __forceinline__ void final_phase(Frame& F) {
    const int gw = F.vcu * NWAVES + F.wave, NGW = F.G * NWAVES, lane = F.lane;
    const float* const st = (const float*)(F.ws + WS_STATS_A); const float* const gf = F.in[I_NFINAL];
    f32x4 gv[4];
#pragma unroll
    for (int j = 0; j < 4; ++j) gv[j] = *((const GAS f32x4*)gf + lane + 64 * j);
    for (int m = gw; m < M; m += NGW) {
        const GAS f32x4* sp = (const GAS f32x4*)(st + (size_t)m * 16);
        const f32x4 a = sp[0], b = sp[1], c = sp[2], d = sp[3]; const f32x4 s = (a + b) + (c + d);
        const float rs = __builtin_amdgcn_rsqf(((s[0] + s[1]) + (s[2] + s[3])) * (1.0f / 1024.0f) + EPS);
        GAS f32x4* yr = (GAS f32x4*)(F.out + (size_t)m * DM) + lane;
#pragma unroll
        for (int j = 0; j < 4; ++j) yr[64 * j] = yr[64 * j] * rs * gv[j];
    }
}

constexpr int NPHASES = 15;
struct Args { const float* in[30]; float* out; unsigned char* ws; int ph_lo, ph_hi, li, pad; };
__global__ void __launch_bounds__(NTHREADS, 2) mk_fwd(Args args) {
    extern __shared__ __attribute__((aligned(16))) unsigned char lds[];
    Frame F;
    F.lds = (LAS unsigned char*)lds;
    F.MISC = (volatile LAS unsigned*)(F.lds + MISC_OFF);
    F.tid = threadIdx.x; F.lane = F.tid & 63; F.wave = __builtin_amdgcn_readfirstlane(F.tid >> 6);
    F.G = gridDim.x; { const int bx = blockIdx.x; F.vcu = (F.G % 8 == 0) ? (bx % 8) * (F.G / 8) + bx / 8 : bx; }
    F.ws = args.ws; F.out = args.out; F.ctl = (gu32*)(args.ws + WS_CTL);
#pragma unroll
    for (int i = 0; i < 30; ++i) F.in[i] = args.in[i];
    for (int u = F.tid; u < (LDS_BYTES - LDSCTL_OFF) / 4; u += NTHREADS) ((LAS unsigned*)(F.lds + LDSCTL_OFF))[u] = 0u;
    __syncthreads();
    const int lo = args.ph_lo, hi = args.ph_hi;
    XcdBarrier bar; bar.bar = (unsigned*)(F.ctl + CW_BAR); bar.x = 0; bar.st = nullptr;
    if (hi - lo > 1) bar = xcd_barrier_post((unsigned*)(F.ctl + CW_BAR), F.MISC + 8);
#ifndef PHMASK
#define PHMASK 0x7fff
#endif
#define IN(k) (((PHMASK >> (k)) & 1) && lo <= (k) && (k) < hi)
#define SEAM(k) do { if (IN(k) && IN((k) + 1)) xcd_barrier(bar); } while (0)
#define PH_BEGIN(k) if (IN(k)) { auto body_ = [&]() __attribute__((always_inline))
#define PH_END(k) ; body_(); if ((REP_MASK >> (k)) & 1) { xcd_barrier(bar); body_(); } } SEAM(k);

    bf16_t* const XB = (bf16_t*)(F.ws + WS_XB); bf16_t* const HB = (bf16_t*)(F.ws + WS_HB); bf16_t* const ACT = (bf16_t*)(F.ws + WS_ACT);
    bf16_t* const Zb = (bf16_t*)(F.ws + WS_Z); bf16_t* const XBCb = (bf16_t*)(F.ws + WS_XBC); bf16_t* const Vb = (bf16_t*)(F.ws + WS_V); bf16_t* const GATES = (bf16_t*)(F.ws + WS_GATES);
    bf16_t* const POOLED = (bf16_t*)(F.ws + WS_POOLED); bf16_t* const MERGED = (bf16_t*)(F.ws + WS_MERGED); bf16_t* const Qb = (bf16_t*)(F.ws + WS_Q); bf16_t* const PB = (bf16_t*)(F.ws + WS_PB);
    float* const T1 = (float*)(F.ws + WS_T1); float* const stA = (float*)(F.ws + WS_STATS_A); float* const stB = (float*)(F.ws + WS_STATS_B); float* const DTb = (float*)(F.ws + WS_DT);
    float* const H = F.out + O_Y;
    pg8::StaticOrder S;

    PH_BEGIN(0) { p0_prologue(F); } PH_END(0)
    PH_BEGIN(1) {
        pg8::Gemm g{XB, (const bf16_t*)(F.ws + WS_WGU1), M, 2 * DFF, DM, DM, 0}; S.init(M, 2 * DFF, F.G, (int)blockIdx.x);
        pg8::Epi E{}; E.kind = pg8::EK_GU; E.stats_in = stA; E.obf = ACT; E.ldo = DFF;
        pg8::gemm_phase(F.lds, g, S, E);
        pg8::Gemm g2{(const bf16_t*)(F.ws + WS_WPOT), (const bf16_t*)(F.ws + WS_WGRP), DM, DM, 256, DM, 256}; S.init_tail(DM, DM, F.G, (int)blockIdx.x);
        pg8::Epi E2{}; E2.kind = pg8::EK_BF16; E2.obf = (bf16_t*)(F.ws + WS_W2); E2.ldo = DM;
        pg8::gemm_phase(F.lds, g2, S, E2);
    } PH_END(1)
    PH_BEGIN(2) {
        pg8::Gemm g{ACT, (const bf16_t*)(F.ws + WS_WD1), M, DM, DFF, DFF, 0}; S.init(MP, DM, F.G, (int)blockIdx.x);
        pg8::Epi E{}; E.kind = pg8::EK_RES; E.coef = 0.5f; E.res_p = F.in[I_XP]; E.res_s = F.in[I_XS]; E.of32 = H; E.obf = HB; E.stats_out = stB;
        pg8::gemm_phase(F.lds, g, S, E);
        pg8::gemm_small(F.lds, g, E, MP, MS, F.G, (int)blockIdx.x);
    } PH_END(2)
    PH_BEGIN(3) {
        pg8::Gemm g{HB, (const bf16_t*)(F.ws + WS_WIN), M, NIN, DM, DM, 0}; S.init(M, NIN, F.G, (int)blockIdx.x);
        pg8::Epi E{}; E.kind = pg8::EK_WIN; E.stats_in = stB; E.Z = Zb; E.XBC = XBCb; E.V = Vb; E.GATES = GATES; E.HALO = (bf16_t*)(F.ws + WS_HALO); E.DT = DTb; E.dt_bias = F.in[I_DTB];
        E.conv_p = F.out + O_CONV_P; E.conv_s = F.out + O_CONV_S; E.pool_p = F.out + O_POOL_P; E.pool_s = F.out + O_POOL_S;
        pg8::gemm_phase(F.lds, g, S, E);
    } PH_END(3)
    PH_BEGIN(4) { ssd_states_phase(F); pool_phase(F); } PH_END(4)
    PH_BEGIN(5) { ssd_scan_phase(F); } PH_END(5)
    PH_BEGIN(6) { ssd_out_phase(F); ssd_seq_phase(F); } PH_END(6)
    PH_BEGIN(7) {
        pg8::Gemm g{Zb, (const bf16_t*)(F.ws + WS_WSSO), M, DM, DI, DI, 0}; S.init(MP, DM, F.G, (int)blockIdx.x);
        pg8::Epi E{}; E.kind = pg8::EK_T1; E.gates = GATES; E.of32 = T1;
        pg8::gemm_phase(F.lds, g, S, E);
        pg8::gemm_small(F.lds, g, E, MP, MS, F.G, (int)blockIdx.x);
    } PH_END(7)
    PH_BEGIN(8) {
        pg8::Gemm g{POOLED, (const bf16_t*)(F.ws + WS_W2), M, DM, DM, DM, 0}; S.init(MP, DM, F.G, (int)blockIdx.x);
        pg8::Epi E{}; E.kind = pg8::EK_MERGE; E.gates = GATES; E.res_p = T1; E.obf = MERGED;
        pg8::gemm_phase(F.lds, g, S, E);
        pg8::gemm_small(F.lds, g, E, MP, MS, F.G, (int)blockIdx.x);
    } PH_END(8)
    PH_BEGIN(9) {
        pg8::Gemm g{MERGED, (const bf16_t*)(F.ws + WS_WO), M, DM, DM, DM, 0}; S.init(MP, DM, F.G, (int)blockIdx.x);
        pg8::Epi E{}; E.kind = pg8::EK_RES; E.coef = 1.0f; E.res_p = H; E.res_s = H + (size_t)MP * DM; E.of32 = H; E.obf = HB; E.stats_out = stA;
        pg8::gemm_phase(F.lds, g, S, E);
        pg8::gemm_small(F.lds, g, E, MP, MS, F.G, (int)blockIdx.x);
    } PH_END(9)
    PH_BEGIN(10) {
        pg8::Gemm g{HB, (const bf16_t*)(F.ws + WS_WGU2), M, 2 * DFF, DM, DM, 0}; S.init(M, 2 * DFF, F.G, (int)blockIdx.x);
        pg8::Epi E{}; E.kind = pg8::EK_GU; E.stats_in = stA; E.obf = ACT; E.ldo = DFF;
        pg8::gemm_phase(F.lds, g, S, E);
    } PH_END(10)
    PH_BEGIN(11) {
        pg8::Gemm g{ACT, (const bf16_t*)(F.ws + WS_WD2), M, DM, DFF, DFF, 0}; S.init(MP, DM, F.G, (int)blockIdx.x);
        pg8::Epi E{}; E.kind = pg8::EK_RES; E.coef = 0.5f; E.res_p = H; E.res_s = H + (size_t)MP * DM; E.of32 = H; E.obf = HB; E.stats_out = stB;
        pg8::gemm_phase(F.lds, g, S, E);
        pg8::gemm_small(F.lds, g, E, MP, MS, F.G, (int)blockIdx.x);
    } PH_END(11)
    PH_BEGIN(12) {
        pg8::Gemm g{PB, (const bf16_t*)(F.ws + WS_WPLE), M, DM, PLE, PLE, 0}; S.init(MP, DM, F.G, (int)blockIdx.x);
        pg8::Epi E{}; E.kind = pg8::EK_BF16; E.obf = Qb; E.ldo = DM;
        pg8::gemm_phase(F.lds, g, S, E);
        pg8::gemm_small(F.lds, g, E, MP, MS, F.G, (int)blockIdx.x);
    } PH_END(12)
    PH_BEGIN(13) {
        pg8::Gemm g{HB, (const bf16_t*)(F.ws + WS_WPG), M, DM, DM, DM, 0}; S.init(MP, DM, F.G, (int)blockIdx.x);
        pg8::Epi E{}; E.kind = pg8::EK_PLE; E.stats_in = stB; E.q = Qb; E.of32 = H; E.stats_out = stA;
        pg8::gemm_phase(F.lds, g, S, E);
        pg8::gemm_small(F.lds, g, E, MP, MS, F.G, (int)blockIdx.x);
    } PH_END(13)
    PH_BEGIN(14) { final_phase(F); } PH_END(14)
#undef IN
#undef SEAM
#undef PH_BEGIN
#undef PH_END
}

extern "C" void kernel_launch(void* const* d_in, const int* in_sizes, int n_in, void* d_out, int out_size, void* d_ws, size_t ws_size, hipStream_t stream) {
    static int grid = 0;
    if (grid == 0) {
        if (n_in != 30 || in_sizes[0] != MP * DM || (size_t)out_size != O_END || ws_size < WS_END) {
            fprintf(stderr, "kernel_launch: shape mismatch: n_in %d in0 %d out %d ws %zu (need %zu)\n", n_in, n_in > 0 ? in_sizes[0] : -1, out_size, ws_size, (size_t)WS_END); grid = -1; return; }
        int dev = 0, cus = 0, per_cu = 0;
        if (hipGetDevice(&dev) != hipSuccess || hipDeviceGetAttribute(&cus, hipDeviceAttributeMultiprocessorCount, dev) != hipSuccess) { grid = -1; return; }
        if (hipFuncSetAttribute((const void*)mk_fwd, hipFuncAttributeMaxDynamicSharedMemorySize, LDS_BYTES) != hipSuccess) { fprintf(stderr, "kernel_launch: hipFuncSetAttribute failed\n"); grid = -1; return; }
        if (hipOccupancyMaxActiveBlocksPerMultiprocessor(&per_cu, (const void*)mk_fwd, NTHREADS, LDS_BYTES) != hipSuccess || per_cu < 1)
            fprintf(stderr, "kernel_launch: occupancy query reports %d workgroups per CU\n", per_cu);
        (void)hipGetLastError();
        grid = cus;
    }
    if (grid < 0) return;
    if (hipMemsetAsync((char*)d_ws + WS_CTL, 0, CTL_ZERO_BYTES, stream) != hipSuccess) { fprintf(stderr, "kernel_launch: memset failed\n"); return; }
    Args a{};
    for (int i = 0; i < 30; ++i) a.in[i] = (const float*)d_in[i];
    a.out = (float*)d_out; a.ws = (unsigned char*)d_ws;
#if MK_MULTI_LAUNCH
    for (int ph = 0; ph < NPHASES; ++ph) { a.ph_lo = ph; a.ph_hi = ph + 1; a.li = ph;
        hipLaunchKernelGGL(mk_fwd, dim3(grid), dim3(NTHREADS), LDS_BYTES, stream, a); }
#else
    a.ph_lo = 0; a.ph_hi = NPHASES; a.li = 0;
    hipLaunchKernelGGL(mk_fwd, dim3(grid), dim3(NTHREADS), LDS_BYTES, stream, a);
#endif
}
```

```cpp
#include <hip/hip_runtime.h>
#include <cstdio>
#include <cstdint>

#define REP_MASK 0x0
#ifndef MK_MULTI_LAUNCH
#define MK_MULTI_LAUNCH 0
#endif

#define GAS __attribute__((address_space(1)))
#define LAS __attribute__((address_space(3)))
typedef unsigned short bf16_t;
typedef short bf16x8 __attribute__((ext_vector_type(8)));
typedef float f32x4 __attribute__((ext_vector_type(4)));
typedef float f32x2 __attribute__((ext_vector_type(2)));
typedef unsigned u32x4 __attribute__((ext_vector_type(4)));
typedef unsigned u32x2 __attribute__((ext_vector_type(2)));
typedef GAS unsigned gu32;

constexpr int DM = 1024, BATCH = 8, SEQ = 2048, DECB = 128, DECS = 8;
constexpr int MP = BATCH * SEQ, MS = DECB * DECS, M = MP + MS;
constexpr int DI = 2048, HD = 64, NH = 32, NG = 8, HPG = 4, DSTATE = 128, CD = 4096;
constexpr int PD = 1024, PBUF = 15, DFF = 2816, PLE = 256;
constexpr int IN_DIM = 9248, NIN = 9472;
constexpr float EPS = 1e-6f;
constexpr int NWAVES = 8, NTHREADS = 512;

constexpr size_t MiB = 1u << 20;
constexpr size_t WS_CTL = 0, CTL_ZERO_BYTES = 1 * MiB;
constexpr size_t WS_STATS_A = 2 * MiB, WS_STATS_B = 4 * MiB, WS_DT = 6 * MiB, WS_CDEC = 9 * MiB;
constexpr size_t WS_WGU1 = 10 * MiB, WS_WD1 = 21 * MiB, WS_WIN = 27 * MiB, WS_WSSO = 46 * MiB, WS_W2 = 50 * MiB, WS_WO = 52 * MiB,
                 WS_WGU2 = 54 * MiB, WS_WD2 = 65 * MiB, WS_WPG = 71 * MiB, WS_WPLE = 73 * MiB, WS_PB = 74 * MiB, WS_WPOT = 480 * MiB, WS_WGRP = 483 * MiB;
constexpr size_t WS_Z = 84 * MiB, WS_XBC = 152 * MiB, WS_V = 288 * MiB, WS_GATES = 322 * MiB, WS_HB = 390 * MiB, WS_HPREV = 424 * MiB, WS_HALO = 488 * MiB, WS_END = 492 * MiB;
constexpr size_t WS_ACT = WS_XBC, WS_T1 = WS_XBC, WS_MERGED = 220 * MiB, WS_Q = WS_V, WS_XB = WS_HB;
static_assert(WS_STATS_A + (size_t)M * 16 * 4 <= WS_STATS_B && WS_STATS_B + (size_t)M * 16 * 4 <= WS_DT && WS_DT + (size_t)M * 32 * 4 <= WS_WGU1, "ws map (small)");
static_assert(WS_WGU1 + (size_t)2 * DFF * DM * 2 <= WS_WD1 && WS_WD1 + (size_t)DM * DFF * 2 <= WS_WIN && WS_WIN + (size_t)NIN * DM * 2 <= WS_WSSO && WS_WSSO + (size_t)DM * DI * 2 <= WS_W2, "ws map (w1)");
static_assert(WS_WGU2 + (size_t)2 * DFF * DM * 2 <= WS_WD2 && WS_WD2 + (size_t)DM * DFF * 2 <= WS_WPG && WS_WPLE + (size_t)DM * PLE * 2 <= WS_PB && WS_PB + (size_t)M * PLE * 2 <= WS_Z, "ws map (w2)");
static_assert(WS_Z + (size_t)M * DI * 2 <= WS_XBC && WS_XBC + (size_t)M * CD * 2 <= WS_V && WS_V + (size_t)M * PD * 2 <= WS_GATES && WS_GATES + (size_t)M * 2 * DM * 2 <= WS_HB &&
              WS_HB + (size_t)M * DM * 2 <= WS_HPREV && WS_HPREV + (size_t)BATCH * 16 * NH * HD * DSTATE * 2 <= WS_END, "ws map (act)");
static_assert(WS_ACT + (size_t)M * DFF * 2 <= WS_V && WS_T1 + (size_t)M * DM * 4 <= WS_MERGED && WS_MERGED + (size_t)M * DM * 2 <= WS_V, "ws overlays");
constexpr int CW_BAR = 4096;

constexpr size_t O_Y = 0, O_SSM_P = (size_t)M * DM, O_CONV_P = O_SSM_P + (size_t)BATCH * NH * HD * DSTATE, O_POOL_P = O_CONV_P + (size_t)BATCH * 3 * CD,
                 O_SSM_S = O_POOL_P + (size_t)BATCH * PBUF * PD, O_CONV_S = O_SSM_S + (size_t)DECB * NH * HD * DSTATE, O_POOL_S = O_CONV_S + (size_t)DECB * 3 * CD,
                 O_END = O_POOL_S + (size_t)DECB * PBUF * PD;

constexpr int RING_BYTES = 131072, LDSCTL_OFF = RING_BYTES, MISC_OFF = LDSCTL_OFF + 320, LDS_BYTES = 147456;

#define RLX_AGENT __ATOMIC_RELAXED, __HIP_MEMORY_SCOPE_AGENT
#define LDS_WAIT() asm volatile("s_waitcnt lgkmcnt(0)" ::: "memory")
#define VM_WAIT() asm volatile("s_waitcnt vmcnt(0)" ::: "memory")

__device__ __forceinline__ unsigned f2bf(float f) { unsigned u = __builtin_bit_cast(unsigned, f); return (u + 0x7fffu + ((u >> 16) & 1u)) >> 16; }
__device__ __forceinline__ unsigned cvt_pk_bf16(float lo, float hi);
__device__ __forceinline__ unsigned pk2(float lo, float hi) { return cvt_pk_bf16(lo, hi); }
__device__ __forceinline__ float bf2f(unsigned b) { return __builtin_bit_cast(float, b << 16); }
__device__ __forceinline__ float bflo(unsigned w) { return __builtin_bit_cast(float, w << 16); }
__device__ __forceinline__ float bfhi(unsigned w) { return __builtin_bit_cast(float, w & 0xffff0000u); }
typedef __bf16 bf16x2_t __attribute__((ext_vector_type(2)));
__device__ __forceinline__ unsigned cvt_pk_bf16(float lo, float hi) { const bf16x2_t v = {(__bf16)lo, (__bf16)hi}; return __builtin_bit_cast(unsigned, v); }
__device__ __forceinline__ float sigm_f(float x) { return __builtin_amdgcn_rcpf(1.0f + __expf(-x)); }
__device__ __forceinline__ float silu_f(float x) { return x * __builtin_amdgcn_rcpf(1.0f + __expf(-x)); }
__device__ __forceinline__ float wave_sum(float v) {
#pragma unroll
    for (int o = 1; o < 64; o <<= 1) v += __shfl_xor(v, o);
    return v;
}

struct Frame {
    LAS unsigned char* lds;
    volatile LAS unsigned* MISC;
    gu32* ctl;
    int tid, lane, wave, vcu, G;
    unsigned char* ws;
    float* out;
    const float* in[30];
};
enum { I_XP = 0, I_XS, I_SSM, I_CONV, I_POOL, I_PP, I_PS, I_NFFN1, I_WGU1, I_WD1, I_NMIX, I_WIN, I_CONVW, I_CONVB, I_DTB, I_ALOG, I_DSKIP, I_NSSD, I_WSSO, I_WPGRP, I_PSCALE,
       I_WPOUT, I_WO, I_NFFN2, I_WGU2, I_WD2, I_NPLE, I_WPG, I_WPLE, I_NFINAL };

namespace pg8 {
constexpr int BM = 256, BK = 64, HALF = 128, HTB = HALF * BK * 2, STAGE_BYTES = 8 * HTB, NXCD = 8, WGM = 8;
__host__ __device__ __forceinline__ int lds_byte(int r, int c) { const int st = (r >> 4) * 2 + (c >> 5), rr = r & 15, cc = c & 31, ob = rr * 64 + cc * 2; return st * 1024 + (ob ^ (((ob >> 9) & 1) << 5)); }
__host__ __device__ __forceinline__ void stage_rc(int b, int& R, int& C) { const int st = b / 1024, sb = b % 1024, swz = sb ^ (((sb >> 9) & 1) << 5); R = (st >> 1) * 16 + swz / 64; C = (st & 1) * 32 + (swz % 64) / 2; }
__host__ __device__ __forceinline__ int perm32(int rho) { const int n = rho >> 4, i = rho & 15; return 8 * (i >> 2) + 4 * n + (i & 3); }
struct Unit { int pm, pn; };
struct Gemm { const bf16_t* A; const bf16_t* Bt; int M, N, K; int lda; int a_pn_step; };
struct StaticOrder {
    int nM, nN, nwg, G, c;
    __host__ __device__ void init(int M_, int N_, int G_, int c_) { nM = M_ / BM; nN = N_ / BM; nwg = nM * nN; G = G_; c = c_; }
    __host__ __device__ void init_tail(int M_, int N_, int G_, int c_) { init(M_, N_, G_, (G_ - 1) - c_); }
    __host__ __device__ bool next(int i, Unit& u) const {
        const long L = (long)i * G + c; if (L >= nwg) return false;
        int wgid = (int)L; { const int q = nwg / NXCD, r = nwg % NXCD, xcd = wgid % NXCD, off = wgid / NXCD; wgid = (xcd < r ? xcd * (q + 1) : r * (q + 1) + (xcd - r) * q) + off; }
        const int nig = WGM * nN, gid = wgid / nig, fm = gid * WGM, gsz = (nM - fm) < WGM ? (nM - fm) : WGM;
        u.pm = fm + ((wgid % nig) % gsz); u.pn = (wgid % nig) / gsz; return true;
    }
};

enum EpiKind { EK_GU = 1, EK_RES = 2, EK_WIN = 3, EK_T1 = 4, EK_MERGE = 5, EK_BF16 = 6, EK_PLE = 7 };
struct Epi {
    const float* stats_in;
    float* stats_out;
    bf16_t* obf;
    float* of32;
    const float* res_p; const float* res_s;
    const bf16_t* res_bf;
    const bf16_t* gates;
    const bf16_t* q;
    bf16_t *Z, *XBC, *V, *GATES, *HALO; float* DT; const float* dt_bias; float *conv_p, *conv_s, *pool_p, *pool_s;
    int kind; int ldo; float coef; int pad;
};

__device__ __forceinline__ u32x4 pack8(const f32x4 a, const f32x4 b) { u32x4 w; w.x = cvt_pk_bf16(a[0], a[1]); w.y = cvt_pk_bf16(a[2], a[3]); w.z = cvt_pk_bf16(b[0], b[1]); w.w = cvt_pk_bf16(b[2], b[3]); return w; }
__device__ __forceinline__ void unpack8(const u32x4 w, f32x4& a, f32x4& b) { a = (f32x4){bflo(w.x), bfhi(w.x), bflo(w.y), bfhi(w.y)}; b = (f32x4){bflo(w.z), bfhi(w.z), bflo(w.w), bfhi(w.w)}; }

__device__ __forceinline__ float row_rs(const float* stats, int row) {
    if (!stats) return 1.0f;
    const GAS f32x4* sp = (const GAS f32x4*)(stats + (size_t)row * 16);
    const f32x4 a = sp[0], b = sp[1], c = sp[2], d = sp[3]; const f32x4 s = (a + b) + (c + d);
    return __builtin_amdgcn_rsqf(((s[0] + s[1]) + (s[2] + s[3])) * (1.0f / 1024.0f) + EPS);
}
__device__ __forceinline__ float softplus_f(float x) { const float e = __expf(-fabsf(x)); const float l = (e < 0.01f) ? e * (1.0f - e * (0.5f - e * (1.0f / 3.0f))) : __logf(1.0f + e); return fmaxf(x, 0.f) + l; }

__device__ __forceinline__ void epilogue(const Epi& E, const f32x4 (&acc)[2][2][4][2], const Unit& u, int wr, int wc, int fr, int fq) {
    const int rowb = u.pm * BM + wr * 64 + fr;
    const int cin = wc * 32 + 8 * fq;
    if (E.kind == EK_GU) {
#pragma unroll
        for (int ai = 0; ai < 2; ++ai)
#pragma unroll
            for (int m = 0; m < 4; ++m) { const int row = rowb + ai * HALF + m * 16; const float r = row_rs(E.stats_in, row);
                const f32x4 g0 = acc[ai][0][m][0] * r, u0 = acc[ai][1][m][0] * r, g1 = acc[ai][0][m][1] * r, u1 = acc[ai][1][m][1] * r;
                const f32x4 o0 = (f32x4){silu_f(g0[0]) * u0[0], silu_f(g0[1]) * u0[1], silu_f(g0[2]) * u0[2], silu_f(g0[3]) * u0[3]};
                const f32x4 o1 = (f32x4){silu_f(g1[0]) * u1[0], silu_f(g1[1]) * u1[1], silu_f(g1[2]) * u1[2], silu_f(g1[3]) * u1[3]};
                *(GAS u32x4*)(E.obf + (size_t)row * E.ldo + u.pn * HALF + cin) = pack8(o0, o1); }
    } else if (E.kind == EK_RES) {
#pragma unroll
        for (int ai = 0; ai < 2; ++ai)
#pragma unroll
            for (int m = 0; m < 4; ++m) { const int row = rowb + ai * HALF + m * 16;
                float ss = 0.f;
#pragma unroll
                for (int bj = 0; bj < 2; ++bj) { const int col = u.pn * BM + bj * HALF + cin;
                    f32x4 r0, r1;
                    if (E.res_p) { const float* rp = (row < MP) ? E.res_p + (size_t)row * DM : E.res_s + (size_t)(row - MP) * DM; r0 = *(const GAS f32x4*)(rp + col); r1 = *(const GAS f32x4*)(rp + col + 4); }
                    else unpack8(*(const GAS u32x4*)(E.res_bf + (size_t)row * DM + col), r0, r1);
                    const f32x4 h0 = r0 + acc[ai][bj][m][0] * E.coef, h1 = r1 + acc[ai][bj][m][1] * E.coef;
                    *(GAS u32x4*)(E.obf + (size_t)row * DM + col) = pack8(h0, h1);
                    ss += (h0[0] * h0[0] + h0[1] * h0[1]) + (h0[2] * h0[2] + h0[3] * h0[3]) + (h1[0] * h1[0] + h1[1] * h1[1]) + (h1[2] * h1[2] + h1[3] * h1[3]); }
                ss += __shfl_xor(ss, 16); ss += __shfl_xor(ss, 32);
                if (fq == 0) *(GAS float*)(E.stats_out + (size_t)row * 16 + u.pn * 4 + wc) = ss; }
    } else if (E.kind == EK_WIN) {
        const int pn = u.pn;
        if (pn < 8) {
            const int colt = pn * BM + cin;
#pragma unroll
            for (int ai = 0; ai < 2; ++ai)
#pragma unroll
                for (int m = 0; m < 4; ++m) { const int row = rowb + ai * HALF + m * 16; const float r = row_rs(E.stats_in, row);
#pragma unroll
                    for (int bj = 0; bj < 2; ++bj) { f32x4 v0 = acc[ai][bj][m][0] * r, v1 = acc[ai][bj][m][1] * r;
#pragma unroll
                        for (int j = 0; j < 4; ++j) { v0[j] = silu_f(v0[j]); v1[j] = silu_f(v1[j]); }
                        *(GAS u32x4*)(E.Z + (size_t)row * DI + colt + bj * HALF) = pack8(v0, v1); } }
        } else if (pn >= 28 && pn < 36) {
            const int colt = (pn - 28) * BM + cin;
#pragma unroll
            for (int ai = 0; ai < 2; ++ai)
#pragma unroll
                for (int m = 0; m < 4; ++m) { const int row = rowb + ai * HALF + m * 16; const float r = row_rs(E.stats_in, row);
#pragma unroll
                    for (int bj = 0; bj < 2; ++bj) { f32x4 v0 = acc[ai][bj][m][0] * r, v1 = acc[ai][bj][m][1] * r;
#pragma unroll
                        for (int j = 0; j < 4; ++j) { v0[j] = sigm_f(v0[j]); v1[j] = sigm_f(v1[j]); }
                        *(GAS u32x4*)(E.GATES + (size_t)row * (2 * DM) + colt + bj * HALF) = pack8(v0, v1); } }
        } else if (pn < 28) {
            const bool isx = pn < 24; bf16_t* const O = isx ? E.XBC : E.V; const int ldo = isx ? CD : PD; const int colt = (isx ? pn - 8 : pn - 24) * BM + cin;
            const int keep = isx ? 3 : PBUF;
#pragma unroll
            for (int ai = 0; ai < 2; ++ai)
#pragma unroll
                for (int m = 0; m < 4; ++m) { const int row = rowb + ai * HALF + m * 16; const float r = row_rs(E.stats_in, row);
                    float* sp = nullptr;
                    if (row < MP) { const int sb = row >> 11, st = row & (SEQ - 1); if (st >= SEQ - keep) sp = (isx ? E.conv_p : E.pool_p) + ((size_t)sb * keep + (st - (SEQ - keep))) * ldo + colt; }
                    else { const int sb = (row - MP) >> 3, st = (row - MP) & 7; const int si = st - (DECS - keep); if (si >= 0) sp = (isx ? E.conv_s : E.pool_s) + ((size_t)sb * keep + si) * ldo + colt; }
                    bf16_t* hp = nullptr;
                    if (isx && row < MP) { const int st = row & (SEQ - 1), tm = st & 127; if (tm >= 125 && st < SEQ - 3) hp = E.HALO + ((((size_t)(row >> 11) * 16 + (st >> 7) + 1) * 3 + (tm - 125)) * CD) + colt; }
#pragma unroll
                    for (int bj = 0; bj < 2; ++bj) { const f32x4 v0 = acc[ai][bj][m][0] * r, v1 = acc[ai][bj][m][1] * r;
                        const u32x4 pk = pack8(v0, v1);
                        *(GAS u32x4*)(O + (size_t)row * ldo + colt + bj * HALF) = pk;
                        if (hp) *(GAS u32x4*)(hp + bj * HALF) = pk;
                        if (sp) { *(GAS f32x4*)(sp + bj * HALF) = v0; *(GAS f32x4*)(sp + bj * HALF + 4) = v1; } } }
        } else if (wc == 0) {
            const f32x4 b0 = *(const GAS f32x4*)(E.dt_bias + 8 * fq), b1 = *(const GAS f32x4*)(E.dt_bias + 8 * fq + 4);
#pragma unroll
            for (int ai = 0; ai < 2; ++ai)
#pragma unroll
                for (int m = 0; m < 4; ++m) { const int row = rowb + ai * HALF + m * 16; const float r = row_rs(E.stats_in, row);
                    f32x4 v0 = acc[ai][0][m][0] * r + b0, v1 = acc[ai][0][m][1] * r + b1;
#pragma unroll
                    for (int j = 0; j < 4; ++j) { v0[j] = softplus_f(v0[j]); v1[j] = softplus_f(v1[j]); }
                    *(GAS f32x4*)(E.DT + (size_t)row * 32 + 8 * fq) = v0; *(GAS f32x4*)(E.DT + (size_t)row * 32 + 8 * fq + 4) = v1; }
        }
    } else if (E.kind == EK_T1) {
#pragma unroll
        for (int ai = 0; ai < 2; ++ai)
#pragma unroll
            for (int m = 0; m < 4; ++m) { const int row = rowb + ai * HALF + m * 16;
#pragma unroll
                for (int bj = 0; bj < 2; ++bj) { const int col = u.pn * BM + bj * HALF + cin;
                    f32x4 g0, g1; unpack8(*(const GAS u32x4*)(E.gates + (size_t)row * (2 * DM) + col), g0, g1);
                    *(GAS u32x4*)(E.obf + (size_t)row * DM + col) = pack8(g0 * acc[ai][bj][m][0], g1 * acc[ai][bj][m][1]); } }
    } else if (E.kind == EK_MERGE) {
#pragma unroll
        for (int ai = 0; ai < 2; ++ai)
#pragma unroll
            for (int m = 0; m < 4; ++m) { const int row = rowb + ai * HALF + m * 16;
#pragma unroll
                for (int bj = 0; bj < 2; ++bj) { const int col = u.pn * BM + bj * HALF + cin;
                    f32x4 g0, g1; unpack8(*(const GAS u32x4*)(E.gates + (size_t)row * (2 * DM) + DM + col), g0, g1);
                    f32x4 t0, t1; unpack8(*(const GAS u32x4*)(E.res_bf + (size_t)row * DM + col), t0, t1);
                    *(GAS u32x4*)(E.obf + (size_t)row * DM + col) = pack8(t0 + g0 * acc[ai][bj][m][0], t1 + g1 * acc[ai][bj][m][1]); } }
    } else if (E.kind == EK_BF16) {
#pragma unroll
        for (int ai = 0; ai < 2; ++ai)
#pragma unroll
            for (int m = 0; m < 4; ++m) { const int row = rowb + ai * HALF + m * 16;
#pragma unroll
                for (int bj = 0; bj < 2; ++bj) { const int col = u.pn * BM + bj * HALF + cin;
                    *(GAS u32x4*)(E.obf + (size_t)row * E.ldo + col) = pack8(acc[ai][bj][m][0], acc[ai][bj][m][1]); } }
    } else if (E.kind == EK_PLE) {
#pragma unroll
        for (int ai = 0; ai < 2; ++ai)
#pragma unroll
            for (int m = 0; m < 4; ++m) { const int row = rowb + ai * HALF + m * 16; const float r = row_rs(E.stats_in, row);
                float ss = 0.f;
#pragma unroll
                for (int bj = 0; bj < 2; ++bj) { const int col = u.pn * BM + bj * HALF + cin;
                    f32x4 q0, q1; unpack8(*(const GAS u32x4*)(E.q + (size_t)row * DM + col), q0, q1);
                    f32x4 r0, r1; unpack8(*(const GAS u32x4*)(E.res_bf + (size_t)row * DM + col), r0, r1);
                    f32x4 h0, h1;
#pragma unroll
                    for (int j = 0; j < 4; ++j) { h0[j] = r0[j] + sigm_f(acc[ai][bj][m][0][j] * r) * q0[j]; h1[j] = r1[j] + sigm_f(acc[ai][bj][m][1][j] * r) * q1[j]; }
                    *(GAS f32x4*)(E.of32 + (size_t)row * DM + col) = h0; *(GAS f32x4*)(E.of32 + (size_t)row * DM + col + 4) = h1;
                    ss += (h0[0] * h0[0] + h0[1] * h0[1]) + (h0[2] * h0[2] + h0[3] * h0[3]) + (h1[0] * h1[0] + h1[1] * h1[1]) + (h1[2] * h1[2] + h1[3] * h1[3]); }
                ss += __shfl_xor(ss, 16); ss += __shfl_xor(ss, 32);
                if (fq == 0) *(GAS float*)(E.stats_out + (size_t)row * 16 + u.pn * 4 + wc) = ss; }
    }
}


__device__ __forceinline__ void epi_seg(const Epi& E, int row, int col, f32x4 v0, f32x4 v1, int lane) {
    if (E.kind == EK_RES) {
        f32x4 r0, r1;
        if (E.res_p) { const float* rp = ((row < MP) ? E.res_p + (size_t)row * DM : E.res_s + (size_t)(row - MP) * DM) + col; r0 = *(const GAS f32x4*)rp; r1 = *(const GAS f32x4*)(rp + 4); }
        else unpack8(*(const GAS u32x4*)(E.res_bf + (size_t)row * DM + col), r0, r1);
        const f32x4 h0 = r0 + v0 * E.coef, h1 = r1 + v1 * E.coef;
        *(GAS u32x4*)(E.obf + (size_t)row * DM + col) = pack8(h0, h1);
        float ss = (h0[0] * h0[0] + h0[1] * h0[1]) + (h0[2] * h0[2] + h0[3] * h0[3]) + (h1[0] * h1[0] + h1[1] * h1[1]) + (h1[2] * h1[2] + h1[3] * h1[3]);
        ss += __shfl_xor(ss, 1); ss += __shfl_xor(ss, 2); ss += __shfl_xor(ss, 4);
        if ((lane & 7) == 0) *(GAS float*)(E.stats_out + (size_t)row * 16 + (col >> 6)) = ss;
    } else if (E.kind == EK_T1) {
        f32x4 g0, g1; unpack8(*(const GAS u32x4*)(E.gates + (size_t)row * (2 * DM) + col), g0, g1);
        *(GAS u32x4*)(E.obf + (size_t)row * DM + col) = pack8(g0 * v0, g1 * v1);
    } else if (E.kind == EK_MERGE) {
        f32x4 g0, g1; unpack8(*(const GAS u32x4*)(E.gates + (size_t)row * (2 * DM) + DM + col), g0, g1);
        f32x4 t0, t1; unpack8(*(const GAS u32x4*)(E.res_bf + (size_t)row * DM + col), t0, t1);
        *(GAS u32x4*)(E.obf + (size_t)row * DM + col) = pack8(t0 + g0 * v0, t1 + g1 * v1);
    } else if (E.kind == EK_BF16) {
        *(GAS u32x4*)(E.obf + (size_t)row * E.ldo + col) = pack8(v0, v1);
    } else if (E.kind == EK_PLE) {
        const float r = row_rs(E.stats_in, row);
        f32x4 q0, q1; unpack8(*(const GAS u32x4*)(E.q + (size_t)row * DM + col), q0, q1);
        f32x4 r0, r1; unpack8(*(const GAS u32x4*)(E.res_bf + (size_t)row * DM + col), r0, r1);
        f32x4 h0, h1;
#pragma unroll
        for (int j = 0; j < 4; ++j) { h0[j] = r0[j] + sigm_f(v0[j] * r) * q0[j]; h1[j] = r1[j] + sigm_f(v1[j] * r) * q1[j]; }
        *(GAS f32x4*)(E.of32 + (size_t)row * DM + col) = h0; *(GAS f32x4*)(E.of32 + (size_t)row * DM + col + 4) = h1;
        float ss = (h0[0] * h0[0] + h0[1] * h0[1]) + (h0[2] * h0[2] + h0[3] * h0[3]) + (h1[0] * h1[0] + h1[1] * h1[1]) + (h1[2] * h1[2] + h1[3] * h1[3]);
        ss += __shfl_xor(ss, 1); ss += __shfl_xor(ss, 2); ss += __shfl_xor(ss, 4);
        if ((lane & 7) == 0) *(GAS float*)(E.stats_out + (size_t)row * 16 + (col >> 6)) = ss;
    }
}
__device__ __forceinline__ void small_tile_sum(LAS unsigned char* lds, const bf16_t* A, int lda, const bf16_t* Bt, int K, int r0, int c0, f32x4& v0, f32x4& v1) {
    const int tid = threadIdx.x, wid = __builtin_amdgcn_readfirstlane(tid >> 6), lane = tid & 63, ql = lane & 15, gq = lane >> 4;
    f32x4 acc[4][4];
#pragma unroll
    for (int m = 0; m < 4; ++m)
#pragma unroll
        for (int n = 0; n < 4; ++n) acc[m][n] = (f32x4){0.f, 0.f, 0.f, 0.f};
    const bf16_t* const ap = A + (size_t)(r0 + ql) * lda + 8 * gq + 32 * wid;
    const bf16_t* const bp = Bt + (size_t)(c0 + ql) * K + 8 * gq + 32 * wid;
    const int nst = (K / 32 - wid + 7) / 8;
    bf16x8 af[4][4], bf[4][4];
#pragma unroll
    for (int u = 0; u < 4; ++u) if (u < nst) {
#pragma unroll
        for (int m = 0; m < 4; ++m) { af[u][m] = *(const GAS bf16x8*)(ap + (size_t)(16 * m) * lda + 256 * u); bf[u][m] = *(const GAS bf16x8*)(bp + (size_t)(16 * m) * K + 256 * u); } }
    for (int i = 0; i < nst; i += 4) {
#pragma unroll
        for (int u = 0; u < 4; ++u) if (i + u < nst) {
#pragma unroll
            for (int m = 0; m < 4; ++m)
#pragma unroll
                for (int n = 0; n < 4; ++n) acc[m][n] = __builtin_amdgcn_mfma_f32_16x16x32_bf16(bf[u][n], af[u][m], acc[m][n], 0, 0, 0);
            if (i + u + 4 < nst) {
#pragma unroll
                for (int m = 0; m < 4; ++m) { af[u][m] = *(const GAS bf16x8*)(ap + (size_t)(16 * m) * lda + 256 * (i + u + 4)); bf[u][m] = *(const GAS bf16x8*)(bp + (size_t)(16 * m) * K + 256 * (i + u + 4)); } }
        }
    }
    LAS f32x4* const slab = (LAS f32x4*)(lds + wid * 16384);
#pragma unroll
    for (int m = 0; m < 4; ++m)
#pragma unroll
        for (int n = 0; n < 4; ++n) slab[(16 * m + ql) * 16 + ((4 * n + gq) ^ ql)] = acc[m][n];
    __syncthreads();
    const int rr = 8 * wid + (lane >> 3), ch0 = 2 * (lane & 7);
    v0 = (f32x4){0.f, 0.f, 0.f, 0.f}; v1 = v0;
#pragma unroll
    for (int s8 = 0; s8 < 8; ++s8) { const LAS f32x4* sl = (const LAS f32x4*)(lds + s8 * 16384) + rr * 16; v0 += sl[ch0 ^ (rr & 15)]; v1 += sl[(ch0 + 1) ^ (rr & 15)]; }
    __syncthreads();
}
__device__ __forceinline__ void gemm_small(LAS unsigned char* lds, const Gemm g, const Epi& E, int row_base, int nrows, int G, int c) {
    const int tid = threadIdx.x, wid = __builtin_amdgcn_readfirstlane(tid >> 6), lane = tid & 63;
    const int ntn = g.N / 64, ntiles = (nrows / 64) * ntn;
    for (int v = c; v < ntiles; v += G) {
        const int r0 = row_base + 64 * (v / ntn), c0 = 64 * (v % ntn);
        f32x4 v0, v1; small_tile_sum(lds, g.A, g.lda, g.Bt, g.K, r0, c0, v0, v1);
        epi_seg(E, r0 + 8 * wid + (lane >> 3), c0 + 8 * (lane & 7), v0, v1, lane);
    }
}
struct Gemm2 { const bf16_t* A1; const bf16_t* B1; const bf16_t* A2; const bf16_t* B2; int K1, lda1, K2, lda2, N; };
__device__ __forceinline__ void gemm_small2(LAS unsigned char* lds, const Gemm2 g, const bf16_t* gates, bf16_t* out, int row_base, int nrows, int G, int c) {
    const int tid = threadIdx.x, wid = __builtin_amdgcn_readfirstlane(tid >> 6), lane = tid & 63;
    const int ntn = g.N / 64, ntiles = (nrows / 64) * ntn;
    for (int v = c; v < ntiles; v += G) {
        const int r0 = row_base + 64 * (v / ntn), c0 = 64 * (v % ntn), row = r0 + 8 * wid + (lane >> 3), col = c0 + 8 * (lane & 7);
        f32x4 a0, a1, b0, b1;
        small_tile_sum(lds, g.A1, g.lda1, g.B1, g.K1, r0, c0, a0, a1);
        small_tile_sum(lds, g.A2, g.lda2, g.B2, g.K2, r0, c0, b0, b1);
        f32x4 g00, g01, g10, g11; unpack8(*(const GAS u32x4*)(gates + (size_t)row * (2 * DM) + col), g00, g01); unpack8(*(const GAS u32x4*)(gates + (size_t)row * (2 * DM) + DM + col), g10, g11);
        *(GAS u32x4*)(out + (size_t)row * DM + col) = pack8(g00 * a0 + g10 * b0, g01 * a1 + g11 * b1);
    }
}

__device__ __forceinline__ void gemm_phase(LAS unsigned char* lds, const Gemm g, const StaticOrder& S, const Epi& E) {
    const int tid = threadIdx.x, wid = __builtin_amdgcn_readfirstlane(tid >> 6), lane = tid & 63, wr = wid >> 2, wc = wid & 3, fr = lane & 15, fq = lane >> 4;
    const int K = g.K, nt = K / BK;
    unsigned voffA[2], voffB[2];
#pragma unroll
    for (int i = 0; i < 2; ++i) { int R, C; stage_rc(tid * 16 + i * 8192, R, C); const int Rb = (R & ~31) + perm32(R & 31);
        voffA[i] = (unsigned)(R * g.lda + C) * 2u; voffB[i] = (unsigned)(Rb * K + C) * 2u; }
    const size_t kstep = (size_t)(BK * 2);
    const size_t hstep = (size_t)HALF * K * 2, hstepA = (size_t)HALF * g.lda * 2;
    const size_t tstep = 2 * hstep, tstepA = 2 * hstepA, pnstepA = (size_t)g.a_pn_step * 2;
    const unsigned ldsw = (unsigned)wid * 1024u;
    const int aoff = lds_byte(wr * 64 + fr, fq * 8), boff = lds_byte(wc * 32 + fr, fq * 8);
#define PG8_SA(b, h) (((b) * 2 + (h)) * HTB)
#define PG8_SB(b, h) ((4 + (b) * 2 + (h)) * HTB)
#define PG8_STAGE(bufoff, gbase, voff) do { _Pragma("unroll") for (int _i = 0; _i < 2; ++_i) \
        __builtin_amdgcn_global_load_lds((const unsigned*)((const char*)(gbase) + (voff)[_i]), (LAS unsigned*)(lds + (bufoff) + ldsw + _i * 8192), 16, 0, 0); } while (0)
#define PG8_LDA(dst, b, h) do { _Pragma("unroll") for (int m = 0; m < 4; ++m) _Pragma("unroll") for (int k = 0; k < 2; ++k) dst[m][k] = *(const LAS bf16x8*)(lds + PG8_SA(b, h) + aoff + m * 2048 + k * 1024); } while (0)
#define PG8_LDB(dst, b, h) do { _Pragma("unroll") for (int n = 0; n < 2; ++n) _Pragma("unroll") for (int k = 0; k < 2; ++k) dst[n][k] = *(const LAS bf16x8*)(lds + PG8_SB(b, h) + boff + n * 2048 + k * 1024); } while (0)
#define PG8_MMA(ai, bj, At, Bt) do { __builtin_amdgcn_s_setprio(1); _Pragma("unroll") for (int m = 0; m < 4; ++m) _Pragma("unroll") for (int n = 0; n < 2; ++n) _Pragma("unroll") for (int k = 0; k < 2; ++k) \
        acc[ai][bj][m][n] = __builtin_amdgcn_mfma_f32_16x16x32_bf16(Bt[n][k], At[m][k], acc[ai][bj][m][n], 0, 0, 0); __builtin_amdgcn_s_setprio(0); } while (0)
#define PG8_WAIT_V(n) asm volatile("s_waitcnt vmcnt(" #n ")" ::: "memory")
#define PG8_WAIT_L(n) asm volatile("s_waitcnt lgkmcnt(" #n ")" ::: "memory")
#define PG8_BAR __builtin_amdgcn_s_barrier()
#define PG8_SCHED __builtin_amdgcn_sched_barrier(0)
    Unit cur, nxt; int ui = 0;
    if (!S.next(0, cur)) return;
    f32x4 acc[2][2][4][2];
#pragma unroll
    for (int a = 0; a < 2; ++a)
#pragma unroll
        for (int b = 0; b < 2; ++b)
#pragma unroll
            for (int m = 0; m < 4; ++m)
#pragma unroll
                for (int n = 0; n < 2; ++n) acc[a][b][m][n] = (f32x4){0.f, 0.f, 0.f, 0.f};
    bf16x8 At[4][2], B0[2][2], B1[2][2];
    const char* cA = (const char*)g.A + (size_t)cur.pm * tstepA + (size_t)cur.pn * pnstepA; const char* cB = (const char*)g.Bt + (size_t)cur.pn * tstep;
    PG8_STAGE(PG8_SB(0, 0), cB, voffB); PG8_STAGE(PG8_SB(0, 1), cB + hstep, voffB); PG8_STAGE(PG8_SA(0, 0), cA, voffA); PG8_STAGE(PG8_SA(0, 1), cA + hstepA, voffA);
    if (wr == 1) PG8_BAR;
    PG8_WAIT_V(2); PG8_BAR;
    PG8_STAGE(PG8_SB(1, 0), cB + kstep, voffB); PG8_STAGE(PG8_SA(1, 0), cA + kstep, voffA); PG8_STAGE(PG8_SB(1, 1), cB + hstep + kstep, voffB);
    PG8_WAIT_V(6); PG8_BAR;
    for (;;) {
        const bool has_next = S.next(ui + 1, nxt);
        const char* nA = has_next ? (const char*)g.A + (size_t)nxt.pm * tstepA + (size_t)nxt.pn * pnstepA : cA; const char* nB = has_next ? (const char*)g.Bt + (size_t)nxt.pn * tstep : cB;
        for (int t = 0; t < nt; t += 2) {
            const bool last = (t == nt - 2);
            const char* a1 = cA + (size_t)(t + 1) * kstep;
            const char* a2 = last ? nA : cA + (size_t)(t + 2) * kstep; const char* b2 = last ? nB : cB + (size_t)(t + 2) * kstep;
            const char* a3 = a2 + kstep; const char* b3 = b2 + kstep;
            PG8_LDB(B0, 0, 0); PG8_LDB(B1, 0, 1); PG8_SCHED; PG8_LDA(At, 0, 0); PG8_STAGE(PG8_SA(1, 1), a1 + hstepA, voffA);
            PG8_WAIT_V(8); PG8_WAIT_L(0); PG8_BAR; PG8_MMA(0, 0, At, B0); PG8_MMA(0, 1, At, B1); PG8_BAR; PG8_SCHED;
            PG8_LDA(At, 0, 1); PG8_STAGE(PG8_SB(0, 0), b2, voffB); PG8_STAGE(PG8_SB(0, 1), b2 + hstep, voffB); PG8_STAGE(PG8_SA(0, 0), a2, voffA);
            PG8_WAIT_V(8); PG8_WAIT_L(0); PG8_BAR; PG8_MMA(1, 0, At, B0); PG8_MMA(1, 1, At, B1); PG8_BAR; PG8_SCHED;
            PG8_LDB(B0, 1, 0); PG8_LDB(B1, 1, 1); PG8_SCHED; PG8_LDA(At, 1, 0); PG8_STAGE(PG8_SA(0, 1), a2 + hstepA, voffA);
            PG8_WAIT_V(8); PG8_WAIT_L(0); PG8_BAR; PG8_MMA(0, 0, At, B0); PG8_MMA(0, 1, At, B1); PG8_BAR; PG8_SCHED;
            PG8_LDA(At, 1, 1); PG8_STAGE(PG8_SB(1, 0), b3, voffB); PG8_STAGE(PG8_SB(1, 1), b3 + hstep, voffB); PG8_STAGE(PG8_SA(1, 0), a3, voffA);
            PG8_WAIT_V(8); PG8_WAIT_L(0); PG8_BAR; PG8_MMA(1, 0, At, B0); PG8_MMA(1, 1, At, B1); PG8_BAR; PG8_SCHED;
        }
        if (wr == 0) PG8_BAR;
        epilogue(E, acc, cur, wr, wc, fr, fq);
        if (!has_next) break;
#pragma unroll
        for (int a = 0; a < 2; ++a)
#pragma unroll
            for (int b = 0; b < 2; ++b)
#pragma unroll
                for (int m = 0; m < 4; ++m)
#pragma unroll
                    for (int n = 0; n < 2; ++n) acc[a][b][m][n] = (f32x4){0.f, 0.f, 0.f, 0.f};
        cur = nxt; cA = nA; cB = nB; ++ui;
        if (wr == 1) PG8_BAR;
    }
    PG8_WAIT_V(0);
    PG8_BAR;
#undef PG8_SA
#undef PG8_SB
#undef PG8_STAGE
#undef PG8_LDA
#undef PG8_LDB
#undef PG8_MMA
#undef PG8_WAIT_V
#undef PG8_WAIT_L
#undef PG8_BAR
#undef PG8_SCHED
}

__device__ __forceinline__ void gemm_phase2(LAS unsigned char* lds, const Gemm2 g, const StaticOrder& S, const bf16_t* gates, bf16_t* out) {
    const int tid = threadIdx.x, wid = __builtin_amdgcn_readfirstlane(tid >> 6), lane = tid & 63, wr = wid >> 2, wc = wid & 3, fr = lane & 15, fq = lane >> 4;
    const int nt1 = g.K1 / BK, nt = nt1 + g.K2 / BK;
    int sR[2], sRb[2], sC[2];
#pragma unroll
    for (int i = 0; i < 2; ++i) { int R, C; stage_rc(tid * 16 + i * 8192, R, C); sR[i] = R; sRb[i] = (R & ~31) + perm32(R & 31); sC[i] = C; }
    const size_t kstep = (size_t)(BK * 2);
    const size_t hB1 = (size_t)HALF * g.K1 * 2, hA1 = (size_t)HALF * g.lda1 * 2, hB2 = (size_t)HALF * g.K2 * 2, hA2 = (size_t)HALF * g.lda2 * 2;
    const unsigned ldsw = (unsigned)wid * 1024u;
    const int aoff = lds_byte(wr * 64 + fr, fq * 8), boff = lds_byte(wc * 32 + fr, fq * 8);
#define PG8_SA(b, h) (((b) * 2 + (h)) * HTB)
#define PG8_SB(b, h) ((4 + (b) * 2 + (h)) * HTB)
#define PG8_STAGE_T(bufoff, isA, h, T) do { const int T_ = (T); const bool nx_ = T_ >= nt; const int Tl_ = nx_ ? T_ - nt : T_; const bool s2_ = !nx_ && Tl_ >= nt1; \
        const char* base_ = (isA) ? (s2_ ? cA2 + (size_t)(Tl_ - nt1) * kstep + (h) * hA2 : (nx_ ? nA1 : cA1) + (size_t)Tl_ * kstep + (h) * hA1) \
                                  : (s2_ ? cB2 + (size_t)(Tl_ - nt1) * kstep + (h) * hB2 : (nx_ ? nB1 : cB1) + (size_t)Tl_ * kstep + (h) * hB1); \
        const int ld_ = (isA) ? (s2_ ? g.lda2 : g.lda1) : (s2_ ? g.K2 : g.K1); \
        _Pragma("unroll") for (int _i = 0; _i < 2; ++_i) { const unsigned vo_ = (unsigned)(((isA) ? sR[_i] : sRb[_i]) * ld_ + sC[_i]) * 2u; \
            __builtin_amdgcn_global_load_lds((const unsigned*)(base_ + vo_), (LAS unsigned*)(lds + (bufoff) + ldsw + _i * 8192), 16, 0, 0); } } while (0)
#define PG8_LDA(dst, b, h) do { _Pragma("unroll") for (int m = 0; m < 4; ++m) _Pragma("unroll") for (int k = 0; k < 2; ++k) dst[m][k] = *(const LAS bf16x8*)(lds + PG8_SA(b, h) + aoff + m * 2048 + k * 1024); } while (0)
#define PG8_LDB(dst, b, h) do { _Pragma("unroll") for (int n = 0; n < 2; ++n) _Pragma("unroll") for (int k = 0; k < 2; ++k) dst[n][k] = *(const LAS bf16x8*)(lds + PG8_SB(b, h) + boff + n * 2048 + k * 1024); } while (0)
#define PG8_MMA(ai, bj, At, Bt) do { __builtin_amdgcn_s_setprio(1); _Pragma("unroll") for (int m = 0; m < 4; ++m) _Pragma("unroll") for (int n = 0; n < 2; ++n) _Pragma("unroll") for (int k = 0; k < 2; ++k) \
        acc[ai][bj][m][n] = __builtin_amdgcn_mfma_f32_16x16x32_bf16(Bt[n][k], At[m][k], acc[ai][bj][m][n], 0, 0, 0); __builtin_amdgcn_s_setprio(0); } while (0)
#define PG8_WAIT_V(n) asm volatile("s_waitcnt vmcnt(" #n ")" ::: "memory")
#define PG8_WAIT_L(n) asm volatile("s_waitcnt lgkmcnt(" #n ")" ::: "memory")
#define PG8_BAR __builtin_amdgcn_s_barrier()
#define PG8_SCHED __builtin_amdgcn_sched_barrier(0)
    Unit cur, nxt; int ui = 0;
    if (!S.next(0, cur)) return;
    f32x4 acc[2][2][4][2];
#pragma unroll
    for (int a = 0; a < 2; ++a)
#pragma unroll
        for (int b = 0; b < 2; ++b)
#pragma unroll
            for (int m = 0; m < 4; ++m)
#pragma unroll
                for (int n = 0; n < 2; ++n) acc[a][b][m][n] = (f32x4){0.f, 0.f, 0.f, 0.f};
    bf16x8 At[4][2], B0[2][2], B1[2][2];
    const char* cA1 = (const char*)g.A1 + (size_t)cur.pm * 2 * hA1; const char* cB1 = (const char*)g.B1 + (size_t)cur.pn * 2 * hB1;
    const char* cA2 = (const char*)g.A2 + (size_t)cur.pm * 2 * hA2; const char* cB2 = (const char*)g.B2 + (size_t)cur.pn * 2 * hB2;
    const char* nA1 = cA1; const char* nB1 = cB1;
    PG8_STAGE_T(PG8_SB(0, 0), false, 0, 0); PG8_STAGE_T(PG8_SB(0, 1), false, 1, 0); PG8_STAGE_T(PG8_SA(0, 0), true, 0, 0); PG8_STAGE_T(PG8_SA(0, 1), true, 1, 0);
    if (wr == 1) PG8_BAR;
    PG8_WAIT_V(2); PG8_BAR;
    PG8_STAGE_T(PG8_SB(1, 0), false, 0, 1); PG8_STAGE_T(PG8_SA(1, 0), true, 0, 1); PG8_STAGE_T(PG8_SB(1, 1), false, 1, 1);
    PG8_WAIT_V(6); PG8_BAR;
    for (;;) {
        const bool has_next = S.next(ui + 1, nxt);
        nA1 = has_next ? (const char*)g.A1 + (size_t)nxt.pm * 2 * hA1 : cA1; nB1 = has_next ? (const char*)g.B1 + (size_t)nxt.pn * 2 * hB1 : cB1;
        const int rowb = cur.pm * BM + wr * 64 + fr, colb = cur.pn * BM + wc * 32 + 8 * fq;
        for (int t = 0; t < nt; t += 2) {
            if (t == nt1) {
#pragma unroll
                for (int ai = 0; ai < 2; ++ai)
#pragma unroll
                    for (int m = 0; m < 4; ++m) { const bf16_t* gp = gates + (size_t)(rowb + ai * HALF + m * 16) * (2 * DM) + colb;
#pragma unroll
                        for (int bj = 0; bj < 2; ++bj) { f32x4 g00, g01, g10, g11; unpack8(*(const GAS u32x4*)(gp + bj * HALF), g00, g01); unpack8(*(const GAS u32x4*)(gp + DM + bj * HALF), g10, g11);
#pragma unroll
                            for (int j = 0; j < 4; ++j) { acc[ai][bj][m][0][j] *= g00[j] * __builtin_amdgcn_rcpf(fmaxf(g10[j], 1e-6f)); acc[ai][bj][m][1][j] *= g01[j] * __builtin_amdgcn_rcpf(fmaxf(g11[j], 1e-6f)); } } }
            }
            PG8_LDB(B0, 0, 0); PG8_LDB(B1, 0, 1); PG8_SCHED; PG8_LDA(At, 0, 0); PG8_STAGE_T(PG8_SA(1, 1), true, 1, t + 1);
            PG8_WAIT_V(8); PG8_WAIT_L(0); PG8_BAR; PG8_MMA(0, 0, At, B0); PG8_MMA(0, 1, At, B1); PG8_BAR; PG8_SCHED;
            PG8_LDA(At, 0, 1); PG8_STAGE_T(PG8_SB(0, 0), false, 0, t + 2); PG8_STAGE_T(PG8_SB(0, 1), false, 1, t + 2); PG8_STAGE_T(PG8_SA(0, 0), true, 0, t + 2);
            PG8_WAIT_V(8); PG8_WAIT_L(0); PG8_BAR; PG8_MMA(1, 0, At, B0); PG8_MMA(1, 1, At, B1); PG8_BAR; PG8_SCHED;
            PG8_LDB(B0, 1, 0); PG8_LDB(B1, 1, 1); PG8_SCHED; PG8_LDA(At, 1, 0); PG8_STAGE_T(PG8_SA(0, 1), true, 1, t + 2);
            PG8_WAIT_V(8); PG8_WAIT_L(0); PG8_BAR; PG8_MMA(0, 0, At, B0); PG8_MMA(0, 1, At, B1); PG8_BAR; PG8_SCHED;
            PG8_LDA(At, 1, 1); PG8_STAGE_T(PG8_SB(1, 0), false, 0, t + 3); PG8_STAGE_T(PG8_SB(1, 1), false, 1, t + 3); PG8_STAGE_T(PG8_SA(1, 0), true, 0, t + 3);
            PG8_WAIT_V(8); PG8_WAIT_L(0); PG8_BAR; PG8_MMA(1, 0, At, B0); PG8_MMA(1, 1, At, B1); PG8_BAR; PG8_SCHED;
        }
        if (wr == 0) PG8_BAR;
#pragma unroll
        for (int ai = 0; ai < 2; ++ai)
#pragma unroll
            for (int m = 0; m < 4; ++m) { const size_t row = (size_t)(rowb + ai * HALF + m * 16);
#pragma unroll
                for (int bj = 0; bj < 2; ++bj) { f32x4 g10, g11; unpack8(*(const GAS u32x4*)(gates + row * (2 * DM) + DM + colb + bj * HALF), g10, g11);
#pragma unroll
                    for (int j = 0; j < 4; ++j) { g10[j] = fmaxf(g10[j], 1e-6f); g11[j] = fmaxf(g11[j], 1e-6f); }
                    *(GAS u32x4*)(out + row * DM + colb + bj * HALF) = pack8(acc[ai][bj][m][0] * g10, acc[ai][bj][m][1] * g11); } }
        if (!has_next) break;
#pragma unroll
        for (int a = 0; a < 2; ++a)
#pragma unroll
            for (int b = 0; b < 2; ++b)
#pragma unroll
                for (int m = 0; m < 4; ++m)
#pragma unroll
                    for (int n = 0; n < 2; ++n) acc[a][b][m][n] = (f32x4){0.f, 0.f, 0.f, 0.f};
        cur = nxt; cA1 = nA1; cB1 = nB1; cA2 = (const char*)g.A2 + (size_t)cur.pm * 2 * hA2; cB2 = (const char*)g.B2 + (size_t)cur.pn * 2 * hB2; ++ui;
        if (wr == 1) PG8_BAR;
    }
    PG8_WAIT_V(0);
    PG8_BAR;
#undef PG8_SA
#undef PG8_SB
#undef PG8_STAGE_T
#undef PG8_LDA
#undef PG8_LDB
#undef PG8_MMA
#undef PG8_WAIT_V
#undef PG8_WAIT_L
#undef PG8_BAR
#undef PG8_SCHED
}
}

#define XB_TMO      128
#define XB_XCNT(j)  (256  + 64 * (j))
#define XB_XSUB(j)  (1280 + 64 * (j))
#define XB_XGEN(j)  (2304 + 64 * (j))
#define XB_TOP      3328
#define XB_TOPGEN   3392
#define XCD_BAR_WORDS 3456
#define XB_SPIN_CAP (1u << 18)
__device__ __forceinline__ unsigned xb_ld(unsigned* p)              { return __hip_atomic_load(p, __ATOMIC_RELAXED, __HIP_MEMORY_SCOPE_AGENT); }
__device__ __forceinline__ unsigned xb_add(unsigned* p, unsigned v) { return __hip_atomic_fetch_add(p, v, __ATOMIC_RELAXED, __HIP_MEMORY_SCOPE_AGENT); }
__device__ __forceinline__ unsigned xb_xcc_id() { return (unsigned)__builtin_amdgcn_s_getreg((3 << 11) | 20) & 0xFu; }
#define XB_SPIN(cond, bar) do { unsigned _sp = 0; while (cond) { __builtin_amdgcn_s_sleep(1); \
    if ((++_sp & 255u) == 0u) { if (xb_ld(&(bar)[XB_TMO])) break; if (_sp > XB_SPIN_CAP) { atomicAdd(&(bar)[XB_TMO], 1u); break; } } } } while (0)
struct XcdBarrier { unsigned* bar; unsigned x; volatile LAS unsigned* st; };
__device__ __forceinline__ XcdBarrier xcd_barrier_post(unsigned* bar, volatile LAS unsigned* st) {
    XcdBarrier b; b.bar = bar; b.x = xb_xcc_id(); b.st = st;
    if (threadIdx.x == 0) (void)xb_add(&bar[XB_XCNT(b.x)], 1u);
    return b;
}
__device__ __forceinline__ void xcd_barrier_complete(unsigned* bar, unsigned x, unsigned& nloc, unsigned& nx) {
    const unsigned G = gridDim.x * gridDim.y * gridDim.z;
    unsigned sum, cnt, mine, sp = 0u;
    for (;;) {
        sum = 0u; cnt = 0u; mine = 0u;
#pragma unroll
        for (unsigned j = 0; j < 16; ++j) { const unsigned c = xb_ld(&bar[XB_XCNT(j)]); sum += c; cnt += (c > 0u) ? 1u : 0u; mine = (j == x) ? c : mine; }
        if (sum == G) break;
        __builtin_amdgcn_s_sleep(1);
        if ((++sp & 255u) == 0u) { if (xb_ld(&bar[XB_TMO])) break; if (sp > XB_SPIN_CAP) { atomicAdd(&bar[XB_TMO], 1u); break; } }
    }
    nloc = mine > 0u ? mine : 1u; nx = cnt > 0u ? cnt : 1u;
}
__device__ __forceinline__ void xcd_barrier(const XcdBarrier& b) {
    asm volatile("s_waitcnt vmcnt(0)" ::: "memory");
    __syncthreads();
    if (threadIdx.x == 0) {
        unsigned* bar = b.bar;
        __builtin_amdgcn_s_waitcnt(0);
        unsigned nloc = b.st[0], nx = b.st[1];
        if (nloc == 0u) { xcd_barrier_complete(bar, b.x, nloc, nx); b.st[0] = nloc; b.st[1] = nx; }
        const unsigned old = xb_add(&bar[XB_XSUB(b.x)], 1u);
        const unsigned gen = old / nloc;
        if (old + 1u == (gen + 1u) * nloc) {
            __builtin_amdgcn_fence(__ATOMIC_RELEASE, "agent");
            asm volatile("s_waitcnt vmcnt(0)" ::: "memory");
            const unsigned og = xb_add(&bar[XB_TOP], 1u);
            const unsigned tg = og / nx;
            if (og + 1u == (tg + 1u) * nx) xb_add(&bar[XB_TOPGEN], 1u);
            else XB_SPIN(xb_ld(&bar[XB_TOPGEN]) == tg, bar);
            __builtin_amdgcn_fence(__ATOMIC_ACQUIRE, "agent");
            xb_add(&bar[XB_XGEN(b.x)], 1u);
            asm volatile("s_waitcnt vmcnt(0)" ::: "memory");
        } else {
            XB_SPIN(xb_ld(&bar[XB_XGEN(b.x)]) == gen, bar);
            __builtin_amdgcn_fence(__ATOMIC_ACQUIRE, "agent");
            asm volatile("s_waitcnt vmcnt(0)" ::: "memory");
        }
    }
    __syncthreads();
}

__device__ __forceinline__ void p0_transpose_item(const float* W, int K, int N, const float* gain, bf16_t* WT, int k0, int n0, int drow0, LAS float* scr, int lane) {
#pragma unroll
    for (int i = 0; i < 8; ++i) { const int kk = 8 * i + (lane >> 3), nn = 4 * (lane & 7);
        f32x4 v = *(const GAS f32x4*)(W + (size_t)(k0 + kk) * N + n0 + nn);
        if (gain) v = v * *(const GAS float*)(gain + k0 + kk);
        scr[kk * 33 + nn] = v.x; scr[kk * 33 + nn + 1] = v.y; scr[kk * 33 + nn + 2] = v.z; scr[kk * 33 + nn + 3] = v.w; }
    LDS_WAIT(); asm volatile("" ::: "memory");
    const int c = lane & 7;
#pragma unroll
    for (int j = 0; j < 4; ++j) { const int n = (lane >> 3) + 8 * j; const LAS float* s = scr + (8 * c) * 33 + n;
        u32x4 o; o.x = pk2(s[0 * 33], s[1 * 33]); o.y = pk2(s[2 * 33], s[3 * 33]); o.z = pk2(s[4 * 33], s[5 * 33]); o.w = pk2(s[6 * 33], s[7 * 33]);
        *(GAS u32x4*)(WT + (size_t)(drow0 + n) * K + k0 + 8 * c) = o; }
    LDS_WAIT(); asm volatile("" ::: "memory");
}
__device__ __forceinline__ int map_gu(int n0) { return n0 < DFF ? (n0 / 128) * 256 + (n0 % 128) : ((n0 - DFF) / 128) * 256 + 128 + ((n0 - DFF) % 128); }
__device__ __forceinline__ int map_win(int n0) { return n0 < 6144 ? n0 : (n0 < 6176 ? 9216 + (n0 - 6144) : n0 - 32); }

__device__ __forceinline__ void p0_prologue(Frame& F) {
    LAS float* scr = (LAS float*)(F.lds + F.wave * 16384);
    const int gw = F.vcu * NWAVES + F.wave, NGW = F.G * NWAVES, lane = F.lane;
    bf16_t* const wgu1 = (bf16_t*)(F.ws + WS_WGU1); bf16_t* const wd1 = (bf16_t*)(F.ws + WS_WD1); bf16_t* const win = (bf16_t*)(F.ws + WS_WIN);
    bf16_t* const wsso = (bf16_t*)(F.ws + WS_WSSO); bf16_t* const wo = (bf16_t*)(F.ws + WS_WO); bf16_t* const wgu2 = (bf16_t*)(F.ws + WS_WGU2);
    bf16_t* const wd2 = (bf16_t*)(F.ws + WS_WD2); bf16_t* const wpg = (bf16_t*)(F.ws + WS_WPG); bf16_t* const wple = (bf16_t*)(F.ws + WS_WPLE);
    constexpr int I_GU = (DM / 64) * (2 * DFF / 32), I_D = (DFF / 64) * (DM / 32), I_IN = (DM / 64) * (IN_DIM / 32), I_SSO = (DI / 64) * (DM / 32), I_SQ = (DM / 64) * (DM / 32), I_PLE = (PLE / 64) * (DM / 32);
    constexpr int NITEMS = 2 * I_GU + 2 * I_D + I_IN + I_SSO + 3 * I_SQ + I_PLE;
    bf16_t* const wpot = (bf16_t*)(F.ws + WS_WPOT);
    for (int it = gw; it < NITEMS; it += NGW) {
        int r = it;
        if (r < I_GU) { const int nb = 2 * DFF / 32, kb = r / nb, n0 = (r % nb) * 32; p0_transpose_item(F.in[I_WGU1], DM, 2 * DFF, F.in[I_NFFN1], wgu1, kb * 64, n0, map_gu(n0), scr, lane); continue; } r -= I_GU;
        if (r < I_GU) { const int nb = 2 * DFF / 32, kb = r / nb, n0 = (r % nb) * 32; p0_transpose_item(F.in[I_WGU2], DM, 2 * DFF, F.in[I_NFFN2], wgu2, kb * 64, n0, map_gu(n0), scr, lane); continue; } r -= I_GU;
        if (r < I_D) { const int nb = DM / 32, kb = r / nb, n0 = (r % nb) * 32; p0_transpose_item(F.in[I_WD1], DFF, DM, nullptr, wd1, kb * 64, n0, n0, scr, lane); continue; } r -= I_D;
        if (r < I_D) { const int nb = DM / 32, kb = r / nb, n0 = (r % nb) * 32; p0_transpose_item(F.in[I_WD2], DFF, DM, nullptr, wd2, kb * 64, n0, n0, scr, lane); continue; } r -= I_D;
        if (r < I_IN) { const int nb = IN_DIM / 32, kb = r / nb, n0 = (r % nb) * 32; p0_transpose_item(F.in[I_WIN], DM, IN_DIM, F.in[I_NMIX], win, kb * 64, n0, map_win(n0), scr, lane); continue; } r -= I_IN;
        if (r < I_SSO) { const int nb = DM / 32, kb = r / nb, n0 = (r % nb) * 32; p0_transpose_item(F.in[I_WSSO], DI, DM, F.in[I_NSSD], wsso, kb * 64, n0, n0, scr, lane); continue; } r -= I_SSO;
        if (r < I_SQ) { const int nb = DM / 32, kb = r / nb, n0 = (r % nb) * 32; p0_transpose_item(F.in[I_WO], DM, DM, nullptr, wo, kb * 64, n0, n0, scr, lane); continue; } r -= I_SQ;
        if (r < I_SQ) { const int nb = DM / 32, kb = r / nb, n0 = (r % nb) * 32; p0_transpose_item(F.in[I_WPG], DM, DM, F.in[I_NPLE], wpg, kb * 64, n0, n0, scr, lane); continue; } r -= I_SQ;
        if (r < I_SQ) { const int nb = DM / 32, kb = r / nb, n0 = (r % nb) * 32; p0_transpose_item(F.in[I_WPOUT], PD, DM, F.in[I_PSCALE], wpot, kb * 64, n0, n0, scr, lane); continue; } r -= I_SQ;
        { const int nb = DM / 32, kb = r / nb, n0 = (r % nb) * 32; p0_transpose_item(F.in[I_WPLE], PLE, DM, nullptr, wple, kb * 64, n0, n0, scr, lane); }
    }
    {
        bf16_t* const wgrp = (bf16_t*)(F.ws + WS_WGRP); const float* Wg = F.in[I_WPGRP];
        for (int e = F.vcu * NTHREADS + F.tid; e < 4 * 256 * 256 / 8; e += F.G * NTHREADS) {
            const f32x4 a = *(const GAS f32x4*)(Wg + (size_t)e * 8), b = *(const GAS f32x4*)(Wg + (size_t)e * 8 + 4);
            u32x4 o; o.x = pk2(a.x, a.y); o.y = pk2(a.z, a.w); o.z = pk2(b.x, b.y); o.w = pk2(b.z, b.w);
            *(GAS u32x4*)(wgrp + (size_t)e * 8) = o; }
    }
    {
        bf16_t* const XB = (bf16_t*)(F.ws + WS_XB); bf16_t* const PB = (bf16_t*)(F.ws + WS_PB); float* const stA = (float*)(F.ws + WS_STATS_A);
        for (int m = gw; m < M; m += NGW) {
            const float* xrow = (m < MP) ? F.in[I_XP] + (size_t)m * DM : F.in[I_XS] + (size_t)(m - MP) * DM;
            const GAS f32x4* xr = (const GAS f32x4*)xrow + lane;
            f32x4 v[4]; float s = 0.f;
#pragma unroll
            for (int j = 0; j < 4; ++j) { v[j] = xr[64 * j]; s += (v[j].x * v[j].x + v[j].y * v[j].y) + (v[j].z * v[j].z + v[j].w * v[j].w); }
            s = wave_sum(s);
            GAS u32x2* o8 = (GAS u32x2*)(XB + (size_t)m * DM) + lane;
#pragma unroll
            for (int j = 0; j < 4; ++j) { u32x2 w; w.x = pk2(v[j].x, v[j].y); w.y = pk2(v[j].z, v[j].w); o8[64 * j] = w; }
            if (lane < 16) *(GAS float*)(stA + (size_t)m * 16 + lane) = (lane == 0) ? s : 0.f;
            const float* prow = (m < MP) ? F.in[I_PP] + (size_t)m * PLE : F.in[I_PS] + (size_t)(m - MP) * PLE;
            const f32x4 pv = *((const GAS f32x4*)prow + lane);
            u32x2 w; w.x = pk2(pv.x, pv.y); w.y = pk2(pv.z, pv.w); *((GAS u32x2*)(PB + (size_t)m * PLE) + lane) = w;
        }
    }
}


typedef short v4i16_t __attribute__((ext_vector_type(4)));
constexpr int IMG_B = 0, IMG_C = 32768, IMG_X = 65536, TAB_ACS = RING_BYTES + 1024, TAB_DT = TAB_ACS + 2048, TAB_SD = TAB_DT + 2048;
constexpr int NCHUNK = SEQ / 128;
template <bool XS> __device__ __forceinline__ int img_off(int row, int ch) { return XS ? 256 * row + 16 * (ch ^ ((row & 7) << 1)) : 256 * row + 16 * (ch ^ (((row & 3) << 2) | ((row >> 2) & 3))); }
__device__ __forceinline__ bf16x8 tr_pair(const LAS unsigned char* p0, const LAS unsigned char* p1) {
    const v4i16_t a = __builtin_amdgcn_ds_read_tr16_b64_v4i16((LAS v4i16_t*)p0), b = __builtin_amdgcn_ds_read_tr16_b64_v4i16((LAS v4i16_t*)p1);
    return (bf16x8){a[0], a[1], a[2], a[3], b[0], b[1], b[2], b[3]};
}
__device__ __forceinline__ void ssd_tables_load(Frame& F, size_t row0, int g, float& d0, float& d1) {
    if (F.wave < 4) { const float* const DT = (const float*)(F.ws + WS_DT); const int head = g * HPG + F.wave;
        d0 = *(const GAS float*)(DT + (row0 + 2 * F.lane) * 32 + head); d1 = *(const GAS float*)(DT + (row0 + 2 * F.lane + 1) * 32 + head); }
}
__device__ __forceinline__ void ssd_tables_compute(Frame& F, int g, float d0, float d1) {
    LAS float* const acs = (LAS float*)(F.lds + TAB_ACS); LAS float* const dtl = (LAS float*)(F.lds + TAB_DT); LAS float* const sdec = (LAS float*)(F.lds + TAB_SD);
    if (F.wave < 4) {
        const int r = F.wave, lane = F.lane, head = g * HPG + r;
        const float Ah = -__expf(*(const GAS float*)(F.in[I_ALOG] + head));
        const float a0 = d0 * Ah, a1 = d1 * Ah, loc = a0 + a1;
        float inc = loc;
#pragma unroll
        for (int o = 1; o < 64; o <<= 1) { const float t = __shfl_up(inc, o); if (lane >= o) inc += t; }
        const float exc = inc - loc;
        acs[(2 * lane) * 4 + r] = exc + a0; acs[(2 * lane + 1) * 4 + r] = inc;
        dtl[(2 * lane) * 4 + r] = d0; dtl[(2 * lane + 1) * 4 + r] = d1;
    }
    __syncthreads();
    { const int s = F.tid >> 2, r = F.tid & 3; sdec[s * 4 + r] = __expf(acs[127 * 4 + r] - acs[s * 4 + r]) * dtl[s * 4 + r]; }
    __syncthreads();
}
__device__ __forceinline__ void ssd_tables(Frame& F, size_t row0, int g) { float d0 = 0.f, d1 = 0.f; ssd_tables_load(F, row0, g, d0, d1); ssd_tables_compute(F, g, d0, d1); }
struct ConvMap { int kind, cc, run, gch; };
__device__ __forceinline__ ConvMap ssd_conv_map(int t, int g) {
    ConvMap m;
    if (t < 256) { m.kind = 0; m.cc = t & 31; m.run = t >> 5; } else if (t < 384) { m.kind = 1; m.cc = (t - 256) & 15; m.run = (t - 256) >> 4; } else { m.kind = 2; m.cc = (t - 384) & 15; m.run = (t - 384) >> 4; }
    m.gch = (m.kind == 0 ? g * 256 : (m.kind == 1 ? DI + g * DSTATE : DI + NG * DSTATE + g * DSTATE)) + 8 * m.cc;
    return m;
}
__device__ __forceinline__ void ssd_conv_load(Frame& F, size_t row0, int b, int c, int g, u32x4 (&raw)[19]) {
    const ConvMap m = ssd_conv_map(F.tid, g);
    const bf16_t* const XBC = (const bf16_t*)(F.ws + WS_XBC); const bf16_t* const HALO = (const bf16_t*)(F.ws + WS_HALO);
#pragma unroll
    for (int i = 0; i < 19; ++i) {
        if (i < 3 && m.run == 0) { if (c == 0) raw[i] = (u32x4){0u, 0u, 0u, 0u}; else raw[i] = *(const GAS u32x4*)(HALO + ((((size_t)b * 16 + c) * 3 + i) * CD) + m.gch); }
        else raw[i] = *(const GAS u32x4*)(XBC + (row0 + 16 * m.run + i - 3) * CD + m.gch); }
}
__device__ __forceinline__ void ssd_conv_store(Frame& F, size_t row0, int g, const u32x4 (&raw)[19]) {
    const ConvMap m = ssd_conv_map(F.tid, g);
    bf16_t* const XBC = (bf16_t*)(F.ws + WS_XBC);
    const float* const convw = F.in[I_CONVW]; const float* const convb = F.in[I_CONVB];
    float cw[4][8], cb[8];
#pragma unroll
    for (int k = 0; k < 4; ++k) { const f32x4 a = *(const GAS f32x4*)(convw + (size_t)k * CD + m.gch), b_ = *(const GAS f32x4*)(convw + (size_t)k * CD + m.gch + 4);
        cw[k][0] = a.x; cw[k][1] = a.y; cw[k][2] = a.z; cw[k][3] = a.w; cw[k][4] = b_.x; cw[k][5] = b_.y; cw[k][6] = b_.z; cw[k][7] = b_.w; }
    { const f32x4 a = *(const GAS f32x4*)(convb + m.gch), b_ = *(const GAS f32x4*)(convb + m.gch + 4); cb[0] = a.x; cb[1] = a.y; cb[2] = a.z; cb[3] = a.w; cb[4] = b_.x; cb[5] = b_.y; cb[6] = b_.z; cb[7] = b_.w; }
    LAS unsigned char* const img = F.lds + (m.kind == 0 ? IMG_X + (m.cc >> 4) * 32768 : IMG_B);
    const LAS float* const sdec = (const LAS float*)(F.lds + TAB_SD);
    const int chl = m.cc & 15, hr = m.cc >> 3;
#pragma unroll
    for (int i = 0; i < 16; ++i) {
        const int s = 16 * m.run + i;
        float o[8];
#pragma unroll
        for (int j2 = 0; j2 < 4; ++j2) {
            const unsigned w0 = raw[i][j2], w1 = raw[i + 1][j2], w2 = raw[i + 2][j2], w3 = raw[i + 3][j2];
            const float lo = cb[2 * j2] + cw[0][2 * j2] * bflo(w0) + cw[1][2 * j2] * bflo(w1) + cw[2][2 * j2] * bflo(w2) + cw[3][2 * j2] * bflo(w3);
            const float hi = cb[2 * j2 + 1] + cw[0][2 * j2 + 1] * bfhi(w0) + cw[1][2 * j2 + 1] * bfhi(w1) + cw[2][2 * j2 + 1] * bfhi(w2) + cw[3][2 * j2 + 1] * bfhi(w3);
            o[2 * j2] = silu_f(lo); o[2 * j2 + 1] = silu_f(hi);
        }
        u32x4 pk; pk.x = cvt_pk_bf16(o[0], o[1]); pk.y = cvt_pk_bf16(o[2], o[3]); pk.z = cvt_pk_bf16(o[4], o[5]); pk.w = cvt_pk_bf16(o[6], o[7]);
        *(GAS u32x4*)(XBC + (row0 + s) * CD + m.gch) = pk;
        if (m.kind == 0) { const float sc = sdec[s * 4 + hr];
            pk.x = cvt_pk_bf16(o[0] * sc, o[1] * sc); pk.y = cvt_pk_bf16(o[2] * sc, o[3] * sc); pk.z = cvt_pk_bf16(o[4] * sc, o[5] * sc); pk.w = cvt_pk_bf16(o[6] * sc, o[7] * sc); }
        if (m.kind != 2) *(LAS u32x4*)(img + img_off<false>(s, chl)) = pk;
    }
}
__device__ __forceinline__ void ssd_copy_load(Frame& F, size_t row0, int g, u32x4 (&raw)[16]) {
    const ConvMap m = ssd_conv_map(F.tid, g);
    const bf16_t* const XBC = (const bf16_t*)(F.ws + WS_XBC);
#pragma unroll
    for (int i = 0; i < 16; ++i) raw[i] = *(const GAS u32x4*)(XBC + (row0 + 16 * m.run + i) * CD + m.gch);
}
__device__ __forceinline__ void ssd_copy_store(Frame& F, int g, const u32x4 (&raw)[16]) {
    const ConvMap m = ssd_conv_map(F.tid, g);
    LAS unsigned char* const img = F.lds + (m.kind == 0 ? IMG_X + (m.cc >> 4) * 32768 : (m.kind == 1 ? IMG_B : IMG_C));
    const int chl = m.cc & 15;
#pragma unroll
    for (int i = 0; i < 16; ++i) { const int s = 16 * m.run + i; *(LAS u32x4*)(img + (m.kind == 0 ? img_off<true>(s, chl) : img_off<false>(s, chl))) = raw[i]; }
}
__device__ __forceinline__ void ssd_states_phase(Frame& F) {
    bf16_t* const ST = (bf16_t*)(F.ws + WS_HPREV);
    float* const CDEC = (float*)(F.ws + WS_CDEC);
    const int w = F.wave, lane = F.lane, ql = lane & 15, gq = lane >> 4, qq = ql >> 2, pp = ql & 3, r = w >> 1, nh = w & 1;
    int sbo[4][2], sxo[4][2];
#pragma unroll
    for (int f = 0; f < 4; ++f) { const int colb = 64 * nh + 16 * f + 4 * pp, colx = 64 * (r & 1) + 16 * f + 4 * pp;
#pragma unroll
        for (int t4 = 0; t4 < 2; ++t4) { sbo[f][t4] = img_off<false>(8 * gq + qq + 4 * t4, colb >> 3) + 2 * (colb & 7); sxo[f][t4] = img_off<false>(8 * gq + qq + 4 * t4, colx >> 3) + 2 * (colx & 7); } }
    u32x4 raw[19]; float d0 = 0.f, d1 = 0.f;
    constexpr int NIT = BATCH * NCHUNK * NG;
    if (F.vcu < NIT) { const int it = F.vcu, g = it & 7, c = (it >> 3) & (NCHUNK - 1), b = it >> 7; const size_t row0 = (size_t)b * SEQ + (size_t)c * 128;
        ssd_conv_load(F, row0, b, c, g, raw); ssd_tables_load(F, row0, g, d0, d1); }
    for (int it = F.vcu; it < NIT; it += F.G) {
        const int g = it & 7, c = (it >> 3) & (NCHUNK - 1), b = it >> 7;
        const size_t row0 = (size_t)b * SEQ + (size_t)c * 128;
        asm volatile("s_waitcnt vmcnt(0)" ::: "memory");
        ssd_tables_compute(F, g, d0, d1);
        ssd_conv_store(F, row0, g, raw);
        __syncthreads();
        if (it + F.G < NIT) { const int it2 = it + F.G, g2 = it2 & 7, c2 = (it2 >> 3) & (NCHUNK - 1), b2 = it2 >> 7; const size_t row2 = (size_t)b2 * SEQ + (size_t)c2 * 128;
            ssd_conv_load(F, row2, b2, c2, g2, raw); ssd_tables_load(F, row2, g2, d0, d1); }
        const int head = g * HPG + r;
        bf16_t* const stp = ST + ((((size_t)b * NCHUNK + c) * NH + head) * HD) * DSTATE;
#pragma unroll
        for (int nh2 = 0; nh2 < 2; ++nh2) {
            f32x4 acc[2][4];
#pragma unroll
            for (int i = 0; i < 2; ++i)
#pragma unroll
                for (int j = 0; j < 4; ++j) acc[i][j] = (f32x4){0.f, 0.f, 0.f, 0.f};
#pragma unroll
            for (int ks = 0; ks < 4; ++ks) {
                bf16x8 af[2], xf[4];
#pragma unroll
                for (int nf = 0; nf < 2; ++nf) { const LAS unsigned char* p = F.lds + IMG_B + sbo[2 * nh2 + nf][0] + 8192 * ks; const LAS unsigned char* p4 = F.lds + IMG_B + sbo[2 * nh2 + nf][1] + 8192 * ks; af[nf] = tr_pair(p, p4); }
#pragma unroll
                for (int pf = 0; pf < 4; ++pf) { const LAS unsigned char* p = F.lds + IMG_X + (r >> 1) * 32768 + sxo[pf][0] + 8192 * ks; const LAS unsigned char* p4 = F.lds + IMG_X + (r >> 1) * 32768 + sxo[pf][1] + 8192 * ks; xf[pf] = tr_pair(p, p4); }
#pragma unroll
                for (int nf = 0; nf < 2; ++nf)
#pragma unroll
                    for (int pf = 0; pf < 4; ++pf) acc[nf][pf] = __builtin_amdgcn_mfma_f32_16x16x32_bf16(af[nf], xf[pf], acc[nf][pf], 0, 0, 0);
            }
#pragma unroll
            for (int pf = 0; pf < 4; ++pf)
#pragma unroll
                for (int nf = 0; nf < 2; ++nf) { u32x2 o; o.x = cvt_pk_bf16(acc[nf][pf][0], acc[nf][pf][1]); o.y = cvt_pk_bf16(acc[nf][pf][2], acc[nf][pf][3]);
                    *(GAS u32x2*)(stp + (size_t)(16 * pf + ql) * DSTATE + 64 * nh + 32 * nh2 + 16 * nf + 4 * gq) = o; }
        }
        if (F.tid < 4) { const LAS float* acs = (const LAS float*)(F.lds + TAB_ACS); *(GAS float*)(CDEC + ((size_t)b * NCHUNK + c) * NH + g * HPG + F.tid) = __expf(acs[127 * 4 + F.tid]); }
        __syncthreads();
    }
}
__device__ __forceinline__ void ssd_scan_phase(Frame& F) {
    bf16_t* const HP = (bf16_t*)(F.ws + WS_HPREV); const float* const CDEC = (const float*)(F.ws + WS_CDEC); float* const hout = F.out + O_SSM_P;
    const int gt = F.vcu * NTHREADS + F.tid, NT = F.G * NTHREADS;
    constexpr int PER = NH * HD * DSTATE / 8;
    for (int e = gt; e < BATCH * PER; e += NT) {
        const int b = e / PER, i8 = e % PER, head = i8 / (HD * DSTATE / 8);
        u32x4 stv[NCHUNK];
#pragma unroll
        for (int c = 0; c < NCHUNK; ++c) stv[c] = *(const GAS u32x4*)(HP + (((size_t)b * NCHUNK + c) * (size_t)PER + i8) * 8);
        f32x4 h0 = (f32x4){0.f, 0.f, 0.f, 0.f}, h1 = h0;
#pragma unroll
        for (int c = 0; c < NCHUNK; ++c) {
            if (c > 0) *(GAS u32x4*)(HP + (((size_t)b * NCHUNK + c) * (size_t)PER + i8) * 8) = pg8::pack8(h0, h1);
            const float d = *(const GAS float*)(CDEC + ((size_t)b * NCHUNK + c) * NH + head);
            f32x4 s0, s1; pg8::unpack8(stv[c], s0, s1);
            h0 = h0 * d + s0; h1 = h1 * d + s1;
        }
        *(GAS f32x4*)(hout + ((size_t)b * PER + i8) * 8) = h0; *(GAS f32x4*)(hout + ((size_t)b * PER + i8) * 8 + 4) = h1;
    }
}
__device__ __forceinline__ void ssd_out_phase(Frame& F) {
    const bf16_t* const HP = (const bf16_t*)(F.ws + WS_HPREV); bf16_t* const ZY = (bf16_t*)(F.ws + WS_Z);
    const int w = F.wave, lane = F.lane, ql = lane & 15, gq = lane >> 4, qq = ql >> 2, pp = ql & 3, q0 = 16 * w;
    const LAS float* const acs = (const LAS float*)(F.lds + TAB_ACS); const LAS float* const dtl = (const LAS float*)(F.lds + TAB_DT);
    int cfo[4], bbo[4], hbo[4], xbo[2][4];
#pragma unroll
    for (int ks = 0; ks < 4; ++ks) { cfo[ks] = IMG_C + img_off<false>(q0 + ql, 4 * ks + gq); bbo[ks] = IMG_B + img_off<false>(ql, 4 * ks + gq); hbo[ks] = img_off<false>(ql, 4 * ks + gq); }
#pragma unroll
    for (int rr = 0; rr < 2; ++rr)
#pragma unroll
        for (int pf = 0; pf < 4; ++pf) xbo[rr][pf] = IMG_X + img_off<true>(4 * gq + qq, 8 * rr + 2 * pf + (pp >> 1)) + 8 * (pp & 1);
    u32x4 raw[16]; float d0 = 0.f, d1 = 0.f;
    constexpr int NIT = BATCH * NCHUNK * NG;
    if (F.vcu < NIT) { const int it = F.vcu, g = it & 7, c = (it >> 3) & (NCHUNK - 1), b = it >> 7; const size_t row0 = (size_t)b * SEQ + (size_t)c * 128;
        ssd_copy_load(F, row0, g, raw); ssd_tables_load(F, row0, g, d0, d1); }
    for (int it = F.vcu; it < NIT; it += F.G) {
        const int g = it & 7, c = (it >> 3) & (NCHUNK - 1), b = it >> 7;
        const size_t row0 = (size_t)b * SEQ + (size_t)c * 128;
        ssd_tables_compute(F, g, d0, d1);
        ssd_copy_store(F, g, raw);
        __syncthreads();
        if (it + F.G < NIT) { const int it2 = it + F.G, g2 = it2 & 7, c2 = (it2 >> 3) & (NCHUNK - 1), b2 = it2 >> 7; const size_t row2 = (size_t)b2 * SEQ + (size_t)c2 * 128;
            ssd_copy_load(F, row2, g2, raw); ssd_tables_load(F, row2, g2, d0, d1); }
        bf16x8 cf[4];
#pragma unroll
        for (int ks = 0; ks < 4; ++ks) cf[ks] = *(const LAS bf16x8*)(F.lds + cfo[ks]);
        bf16_t* const zp = ZY + (row0 + q0 + ql) * DI + g * 256 + 4 * gq;
        const LAS float* const acs_l = acs + 16 * gq; const LAS float* const dtl_l = dtl + 16 * gq;
        f32x4 acc[4][4];
        float aq[4];
#pragma unroll
        for (int r = 0; r < 4; ++r) { aq[r] = acs[(q0 + ql) * 4 + r];
#pragma unroll
            for (int pf = 0; pf < 4; ++pf) acc[r][pf] = (f32x4){0.f, 0.f, 0.f, 0.f}; }
#pragma unroll
        for (int ks = 0; ks < 4; ++ks) if (2 * ks <= w) {
            f32x4 cb[2];
#pragma unroll
            for (int hf = 0; hf < 2; ++hf) { cb[hf] = (f32x4){0.f, 0.f, 0.f, 0.f};
                if (2 * ks + hf <= w) {
#pragma unroll
                    for (int kn = 0; kn < 4; ++kn) { const bf16x8 bfr = *(const LAS bf16x8*)(F.lds + bbo[kn] + 4096 * (2 * ks + hf)); cb[hf] = __builtin_amdgcn_mfma_f32_16x16x32_bf16(bfr, cf[kn], cb[hf], 0, 0, 0); } } }
#pragma unroll
            for (int r = 0; r < 4; ++r) {
                const float Dh = *(const GAS float*)(F.in[I_DSKIP] + g * HPG + r);
                float v[8];
#pragma unroll
                for (int hf = 0; hf < 2; ++hf) { const int sf = 2 * ks + hf;
#pragma unroll
                    for (int rg = 0; rg < 4; ++rg) { const int sl = 4 * gq + rg;
                        float val = 0.f;
                        if (sf <= w) { const float as = acs_l[64 * sf + 4 * rg + r], d = dtl_l[64 * sf + 4 * rg + r];
                            val = cb[hf][rg] * __expf(aq[r] - as) * d;
                            if (sf == w) { if (sl > ql) val = 0.f; else if (sl == ql) val += Dh; } }
                        v[4 * hf + rg] = val; } }
                u32x4 pk; pk.x = cvt_pk_bf16(v[0], v[1]); pk.y = cvt_pk_bf16(v[2], v[3]); pk.z = cvt_pk_bf16(v[4], v[5]); pk.w = cvt_pk_bf16(v[6], v[7]);
                const bf16x8 wf = __builtin_bit_cast(bf16x8, pk);
#pragma unroll
                for (int pf = 0; pf < 4; ++pf) {
                    const LAS unsigned char* const xb = F.lds + xbo[r & 1][pf] + (r >> 1) * 32768 + 8192 * ks;
                    const bf16x8 xf = tr_pair(xb, xb + 4096);
                    acc[r][pf] = __builtin_amdgcn_mfma_f32_16x16x32_bf16(xf, wf, acc[r][pf], 0, 0, 0); }
            }
        }
        u32x4 hreg[8];
        if (c > 0) {
            const u32x4* hsrc = (const u32x4*)(HP + ((((size_t)b * NCHUNK + c) * NH + g * HPG) * HD) * DSTATE) + F.tid;
#pragma unroll
            for (int i = 0; i < 8; ++i) hreg[i] = *(const GAS u32x4*)(hsrc + 512 * i);
        }
        if (c > 0) {
            __syncthreads();
#pragma unroll
            for (int i = 0; i < 8; ++i) { const int e = F.tid + 512 * i, hr_ = e >> 10, p_ = (e >> 4) & 63, ch_ = e & 15;
                *(LAS u32x4*)(F.lds + IMG_X + hr_ * 16384 + img_off<false>(p_, ch_)) = hreg[i]; }
            __syncthreads();
#pragma unroll
            for (int r = 0; r < 4; ++r) { const float eaq = __expf(aq[r]);
#pragma unroll
                for (int pf = 0; pf < 4; ++pf) { f32x4 yo = (f32x4){0.f, 0.f, 0.f, 0.f};
#pragma unroll
                    for (int ks = 0; ks < 4; ++ks) { const bf16x8 hf_ = *(const LAS bf16x8*)(F.lds + IMG_X + r * 16384 + hbo[ks] + 4096 * pf); yo = __builtin_amdgcn_mfma_f32_16x16x32_bf16(hf_, cf[ks], yo, 0, 0, 0); }
                    acc[r][pf] += yo * eaq; } }
        }
        float ssum = 0.f;
#pragma unroll
        for (int r = 0; r < 4; ++r)
#pragma unroll
            for (int pf = 0; pf < 4; ++pf) {
                const u32x2 zz = *(const GAS u32x2*)(zp + r * 64 + 16 * pf);
                const f32x4 y = acc[r][pf] * (f32x4){bflo(zz.x), bfhi(zz.x), bflo(zz.y), bfhi(zz.y)};
                acc[r][pf] = y; ssum += (y[0] * y[0] + y[1] * y[1]) + (y[2] * y[2] + y[3] * y[3]); }
        ssum += __shfl_xor(ssum, 16); ssum += __shfl_xor(ssum, 32);
        const float rsn = __builtin_amdgcn_rsqf(ssum * (1.0f / 256.0f) + EPS);
#pragma unroll
        for (int r = 0; r < 4; ++r)
#pragma unroll
            for (int pf = 0; pf < 4; ++pf) { u32x2 o; o.x = cvt_pk_bf16(acc[r][pf][0] * rsn, acc[r][pf][1] * rsn); o.y = cvt_pk_bf16(acc[r][pf][2] * rsn, acc[r][pf][3] * rsn);
                *(GAS u32x2*)(zp + r * 64 + 16 * pf) = o; }
        __syncthreads();
    }
}

__device__ __forceinline__ void ssd_seq_phase(Frame& F) {
    const int r = F.wave & 3, nh = F.wave >> 2, lane = F.lane, idx = r * 64 + lane;
    LAS float* const bc = (LAS float*)F.lds;
    LAS float* const lxs = bc + 2048;
    LAS float* const yp = bc + 4096;
    LAS float* const ldt = bc + 8192; LAS float* const ssq = bc + 8192 + 32;
    const bf16_t* const XBC = (const bf16_t*)(F.ws + WS_XBC); const bf16_t* const Zs = (const bf16_t*)(F.ws + WS_Z); bf16_t* const YN = (bf16_t*)(F.ws + WS_Z);
    const float* const DT = (const float*)(F.ws + WS_DT);
    const float* const convw = F.in[I_CONVW]; const float* const convb = F.in[I_CONVB];
    for (int it = F.vcu; it < DECB * NG; it += F.G) {
        const int b = it >> 3, g = it & 7, head = g * HPG + r;
        const size_t row0 = (size_t)MP + (size_t)b * DECS;
        const int xch = g * 256 + idx;
        {
            const int ch = (nh == 0) ? ((idx < 128) ? (DI + g * DSTATE + idx) : (DI + NG * DSTATE + g * DSTATE + (idx - 128))) : xch;
            float cw[4];
#pragma unroll
            for (int k = 0; k < 4; ++k) cw[k] = *(const GAS float*)(convw + (size_t)k * CD + ch);
            const float cbv = *(const GAS float*)(convb + ch);
            const float* cs = F.in[I_CONV] + (size_t)b * 3 * CD;
            float x3 = *(const GAS float*)(cs + ch), x2 = *(const GAS float*)(cs + CD + ch), x1 = *(const GAS float*)(cs + 2 * CD + ch);
            LAS float* const dst = (nh == 0) ? bc : lxs;
#pragma unroll
            for (int j = 0; j < 8; ++j) {
                const float xr = bf2f(*(const GAS bf16_t*)(XBC + (row0 + j) * CD + ch));
                const float cx = cbv + cw[0] * x3 + cw[1] * x2 + cw[2] * x1 + cw[3] * xr; x3 = x2; x2 = x1; x1 = xr;
                dst[j * 256 + idx] = silu_f(cx);
            }
            if (nh == 1 && lane < 8) ldt[lane * 4 + r] = *(const GAS float*)(DT + (row0 + lane) * 32 + head);
        }
        __syncthreads();
        {
            const float Ah = -__expf(*(const GAS float*)(F.in[I_ALOG] + head));
            const int pg = lane >> 4, nc = lane & 15;
            f32x4 h[16];
            const float* const hin = F.in[I_SSM] + (((size_t)b * NH + head) * HD + 16 * pg) * DSTATE + 64 * nh + 4 * nc;
#pragma unroll
            for (int i = 0; i < 16; ++i) h[i] = *(const GAS f32x4*)(hin + (size_t)i * DSTATE);
            for (int j = 0; j < 8; ++j) {
                const float dtv = ldt[j * 4 + r], dA = __expf(dtv * Ah);
                const f32x4 Bv = *(const LAS f32x4*)(bc + j * 256 + 64 * nh + 4 * nc), Cv = *(const LAS f32x4*)(bc + j * 256 + 128 + 64 * nh + 4 * nc);
                float part[16];
#pragma unroll
                for (int i4 = 0; i4 < 4; ++i4) { const f32x4 xs4 = *(const LAS f32x4*)(lxs + j * 256 + r * 64 + 16 * pg + 4 * i4);
#pragma unroll
                    for (int k = 0; k < 4; ++k) { const int i = 4 * i4 + k; const float dx = dtv * xs4[k];
                        h[i] = h[i] * dA + Bv * dx;
                        part[i] = (Cv.x * h[i].x + Cv.y * h[i].y) + (Cv.z * h[i].z + Cv.w * h[i].w); } }
#pragma unroll
                for (int i = 0; i < 8; ++i) { const bool up = (nc & 8) != 0; const float keep = up ? part[i + 8] : part[i], send = up ? part[i] : part[i + 8]; part[i] = keep + __shfl_xor(send, 8); }
#pragma unroll
                for (int i = 0; i < 4; ++i) { const bool up = (nc & 4) != 0; const float keep = up ? part[i + 4] : part[i], send = up ? part[i] : part[i + 4]; part[i] = keep + __shfl_xor(send, 4); }
#pragma unroll
                for (int i = 0; i < 2; ++i) { const bool up = (nc & 2) != 0; const float keep = up ? part[i + 2] : part[i], send = up ? part[i] : part[i + 2]; part[i] = keep + __shfl_xor(send, 2); }
                { const bool up = (nc & 1) != 0; const float keep = up ? part[1] : part[0], send = up ? part[0] : part[1]; part[0] = keep + __shfl_xor(send, 1); }
                yp[(j * 2 + nh) * 256 + r * 64 + 16 * pg + nc] = part[0];
            }
            float* const hout = F.out + O_SSM_S + (((size_t)b * NH + head) * HD + 16 * pg) * DSTATE + 64 * nh + 4 * nc;
#pragma unroll
            for (int i = 0; i < 16; ++i) *(GAS f32x4*)(hout + (size_t)i * DSTATE) = h[i];
        }
        __syncthreads();
        float ygv[4];
        {
            const float Dh = *(const GAS float*)(F.in[I_DSKIP] + head);
#pragma unroll
            for (int jj = 0; jj < 4; ++jj) { const int j = 4 * nh + jj;
                const float y = (yp[(j * 2) * 256 + idx] + yp[(j * 2 + 1) * 256 + idx]) + Dh * lxs[j * 256 + idx];
                ygv[jj] = y * bf2f(*(const GAS bf16_t*)(Zs + (row0 + j) * DI + xch));
                const float ss = wave_sum(ygv[jj] * ygv[jj]);
                if (lane == 0) ssq[j * 4 + r] = ss; }
        }
        __syncthreads();
#pragma unroll
        for (int jj = 0; jj < 4; ++jj) { const int j = 4 * nh + jj;
            const f32x4 s4 = *(const LAS f32x4*)(ssq + j * 4);
            const float rsn = __builtin_amdgcn_rsqf(((s4.x + s4.y) + (s4.z + s4.w)) * (1.0f / 256.0f) + EPS);
            *(GAS bf16_t*)(YN + (row0 + j) * DI + xch) = (bf16_t)f2bf(ygv[jj] * rsn); }
        __syncthreads();
    }
}
template <int W> __device__ __forceinline__ void pool_run(const bf16_t* V, bf16_t* PO, int run, int cv) {
    const int row0 = run * 16, t0 = row0 & (SEQ - 1);
    u32x4 raw[16 + W - 1];
#pragma unroll
    for (int e = 0; e < 16 + W - 1; ++e) {
        const int dt_ = e - (W - 1);
        if (t0 + dt_ >= 0) raw[e] = *(const GAS u32x4*)(V + (size_t)(row0 + dt_) * PD + cv); else raw[e] = (u32x4){0u, 0u, 0u, 0u};
    }
    f32x4 s0 = (f32x4){0.f, 0.f, 0.f, 0.f}, s1 = s0;
#pragma unroll
    for (int e = 0; e < W - 1; ++e) { f32x4 x0, x1; pg8::unpack8(raw[e], x0, x1); s0 += x0; s1 += x1; }
#pragma unroll
    for (int i = 0; i < 16; ++i) {
        f32x4 c0, c1; pg8::unpack8(raw[i + W - 1], c0, c1);
        s0 += c0; s1 += c1;
        const int t = t0 + i; const float ic = 1.0f / (float)((t + 1 < W) ? t + 1 : W);
        const f32x4 o0 = s0 * ic - c0, o1 = s1 * ic - c1;
        u32x4 o; o.x = pk2(o0.x, o0.y); o.y = pk2(o0.z, o0.w); o.z = pk2(o1.x, o1.y); o.w = pk2(o1.z, o1.w);
        *(GAS u32x4*)(PO + (size_t)(row0 + i) * PD + cv) = o;
        f32x4 x0, x1; pg8::unpack8(raw[i], x0, x1); s0 -= x0; s1 -= x1;
    }
}
__device__ __forceinline__ void pool_phase(Frame& F) {
    const bf16_t* const V = (const bf16_t*)(F.ws + WS_V); bf16_t* const PO = (bf16_t*)(F.out + O_Y);
    const float* const sp = F.in[I_POOL];
    const int gt = F.vcu * NTHREADS + F.tid, NT = F.G * NTHREADS;
    for (int e = gt; e < (MP / 16) * 128; e += NT) {
        const int c32 = e & 31, rl = (e >> 5) & 1, grp = (e >> 6) & 3, run = (e >> 8) * 2 + rl, cv = (grp * 32 + c32) * 8;
        if (grp == 0) pool_run<2>(V, PO, run, cv); else if (grp == 1) pool_run<4>(V, PO, run, cv); else if (grp == 2) pool_run<8>(V, PO, run, cv); else pool_run<16>(V, PO, run, cv);
    }
    for (int e = gt; e < MS * 128; e += NT) {
        const int row = MP + (e >> 7), cv = (e & 127) * 8, w = 2 << (cv >> 8);
        const int rr = row - MP, b = rr >> 3, t = rr & 7;
        float s[8];
#pragma unroll
        for (int j = 0; j < 8; ++j) s[j] = 0.f;
        f32x4 c0, c1; pg8::unpack8(*(const GAS u32x4*)(V + (size_t)row * PD + cv), c0, c1);
        for (int k = 0; k < w; ++k) { const int tt = t - k; f32x4 a0, a1;
            if (tt >= 0) pg8::unpack8(*(const GAS u32x4*)(V + (size_t)(row - k) * PD + cv), a0, a1);
            else { const float* p = sp + ((size_t)b * PBUF + (PBUF + tt)) * PD + cv; a0 = *(const GAS f32x4*)p; a1 = *(const GAS f32x4*)(p + 4); }
            s[0] += a0.x; s[1] += a0.y; s[2] += a0.z; s[3] += a0.w; s[4] += a1.x; s[5] += a1.y; s[6] += a1.z; s[7] += a1.w; }
        const float ic = 1.0f / (float)w;
        f32x4 o0 = (f32x4){s[0] * ic, s[1] * ic, s[2] * ic, s[3] * ic} - c0, o1 = (f32x4){s[4] * ic, s[5] * ic, s[6] * ic, s[7] * ic} - c1;
        u32x4 o; o.x = pk2(o0.x, o0.y); o.y = pk2(o0.z, o0.w); o.z = pk2(o1.x, o1.y); o.w = pk2(o1.z, o1.w);
        *(GAS u32x4*)(PO + (size_t)row * PD + cv) = o;
    }
    float* const ops = F.out + O_POOL_S;
    for (int e = gt; e < DECB * 7 * (PD / 4); e += NT) {
        const int c4 = e & 255, i = (e >> 8) % 7, b = (e >> 8) / 7;
        *(GAS f32x4*)(ops + ((size_t)b * PBUF + i) * PD + c4 * 4) = *(const GAS f32x4*)(sp + ((size_t)b * PBUF + 8 + i) * PD + c4 * 4);
    }
}
__device__ __forceinline__ void final_phase(Frame& F) {
    const int gw = F.vcu * NWAVES + F.wave, NGW = F.G * NWAVES, lane = F.lane;
    const float* const st = (const float*)(F.ws + WS_STATS_A); const float* const gf = F.in[I_NFINAL];
    f32x4 gv[4];
#pragma unroll
    for (int j = 0; j < 4; ++j) gv[j] = *((const GAS f32x4*)gf + lane + 64 * j);
    for (int m = gw; m < M; m += NGW) {
        const GAS f32x4* sp = (const GAS f32x4*)(st + (size_t)m * 16);
        const f32x4 a = sp[0], b = sp[1], c = sp[2], d = sp[3]; const f32x4 s = (a + b) + (c + d);
        const float rs = __builtin_amdgcn_rsqf(((s[0] + s[1]) + (s[2] + s[3])) * (1.0f / 1024.0f) + EPS);
        GAS f32x4* yr = (GAS f32x4*)(F.out + (size_t)m * DM) + lane;
#pragma unroll
        for (int j = 0; j < 4; ++j) yr[64 * j] = yr[64 * j] * rs * gv[j];
    }
}

constexpr int NPHASES = 13;
struct Args { const float* in[30]; float* out; unsigned char* ws; int ph_lo, ph_hi, li, pad; };
__global__ void __launch_bounds__(NTHREADS, 2) mk_fwd(Args args) {
    extern __shared__ __attribute__((aligned(16))) unsigned char lds[];
    Frame F;
    F.lds = (LAS unsigned char*)lds;
    F.MISC = (volatile LAS unsigned*)(F.lds + MISC_OFF);
    F.tid = threadIdx.x; F.lane = F.tid & 63; F.wave = __builtin_amdgcn_readfirstlane(F.tid >> 6);
    F.G = gridDim.x; { const int bx = blockIdx.x; F.vcu = (F.G % 8 == 0) ? (bx % 8) * (F.G / 8) + bx / 8 : bx; }
    F.ws = args.ws; F.out = args.out; F.ctl = (gu32*)(args.ws + WS_CTL);
#pragma unroll
    for (int i = 0; i < 30; ++i) F.in[i] = args.in[i];
    for (int u = F.tid; u < (LDS_BYTES - LDSCTL_OFF) / 4; u += NTHREADS) ((LAS unsigned*)(F.lds + LDSCTL_OFF))[u] = 0u;
    __syncthreads();
    const int lo = args.ph_lo, hi = args.ph_hi;
    XcdBarrier bar; bar.bar = (unsigned*)(F.ctl + CW_BAR); bar.x = 0; bar.st = nullptr;
    if (hi - lo > 1) bar = xcd_barrier_post((unsigned*)(F.ctl + CW_BAR), F.MISC + 8);
#ifndef PHMASK
#define PHMASK 0x1fff
#endif
#define IN(k) (((PHMASK >> (k)) & 1) && lo <= (k) && (k) < hi)
#define SEAM(k) do { if (IN(k) && IN((k) + 1)) xcd_barrier(bar); } while (0)
#define PH_BEGIN(k) if (IN(k)) { auto body_ = [&]() __attribute__((always_inline))
#define PH_END(k) ; body_(); if ((REP_MASK >> (k)) & 1) { xcd_barrier(bar); body_(); } } SEAM(k);

    bf16_t* const XB = (bf16_t*)(F.ws + WS_XB); bf16_t* const HB = (bf16_t*)(F.ws + WS_HB); bf16_t* const ACT = (bf16_t*)(F.ws + WS_ACT);
    bf16_t* const Zb = (bf16_t*)(F.ws + WS_Z); bf16_t* const XBCb = (bf16_t*)(F.ws + WS_XBC); bf16_t* const Vb = (bf16_t*)(F.ws + WS_V); bf16_t* const GATES = (bf16_t*)(F.ws + WS_GATES);
    bf16_t* const POOLED = (bf16_t*)(F.out + O_Y); bf16_t* const MERGED = (bf16_t*)(F.ws + WS_MERGED); bf16_t* const Qb = (bf16_t*)(F.ws + WS_Q); bf16_t* const PB = (bf16_t*)(F.ws + WS_PB);
    float* const T1 = (float*)(F.ws + WS_T1); float* const stA = (float*)(F.ws + WS_STATS_A); float* const stB = (float*)(F.ws + WS_STATS_B); float* const DTb = (float*)(F.ws + WS_DT);
    float* const H = F.out + O_Y;
    pg8::StaticOrder S;

    PH_BEGIN(0) { p0_prologue(F); } PH_END(0)
    PH_BEGIN(1) {
        pg8::Gemm g{XB, (const bf16_t*)(F.ws + WS_WGU1), M, 2 * DFF, DM, DM, 0}; S.init(M, 2 * DFF, F.G, (int)blockIdx.x);
        pg8::Epi E{}; E.kind = pg8::EK_GU; E.stats_in = stA; E.obf = ACT; E.ldo = DFF;
        pg8::gemm_phase(F.lds, g, S, E);
        pg8::Gemm g2{(const bf16_t*)(F.ws + WS_WPOT), (const bf16_t*)(F.ws + WS_WGRP), DM, DM, 256, DM, 256}; S.init_tail(DM, DM, F.G, (int)blockIdx.x);
        pg8::Epi E2{}; E2.kind = pg8::EK_BF16; E2.obf = (bf16_t*)(F.ws + WS_W2); E2.ldo = DM;
        pg8::gemm_phase(F.lds, g2, S, E2);
    } PH_END(1)
    PH_BEGIN(2) {
        pg8::Gemm g{ACT, (const bf16_t*)(F.ws + WS_WD1), M, DM, DFF, DFF, 0}; S.init(MP, DM, F.G, (int)blockIdx.x);
        pg8::Epi E{}; E.kind = pg8::EK_RES; E.coef = 0.5f; E.res_p = F.in[I_XP]; E.res_s = F.in[I_XS]; E.obf = HB; E.stats_out = stB;
        pg8::gemm_phase(F.lds, g, S, E);
        pg8::gemm_small(F.lds, g, E, MP, MS, F.G, (int)blockIdx.x);
    } PH_END(2)
    PH_BEGIN(3) {
        pg8::Gemm g{HB, (const bf16_t*)(F.ws + WS_WIN), M, NIN, DM, DM, 0}; S.init(M, NIN, F.G, (int)blockIdx.x);
        pg8::Epi E{}; E.kind = pg8::EK_WIN; E.stats_in = stB; E.Z = Zb; E.XBC = XBCb; E.V = Vb; E.GATES = GATES; E.HALO = (bf16_t*)(F.ws + WS_HALO); E.DT = DTb; E.dt_bias = F.in[I_DTB];
        E.conv_p = F.out + O_CONV_P; E.conv_s = F.out + O_CONV_S; E.pool_p = F.out + O_POOL_P; E.pool_s = F.out + O_POOL_S;
        pg8::gemm_phase(F.lds, g, S, E);
    } PH_END(3)
    PH_BEGIN(4) { ssd_states_phase(F); pool_phase(F); } PH_END(4)
    PH_BEGIN(5) { ssd_scan_phase(F);

        pg8::Gemm g{PB, (const bf16_t*)(F.ws + WS_WPLE), M, DM, PLE, PLE, 0}; S.init(MP, DM, F.G, (int)blockIdx.x);
        pg8::Epi E{}; E.kind = pg8::EK_BF16; E.obf = Qb; E.ldo = DM;
        pg8::gemm_phase(F.lds, g, S, E);
        pg8::gemm_small(F.lds, g, E, MP, MS, F.G, (int)blockIdx.x);
        } PH_END(5)
    PH_BEGIN(6) { ssd_out_phase(F); ssd_seq_phase(F); } PH_END(6)
    PH_BEGIN(7) {
        pg8::Gemm2 g{Zb, (const bf16_t*)(F.ws + WS_WSSO), POOLED, (const bf16_t*)(F.ws + WS_W2), DI, DI, DM, DM, DM}; S.init(MP, DM, F.G, (int)blockIdx.x);
        pg8::gemm_phase2(F.lds, g, S, GATES, MERGED);
        pg8::gemm_small2(F.lds, g, GATES, MERGED, MP, MS, F.G, (int)blockIdx.x);
    } PH_END(7)
    PH_BEGIN(8) {
        pg8::Gemm g{MERGED, (const bf16_t*)(F.ws + WS_WO), M, DM, DM, DM, 0}; S.init(MP, DM, F.G, (int)blockIdx.x);
        pg8::Epi E{}; E.kind = pg8::EK_RES; E.coef = 1.0f; E.res_bf = HB; E.obf = HB; E.stats_out = stA;
        pg8::gemm_phase(F.lds, g, S, E);
        pg8::gemm_small(F.lds, g, E, MP, MS, F.G, (int)blockIdx.x);
    } PH_END(8)
    PH_BEGIN(9) {
        pg8::Gemm g{HB, (const bf16_t*)(F.ws + WS_WGU2), M, 2 * DFF, DM, DM, 0}; S.init(M, 2 * DFF, F.G, (int)blockIdx.x);
        pg8::Epi E{}; E.kind = pg8::EK_GU; E.stats_in = stA; E.obf = ACT; E.ldo = DFF;
        pg8::gemm_phase(F.lds, g, S, E);
    } PH_END(9)
    PH_BEGIN(10) {
        pg8::Gemm g{ACT, (const bf16_t*)(F.ws + WS_WD2), M, DM, DFF, DFF, 0}; S.init(MP, DM, F.G, (int)blockIdx.x);
        pg8::Epi E{}; E.kind = pg8::EK_RES; E.coef = 0.5f; E.res_bf = HB; E.obf = HB; E.stats_out = stB;
        pg8::gemm_phase(F.lds, g, S, E);
        pg8::gemm_small(F.lds, g, E, MP, MS, F.G, (int)blockIdx.x);
    } PH_END(10)
    PH_BEGIN(11) {
        pg8::Gemm g{HB, (const bf16_t*)(F.ws + WS_WPG), M, DM, DM, DM, 0}; S.init(MP, DM, F.G, (int)blockIdx.x);
        pg8::Epi E{}; E.kind = pg8::EK_PLE; E.stats_in = stB; E.q = Qb; E.res_bf = HB; E.of32 = H; E.stats_out = stA;
        pg8::gemm_phase(F.lds, g, S, E);
        pg8::gemm_small(F.lds, g, E, MP, MS, F.G, (int)blockIdx.x);
    } PH_END(11)
    PH_BEGIN(12) { final_phase(F); } PH_END(12)
#undef IN
#undef SEAM
#undef PH_BEGIN
#undef PH_END
}

extern "C" void kernel_launch(void* const* d_in, const int* in_sizes, int n_in, void* d_out, int out_size, void* d_ws, size_t ws_size, hipStream_t stream) {
    static int grid = 0;
    if (grid == 0) {
        if (n_in != 30 || in_sizes[0] != MP * DM || (size_t)out_size != O_END || ws_size < WS_END) {
            fprintf(stderr, "kernel_launch: shape mismatch: n_in %d in0 %d out %d ws %zu (need %zu)\n", n_in, n_in > 0 ? in_sizes[0] : -1, out_size, ws_size, (size_t)WS_END); grid = -1; return; }
        int dev = 0, cus = 0, per_cu = 0;
        if (hipGetDevice(&dev) != hipSuccess || hipDeviceGetAttribute(&cus, hipDeviceAttributeMultiprocessorCount, dev) != hipSuccess) { grid = -1; return; }
        if (hipFuncSetAttribute((const void*)mk_fwd, hipFuncAttributeMaxDynamicSharedMemorySize, LDS_BYTES) != hipSuccess) { fprintf(stderr, "kernel_launch: hipFuncSetAttribute failed\n"); grid = -1; return; }
        if (hipOccupancyMaxActiveBlocksPerMultiprocessor(&per_cu, (const void*)mk_fwd, NTHREADS, LDS_BYTES) != hipSuccess || per_cu < 1)
            fprintf(stderr, "kernel_launch: occupancy query reports %d workgroups per CU\n", per_cu);
        (void)hipGetLastError();
        grid = cus;
    }
    if (grid < 0) return;
    if (hipMemsetAsync((char*)d_ws + WS_CTL, 0, CTL_ZERO_BYTES, stream) != hipSuccess) { fprintf(stderr, "kernel_launch: memset failed\n"); return; }
    Args a{};
    for (int i = 0; i < 30; ++i) a.in[i] = (const float*)d_in[i];
    a.out = (float*)d_out; a.ws = (unsigned char*)d_ws;
#if MK_MULTI_LAUNCH
    for (int ph = 0; ph < NPHASES; ++ph) { a.ph_lo = ph; a.ph_hi = ph + 1; a.li = ph;
        hipLaunchKernelGGL(mk_fwd, dim3(grid), dim3(NTHREADS), LDS_BYTES, stream, a); }
#else
    a.ph_lo = 0; a.ph_hi = NPHASES; a.li = 0;
    hipLaunchKernelGGL(mk_fwd, dim3(grid), dim3(NTHREADS), LDS_BYTES, stream, a);
#endif
}
```

```cpp
#include <hip/hip_runtime.h>
#include <cstdio>
#include <cstdint>

#define REP_MASK 0x0
#ifndef MK_MULTI_LAUNCH
#define MK_MULTI_LAUNCH 0
#endif

#define GAS __attribute__((address_space(1)))
#define LAS __attribute__((address_space(3)))
typedef unsigned short bf16_t;
typedef short bf16x8 __attribute__((ext_vector_type(8)));
typedef float f32x4 __attribute__((ext_vector_type(4)));
typedef float f32x2 __attribute__((ext_vector_type(2)));
typedef unsigned u32x4 __attribute__((ext_vector_type(4)));
typedef unsigned u32x2 __attribute__((ext_vector_type(2)));
typedef GAS unsigned gu32;

constexpr int DM = 1024, BATCH = 8, SEQ = 2048, DECB = 128, DECS = 8;
constexpr int MP = BATCH * SEQ, MS = DECB * DECS, M = MP + MS;
constexpr int DI = 2048, HD = 64, NH = 32, NG = 8, HPG = 4, DSTATE = 128, CD = 4096;
constexpr int PD = 1024, PBUF = 15, DFF = 2816, PLE = 256;
constexpr int IN_DIM = 9248, NIN = 9472;
constexpr float EPS = 1e-6f;
constexpr int NWAVES = 8, NTHREADS = 512;

constexpr size_t MiB = 1u << 20;
constexpr size_t WS_CTL = 0, CTL_ZERO_BYTES = 1 * MiB;
constexpr size_t WS_STATS_A = 2 * MiB, WS_STATS_B = 4 * MiB, WS_DT = 6 * MiB, WS_CDEC = 9 * MiB;
constexpr size_t WS_WGU1 = 10 * MiB, WS_WD1 = 21 * MiB, WS_WIN = 27 * MiB, WS_WSSO = 46 * MiB, WS_W2 = 50 * MiB, WS_WO = 52 * MiB,
                 WS_WGU2 = 54 * MiB, WS_WD2 = 65 * MiB, WS_WPG = 71 * MiB, WS_WPLE = 73 * MiB, WS_PB = 74 * MiB, WS_WPOT = 480 * MiB, WS_WGRP = 483 * MiB;
constexpr size_t WS_Z = 84 * MiB, WS_XBC = 152 * MiB, WS_V = 288 * MiB, WS_GATES = 322 * MiB, WS_HB = 390 * MiB, WS_HPREV = 424 * MiB, WS_HALO = 488 * MiB, WS_END = 492 * MiB;
constexpr size_t WS_ACT = WS_XBC, WS_T1 = WS_XBC, WS_MERGED = 220 * MiB, WS_Q = WS_V, WS_XB = WS_HB;
static_assert(WS_STATS_A + (size_t)M * 16 * 4 <= WS_STATS_B && WS_STATS_B + (size_t)M * 16 * 4 <= WS_DT && WS_DT + (size_t)M * 32 * 4 <= WS_WGU1, "ws map (small)");
static_assert(WS_WGU1 + (size_t)2 * DFF * DM * 2 <= WS_WD1 && WS_WD1 + (size_t)DM * DFF * 2 <= WS_WIN && WS_WIN + (size_t)NIN * DM * 2 <= WS_WSSO && WS_WSSO + (size_t)DM * DI * 2 <= WS_W2, "ws map (w1)");
static_assert(WS_WGU2 + (size_t)2 * DFF * DM * 2 <= WS_WD2 && WS_WD2 + (size_t)DM * DFF * 2 <= WS_WPG && WS_WPLE + (size_t)DM * PLE * 2 <= WS_PB && WS_PB + (size_t)M * PLE * 2 <= WS_Z, "ws map (w2)");
static_assert(WS_Z + (size_t)M * DI * 2 <= WS_XBC && WS_XBC + (size_t)M * CD * 2 <= WS_V && WS_V + (size_t)M * PD * 2 <= WS_GATES && WS_GATES + (size_t)M * 2 * DM * 2 <= WS_HB &&
              WS_HB + (size_t)M * DM * 2 <= WS_HPREV && WS_HPREV + (size_t)BATCH * 16 * NH * HD * DSTATE * 2 <= WS_END, "ws map (act)");
static_assert(WS_ACT + (size_t)M * DFF * 2 <= WS_V && WS_T1 + (size_t)M * DM * 4 <= WS_MERGED && WS_MERGED + (size_t)M * DM * 2 <= WS_V, "ws overlays");
constexpr int CW_BAR = 4096;

constexpr size_t O_Y = 0, O_SSM_P = (size_t)M * DM, O_CONV_P = O_SSM_P + (size_t)BATCH * NH * HD * DSTATE, O_POOL_P = O_CONV_P + (size_t)BATCH * 3 * CD,
                 O_SSM_S = O_POOL_P + (size_t)BATCH * PBUF * PD, O_CONV_S = O_SSM_S + (size_t)DECB * NH * HD * DSTATE, O_POOL_S = O_CONV_S + (size_t)DECB * 3 * CD,
                 O_END = O_POOL_S + (size_t)DECB * PBUF * PD;

constexpr int RING_BYTES = 131072, LDSCTL_OFF = RING_BYTES, MISC_OFF = LDSCTL_OFF + 320, LDS_BYTES = 147456;

#define RLX_AGENT __ATOMIC_RELAXED, __HIP_MEMORY_SCOPE_AGENT
#define LDS_WAIT() asm volatile("s_waitcnt lgkmcnt(0)" ::: "memory")
#define VM_WAIT() asm volatile("s_waitcnt vmcnt(0)" ::: "memory")

__device__ __forceinline__ unsigned f2bf(float f) { unsigned u = __builtin_bit_cast(unsigned, f); return (u + 0x7fffu + ((u >> 16) & 1u)) >> 16; }
__device__ __forceinline__ unsigned cvt_pk_bf16(float lo, float hi);
__device__ __forceinline__ unsigned pk2(float lo, float hi) { return cvt_pk_bf16(lo, hi); }
__device__ __forceinline__ float bf2f(unsigned b) { return __builtin_bit_cast(float, b << 16); }
__device__ __forceinline__ float bflo(unsigned w) { return __builtin_bit_cast(float, w << 16); }
__device__ __forceinline__ float bfhi(unsigned w) { return __builtin_bit_cast(float, w & 0xffff0000u); }
typedef __bf16 bf16x2_t __attribute__((ext_vector_type(2)));
__device__ __forceinline__ unsigned cvt_pk_bf16(float lo, float hi) { const bf16x2_t v = {(__bf16)lo, (__bf16)hi}; return __builtin_bit_cast(unsigned, v); }
__device__ __forceinline__ float sigm_f(float x) { return __builtin_amdgcn_rcpf(1.0f + __expf(-x)); }
__device__ __forceinline__ float silu_f(float x) { return x * __builtin_amdgcn_rcpf(1.0f + __expf(-x)); }
__device__ __forceinline__ float wave_sum(float v) {
#pragma unroll
    for (int o = 1; o < 64; o <<= 1) v += __shfl_xor(v, o);
    return v;
}

struct Frame {
    LAS unsigned char* lds;
    volatile LAS unsigned* MISC;
    gu32* ctl;
    int tid, lane, wave, vcu, G;
    unsigned char* ws;
    float* out;
    const float* in[30];
};
enum { I_XP = 0, I_XS, I_SSM, I_CONV, I_POOL, I_PP, I_PS, I_NFFN1, I_WGU1, I_WD1, I_NMIX, I_WIN, I_CONVW, I_CONVB, I_DTB, I_ALOG, I_DSKIP, I_NSSD, I_WSSO, I_WPGRP, I_PSCALE,
       I_WPOUT, I_WO, I_NFFN2, I_WGU2, I_WD2, I_NPLE, I_WPG, I_WPLE, I_NFINAL };

namespace pg8 {
constexpr int BM = 256, BK = 64, HALF = 128, HTB = HALF * BK * 2, STAGE_BYTES = 8 * HTB, NXCD = 8, WGM = 8;
__host__ __device__ __forceinline__ int lds_byte(int r, int c) { const int st = (r >> 4) * 2 + (c >> 5), rr = r & 15, cc = c & 31, ob = rr * 64 + cc * 2; return st * 1024 + (ob ^ (((ob >> 9) & 1) << 5)); }
__host__ __device__ __forceinline__ void stage_rc(int b, int& R, int& C) { const int st = b / 1024, sb = b % 1024, swz = sb ^ (((sb >> 9) & 1) << 5); R = (st >> 1) * 16 + swz / 64; C = (st & 1) * 32 + (swz % 64) / 2; }
__host__ __device__ __forceinline__ int perm32(int rho) { const int n = rho >> 4, i = rho & 15; return 8 * (i >> 2) + 4 * n + (i & 3); }
struct Unit { int pm, pn; };
struct Gemm { const bf16_t* A; const bf16_t* Bt; int M, N, K; int lda; int a_pn_step; };
struct StaticOrder {
    int nM, nN, nwg, G, c;
    __host__ __device__ void init(int M_, int N_, int G_, int c_) { nM = M_ / BM; nN = N_ / BM; nwg = nM * nN; G = G_; c = c_; }
    __host__ __device__ void init_tail(int M_, int N_, int G_, int c_) { init(M_, N_, G_, (G_ - 1) - c_); }
    __host__ __device__ bool next(int i, Unit& u) const {
        const long L = (long)i * G + c; if (L >= nwg) return false;
        int wgid = (int)L; { const int q = nwg / NXCD, r = nwg % NXCD, xcd = wgid % NXCD, off = wgid / NXCD; wgid = (xcd < r ? xcd * (q + 1) : r * (q + 1) + (xcd - r) * q) + off; }
        const int nig = WGM * nN, gid = wgid / nig, fm = gid * WGM, gsz = (nM - fm) < WGM ? (nM - fm) : WGM;
        u.pm = fm + ((wgid % nig) % gsz); u.pn = (wgid % nig) / gsz; return true;
    }
};

enum EpiKind { EK_GU = 1, EK_RES = 2, EK_WIN = 3, EK_T1 = 4, EK_MERGE = 5, EK_BF16 = 6, EK_PLE = 7 };
struct Epi {
    const float* stats_in;
    float* stats_out;
    bf16_t* obf;
    float* of32;
    const float* res_p; const float* res_s;
    const bf16_t* res_bf;
    const bf16_t* gates;
    const bf16_t* q;
    bf16_t *Z, *XBC, *V, *GATES, *HALO; float* DT; const float* dt_bias; float *conv_p, *conv_s, *pool_p, *pool_s;
    int kind; int ldo; float coef; int pad;
};

__device__ __forceinline__ u32x4 pack8(const f32x4 a, const f32x4 b) { u32x4 w; w.x = cvt_pk_bf16(a[0], a[1]); w.y = cvt_pk_bf16(a[2], a[3]); w.z = cvt_pk_bf16(b[0], b[1]); w.w = cvt_pk_bf16(b[2], b[3]); return w; }
__device__ __forceinline__ void unpack8(const u32x4 w, f32x4& a, f32x4& b) { a = (f32x4){bflo(w.x), bfhi(w.x), bflo(w.y), bfhi(w.y)}; b = (f32x4){bflo(w.z), bfhi(w.z), bflo(w.w), bfhi(w.w)}; }

__device__ __forceinline__ float row_rs(const float* stats, int row) {
    if (!stats) return 1.0f;
    const GAS f32x4* sp = (const GAS f32x4*)(stats + (size_t)row * 16);
    const f32x4 a = sp[0], b = sp[1], c = sp[2], d = sp[3]; const f32x4 s = (a + b) + (c + d);
    return __builtin_amdgcn_rsqf(((s[0] + s[1]) + (s[2] + s[3])) * (1.0f / 1024.0f) + EPS);
}
__device__ __forceinline__ float softplus_f(float x) { const float e = __expf(-fabsf(x)); const float l = (e < 0.01f) ? e * (1.0f - e * (0.5f - e * (1.0f / 3.0f))) : __logf(1.0f + e); return fmaxf(x, 0.f) + l; }

__device__ __forceinline__ void epilogue(const Epi& E, const f32x4 (&acc)[2][2][4][2], const Unit& u, int wr, int wc, int fr, int fq) {
    const int rowb = u.pm * BM + wr * 64 + fr;
    const int cin = wc * 32 + 8 * fq;
    if (E.kind == EK_GU) {
#pragma unroll
        for (int ai = 0; ai < 2; ++ai)
#pragma unroll
            for (int m = 0; m < 4; ++m) { const int row = rowb + ai * HALF + m * 16; const float r = row_rs(E.stats_in, row);
                const f32x4 g0 = acc[ai][0][m][0] * r, u0 = acc[ai][1][m][0] * r, g1 = acc[ai][0][m][1] * r, u1 = acc[ai][1][m][1] * r;
                const f32x4 o0 = (f32x4){silu_f(g0[0]) * u0[0], silu_f(g0[1]) * u0[1], silu_f(g0[2]) * u0[2], silu_f(g0[3]) * u0[3]};
                const f32x4 o1 = (f32x4){silu_f(g1[0]) * u1[0], silu_f(g1[1]) * u1[1], silu_f(g1[2]) * u1[2], silu_f(g1[3]) * u1[3]};
                *(GAS u32x4*)(E.obf + (size_t)row * E.ldo + u.pn * HALF + cin) = pack8(o0, o1); }
    } else if (E.kind == EK_RES) {
#pragma unroll
        for (int ai = 0; ai < 2; ++ai)
#pragma unroll
            for (int m = 0; m < 4; ++m) { const int row = rowb + ai * HALF + m * 16;
                float ss = 0.f;
#pragma unroll
                for (int bj = 0; bj < 2; ++bj) { const int col = u.pn * BM + bj * HALF + cin;
                    f32x4 r0, r1;
                    if (E.res_p) { const float* rp = (row < MP) ? E.res_p + (size_t)row * DM : E.res_s + (size_t)(row - MP) * DM; r0 = *(const GAS f32x4*)(rp + col); r1 = *(const GAS f32x4*)(rp + col + 4); }
                    else unpack8(*(const GAS u32x4*)(E.res_bf + (size_t)row * DM + col), r0, r1);
                    const f32x4 h0 = r0 + acc[ai][bj][m][0] * E.coef, h1 = r1 + acc[ai][bj][m][1] * E.coef;
                    *(GAS u32x4*)(E.obf + (size_t)row * DM + col) = pack8(h0, h1);
                    ss += (h0[0] * h0[0] + h0[1] * h0[1]) + (h0[2] * h0[2] + h0[3] * h0[3]) + (h1[0] * h1[0] + h1[1] * h1[1]) + (h1[2] * h1[2] + h1[3] * h1[3]); }
                ss += __shfl_xor(ss, 16); ss += __shfl_xor(ss, 32);
                if (fq == 0) *(GAS float*)(E.stats_out + (size_t)row * 16 + u.pn * 4 + wc) = ss; }
    } else if (E.kind == EK_WIN) {
        const int pn = u.pn;
        if (pn < 8) {
            const int colt = pn * BM + cin;
#pragma unroll
            for (int ai = 0; ai < 2; ++ai)
#pragma unroll
                for (int m = 0; m < 4; ++m) { const int row = rowb + ai * HALF + m * 16; const float r = row_rs(E.stats_in, row);
#pragma unroll
                    for (int bj = 0; bj < 2; ++bj) { f32x4 v0 = acc[ai][bj][m][0] * r, v1 = acc[ai][bj][m][1] * r;
#pragma unroll
                        for (int j = 0; j < 4; ++j) { v0[j] = silu_f(v0[j]); v1[j] = silu_f(v1[j]); }
                        *(GAS u32x4*)(E.Z + (size_t)row * DI + colt + bj * HALF) = pack8(v0, v1); } }
        } else if (pn >= 28 && pn < 36) {
            const int colt = (pn - 28) * BM + cin;
#pragma unroll
            for (int ai = 0; ai < 2; ++ai)
#pragma unroll
                for (int m = 0; m < 4; ++m) { const int row = rowb + ai * HALF + m * 16; const float r = row_rs(E.stats_in, row);
#pragma unroll
                    for (int bj = 0; bj < 2; ++bj) { f32x4 v0 = acc[ai][bj][m][0] * r, v1 = acc[ai][bj][m][1] * r;
#pragma unroll
                        for (int j = 0; j < 4; ++j) { v0[j] = sigm_f(v0[j]); v1[j] = sigm_f(v1[j]); }
                        *(GAS u32x4*)(E.GATES + (size_t)row * (2 * DM) + colt + bj * HALF) = pack8(v0, v1); } }
        } else if (pn < 28) {
            const bool isx = pn < 24; bf16_t* const O = isx ? E.XBC : E.V; const int ldo = isx ? CD : PD; const int colt = (isx ? pn - 8 : pn - 24) * BM + cin;
            const int keep = isx ? 3 : PBUF;
#pragma unroll
            for (int ai = 0; ai < 2; ++ai)
#pragma unroll
                for (int m = 0; m < 4; ++m) { const int row = rowb + ai * HALF + m * 16; const float r = row_rs(E.stats_in, row);
                    float* sp = nullptr;
                    if (row < MP) { const int sb = row >> 11, st = row & (SEQ - 1); if (st >= SEQ - keep) sp = (isx ? E.conv_p : E.pool_p) + ((size_t)sb * keep + (st - (SEQ - keep))) * ldo + colt; }
                    else { const int sb = (row - MP) >> 3, st = (row - MP) & 7; const int si = st - (DECS - keep); if (si >= 0) sp = (isx ? E.conv_s : E.pool_s) + ((size_t)sb * keep + si) * ldo + colt; }
                    bf16_t* hp = nullptr;
                    if (isx && row < MP) { const int st = row & (SEQ - 1), tm = st & 127; if (tm >= 125 && st < SEQ - 3) hp = E.HALO + ((((size_t)(row >> 11) * 16 + (st >> 7) + 1) * 3 + (tm - 125)) * CD) + colt; }
#pragma unroll
                    for (int bj = 0; bj < 2; ++bj) { const f32x4 v0 = acc[ai][bj][m][0] * r, v1 = acc[ai][bj][m][1] * r;
                        const u32x4 pk = pack8(v0, v1);
                        *(GAS u32x4*)(O + (size_t)row * ldo + colt + bj * HALF) = pk;
                        if (hp) *(GAS u32x4*)(hp + bj * HALF) = pk;
                        if (sp) { *(GAS f32x4*)(sp + bj * HALF) = v0; *(GAS f32x4*)(sp + bj * HALF + 4) = v1; } } }
        } else if (wc == 0) {
            const f32x4 b0 = *(const GAS f32x4*)(E.dt_bias + 8 * fq), b1 = *(const GAS f32x4*)(E.dt_bias + 8 * fq + 4);
#pragma unroll
            for (int ai = 0; ai < 2; ++ai)
#pragma unroll
                for (int m = 0; m < 4; ++m) { const int row = rowb + ai * HALF + m * 16; const float r = row_rs(E.stats_in, row);
                    f32x4 v0 = acc[ai][0][m][0] * r + b0, v1 = acc[ai][0][m][1] * r + b1;
#pragma unroll
                    for (int j = 0; j < 4; ++j) { v0[j] = softplus_f(v0[j]); v1[j] = softplus_f(v1[j]); }
                    *(GAS f32x4*)(E.DT + (size_t)row * 32 + 8 * fq) = v0; *(GAS f32x4*)(E.DT + (size_t)row * 32 + 8 * fq + 4) = v1; }
        }
    } else if (E.kind == EK_T1) {
#pragma unroll
        for (int ai = 0; ai < 2; ++ai)
#pragma unroll
            for (int m = 0; m < 4; ++m) { const int row = rowb + ai * HALF + m * 16;
#pragma unroll
                for (int bj = 0; bj < 2; ++bj) { const int col = u.pn * BM + bj * HALF + cin;
                    f32x4 g0, g1; unpack8(*(const GAS u32x4*)(E.gates + (size_t)row * (2 * DM) + col), g0, g1);
                    *(GAS u32x4*)(E.obf + (size_t)row * DM + col) = pack8(g0 * acc[ai][bj][m][0], g1 * acc[ai][bj][m][1]); } }
    } else if (E.kind == EK_MERGE) {
#pragma unroll
        for (int ai = 0; ai < 2; ++ai)
#pragma unroll
            for (int m = 0; m < 4; ++m) { const int row = rowb + ai * HALF + m * 16;
#pragma unroll
                for (int bj = 0; bj < 2; ++bj) { const int col = u.pn * BM + bj * HALF + cin;
                    f32x4 g0, g1; unpack8(*(const GAS u32x4*)(E.gates + (size_t)row * (2 * DM) + DM + col), g0, g1);
                    f32x4 t0, t1; unpack8(*(const GAS u32x4*)(E.res_bf + (size_t)row * DM + col), t0, t1);
                    *(GAS u32x4*)(E.obf + (size_t)row * DM + col) = pack8(t0 + g0 * acc[ai][bj][m][0], t1 + g1 * acc[ai][bj][m][1]); } }
    } else if (E.kind == EK_BF16) {
#pragma unroll
        for (int ai = 0; ai < 2; ++ai)
#pragma unroll
            for (int m = 0; m < 4; ++m) { const int row = rowb + ai * HALF + m * 16;
#pragma unroll
                for (int bj = 0; bj < 2; ++bj) { const int col = u.pn * BM + bj * HALF + cin;
                    *(GAS u32x4*)(E.obf + (size_t)row * E.ldo + col) = pack8(acc[ai][bj][m][0], acc[ai][bj][m][1]); } }
    } else if (E.kind == EK_PLE) {
#pragma unroll
        for (int ai = 0; ai < 2; ++ai)
#pragma unroll
            for (int m = 0; m < 4; ++m) { const int row = rowb + ai * HALF + m * 16; const float r = row_rs(E.stats_in, row);
                float ss = 0.f;
#pragma unroll
                for (int bj = 0; bj < 2; ++bj) { const int col = u.pn * BM + bj * HALF + cin;
                    f32x4 q0, q1; unpack8(*(const GAS u32x4*)(E.q + (size_t)row * DM + col), q0, q1);
                    f32x4 r0, r1; unpack8(*(const GAS u32x4*)(E.res_bf + (size_t)row * DM + col), r0, r1);
                    f32x4 h0, h1;
#pragma unroll
                    for (int j = 0; j < 4; ++j) { h0[j] = r0[j] + sigm_f(acc[ai][bj][m][0][j] * r) * q0[j]; h1[j] = r1[j] + sigm_f(acc[ai][bj][m][1][j] * r) * q1[j]; }
                    *(GAS f32x4*)(E.of32 + (size_t)row * DM + col) = h0; *(GAS f32x4*)(E.of32 + (size_t)row * DM + col + 4) = h1;
                    ss += (h0[0] * h0[0] + h0[1] * h0[1]) + (h0[2] * h0[2] + h0[3] * h0[3]) + (h1[0] * h1[0] + h1[1] * h1[1]) + (h1[2] * h1[2] + h1[3] * h1[3]); }
                ss += __shfl_xor(ss, 16); ss += __shfl_xor(ss, 32);
                if (fq == 0) *(GAS float*)(E.stats_out + (size_t)row * 16 + u.pn * 4 + wc) = ss; }
    }
}


__device__ __forceinline__ void epi_seg(const Epi& E, int row, int col, f32x4 v0, f32x4 v1, int lane) {
    if (E.kind == EK_RES) {
        f32x4 r0, r1;
        if (E.res_p) { const float* rp = ((row < MP) ? E.res_p + (size_t)row * DM : E.res_s + (size_t)(row - MP) * DM) + col; r0 = *(const GAS f32x4*)rp; r1 = *(const GAS f32x4*)(rp + 4); }
        else unpack8(*(const GAS u32x4*)(E.res_bf + (size_t)row * DM + col), r0, r1);
        const f32x4 h0 = r0 + v0 * E.coef, h1 = r1 + v1 * E.coef;
        *(GAS u32x4*)(E.obf + (size_t)row * DM + col) = pack8(h0, h1);
        float ss = (h0[0] * h0[0] + h0[1] * h0[1]) + (h0[2] * h0[2] + h0[3] * h0[3]) + (h1[0] * h1[0] + h1[1] * h1[1]) + (h1[2] * h1[2] + h1[3] * h1[3]);
        ss += __shfl_xor(ss, 1); ss += __shfl_xor(ss, 2); ss += __shfl_xor(ss, 4);
        if ((lane & 7) == 0) *(GAS float*)(E.stats_out + (size_t)row * 16 + (col >> 6)) = ss;
    } else if (E.kind == EK_T1) {
        f32x4 g0, g1; unpack8(*(const GAS u32x4*)(E.gates + (size_t)row * (2 * DM) + col), g0, g1);
        *(GAS u32x4*)(E.obf + (size_t)row * DM + col) = pack8(g0 * v0, g1 * v1);
    } else if (E.kind == EK_MERGE) {
        f32x4 g0, g1; unpack8(*(const GAS u32x4*)(E.gates + (size_t)row * (2 * DM) + DM + col), g0, g1);
        f32x4 t0, t1; unpack8(*(const GAS u32x4*)(E.res_bf + (size_t)row * DM + col), t0, t1);
        *(GAS u32x4*)(E.obf + (size_t)row * DM + col) = pack8(t0 + g0 * v0, t1 + g1 * v1);
    } else if (E.kind == EK_BF16) {
        *(GAS u32x4*)(E.obf + (size_t)row * E.ldo + col) = pack8(v0, v1);
    } else if (E.kind == EK_PLE) {
        const float r = row_rs(E.stats_in, row);
        f32x4 q0, q1; unpack8(*(const GAS u32x4*)(E.q + (size_t)row * DM + col), q0, q1);
        f32x4 r0, r1; unpack8(*(const GAS u32x4*)(E.res_bf + (size_t)row * DM + col), r0, r1);
        f32x4 h0, h1;
#pragma unroll
        for (int j = 0; j < 4; ++j) { h0[j] = r0[j] + sigm_f(v0[j] * r) * q0[j]; h1[j] = r1[j] + sigm_f(v1[j] * r) * q1[j]; }
        *(GAS f32x4*)(E.of32 + (size_t)row * DM + col) = h0; *(GAS f32x4*)(E.of32 + (size_t)row * DM + col + 4) = h1;
        float ss = (h0[0] * h0[0] + h0[1] * h0[1]) + (h0[2] * h0[2] + h0[3] * h0[3]) + (h1[0] * h1[0] + h1[1] * h1[1]) + (h1[2] * h1[2] + h1[3] * h1[3]);
        ss += __shfl_xor(ss, 1); ss += __shfl_xor(ss, 2); ss += __shfl_xor(ss, 4);
        if ((lane & 7) == 0) *(GAS float*)(E.stats_out + (size_t)row * 16 + (col >> 6)) = ss;
    }
}
__device__ __forceinline__ void small_tile_sum(LAS unsigned char* lds, const bf16_t* A, int lda, const bf16_t* Bt, int K, int r0, int c0, f32x4& v0, f32x4& v1) {
    const int tid = threadIdx.x, wid = __builtin_amdgcn_readfirstlane(tid >> 6), lane = tid & 63, ql = lane & 15, gq = lane >> 4;
    f32x4 acc[4][4];
#pragma unroll
    for (int m = 0; m < 4; ++m)
#pragma unroll
        for (int n = 0; n < 4; ++n) acc[m][n] = (f32x4){0.f, 0.f, 0.f, 0.f};
    const bf16_t* const ap = A + (size_t)(r0 + ql) * lda + 8 * gq + 32 * wid;
    const bf16_t* const bp = Bt + (size_t)(c0 + ql) * K + 8 * gq + 32 * wid;
    const int nst = (K / 32 - wid + 7) / 8;
    bf16x8 af[4][4], bf[4][4];
#pragma unroll
    for (int u = 0; u < 4; ++u) if (u < nst) {
#pragma unroll
        for (int m = 0; m < 4; ++m) { af[u][m] = *(const GAS bf16x8*)(ap + (size_t)(16 * m) * lda + 256 * u); bf[u][m] = *(const GAS bf16x8*)(bp + (size_t)(16 * m) * K + 256 * u); } }
    for (int i = 0; i < nst; i += 4) {
#pragma unroll
        for (int u = 0; u < 4; ++u) if (i + u < nst) {
#pragma unroll
            for (int m = 0; m < 4; ++m)
#pragma unroll
                for (int n = 0; n < 4; ++n) acc[m][n] = __builtin_amdgcn_mfma_f32_16x16x32_bf16(bf[u][n], af[u][m], acc[m][n], 0, 0, 0);
            if (i + u + 4 < nst) {
#pragma unroll
                for (int m = 0; m < 4; ++m) { af[u][m] = *(const GAS bf16x8*)(ap + (size_t)(16 * m) * lda + 256 * (i + u + 4)); bf[u][m] = *(const GAS bf16x8*)(bp + (size_t)(16 * m) * K + 256 * (i + u + 4)); } }
        }
    }
    LAS f32x4* const slab = (LAS f32x4*)(lds + wid * 16384);
#pragma unroll
    for (int m = 0; m < 4; ++m)
#pragma unroll
        for (int n = 0; n < 4; ++n) slab[(16 * m + ql) * 16 + ((4 * n + gq) ^ ql)] = acc[m][n];
    __syncthreads();
    const int rr = 8 * wid + (lane >> 3), ch0 = 2 * (lane & 7);
    v0 = (f32x4){0.f, 0.f, 0.f, 0.f}; v1 = v0;
#pragma unroll
    for (int s8 = 0; s8 < 8; ++s8) { const LAS f32x4* sl = (const LAS f32x4*)(lds + s8 * 16384) + rr * 16; v0 += sl[ch0 ^ (rr & 15)]; v1 += sl[(ch0 + 1) ^ (rr & 15)]; }
    __syncthreads();
}
__device__ __forceinline__ void gemm_small(LAS unsigned char* lds, const Gemm g, const Epi& E, int row_base, int nrows, int G, int c) {
    const int tid = threadIdx.x, wid = __builtin_amdgcn_readfirstlane(tid >> 6), lane = tid & 63;
    const int ntn = g.N / 64, ntiles = (nrows / 64) * ntn;
    for (int v = c; v < ntiles; v += G) {
        const int r0 = row_base + 64 * (v / ntn), c0 = 64 * (v % ntn);
        f32x4 v0, v1; small_tile_sum(lds, g.A, g.lda, g.Bt, g.K, r0, c0, v0, v1);
        epi_seg(E, r0 + 8 * wid + (lane >> 3), c0 + 8 * (lane & 7), v0, v1, lane);
    }
}
struct Gemm2 { const bf16_t* A1; const bf16_t* B1; const bf16_t* A2; const bf16_t* B2; int K1, lda1, K2, lda2, N; };
__device__ __forceinline__ void gemm_small2(LAS unsigned char* lds, const Gemm2 g, const bf16_t* gates, bf16_t* out, int row_base, int nrows, int G, int c) {
    const int tid = threadIdx.x, wid = __builtin_amdgcn_readfirstlane(tid >> 6), lane = tid & 63;
    const int ntn = g.N / 64, ntiles = (nrows / 64) * ntn;
    for (int v = c; v < ntiles; v += G) {
        const int r0 = row_base + 64 * (v / ntn), c0 = 64 * (v % ntn), row = r0 + 8 * wid + (lane >> 3), col = c0 + 8 * (lane & 7);
        f32x4 a0, a1, b0, b1;
        small_tile_sum(lds, g.A1, g.lda1, g.B1, g.K1, r0, c0, a0, a1);
        small_tile_sum(lds, g.A2, g.lda2, g.B2, g.K2, r0, c0, b0, b1);
        f32x4 g00, g01, g10, g11; unpack8(*(const GAS u32x4*)(gates + (size_t)row * (2 * DM) + col), g00, g01); unpack8(*(const GAS u32x4*)(gates + (size_t)row * (2 * DM) + DM + col), g10, g11);
        *(GAS u32x4*)(out + (size_t)row * DM + col) = pack8(g00 * a0 + g10 * b0, g01 * a1 + g11 * b1);
    }
}

__device__ __forceinline__ void gemm_phase(LAS unsigned char* lds, const Gemm g, const StaticOrder& S, const Epi& E) {
    const int tid = threadIdx.x, wid = __builtin_amdgcn_readfirstlane(tid >> 6), lane = tid & 63, wr = wid >> 2, wc = wid & 3, fr = lane & 15, fq = lane >> 4;
    const int K = g.K, nt = K / BK;
    unsigned voffA[2], voffB[2];
#pragma unroll
    for (int i = 0; i < 2; ++i) { int R, C; stage_rc(tid * 16 + i * 8192, R, C); const int Rb = (R & ~31) + perm32(R & 31);
        voffA[i] = (unsigned)(R * g.lda + C) * 2u; voffB[i] = (unsigned)(Rb * K + C) * 2u; }
    const size_t kstep = (size_t)(BK * 2);
    const size_t hstep = (size_t)HALF * K * 2, hstepA = (size_t)HALF * g.lda * 2;
    const size_t tstep = 2 * hstep, tstepA = 2 * hstepA, pnstepA = (size_t)g.a_pn_step * 2;
    const unsigned ldsw = (unsigned)wid * 1024u;
    const int aoff = lds_byte(wr * 64 + fr, fq * 8), boff = lds_byte(wc * 32 + fr, fq * 8);
#define PG8_SA(b, h) (((b) * 2 + (h)) * HTB)
#define PG8_SB(b, h) ((4 + (b) * 2 + (h)) * HTB)
#define PG8_STAGE(bufoff, gbase, voff) do { _Pragma("unroll") for (int _i = 0; _i < 2; ++_i) \
        __builtin_amdgcn_global_load_lds((const unsigned*)((const char*)(gbase) + (voff)[_i]), (LAS unsigned*)(lds + (bufoff) + ldsw + _i * 8192), 16, 0, 0); } while (0)
#define PG8_LDA(dst, b, h) do { _Pragma("unroll") for (int m = 0; m < 4; ++m) _Pragma("unroll") for (int k = 0; k < 2; ++k) dst[m][k] = *(const LAS bf16x8*)(lds + PG8_SA(b, h) + aoff + m * 2048 + k * 1024); } while (0)
#define PG8_LDB(dst, b, h) do { _Pragma("unroll") for (int n = 0; n < 2; ++n) _Pragma("unroll") for (int k = 0; k < 2; ++k) dst[n][k] = *(const LAS bf16x8*)(lds + PG8_SB(b, h) + boff + n * 2048 + k * 1024); } while (0)
#define PG8_MMA(ai, bj, At, Bt) do { __builtin_amdgcn_s_setprio(1); _Pragma("unroll") for (int m = 0; m < 4; ++m) _Pragma("unroll") for (int n = 0; n < 2; ++n) _Pragma("unroll") for (int k = 0; k < 2; ++k) \
        acc[ai][bj][m][n] = __builtin_amdgcn_mfma_f32_16x16x32_bf16(Bt[n][k], At[m][k], acc[ai][bj][m][n], 0, 0, 0); __builtin_amdgcn_s_setprio(0); } while (0)
#define PG8_WAIT_V(n) asm volatile("s_waitcnt vmcnt(" #n ")" ::: "memory")
#define PG8_WAIT_L(n) asm volatile("s_waitcnt lgkmcnt(" #n ")" ::: "memory")
#define PG8_BAR __builtin_amdgcn_s_barrier()
#define PG8_SCHED __builtin_amdgcn_sched_barrier(0)
    Unit cur, nxt; int ui = 0;
    if (!S.next(0, cur)) return;
    f32x4 acc[2][2][4][2];
#pragma unroll
    for (int a = 0; a < 2; ++a)
#pragma unroll
        for (int b = 0; b < 2; ++b)
#pragma unroll
            for (int m = 0; m < 4; ++m)
#pragma unroll
                for (int n = 0; n < 2; ++n) acc[a][b][m][n] = (f32x4){0.f, 0.f, 0.f, 0.f};
    bf16x8 At[4][2], B0[2][2], B1[2][2];
    const char* cA = (const char*)g.A + (size_t)cur.pm * tstepA + (size_t)cur.pn * pnstepA; const char* cB = (const char*)g.Bt + (size_t)cur.pn * tstep;
    PG8_STAGE(PG8_SB(0, 0), cB, voffB); PG8_STAGE(PG8_SB(0, 1), cB + hstep, voffB); PG8_STAGE(PG8_SA(0, 0), cA, voffA); PG8_STAGE(PG8_SA(0, 1), cA + hstepA, voffA);
    if (wr == 1) PG8_BAR;
    PG8_WAIT_V(2); PG8_BAR;
    PG8_STAGE(PG8_SB(1, 0), cB + kstep, voffB); PG8_STAGE(PG8_SA(1, 0), cA + kstep, voffA); PG8_STAGE(PG8_SB(1, 1), cB + hstep + kstep, voffB);
    PG8_WAIT_V(6); PG8_BAR;
    for (;;) {
        const bool has_next = S.next(ui + 1, nxt);
        const char* nA = has_next ? (const char*)g.A + (size_t)nxt.pm * tstepA + (size_t)nxt.pn * pnstepA : cA; const char* nB = has_next ? (const char*)g.Bt + (size_t)nxt.pn * tstep : cB;
        for (int t = 0; t < nt; t += 2) {
            const bool last = (t == nt - 2);
            const char* a1 = cA + (size_t)(t + 1) * kstep;
            const char* a2 = last ? nA : cA + (size_t)(t + 2) * kstep; const char* b2 = last ? nB : cB + (size_t)(t + 2) * kstep;
            const char* a3 = a2 + kstep; const char* b3 = b2 + kstep;
            PG8_LDB(B0, 0, 0); PG8_LDB(B1, 0, 1); PG8_SCHED; PG8_LDA(At, 0, 0); PG8_STAGE(PG8_SA(1, 1), a1 + hstepA, voffA);
            PG8_WAIT_V(8); PG8_WAIT_L(0); PG8_BAR; PG8_MMA(0, 0, At, B0); PG8_MMA(0, 1, At, B1); PG8_BAR; PG8_SCHED;
            PG8_LDA(At, 0, 1); PG8_STAGE(PG8_SB(0, 0), b2, voffB); PG8_STAGE(PG8_SB(0, 1), b2 + hstep, voffB); PG8_STAGE(PG8_SA(0, 0), a2, voffA);
            PG8_WAIT_V(8); PG8_WAIT_L(0); PG8_BAR; PG8_MMA(1, 0, At, B0); PG8_MMA(1, 1, At, B1); PG8_BAR; PG8_SCHED;
            PG8_LDB(B0, 1, 0); PG8_LDB(B1, 1, 1); PG8_SCHED; PG8_LDA(At, 1, 0); PG8_STAGE(PG8_SA(0, 1), a2 + hstepA, voffA);
            PG8_WAIT_V(8); PG8_WAIT_L(0); PG8_BAR; PG8_MMA(0, 0, At, B0); PG8_MMA(0, 1, At, B1); PG8_BAR; PG8_SCHED;
            PG8_LDA(At, 1, 1); PG8_STAGE(PG8_SB(1, 0), b3, voffB); PG8_STAGE(PG8_SB(1, 1), b3 + hstep, voffB); PG8_STAGE(PG8_SA(1, 0), a3, voffA);
            PG8_WAIT_V(8); PG8_WAIT_L(0); PG8_BAR; PG8_MMA(1, 0, At, B0); PG8_MMA(1, 1, At, B1); PG8_BAR; PG8_SCHED;
        }
        if (wr == 0) PG8_BAR;
        epilogue(E, acc, cur, wr, wc, fr, fq);
        if (!has_next) break;
#pragma unroll
        for (int a = 0; a < 2; ++a)
#pragma unroll
            for (int b = 0; b < 2; ++b)
#pragma unroll
                for (int m = 0; m < 4; ++m)
#pragma unroll
                    for (int n = 0; n < 2; ++n) acc[a][b][m][n] = (f32x4){0.f, 0.f, 0.f, 0.f};
        cur = nxt; cA = nA; cB = nB; ++ui;
        if (wr == 1) PG8_BAR;
    }
    PG8_WAIT_V(0);
    PG8_BAR;
#undef PG8_SA
#undef PG8_SB
#undef PG8_STAGE
#undef PG8_LDA
#undef PG8_LDB
#undef PG8_MMA
#undef PG8_WAIT_V
#undef PG8_WAIT_L
#undef PG8_BAR
#undef PG8_SCHED
}

__device__ __forceinline__ void gemm_phase2(LAS unsigned char* lds, const Gemm2 g, const StaticOrder& S, const bf16_t* gates, bf16_t* out) {
    const int tid = threadIdx.x, wid = __builtin_amdgcn_readfirstlane(tid >> 6), lane = tid & 63, wr = wid >> 2, wc = wid & 3, fr = lane & 15, fq = lane >> 4;
    const int nt1 = g.K1 / BK, nt = nt1 + g.K2 / BK;
    int sR[2], sRb[2], sC[2];
#pragma unroll
    for (int i = 0; i < 2; ++i) { int R, C; stage_rc(tid * 16 + i * 8192, R, C); sR[i] = R; sRb[i] = (R & ~31) + perm32(R & 31); sC[i] = C; }
    const size_t kstep = (size_t)(BK * 2);
    const size_t hB1 = (size_t)HALF * g.K1 * 2, hA1 = (size_t)HALF * g.lda1 * 2, hB2 = (size_t)HALF * g.K2 * 2, hA2 = (size_t)HALF * g.lda2 * 2;
    const unsigned ldsw = (unsigned)wid * 1024u;
    const int aoff = lds_byte(wr * 64 + fr, fq * 8), boff = lds_byte(wc * 32 + fr, fq * 8);
#define PG8_SA(b, h) (((b) * 2 + (h)) * HTB)
#define PG8_SB(b, h) ((4 + (b) * 2 + (h)) * HTB)
#define PG8_STAGE_T(bufoff, isA, h, T) do { const int T_ = (T); const bool nx_ = T_ >= nt; const int Tl_ = nx_ ? T_ - nt : T_; const bool s2_ = !nx_ && Tl_ >= nt1; \
        const char* base_ = (isA) ? (s2_ ? cA2 + (size_t)(Tl_ - nt1) * kstep + (h) * hA2 : (nx_ ? nA1 : cA1) + (size_t)Tl_ * kstep + (h) * hA1) \
                                  : (s2_ ? cB2 + (size_t)(Tl_ - nt1) * kstep + (h) * hB2 : (nx_ ? nB1 : cB1) + (size_t)Tl_ * kstep + (h) * hB1); \
        const int ld_ = (isA) ? (s2_ ? g.lda2 : g.lda1) : (s2_ ? g.K2 : g.K1); \
        _Pragma("unroll") for (int _i = 0; _i < 2; ++_i) { const unsigned vo_ = (unsigned)(((isA) ? sR[_i] : sRb[_i]) * ld_ + sC[_i]) * 2u; \
            __builtin_amdgcn_global_load_lds((const unsigned*)(base_ + vo_), (LAS unsigned*)(lds + (bufoff) + ldsw + _i * 8192), 16, 0, 0); } } while (0)
#define PG8_LDA(dst, b, h) do { _Pragma("unroll") for (int m = 0; m < 4; ++m) _Pragma("unroll") for (int k = 0; k < 2; ++k) dst[m][k] = *(const LAS bf16x8*)(lds + PG8_SA(b, h) + aoff + m * 2048 + k * 1024); } while (0)
#define PG8_LDB(dst, b, h) do { _Pragma("unroll") for (int n = 0; n < 2; ++n) _Pragma("unroll") for (int k = 0; k < 2; ++k) dst[n][k] = *(const LAS bf16x8*)(lds + PG8_SB(b, h) + boff + n * 2048 + k * 1024); } while (0)
#define PG8_MMA(ai, bj, At, Bt) do { __builtin_amdgcn_s_setprio(1); _Pragma("unroll") for (int m = 0; m < 4; ++m) _Pragma("unroll") for (int n = 0; n < 2; ++n) _Pragma("unroll") for (int k = 0; k < 2; ++k) \
        acc[ai][bj][m][n] = __builtin_amdgcn_mfma_f32_16x16x32_bf16(Bt[n][k], At[m][k], acc[ai][bj][m][n], 0, 0, 0); __builtin_amdgcn_s_setprio(0); } while (0)
#define PG8_WAIT_V(n) asm volatile("s_waitcnt vmcnt(" #n ")" ::: "memory")
#define PG8_WAIT_L(n) asm volatile("s_waitcnt lgkmcnt(" #n ")" ::: "memory")
#define PG8_BAR __builtin_amdgcn_s_barrier()
#define PG8_SCHED __builtin_amdgcn_sched_barrier(0)
    Unit cur, nxt; int ui = 0;
    if (!S.next(0, cur)) return;
    f32x4 acc[2][2][4][2];
#pragma unroll
    for (int a = 0; a < 2; ++a)
#pragma unroll
        for (int b = 0; b < 2; ++b)
#pragma unroll
            for (int m = 0; m < 4; ++m)
#pragma unroll
                for (int n = 0; n < 2; ++n) acc[a][b][m][n] = (f32x4){0.f, 0.f, 0.f, 0.f};
    bf16x8 At[4][2], B0[2][2], B1[2][2];
    const char* cA1 = (const char*)g.A1 + (size_t)cur.pm * 2 * hA1; const char* cB1 = (const char*)g.B1 + (size_t)cur.pn * 2 * hB1;
    const char* cA2 = (const char*)g.A2 + (size_t)cur.pm * 2 * hA2; const char* cB2 = (const char*)g.B2 + (size_t)cur.pn * 2 * hB2;
    const char* nA1 = cA1; const char* nB1 = cB1;
    PG8_STAGE_T(PG8_SB(0, 0), false, 0, 0); PG8_STAGE_T(PG8_SB(0, 1), false, 1, 0); PG8_STAGE_T(PG8_SA(0, 0), true, 0, 0); PG8_STAGE_T(PG8_SA(0, 1), true, 1, 0);
    if (wr == 1) PG8_BAR;
    PG8_WAIT_V(2); PG8_BAR;
    PG8_STAGE_T(PG8_SB(1, 0), false, 0, 1); PG8_STAGE_T(PG8_SA(1, 0), true, 0, 1); PG8_STAGE_T(PG8_SB(1, 1), false, 1, 1);
    PG8_WAIT_V(6); PG8_BAR;
    for (;;) {
        const bool has_next = S.next(ui + 1, nxt);
        nA1 = has_next ? (const char*)g.A1 + (size_t)nxt.pm * 2 * hA1 : cA1; nB1 = has_next ? (const char*)g.B1 + (size_t)nxt.pn * 2 * hB1 : cB1;
        const int rowb = cur.pm * BM + wr * 64 + fr, colb = cur.pn * BM + wc * 32 + 8 * fq;
        for (int t = 0; t < nt; t += 2) {
            if (t == nt1) {
#pragma unroll
                for (int ai = 0; ai < 2; ++ai)
#pragma unroll
                    for (int m = 0; m < 4; ++m) { const bf16_t* gp = gates + (size_t)(rowb + ai * HALF + m * 16) * (2 * DM) + colb;
#pragma unroll
                        for (int bj = 0; bj < 2; ++bj) { f32x4 g00, g01, g10, g11; unpack8(*(const GAS u32x4*)(gp + bj * HALF), g00, g01); unpack8(*(const GAS u32x4*)(gp + DM + bj * HALF), g10, g11);
#pragma unroll
                            for (int j = 0; j < 4; ++j) { acc[ai][bj][m][0][j] *= g00[j] * __builtin_amdgcn_rcpf(fmaxf(g10[j], 1e-6f)); acc[ai][bj][m][1][j] *= g01[j] * __builtin_amdgcn_rcpf(fmaxf(g11[j], 1e-6f)); } } }
            }
            PG8_LDB(B0, 0, 0); PG8_LDB(B1, 0, 1); PG8_SCHED; PG8_LDA(At, 0, 0); PG8_STAGE_T(PG8_SA(1, 1), true, 1, t + 1);
            PG8_WAIT_V(8); PG8_WAIT_L(0); PG8_BAR; PG8_MMA(0, 0, At, B0); PG8_MMA(0, 1, At, B1); PG8_BAR; PG8_SCHED;
            PG8_LDA(At, 0, 1); PG8_STAGE_T(PG8_SB(0, 0), false, 0, t + 2); PG8_STAGE_T(PG8_SB(0, 1), false, 1, t + 2); PG8_STAGE_T(PG8_SA(0, 0), true, 0, t + 2);
            PG8_WAIT_V(8); PG8_WAIT_L(0); PG8_BAR; PG8_MMA(1, 0, At, B0); PG8_MMA(1, 1, At, B1); PG8_BAR; PG8_SCHED;
            PG8_LDB(B0, 1, 0); PG8_LDB(B1, 1, 1); PG8_SCHED; PG8_LDA(At, 1, 0); PG8_STAGE_T(PG8_SA(0, 1), true, 1, t + 2);
            PG8_WAIT_V(8); PG8_WAIT_L(0); PG8_BAR; PG8_MMA(0, 0, At, B0); PG8_MMA(0, 1, At, B1); PG8_BAR; PG8_SCHED;
            PG8_LDA(At, 1, 1); PG8_STAGE_T(PG8_SB(1, 0), false, 0, t + 3); PG8_STAGE_T(PG8_SB(1, 1), false, 1, t + 3); PG8_STAGE_T(PG8_SA(1, 0), true, 0, t + 3);
            PG8_WAIT_V(8); PG8_WAIT_L(0); PG8_BAR; PG8_MMA(1, 0, At, B0); PG8_MMA(1, 1, At, B1); PG8_BAR; PG8_SCHED;
        }
        if (wr == 0) PG8_BAR;
#pragma unroll
        for (int ai = 0; ai < 2; ++ai)
#pragma unroll
            for (int m = 0; m < 4; ++m) { const size_t row = (size_t)(rowb + ai * HALF + m * 16);
#pragma unroll
                for (int bj = 0; bj < 2; ++bj) { f32x4 g10, g11; unpack8(*(const GAS u32x4*)(gates + row * (2 * DM) + DM + colb + bj * HALF), g10, g11);
#pragma unroll
                    for (int j = 0; j < 4; ++j) { g10[j] = fmaxf(g10[j], 1e-6f); g11[j] = fmaxf(g11[j], 1e-6f); }
                    *(GAS u32x4*)(out + row * DM + colb + bj * HALF) = pack8(acc[ai][bj][m][0] * g10, acc[ai][bj][m][1] * g11); } }
        if (!has_next) break;
#pragma unroll
        for (int a = 0; a < 2; ++a)
#pragma unroll
            for (int b = 0; b < 2; ++b)
#pragma unroll
                for (int m = 0; m < 4; ++m)
#pragma unroll
                    for (int n = 0; n < 2; ++n) acc[a][b][m][n] = (f32x4){0.f, 0.f, 0.f, 0.f};
        cur = nxt; cA1 = nA1; cB1 = nB1; cA2 = (const char*)g.A2 + (size_t)cur.pm * 2 * hA2; cB2 = (const char*)g.B2 + (size_t)cur.pn * 2 * hB2; ++ui;
        if (wr == 1) PG8_BAR;
    }
    PG8_WAIT_V(0);
    PG8_BAR;
#undef PG8_SA
#undef PG8_SB
#undef PG8_STAGE_T
#undef PG8_LDA
#undef PG8_LDB
#undef PG8_MMA
#undef PG8_WAIT_V
#undef PG8_WAIT_L
#undef PG8_BAR
#undef PG8_SCHED
}
}

#define XB_TMO      128
#define XB_XCNT(j)  (256  + 64 * (j))
#define XB_XSUB(j)  (1280 + 64 * (j))
#define XB_XGEN(j)  (2304 + 64 * (j))
#define XB_TOP      3328
#define XB_TOPGEN   3392
#define XCD_BAR_WORDS 3456
#define XB_SPIN_CAP (1u << 18)
__device__ __forceinline__ unsigned xb_ld(unsigned* p)              { return __hip_atomic_load(p, __ATOMIC_RELAXED, __HIP_MEMORY_SCOPE_AGENT); }
__device__ __forceinline__ unsigned xb_add(unsigned* p, unsigned v) { return __hip_atomic_fetch_add(p, v, __ATOMIC_RELAXED, __HIP_MEMORY_SCOPE_AGENT); }
__device__ __forceinline__ unsigned xb_xcc_id() { return (unsigned)__builtin_amdgcn_s_getreg((3 << 11) | 20) & 0xFu; }
#define XB_SPIN(cond, bar) do { unsigned _sp = 0; while (cond) { __builtin_amdgcn_s_sleep(1); \
    if ((++_sp & 255u) == 0u) { if (xb_ld(&(bar)[XB_TMO])) break; if (_sp > XB_SPIN_CAP) { atomicAdd(&(bar)[XB_TMO], 1u); break; } } } } while (0)
struct XcdBarrier { unsigned* bar; unsigned x; volatile LAS unsigned* st; };
__device__ __forceinline__ XcdBarrier xcd_barrier_post(unsigned* bar, volatile LAS unsigned* st) {
    XcdBarrier b; b.bar = bar; b.x = xb_xcc_id(); b.st = st;
    if (threadIdx.x == 0) (void)xb_add(&bar[XB_XCNT(b.x)], 1u);
    return b;
}
__device__ __forceinline__ void xcd_barrier_complete(unsigned* bar, unsigned x, unsigned& nloc, unsigned& nx) {
    const unsigned G = gridDim.x * gridDim.y * gridDim.z;
    unsigned sum, cnt, mine, sp = 0u;
    for (;;) {
        sum = 0u; cnt = 0u; mine = 0u;
#pragma unroll
        for (unsigned j = 0; j < 16; ++j) { const unsigned c = xb_ld(&bar[XB_XCNT(j)]); sum += c; cnt += (c > 0u) ? 1u : 0u; mine = (j == x) ? c : mine; }
        if (sum == G) break;
        __builtin_amdgcn_s_sleep(1);
        if ((++sp & 255u) == 0u) { if (xb_ld(&bar[XB_TMO])) break; if (sp > XB_SPIN_CAP) { atomicAdd(&bar[XB_TMO], 1u); break; } }
    }
    nloc = mine > 0u ? mine : 1u; nx = cnt > 0u ? cnt : 1u;
}
__device__ __forceinline__ void xcd_barrier(const XcdBarrier& b) {
    asm volatile("s_waitcnt vmcnt(0)" ::: "memory");
    __syncthreads();
    if (threadIdx.x == 0) {
        unsigned* bar = b.bar;
        __builtin_amdgcn_s_waitcnt(0);
        unsigned nloc = b.st[0], nx = b.st[1];
        if (nloc == 0u) { xcd_barrier_complete(bar, b.x, nloc, nx); b.st[0] = nloc; b.st[1] = nx; }
        const unsigned old = xb_add(&bar[XB_XSUB(b.x)], 1u);
        const unsigned gen = old / nloc;
        if (old + 1u == (gen + 1u) * nloc) {
            __builtin_amdgcn_fence(__ATOMIC_RELEASE, "agent");
            asm volatile("s_waitcnt vmcnt(0)" ::: "memory");
            const unsigned og = xb_add(&bar[XB_TOP], 1u);
            const unsigned tg = og / nx;
            if (og + 1u == (tg + 1u) * nx) xb_add(&bar[XB_TOPGEN], 1u);
            else XB_SPIN(xb_ld(&bar[XB_TOPGEN]) == tg, bar);
            __builtin_amdgcn_fence(__ATOMIC_ACQUIRE, "agent");
            xb_add(&bar[XB_XGEN(b.x)], 1u);
            asm volatile("s_waitcnt vmcnt(0)" ::: "memory");
        } else {
            XB_SPIN(xb_ld(&bar[XB_XGEN(b.x)]) == gen, bar);
            __builtin_amdgcn_fence(__ATOMIC_ACQUIRE, "agent");
            asm volatile("s_waitcnt vmcnt(0)" ::: "memory");
        }
    }
    __syncthreads();
}

__device__ __forceinline__ void p0_transpose_item(const float* W, int K, int N, const float* gain, bf16_t* WT, int k0, int n0, int drow0, LAS float* scr, int lane) {
#pragma unroll
    for (int i = 0; i < 8; ++i) { const int kk = 8 * i + (lane >> 3), nn = 4 * (lane & 7);
        f32x4 v = *(const GAS f32x4*)(W + (size_t)(k0 + kk) * N + n0 + nn);
        if (gain) v = v * *(const GAS float*)(gain + k0 + kk);
        scr[kk * 33 + nn] = v.x; scr[kk * 33 + nn + 1] = v.y; scr[kk * 33 + nn + 2] = v.z; scr[kk * 33 + nn + 3] = v.w; }
    LDS_WAIT(); asm volatile("" ::: "memory");
    const int c = lane & 7;
#pragma unroll
    for (int j = 0; j < 4; ++j) { const int n = (lane >> 3) + 8 * j; const LAS float* s = scr + (8 * c) * 33 + n;
        u32x4 o; o.x = pk2(s[0 * 33], s[1 * 33]); o.y = pk2(s[2 * 33], s[3 * 33]); o.z = pk2(s[4 * 33], s[5 * 33]); o.w = pk2(s[6 * 33], s[7 * 33]);
        *(GAS u32x4*)(WT + (size_t)(drow0 + n) * K + k0 + 8 * c) = o; }
    LDS_WAIT(); asm volatile("" ::: "memory");
}
__device__ __forceinline__ int map_gu(int n0) { return n0 < DFF ? (n0 / 128) * 256 + (n0 % 128) : ((n0 - DFF) / 128) * 256 + 128 + ((n0 - DFF) % 128); }
__device__ __forceinline__ int map_win(int n0) { return n0 < 6144 ? n0 : (n0 < 6176 ? 9216 + (n0 - 6144) : n0 - 32); }

__device__ __forceinline__ void p0_prologue(Frame& F) {
    LAS float* scr = (LAS float*)(F.lds + F.wave * 16384);
    const int gw = F.vcu * NWAVES + F.wave, NGW = F.G * NWAVES, lane = F.lane;
    bf16_t* const wgu1 = (bf16_t*)(F.ws + WS_WGU1); bf16_t* const wd1 = (bf16_t*)(F.ws + WS_WD1); bf16_t* const win = (bf16_t*)(F.ws + WS_WIN);
    bf16_t* const wsso = (bf16_t*)(F.ws + WS_WSSO); bf16_t* const wo = (bf16_t*)(F.ws + WS_WO); bf16_t* const wgu2 = (bf16_t*)(F.ws + WS_WGU2);
    bf16_t* const wd2 = (bf16_t*)(F.ws + WS_WD2); bf16_t* const wpg = (bf16_t*)(F.ws + WS_WPG); bf16_t* const wple = (bf16_t*)(F.ws + WS_WPLE);
    constexpr int I_GU = (DM / 64) * (2 * DFF / 32), I_D = (DFF / 64) * (DM / 32), I_IN = (DM / 64) * (IN_DIM / 32), I_SSO = (DI / 64) * (DM / 32), I_SQ = (DM / 64) * (DM / 32), I_PLE = (PLE / 64) * (DM / 32);
    constexpr int NITEMS = 2 * I_GU + 2 * I_D + I_IN + I_SSO + 3 * I_SQ + I_PLE;
    bf16_t* const wpot = (bf16_t*)(F.ws + WS_WPOT);
    for (int it = gw; it < NITEMS; it += NGW) {
        int r = it;
        if (r < I_GU) { const int nb = 2 * DFF / 32, kb = r / nb, n0 = (r % nb) * 32; p0_transpose_item(F.in[I_WGU1], DM, 2 * DFF, F.in[I_NFFN1], wgu1, kb * 64, n0, map_gu(n0), scr, lane); continue; } r -= I_GU;
        if (r < I_GU) { const int nb = 2 * DFF / 32, kb = r / nb, n0 = (r % nb) * 32; p0_transpose_item(F.in[I_WGU2], DM, 2 * DFF, F.in[I_NFFN2], wgu2, kb * 64, n0, map_gu(n0), scr, lane); continue; } r -= I_GU;
        if (r < I_D) { const int nb = DM / 32, kb = r / nb, n0 = (r % nb) * 32; p0_transpose_item(F.in[I_WD1], DFF, DM, nullptr, wd1, kb * 64, n0, n0, scr, lane); continue; } r -= I_D;
        if (r < I_D) { const int nb = DM / 32, kb = r / nb, n0 = (r % nb) * 32; p0_transpose_item(F.in[I_WD2], DFF, DM, nullptr, wd2, kb * 64, n0, n0, scr, lane); continue; } r -= I_D;
        if (r < I_IN) { const int nb = IN_DIM / 32, kb = r / nb, n0 = (r % nb) * 32; p0_transpose_item(F.in[I_WIN], DM, IN_DIM, F.in[I_NMIX], win, kb * 64, n0, map_win(n0), scr, lane); continue; } r -= I_IN;
        if (r < I_SSO) { const int nb = DM / 32, kb = r / nb, n0 = (r % nb) * 32; p0_transpose_item(F.in[I_WSSO], DI, DM, F.in[I_NSSD], wsso, kb * 64, n0, n0, scr, lane); continue; } r -= I_SSO;
        if (r < I_SQ) { const int nb = DM / 32, kb = r / nb, n0 = (r % nb) * 32; p0_transpose_item(F.in[I_WO], DM, DM, nullptr, wo, kb * 64, n0, n0, scr, lane); continue; } r -= I_SQ;
        if (r < I_SQ) { const int nb = DM / 32, kb = r / nb, n0 = (r % nb) * 32; p0_transpose_item(F.in[I_WPG], DM, DM, F.in[I_NPLE], wpg, kb * 64, n0, n0, scr, lane); continue; } r -= I_SQ;
        if (r < I_SQ) { const int nb = DM / 32, kb = r / nb, n0 = (r % nb) * 32; p0_transpose_item(F.in[I_WPOUT], PD, DM, F.in[I_PSCALE], wpot, kb * 64, n0, n0, scr, lane); continue; } r -= I_SQ;
        { const int nb = DM / 32, kb = r / nb, n0 = (r % nb) * 32; p0_transpose_item(F.in[I_WPLE], PLE, DM, nullptr, wple, kb * 64, n0, n0, scr, lane); }
    }
    {
        bf16_t* const wgrp = (bf16_t*)(F.ws + WS_WGRP); const float* Wg = F.in[I_WPGRP];
        for (int e = F.vcu * NTHREADS + F.tid; e < 4 * 256 * 256 / 8; e += F.G * NTHREADS) {
            const f32x4 a = *(const GAS f32x4*)(Wg + (size_t)e * 8), b = *(const GAS f32x4*)(Wg + (size_t)e * 8 + 4);
            u32x4 o; o.x = pk2(a.x, a.y); o.y = pk2(a.z, a.w); o.z = pk2(b.x, b.y); o.w = pk2(b.z, b.w);
            *(GAS u32x4*)(wgrp + (size_t)e * 8) = o; }
    }
    {
        bf16_t* const XB = (bf16_t*)(F.ws + WS_XB); bf16_t* const PB = (bf16_t*)(F.ws + WS_PB); float* const stA = (float*)(F.ws + WS_STATS_A);
        for (int m = gw; m < M; m += NGW) {
            const float* xrow = (m < MP) ? F.in[I_XP] + (size_t)m * DM : F.in[I_XS] + (size_t)(m - MP) * DM;
            const GAS f32x4* xr = (const GAS f32x4*)xrow + lane;
            f32x4 v[4]; float s = 0.f;
#pragma unroll
            for (int j = 0; j < 4; ++j) { v[j] = xr[64 * j]; s += (v[j].x * v[j].x + v[j].y * v[j].y) + (v[j].z * v[j].z + v[j].w * v[j].w); }
            s = wave_sum(s);
            GAS u32x2* o8 = (GAS u32x2*)(XB + (size_t)m * DM) + lane;
#pragma unroll
            for (int j = 0; j < 4; ++j) { u32x2 w; w.x = pk2(v[j].x, v[j].y); w.y = pk2(v[j].z, v[j].w); o8[64 * j] = w; }
            if (lane < 16) *(GAS float*)(stA + (size_t)m * 16 + lane) = (lane == 0) ? s : 0.f;
            const float* prow = (m < MP) ? F.in[I_PP] + (size_t)m * PLE : F.in[I_PS] + (size_t)(m - MP) * PLE;
            const f32x4 pv = *((const GAS f32x4*)prow + lane);
            u32x2 w; w.x = pk2(pv.x, pv.y); w.y = pk2(pv.z, pv.w); *((GAS u32x2*)(PB + (size_t)m * PLE) + lane) = w;
        }
    }
}


typedef short v4i16_t __attribute__((ext_vector_type(4)));
constexpr int IMG_B = 0, IMG_C = 32768, IMG_X = 65536, TAB_ACS = RING_BYTES + 1024, TAB_DT = TAB_ACS + 2048, TAB_SD = TAB_DT + 2048;
constexpr int NCHUNK = SEQ / 128;
template <bool XS> __device__ __forceinline__ int img_off(int row, int ch) { return XS ? 256 * row + 16 * (ch ^ ((row & 7) << 1)) : 256 * row + 16 * (ch ^ (((row & 3) << 2) | ((row >> 2) & 3))); }
__device__ __forceinline__ bf16x8 tr_pair(const LAS unsigned char* p0, const LAS unsigned char* p1) {
    const v4i16_t a = __builtin_amdgcn_ds_read_tr16_b64_v4i16((LAS v4i16_t*)p0), b = __builtin_amdgcn_ds_read_tr16_b64_v4i16((LAS v4i16_t*)p1);
    return (bf16x8){a[0], a[1], a[2], a[3], b[0], b[1], b[2], b[3]};
}
__device__ __forceinline__ void ssd_tables_load(Frame& F, size_t row0, int g, float& d0, float& d1) {
    if (F.wave < 4) { const float* const DT = (const float*)(F.ws + WS_DT); const int head = g * HPG + F.wave;
        d0 = *(const GAS float*)(DT + (row0 + 2 * F.lane) * 32 + head); d1 = *(const GAS float*)(DT + (row0 + 2 * F.lane + 1) * 32 + head); }
}
__device__ __forceinline__ void ssd_tables_compute(Frame& F, int g, float d0, float d1) {
    LAS float* const acs = (LAS float*)(F.lds + TAB_ACS); LAS float* const dtl = (LAS float*)(F.lds + TAB_DT); LAS float* const sdec = (LAS float*)(F.lds + TAB_SD);
    if (F.wave < 4) {
        const int r = F.wave, lane = F.lane, head = g * HPG + r;
        const float Ah = -__expf(*(const GAS float*)(F.in[I_ALOG] + head));
        const float a0 = d0 * Ah, a1 = d1 * Ah, loc = a0 + a1;
        float inc = loc;
#pragma unroll
        for (int o = 1; o < 64; o <<= 1) { const float t = __shfl_up(inc, o); if (lane >= o) inc += t; }
        const float exc = inc - loc;
        acs[(2 * lane) * 4 + r] = exc + a0; acs[(2 * lane + 1) * 4 + r] = inc;
        dtl[(2 * lane) * 4 + r] = d0; dtl[(2 * lane + 1) * 4 + r] = d1;
    }
    __syncthreads();
    { const int s = F.tid >> 2, r = F.tid & 3; sdec[s * 4 + r] = __expf(acs[127 * 4 + r] - acs[s * 4 + r]) * dtl[s * 4 + r]; }
    __syncthreads();
}
__device__ __forceinline__ void ssd_tables(Frame& F, size_t row0, int g) { float d0 = 0.f, d1 = 0.f; ssd_tables_load(F, row0, g, d0, d1); ssd_tables_compute(F, g, d0, d1); }
struct ConvMap { int kind, cc, run, gch; };
__device__ __forceinline__ ConvMap ssd_conv_map(int t, int g) {
    ConvMap m;
    if (t < 256) { m.kind = 0; m.cc = t & 31; m.run = t >> 5; } else if (t < 384) { m.kind = 1; m.cc = (t - 256) & 15; m.run = (t - 256) >> 4; } else { m.kind = 2; m.cc = (t - 384) & 15; m.run = (t - 384) >> 4; }
    m.gch = (m.kind == 0 ? g * 256 : (m.kind == 1 ? DI + g * DSTATE : DI + NG * DSTATE + g * DSTATE)) + 8 * m.cc;
    return m;
}
__device__ __forceinline__ void ssd_conv_load(Frame& F, size_t row0, int b, int c, int g, u32x4 (&raw)[19]) {
    const ConvMap m = ssd_conv_map(F.tid, g);
    const bf16_t* const XBC = (const bf16_t*)(F.ws + WS_XBC); const bf16_t* const HALO = (const bf16_t*)(F.ws + WS_HALO);
#pragma unroll
    for (int i = 0; i < 19; ++i) {
        if (i < 3 && m.run == 0) { if (c == 0) raw[i] = (u32x4){0u, 0u, 0u, 0u}; else raw[i] = *(const GAS u32x4*)(HALO + ((((size_t)b * 16 + c) * 3 + i) * CD) + m.gch); }
        else raw[i] = *(const GAS u32x4*)(XBC + (row0 + 16 * m.run + i - 3) * CD + m.gch); }
}
__device__ __forceinline__ void ssd_conv_store(Frame& F, size_t row0, int g, const u32x4 (&raw)[19]) {
    const ConvMap m = ssd_conv_map(F.tid, g);
    bf16_t* const XBC = (bf16_t*)(F.ws + WS_XBC);
    const float* const convw = F.in[I_CONVW]; const float* const convb = F.in[I_CONVB];
    float cw[4][8], cb[8];
#pragma unroll
    for (int k = 0; k < 4; ++k) { const f32x4 a = *(const GAS f32x4*)(convw + (size_t)k * CD + m.gch), b_ = *(const GAS f32x4*)(convw + (size_t)k * CD + m.gch + 4);
        cw[k][0] = a.x; cw[k][1] = a.y; cw[k][2] = a.z; cw[k][3] = a.w; cw[k][4] = b_.x; cw[k][5] = b_.y; cw[k][6] = b_.z; cw[k][7] = b_.w; }
    { const f32x4 a = *(const GAS f32x4*)(convb + m.gch), b_ = *(const GAS f32x4*)(convb + m.gch + 4); cb[0] = a.x; cb[1] = a.y; cb[2] = a.z; cb[3] = a.w; cb[4] = b_.x; cb[5] = b_.y; cb[6] = b_.z; cb[7] = b_.w; }
    LAS unsigned char* const img = F.lds + (m.kind == 0 ? IMG_X + (m.cc >> 4) * 32768 : IMG_B);
    const LAS float* const sdec = (const LAS float*)(F.lds + TAB_SD);
    const int chl = m.cc & 15, hr = m.cc >> 3;
#pragma unroll
    for (int i = 0; i < 16; ++i) {
        const int s = 16 * m.run + i;
        float o[8];
#pragma unroll
        for (int j2 = 0; j2 < 4; ++j2) {
            const unsigned w0 = raw[i][j2], w1 = raw[i + 1][j2], w2 = raw[i + 2][j2], w3 = raw[i + 3][j2];
            const float lo = cb[2 * j2] + cw[0][2 * j2] * bflo(w0) + cw[1][2 * j2] * bflo(w1) + cw[2][2 * j2] * bflo(w2) + cw[3][2 * j2] * bflo(w3);
            const float hi = cb[2 * j2 + 1] + cw[0][2 * j2 + 1] * bfhi(w0) + cw[1][2 * j2 + 1] * bfhi(w1) + cw[2][2 * j2 + 1] * bfhi(w2) + cw[3][2 * j2 + 1] * bfhi(w3);
            o[2 * j2] = silu_f(lo); o[2 * j2 + 1] = silu_f(hi);
        }
        u32x4 pk; pk.x = cvt_pk_bf16(o[0], o[1]); pk.y = cvt_pk_bf16(o[2], o[3]); pk.z = cvt_pk_bf16(o[4], o[5]); pk.w = cvt_pk_bf16(o[6], o[7]);
        *(GAS u32x4*)(XBC + (row0 + s) * CD + m.gch) = pk;
        if (m.kind == 0) { const float sc = sdec[s * 4 + hr];
            pk.x = cvt_pk_bf16(o[0] * sc, o[1] * sc); pk.y = cvt_pk_bf16(o[2] * sc, o[3] * sc); pk.z = cvt_pk_bf16(o[4] * sc, o[5] * sc); pk.w = cvt_pk_bf16(o[6] * sc, o[7] * sc); }
        if (m.kind != 2) *(LAS u32x4*)(img + img_off<false>(s, chl)) = pk;
    }
}
__device__ __forceinline__ void ssd_copy_load(Frame& F, size_t row0, int g, u32x4 (&raw)[16]) {
    const ConvMap m = ssd_conv_map(F.tid, g);
    const bf16_t* const XBC = (const bf16_t*)(F.ws + WS_XBC);
#pragma unroll
    for (int i = 0; i < 16; ++i) raw[i] = *(const GAS u32x4*)(XBC + (row0 + 16 * m.run + i) * CD + m.gch);
}
__device__ __forceinline__ void ssd_copy_store(Frame& F, int g, const u32x4 (&raw)[16]) {
    const ConvMap m = ssd_conv_map(F.tid, g);
    LAS unsigned char* const img = F.lds + (m.kind == 0 ? IMG_X + (m.cc >> 4) * 32768 : (m.kind == 1 ? IMG_B : IMG_C));
    const int chl = m.cc & 15;
#pragma unroll
    for (int i = 0; i < 16; ++i) { const int s = 16 * m.run + i; *(LAS u32x4*)(img + (m.kind == 0 ? img_off<true>(s, chl) : img_off<false>(s, chl))) = raw[i]; }
}
__device__ __forceinline__ void ssd_states_phase(Frame& F) {
    bf16_t* const ST = (bf16_t*)(F.ws + WS_HPREV);
    float* const CDEC = (float*)(F.ws + WS_CDEC);
    const int w = F.wave, lane = F.lane, ql = lane & 15, gq = lane >> 4, qq = ql >> 2, pp = ql & 3, r = w >> 1, nh = w & 1;
    int sbo[4][2], sxo[4][2];
#pragma unroll
    for (int f = 0; f < 4; ++f) { const int colb = 64 * nh + 16 * f + 4 * pp, colx = 64 * (r & 1) + 16 * f + 4 * pp;
#pragma unroll
        for (int t4 = 0; t4 < 2; ++t4) { sbo[f][t4] = img_off<false>(8 * gq + qq + 4 * t4, colb >> 3) + 2 * (colb & 7); sxo[f][t4] = img_off<false>(8 * gq + qq + 4 * t4, colx >> 3) + 2 * (colx & 7); } }
    u32x4 raw[19]; float d0 = 0.f, d1 = 0.f;
    constexpr int NIT = BATCH * NCHUNK * NG;
    if (F.vcu < NIT) { const int it = F.vcu, g = it & 7, c = (it >> 3) & (NCHUNK - 1), b = it >> 7; const size_t row0 = (size_t)b * SEQ + (size_t)c * 128;
        ssd_conv_load(F, row0, b, c, g, raw); ssd_tables_load(F, row0, g, d0, d1); }
    for (int it = F.vcu; it < NIT; it += F.G) {
        const int g = it & 7, c = (it >> 3) & (NCHUNK - 1), b = it >> 7;
        const size_t row0 = (size_t)b * SEQ + (size_t)c * 128;
        asm volatile("s_waitcnt vmcnt(0)" ::: "memory");
        ssd_tables_compute(F, g, d0, d1);
        ssd_conv_store(F, row0, g, raw);
        __syncthreads();
        if (it + F.G < NIT) { const int it2 = it + F.G, g2 = it2 & 7, c2 = (it2 >> 3) & (NCHUNK - 1), b2 = it2 >> 7; const size_t row2 = (size_t)b2 * SEQ + (size_t)c2 * 128;
            ssd_conv_load(F, row2, b2, c2, g2, raw); ssd_tables_load(F, row2, g2, d0, d1); }
        const int head = g * HPG + r;
        bf16_t* const stp = ST + ((((size_t)b * NCHUNK + c) * NH + head) * HD) * DSTATE;
#pragma unroll
        for (int nh2 = 0; nh2 < 2; ++nh2) {
            f32x4 acc[2][4];
#pragma unroll
            for (int i = 0; i < 2; ++i)
#pragma unroll
                for (int j = 0; j < 4; ++j) acc[i][j] = (f32x4){0.f, 0.f, 0.f, 0.f};
#pragma unroll
            for (int ks = 0; ks < 4; ++ks) {
                bf16x8 af[2], xf[4];
#pragma unroll
                for (int nf = 0; nf < 2; ++nf) { const LAS unsigned char* p = F.lds + IMG_B + sbo[2 * nh2 + nf][0] + 8192 * ks; const LAS unsigned char* p4 = F.lds + IMG_B + sbo[2 * nh2 + nf][1] + 8192 * ks; af[nf] = tr_pair(p, p4); }
#pragma unroll
                for (int pf = 0; pf < 4; ++pf) { const LAS unsigned char* p = F.lds + IMG_X + (r >> 1) * 32768 + sxo[pf][0] + 8192 * ks; const LAS unsigned char* p4 = F.lds + IMG_X + (r >> 1) * 32768 + sxo[pf][1] + 8192 * ks; xf[pf] = tr_pair(p, p4); }
#pragma unroll
                for (int nf = 0; nf < 2; ++nf)
#pragma unroll
                    for (int pf = 0; pf < 4; ++pf) acc[nf][pf] = __builtin_amdgcn_mfma_f32_16x16x32_bf16(af[nf], xf[pf], acc[nf][pf], 0, 0, 0);
            }
#pragma unroll
            for (int pf = 0; pf < 4; ++pf)
#pragma unroll
                for (int nf = 0; nf < 2; ++nf) { u32x2 o; o.x = cvt_pk_bf16(acc[nf][pf][0], acc[nf][pf][1]); o.y = cvt_pk_bf16(acc[nf][pf][2], acc[nf][pf][3]);
                    *(GAS u32x2*)(stp + (size_t)(16 * pf + ql) * DSTATE + 64 * nh + 32 * nh2 + 16 * nf + 4 * gq) = o; }
        }
        if (F.tid < 4) { const LAS float* acs = (const LAS float*)(F.lds + TAB_ACS); *(GAS float*)(CDEC + ((size_t)b * NCHUNK + c) * NH + g * HPG + F.tid) = __expf(acs[127 * 4 + F.tid]); }
        __syncthreads();
    }
}
__device__ __forceinline__ void ssd_scan_phase(Frame& F) {
    bf16_t* const HP = (bf16_t*)(F.ws + WS_HPREV); const float* const CDEC = (const float*)(F.ws + WS_CDEC); float* const hout = F.out + O_SSM_P;
    const int gt = F.vcu * NTHREADS + F.tid, NT = F.G * NTHREADS;
    constexpr int PER = NH * HD * DSTATE / 8;
    for (int e = gt; e < BATCH * PER; e += NT) {
        const int b = e / PER, i8 = e % PER, head = i8 / (HD * DSTATE / 8);
        u32x4 stv[NCHUNK];
#pragma unroll
        for (int c = 0; c < NCHUNK; ++c) stv[c] = *(const GAS u32x4*)(HP + (((size_t)b * NCHUNK + c) * (size_t)PER + i8) * 8);
        f32x4 h0 = (f32x4){0.f, 0.f, 0.f, 0.f}, h1 = h0;
#pragma unroll
        for (int c = 0; c < NCHUNK; ++c) {
            if (c > 0) *(GAS u32x4*)(HP + (((size_t)b * NCHUNK + c) * (size_t)PER + i8) * 8) = pg8::pack8(h0, h1);
            const float d = *(const GAS float*)(CDEC + ((size_t)b * NCHUNK + c) * NH + head);
            f32x4 s0, s1; pg8::unpack8(stv[c], s0, s1);
            h0 = h0 * d + s0; h1 = h1 * d + s1;
        }
        *(GAS f32x4*)(hout + ((size_t)b * PER + i8) * 8) = h0; *(GAS f32x4*)(hout + ((size_t)b * PER + i8) * 8 + 4) = h1;
    }
}
__device__ __forceinline__ void ssd_out_phase(Frame& F) {
    const bf16_t* const HP = (const bf16_t*)(F.ws + WS_HPREV); bf16_t* const ZY = (bf16_t*)(F.ws + WS_Z);
    const int w = F.wave, lane = F.lane, ql = lane & 15, gq = lane >> 4, qq = ql >> 2, pp = ql & 3, q0 = 16 * w;
    const LAS float* const acs = (const LAS float*)(F.lds + TAB_ACS); const LAS float* const dtl = (const LAS float*)(F.lds + TAB_DT);
    int cfo[4], bbo[4], hbo[4], xbo[2][4];
#pragma unroll
    for (int ks = 0; ks < 4; ++ks) { cfo[ks] = IMG_C + img_off<false>(q0 + ql, 4 * ks + gq); bbo[ks] = IMG_B + img_off<false>(ql, 4 * ks + gq); hbo[ks] = img_off<false>(ql, 4 * ks + gq); }
#pragma unroll
    for (int rr = 0; rr < 2; ++rr)
#pragma unroll
        for (int pf = 0; pf < 4; ++pf) xbo[rr][pf] = IMG_X + img_off<true>(4 * gq + qq, 8 * rr + 2 * pf + (pp >> 1)) + 8 * (pp & 1);
    u32x4 raw[16]; float d0 = 0.f, d1 = 0.f;
    constexpr int NIT = BATCH * NCHUNK * NG;
    if (F.vcu < NIT) { const int it = F.vcu, g = it & 7, c = (it >> 3) & (NCHUNK - 1), b = it >> 7; const size_t row0 = (size_t)b * SEQ + (size_t)c * 128;
        ssd_copy_load(F, row0, g, raw); ssd_tables_load(F, row0, g, d0, d1); }
    for (int it = F.vcu; it < NIT; it += F.G) {
        const int g = it & 7, c = (it >> 3) & (NCHUNK - 1), b = it >> 7;
        const size_t row0 = (size_t)b * SEQ + (size_t)c * 128;
        ssd_tables_compute(F, g, d0, d1);
        ssd_copy_store(F, g, raw);
        __syncthreads();
        if (it + F.G < NIT) { const int it2 = it + F.G, g2 = it2 & 7, c2 = (it2 >> 3) & (NCHUNK - 1), b2 = it2 >> 7; const size_t row2 = (size_t)b2 * SEQ + (size_t)c2 * 128;
            ssd_copy_load(F, row2, g2, raw); ssd_tables_load(F, row2, g2, d0, d1); }
        bf16x8 cf[4];
#pragma unroll
        for (int ks = 0; ks < 4; ++ks) cf[ks] = *(const LAS bf16x8*)(F.lds + cfo[ks]);
        bf16_t* const zp = ZY + (row0 + q0 + ql) * DI + g * 256 + 4 * gq;
        const LAS float* const acs_l = acs + 16 * gq; const LAS float* const dtl_l = dtl + 16 * gq;
        f32x4 acc[4][4];
        float aq[4];
#pragma unroll
        for (int r = 0; r < 4; ++r) { aq[r] = acs[(q0 + ql) * 4 + r];
#pragma unroll
            for (int pf = 0; pf < 4; ++pf) acc[r][pf] = (f32x4){0.f, 0.f, 0.f, 0.f}; }
#pragma unroll
        for (int ks = 0; ks < 4; ++ks) if (2 * ks <= w) {
            f32x4 cb[2];
#pragma unroll
            for (int hf = 0; hf < 2; ++hf) { cb[hf] = (f32x4){0.f, 0.f, 0.f, 0.f};
                if (2 * ks + hf <= w) {
#pragma unroll
                    for (int kn = 0; kn < 4; ++kn) { const bf16x8 bfr = *(const LAS bf16x8*)(F.lds + bbo[kn] + 4096 * (2 * ks + hf)); cb[hf] = __builtin_amdgcn_mfma_f32_16x16x32_bf16(bfr, cf[kn], cb[hf], 0, 0, 0); } } }
#pragma unroll
            for (int r = 0; r < 4; ++r) {
                const float Dh = *(const GAS float*)(F.in[I_DSKIP] + g * HPG + r);
                float v[8];
#pragma unroll
                for (int hf = 0; hf < 2; ++hf) { const int sf = 2 * ks + hf;
#pragma unroll
                    for (int rg = 0; rg < 4; ++rg) { const int sl = 4 * gq + rg;
                        float val = 0.f;
                        if (sf <= w) { const float as = acs_l[64 * sf + 4 * rg + r], d = dtl_l[64 * sf + 4 * rg + r];
                            val = cb[hf][rg] * __expf(aq[r] - as) * d;
                            if (sf == w) { if (sl > ql) val = 0.f; else if (sl == ql) val += Dh; } }
                        v[4 * hf + rg] = val; } }
                u32x4 pk; pk.x = cvt_pk_bf16(v[0], v[1]); pk.y = cvt_pk_bf16(v[2], v[3]); pk.z = cvt_pk_bf16(v[4], v[5]); pk.w = cvt_pk_bf16(v[6], v[7]);
                const bf16x8 wf = __builtin_bit_cast(bf16x8, pk);
#pragma unroll
                for (int pf = 0; pf < 4; ++pf) {
                    const LAS unsigned char* const xb = F.lds + xbo[r & 1][pf] + (r >> 1) * 32768 + 8192 * ks;
                    const bf16x8 xf = tr_pair(xb, xb + 4096);
                    acc[r][pf] = __builtin_amdgcn_mfma_f32_16x16x32_bf16(xf, wf, acc[r][pf], 0, 0, 0); }
            }
        }
        u32x4 hreg[8];
        if (c > 0) {
            const u32x4* hsrc = (const u32x4*)(HP + ((((size_t)b * NCHUNK + c) * NH + g * HPG) * HD) * DSTATE) + F.tid;
#pragma unroll
            for (int i = 0; i < 8; ++i) hreg[i] = *(const GAS u32x4*)(hsrc + 512 * i);
        }
        if (c > 0) {
            __syncthreads();
#pragma unroll
            for (int i = 0; i < 8; ++i) { const int e = F.tid + 512 * i, hr_ = e >> 10, p_ = (e >> 4) & 63, ch_ = e & 15;
                *(LAS u32x4*)(F.lds + IMG_X + hr_ * 16384 + img_off<false>(p_, ch_)) = hreg[i]; }
            __syncthreads();
#pragma unroll
            for (int r = 0; r < 4; ++r) { const float eaq = __expf(aq[r]);
#pragma unroll
                for (int pf = 0; pf < 4; ++pf) { f32x4 yo = (f32x4){0.f, 0.f, 0.f, 0.f};
#pragma unroll
                    for (int ks = 0; ks < 4; ++ks) { const bf16x8 hf_ = *(const LAS bf16x8*)(F.lds + IMG_X + r * 16384 + hbo[ks] + 4096 * pf); yo = __builtin_amdgcn_mfma_f32_16x16x32_bf16(hf_, cf[ks], yo, 0, 0, 0); }
                    acc[r][pf] += yo * eaq; } }
        }
        float ssum = 0.f;
#pragma unroll
        for (int r = 0; r < 4; ++r)
#pragma unroll
            for (int pf = 0; pf < 4; ++pf) {
                const u32x2 zz = *(const GAS u32x2*)(zp + r * 64 + 16 * pf);
                const f32x4 y = acc[r][pf] * (f32x4){bflo(zz.x), bfhi(zz.x), bflo(zz.y), bfhi(zz.y)};
                acc[r][pf] = y; ssum += (y[0] * y[0] + y[1] * y[1]) + (y[2] * y[2] + y[3] * y[3]); }
        ssum += __shfl_xor(ssum, 16); ssum += __shfl_xor(ssum, 32);
        const float rsn = __builtin_amdgcn_rsqf(ssum * (1.0f / 256.0f) + EPS);
#pragma unroll
        for (int r = 0; r < 4; ++r)
#pragma unroll
            for (int pf = 0; pf < 4; ++pf) { u32x2 o; o.x = cvt_pk_bf16(acc[r][pf][0] * rsn, acc[r][pf][1] * rsn); o.y = cvt_pk_bf16(acc[r][pf][2] * rsn, acc[r][pf][3] * rsn);
                *(GAS u32x2*)(zp + r * 64 + 16 * pf) = o; }
        __syncthreads();
    }
}

__device__ __forceinline__ void ssd_seq_phase(Frame& F) {
    const int r = F.wave & 3, nh = F.wave >> 2, lane = F.lane, idx = r * 64 + lane;
    LAS float* const bc = (LAS float*)F.lds;
    LAS float* const lxs = bc + 2048;
    LAS float* const yp = bc + 4096;
    LAS float* const ldt = bc + 8192; LAS float* const ssq = bc + 8192 + 32;
    const bf16_t* const XBC = (const bf16_t*)(F.ws + WS_XBC); const bf16_t* const Zs = (const bf16_t*)(F.ws + WS_Z); bf16_t* const YN = (bf16_t*)(F.ws + WS_Z);
    const float* const DT = (const float*)(F.ws + WS_DT);
    const float* const convw = F.in[I_CONVW]; const float* const convb = F.in[I_CONVB];
    for (int it = F.vcu; it < DECB * NG; it += F.G) {
        const int b = it >> 3, g = it & 7, head = g * HPG + r;
        const size_t row0 = (size_t)MP + (size_t)b * DECS;
        const int xch = g * 256 + idx;
        {
            const int ch = (nh == 0) ? ((idx < 128) ? (DI + g * DSTATE + idx) : (DI + NG * DSTATE + g * DSTATE + (idx - 128))) : xch;
            float cw[4];
#pragma unroll
            for (int k = 0; k < 4; ++k) cw[k] = *(const GAS float*)(convw + (size_t)k * CD + ch);
            const float cbv = *(const GAS float*)(convb + ch);
            const float* cs = F.in[I_CONV] + (size_t)b * 3 * CD;
            float x3 = *(const GAS float*)(cs + ch), x2 = *(const GAS float*)(cs + CD + ch), x1 = *(const GAS float*)(cs + 2 * CD + ch);
            LAS float* const dst = (nh == 0) ? bc : lxs;
#pragma unroll
            for (int j = 0; j < 8; ++j) {
                const float xr = bf2f(*(const GAS bf16_t*)(XBC + (row0 + j) * CD + ch));
                const float cx = cbv + cw[0] * x3 + cw[1] * x2 + cw[2] * x1 + cw[3] * xr; x3 = x2; x2 = x1; x1 = xr;
                dst[j * 256 + idx] = silu_f(cx);
            }
            if (nh == 1 && lane < 8) ldt[lane * 4 + r] = *(const GAS float*)(DT + (row0 + lane) * 32 + head);
        }
        __syncthreads();
        {
            const float Ah = -__expf(*(const GAS float*)(F.in[I_ALOG] + head));
            const int pg = lane >> 4, nc = lane & 15;
            f32x4 h[16];
            const float* const hin = F.in[I_SSM] + (((size_t)b * NH + head) * HD + 16 * pg) * DSTATE + 64 * nh + 4 * nc;
#pragma unroll
            for (int i = 0; i < 16; ++i) h[i] = *(const GAS f32x4*)(hin + (size_t)i * DSTATE);
            for (int j = 0; j < 8; ++j) {
                const float dtv = ldt[j * 4 + r], dA = __expf(dtv * Ah);
                const f32x4 Bv = *(const LAS f32x4*)(bc + j * 256 + 64 * nh + 4 * nc), Cv = *(const LAS f32x4*)(bc + j * 256 + 128 + 64 * nh + 4 * nc);
                float part[16];
#pragma unroll
                for (int i4 = 0; i4 < 4; ++i4) { const f32x4 xs4 = *(const LAS f32x4*)(lxs + j * 256 + r * 64 + 16 * pg + 4 * i4);
#pragma unroll
                    for (int k = 0; k < 4; ++k) { const int i = 4 * i4 + k; const float dx = dtv * xs4[k];
                        h[i] = h[i] * dA + Bv * dx;
                        part[i] = (Cv.x * h[i].x + Cv.y * h[i].y) + (Cv.z * h[i].z + Cv.w * h[i].w); } }
#pragma unroll
                for (int i = 0; i < 8; ++i) { const bool up = (nc & 8) != 0; const float keep = up ? part[i + 8] : part[i], send = up ? part[i] : part[i + 8]; part[i] = keep + __shfl_xor(send, 8); }
#pragma unroll
                for (int i = 0; i < 4; ++i) { const bool up = (nc & 4) != 0; const float keep = up ? part[i + 4] : part[i], send = up ? part[i] : part[i + 4]; part[i] = keep + __shfl_xor(send, 4); }
#pragma unroll
                for (int i = 0; i < 2; ++i) { const bool up = (nc & 2) != 0; const float keep = up ? part[i + 2] : part[i], send = up ? part[i] : part[i + 2]; part[i] = keep + __shfl_xor(send, 2); }
                { const bool up = (nc & 1) != 0; const float keep = up ? part[1] : part[0], send = up ? part[0] : part[1]; part[0] = keep + __shfl_xor(send, 1); }
                yp[(j * 2 + nh) * 256 + r * 64 + 16 * pg + nc] = part[0];
            }
            float* const hout = F.out + O_SSM_S + (((size_t)b * NH + head) * HD + 16 * pg) * DSTATE + 64 * nh + 4 * nc;
#pragma unroll
            for (int i = 0; i < 16; ++i) *(GAS f32x4*)(hout + (size_t)i * DSTATE) = h[i];
        }
        __syncthreads();
        float ygv[4];
        {
            const float Dh = *(const GAS float*)(F.in[I_DSKIP] + head);
#pragma unroll
            for (int jj = 0; jj < 4; ++jj) { const int j = 4 * nh + jj;
                const float y = (yp[(j * 2) * 256 + idx] + yp[(j * 2 + 1) * 256 + idx]) + Dh * lxs[j * 256 + idx];
                ygv[jj] = y * bf2f(*(const GAS bf16_t*)(Zs + (row0 + j) * DI + xch));
                const float ss = wave_sum(ygv[jj] * ygv[jj]);
                if (lane == 0) ssq[j * 4 + r] = ss; }
        }
        __syncthreads();
#pragma unroll
        for (int jj = 0; jj < 4; ++jj) { const int j = 4 * nh + jj;
            const f32x4 s4 = *(const LAS f32x4*)(ssq + j * 4);
            const float rsn = __builtin_amdgcn_rsqf(((s4.x + s4.y) + (s4.z + s4.w)) * (1.0f / 256.0f) + EPS);
            *(GAS bf16_t*)(YN + (row0 + j) * DI + xch) = (bf16_t)f2bf(ygv[jj] * rsn); }
        __syncthreads();
    }
}
template <int W> __device__ __forceinline__ void pool_run(const bf16_t* V, bf16_t* PO, int run, int cv) {
    const int row0 = run * 16, t0 = row0 & (SEQ - 1);
    u32x4 raw[16 + W - 1];
#pragma unroll
    for (int e = 0; e < 16 + W - 1; ++e) {
        const int dt_ = e - (W - 1);
        if (t0 + dt_ >= 0) raw[e] = *(const GAS u32x4*)(V + (size_t)(row0 + dt_) * PD + cv); else raw[e] = (u32x4){0u, 0u, 0u, 0u};
    }
    f32x4 s0 = (f32x4){0.f, 0.f, 0.f, 0.f}, s1 = s0;
#pragma unroll
    for (int e = 0; e < W - 1; ++e) { f32x4 x0, x1; pg8::unpack8(raw[e], x0, x1); s0 += x0; s1 += x1; }
#pragma unroll
    for (int i = 0; i < 16; ++i) {
        f32x4 c0, c1; pg8::unpack8(raw[i + W - 1], c0, c1);
        s0 += c0; s1 += c1;
        const int t = t0 + i; const float ic = 1.0f / (float)((t + 1 < W) ? t + 1 : W);
        const f32x4 o0 = s0 * ic - c0, o1 = s1 * ic - c1;
        u32x4 o; o.x = pk2(o0.x, o0.y); o.y = pk2(o0.z, o0.w); o.z = pk2(o1.x, o1.y); o.w = pk2(o1.z, o1.w);
        *(GAS u32x4*)(PO + (size_t)(row0 + i) * PD + cv) = o;
        f32x4 x0, x1; pg8::unpack8(raw[i], x0, x1); s0 -= x0; s1 -= x1;
    }
}
template <int W> __device__ __forceinline__ void pool_run_s(const bf16_t* V, bf16_t* PO, const float* sp, int b, int cv) {
    const size_t row0 = (size_t)MP + (size_t)b * DECS;
    f32x4 a0[8 + W - 1], a1[8 + W - 1];
#pragma unroll
    for (int e = 0; e < 8 + W - 1; ++e) { const int t = e - (W - 1);
        if (t >= 0) pg8::unpack8(*(const GAS u32x4*)(V + (row0 + t) * PD + cv), a0[e], a1[e]);
        else { const float* p = sp + ((size_t)b * PBUF + (PBUF + t)) * PD + cv; a0[e] = *(const GAS f32x4*)p; a1[e] = *(const GAS f32x4*)(p + 4); } }
    f32x4 s0 = (f32x4){0.f, 0.f, 0.f, 0.f}, s1 = s0;
#pragma unroll
    for (int e = 0; e < W - 1; ++e) { s0 += a0[e]; s1 += a1[e]; }
    const float ic = 1.0f / (float)W;
#pragma unroll
    for (int i = 0; i < 8; ++i) {
        s0 += a0[i + W - 1]; s1 += a1[i + W - 1];
        const f32x4 o0 = s0 * ic - a0[i + W - 1], o1 = s1 * ic - a1[i + W - 1];
        u32x4 o; o.x = pk2(o0.x, o0.y); o.y = pk2(o0.z, o0.w); o.z = pk2(o1.x, o1.y); o.w = pk2(o1.z, o1.w);
        *(GAS u32x4*)(PO + (row0 + i) * PD + cv) = o;
        s0 -= a0[i]; s1 -= a1[i];
    }
}
__device__ __forceinline__ void pool_phase(Frame& F) {
    const bf16_t* const V = (const bf16_t*)(F.ws + WS_V); bf16_t* const PO = (bf16_t*)(F.out + O_Y);
    const float* const sp = F.in[I_POOL];
    const int gt = F.vcu * NTHREADS + F.tid, NT = F.G * NTHREADS;
    for (int e = gt; e < (MP / 16) * 128; e += NT) {
        const int c32 = e & 31, rl = (e >> 5) & 1, grp = (e >> 6) & 3, run = (e >> 8) * 2 + rl, cv = (grp * 32 + c32) * 8;
        if (grp == 0) pool_run<2>(V, PO, run, cv); else if (grp == 1) pool_run<4>(V, PO, run, cv); else if (grp == 2) pool_run<8>(V, PO, run, cv); else pool_run<16>(V, PO, run, cv);
    }
    for (int e = gt; e < (MS / 8) * 128; e += NT) {
        const int c32 = e & 31, grp = (e >> 5) & 3, b = e >> 7, cv = (grp * 32 + c32) * 8;
        if (grp == 0) pool_run_s<2>(V, PO, sp, b, cv); else if (grp == 1) pool_run_s<4>(V, PO, sp, b, cv); else if (grp == 2) pool_run_s<8>(V, PO, sp, b, cv); else pool_run_s<16>(V, PO, sp, b, cv);
    }
    float* const ops = F.out + O_POOL_S;
    for (int e = gt; e < DECB * 7 * (PD / 4); e += NT) {
        const int c4 = e & 255, i = (e >> 8) % 7, b = (e >> 8) / 7;
        *(GAS f32x4*)(ops + ((size_t)b * PBUF + i) * PD + c4 * 4) = *(const GAS f32x4*)(sp + ((size_t)b * PBUF + 8 + i) * PD + c4 * 4);
    }
}
__device__ __forceinline__ void final_phase(Frame& F) {
    const int gw = F.vcu * NWAVES + F.wave, NGW = F.G * NWAVES, lane = F.lane;
    const float* const st = (const float*)(F.ws + WS_STATS_A); const float* const gf = F.in[I_NFINAL];
    f32x4 gv[4];
#pragma unroll
    for (int j = 0; j < 4; ++j) gv[j] = *((const GAS f32x4*)gf + lane + 64 * j);
    for (int m = gw; m < M; m += NGW) {
        const GAS f32x4* sp = (const GAS f32x4*)(st + (size_t)m * 16);
        const f32x4 a = sp[0], b = sp[1], c = sp[2], d = sp[3]; const f32x4 s = (a + b) + (c + d);
        const float rs = __builtin_amdgcn_rsqf(((s[0] + s[1]) + (s[2] + s[3])) * (1.0f / 1024.0f) + EPS);
        GAS f32x4* yr = (GAS f32x4*)(F.out + (size_t)m * DM) + lane;
#pragma unroll
        for (int j = 0; j < 4; ++j) yr[64 * j] = yr[64 * j] * rs * gv[j];
    }
}

constexpr int NPHASES = 13;
struct Args { const float* in[30]; float* out; unsigned char* ws; int ph_lo, ph_hi, li, pad; };
__global__ void __launch_bounds__(NTHREADS, 2) mk_fwd(Args args) {
    extern __shared__ __attribute__((aligned(16))) unsigned char lds[];
    Frame F;
    F.lds = (LAS unsigned char*)lds;
    F.MISC = (volatile LAS unsigned*)(F.lds + MISC_OFF);
    F.tid = threadIdx.x; F.lane = F.tid & 63; F.wave = __builtin_amdgcn_readfirstlane(F.tid >> 6);
    F.G = gridDim.x; { const int bx = blockIdx.x; F.vcu = (F.G % 8 == 0) ? (bx % 8) * (F.G / 8) + bx / 8 : bx; }
    F.ws = args.ws; F.out = args.out; F.ctl = (gu32*)(args.ws + WS_CTL);
#pragma unroll
    for (int i = 0; i < 30; ++i) F.in[i] = args.in[i];
    for (int u = F.tid; u < (LDS_BYTES - LDSCTL_OFF) / 4; u += NTHREADS) ((LAS unsigned*)(F.lds + LDSCTL_OFF))[u] = 0u;
    __syncthreads();
    const int lo = args.ph_lo, hi = args.ph_hi;
    XcdBarrier bar; bar.bar = (unsigned*)(F.ctl + CW_BAR); bar.x = 0; bar.st = nullptr;
    if (hi - lo > 1) bar = xcd_barrier_post((unsigned*)(F.ctl + CW_BAR), F.MISC + 8);
#ifndef PHMASK
#define PHMASK 0x1fff
#endif
#define IN(k) (((PHMASK >> (k)) & 1) && lo <= (k) && (k) < hi)
#define SEAM(k) do { if (IN(k) && IN((k) + 1)) xcd_barrier(bar); } while (0)
#define PH_BEGIN(k) if (IN(k)) { auto body_ = [&]() __attribute__((always_inline))
#define PH_END(k) ; body_(); if ((REP_MASK >> (k)) & 1) { xcd_barrier(bar); body_(); } } SEAM(k);

    bf16_t* const XB = (bf16_t*)(F.ws + WS_XB); bf16_t* const HB = (bf16_t*)(F.ws + WS_HB); bf16_t* const ACT = (bf16_t*)(F.ws + WS_ACT);
    bf16_t* const Zb = (bf16_t*)(F.ws + WS_Z); bf16_t* const XBCb = (bf16_t*)(F.ws + WS_XBC); bf16_t* const Vb = (bf16_t*)(F.ws + WS_V); bf16_t* const GATES = (bf16_t*)(F.ws + WS_GATES);
    bf16_t* const POOLED = (bf16_t*)(F.out + O_Y); bf16_t* const MERGED = (bf16_t*)(F.ws + WS_MERGED); bf16_t* const Qb = (bf16_t*)(F.ws + WS_Q); bf16_t* const PB = (bf16_t*)(F.ws + WS_PB);
    float* const T1 = (float*)(F.ws + WS_T1); float* const stA = (float*)(F.ws + WS_STATS_A); float* const stB = (float*)(F.ws + WS_STATS_B); float* const DTb = (float*)(F.ws + WS_DT);
    float* const H = F.out + O_Y;
    pg8::StaticOrder S;

    PH_BEGIN(0) { p0_prologue(F); } PH_END(0)
    PH_BEGIN(1) {
        pg8::Gemm g{XB, (const bf16_t*)(F.ws + WS_WGU1), M, 2 * DFF, DM, DM, 0}; S.init(M, 2 * DFF, F.G, (int)blockIdx.x);
        pg8::Epi E{}; E.kind = pg8::EK_GU; E.stats_in = stA; E.obf = ACT; E.ldo = DFF;
        pg8::gemm_phase(F.lds, g, S, E);
        pg8::Gemm g2{(const bf16_t*)(F.ws + WS_WPOT), (const bf16_t*)(F.ws + WS_WGRP), DM, DM, 256, DM, 256}; S.init_tail(DM, DM, F.G, (int)blockIdx.x);
        pg8::Epi E2{}; E2.kind = pg8::EK_BF16; E2.obf = (bf16_t*)(F.ws + WS_W2); E2.ldo = DM;
        pg8::gemm_phase(F.lds, g2, S, E2);
    } PH_END(1)
    PH_BEGIN(2) {
        pg8::Gemm g{ACT, (const bf16_t*)(F.ws + WS_WD1), M, DM, DFF, DFF, 0}; S.init(MP, DM, F.G, (int)blockIdx.x);
        pg8::Epi E{}; E.kind = pg8::EK_RES; E.coef = 0.5f; E.res_p = F.in[I_XP]; E.res_s = F.in[I_XS]; E.obf = HB; E.stats_out = stB;
        pg8::gemm_phase(F.lds, g, S, E);
        pg8::gemm_small(F.lds, g, E, MP, MS, F.G, (int)blockIdx.x);
    } PH_END(2)
    PH_BEGIN(3) {
        pg8::Gemm g{HB, (const bf16_t*)(F.ws + WS_WIN), M, NIN, DM, DM, 0}; S.init(M, NIN, F.G, (int)blockIdx.x);
        pg8::Epi E{}; E.kind = pg8::EK_WIN; E.stats_in = stB; E.Z = Zb; E.XBC = XBCb; E.V = Vb; E.GATES = GATES; E.HALO = (bf16_t*)(F.ws + WS_HALO); E.DT = DTb; E.dt_bias = F.in[I_DTB];
        E.conv_p = F.out + O_CONV_P; E.conv_s = F.out + O_CONV_S; E.pool_p = F.out + O_POOL_P; E.pool_s = F.out + O_POOL_S;
        pg8::gemm_phase(F.lds, g, S, E);
    } PH_END(3)
    PH_BEGIN(4) { ssd_states_phase(F); pool_phase(F); } PH_END(4)
    PH_BEGIN(5) { ssd_scan_phase(F);

        pg8::Gemm g{PB, (const bf16_t*)(F.ws + WS_WPLE), M, DM, PLE, PLE, 0}; S.init(MP, DM, F.G, (int)blockIdx.x);
        pg8::Epi E{}; E.kind = pg8::EK_BF16; E.obf = Qb; E.ldo = DM;
        pg8::gemm_phase(F.lds, g, S, E);
        pg8::gemm_small(F.lds, g, E, MP, MS, F.G, (int)blockIdx.x);
        } PH_END(5)
    PH_BEGIN(6) { ssd_out_phase(F); ssd_seq_phase(F); } PH_END(6)
    PH_BEGIN(7) {
        pg8::Gemm2 g{Zb, (const bf16_t*)(F.ws + WS_WSSO), POOLED, (const bf16_t*)(F.ws + WS_W2), DI, DI, DM, DM, DM}; S.init(MP, DM, F.G, (int)blockIdx.x);
        pg8::gemm_phase2(F.lds, g, S, GATES, MERGED);
        pg8::gemm_small2(F.lds, g, GATES, MERGED, MP, MS, F.G, (int)blockIdx.x);
    } PH_END(7)
    PH_BEGIN(8) {
        pg8::Gemm g{MERGED, (const bf16_t*)(F.ws + WS_WO), M, DM, DM, DM, 0}; S.init(MP, DM, F.G, (int)blockIdx.x);
        pg8::Epi E{}; E.kind = pg8::EK_RES; E.coef = 1.0f; E.res_bf = HB; E.obf = HB; E.stats_out = stA;
        pg8::gemm_phase(F.lds, g, S, E);
        pg8::gemm_small(F.lds, g, E, MP, MS, F.G, (int)blockIdx.x);
    } PH_END(8)
    PH_BEGIN(9) {
        pg8::Gemm g{HB, (const bf16_t*)(F.ws + WS_WGU2), M, 2 * DFF, DM, DM, 0}; S.init(M, 2 * DFF, F.G, (int)blockIdx.x);
        pg8::Epi E{}; E.kind = pg8::EK_GU; E.stats_in = stA; E.obf = ACT; E.ldo = DFF;
        pg8::gemm_phase(F.lds, g, S, E);
    } PH_END(9)
    PH_BEGIN(10) {
        pg8::Gemm g{ACT, (const bf16_t*)(F.ws + WS_WD2), M, DM, DFF, DFF, 0}; S.init(MP, DM, F.G, (int)blockIdx.x);
        pg8::Epi E{}; E.kind = pg8::EK_RES; E.coef = 0.5f; E.res_bf = HB; E.obf = HB; E.stats_out = stB;
        pg8::gemm_phase(F.lds, g, S, E);
        pg8::gemm_small(F.lds, g, E, MP, MS, F.G, (int)blockIdx.x);
    } PH_END(10)
    PH_BEGIN(11) {
        pg8::Gemm g{HB, (const bf16_t*)(F.ws + WS_WPG), M, DM, DM, DM, 0}; S.init(MP, DM, F.G, (int)blockIdx.x);
        pg8::Epi E{}; E.kind = pg8::EK_PLE; E.stats_in = stB; E.q = Qb; E.res_bf = HB; E.of32 = H; E.stats_out = stA;
        pg8::gemm_phase(F.lds, g, S, E);
        pg8::gemm_small(F.lds, g, E, MP, MS, F.G, (int)blockIdx.x);
    } PH_END(11)
    PH_BEGIN(12) { final_phase(F); } PH_END(12)
#undef IN
#undef SEAM
#undef PH_BEGIN
#undef PH_END
}

extern "C" void kernel_launch(void* const* d_in, const int* in_sizes, int n_in, void* d_out, int out_size, void* d_ws, size_t ws_size, hipStream_t stream) {
    static int grid = 0;
    if (grid == 0) {
        if (n_in != 30 || in_sizes[0] != MP * DM || (size_t)out_size != O_END || ws_size < WS_END) {
            fprintf(stderr, "kernel_launch: shape mismatch: n_in %d in0 %d out %d ws %zu (need %zu)\n", n_in, n_in > 0 ? in_sizes[0] : -1, out_size, ws_size, (size_t)WS_END); grid = -1; return; }
        int dev = 0, cus = 0, per_cu = 0;
        if (hipGetDevice(&dev) != hipSuccess || hipDeviceGetAttribute(&cus, hipDeviceAttributeMultiprocessorCount, dev) != hipSuccess) { grid = -1; return; }
        if (hipFuncSetAttribute((const void*)mk_fwd, hipFuncAttributeMaxDynamicSharedMemorySize, LDS_BYTES) != hipSuccess) { fprintf(stderr, "kernel_launch: hipFuncSetAttribute failed\n"); grid = -1; return; }
        if (hipOccupancyMaxActiveBlocksPerMultiprocessor(&per_cu, (const void*)mk_fwd, NTHREADS, LDS_BYTES) != hipSuccess || per_cu < 1)
            fprintf(stderr, "kernel_launch: occupancy query reports %d workgroups per CU\n", per_cu);
        (void)hipGetLastError();
        grid = cus;
    }
    if (grid < 0) return;
    if (hipMemsetAsync((char*)d_ws + WS_CTL, 0, CTL_ZERO_BYTES, stream) != hipSuccess) { fprintf(stderr, "kernel_launch: memset failed\n"); return; }
    Args a{};
    for (int i = 0; i < 30; ++i) a.in[i] = (const float*)d_in[i];
    a.out = (float*)d_out; a.ws = (unsigned char*)d_ws;
#if MK_MULTI_LAUNCH
    for (int ph = 0; ph < NPHASES; ++ph) { a.ph_lo = ph; a.ph_hi = ph + 1; a.li = ph;
        hipLaunchKernelGGL(mk_fwd, dim3(grid), dim3(NTHREADS), LDS_BYTES, stream, a); }
#else
    a.ph_lo = 0; a.ph_hi = NPHASES; a.li = 0;
    hipLaunchKernelGGL(mk_fwd, dim3(grid), dim3(NTHREADS), LDS_BYTES, stream, a);
#endif
}
```

```cpp
#include <hip/hip_runtime.h>
#include <cstdio>
#include <cstdint>

#define REP_MASK 0x0
#ifndef MK_MULTI_LAUNCH
#define MK_MULTI_LAUNCH 0
#endif

#define GAS __attribute__((address_space(1)))
#define LAS __attribute__((address_space(3)))
typedef unsigned short bf16_t;
typedef short bf16x8 __attribute__((ext_vector_type(8)));
typedef float f32x4 __attribute__((ext_vector_type(4)));
typedef float f32x2 __attribute__((ext_vector_type(2)));
typedef unsigned u32x4 __attribute__((ext_vector_type(4)));
typedef unsigned u32x2 __attribute__((ext_vector_type(2)));
typedef GAS unsigned gu32;

constexpr int DM = 1024, BATCH = 8, SEQ = 2048, DECB = 128, DECS = 8;
constexpr int MP = BATCH * SEQ, MS = DECB * DECS, M = MP + MS;
constexpr int DI = 2048, HD = 64, NH = 32, NG = 8, HPG = 4, DSTATE = 128, CD = 4096;
constexpr int PD = 1024, PBUF = 15, DFF = 2816, PLE = 256;
constexpr int IN_DIM = 9248, NIN = 9472;
constexpr float EPS = 1e-6f;
constexpr int NWAVES = 8, NTHREADS = 512;

constexpr size_t MiB = 1u << 20;
constexpr size_t WS_CTL = 0, CTL_ZERO_BYTES = 32768;
constexpr size_t WS_STATS_A = 2 * MiB, WS_STATS_B = 4 * MiB, WS_DT = 6 * MiB, WS_CDEC = 9 * MiB;
constexpr size_t WS_WGU1 = 10 * MiB, WS_WD1 = 21 * MiB, WS_WIN = 27 * MiB, WS_WSSO = 46 * MiB, WS_W2 = 50 * MiB, WS_WO = 52 * MiB,
                 WS_WGU2 = 54 * MiB, WS_WD2 = 65 * MiB, WS_WPG = 71 * MiB, WS_WPLE = 73 * MiB, WS_PB = 74 * MiB, WS_WPOT = 480 * MiB, WS_WGRP = 483 * MiB;
constexpr size_t WS_Z = 84 * MiB, WS_XBC = 152 * MiB, WS_V = 288 * MiB, WS_GATES = 322 * MiB, WS_HB = 390 * MiB, WS_HPREV = 424 * MiB, WS_HALO = 488 * MiB, WS_END = 492 * MiB;
constexpr size_t WS_ACT = WS_XBC, WS_T1 = WS_XBC, WS_MERGED = 220 * MiB, WS_Q = WS_V, WS_XB = WS_HB;
static_assert(WS_STATS_A + (size_t)M * 16 * 4 <= WS_STATS_B && WS_STATS_B + (size_t)M * 16 * 4 <= WS_DT && WS_DT + (size_t)M * 32 * 4 <= WS_WGU1, "ws map (small)");
static_assert(WS_WGU1 + (size_t)2 * DFF * DM * 2 <= WS_WD1 && WS_WD1 + (size_t)DM * DFF * 2 <= WS_WIN && WS_WIN + (size_t)NIN * DM * 2 <= WS_WSSO && WS_WSSO + (size_t)DM * DI * 2 <= WS_W2, "ws map (w1)");
static_assert(WS_WGU2 + (size_t)2 * DFF * DM * 2 <= WS_WD2 && WS_WD2 + (size_t)DM * DFF * 2 <= WS_WPG && WS_WPLE + (size_t)DM * PLE * 2 <= WS_PB && WS_PB + (size_t)M * PLE * 2 <= WS_Z, "ws map (w2)");
static_assert(WS_Z + (size_t)M * DI * 2 <= WS_XBC && WS_XBC + (size_t)M * CD * 2 <= WS_V && WS_V + (size_t)M * PD * 2 <= WS_GATES && WS_GATES + (size_t)M * 2 * DM * 2 <= WS_HB &&
              WS_HB + (size_t)M * DM * 2 <= WS_HPREV && WS_HPREV + (size_t)BATCH * 16 * NH * HD * DSTATE * 2 <= WS_END, "ws map (act)");
static_assert(WS_ACT + (size_t)M * DFF * 2 <= WS_V && WS_T1 + (size_t)M * DM * 4 <= WS_MERGED && WS_MERGED + (size_t)M * DM * 2 <= WS_V, "ws overlays");
constexpr int CW_BAR = 4096;

constexpr size_t O_Y = 0, O_SSM_P = (size_t)M * DM, O_CONV_P = O_SSM_P + (size_t)BATCH * NH * HD * DSTATE, O_POOL_P = O_CONV_P + (size_t)BATCH * 3 * CD,
                 O_SSM_S = O_POOL_P + (size_t)BATCH * PBUF * PD, O_CONV_S = O_SSM_S + (size_t)DECB * NH * HD * DSTATE, O_POOL_S = O_CONV_S + (size_t)DECB * 3 * CD,
                 O_END = O_POOL_S + (size_t)DECB * PBUF * PD;

constexpr int RING_BYTES = 131072, LDSCTL_OFF = RING_BYTES, MISC_OFF = LDSCTL_OFF + 320, LDS_BYTES = 147456;

#define RLX_AGENT __ATOMIC_RELAXED, __HIP_MEMORY_SCOPE_AGENT
#define LDS_WAIT() asm volatile("s_waitcnt lgkmcnt(0)" ::: "memory")
#define VM_WAIT() asm volatile("s_waitcnt vmcnt(0)" ::: "memory")

__device__ __forceinline__ unsigned f2bf(float f) { unsigned u = __builtin_bit_cast(unsigned, f); return (u + 0x7fffu + ((u >> 16) & 1u)) >> 16; }
__device__ __forceinline__ unsigned cvt_pk_bf16(float lo, float hi);
__device__ __forceinline__ unsigned pk2(float lo, float hi) { return cvt_pk_bf16(lo, hi); }
__device__ __forceinline__ float bf2f(unsigned b) { return __builtin_bit_cast(float, b << 16); }
__device__ __forceinline__ float bflo(unsigned w) { return __builtin_bit_cast(float, w << 16); }
__device__ __forceinline__ float bfhi(unsigned w) { return __builtin_bit_cast(float, w & 0xffff0000u); }
typedef __bf16 bf16x2_t __attribute__((ext_vector_type(2)));
__device__ __forceinline__ unsigned cvt_pk_bf16(float lo, float hi) { const bf16x2_t v = {(__bf16)lo, (__bf16)hi}; return __builtin_bit_cast(unsigned, v); }
__device__ __forceinline__ float sigm_f(float x) { return __builtin_amdgcn_rcpf(1.0f + __expf(-x)); }
__device__ __forceinline__ float silu_f(float x) { return x * __builtin_amdgcn_rcpf(1.0f + __expf(-x)); }
__device__ __forceinline__ float wave_sum(float v) {
#pragma unroll
    for (int o = 1; o < 64; o <<= 1) v += __shfl_xor(v, o);
    return v;
}

struct Frame {
    LAS unsigned char* lds;
    volatile LAS unsigned* MISC;
    gu32* ctl;
    int tid, lane, wave, vcu, G;
    unsigned char* ws;
    float* out;
    const float* in[30];
};
enum { I_XP = 0, I_XS, I_SSM, I_CONV, I_POOL, I_PP, I_PS, I_NFFN1, I_WGU1, I_WD1, I_NMIX, I_WIN, I_CONVW, I_CONVB, I_DTB, I_ALOG, I_DSKIP, I_NSSD, I_WSSO, I_WPGRP, I_PSCALE,
       I_WPOUT, I_WO, I_NFFN2, I_WGU2, I_WD2, I_NPLE, I_WPG, I_WPLE, I_NFINAL };

namespace pg8 {
constexpr int BM = 256, BK = 64, HALF = 128, HTB = HALF * BK * 2, STAGE_BYTES = 8 * HTB, NXCD = 8, WGM = 4;
__host__ __device__ __forceinline__ int lds_byte(int r, int c) { const int st = (r >> 4) * 2 + (c >> 5), rr = r & 15, cc = c & 31, ob = rr * 64 + cc * 2; return st * 1024 + (ob ^ (((ob >> 9) & 1) << 5)); }
__host__ __device__ __forceinline__ void stage_rc(int b, int& R, int& C) { const int st = b / 1024, sb = b % 1024, swz = sb ^ (((sb >> 9) & 1) << 5); R = (st >> 1) * 16 + swz / 64; C = (st & 1) * 32 + (swz % 64) / 2; }
__host__ __device__ __forceinline__ int perm32(int rho) { const int n = rho >> 4, i = rho & 15; return 8 * (i >> 2) + 4 * n + (i & 3); }
struct Unit { int pm, pn; };
struct Gemm { const bf16_t* A; const bf16_t* Bt; int M, N, K; int lda; int a_pn_step; };
struct StaticOrder {
    int nM, nN, nwg, G, c;
    __host__ __device__ void init(int M_, int N_, int G_, int c_) { nM = M_ / BM; nN = N_ / BM; nwg = nM * nN; G = G_; c = c_; }
    __host__ __device__ void init_tail(int M_, int N_, int G_, int c_) { init(M_, N_, G_, (G_ - 1) - c_); }
    __host__ __device__ bool next(int i, Unit& u) const {
        const long L = (long)i * G + c; if (L >= nwg) return false;
        int wgid = (int)L; { const int q = nwg / NXCD, r = nwg % NXCD, xcd = wgid % NXCD, off = wgid / NXCD; wgid = (xcd < r ? xcd * (q + 1) : r * (q + 1) + (xcd - r) * q) + off; }
        const int nig = WGM * nN, gid = wgid / nig, fm = gid * WGM, gsz = (nM - fm) < WGM ? (nM - fm) : WGM;
        u.pm = fm + ((wgid % nig) % gsz); u.pn = (wgid % nig) / gsz; return true;
    }
};

enum EpiKind { EK_GU = 1, EK_RES = 2, EK_WIN = 3, EK_T1 = 4, EK_MERGE = 5, EK_BF16 = 6, EK_PLE = 7 };
struct Epi {
    const float* stats_in;
    float* stats_out;
    bf16_t* obf;
    float* of32;
    const float* res_p; const float* res_s;
    const bf16_t* res_bf;
    const bf16_t* gates;
    const bf16_t* q;
    bf16_t *Z, *XBC, *V, *GATES, *HALO; float* DT; const float* dt_bias; float *conv_p, *conv_s, *pool_p, *pool_s;
    int kind; int ldo; float coef; int pad;
};

__device__ __forceinline__ u32x4 pack8(const f32x4 a, const f32x4 b) { u32x4 w; w.x = cvt_pk_bf16(a[0], a[1]); w.y = cvt_pk_bf16(a[2], a[3]); w.z = cvt_pk_bf16(b[0], b[1]); w.w = cvt_pk_bf16(b[2], b[3]); return w; }
__device__ __forceinline__ void unpack8(const u32x4 w, f32x4& a, f32x4& b) { a = (f32x4){bflo(w.x), bfhi(w.x), bflo(w.y), bfhi(w.y)}; b = (f32x4){bflo(w.z), bfhi(w.z), bflo(w.w), bfhi(w.w)}; }

__device__ __forceinline__ float row_rs(const float* stats, int row) {
    if (!stats) return 1.0f;
    const GAS f32x4* sp = (const GAS f32x4*)(stats + (size_t)row * 16);
    const f32x4 a = sp[0], b = sp[1], c = sp[2], d = sp[3]; const f32x4 s = (a + b) + (c + d);
    return __builtin_amdgcn_rsqf(((s[0] + s[1]) + (s[2] + s[3])) * (1.0f / 1024.0f) + EPS);
}
__device__ __forceinline__ float softplus_f(float x) { const float e = __expf(-fabsf(x)); const float l = (e < 0.01f) ? e * (1.0f - e * (0.5f - e * (1.0f / 3.0f))) : __logf(1.0f + e); return fmaxf(x, 0.f) + l; }

__device__ __forceinline__ void epilogue(const Epi& E, const f32x4 (&acc)[2][2][4][2], const Unit& u, int wr, int wc, int fr, int fq) {
    const int rowb = u.pm * BM + wr * 64 + fr;
    const int cin = wc * 32 + 8 * fq;
    if (E.kind == EK_GU) {
#pragma unroll
        for (int ai = 0; ai < 2; ++ai)
#pragma unroll
            for (int m = 0; m < 4; ++m) { const int row = rowb + ai * HALF + m * 16; const float r = row_rs(E.stats_in, row);
                const f32x4 g0 = acc[ai][0][m][0] * r, u0 = acc[ai][1][m][0] * r, g1 = acc[ai][0][m][1] * r, u1 = acc[ai][1][m][1] * r;
                const f32x4 o0 = (f32x4){silu_f(g0[0]) * u0[0], silu_f(g0[1]) * u0[1], silu_f(g0[2]) * u0[2], silu_f(g0[3]) * u0[3]};
                const f32x4 o1 = (f32x4){silu_f(g1[0]) * u1[0], silu_f(g1[1]) * u1[1], silu_f(g1[2]) * u1[2], silu_f(g1[3]) * u1[3]};
                *(GAS u32x4*)(E.obf + (size_t)row * E.ldo + u.pn * HALF + cin) = pack8(o0, o1); }
    } else if (E.kind == EK_RES) {
#pragma unroll
        for (int ai = 0; ai < 2; ++ai)
#pragma unroll
            for (int m = 0; m < 4; ++m) { const int row = rowb + ai * HALF + m * 16;
                float ss = 0.f;
#pragma unroll
                for (int bj = 0; bj < 2; ++bj) { const int col = u.pn * BM + bj * HALF + cin;
                    f32x4 r0, r1;
                    if (E.res_p) { const float* rp = (row < MP) ? E.res_p + (size_t)row * DM : E.res_s + (size_t)(row - MP) * DM; r0 = *(const GAS f32x4*)(rp + col); r1 = *(const GAS f32x4*)(rp + col + 4); }
                    else unpack8(*(const GAS u32x4*)(E.res_bf + (size_t)row * DM + col), r0, r1);
                    const f32x4 h0 = r0 + acc[ai][bj][m][0] * E.coef, h1 = r1 + acc[ai][bj][m][1] * E.coef;
                    *(GAS u32x4*)(E.obf + (size_t)row * DM + col) = pack8(h0, h1);
                    ss += (h0[0] * h0[0] + h0[1] * h0[1]) + (h0[2] * h0[2] + h0[3] * h0[3]) + (h1[0] * h1[0] + h1[1] * h1[1]) + (h1[2] * h1[2] + h1[3] * h1[3]); }
                ss += __shfl_xor(ss, 16); ss += __shfl_xor(ss, 32);
                if (fq == 0) *(GAS float*)(E.stats_out + (size_t)row * 16 + u.pn * 4 + wc) = ss; }
    } else if (E.kind == EK_WIN) {
        const int pn = u.pn;
        if (pn < 8) {
            const int colt = pn * BM + cin;
#pragma unroll
            for (int ai = 0; ai < 2; ++ai)
#pragma unroll
                for (int m = 0; m < 4; ++m) { const int row = rowb + ai * HALF + m * 16; const float r = row_rs(E.stats_in, row);
#pragma unroll
                    for (int bj = 0; bj < 2; ++bj) { f32x4 v0 = acc[ai][bj][m][0] * r, v1 = acc[ai][bj][m][1] * r;
#pragma unroll
                        for (int j = 0; j < 4; ++j) { v0[j] = silu_f(v0[j]); v1[j] = silu_f(v1[j]); }
                        *(GAS u32x4*)(E.Z + (size_t)row * DI + colt + bj * HALF) = pack8(v0, v1); } }
        } else if (pn >= 28 && pn < 36) {
            const int colt = (pn - 28) * BM + cin;
#pragma unroll
            for (int ai = 0; ai < 2; ++ai)
#pragma unroll
                for (int m = 0; m < 4; ++m) { const int row = rowb + ai * HALF + m * 16; const float r = row_rs(E.stats_in, row);
#pragma unroll
                    for (int bj = 0; bj < 2; ++bj) { f32x4 v0 = acc[ai][bj][m][0] * r, v1 = acc[ai][bj][m][1] * r;
#pragma unroll
                        for (int j = 0; j < 4; ++j) { v0[j] = sigm_f(v0[j]); v1[j] = sigm_f(v1[j]); }
                        *(GAS u32x4*)(E.GATES + (size_t)row * (2 * DM) + colt + bj * HALF) = pack8(v0, v1); } }
        } else if (pn < 28) {
            const bool isx = pn < 24; bf16_t* const O = isx ? E.XBC : E.V; const int ldo = isx ? CD : PD; const int colt = (isx ? pn - 8 : pn - 24) * BM + cin;
            const int keep = isx ? 3 : PBUF;
#pragma unroll
            for (int ai = 0; ai < 2; ++ai)
#pragma unroll
                for (int m = 0; m < 4; ++m) { const int row = rowb + ai * HALF + m * 16; const float r = row_rs(E.stats_in, row);
                    float* sp = nullptr;
                    if (row < MP) { const int sb = row >> 11, st = row & (SEQ - 1); if (st >= SEQ - keep) sp = (isx ? E.conv_p : E.pool_p) + ((size_t)sb * keep + (st - (SEQ - keep))) * ldo + colt; }
                    else { const int sb = (row - MP) >> 3, st = (row - MP) & 7; const int si = st - (DECS - keep); if (si >= 0) sp = (isx ? E.conv_s : E.pool_s) + ((size_t)sb * keep + si) * ldo + colt; }
                    bf16_t* hp = nullptr;
                    if (isx && row < MP) { const int st = row & (SEQ - 1), tm = st & 127; if (tm >= 125 && st < SEQ - 3) hp = E.HALO + ((((size_t)(row >> 11) * 16 + (st >> 7) + 1) * 3 + (tm - 125)) * CD) + colt; }
#pragma unroll
                    for (int bj = 0; bj < 2; ++bj) { const f32x4 v0 = acc[ai][bj][m][0] * r, v1 = acc[ai][bj][m][1] * r;
                        const u32x4 pk = pack8(v0, v1);
                        *(GAS u32x4*)(O + (size_t)row * ldo + colt + bj * HALF) = pk;
                        if (hp) *(GAS u32x4*)(hp + bj * HALF) = pk;
                        if (sp) { *(GAS f32x4*)(sp + bj * HALF) = v0; *(GAS f32x4*)(sp + bj * HALF + 4) = v1; } } }
        } else if (wc == 0) {
            const f32x4 b0 = *(const GAS f32x4*)(E.dt_bias + 8 * fq), b1 = *(const GAS f32x4*)(E.dt_bias + 8 * fq + 4);
#pragma unroll
            for (int ai = 0; ai < 2; ++ai)
#pragma unroll
                for (int m = 0; m < 4; ++m) { const int row = rowb + ai * HALF + m * 16; const float r = row_rs(E.stats_in, row);
                    f32x4 v0 = acc[ai][0][m][0] * r + b0, v1 = acc[ai][0][m][1] * r + b1;
#pragma unroll
                    for (int j = 0; j < 4; ++j) { v0[j] = softplus_f(v0[j]); v1[j] = softplus_f(v1[j]); }
                    *(GAS f32x4*)(E.DT + (size_t)row * 32 + 8 * fq) = v0; *(GAS f32x4*)(E.DT + (size_t)row * 32 + 8 * fq + 4) = v1; }
        }
    } else if (E.kind == EK_T1) {
#pragma unroll
        for (int ai = 0; ai < 2; ++ai)
#pragma unroll
            for (int m = 0; m < 4; ++m) { const int row = rowb + ai * HALF + m * 16;
#pragma unroll
                for (int bj = 0; bj < 2; ++bj) { const int col = u.pn * BM + bj * HALF + cin;
                    f32x4 g0, g1; unpack8(*(const GAS u32x4*)(E.gates + (size_t)row * (2 * DM) + col), g0, g1);
                    *(GAS u32x4*)(E.obf + (size_t)row * DM + col) = pack8(g0 * acc[ai][bj][m][0], g1 * acc[ai][bj][m][1]); } }
    } else if (E.kind == EK_MERGE) {
#pragma unroll
        for (int ai = 0; ai < 2; ++ai)
#pragma unroll
            for (int m = 0; m < 4; ++m) { const int row = rowb + ai * HALF + m * 16;
#pragma unroll
                for (int bj = 0; bj < 2; ++bj) { const int col = u.pn * BM + bj * HALF + cin;
                    f32x4 g0, g1; unpack8(*(const GAS u32x4*)(E.gates + (size_t)row * (2 * DM) + DM + col), g0, g1);
                    f32x4 t0, t1; unpack8(*(const GAS u32x4*)(E.res_bf + (size_t)row * DM + col), t0, t1);
                    *(GAS u32x4*)(E.obf + (size_t)row * DM + col) = pack8(t0 + g0 * acc[ai][bj][m][0], t1 + g1 * acc[ai][bj][m][1]); } }
    } else if (E.kind == EK_BF16) {
#pragma unroll
        for (int ai = 0; ai < 2; ++ai)
#pragma unroll
            for (int m = 0; m < 4; ++m) { const int row = rowb + ai * HALF + m * 16;
#pragma unroll
                for (int bj = 0; bj < 2; ++bj) { const int col = u.pn * BM + bj * HALF + cin;
                    *(GAS u32x4*)(E.obf + (size_t)row * E.ldo + col) = pack8(acc[ai][bj][m][0], acc[ai][bj][m][1]); } }
    } else if (E.kind == EK_PLE) {
#pragma unroll
        for (int ai = 0; ai < 2; ++ai)
#pragma unroll
            for (int m = 0; m < 4; ++m) { const int row = rowb + ai * HALF + m * 16; const float r = row_rs(E.stats_in, row);
                float ss = 0.f;
#pragma unroll
                for (int bj = 0; bj < 2; ++bj) { const int col = u.pn * BM + bj * HALF + cin;
                    f32x4 q0, q1; unpack8(*(const GAS u32x4*)(E.q + (size_t)row * DM + col), q0, q1);
                    f32x4 r0, r1; unpack8(*(const GAS u32x4*)(E.res_bf + (size_t)row * DM + col), r0, r1);
                    f32x4 h0, h1;
#pragma unroll
                    for (int j = 0; j < 4; ++j) { h0[j] = r0[j] + sigm_f(acc[ai][bj][m][0][j] * r) * q0[j]; h1[j] = r1[j] + sigm_f(acc[ai][bj][m][1][j] * r) * q1[j]; }
                    *(GAS f32x4*)(E.of32 + (size_t)row * DM + col) = h0; *(GAS f32x4*)(E.of32 + (size_t)row * DM + col + 4) = h1;
                    ss += (h0[0] * h0[0] + h0[1] * h0[1]) + (h0[2] * h0[2] + h0[3] * h0[3]) + (h1[0] * h1[0] + h1[1] * h1[1]) + (h1[2] * h1[2] + h1[3] * h1[3]); }
                ss += __shfl_xor(ss, 16); ss += __shfl_xor(ss, 32);
                if (fq == 0) *(GAS float*)(E.stats_out + (size_t)row * 16 + u.pn * 4 + wc) = ss; }
    }
}


__device__ __forceinline__ void epi_seg(const Epi& E, int row, int col, f32x4 v0, f32x4 v1, int lane) {
    if (E.kind == EK_RES) {
        f32x4 r0, r1;
        if (E.res_p) { const float* rp = ((row < MP) ? E.res_p + (size_t)row * DM : E.res_s + (size_t)(row - MP) * DM) + col; r0 = *(const GAS f32x4*)rp; r1 = *(const GAS f32x4*)(rp + 4); }
        else unpack8(*(const GAS u32x4*)(E.res_bf + (size_t)row * DM + col), r0, r1);
        const f32x4 h0 = r0 + v0 * E.coef, h1 = r1 + v1 * E.coef;
        *(GAS u32x4*)(E.obf + (size_t)row * DM + col) = pack8(h0, h1);
        float ss = (h0[0] * h0[0] + h0[1] * h0[1]) + (h0[2] * h0[2] + h0[3] * h0[3]) + (h1[0] * h1[0] + h1[1] * h1[1]) + (h1[2] * h1[2] + h1[3] * h1[3]);
        ss += __shfl_xor(ss, 1); ss += __shfl_xor(ss, 2); ss += __shfl_xor(ss, 4);
        if ((lane & 7) == 0) *(GAS float*)(E.stats_out + (size_t)row * 16 + (col >> 6)) = ss;
    } else if (E.kind == EK_T1) {
        f32x4 g0, g1; unpack8(*(const GAS u32x4*)(E.gates + (size_t)row * (2 * DM) + col), g0, g1);
        *(GAS u32x4*)(E.obf + (size_t)row * DM + col) = pack8(g0 * v0, g1 * v1);
    } else if (E.kind == EK_MERGE) {
        f32x4 g0, g1; unpack8(*(const GAS u32x4*)(E.gates + (size_t)row * (2 * DM) + DM + col), g0, g1);
        f32x4 t0, t1; unpack8(*(const GAS u32x4*)(E.res_bf + (size_t)row * DM + col), t0, t1);
        *(GAS u32x4*)(E.obf + (size_t)row * DM + col) = pack8(t0 + g0 * v0, t1 + g1 * v1);
    } else if (E.kind == EK_BF16) {
        *(GAS u32x4*)(E.obf + (size_t)row * E.ldo + col) = pack8(v0, v1);
    } else if (E.kind == EK_PLE) {
        const float r = row_rs(E.stats_in, row);
        f32x4 q0, q1; unpack8(*(const GAS u32x4*)(E.q + (size_t)row * DM + col), q0, q1);
        f32x4 r0, r1; unpack8(*(const GAS u32x4*)(E.res_bf + (size_t)row * DM + col), r0, r1);
        f32x4 h0, h1;
#pragma unroll
        for (int j = 0; j < 4; ++j) { h0[j] = r0[j] + sigm_f(v0[j] * r) * q0[j]; h1[j] = r1[j] + sigm_f(v1[j] * r) * q1[j]; }
        *(GAS f32x4*)(E.of32 + (size_t)row * DM + col) = h0; *(GAS f32x4*)(E.of32 + (size_t)row * DM + col + 4) = h1;
        float ss = (h0[0] * h0[0] + h0[1] * h0[1]) + (h0[2] * h0[2] + h0[3] * h0[3]) + (h1[0] * h1[0] + h1[1] * h1[1]) + (h1[2] * h1[2] + h1[3] * h1[3]);
        ss += __shfl_xor(ss, 1); ss += __shfl_xor(ss, 2); ss += __shfl_xor(ss, 4);
        if ((lane & 7) == 0) *(GAS float*)(E.stats_out + (size_t)row * 16 + (col >> 6)) = ss;
    }
}
__device__ __forceinline__ void small_tile_sum(LAS unsigned char* lds, const bf16_t* A, int lda, const bf16_t* Bt, int K, int r0, int c0, f32x4& v0, f32x4& v1) {
    const int tid = threadIdx.x, wid = __builtin_amdgcn_readfirstlane(tid >> 6), lane = tid & 63, ql = lane & 15, gq = lane >> 4;
    f32x4 acc[4][4];
#pragma unroll
    for (int m = 0; m < 4; ++m)
#pragma unroll
        for (int n = 0; n < 4; ++n) acc[m][n] = (f32x4){0.f, 0.f, 0.f, 0.f};
    const bf16_t* const ap = A + (size_t)(r0 + ql) * lda + 8 * gq + 32 * wid;
    const bf16_t* const bp = Bt + (size_t)(c0 + ql) * K + 8 * gq + 32 * wid;
    const int nst = (K / 32 - wid + 7) / 8;
    bf16x8 af[4][4], bf[4][4];
#pragma unroll
    for (int u = 0; u < 4; ++u) if (u < nst) {
#pragma unroll
        for (int m = 0; m < 4; ++m) { af[u][m] = *(const GAS bf16x8*)(ap + (size_t)(16 * m) * lda + 256 * u); bf[u][m] = *(const GAS bf16x8*)(bp + (size_t)(16 * m) * K + 256 * u); } }
    for (int i = 0; i < nst; i += 4) {
#pragma unroll
        for (int u = 0; u < 4; ++u) if (i + u < nst) {
#pragma unroll
            for (int m = 0; m < 4; ++m)
#pragma unroll
                for (int n = 0; n < 4; ++n) acc[m][n] = __builtin_amdgcn_mfma_f32_16x16x32_bf16(bf[u][n], af[u][m], acc[m][n], 0, 0, 0);
            if (i + u + 4 < nst) {
#pragma unroll
                for (int m = 0; m < 4; ++m) { af[u][m] = *(const GAS bf16x8*)(ap + (size_t)(16 * m) * lda + 256 * (i + u + 4)); bf[u][m] = *(const GAS bf16x8*)(bp + (size_t)(16 * m) * K + 256 * (i + u + 4)); } }
        }
    }
    LAS f32x4* const slab = (LAS f32x4*)(lds + wid * 16384);
#pragma unroll
    for (int m = 0; m < 4; ++m)
#pragma unroll
        for (int n = 0; n < 4; ++n) slab[(16 * m + ql) * 16 + ((4 * n + gq) ^ ql)] = acc[m][n];
    __syncthreads();
    const int rr = 8 * wid + (lane >> 3), ch0 = 2 * (lane & 7);
    v0 = (f32x4){0.f, 0.f, 0.f, 0.f}; v1 = v0;
#pragma unroll
    for (int s8 = 0; s8 < 8; ++s8) { const LAS f32x4* sl = (const LAS f32x4*)(lds + s8 * 16384) + rr * 16; v0 += sl[ch0 ^ (rr & 15)]; v1 += sl[(ch0 + 1) ^ (rr & 15)]; }
    __syncthreads();
}
__device__ __forceinline__ void gemm_small(LAS unsigned char* lds, const Gemm g, const Epi& E, int row_base, int nrows, int G, int c) {
    const int tid = threadIdx.x, wid = __builtin_amdgcn_readfirstlane(tid >> 6), lane = tid & 63;
    const int ntn = g.N / 64, ntiles = (nrows / 64) * ntn;
    for (int v = c; v < ntiles; v += G) {
        const int r0 = row_base + 64 * (v / ntn), c0 = 64 * (v % ntn);
        f32x4 v0, v1; small_tile_sum(lds, g.A, g.lda, g.Bt, g.K, r0, c0, v0, v1);
        epi_seg(E, r0 + 8 * wid + (lane >> 3), c0 + 8 * (lane & 7), v0, v1, lane);
    }
}
struct Gemm2 { const bf16_t* A1; const bf16_t* B1; const bf16_t* A2; const bf16_t* B2; int K1, lda1, K2, lda2, N; };
__device__ __forceinline__ void gemm_small2(LAS unsigned char* lds, const Gemm2 g, const bf16_t* gates, bf16_t* out, int row_base, int nrows, int G, int c) {
    const int tid = threadIdx.x, wid = __builtin_amdgcn_readfirstlane(tid >> 6), lane = tid & 63;
    const int ntn = g.N / 64, ntiles = (nrows / 64) * ntn;
    for (int v = c; v < ntiles; v += G) {
        const int r0 = row_base + 64 * (v / ntn), c0 = 64 * (v % ntn), row = r0 + 8 * wid + (lane >> 3), col = c0 + 8 * (lane & 7);
        f32x4 a0, a1, b0, b1;
        small_tile_sum(lds, g.A1, g.lda1, g.B1, g.K1, r0, c0, a0, a1);
        small_tile_sum(lds, g.A2, g.lda2, g.B2, g.K2, r0, c0, b0, b1);
        f32x4 g00, g01, g10, g11; unpack8(*(const GAS u32x4*)(gates + (size_t)row * (2 * DM) + col), g00, g01); unpack8(*(const GAS u32x4*)(gates + (size_t)row * (2 * DM) + DM + col), g10, g11);
        *(GAS u32x4*)(out + (size_t)row * DM + col) = pack8(g00 * a0 + g10 * b0, g01 * a1 + g11 * b1);
    }
}

__device__ __forceinline__ void gemm_phase(LAS unsigned char* lds, const Gemm g, const StaticOrder& S, const Epi& E) {
    const int tid = threadIdx.x, wid = __builtin_amdgcn_readfirstlane(tid >> 6), lane = tid & 63, wr = wid >> 2, wc = wid & 3, fr = lane & 15, fq = lane >> 4;
    const int K = g.K, nt = K / BK;
    unsigned voffA[2], voffB[2];
#pragma unroll
    for (int i = 0; i < 2; ++i) { int R, C; stage_rc(tid * 16 + i * 8192, R, C); const int Rb = (R & ~31) + perm32(R & 31);
        voffA[i] = (unsigned)(R * g.lda + C) * 2u; voffB[i] = (unsigned)(Rb * K + C) * 2u; }
    const size_t kstep = (size_t)(BK * 2);
    const size_t hstep = (size_t)HALF * K * 2, hstepA = (size_t)HALF * g.lda * 2;
    const size_t tstep = 2 * hstep, tstepA = 2 * hstepA, pnstepA = (size_t)g.a_pn_step * 2;
    const unsigned ldsw = (unsigned)wid * 1024u;
    const int aoff = lds_byte(wr * 64 + fr, fq * 8), boff = lds_byte(wc * 32 + fr, fq * 8);
#define PG8_SA(b, h) (((b) * 2 + (h)) * HTB)
#define PG8_SB(b, h) ((4 + (b) * 2 + (h)) * HTB)
#define PG8_STAGE(bufoff, gbase, voff) do { _Pragma("unroll") for (int _i = 0; _i < 2; ++_i) \
        __builtin_amdgcn_global_load_lds((const unsigned*)((const char*)(gbase) + (voff)[_i]), (LAS unsigned*)(lds + (bufoff) + ldsw + _i * 8192), 16, 0, 0); } while (0)
#define PG8_LDA(dst, b, h) do { _Pragma("unroll") for (int m = 0; m < 4; ++m) _Pragma("unroll") for (int k = 0; k < 2; ++k) dst[m][k] = *(const LAS bf16x8*)(lds + PG8_SA(b, h) + aoff + m * 2048 + k * 1024); } while (0)
#define PG8_LDB(dst, b, h) do { _Pragma("unroll") for (int n = 0; n < 2; ++n) _Pragma("unroll") for (int k = 0; k < 2; ++k) dst[n][k] = *(const LAS bf16x8*)(lds + PG8_SB(b, h) + boff + n * 2048 + k * 1024); } while (0)
#define PG8_MMA(ai, bj, At, Bt) do { __builtin_amdgcn_s_setprio(1); _Pragma("unroll") for (int m = 0; m < 4; ++m) _Pragma("unroll") for (int n = 0; n < 2; ++n) _Pragma("unroll") for (int k = 0; k < 2; ++k) \
        acc[ai][bj][m][n] = __builtin_amdgcn_mfma_f32_16x16x32_bf16(Bt[n][k], At[m][k], acc[ai][bj][m][n], 0, 0, 0); __builtin_amdgcn_s_setprio(0); } while (0)
#define PG8_WAIT_V(n) asm volatile("s_waitcnt vmcnt(" #n ")" ::: "memory")
#define PG8_WAIT_L(n) asm volatile("s_waitcnt lgkmcnt(" #n ")" ::: "memory")
#define PG8_BAR __builtin_amdgcn_s_barrier()
#define PG8_SCHED __builtin_amdgcn_sched_barrier(0)
    Unit cur, nxt; int ui = 0;
    if (!S.next(0, cur)) return;
    f32x4 acc[2][2][4][2];
#pragma unroll
    for (int a = 0; a < 2; ++a)
#pragma unroll
        for (int b = 0; b < 2; ++b)
#pragma unroll
            for (int m = 0; m < 4; ++m)
#pragma unroll
                for (int n = 0; n < 2; ++n) acc[a][b][m][n] = (f32x4){0.f, 0.f, 0.f, 0.f};
    bf16x8 At[4][2], B0[2][2], B1[2][2];
    const char* cA = (const char*)g.A + (size_t)cur.pm * tstepA + (size_t)cur.pn * pnstepA; const char* cB = (const char*)g.Bt + (size_t)cur.pn * tstep;
    PG8_STAGE(PG8_SB(0, 0), cB, voffB); PG8_STAGE(PG8_SB(0, 1), cB + hstep, voffB); PG8_STAGE(PG8_SA(0, 0), cA, voffA); PG8_STAGE(PG8_SA(0, 1), cA + hstepA, voffA);
    if (wr == 1) PG8_BAR;
    PG8_WAIT_V(2); PG8_BAR;
    PG8_STAGE(PG8_SB(1, 0), cB + kstep, voffB); PG8_STAGE(PG8_SA(1, 0), cA + kstep, voffA); PG8_STAGE(PG8_SB(1, 1), cB + hstep + kstep, voffB);
    PG8_WAIT_V(6); PG8_BAR;
    for (;;) {
        const bool has_next = S.next(ui + 1, nxt);
        const char* nA = has_next ? (const char*)g.A + (size_t)nxt.pm * tstepA + (size_t)nxt.pn * pnstepA : cA; const char* nB = has_next ? (const char*)g.Bt + (size_t)nxt.pn * tstep : cB;
        for (int t = 0; t < nt; t += 2) {
            const bool last = (t == nt - 2);
            const char* a1 = cA + (size_t)(t + 1) * kstep;
            const char* a2 = last ? nA : cA + (size_t)(t + 2) * kstep; const char* b2 = last ? nB : cB + (size_t)(t + 2) * kstep;
            const char* a3 = a2 + kstep; const char* b3 = b2 + kstep;
            PG8_LDB(B0, 0, 0); PG8_LDB(B1, 0, 1); PG8_SCHED; PG8_LDA(At, 0, 0); PG8_STAGE(PG8_SA(1, 1), a1 + hstepA, voffA);
            PG8_WAIT_V(8); PG8_WAIT_L(0); PG8_BAR; PG8_MMA(0, 0, At, B0); PG8_MMA(0, 1, At, B1); PG8_BAR; PG8_SCHED;
            PG8_LDA(At, 0, 1); PG8_STAGE(PG8_SB(0, 0), b2, voffB); PG8_STAGE(PG8_SB(0, 1), b2 + hstep, voffB); PG8_STAGE(PG8_SA(0, 0), a2, voffA);
            PG8_WAIT_V(8); PG8_WAIT_L(0); PG8_BAR; PG8_MMA(1, 0, At, B0); PG8_MMA(1, 1, At, B1); PG8_BAR; PG8_SCHED;
            PG8_LDB(B0, 1, 0); PG8_LDB(B1, 1, 1); PG8_SCHED; PG8_LDA(At, 1, 0); PG8_STAGE(PG8_SA(0, 1), a2 + hstepA, voffA);
            PG8_WAIT_V(8); PG8_WAIT_L(0); PG8_BAR; PG8_MMA(0, 0, At, B0); PG8_MMA(0, 1, At, B1); PG8_BAR; PG8_SCHED;
            PG8_LDA(At, 1, 1); PG8_STAGE(PG8_SB(1, 0), b3, voffB); PG8_STAGE(PG8_SB(1, 1), b3 + hstep, voffB); PG8_STAGE(PG8_SA(1, 0), a3, voffA);
            PG8_WAIT_V(8); PG8_WAIT_L(0); PG8_BAR; PG8_MMA(1, 0, At, B0); PG8_MMA(1, 1, At, B1); PG8_BAR; PG8_SCHED;
        }
        if (wr == 0) PG8_BAR;
        epilogue(E, acc, cur, wr, wc, fr, fq);
        if (!has_next) break;
#pragma unroll
        for (int a = 0; a < 2; ++a)
#pragma unroll
            for (int b = 0; b < 2; ++b)
#pragma unroll
                for (int m = 0; m < 4; ++m)
#pragma unroll
                    for (int n = 0; n < 2; ++n) acc[a][b][m][n] = (f32x4){0.f, 0.f, 0.f, 0.f};
        cur = nxt; cA = nA; cB = nB; ++ui;
        if (wr == 1) PG8_BAR;
    }
    PG8_WAIT_V(0);
    PG8_BAR;
#undef PG8_SA
#undef PG8_SB
#undef PG8_STAGE
#undef PG8_LDA
#undef PG8_LDB
#undef PG8_MMA
#undef PG8_WAIT_V
#undef PG8_WAIT_L
#undef PG8_BAR
#undef PG8_SCHED
}

__device__ __forceinline__ void gemm_phase2(LAS unsigned char* lds, const Gemm2 g, const StaticOrder& S, const bf16_t* gates, bf16_t* out) {
    const int tid = threadIdx.x, wid = __builtin_amdgcn_readfirstlane(tid >> 6), lane = tid & 63, wr = wid >> 2, wc = wid & 3, fr = lane & 15, fq = lane >> 4;
    const int nt1 = g.K1 / BK, nt = nt1 + g.K2 / BK;
    int sR[2], sRb[2], sC[2];
#pragma unroll
    for (int i = 0; i < 2; ++i) { int R, C; stage_rc(tid * 16 + i * 8192, R, C); sR[i] = R; sRb[i] = (R & ~31) + perm32(R & 31); sC[i] = C; }
    const size_t kstep = (size_t)(BK * 2);
    const size_t hB1 = (size_t)HALF * g.K1 * 2, hA1 = (size_t)HALF * g.lda1 * 2, hB2 = (size_t)HALF * g.K2 * 2, hA2 = (size_t)HALF * g.lda2 * 2;
    const unsigned ldsw = (unsigned)wid * 1024u;
    const int aoff = lds_byte(wr * 64 + fr, fq * 8), boff = lds_byte(wc * 32 + fr, fq * 8);
#define PG8_SA(b, h) (((b) * 2 + (h)) * HTB)
#define PG8_SB(b, h) ((4 + (b) * 2 + (h)) * HTB)
#define PG8_STAGE_T(bufoff, isA, h, T) do { const int T_ = (T); const bool nx_ = T_ >= nt; const int Tl_ = nx_ ? T_ - nt : T_; const bool s2_ = !nx_ && Tl_ >= nt1; \
        const char* base_ = (isA) ? (s2_ ? cA2 + (size_t)(Tl_ - nt1) * kstep + (h) * hA2 : (nx_ ? nA1 : cA1) + (size_t)Tl_ * kstep + (h) * hA1) \
                                  : (s2_ ? cB2 + (size_t)(Tl_ - nt1) * kstep + (h) * hB2 : (nx_ ? nB1 : cB1) + (size_t)Tl_ * kstep + (h) * hB1); \
        const int ld_ = (isA) ? (s2_ ? g.lda2 : g.lda1) : (s2_ ? g.K2 : g.K1); \
        _Pragma("unroll") for (int _i = 0; _i < 2; ++_i) { const unsigned vo_ = (unsigned)(((isA) ? sR[_i] : sRb[_i]) * ld_ + sC[_i]) * 2u; \
            __builtin_amdgcn_global_load_lds((const unsigned*)(base_ + vo_), (LAS unsigned*)(lds + (bufoff) + ldsw + _i * 8192), 16, 0, 0); } } while (0)
#define PG8_LDA(dst, b, h) do { _Pragma("unroll") for (int m = 0; m < 4; ++m) _Pragma("unroll") for (int k = 0; k < 2; ++k) dst[m][k] = *(const LAS bf16x8*)(lds + PG8_SA(b, h) + aoff + m * 2048 + k * 1024); } while (0)
#define PG8_LDB(dst, b, h) do { _Pragma("unroll") for (int n = 0; n < 2; ++n) _Pragma("unroll") for (int k = 0; k < 2; ++k) dst[n][k] = *(const LAS bf16x8*)(lds + PG8_SB(b, h) + boff + n * 2048 + k * 1024); } while (0)
#define PG8_MMA(ai, bj, At, Bt) do { __builtin_amdgcn_s_setprio(1); _Pragma("unroll") for (int m = 0; m < 4; ++m) _Pragma("unroll") for (int n = 0; n < 2; ++n) _Pragma("unroll") for (int k = 0; k < 2; ++k) \
        acc[ai][bj][m][n] = __builtin_amdgcn_mfma_f32_16x16x32_bf16(Bt[n][k], At[m][k], acc[ai][bj][m][n], 0, 0, 0); __builtin_amdgcn_s_setprio(0); } while (0)
#define PG8_WAIT_V(n) asm volatile("s_waitcnt vmcnt(" #n ")" ::: "memory")
#define PG8_WAIT_L(n) asm volatile("s_waitcnt lgkmcnt(" #n ")" ::: "memory")
#define PG8_BAR __builtin_amdgcn_s_barrier()
#define PG8_SCHED __builtin_amdgcn_sched_barrier(0)
    Unit cur, nxt; int ui = 0;
    if (!S.next(0, cur)) return;
    f32x4 acc[2][2][4][2];
#pragma unroll
    for (int a = 0; a < 2; ++a)
#pragma unroll
        for (int b = 0; b < 2; ++b)
#pragma unroll
            for (int m = 0; m < 4; ++m)
#pragma unroll
                for (int n = 0; n < 2; ++n) acc[a][b][m][n] = (f32x4){0.f, 0.f, 0.f, 0.f};
    bf16x8 At[4][2], B0[2][2], B1[2][2];
    const char* cA1 = (const char*)g.A1 + (size_t)cur.pm * 2 * hA1; const char* cB1 = (const char*)g.B1 + (size_t)cur.pn * 2 * hB1;
    const char* cA2 = (const char*)g.A2 + (size_t)cur.pm * 2 * hA2; const char* cB2 = (const char*)g.B2 + (size_t)cur.pn * 2 * hB2;
    const char* nA1 = cA1; const char* nB1 = cB1;
    PG8_STAGE_T(PG8_SB(0, 0), false, 0, 0); PG8_STAGE_T(PG8_SB(0, 1), false, 1, 0); PG8_STAGE_T(PG8_SA(0, 0), true, 0, 0); PG8_STAGE_T(PG8_SA(0, 1), true, 1, 0);
    if (wr == 1) PG8_BAR;
    PG8_WAIT_V(2); PG8_BAR;
    PG8_STAGE_T(PG8_SB(1, 0), false, 0, 1); PG8_STAGE_T(PG8_SA(1, 0), true, 0, 1); PG8_STAGE_T(PG8_SB(1, 1), false, 1, 1);
    PG8_WAIT_V(6); PG8_BAR;
    for (;;) {
        const bool has_next = S.next(ui + 1, nxt);
        nA1 = has_next ? (const char*)g.A1 + (size_t)nxt.pm * 2 * hA1 : cA1; nB1 = has_next ? (const char*)g.B1 + (size_t)nxt.pn * 2 * hB1 : cB1;
        const int rowb = cur.pm * BM + wr * 64 + fr, colb = cur.pn * BM + wc * 32 + 8 * fq;
        for (int t = 0; t < nt; t += 2) {
            if (t == nt1) {
#pragma unroll
                for (int ai = 0; ai < 2; ++ai)
#pragma unroll
                    for (int m = 0; m < 4; ++m) { const bf16_t* gp = gates + (size_t)(rowb + ai * HALF + m * 16) * (2 * DM) + colb;
#pragma unroll
                        for (int bj = 0; bj < 2; ++bj) { f32x4 g00, g01, g10, g11; unpack8(*(const GAS u32x4*)(gp + bj * HALF), g00, g01); unpack8(*(const GAS u32x4*)(gp + DM + bj * HALF), g10, g11);
#pragma unroll
                            for (int j = 0; j < 4; ++j) { acc[ai][bj][m][0][j] *= g00[j] * __builtin_amdgcn_rcpf(fmaxf(g10[j], 1e-6f)); acc[ai][bj][m][1][j] *= g01[j] * __builtin_amdgcn_rcpf(fmaxf(g11[j], 1e-6f)); } } }
            }
            PG8_LDB(B0, 0, 0); PG8_LDB(B1, 0, 1); PG8_SCHED; PG8_LDA(At, 0, 0); PG8_STAGE_T(PG8_SA(1, 1), true, 1, t + 1);
            PG8_WAIT_V(8); PG8_WAIT_L(0); PG8_BAR; PG8_MMA(0, 0, At, B0); PG8_MMA(0, 1, At, B1); PG8_BAR; PG8_SCHED;
            PG8_LDA(At, 0, 1); PG8_STAGE_T(PG8_SB(0, 0), false, 0, t + 2); PG8_STAGE_T(PG8_SB(0, 1), false, 1, t + 2); PG8_STAGE_T(PG8_SA(0, 0), true, 0, t + 2);
            PG8_WAIT_V(8); PG8_WAIT_L(0); PG8_BAR; PG8_MMA(1, 0, At, B0); PG8_MMA(1, 1, At, B1); PG8_BAR; PG8_SCHED;
            PG8_LDB(B0, 1, 0); PG8_LDB(B1, 1, 1); PG8_SCHED; PG8_LDA(At, 1, 0); PG8_STAGE_T(PG8_SA(0, 1), true, 1, t + 2);
            PG8_WAIT_V(8); PG8_WAIT_L(0); PG8_BAR; PG8_MMA(0, 0, At, B0); PG8_MMA(0, 1, At, B1); PG8_BAR; PG8_SCHED;
            PG8_LDA(At, 1, 1); PG8_STAGE_T(PG8_SB(1, 0), false, 0, t + 3); PG8_STAGE_T(PG8_SB(1, 1), false, 1, t + 3); PG8_STAGE_T(PG8_SA(1, 0), true, 0, t + 3);
            PG8_WAIT_V(8); PG8_WAIT_L(0); PG8_BAR; PG8_MMA(1, 0, At, B0); PG8_MMA(1, 1, At, B1); PG8_BAR; PG8_SCHED;
        }
        if (wr == 0) PG8_BAR;
#pragma unroll
        for (int ai = 0; ai < 2; ++ai)
#pragma unroll
            for (int m = 0; m < 4; ++m) { const size_t row = (size_t)(rowb + ai * HALF + m * 16);
#pragma unroll
                for (int bj = 0; bj < 2; ++bj) { f32x4 g10, g11; unpack8(*(const GAS u32x4*)(gates + row * (2 * DM) + DM + colb + bj * HALF), g10, g11);
#pragma unroll
                    for (int j = 0; j < 4; ++j) { g10[j] = fmaxf(g10[j], 1e-6f); g11[j] = fmaxf(g11[j], 1e-6f); }
                    *(GAS u32x4*)(out + row * DM + colb + bj * HALF) = pack8(acc[ai][bj][m][0] * g10, acc[ai][bj][m][1] * g11); } }
        if (!has_next) break;
#pragma unroll
        for (int a = 0; a < 2; ++a)
#pragma unroll
            for (int b = 0; b < 2; ++b)
#pragma unroll
                for (int m = 0; m < 4; ++m)
#pragma unroll
                    for (int n = 0; n < 2; ++n) acc[a][b][m][n] = (f32x4){0.f, 0.f, 0.f, 0.f};
        cur = nxt; cA1 = nA1; cB1 = nB1; cA2 = (const char*)g.A2 + (size_t)cur.pm * 2 * hA2; cB2 = (const char*)g.B2 + (size_t)cur.pn * 2 * hB2; ++ui;
        if (wr == 1) PG8_BAR;
    }
    PG8_WAIT_V(0);
    PG8_BAR;
#undef PG8_SA
#undef PG8_SB
#undef PG8_STAGE_T
#undef PG8_LDA
#undef PG8_LDB
#undef PG8_MMA
#undef PG8_WAIT_V
#undef PG8_WAIT_L
#undef PG8_BAR
#undef PG8_SCHED
}
}

#define XB_TMO      128
#define XB_XCNT(j)  (256  + 64 * (j))
#define XB_XSUB(j)  (1280 + 64 * (j))
#define XB_XGEN(j)  (2304 + 64 * (j))
#define XB_TOP      3328
#define XB_TOPGEN   3392
#define XCD_BAR_WORDS 3456
#define XB_SPIN_CAP (1u << 18)
__device__ __forceinline__ unsigned xb_ld(unsigned* p)              { return __hip_atomic_load(p, __ATOMIC_RELAXED, __HIP_MEMORY_SCOPE_AGENT); }
__device__ __forceinline__ unsigned xb_add(unsigned* p, unsigned v) { return __hip_atomic_fetch_add(p, v, __ATOMIC_RELAXED, __HIP_MEMORY_SCOPE_AGENT); }
__device__ __forceinline__ unsigned xb_xcc_id() { return (unsigned)__builtin_amdgcn_s_getreg((3 << 11) | 20) & 0xFu; }
#define XB_SPIN(cond, bar) do { unsigned _sp = 0; while (cond) { __builtin_amdgcn_s_sleep(1); \
    if ((++_sp & 255u) == 0u) { if (xb_ld(&(bar)[XB_TMO])) break; if (_sp > XB_SPIN_CAP) { atomicAdd(&(bar)[XB_TMO], 1u); break; } } } } while (0)
struct XcdBarrier { unsigned* bar; unsigned x; volatile LAS unsigned* st; };
__device__ __forceinline__ XcdBarrier xcd_barrier_post(unsigned* bar, volatile LAS unsigned* st) {
    XcdBarrier b; b.bar = bar; b.x = xb_xcc_id(); b.st = st;
    if (threadIdx.x == 0) (void)xb_add(&bar[XB_XCNT(b.x)], 1u);
    return b;
}
__device__ __forceinline__ void xcd_barrier_complete(unsigned* bar, unsigned x, unsigned& nloc, unsigned& nx) {
    const unsigned G = gridDim.x * gridDim.y * gridDim.z;
    unsigned sum, cnt, mine, sp = 0u;
    for (;;) {
        sum = 0u; cnt = 0u; mine = 0u;
#pragma unroll
        for (unsigned j = 0; j < 16; ++j) { const unsigned c = xb_ld(&bar[XB_XCNT(j)]); sum += c; cnt += (c > 0u) ? 1u : 0u; mine = (j == x) ? c : mine; }
        if (sum == G) break;
        __builtin_amdgcn_s_sleep(1);
        if ((++sp & 255u) == 0u) { if (xb_ld(&bar[XB_TMO])) break; if (sp > XB_SPIN_CAP) { atomicAdd(&bar[XB_TMO], 1u); break; } }
    }
    nloc = mine > 0u ? mine : 1u; nx = cnt > 0u ? cnt : 1u;
}
__device__ __forceinline__ void xcd_barrier(const XcdBarrier& b) {
    asm volatile("s_waitcnt vmcnt(0)" ::: "memory");
    __syncthreads();
    if (threadIdx.x == 0) {
        unsigned* bar = b.bar;
        __builtin_amdgcn_s_waitcnt(0);
        unsigned nloc = b.st[0], nx = b.st[1];
        if (nloc == 0u) { xcd_barrier_complete(bar, b.x, nloc, nx); b.st[0] = nloc; b.st[1] = nx; }
        const unsigned old = xb_add(&bar[XB_XSUB(b.x)], 1u);
        const unsigned gen = old / nloc;
        if (old + 1u == (gen + 1u) * nloc) {
            __builtin_amdgcn_fence(__ATOMIC_RELEASE, "agent");
            asm volatile("s_waitcnt vmcnt(0)" ::: "memory");
            const unsigned og = xb_add(&bar[XB_TOP], 1u);
            const unsigned tg = og / nx;
            if (og + 1u == (tg + 1u) * nx) xb_add(&bar[XB_TOPGEN], 1u);
            else XB_SPIN(xb_ld(&bar[XB_TOPGEN]) == tg, bar);
            __builtin_amdgcn_fence(__ATOMIC_ACQUIRE, "agent");
            xb_add(&bar[XB_XGEN(b.x)], 1u);
            asm volatile("s_waitcnt vmcnt(0)" ::: "memory");
        } else {
            XB_SPIN(xb_ld(&bar[XB_XGEN(b.x)]) == gen, bar);
            __builtin_amdgcn_fence(__ATOMIC_ACQUIRE, "agent");
            asm volatile("s_waitcnt vmcnt(0)" ::: "memory");
        }
    }
    __syncthreads();
}

__device__ __forceinline__ void p0_transpose_item(const float* W, int K, int N, const float* gain, bf16_t* WT, int k0, int n0, int drow0, LAS float* scr, int lane) {
#pragma unroll
    for (int i = 0; i < 8; ++i) { const int kk = 8 * i + (lane >> 3), nn = 4 * (lane & 7);
        f32x4 v = *(const GAS f32x4*)(W + (size_t)(k0 + kk) * N + n0 + nn);
        if (gain) v = v * *(const GAS float*)(gain + k0 + kk);
        scr[kk * 33 + nn] = v.x; scr[kk * 33 + nn + 1] = v.y; scr[kk * 33 + nn + 2] = v.z; scr[kk * 33 + nn + 3] = v.w; }
    LDS_WAIT(); asm volatile("" ::: "memory");
    const int c = lane & 7;
#pragma unroll
    for (int j = 0; j < 4; ++j) { const int n = (lane >> 3) + 8 * j; const LAS float* s = scr + (8 * c) * 33 + n;
        u32x4 o; o.x = pk2(s[0 * 33], s[1 * 33]); o.y = pk2(s[2 * 33], s[3 * 33]); o.z = pk2(s[4 * 33], s[5 * 33]); o.w = pk2(s[6 * 33], s[7 * 33]);
        *(GAS u32x4*)(WT + (size_t)(drow0 + n) * K + k0 + 8 * c) = o; }
    LDS_WAIT(); asm volatile("" ::: "memory");
}
__device__ __forceinline__ int map_gu(int n0) { return n0 < DFF ? (n0 / 128) * 256 + (n0 % 128) : ((n0 - DFF) / 128) * 256 + 128 + ((n0 - DFF) % 128); }
__device__ __forceinline__ int map_win(int n0) { return n0 < 6144 ? n0 : (n0 < 6176 ? 9216 + (n0 - 6144) : n0 - 32); }

__device__ __forceinline__ void p0_prologue(Frame& F) {
    LAS float* scr = (LAS float*)(F.lds + F.wave * 16384);
    const int gw = F.vcu * NWAVES + F.wave, NGW = F.G * NWAVES, lane = F.lane;
    bf16_t* const wgu1 = (bf16_t*)(F.ws + WS_WGU1); bf16_t* const wd1 = (bf16_t*)(F.ws + WS_WD1); bf16_t* const win = (bf16_t*)(F.ws + WS_WIN);
    bf16_t* const wsso = (bf16_t*)(F.ws + WS_WSSO); bf16_t* const wo = (bf16_t*)(F.ws + WS_WO); bf16_t* const wgu2 = (bf16_t*)(F.ws + WS_WGU2);
    bf16_t* const wd2 = (bf16_t*)(F.ws + WS_WD2); bf16_t* const wpg = (bf16_t*)(F.ws + WS_WPG); bf16_t* const wple = (bf16_t*)(F.ws + WS_WPLE);
    constexpr int I_GU = (DM / 64) * (2 * DFF / 32), I_D = (DFF / 64) * (DM / 32), I_IN = (DM / 64) * (IN_DIM / 32), I_SSO = (DI / 64) * (DM / 32), I_SQ = (DM / 64) * (DM / 32), I_PLE = (PLE / 64) * (DM / 32);
    constexpr int NITEMS = 2 * I_GU + 2 * I_D + I_IN + I_SSO + 3 * I_SQ + I_PLE;
    bf16_t* const wpot = (bf16_t*)(F.ws + WS_WPOT);
    for (int it = gw; it < NITEMS; it += NGW) {
        int r = it;
        if (r < I_GU) { const int nb = 2 * DFF / 32, kb = r / nb, n0 = (r % nb) * 32; p0_transpose_item(F.in[I_WGU1], DM, 2 * DFF, F.in[I_NFFN1], wgu1, kb * 64, n0, map_gu(n0), scr, lane); continue; } r -= I_GU;
        if (r < I_GU) { const int nb = 2 * DFF / 32, kb = r / nb, n0 = (r % nb) * 32; p0_transpose_item(F.in[I_WGU2], DM, 2 * DFF, F.in[I_NFFN2], wgu2, kb * 64, n0, map_gu(n0), scr, lane); continue; } r -= I_GU;
        if (r < I_D) { const int nb = DM / 32, kb = r / nb, n0 = (r % nb) * 32; p0_transpose_item(F.in[I_WD1], DFF, DM, nullptr, wd1, kb * 64, n0, n0, scr, lane); continue; } r -= I_D;
        if (r < I_D) { const int nb = DM / 32, kb = r / nb, n0 = (r % nb) * 32; p0_transpose_item(F.in[I_WD2], DFF, DM, nullptr, wd2, kb * 64, n0, n0, scr, lane); continue; } r -= I_D;
        if (r < I_IN) { const int nb = IN_DIM / 32, kb = r / nb, n0 = (r % nb) * 32; p0_transpose_item(F.in[I_WIN], DM, IN_DIM, F.in[I_NMIX], win, kb * 64, n0, map_win(n0), scr, lane); continue; } r -= I_IN;
        if (r < I_SSO) { const int nb = DM / 32, kb = r / nb, n0 = (r % nb) * 32; p0_transpose_item(F.in[I_WSSO], DI, DM, F.in[I_NSSD], wsso, kb * 64, n0, n0, scr, lane); continue; } r -= I_SSO;
        if (r < I_SQ) { const int nb = DM / 32, kb = r / nb, n0 = (r % nb) * 32; p0_transpose_item(F.in[I_WO], DM, DM, nullptr, wo, kb * 64, n0, n0, scr, lane); continue; } r -= I_SQ;
        if (r < I_SQ) { const int nb = DM / 32, kb = r / nb, n0 = (r % nb) * 32; p0_transpose_item(F.in[I_WPG], DM, DM, F.in[I_NPLE], wpg, kb * 64, n0, n0, scr, lane); continue; } r -= I_SQ;
        if (r < I_SQ) { const int nb = DM / 32, kb = r / nb, n0 = (r % nb) * 32; p0_transpose_item(F.in[I_WPOUT], PD, DM, F.in[I_PSCALE], wpot, kb * 64, n0, n0, scr, lane); continue; } r -= I_SQ;
        { const int nb = DM / 32, kb = r / nb, n0 = (r % nb) * 32; p0_transpose_item(F.in[I_WPLE], PLE, DM, nullptr, wple, kb * 64, n0, n0, scr, lane); }
    }
    {
        bf16_t* const wgrp = (bf16_t*)(F.ws + WS_WGRP); const float* Wg = F.in[I_WPGRP];
        for (int e = F.vcu * NTHREADS + F.tid; e < 4 * 256 * 256 / 8; e += F.G * NTHREADS) {
            const f32x4 a = *(const GAS f32x4*)(Wg + (size_t)e * 8), b = *(const GAS f32x4*)(Wg + (size_t)e * 8 + 4);
            u32x4 o; o.x = pk2(a.x, a.y); o.y = pk2(a.z, a.w); o.z = pk2(b.x, b.y); o.w = pk2(b.z, b.w);
            *(GAS u32x4*)(wgrp + (size_t)e * 8) = o; }
    }
    {
        bf16_t* const XB = (bf16_t*)(F.ws + WS_XB); bf16_t* const PB = (bf16_t*)(F.ws + WS_PB); float* const stA = (float*)(F.ws + WS_STATS_A);
        for (int m = gw; m < M; m += NGW) {
            const float* xrow = (m < MP) ? F.in[I_XP] + (size_t)m * DM : F.in[I_XS] + (size_t)(m - MP) * DM;
            const GAS f32x4* xr = (const GAS f32x4*)xrow + lane;
            f32x4 v[4]; float s = 0.f;
#pragma unroll
            for (int j = 0; j < 4; ++j) { v[j] = xr[64 * j]; s += (v[j].x * v[j].x + v[j].y * v[j].y) + (v[j].z * v[j].z + v[j].w * v[j].w); }
            s = wave_sum(s);
            GAS u32x2* o8 = (GAS u32x2*)(XB + (size_t)m * DM) + lane;
#pragma unroll
            for (int j = 0; j < 4; ++j) { u32x2 w; w.x = pk2(v[j].x, v[j].y); w.y = pk2(v[j].z, v[j].w); o8[64 * j] = w; }
            if (lane < 16) *(GAS float*)(stA + (size_t)m * 16 + lane) = (lane == 0) ? s : 0.f;
            const float* prow = (m < MP) ? F.in[I_PP] + (size_t)m * PLE : F.in[I_PS] + (size_t)(m - MP) * PLE;
            const f32x4 pv = *((const GAS f32x4*)prow + lane);
            u32x2 w; w.x = pk2(pv.x, pv.y); w.y = pk2(pv.z, pv.w); *((GAS u32x2*)(PB + (size_t)m * PLE) + lane) = w;
        }
    }
}


typedef short v4i16_t __attribute__((ext_vector_type(4)));
constexpr int IMG_B = 0, IMG_C = 32768, IMG_X = 65536, TAB_ACS = RING_BYTES + 1024, TAB_DT = TAB_ACS + 2048, TAB_SD = TAB_DT + 2048;
constexpr int NCHUNK = SEQ / 128;
template <bool XS> __device__ __forceinline__ int img_off(int row, int ch) { return XS ? 256 * row + 16 * (ch ^ ((row & 7) << 1)) : 256 * row + 16 * (ch ^ (((row & 3) << 2) | ((row >> 2) & 3))); }
__device__ __forceinline__ bf16x8 tr_pair(const LAS unsigned char* p0, const LAS unsigned char* p1) {
    const v4i16_t a = __builtin_amdgcn_ds_read_tr16_b64_v4i16((LAS v4i16_t*)p0), b = __builtin_amdgcn_ds_read_tr16_b64_v4i16((LAS v4i16_t*)p1);
    return (bf16x8){a[0], a[1], a[2], a[3], b[0], b[1], b[2], b[3]};
}
__device__ __forceinline__ void ssd_tables_load(Frame& F, size_t row0, int g, float& d0, float& d1) {
    if (F.wave < 4) { const float* const DT = (const float*)(F.ws + WS_DT); const int head = g * HPG + F.wave;
        d0 = *(const GAS float*)(DT + (row0 + 2 * F.lane) * 32 + head); d1 = *(const GAS float*)(DT + (row0 + 2 * F.lane + 1) * 32 + head); }
}
__device__ __forceinline__ void ssd_tables_compute(Frame& F, int g, float d0, float d1) {
    LAS float* const acs = (LAS float*)(F.lds + TAB_ACS); LAS float* const dtl = (LAS float*)(F.lds + TAB_DT); LAS float* const sdec = (LAS float*)(F.lds + TAB_SD);
    if (F.wave < 4) {
        const int r = F.wave, lane = F.lane, head = g * HPG + r;
        const float Ah = -__expf(*(const GAS float*)(F.in[I_ALOG] + head));
        const float a0 = d0 * Ah, a1 = d1 * Ah, loc = a0 + a1;
        float inc = loc;
#pragma unroll
        for (int o = 1; o < 64; o <<= 1) { const float t = __shfl_up(inc, o); if (lane >= o) inc += t; }
        const float exc = inc - loc;
        acs[(2 * lane) * 4 + r] = exc + a0; acs[(2 * lane + 1) * 4 + r] = inc;
        dtl[(2 * lane) * 4 + r] = d0; dtl[(2 * lane + 1) * 4 + r] = d1;
    }
    __syncthreads();
    { const int s = F.tid >> 2, r = F.tid & 3; sdec[s * 4 + r] = __expf(acs[127 * 4 + r] - acs[s * 4 + r]) * dtl[s * 4 + r]; }
    __syncthreads();
}
__device__ __forceinline__ void ssd_tables(Frame& F, size_t row0, int g) { float d0 = 0.f, d1 = 0.f; ssd_tables_load(F, row0, g, d0, d1); ssd_tables_compute(F, g, d0, d1); }
struct ConvMap { int kind, cc, run, gch; };
__device__ __forceinline__ ConvMap ssd_conv_map(int t, int g) {
    ConvMap m;
    if (t < 256) { m.kind = 0; m.cc = t & 31; m.run = t >> 5; } else if (t < 384) { m.kind = 1; m.cc = (t - 256) & 15; m.run = (t - 256) >> 4; } else { m.kind = 2; m.cc = (t - 384) & 15; m.run = (t - 384) >> 4; }
    m.gch = (m.kind == 0 ? g * 256 : (m.kind == 1 ? DI + g * DSTATE : DI + NG * DSTATE + g * DSTATE)) + 8 * m.cc;
    return m;
}
__device__ __forceinline__ void ssd_conv_load(Frame& F, size_t row0, int b, int c, int g, u32x4 (&raw)[19]) {
    const ConvMap m = ssd_conv_map(F.tid, g);
    const bf16_t* const XBC = (const bf16_t*)(F.ws + WS_XBC); const bf16_t* const HALO = (const bf16_t*)(F.ws + WS_HALO);
#pragma unroll
    for (int i = 0; i < 19; ++i) {
        if (i < 3 && m.run == 0) { if (c == 0) raw[i] = (u32x4){0u, 0u, 0u, 0u}; else raw[i] = *(const GAS u32x4*)(HALO + ((((size_t)b * 16 + c) * 3 + i) * CD) + m.gch); }
        else raw[i] = *(const GAS u32x4*)(XBC + (row0 + 16 * m.run + i - 3) * CD + m.gch); }
}
__device__ __forceinline__ void ssd_conv_store(Frame& F, size_t row0, int g, const u32x4 (&raw)[19]) {
    const ConvMap m = ssd_conv_map(F.tid, g);
    bf16_t* const XBC = (bf16_t*)(F.ws + WS_XBC);
    const float* const convw = F.in[I_CONVW]; const float* const convb = F.in[I_CONVB];
    float cw[4][8], cb[8];
#pragma unroll
    for (int k = 0; k < 4; ++k) { const f32x4 a = *(const GAS f32x4*)(convw + (size_t)k * CD + m.gch), b_ = *(const GAS f32x4*)(convw + (size_t)k * CD + m.gch + 4);
        cw[k][0] = a.x; cw[k][1] = a.y; cw[k][2] = a.z; cw[k][3] = a.w; cw[k][4] = b_.x; cw[k][5] = b_.y; cw[k][6] = b_.z; cw[k][7] = b_.w; }
    { const f32x4 a = *(const GAS f32x4*)(convb + m.gch), b_ = *(const GAS f32x4*)(convb + m.gch + 4); cb[0] = a.x; cb[1] = a.y; cb[2] = a.z; cb[3] = a.w; cb[4] = b_.x; cb[5] = b_.y; cb[6] = b_.z; cb[7] = b_.w; }
    LAS unsigned char* const img = F.lds + (m.kind == 0 ? IMG_X + (m.cc >> 4) * 32768 : IMG_B);
    const LAS float* const sdec = (const LAS float*)(F.lds + TAB_SD);
    const int chl = m.cc & 15, hr = m.cc >> 3;
#pragma unroll
    for (int i = 0; i < 16; ++i) {
        const int s = 16 * m.run + i;
        float o[8];
#pragma unroll
        for (int j2 = 0; j2 < 4; ++j2) {
            const unsigned w0 = raw[i][j2], w1 = raw[i + 1][j2], w2 = raw[i + 2][j2], w3 = raw[i + 3][j2];
            const float lo = cb[2 * j2] + cw[0][2 * j2] * bflo(w0) + cw[1][2 * j2] * bflo(w1) + cw[2][2 * j2] * bflo(w2) + cw[3][2 * j2] * bflo(w3);
            const float hi = cb[2 * j2 + 1] + cw[0][2 * j2 + 1] * bfhi(w0) + cw[1][2 * j2 + 1] * bfhi(w1) + cw[2][2 * j2 + 1] * bfhi(w2) + cw[3][2 * j2 + 1] * bfhi(w3);
            o[2 * j2] = silu_f(lo); o[2 * j2 + 1] = silu_f(hi);
        }
        u32x4 pk; pk.x = cvt_pk_bf16(o[0], o[1]); pk.y = cvt_pk_bf16(o[2], o[3]); pk.z = cvt_pk_bf16(o[4], o[5]); pk.w = cvt_pk_bf16(o[6], o[7]);
        *(GAS u32x4*)(XBC + (row0 + s) * CD + m.gch) = pk;
        if (m.kind == 0) { const float sc = sdec[s * 4 + hr];
            pk.x = cvt_pk_bf16(o[0] * sc, o[1] * sc); pk.y = cvt_pk_bf16(o[2] * sc, o[3] * sc); pk.z = cvt_pk_bf16(o[4] * sc, o[5] * sc); pk.w = cvt_pk_bf16(o[6] * sc, o[7] * sc); }
        if (m.kind != 2) *(LAS u32x4*)(img + img_off<false>(s, chl)) = pk;
    }
}
__device__ __forceinline__ void ssd_copy_load(Frame& F, size_t row0, int g, u32x4 (&raw)[16]) {
    const ConvMap m = ssd_conv_map(F.tid, g);
    const bf16_t* const XBC = (const bf16_t*)(F.ws + WS_XBC);
#pragma unroll
    for (int i = 0; i < 16; ++i) raw[i] = *(const GAS u32x4*)(XBC + (row0 + 16 * m.run + i) * CD + m.gch);
}
__device__ __forceinline__ void ssd_copy_store(Frame& F, int g, const u32x4 (&raw)[16]) {
    const ConvMap m = ssd_conv_map(F.tid, g);
    LAS unsigned char* const img = F.lds + (m.kind == 0 ? IMG_X + (m.cc >> 4) * 32768 : (m.kind == 1 ? IMG_B : IMG_C));
    const int chl = m.cc & 15;
#pragma unroll
    for (int i = 0; i < 16; ++i) { const int s = 16 * m.run + i; *(LAS u32x4*)(img + (m.kind == 0 ? img_off<true>(s, chl) : img_off<false>(s, chl))) = raw[i]; }
}
__device__ __forceinline__ void ssd_states_phase(Frame& F) {
    bf16_t* const ST = (bf16_t*)(F.ws + WS_HPREV);
    float* const CDEC = (float*)(F.ws + WS_CDEC);
    const int w = F.wave, lane = F.lane, ql = lane & 15, gq = lane >> 4, qq = ql >> 2, pp = ql & 3, r = w >> 1, nh = w & 1;
    int sbo[4][2], sxo[4][2];
#pragma unroll
    for (int f = 0; f < 4; ++f) { const int colb = 64 * nh + 16 * f + 4 * pp, colx = 64 * (r & 1) + 16 * f + 4 * pp;
#pragma unroll
        for (int t4 = 0; t4 < 2; ++t4) { sbo[f][t4] = img_off<false>(8 * gq + qq + 4 * t4, colb >> 3) + 2 * (colb & 7); sxo[f][t4] = img_off<false>(8 * gq + qq + 4 * t4, colx >> 3) + 2 * (colx & 7); } }
    u32x4 raw[19]; float d0 = 0.f, d1 = 0.f;
    constexpr int NIT = BATCH * NCHUNK * NG;
    if (F.vcu < NIT) { const int it = F.vcu, g = it & 7, c = (it >> 3) & (NCHUNK - 1), b = it >> 7; const size_t row0 = (size_t)b * SEQ + (size_t)c * 128;
        ssd_conv_load(F, row0, b, c, g, raw); ssd_tables_load(F, row0, g, d0, d1); }
    for (int it = F.vcu; it < NIT; it += F.G) {
        const int g = it & 7, c = (it >> 3) & (NCHUNK - 1), b = it >> 7;
        const size_t row0 = (size_t)b * SEQ + (size_t)c * 128;
        asm volatile("s_waitcnt vmcnt(0)" ::: "memory");
        ssd_tables_compute(F, g, d0, d1);
        ssd_conv_store(F, row0, g, raw);
        __syncthreads();
        if (it + F.G < NIT) { const int it2 = it + F.G, g2 = it2 & 7, c2 = (it2 >> 3) & (NCHUNK - 1), b2 = it2 >> 7; const size_t row2 = (size_t)b2 * SEQ + (size_t)c2 * 128;
            ssd_conv_load(F, row2, b2, c2, g2, raw); ssd_tables_load(F, row2, g2, d0, d1); }
        const int head = g * HPG + r;
        bf16_t* const stp = ST + ((((size_t)b * NCHUNK + c) * NH + head) * HD) * DSTATE;
#pragma unroll
        for (int nh2 = 0; nh2 < 2; ++nh2) {
            f32x4 acc[2][4];
#pragma unroll
            for (int i = 0; i < 2; ++i)
#pragma unroll
                for (int j = 0; j < 4; ++j) acc[i][j] = (f32x4){0.f, 0.f, 0.f, 0.f};
#pragma unroll
            for (int ks = 0; ks < 4; ++ks) {
                bf16x8 af[2], xf[4];
#pragma unroll
                for (int nf = 0; nf < 2; ++nf) { const LAS unsigned char* p = F.lds + IMG_B + sbo[2 * nh2 + nf][0] + 8192 * ks; const LAS unsigned char* p4 = F.lds + IMG_B + sbo[2 * nh2 + nf][1] + 8192 * ks; af[nf] = tr_pair(p, p4); }
#pragma unroll
                for (int pf = 0; pf < 4; ++pf) { const LAS unsigned char* p = F.lds + IMG_X + (r >> 1) * 32768 + sxo[pf][0] + 8192 * ks; const LAS unsigned char* p4 = F.lds + IMG_X + (r >> 1) * 32768 + sxo[pf][1] + 8192 * ks; xf[pf] = tr_pair(p, p4); }
#pragma unroll
                for (int nf = 0; nf < 2; ++nf)
#pragma unroll
                    for (int pf = 0; pf < 4; ++pf) acc[nf][pf] = __builtin_amdgcn_mfma_f32_16x16x32_bf16(af[nf], xf[pf], acc[nf][pf], 0, 0, 0);
            }
#pragma unroll
            for (int pf = 0; pf < 4; ++pf)
#pragma unroll
                for (int nf = 0; nf < 2; ++nf) { u32x2 o; o.x = cvt_pk_bf16(acc[nf][pf][0], acc[nf][pf][1]); o.y = cvt_pk_bf16(acc[nf][pf][2], acc[nf][pf][3]);
                    *(GAS u32x2*)(stp + (size_t)(16 * pf + ql) * DSTATE + 64 * nh + 32 * nh2 + 16 * nf + 4 * gq) = o; }
        }
        if (F.tid < 4) { const LAS float* acs = (const LAS float*)(F.lds + TAB_ACS); *(GAS float*)(CDEC + ((size_t)b * NCHUNK + c) * NH + g * HPG + F.tid) = __expf(acs[127 * 4 + F.tid]); }
        __syncthreads();
    }
}
__device__ __forceinline__ void ssd_scan_phase(Frame& F) {
    bf16_t* const HP = (bf16_t*)(F.ws + WS_HPREV); const float* const CDEC = (const float*)(F.ws + WS_CDEC); float* const hout = F.out + O_SSM_P;
    const int gt = F.vcu * NTHREADS + F.tid, NT = F.G * NTHREADS;
    constexpr int PER = NH * HD * DSTATE / 8;
    for (int e = gt; e < BATCH * PER; e += NT) {
        const int b = e / PER, i8 = e % PER, head = i8 / (HD * DSTATE / 8);
        u32x4 stv[NCHUNK];
#pragma unroll
        for (int c = 0; c < NCHUNK; ++c) stv[c] = *(const GAS u32x4*)(HP + (((size_t)b * NCHUNK + c) * (size_t)PER + i8) * 8);
        f32x4 h0 = (f32x4){0.f, 0.f, 0.f, 0.f}, h1 = h0;
#pragma unroll
        for (int c = 0; c < NCHUNK; ++c) {
            if (c > 0) *(GAS u32x4*)(HP + (((size_t)b * NCHUNK + c) * (size_t)PER + i8) * 8) = pg8::pack8(h0, h1);
            const float d = *(const GAS float*)(CDEC + ((size_t)b * NCHUNK + c) * NH + head);
            f32x4 s0, s1; pg8::unpack8(stv[c], s0, s1);
            h0 = h0 * d + s0; h1 = h1 * d + s1;
        }
        *(GAS f32x4*)(hout + ((size_t)b * PER + i8) * 8) = h0; *(GAS f32x4*)(hout + ((size_t)b * PER + i8) * 8 + 4) = h1;
    }
}
__device__ __forceinline__ void ssd_out_phase(Frame& F) {
    const bf16_t* const HP = (const bf16_t*)(F.ws + WS_HPREV); bf16_t* const ZY = (bf16_t*)(F.ws + WS_Z);
    const int w = F.wave, lane = F.lane, ql = lane & 15, gq = lane >> 4, qq = ql >> 2, pp = ql & 3, q0 = 16 * w;
    const LAS float* const acs = (const LAS float*)(F.lds + TAB_ACS); const LAS float* const dtl = (const LAS float*)(F.lds + TAB_DT);
    int cfo[4], bbo[4], hbo[4], xbo[2][4];
#pragma unroll
    for (int ks = 0; ks < 4; ++ks) { cfo[ks] = IMG_C + img_off<false>(q0 + ql, 4 * ks + gq); bbo[ks] = IMG_B + img_off<false>(ql, 4 * ks + gq); hbo[ks] = img_off<false>(ql, 4 * ks + gq); }
#pragma unroll
    for (int rr = 0; rr < 2; ++rr)
#pragma unroll
        for (int pf = 0; pf < 4; ++pf) xbo[rr][pf] = IMG_X + img_off<true>(4 * gq + qq, 8 * rr + 2 * pf + (pp >> 1)) + 8 * (pp & 1);
    u32x4 raw[16]; float d0 = 0.f, d1 = 0.f;
    constexpr int NIT = BATCH * NCHUNK * NG;
    if (F.vcu < NIT) { const int it = F.vcu, g = it & 7, c = (it >> 3) & (NCHUNK - 1), b = it >> 7; const size_t row0 = (size_t)b * SEQ + (size_t)c * 128;
        ssd_copy_load(F, row0, g, raw); ssd_tables_load(F, row0, g, d0, d1); }
    for (int it = F.vcu; it < NIT; it += F.G) {
        const int g = it & 7, c = (it >> 3) & (NCHUNK - 1), b = it >> 7;
        const size_t row0 = (size_t)b * SEQ + (size_t)c * 128;
        ssd_tables_compute(F, g, d0, d1);
        ssd_copy_store(F, g, raw);
        __syncthreads();
        if (it + F.G < NIT) { const int it2 = it + F.G, g2 = it2 & 7, c2 = (it2 >> 3) & (NCHUNK - 1), b2 = it2 >> 7; const size_t row2 = (size_t)b2 * SEQ + (size_t)c2 * 128;
            ssd_copy_load(F, row2, g2, raw); ssd_tables_load(F, row2, g2, d0, d1); }
        bf16x8 cf[4];
#pragma unroll
        for (int ks = 0; ks < 4; ++ks) cf[ks] = *(const LAS bf16x8*)(F.lds + cfo[ks]);
        bf16_t* const zp = ZY + (row0 + q0 + ql) * DI + g * 256 + 4 * gq;
        const LAS float* const acs_l = acs + 16 * gq; const LAS float* const dtl_l = dtl + 16 * gq;
        f32x4 acc[4][4];
        float aq[4];
#pragma unroll
        for (int r = 0; r < 4; ++r) { aq[r] = acs[(q0 + ql) * 4 + r];
#pragma unroll
            for (int pf = 0; pf < 4; ++pf) acc[r][pf] = (f32x4){0.f, 0.f, 0.f, 0.f}; }
#pragma unroll
        for (int ks = 0; ks < 4; ++ks) if (2 * ks <= w) {
            f32x4 cb[2];
#pragma unroll
            for (int hf = 0; hf < 2; ++hf) { cb[hf] = (f32x4){0.f, 0.f, 0.f, 0.f};
                if (2 * ks + hf <= w) {
#pragma unroll
                    for (int kn = 0; kn < 4; ++kn) { const bf16x8 bfr = *(const LAS bf16x8*)(F.lds + bbo[kn] + 4096 * (2 * ks + hf)); cb[hf] = __builtin_amdgcn_mfma_f32_16x16x32_bf16(bfr, cf[kn], cb[hf], 0, 0, 0); } } }
#pragma unroll
            for (int r = 0; r < 4; ++r) {
                const float Dh = *(const GAS float*)(F.in[I_DSKIP] + g * HPG + r);
                float v[8];
#pragma unroll
                for (int hf = 0; hf < 2; ++hf) { const int sf = 2 * ks + hf;
#pragma unroll
                    for (int rg = 0; rg < 4; ++rg) { const int sl = 4 * gq + rg;
                        float val = 0.f;
                        if (sf <= w) { const float as = acs_l[64 * sf + 4 * rg + r], d = dtl_l[64 * sf + 4 * rg + r];
                            val = cb[hf][rg] * __expf(aq[r] - as) * d;
                            if (sf == w) { if (sl > ql) val = 0.f; else if (sl == ql) val += Dh; } }
                        v[4 * hf + rg] = val; } }
                u32x4 pk; pk.x = cvt_pk_bf16(v[0], v[1]); pk.y = cvt_pk_bf16(v[2], v[3]); pk.z = cvt_pk_bf16(v[4], v[5]); pk.w = cvt_pk_bf16(v[6], v[7]);
                const bf16x8 wf = __builtin_bit_cast(bf16x8, pk);
#pragma unroll
                for (int pf = 0; pf < 4; ++pf) {
                    const LAS unsigned char* const xb = F.lds + xbo[r & 1][pf] + (r >> 1) * 32768 + 8192 * ks;
                    const bf16x8 xf = tr_pair(xb, xb + 4096);
                    acc[r][pf] = __builtin_amdgcn_mfma_f32_16x16x32_bf16(xf, wf, acc[r][pf], 0, 0, 0); }
            }
        }
        u32x4 hreg[8];
        if (c > 0) {
            const u32x4* hsrc = (const u32x4*)(HP + ((((size_t)b * NCHUNK + c) * NH + g * HPG) * HD) * DSTATE) + F.tid;
#pragma unroll
            for (int i = 0; i < 8; ++i) hreg[i] = *(const GAS u32x4*)(hsrc + 512 * i);
        }
        if (c > 0) {
            __syncthreads();
#pragma unroll
            for (int i = 0; i < 8; ++i) { const int e = F.tid + 512 * i, hr_ = e >> 10, p_ = (e >> 4) & 63, ch_ = e & 15;
                *(LAS u32x4*)(F.lds + IMG_X + hr_ * 16384 + img_off<false>(p_, ch_)) = hreg[i]; }
            __syncthreads();
#pragma unroll
            for (int r = 0; r < 4; ++r) { const float eaq = __expf(aq[r]);
#pragma unroll
                for (int pf = 0; pf < 4; ++pf) { f32x4 yo = (f32x4){0.f, 0.f, 0.f, 0.f};
#pragma unroll
                    for (int ks = 0; ks < 4; ++ks) { const bf16x8 hf_ = *(const LAS bf16x8*)(F.lds + IMG_X + r * 16384 + hbo[ks] + 4096 * pf); yo = __builtin_amdgcn_mfma_f32_16x16x32_bf16(hf_, cf[ks], yo, 0, 0, 0); }
                    acc[r][pf] += yo * eaq; } }
        }
        float ssum = 0.f;
#pragma unroll
        for (int r = 0; r < 4; ++r)
#pragma unroll
            for (int pf = 0; pf < 4; ++pf) {
                const u32x2 zz = *(const GAS u32x2*)(zp + r * 64 + 16 * pf);
                const f32x4 y = acc[r][pf] * (f32x4){bflo(zz.x), bfhi(zz.x), bflo(zz.y), bfhi(zz.y)};
                acc[r][pf] = y; ssum += (y[0] * y[0] + y[1] * y[1]) + (y[2] * y[2] + y[3] * y[3]); }
        ssum += __shfl_xor(ssum, 16); ssum += __shfl_xor(ssum, 32);
        const float rsn = __builtin_amdgcn_rsqf(ssum * (1.0f / 256.0f) + EPS);
#pragma unroll
        for (int r = 0; r < 4; ++r)
#pragma unroll
            for (int pf = 0; pf < 4; ++pf) { u32x2 o; o.x = cvt_pk_bf16(acc[r][pf][0] * rsn, acc[r][pf][1] * rsn); o.y = cvt_pk_bf16(acc[r][pf][2] * rsn, acc[r][pf][3] * rsn);
                *(GAS u32x2*)(zp + r * 64 + 16 * pf) = o; }
        __syncthreads();
    }
}

__device__ __forceinline__ void ssd_seq_phase(Frame& F) {
    const int r = F.wave & 3, nh = F.wave >> 2, lane = F.lane, idx = r * 64 + lane;
    LAS float* const bc = (LAS float*)F.lds;
    LAS float* const lxs = bc + 2048;
    LAS float* const yp = bc + 4096;
    LAS float* const ldt = bc + 8192; LAS float* const ssq = bc + 8192 + 32;
    const bf16_t* const XBC = (const bf16_t*)(F.ws + WS_XBC); const bf16_t* const Zs = (const bf16_t*)(F.ws + WS_Z); bf16_t* const YN = (bf16_t*)(F.ws + WS_Z);
    const float* const DT = (const float*)(F.ws + WS_DT);
    const float* const convw = F.in[I_CONVW]; const float* const convb = F.in[I_CONVB];
    for (int it = F.vcu; it < DECB * NG; it += F.G) {
        const int b = it >> 3, g = it & 7, head = g * HPG + r;
        const size_t row0 = (size_t)MP + (size_t)b * DECS;
        const int xch = g * 256 + idx;
        {
            const int ch = (nh == 0) ? ((idx < 128) ? (DI + g * DSTATE + idx) : (DI + NG * DSTATE + g * DSTATE + (idx - 128))) : xch;
            float cw[4];
#pragma unroll
            for (int k = 0; k < 4; ++k) cw[k] = *(const GAS float*)(convw + (size_t)k * CD + ch);
            const float cbv = *(const GAS float*)(convb + ch);
            const float* cs = F.in[I_CONV] + (size_t)b * 3 * CD;
            float x3 = *(const GAS float*)(cs + ch), x2 = *(const GAS float*)(cs + CD + ch), x1 = *(const GAS float*)(cs + 2 * CD + ch);
            LAS float* const dst = (nh == 0) ? bc : lxs;
#pragma unroll
            for (int j = 0; j < 8; ++j) {
                const float xr = bf2f(*(const GAS bf16_t*)(XBC + (row0 + j) * CD + ch));
                const float cx = cbv + cw[0] * x3 + cw[1] * x2 + cw[2] * x1 + cw[3] * xr; x3 = x2; x2 = x1; x1 = xr;
                dst[j * 256 + idx] = silu_f(cx);
            }
            if (nh == 1 && lane < 8) ldt[lane * 4 + r] = *(const GAS float*)(DT + (row0 + lane) * 32 + head);
        }
        __syncthreads();
        {
            const float Ah = -__expf(*(const GAS float*)(F.in[I_ALOG] + head));
            const int pg = lane >> 4, nc = lane & 15;
            f32x4 h[16];
            const float* const hin = F.in[I_SSM] + (((size_t)b * NH + head) * HD + 16 * pg) * DSTATE + 64 * nh + 4 * nc;
#pragma unroll
            for (int i = 0; i < 16; ++i) h[i] = *(const GAS f32x4*)(hin + (size_t)i * DSTATE);
            for (int j = 0; j < 8; ++j) {
                const float dtv = ldt[j * 4 + r], dA = __expf(dtv * Ah);
                const f32x4 Bv = *(const LAS f32x4*)(bc + j * 256 + 64 * nh + 4 * nc), Cv = *(const LAS f32x4*)(bc + j * 256 + 128 + 64 * nh + 4 * nc);
                float part[16];
#pragma unroll
                for (int i4 = 0; i4 < 4; ++i4) { const f32x4 xs4 = *(const LAS f32x4*)(lxs + j * 256 + r * 64 + 16 * pg + 4 * i4);
#pragma unroll
                    for (int k = 0; k < 4; ++k) { const int i = 4 * i4 + k; const float dx = dtv * xs4[k];
                        h[i] = h[i] * dA + Bv * dx;
                        part[i] = (Cv.x * h[i].x + Cv.y * h[i].y) + (Cv.z * h[i].z + Cv.w * h[i].w); } }
#pragma unroll
                for (int i = 0; i < 8; ++i) { const bool up = (nc & 8) != 0; const float keep = up ? part[i + 8] : part[i], send = up ? part[i] : part[i + 8]; part[i] = keep + __shfl_xor(send, 8); }
#pragma unroll
                for (int i = 0; i < 4; ++i) { const bool up = (nc & 4) != 0; const float keep = up ? part[i + 4] : part[i], send = up ? part[i] : part[i + 4]; part[i] = keep + __shfl_xor(send, 4); }
#pragma unroll
                for (int i = 0; i < 2; ++i) { const bool up = (nc & 2) != 0; const float keep = up ? part[i + 2] : part[i], send = up ? part[i] : part[i + 2]; part[i] = keep + __shfl_xor(send, 2); }
                { const bool up = (nc & 1) != 0; const float keep = up ? part[1] : part[0], send = up ? part[0] : part[1]; part[0] = keep + __shfl_xor(send, 1); }
                yp[(j * 2 + nh) * 256 + r * 64 + 16 * pg + nc] = part[0];
            }
            float* const hout = F.out + O_SSM_S + (((size_t)b * NH + head) * HD + 16 * pg) * DSTATE + 64 * nh + 4 * nc;
#pragma unroll
            for (int i = 0; i < 16; ++i) *(GAS f32x4*)(hout + (size_t)i * DSTATE) = h[i];
        }
        __syncthreads();
        float ygv[4];
        {
            const float Dh = *(const GAS float*)(F.in[I_DSKIP] + head);
#pragma unroll
            for (int jj = 0; jj < 4; ++jj) { const int j = 4 * nh + jj;
                const float y = (yp[(j * 2) * 256 + idx] + yp[(j * 2 + 1) * 256 + idx]) + Dh * lxs[j * 256 + idx];
                ygv[jj] = y * bf2f(*(const GAS bf16_t*)(Zs + (row0 + j) * DI + xch));
                const float ss = wave_sum(ygv[jj] * ygv[jj]);
                if (lane == 0) ssq[j * 4 + r] = ss; }
        }
        __syncthreads();
#pragma unroll
        for (int jj = 0; jj < 4; ++jj) { const int j = 4 * nh + jj;
            const f32x4 s4 = *(const LAS f32x4*)(ssq + j * 4);
            const float rsn = __builtin_amdgcn_rsqf(((s4.x + s4.y) + (s4.z + s4.w)) * (1.0f / 256.0f) + EPS);
            *(GAS bf16_t*)(YN + (row0 + j) * DI + xch) = (bf16_t)f2bf(ygv[jj] * rsn); }
        __syncthreads();
    }
}
template <int W> __device__ __forceinline__ void pool_run(const bf16_t* V, bf16_t* PO, int run, int cv) {
    const int row0 = run * 16, t0 = row0 & (SEQ - 1);
    u32x4 raw[16 + W - 1];
#pragma unroll
    for (int e = 0; e < 16 + W - 1; ++e) {
        const int dt_ = e - (W - 1);
        if (t0 + dt_ >= 0) raw[e] = *(const GAS u32x4*)(V + (size_t)(row0 + dt_) * PD + cv); else raw[e] = (u32x4){0u, 0u, 0u, 0u};
    }
    f32x4 s0 = (f32x4){0.f, 0.f, 0.f, 0.f}, s1 = s0;
#pragma unroll
    for (int e = 0; e < W - 1; ++e) { f32x4 x0, x1; pg8::unpack8(raw[e], x0, x1); s0 += x0; s1 += x1; }
#pragma unroll
    for (int i = 0; i < 16; ++i) {
        f32x4 c0, c1; pg8::unpack8(raw[i + W - 1], c0, c1);
        s0 += c0; s1 += c1;
        const int t = t0 + i; const float ic = 1.0f / (float)((t + 1 < W) ? t + 1 : W);
        const f32x4 o0 = s0 * ic - c0, o1 = s1 * ic - c1;
        u32x4 o; o.x = pk2(o0.x, o0.y); o.y = pk2(o0.z, o0.w); o.z = pk2(o1.x, o1.y); o.w = pk2(o1.z, o1.w);
        *(GAS u32x4*)(PO + (size_t)(row0 + i) * PD + cv) = o;
        f32x4 x0, x1; pg8::unpack8(raw[i], x0, x1); s0 -= x0; s1 -= x1;
    }
}
template <int W> __device__ __forceinline__ void pool_run_s(const bf16_t* V, bf16_t* PO, const float* sp, int b, int cv) {
    const size_t row0 = (size_t)MP + (size_t)b * DECS;
    f32x4 a0[8 + W - 1], a1[8 + W - 1];
#pragma unroll
    for (int e = 0; e < 8 + W - 1; ++e) { const int t = e - (W - 1);
        if (t >= 0) pg8::unpack8(*(const GAS u32x4*)(V + (row0 + t) * PD + cv), a0[e], a1[e]);
        else { const float* p = sp + ((size_t)b * PBUF + (PBUF + t)) * PD + cv; a0[e] = *(const GAS f32x4*)p; a1[e] = *(const GAS f32x4*)(p + 4); } }
    f32x4 s0 = (f32x4){0.f, 0.f, 0.f, 0.f}, s1 = s0;
#pragma unroll
    for (int e = 0; e < W - 1; ++e) { s0 += a0[e]; s1 += a1[e]; }
    const float ic = 1.0f / (float)W;
#pragma unroll
    for (int i = 0; i < 8; ++i) {
        s0 += a0[i + W - 1]; s1 += a1[i + W - 1];
        const f32x4 o0 = s0 * ic - a0[i + W - 1], o1 = s1 * ic - a1[i + W - 1];
        u32x4 o; o.x = pk2(o0.x, o0.y); o.y = pk2(o0.z, o0.w); o.z = pk2(o1.x, o1.y); o.w = pk2(o1.z, o1.w);
        *(GAS u32x4*)(PO + (row0 + i) * PD + cv) = o;
        s0 -= a0[i]; s1 -= a1[i];
    }
}
__device__ __forceinline__ void pool_phase(Frame& F) {
    const bf16_t* const V = (const bf16_t*)(F.ws + WS_V); bf16_t* const PO = (bf16_t*)(F.out + O_Y);
    const float* const sp = F.in[I_POOL];
    const int gt = F.vcu * NTHREADS + F.tid, NT = F.G * NTHREADS;
    for (int e = gt; e < (MP / 16) * 128; e += NT) {
        const int c32 = e & 31, rl = (e >> 5) & 1, grp = (e >> 6) & 3, run = (e >> 8) * 2 + rl, cv = (grp * 32 + c32) * 8;
        if (grp == 0) pool_run<2>(V, PO, run, cv); else if (grp == 1) pool_run<4>(V, PO, run, cv); else if (grp == 2) pool_run<8>(V, PO, run, cv); else pool_run<16>(V, PO, run, cv);
    }
    for (int e = gt; e < (MS / 8) * 128; e += NT) {
        const int c32 = e & 31, grp = (e >> 5) & 3, b = e >> 7, cv = (grp * 32 + c32) * 8;
        if (grp == 0) pool_run_s<2>(V, PO, sp, b, cv); else if (grp == 1) pool_run_s<4>(V, PO, sp, b, cv); else if (grp == 2) pool_run_s<8>(V, PO, sp, b, cv); else pool_run_s<16>(V, PO, sp, b, cv);
    }
    float* const ops = F.out + O_POOL_S;
    for (int e = gt; e < DECB * 7 * (PD / 4); e += NT) {
        const int c4 = e & 255, i = (e >> 8) % 7, b = (e >> 8) / 7;
        *(GAS f32x4*)(ops + ((size_t)b * PBUF + i) * PD + c4 * 4) = *(const GAS f32x4*)(sp + ((size_t)b * PBUF + 8 + i) * PD + c4 * 4);
    }
}
__device__ __forceinline__ void final_phase(Frame& F) {
    const int gw = F.vcu * NWAVES + F.wave, NGW = F.G * NWAVES, lane = F.lane;
    const float* const st = (const float*)(F.ws + WS_STATS_A); const float* const gf = F.in[I_NFINAL];
    f32x4 gv[4];
#pragma unroll
    for (int j = 0; j < 4; ++j) gv[j] = *((const GAS f32x4*)gf + lane + 64 * j);
    for (int m = gw; m < M; m += NGW) {
        const GAS f32x4* sp = (const GAS f32x4*)(st + (size_t)m * 16);
        const f32x4 a = sp[0], b = sp[1], c = sp[2], d = sp[3]; const f32x4 s = (a + b) + (c + d);
        const float rs = __builtin_amdgcn_rsqf(((s[0] + s[1]) + (s[2] + s[3])) * (1.0f / 1024.0f) + EPS);
        GAS f32x4* yr = (GAS f32x4*)(F.out + (size_t)m * DM) + lane;
#pragma unroll
        for (int j = 0; j < 4; ++j) yr[64 * j] = yr[64 * j] * rs * gv[j];
    }
}

constexpr int NPHASES = 13;
struct Args { const float* in[30]; float* out; unsigned char* ws; int ph_lo, ph_hi, li, pad; };
__global__ void __launch_bounds__(NTHREADS, 2) mk_fwd(Args args) {
    extern __shared__ __attribute__((aligned(16))) unsigned char lds[];
    Frame F;
    F.lds = (LAS unsigned char*)lds;
    F.MISC = (volatile LAS unsigned*)(F.lds + MISC_OFF);
    F.tid = threadIdx.x; F.lane = F.tid & 63; F.wave = __builtin_amdgcn_readfirstlane(F.tid >> 6);
    F.G = gridDim.x; { const int bx = blockIdx.x; F.vcu = (F.G % 8 == 0) ? (bx % 8) * (F.G / 8) + bx / 8 : bx; }
    F.ws = args.ws; F.out = args.out; F.ctl = (gu32*)(args.ws + WS_CTL);
#pragma unroll
    for (int i = 0; i < 30; ++i) F.in[i] = args.in[i];
    for (int u = F.tid; u < (LDS_BYTES - LDSCTL_OFF) / 4; u += NTHREADS) ((LAS unsigned*)(F.lds + LDSCTL_OFF))[u] = 0u;
    __syncthreads();
    const int lo = args.ph_lo, hi = args.ph_hi;
    XcdBarrier bar; bar.bar = (unsigned*)(F.ctl + CW_BAR); bar.x = 0; bar.st = nullptr;
    if (hi - lo > 1) bar = xcd_barrier_post((unsigned*)(F.ctl + CW_BAR), F.MISC + 8);
#ifndef PHMASK
#define PHMASK 0x1fff
#endif
#define IN(k) (((PHMASK >> (k)) & 1) && lo <= (k) && (k) < hi)
#define SEAM(k) do { if (IN(k) && IN((k) + 1)) xcd_barrier(bar); } while (0)
#define PH_BEGIN(k) if (IN(k)) { auto body_ = [&]() __attribute__((always_inline))
#define PH_END(k) ; body_(); if ((REP_MASK >> (k)) & 1) { xcd_barrier(bar); body_(); } } SEAM(k);

    bf16_t* const XB = (bf16_t*)(F.ws + WS_XB); bf16_t* const HB = (bf16_t*)(F.ws + WS_HB); bf16_t* const ACT = (bf16_t*)(F.ws + WS_ACT);
    bf16_t* const Zb = (bf16_t*)(F.ws + WS_Z); bf16_t* const XBCb = (bf16_t*)(F.ws + WS_XBC); bf16_t* const Vb = (bf16_t*)(F.ws + WS_V); bf16_t* const GATES = (bf16_t*)(F.ws + WS_GATES);
    bf16_t* const POOLED = (bf16_t*)(F.out + O_Y); bf16_t* const MERGED = (bf16_t*)(F.ws + WS_MERGED); bf16_t* const Qb = (bf16_t*)(F.ws + WS_Q); bf16_t* const PB = (bf16_t*)(F.ws + WS_PB);
    float* const T1 = (float*)(F.ws + WS_T1); float* const stA = (float*)(F.ws + WS_STATS_A); float* const stB = (float*)(F.ws + WS_STATS_B); float* const DTb = (float*)(F.ws + WS_DT);
    float* const H = F.out + O_Y;
    pg8::StaticOrder S;

    PH_BEGIN(0) { p0_prologue(F); } PH_END(0)
    PH_BEGIN(1) {
        pg8::Gemm g{XB, (const bf16_t*)(F.ws + WS_WGU1), M, 2 * DFF, DM, DM, 0}; S.init(M, 2 * DFF, F.G, (int)blockIdx.x);
        pg8::Epi E{}; E.kind = pg8::EK_GU; E.stats_in = stA; E.obf = ACT; E.ldo = DFF;
        pg8::gemm_phase(F.lds, g, S, E);
        pg8::Gemm g2{(const bf16_t*)(F.ws + WS_WPOT), (const bf16_t*)(F.ws + WS_WGRP), DM, DM, 256, DM, 256}; S.init_tail(DM, DM, F.G, (int)blockIdx.x);
        pg8::Epi E2{}; E2.kind = pg8::EK_BF16; E2.obf = (bf16_t*)(F.ws + WS_W2); E2.ldo = DM;
        pg8::gemm_phase(F.lds, g2, S, E2);
    } PH_END(1)
    PH_BEGIN(2) {
        pg8::Gemm g{ACT, (const bf16_t*)(F.ws + WS_WD1), M, DM, DFF, DFF, 0}; S.init(MP, DM, F.G, (int)blockIdx.x);
        pg8::Epi E{}; E.kind = pg8::EK_RES; E.coef = 0.5f; E.res_p = F.in[I_XP]; E.res_s = F.in[I_XS]; E.obf = HB; E.stats_out = stB;
        pg8::gemm_phase(F.lds, g, S, E);
        pg8::gemm_small(F.lds, g, E, MP, MS, F.G, (int)blockIdx.x);
    } PH_END(2)
    PH_BEGIN(3) {
        pg8::Gemm g{HB, (const bf16_t*)(F.ws + WS_WIN), M, NIN, DM, DM, 0}; S.init(M, NIN, F.G, (int)blockIdx.x);
        pg8::Epi E{}; E.kind = pg8::EK_WIN; E.stats_in = stB; E.Z = Zb; E.XBC = XBCb; E.V = Vb; E.GATES = GATES; E.HALO = (bf16_t*)(F.ws + WS_HALO); E.DT = DTb; E.dt_bias = F.in[I_DTB];
        E.conv_p = F.out + O_CONV_P; E.conv_s = F.out + O_CONV_S; E.pool_p = F.out + O_POOL_P; E.pool_s = F.out + O_POOL_S;
        pg8::gemm_phase(F.lds, g, S, E);
    } PH_END(3)
    PH_BEGIN(4) { ssd_states_phase(F); pool_phase(F); } PH_END(4)
    PH_BEGIN(5) { ssd_scan_phase(F);

        pg8::Gemm g{PB, (const bf16_t*)(F.ws + WS_WPLE), M, DM, PLE, PLE, 0}; S.init(MP, DM, F.G, (int)blockIdx.x);
        pg8::Epi E{}; E.kind = pg8::EK_BF16; E.obf = Qb; E.ldo = DM;
        pg8::gemm_phase(F.lds, g, S, E);
        pg8::gemm_small(F.lds, g, E, MP, MS, F.G, (int)blockIdx.x);
        } PH_END(5)
    PH_BEGIN(6) { ssd_out_phase(F); ssd_seq_phase(F); } PH_END(6)
    PH_BEGIN(7) {
        pg8::Gemm2 g{Zb, (const bf16_t*)(F.ws + WS_WSSO), POOLED, (const bf16_t*)(F.ws + WS_W2), DI, DI, DM, DM, DM}; S.init(MP, DM, F.G, (int)blockIdx.x);
        pg8::gemm_phase2(F.lds, g, S, GATES, MERGED);
        pg8::gemm_small2(F.lds, g, GATES, MERGED, MP, MS, F.G, (int)blockIdx.x);
    } PH_END(7)
    PH_BEGIN(8) {
        pg8::Gemm g{MERGED, (const bf16_t*)(F.ws + WS_WO), M, DM, DM, DM, 0}; S.init(MP, DM, F.G, (int)blockIdx.x);
        pg8::Epi E{}; E.kind = pg8::EK_RES; E.coef = 1.0f; E.res_bf = HB; E.obf = HB; E.stats_out = stA;
        pg8::gemm_phase(F.lds, g, S, E);
        pg8::gemm_small(F.lds, g, E, MP, MS, F.G, (int)blockIdx.x);
    } PH_END(8)
    PH_BEGIN(9) {
        pg8::Gemm g{HB, (const bf16_t*)(F.ws + WS_WGU2), M, 2 * DFF, DM, DM, 0}; S.init(M, 2 * DFF, F.G, (int)blockIdx.x);
        pg8::Epi E{}; E.kind = pg8::EK_GU; E.stats_in = stA; E.obf = ACT; E.ldo = DFF;
        pg8::gemm_phase(F.lds, g, S, E);
    } PH_END(9)
    PH_BEGIN(10) {
        pg8::Gemm g{ACT, (const bf16_t*)(F.ws + WS_WD2), M, DM, DFF, DFF, 0}; S.init(MP, DM, F.G, (int)blockIdx.x);
        pg8::Epi E{}; E.kind = pg8::EK_RES; E.coef = 0.5f; E.res_bf = HB; E.obf = HB; E.stats_out = stB;
        pg8::gemm_phase(F.lds, g, S, E);
        pg8::gemm_small(F.lds, g, E, MP, MS, F.G, (int)blockIdx.x);
    } PH_END(10)
    PH_BEGIN(11) {
        pg8::Gemm g{HB, (const bf16_t*)(F.ws + WS_WPG), M, DM, DM, DM, 0}; S.init(MP, DM, F.G, (int)blockIdx.x);
        pg8::Epi E{}; E.kind = pg8::EK_PLE; E.stats_in = stB; E.q = Qb; E.res_bf = HB; E.of32 = H; E.stats_out = stA;
        pg8::gemm_phase(F.lds, g, S, E);
        pg8::gemm_small(F.lds, g, E, MP, MS, F.G, (int)blockIdx.x);
    } PH_END(11)
    PH_BEGIN(12) { final_phase(F); } PH_END(12)
#undef IN
#undef SEAM
#undef PH_BEGIN
#undef PH_END
}

extern "C" void kernel_launch(void* const* d_in, const int* in_sizes, int n_in, void* d_out, int out_size, void* d_ws, size_t ws_size, hipStream_t stream) {
    static int grid = 0;
    if (grid == 0) {
        if (n_in != 30 || in_sizes[0] != MP * DM || (size_t)out_size != O_END || ws_size < WS_END) {
            fprintf(stderr, "kernel_launch: shape mismatch: n_in %d in0 %d out %d ws %zu (need %zu)\n", n_in, n_in > 0 ? in_sizes[0] : -1, out_size, ws_size, (size_t)WS_END); grid = -1; return; }
        int dev = 0, cus = 0, per_cu = 0;
        if (hipGetDevice(&dev) != hipSuccess || hipDeviceGetAttribute(&cus, hipDeviceAttributeMultiprocessorCount, dev) != hipSuccess) { grid = -1; return; }
        if (hipFuncSetAttribute((const void*)mk_fwd, hipFuncAttributeMaxDynamicSharedMemorySize, LDS_BYTES) != hipSuccess) { fprintf(stderr, "kernel_launch: hipFuncSetAttribute failed\n"); grid = -1; return; }
        if (hipOccupancyMaxActiveBlocksPerMultiprocessor(&per_cu, (const void*)mk_fwd, NTHREADS, LDS_BYTES) != hipSuccess || per_cu < 1)
            fprintf(stderr, "kernel_launch: occupancy query reports %d workgroups per CU\n", per_cu);
        (void)hipGetLastError();
        grid = cus;
    }
    if (grid < 0) return;
    if (hipMemsetAsync((char*)d_ws + WS_CTL, 0, CTL_ZERO_BYTES, stream) != hipSuccess) { fprintf(stderr, "kernel_launch: memset failed\n"); return; }
    Args a{};
    for (int i = 0; i < 30; ++i) a.in[i] = (const float*)d_in[i];
    a.out = (float*)d_out; a.ws = (unsigned char*)d_ws;
#if MK_MULTI_LAUNCH
    for (int ph = 0; ph < NPHASES; ++ph) { a.ph_lo = ph; a.ph_hi = ph + 1; a.li = ph;
        hipLaunchKernelGGL(mk_fwd, dim3(grid), dim3(NTHREADS), LDS_BYTES, stream, a); }
#else
    a.ph_lo = 0; a.ph_hi = NPHASES; a.li = 0;
    hipLaunchKernelGGL(mk_fwd, dim3(grid), dim3(NTHREADS), LDS_BYTES, stream, a);
#endif
}
```

```cpp
#include <hip/hip_runtime.h>
#include <cstdio>
#include <cstdint>

#define REP_MASK 0x0
#ifndef MK_MULTI_LAUNCH
#define MK_MULTI_LAUNCH 0
#endif

#define GAS __attribute__((address_space(1)))
#define LAS __attribute__((address_space(3)))
typedef unsigned short bf16_t;
typedef short bf16x8 __attribute__((ext_vector_type(8)));
typedef float f32x4 __attribute__((ext_vector_type(4)));
typedef float f32x2 __attribute__((ext_vector_type(2)));
typedef unsigned u32x4 __attribute__((ext_vector_type(4)));
typedef unsigned u32x2 __attribute__((ext_vector_type(2)));
typedef GAS unsigned gu32;

constexpr int DM = 1024, BATCH = 8, SEQ = 2048, DECB = 128, DECS = 8;
constexpr int MP = BATCH * SEQ, MS = DECB * DECS, M = MP + MS;
constexpr int DI = 2048, HD = 64, NH = 32, NG = 8, HPG = 4, DSTATE = 128, CD = 4096;
constexpr int PD = 1024, PBUF = 15, DFF = 2816, PLE = 256;
constexpr int IN_DIM = 9248, NIN = 9472;
constexpr float EPS = 1e-6f;
constexpr int NWAVES = 8, NTHREADS = 512;

constexpr size_t MiB = 1u << 20;
constexpr size_t WS_CTL = 0, CTL_ZERO_BYTES = 32768;
constexpr size_t WS_STATS_A = 2 * MiB, WS_STATS_B = 4 * MiB, WS_DT = 6 * MiB, WS_CDEC = 9 * MiB;
constexpr size_t WS_WGU1 = 10 * MiB, WS_WD1 = 21 * MiB, WS_WIN = 27 * MiB, WS_WSSO = 46 * MiB, WS_W2 = 50 * MiB, WS_WO = 52 * MiB,
                 WS_WGU2 = 54 * MiB, WS_WD2 = 65 * MiB, WS_WPG = 71 * MiB, WS_WPLE = 73 * MiB, WS_PB = 74 * MiB, WS_WPOT = 480 * MiB, WS_WGRP = 483 * MiB;
constexpr size_t WS_Z = 84 * MiB, WS_XBC = 152 * MiB, WS_V = 288 * MiB, WS_GATES = 322 * MiB, WS_HB = 390 * MiB, WS_HPREV = 424 * MiB, WS_HALO = 488 * MiB, WS_END = 492 * MiB;
constexpr size_t WS_ACT = WS_XBC, WS_T1 = WS_XBC, WS_MERGED = 220 * MiB, WS_Q = WS_V, WS_XB = WS_HB;
static_assert(WS_STATS_A + (size_t)M * 16 * 4 <= WS_STATS_B && WS_STATS_B + (size_t)M * 16 * 4 <= WS_DT && WS_DT + (size_t)M * 32 * 4 <= WS_WGU1, "ws map (small)");
static_assert(WS_WGU1 + (size_t)2 * DFF * DM * 2 <= WS_WD1 && WS_WD1 + (size_t)DM * DFF * 2 <= WS_WIN && WS_WIN + (size_t)NIN * DM * 2 <= WS_WSSO && WS_WSSO + (size_t)DM * DI * 2 <= WS_W2, "ws map (w1)");
static_assert(WS_WGU2 + (size_t)2 * DFF * DM * 2 <= WS_WD2 && WS_WD2 + (size_t)DM * DFF * 2 <= WS_WPG && WS_WPLE + (size_t)DM * PLE * 2 <= WS_PB && WS_PB + (size_t)M * PLE * 2 <= WS_Z, "ws map (w2)");
static_assert(WS_Z + (size_t)M * DI * 2 <= WS_XBC && WS_XBC + (size_t)M * CD * 2 <= WS_V && WS_V + (size_t)M * PD * 2 <= WS_GATES && WS_GATES + (size_t)M * 2 * DM * 2 <= WS_HB &&
              WS_HB + (size_t)M * DM * 2 <= WS_HPREV && WS_HPREV + (size_t)BATCH * 16 * NH * HD * DSTATE * 2 <= WS_END, "ws map (act)");
static_assert(WS_ACT + (size_t)M * DFF * 2 <= WS_V && WS_T1 + (size_t)M * DM * 4 <= WS_MERGED && WS_MERGED + (size_t)M * DM * 2 <= WS_V, "ws overlays");
constexpr int CW_BAR = 4096;

constexpr size_t O_Y = 0, O_SSM_P = (size_t)M * DM, O_CONV_P = O_SSM_P + (size_t)BATCH * NH * HD * DSTATE, O_POOL_P = O_CONV_P + (size_t)BATCH * 3 * CD,
                 O_SSM_S = O_POOL_P + (size_t)BATCH * PBUF * PD, O_CONV_S = O_SSM_S + (size_t)DECB * NH * HD * DSTATE, O_POOL_S = O_CONV_S + (size_t)DECB * 3 * CD,
                 O_END = O_POOL_S + (size_t)DECB * PBUF * PD;

constexpr int RING_BYTES = 131072, LDSCTL_OFF = RING_BYTES, MISC_OFF = LDSCTL_OFF + 320, LDS_BYTES = 147456;

#define RLX_AGENT __ATOMIC_RELAXED, __HIP_MEMORY_SCOPE_AGENT
#define LDS_WAIT() asm volatile("s_waitcnt lgkmcnt(0)" ::: "memory")
#define VM_WAIT() asm volatile("s_waitcnt vmcnt(0)" ::: "memory")

__device__ __forceinline__ unsigned f2bf(float f) { unsigned u = __builtin_bit_cast(unsigned, f); return (u + 0x7fffu + ((u >> 16) & 1u)) >> 16; }
__device__ __forceinline__ unsigned cvt_pk_bf16(float lo, float hi);
__device__ __forceinline__ unsigned pk2(float lo, float hi) { return cvt_pk_bf16(lo, hi); }
__device__ __forceinline__ float bf2f(unsigned b) { return __builtin_bit_cast(float, b << 16); }
__device__ __forceinline__ float bflo(unsigned w) { return __builtin_bit_cast(float, w << 16); }
__device__ __forceinline__ float bfhi(unsigned w) { return __builtin_bit_cast(float, w & 0xffff0000u); }
typedef __bf16 bf16x2_t __attribute__((ext_vector_type(2)));
__device__ __forceinline__ unsigned cvt_pk_bf16(float lo, float hi) { const bf16x2_t v = {(__bf16)lo, (__bf16)hi}; return __builtin_bit_cast(unsigned, v); }
__device__ __forceinline__ float sigm_f(float x) { return __builtin_amdgcn_rcpf(1.0f + __expf(-x)); }
__device__ __forceinline__ float silu_f(float x) { return x * __builtin_amdgcn_rcpf(1.0f + __expf(-x)); }
__device__ __forceinline__ float wave_sum(float v) {
#pragma unroll
    for (int o = 1; o < 64; o <<= 1) v += __shfl_xor(v, o);
    return v;
}

struct Frame {
    LAS unsigned char* lds;
    volatile LAS unsigned* MISC;
    gu32* ctl;
    int tid, lane, wave, vcu, G;
    unsigned char* ws;
    float* out;
    const float* in[30];
};
enum { I_XP = 0, I_XS, I_SSM, I_CONV, I_POOL, I_PP, I_PS, I_NFFN1, I_WGU1, I_WD1, I_NMIX, I_WIN, I_CONVW, I_CONVB, I_DTB, I_ALOG, I_DSKIP, I_NSSD, I_WSSO, I_WPGRP, I_PSCALE,
       I_WPOUT, I_WO, I_NFFN2, I_WGU2, I_WD2, I_NPLE, I_WPG, I_WPLE, I_NFINAL };

namespace pg8 {
constexpr int BM = 256, BK = 64, HALF = 128, HTB = HALF * BK * 2, STAGE_BYTES = 8 * HTB, NXCD = 8, WGM = 4;
__host__ __device__ __forceinline__ int lds_byte(int r, int c) { const int st = (r >> 4) * 2 + (c >> 5), rr = r & 15, cc = c & 31, ob = rr * 64 + cc * 2; return st * 1024 + (ob ^ (((ob >> 9) & 1) << 5)); }
__host__ __device__ __forceinline__ void stage_rc(int b, int& R, int& C) { const int st = b / 1024, sb = b % 1024, swz = sb ^ (((sb >> 9) & 1) << 5); R = (st >> 1) * 16 + swz / 64; C = (st & 1) * 32 + (swz % 64) / 2; }
__host__ __device__ __forceinline__ int perm32(int rho) { const int n = rho >> 4, i = rho & 15; return 8 * (i >> 2) + 4 * n + (i & 3); }
struct Unit { int pm, pn; };
struct Gemm { const bf16_t* A; const bf16_t* Bt; int M, N, K; int lda; int a_pn_step; };
struct StaticOrder {
    int nM, nN, nwg, G, c;
    __host__ __device__ void init(int M_, int N_, int G_, int c_) { nM = M_ / BM; nN = N_ / BM; nwg = nM * nN; G = G_; c = c_; }
    __host__ __device__ void init_tail(int M_, int N_, int G_, int c_) { init(M_, N_, G_, (G_ - 1) - c_); }
    __host__ __device__ bool next(int i, Unit& u) const {
        const long L = (long)i * G + c; if (L >= nwg) return false;
        int wgid = (int)L; { const int q = nwg / NXCD, r = nwg % NXCD, xcd = wgid % NXCD, off = wgid / NXCD; wgid = (xcd < r ? xcd * (q + 1) : r * (q + 1) + (xcd - r) * q) + off; }
        const int nig = WGM * nN, gid = wgid / nig, fm = gid * WGM, gsz = (nM - fm) < WGM ? (nM - fm) : WGM;
        u.pm = fm + ((wgid % nig) % gsz); u.pn = (wgid % nig) / gsz; return true;
    }
};

enum EpiKind { EK_GU = 1, EK_RES = 2, EK_WIN = 3, EK_T1 = 4, EK_MERGE = 5, EK_BF16 = 6, EK_PLE = 7 };
struct Epi {
    const float* stats_in;
    float* stats_out;
    bf16_t* obf;
    float* of32;
    const float* res_p; const float* res_s;
    const bf16_t* res_bf;
    const bf16_t* gates;
    const bf16_t* q;
    bf16_t *Z, *XBC, *V, *GATES, *HALO; float* DT; const float* dt_bias; float *conv_p, *conv_s, *pool_p, *pool_s;
    int kind; int ldo; float coef; int pad;
};

__device__ __forceinline__ u32x4 pack8(const f32x4 a, const f32x4 b) { u32x4 w; w.x = cvt_pk_bf16(a[0], a[1]); w.y = cvt_pk_bf16(a[2], a[3]); w.z = cvt_pk_bf16(b[0], b[1]); w.w = cvt_pk_bf16(b[2], b[3]); return w; }
__device__ __forceinline__ void unpack8(const u32x4 w, f32x4& a, f32x4& b) { a = (f32x4){bflo(w.x), bfhi(w.x), bflo(w.y), bfhi(w.y)}; b = (f32x4){bflo(w.z), bfhi(w.z), bflo(w.w), bfhi(w.w)}; }

__device__ __forceinline__ float row_rs(const float* stats, int row) {
    if (!stats) return 1.0f;
    const GAS f32x4* sp = (const GAS f32x4*)(stats + (size_t)row * 16);
    const f32x4 a = sp[0], b = sp[1], c = sp[2], d = sp[3]; const f32x4 s = (a + b) + (c + d);
    return __builtin_amdgcn_rsqf(((s[0] + s[1]) + (s[2] + s[3])) * (1.0f / 1024.0f) + EPS);
}
__device__ __forceinline__ float softplus_f(float x) { const float e = __expf(-fabsf(x)); const float l = (e < 0.01f) ? e * (1.0f - e * (0.5f - e * (1.0f / 3.0f))) : __logf(1.0f + e); return fmaxf(x, 0.f) + l; }

__device__ __forceinline__ void epilogue(const Epi& E, const f32x4 (&acc)[2][2][4][2], const Unit& u, int wr, int wc, int fr, int fq) {
    const int rowb = u.pm * BM + wr * 64 + fr;
    const int cin = wc * 32 + 8 * fq;
    if (E.kind == EK_GU) {
#pragma unroll
        for (int ai = 0; ai < 2; ++ai)
#pragma unroll
            for (int m = 0; m < 4; ++m) { const int row = rowb + ai * HALF + m * 16; const float r = row_rs(E.stats_in, row);
                const f32x4 g0 = acc[ai][0][m][0] * r, u0 = acc[ai][1][m][0] * r, g1 = acc[ai][0][m][1] * r, u1 = acc[ai][1][m][1] * r;
                const f32x4 o0 = (f32x4){silu_f(g0[0]) * u0[0], silu_f(g0[1]) * u0[1], silu_f(g0[2]) * u0[2], silu_f(g0[3]) * u0[3]};
                const f32x4 o1 = (f32x4){silu_f(g1[0]) * u1[0], silu_f(g1[1]) * u1[1], silu_f(g1[2]) * u1[2], silu_f(g1[3]) * u1[3]};
                *(GAS u32x4*)(E.obf + (size_t)row * E.ldo + u.pn * HALF + cin) = pack8(o0, o1); }
    } else if (E.kind == EK_RES) {
#pragma unroll
        for (int ai = 0; ai < 2; ++ai)
#pragma unroll
            for (int m = 0; m < 4; ++m) { const int row = rowb + ai * HALF + m * 16;
                float ss = 0.f;
#pragma unroll
                for (int bj = 0; bj < 2; ++bj) { const int col = u.pn * BM + bj * HALF + cin;
                    f32x4 r0, r1;
                    if (E.res_p) { const float* rp = (row < MP) ? E.res_p + (size_t)row * DM : E.res_s + (size_t)(row - MP) * DM; r0 = *(const GAS f32x4*)(rp + col); r1 = *(const GAS f32x4*)(rp + col + 4); }
                    else unpack8(*(const GAS u32x4*)(E.res_bf + (size_t)row * DM + col), r0, r1);
                    const f32x4 h0 = r0 + acc[ai][bj][m][0] * E.coef, h1 = r1 + acc[ai][bj][m][1] * E.coef;
                    *(GAS u32x4*)(E.obf + (size_t)row * DM + col) = pack8(h0, h1);
                    ss += (h0[0] * h0[0] + h0[1] * h0[1]) + (h0[2] * h0[2] + h0[3] * h0[3]) + (h1[0] * h1[0] + h1[1] * h1[1]) + (h1[2] * h1[2] + h1[3] * h1[3]); }
                ss += __shfl_xor(ss, 16); ss += __shfl_xor(ss, 32);
                if (fq == 0) *(GAS float*)(E.stats_out + (size_t)row * 16 + u.pn * 4 + wc) = ss; }
    } else if (E.kind == EK_WIN) {
        const int pn = u.pn;
        if (pn < 8) {
            const int colt = pn * BM + cin;
#pragma unroll
            for (int ai = 0; ai < 2; ++ai)
#pragma unroll
                for (int m = 0; m < 4; ++m) { const int row = rowb + ai * HALF + m * 16; const float r = row_rs(E.stats_in, row);
#pragma unroll
                    for (int bj = 0; bj < 2; ++bj) { f32x4 v0 = acc[ai][bj][m][0] * r, v1 = acc[ai][bj][m][1] * r;
#pragma unroll
                        for (int j = 0; j < 4; ++j) { v0[j] = silu_f(v0[j]); v1[j] = silu_f(v1[j]); }
                        *(GAS u32x4*)(E.Z + (size_t)row * DI + colt + bj * HALF) = pack8(v0, v1); } }
        } else if (pn >= 28 && pn < 36) {
            const int colt = (pn - 28) * BM + cin;
#pragma unroll
            for (int ai = 0; ai < 2; ++ai)
#pragma unroll
                for (int m = 0; m < 4; ++m) { const int row = rowb + ai * HALF + m * 16; const float r = row_rs(E.stats_in, row);
#pragma unroll
                    for (int bj = 0; bj < 2; ++bj) { f32x4 v0 = acc[ai][bj][m][0] * r, v1 = acc[ai][bj][m][1] * r;
#pragma unroll
                        for (int j = 0; j < 4; ++j) { v0[j] = sigm_f(v0[j]); v1[j] = sigm_f(v1[j]); }
                        *(GAS u32x4*)(E.GATES + (size_t)row * (2 * DM) + colt + bj * HALF) = pack8(v0, v1); } }
        } else if (pn < 28) {
            const bool isx = pn < 24; bf16_t* const O = isx ? E.XBC : E.V; const int ldo = isx ? CD : PD; const int colt = (isx ? pn - 8 : pn - 24) * BM + cin;
            const int keep = isx ? 3 : PBUF;
#pragma unroll
            for (int ai = 0; ai < 2; ++ai)
#pragma unroll
                for (int m = 0; m < 4; ++m) { const int row = rowb + ai * HALF + m * 16; const float r = row_rs(E.stats_in, row);
                    float* sp = nullptr;
                    if (row < MP) { const int sb = row >> 11, st = row & (SEQ - 1); if (st >= SEQ - keep) sp = (isx ? E.conv_p : E.pool_p) + ((size_t)sb * keep + (st - (SEQ - keep))) * ldo + colt; }
                    else { const int sb = (row - MP) >> 3, st = (row - MP) & 7; const int si = st - (DECS - keep); if (si >= 0) sp = (isx ? E.conv_s : E.pool_s) + ((size_t)sb * keep + si) * ldo + colt; }
                    bf16_t* hp = nullptr;
                    if (isx && row < MP) { const int st = row & (SEQ - 1), tm = st & 127; if (tm >= 125 && st < SEQ - 3) hp = E.HALO + ((((size_t)(row >> 11) * 16 + (st >> 7) + 1) * 3 + (tm - 125)) * CD) + colt; }
#pragma unroll
                    for (int bj = 0; bj < 2; ++bj) { const f32x4 v0 = acc[ai][bj][m][0] * r, v1 = acc[ai][bj][m][1] * r;
                        const u32x4 pk = pack8(v0, v1);
                        *(GAS u32x4*)(O + (size_t)row * ldo + colt + bj * HALF) = pk;
                        if (hp) *(GAS u32x4*)(hp + bj * HALF) = pk;
                        if (sp) { *(GAS f32x4*)(sp + bj * HALF) = v0; *(GAS f32x4*)(sp + bj * HALF + 4) = v1; } } }
        } else if (wc == 0) {
            const f32x4 b0 = *(const GAS f32x4*)(E.dt_bias + 8 * fq), b1 = *(const GAS f32x4*)(E.dt_bias + 8 * fq + 4);
#pragma unroll
            for (int ai = 0; ai < 2; ++ai)
#pragma unroll
                for (int m = 0; m < 4; ++m) { const int row = rowb + ai * HALF + m * 16; const float r = row_rs(E.stats_in, row);
                    f32x4 v0 = acc[ai][0][m][0] * r + b0, v1 = acc[ai][0][m][1] * r + b1;
#pragma unroll
                    for (int j = 0; j < 4; ++j) { v0[j] = softplus_f(v0[j]); v1[j] = softplus_f(v1[j]); }
                    *(GAS f32x4*)(E.DT + (size_t)row * 32 + 8 * fq) = v0; *(GAS f32x4*)(E.DT + (size_t)row * 32 + 8 * fq + 4) = v1; }
        }
    } else if (E.kind == EK_T1) {
#pragma unroll
        for (int ai = 0; ai < 2; ++ai)
#pragma unroll
            for (int m = 0; m < 4; ++m) { const int row = rowb + ai * HALF + m * 16;
#pragma unroll
                for (int bj = 0; bj < 2; ++bj) { const int col = u.pn * BM + bj * HALF + cin;
                    f32x4 g0, g1; unpack8(*(const GAS u32x4*)(E.gates + (size_t)row * (2 * DM) + col), g0, g1);
                    *(GAS u32x4*)(E.obf + (size_t)row * DM + col) = pack8(g0 * acc[ai][bj][m][0], g1 * acc[ai][bj][m][1]); } }
    } else if (E.kind == EK_MERGE) {
#pragma unroll
        for (int ai = 0; ai < 2; ++ai)
#pragma unroll
            for (int m = 0; m < 4; ++m) { const int row = rowb + ai * HALF + m * 16;
#pragma unroll
                for (int bj = 0; bj < 2; ++bj) { const int col = u.pn * BM + bj * HALF + cin;
                    f32x4 g0, g1; unpack8(*(const GAS u32x4*)(E.gates + (size_t)row * (2 * DM) + DM + col), g0, g1);
                    f32x4 t0, t1; unpack8(*(const GAS u32x4*)(E.res_bf + (size_t)row * DM + col), t0, t1);
                    *(GAS u32x4*)(E.obf + (size_t)row * DM + col) = pack8(t0 + g0 * acc[ai][bj][m][0], t1 + g1 * acc[ai][bj][m][1]); } }
    } else if (E.kind == EK_BF16) {
#pragma unroll
        for (int ai = 0; ai < 2; ++ai)
#pragma unroll
            for (int m = 0; m < 4; ++m) { const int row = rowb + ai * HALF + m * 16;
#pragma unroll
                for (int bj = 0; bj < 2; ++bj) { const int col = u.pn * BM + bj * HALF + cin;
                    *(GAS u32x4*)(E.obf + (size_t)row * E.ldo + col) = pack8(acc[ai][bj][m][0], acc[ai][bj][m][1]); } }
    } else if (E.kind == EK_PLE) {
#pragma unroll
        for (int ai = 0; ai < 2; ++ai)
#pragma unroll
            for (int m = 0; m < 4; ++m) { const int row = rowb + ai * HALF + m * 16; const float r = row_rs(E.stats_in, row);
                float ss = 0.f;
#pragma unroll
                for (int bj = 0; bj < 2; ++bj) { const int col = u.pn * BM + bj * HALF + cin;
                    f32x4 q0, q1; unpack8(*(const GAS u32x4*)(E.q + (size_t)row * DM + col), q0, q1);
                    f32x4 r0, r1; unpack8(*(const GAS u32x4*)(E.res_bf + (size_t)row * DM + col), r0, r1);
                    f32x4 h0, h1;
#pragma unroll
                    for (int j = 0; j < 4; ++j) { h0[j] = r0[j] + sigm_f(acc[ai][bj][m][0][j] * r) * q0[j]; h1[j] = r1[j] + sigm_f(acc[ai][bj][m][1][j] * r) * q1[j]; }
                    *(GAS u32x4*)(E.obf + (size_t)row * DM + col) = pack8(h0, h1);
                    ss += (h0[0] * h0[0] + h0[1] * h0[1]) + (h0[2] * h0[2] + h0[3] * h0[3]) + (h1[0] * h1[0] + h1[1] * h1[1]) + (h1[2] * h1[2] + h1[3] * h1[3]); }
                ss += __shfl_xor(ss, 16); ss += __shfl_xor(ss, 32);
                if (fq == 0) *(GAS float*)(E.stats_out + (size_t)row * 16 + u.pn * 4 + wc) = ss; }
    }
}


__device__ __forceinline__ void epi_seg(const Epi& E, int row, int col, f32x4 v0, f32x4 v1, int lane) {
    if (E.kind == EK_RES) {
        f32x4 r0, r1;
        if (E.res_p) { const float* rp = ((row < MP) ? E.res_p + (size_t)row * DM : E.res_s + (size_t)(row - MP) * DM) + col; r0 = *(const GAS f32x4*)rp; r1 = *(const GAS f32x4*)(rp + 4); }
        else unpack8(*(const GAS u32x4*)(E.res_bf + (size_t)row * DM + col), r0, r1);
        const f32x4 h0 = r0 + v0 * E.coef, h1 = r1 + v1 * E.coef;
        *(GAS u32x4*)(E.obf + (size_t)row * DM + col) = pack8(h0, h1);
        float ss = (h0[0] * h0[0] + h0[1] * h0[1]) + (h0[2] * h0[2] + h0[3] * h0[3]) + (h1[0] * h1[0] + h1[1] * h1[1]) + (h1[2] * h1[2] + h1[3] * h1[3]);
        ss += __shfl_xor(ss, 1); ss += __shfl_xor(ss, 2); ss += __shfl_xor(ss, 4);
        if ((lane & 7) == 0) *(GAS float*)(E.stats_out + (size_t)row * 16 + (col >> 6)) = ss;
    } else if (E.kind == EK_T1) {
        f32x4 g0, g1; unpack8(*(const GAS u32x4*)(E.gates + (size_t)row * (2 * DM) + col), g0, g1);
        *(GAS u32x4*)(E.obf + (size_t)row * DM + col) = pack8(g0 * v0, g1 * v1);
    } else if (E.kind == EK_MERGE) {
        f32x4 g0, g1; unpack8(*(const GAS u32x4*)(E.gates + (size_t)row * (2 * DM) + DM + col), g0, g1);
        f32x4 t0, t1; unpack8(*(const GAS u32x4*)(E.res_bf + (size_t)row * DM + col), t0, t1);
        *(GAS u32x4*)(E.obf + (size_t)row * DM + col) = pack8(t0 + g0 * v0, t1 + g1 * v1);
    } else if (E.kind == EK_BF16) {
        *(GAS u32x4*)(E.obf + (size_t)row * E.ldo + col) = pack8(v0, v1);
    } else if (E.kind == EK_PLE) {
        const float r = row_rs(E.stats_in, row);
        f32x4 q0, q1; unpack8(*(const GAS u32x4*)(E.q + (size_t)row * DM + col), q0, q1);
        f32x4 r0, r1; unpack8(*(const GAS u32x4*)(E.res_bf + (size_t)row * DM + col), r0, r1);
        f32x4 h0, h1;
#pragma unroll
        for (int j = 0; j < 4; ++j) { h0[j] = r0[j] + sigm_f(v0[j] * r) * q0[j]; h1[j] = r1[j] + sigm_f(v1[j] * r) * q1[j]; }
        *(GAS u32x4*)(E.obf + (size_t)row * DM + col) = pack8(h0, h1);
        float ss = (h0[0] * h0[0] + h0[1] * h0[1]) + (h0[2] * h0[2] + h0[3] * h0[3]) + (h1[0] * h1[0] + h1[1] * h1[1]) + (h1[2] * h1[2] + h1[3] * h1[3]);
        ss += __shfl_xor(ss, 1); ss += __shfl_xor(ss, 2); ss += __shfl_xor(ss, 4);
        if ((lane & 7) == 0) *(GAS float*)(E.stats_out + (size_t)row * 16 + (col >> 6)) = ss;
    }
}
__device__ __forceinline__ void small_tile_sum(LAS unsigned char* lds, const bf16_t* A, int lda, const bf16_t* Bt, int K, int r0, int c0, f32x4& v0, f32x4& v1) {
    const int tid = threadIdx.x, wid = __builtin_amdgcn_readfirstlane(tid >> 6), lane = tid & 63, ql = lane & 15, gq = lane >> 4;
    f32x4 acc[4][4];
#pragma unroll
    for (int m = 0; m < 4; ++m)
#pragma unroll
        for (int n = 0; n < 4; ++n) acc[m][n] = (f32x4){0.f, 0.f, 0.f, 0.f};
    const bf16_t* const ap = A + (size_t)(r0 + ql) * lda + 8 * gq + 32 * wid;
    const bf16_t* const bp = Bt + (size_t)(c0 + ql) * K + 8 * gq + 32 * wid;
    const int nst = (K / 32 - wid + 7) / 8;
    bf16x8 af[4][4], bf[4][4];
#pragma unroll
    for (int u = 0; u < 4; ++u) if (u < nst) {
#pragma unroll
        for (int m = 0; m < 4; ++m) { af[u][m] = *(const GAS bf16x8*)(ap + (size_t)(16 * m) * lda + 256 * u); bf[u][m] = *(const GAS bf16x8*)(bp + (size_t)(16 * m) * K + 256 * u); } }
    for (int i = 0; i < nst; i += 4) {
#pragma unroll
        for (int u = 0; u < 4; ++u) if (i + u < nst) {
#pragma unroll
            for (int m = 0; m < 4; ++m)
#pragma unroll
                for (int n = 0; n < 4; ++n) acc[m][n] = __builtin_amdgcn_mfma_f32_16x16x32_bf16(bf[u][n], af[u][m], acc[m][n], 0, 0, 0);
            if (i + u + 4 < nst) {
#pragma unroll
                for (int m = 0; m < 4; ++m) { af[u][m] = *(const GAS bf16x8*)(ap + (size_t)(16 * m) * lda + 256 * (i + u + 4)); bf[u][m] = *(const GAS bf16x8*)(bp + (size_t)(16 * m) * K + 256 * (i + u + 4)); } }
        }
    }
    LAS f32x4* const slab = (LAS f32x4*)(lds + wid * 16384);
#pragma unroll
    for (int m = 0; m < 4; ++m)
#pragma unroll
        for (int n = 0; n < 4; ++n) slab[(16 * m + ql) * 16 + ((4 * n + gq) ^ ql)] = acc[m][n];
    __syncthreads();
    const int rr = 8 * wid + (lane >> 3), ch0 = 2 * (lane & 7);
    v0 = (f32x4){0.f, 0.f, 0.f, 0.f}; v1 = v0;
#pragma unroll
    for (int s8 = 0; s8 < 8; ++s8) { const LAS f32x4* sl = (const LAS f32x4*)(lds + s8 * 16384) + rr * 16; v0 += sl[ch0 ^ (rr & 15)]; v1 += sl[(ch0 + 1) ^ (rr & 15)]; }
    __syncthreads();
}
__device__ __forceinline__ void gemm_small(LAS unsigned char* lds, const Gemm g, const Epi& E, int row_base, int nrows, int G, int c) {
    const int tid = threadIdx.x, wid = __builtin_amdgcn_readfirstlane(tid >> 6), lane = tid & 63;
    const int ntn = g.N / 64, ntiles = (nrows / 64) * ntn;
    for (int v = c; v < ntiles; v += G) {
        const int r0 = row_base + 64 * (v / ntn), c0 = 64 * (v % ntn);
        f32x4 v0, v1; small_tile_sum(lds, g.A, g.lda, g.Bt, g.K, r0, c0, v0, v1);
        epi_seg(E, r0 + 8 * wid + (lane >> 3), c0 + 8 * (lane & 7), v0, v1, lane);
    }
}
struct Gemm2 { const bf16_t* A1; const bf16_t* B1; const bf16_t* A2; const bf16_t* B2; int K1, lda1, K2, lda2, N; };
__device__ __forceinline__ void gemm_small2(LAS unsigned char* lds, const Gemm2 g, const bf16_t* gates, bf16_t* out, int row_base, int nrows, int G, int c) {
    const int tid = threadIdx.x, wid = __builtin_amdgcn_readfirstlane(tid >> 6), lane = tid & 63;
    const int ntn = g.N / 64, ntiles = (nrows / 64) * ntn;
    for (int v = c; v < ntiles; v += G) {
        const int r0 = row_base + 64 * (v / ntn), c0 = 64 * (v % ntn), row = r0 + 8 * wid + (lane >> 3), col = c0 + 8 * (lane & 7);
        f32x4 a0, a1, b0, b1;
        small_tile_sum(lds, g.A1, g.lda1, g.B1, g.K1, r0, c0, a0, a1);
        small_tile_sum(lds, g.A2, g.lda2, g.B2, g.K2, r0, c0, b0, b1);
        f32x4 g00, g01, g10, g11; unpack8(*(const GAS u32x4*)(gates + (size_t)row * (2 * DM) + col), g00, g01); unpack8(*(const GAS u32x4*)(gates + (size_t)row * (2 * DM) + DM + col), g10, g11);
        *(GAS u32x4*)(out + (size_t)row * DM + col) = pack8(g00 * a0 + g10 * b0, g01 * a1 + g11 * b1);
    }
}

__device__ __forceinline__ void gemm_phase(LAS unsigned char* lds, const Gemm g, const StaticOrder& S, const Epi& E) {
    const int tid = threadIdx.x, wid = __builtin_amdgcn_readfirstlane(tid >> 6), lane = tid & 63, wr = wid >> 2, wc = wid & 3, fr = lane & 15, fq = lane >> 4;
    const int K = g.K, nt = K / BK;
    unsigned voffA[2], voffB[2];
#pragma unroll
    for (int i = 0; i < 2; ++i) { int R, C; stage_rc(tid * 16 + i * 8192, R, C); const int Rb = (R & ~31) + perm32(R & 31);
        voffA[i] = (unsigned)(R * g.lda + C) * 2u; voffB[i] = (unsigned)(Rb * K + C) * 2u; }
    const size_t kstep = (size_t)(BK * 2);
    const size_t hstep = (size_t)HALF * K * 2, hstepA = (size_t)HALF * g.lda * 2;
    const size_t tstep = 2 * hstep, tstepA = 2 * hstepA, pnstepA = (size_t)g.a_pn_step * 2;
    const unsigned ldsw = (unsigned)wid * 1024u;
    const int aoff = lds_byte(wr * 64 + fr, fq * 8), boff = lds_byte(wc * 32 + fr, fq * 8);
#define PG8_SA(b, h) (((b) * 2 + (h)) * HTB)
#define PG8_SB(b, h) ((4 + (b) * 2 + (h)) * HTB)
#define PG8_STAGE(bufoff, gbase, voff) do { _Pragma("unroll") for (int _i = 0; _i < 2; ++_i) \
        __builtin_amdgcn_global_load_lds((const unsigned*)((const char*)(gbase) + (voff)[_i]), (LAS unsigned*)(lds + (bufoff) + ldsw + _i * 8192), 16, 0, 0); } while (0)
#define PG8_LDA(dst, b, h) do { _Pragma("unroll") for (int m = 0; m < 4; ++m) _Pragma("unroll") for (int k = 0; k < 2; ++k) dst[m][k] = *(const LAS bf16x8*)(lds + PG8_SA(b, h) + aoff + m * 2048 + k * 1024); } while (0)
#define PG8_LDB(dst, b, h) do { _Pragma("unroll") for (int n = 0; n < 2; ++n) _Pragma("unroll") for (int k = 0; k < 2; ++k) dst[n][k] = *(const LAS bf16x8*)(lds + PG8_SB(b, h) + boff + n * 2048 + k * 1024); } while (0)
#define PG8_MMA(ai, bj, At, Bt) do { __builtin_amdgcn_s_setprio(1); _Pragma("unroll") for (int m = 0; m < 4; ++m) _Pragma("unroll") for (int n = 0; n < 2; ++n) _Pragma("unroll") for (int k = 0; k < 2; ++k) \
        acc[ai][bj][m][n] = __builtin_amdgcn_mfma_f32_16x16x32_bf16(Bt[n][k], At[m][k], acc[ai][bj][m][n], 0, 0, 0); __builtin_amdgcn_s_setprio(0); } while (0)
#define PG8_WAIT_V(n) asm volatile("s_waitcnt vmcnt(" #n ")" ::: "memory")
#define PG8_WAIT_L(n) asm volatile("s_waitcnt lgkmcnt(" #n ")" ::: "memory")
#define PG8_BAR __builtin_amdgcn_s_barrier()
#define PG8_SCHED __builtin_amdgcn_sched_barrier(0)
    Unit cur, nxt; int ui = 0;
    if (!S.next(0, cur)) return;
    f32x4 acc[2][2][4][2];
#pragma unroll
    for (int a = 0; a < 2; ++a)
#pragma unroll
        for (int b = 0; b < 2; ++b)
#pragma unroll
            for (int m = 0; m < 4; ++m)
#pragma unroll
                for (int n = 0; n < 2; ++n) acc[a][b][m][n] = (f32x4){0.f, 0.f, 0.f, 0.f};
    bf16x8 At[4][2], B0[2][2], B1[2][2];
    const char* cA = (const char*)g.A + (size_t)cur.pm * tstepA + (size_t)cur.pn * pnstepA; const char* cB = (const char*)g.Bt + (size_t)cur.pn * tstep;
    PG8_STAGE(PG8_SB(0, 0), cB, voffB); PG8_STAGE(PG8_SB(0, 1), cB + hstep, voffB); PG8_STAGE(PG8_SA(0, 0), cA, voffA); PG8_STAGE(PG8_SA(0, 1), cA + hstepA, voffA);
    if (wr == 1) PG8_BAR;
    PG8_WAIT_V(2); PG8_BAR;
    PG8_STAGE(PG8_SB(1, 0), cB + kstep, voffB); PG8_STAGE(PG8_SA(1, 0), cA + kstep, voffA); PG8_STAGE(PG8_SB(1, 1), cB + hstep + kstep, voffB);
    PG8_WAIT_V(6); PG8_BAR;
    for (;;) {
        const bool has_next = S.next(ui + 1, nxt);
        const char* nA = has_next ? (const char*)g.A + (size_t)nxt.pm * tstepA + (size_t)nxt.pn * pnstepA : cA; const char* nB = has_next ? (const char*)g.Bt + (size_t)nxt.pn * tstep : cB;
        for (int t = 0; t < nt; t += 2) {
            const bool last = (t == nt - 2);
            const char* a1 = cA + (size_t)(t + 1) * kstep;
            const char* a2 = last ? nA : cA + (size_t)(t + 2) * kstep; const char* b2 = last ? nB : cB + (size_t)(t + 2) * kstep;
            const char* a3 = a2 + kstep; const char* b3 = b2 + kstep;
            PG8_LDB(B0, 0, 0); PG8_LDB(B1, 0, 1); PG8_SCHED; PG8_LDA(At, 0, 0); PG8_STAGE(PG8_SA(1, 1), a1 + hstepA, voffA);
            PG8_WAIT_V(8); PG8_WAIT_L(0); PG8_BAR; PG8_MMA(0, 0, At, B0); PG8_MMA(0, 1, At, B1); PG8_BAR; PG8_SCHED;
            PG8_LDA(At, 0, 1); PG8_STAGE(PG8_SB(0, 0), b2, voffB); PG8_STAGE(PG8_SB(0, 1), b2 + hstep, voffB); PG8_STAGE(PG8_SA(0, 0), a2, voffA);
            PG8_WAIT_V(8); PG8_WAIT_L(0); PG8_BAR; PG8_MMA(1, 0, At, B0); PG8_MMA(1, 1, At, B1); PG8_BAR; PG8_SCHED;
            PG8_LDB(B0, 1, 0); PG8_LDB(B1, 1, 1); PG8_SCHED; PG8_LDA(At, 1, 0); PG8_STAGE(PG8_SA(0, 1), a2 + hstepA, voffA);
            PG8_WAIT_V(8); PG8_WAIT_L(0); PG8_BAR; PG8_MMA(0, 0, At, B0); PG8_MMA(0, 1, At, B1); PG8_BAR; PG8_SCHED;
            PG8_LDA(At, 1, 1); PG8_STAGE(PG8_SB(1, 0), b3, voffB); PG8_STAGE(PG8_SB(1, 1), b3 + hstep, voffB); PG8_STAGE(PG8_SA(1, 0), a3, voffA);
            PG8_WAIT_V(8); PG8_WAIT_L(0); PG8_BAR; PG8_MMA(1, 0, At, B0); PG8_MMA(1, 1, At, B1); PG8_BAR; PG8_SCHED;
        }
        if (wr == 0) PG8_BAR;
        epilogue(E, acc, cur, wr, wc, fr, fq);
        if (!has_next) break;
#pragma unroll
        for (int a = 0; a < 2; ++a)
#pragma unroll
            for (int b = 0; b < 2; ++b)
#pragma unroll
                for (int m = 0; m < 4; ++m)
#pragma unroll
                    for (int n = 0; n < 2; ++n) acc[a][b][m][n] = (f32x4){0.f, 0.f, 0.f, 0.f};
        cur = nxt; cA = nA; cB = nB; ++ui;
        if (wr == 1) PG8_BAR;
    }
    PG8_WAIT_V(0);
    PG8_BAR;
#undef PG8_SA
#undef PG8_SB
#undef PG8_STAGE
#undef PG8_LDA
#undef PG8_LDB
#undef PG8_MMA
#undef PG8_WAIT_V
#undef PG8_WAIT_L
#undef PG8_BAR
#undef PG8_SCHED
}

__device__ __forceinline__ void gemm_phase2(LAS unsigned char* lds, const Gemm2 g, const StaticOrder& S, const bf16_t* gates, bf16_t* out) {
    const int tid = threadIdx.x, wid = __builtin_amdgcn_readfirstlane(tid >> 6), lane = tid & 63, wr = wid >> 2, wc = wid & 3, fr = lane & 15, fq = lane >> 4;
    const int nt1 = g.K1 / BK, nt = nt1 + g.K2 / BK;
    int sR[2], sRb[2], sC[2];
#pragma unroll
    for (int i = 0; i < 2; ++i) { int R, C; stage_rc(tid * 16 + i * 8192, R, C); sR[i] = R; sRb[i] = (R & ~31) + perm32(R & 31); sC[i] = C; }
    const size_t kstep = (size_t)(BK * 2);
    const size_t hB1 = (size_t)HALF * g.K1 * 2, hA1 = (size_t)HALF * g.lda1 * 2, hB2 = (size_t)HALF * g.K2 * 2, hA2 = (size_t)HALF * g.lda2 * 2;
    const unsigned ldsw = (unsigned)wid * 1024u;
    const int aoff = lds_byte(wr * 64 + fr, fq * 8), boff = lds_byte(wc * 32 + fr, fq * 8);
#define PG8_SA(b, h) (((b) * 2 + (h)) * HTB)
#define PG8_SB(b, h) ((4 + (b) * 2 + (h)) * HTB)
#define PG8_STAGE_T(bufoff, isA, h, T) do { const int T_ = (T); const bool nx_ = T_ >= nt; const int Tl_ = nx_ ? T_ - nt : T_; const bool s2_ = !nx_ && Tl_ >= nt1; \
        const char* base_ = (isA) ? (s2_ ? cA2 + (size_t)(Tl_ - nt1) * kstep + (h) * hA2 : (nx_ ? nA1 : cA1) + (size_t)Tl_ * kstep + (h) * hA1) \
                                  : (s2_ ? cB2 + (size_t)(Tl_ - nt1) * kstep + (h) * hB2 : (nx_ ? nB1 : cB1) + (size_t)Tl_ * kstep + (h) * hB1); \
        const int ld_ = (isA) ? (s2_ ? g.lda2 : g.lda1) : (s2_ ? g.K2 : g.K1); \
        _Pragma("unroll") for (int _i = 0; _i < 2; ++_i) { const unsigned vo_ = (unsigned)(((isA) ? sR[_i] : sRb[_i]) * ld_ + sC[_i]) * 2u; \
            __builtin_amdgcn_global_load_lds((const unsigned*)(base_ + vo_), (LAS unsigned*)(lds + (bufoff) + ldsw + _i * 8192), 16, 0, 0); } } while (0)
#define PG8_LDA(dst, b, h) do { _Pragma("unroll") for (int m = 0; m < 4; ++m) _Pragma("unroll") for (int k = 0; k < 2; ++k) dst[m][k] = *(const LAS bf16x8*)(lds + PG8_SA(b, h) + aoff + m * 2048 + k * 1024); } while (0)
#define PG8_LDB(dst, b, h) do { _Pragma("unroll") for (int n = 0; n < 2; ++n) _Pragma("unroll") for (int k = 0; k < 2; ++k) dst[n][k] = *(const LAS bf16x8*)(lds + PG8_SB(b, h) + boff + n * 2048 + k * 1024); } while (0)
#define PG8_MMA(ai, bj, At, Bt) do { __builtin_amdgcn_s_setprio(1); _Pragma("unroll") for (int m = 0; m < 4; ++m) _Pragma("unroll") for (int n = 0; n < 2; ++n) _Pragma("unroll") for (int k = 0; k < 2; ++k) \
        acc[ai][bj][m][n] = __builtin_amdgcn_mfma_f32_16x16x32_bf16(Bt[n][k], At[m][k], acc[ai][bj][m][n], 0, 0, 0); __builtin_amdgcn_s_setprio(0); } while (0)
#define PG8_WAIT_V(n) asm volatile("s_waitcnt vmcnt(" #n ")" ::: "memory")
#define PG8_WAIT_L(n) asm volatile("s_waitcnt lgkmcnt(" #n ")" ::: "memory")
#define PG8_BAR __builtin_amdgcn_s_barrier()
#define PG8_SCHED __builtin_amdgcn_sched_barrier(0)
    Unit cur, nxt; int ui = 0;
    if (!S.next(0, cur)) return;
    f32x4 acc[2][2][4][2];
#pragma unroll
    for (int a = 0; a < 2; ++a)
#pragma unroll
        for (int b = 0; b < 2; ++b)
#pragma unroll
            for (int m = 0; m < 4; ++m)
#pragma unroll
                for (int n = 0; n < 2; ++n) acc[a][b][m][n] = (f32x4){0.f, 0.f, 0.f, 0.f};
    bf16x8 At[4][2], B0[2][2], B1[2][2];
    const char* cA1 = (const char*)g.A1 + (size_t)cur.pm * 2 * hA1; const char* cB1 = (const char*)g.B1 + (size_t)cur.pn * 2 * hB1;
    const char* cA2 = (const char*)g.A2 + (size_t)cur.pm * 2 * hA2; const char* cB2 = (const char*)g.B2 + (size_t)cur.pn * 2 * hB2;
    const char* nA1 = cA1; const char* nB1 = cB1;
    PG8_STAGE_T(PG8_SB(0, 0), false, 0, 0); PG8_STAGE_T(PG8_SB(0, 1), false, 1, 0); PG8_STAGE_T(PG8_SA(0, 0), true, 0, 0); PG8_STAGE_T(PG8_SA(0, 1), true, 1, 0);
    if (wr == 1) PG8_BAR;
    PG8_WAIT_V(2); PG8_BAR;
    PG8_STAGE_T(PG8_SB(1, 0), false, 0, 1); PG8_STAGE_T(PG8_SA(1, 0), true, 0, 1); PG8_STAGE_T(PG8_SB(1, 1), false, 1, 1);
    PG8_WAIT_V(6); PG8_BAR;
    for (;;) {
        const bool has_next = S.next(ui + 1, nxt);
        nA1 = has_next ? (const char*)g.A1 + (size_t)nxt.pm * 2 * hA1 : cA1; nB1 = has_next ? (const char*)g.B1 + (size_t)nxt.pn * 2 * hB1 : cB1;
        const int rowb = cur.pm * BM + wr * 64 + fr, colb = cur.pn * BM + wc * 32 + 8 * fq;
        for (int t = 0; t < nt; t += 2) {
            if (t == nt1) {
#pragma unroll
                for (int ai = 0; ai < 2; ++ai)
#pragma unroll
                    for (int m = 0; m < 4; ++m) { const bf16_t* gp = gates + (size_t)(rowb + ai * HALF + m * 16) * (2 * DM) + colb;
#pragma unroll
                        for (int bj = 0; bj < 2; ++bj) { f32x4 g00, g01, g10, g11; unpack8(*(const GAS u32x4*)(gp + bj * HALF), g00, g01); unpack8(*(const GAS u32x4*)(gp + DM + bj * HALF), g10, g11);
#pragma unroll
                            for (int j = 0; j < 4; ++j) { acc[ai][bj][m][0][j] *= g00[j] * __builtin_amdgcn_rcpf(fmaxf(g10[j], 1e-6f)); acc[ai][bj][m][1][j] *= g01[j] * __builtin_amdgcn_rcpf(fmaxf(g11[j], 1e-6f)); } } }
            }
            PG8_LDB(B0, 0, 0); PG8_LDB(B1, 0, 1); PG8_SCHED; PG8_LDA(At, 0, 0); PG8_STAGE_T(PG8_SA(1, 1), true, 1, t + 1);
            PG8_WAIT_V(8); PG8_WAIT_L(0); PG8_BAR; PG8_MMA(0, 0, At, B0); PG8_MMA(0, 1, At, B1); PG8_BAR; PG8_SCHED;
            PG8_LDA(At, 0, 1); PG8_STAGE_T(PG8_SB(0, 0), false, 0, t + 2); PG8_STAGE_T(PG8_SB(0, 1), false, 1, t + 2); PG8_STAGE_T(PG8_SA(0, 0), true, 0, t + 2);
            PG8_WAIT_V(8); PG8_WAIT_L(0); PG8_BAR; PG8_MMA(1, 0, At, B0); PG8_MMA(1, 1, At, B1); PG8_BAR; PG8_SCHED;
            PG8_LDB(B0, 1, 0); PG8_LDB(B1, 1, 1); PG8_SCHED; PG8_LDA(At, 1, 0); PG8_STAGE_T(PG8_SA(0, 1), true, 1, t + 2);
            PG8_WAIT_V(8); PG8_WAIT_L(0); PG8_BAR; PG8_MMA(0, 0, At, B0); PG8_MMA(0, 1, At, B1); PG8_BAR; PG8_SCHED;
            PG8_LDA(At, 1, 1); PG8_STAGE_T(PG8_SB(1, 0), false, 0, t + 3); PG8_STAGE_T(PG8_SB(1, 1), false, 1, t + 3); PG8_STAGE_T(PG8_SA(1, 0), true, 0, t + 3);
            PG8_WAIT_V(8); PG8_WAIT_L(0); PG8_BAR; PG8_MMA(1, 0, At, B0); PG8_MMA(1, 1, At, B1); PG8_BAR; PG8_SCHED;
        }
        if (wr == 0) PG8_BAR;
#pragma unroll
        for (int ai = 0; ai < 2; ++ai)
#pragma unroll
            for (int m = 0; m < 4; ++m) { const size_t row = (size_t)(rowb + ai * HALF + m * 16);
#pragma unroll
                for (int bj = 0; bj < 2; ++bj) { f32x4 g10, g11; unpack8(*(const GAS u32x4*)(gates + row * (2 * DM) + DM + colb + bj * HALF), g10, g11);
#pragma unroll
                    for (int j = 0; j < 4; ++j) { g10[j] = fmaxf(g10[j], 1e-6f); g11[j] = fmaxf(g11[j], 1e-6f); }
                    *(GAS u32x4*)(out + row * DM + colb + bj * HALF) = pack8(acc[ai][bj][m][0] * g10, acc[ai][bj][m][1] * g11); } }
        if (!has_next) break;
#pragma unroll
        for (int a = 0; a < 2; ++a)
#pragma unroll
            for (int b = 0; b < 2; ++b)
#pragma unroll
                for (int m = 0; m < 4; ++m)
#pragma unroll
                    for (int n = 0; n < 2; ++n) acc[a][b][m][n] = (f32x4){0.f, 0.f, 0.f, 0.f};
        cur = nxt; cA1 = nA1; cB1 = nB1; cA2 = (const char*)g.A2 + (size_t)cur.pm * 2 * hA2; cB2 = (const char*)g.B2 + (size_t)cur.pn * 2 * hB2; ++ui;
        if (wr == 1) PG8_BAR;
    }
    PG8_WAIT_V(0);
    PG8_BAR;
#undef PG8_SA
#undef PG8_SB
#undef PG8_STAGE_T
#undef PG8_LDA
#undef PG8_LDB
#undef PG8_MMA
#undef PG8_WAIT_V
#undef PG8_WAIT_L
#undef PG8_BAR
#undef PG8_SCHED
}
}

#define XB_TMO      128
#define XB_XCNT(j)  (256  + 64 * (j))
#define XB_XSUB(j)  (1280 + 64 * (j))
#define XB_XGEN(j)  (2304 + 64 * (j))
#define XB_TOP      3328
#define XB_TOPGEN   3392
#define XCD_BAR_WORDS 3456
#define XB_SPIN_CAP (1u << 18)
__device__ __forceinline__ unsigned xb_ld(unsigned* p)              { return __hip_atomic_load(p, __ATOMIC_RELAXED, __HIP_MEMORY_SCOPE_AGENT); }
__device__ __forceinline__ unsigned xb_add(unsigned* p, unsigned v) { return __hip_atomic_fetch_add(p, v, __ATOMIC_RELAXED, __HIP_MEMORY_SCOPE_AGENT); }
__device__ __forceinline__ unsigned xb_xcc_id() { return (unsigned)__builtin_amdgcn_s_getreg((3 << 11) | 20) & 0xFu; }
#define XB_SPIN(cond, bar) do { unsigned _sp = 0; while (cond) { __builtin_amdgcn_s_sleep(1); \
    if ((++_sp & 255u) == 0u) { if (xb_ld(&(bar)[XB_TMO])) break; if (_sp > XB_SPIN_CAP) { atomicAdd(&(bar)[XB_TMO], 1u); break; } } } } while (0)
struct XcdBarrier { unsigned* bar; unsigned x; volatile LAS unsigned* st; };
__device__ __forceinline__ XcdBarrier xcd_barrier_post(unsigned* bar, volatile LAS unsigned* st) {
    XcdBarrier b; b.bar = bar; b.x = xb_xcc_id(); b.st = st;
    if (threadIdx.x == 0) (void)xb_add(&bar[XB_XCNT(b.x)], 1u);
    return b;
}
__device__ __forceinline__ void xcd_barrier_complete(unsigned* bar, unsigned x, unsigned& nloc, unsigned& nx) {
    const unsigned G = gridDim.x * gridDim.y * gridDim.z;
    unsigned sum, cnt, mine, sp = 0u;
    for (;;) {
        sum = 0u; cnt = 0u; mine = 0u;
#pragma unroll
        for (unsigned j = 0; j < 16; ++j) { const unsigned c = xb_ld(&bar[XB_XCNT(j)]); sum += c; cnt += (c > 0u) ? 1u : 0u; mine = (j == x) ? c : mine; }
        if (sum == G) break;
        __builtin_amdgcn_s_sleep(1);
        if ((++sp & 255u) == 0u) { if (xb_ld(&bar[XB_TMO])) break; if (sp > XB_SPIN_CAP) { atomicAdd(&bar[XB_TMO], 1u); break; } }
    }
    nloc = mine > 0u ? mine : 1u; nx = cnt > 0u ? cnt : 1u;
}
__device__ __forceinline__ void xcd_barrier(const XcdBarrier& b) {
    asm volatile("s_waitcnt vmcnt(0)" ::: "memory");
    __syncthreads();
    if (threadIdx.x == 0) {
        unsigned* bar = b.bar;
        __builtin_amdgcn_s_waitcnt(0);
        unsigned nloc = b.st[0], nx = b.st[1];
        if (nloc == 0u) { xcd_barrier_complete(bar, b.x, nloc, nx); b.st[0] = nloc; b.st[1] = nx; }
        const unsigned old = xb_add(&bar[XB_XSUB(b.x)], 1u);
        const unsigned gen = old / nloc;
        if (old + 1u == (gen + 1u) * nloc) {
            __builtin_amdgcn_fence(__ATOMIC_RELEASE, "agent");
            asm volatile("s_waitcnt vmcnt(0)" ::: "memory");
            const unsigned og = xb_add(&bar[XB_TOP], 1u);
            const unsigned tg = og / nx;
            if (og + 1u == (tg + 1u) * nx) xb_add(&bar[XB_TOPGEN], 1u);
            else XB_SPIN(xb_ld(&bar[XB_TOPGEN]) == tg, bar);
            __builtin_amdgcn_fence(__ATOMIC_ACQUIRE, "agent");
            xb_add(&bar[XB_XGEN(b.x)], 1u);
            asm volatile("s_waitcnt vmcnt(0)" ::: "memory");
        } else {
            XB_SPIN(xb_ld(&bar[XB_XGEN(b.x)]) == gen, bar);
            __builtin_amdgcn_fence(__ATOMIC_ACQUIRE, "agent");
            asm volatile("s_waitcnt vmcnt(0)" ::: "memory");
        }
    }
    __syncthreads();
}

__device__ __forceinline__ void p0_transpose_item(const float* W, int K, int N, const float* gain, bf16_t* WT, int k0, int n0, int drow0, LAS float* scr, int lane) {
#pragma unroll
    for (int i = 0; i < 8; ++i) { const int kk = 8 * i + (lane >> 3), nn = 4 * (lane & 7);
        f32x4 v = *(const GAS f32x4*)(W + (size_t)(k0 + kk) * N + n0 + nn);
        if (gain) v = v * *(const GAS float*)(gain + k0 + kk);
        scr[kk * 33 + nn] = v.x; scr[kk * 33 + nn + 1] = v.y; scr[kk * 33 + nn + 2] = v.z; scr[kk * 33 + nn + 3] = v.w; }
    LDS_WAIT(); asm volatile("" ::: "memory");
    const int c = lane & 7;
#pragma unroll
    for (int j = 0; j < 4; ++j) { const int n = (lane >> 3) + 8 * j; const LAS float* s = scr + (8 * c) * 33 + n;
        u32x4 o; o.x = pk2(s[0 * 33], s[1 * 33]); o.y = pk2(s[2 * 33], s[3 * 33]); o.z = pk2(s[4 * 33], s[5 * 33]); o.w = pk2(s[6 * 33], s[7 * 33]);
        *(GAS u32x4*)(WT + (size_t)(drow0 + n) * K + k0 + 8 * c) = o; }
    LDS_WAIT(); asm volatile("" ::: "memory");
}
__device__ __forceinline__ int map_gu(int n0) { return n0 < DFF ? (n0 / 128) * 256 + (n0 % 128) : ((n0 - DFF) / 128) * 256 + 128 + ((n0 - DFF) % 128); }
__device__ __forceinline__ int map_win(int n0) { return n0 < 6144 ? n0 : (n0 < 6176 ? 9216 + (n0 - 6144) : n0 - 32); }

__device__ __forceinline__ void p0_prologue(Frame& F) {
    LAS float* scr = (LAS float*)(F.lds + F.wave * 16384);
    const int gw = F.vcu * NWAVES + F.wave, NGW = F.G * NWAVES, lane = F.lane;
    bf16_t* const wgu1 = (bf16_t*)(F.ws + WS_WGU1); bf16_t* const wd1 = (bf16_t*)(F.ws + WS_WD1); bf16_t* const win = (bf16_t*)(F.ws + WS_WIN);
    bf16_t* const wsso = (bf16_t*)(F.ws + WS_WSSO); bf16_t* const wo = (bf16_t*)(F.ws + WS_WO); bf16_t* const wgu2 = (bf16_t*)(F.ws + WS_WGU2);
    bf16_t* const wd2 = (bf16_t*)(F.ws + WS_WD2); bf16_t* const wpg = (bf16_t*)(F.ws + WS_WPG); bf16_t* const wple = (bf16_t*)(F.ws + WS_WPLE);
    constexpr int I_GU = (DM / 64) * (2 * DFF / 32), I_D = (DFF / 64) * (DM / 32), I_IN = (DM / 64) * (IN_DIM / 32), I_SSO = (DI / 64) * (DM / 32), I_SQ = (DM / 64) * (DM / 32), I_PLE = (PLE / 64) * (DM / 32);
    constexpr int NITEMS = 2 * I_GU + 2 * I_D + I_IN + I_SSO + 3 * I_SQ + I_PLE;
    bf16_t* const wpot = (bf16_t*)(F.ws + WS_WPOT);
    for (int it = gw; it < NITEMS; it += NGW) {
        int r = it;
        if (r < I_GU) { const int nb = 2 * DFF / 32, kb = r / nb, n0 = (r % nb) * 32; p0_transpose_item(F.in[I_WGU1], DM, 2 * DFF, F.in[I_NFFN1], wgu1, kb * 64, n0, map_gu(n0), scr, lane); continue; } r -= I_GU;
        if (r < I_GU) { const int nb = 2 * DFF / 32, kb = r / nb, n0 = (r % nb) * 32; p0_transpose_item(F.in[I_WGU2], DM, 2 * DFF, F.in[I_NFFN2], wgu2, kb * 64, n0, map_gu(n0), scr, lane); continue; } r -= I_GU;
        if (r < I_D) { const int nb = DM / 32, kb = r / nb, n0 = (r % nb) * 32; p0_transpose_item(F.in[I_WD1], DFF, DM, nullptr, wd1, kb * 64, n0, n0, scr, lane); continue; } r -= I_D;
        if (r < I_D) { const int nb = DM / 32, kb = r / nb, n0 = (r % nb) * 32; p0_transpose_item(F.in[I_WD2], DFF, DM, nullptr, wd2, kb * 64, n0, n0, scr, lane); continue; } r -= I_D;
        if (r < I_IN) { const int nb = IN_DIM / 32, kb = r / nb, n0 = (r % nb) * 32; p0_transpose_item(F.in[I_WIN], DM, IN_DIM, F.in[I_NMIX], win, kb * 64, n0, map_win(n0), scr, lane); continue; } r -= I_IN;
        if (r < I_SSO) { const int nb = DM / 32, kb = r / nb, n0 = (r % nb) * 32; p0_transpose_item(F.in[I_WSSO], DI, DM, F.in[I_NSSD], wsso, kb * 64, n0, n0, scr, lane); continue; } r -= I_SSO;
        if (r < I_SQ) { const int nb = DM / 32, kb = r / nb, n0 = (r % nb) * 32; p0_transpose_item(F.in[I_WO], DM, DM, nullptr, wo, kb * 64, n0, n0, scr, lane); continue; } r -= I_SQ;
        if (r < I_SQ) { const int nb = DM / 32, kb = r / nb, n0 = (r % nb) * 32; p0_transpose_item(F.in[I_WPG], DM, DM, F.in[I_NPLE], wpg, kb * 64, n0, n0, scr, lane); continue; } r -= I_SQ;
        if (r < I_SQ) { const int nb = DM / 32, kb = r / nb, n0 = (r % nb) * 32; p0_transpose_item(F.in[I_WPOUT], PD, DM, F.in[I_PSCALE], wpot, kb * 64, n0, n0, scr, lane); continue; } r -= I_SQ;
        { const int nb = DM / 32, kb = r / nb, n0 = (r % nb) * 32; p0_transpose_item(F.in[I_WPLE], PLE, DM, nullptr, wple, kb * 64, n0, n0, scr, lane); }
    }
    {
        bf16_t* const wgrp = (bf16_t*)(F.ws + WS_WGRP); const float* Wg = F.in[I_WPGRP];
        for (int e = F.vcu * NTHREADS + F.tid; e < 4 * 256 * 256 / 8; e += F.G * NTHREADS) {
            const f32x4 a = *(const GAS f32x4*)(Wg + (size_t)e * 8), b = *(const GAS f32x4*)(Wg + (size_t)e * 8 + 4);
            u32x4 o; o.x = pk2(a.x, a.y); o.y = pk2(a.z, a.w); o.z = pk2(b.x, b.y); o.w = pk2(b.z, b.w);
            *(GAS u32x4*)(wgrp + (size_t)e * 8) = o; }
    }
    {
        bf16_t* const XB = (bf16_t*)(F.ws + WS_XB); bf16_t* const PB = (bf16_t*)(F.ws + WS_PB); float* const stA = (float*)(F.ws + WS_STATS_A);
        for (int m = gw; m < M; m += NGW) {
            const float* xrow = (m < MP) ? F.in[I_XP] + (size_t)m * DM : F.in[I_XS] + (size_t)(m - MP) * DM;
            const GAS f32x4* xr = (const GAS f32x4*)xrow + lane;
            f32x4 v[4]; float s = 0.f;
#pragma unroll
            for (int j = 0; j < 4; ++j) { v[j] = xr[64 * j]; s += (v[j].x * v[j].x + v[j].y * v[j].y) + (v[j].z * v[j].z + v[j].w * v[j].w); }
            s = wave_sum(s);
            GAS u32x2* o8 = (GAS u32x2*)(XB + (size_t)m * DM) + lane;
#pragma unroll
            for (int j = 0; j < 4; ++j) { u32x2 w; w.x = pk2(v[j].x, v[j].y); w.y = pk2(v[j].z, v[j].w); o8[64 * j] = w; }
            if (lane < 16) *(GAS float*)(stA + (size_t)m * 16 + lane) = (lane == 0) ? s : 0.f;
            const float* prow = (m < MP) ? F.in[I_PP] + (size_t)m * PLE : F.in[I_PS] + (size_t)(m - MP) * PLE;
            const f32x4 pv = *((const GAS f32x4*)prow + lane);
            u32x2 w; w.x = pk2(pv.x, pv.y); w.y = pk2(pv.z, pv.w); *((GAS u32x2*)(PB + (size_t)m * PLE) + lane) = w;
        }
    }
}


typedef short v4i16_t __attribute__((ext_vector_type(4)));
constexpr int IMG_B = 0, IMG_C = 32768, IMG_X = 65536, TAB_ACS = RING_BYTES + 1024, TAB_DT = TAB_ACS + 2048, TAB_SD = TAB_DT + 2048;
constexpr int NCHUNK = SEQ / 128;
template <bool XS> __device__ __forceinline__ int img_off(int row, int ch) { return XS ? 256 * row + 16 * (ch ^ ((row & 7) << 1)) : 256 * row + 16 * (ch ^ (((row & 3) << 2) | ((row >> 2) & 3))); }
__device__ __forceinline__ bf16x8 tr_pair(const LAS unsigned char* p0, const LAS unsigned char* p1) {
    const v4i16_t a = __builtin_amdgcn_ds_read_tr16_b64_v4i16((LAS v4i16_t*)p0), b = __builtin_amdgcn_ds_read_tr16_b64_v4i16((LAS v4i16_t*)p1);
    return (bf16x8){a[0], a[1], a[2], a[3], b[0], b[1], b[2], b[3]};
}
__device__ __forceinline__ void ssd_tables_load(Frame& F, size_t row0, int g, float& d0, float& d1) {
    if (F.wave < 4) { const float* const DT = (const float*)(F.ws + WS_DT); const int head = g * HPG + F.wave;
        d0 = *(const GAS float*)(DT + (row0 + 2 * F.lane) * 32 + head); d1 = *(const GAS float*)(DT + (row0 + 2 * F.lane + 1) * 32 + head); }
}
__device__ __forceinline__ void ssd_tables_compute(Frame& F, int g, float d0, float d1) {
    LAS float* const acs = (LAS float*)(F.lds + TAB_ACS); LAS float* const dtl = (LAS float*)(F.lds + TAB_DT); LAS float* const sdec = (LAS float*)(F.lds + TAB_SD);
    if (F.wave < 4) {
        const int r = F.wave, lane = F.lane, head = g * HPG + r;
        const float Ah = -__expf(*(const GAS float*)(F.in[I_ALOG] + head));
        const float a0 = d0 * Ah, a1 = d1 * Ah, loc = a0 + a1;
        float inc = loc;
#pragma unroll
        for (int o = 1; o < 64; o <<= 1) { const float t = __shfl_up(inc, o); if (lane >= o) inc += t; }
        const float exc = inc - loc;
        acs[(2 * lane) * 4 + r] = exc + a0; acs[(2 * lane + 1) * 4 + r] = inc;
        dtl[(2 * lane) * 4 + r] = d0; dtl[(2 * lane + 1) * 4 + r] = d1;
    }
    __syncthreads();
    { const int s = F.tid >> 2, r = F.tid & 3; sdec[s * 4 + r] = __expf(acs[127 * 4 + r] - acs[s * 4 + r]) * dtl[s * 4 + r]; }
    __syncthreads();
}
__device__ __forceinline__ void ssd_tables(Frame& F, size_t row0, int g) { float d0 = 0.f, d1 = 0.f; ssd_tables_load(F, row0, g, d0, d1); ssd_tables_compute(F, g, d0, d1); }
struct ConvMap { int kind, cc, run, gch; };
__device__ __forceinline__ ConvMap ssd_conv_map(int t, int g) {
    ConvMap m;
    if (t < 256) { m.kind = 0; m.cc = t & 31; m.run = t >> 5; } else if (t < 384) { m.kind = 1; m.cc = (t - 256) & 15; m.run = (t - 256) >> 4; } else { m.kind = 2; m.cc = (t - 384) & 15; m.run = (t - 384) >> 4; }
    m.gch = (m.kind == 0 ? g * 256 : (m.kind == 1 ? DI + g * DSTATE : DI + NG * DSTATE + g * DSTATE)) + 8 * m.cc;
    return m;
}
__device__ __forceinline__ void ssd_conv_load(Frame& F, size_t row0, int b, int c, int g, u32x4 (&raw)[19]) {
    const ConvMap m = ssd_conv_map(F.tid, g);
    const bf16_t* const XBC = (const bf16_t*)(F.ws + WS_XBC); const bf16_t* const HALO = (const bf16_t*)(F.ws + WS_HALO);
#pragma unroll
    for (int i = 0; i < 19; ++i) {
        if (i < 3 && m.run == 0) { if (c == 0) raw[i] = (u32x4){0u, 0u, 0u, 0u}; else raw[i] = *(const GAS u32x4*)(HALO + ((((size_t)b * 16 + c) * 3 + i) * CD) + m.gch); }
        else raw[i] = *(const GAS u32x4*)(XBC + (row0 + 16 * m.run + i - 3) * CD + m.gch); }
}
__device__ __forceinline__ void ssd_conv_store(Frame& F, size_t row0, int g, const u32x4 (&raw)[19]) {
    const ConvMap m = ssd_conv_map(F.tid, g);
    bf16_t* const XBC = (bf16_t*)(F.ws + WS_XBC);
    const float* const convw = F.in[I_CONVW]; const float* const convb = F.in[I_CONVB];
    float cw[4][8], cb[8];
#pragma unroll
    for (int k = 0; k < 4; ++k) { const f32x4 a = *(const GAS f32x4*)(convw + (size_t)k * CD + m.gch), b_ = *(const GAS f32x4*)(convw + (size_t)k * CD + m.gch + 4);
        cw[k][0] = a.x; cw[k][1] = a.y; cw[k][2] = a.z; cw[k][3] = a.w; cw[k][4] = b_.x; cw[k][5] = b_.y; cw[k][6] = b_.z; cw[k][7] = b_.w; }
    { const f32x4 a = *(const GAS f32x4*)(convb + m.gch), b_ = *(const GAS f32x4*)(convb + m.gch + 4); cb[0] = a.x; cb[1] = a.y; cb[2] = a.z; cb[3] = a.w; cb[4] = b_.x; cb[5] = b_.y; cb[6] = b_.z; cb[7] = b_.w; }
    LAS unsigned char* const img = F.lds + (m.kind == 0 ? IMG_X + (m.cc >> 4) * 32768 : IMG_B);
    const LAS float* const sdec = (const LAS float*)(F.lds + TAB_SD);
    const int chl = m.cc & 15, hr = m.cc >> 3;
#pragma unroll
    for (int i = 0; i < 16; ++i) {
        const int s = 16 * m.run + i;
        float o[8];
#pragma unroll
        for (int j2 = 0; j2 < 4; ++j2) {
            const unsigned w0 = raw[i][j2], w1 = raw[i + 1][j2], w2 = raw[i + 2][j2], w3 = raw[i + 3][j2];
            const float lo = cb[2 * j2] + cw[0][2 * j2] * bflo(w0) + cw[1][2 * j2] * bflo(w1) + cw[2][2 * j2] * bflo(w2) + cw[3][2 * j2] * bflo(w3);
            const float hi = cb[2 * j2 + 1] + cw[0][2 * j2 + 1] * bfhi(w0) + cw[1][2 * j2 + 1] * bfhi(w1) + cw[2][2 * j2 + 1] * bfhi(w2) + cw[3][2 * j2 + 1] * bfhi(w3);
            o[2 * j2] = silu_f(lo); o[2 * j2 + 1] = silu_f(hi);
        }
        u32x4 pk; pk.x = cvt_pk_bf16(o[0], o[1]); pk.y = cvt_pk_bf16(o[2], o[3]); pk.z = cvt_pk_bf16(o[4], o[5]); pk.w = cvt_pk_bf16(o[6], o[7]);
        *(GAS u32x4*)(XBC + (row0 + s) * CD + m.gch) = pk;
        if (m.kind == 0) { const float sc = sdec[s * 4 + hr];
            pk.x = cvt_pk_bf16(o[0] * sc, o[1] * sc); pk.y = cvt_pk_bf16(o[2] * sc, o[3] * sc); pk.z = cvt_pk_bf16(o[4] * sc, o[5] * sc); pk.w = cvt_pk_bf16(o[6] * sc, o[7] * sc); }
        if (m.kind != 2) *(LAS u32x4*)(img + img_off<false>(s, chl)) = pk;
    }
}
__device__ __forceinline__ void ssd_copy_load(Frame& F, size_t row0, int g, u32x4 (&raw)[16]) {
    const ConvMap m = ssd_conv_map(F.tid, g);
    const bf16_t* const XBC = (const bf16_t*)(F.ws + WS_XBC);
#pragma unroll
    for (int i = 0; i < 16; ++i) raw[i] = *(const GAS u32x4*)(XBC + (row0 + 16 * m.run + i) * CD + m.gch);
}
__device__ __forceinline__ void ssd_copy_store(Frame& F, int g, const u32x4 (&raw)[16]) {
    const ConvMap m = ssd_conv_map(F.tid, g);
    LAS unsigned char* const img = F.lds + (m.kind == 0 ? IMG_X + (m.cc >> 4) * 32768 : (m.kind == 1 ? IMG_B : IMG_C));
    const int chl = m.cc & 15;
#pragma unroll
    for (int i = 0; i < 16; ++i) { const int s = 16 * m.run + i; *(LAS u32x4*)(img + (m.kind == 0 ? img_off<true>(s, chl) : img_off<false>(s, chl))) = raw[i]; }
}
__device__ __forceinline__ void ssd_states_phase(Frame& F) {
    bf16_t* const ST = (bf16_t*)(F.ws + WS_HPREV);
    float* const CDEC = (float*)(F.ws + WS_CDEC);
    const int w = F.wave, lane = F.lane, ql = lane & 15, gq = lane >> 4, qq = ql >> 2, pp = ql & 3, r = w >> 1, nh = w & 1;
    int sbo[4][2], sxo[4][2];
#pragma unroll
    for (int f = 0; f < 4; ++f) { const int colb = 64 * nh + 16 * f + 4 * pp, colx = 64 * (r & 1) + 16 * f + 4 * pp;
#pragma unroll
        for (int t4 = 0; t4 < 2; ++t4) { sbo[f][t4] = img_off<false>(8 * gq + qq + 4 * t4, colb >> 3) + 2 * (colb & 7); sxo[f][t4] = img_off<false>(8 * gq + qq + 4 * t4, colx >> 3) + 2 * (colx & 7); } }
    u32x4 raw[19]; float d0 = 0.f, d1 = 0.f;
    constexpr int NIT = BATCH * NCHUNK * NG;
    if (F.vcu < NIT) { const int it = F.vcu, g = it & 7, c = (it >> 3) & (NCHUNK - 1), b = it >> 7; const size_t row0 = (size_t)b * SEQ + (size_t)c * 128;
        ssd_conv_load(F, row0, b, c, g, raw); ssd_tables_load(F, row0, g, d0, d1); }
    for (int it = F.vcu; it < NIT; it += F.G) {
        const int g = it & 7, c = (it >> 3) & (NCHUNK - 1), b = it >> 7;
        const size_t row0 = (size_t)b * SEQ + (size_t)c * 128;
        asm volatile("s_waitcnt vmcnt(0)" ::: "memory");
        ssd_tables_compute(F, g, d0, d1);
        ssd_conv_store(F, row0, g, raw);
        __syncthreads();
        if (it + F.G < NIT) { const int it2 = it + F.G, g2 = it2 & 7, c2 = (it2 >> 3) & (NCHUNK - 1), b2 = it2 >> 7; const size_t row2 = (size_t)b2 * SEQ + (size_t)c2 * 128;
            ssd_conv_load(F, row2, b2, c2, g2, raw); ssd_tables_load(F, row2, g2, d0, d1); }
        const int head = g * HPG + r;
        bf16_t* const stp = ST + ((((size_t)b * NCHUNK + c) * NH + head) * HD) * DSTATE;
#pragma unroll
        for (int nh2 = 0; nh2 < 2; ++nh2) {
            f32x4 acc[2][4];
#pragma unroll
            for (int i = 0; i < 2; ++i)
#pragma unroll
                for (int j = 0; j < 4; ++j) acc[i][j] = (f32x4){0.f, 0.f, 0.f, 0.f};
#pragma unroll
            for (int ks = 0; ks < 4; ++ks) {
                bf16x8 af[2], xf[4];
#pragma unroll
                for (int nf = 0; nf < 2; ++nf) { const LAS unsigned char* p = F.lds + IMG_B + sbo[2 * nh2 + nf][0] + 8192 * ks; const LAS unsigned char* p4 = F.lds + IMG_B + sbo[2 * nh2 + nf][1] + 8192 * ks; af[nf] = tr_pair(p, p4); }
#pragma unroll
                for (int pf = 0; pf < 4; ++pf) { const LAS unsigned char* p = F.lds + IMG_X + (r >> 1) * 32768 + sxo[pf][0] + 8192 * ks; const LAS unsigned char* p4 = F.lds + IMG_X + (r >> 1) * 32768 + sxo[pf][1] + 8192 * ks; xf[pf] = tr_pair(p, p4); }
#pragma unroll
                for (int nf = 0; nf < 2; ++nf)
#pragma unroll
                    for (int pf = 0; pf < 4; ++pf) acc[nf][pf] = __builtin_amdgcn_mfma_f32_16x16x32_bf16(af[nf], xf[pf], acc[nf][pf], 0, 0, 0);
            }
#pragma unroll
            for (int pf = 0; pf < 4; ++pf)
#pragma unroll
                for (int nf = 0; nf < 2; ++nf) { u32x2 o; o.x = cvt_pk_bf16(acc[nf][pf][0], acc[nf][pf][1]); o.y = cvt_pk_bf16(acc[nf][pf][2], acc[nf][pf][3]);
                    *(GAS u32x2*)(stp + (size_t)(16 * pf + ql) * DSTATE + 64 * nh + 32 * nh2 + 16 * nf + 4 * gq) = o; }
        }
        if (F.tid < 4) { const LAS float* acs = (const LAS float*)(F.lds + TAB_ACS); *(GAS float*)(CDEC + ((size_t)b * NCHUNK + c) * NH + g * HPG + F.tid) = __expf(acs[127 * 4 + F.tid]); }
        __syncthreads();
    }
}
__device__ __forceinline__ void ssd_scan_phase(Frame& F) {
    bf16_t* const HP = (bf16_t*)(F.ws + WS_HPREV); const float* const CDEC = (const float*)(F.ws + WS_CDEC); float* const hout = F.out + O_SSM_P;
    const int gt = F.vcu * NTHREADS + F.tid, NT = F.G * NTHREADS;
    constexpr int PER = NH * HD * DSTATE / 8;
    for (int e = gt; e < BATCH * PER; e += NT) {
        const int b = e / PER, i8 = e % PER, head = i8 / (HD * DSTATE / 8);
        u32x4 stv[NCHUNK];
#pragma unroll
        for (int c = 0; c < NCHUNK; ++c) stv[c] = *(const GAS u32x4*)(HP + (((size_t)b * NCHUNK + c) * (size_t)PER + i8) * 8);
        f32x4 h0 = (f32x4){0.f, 0.f, 0.f, 0.f}, h1 = h0;
#pragma unroll
        for (int c = 0; c < NCHUNK; ++c) {
            if (c > 0) *(GAS u32x4*)(HP + (((size_t)b * NCHUNK + c) * (size_t)PER + i8) * 8) = pg8::pack8(h0, h1);
            const float d = *(const GAS float*)(CDEC + ((size_t)b * NCHUNK + c) * NH + head);
            f32x4 s0, s1; pg8::unpack8(stv[c], s0, s1);
            h0 = h0 * d + s0; h1 = h1 * d + s1;
        }
        *(GAS f32x4*)(hout + ((size_t)b * PER + i8) * 8) = h0; *(GAS f32x4*)(hout + ((size_t)b * PER + i8) * 8 + 4) = h1;
    }
}
__device__ __forceinline__ void ssd_out_phase(Frame& F) {
    const bf16_t* const HP = (const bf16_t*)(F.ws + WS_HPREV); bf16_t* const ZY = (bf16_t*)(F.ws + WS_Z);
    const int w = F.wave, lane = F.lane, ql = lane & 15, gq = lane >> 4, qq = ql >> 2, pp = ql & 3, q0 = 16 * w;
    const LAS float* const acs = (const LAS float*)(F.lds + TAB_ACS); const LAS float* const dtl = (const LAS float*)(F.lds + TAB_DT);
    int cfo[4], bbo[4], hbo[4], xbo[2][4];
#pragma unroll
    for (int ks = 0; ks < 4; ++ks) { cfo[ks] = IMG_C + img_off<false>(q0 + ql, 4 * ks + gq); bbo[ks] = IMG_B + img_off<false>(ql, 4 * ks + gq); hbo[ks] = img_off<false>(ql, 4 * ks + gq); }
#pragma unroll
    for (int rr = 0; rr < 2; ++rr)
#pragma unroll
        for (int pf = 0; pf < 4; ++pf) xbo[rr][pf] = IMG_X + img_off<true>(4 * gq + qq, 8 * rr + 2 * pf + (pp >> 1)) + 8 * (pp & 1);
    u32x4 raw[16]; float d0 = 0.f, d1 = 0.f;
    constexpr int NIT = BATCH * NCHUNK * NG;
    if (F.vcu < NIT) { const int it = F.vcu, g = it & 7, c = (it >> 3) & (NCHUNK - 1), b = it >> 7; const size_t row0 = (size_t)b * SEQ + (size_t)c * 128;
        ssd_copy_load(F, row0, g, raw); ssd_tables_load(F, row0, g, d0, d1); }
    for (int it = F.vcu; it < NIT; it += F.G) {
        const int g = it & 7, c = (it >> 3) & (NCHUNK - 1), b = it >> 7;
        const size_t row0 = (size_t)b * SEQ + (size_t)c * 128;
        ssd_tables_compute(F, g, d0, d1);
        ssd_copy_store(F, g, raw);
        __syncthreads();
        if (it + F.G < NIT) { const int it2 = it + F.G, g2 = it2 & 7, c2 = (it2 >> 3) & (NCHUNK - 1), b2 = it2 >> 7; const size_t row2 = (size_t)b2 * SEQ + (size_t)c2 * 128;
            ssd_copy_load(F, row2, g2, raw); ssd_tables_load(F, row2, g2, d0, d1); }
        bf16x8 cf[4];
#pragma unroll
        for (int ks = 0; ks < 4; ++ks) cf[ks] = *(const LAS bf16x8*)(F.lds + cfo[ks]);
        bf16_t* const zp = ZY + (row0 + q0 + ql) * DI + g * 256 + 4 * gq;
        const LAS float* const acs_l = acs + 16 * gq; const LAS float* const dtl_l = dtl + 16 * gq;
        f32x4 acc[4][4];
        float aq[4];
#pragma unroll
        for (int r = 0; r < 4; ++r) { aq[r] = acs[(q0 + ql) * 4 + r];
#pragma unroll
            for (int pf = 0; pf < 4; ++pf) acc[r][pf] = (f32x4){0.f, 0.f, 0.f, 0.f}; }
#pragma unroll
        for (int ks = 0; ks < 4; ++ks) if (2 * ks <= w) {
            f32x4 cb[2];
#pragma unroll
            for (int hf = 0; hf < 2; ++hf) { cb[hf] = (f32x4){0.f, 0.f, 0.f, 0.f};
                if (2 * ks + hf <= w) {
#pragma unroll
                    for (int kn = 0; kn < 4; ++kn) { const bf16x8 bfr = *(const LAS bf16x8*)(F.lds + bbo[kn] + 4096 * (2 * ks + hf)); cb[hf] = __builtin_amdgcn_mfma_f32_16x16x32_bf16(bfr, cf[kn], cb[hf], 0, 0, 0); } } }
#pragma unroll
            for (int r = 0; r < 4; ++r) {
                const float Dh = *(const GAS float*)(F.in[I_DSKIP] + g * HPG + r);
                float v[8];
#pragma unroll
                for (int hf = 0; hf < 2; ++hf) { const int sf = 2 * ks + hf;
#pragma unroll
                    for (int rg = 0; rg < 4; ++rg) { const int sl = 4 * gq + rg;
                        float val = 0.f;
                        if (sf <= w) { const float as = acs_l[64 * sf + 4 * rg + r], d = dtl_l[64 * sf + 4 * rg + r];
                            val = cb[hf][rg] * __expf(aq[r] - as) * d;
                            if (sf == w) { if (sl > ql) val = 0.f; else if (sl == ql) val += Dh; } }
                        v[4 * hf + rg] = val; } }
                u32x4 pk; pk.x = cvt_pk_bf16(v[0], v[1]); pk.y = cvt_pk_bf16(v[2], v[3]); pk.z = cvt_pk_bf16(v[4], v[5]); pk.w = cvt_pk_bf16(v[6], v[7]);
                const bf16x8 wf = __builtin_bit_cast(bf16x8, pk);
#pragma unroll
                for (int pf = 0; pf < 4; ++pf) {
                    const LAS unsigned char* const xb = F.lds + xbo[r & 1][pf] + (r >> 1) * 32768 + 8192 * ks;
                    const bf16x8 xf = tr_pair(xb, xb + 4096);
                    acc[r][pf] = __builtin_amdgcn_mfma_f32_16x16x32_bf16(xf, wf, acc[r][pf], 0, 0, 0); }
            }
        }
        u32x4 hreg[8];
        if (c > 0) {
            const u32x4* hsrc = (const u32x4*)(HP + ((((size_t)b * NCHUNK + c) * NH + g * HPG) * HD) * DSTATE) + F.tid;
#pragma unroll
            for (int i = 0; i < 8; ++i) hreg[i] = *(const GAS u32x4*)(hsrc + 512 * i);
        }
        if (c > 0) {
            __syncthreads();
#pragma unroll
            for (int i = 0; i < 8; ++i) { const int e = F.tid + 512 * i, hr_ = e >> 10, p_ = (e >> 4) & 63, ch_ = e & 15;
                *(LAS u32x4*)(F.lds + IMG_X + hr_ * 16384 + img_off<false>(p_, ch_)) = hreg[i]; }
            __syncthreads();
#pragma unroll
            for (int r = 0; r < 4; ++r) { const float eaq = __expf(aq[r]);
#pragma unroll
                for (int pf = 0; pf < 4; ++pf) { f32x4 yo = (f32x4){0.f, 0.f, 0.f, 0.f};
#pragma unroll
                    for (int ks = 0; ks < 4; ++ks) { const bf16x8 hf_ = *(const LAS bf16x8*)(F.lds + IMG_X + r * 16384 + hbo[ks] + 4096 * pf); yo = __builtin_amdgcn_mfma_f32_16x16x32_bf16(hf_, cf[ks], yo, 0, 0, 0); }
                    acc[r][pf] += yo * eaq; } }
        }
        float ssum = 0.f;
#pragma unroll
        for (int r = 0; r < 4; ++r)
#pragma unroll
            for (int pf = 0; pf < 4; ++pf) {
                const u32x2 zz = *(const GAS u32x2*)(zp + r * 64 + 16 * pf);
                const f32x4 y = acc[r][pf] * (f32x4){bflo(zz.x), bfhi(zz.x), bflo(zz.y), bfhi(zz.y)};
                acc[r][pf] = y; ssum += (y[0] * y[0] + y[1] * y[1]) + (y[2] * y[2] + y[3] * y[3]); }
        ssum += __shfl_xor(ssum, 16); ssum += __shfl_xor(ssum, 32);
        const float rsn = __builtin_amdgcn_rsqf(ssum * (1.0f / 256.0f) + EPS);
#pragma unroll
        for (int r = 0; r < 4; ++r)
#pragma unroll
            for (int pf = 0; pf < 4; ++pf) { u32x2 o; o.x = cvt_pk_bf16(acc[r][pf][0] * rsn, acc[r][pf][1] * rsn); o.y = cvt_pk_bf16(acc[r][pf][2] * rsn, acc[r][pf][3] * rsn);
                *(GAS u32x2*)(zp + r * 64 + 16 * pf) = o; }
        __syncthreads();
    }
}

__device__ __forceinline__ void ssd_seq_phase(Frame& F) {
    const int r = F.wave & 3, nh = F.wave >> 2, lane = F.lane, idx = r * 64 + lane;
    LAS float* const bc = (LAS float*)F.lds;
    LAS float* const lxs = bc + 2048;
    LAS float* const yp = bc + 4096;
    LAS float* const ldt = bc + 8192; LAS float* const ssq = bc + 8192 + 32;
    const bf16_t* const XBC = (const bf16_t*)(F.ws + WS_XBC); const bf16_t* const Zs = (const bf16_t*)(F.ws + WS_Z); bf16_t* const YN = (bf16_t*)(F.ws + WS_Z);
    const float* const DT = (const float*)(F.ws + WS_DT);
    const float* const convw = F.in[I_CONVW]; const float* const convb = F.in[I_CONVB];
    for (int it = F.vcu; it < DECB * NG; it += F.G) {
        const int b = it >> 3, g = it & 7, head = g * HPG + r;
        const size_t row0 = (size_t)MP + (size_t)b * DECS;
        const int xch = g * 256 + idx;
        {
            const int ch = (nh == 0) ? ((idx < 128) ? (DI + g * DSTATE + idx) : (DI + NG * DSTATE + g * DSTATE + (idx - 128))) : xch;
            float cw[4];
#pragma unroll
            for (int k = 0; k < 4; ++k) cw[k] = *(const GAS float*)(convw + (size_t)k * CD + ch);
            const float cbv = *(const GAS float*)(convb + ch);
            const float* cs = F.in[I_CONV] + (size_t)b * 3 * CD;
            float x3 = *(const GAS float*)(cs + ch), x2 = *(const GAS float*)(cs + CD + ch), x1 = *(const GAS float*)(cs + 2 * CD + ch);
            LAS float* const dst = (nh == 0) ? bc : lxs;
#pragma unroll
            for (int j = 0; j < 8; ++j) {
                const float xr = bf2f(*(const GAS bf16_t*)(XBC + (row0 + j) * CD + ch));
                const float cx = cbv + cw[0] * x3 + cw[1] * x2 + cw[2] * x1 + cw[3] * xr; x3 = x2; x2 = x1; x1 = xr;
                dst[j * 256 + idx] = silu_f(cx);
            }
            if (nh == 1 && lane < 8) ldt[lane * 4 + r] = *(const GAS float*)(DT + (row0 + lane) * 32 + head);
        }
        __syncthreads();
        {
            const float Ah = -__expf(*(const GAS float*)(F.in[I_ALOG] + head));
            const int pg = lane >> 4, nc = lane & 15;
            f32x4 h[16];
            const float* const hin = F.in[I_SSM] + (((size_t)b * NH + head) * HD + 16 * pg) * DSTATE + 64 * nh + 4 * nc;
#pragma unroll
            for (int i = 0; i < 16; ++i) h[i] = *(const GAS f32x4*)(hin + (size_t)i * DSTATE);
            for (int j = 0; j < 8; ++j) {
                const float dtv = ldt[j * 4 + r], dA = __expf(dtv * Ah);
                const f32x4 Bv = *(const LAS f32x4*)(bc + j * 256 + 64 * nh + 4 * nc), Cv = *(const LAS f32x4*)(bc + j * 256 + 128 + 64 * nh + 4 * nc);
                float part[16];
#pragma unroll
                for (int i4 = 0; i4 < 4; ++i4) { const f32x4 xs4 = *(const LAS f32x4*)(lxs + j * 256 + r * 64 + 16 * pg + 4 * i4);
#pragma unroll
                    for (int k = 0; k < 4; ++k) { const int i = 4 * i4 + k; const float dx = dtv * xs4[k];
                        h[i] = h[i] * dA + Bv * dx;
                        part[i] = (Cv.x * h[i].x + Cv.y * h[i].y) + (Cv.z * h[i].z + Cv.w * h[i].w); } }
#pragma unroll
                for (int i = 0; i < 8; ++i) { const bool up = (nc & 8) != 0; const float keep = up ? part[i + 8] : part[i], send = up ? part[i] : part[i + 8]; part[i] = keep + __shfl_xor(send, 8); }
#pragma unroll
                for (int i = 0; i < 4; ++i) { const bool up = (nc & 4) != 0; const float keep = up ? part[i + 4] : part[i], send = up ? part[i] : part[i + 4]; part[i] = keep + __shfl_xor(send, 4); }
#pragma unroll
                for (int i = 0; i < 2; ++i) { const bool up = (nc & 2) != 0; const float keep = up ? part[i + 2] : part[i], send = up ? part[i] : part[i + 2]; part[i] = keep + __shfl_xor(send, 2); }
                { const bool up = (nc & 1) != 0; const float keep = up ? part[1] : part[0], send = up ? part[0] : part[1]; part[0] = keep + __shfl_xor(send, 1); }
                yp[(j * 2 + nh) * 256 + r * 64 + 16 * pg + nc] = part[0];
            }
            float* const hout = F.out + O_SSM_S + (((size_t)b * NH + head) * HD + 16 * pg) * DSTATE + 64 * nh + 4 * nc;
#pragma unroll
            for (int i = 0; i < 16; ++i) *(GAS f32x4*)(hout + (size_t)i * DSTATE) = h[i];
        }
        __syncthreads();
        float ygv[4];
        {
            const float Dh = *(const GAS float*)(F.in[I_DSKIP] + head);
#pragma unroll
            for (int jj = 0; jj < 4; ++jj) { const int j = 4 * nh + jj;
                const float y = (yp[(j * 2) * 256 + idx] + yp[(j * 2 + 1) * 256 + idx]) + Dh * lxs[j * 256 + idx];
                ygv[jj] = y * bf2f(*(const GAS bf16_t*)(Zs + (row0 + j) * DI + xch));
                const float ss = wave_sum(ygv[jj] * ygv[jj]);
                if (lane == 0) ssq[j * 4 + r] = ss; }
        }
        __syncthreads();
#pragma unroll
        for (int jj = 0; jj < 4; ++jj) { const int j = 4 * nh + jj;
            const f32x4 s4 = *(const LAS f32x4*)(ssq + j * 4);
            const float rsn = __builtin_amdgcn_rsqf(((s4.x + s4.y) + (s4.z + s4.w)) * (1.0f / 256.0f) + EPS);
            *(GAS bf16_t*)(YN + (row0 + j) * DI + xch) = (bf16_t)f2bf(ygv[jj] * rsn); }
        __syncthreads();
    }
}
template <int W> __device__ __forceinline__ void pool_run(const bf16_t* V, bf16_t* PO, int run, int cv) {
    const int row0 = run * 16, t0 = row0 & (SEQ - 1);
    u32x4 raw[16 + W - 1];
#pragma unroll
    for (int e = 0; e < 16 + W - 1; ++e) {
        const int dt_ = e - (W - 1);
        if (t0 + dt_ >= 0) raw[e] = *(const GAS u32x4*)(V + (size_t)(row0 + dt_) * PD + cv); else raw[e] = (u32x4){0u, 0u, 0u, 0u};
    }
    f32x4 s0 = (f32x4){0.f, 0.f, 0.f, 0.f}, s1 = s0;
#pragma unroll
    for (int e = 0; e < W - 1; ++e) { f32x4 x0, x1; pg8::unpack8(raw[e], x0, x1); s0 += x0; s1 += x1; }
#pragma unroll
    for (int i = 0; i < 16; ++i) {
        f32x4 c0, c1; pg8::unpack8(raw[i + W - 1], c0, c1);
        s0 += c0; s1 += c1;
        const int t = t0 + i; const float ic = 1.0f / (float)((t + 1 < W) ? t + 1 : W);
        const f32x4 o0 = s0 * ic - c0, o1 = s1 * ic - c1;
        u32x4 o; o.x = pk2(o0.x, o0.y); o.y = pk2(o0.z, o0.w); o.z = pk2(o1.x, o1.y); o.w = pk2(o1.z, o1.w);
        *(GAS u32x4*)(PO + (size_t)(row0 + i) * PD + cv) = o;
        f32x4 x0, x1; pg8::unpack8(raw[i], x0, x1); s0 -= x0; s1 -= x1;
    }
}
template <int W> __device__ __forceinline__ void pool_run_s(const bf16_t* V, bf16_t* PO, const float* sp, int b, int cv) {
    const size_t row0 = (size_t)MP + (size_t)b * DECS;
    f32x4 a0[8 + W - 1], a1[8 + W - 1];
#pragma unroll
    for (int e = 0; e < 8 + W - 1; ++e) { const int t = e - (W - 1);
        if (t >= 0) pg8::unpack8(*(const GAS u32x4*)(V + (row0 + t) * PD + cv), a0[e], a1[e]);
        else { const float* p = sp + ((size_t)b * PBUF + (PBUF + t)) * PD + cv; a0[e] = *(const GAS f32x4*)p; a1[e] = *(const GAS f32x4*)(p + 4); } }
    f32x4 s0 = (f32x4){0.f, 0.f, 0.f, 0.f}, s1 = s0;
#pragma unroll
    for (int e = 0; e < W - 1; ++e) { s0 += a0[e]; s1 += a1[e]; }
    const float ic = 1.0f / (float)W;
#pragma unroll
    for (int i = 0; i < 8; ++i) {
        s0 += a0[i + W - 1]; s1 += a1[i + W - 1];
        const f32x4 o0 = s0 * ic - a0[i + W - 1], o1 = s1 * ic - a1[i + W - 1];
        u32x4 o; o.x = pk2(o0.x, o0.y); o.y = pk2(o0.z, o0.w); o.z = pk2(o1.x, o1.y); o.w = pk2(o1.z, o1.w);
        *(GAS u32x4*)(PO + (row0 + i) * PD + cv) = o;
        s0 -= a0[i]; s1 -= a1[i];
    }
}
__device__ __forceinline__ void pool_phase(Frame& F) {
    const bf16_t* const V = (const bf16_t*)(F.ws + WS_V); bf16_t* const PO = (bf16_t*)(F.out + O_Y);
    const float* const sp = F.in[I_POOL];
    const int gt = F.vcu * NTHREADS + F.tid, NT = F.G * NTHREADS;
    for (int e = gt; e < (MP / 16) * 128; e += NT) {
        const int c32 = e & 31, rl = (e >> 5) & 1, grp = (e >> 6) & 3, run = (e >> 8) * 2 + rl, cv = (grp * 32 + c32) * 8;
        if (grp == 0) pool_run<2>(V, PO, run, cv); else if (grp == 1) pool_run<4>(V, PO, run, cv); else if (grp == 2) pool_run<8>(V, PO, run, cv); else pool_run<16>(V, PO, run, cv);
    }
    for (int e = gt; e < (MS / 8) * 128; e += NT) {
        const int c32 = e & 31, grp = (e >> 5) & 3, b = e >> 7, cv = (grp * 32 + c32) * 8;
        if (grp == 0) pool_run_s<2>(V, PO, sp, b, cv); else if (grp == 1) pool_run_s<4>(V, PO, sp, b, cv); else if (grp == 2) pool_run_s<8>(V, PO, sp, b, cv); else pool_run_s<16>(V, PO, sp, b, cv);
    }
    float* const ops = F.out + O_POOL_S;
    for (int e = gt; e < DECB * 7 * (PD / 4); e += NT) {
        const int c4 = e & 255, i = (e >> 8) % 7, b = (e >> 8) / 7;
        *(GAS f32x4*)(ops + ((size_t)b * PBUF + i) * PD + c4 * 4) = *(const GAS f32x4*)(sp + ((size_t)b * PBUF + 8 + i) * PD + c4 * 4);
    }
}
__device__ __forceinline__ void final_phase(Frame& F) {
    const int gw = F.vcu * NWAVES + F.wave, NGW = F.G * NWAVES, lane = F.lane;
    const float* const st = (const float*)(F.ws + WS_STATS_A); const float* const gf = F.in[I_NFINAL];
    f32x4 gv[4];
#pragma unroll
    for (int j = 0; j < 4; ++j) gv[j] = *((const GAS f32x4*)gf + lane + 64 * j);
    const bf16_t* const h4 = (const bf16_t*)(F.ws + WS_ACT);
    for (int m = gw; m < M; m += NGW) {
        const GAS f32x4* sp = (const GAS f32x4*)(st + (size_t)m * 16);
        const f32x4 a = sp[0], b = sp[1], c = sp[2], d = sp[3]; const f32x4 s = (a + b) + (c + d);
        const float rs = __builtin_amdgcn_rsqf(((s[0] + s[1]) + (s[2] + s[3])) * (1.0f / 1024.0f) + EPS);
        const GAS u32x2* hr = (const GAS u32x2*)(h4 + (size_t)m * DM) + lane;
        GAS f32x4* yr = (GAS f32x4*)(F.out + (size_t)m * DM) + lane;
#pragma unroll
        for (int j = 0; j < 4; ++j) { const u32x2 w = hr[64 * j]; yr[64 * j] = (f32x4){bflo(w.x), bfhi(w.x), bflo(w.y), bfhi(w.y)} * rs * gv[j]; }
    }
}

constexpr int NPHASES = 13;
struct Args { const float* in[30]; float* out; unsigned char* ws; int ph_lo, ph_hi, li, pad; };
__global__ void __launch_bounds__(NTHREADS, 2) mk_fwd(Args args) {
    extern __shared__ __attribute__((aligned(16))) unsigned char lds[];
    Frame F;
    F.lds = (LAS unsigned char*)lds;
    F.MISC = (volatile LAS unsigned*)(F.lds + MISC_OFF);
    F.tid = threadIdx.x; F.lane = F.tid & 63; F.wave = __builtin_amdgcn_readfirstlane(F.tid >> 6);
    F.G = gridDim.x; { const int bx = blockIdx.x; F.vcu = (F.G % 8 == 0) ? (bx % 8) * (F.G / 8) + bx / 8 : bx; }
    F.ws = args.ws; F.out = args.out; F.ctl = (gu32*)(args.ws + WS_CTL);
#pragma unroll
    for (int i = 0; i < 30; ++i) F.in[i] = args.in[i];
    for (int u = F.tid; u < (LDS_BYTES - LDSCTL_OFF) / 4; u += NTHREADS) ((LAS unsigned*)(F.lds + LDSCTL_OFF))[u] = 0u;
    __syncthreads();
    const int lo = args.ph_lo, hi = args.ph_hi;
    XcdBarrier bar; bar.bar = (unsigned*)(F.ctl + CW_BAR); bar.x = 0; bar.st = nullptr;
    if (hi - lo > 1) bar = xcd_barrier_post((unsigned*)(F.ctl + CW_BAR), F.MISC + 8);
#ifndef PHMASK
#define PHMASK 0x1fff
#endif
#define IN(k) (((PHMASK >> (k)) & 1) && lo <= (k) && (k) < hi)
#define SEAM(k) do { if (IN(k) && IN((k) + 1)) xcd_barrier(bar); } while (0)
#define PH_BEGIN(k) if (IN(k)) { auto body_ = [&]() __attribute__((always_inline))
#define PH_END(k) ; body_(); if ((REP_MASK >> (k)) & 1) { xcd_barrier(bar); body_(); } } SEAM(k);

    bf16_t* const XB = (bf16_t*)(F.ws + WS_XB); bf16_t* const HB = (bf16_t*)(F.ws + WS_HB); bf16_t* const ACT = (bf16_t*)(F.ws + WS_ACT);
    bf16_t* const Zb = (bf16_t*)(F.ws + WS_Z); bf16_t* const XBCb = (bf16_t*)(F.ws + WS_XBC); bf16_t* const Vb = (bf16_t*)(F.ws + WS_V); bf16_t* const GATES = (bf16_t*)(F.ws + WS_GATES);
    bf16_t* const POOLED = (bf16_t*)(F.out + O_Y); bf16_t* const MERGED = (bf16_t*)(F.ws + WS_MERGED); bf16_t* const Qb = (bf16_t*)(F.ws + WS_Q); bf16_t* const PB = (bf16_t*)(F.ws + WS_PB);
    float* const T1 = (float*)(F.ws + WS_T1); float* const stA = (float*)(F.ws + WS_STATS_A); float* const stB = (float*)(F.ws + WS_STATS_B); float* const DTb = (float*)(F.ws + WS_DT);
    float* const H = F.out + O_Y;
    pg8::StaticOrder S;

    PH_BEGIN(0) { p0_prologue(F); } PH_END(0)
    PH_BEGIN(1) {
        pg8::Gemm g{XB, (const bf16_t*)(F.ws + WS_WGU1), M, 2 * DFF, DM, DM, 0}; S.init(M, 2 * DFF, F.G, (int)blockIdx.x);
        pg8::Epi E{}; E.kind = pg8::EK_GU; E.stats_in = stA; E.obf = ACT; E.ldo = DFF;
        pg8::gemm_phase(F.lds, g, S, E);
        pg8::Gemm g2{(const bf16_t*)(F.ws + WS_WPOT), (const bf16_t*)(F.ws + WS_WGRP), DM, DM, 256, DM, 256}; S.init_tail(DM, DM, F.G, (int)blockIdx.x);
        pg8::Epi E2{}; E2.kind = pg8::EK_BF16; E2.obf = (bf16_t*)(F.ws + WS_W2); E2.ldo = DM;
        pg8::gemm_phase(F.lds, g2, S, E2);
    } PH_END(1)
    PH_BEGIN(2) {
        pg8::Gemm g{ACT, (const bf16_t*)(F.ws + WS_WD1), M, DM, DFF, DFF, 0}; S.init(MP, DM, F.G, (int)blockIdx.x);
        pg8::Epi E{}; E.kind = pg8::EK_RES; E.coef = 0.5f; E.res_p = F.in[I_XP]; E.res_s = F.in[I_XS]; E.obf = HB; E.stats_out = stB;
        pg8::gemm_phase(F.lds, g, S, E);
        pg8::gemm_small(F.lds, g, E, MP, MS, F.G, (int)blockIdx.x);
    } PH_END(2)
    PH_BEGIN(3) {
        pg8::Gemm g{HB, (const bf16_t*)(F.ws + WS_WIN), M, NIN, DM, DM, 0}; S.init(M, NIN, F.G, (int)blockIdx.x);
        pg8::Epi E{}; E.kind = pg8::EK_WIN; E.stats_in = stB; E.Z = Zb; E.XBC = XBCb; E.V = Vb; E.GATES = GATES; E.HALO = (bf16_t*)(F.ws + WS_HALO); E.DT = DTb; E.dt_bias = F.in[I_DTB];
        E.conv_p = F.out + O_CONV_P; E.conv_s = F.out + O_CONV_S; E.pool_p = F.out + O_POOL_P; E.pool_s = F.out + O_POOL_S;
        pg8::gemm_phase(F.lds, g, S, E);
    } PH_END(3)
    PH_BEGIN(4) { ssd_states_phase(F); pool_phase(F); } PH_END(4)
    PH_BEGIN(5) { ssd_scan_phase(F);

        pg8::Gemm g{PB, (const bf16_t*)(F.ws + WS_WPLE), M, DM, PLE, PLE, 0}; S.init(MP, DM, F.G, (int)blockIdx.x);
        pg8::Epi E{}; E.kind = pg8::EK_BF16; E.obf = Qb; E.ldo = DM;
        pg8::gemm_phase(F.lds, g, S, E);
        pg8::gemm_small(F.lds, g, E, MP, MS, F.G, (int)blockIdx.x);
        } PH_END(5)
    PH_BEGIN(6) { ssd_out_phase(F); ssd_seq_phase(F); } PH_END(6)
    PH_BEGIN(7) {
        pg8::Gemm2 g{Zb, (const bf16_t*)(F.ws + WS_WSSO), POOLED, (const bf16_t*)(F.ws + WS_W2), DI, DI, DM, DM, DM}; S.init(MP, DM, F.G, (int)blockIdx.x);
        pg8::gemm_phase2(F.lds, g, S, GATES, MERGED);
        pg8::gemm_small2(F.lds, g, GATES, MERGED, MP, MS, F.G, (int)blockIdx.x);
    } PH_END(7)
    PH_BEGIN(8) {
        pg8::Gemm g{MERGED, (const bf16_t*)(F.ws + WS_WO), M, DM, DM, DM, 0}; S.init(MP, DM, F.G, (int)blockIdx.x);
        pg8::Epi E{}; E.kind = pg8::EK_RES; E.coef = 1.0f; E.res_bf = HB; E.obf = HB; E.stats_out = stA;
        pg8::gemm_phase(F.lds, g, S, E);
        pg8::gemm_small(F.lds, g, E, MP, MS, F.G, (int)blockIdx.x);
    } PH_END(8)
    PH_BEGIN(9) {
        pg8::Gemm g{HB, (const bf16_t*)(F.ws + WS_WGU2), M, 2 * DFF, DM, DM, 0}; S.init(M, 2 * DFF, F.G, (int)blockIdx.x);
        pg8::Epi E{}; E.kind = pg8::EK_GU; E.stats_in = stA; E.obf = ACT; E.ldo = DFF;
        pg8::gemm_phase(F.lds, g, S, E);
    } PH_END(9)
    PH_BEGIN(10) {
        pg8::Gemm g{ACT, (const bf16_t*)(F.ws + WS_WD2), M, DM, DFF, DFF, 0}; S.init(MP, DM, F.G, (int)blockIdx.x);
        pg8::Epi E{}; E.kind = pg8::EK_RES; E.coef = 0.5f; E.res_bf = HB; E.obf = HB; E.stats_out = stB;
        pg8::gemm_phase(F.lds, g, S, E);
        pg8::gemm_small(F.lds, g, E, MP, MS, F.G, (int)blockIdx.x);
    } PH_END(10)
    PH_BEGIN(11) {
        pg8::Gemm g{HB, (const bf16_t*)(F.ws + WS_WPG), M, DM, DM, DM, 0}; S.init(MP, DM, F.G, (int)blockIdx.x);
        pg8::Epi E{}; E.kind = pg8::EK_PLE; E.stats_in = stB; E.q = Qb; E.res_bf = HB; E.obf = ACT; E.stats_out = stA;
        pg8::gemm_phase(F.lds, g, S, E);
        pg8::gemm_small(F.lds, g, E, MP, MS, F.G, (int)blockIdx.x);
    } PH_END(11)
    PH_BEGIN(12) { final_phase(F); } PH_END(12)
#undef IN
#undef SEAM
#undef PH_BEGIN
#undef PH_END
}

extern "C" void kernel_launch(void* const* d_in, const int* in_sizes, int n_in, void* d_out, int out_size, void* d_ws, size_t ws_size, hipStream_t stream) {
    static int grid = 0;
    if (grid == 0) {
        if (n_in != 30 || in_sizes[0] != MP * DM || (size_t)out_size != O_END || ws_size < WS_END) {
            fprintf(stderr, "kernel_launch: shape mismatch: n_in %d in0 %d out %d ws %zu (need %zu)\n", n_in, n_in > 0 ? in_sizes[0] : -1, out_size, ws_size, (size_t)WS_END); grid = -1; return; }
        int dev = 0, cus = 0, per_cu = 0;
        if (hipGetDevice(&dev) != hipSuccess || hipDeviceGetAttribute(&cus, hipDeviceAttributeMultiprocessorCount, dev) != hipSuccess) { grid = -1; return; }
        if (hipFuncSetAttribute((const void*)mk_fwd, hipFuncAttributeMaxDynamicSharedMemorySize, LDS_BYTES) != hipSuccess) { fprintf(stderr, "kernel_launch: hipFuncSetAttribute failed\n"); grid = -1; return; }
        if (hipOccupancyMaxActiveBlocksPerMultiprocessor(&per_cu, (const void*)mk_fwd, NTHREADS, LDS_BYTES) != hipSuccess || per_cu < 1)
            fprintf(stderr, "kernel_launch: occupancy query reports %d workgroups per CU\n", per_cu);
        (void)hipGetLastError();
        grid = cus;
    }
    if (grid < 0) return;
    if (hipMemsetAsync((char*)d_ws + WS_CTL, 0, CTL_ZERO_BYTES, stream) != hipSuccess) { fprintf(stderr, "kernel_launch: memset failed\n"); return; }
    Args a{};
    for (int i = 0; i < 30; ++i) a.in[i] = (const float*)d_in[i];
    a.out = (float*)d_out; a.ws = (unsigned char*)d_ws;
#if MK_MULTI_LAUNCH
    for (int ph = 0; ph < NPHASES; ++ph) { a.ph_lo = ph; a.ph_hi = ph + 1; a.li = ph;
        hipLaunchKernelGGL(mk_fwd, dim3(grid), dim3(NTHREADS), LDS_BYTES, stream, a); }
#else
    a.ph_lo = 0; a.ph_hi = NPHASES; a.li = 0;
    hipLaunchKernelGGL(mk_fwd, dim3(grid), dim3(NTHREADS), LDS_BYTES, stream, a);
#endif
}
```

```cpp
#include <hip/hip_runtime.h>
#include <cstdio>
#include <cstdint>

#define REP_MASK 0x0
#ifndef MK_MULTI_LAUNCH
#define MK_MULTI_LAUNCH 0
#endif

#define GAS __attribute__((address_space(1)))
#define LAS __attribute__((address_space(3)))
typedef unsigned short bf16_t;
typedef short bf16x8 __attribute__((ext_vector_type(8)));
typedef float f32x4 __attribute__((ext_vector_type(4)));
typedef float f32x2 __attribute__((ext_vector_type(2)));
typedef unsigned u32x4 __attribute__((ext_vector_type(4)));
typedef unsigned u32x2 __attribute__((ext_vector_type(2)));
typedef GAS unsigned gu32;

constexpr int DM = 1024, BATCH = 8, SEQ = 2048, DECB = 128, DECS = 8;
constexpr int MP = BATCH * SEQ, MS = DECB * DECS, M = MP + MS;
constexpr int DI = 2048, HD = 64, NH = 32, NG = 8, HPG = 4, DSTATE = 128, CD = 4096;
constexpr int PD = 1024, PBUF = 15, DFF = 2816, PLE = 256;
constexpr int IN_DIM = 9248, NIN = 9472;
constexpr float EPS = 1e-6f;
constexpr int NWAVES = 8, NTHREADS = 512;

constexpr size_t MiB = 1u << 20;
constexpr size_t WS_CTL = 0, CTL_ZERO_BYTES = 32768;
constexpr size_t WS_STATS_A = 2 * MiB, WS_STATS_B = 4 * MiB, WS_DT = 6 * MiB, WS_CDEC = 9 * MiB;
constexpr size_t WS_WGU1 = 10 * MiB, WS_WD1 = 21 * MiB, WS_WIN = 27 * MiB, WS_WSSO = 46 * MiB, WS_W2 = 50 * MiB, WS_WO = 52 * MiB,
                 WS_WGU2 = 54 * MiB, WS_WD2 = 65 * MiB, WS_WPG = 71 * MiB, WS_WPLE = 73 * MiB, WS_PB = 74 * MiB, WS_WPOT = 480 * MiB, WS_WGRP = 483 * MiB;
constexpr size_t WS_Z = 84 * MiB, WS_XBC = 152 * MiB, WS_V = 288 * MiB, WS_GATES = 322 * MiB, WS_HB = 390 * MiB, WS_HPREV = 424 * MiB, WS_HALO = 488 * MiB, WS_EAQ = 492 * MiB, WS_END = 495 * MiB;
constexpr size_t WS_ACT = WS_XBC, WS_T1 = WS_XBC, WS_MERGED = 220 * MiB, WS_Q = WS_V, WS_XB = WS_HB;
static_assert(WS_STATS_A + (size_t)M * 16 * 4 <= WS_STATS_B && WS_STATS_B + (size_t)M * 16 * 4 <= WS_DT && WS_DT + (size_t)M * 32 * 4 <= WS_WGU1, "ws map (small)");
static_assert(WS_WGU1 + (size_t)2 * DFF * DM * 2 <= WS_WD1 && WS_WD1 + (size_t)DM * DFF * 2 <= WS_WIN && WS_WIN + (size_t)NIN * DM * 2 <= WS_WSSO && WS_WSSO + (size_t)DM * DI * 2 <= WS_W2, "ws map (w1)");
static_assert(WS_WGU2 + (size_t)2 * DFF * DM * 2 <= WS_WD2 && WS_WD2 + (size_t)DM * DFF * 2 <= WS_WPG && WS_WPLE + (size_t)DM * PLE * 2 <= WS_PB && WS_PB + (size_t)M * PLE * 2 <= WS_Z, "ws map (w2)");
static_assert(WS_Z + (size_t)M * DI * 2 <= WS_XBC && WS_XBC + (size_t)M * CD * 2 <= WS_V && WS_V + (size_t)M * PD * 2 <= WS_GATES && WS_GATES + (size_t)M * 2 * DM * 2 <= WS_HB &&
              WS_HB + (size_t)M * DM * 2 <= WS_HPREV && WS_HPREV + (size_t)BATCH * 16 * NH * HD * DSTATE * 2 <= WS_END, "ws map (act)");
static_assert(WS_ACT + (size_t)M * DFF * 2 <= WS_V && WS_T1 + (size_t)M * DM * 4 <= WS_MERGED && WS_MERGED + (size_t)M * DM * 2 <= WS_V, "ws overlays");
constexpr int CW_BAR = 4096;

constexpr size_t O_Y = 0, O_SSM_P = (size_t)M * DM, O_CONV_P = O_SSM_P + (size_t)BATCH * NH * HD * DSTATE, O_POOL_P = O_CONV_P + (size_t)BATCH * 3 * CD,
                 O_SSM_S = O_POOL_P + (size_t)BATCH * PBUF * PD, O_CONV_S = O_SSM_S + (size_t)DECB * NH * HD * DSTATE, O_POOL_S = O_CONV_S + (size_t)DECB * 3 * CD,
                 O_END = O_POOL_S + (size_t)DECB * PBUF * PD;

constexpr int RING_BYTES = 131072, LDSCTL_OFF = RING_BYTES, MISC_OFF = LDSCTL_OFF + 320, LDS_BYTES = 147456;

#define RLX_AGENT __ATOMIC_RELAXED, __HIP_MEMORY_SCOPE_AGENT
#define LDS_WAIT() asm volatile("s_waitcnt lgkmcnt(0)" ::: "memory")
#define VM_WAIT() asm volatile("s_waitcnt vmcnt(0)" ::: "memory")

__device__ __forceinline__ unsigned f2bf(float f) { unsigned u = __builtin_bit_cast(unsigned, f); return (u + 0x7fffu + ((u >> 16) & 1u)) >> 16; }
__device__ __forceinline__ unsigned cvt_pk_bf16(float lo, float hi);
__device__ __forceinline__ unsigned pk2(float lo, float hi) { return cvt_pk_bf16(lo, hi); }
__device__ __forceinline__ float bf2f(unsigned b) { return __builtin_bit_cast(float, b << 16); }
__device__ __forceinline__ float bflo(unsigned w) { return __builtin_bit_cast(float, w << 16); }
__device__ __forceinline__ float bfhi(unsigned w) { return __builtin_bit_cast(float, w & 0xffff0000u); }
typedef __bf16 bf16x2_t __attribute__((ext_vector_type(2)));
__device__ __forceinline__ unsigned cvt_pk_bf16(float lo, float hi) { const bf16x2_t v = {(__bf16)lo, (__bf16)hi}; return __builtin_bit_cast(unsigned, v); }
__device__ __forceinline__ float sigm_f(float x) { return __builtin_amdgcn_rcpf(1.0f + __expf(-x)); }
__device__ __forceinline__ float silu_f(float x) { return x * __builtin_amdgcn_rcpf(1.0f + __expf(-x)); }
__device__ __forceinline__ float wave_sum(float v) {
#pragma unroll
    for (int o = 1; o < 64; o <<= 1) v += __shfl_xor(v, o);
    return v;
}

struct Frame {
    LAS unsigned char* lds;
    volatile LAS unsigned* MISC;
    gu32* ctl;
    int tid, lane, wave, vcu, G;
    unsigned char* ws;
    float* out;
    const float* in[30];
};
enum { I_XP = 0, I_XS, I_SSM, I_CONV, I_POOL, I_PP, I_PS, I_NFFN1, I_WGU1, I_WD1, I_NMIX, I_WIN, I_CONVW, I_CONVB, I_DTB, I_ALOG, I_DSKIP, I_NSSD, I_WSSO, I_WPGRP, I_PSCALE,
       I_WPOUT, I_WO, I_NFFN2, I_WGU2, I_WD2, I_NPLE, I_WPG, I_WPLE, I_NFINAL };

namespace pg8 {
constexpr int BM = 256, BK = 64, HALF = 128, HTB = HALF * BK * 2, STAGE_BYTES = 8 * HTB, NXCD = 8, WGM = 4;
__host__ __device__ __forceinline__ int lds_byte(int r, int c) { const int st = (r >> 4) * 2 + (c >> 5), rr = r & 15, cc = c & 31, ob = rr * 64 + cc * 2; return st * 1024 + (ob ^ (((ob >> 9) & 1) << 5)); }
__host__ __device__ __forceinline__ void stage_rc(int b, int& R, int& C) { const int st = b / 1024, sb = b % 1024, swz = sb ^ (((sb >> 9) & 1) << 5); R = (st >> 1) * 16 + swz / 64; C = (st & 1) * 32 + (swz % 64) / 2; }
__host__ __device__ __forceinline__ int perm32(int rho) { const int n = rho >> 4, i = rho & 15; return 8 * (i >> 2) + 4 * n + (i & 3); }
struct Unit { int pm, pn; };
struct Gemm { const bf16_t* A; const bf16_t* Bt; int M, N, K; int lda; int a_pn_step; };
struct StaticOrder {
    int nM, nN, nwg, G, c;
    __host__ __device__ void init(int M_, int N_, int G_, int c_) { nM = M_ / BM; nN = N_ / BM; nwg = nM * nN; G = G_; c = c_; }
    __host__ __device__ void init_tail(int M_, int N_, int G_, int c_) { init(M_, N_, G_, (G_ - 1) - c_); }
    __host__ __device__ bool next(int i, Unit& u) const {
        const long L = (long)i * G + c; if (L >= nwg) return false;
        int wgid = (int)L; { const int q = nwg / NXCD, r = nwg % NXCD, xcd = wgid % NXCD, off = wgid / NXCD; wgid = (xcd < r ? xcd * (q + 1) : r * (q + 1) + (xcd - r) * q) + off; }
        const int nig = WGM * nN, gid = wgid / nig, fm = gid * WGM, gsz = (nM - fm) < WGM ? (nM - fm) : WGM;
        u.pm = fm + ((wgid % nig) % gsz); u.pn = (wgid % nig) / gsz; return true;
    }
};

enum EpiKind { EK_GU = 1, EK_RES = 2, EK_WIN = 3, EK_T1 = 4, EK_MERGE = 5, EK_BF16 = 6, EK_PLE = 7 };
struct Epi {
    const float* stats_in;
    float* stats_out;
    bf16_t* obf;
    float* of32;
    const float* res_p; const float* res_s;
    const bf16_t* res_bf;
    const bf16_t* gates;
    const bf16_t* q;
    bf16_t *Z, *XBC, *V, *GATES, *HALO; float* DT; const float* dt_bias; float *conv_p, *conv_s, *pool_p, *pool_s;
    int kind; int ldo; float coef; int pad;
};

__device__ __forceinline__ u32x4 pack8(const f32x4 a, const f32x4 b) { u32x4 w; w.x = cvt_pk_bf16(a[0], a[1]); w.y = cvt_pk_bf16(a[2], a[3]); w.z = cvt_pk_bf16(b[0], b[1]); w.w = cvt_pk_bf16(b[2], b[3]); return w; }
__device__ __forceinline__ void unpack8(const u32x4 w, f32x4& a, f32x4& b) { a = (f32x4){bflo(w.x), bfhi(w.x), bflo(w.y), bfhi(w.y)}; b = (f32x4){bflo(w.z), bfhi(w.z), bflo(w.w), bfhi(w.w)}; }

__device__ __forceinline__ float row_rs(const float* stats, int row) {
    if (!stats) return 1.0f;
    const GAS f32x4* sp = (const GAS f32x4*)(stats + (size_t)row * 16);
    const f32x4 a = sp[0], b = sp[1], c = sp[2], d = sp[3]; const f32x4 s = (a + b) + (c + d);
    return __builtin_amdgcn_rsqf(((s[0] + s[1]) + (s[2] + s[3])) * (1.0f / 1024.0f) + EPS);
}
__device__ __forceinline__ float softplus_f(float x) { const float e = __expf(-fabsf(x)); const float l = (e < 0.01f) ? e * (1.0f - e * (0.5f - e * (1.0f / 3.0f))) : __logf(1.0f + e); return fmaxf(x, 0.f) + l; }

__device__ __forceinline__ void epilogue(const Epi& E, const f32x4 (&acc)[2][2][4][2], const Unit& u, int wr, int wc, int fr, int fq) {
    const int rowb = u.pm * BM + wr * 64 + fr;
    const int cin = wc * 32 + 8 * fq;
    if (E.kind == EK_GU) {
#pragma unroll
        for (int ai = 0; ai < 2; ++ai)
#pragma unroll
            for (int m = 0; m < 4; ++m) { const int row = rowb + ai * HALF + m * 16; const float r = row_rs(E.stats_in, row);
                const f32x4 g0 = acc[ai][0][m][0] * r, u0 = acc[ai][1][m][0] * r, g1 = acc[ai][0][m][1] * r, u1 = acc[ai][1][m][1] * r;
                const f32x4 o0 = (f32x4){silu_f(g0[0]) * u0[0], silu_f(g0[1]) * u0[1], silu_f(g0[2]) * u0[2], silu_f(g0[3]) * u0[3]};
                const f32x4 o1 = (f32x4){silu_f(g1[0]) * u1[0], silu_f(g1[1]) * u1[1], silu_f(g1[2]) * u1[2], silu_f(g1[3]) * u1[3]};
                *(GAS u32x4*)(E.obf + (size_t)row * E.ldo + u.pn * HALF + cin) = pack8(o0, o1); }
    } else if (E.kind == EK_RES) {
#pragma unroll
        for (int ai = 0; ai < 2; ++ai)
#pragma unroll
            for (int m = 0; m < 4; ++m) { const int row = rowb + ai * HALF + m * 16;
                float ss = 0.f;
#pragma unroll
                for (int bj = 0; bj < 2; ++bj) { const int col = u.pn * BM + bj * HALF + cin;
                    f32x4 r0, r1;
                    if (E.res_p) { const float* rp = (row < MP) ? E.res_p + (size_t)row * DM : E.res_s + (size_t)(row - MP) * DM; r0 = *(const GAS f32x4*)(rp + col); r1 = *(const GAS f32x4*)(rp + col + 4); }
                    else unpack8(*(const GAS u32x4*)(E.res_bf + (size_t)row * DM + col), r0, r1);
                    const f32x4 h0 = r0 + acc[ai][bj][m][0] * E.coef, h1 = r1 + acc[ai][bj][m][1] * E.coef;
                    *(GAS u32x4*)(E.obf + (size_t)row * DM + col) = pack8(h0, h1);
                    ss += (h0[0] * h0[0] + h0[1] * h0[1]) + (h0[2] * h0[2] + h0[3] * h0[3]) + (h1[0] * h1[0] + h1[1] * h1[1]) + (h1[2] * h1[2] + h1[3] * h1[3]); }
                ss += __shfl_xor(ss, 16); ss += __shfl_xor(ss, 32);
                if (fq == 0) *(GAS float*)(E.stats_out + (size_t)row * 16 + u.pn * 4 + wc) = ss; }
    } else if (E.kind == EK_WIN) {
        const int pn = u.pn;
        if (pn < 8) {
            const int colt = pn * BM + cin;
#pragma unroll
            for (int ai = 0; ai < 2; ++ai)
#pragma unroll
                for (int m = 0; m < 4; ++m) { const int row = rowb + ai * HALF + m * 16; const float r = row_rs(E.stats_in, row);
#pragma unroll
                    for (int bj = 0; bj < 2; ++bj) { f32x4 v0 = acc[ai][bj][m][0] * r, v1 = acc[ai][bj][m][1] * r;
#pragma unroll
                        for (int j = 0; j < 4; ++j) { v0[j] = silu_f(v0[j]); v1[j] = silu_f(v1[j]); }
                        *(GAS u32x4*)(E.Z + (size_t)row * DI + colt + bj * HALF) = pack8(v0, v1); } }
        } else if (pn >= 28 && pn < 36) {
            const int colt = (pn - 28) * BM + cin;
#pragma unroll
            for (int ai = 0; ai < 2; ++ai)
#pragma unroll
                for (int m = 0; m < 4; ++m) { const int row = rowb + ai * HALF + m * 16; const float r = row_rs(E.stats_in, row);
#pragma unroll
                    for (int bj = 0; bj < 2; ++bj) { f32x4 v0 = acc[ai][bj][m][0] * r, v1 = acc[ai][bj][m][1] * r;
#pragma unroll
                        for (int j = 0; j < 4; ++j) { v0[j] = sigm_f(v0[j]); v1[j] = sigm_f(v1[j]); }
                        *(GAS u32x4*)(E.GATES + (size_t)row * (2 * DM) + colt + bj * HALF) = pack8(v0, v1); } }
        } else if (pn < 28) {
            const bool isx = pn < 24; bf16_t* const O = isx ? E.XBC : E.V; const int ldo = isx ? CD : PD; const int colt = (isx ? pn - 8 : pn - 24) * BM + cin;
            const int keep = isx ? 3 : PBUF;
#pragma unroll
            for (int ai = 0; ai < 2; ++ai)
#pragma unroll
                for (int m = 0; m < 4; ++m) { const int row = rowb + ai * HALF + m * 16; const float r = row_rs(E.stats_in, row);
                    float* sp = nullptr;
                    if (row < MP) { const int sb = row >> 11, st = row & (SEQ - 1); if (st >= SEQ - keep) sp = (isx ? E.conv_p : E.pool_p) + ((size_t)sb * keep + (st - (SEQ - keep))) * ldo + colt; }
                    else { const int sb = (row - MP) >> 3, st = (row - MP) & 7; const int si = st - (DECS - keep); if (si >= 0) sp = (isx ? E.conv_s : E.pool_s) + ((size_t)sb * keep + si) * ldo + colt; }
                    bf16_t* hp = nullptr;
                    if (isx && row < MP) { const int st = row & (SEQ - 1), tm = st & 127; if (tm >= 125 && st < SEQ - 3) hp = E.HALO + ((((size_t)(row >> 11) * 16 + (st >> 7) + 1) * 3 + (tm - 125)) * CD) + colt; }
#pragma unroll
                    for (int bj = 0; bj < 2; ++bj) { const f32x4 v0 = acc[ai][bj][m][0] * r, v1 = acc[ai][bj][m][1] * r;
                        const u32x4 pk = pack8(v0, v1);
                        *(GAS u32x4*)(O + (size_t)row * ldo + colt + bj * HALF) = pk;
                        if (hp) *(GAS u32x4*)(hp + bj * HALF) = pk;
                        if (sp) { *(GAS f32x4*)(sp + bj * HALF) = v0; *(GAS f32x4*)(sp + bj * HALF + 4) = v1; } } }
        } else if (wc == 0) {
            const f32x4 b0 = *(const GAS f32x4*)(E.dt_bias + 8 * fq), b1 = *(const GAS f32x4*)(E.dt_bias + 8 * fq + 4);
#pragma unroll
            for (int ai = 0; ai < 2; ++ai)
#pragma unroll
                for (int m = 0; m < 4; ++m) { const int row = rowb + ai * HALF + m * 16; const float r = row_rs(E.stats_in, row);
                    f32x4 v0 = acc[ai][0][m][0] * r + b0, v1 = acc[ai][0][m][1] * r + b1;
#pragma unroll
                    for (int j = 0; j < 4; ++j) { v0[j] = softplus_f(v0[j]); v1[j] = softplus_f(v1[j]); }
                    *(GAS f32x4*)(E.DT + (size_t)row * 32 + 8 * fq) = v0; *(GAS f32x4*)(E.DT + (size_t)row * 32 + 8 * fq + 4) = v1; }
        }
    } else if (E.kind == EK_T1) {
#pragma unroll
        for (int ai = 0; ai < 2; ++ai)
#pragma unroll
            for (int m = 0; m < 4; ++m) { const int row = rowb + ai * HALF + m * 16;
#pragma unroll
                for (int bj = 0; bj < 2; ++bj) { const int col = u.pn * BM + bj * HALF + cin;
                    f32x4 g0, g1; unpack8(*(const GAS u32x4*)(E.gates + (size_t)row * (2 * DM) + col), g0, g1);
                    *(GAS u32x4*)(E.obf + (size_t)row * DM + col) = pack8(g0 * acc[ai][bj][m][0], g1 * acc[ai][bj][m][1]); } }
    } else if (E.kind == EK_MERGE) {
#pragma unroll
        for (int ai = 0; ai < 2; ++ai)
#pragma unroll
            for (int m = 0; m < 4; ++m) { const int row = rowb + ai * HALF + m * 16;
#pragma unroll
                for (int bj = 0; bj < 2; ++bj) { const int col = u.pn * BM + bj * HALF + cin;
                    f32x4 g0, g1; unpack8(*(const GAS u32x4*)(E.gates + (size_t)row * (2 * DM) + DM + col), g0, g1);
                    f32x4 t0, t1; unpack8(*(const GAS u32x4*)(E.res_bf + (size_t)row * DM + col), t0, t1);
                    *(GAS u32x4*)(E.obf + (size_t)row * DM + col) = pack8(t0 + g0 * acc[ai][bj][m][0], t1 + g1 * acc[ai][bj][m][1]); } }
    } else if (E.kind == EK_BF16) {
#pragma unroll
        for (int ai = 0; ai < 2; ++ai)
#pragma unroll
            for (int m = 0; m < 4; ++m) { const int row = rowb + ai * HALF + m * 16;
#pragma unroll
                for (int bj = 0; bj < 2; ++bj) { const int col = u.pn * BM + bj * HALF + cin;
                    *(GAS u32x4*)(E.obf + (size_t)row * E.ldo + col) = pack8(acc[ai][bj][m][0], acc[ai][bj][m][1]); } }
    } else if (E.kind == EK_PLE) {
#pragma unroll
        for (int ai = 0; ai < 2; ++ai)
#pragma unroll
            for (int m = 0; m < 4; ++m) { const int row = rowb + ai * HALF + m * 16; const float r = row_rs(E.stats_in, row);
                float ss = 0.f;
#pragma unroll
                for (int bj = 0; bj < 2; ++bj) { const int col = u.pn * BM + bj * HALF + cin;
                    f32x4 q0, q1; unpack8(*(const GAS u32x4*)(E.q + (size_t)row * DM + col), q0, q1);
                    f32x4 r0, r1; unpack8(*(const GAS u32x4*)(E.res_bf + (size_t)row * DM + col), r0, r1);
                    f32x4 h0, h1;
#pragma unroll
                    for (int j = 0; j < 4; ++j) { h0[j] = r0[j] + sigm_f(acc[ai][bj][m][0][j] * r) * q0[j]; h1[j] = r1[j] + sigm_f(acc[ai][bj][m][1][j] * r) * q1[j]; }
                    *(GAS u32x4*)(E.obf + (size_t)row * DM + col) = pack8(h0, h1);
                    ss += (h0[0] * h0[0] + h0[1] * h0[1]) + (h0[2] * h0[2] + h0[3] * h0[3]) + (h1[0] * h1[0] + h1[1] * h1[1]) + (h1[2] * h1[2] + h1[3] * h1[3]); }
                ss += __shfl_xor(ss, 16); ss += __shfl_xor(ss, 32);
                if (fq == 0) *(GAS float*)(E.stats_out + (size_t)row * 16 + u.pn * 4 + wc) = ss; }
    }
}


__device__ __forceinline__ void epi_seg(const Epi& E, int row, int col, f32x4 v0, f32x4 v1, int lane) {
    if (E.kind == EK_RES) {
        f32x4 r0, r1;
        if (E.res_p) { const float* rp = ((row < MP) ? E.res_p + (size_t)row * DM : E.res_s + (size_t)(row - MP) * DM) + col; r0 = *(const GAS f32x4*)rp; r1 = *(const GAS f32x4*)(rp + 4); }
        else unpack8(*(const GAS u32x4*)(E.res_bf + (size_t)row * DM + col), r0, r1);
        const f32x4 h0 = r0 + v0 * E.coef, h1 = r1 + v1 * E.coef;
        *(GAS u32x4*)(E.obf + (size_t)row * DM + col) = pack8(h0, h1);
        float ss = (h0[0] * h0[0] + h0[1] * h0[1]) + (h0[2] * h0[2] + h0[3] * h0[3]) + (h1[0] * h1[0] + h1[1] * h1[1]) + (h1[2] * h1[2] + h1[3] * h1[3]);
        ss += __shfl_xor(ss, 1); ss += __shfl_xor(ss, 2); ss += __shfl_xor(ss, 4);
        if ((lane & 7) == 0) *(GAS float*)(E.stats_out + (size_t)row * 16 + (col >> 6)) = ss;
    } else if (E.kind == EK_T1) {
        f32x4 g0, g1; unpack8(*(const GAS u32x4*)(E.gates + (size_t)row * (2 * DM) + col), g0, g1);
        *(GAS u32x4*)(E.obf + (size_t)row * DM + col) = pack8(g0 * v0, g1 * v1);
    } else if (E.kind == EK_MERGE) {
        f32x4 g0, g1; unpack8(*(const GAS u32x4*)(E.gates + (size_t)row * (2 * DM) + DM + col), g0, g1);
        f32x4 t0, t1; unpack8(*(const GAS u32x4*)(E.res_bf + (size_t)row * DM + col), t0, t1);
        *(GAS u32x4*)(E.obf + (size_t)row * DM + col) = pack8(t0 + g0 * v0, t1 + g1 * v1);
    } else if (E.kind == EK_BF16) {
        *(GAS u32x4*)(E.obf + (size_t)row * E.ldo + col) = pack8(v0, v1);
    } else if (E.kind == EK_PLE) {
        const float r = row_rs(E.stats_in, row);
        f32x4 q0, q1; unpack8(*(const GAS u32x4*)(E.q + (size_t)row * DM + col), q0, q1);
        f32x4 r0, r1; unpack8(*(const GAS u32x4*)(E.res_bf + (size_t)row * DM + col), r0, r1);
        f32x4 h0, h1;
#pragma unroll
        for (int j = 0; j < 4; ++j) { h0[j] = r0[j] + sigm_f(v0[j] * r) * q0[j]; h1[j] = r1[j] + sigm_f(v1[j] * r) * q1[j]; }
        *(GAS u32x4*)(E.obf + (size_t)row * DM + col) = pack8(h0, h1);
        float ss = (h0[0] * h0[0] + h0[1] * h0[1]) + (h0[2] * h0[2] + h0[3] * h0[3]) + (h1[0] * h1[0] + h1[1] * h1[1]) + (h1[2] * h1[2] + h1[3] * h1[3]);
        ss += __shfl_xor(ss, 1); ss += __shfl_xor(ss, 2); ss += __shfl_xor(ss, 4);
        if ((lane & 7) == 0) *(GAS float*)(E.stats_out + (size_t)row * 16 + (col >> 6)) = ss;
    }
}
__device__ __forceinline__ void small_tile_sum(LAS unsigned char* lds, const bf16_t* A, int lda, const bf16_t* Bt, int K, int r0, int c0, f32x4& v0, f32x4& v1) {
    const int tid = threadIdx.x, wid = __builtin_amdgcn_readfirstlane(tid >> 6), lane = tid & 63, ql = lane & 15, gq = lane >> 4;
    f32x4 acc[4][4];
#pragma unroll
    for (int m = 0; m < 4; ++m)
#pragma unroll
        for (int n = 0; n < 4; ++n) acc[m][n] = (f32x4){0.f, 0.f, 0.f, 0.f};
    const bf16_t* const ap = A + (size_t)(r0 + ql) * lda + 8 * gq + 32 * wid;
    const bf16_t* const bp = Bt + (size_t)(c0 + ql) * K + 8 * gq + 32 * wid;
    const int nst = (K / 32 - wid + 7) / 8;
    bf16x8 af[4][4], bf[4][4];
#pragma unroll
    for (int u = 0; u < 4; ++u) if (u < nst) {
#pragma unroll
        for (int m = 0; m < 4; ++m) { af[u][m] = *(const GAS bf16x8*)(ap + (size_t)(16 * m) * lda + 256 * u); bf[u][m] = *(const GAS bf16x8*)(bp + (size_t)(16 * m) * K + 256 * u); } }
    for (int i = 0; i < nst; i += 4) {
#pragma unroll
        for (int u = 0; u < 4; ++u) if (i + u < nst) {
#pragma unroll
            for (int m = 0; m < 4; ++m)
#pragma unroll
                for (int n = 0; n < 4; ++n) acc[m][n] = __builtin_amdgcn_mfma_f32_16x16x32_bf16(bf[u][n], af[u][m], acc[m][n], 0, 0, 0);
            if (i + u + 4 < nst) {
#pragma unroll
                for (int m = 0; m < 4; ++m) { af[u][m] = *(const GAS bf16x8*)(ap + (size_t)(16 * m) * lda + 256 * (i + u + 4)); bf[u][m] = *(const GAS bf16x8*)(bp + (size_t)(16 * m) * K + 256 * (i + u + 4)); } }
        }
    }
    LAS f32x4* const slab = (LAS f32x4*)(lds + wid * 16384);
#pragma unroll
    for (int m = 0; m < 4; ++m)
#pragma unroll
        for (int n = 0; n < 4; ++n) slab[(16 * m + ql) * 16 + ((4 * n + gq) ^ ql)] = acc[m][n];
    __syncthreads();
    const int rr = 8 * wid + (lane >> 3), ch0 = 2 * (lane & 7);
    v0 = (f32x4){0.f, 0.f, 0.f, 0.f}; v1 = v0;
#pragma unroll
    for (int s8 = 0; s8 < 8; ++s8) { const LAS f32x4* sl = (const LAS f32x4*)(lds + s8 * 16384) + rr * 16; v0 += sl[ch0 ^ (rr & 15)]; v1 += sl[(ch0 + 1) ^ (rr & 15)]; }
    __syncthreads();
}
__device__ __forceinline__ void gemm_small(LAS unsigned char* lds, const Gemm g, const Epi& E, int row_base, int nrows, int G, int c) {
    const int tid = threadIdx.x, wid = __builtin_amdgcn_readfirstlane(tid >> 6), lane = tid & 63;
    const int ntn = g.N / 64, ntiles = (nrows / 64) * ntn;
    for (int v = c; v < ntiles; v += G) {
        const int r0 = row_base + 64 * (v / ntn), c0 = 64 * (v % ntn);
        f32x4 v0, v1; small_tile_sum(lds, g.A, g.lda, g.Bt, g.K, r0, c0, v0, v1);
        epi_seg(E, r0 + 8 * wid + (lane >> 3), c0 + 8 * (lane & 7), v0, v1, lane);
    }
}
struct Gemm2 { const bf16_t* A1; const bf16_t* B1; const bf16_t* A2; const bf16_t* B2; int K1, lda1, K2, lda2, N; };
__device__ __forceinline__ void gemm_small2(LAS unsigned char* lds, const Gemm2 g, const bf16_t* gates, bf16_t* out, int row_base, int nrows, int G, int c) {
    const int tid = threadIdx.x, wid = __builtin_amdgcn_readfirstlane(tid >> 6), lane = tid & 63;
    const int ntn = g.N / 64, ntiles = (nrows / 64) * ntn;
    for (int v = c; v < ntiles; v += G) {
        const int r0 = row_base + 64 * (v / ntn), c0 = 64 * (v % ntn), row = r0 + 8 * wid + (lane >> 3), col = c0 + 8 * (lane & 7);
        f32x4 a0, a1, b0, b1;
        small_tile_sum(lds, g.A1, g.lda1, g.B1, g.K1, r0, c0, a0, a1);
        small_tile_sum(lds, g.A2, g.lda2, g.B2, g.K2, r0, c0, b0, b1);
        f32x4 g00, g01, g10, g11; unpack8(*(const GAS u32x4*)(gates + (size_t)row * (2 * DM) + col), g00, g01); unpack8(*(const GAS u32x4*)(gates + (size_t)row * (2 * DM) + DM + col), g10, g11);
        *(GAS u32x4*)(out + (size_t)row * DM + col) = pack8(g00 * a0 + g10 * b0, g01 * a1 + g11 * b1);
    }
}

__device__ __forceinline__ void gemm_phase(LAS unsigned char* lds, const Gemm g, const StaticOrder& S, const Epi& E) {
    const int tid = threadIdx.x, wid = __builtin_amdgcn_readfirstlane(tid >> 6), lane = tid & 63, wr = wid >> 2, wc = wid & 3, fr = lane & 15, fq = lane >> 4;
    const int K = g.K, nt = K / BK;
    unsigned voffA[2], voffB[2];
#pragma unroll
    for (int i = 0; i < 2; ++i) { int R, C; stage_rc(tid * 16 + i * 8192, R, C); const int Rb = (R & ~31) + perm32(R & 31);
        voffA[i] = (unsigned)(R * g.lda + C) * 2u; voffB[i] = (unsigned)(Rb * K + C) * 2u; }
    const size_t kstep = (size_t)(BK * 2);
    const size_t hstep = (size_t)HALF * K * 2, hstepA = (size_t)HALF * g.lda * 2;
    const size_t tstep = 2 * hstep, tstepA = 2 * hstepA, pnstepA = (size_t)g.a_pn_step * 2;
    const unsigned ldsw = (unsigned)wid * 1024u;
    const int aoff = lds_byte(wr * 64 + fr, fq * 8), boff = lds_byte(wc * 32 + fr, fq * 8);
#define PG8_SA(b, h) (((b) * 2 + (h)) * HTB)
#define PG8_SB(b, h) ((4 + (b) * 2 + (h)) * HTB)
#define PG8_STAGE(bufoff, gbase, voff) do { _Pragma("unroll") for (int _i = 0; _i < 2; ++_i) \
        __builtin_amdgcn_global_load_lds((const unsigned*)((const char*)(gbase) + (voff)[_i]), (LAS unsigned*)(lds + (bufoff) + ldsw + _i * 8192), 16, 0, 0); } while (0)
#define PG8_LDA(dst, b, h) do { _Pragma("unroll") for (int m = 0; m < 4; ++m) _Pragma("unroll") for (int k = 0; k < 2; ++k) dst[m][k] = *(const LAS bf16x8*)(lds + PG8_SA(b, h) + aoff + m * 2048 + k * 1024); } while (0)
#define PG8_LDB(dst, b, h) do { _Pragma("unroll") for (int n = 0; n < 2; ++n) _Pragma("unroll") for (int k = 0; k < 2; ++k) dst[n][k] = *(const LAS bf16x8*)(lds + PG8_SB(b, h) + boff + n * 2048 + k * 1024); } while (0)
#define PG8_MMA(ai, bj, At, Bt) do { __builtin_amdgcn_s_setprio(1); _Pragma("unroll") for (int m = 0; m < 4; ++m) _Pragma("unroll") for (int n = 0; n < 2; ++n) _Pragma("unroll") for (int k = 0; k < 2; ++k) \
        acc[ai][bj][m][n] = __builtin_amdgcn_mfma_f32_16x16x32_bf16(Bt[n][k], At[m][k], acc[ai][bj][m][n], 0, 0, 0); __builtin_amdgcn_s_setprio(0); } while (0)
#define PG8_WAIT_V(n) asm volatile("s_waitcnt vmcnt(" #n ")" ::: "memory")
#define PG8_WAIT_L(n) asm volatile("s_waitcnt lgkmcnt(" #n ")" ::: "memory")
#define PG8_BAR __builtin_amdgcn_s_barrier()
#define PG8_SCHED __builtin_amdgcn_sched_barrier(0)
    Unit cur, nxt; int ui = 0;
    if (!S.next(0, cur)) return;
    f32x4 acc[2][2][4][2];
#pragma unroll
    for (int a = 0; a < 2; ++a)
#pragma unroll
        for (int b = 0; b < 2; ++b)
#pragma unroll
            for (int m = 0; m < 4; ++m)
#pragma unroll
                for (int n = 0; n < 2; ++n) acc[a][b][m][n] = (f32x4){0.f, 0.f, 0.f, 0.f};
    bf16x8 At[4][2], B0[2][2], B1[2][2];
    const char* cA = (const char*)g.A + (size_t)cur.pm * tstepA + (size_t)cur.pn * pnstepA; const char* cB = (const char*)g.Bt + (size_t)cur.pn * tstep;
    PG8_STAGE(PG8_SB(0, 0), cB, voffB); PG8_STAGE(PG8_SB(0, 1), cB + hstep, voffB); PG8_STAGE(PG8_SA(0, 0), cA, voffA); PG8_STAGE(PG8_SA(0, 1), cA + hstepA, voffA);
    if (wr == 1) PG8_BAR;
    PG8_WAIT_V(2); PG8_BAR;
    PG8_STAGE(PG8_SB(1, 0), cB + kstep, voffB); PG8_STAGE(PG8_SA(1, 0), cA + kstep, voffA); PG8_STAGE(PG8_SB(1, 1), cB + hstep + kstep, voffB);
    PG8_WAIT_V(6); PG8_BAR;
    for (;;) {
        const bool has_next = S.next(ui + 1, nxt);
        const char* nA = has_next ? (const char*)g.A + (size_t)nxt.pm * tstepA + (size_t)nxt.pn * pnstepA : cA; const char* nB = has_next ? (const char*)g.Bt + (size_t)nxt.pn * tstep : cB;
        for (int t = 0; t < nt; t += 2) {
            const bool last = (t == nt - 2);
            const char* a1 = cA + (size_t)(t + 1) * kstep;
            const char* a2 = last ? nA : cA + (size_t)(t + 2) * kstep; const char* b2 = last ? nB : cB + (size_t)(t + 2) * kstep;
            const char* a3 = a2 + kstep; const char* b3 = b2 + kstep;
            PG8_LDB(B0, 0, 0); PG8_LDB(B1, 0, 1); PG8_SCHED; PG8_LDA(At, 0, 0); PG8_STAGE(PG8_SA(1, 1), a1 + hstepA, voffA);
            PG8_WAIT_V(8); PG8_WAIT_L(0); PG8_BAR; PG8_MMA(0, 0, At, B0); PG8_MMA(0, 1, At, B1); PG8_BAR; PG8_SCHED;
            PG8_LDA(At, 0, 1); PG8_STAGE(PG8_SB(0, 0), b2, voffB); PG8_STAGE(PG8_SB(0, 1), b2 + hstep, voffB); PG8_STAGE(PG8_SA(0, 0), a2, voffA);
            PG8_WAIT_V(8); PG8_WAIT_L(0); PG8_BAR; PG8_MMA(1, 0, At, B0); PG8_MMA(1, 1, At, B1); PG8_BAR; PG8_SCHED;
            PG8_LDB(B0, 1, 0); PG8_LDB(B1, 1, 1); PG8_SCHED; PG8_LDA(At, 1, 0); PG8_STAGE(PG8_SA(0, 1), a2 + hstepA, voffA);
            PG8_WAIT_V(8); PG8_WAIT_L(0); PG8_BAR; PG8_MMA(0, 0, At, B0); PG8_MMA(0, 1, At, B1); PG8_BAR; PG8_SCHED;
            PG8_LDA(At, 1, 1); PG8_STAGE(PG8_SB(1, 0), b3, voffB); PG8_STAGE(PG8_SB(1, 1), b3 + hstep, voffB); PG8_STAGE(PG8_SA(1, 0), a3, voffA);
            PG8_WAIT_V(8); PG8_WAIT_L(0); PG8_BAR; PG8_MMA(1, 0, At, B0); PG8_MMA(1, 1, At, B1); PG8_BAR; PG8_SCHED;
        }
        if (wr == 0) PG8_BAR;
        epilogue(E, acc, cur, wr, wc, fr, fq);
        if (!has_next) break;
#pragma unroll
        for (int a = 0; a < 2; ++a)
#pragma unroll
            for (int b = 0; b < 2; ++b)
#pragma unroll
                for (int m = 0; m < 4; ++m)
#pragma unroll
                    for (int n = 0; n < 2; ++n) acc[a][b][m][n] = (f32x4){0.f, 0.f, 0.f, 0.f};
        cur = nxt; cA = nA; cB = nB; ++ui;
        if (wr == 1) PG8_BAR;
    }
    PG8_WAIT_V(0);
    PG8_BAR;
#undef PG8_SA
#undef PG8_SB
#undef PG8_STAGE
#undef PG8_LDA
#undef PG8_LDB
#undef PG8_MMA
#undef PG8_WAIT_V
#undef PG8_WAIT_L
#undef PG8_BAR
#undef PG8_SCHED
}

__device__ __forceinline__ void gemm_phase2(LAS unsigned char* lds, const Gemm2 g, const StaticOrder& S, const bf16_t* gates, bf16_t* out) {
    const int tid = threadIdx.x, wid = __builtin_amdgcn_readfirstlane(tid >> 6), lane = tid & 63, wr = wid >> 2, wc = wid & 3, fr = lane & 15, fq = lane >> 4;
    const int nt1 = g.K1 / BK, nt = nt1 + g.K2 / BK;
    int sR[2], sRb[2], sC[2];
#pragma unroll
    for (int i = 0; i < 2; ++i) { int R, C; stage_rc(tid * 16 + i * 8192, R, C); sR[i] = R; sRb[i] = (R & ~31) + perm32(R & 31); sC[i] = C; }
    const size_t kstep = (size_t)(BK * 2);
    const size_t hB1 = (size_t)HALF * g.K1 * 2, hA1 = (size_t)HALF * g.lda1 * 2, hB2 = (size_t)HALF * g.K2 * 2, hA2 = (size_t)HALF * g.lda2 * 2;
    const unsigned ldsw = (unsigned)wid * 1024u;
    const int aoff = lds_byte(wr * 64 + fr, fq * 8), boff = lds_byte(wc * 32 + fr, fq * 8);
#define PG8_SA(b, h) (((b) * 2 + (h)) * HTB)
#define PG8_SB(b, h) ((4 + (b) * 2 + (h)) * HTB)
#define PG8_STAGE_T(bufoff, isA, h, T) do { const int T_ = (T); const bool nx_ = T_ >= nt; const int Tl_ = nx_ ? T_ - nt : T_; const bool s2_ = !nx_ && Tl_ >= nt1; \
        const char* base_ = (isA) ? (s2_ ? cA2 + (size_t)(Tl_ - nt1) * kstep + (h) * hA2 : (nx_ ? nA1 : cA1) + (size_t)Tl_ * kstep + (h) * hA1) \
                                  : (s2_ ? cB2 + (size_t)(Tl_ - nt1) * kstep + (h) * hB2 : (nx_ ? nB1 : cB1) + (size_t)Tl_ * kstep + (h) * hB1); \
        const int ld_ = (isA) ? (s2_ ? g.lda2 : g.lda1) : (s2_ ? g.K2 : g.K1); \
        _Pragma("unroll") for (int _i = 0; _i < 2; ++_i) { const unsigned vo_ = (unsigned)(((isA) ? sR[_i] : sRb[_i]) * ld_ + sC[_i]) * 2u; \
            __builtin_amdgcn_global_load_lds((const unsigned*)(base_ + vo_), (LAS unsigned*)(lds + (bufoff) + ldsw + _i * 8192), 16, 0, 0); } } while (0)
#define PG8_LDA(dst, b, h) do { _Pragma("unroll") for (int m = 0; m < 4; ++m) _Pragma("unroll") for (int k = 0; k < 2; ++k) dst[m][k] = *(const LAS bf16x8*)(lds + PG8_SA(b, h) + aoff + m * 2048 + k * 1024); } while (0)
#define PG8_LDB(dst, b, h) do { _Pragma("unroll") for (int n = 0; n < 2; ++n) _Pragma("unroll") for (int k = 0; k < 2; ++k) dst[n][k] = *(const LAS bf16x8*)(lds + PG8_SB(b, h) + boff + n * 2048 + k * 1024); } while (0)
#define PG8_MMA(ai, bj, At, Bt) do { __builtin_amdgcn_s_setprio(1); _Pragma("unroll") for (int m = 0; m < 4; ++m) _Pragma("unroll") for (int n = 0; n < 2; ++n) _Pragma("unroll") for (int k = 0; k < 2; ++k) \
        acc[ai][bj][m][n] = __builtin_amdgcn_mfma_f32_16x16x32_bf16(Bt[n][k], At[m][k], acc[ai][bj][m][n], 0, 0, 0); __builtin_amdgcn_s_setprio(0); } while (0)
#define PG8_WAIT_V(n) asm volatile("s_waitcnt vmcnt(" #n ")" ::: "memory")
#define PG8_WAIT_L(n) asm volatile("s_waitcnt lgkmcnt(" #n ")" ::: "memory")
#define PG8_BAR __builtin_amdgcn_s_barrier()
#define PG8_SCHED __builtin_amdgcn_sched_barrier(0)
    Unit cur, nxt; int ui = 0;
    if (!S.next(0, cur)) return;
    f32x4 acc[2][2][4][2];
#pragma unroll
    for (int a = 0; a < 2; ++a)
#pragma unroll
        for (int b = 0; b < 2; ++b)
#pragma unroll
            for (int m = 0; m < 4; ++m)
#pragma unroll
                for (int n = 0; n < 2; ++n) acc[a][b][m][n] = (f32x4){0.f, 0.f, 0.f, 0.f};
    bf16x8 At[4][2], B0[2][2], B1[2][2];
    const char* cA1 = (const char*)g.A1 + (size_t)cur.pm * 2 * hA1; const char* cB1 = (const char*)g.B1 + (size_t)cur.pn * 2 * hB1;
    const char* cA2 = (const char*)g.A2 + (size_t)cur.pm * 2 * hA2; const char* cB2 = (const char*)g.B2 + (size_t)cur.pn * 2 * hB2;
    const char* nA1 = cA1; const char* nB1 = cB1;
    PG8_STAGE_T(PG8_SB(0, 0), false, 0, 0); PG8_STAGE_T(PG8_SB(0, 1), false, 1, 0); PG8_STAGE_T(PG8_SA(0, 0), true, 0, 0); PG8_STAGE_T(PG8_SA(0, 1), true, 1, 0);
    if (wr == 1) PG8_BAR;
    PG8_WAIT_V(2); PG8_BAR;
    PG8_STAGE_T(PG8_SB(1, 0), false, 0, 1); PG8_STAGE_T(PG8_SA(1, 0), true, 0, 1); PG8_STAGE_T(PG8_SB(1, 1), false, 1, 1);
    PG8_WAIT_V(6); PG8_BAR;
    for (;;) {
        const bool has_next = S.next(ui + 1, nxt);
        nA1 = has_next ? (const char*)g.A1 + (size_t)nxt.pm * 2 * hA1 : cA1; nB1 = has_next ? (const char*)g.B1 + (size_t)nxt.pn * 2 * hB1 : cB1;
        const int rowb = cur.pm * BM + wr * 64 + fr, colb = cur.pn * BM + wc * 32 + 8 * fq;
        for (int t = 0; t < nt; t += 2) {
            if (t == nt1) {
#pragma unroll
                for (int ai = 0; ai < 2; ++ai)
#pragma unroll
                    for (int m = 0; m < 4; ++m) { const bf16_t* gp = gates + (size_t)(rowb + ai * HALF + m * 16) * (2 * DM) + colb;
#pragma unroll
                        for (int bj = 0; bj < 2; ++bj) { f32x4 g00, g01, g10, g11; unpack8(*(const GAS u32x4*)(gp + bj * HALF), g00, g01); unpack8(*(const GAS u32x4*)(gp + DM + bj * HALF), g10, g11);
#pragma unroll
                            for (int j = 0; j < 4; ++j) { acc[ai][bj][m][0][j] *= g00[j] * __builtin_amdgcn_rcpf(fmaxf(g10[j], 1e-6f)); acc[ai][bj][m][1][j] *= g01[j] * __builtin_amdgcn_rcpf(fmaxf(g11[j], 1e-6f)); } } }
            }
            PG8_LDB(B0, 0, 0); PG8_LDB(B1, 0, 1); PG8_SCHED; PG8_LDA(At, 0, 0); PG8_STAGE_T(PG8_SA(1, 1), true, 1, t + 1);
            PG8_WAIT_V(8); PG8_WAIT_L(0); PG8_BAR; PG8_MMA(0, 0, At, B0); PG8_MMA(0, 1, At, B1); PG8_BAR; PG8_SCHED;
            PG8_LDA(At, 0, 1); PG8_STAGE_T(PG8_SB(0, 0), false, 0, t + 2); PG8_STAGE_T(PG8_SB(0, 1), false, 1, t + 2); PG8_STAGE_T(PG8_SA(0, 0), true, 0, t + 2);
            PG8_WAIT_V(8); PG8_WAIT_L(0); PG8_BAR; PG8_MMA(1, 0, At, B0); PG8_MMA(1, 1, At, B1); PG8_BAR; PG8_SCHED;
            PG8_LDB(B0, 1, 0); PG8_LDB(B1, 1, 1); PG8_SCHED; PG8_LDA(At, 1, 0); PG8_STAGE_T(PG8_SA(0, 1), true, 1, t + 2);
            PG8_WAIT_V(8); PG8_WAIT_L(0); PG8_BAR; PG8_MMA(0, 0, At, B0); PG8_MMA(0, 1, At, B1); PG8_BAR; PG8_SCHED;
            PG8_LDA(At, 1, 1); PG8_STAGE_T(PG8_SB(1, 0), false, 0, t + 3); PG8_STAGE_T(PG8_SB(1, 1), false, 1, t + 3); PG8_STAGE_T(PG8_SA(1, 0), true, 0, t + 3);
            PG8_WAIT_V(8); PG8_WAIT_L(0); PG8_BAR; PG8_MMA(1, 0, At, B0); PG8_MMA(1, 1, At, B1); PG8_BAR; PG8_SCHED;
        }
        if (wr == 0) PG8_BAR;
#pragma unroll
        for (int ai = 0; ai < 2; ++ai)
#pragma unroll
            for (int m = 0; m < 4; ++m) { const size_t row = (size_t)(rowb + ai * HALF + m * 16);
#pragma unroll
                for (int bj = 0; bj < 2; ++bj) { f32x4 g10, g11; unpack8(*(const GAS u32x4*)(gates + row * (2 * DM) + DM + colb + bj * HALF), g10, g11);
#pragma unroll
                    for (int j = 0; j < 4; ++j) { g10[j] = fmaxf(g10[j], 1e-6f); g11[j] = fmaxf(g11[j], 1e-6f); }
                    *(GAS u32x4*)(out + row * DM + colb + bj * HALF) = pack8(acc[ai][bj][m][0] * g10, acc[ai][bj][m][1] * g11); } }
        if (!has_next) break;
#pragma unroll
        for (int a = 0; a < 2; ++a)
#pragma unroll
            for (int b = 0; b < 2; ++b)
#pragma unroll
                for (int m = 0; m < 4; ++m)
#pragma unroll
                    for (int n = 0; n < 2; ++n) acc[a][b][m][n] = (f32x4){0.f, 0.f, 0.f, 0.f};
        cur = nxt; cA1 = nA1; cB1 = nB1; cA2 = (const char*)g.A2 + (size_t)cur.pm * 2 * hA2; cB2 = (const char*)g.B2 + (size_t)cur.pn * 2 * hB2; ++ui;
        if (wr == 1) PG8_BAR;
    }
    PG8_WAIT_V(0);
    PG8_BAR;
#undef PG8_SA
#undef PG8_SB
#undef PG8_STAGE_T
#undef PG8_LDA
#undef PG8_LDB
#undef PG8_MMA
#undef PG8_WAIT_V
#undef PG8_WAIT_L
#undef PG8_BAR
#undef PG8_SCHED
}
}

#define XB_TMO      128
#define XB_XCNT(j)  (256  + 64 * (j))
#define XB_XSUB(j)  (1280 + 64 * (j))
#define XB_XGEN(j)  (2304 + 64 * (j))
#define XB_TOP      3328
#define XB_TOPGEN   3392
#define XCD_BAR_WORDS 3456
#define XB_SPIN_CAP (1u << 18)
__device__ __forceinline__ unsigned xb_ld(unsigned* p)              { return __hip_atomic_load(p, __ATOMIC_RELAXED, __HIP_MEMORY_SCOPE_AGENT); }
__device__ __forceinline__ unsigned xb_add(unsigned* p, unsigned v) { return __hip_atomic_fetch_add(p, v, __ATOMIC_RELAXED, __HIP_MEMORY_SCOPE_AGENT); }
__device__ __forceinline__ unsigned xb_xcc_id() { return (unsigned)__builtin_amdgcn_s_getreg((3 << 11) | 20) & 0xFu; }
#define XB_SPIN(cond, bar) do { unsigned _sp = 0; while (cond) { __builtin_amdgcn_s_sleep(1); \
    if ((++_sp & 255u) == 0u) { if (xb_ld(&(bar)[XB_TMO])) break; if (_sp > XB_SPIN_CAP) { atomicAdd(&(bar)[XB_TMO], 1u); break; } } } } while (0)
struct XcdBarrier { unsigned* bar; unsigned x; volatile LAS unsigned* st; };
__device__ __forceinline__ XcdBarrier xcd_barrier_post(unsigned* bar, volatile LAS unsigned* st) {
    XcdBarrier b; b.bar = bar; b.x = xb_xcc_id(); b.st = st;
    if (threadIdx.x == 0) (void)xb_add(&bar[XB_XCNT(b.x)], 1u);
    return b;
}
__device__ __forceinline__ void xcd_barrier_complete(unsigned* bar, unsigned x, unsigned& nloc, unsigned& nx) {
    const unsigned G = gridDim.x * gridDim.y * gridDim.z;
    unsigned sum, cnt, mine, sp = 0u;
    for (;;) {
        sum = 0u; cnt = 0u; mine = 0u;
#pragma unroll
        for (unsigned j = 0; j < 16; ++j) { const unsigned c = xb_ld(&bar[XB_XCNT(j)]); sum += c; cnt += (c > 0u) ? 1u : 0u; mine = (j == x) ? c : mine; }
        if (sum == G) break;
        __builtin_amdgcn_s_sleep(1);
        if ((++sp & 255u) == 0u) { if (xb_ld(&bar[XB_TMO])) break; if (sp > XB_SPIN_CAP) { atomicAdd(&bar[XB_TMO], 1u); break; } }
    }
    nloc = mine > 0u ? mine : 1u; nx = cnt > 0u ? cnt : 1u;
}
__device__ __forceinline__ void xcd_barrier(const XcdBarrier& b) {
    asm volatile("s_waitcnt vmcnt(0)" ::: "memory");
    __syncthreads();
    if (threadIdx.x == 0) {
        unsigned* bar = b.bar;
        __builtin_amdgcn_s_waitcnt(0);
        unsigned nloc = b.st[0], nx = b.st[1];
        if (nloc == 0u) { xcd_barrier_complete(bar, b.x, nloc, nx); b.st[0] = nloc; b.st[1] = nx; }
        const unsigned old = xb_add(&bar[XB_XSUB(b.x)], 1u);
        const unsigned gen = old / nloc;
        if (old + 1u == (gen + 1u) * nloc) {
            __builtin_amdgcn_fence(__ATOMIC_RELEASE, "agent");
            asm volatile("s_waitcnt vmcnt(0)" ::: "memory");
            const unsigned og = xb_add(&bar[XB_TOP], 1u);
            const unsigned tg = og / nx;
            if (og + 1u == (tg + 1u) * nx) xb_add(&bar[XB_TOPGEN], 1u);
            else XB_SPIN(xb_ld(&bar[XB_TOPGEN]) == tg, bar);
            __builtin_amdgcn_fence(__ATOMIC_ACQUIRE, "agent");
            xb_add(&bar[XB_XGEN(b.x)], 1u);
            asm volatile("s_waitcnt vmcnt(0)" ::: "memory");
        } else {
            XB_SPIN(xb_ld(&bar[XB_XGEN(b.x)]) == gen, bar);
            __builtin_amdgcn_fence(__ATOMIC_ACQUIRE, "agent");
            asm volatile("s_waitcnt vmcnt(0)" ::: "memory");
        }
    }
    __syncthreads();
}

__device__ __forceinline__ void p0_transpose_item(const float* W, int K, int N, const float* gain, bf16_t* WT, int k0, int n0, int drow0, LAS float* scr, int lane) {
#pragma unroll
    for (int i = 0; i < 8; ++i) { const int kk = 8 * i + (lane >> 3), nn = 4 * (lane & 7);
        f32x4 v = *(const GAS f32x4*)(W + (size_t)(k0 + kk) * N + n0 + nn);
        if (gain) v = v * *(const GAS float*)(gain + k0 + kk);
        scr[kk * 33 + nn] = v.x; scr[kk * 33 + nn + 1] = v.y; scr[kk * 33 + nn + 2] = v.z; scr[kk * 33 + nn + 3] = v.w; }
    LDS_WAIT(); asm volatile("" ::: "memory");
    const int c = lane & 7;
#pragma unroll
    for (int j = 0; j < 4; ++j) { const int n = (lane >> 3) + 8 * j; const LAS float* s = scr + (8 * c) * 33 + n;
        u32x4 o; o.x = pk2(s[0 * 33], s[1 * 33]); o.y = pk2(s[2 * 33], s[3 * 33]); o.z = pk2(s[4 * 33], s[5 * 33]); o.w = pk2(s[6 * 33], s[7 * 33]);
        *(GAS u32x4*)(WT + (size_t)(drow0 + n) * K + k0 + 8 * c) = o; }
    LDS_WAIT(); asm volatile("" ::: "memory");
}
__device__ __forceinline__ int map_gu(int n0) { return n0 < DFF ? (n0 / 128) * 256 + (n0 % 128) : ((n0 - DFF) / 128) * 256 + 128 + ((n0 - DFF) % 128); }
__device__ __forceinline__ int map_win(int n0) { return n0 < 6144 ? n0 : (n0 < 6176 ? 9216 + (n0 - 6144) : n0 - 32); }

__device__ __forceinline__ void p0_prologue(Frame& F) {
    LAS float* scr = (LAS float*)(F.lds + F.wave * 16384);
    const int gw = F.vcu * NWAVES + F.wave, NGW = F.G * NWAVES, lane = F.lane;
    bf16_t* const wgu1 = (bf16_t*)(F.ws + WS_WGU1); bf16_t* const wd1 = (bf16_t*)(F.ws + WS_WD1); bf16_t* const win = (bf16_t*)(F.ws + WS_WIN);
    bf16_t* const wsso = (bf16_t*)(F.ws + WS_WSSO); bf16_t* const wo = (bf16_t*)(F.ws + WS_WO); bf16_t* const wgu2 = (bf16_t*)(F.ws + WS_WGU2);
    bf16_t* const wd2 = (bf16_t*)(F.ws + WS_WD2); bf16_t* const wpg = (bf16_t*)(F.ws + WS_WPG); bf16_t* const wple = (bf16_t*)(F.ws + WS_WPLE);
    constexpr int I_GU = (DM / 64) * (2 * DFF / 32), I_D = (DFF / 64) * (DM / 32), I_IN = (DM / 64) * (IN_DIM / 32), I_SSO = (DI / 64) * (DM / 32), I_SQ = (DM / 64) * (DM / 32), I_PLE = (PLE / 64) * (DM / 32);
    constexpr int NITEMS = 2 * I_GU + 2 * I_D + I_IN + I_SSO + 3 * I_SQ + I_PLE;
    bf16_t* const wpot = (bf16_t*)(F.ws + WS_WPOT);
    for (int it = gw; it < NITEMS; it += NGW) {
        int r = it;
        if (r < I_GU) { const int nb = 2 * DFF / 32, kb = r / nb, n0 = (r % nb) * 32; p0_transpose_item(F.in[I_WGU1], DM, 2 * DFF, F.in[I_NFFN1], wgu1, kb * 64, n0, map_gu(n0), scr, lane); continue; } r -= I_GU;
        if (r < I_GU) { const int nb = 2 * DFF / 32, kb = r / nb, n0 = (r % nb) * 32; p0_transpose_item(F.in[I_WGU2], DM, 2 * DFF, F.in[I_NFFN2], wgu2, kb * 64, n0, map_gu(n0), scr, lane); continue; } r -= I_GU;
        if (r < I_D) { const int nb = DM / 32, kb = r / nb, n0 = (r % nb) * 32; p0_transpose_item(F.in[I_WD1], DFF, DM, nullptr, wd1, kb * 64, n0, n0, scr, lane); continue; } r -= I_D;
        if (r < I_D) { const int nb = DM / 32, kb = r / nb, n0 = (r % nb) * 32; p0_transpose_item(F.in[I_WD2], DFF, DM, nullptr, wd2, kb * 64, n0, n0, scr, lane); continue; } r -= I_D;
        if (r < I_IN) { const int nb = IN_DIM / 32, kb = r / nb, n0 = (r % nb) * 32; p0_transpose_item(F.in[I_WIN], DM, IN_DIM, F.in[I_NMIX], win, kb * 64, n0, map_win(n0), scr, lane); continue; } r -= I_IN;
        if (r < I_SSO) { const int nb = DM / 32, kb = r / nb, n0 = (r % nb) * 32; p0_transpose_item(F.in[I_WSSO], DI, DM, F.in[I_NSSD], wsso, kb * 64, n0, n0, scr, lane); continue; } r -= I_SSO;
        if (r < I_SQ) { const int nb = DM / 32, kb = r / nb, n0 = (r % nb) * 32; p0_transpose_item(F.in[I_WO], DM, DM, nullptr, wo, kb * 64, n0, n0, scr, lane); continue; } r -= I_SQ;
        if (r < I_SQ) { const int nb = DM / 32, kb = r / nb, n0 = (r % nb) * 32; p0_transpose_item(F.in[I_WPG], DM, DM, F.in[I_NPLE], wpg, kb * 64, n0, n0, scr, lane); continue; } r -= I_SQ;
        if (r < I_SQ) { const int nb = DM / 32, kb = r / nb, n0 = (r % nb) * 32; p0_transpose_item(F.in[I_WPOUT], PD, DM, F.in[I_PSCALE], wpot, kb * 64, n0, n0, scr, lane); continue; } r -= I_SQ;
        { const int nb = DM / 32, kb = r / nb, n0 = (r % nb) * 32; p0_transpose_item(F.in[I_WPLE], PLE, DM, nullptr, wple, kb * 64, n0, n0, scr, lane); }
    }
    {
        bf16_t* const wgrp = (bf16_t*)(F.ws + WS_WGRP); const float* Wg = F.in[I_WPGRP];
        for (int e = F.vcu * NTHREADS + F.tid; e < 4 * 256 * 256 / 8; e += F.G * NTHREADS) {
            const f32x4 a = *(const GAS f32x4*)(Wg + (size_t)e * 8), b = *(const GAS f32x4*)(Wg + (size_t)e * 8 + 4);
            u32x4 o; o.x = pk2(a.x, a.y); o.y = pk2(a.z, a.w); o.z = pk2(b.x, b.y); o.w = pk2(b.z, b.w);
            *(GAS u32x4*)(wgrp + (size_t)e * 8) = o; }
    }
    {
        bf16_t* const XB = (bf16_t*)(F.ws + WS_XB); bf16_t* const PB = (bf16_t*)(F.ws + WS_PB); float* const stA = (float*)(F.ws + WS_STATS_A);
        for (int m = gw; m < M; m += NGW) {
            const float* xrow = (m < MP) ? F.in[I_XP] + (size_t)m * DM : F.in[I_XS] + (size_t)(m - MP) * DM;
            const GAS f32x4* xr = (const GAS f32x4*)xrow + lane;
            f32x4 v[4]; float s = 0.f;
#pragma unroll
            for (int j = 0; j < 4; ++j) { v[j] = xr[64 * j]; s += (v[j].x * v[j].x + v[j].y * v[j].y) + (v[j].z * v[j].z + v[j].w * v[j].w); }
            s = wave_sum(s);
            GAS u32x2* o8 = (GAS u32x2*)(XB + (size_t)m * DM) + lane;
#pragma unroll
            for (int j = 0; j < 4; ++j) { u32x2 w; w.x = pk2(v[j].x, v[j].y); w.y = pk2(v[j].z, v[j].w); o8[64 * j] = w; }
            if (lane < 16) *(GAS float*)(stA + (size_t)m * 16 + lane) = (lane == 0) ? s : 0.f;
            const float* prow = (m < MP) ? F.in[I_PP] + (size_t)m * PLE : F.in[I_PS] + (size_t)(m - MP) * PLE;
            const f32x4 pv = *((const GAS f32x4*)prow + lane);
            u32x2 w; w.x = pk2(pv.x, pv.y); w.y = pk2(pv.z, pv.w); *((GAS u32x2*)(PB + (size_t)m * PLE) + lane) = w;
        }
    }
}


typedef short v4i16_t __attribute__((ext_vector_type(4)));
constexpr int IMG_B = 0, IMG_C = 32768, IMG_X = 65536, TAB_ACS = RING_BYTES + 1024, TAB_DT = TAB_ACS + 2048, TAB_SD = TAB_DT + 2048;
constexpr int NCHUNK = SEQ / 128;
template <bool XS> __device__ __forceinline__ int img_off(int row, int ch) { return XS ? 256 * row + 16 * (ch ^ ((row & 7) << 1)) : 256 * row + 16 * (ch ^ (((row & 3) << 2) | ((row >> 2) & 3))); }
__device__ __forceinline__ bf16x8 tr_pair(const LAS unsigned char* p0, const LAS unsigned char* p1) {
    const v4i16_t a = __builtin_amdgcn_ds_read_tr16_b64_v4i16((LAS v4i16_t*)p0), b = __builtin_amdgcn_ds_read_tr16_b64_v4i16((LAS v4i16_t*)p1);
    return (bf16x8){a[0], a[1], a[2], a[3], b[0], b[1], b[2], b[3]};
}
__device__ __forceinline__ void ssd_tables_load(Frame& F, size_t row0, int g, float& d0, float& d1) {
    if (F.wave < 4) { const float* const DT = (const float*)(F.ws + WS_DT); const int head = g * HPG + F.wave;
        d0 = *(const GAS float*)(DT + (row0 + 2 * F.lane) * 32 + head); d1 = *(const GAS float*)(DT + (row0 + 2 * F.lane + 1) * 32 + head); }
}
__device__ __forceinline__ void ssd_tables_compute(Frame& F, int g, float d0, float d1) {
    LAS float* const acs = (LAS float*)(F.lds + TAB_ACS); LAS float* const dtl = (LAS float*)(F.lds + TAB_DT); LAS float* const sdec = (LAS float*)(F.lds + TAB_SD);
    if (F.wave < 4) {
        const int r = F.wave, lane = F.lane, head = g * HPG + r;
        const float Ah = -__expf(*(const GAS float*)(F.in[I_ALOG] + head));
        const float a0 = d0 * Ah, a1 = d1 * Ah, loc = a0 + a1;
        float inc = loc;
#pragma unroll
        for (int o = 1; o < 64; o <<= 1) { const float t = __shfl_up(inc, o); if (lane >= o) inc += t; }
        const float exc = inc - loc;
        acs[(2 * lane) * 4 + r] = exc + a0; acs[(2 * lane + 1) * 4 + r] = inc;
        dtl[(2 * lane) * 4 + r] = d0; dtl[(2 * lane + 1) * 4 + r] = d1;
    }
    __syncthreads();
    { const int s = F.tid >> 2, r = F.tid & 3; sdec[s * 4 + r] = __expf(acs[127 * 4 + r] - acs[s * 4 + r]) * dtl[s * 4 + r]; }
    __syncthreads();
}
__device__ __forceinline__ void ssd_tables(Frame& F, size_t row0, int g) { float d0 = 0.f, d1 = 0.f; ssd_tables_load(F, row0, g, d0, d1); ssd_tables_compute(F, g, d0, d1); }
struct ConvMap { int kind, cc, run, gch; };
__device__ __forceinline__ ConvMap ssd_conv_map(int t, int g) {
    ConvMap m;
    if (t < 256) { m.kind = 0; m.cc = t & 31; m.run = t >> 5; } else if (t < 384) { m.kind = 1; m.cc = (t - 256) & 15; m.run = (t - 256) >> 4; } else { m.kind = 2; m.cc = (t - 384) & 15; m.run = (t - 384) >> 4; }
    m.gch = (m.kind == 0 ? g * 256 : (m.kind == 1 ? DI + g * DSTATE : DI + NG * DSTATE + g * DSTATE)) + 8 * m.cc;
    return m;
}
__device__ __forceinline__ void ssd_conv_load(Frame& F, size_t row0, int b, int c, int g, u32x4 (&raw)[19]) {
    const ConvMap m = ssd_conv_map(F.tid, g);
    const bf16_t* const XBC = (const bf16_t*)(F.ws + WS_XBC); const bf16_t* const HALO = (const bf16_t*)(F.ws + WS_HALO);
#pragma unroll
    for (int i = 0; i < 19; ++i) {
        if (i < 3 && m.run == 0) { if (c == 0) raw[i] = (u32x4){0u, 0u, 0u, 0u}; else raw[i] = *(const GAS u32x4*)(HALO + ((((size_t)b * 16 + c) * 3 + i) * CD) + m.gch); }
        else raw[i] = *(const GAS u32x4*)(XBC + (row0 + 16 * m.run + i - 3) * CD + m.gch); }
}
__device__ __forceinline__ void ssd_conv_store(Frame& F, size_t row0, int g, const u32x4 (&raw)[19]) {
    const ConvMap m = ssd_conv_map(F.tid, g);
    bf16_t* const XBC = (bf16_t*)(F.ws + WS_XBC);
    const float* const convw = F.in[I_CONVW]; const float* const convb = F.in[I_CONVB];
    float cw[4][8], cb[8];
#pragma unroll
    for (int k = 0; k < 4; ++k) { const f32x4 a = *(const GAS f32x4*)(convw + (size_t)k * CD + m.gch), b_ = *(const GAS f32x4*)(convw + (size_t)k * CD + m.gch + 4);
        cw[k][0] = a.x; cw[k][1] = a.y; cw[k][2] = a.z; cw[k][3] = a.w; cw[k][4] = b_.x; cw[k][5] = b_.y; cw[k][6] = b_.z; cw[k][7] = b_.w; }
    { const f32x4 a = *(const GAS f32x4*)(convb + m.gch), b_ = *(const GAS f32x4*)(convb + m.gch + 4); cb[0] = a.x; cb[1] = a.y; cb[2] = a.z; cb[3] = a.w; cb[4] = b_.x; cb[5] = b_.y; cb[6] = b_.z; cb[7] = b_.w; }
    LAS unsigned char* const img = F.lds + (m.kind == 0 ? IMG_X + (m.cc >> 4) * 32768 : IMG_B);
    const LAS float* const sdec = (const LAS float*)(F.lds + TAB_SD);
    const int chl = m.cc & 15, hr = m.cc >> 3;
#pragma unroll
    for (int i = 0; i < 16; ++i) {
        const int s = 16 * m.run + i;
        float o[8];
#pragma unroll
        for (int j2 = 0; j2 < 4; ++j2) {
            const unsigned w0 = raw[i][j2], w1 = raw[i + 1][j2], w2 = raw[i + 2][j2], w3 = raw[i + 3][j2];
            const float lo = cb[2 * j2] + cw[0][2 * j2] * bflo(w0) + cw[1][2 * j2] * bflo(w1) + cw[2][2 * j2] * bflo(w2) + cw[3][2 * j2] * bflo(w3);
            const float hi = cb[2 * j2 + 1] + cw[0][2 * j2 + 1] * bfhi(w0) + cw[1][2 * j2 + 1] * bfhi(w1) + cw[2][2 * j2 + 1] * bfhi(w2) + cw[3][2 * j2 + 1] * bfhi(w3);
            o[2 * j2] = silu_f(lo); o[2 * j2 + 1] = silu_f(hi);
        }
        u32x4 pk; pk.x = cvt_pk_bf16(o[0], o[1]); pk.y = cvt_pk_bf16(o[2], o[3]); pk.z = cvt_pk_bf16(o[4], o[5]); pk.w = cvt_pk_bf16(o[6], o[7]);
        *(GAS u32x4*)(XBC + (row0 + s) * CD + m.gch) = pk;
        if (m.kind == 0) { const float sc = sdec[s * 4 + hr];
            pk.x = cvt_pk_bf16(o[0] * sc, o[1] * sc); pk.y = cvt_pk_bf16(o[2] * sc, o[3] * sc); pk.z = cvt_pk_bf16(o[4] * sc, o[5] * sc); pk.w = cvt_pk_bf16(o[6] * sc, o[7] * sc); }
        if (m.kind != 2) *(LAS u32x4*)(img + img_off<false>(s, chl)) = pk;
    }
}
__device__ __forceinline__ void ssd_copy_load(Frame& F, size_t row0, int g, u32x4 (&raw)[16]) {
    const ConvMap m = ssd_conv_map(F.tid, g);
    const bf16_t* const XBC = (const bf16_t*)(F.ws + WS_XBC);
#pragma unroll
    for (int i = 0; i < 16; ++i) raw[i] = *(const GAS u32x4*)(XBC + (row0 + 16 * m.run + i) * CD + m.gch);
}
__device__ __forceinline__ void ssd_copy_store(Frame& F, int g, const u32x4 (&raw)[16]) {
    const ConvMap m = ssd_conv_map(F.tid, g);
    LAS unsigned char* const img = F.lds + (m.kind == 0 ? IMG_X + (m.cc >> 4) * 32768 : (m.kind == 1 ? IMG_B : IMG_C));
    const int chl = m.cc & 15;
#pragma unroll
    for (int i = 0; i < 16; ++i) { const int s = 16 * m.run + i; *(LAS u32x4*)(img + (m.kind == 0 ? img_off<true>(s, chl) : img_off<false>(s, chl))) = raw[i]; }
}
__device__ __forceinline__ void ssd_states_phase(Frame& F) {
    bf16_t* const ST = (bf16_t*)(F.ws + WS_HPREV);
    float* const CDEC = (float*)(F.ws + WS_CDEC);
    const int w = F.wave, lane = F.lane, ql = lane & 15, gq = lane >> 4, qq = ql >> 2, pp = ql & 3, r = w >> 1, nh = w & 1;
    int sbo[4][2], sxo[4][2];
#pragma unroll
    for (int f = 0; f < 4; ++f) { const int colb = 64 * nh + 16 * f + 4 * pp, colx = 64 * (r & 1) + 16 * f + 4 * pp;
#pragma unroll
        for (int t4 = 0; t4 < 2; ++t4) { sbo[f][t4] = img_off<false>(8 * gq + qq + 4 * t4, colb >> 3) + 2 * (colb & 7); sxo[f][t4] = img_off<false>(8 * gq + qq + 4 * t4, colx >> 3) + 2 * (colx & 7); } }
    u32x4 raw[19]; float d0 = 0.f, d1 = 0.f;
    constexpr int NIT = BATCH * NCHUNK * NG;
    if (F.vcu < NIT) { const int it = F.vcu, g = it & 7, c = (it >> 3) & (NCHUNK - 1), b = it >> 7; const size_t row0 = (size_t)b * SEQ + (size_t)c * 128;
        ssd_conv_load(F, row0, b, c, g, raw); ssd_tables_load(F, row0, g, d0, d1); }
    for (int it = F.vcu; it < NIT; it += F.G) {
        const int g = it & 7, c = (it >> 3) & (NCHUNK - 1), b = it >> 7;
        const size_t row0 = (size_t)b * SEQ + (size_t)c * 128;
        asm volatile("s_waitcnt vmcnt(0)" ::: "memory");
        ssd_tables_compute(F, g, d0, d1);
        ssd_conv_store(F, row0, g, raw);
        __syncthreads();
        if (it + F.G < NIT) { const int it2 = it + F.G, g2 = it2 & 7, c2 = (it2 >> 3) & (NCHUNK - 1), b2 = it2 >> 7; const size_t row2 = (size_t)b2 * SEQ + (size_t)c2 * 128;
            ssd_conv_load(F, row2, b2, c2, g2, raw); ssd_tables_load(F, row2, g2, d0, d1); }
        const int head = g * HPG + r;
        bf16_t* const stp = ST + ((((size_t)b * NCHUNK + c) * NH + head) * HD) * DSTATE;
#pragma unroll
        for (int nh2 = 0; nh2 < 2; ++nh2) {
            f32x4 acc[2][4];
#pragma unroll
            for (int i = 0; i < 2; ++i)
#pragma unroll
                for (int j = 0; j < 4; ++j) acc[i][j] = (f32x4){0.f, 0.f, 0.f, 0.f};
#pragma unroll
            for (int ks = 0; ks < 4; ++ks) {
                bf16x8 af[2], xf[4];
#pragma unroll
                for (int nf = 0; nf < 2; ++nf) { const LAS unsigned char* p = F.lds + IMG_B + sbo[2 * nh2 + nf][0] + 8192 * ks; const LAS unsigned char* p4 = F.lds + IMG_B + sbo[2 * nh2 + nf][1] + 8192 * ks; af[nf] = tr_pair(p, p4); }
#pragma unroll
                for (int pf = 0; pf < 4; ++pf) { const LAS unsigned char* p = F.lds + IMG_X + (r >> 1) * 32768 + sxo[pf][0] + 8192 * ks; const LAS unsigned char* p4 = F.lds + IMG_X + (r >> 1) * 32768 + sxo[pf][1] + 8192 * ks; xf[pf] = tr_pair(p, p4); }
#pragma unroll
                for (int nf = 0; nf < 2; ++nf)
#pragma unroll
                    for (int pf = 0; pf < 4; ++pf) acc[nf][pf] = __builtin_amdgcn_mfma_f32_16x16x32_bf16(af[nf], xf[pf], acc[nf][pf], 0, 0, 0);
            }
#pragma unroll
            for (int pf = 0; pf < 4; ++pf)
#pragma unroll
                for (int nf = 0; nf < 2; ++nf) { u32x2 o; o.x = cvt_pk_bf16(acc[nf][pf][0], acc[nf][pf][1]); o.y = cvt_pk_bf16(acc[nf][pf][2], acc[nf][pf][3]);
                    *(GAS u32x2*)(stp + (size_t)(16 * pf + ql) * DSTATE + 64 * nh + 32 * nh2 + 16 * nf + 4 * gq) = o; }
        }
        if (F.tid < 4) { const LAS float* acs = (const LAS float*)(F.lds + TAB_ACS); *(GAS float*)(CDEC + ((size_t)b * NCHUNK + c) * NH + g * HPG + F.tid) = __expf(acs[127 * 4 + F.tid]); }
        __syncthreads();
    }
}
__device__ __forceinline__ void ssd_scan_phase(Frame& F) {
    bf16_t* const HP = (bf16_t*)(F.ws + WS_HPREV); const float* const CDEC = (const float*)(F.ws + WS_CDEC); float* const hout = F.out + O_SSM_P;
    const int gt = F.vcu * NTHREADS + F.tid, NT = F.G * NTHREADS;
    constexpr int PER = NH * HD * DSTATE / 8;
    for (int e = gt; e < BATCH * PER; e += NT) {
        const int b = e / PER, i8 = e % PER, head = i8 / (HD * DSTATE / 8);
        u32x4 stv[NCHUNK];
#pragma unroll
        for (int c = 0; c < NCHUNK; ++c) stv[c] = *(const GAS u32x4*)(HP + (((size_t)b * NCHUNK + c) * (size_t)PER + i8) * 8);
        f32x4 h0 = (f32x4){0.f, 0.f, 0.f, 0.f}, h1 = h0;
#pragma unroll
        for (int c = 0; c < NCHUNK; ++c) {
            if (c > 0) *(GAS u32x4*)(HP + (((size_t)b * NCHUNK + c) * (size_t)PER + i8) * 8) = pg8::pack8(h0, h1);
            const float d = *(const GAS float*)(CDEC + ((size_t)b * NCHUNK + c) * NH + head);
            f32x4 s0, s1; pg8::unpack8(stv[c], s0, s1);
            h0 = h0 * d + s0; h1 = h1 * d + s1;
        }
        *(GAS f32x4*)(hout + ((size_t)b * PER + i8) * 8) = h0; *(GAS f32x4*)(hout + ((size_t)b * PER + i8) * 8 + 4) = h1;
    }
}
__device__ __forceinline__ void ssd_out_phase(Frame& F) {
    const bf16_t* const HP = (const bf16_t*)(F.ws + WS_HPREV); bf16_t* const ZY = (bf16_t*)(F.ws + WS_Z);
    const int w = F.wave, lane = F.lane, ql = lane & 15, gq = lane >> 4, qq = ql >> 2, pp = ql & 3, q0 = 16 * w;
    const LAS float* const acs = (const LAS float*)(F.lds + TAB_ACS); const LAS float* const dtl = (const LAS float*)(F.lds + TAB_DT);
    int cfo[4], bbo[4], hbo[4], xbo[2][4];
#pragma unroll
    for (int ks = 0; ks < 4; ++ks) { cfo[ks] = IMG_C + img_off<false>(q0 + ql, 4 * ks + gq); bbo[ks] = IMG_B + img_off<false>(ql, 4 * ks + gq); hbo[ks] = img_off<false>(ql, 4 * ks + gq); }
#pragma unroll
    for (int rr = 0; rr < 2; ++rr)
#pragma unroll
        for (int pf = 0; pf < 4; ++pf) xbo[rr][pf] = IMG_X + img_off<true>(4 * gq + qq, 8 * rr + 2 * pf + (pp >> 1)) + 8 * (pp & 1);
    u32x4 raw[16]; float d0 = 0.f, d1 = 0.f;
    constexpr int NIT = BATCH * NCHUNK * NG;
    if (F.vcu < NIT) { const int it = F.vcu, g = it & 7, c = (it >> 3) & (NCHUNK - 1), b = it >> 7; const size_t row0 = (size_t)b * SEQ + (size_t)c * 128;
        ssd_copy_load(F, row0, g, raw); ssd_tables_load(F, row0, g, d0, d1); }
    for (int it = F.vcu; it < NIT; it += F.G) {
        const int g = it & 7, c = (it >> 3) & (NCHUNK - 1), b = it >> 7;
        const size_t row0 = (size_t)b * SEQ + (size_t)c * 128;
        ssd_tables_compute(F, g, d0, d1);
        ssd_copy_store(F, g, raw);
        __syncthreads();
        if (it + F.G < NIT) { const int it2 = it + F.G, g2 = it2 & 7, c2 = (it2 >> 3) & (NCHUNK - 1), b2 = it2 >> 7; const size_t row2 = (size_t)b2 * SEQ + (size_t)c2 * 128;
            ssd_copy_load(F, row2, g2, raw); ssd_tables_load(F, row2, g2, d0, d1); }
        bf16x8 cf[4];
#pragma unroll
        for (int ks = 0; ks < 4; ++ks) cf[ks] = *(const LAS bf16x8*)(F.lds + cfo[ks]);
        bf16_t* const zp = ZY + (row0 + q0 + ql) * DI + g * 256 + 4 * gq;
        const LAS float* const acs_l = acs + 16 * gq; const LAS float* const dtl_l = dtl + 16 * gq;
        f32x4 acc[4][4];
        float aq[4];
#pragma unroll
        for (int r = 0; r < 4; ++r) { aq[r] = acs[(q0 + ql) * 4 + r];
#pragma unroll
            for (int pf = 0; pf < 4; ++pf) acc[r][pf] = (f32x4){0.f, 0.f, 0.f, 0.f}; }
#pragma unroll
        for (int ks = 0; ks < 4; ++ks) if (2 * ks <= w) {
            f32x4 cb[2];
#pragma unroll
            for (int hf = 0; hf < 2; ++hf) { cb[hf] = (f32x4){0.f, 0.f, 0.f, 0.f};
                if (2 * ks + hf <= w) {
#pragma unroll
                    for (int kn = 0; kn < 4; ++kn) { const bf16x8 bfr = *(const LAS bf16x8*)(F.lds + bbo[kn] + 4096 * (2 * ks + hf)); cb[hf] = __builtin_amdgcn_mfma_f32_16x16x32_bf16(bfr, cf[kn], cb[hf], 0, 0, 0); } } }
#pragma unroll
            for (int r = 0; r < 4; ++r) {
                const float Dh = *(const GAS float*)(F.in[I_DSKIP] + g * HPG + r);
                float v[8];
#pragma unroll
                for (int hf = 0; hf < 2; ++hf) { const int sf = 2 * ks + hf;
#pragma unroll
                    for (int rg = 0; rg < 4; ++rg) { const int sl = 4 * gq + rg;
                        float val = 0.f;
                        if (sf <= w) { const float as = acs_l[64 * sf + 4 * rg + r], d = dtl_l[64 * sf + 4 * rg + r];
                            val = cb[hf][rg] * __expf(aq[r] - as) * d;
                            if (sf == w) { if (sl > ql) val = 0.f; else if (sl == ql) val += Dh; } }
                        v[4 * hf + rg] = val; } }
                u32x4 pk; pk.x = cvt_pk_bf16(v[0], v[1]); pk.y = cvt_pk_bf16(v[2], v[3]); pk.z = cvt_pk_bf16(v[4], v[5]); pk.w = cvt_pk_bf16(v[6], v[7]);
                const bf16x8 wf = __builtin_bit_cast(bf16x8, pk);
#pragma unroll
                for (int pf = 0; pf < 4; ++pf) {
                    const LAS unsigned char* const xb = F.lds + xbo[r & 1][pf] + (r >> 1) * 32768 + 8192 * ks;
                    const bf16x8 xf = tr_pair(xb, xb + 4096);
                    acc[r][pf] = __builtin_amdgcn_mfma_f32_16x16x32_bf16(xf, wf, acc[r][pf], 0, 0, 0); }
            }
        }
        u32x4 hreg[8];
        if (c > 0) {
            const u32x4* hsrc = (const u32x4*)(HP + ((((size_t)b * NCHUNK + c) * NH + g * HPG) * HD) * DSTATE) + F.tid;
#pragma unroll
            for (int i = 0; i < 8; ++i) hreg[i] = *(const GAS u32x4*)(hsrc + 512 * i);
        }
        if (c > 0) {
            __syncthreads();
#pragma unroll
            for (int i = 0; i < 8; ++i) { const int e = F.tid + 512 * i, hr_ = e >> 10, p_ = (e >> 4) & 63, ch_ = e & 15;
                *(LAS u32x4*)(F.lds + IMG_X + hr_ * 16384 + img_off<false>(p_, ch_)) = hreg[i]; }
            __syncthreads();
#pragma unroll
            for (int r = 0; r < 4; ++r) { const float eaq = __expf(aq[r]);
#pragma unroll
                for (int pf = 0; pf < 4; ++pf) { f32x4 yo = (f32x4){0.f, 0.f, 0.f, 0.f};
#pragma unroll
                    for (int ks = 0; ks < 4; ++ks) { const bf16x8 hf_ = *(const LAS bf16x8*)(F.lds + IMG_X + r * 16384 + hbo[ks] + 4096 * pf); yo = __builtin_amdgcn_mfma_f32_16x16x32_bf16(hf_, cf[ks], yo, 0, 0, 0); }
                    acc[r][pf] += yo * eaq; } }
        }
        float ssum = 0.f;
#pragma unroll
        for (int r = 0; r < 4; ++r)
#pragma unroll
            for (int pf = 0; pf < 4; ++pf) {
                const u32x2 zz = *(const GAS u32x2*)(zp + r * 64 + 16 * pf);
                const f32x4 y = acc[r][pf] * (f32x4){bflo(zz.x), bfhi(zz.x), bflo(zz.y), bfhi(zz.y)};
                acc[r][pf] = y; ssum += (y[0] * y[0] + y[1] * y[1]) + (y[2] * y[2] + y[3] * y[3]); }
        ssum += __shfl_xor(ssum, 16); ssum += __shfl_xor(ssum, 32);
        const float rsn = __builtin_amdgcn_rsqf(ssum * (1.0f / 256.0f) + EPS);
#pragma unroll
        for (int r = 0; r < 4; ++r)
#pragma unroll
            for (int pf = 0; pf < 4; ++pf) { u32x2 o; o.x = cvt_pk_bf16(acc[r][pf][0] * rsn, acc[r][pf][1] * rsn); o.y = cvt_pk_bf16(acc[r][pf][2] * rsn, acc[r][pf][3] * rsn);
                *(GAS u32x2*)(zp + r * 64 + 16 * pf) = o; }
        __syncthreads();
    }
}


__device__ __forceinline__ void ssd_conv_store_local(Frame& F, size_t row0, int g, const u32x4 (&raw)[19]) {
    const ConvMap m = ssd_conv_map(F.tid, g);
    bf16_t* const XBC = (bf16_t*)(F.ws + WS_XBC);
    const float* const convw = F.in[I_CONVW]; const float* const convb = F.in[I_CONVB];
    float cw[4][8], cb[8];
#pragma unroll
    for (int k = 0; k < 4; ++k) { const f32x4 a = *(const GAS f32x4*)(convw + (size_t)k * CD + m.gch), b_ = *(const GAS f32x4*)(convw + (size_t)k * CD + m.gch + 4);
        cw[k][0] = a.x; cw[k][1] = a.y; cw[k][2] = a.z; cw[k][3] = a.w; cw[k][4] = b_.x; cw[k][5] = b_.y; cw[k][6] = b_.z; cw[k][7] = b_.w; }
    { const f32x4 a = *(const GAS f32x4*)(convb + m.gch), b_ = *(const GAS f32x4*)(convb + m.gch + 4); cb[0] = a.x; cb[1] = a.y; cb[2] = a.z; cb[3] = a.w; cb[4] = b_.x; cb[5] = b_.y; cb[6] = b_.z; cb[7] = b_.w; }
    LAS unsigned char* const img = F.lds + (m.kind == 0 ? IMG_X + (m.cc >> 4) * 32768 : (m.kind == 1 ? IMG_B : IMG_C));
    const int chl = m.cc & 15;
#pragma unroll
    for (int i = 0; i < 16; ++i) {
        const int s = 16 * m.run + i;
        float o[8];
#pragma unroll
        for (int j2 = 0; j2 < 4; ++j2) {
            const unsigned w0 = raw[i][j2], w1 = raw[i + 1][j2], w2 = raw[i + 2][j2], w3 = raw[i + 3][j2];
            const float lo = cb[2 * j2] + cw[0][2 * j2] * bflo(w0) + cw[1][2 * j2] * bflo(w1) + cw[2][2 * j2] * bflo(w2) + cw[3][2 * j2] * bflo(w3);
            const float hi = cb[2 * j2 + 1] + cw[0][2 * j2 + 1] * bfhi(w0) + cw[1][2 * j2 + 1] * bfhi(w1) + cw[2][2 * j2 + 1] * bfhi(w2) + cw[3][2 * j2 + 1] * bfhi(w3);
            o[2 * j2] = silu_f(lo); o[2 * j2 + 1] = silu_f(hi);
        }
        u32x4 pk; pk.x = cvt_pk_bf16(o[0], o[1]); pk.y = cvt_pk_bf16(o[2], o[3]); pk.z = cvt_pk_bf16(o[4], o[5]); pk.w = cvt_pk_bf16(o[6], o[7]);
        if (m.kind == 2) *(GAS u32x4*)(XBC + (row0 + s) * CD + m.gch) = pk;
        *(LAS u32x4*)(img + (m.kind == 0 ? img_off<true>(s, chl) : img_off<false>(s, chl))) = pk;
    }
}
__device__ __forceinline__ void ssd_local_phase(Frame& F) {
    bf16_t* const XBC = (bf16_t*)(F.ws + WS_XBC); bf16_t* const ST = (bf16_t*)(F.ws + WS_HPREV); float* const CDEC = (float*)(F.ws + WS_CDEC); float* const EAQ = (float*)(F.ws + WS_EAQ);
    const int w = F.wave, lane = F.lane, q0 = 16 * w, hr = w >> 1, nh = w & 1;
    const LAS float* const acs = (const LAS float*)(F.lds + TAB_ACS); const LAS float* const dtl = (const LAS float*)(F.lds + TAB_DT); const LAS float* const sdec = (const LAS float*)(F.lds + TAB_SD);
    u32x4 raw[19]; float d0 = 0.f, d1 = 0.f;
    constexpr int NIT = BATCH * NCHUNK * NG;
    if (F.vcu < NIT) { const int it = F.vcu, g = it & 7, c = (it >> 3) & (NCHUNK - 1), b = it >> 7; const size_t row0 = (size_t)b * SEQ + (size_t)c * 128;
        ssd_conv_load(F, row0, b, c, g, raw); ssd_tables_load(F, row0, g, d0, d1); }
    for (int it = F.vcu; it < NIT; it += F.G) {
        const int g = it & 7, c = (it >> 3) & (NCHUNK - 1), b = it >> 7;
        const size_t row0 = (size_t)b * SEQ + (size_t)c * 128;
        asm volatile("s_waitcnt vmcnt(0)" ::: "memory");
        ssd_tables_compute(F, g, d0, d1);
        ssd_conv_store_local(F, row0, g, raw);
        __syncthreads();
        int lane_ = lane; asm volatile("" : "+v"(lane_));
        const int ql = lane_ & 15, gq = lane_ >> 4, qq = ql >> 2, pp = ql & 3;
        int cfo[4], bbo[4], xbo[2][4], sbo[4];
#pragma unroll
        for (int ks = 0; ks < 4; ++ks) { cfo[ks] = IMG_C + img_off<false>(q0 + ql, 4 * ks + gq); bbo[ks] = IMG_B + img_off<false>(ql, 4 * ks + gq); }
#pragma unroll
        for (int rr = 0; rr < 2; ++rr)
#pragma unroll
                for (int pf = 0; pf < 4; ++pf) xbo[rr][pf] = IMG_X + img_off<true>(4 * gq + qq, 8 * rr + 2 * pf + (pp >> 1)) + 8 * (pp & 1);
#pragma unroll
        for (int nf = 0; nf < 4; ++nf) { const int col = 64 * nh + 16 * nf + 4 * pp; sbo[nf] = IMG_B + img_off<false>(4 * gq + qq, col >> 3) + 2 * (col & 7); }
        {
            bf16x8 cf[4];
#pragma unroll
            for (int ks = 0; ks < 4; ++ks) cf[ks] = *(const LAS bf16x8*)(F.lds + cfo[ks]);
            const LAS float* const acs_l = acs + 16 * gq; const LAS float* const dtl_l = dtl + 16 * gq;
            f32x4 acc[4][4]; float aq[4];
#pragma unroll
            for (int r = 0; r < 4; ++r) { aq[r] = acs[(q0 + ql) * 4 + r];
#pragma unroll
                for (int pf = 0; pf < 4; ++pf) acc[r][pf] = (f32x4){0.f, 0.f, 0.f, 0.f}; }
#pragma unroll
            for (int ks = 0; ks < 4; ++ks) if (2 * ks <= w) {
                f32x4 cb[2];
#pragma unroll
                for (int hf = 0; hf < 2; ++hf) { cb[hf] = (f32x4){0.f, 0.f, 0.f, 0.f};
                    if (2 * ks + hf <= w) {
#pragma unroll
                        for (int kn = 0; kn < 4; ++kn) { const bf16x8 bfr = *(const LAS bf16x8*)(F.lds + bbo[kn] + 4096 * (2 * ks + hf)); cb[hf] = __builtin_amdgcn_mfma_f32_16x16x32_bf16(bfr, cf[kn], cb[hf], 0, 0, 0); } } }
#pragma unroll
                for (int r = 0; r < 4; ++r) {
                    const float Dh = *(const GAS float*)(F.in[I_DSKIP] + g * HPG + r);
                    float v[8];
#pragma unroll
                    for (int hf = 0; hf < 2; ++hf) { const int sf = 2 * ks + hf;
#pragma unroll
                        for (int rg = 0; rg < 4; ++rg) { const int sl = 4 * gq + rg;
                            float val = 0.f;
                            if (sf <= w) { const float as = acs_l[64 * sf + 4 * rg + r], d = dtl_l[64 * sf + 4 * rg + r];
                                val = cb[hf][rg] * __expf(aq[r] - as) * d;
                                if (sf == w) { if (sl > ql) val = 0.f; else if (sl == ql) val += Dh; } }
                            v[4 * hf + rg] = val; } }
                    u32x4 pk; pk.x = cvt_pk_bf16(v[0], v[1]); pk.y = cvt_pk_bf16(v[2], v[3]); pk.z = cvt_pk_bf16(v[4], v[5]); pk.w = cvt_pk_bf16(v[6], v[7]);
                    const bf16x8 wf = __builtin_bit_cast(bf16x8, pk);
#pragma unroll
                    for (int pf = 0; pf < 4; ++pf) {
                        const LAS unsigned char* const xb = F.lds + xbo[r & 1][pf] + (r >> 1) * 32768 + 8192 * ks;
                        const bf16x8 xf = tr_pair(xb, xb + 4096);
                        acc[r][pf] = __builtin_amdgcn_mfma_f32_16x16x32_bf16(xf, wf, acc[r][pf], 0, 0, 0); }
                }
            }
            bf16_t* const yp = XBC + (row0 + q0 + ql) * CD + g * 256 + 4 * gq;
#pragma unroll
            for (int r = 0; r < 4; ++r)
#pragma unroll
                for (int pf = 0; pf < 4; ++pf) { u32x2 o; o.x = cvt_pk_bf16(acc[r][pf][0], acc[r][pf][1]); o.y = cvt_pk_bf16(acc[r][pf][2], acc[r][pf][3]); *(GAS u32x2*)(yp + r * 64 + 16 * pf) = o; }
            if (gq == 0) *(GAS f32x4*)(EAQ + (row0 + q0 + ql) * 32 + g * HPG) = (f32x4){__expf(aq[0]), __expf(aq[1]), __expf(aq[2]), __expf(aq[3])};
        }
        asm volatile("" ::: "memory"); __builtin_amdgcn_sched_barrier(0);
        if (it + F.G < NIT) { const int it2 = it + F.G, g2 = it2 & 7, c2 = (it2 >> 3) & (NCHUNK - 1), b2 = it2 >> 7; const size_t row2 = (size_t)b2 * SEQ + (size_t)c2 * 128;
            ssd_conv_load(F, row2, b2, c2, g2, raw); ssd_tables_load(F, row2, g2, d0, d1); }
        {
            const int head = g * HPG + hr;
            bf16_t* const stp = ST + ((((size_t)b * NCHUNK + c) * NH + head) * HD) * DSTATE;
#pragma unroll
            for (int nh2 = 0; nh2 < 2; ++nh2) {
                f32x4 acc[2][4];
#pragma unroll
                for (int i = 0; i < 2; ++i)
#pragma unroll
                    for (int j = 0; j < 4; ++j) acc[i][j] = (f32x4){0.f, 0.f, 0.f, 0.f};
#pragma unroll
                for (int ks = 0; ks < 4; ++ks) {
                    asm volatile("" ::: "memory");
                    float sd[8];
#pragma unroll
                    for (int j = 0; j < 8; ++j) sd[j] = sdec[(32 * ks + 16 * (j >> 2) + 4 * gq + (j & 3)) * 4 + hr];
                    bf16x8 af[2], xf[4];
#pragma unroll
                    for (int nf = 0; nf < 2; ++nf) { const LAS unsigned char* p = F.lds + sbo[2 * nh2 + nf] + 8192 * ks; af[nf] = tr_pair(p, p + 4096); }
#pragma unroll
                    for (int pf = 0; pf < 4; ++pf) { const LAS unsigned char* p = F.lds + xbo[hr & 1][pf] + (hr >> 1) * 32768 + 8192 * ks;
                        const u32x4 xr = __builtin_bit_cast(u32x4, tr_pair(p, p + 4096));
                        u32x4 xs; xs.x = cvt_pk_bf16(bflo(xr.x) * sd[0], bfhi(xr.x) * sd[1]); xs.y = cvt_pk_bf16(bflo(xr.y) * sd[2], bfhi(xr.y) * sd[3]);
                        xs.z = cvt_pk_bf16(bflo(xr.z) * sd[4], bfhi(xr.z) * sd[5]); xs.w = cvt_pk_bf16(bflo(xr.w) * sd[6], bfhi(xr.w) * sd[7]);
                        xf[pf] = __builtin_bit_cast(bf16x8, xs); }
#pragma unroll
                    for (int nf = 0; nf < 2; ++nf)
#pragma unroll
                        for (int pf = 0; pf < 4; ++pf) acc[nf][pf] = __builtin_amdgcn_mfma_f32_16x16x32_bf16(af[nf], xf[pf], acc[nf][pf], 0, 0, 0);
                }
#pragma unroll
                for (int pf = 0; pf < 4; ++pf)
#pragma unroll
                    for (int nf = 0; nf < 2; ++nf) { u32x2 o; o.x = cvt_pk_bf16(acc[nf][pf][0], acc[nf][pf][1]); o.y = cvt_pk_bf16(acc[nf][pf][2], acc[nf][pf][3]);
                        *(GAS u32x2*)(stp + (size_t)(16 * pf + ql) * DSTATE + 64 * nh + 32 * nh2 + 16 * nf + 4 * gq) = o; }
            }
            if (F.tid < 4) *(GAS float*)(CDEC + ((size_t)b * NCHUNK + c) * NH + g * HPG + F.tid) = __expf(acs[127 * 4 + F.tid]);
        }
        __syncthreads();
    }
}
__device__ __forceinline__ void ssd_final_phase(Frame& F) {
    const bf16_t* const XBC = (const bf16_t*)(F.ws + WS_XBC); const bf16_t* const HP = (const bf16_t*)(F.ws + WS_HPREV); bf16_t* const ZY = (bf16_t*)(F.ws + WS_Z); const float* const EAQ = (const float*)(F.ws + WS_EAQ);
    const int w = F.wave, lane = F.lane, ql = lane & 15, gq = lane >> 4, q0 = 16 * w;
    int cfo[4], hbo[4];
#pragma unroll
    for (int ks = 0; ks < 4; ++ks) { cfo[ks] = IMG_C + img_off<false>(q0 + ql, 4 * ks + gq); hbo[ks] = img_off<false>(ql, 4 * ks + gq); }
    u32x4 creg[4], hreg[8];
    constexpr int NIT = BATCH * NCHUNK * NG;
    auto loads = [&](int it) __attribute__((always_inline)) {
        const int g = it & 7, c = (it >> 3) & (NCHUNK - 1), b = it >> 7; const size_t row0 = (size_t)b * SEQ + (size_t)c * 128;
#pragma unroll
        for (int i = 0; i < 4; ++i) { const int e = F.tid + 512 * i; creg[i] = *(const GAS u32x4*)(XBC + (row0 + (e >> 4)) * CD + DI + NG * DSTATE + g * DSTATE + 8 * (e & 15)); }
        if (c > 0) { const u32x4* hsrc = (const u32x4*)(HP + ((((size_t)b * NCHUNK + c) * NH + g * HPG) * HD) * DSTATE) + F.tid;
#pragma unroll
            for (int i = 0; i < 8; ++i) hreg[i] = *(const GAS u32x4*)(hsrc + 512 * i); } };
    if (F.vcu < NIT) loads(F.vcu);
    for (int it = F.vcu; it < NIT; it += F.G) {
        const int g = it & 7, c = (it >> 3) & (NCHUNK - 1), b = it >> 7;
        const size_t row0 = (size_t)b * SEQ + (size_t)c * 128;
#pragma unroll
        for (int i = 0; i < 4; ++i) { const int e = F.tid + 512 * i; *(LAS u32x4*)(F.lds + IMG_C + img_off<false>(e >> 4, e & 15)) = creg[i]; }
        if (c > 0) {
#pragma unroll
            for (int i = 0; i < 8; ++i) { const int e = F.tid + 512 * i, hr_ = e >> 10, p_ = (e >> 4) & 63, ch_ = e & 15; *(LAS u32x4*)(F.lds + IMG_X + hr_ * 16384 + img_off<false>(p_, ch_)) = hreg[i]; } }
        __syncthreads();
        if (it + F.G < NIT) loads(it + F.G);
        bf16x8 cf[4];
#pragma unroll
        for (int ks = 0; ks < 4; ++ks) cf[ks] = *(const LAS bf16x8*)(F.lds + cfo[ks]);
        const size_t rowq = row0 + q0 + ql;
        bf16_t* const zp = ZY + rowq * DI + g * 256 + 4 * gq; const bf16_t* const yp = XBC + rowq * CD + g * 256 + 4 * gq;
        const f32x4 eaq = *(const GAS f32x4*)(EAQ + rowq * 32 + g * HPG);
        u32x2 zr[4][4], yr[4][4];
#pragma unroll
        for (int r = 0; r < 4; ++r)
#pragma unroll
            for (int pf = 0; pf < 4; ++pf) { zr[r][pf] = *(const GAS u32x2*)(zp + r * 64 + 16 * pf); yr[r][pf] = *(const GAS u32x2*)(yp + r * 64 + 16 * pf); }
        f32x4 acc[4][4]; float ssum = 0.f;
#pragma unroll
        for (int r = 0; r < 4; ++r)
#pragma unroll
            for (int pf = 0; pf < 4; ++pf) { f32x4 yo = (f32x4){0.f, 0.f, 0.f, 0.f};
                if (c > 0) {
#pragma unroll
                    for (int ks = 0; ks < 4; ++ks) { const bf16x8 hf_ = *(const LAS bf16x8*)(F.lds + IMG_X + r * 16384 + hbo[ks] + 4096 * pf); yo = __builtin_amdgcn_mfma_f32_16x16x32_bf16(hf_, cf[ks], yo, 0, 0, 0); } }
                const u32x2 zz = zr[r][pf], yy = yr[r][pf];
                const f32x4 y = ((f32x4){bflo(yy.x), bfhi(yy.x), bflo(yy.y), bfhi(yy.y)} + yo * eaq[r]) * (f32x4){bflo(zz.x), bfhi(zz.x), bflo(zz.y), bfhi(zz.y)};
                acc[r][pf] = y; ssum += (y[0] * y[0] + y[1] * y[1]) + (y[2] * y[2] + y[3] * y[3]); }
        ssum += __shfl_xor(ssum, 16); ssum += __shfl_xor(ssum, 32);
        const float rsn = __builtin_amdgcn_rsqf(ssum * (1.0f / 256.0f) + EPS);
#pragma unroll
        for (int r = 0; r < 4; ++r)
#pragma unroll
            for (int pf = 0; pf < 4; ++pf) { u32x2 o; o.x = cvt_pk_bf16(acc[r][pf][0] * rsn, acc[r][pf][1] * rsn); o.y = cvt_pk_bf16(acc[r][pf][2] * rsn, acc[r][pf][3] * rsn);
                *(GAS u32x2*)(zp + r * 64 + 16 * pf) = o; }
        __syncthreads();
    }
}

__device__ __forceinline__ void ssd_seq_phase(Frame& F) {
    const int r = F.wave & 3, nh = F.wave >> 2, lane = F.lane, idx = r * 64 + lane;
    LAS float* const bc = (LAS float*)F.lds;
    LAS float* const lxs = bc + 2048;
    LAS float* const yp = bc + 4096;
    LAS float* const ldt = bc + 8192; LAS float* const ssq = bc + 8192 + 32;
    const bf16_t* const XBC = (const bf16_t*)(F.ws + WS_XBC); const bf16_t* const Zs = (const bf16_t*)(F.ws + WS_Z); bf16_t* const YN = (bf16_t*)(F.ws + WS_Z);
    const float* const DT = (const float*)(F.ws + WS_DT);
    const float* const convw = F.in[I_CONVW]; const float* const convb = F.in[I_CONVB];
    for (int it = F.vcu; it < DECB * NG; it += F.G) {
        const int b = it >> 3, g = it & 7, head = g * HPG + r;
        const size_t row0 = (size_t)MP + (size_t)b * DECS;
        const int xch = g * 256 + idx;
        {
            const int ch = (nh == 0) ? ((idx < 128) ? (DI + g * DSTATE + idx) : (DI + NG * DSTATE + g * DSTATE + (idx - 128))) : xch;
            float cw[4];
#pragma unroll
            for (int k = 0; k < 4; ++k) cw[k] = *(const GAS float*)(convw + (size_t)k * CD + ch);
            const float cbv = *(const GAS float*)(convb + ch);
            const float* cs = F.in[I_CONV] + (size_t)b * 3 * CD;
            float x3 = *(const GAS float*)(cs + ch), x2 = *(const GAS float*)(cs + CD + ch), x1 = *(const GAS float*)(cs + 2 * CD + ch);
            LAS float* const dst = (nh == 0) ? bc : lxs;
#pragma unroll
            for (int j = 0; j < 8; ++j) {
                const float xr = bf2f(*(const GAS bf16_t*)(XBC + (row0 + j) * CD + ch));
                const float cx = cbv + cw[0] * x3 + cw[1] * x2 + cw[2] * x1 + cw[3] * xr; x3 = x2; x2 = x1; x1 = xr;
                dst[j * 256 + idx] = silu_f(cx);
            }
            if (nh == 1 && lane < 8) ldt[lane * 4 + r] = *(const GAS float*)(DT + (row0 + lane) * 32 + head);
        }
        __syncthreads();
        {
            const float Ah = -__expf(*(const GAS float*)(F.in[I_ALOG] + head));
            const int pg = lane >> 4, nc = lane & 15;
            f32x4 h[16];
            const float* const hin = F.in[I_SSM] + (((size_t)b * NH + head) * HD + 16 * pg) * DSTATE + 64 * nh + 4 * nc;
#pragma unroll
            for (int i = 0; i < 16; ++i) h[i] = *(const GAS f32x4*)(hin + (size_t)i * DSTATE);
            for (int j = 0; j < 8; ++j) {
                const float dtv = ldt[j * 4 + r], dA = __expf(dtv * Ah);
                const f32x4 Bv = *(const LAS f32x4*)(bc + j * 256 + 64 * nh + 4 * nc), Cv = *(const LAS f32x4*)(bc + j * 256 + 128 + 64 * nh + 4 * nc);
                float part[16];
#pragma unroll
                for (int i4 = 0; i4 < 4; ++i4) { const f32x4 xs4 = *(const LAS f32x4*)(lxs + j * 256 + r * 64 + 16 * pg + 4 * i4);
#pragma unroll
                    for (int k = 0; k < 4; ++k) { const int i = 4 * i4 + k; const float dx = dtv * xs4[k];
                        h[i] = h[i] * dA + Bv * dx;
                        part[i] = (Cv.x * h[i].x + Cv.y * h[i].y) + (Cv.z * h[i].z + Cv.w * h[i].w); } }
#pragma unroll
                for (int i = 0; i < 8; ++i) { const bool up = (nc & 8) != 0; const float keep = up ? part[i + 8] : part[i], send = up ? part[i] : part[i + 8]; part[i] = keep + __shfl_xor(send, 8); }
#pragma unroll
                for (int i = 0; i < 4; ++i) { const bool up = (nc & 4) != 0; const float keep = up ? part[i + 4] : part[i], send = up ? part[i] : part[i + 4]; part[i] = keep + __shfl_xor(send, 4); }
#pragma unroll
                for (int i = 0; i < 2; ++i) { const bool up = (nc & 2) != 0; const float keep = up ? part[i + 2] : part[i], send = up ? part[i] : part[i + 2]; part[i] = keep + __shfl_xor(send, 2); }
                { const bool up = (nc & 1) != 0; const float keep = up ? part[1] : part[0], send = up ? part[0] : part[1]; part[0] = keep + __shfl_xor(send, 1); }
                yp[(j * 2 + nh) * 256 + r * 64 + 16 * pg + nc] = part[0];
            }
            float* const hout = F.out + O_SSM_S + (((size_t)b * NH + head) * HD + 16 * pg) * DSTATE + 64 * nh + 4 * nc;
#pragma unroll
            for (int i = 0; i < 16; ++i) *(GAS f32x4*)(hout + (size_t)i * DSTATE) = h[i];
        }
        __syncthreads();
        float ygv[4];
        {
            const float Dh = *(const GAS float*)(F.in[I_DSKIP] + head);
#pragma unroll
            for (int jj = 0; jj < 4; ++jj) { const int j = 4 * nh + jj;
                const float y = (yp[(j * 2) * 256 + idx] + yp[(j * 2 + 1) * 256 + idx]) + Dh * lxs[j * 256 + idx];
                ygv[jj] = y * bf2f(*(const GAS bf16_t*)(Zs + (row0 + j) * DI + xch));
                const float ss = wave_sum(ygv[jj] * ygv[jj]);
                if (lane == 0) ssq[j * 4 + r] = ss; }
        }
        __syncthreads();
#pragma unroll
        for (int jj = 0; jj < 4; ++jj) { const int j = 4 * nh + jj;
            const f32x4 s4 = *(const LAS f32x4*)(ssq + j * 4);
            const float rsn = __builtin_amdgcn_rsqf(((s4.x + s4.y) + (s4.z + s4.w)) * (1.0f / 256.0f) + EPS);
            *(GAS bf16_t*)(YN + (row0 + j) * DI + xch) = (bf16_t)f2bf(ygv[jj] * rsn); }
        __syncthreads();
    }
}
template <int W> __device__ __forceinline__ void pool_run(const bf16_t* V, bf16_t* PO, int run, int cv) {
    const int row0 = run * 16, t0 = row0 & (SEQ - 1);
    u32x4 raw[16 + W - 1];
#pragma unroll
    for (int e = 0; e < 16 + W - 1; ++e) {
        const int dt_ = e - (W - 1);
        if (t0 + dt_ >= 0) raw[e] = *(const GAS u32x4*)(V + (size_t)(row0 + dt_) * PD + cv); else raw[e] = (u32x4){0u, 0u, 0u, 0u};
    }
    f32x4 s0 = (f32x4){0.f, 0.f, 0.f, 0.f}, s1 = s0;
#pragma unroll
    for (int e = 0; e < W - 1; ++e) { f32x4 x0, x1; pg8::unpack8(raw[e], x0, x1); s0 += x0; s1 += x1; }
#pragma unroll
    for (int i = 0; i < 16; ++i) {
        f32x4 c0, c1; pg8::unpack8(raw[i + W - 1], c0, c1);
        s0 += c0; s1 += c1;
        const int t = t0 + i; const float ic = 1.0f / (float)((t + 1 < W) ? t + 1 : W);
        const f32x4 o0 = s0 * ic - c0, o1 = s1 * ic - c1;
        u32x4 o; o.x = pk2(o0.x, o0.y); o.y = pk2(o0.z, o0.w); o.z = pk2(o1.x, o1.y); o.w = pk2(o1.z, o1.w);
        *(GAS u32x4*)(PO + (size_t)(row0 + i) * PD + cv) = o;
        f32x4 x0, x1; pg8::unpack8(raw[i], x0, x1); s0 -= x0; s1 -= x1;
    }
}
template <int W> __device__ __forceinline__ void pool_run_s(const bf16_t* V, bf16_t* PO, const float* sp, int b, int cv) {
    const size_t row0 = (size_t)MP + (size_t)b * DECS;
    f32x4 a0[8 + W - 1], a1[8 + W - 1];
#pragma unroll
    for (int e = 0; e < 8 + W - 1; ++e) { const int t = e - (W - 1);
        if (t >= 0) pg8::unpack8(*(const GAS u32x4*)(V + (row0 + t) * PD + cv), a0[e], a1[e]);
        else { const float* p = sp + ((size_t)b * PBUF + (PBUF + t)) * PD + cv; a0[e] = *(const GAS f32x4*)p; a1[e] = *(const GAS f32x4*)(p + 4); } }
    f32x4 s0 = (f32x4){0.f, 0.f, 0.f, 0.f}, s1 = s0;
#pragma unroll
    for (int e = 0; e < W - 1; ++e) { s0 += a0[e]; s1 += a1[e]; }
    const float ic = 1.0f / (float)W;
#pragma unroll
    for (int i = 0; i < 8; ++i) {
        s0 += a0[i + W - 1]; s1 += a1[i + W - 1];
        const f32x4 o0 = s0 * ic - a0[i + W - 1], o1 = s1 * ic - a1[i + W - 1];
        u32x4 o; o.x = pk2(o0.x, o0.y); o.y = pk2(o0.z, o0.w); o.z = pk2(o1.x, o1.y); o.w = pk2(o1.z, o1.w);
        *(GAS u32x4*)(PO + (row0 + i) * PD + cv) = o;
        s0 -= a0[i]; s1 -= a1[i];
    }
}
__device__ __forceinline__ void pool_phase(Frame& F) {
    const bf16_t* const V = (const bf16_t*)(F.ws + WS_V); bf16_t* const PO = (bf16_t*)(F.out + O_Y);
    const float* const sp = F.in[I_POOL];
    const int gt = F.vcu * NTHREADS + F.tid, NT = F.G * NTHREADS;
    for (int e = gt; e < (MP / 16) * 128; e += NT) {
        const int c32 = e & 31, rl = (e >> 5) & 1, grp = (e >> 6) & 3, run = (e >> 8) * 2 + rl, cv = (grp * 32 + c32) * 8;
        if (grp == 0) pool_run<2>(V, PO, run, cv); else if (grp == 1) pool_run<4>(V, PO, run, cv); else if (grp == 2) pool_run<8>(V, PO, run, cv); else pool_run<16>(V, PO, run, cv);
    }
    for (int e = gt; e < (MS / 8) * 128; e += NT) {
        const int c32 = e & 31, grp = (e >> 5) & 3, b = e >> 7, cv = (grp * 32 + c32) * 8;
        if (grp == 0) pool_run_s<2>(V, PO, sp, b, cv); else if (grp == 1) pool_run_s<4>(V, PO, sp, b, cv); else if (grp == 2) pool_run_s<8>(V, PO, sp, b, cv); else pool_run_s<16>(V, PO, sp, b, cv);
    }
    float* const ops = F.out + O_POOL_S;
    for (int e = gt; e < DECB * 7 * (PD / 4); e += NT) {
        const int c4 = e & 255, i = (e >> 8) % 7, b = (e >> 8) / 7;
        *(GAS f32x4*)(ops + ((size_t)b * PBUF + i) * PD + c4 * 4) = *(const GAS f32x4*)(sp + ((size_t)b * PBUF + 8 + i) * PD + c4 * 4);
    }
}
__device__ __forceinline__ void final_phase(Frame& F) {
    const int gw = F.vcu * NWAVES + F.wave, NGW = F.G * NWAVES, lane = F.lane;
    const float* const st = (const float*)(F.ws + WS_STATS_A); const float* const gf = F.in[I_NFINAL];
    f32x4 gv[4];
#pragma unroll
    for (int j = 0; j < 4; ++j) gv[j] = *((const GAS f32x4*)gf + lane + 64 * j);
    const bf16_t* const h4 = (const bf16_t*)(F.ws + WS_ACT);
    for (int m = gw; m < M; m += NGW) {
        const GAS f32x4* sp = (const GAS f32x4*)(st + (size_t)m * 16);
        const f32x4 a = sp[0], b = sp[1], c = sp[2], d = sp[3]; const f32x4 s = (a + b) + (c + d);
        const float rs = __builtin_amdgcn_rsqf(((s[0] + s[1]) + (s[2] + s[3])) * (1.0f / 1024.0f) + EPS);
        const GAS u32x2* hr = (const GAS u32x2*)(h4 + (size_t)m * DM) + lane;
        GAS f32x4* yr = (GAS f32x4*)(F.out + (size_t)m * DM) + lane;
#pragma unroll
        for (int j = 0; j < 4; ++j) { const u32x2 w = hr[64 * j]; yr[64 * j] = (f32x4){bflo(w.x), bfhi(w.x), bflo(w.y), bfhi(w.y)} * rs * gv[j]; }
    }
}

constexpr int NPHASES = 13;
struct Args { const float* in[30]; float* out; unsigned char* ws; int ph_lo, ph_hi, li, pad; };
__global__ void __launch_bounds__(NTHREADS, 2) mk_fwd(Args args) {
    extern __shared__ __attribute__((aligned(16))) unsigned char lds[];
    Frame F;
    F.lds = (LAS unsigned char*)lds;
    F.MISC = (volatile LAS unsigned*)(F.lds + MISC_OFF);
    F.tid = threadIdx.x; F.lane = F.tid & 63; F.wave = __builtin_amdgcn_readfirstlane(F.tid >> 6);
    F.G = gridDim.x; { const int bx = blockIdx.x; F.vcu = (F.G % 8 == 0) ? (bx % 8) * (F.G / 8) + bx / 8 : bx; }
    F.ws = args.ws; F.out = args.out; F.ctl = (gu32*)(args.ws + WS_CTL);
#pragma unroll
    for (int i = 0; i < 30; ++i) F.in[i] = args.in[i];
    for (int u = F.tid; u < (LDS_BYTES - LDSCTL_OFF) / 4; u += NTHREADS) ((LAS unsigned*)(F.lds + LDSCTL_OFF))[u] = 0u;
    __syncthreads();
    const int lo = args.ph_lo, hi = args.ph_hi;
    XcdBarrier bar; bar.bar = (unsigned*)(F.ctl + CW_BAR); bar.x = 0; bar.st = nullptr;
    if (hi - lo > 1) bar = xcd_barrier_post((unsigned*)(F.ctl + CW_BAR), F.MISC + 8);
#ifndef PHMASK
#define PHMASK 0x1fff
#endif
#define IN(k) (((PHMASK >> (k)) & 1) && lo <= (k) && (k) < hi)
#define SEAM(k) do { if (IN(k) && IN((k) + 1)) xcd_barrier(bar); } while (0)
#define PH_BEGIN(k) if (IN(k)) { auto body_ = [&]() __attribute__((always_inline))
#define PH_END(k) ; body_(); if ((REP_MASK >> (k)) & 1) { xcd_barrier(bar); body_(); } } SEAM(k);

    bf16_t* const XB = (bf16_t*)(F.ws + WS_XB); bf16_t* const HB = (bf16_t*)(F.ws + WS_HB); bf16_t* const ACT = (bf16_t*)(F.ws + WS_ACT);
    bf16_t* const Zb = (bf16_t*)(F.ws + WS_Z); bf16_t* const XBCb = (bf16_t*)(F.ws + WS_XBC); bf16_t* const Vb = (bf16_t*)(F.ws + WS_V); bf16_t* const GATES = (bf16_t*)(F.ws + WS_GATES);
    bf16_t* const POOLED = (bf16_t*)(F.out + O_Y); bf16_t* const MERGED = (bf16_t*)(F.ws + WS_MERGED); bf16_t* const Qb = (bf16_t*)(F.ws + WS_Q); bf16_t* const PB = (bf16_t*)(F.ws + WS_PB);
    float* const T1 = (float*)(F.ws + WS_T1); float* const stA = (float*)(F.ws + WS_STATS_A); float* const stB = (float*)(F.ws + WS_STATS_B); float* const DTb = (float*)(F.ws + WS_DT);
    float* const H = F.out + O_Y;
    pg8::StaticOrder S;

    PH_BEGIN(0) { p0_prologue(F); } PH_END(0)
    PH_BEGIN(1) {
        pg8::Gemm g{XB, (const bf16_t*)(F.ws + WS_WGU1), M, 2 * DFF, DM, DM, 0}; S.init(M, 2 * DFF, F.G, (int)blockIdx.x);
        pg8::Epi E{}; E.kind = pg8::EK_GU; E.stats_in = stA; E.obf = ACT; E.ldo = DFF;
        pg8::gemm_phase(F.lds, g, S, E);
        pg8::Gemm g2{(const bf16_t*)(F.ws + WS_WPOT), (const bf16_t*)(F.ws + WS_WGRP), DM, DM, 256, DM, 256}; S.init_tail(DM, DM, F.G, (int)blockIdx.x);
        pg8::Epi E2{}; E2.kind = pg8::EK_BF16; E2.obf = (bf16_t*)(F.ws + WS_W2); E2.ldo = DM;
        pg8::gemm_phase(F.lds, g2, S, E2);
    } PH_END(1)
    PH_BEGIN(2) {
        pg8::Gemm g{ACT, (const bf16_t*)(F.ws + WS_WD1), M, DM, DFF, DFF, 0}; S.init(MP, DM, F.G, (int)blockIdx.x);
        pg8::Epi E{}; E.kind = pg8::EK_RES; E.coef = 0.5f; E.res_p = F.in[I_XP]; E.res_s = F.in[I_XS]; E.obf = HB; E.stats_out = stB;
        pg8::gemm_phase(F.lds, g, S, E);
        pg8::gemm_small(F.lds, g, E, MP, MS, F.G, (int)blockIdx.x);
    } PH_END(2)
    PH_BEGIN(3) {
        pg8::Gemm g{HB, (const bf16_t*)(F.ws + WS_WIN), M, NIN, DM, DM, 0}; S.init(M, NIN, F.G, (int)blockIdx.x);
        pg8::Epi E{}; E.kind = pg8::EK_WIN; E.stats_in = stB; E.Z = Zb; E.XBC = XBCb; E.V = Vb; E.GATES = GATES; E.HALO = (bf16_t*)(F.ws + WS_HALO); E.DT = DTb; E.dt_bias = F.in[I_DTB];
        E.conv_p = F.out + O_CONV_P; E.conv_s = F.out + O_CONV_S; E.pool_p = F.out + O_POOL_P; E.pool_s = F.out + O_POOL_S;
        pg8::gemm_phase(F.lds, g, S, E);
    } PH_END(3)
    PH_BEGIN(4) { ssd_local_phase(F); pool_phase(F); } PH_END(4)
    PH_BEGIN(5) { ssd_scan_phase(F);

        pg8::Gemm g{PB, (const bf16_t*)(F.ws + WS_WPLE), M, DM, PLE, PLE, 0}; S.init(MP, DM, F.G, (int)blockIdx.x);
        pg8::Epi E{}; E.kind = pg8::EK_BF16; E.obf = Qb; E.ldo = DM;
        pg8::gemm_phase(F.lds, g, S, E);
        pg8::gemm_small(F.lds, g, E, MP, MS, F.G, (int)blockIdx.x);
        } PH_END(5)
    PH_BEGIN(6) { ssd_final_phase(F); ssd_seq_phase(F); } PH_END(6)
    PH_BEGIN(7) {
        pg8::Gemm2 g{Zb, (const bf16_t*)(F.ws + WS_WSSO), POOLED, (const bf16_t*)(F.ws + WS_W2), DI, DI, DM, DM, DM}; S.init(MP, DM, F.G, (int)blockIdx.x);
        pg8::gemm_phase2(F.lds, g, S, GATES, MERGED);
        pg8::gemm_small2(F.lds, g, GATES, MERGED, MP, MS, F.G, (int)blockIdx.x);
    } PH_END(7)
    PH_BEGIN(8) {
        pg8::Gemm g{MERGED, (const bf16_t*)(F.ws + WS_WO), M, DM, DM, DM, 0}; S.init(MP, DM, F.G, (int)blockIdx.x);
        pg8::Epi E{}; E.kind = pg8::EK_RES; E.coef = 1.0f; E.res_bf = HB; E.obf = HB; E.stats_out = stA;
        pg8::gemm_phase(F.lds, g, S, E);
        pg8::gemm_small(F.lds, g, E, MP, MS, F.G, (int)blockIdx.x);
    } PH_END(8)
    PH_BEGIN(9) {
        pg8::Gemm g{HB, (const bf16_t*)(F.ws + WS_WGU2), M, 2 * DFF, DM, DM, 0}; S.init(M, 2 * DFF, F.G, (int)blockIdx.x);
        pg8::Epi E{}; E.kind = pg8::EK_GU; E.stats_in = stA; E.obf = ACT; E.ldo = DFF;
        pg8::gemm_phase(F.lds, g, S, E);
    } PH_END(9)
    PH_BEGIN(10) {
        pg8::Gemm g{ACT, (const bf16_t*)(F.ws + WS_WD2), M, DM, DFF, DFF, 0}; S.init(MP, DM, F.G, (int)blockIdx.x);
        pg8::Epi E{}; E.kind = pg8::EK_RES; E.coef = 0.5f; E.res_bf = HB; E.obf = HB; E.stats_out = stB;
        pg8::gemm_phase(F.lds, g, S, E);
        pg8::gemm_small(F.lds, g, E, MP, MS, F.G, (int)blockIdx.x);
    } PH_END(10)
    PH_BEGIN(11) {
        pg8::Gemm g{HB, (const bf16_t*)(F.ws + WS_WPG), M, DM, DM, DM, 0}; S.init(MP, DM, F.G, (int)blockIdx.x);
        pg8::Epi E{}; E.kind = pg8::EK_PLE; E.stats_in = stB; E.q = Qb; E.res_bf = HB; E.obf = ACT; E.stats_out = stA;
        pg8::gemm_phase(F.lds, g, S, E);
        pg8::gemm_small(F.lds, g, E, MP, MS, F.G, (int)blockIdx.x);
    } PH_END(11)
    PH_BEGIN(12) { final_phase(F); } PH_END(12)
#undef IN
#undef SEAM
#undef PH_BEGIN
#undef PH_END
}

extern "C" void kernel_launch(void* const* d_in, const int* in_sizes, int n_in, void* d_out, int out_size, void* d_ws, size_t ws_size, hipStream_t stream) {
    static int grid = 0;
    if (grid == 0) {
        if (n_in != 30 || in_sizes[0] != MP * DM || (size_t)out_size != O_END || ws_size < WS_END) {
            fprintf(stderr, "kernel_launch: shape mismatch: n_in %d in0 %d out %d ws %zu (need %zu)\n", n_in, n_in > 0 ? in_sizes[0] : -1, out_size, ws_size, (size_t)WS_END); grid = -1; return; }
        int dev = 0, cus = 0, per_cu = 0;
        if (hipGetDevice(&dev) != hipSuccess || hipDeviceGetAttribute(&cus, hipDeviceAttributeMultiprocessorCount, dev) != hipSuccess) { grid = -1; return; }
        if (hipFuncSetAttribute((const void*)mk_fwd, hipFuncAttributeMaxDynamicSharedMemorySize, LDS_BYTES) != hipSuccess) { fprintf(stderr, "kernel_launch: hipFuncSetAttribute failed\n"); grid = -1; return; }
        if (hipOccupancyMaxActiveBlocksPerMultiprocessor(&per_cu, (const void*)mk_fwd, NTHREADS, LDS_BYTES) != hipSuccess || per_cu < 1)
            fprintf(stderr, "kernel_launch: occupancy query reports %d workgroups per CU\n", per_cu);
        (void)hipGetLastError();
        grid = cus;
    }
    if (grid < 0) return;
    if (hipMemsetAsync((char*)d_ws + WS_CTL, 0, CTL_ZERO_BYTES, stream) != hipSuccess) { fprintf(stderr, "kernel_launch: memset failed\n"); return; }
    Args a{};
    for (int i = 0; i < 30; ++i) a.in[i] = (const float*)d_in[i];
    a.out = (float*)d_out; a.ws = (unsigned char*)d_ws;
#if MK_MULTI_LAUNCH
    for (int ph = 0; ph < NPHASES; ++ph) { a.ph_lo = ph; a.ph_hi = ph + 1; a.li = ph;
        hipLaunchKernelGGL(mk_fwd, dim3(grid), dim3(NTHREADS), LDS_BYTES, stream, a); }
#else
    a.ph_lo = 0; a.ph_hi = NPHASES; a.li = 0;
    hipLaunchKernelGGL(mk_fwd, dim3(grid), dim3(NTHREADS), LDS_BYTES, stream, a);
#endif
}
```

```cpp
#include <hip/hip_runtime.h>
#include <cstdio>
#include <cstdint>

#define REP_MASK 0x0
#ifndef MK_MULTI_LAUNCH
#define MK_MULTI_LAUNCH 0
#endif

#define GAS __attribute__((address_space(1)))
#define LAS __attribute__((address_space(3)))
typedef unsigned short bf16_t;
typedef short bf16x8 __attribute__((ext_vector_type(8)));
typedef float f32x4 __attribute__((ext_vector_type(4)));
typedef float f32x2 __attribute__((ext_vector_type(2)));
typedef unsigned u32x4 __attribute__((ext_vector_type(4)));
typedef unsigned u32x2 __attribute__((ext_vector_type(2)));
typedef GAS unsigned gu32;

constexpr int DM = 1024, BATCH = 8, SEQ = 2048, DECB = 128, DECS = 8;
constexpr int MP = BATCH * SEQ, MS = DECB * DECS, M = MP + MS;
constexpr int DI = 2048, HD = 64, NH = 32, NG = 8, HPG = 4, DSTATE = 128, CD = 4096;
constexpr int PD = 1024, PBUF = 15, DFF = 2816, PLE = 256;
constexpr int IN_DIM = 9248, NIN = 9472;
constexpr float EPS = 1e-6f;
constexpr int NWAVES = 8, NTHREADS = 512;

constexpr size_t MiB = 1u << 20;
constexpr size_t WS_CTL = 0, CTL_ZERO_BYTES = 32768;
constexpr size_t WS_STATS_A = 2 * MiB, WS_STATS_B = 4 * MiB, WS_DT = 6 * MiB, WS_CDEC = 9 * MiB;
constexpr size_t WS_WGU1 = 10 * MiB, WS_WD1 = 21 * MiB, WS_WIN = 27 * MiB, WS_WSSO = 46 * MiB, WS_W2 = 50 * MiB, WS_WO = 52 * MiB,
                 WS_WGU2 = 54 * MiB, WS_WD2 = 65 * MiB, WS_WPG = 71 * MiB, WS_WPLE = 73 * MiB, WS_PB = 74 * MiB, WS_WPOT = 480 * MiB, WS_WGRP = 483 * MiB;
constexpr size_t WS_Z = 84 * MiB, WS_XBC = 152 * MiB, WS_V = 288 * MiB, WS_GATES = 322 * MiB, WS_HB = 390 * MiB, WS_HPREV = 424 * MiB, WS_HALO = 488 * MiB, WS_EAQ = 492 * MiB, WS_END = 495 * MiB;
constexpr size_t WS_ACT = WS_XBC, WS_T1 = WS_XBC, WS_MERGED = 220 * MiB, WS_Q = WS_V, WS_XB = WS_HB;
static_assert(WS_STATS_A + (size_t)M * 16 * 4 <= WS_STATS_B && WS_STATS_B + (size_t)M * 16 * 4 <= WS_DT && WS_DT + (size_t)M * 32 * 4 <= WS_WGU1, "ws map (small)");
static_assert(WS_WGU1 + (size_t)2 * DFF * DM * 2 <= WS_WD1 && WS_WD1 + (size_t)DM * DFF * 2 <= WS_WIN && WS_WIN + (size_t)NIN * DM * 2 <= WS_WSSO && WS_WSSO + (size_t)DM * DI * 2 <= WS_W2, "ws map (w1)");
static_assert(WS_WGU2 + (size_t)2 * DFF * DM * 2 <= WS_WD2 && WS_WD2 + (size_t)DM * DFF * 2 <= WS_WPG && WS_WPLE + (size_t)DM * PLE * 2 <= WS_PB && WS_PB + (size_t)M * PLE * 2 <= WS_Z, "ws map (w2)");
static_assert(WS_Z + (size_t)M * DI * 2 <= WS_XBC && WS_XBC + (size_t)M * CD * 2 <= WS_V && WS_V + (size_t)M * PD * 2 <= WS_GATES && WS_GATES + (size_t)M * 2 * DM * 2 <= WS_HB &&
              WS_HB + (size_t)M * DM * 2 <= WS_HPREV && WS_HPREV + (size_t)BATCH * 16 * NH * HD * DSTATE * 2 <= WS_END, "ws map (act)");
static_assert(WS_ACT + (size_t)M * DFF * 2 <= WS_V && WS_T1 + (size_t)M * DM * 4 <= WS_MERGED && WS_MERGED + (size_t)M * DM * 2 <= WS_V, "ws overlays");
constexpr int CW_BAR = 4096;

constexpr size_t O_Y = 0, O_SSM_P = (size_t)M * DM, O_CONV_P = O_SSM_P + (size_t)BATCH * NH * HD * DSTATE, O_POOL_P = O_CONV_P + (size_t)BATCH * 3 * CD,
                 O_SSM_S = O_POOL_P + (size_t)BATCH * PBUF * PD, O_CONV_S = O_SSM_S + (size_t)DECB * NH * HD * DSTATE, O_POOL_S = O_CONV_S + (size_t)DECB * 3 * CD,
                 O_END = O_POOL_S + (size_t)DECB * PBUF * PD;

constexpr int RING_BYTES = 131072, LDSCTL_OFF = RING_BYTES, MISC_OFF = LDSCTL_OFF + 320, LDS_BYTES = 147456;

#define RLX_AGENT __ATOMIC_RELAXED, __HIP_MEMORY_SCOPE_AGENT
#define LDS_WAIT() asm volatile("s_waitcnt lgkmcnt(0)" ::: "memory")
#define VM_WAIT() asm volatile("s_waitcnt vmcnt(0)" ::: "memory")

__device__ __forceinline__ unsigned f2bf(float f) { unsigned u = __builtin_bit_cast(unsigned, f); return (u + 0x7fffu + ((u >> 16) & 1u)) >> 16; }
__device__ __forceinline__ unsigned cvt_pk_bf16(float lo, float hi);
__device__ __forceinline__ unsigned pk2(float lo, float hi) { return cvt_pk_bf16(lo, hi); }
__device__ __forceinline__ float bf2f(unsigned b) { return __builtin_bit_cast(float, b << 16); }
__device__ __forceinline__ float bflo(unsigned w) { return __builtin_bit_cast(float, w << 16); }
__device__ __forceinline__ float bfhi(unsigned w) { return __builtin_bit_cast(float, w & 0xffff0000u); }
typedef __bf16 bf16x2_t __attribute__((ext_vector_type(2)));
__device__ __forceinline__ unsigned cvt_pk_bf16(float lo, float hi) { const bf16x2_t v = {(__bf16)lo, (__bf16)hi}; return __builtin_bit_cast(unsigned, v); }
__device__ __forceinline__ float sigm_f(float x) { return __builtin_amdgcn_rcpf(1.0f + __expf(-x)); }
__device__ __forceinline__ float silu_f(float x) { return x * __builtin_amdgcn_rcpf(1.0f + __expf(-x)); }
__device__ __forceinline__ float wave_sum(float v) {
#pragma unroll
    for (int o = 1; o < 64; o <<= 1) v += __shfl_xor(v, o);
    return v;
}

struct Frame {
    LAS unsigned char* lds;
    volatile LAS unsigned* MISC;
    gu32* ctl;
    int tid, lane, wave, vcu, G;
    unsigned char* ws;
    float* out;
    const float* in[30];
};
enum { I_XP = 0, I_XS, I_SSM, I_CONV, I_POOL, I_PP, I_PS, I_NFFN1, I_WGU1, I_WD1, I_NMIX, I_WIN, I_CONVW, I_CONVB, I_DTB, I_ALOG, I_DSKIP, I_NSSD, I_WSSO, I_WPGRP, I_PSCALE,
       I_WPOUT, I_WO, I_NFFN2, I_WGU2, I_WD2, I_NPLE, I_WPG, I_WPLE, I_NFINAL };

namespace pg8 {
constexpr int BM = 256, BK = 64, HALF = 128, HTB = HALF * BK * 2, STAGE_BYTES = 8 * HTB, NXCD = 8, WGM = 4;
__host__ __device__ __forceinline__ int lds_byte(int r, int c) { const int st = (r >> 4) * 2 + (c >> 5), rr = r & 15, cc = c & 31, ob = rr * 64 + cc * 2; return st * 1024 + (ob ^ (((ob >> 9) & 1) << 5)); }
__host__ __device__ __forceinline__ void stage_rc(int b, int& R, int& C) { const int st = b / 1024, sb = b % 1024, swz = sb ^ (((sb >> 9) & 1) << 5); R = (st >> 1) * 16 + swz / 64; C = (st & 1) * 32 + (swz % 64) / 2; }
__host__ __device__ __forceinline__ int perm32(int rho) { const int n = rho >> 4, i = rho & 15; return 8 * (i >> 2) + 4 * n + (i & 3); }
struct Unit { int pm, pn; };
struct Gemm { const bf16_t* A; const bf16_t* Bt; int M, N, K; int lda; int a_pn_step; };
struct StaticOrder {
    int nM, nN, nwg, G, c;
    __host__ __device__ void init(int M_, int N_, int G_, int c_) { nM = M_ / BM; nN = N_ / BM; nwg = nM * nN; G = G_; c = c_; }
    __host__ __device__ void init_tail(int M_, int N_, int G_, int c_) { init(M_, N_, G_, (G_ - 1) - c_); }
    __host__ __device__ bool next(int i, Unit& u) const {
        const long L = (long)i * G + c; if (L >= nwg) return false;
        int wgid = (int)L; { const int q = nwg / NXCD, r = nwg % NXCD, xcd = wgid % NXCD, off = wgid / NXCD; wgid = (xcd < r ? xcd * (q + 1) : r * (q + 1) + (xcd - r) * q) + off; }
        const int nig = WGM * nN, gid = wgid / nig, fm = gid * WGM, gsz = (nM - fm) < WGM ? (nM - fm) : WGM;
        u.pm = fm + ((wgid % nig) % gsz); u.pn = (wgid % nig) / gsz; return true;
    }
};

enum EpiKind { EK_GU = 1, EK_RES = 2, EK_WIN = 3, EK_T1 = 4, EK_MERGE = 5, EK_BF16 = 6, EK_PLE = 7 };
struct Epi {
    const float* stats_in;
    float* stats_out;
    bf16_t* obf;
    float* of32;
    const float* res_p; const float* res_s;
    const bf16_t* res_bf;
    const bf16_t* gates;
    const bf16_t* q;
    bf16_t *Z, *XBC, *V, *GATES, *HALO; float* DT; const float* dt_bias; float *conv_p, *conv_s, *pool_p, *pool_s;
    int kind; int ldo; float coef; int pad;
};

__device__ __forceinline__ u32x4 pack8(const f32x4 a, const f32x4 b) { u32x4 w; w.x = cvt_pk_bf16(a[0], a[1]); w.y = cvt_pk_bf16(a[2], a[3]); w.z = cvt_pk_bf16(b[0], b[1]); w.w = cvt_pk_bf16(b[2], b[3]); return w; }
__device__ __forceinline__ void unpack8(const u32x4 w, f32x4& a, f32x4& b) { a = (f32x4){bflo(w.x), bfhi(w.x), bflo(w.y), bfhi(w.y)}; b = (f32x4){bflo(w.z), bfhi(w.z), bflo(w.w), bfhi(w.w)}; }

__device__ __forceinline__ float row_rs(const float* stats, int row) {
    if (!stats) return 1.0f;
    const GAS f32x4* sp = (const GAS f32x4*)(stats + (size_t)row * 16);
    const f32x4 a = sp[0], b = sp[1], c = sp[2], d = sp[3]; const f32x4 s = (a + b) + (c + d);
    return __builtin_amdgcn_rsqf(((s[0] + s[1]) + (s[2] + s[3])) * (1.0f / 1024.0f) + EPS);
}
__device__ __forceinline__ float softplus_f(float x) { const float e = __expf(-fabsf(x)); const float l = (e < 0.01f) ? e * (1.0f - e * (0.5f - e * (1.0f / 3.0f))) : __logf(1.0f + e); return fmaxf(x, 0.f) + l; }

__device__ __forceinline__ void epilogue(const Epi& E, const f32x4 (&acc)[2][2][4][2], const Unit& u, int wr, int wc, int fr, int fq) {
    const int rowb = u.pm * BM + wr * 64 + fr;
    const int cin = wc * 32 + 8 * fq;
    if (E.kind == EK_GU) {
#pragma unroll
        for (int ai = 0; ai < 2; ++ai)
#pragma unroll
            for (int m = 0; m < 4; ++m) { const int row = rowb + ai * HALF + m * 16; const float r = row_rs(E.stats_in, row);
                const f32x4 g0 = acc[ai][0][m][0] * r, u0 = acc[ai][1][m][0] * r, g1 = acc[ai][0][m][1] * r, u1 = acc[ai][1][m][1] * r;
                const f32x4 o0 = (f32x4){silu_f(g0[0]) * u0[0], silu_f(g0[1]) * u0[1], silu_f(g0[2]) * u0[2], silu_f(g0[3]) * u0[3]};
                const f32x4 o1 = (f32x4){silu_f(g1[0]) * u1[0], silu_f(g1[1]) * u1[1], silu_f(g1[2]) * u1[2], silu_f(g1[3]) * u1[3]};
                *(GAS u32x4*)(E.obf + (size_t)row * E.ldo + u.pn * HALF + cin) = pack8(o0, o1); }
    } else if (E.kind == EK_RES) {
#pragma unroll
        for (int ai = 0; ai < 2; ++ai)
#pragma unroll
            for (int m = 0; m < 4; ++m) { const int row = rowb + ai * HALF + m * 16;
                float ss = 0.f;
#pragma unroll
                for (int bj = 0; bj < 2; ++bj) { const int col = u.pn * BM + bj * HALF + cin;
                    f32x4 r0, r1;
                    if (E.res_p) { const float* rp = (row < MP) ? E.res_p + (size_t)row * DM : E.res_s + (size_t)(row - MP) * DM; r0 = *(const GAS f32x4*)(rp + col); r1 = *(const GAS f32x4*)(rp + col + 4); }
                    else unpack8(*(const GAS u32x4*)(E.res_bf + (size_t)row * DM + col), r0, r1);
                    const f32x4 h0 = r0 + acc[ai][bj][m][0] * E.coef, h1 = r1 + acc[ai][bj][m][1] * E.coef;
                    *(GAS u32x4*)(E.obf + (size_t)row * DM + col) = pack8(h0, h1);
                    ss += (h0[0] * h0[0] + h0[1] * h0[1]) + (h0[2] * h0[2] + h0[3] * h0[3]) + (h1[0] * h1[0] + h1[1] * h1[1]) + (h1[2] * h1[2] + h1[3] * h1[3]); }
                ss += __shfl_xor(ss, 16); ss += __shfl_xor(ss, 32);
                if (fq == 0) *(GAS float*)(E.stats_out + (size_t)row * 16 + u.pn * 4 + wc) = ss; }
    } else if (E.kind == EK_WIN) {
        const int pn = u.pn;
        if (pn < 8) {
            const int colt = pn * BM + cin;
#pragma unroll
            for (int ai = 0; ai < 2; ++ai)
#pragma unroll
                for (int m = 0; m < 4; ++m) { const int row = rowb + ai * HALF + m * 16; const float r = row_rs(E.stats_in, row);
#pragma unroll
                    for (int bj = 0; bj < 2; ++bj) { f32x4 v0 = acc[ai][bj][m][0] * r, v1 = acc[ai][bj][m][1] * r;
#pragma unroll
                        for (int j = 0; j < 4; ++j) { v0[j] = silu_f(v0[j]); v1[j] = silu_f(v1[j]); }
                        *(GAS u32x4*)(E.Z + (size_t)row * DI + colt + bj * HALF) = pack8(v0, v1); } }
        } else if (pn >= 28 && pn < 36) {
            const int colt = (pn - 28) * BM + cin;
#pragma unroll
            for (int ai = 0; ai < 2; ++ai)
#pragma unroll
                for (int m = 0; m < 4; ++m) { const int row = rowb + ai * HALF + m * 16; const float r = row_rs(E.stats_in, row);
#pragma unroll
                    for (int bj = 0; bj < 2; ++bj) { f32x4 v0 = acc[ai][bj][m][0] * r, v1 = acc[ai][bj][m][1] * r;
#pragma unroll
                        for (int j = 0; j < 4; ++j) { v0[j] = sigm_f(v0[j]); v1[j] = sigm_f(v1[j]); }
                        *(GAS u32x4*)(E.GATES + (size_t)row * (2 * DM) + colt + bj * HALF) = pack8(v0, v1); } }
        } else if (pn < 28) {
            const bool isx = pn < 24; bf16_t* const O = isx ? E.XBC : E.V; const int ldo = isx ? CD : PD; const int colt = (isx ? pn - 8 : pn - 24) * BM + cin;
            const int keep = isx ? 3 : PBUF;
#pragma unroll
            for (int ai = 0; ai < 2; ++ai)
#pragma unroll
                for (int m = 0; m < 4; ++m) { const int row = rowb + ai * HALF + m * 16; const float r = row_rs(E.stats_in, row);
                    float* sp = nullptr;
                    if (row < MP) { const int sb = row >> 11, st = row & (SEQ - 1); if (st >= SEQ - keep) sp = (isx ? E.conv_p : E.pool_p) + ((size_t)sb * keep + (st - (SEQ - keep))) * ldo + colt; }
                    else { const int sb = (row - MP) >> 3, st = (row - MP) & 7; const int si = st - (DECS - keep); if (si >= 0) sp = (isx ? E.conv_s : E.pool_s) + ((size_t)sb * keep + si) * ldo + colt; }
                    bf16_t* hp = nullptr;
                    if (isx && row < MP) { const int st = row & (SEQ - 1), tm = st & 127; if (tm >= 125 && st < SEQ - 3) hp = E.HALO + ((((size_t)(row >> 11) * 16 + (st >> 7) + 1) * 3 + (tm - 125)) * CD) + colt; }
#pragma unroll
                    for (int bj = 0; bj < 2; ++bj) { const f32x4 v0 = acc[ai][bj][m][0] * r, v1 = acc[ai][bj][m][1] * r;
                        const u32x4 pk = pack8(v0, v1);
                        *(GAS u32x4*)(O + (size_t)row * ldo + colt + bj * HALF) = pk;
                        if (hp) *(GAS u32x4*)(hp + bj * HALF) = pk;
                        if (sp) { *(GAS f32x4*)(sp + bj * HALF) = v0; *(GAS f32x4*)(sp + bj * HALF + 4) = v1; } } }
        } else if (wc == 0) {
            const f32x4 b0 = *(const GAS f32x4*)(E.dt_bias + 8 * fq), b1 = *(const GAS f32x4*)(E.dt_bias + 8 * fq + 4);
#pragma unroll
            for (int ai = 0; ai < 2; ++ai)
#pragma unroll
                for (int m = 0; m < 4; ++m) { const int row = rowb + ai * HALF + m * 16; const float r = row_rs(E.stats_in, row);
                    f32x4 v0 = acc[ai][0][m][0] * r + b0, v1 = acc[ai][0][m][1] * r + b1;
#pragma unroll
                    for (int j = 0; j < 4; ++j) { v0[j] = softplus_f(v0[j]); v1[j] = softplus_f(v1[j]); }
                    *(GAS f32x4*)(E.DT + (size_t)row * 32 + 8 * fq) = v0; *(GAS f32x4*)(E.DT + (size_t)row * 32 + 8 * fq + 4) = v1; }
        }
    } else if (E.kind == EK_T1) {
#pragma unroll
        for (int ai = 0; ai < 2; ++ai)
#pragma unroll
            for (int m = 0; m < 4; ++m) { const int row = rowb + ai * HALF + m * 16;
#pragma unroll
                for (int bj = 0; bj < 2; ++bj) { const int col = u.pn * BM + bj * HALF + cin;
                    f32x4 g0, g1; unpack8(*(const GAS u32x4*)(E.gates + (size_t)row * (2 * DM) + col), g0, g1);
                    *(GAS u32x4*)(E.obf + (size_t)row * DM + col) = pack8(g0 * acc[ai][bj][m][0], g1 * acc[ai][bj][m][1]); } }
    } else if (E.kind == EK_MERGE) {
#pragma unroll
        for (int ai = 0; ai < 2; ++ai)
#pragma unroll
            for (int m = 0; m < 4; ++m) { const int row = rowb + ai * HALF + m * 16;
#pragma unroll
                for (int bj = 0; bj < 2; ++bj) { const int col = u.pn * BM + bj * HALF + cin;
                    f32x4 g0, g1; unpack8(*(const GAS u32x4*)(E.gates + (size_t)row * (2 * DM) + DM + col), g0, g1);
                    f32x4 t0, t1; unpack8(*(const GAS u32x4*)(E.res_bf + (size_t)row * DM + col), t0, t1);
                    *(GAS u32x4*)(E.obf + (size_t)row * DM + col) = pack8(t0 + g0 * acc[ai][bj][m][0], t1 + g1 * acc[ai][bj][m][1]); } }
    } else if (E.kind == EK_BF16) {
#pragma unroll
        for (int ai = 0; ai < 2; ++ai)
#pragma unroll
            for (int m = 0; m < 4; ++m) { const int row = rowb + ai * HALF + m * 16;
#pragma unroll
                for (int bj = 0; bj < 2; ++bj) { const int col = u.pn * BM + bj * HALF + cin;
                    *(GAS u32x4*)(E.obf + (size_t)row * E.ldo + col) = pack8(acc[ai][bj][m][0], acc[ai][bj][m][1]); } }
    } else if (E.kind == EK_PLE) {
#pragma unroll
        for (int ai = 0; ai < 2; ++ai)
#pragma unroll
            for (int m = 0; m < 4; ++m) { const int row = rowb + ai * HALF + m * 16; const float r = row_rs(E.stats_in, row);
                float ss = 0.f;
#pragma unroll
                for (int bj = 0; bj < 2; ++bj) { const int col = u.pn * BM + bj * HALF + cin;
                    f32x4 q0, q1; unpack8(*(const GAS u32x4*)(E.q + (size_t)row * DM + col), q0, q1);
                    f32x4 r0, r1; unpack8(*(const GAS u32x4*)(E.res_bf + (size_t)row * DM + col), r0, r1);
                    f32x4 h0, h1;
#pragma unroll
                    for (int j = 0; j < 4; ++j) { h0[j] = r0[j] + sigm_f(acc[ai][bj][m][0][j] * r) * q0[j]; h1[j] = r1[j] + sigm_f(acc[ai][bj][m][1][j] * r) * q1[j]; }
                    *(GAS u32x4*)(E.obf + (size_t)row * DM + col) = pack8(h0, h1);
                    ss += (h0[0] * h0[0] + h0[1] * h0[1]) + (h0[2] * h0[2] + h0[3] * h0[3]) + (h1[0] * h1[0] + h1[1] * h1[1]) + (h1[2] * h1[2] + h1[3] * h1[3]); }
                ss += __shfl_xor(ss, 16); ss += __shfl_xor(ss, 32);
                if (fq == 0) *(GAS float*)(E.stats_out + (size_t)row * 16 + u.pn * 4 + wc) = ss; }
    }
}


__device__ __forceinline__ void epi_seg(const Epi& E, int row, int col, f32x4 v0, f32x4 v1, int lane) {
    if (E.kind == EK_RES) {
        f32x4 r0, r1;
        if (E.res_p) { const float* rp = ((row < MP) ? E.res_p + (size_t)row * DM : E.res_s + (size_t)(row - MP) * DM) + col; r0 = *(const GAS f32x4*)rp; r1 = *(const GAS f32x4*)(rp + 4); }
        else unpack8(*(const GAS u32x4*)(E.res_bf + (size_t)row * DM + col), r0, r1);
        const f32x4 h0 = r0 + v0 * E.coef, h1 = r1 + v1 * E.coef;
        *(GAS u32x4*)(E.obf + (size_t)row * DM + col) = pack8(h0, h1);
        float ss = (h0[0] * h0[0] + h0[1] * h0[1]) + (h0[2] * h0[2] + h0[3] * h0[3]) + (h1[0] * h1[0] + h1[1] * h1[1]) + (h1[2] * h1[2] + h1[3] * h1[3]);
        ss += __shfl_xor(ss, 1); ss += __shfl_xor(ss, 2); ss += __shfl_xor(ss, 4);
        if ((lane & 7) == 0) *(GAS float*)(E.stats_out + (size_t)row * 16 + (col >> 6)) = ss;
    } else if (E.kind == EK_T1) {
        f32x4 g0, g1; unpack8(*(const GAS u32x4*)(E.gates + (size_t)row * (2 * DM) + col), g0, g1);
        *(GAS u32x4*)(E.obf + (size_t)row * DM + col) = pack8(g0 * v0, g1 * v1);
    } else if (E.kind == EK_MERGE) {
        f32x4 g0, g1; unpack8(*(const GAS u32x4*)(E.gates + (size_t)row * (2 * DM) + DM + col), g0, g1);
        f32x4 t0, t1; unpack8(*(const GAS u32x4*)(E.res_bf + (size_t)row * DM + col), t0, t1);
        *(GAS u32x4*)(E.obf + (size_t)row * DM + col) = pack8(t0 + g0 * v0, t1 + g1 * v1);
    } else if (E.kind == EK_BF16) {
        *(GAS u32x4*)(E.obf + (size_t)row * E.ldo + col) = pack8(v0, v1);
    } else if (E.kind == EK_PLE) {
        const float r = row_rs(E.stats_in, row);
        f32x4 q0, q1; unpack8(*(const GAS u32x4*)(E.q + (size_t)row * DM + col), q0, q1);
        f32x4 r0, r1; unpack8(*(const GAS u32x4*)(E.res_bf + (size_t)row * DM + col), r0, r1);
        f32x4 h0, h1;
#pragma unroll
        for (int j = 0; j < 4; ++j) { h0[j] = r0[j] + sigm_f(v0[j] * r) * q0[j]; h1[j] = r1[j] + sigm_f(v1[j] * r) * q1[j]; }
        *(GAS u32x4*)(E.obf + (size_t)row * DM + col) = pack8(h0, h1);
        float ss = (h0[0] * h0[0] + h0[1] * h0[1]) + (h0[2] * h0[2] + h0[3] * h0[3]) + (h1[0] * h1[0] + h1[1] * h1[1]) + (h1[2] * h1[2] + h1[3] * h1[3]);
        ss += __shfl_xor(ss, 1); ss += __shfl_xor(ss, 2); ss += __shfl_xor(ss, 4);
        if ((lane & 7) == 0) *(GAS float*)(E.stats_out + (size_t)row * 16 + (col >> 6)) = ss;
    }
}
__device__ __forceinline__ int sw_off(int row, int ch) { return 256 * row + 16 * (ch ^ (((row & 3) << 2) | ((row >> 2) & 3))); }
__device__ __forceinline__ void small_tile_sum(LAS unsigned char* lds, const bf16_t* A, int lda, const bf16_t* Bt, int K, int r0, int c0, f32x4& v0, f32x4& v1) {
    const int tid = threadIdx.x, wid = __builtin_amdgcn_readfirstlane(tid >> 6), lane = tid & 63, ql = lane & 15, gq = lane >> 4, mw = wid >> 1, nh = wid & 1;
    const int nst = K / 128;
    const char* src[4]; int dst[4];
#pragma unroll
    for (int i = 0; i < 4; ++i) { const int p = 4 * wid + i, isB = p >> 4, row = 4 * (p & 15) + (lane >> 4), cs = lane & 15, ch = cs ^ (((row & 3) << 2) | ((row >> 2) & 3));
        src[i] = isB ? (const char*)(Bt + (size_t)(c0 + (row & ~31) + perm32(row & 31)) * K + 8 * ch) : (const char*)(A + (size_t)(r0 + row) * lda + 8 * ch);
        dst[i] = isB * 16384 + 1024 * (p & 15); }
#define ST_ISSUE(st) do { _Pragma("unroll") for (int _i = 0; _i < 4; ++_i) \
        __builtin_amdgcn_global_load_lds((const unsigned*)(src[_i] + (size_t)(st) * 256), (LAS unsigned*)(lds + ((st) & 3) * 32768 + dst[_i]), 16, 0, 0); } while (0)
    f32x4 acc0 = (f32x4){0.f, 0.f, 0.f, 0.f}, acc1 = acc0;
    int aoff[4], boff0[4], boff1[4];
#pragma unroll
    for (int ks = 0; ks < 4; ++ks) { aoff[ks] = sw_off(16 * mw + ql, 4 * ks + gq); boff0[ks] = 16384 + sw_off(32 * nh + ql, 4 * ks + gq); boff1[ks] = 16384 + sw_off(32 * nh + 16 + ql, 4 * ks + gq); }
    ST_ISSUE(0); if (nst > 1) ST_ISSUE(1); if (nst > 2) ST_ISSUE(2);
    for (int t = 0; t < nst; ++t) {
        const int ahead = (nst - 1 - t) < 2 ? (nst - 1 - t) : 2;
        if (ahead == 2) asm volatile("s_waitcnt vmcnt(8)" ::: "memory"); else if (ahead == 1) asm volatile("s_waitcnt vmcnt(4)" ::: "memory"); else asm volatile("s_waitcnt vmcnt(0)" ::: "memory");
        __builtin_amdgcn_s_barrier(); asm volatile("" ::: "memory");
        if (t + 3 < nst) ST_ISSUE(t + 3);
        const LAS unsigned char* const sl = lds + (t & 3) * 32768;
#pragma unroll
        for (int ks = 0; ks < 4; ++ks) {
            const bf16x8 af = *(const LAS bf16x8*)(sl + aoff[ks]), b0 = *(const LAS bf16x8*)(sl + boff0[ks]), b1 = *(const LAS bf16x8*)(sl + boff1[ks]);
            acc0 = __builtin_amdgcn_mfma_f32_16x16x32_bf16(b0, af, acc0, 0, 0, 0); acc1 = __builtin_amdgcn_mfma_f32_16x16x32_bf16(b1, af, acc1, 0, 0, 0);
        }
        asm volatile("s_waitcnt lgkmcnt(0)" ::: "memory");
    }
#undef ST_ISSUE
    __syncthreads();
    LAS f32x4* const tile = (LAS f32x4*)lds;
    { const int row = 16 * mw + ql, chb = 8 * nh + 2 * gq; tile[row * 16 + (chb ^ (row & 15))] = acc0; tile[row * 16 + ((chb + 1) ^ (row & 15))] = acc1; }
    __syncthreads();
    const int rr = 8 * wid + (lane >> 3), ch0 = 2 * (lane & 7);
    v0 = tile[rr * 16 + (ch0 ^ (rr & 15))]; v1 = tile[rr * 16 + ((ch0 + 1) ^ (rr & 15))];
    __syncthreads();
}
__device__ __forceinline__ void gemm_small(LAS unsigned char* lds, const Gemm g, const Epi& E, int row_base, int nrows, int G, int c) {
    const int tid = threadIdx.x, wid = __builtin_amdgcn_readfirstlane(tid >> 6), lane = tid & 63;
    const int ntn = g.N / 64, ntiles = (nrows / 64) * ntn;
    for (int v = c; v < ntiles; v += G) {
        const int r0 = row_base + 64 * (v / ntn), c0 = 64 * (v % ntn);
        f32x4 v0, v1; small_tile_sum(lds, g.A, g.lda, g.Bt, g.K, r0, c0, v0, v1);
        epi_seg(E, r0 + 8 * wid + (lane >> 3), c0 + 8 * (lane & 7), v0, v1, lane);
    }
}
struct Gemm2 { const bf16_t* A1; const bf16_t* B1; const bf16_t* A2; const bf16_t* B2; int K1, lda1, K2, lda2, N; };
__device__ __forceinline__ void gemm_small2(LAS unsigned char* lds, const Gemm2 g, const bf16_t* gates, bf16_t* out, int row_base, int nrows, int G, int c) {
    const int tid = threadIdx.x, wid = __builtin_amdgcn_readfirstlane(tid >> 6), lane = tid & 63;
    const int ntn = g.N / 64, ntiles = (nrows / 64) * ntn;
    for (int v = c; v < ntiles; v += G) {
        const int r0 = row_base + 64 * (v / ntn), c0 = 64 * (v % ntn), row = r0 + 8 * wid + (lane >> 3), col = c0 + 8 * (lane & 7);
        f32x4 a0, a1, b0, b1;
        small_tile_sum(lds, g.A1, g.lda1, g.B1, g.K1, r0, c0, a0, a1);
        small_tile_sum(lds, g.A2, g.lda2, g.B2, g.K2, r0, c0, b0, b1);
        f32x4 g00, g01, g10, g11; unpack8(*(const GAS u32x4*)(gates + (size_t)row * (2 * DM) + col), g00, g01); unpack8(*(const GAS u32x4*)(gates + (size_t)row * (2 * DM) + DM + col), g10, g11);
        *(GAS u32x4*)(out + (size_t)row * DM + col) = pack8(g00 * a0 + g10 * b0, g01 * a1 + g11 * b1);
    }
}

__device__ __forceinline__ void gemm_phase(LAS unsigned char* lds, const Gemm g, const StaticOrder& S, const Epi& E) {
    const int tid = threadIdx.x, wid = __builtin_amdgcn_readfirstlane(tid >> 6), lane = tid & 63, wr = wid >> 2, wc = wid & 3, fr = lane & 15, fq = lane >> 4;
    const int K = g.K, nt = K / BK;
    unsigned voffA[2], voffB[2];
#pragma unroll
    for (int i = 0; i < 2; ++i) { int R, C; stage_rc(tid * 16 + i * 8192, R, C); const int Rb = (R & ~31) + perm32(R & 31);
        voffA[i] = (unsigned)(R * g.lda + C) * 2u; voffB[i] = (unsigned)(Rb * K + C) * 2u; }
    const size_t kstep = (size_t)(BK * 2);
    const size_t hstep = (size_t)HALF * K * 2, hstepA = (size_t)HALF * g.lda * 2;
    const size_t tstep = 2 * hstep, tstepA = 2 * hstepA, pnstepA = (size_t)g.a_pn_step * 2;
    const unsigned ldsw = (unsigned)wid * 1024u;
    const int aoff = lds_byte(wr * 64 + fr, fq * 8), boff = lds_byte(wc * 32 + fr, fq * 8);
#define PG8_SA(b, h) (((b) * 2 + (h)) * HTB)
#define PG8_SB(b, h) ((4 + (b) * 2 + (h)) * HTB)
#define PG8_STAGE(bufoff, gbase, voff) do { _Pragma("unroll") for (int _i = 0; _i < 2; ++_i) \
        __builtin_amdgcn_global_load_lds((const unsigned*)((const char*)(gbase) + (voff)[_i]), (LAS unsigned*)(lds + (bufoff) + ldsw + _i * 8192), 16, 0, 0); } while (0)
#define PG8_LDA(dst, b, h) do { _Pragma("unroll") for (int m = 0; m < 4; ++m) _Pragma("unroll") for (int k = 0; k < 2; ++k) dst[m][k] = *(const LAS bf16x8*)(lds + PG8_SA(b, h) + aoff + m * 2048 + k * 1024); } while (0)
#define PG8_LDB(dst, b, h) do { _Pragma("unroll") for (int n = 0; n < 2; ++n) _Pragma("unroll") for (int k = 0; k < 2; ++k) dst[n][k] = *(const LAS bf16x8*)(lds + PG8_SB(b, h) + boff + n * 2048 + k * 1024); } while (0)
#define PG8_MMA(ai, bj, At, Bt) do { __builtin_amdgcn_s_setprio(1); _Pragma("unroll") for (int m = 0; m < 4; ++m) _Pragma("unroll") for (int n = 0; n < 2; ++n) _Pragma("unroll") for (int k = 0; k < 2; ++k) \
        acc[ai][bj][m][n] = __builtin_amdgcn_mfma_f32_16x16x32_bf16(Bt[n][k], At[m][k], acc[ai][bj][m][n], 0, 0, 0); __builtin_amdgcn_s_setprio(0); } while (0)
#define PG8_WAIT_V(n) asm volatile("s_waitcnt vmcnt(" #n ")" ::: "memory")
#define PG8_WAIT_L(n) asm volatile("s_waitcnt lgkmcnt(" #n ")" ::: "memory")
#define PG8_BAR __builtin_amdgcn_s_barrier()
#define PG8_SCHED __builtin_amdgcn_sched_barrier(0)
    Unit cur, nxt; int ui = 0;
    if (!S.next(0, cur)) return;
    f32x4 acc[2][2][4][2];
#pragma unroll
    for (int a = 0; a < 2; ++a)
#pragma unroll
        for (int b = 0; b < 2; ++b)
#pragma unroll
            for (int m = 0; m < 4; ++m)
#pragma unroll
                for (int n = 0; n < 2; ++n) acc[a][b][m][n] = (f32x4){0.f, 0.f, 0.f, 0.f};
    bf16x8 At[4][2], B0[2][2], B1[2][2];
    const char* cA = (const char*)g.A + (size_t)cur.pm * tstepA + (size_t)cur.pn * pnstepA; const char* cB = (const char*)g.Bt + (size_t)cur.pn * tstep;
    PG8_STAGE(PG8_SB(0, 0), cB, voffB); PG8_STAGE(PG8_SB(0, 1), cB + hstep, voffB); PG8_STAGE(PG8_SA(0, 0), cA, voffA); PG8_STAGE(PG8_SA(0, 1), cA + hstepA, voffA);
    if (wr == 1) PG8_BAR;
    PG8_WAIT_V(2); PG8_BAR;
    PG8_STAGE(PG8_SB(1, 0), cB + kstep, voffB); PG8_STAGE(PG8_SA(1, 0), cA + kstep, voffA); PG8_STAGE(PG8_SB(1, 1), cB + hstep + kstep, voffB);
    PG8_WAIT_V(6); PG8_BAR;
    for (;;) {
        const bool has_next = S.next(ui + 1, nxt);
        const char* nA = has_next ? (const char*)g.A + (size_t)nxt.pm * tstepA + (size_t)nxt.pn * pnstepA : cA; const char* nB = has_next ? (const char*)g.Bt + (size_t)nxt.pn * tstep : cB;
        for (int t = 0; t < nt; t += 2) {
            const bool last = (t == nt - 2);
            const char* a1 = cA + (size_t)(t + 1) * kstep;
            const char* a2 = last ? nA : cA + (size_t)(t + 2) * kstep; const char* b2 = last ? nB : cB + (size_t)(t + 2) * kstep;
            const char* a3 = a2 + kstep; const char* b3 = b2 + kstep;
            PG8_LDB(B0, 0, 0); PG8_LDB(B1, 0, 1); PG8_SCHED; PG8_LDA(At, 0, 0); PG8_STAGE(PG8_SA(1, 1), a1 + hstepA, voffA);
            PG8_WAIT_V(8); PG8_WAIT_L(0); PG8_BAR; PG8_MMA(0, 0, At, B0); PG8_MMA(0, 1, At, B1); PG8_BAR; PG8_SCHED;
            PG8_LDA(At, 0, 1); PG8_STAGE(PG8_SB(0, 0), b2, voffB); PG8_STAGE(PG8_SB(0, 1), b2 + hstep, voffB); PG8_STAGE(PG8_SA(0, 0), a2, voffA);
            PG8_WAIT_V(8); PG8_WAIT_L(0); PG8_BAR; PG8_MMA(1, 0, At, B0); PG8_MMA(1, 1, At, B1); PG8_BAR; PG8_SCHED;
            PG8_LDB(B0, 1, 0); PG8_LDB(B1, 1, 1); PG8_SCHED; PG8_LDA(At, 1, 0); PG8_STAGE(PG8_SA(0, 1), a2 + hstepA, voffA);
            PG8_WAIT_V(8); PG8_WAIT_L(0); PG8_BAR; PG8_MMA(0, 0, At, B0); PG8_MMA(0, 1, At, B1); PG8_BAR; PG8_SCHED;
            PG8_LDA(At, 1, 1); PG8_STAGE(PG8_SB(1, 0), b3, voffB); PG8_STAGE(PG8_SB(1, 1), b3 + hstep, voffB); PG8_STAGE(PG8_SA(1, 0), a3, voffA);
            PG8_WAIT_V(8); PG8_WAIT_L(0); PG8_BAR; PG8_MMA(1, 0, At, B0); PG8_MMA(1, 1, At, B1); PG8_BAR; PG8_SCHED;
        }
        if (wr == 0) PG8_BAR;
        epilogue(E, acc, cur, wr, wc, fr, fq);
        if (!has_next) break;
#pragma unroll
        for (int a = 0; a < 2; ++a)
#pragma unroll
            for (int b = 0; b < 2; ++b)
#pragma unroll
                for (int m = 0; m < 4; ++m)
#pragma unroll
                    for (int n = 0; n < 2; ++n) acc[a][b][m][n] = (f32x4){0.f, 0.f, 0.f, 0.f};
        cur = nxt; cA = nA; cB = nB; ++ui;
        if (wr == 1) PG8_BAR;
    }
    PG8_WAIT_V(0);
    PG8_BAR;
#undef PG8_SA
#undef PG8_SB
#undef PG8_STAGE
#undef PG8_LDA
#undef PG8_LDB
#undef PG8_MMA
#undef PG8_WAIT_V
#undef PG8_WAIT_L
#undef PG8_BAR
#undef PG8_SCHED
}

__device__ __forceinline__ void gemm_phase2(LAS unsigned char* lds, const Gemm2 g, const StaticOrder& S, const bf16_t* gates, bf16_t* out) {
    const int tid = threadIdx.x, wid = __builtin_amdgcn_readfirstlane(tid >> 6), lane = tid & 63, wr = wid >> 2, wc = wid & 3, fr = lane & 15, fq = lane >> 4;
    const int nt1 = g.K1 / BK, nt = nt1 + g.K2 / BK;
    int sR[2], sRb[2], sC[2];
#pragma unroll
    for (int i = 0; i < 2; ++i) { int R, C; stage_rc(tid * 16 + i * 8192, R, C); sR[i] = R; sRb[i] = (R & ~31) + perm32(R & 31); sC[i] = C; }
    const size_t kstep = (size_t)(BK * 2);
    const size_t hB1 = (size_t)HALF * g.K1 * 2, hA1 = (size_t)HALF * g.lda1 * 2, hB2 = (size_t)HALF * g.K2 * 2, hA2 = (size_t)HALF * g.lda2 * 2;
    const unsigned ldsw = (unsigned)wid * 1024u;
    const int aoff = lds_byte(wr * 64 + fr, fq * 8), boff = lds_byte(wc * 32 + fr, fq * 8);
#define PG8_SA(b, h) (((b) * 2 + (h)) * HTB)
#define PG8_SB(b, h) ((4 + (b) * 2 + (h)) * HTB)
#define PG8_STAGE_T(bufoff, isA, h, T) do { const int T_ = (T); const bool nx_ = T_ >= nt; const int Tl_ = nx_ ? T_ - nt : T_; const bool s2_ = !nx_ && Tl_ >= nt1; \
        const char* base_ = (isA) ? (s2_ ? cA2 + (size_t)(Tl_ - nt1) * kstep + (h) * hA2 : (nx_ ? nA1 : cA1) + (size_t)Tl_ * kstep + (h) * hA1) \
                                  : (s2_ ? cB2 + (size_t)(Tl_ - nt1) * kstep + (h) * hB2 : (nx_ ? nB1 : cB1) + (size_t)Tl_ * kstep + (h) * hB1); \
        const int ld_ = (isA) ? (s2_ ? g.lda2 : g.lda1) : (s2_ ? g.K2 : g.K1); \
        _Pragma("unroll") for (int _i = 0; _i < 2; ++_i) { const unsigned vo_ = (unsigned)(((isA) ? sR[_i] : sRb[_i]) * ld_ + sC[_i]) * 2u; \
            __builtin_amdgcn_global_load_lds((const unsigned*)(base_ + vo_), (LAS unsigned*)(lds + (bufoff) + ldsw + _i * 8192), 16, 0, 0); } } while (0)
#define PG8_LDA(dst, b, h) do { _Pragma("unroll") for (int m = 0; m < 4; ++m) _Pragma("unroll") for (int k = 0; k < 2; ++k) dst[m][k] = *(const LAS bf16x8*)(lds + PG8_SA(b, h) + aoff + m * 2048 + k * 1024); } while (0)
#define PG8_LDB(dst, b, h) do { _Pragma("unroll") for (int n = 0; n < 2; ++n) _Pragma("unroll") for (int k = 0; k < 2; ++k) dst[n][k] = *(const LAS bf16x8*)(lds + PG8_SB(b, h) + boff + n * 2048 + k * 1024); } while (0)
#define PG8_MMA(ai, bj, At, Bt) do { __builtin_amdgcn_s_setprio(1); _Pragma("unroll") for (int m = 0; m < 4; ++m) _Pragma("unroll") for (int n = 0; n < 2; ++n) _Pragma("unroll") for (int k = 0; k < 2; ++k) \
        acc[ai][bj][m][n] = __builtin_amdgcn_mfma_f32_16x16x32_bf16(Bt[n][k], At[m][k], acc[ai][bj][m][n], 0, 0, 0); __builtin_amdgcn_s_setprio(0); } while (0)
#define PG8_WAIT_V(n) asm volatile("s_waitcnt vmcnt(" #n ")" ::: "memory")
#define PG8_WAIT_L(n) asm volatile("s_waitcnt lgkmcnt(" #n ")" ::: "memory")
#define PG8_BAR __builtin_amdgcn_s_barrier()
#define PG8_SCHED __builtin_amdgcn_sched_barrier(0)
    Unit cur, nxt; int ui = 0;
    if (!S.next(0, cur)) return;
    f32x4 acc[2][2][4][2];
#pragma unroll
    for (int a = 0; a < 2; ++a)
#pragma unroll
        for (int b = 0; b < 2; ++b)
#pragma unroll
            for (int m = 0; m < 4; ++m)
#pragma unroll
                for (int n = 0; n < 2; ++n) acc[a][b][m][n] = (f32x4){0.f, 0.f, 0.f, 0.f};
    bf16x8 At[4][2], B0[2][2], B1[2][2];
    const char* cA1 = (const char*)g.A1 + (size_t)cur.pm * 2 * hA1; const char* cB1 = (const char*)g.B1 + (size_t)cur.pn * 2 * hB1;
    const char* cA2 = (const char*)g.A2 + (size_t)cur.pm * 2 * hA2; const char* cB2 = (const char*)g.B2 + (size_t)cur.pn * 2 * hB2;
    const char* nA1 = cA1; const char* nB1 = cB1;
    PG8_STAGE_T(PG8_SB(0, 0), false, 0, 0); PG8_STAGE_T(PG8_SB(0, 1), false, 1, 0); PG8_STAGE_T(PG8_SA(0, 0), true, 0, 0); PG8_STAGE_T(PG8_SA(0, 1), true, 1, 0);
    if (wr == 1) PG8_BAR;
    PG8_WAIT_V(2); PG8_BAR;
    PG8_STAGE_T(PG8_SB(1, 0), false, 0, 1); PG8_STAGE_T(PG8_SA(1, 0), true, 0, 1); PG8_STAGE_T(PG8_SB(1, 1), false, 1, 1);
    PG8_WAIT_V(6); PG8_BAR;
    for (;;) {
        const bool has_next = S.next(ui + 1, nxt);
        nA1 = has_next ? (const char*)g.A1 + (size_t)nxt.pm * 2 * hA1 : cA1; nB1 = has_next ? (const char*)g.B1 + (size_t)nxt.pn * 2 * hB1 : cB1;
        const int rowb = cur.pm * BM + wr * 64 + fr, colb = cur.pn * BM + wc * 32 + 8 * fq;
        for (int t = 0; t < nt; t += 2) {
            if (t == nt1) {
#pragma unroll
                for (int ai = 0; ai < 2; ++ai)
#pragma unroll
                    for (int m = 0; m < 4; ++m) { const bf16_t* gp = gates + (size_t)(rowb + ai * HALF + m * 16) * (2 * DM) + colb;
#pragma unroll
                        for (int bj = 0; bj < 2; ++bj) { f32x4 g00, g01, g10, g11; unpack8(*(const GAS u32x4*)(gp + bj * HALF), g00, g01); unpack8(*(const GAS u32x4*)(gp + DM + bj * HALF), g10, g11);
#pragma unroll
                            for (int j = 0; j < 4; ++j) { acc[ai][bj][m][0][j] *= g00[j] * __builtin_amdgcn_rcpf(fmaxf(g10[j], 1e-6f)); acc[ai][bj][m][1][j] *= g01[j] * __builtin_amdgcn_rcpf(fmaxf(g11[j], 1e-6f)); } } }
            }
            PG8_LDB(B0, 0, 0); PG8_LDB(B1, 0, 1); PG8_SCHED; PG8_LDA(At, 0, 0); PG8_STAGE_T(PG8_SA(1, 1), true, 1, t + 1);
            PG8_WAIT_V(8); PG8_WAIT_L(0); PG8_BAR; PG8_MMA(0, 0, At, B0); PG8_MMA(0, 1, At, B1); PG8_BAR; PG8_SCHED;
            PG8_LDA(At, 0, 1); PG8_STAGE_T(PG8_SB(0, 0), false, 0, t + 2); PG8_STAGE_T(PG8_SB(0, 1), false, 1, t + 2); PG8_STAGE_T(PG8_SA(0, 0), true, 0, t + 2);
            PG8_WAIT_V(8); PG8_WAIT_L(0); PG8_BAR; PG8_MMA(1, 0, At, B0); PG8_MMA(1, 1, At, B1); PG8_BAR; PG8_SCHED;
            PG8_LDB(B0, 1, 0); PG8_LDB(B1, 1, 1); PG8_SCHED; PG8_LDA(At, 1, 0); PG8_STAGE_T(PG8_SA(0, 1), true, 1, t + 2);
            PG8_WAIT_V(8); PG8_WAIT_L(0); PG8_BAR; PG8_MMA(0, 0, At, B0); PG8_MMA(0, 1, At, B1); PG8_BAR; PG8_SCHED;
            PG8_LDA(At, 1, 1); PG8_STAGE_T(PG8_SB(1, 0), false, 0, t + 3); PG8_STAGE_T(PG8_SB(1, 1), false, 1, t + 3); PG8_STAGE_T(PG8_SA(1, 0), true, 0, t + 3);
            PG8_WAIT_V(8); PG8_WAIT_L(0); PG8_BAR; PG8_MMA(1, 0, At, B0); PG8_MMA(1, 1, At, B1); PG8_BAR; PG8_SCHED;
        }
        if (wr == 0) PG8_BAR;
#pragma unroll
        for (int ai = 0; ai < 2; ++ai)
#pragma unroll
            for (int m = 0; m < 4; ++m) { const size_t row = (size_t)(rowb + ai * HALF + m * 16);
#pragma unroll
                for (int bj = 0; bj < 2; ++bj) { f32x4 g10, g11; unpack8(*(const GAS u32x4*)(gates + row * (2 * DM) + DM + colb + bj * HALF), g10, g11);
#pragma unroll
                    for (int j = 0; j < 4; ++j) { g10[j] = fmaxf(g10[j], 1e-6f); g11[j] = fmaxf(g11[j], 1e-6f); }
                    *(GAS u32x4*)(out + row * DM + colb + bj * HALF) = pack8(acc[ai][bj][m][0] * g10, acc[ai][bj][m][1] * g11); } }
        if (!has_next) break;
#pragma unroll
        for (int a = 0; a < 2; ++a)
#pragma unroll
            for (int b = 0; b < 2; ++b)
#pragma unroll
                for (int m = 0; m < 4; ++m)
#pragma unroll
                    for (int n = 0; n < 2; ++n) acc[a][b][m][n] = (f32x4){0.f, 0.f, 0.f, 0.f};
        cur = nxt; cA1 = nA1; cB1 = nB1; cA2 = (const char*)g.A2 + (size_t)cur.pm * 2 * hA2; cB2 = (const char*)g.B2 + (size_t)cur.pn * 2 * hB2; ++ui;
        if (wr == 1) PG8_BAR;
    }
    PG8_WAIT_V(0);
    PG8_BAR;
#undef PG8_SA
#undef PG8_SB
#undef PG8_STAGE_T
#undef PG8_LDA
#undef PG8_LDB
#undef PG8_MMA
#undef PG8_WAIT_V
#undef PG8_WAIT_L
#undef PG8_BAR
#undef PG8_SCHED
}
}

#define XB_TMO      128
#define XB_XCNT(j)  (256  + 64 * (j))
#define XB_XSUB(j)  (1280 + 64 * (j))
#define XB_XGEN(j)  (2304 + 64 * (j))
#define XB_TOP      3328
#define XB_TOPGEN   3392
#define XCD_BAR_WORDS 3456
#define XB_SPIN_CAP (1u << 18)
__device__ __forceinline__ unsigned xb_ld(unsigned* p)              { return __hip_atomic_load(p, __ATOMIC_RELAXED, __HIP_MEMORY_SCOPE_AGENT); }
__device__ __forceinline__ unsigned xb_add(unsigned* p, unsigned v) { return __hip_atomic_fetch_add(p, v, __ATOMIC_RELAXED, __HIP_MEMORY_SCOPE_AGENT); }
__device__ __forceinline__ unsigned xb_xcc_id() { return (unsigned)__builtin_amdgcn_s_getreg((3 << 11) | 20) & 0xFu; }
#define XB_SPIN(cond, bar) do { unsigned _sp = 0; while (cond) { __builtin_amdgcn_s_sleep(1); \
    if ((++_sp & 255u) == 0u) { if (xb_ld(&(bar)[XB_TMO])) break; if (_sp > XB_SPIN_CAP) { atomicAdd(&(bar)[XB_TMO], 1u); break; } } } } while (0)
struct XcdBarrier { unsigned* bar; unsigned x; volatile LAS unsigned* st; };
__device__ __forceinline__ XcdBarrier xcd_barrier_post(unsigned* bar, volatile LAS unsigned* st) {
    XcdBarrier b; b.bar = bar; b.x = xb_xcc_id(); b.st = st;
    if (threadIdx.x == 0) (void)xb_add(&bar[XB_XCNT(b.x)], 1u);
    return b;
}
__device__ __forceinline__ void xcd_barrier_complete(unsigned* bar, unsigned x, unsigned& nloc, unsigned& nx) {
    const unsigned G = gridDim.x * gridDim.y * gridDim.z;
    unsigned sum, cnt, mine, sp = 0u;
    for (;;) {
        sum = 0u; cnt = 0u; mine = 0u;
#pragma unroll
        for (unsigned j = 0; j < 16; ++j) { const unsigned c = xb_ld(&bar[XB_XCNT(j)]); sum += c; cnt += (c > 0u) ? 1u : 0u; mine = (j == x) ? c : mine; }
        if (sum == G) break;
        __builtin_amdgcn_s_sleep(1);
        if ((++sp & 255u) == 0u) { if (xb_ld(&bar[XB_TMO])) break; if (sp > XB_SPIN_CAP) { atomicAdd(&bar[XB_TMO], 1u); break; } }
    }
    nloc = mine > 0u ? mine : 1u; nx = cnt > 0u ? cnt : 1u;
}
__device__ __forceinline__ void xcd_barrier(const XcdBarrier& b) {
    asm volatile("s_waitcnt vmcnt(0)" ::: "memory");
    __syncthreads();
    if (threadIdx.x == 0) {
        unsigned* bar = b.bar;
        __builtin_amdgcn_s_waitcnt(0);
        unsigned nloc = b.st[0], nx = b.st[1];
        if (nloc == 0u) { xcd_barrier_complete(bar, b.x, nloc, nx); b.st[0] = nloc; b.st[1] = nx; }
        const unsigned old = xb_add(&bar[XB_XSUB(b.x)], 1u);
        const unsigned gen = old / nloc;
        if (old + 1u == (gen + 1u) * nloc) {
            __builtin_amdgcn_fence(__ATOMIC_RELEASE, "agent");
            asm volatile("s_waitcnt vmcnt(0)" ::: "memory");
            const unsigned og = xb_add(&bar[XB_TOP], 1u);
            const unsigned tg = og / nx;
            if (og + 1u == (tg + 1u) * nx) xb_add(&bar[XB_TOPGEN], 1u);
            else XB_SPIN(xb_ld(&bar[XB_TOPGEN]) == tg, bar);
            __builtin_amdgcn_fence(__ATOMIC_ACQUIRE, "agent");
            xb_add(&bar[XB_XGEN(b.x)], 1u);
            asm volatile("s_waitcnt vmcnt(0)" ::: "memory");
        } else {
            XB_SPIN(xb_ld(&bar[XB_XGEN(b.x)]) == gen, bar);
            __builtin_amdgcn_fence(__ATOMIC_ACQUIRE, "agent");
            asm volatile("s_waitcnt vmcnt(0)" ::: "memory");
        }
    }
    __syncthreads();
}

__device__ __forceinline__ void p0_transpose_item(const float* W, int K, int N, const float* gain, bf16_t* WT, int k0, int n0, int drow0, LAS float* scr, int lane) {
#pragma unroll
    for (int i = 0; i < 8; ++i) { const int kk = 8 * i + (lane >> 3), nn = 4 * (lane & 7);
        f32x4 v = *(const GAS f32x4*)(W + (size_t)(k0 + kk) * N + n0 + nn);
        if (gain) v = v * *(const GAS float*)(gain + k0 + kk);
        scr[kk * 33 + nn] = v.x; scr[kk * 33 + nn + 1] = v.y; scr[kk * 33 + nn + 2] = v.z; scr[kk * 33 + nn + 3] = v.w; }
    LDS_WAIT(); asm volatile("" ::: "memory");
    const int c = lane & 7;
#pragma unroll
    for (int j = 0; j < 4; ++j) { const int n = (lane >> 3) + 8 * j; const LAS float* s = scr + (8 * c) * 33 + n;
        u32x4 o; o.x = pk2(s[0 * 33], s[1 * 33]); o.y = pk2(s[2 * 33], s[3 * 33]); o.z = pk2(s[4 * 33], s[5 * 33]); o.w = pk2(s[6 * 33], s[7 * 33]);
        *(GAS u32x4*)(WT + (size_t)(drow0 + n) * K + k0 + 8 * c) = o; }
    LDS_WAIT(); asm volatile("" ::: "memory");
}
__device__ __forceinline__ int map_gu(int n0) { return n0 < DFF ? (n0 / 128) * 256 + (n0 % 128) : ((n0 - DFF) / 128) * 256 + 128 + ((n0 - DFF) % 128); }
__device__ __forceinline__ int map_win(int n0) { return n0 < 6144 ? n0 : (n0 < 6176 ? 9216 + (n0 - 6144) : n0 - 32); }

__device__ __forceinline__ void p0_prologue(Frame& F) {
    LAS float* scr = (LAS float*)(F.lds + F.wave * 16384);
    const int gw = F.vcu * NWAVES + F.wave, NGW = F.G * NWAVES, lane = F.lane;
    bf16_t* const wgu1 = (bf16_t*)(F.ws + WS_WGU1); bf16_t* const wd1 = (bf16_t*)(F.ws + WS_WD1); bf16_t* const win = (bf16_t*)(F.ws + WS_WIN);
    bf16_t* const wsso = (bf16_t*)(F.ws + WS_WSSO); bf16_t* const wo = (bf16_t*)(F.ws + WS_WO); bf16_t* const wgu2 = (bf16_t*)(F.ws + WS_WGU2);
    bf16_t* const wd2 = (bf16_t*)(F.ws + WS_WD2); bf16_t* const wpg = (bf16_t*)(F.ws + WS_WPG); bf16_t* const wple = (bf16_t*)(F.ws + WS_WPLE);
    constexpr int I_GU = (DM / 64) * (2 * DFF / 32), I_D = (DFF / 64) * (DM / 32), I_IN = (DM / 64) * (IN_DIM / 32), I_SSO = (DI / 64) * (DM / 32), I_SQ = (DM / 64) * (DM / 32), I_PLE = (PLE / 64) * (DM / 32);
    constexpr int NITEMS = 2 * I_GU + 2 * I_D + I_IN + I_SSO + 3 * I_SQ + I_PLE;
    bf16_t* const wpot = (bf16_t*)(F.ws + WS_WPOT);
    for (int it = gw; it < NITEMS; it += NGW) {
        int r = it;
        if (r < I_GU) { const int nb = 2 * DFF / 32, kb = r / nb, n0 = (r % nb) * 32; p0_transpose_item(F.in[I_WGU1], DM, 2 * DFF, F.in[I_NFFN1], wgu1, kb * 64, n0, map_gu(n0), scr, lane); continue; } r -= I_GU;
        if (r < I_GU) { const int nb = 2 * DFF / 32, kb = r / nb, n0 = (r % nb) * 32; p0_transpose_item(F.in[I_WGU2], DM, 2 * DFF, F.in[I_NFFN2], wgu2, kb * 64, n0, map_gu(n0), scr, lane); continue; } r -= I_GU;
        if (r < I_D) { const int nb = DM / 32, kb = r / nb, n0 = (r % nb) * 32; p0_transpose_item(F.in[I_WD1], DFF, DM, nullptr, wd1, kb * 64, n0, n0, scr, lane); continue; } r -= I_D;
        if (r < I_D) { const int nb = DM / 32, kb = r / nb, n0 = (r % nb) * 32; p0_transpose_item(F.in[I_WD2], DFF, DM, nullptr, wd2, kb * 64, n0, n0, scr, lane); continue; } r -= I_D;
        if (r < I_IN) { const int nb = IN_DIM / 32, kb = r / nb, n0 = (r % nb) * 32; p0_transpose_item(F.in[I_WIN], DM, IN_DIM, F.in[I_NMIX], win, kb * 64, n0, map_win(n0), scr, lane); continue; } r -= I_IN;
        if (r < I_SSO) { const int nb = DM / 32, kb = r / nb, n0 = (r % nb) * 32; p0_transpose_item(F.in[I_WSSO], DI, DM, F.in[I_NSSD], wsso, kb * 64, n0, n0, scr, lane); continue; } r -= I_SSO;
        if (r < I_SQ) { const int nb = DM / 32, kb = r / nb, n0 = (r % nb) * 32; p0_transpose_item(F.in[I_WO], DM, DM, nullptr, wo, kb * 64, n0, n0, scr, lane); continue; } r -= I_SQ;
        if (r < I_SQ) { const int nb = DM / 32, kb = r / nb, n0 = (r % nb) * 32; p0_transpose_item(F.in[I_WPG], DM, DM, F.in[I_NPLE], wpg, kb * 64, n0, n0, scr, lane); continue; } r -= I_SQ;
        if (r < I_SQ) { const int nb = DM / 32, kb = r / nb, n0 = (r % nb) * 32; p0_transpose_item(F.in[I_WPOUT], PD, DM, F.in[I_PSCALE], wpot, kb * 64, n0, n0, scr, lane); continue; } r -= I_SQ;
        { const int nb = DM / 32, kb = r / nb, n0 = (r % nb) * 32; p0_transpose_item(F.in[I_WPLE], PLE, DM, nullptr, wple, kb * 64, n0, n0, scr, lane); }
    }
    {
        bf16_t* const wgrp = (bf16_t*)(F.ws + WS_WGRP); const float* Wg = F.in[I_WPGRP];
        for (int e = F.vcu * NTHREADS + F.tid; e < 4 * 256 * 256 / 8; e += F.G * NTHREADS) {
            const f32x4 a = *(const GAS f32x4*)(Wg + (size_t)e * 8), b = *(const GAS f32x4*)(Wg + (size_t)e * 8 + 4);
            u32x4 o; o.x = pk2(a.x, a.y); o.y = pk2(a.z, a.w); o.z = pk2(b.x, b.y); o.w = pk2(b.z, b.w);
            *(GAS u32x4*)(wgrp + (size_t)e * 8) = o; }
    }
    {
        bf16_t* const XB = (bf16_t*)(F.ws + WS_XB); bf16_t* const PB = (bf16_t*)(F.ws + WS_PB); float* const stA = (float*)(F.ws + WS_STATS_A);
        for (int m = gw; m < M; m += NGW) {
            const float* xrow = (m < MP) ? F.in[I_XP] + (size_t)m * DM : F.in[I_XS] + (size_t)(m - MP) * DM;
            const GAS f32x4* xr = (const GAS f32x4*)xrow + lane;
            f32x4 v[4]; float s = 0.f;
#pragma unroll
            for (int j = 0; j < 4; ++j) { v[j] = xr[64 * j]; s += (v[j].x * v[j].x + v[j].y * v[j].y) + (v[j].z * v[j].z + v[j].w * v[j].w); }
            s = wave_sum(s);
            GAS u32x2* o8 = (GAS u32x2*)(XB + (size_t)m * DM) + lane;
#pragma unroll
            for (int j = 0; j < 4; ++j) { u32x2 w; w.x = pk2(v[j].x, v[j].y); w.y = pk2(v[j].z, v[j].w); o8[64 * j] = w; }
            if (lane < 16) *(GAS float*)(stA + (size_t)m * 16 + lane) = (lane == 0) ? s : 0.f;
            const float* prow = (m < MP) ? F.in[I_PP] + (size_t)m * PLE : F.in[I_PS] + (size_t)(m - MP) * PLE;
            const f32x4 pv = *((const GAS f32x4*)prow + lane);
            u32x2 w; w.x = pk2(pv.x, pv.y); w.y = pk2(pv.z, pv.w); *((GAS u32x2*)(PB + (size_t)m * PLE) + lane) = w;
        }
    }
}


typedef short v4i16_t __attribute__((ext_vector_type(4)));
constexpr int IMG_B = 0, IMG_C = 32768, IMG_X = 65536, TAB_ACS = RING_BYTES + 1024, TAB_DT = TAB_ACS + 2048, TAB_SD = TAB_DT + 2048;
constexpr int NCHUNK = SEQ / 128;
template <bool XS> __device__ __forceinline__ int img_off(int row, int ch) { return XS ? 256 * row + 16 * (ch ^ ((row & 7) << 1)) : 256 * row + 16 * (ch ^ (((row & 3) << 2) | ((row >> 2) & 3))); }
__device__ __forceinline__ bf16x8 tr_pair(const LAS unsigned char* p0, const LAS unsigned char* p1) {
    const v4i16_t a = __builtin_amdgcn_ds_read_tr16_b64_v4i16((LAS v4i16_t*)p0), b = __builtin_amdgcn_ds_read_tr16_b64_v4i16((LAS v4i16_t*)p1);
    return (bf16x8){a[0], a[1], a[2], a[3], b[0], b[1], b[2], b[3]};
}
__device__ __forceinline__ void ssd_tables_load(Frame& F, size_t row0, int g, float& d0, float& d1) {
    if (F.wave < 4) { const float* const DT = (const float*)(F.ws + WS_DT); const int head = g * HPG + F.wave;
        d0 = *(const GAS float*)(DT + (row0 + 2 * F.lane) * 32 + head); d1 = *(const GAS float*)(DT + (row0 + 2 * F.lane + 1) * 32 + head); }
}
__device__ __forceinline__ void ssd_tables_compute(Frame& F, int g, float d0, float d1) {
    LAS float* const acs = (LAS float*)(F.lds + TAB_ACS); LAS float* const dtl = (LAS float*)(F.lds + TAB_DT); LAS float* const sdec = (LAS float*)(F.lds + TAB_SD);
    if (F.wave < 4) {
        const int r = F.wave, lane = F.lane, head = g * HPG + r;
        const float Ah = -__expf(*(const GAS float*)(F.in[I_ALOG] + head));
        const float a0 = d0 * Ah, a1 = d1 * Ah, loc = a0 + a1;
        float inc = loc;
#pragma unroll
        for (int o = 1; o < 64; o <<= 1) { const float t = __shfl_up(inc, o); if (lane >= o) inc += t; }
        const float exc = inc - loc;
        acs[(2 * lane) * 4 + r] = exc + a0; acs[(2 * lane + 1) * 4 + r] = inc;
        dtl[(2 * lane) * 4 + r] = d0; dtl[(2 * lane + 1) * 4 + r] = d1;
    }
    __syncthreads();
    { const int s = F.tid >> 2, r = F.tid & 3; sdec[s * 4 + r] = __expf(acs[127 * 4 + r] - acs[s * 4 + r]) * dtl[s * 4 + r]; }
    __syncthreads();
}
__device__ __forceinline__ void ssd_tables(Frame& F, size_t row0, int g) { float d0 = 0.f, d1 = 0.f; ssd_tables_load(F, row0, g, d0, d1); ssd_tables_compute(F, g, d0, d1); }
struct ConvMap { int kind, cc, run, gch; };
__device__ __forceinline__ ConvMap ssd_conv_map(int t, int g) {
    ConvMap m;
    if (t < 256) { m.kind = 0; m.cc = t & 31; m.run = t >> 5; } else if (t < 384) { m.kind = 1; m.cc = (t - 256) & 15; m.run = (t - 256) >> 4; } else { m.kind = 2; m.cc = (t - 384) & 15; m.run = (t - 384) >> 4; }
    m.gch = (m.kind == 0 ? g * 256 : (m.kind == 1 ? DI + g * DSTATE : DI + NG * DSTATE + g * DSTATE)) + 8 * m.cc;
    return m;
}
__device__ __forceinline__ void ssd_conv_load(Frame& F, size_t row0, int b, int c, int g, u32x4 (&raw)[19]) {
    const ConvMap m = ssd_conv_map(F.tid, g);
    const bf16_t* const XBC = (const bf16_t*)(F.ws + WS_XBC); const bf16_t* const HALO = (const bf16_t*)(F.ws + WS_HALO);
#pragma unroll
    for (int i = 0; i < 19; ++i) {
        if (i < 3 && m.run == 0) { if (c == 0) raw[i] = (u32x4){0u, 0u, 0u, 0u}; else raw[i] = *(const GAS u32x4*)(HALO + ((((size_t)b * 16 + c) * 3 + i) * CD) + m.gch); }
        else raw[i] = *(const GAS u32x4*)(XBC + (row0 + 16 * m.run + i - 3) * CD + m.gch); }
}
__device__ __forceinline__ void ssd_conv_store(Frame& F, size_t row0, int g, const u32x4 (&raw)[19]) {
    const ConvMap m = ssd_conv_map(F.tid, g);
    bf16_t* const XBC = (bf16_t*)(F.ws + WS_XBC);
    const float* const convw = F.in[I_CONVW]; const float* const convb = F.in[I_CONVB];
    float cw[4][8], cb[8];
#pragma unroll
    for (int k = 0; k < 4; ++k) { const f32x4 a = *(const GAS f32x4*)(convw + (size_t)k * CD + m.gch), b_ = *(const GAS f32x4*)(convw + (size_t)k * CD + m.gch + 4);
        cw[k][0] = a.x; cw[k][1] = a.y; cw[k][2] = a.z; cw[k][3] = a.w; cw[k][4] = b_.x; cw[k][5] = b_.y; cw[k][6] = b_.z; cw[k][7] = b_.w; }
    { const f32x4 a = *(const GAS f32x4*)(convb + m.gch), b_ = *(const GAS f32x4*)(convb + m.gch + 4); cb[0] = a.x; cb[1] = a.y; cb[2] = a.z; cb[3] = a.w; cb[4] = b_.x; cb[5] = b_.y; cb[6] = b_.z; cb[7] = b_.w; }
    LAS unsigned char* const img = F.lds + (m.kind == 0 ? IMG_X + (m.cc >> 4) * 32768 : IMG_B);
    const LAS float* const sdec = (const LAS float*)(F.lds + TAB_SD);
    const int chl = m.cc & 15, hr = m.cc >> 3;
#pragma unroll
    for (int i = 0; i < 16; ++i) {
        const int s = 16 * m.run + i;
        float o[8];
#pragma unroll
        for (int j2 = 0; j2 < 4; ++j2) {
            const unsigned w0 = raw[i][j2], w1 = raw[i + 1][j2], w2 = raw[i + 2][j2], w3 = raw[i + 3][j2];
            const float lo = cb[2 * j2] + cw[0][2 * j2] * bflo(w0) + cw[1][2 * j2] * bflo(w1) + cw[2][2 * j2] * bflo(w2) + cw[3][2 * j2] * bflo(w3);
            const float hi = cb[2 * j2 + 1] + cw[0][2 * j2 + 1] * bfhi(w0) + cw[1][2 * j2 + 1] * bfhi(w1) + cw[2][2 * j2 + 1] * bfhi(w2) + cw[3][2 * j2 + 1] * bfhi(w3);
            o[2 * j2] = silu_f(lo); o[2 * j2 + 1] = silu_f(hi);
        }
        u32x4 pk; pk.x = cvt_pk_bf16(o[0], o[1]); pk.y = cvt_pk_bf16(o[2], o[3]); pk.z = cvt_pk_bf16(o[4], o[5]); pk.w = cvt_pk_bf16(o[6], o[7]);
        *(GAS u32x4*)(XBC + (row0 + s) * CD + m.gch) = pk;
        if (m.kind == 0) { const float sc = sdec[s * 4 + hr];
            pk.x = cvt_pk_bf16(o[0] * sc, o[1] * sc); pk.y = cvt_pk_bf16(o[2] * sc, o[3] * sc); pk.z = cvt_pk_bf16(o[4] * sc, o[5] * sc); pk.w = cvt_pk_bf16(o[6] * sc, o[7] * sc); }
        if (m.kind != 2) *(LAS u32x4*)(img + img_off<false>(s, chl)) = pk;
    }
}
__device__ __forceinline__ void ssd_copy_load(Frame& F, size_t row0, int g, u32x4 (&raw)[16]) {
    const ConvMap m = ssd_conv_map(F.tid, g);
    const bf16_t* const XBC = (const bf16_t*)(F.ws + WS_XBC);
#pragma unroll
    for (int i = 0; i < 16; ++i) raw[i] = *(const GAS u32x4*)(XBC + (row0 + 16 * m.run + i) * CD + m.gch);
}
__device__ __forceinline__ void ssd_copy_store(Frame& F, int g, const u32x4 (&raw)[16]) {
    const ConvMap m = ssd_conv_map(F.tid, g);
    LAS unsigned char* const img = F.lds + (m.kind == 0 ? IMG_X + (m.cc >> 4) * 32768 : (m.kind == 1 ? IMG_B : IMG_C));
    const int chl = m.cc & 15;
#pragma unroll
    for (int i = 0; i < 16; ++i) { const int s = 16 * m.run + i; *(LAS u32x4*)(img + (m.kind == 0 ? img_off<true>(s, chl) : img_off<false>(s, chl))) = raw[i]; }
}
__device__ __forceinline__ void ssd_states_phase(Frame& F) {
    bf16_t* const ST = (bf16_t*)(F.ws + WS_HPREV);
    float* const CDEC = (float*)(F.ws + WS_CDEC);
    const int w = F.wave, lane = F.lane, ql = lane & 15, gq = lane >> 4, qq = ql >> 2, pp = ql & 3, r = w >> 1, nh = w & 1;
    int sbo[4][2], sxo[4][2];
#pragma unroll
    for (int f = 0; f < 4; ++f) { const int colb = 64 * nh + 16 * f + 4 * pp, colx = 64 * (r & 1) + 16 * f + 4 * pp;
#pragma unroll
        for (int t4 = 0; t4 < 2; ++t4) { sbo[f][t4] = img_off<false>(8 * gq + qq + 4 * t4, colb >> 3) + 2 * (colb & 7); sxo[f][t4] = img_off<false>(8 * gq + qq + 4 * t4, colx >> 3) + 2 * (colx & 7); } }
    u32x4 raw[19]; float d0 = 0.f, d1 = 0.f;
    constexpr int NIT = BATCH * NCHUNK * NG;
    if (F.vcu < NIT) { const int it = F.vcu, g = it & 7, c = (it >> 3) & (NCHUNK - 1), b = it >> 7; const size_t row0 = (size_t)b * SEQ + (size_t)c * 128;
        ssd_conv_load(F, row0, b, c, g, raw); ssd_tables_load(F, row0, g, d0, d1); }
    for (int it = F.vcu; it < NIT; it += F.G) {
        const int g = it & 7, c = (it >> 3) & (NCHUNK - 1), b = it >> 7;
        const size_t row0 = (size_t)b * SEQ + (size_t)c * 128;
        asm volatile("s_waitcnt vmcnt(0)" ::: "memory");
        ssd_tables_compute(F, g, d0, d1);
        ssd_conv_store(F, row0, g, raw);
        __syncthreads();
        if (it + F.G < NIT) { const int it2 = it + F.G, g2 = it2 & 7, c2 = (it2 >> 3) & (NCHUNK - 1), b2 = it2 >> 7; const size_t row2 = (size_t)b2 * SEQ + (size_t)c2 * 128;
            ssd_conv_load(F, row2, b2, c2, g2, raw); ssd_tables_load(F, row2, g2, d0, d1); }
        const int head = g * HPG + r;
        bf16_t* const stp = ST + ((((size_t)b * NCHUNK + c) * NH + head) * HD) * DSTATE;
#pragma unroll
        for (int nh2 = 0; nh2 < 2; ++nh2) {
            f32x4 acc[2][4];
#pragma unroll
            for (int i = 0; i < 2; ++i)
#pragma unroll
                for (int j = 0; j < 4; ++j) acc[i][j] = (f32x4){0.f, 0.f, 0.f, 0.f};
#pragma unroll
            for (int ks = 0; ks < 4; ++ks) {
                bf16x8 af[2], xf[4];
#pragma unroll
                for (int nf = 0; nf < 2; ++nf) { const LAS unsigned char* p = F.lds + IMG_B + sbo[2 * nh2 + nf][0] + 8192 * ks; const LAS unsigned char* p4 = F.lds + IMG_B + sbo[2 * nh2 + nf][1] + 8192 * ks; af[nf] = tr_pair(p, p4); }
#pragma unroll
                for (int pf = 0; pf < 4; ++pf) { const LAS unsigned char* p = F.lds + IMG_X + (r >> 1) * 32768 + sxo[pf][0] + 8192 * ks; const LAS unsigned char* p4 = F.lds + IMG_X + (r >> 1) * 32768 + sxo[pf][1] + 8192 * ks; xf[pf] = tr_pair(p, p4); }
#pragma unroll
                for (int nf = 0; nf < 2; ++nf)
#pragma unroll
                    for (int pf = 0; pf < 4; ++pf) acc[nf][pf] = __builtin_amdgcn_mfma_f32_16x16x32_bf16(af[nf], xf[pf], acc[nf][pf], 0, 0, 0);
            }
#pragma unroll
            for (int pf = 0; pf < 4; ++pf)
#pragma unroll
                for (int nf = 0; nf < 2; ++nf) { u32x2 o; o.x = cvt_pk_bf16(acc[nf][pf][0], acc[nf][pf][1]); o.y = cvt_pk_bf16(acc[nf][pf][2], acc[nf][pf][3]);
                    *(GAS u32x2*)(stp + (size_t)(16 * pf + ql) * DSTATE + 64 * nh + 32 * nh2 + 16 * nf + 4 * gq) = o; }
        }
        if (F.tid < 4) { const LAS float* acs = (const LAS float*)(F.lds + TAB_ACS); *(GAS float*)(CDEC + ((size_t)b * NCHUNK + c) * NH + g * HPG + F.tid) = __expf(acs[127 * 4 + F.tid]); }
        __syncthreads();
    }
}
__device__ __forceinline__ void ssd_scan_phase(Frame& F) {
    bf16_t* const HP = (bf16_t*)(F.ws + WS_HPREV); const float* const CDEC = (const float*)(F.ws + WS_CDEC); float* const hout = F.out + O_SSM_P;
    const int gt = F.vcu * NTHREADS + F.tid, NT = F.G * NTHREADS;
    constexpr int PER = NH * HD * DSTATE / 8;
    for (int e = gt; e < BATCH * PER; e += NT) {
        const int b = e / PER, i8 = e % PER, head = i8 / (HD * DSTATE / 8);
        u32x4 stv[NCHUNK];
#pragma unroll
        for (int c = 0; c < NCHUNK; ++c) stv[c] = *(const GAS u32x4*)(HP + (((size_t)b * NCHUNK + c) * (size_t)PER + i8) * 8);
        f32x4 h0 = (f32x4){0.f, 0.f, 0.f, 0.f}, h1 = h0;
#pragma unroll
        for (int c = 0; c < NCHUNK; ++c) {
            if (c > 0) *(GAS u32x4*)(HP + (((size_t)b * NCHUNK + c) * (size_t)PER + i8) * 8) = pg8::pack8(h0, h1);
            const float d = *(const GAS float*)(CDEC + ((size_t)b * NCHUNK + c) * NH + head);
            f32x4 s0, s1; pg8::unpack8(stv[c], s0, s1);
            h0 = h0 * d + s0; h1 = h1 * d + s1;
        }
        *(GAS f32x4*)(hout + ((size_t)b * PER + i8) * 8) = h0; *(GAS f32x4*)(hout + ((size_t)b * PER + i8) * 8 + 4) = h1;
    }
}
__device__ __forceinline__ void ssd_out_phase(Frame& F) {
    const bf16_t* const HP = (const bf16_t*)(F.ws + WS_HPREV); bf16_t* const ZY = (bf16_t*)(F.ws + WS_Z);
    const int w = F.wave, lane = F.lane, ql = lane & 15, gq = lane >> 4, qq = ql >> 2, pp = ql & 3, q0 = 16 * w;
    const LAS float* const acs = (const LAS float*)(F.lds + TAB_ACS); const LAS float* const dtl = (const LAS float*)(F.lds + TAB_DT);
    int cfo[4], bbo[4], hbo[4], xbo[2][4];
#pragma unroll
    for (int ks = 0; ks < 4; ++ks) { cfo[ks] = IMG_C + img_off<false>(q0 + ql, 4 * ks + gq); bbo[ks] = IMG_B + img_off<false>(ql, 4 * ks + gq); hbo[ks] = img_off<false>(ql, 4 * ks + gq); }
#pragma unroll
    for (int rr = 0; rr < 2; ++rr)
#pragma unroll
        for (int pf = 0; pf < 4; ++pf) xbo[rr][pf] = IMG_X + img_off<true>(4 * gq + qq, 8 * rr + 2 * pf + (pp >> 1)) + 8 * (pp & 1);
    u32x4 raw[16]; float d0 = 0.f, d1 = 0.f;
    constexpr int NIT = BATCH * NCHUNK * NG;
    if (F.vcu < NIT) { const int it = F.vcu, g = it & 7, c = (it >> 3) & (NCHUNK - 1), b = it >> 7; const size_t row0 = (size_t)b * SEQ + (size_t)c * 128;
        ssd_copy_load(F, row0, g, raw); ssd_tables_load(F, row0, g, d0, d1); }
    for (int it = F.vcu; it < NIT; it += F.G) {
        const int g = it & 7, c = (it >> 3) & (NCHUNK - 1), b = it >> 7;
        const size_t row0 = (size_t)b * SEQ + (size_t)c * 128;
        ssd_tables_compute(F, g, d0, d1);
        ssd_copy_store(F, g, raw);
        __syncthreads();
        if (it + F.G < NIT) { const int it2 = it + F.G, g2 = it2 & 7, c2 = (it2 >> 3) & (NCHUNK - 1), b2 = it2 >> 7; const size_t row2 = (size_t)b2 * SEQ + (size_t)c2 * 128;
            ssd_copy_load(F, row2, g2, raw); ssd_tables_load(F, row2, g2, d0, d1); }
        bf16x8 cf[4];
#pragma unroll
        for (int ks = 0; ks < 4; ++ks) cf[ks] = *(const LAS bf16x8*)(F.lds + cfo[ks]);
        bf16_t* const zp = ZY + (row0 + q0 + ql) * DI + g * 256 + 4 * gq;
        const LAS float* const acs_l = acs + 16 * gq; const LAS float* const dtl_l = dtl + 16 * gq;
        f32x4 acc[4][4];
        float aq[4];
#pragma unroll
        for (int r = 0; r < 4; ++r) { aq[r] = acs[(q0 + ql) * 4 + r];
#pragma unroll
            for (int pf = 0; pf < 4; ++pf) acc[r][pf] = (f32x4){0.f, 0.f, 0.f, 0.f}; }
#pragma unroll
        for (int ks = 0; ks < 4; ++ks) if (2 * ks <= w) {
            f32x4 cb[2];
#pragma unroll
            for (int hf = 0; hf < 2; ++hf) { cb[hf] = (f32x4){0.f, 0.f, 0.f, 0.f};
                if (2 * ks + hf <= w) {
#pragma unroll
                    for (int kn = 0; kn < 4; ++kn) { const bf16x8 bfr = *(const LAS bf16x8*)(F.lds + bbo[kn] + 4096 * (2 * ks + hf)); cb[hf] = __builtin_amdgcn_mfma_f32_16x16x32_bf16(bfr, cf[kn], cb[hf], 0, 0, 0); } } }
#pragma unroll
            for (int r = 0; r < 4; ++r) {
                const float Dh = *(const GAS float*)(F.in[I_DSKIP] + g * HPG + r);
                float v[8];
#pragma unroll
                for (int hf = 0; hf < 2; ++hf) { const int sf = 2 * ks + hf;
#pragma unroll
                    for (int rg = 0; rg < 4; ++rg) { const int sl = 4 * gq + rg;
                        float val = 0.f;
                        if (sf <= w) { const float as = acs_l[64 * sf + 4 * rg + r], d = dtl_l[64 * sf + 4 * rg + r];
                            val = cb[hf][rg] * __expf(aq[r] - as) * d;
                            if (sf == w) { if (sl > ql) val = 0.f; else if (sl == ql) val += Dh; } }
                        v[4 * hf + rg] = val; } }
                u32x4 pk; pk.x = cvt_pk_bf16(v[0], v[1]); pk.y = cvt_pk_bf16(v[2], v[3]); pk.z = cvt_pk_bf16(v[4], v[5]); pk.w = cvt_pk_bf16(v[6], v[7]);
                const bf16x8 wf = __builtin_bit_cast(bf16x8, pk);
#pragma unroll
                for (int pf = 0; pf < 4; ++pf) {
                    const LAS unsigned char* const xb = F.lds + xbo[r & 1][pf] + (r >> 1) * 32768 + 8192 * ks;
                    const bf16x8 xf = tr_pair(xb, xb + 4096);
                    acc[r][pf] = __builtin_amdgcn_mfma_f32_16x16x32_bf16(xf, wf, acc[r][pf], 0, 0, 0); }
            }
        }
        u32x4 hreg[8];
        if (c > 0) {
            const u32x4* hsrc = (const u32x4*)(HP + ((((size_t)b * NCHUNK + c) * NH + g * HPG) * HD) * DSTATE) + F.tid;
#pragma unroll
            for (int i = 0; i < 8; ++i) hreg[i] = *(const GAS u32x4*)(hsrc + 512 * i);
        }
        if (c > 0) {
            __syncthreads();
#pragma unroll
            for (int i = 0; i < 8; ++i) { const int e = F.tid + 512 * i, hr_ = e >> 10, p_ = (e >> 4) & 63, ch_ = e & 15;
                *(LAS u32x4*)(F.lds + IMG_X + hr_ * 16384 + img_off<false>(p_, ch_)) = hreg[i]; }
            __syncthreads();
#pragma unroll
            for (int r = 0; r < 4; ++r) { const float eaq = __expf(aq[r]);
#pragma unroll
                for (int pf = 0; pf < 4; ++pf) { f32x4 yo = (f32x4){0.f, 0.f, 0.f, 0.f};
#pragma unroll
                    for (int ks = 0; ks < 4; ++ks) { const bf16x8 hf_ = *(const LAS bf16x8*)(F.lds + IMG_X + r * 16384 + hbo[ks] + 4096 * pf); yo = __builtin_amdgcn_mfma_f32_16x16x32_bf16(hf_, cf[ks], yo, 0, 0, 0); }
                    acc[r][pf] += yo * eaq; } }
        }
        float ssum = 0.f;
#pragma unroll
        for (int r = 0; r < 4; ++r)
#pragma unroll
            for (int pf = 0; pf < 4; ++pf) {
                const u32x2 zz = *(const GAS u32x2*)(zp + r * 64 + 16 * pf);
                const f32x4 y = acc[r][pf] * (f32x4){bflo(zz.x), bfhi(zz.x), bflo(zz.y), bfhi(zz.y)};
                acc[r][pf] = y; ssum += (y[0] * y[0] + y[1] * y[1]) + (y[2] * y[2] + y[3] * y[3]); }
        ssum += __shfl_xor(ssum, 16); ssum += __shfl_xor(ssum, 32);
        const float rsn = __builtin_amdgcn_rsqf(ssum * (1.0f / 256.0f) + EPS);
#pragma unroll
        for (int r = 0; r < 4; ++r)
#pragma unroll
            for (int pf = 0; pf < 4; ++pf) { u32x2 o; o.x = cvt_pk_bf16(acc[r][pf][0] * rsn, acc[r][pf][1] * rsn); o.y = cvt_pk_bf16(acc[r][pf][2] * rsn, acc[r][pf][3] * rsn);
                *(GAS u32x2*)(zp + r * 64 + 16 * pf) = o; }
        __syncthreads();
    }
}


__device__ __forceinline__ void ssd_conv_store_local(Frame& F, size_t row0, int g, const u32x4 (&raw)[19]) {
    const ConvMap m = ssd_conv_map(F.tid, g);
    bf16_t* const XBC = (bf16_t*)(F.ws + WS_XBC);
    const float* const convw = F.in[I_CONVW]; const float* const convb = F.in[I_CONVB];
    float cw[4][8], cb[8];
#pragma unroll
    for (int k = 0; k < 4; ++k) { const f32x4 a = *(const GAS f32x4*)(convw + (size_t)k * CD + m.gch), b_ = *(const GAS f32x4*)(convw + (size_t)k * CD + m.gch + 4);
        cw[k][0] = a.x; cw[k][1] = a.y; cw[k][2] = a.z; cw[k][3] = a.w; cw[k][4] = b_.x; cw[k][5] = b_.y; cw[k][6] = b_.z; cw[k][7] = b_.w; }
    { const f32x4 a = *(const GAS f32x4*)(convb + m.gch), b_ = *(const GAS f32x4*)(convb + m.gch + 4); cb[0] = a.x; cb[1] = a.y; cb[2] = a.z; cb[3] = a.w; cb[4] = b_.x; cb[5] = b_.y; cb[6] = b_.z; cb[7] = b_.w; }
    LAS unsigned char* const img = F.lds + (m.kind == 0 ? IMG_X + (m.cc >> 4) * 32768 : (m.kind == 1 ? IMG_B : IMG_C));
    const int chl = m.cc & 15;
#pragma unroll
    for (int i = 0; i < 16; ++i) {
        const int s = 16 * m.run + i;
        float o[8];
#pragma unroll
        for (int j2 = 0; j2 < 4; ++j2) {
            const unsigned w0 = raw[i][j2], w1 = raw[i + 1][j2], w2 = raw[i + 2][j2], w3 = raw[i + 3][j2];
            const float lo = cb[2 * j2] + cw[0][2 * j2] * bflo(w0) + cw[1][2 * j2] * bflo(w1) + cw[2][2 * j2] * bflo(w2) + cw[3][2 * j2] * bflo(w3);
            const float hi = cb[2 * j2 + 1] + cw[0][2 * j2 + 1] * bfhi(w0) + cw[1][2 * j2 + 1] * bfhi(w1) + cw[2][2 * j2 + 1] * bfhi(w2) + cw[3][2 * j2 + 1] * bfhi(w3);
            o[2 * j2] = silu_f(lo); o[2 * j2 + 1] = silu_f(hi);
        }
        u32x4 pk; pk.x = cvt_pk_bf16(o[0], o[1]); pk.y = cvt_pk_bf16(o[2], o[3]); pk.z = cvt_pk_bf16(o[4], o[5]); pk.w = cvt_pk_bf16(o[6], o[7]);
        if (m.kind == 2) *(GAS u32x4*)(XBC + (row0 + s) * CD + m.gch) = pk;
        *(LAS u32x4*)(img + (m.kind == 0 ? img_off<true>(s, chl) : img_off<false>(s, chl))) = pk;
    }
}
__device__ __forceinline__ void ssd_local_phase(Frame& F) {
    bf16_t* const XBC = (bf16_t*)(F.ws + WS_XBC); bf16_t* const ST = (bf16_t*)(F.ws + WS_HPREV); float* const CDEC = (float*)(F.ws + WS_CDEC); float* const EAQ = (float*)(F.ws + WS_EAQ);
    const int w = F.wave, lane = F.lane, q0 = 16 * w, hr = w >> 1, nh = w & 1;
    const LAS float* const acs = (const LAS float*)(F.lds + TAB_ACS); const LAS float* const dtl = (const LAS float*)(F.lds + TAB_DT); const LAS float* const sdec = (const LAS float*)(F.lds + TAB_SD);
    u32x4 raw[19]; float d0 = 0.f, d1 = 0.f;
    constexpr int NIT = BATCH * NCHUNK * NG;
    if (F.vcu < NIT) { const int it = F.vcu, g = it & 7, c = (it >> 3) & (NCHUNK - 1), b = it >> 7; const size_t row0 = (size_t)b * SEQ + (size_t)c * 128;
        ssd_conv_load(F, row0, b, c, g, raw); ssd_tables_load(F, row0, g, d0, d1); }
    for (int it = F.vcu; it < NIT; it += F.G) {
        const int g = it & 7, c = (it >> 3) & (NCHUNK - 1), b = it >> 7;
        const size_t row0 = (size_t)b * SEQ + (size_t)c * 128;
        asm volatile("s_waitcnt vmcnt(0)" ::: "memory");
        ssd_tables_compute(F, g, d0, d1);
        ssd_conv_store_local(F, row0, g, raw);
        __syncthreads();
        int lane_ = lane; asm volatile("" : "+v"(lane_));
        const int ql = lane_ & 15, gq = lane_ >> 4, qq = ql >> 2, pp = ql & 3;
        int cfo[4], bbo[4], xbo[2][4], sbo[4];
#pragma unroll
        for (int ks = 0; ks < 4; ++ks) { cfo[ks] = IMG_C + img_off<false>(q0 + ql, 4 * ks + gq); bbo[ks] = IMG_B + img_off<false>(ql, 4 * ks + gq); }
#pragma unroll
        for (int rr = 0; rr < 2; ++rr)
#pragma unroll
                for (int pf = 0; pf < 4; ++pf) xbo[rr][pf] = IMG_X + img_off<true>(4 * gq + qq, 8 * rr + 2 * pf + (pp >> 1)) + 8 * (pp & 1);
#pragma unroll
        for (int nf = 0; nf < 4; ++nf) { const int col = 64 * nh + 16 * nf + 4 * pp; sbo[nf] = IMG_B + img_off<false>(4 * gq + qq, col >> 3) + 2 * (col & 7); }
        {
            bf16x8 cf[4];
#pragma unroll
            for (int ks = 0; ks < 4; ++ks) cf[ks] = *(const LAS bf16x8*)(F.lds + cfo[ks]);
            const LAS float* const acs_l = acs + 16 * gq; const LAS float* const dtl_l = dtl + 16 * gq;
            f32x4 acc[4][4]; float aq[4];
#pragma unroll
            for (int r = 0; r < 4; ++r) { aq[r] = acs[(q0 + ql) * 4 + r];
#pragma unroll
                for (int pf = 0; pf < 4; ++pf) acc[r][pf] = (f32x4){0.f, 0.f, 0.f, 0.f}; }
#pragma unroll
            for (int ks = 0; ks < 4; ++ks) if (2 * ks <= w) {
                f32x4 cb[2];
#pragma unroll
                for (int hf = 0; hf < 2; ++hf) { cb[hf] = (f32x4){0.f, 0.f, 0.f, 0.f};
                    if (2 * ks + hf <= w) {
#pragma unroll
                        for (int kn = 0; kn < 4; ++kn) { const bf16x8 bfr = *(const LAS bf16x8*)(F.lds + bbo[kn] + 4096 * (2 * ks + hf)); cb[hf] = __builtin_amdgcn_mfma_f32_16x16x32_bf16(bfr, cf[kn], cb[hf], 0, 0, 0); } } }
#pragma unroll
                for (int r = 0; r < 4; ++r) {
                    const float Dh = *(const GAS float*)(F.in[I_DSKIP] + g * HPG + r);
                    float v[8];
#pragma unroll
                    for (int hf = 0; hf < 2; ++hf) { const int sf = 2 * ks + hf;
#pragma unroll
                        for (int rg = 0; rg < 4; ++rg) { const int sl = 4 * gq + rg;
                            float val = 0.f;
                            if (sf <= w) { const float as = acs_l[64 * sf + 4 * rg + r], d = dtl_l[64 * sf + 4 * rg + r];
                                val = cb[hf][rg] * __expf(aq[r] - as) * d;
                                if (sf == w) { if (sl > ql) val = 0.f; else if (sl == ql) val += Dh; } }
                            v[4 * hf + rg] = val; } }
                    u32x4 pk; pk.x = cvt_pk_bf16(v[0], v[1]); pk.y = cvt_pk_bf16(v[2], v[3]); pk.z = cvt_pk_bf16(v[4], v[5]); pk.w = cvt_pk_bf16(v[6], v[7]);
                    const bf16x8 wf = __builtin_bit_cast(bf16x8, pk);
#pragma unroll
                    for (int pf = 0; pf < 4; ++pf) {
                        const LAS unsigned char* const xb = F.lds + xbo[r & 1][pf] + (r >> 1) * 32768 + 8192 * ks;
                        const bf16x8 xf = tr_pair(xb, xb + 4096);
                        acc[r][pf] = __builtin_amdgcn_mfma_f32_16x16x32_bf16(xf, wf, acc[r][pf], 0, 0, 0); }
                }
            }
            bf16_t* const yp = XBC + (row0 + q0 + ql) * CD + g * 256 + 4 * gq;
#pragma unroll
            for (int r = 0; r < 4; ++r)
#pragma unroll
                for (int pf = 0; pf < 4; ++pf) { u32x2 o; o.x = cvt_pk_bf16(acc[r][pf][0], acc[r][pf][1]); o.y = cvt_pk_bf16(acc[r][pf][2], acc[r][pf][3]); *(GAS u32x2*)(yp + r * 64 + 16 * pf) = o; }
            if (gq == 0) *(GAS f32x4*)(EAQ + (row0 + q0 + ql) * 32 + g * HPG) = (f32x4){__expf(aq[0]), __expf(aq[1]), __expf(aq[2]), __expf(aq[3])};
        }
        asm volatile("" ::: "memory"); __builtin_amdgcn_sched_barrier(0);
        if (it + F.G < NIT) { const int it2 = it + F.G, g2 = it2 & 7, c2 = (it2 >> 3) & (NCHUNK - 1), b2 = it2 >> 7; const size_t row2 = (size_t)b2 * SEQ + (size_t)c2 * 128;
            ssd_conv_load(F, row2, b2, c2, g2, raw); ssd_tables_load(F, row2, g2, d0, d1); }
        {
            const int head = g * HPG + hr;
            bf16_t* const stp = ST + ((((size_t)b * NCHUNK + c) * NH + head) * HD) * DSTATE;
#pragma unroll
            for (int nh2 = 0; nh2 < 2; ++nh2) {
                f32x4 acc[2][4];
#pragma unroll
                for (int i = 0; i < 2; ++i)
#pragma unroll
                    for (int j = 0; j < 4; ++j) acc[i][j] = (f32x4){0.f, 0.f, 0.f, 0.f};
#pragma unroll
                for (int ks = 0; ks < 4; ++ks) {
                    asm volatile("" ::: "memory");
                    float sd[8];
#pragma unroll
                    for (int j = 0; j < 8; ++j) sd[j] = sdec[(32 * ks + 16 * (j >> 2) + 4 * gq + (j & 3)) * 4 + hr];
                    bf16x8 af[2], xf[4];
#pragma unroll
                    for (int nf = 0; nf < 2; ++nf) { const LAS unsigned char* p = F.lds + sbo[2 * nh2 + nf] + 8192 * ks; af[nf] = tr_pair(p, p + 4096); }
#pragma unroll
                    for (int pf = 0; pf < 4; ++pf) { const LAS unsigned char* p = F.lds + xbo[hr & 1][pf] + (hr >> 1) * 32768 + 8192 * ks;
                        const u32x4 xr = __builtin_bit_cast(u32x4, tr_pair(p, p + 4096));
                        u32x4 xs; xs.x = cvt_pk_bf16(bflo(xr.x) * sd[0], bfhi(xr.x) * sd[1]); xs.y = cvt_pk_bf16(bflo(xr.y) * sd[2], bfhi(xr.y) * sd[3]);
                        xs.z = cvt_pk_bf16(bflo(xr.z) * sd[4], bfhi(xr.z) * sd[5]); xs.w = cvt_pk_bf16(bflo(xr.w) * sd[6], bfhi(xr.w) * sd[7]);
                        xf[pf] = __builtin_bit_cast(bf16x8, xs); }
#pragma unroll
                    for (int nf = 0; nf < 2; ++nf)
#pragma unroll
                        for (int pf = 0; pf < 4; ++pf) acc[nf][pf] = __builtin_amdgcn_mfma_f32_16x16x32_bf16(af[nf], xf[pf], acc[nf][pf], 0, 0, 0);
                }
#pragma unroll
                for (int pf = 0; pf < 4; ++pf)
#pragma unroll
                    for (int nf = 0; nf < 2; ++nf) { u32x2 o; o.x = cvt_pk_bf16(acc[nf][pf][0], acc[nf][pf][1]); o.y = cvt_pk_bf16(acc[nf][pf][2], acc[nf][pf][3]);
                        *(GAS u32x2*)(stp + (size_t)(16 * pf + ql) * DSTATE + 64 * nh + 32 * nh2 + 16 * nf + 4 * gq) = o; }
            }
            if (F.tid < 4) *(GAS float*)(CDEC + ((size_t)b * NCHUNK + c) * NH + g * HPG + F.tid) = __expf(acs[127 * 4 + F.tid]);
        }
        __syncthreads();
    }
}
__device__ __forceinline__ void ssd_final_phase(Frame& F) {
    const bf16_t* const XBC = (const bf16_t*)(F.ws + WS_XBC); const bf16_t* const HP = (const bf16_t*)(F.ws + WS_HPREV); bf16_t* const ZY = (bf16_t*)(F.ws + WS_Z); const float* const EAQ = (const float*)(F.ws + WS_EAQ);
    const int w = F.wave, lane = F.lane, ql = lane & 15, gq = lane >> 4, q0 = 16 * w;
    int cfo[4], hbo[4];
#pragma unroll
    for (int ks = 0; ks < 4; ++ks) { cfo[ks] = IMG_C + img_off<false>(q0 + ql, 4 * ks + gq); hbo[ks] = img_off<false>(ql, 4 * ks + gq); }
    u32x4 creg[4], hreg[8];
    constexpr int NIT = BATCH * NCHUNK * NG;
    auto loads = [&](int it) __attribute__((always_inline)) {
        const int g = it & 7, c = (it >> 3) & (NCHUNK - 1), b = it >> 7; const size_t row0 = (size_t)b * SEQ + (size_t)c * 128;
#pragma unroll
        for (int i = 0; i < 4; ++i) { const int e = F.tid + 512 * i; creg[i] = *(const GAS u32x4*)(XBC + (row0 + (e >> 4)) * CD + DI + NG * DSTATE + g * DSTATE + 8 * (e & 15)); }
        if (c > 0) { const u32x4* hsrc = (const u32x4*)(HP + ((((size_t)b * NCHUNK + c) * NH + g * HPG) * HD) * DSTATE) + F.tid;
#pragma unroll
            for (int i = 0; i < 8; ++i) hreg[i] = *(const GAS u32x4*)(hsrc + 512 * i); } };
    if (F.vcu < NIT) loads(F.vcu);
    for (int it = F.vcu; it < NIT; it += F.G) {
        const int g = it & 7, c = (it >> 3) & (NCHUNK - 1), b = it >> 7;
        const size_t row0 = (size_t)b * SEQ + (size_t)c * 128;
#pragma unroll
        for (int i = 0; i < 4; ++i) { const int e = F.tid + 512 * i; *(LAS u32x4*)(F.lds + IMG_C + img_off<false>(e >> 4, e & 15)) = creg[i]; }
        if (c > 0) {
#pragma unroll
            for (int i = 0; i < 8; ++i) { const int e = F.tid + 512 * i, hr_ = e >> 10, p_ = (e >> 4) & 63, ch_ = e & 15; *(LAS u32x4*)(F.lds + IMG_X + hr_ * 16384 + img_off<false>(p_, ch_)) = hreg[i]; } }
        __syncthreads();
        if (it + F.G < NIT) loads(it + F.G);
        bf16x8 cf[4];
#pragma unroll
        for (int ks = 0; ks < 4; ++ks) cf[ks] = *(const LAS bf16x8*)(F.lds + cfo[ks]);
        const size_t rowq = row0 + q0 + ql;
        bf16_t* const zp = ZY + rowq * DI + g * 256 + 4 * gq; const bf16_t* const yp = XBC + rowq * CD + g * 256 + 4 * gq;
        const f32x4 eaq = *(const GAS f32x4*)(EAQ + rowq * 32 + g * HPG);
        u32x2 zr[4][4], yr[4][4];
#pragma unroll
        for (int r = 0; r < 4; ++r)
#pragma unroll
            for (int pf = 0; pf < 4; ++pf) { zr[r][pf] = *(const GAS u32x2*)(zp + r * 64 + 16 * pf); yr[r][pf] = *(const GAS u32x2*)(yp + r * 64 + 16 * pf); }
        f32x4 acc[4][4]; float ssum = 0.f;
#pragma unroll
        for (int r = 0; r < 4; ++r)
#pragma unroll
            for (int pf = 0; pf < 4; ++pf) { f32x4 yo = (f32x4){0.f, 0.f, 0.f, 0.f};
                if (c > 0) {
#pragma unroll
                    for (int ks = 0; ks < 4; ++ks) { const bf16x8 hf_ = *(const LAS bf16x8*)(F.lds + IMG_X + r * 16384 + hbo[ks] + 4096 * pf); yo = __builtin_amdgcn_mfma_f32_16x16x32_bf16(hf_, cf[ks], yo, 0, 0, 0); } }
                const u32x2 zz = zr[r][pf], yy = yr[r][pf];
                const f32x4 y = ((f32x4){bflo(yy.x), bfhi(yy.x), bflo(yy.y), bfhi(yy.y)} + yo * eaq[r]) * (f32x4){bflo(zz.x), bfhi(zz.x), bflo(zz.y), bfhi(zz.y)};
                acc[r][pf] = y; ssum += (y[0] * y[0] + y[1] * y[1]) + (y[2] * y[2] + y[3] * y[3]); }
        ssum += __shfl_xor(ssum, 16); ssum += __shfl_xor(ssum, 32);
        const float rsn = __builtin_amdgcn_rsqf(ssum * (1.0f / 256.0f) + EPS);
#pragma unroll
        for (int r = 0; r < 4; ++r)
#pragma unroll
            for (int pf = 0; pf < 4; ++pf) { u32x2 o; o.x = cvt_pk_bf16(acc[r][pf][0] * rsn, acc[r][pf][1] * rsn); o.y = cvt_pk_bf16(acc[r][pf][2] * rsn, acc[r][pf][3] * rsn);
                *(GAS u32x2*)(zp + r * 64 + 16 * pf) = o; }
        __syncthreads();
    }
}

__device__ __forceinline__ void ssd_seq_phase(Frame& F) {
    const int r = F.wave & 3, nh = F.wave >> 2, lane = F.lane, idx = r * 64 + lane;
    LAS float* const bc = (LAS float*)F.lds;
    LAS float* const lxs = bc + 2048;
    LAS float* const yp = bc + 4096;
    LAS float* const ldt = bc + 8192; LAS float* const ssq = bc + 8192 + 32;
    const bf16_t* const XBC = (const bf16_t*)(F.ws + WS_XBC); const bf16_t* const Zs = (const bf16_t*)(F.ws + WS_Z); bf16_t* const YN = (bf16_t*)(F.ws + WS_Z);
    const float* const DT = (const float*)(F.ws + WS_DT);
    const float* const convw = F.in[I_CONVW]; const float* const convb = F.in[I_CONVB];
    for (int it = F.vcu; it < DECB * NG; it += F.G) {
        const int b = it >> 3, g = it & 7, head = g * HPG + r;
        const size_t row0 = (size_t)MP + (size_t)b * DECS;
        const int xch = g * 256 + idx;
        {
            const int ch = (nh == 0) ? ((idx < 128) ? (DI + g * DSTATE + idx) : (DI + NG * DSTATE + g * DSTATE + (idx - 128))) : xch;
            float cw[4];
#pragma unroll
            for (int k = 0; k < 4; ++k) cw[k] = *(const GAS float*)(convw + (size_t)k * CD + ch);
            const float cbv = *(const GAS float*)(convb + ch);
            const float* cs = F.in[I_CONV] + (size_t)b * 3 * CD;
            float x3 = *(const GAS float*)(cs + ch), x2 = *(const GAS float*)(cs + CD + ch), x1 = *(const GAS float*)(cs + 2 * CD + ch);
            LAS float* const dst = (nh == 0) ? bc : lxs;
#pragma unroll
            for (int j = 0; j < 8; ++j) {
                const float xr = bf2f(*(const GAS bf16_t*)(XBC + (row0 + j) * CD + ch));
                const float cx = cbv + cw[0] * x3 + cw[1] * x2 + cw[2] * x1 + cw[3] * xr; x3 = x2; x2 = x1; x1 = xr;
                dst[j * 256 + idx] = silu_f(cx);
            }
            if (nh == 1 && lane < 8) ldt[lane * 4 + r] = *(const GAS float*)(DT + (row0 + lane) * 32 + head);
        }
        __syncthreads();
        {
            const float Ah = -__expf(*(const GAS float*)(F.in[I_ALOG] + head));
            const int pg = lane >> 4, nc = lane & 15;
            f32x4 h[16];
            const float* const hin = F.in[I_SSM] + (((size_t)b * NH + head) * HD + 16 * pg) * DSTATE + 64 * nh + 4 * nc;
#pragma unroll
            for (int i = 0; i < 16; ++i) h[i] = *(const GAS f32x4*)(hin + (size_t)i * DSTATE);
            for (int j = 0; j < 8; ++j) {
                const float dtv = ldt[j * 4 + r], dA = __expf(dtv * Ah);
                const f32x4 Bv = *(const LAS f32x4*)(bc + j * 256 + 64 * nh + 4 * nc), Cv = *(const LAS f32x4*)(bc + j * 256 + 128 + 64 * nh + 4 * nc);
                float part[16];
#pragma unroll
                for (int i4 = 0; i4 < 4; ++i4) { const f32x4 xs4 = *(const LAS f32x4*)(lxs + j * 256 + r * 64 + 16 * pg + 4 * i4);
#pragma unroll
                    for (int k = 0; k < 4; ++k) { const int i = 4 * i4 + k; const float dx = dtv * xs4[k];
                        h[i] = h[i] * dA + Bv * dx;
                        part[i] = (Cv.x * h[i].x + Cv.y * h[i].y) + (Cv.z * h[i].z + Cv.w * h[i].w); } }
#pragma unroll
                for (int i = 0; i < 8; ++i) { const bool up = (nc & 8) != 0; const float keep = up ? part[i + 8] : part[i], send = up ? part[i] : part[i + 8]; part[i] = keep + __shfl_xor(send, 8); }
#pragma unroll
                for (int i = 0; i < 4; ++i) { const bool up = (nc & 4) != 0; const float keep = up ? part[i + 4] : part[i], send = up ? part[i] : part[i + 4]; part[i] = keep + __shfl_xor(send, 4); }
#pragma unroll
                for (int i = 0; i < 2; ++i) { const bool up = (nc & 2) != 0; const float keep = up ? part[i + 2] : part[i], send = up ? part[i] : part[i + 2]; part[i] = keep + __shfl_xor(send, 2); }
                { const bool up = (nc & 1) != 0; const float keep = up ? part[1] : part[0], send = up ? part[0] : part[1]; part[0] = keep + __shfl_xor(send, 1); }
                yp[(j * 2 + nh) * 256 + r * 64 + 16 * pg + nc] = part[0];
            }
            float* const hout = F.out + O_SSM_S + (((size_t)b * NH + head) * HD + 16 * pg) * DSTATE + 64 * nh + 4 * nc;
#pragma unroll
            for (int i = 0; i < 16; ++i) *(GAS f32x4*)(hout + (size_t)i * DSTATE) = h[i];
        }
        __syncthreads();
        float ygv[4];
        {
            const float Dh = *(const GAS float*)(F.in[I_DSKIP] + head);
#pragma unroll
            for (int jj = 0; jj < 4; ++jj) { const int j = 4 * nh + jj;
                const float y = (yp[(j * 2) * 256 + idx] + yp[(j * 2 + 1) * 256 + idx]) + Dh * lxs[j * 256 + idx];
                ygv[jj] = y * bf2f(*(const GAS bf16_t*)(Zs + (row0 + j) * DI + xch));
                const float ss = wave_sum(ygv[jj] * ygv[jj]);
                if (lane == 0) ssq[j * 4 + r] = ss; }
        }
        __syncthreads();
#pragma unroll
        for (int jj = 0; jj < 4; ++jj) { const int j = 4 * nh + jj;
            const f32x4 s4 = *(const LAS f32x4*)(ssq + j * 4);
            const float rsn = __builtin_amdgcn_rsqf(((s4.x + s4.y) + (s4.z + s4.w)) * (1.0f / 256.0f) + EPS);
            *(GAS bf16_t*)(YN + (row0 + j) * DI + xch) = (bf16_t)f2bf(ygv[jj] * rsn); }
        __syncthreads();
    }
}
template <int W> __device__ __forceinline__ void pool_run(const bf16_t* V, bf16_t* PO, int run, int cv) {
    const int row0 = run * 16, t0 = row0 & (SEQ - 1);
    u32x4 raw[16 + W - 1];
#pragma unroll
    for (int e = 0; e < 16 + W - 1; ++e) {
        const int dt_ = e - (W - 1);
        if (t0 + dt_ >= 0) raw[e] = *(const GAS u32x4*)(V + (size_t)(row0 + dt_) * PD + cv); else raw[e] = (u32x4){0u, 0u, 0u, 0u};
    }
    f32x4 s0 = (f32x4){0.f, 0.f, 0.f, 0.f}, s1 = s0;
#pragma unroll
    for (int e = 0; e < W - 1; ++e) { f32x4 x0, x1; pg8::unpack8(raw[e], x0, x1); s0 += x0; s1 += x1; }
#pragma unroll
    for (int i = 0; i < 16; ++i) {
        f32x4 c0, c1; pg8::unpack8(raw[i + W - 1], c0, c1);
        s0 += c0; s1 += c1;
        const int t = t0 + i; const float ic = 1.0f / (float)((t + 1 < W) ? t + 1 : W);
        const f32x4 o0 = s0 * ic - c0, o1 = s1 * ic - c1;
        u32x4 o; o.x = pk2(o0.x, o0.y); o.y = pk2(o0.z, o0.w); o.z = pk2(o1.x, o1.y); o.w = pk2(o1.z, o1.w);
        *(GAS u32x4*)(PO + (size_t)(row0 + i) * PD + cv) = o;
        f32x4 x0, x1; pg8::unpack8(raw[i], x0, x1); s0 -= x0; s1 -= x1;
    }
}
template <int W> __device__ __forceinline__ void pool_run_s(const bf16_t* V, bf16_t* PO, const float* sp, int b, int cv) {
    const size_t row0 = (size_t)MP + (size_t)b * DECS;
    f32x4 a0[8 + W - 1], a1[8 + W - 1];
#pragma unroll
    for (int e = 0; e < 8 + W - 1; ++e) { const int t = e - (W - 1);
        if (t >= 0) pg8::unpack8(*(const GAS u32x4*)(V + (row0 + t) * PD + cv), a0[e], a1[e]);
        else { const float* p = sp + ((size_t)b * PBUF + (PBUF + t)) * PD + cv; a0[e] = *(const GAS f32x4*)p; a1[e] = *(const GAS f32x4*)(p + 4); } }
    f32x4 s0 = (f32x4){0.f, 0.f, 0.f, 0.f}, s1 = s0;
#pragma unroll
    for (int e = 0; e < W - 1; ++e) { s0 += a0[e]; s1 += a1[e]; }
    const float ic = 1.0f / (float)W;
#pragma unroll
    for (int i = 0; i < 8; ++i) {
        s0 += a0[i + W - 1]; s1 += a1[i + W - 1];
        const f32x4 o0 = s0 * ic - a0[i + W - 1], o1 = s1 * ic - a1[i + W - 1];
        u32x4 o; o.x = pk2(o0.x, o0.y); o.y = pk2(o0.z, o0.w); o.z = pk2(o1.x, o1.y); o.w = pk2(o1.z, o1.w);
        *(GAS u32x4*)(PO + (row0 + i) * PD + cv) = o;
        s0 -= a0[i]; s1 -= a1[i];
    }
}
__device__ __forceinline__ void pool_phase(Frame& F) {
    const bf16_t* const V = (const bf16_t*)(F.ws + WS_V); bf16_t* const PO = (bf16_t*)(F.out + O_Y);
    const float* const sp = F.in[I_POOL];
    const int gt = F.vcu * NTHREADS + F.tid, NT = F.G * NTHREADS;
    for (int e = gt; e < (MP / 16) * 128; e += NT) {
        const int c32 = e & 31, rl = (e >> 5) & 1, grp = (e >> 6) & 3, run = (e >> 8) * 2 + rl, cv = (grp * 32 + c32) * 8;
        if (grp == 0) pool_run<2>(V, PO, run, cv); else if (grp == 1) pool_run<4>(V, PO, run, cv); else if (grp == 2) pool_run<8>(V, PO, run, cv); else pool_run<16>(V, PO, run, cv);
    }
    for (int e = gt; e < (MS / 8) * 128; e += NT) {
        const int c32 = e & 31, grp = (e >> 5) & 3, b = e >> 7, cv = (grp * 32 + c32) * 8;
        if (grp == 0) pool_run_s<2>(V, PO, sp, b, cv); else if (grp == 1) pool_run_s<4>(V, PO, sp, b, cv); else if (grp == 2) pool_run_s<8>(V, PO, sp, b, cv); else pool_run_s<16>(V, PO, sp, b, cv);
    }
    float* const ops = F.out + O_POOL_S;
    for (int e = gt; e < DECB * 7 * (PD / 4); e += NT) {
        const int c4 = e & 255, i = (e >> 8) % 7, b = (e >> 8) / 7;
        *(GAS f32x4*)(ops + ((size_t)b * PBUF + i) * PD + c4 * 4) = *(const GAS f32x4*)(sp + ((size_t)b * PBUF + 8 + i) * PD + c4 * 4);
    }
}
__device__ __forceinline__ void final_phase(Frame& F) {
    const int gw = F.vcu * NWAVES + F.wave, NGW = F.G * NWAVES, lane = F.lane;
    const float* const st = (const float*)(F.ws + WS_STATS_A); const float* const gf = F.in[I_NFINAL];
    f32x4 gv[4];
#pragma unroll
    for (int j = 0; j < 4; ++j) gv[j] = *((const GAS f32x4*)gf + lane + 64 * j);
    const bf16_t* const h4 = (const bf16_t*)(F.ws + WS_ACT);
    for (int m = gw; m < M; m += NGW) {
        const GAS f32x4* sp = (const GAS f32x4*)(st + (size_t)m * 16);
        const f32x4 a = sp[0], b = sp[1], c = sp[2], d = sp[3]; const f32x4 s = (a + b) + (c + d);
        const float rs = __builtin_amdgcn_rsqf(((s[0] + s[1]) + (s[2] + s[3])) * (1.0f / 1024.0f) + EPS);
        const GAS u32x2* hr = (const GAS u32x2*)(h4 + (size_t)m * DM) + lane;
        GAS f32x4* yr = (GAS f32x4*)(F.out + (size_t)m * DM) + lane;
#pragma unroll
        for (int j = 0; j < 4; ++j) { const u32x2 w = hr[64 * j]; yr[64 * j] = (f32x4){bflo(w.x), bfhi(w.x), bflo(w.y), bfhi(w.y)} * rs * gv[j]; }
    }
}

constexpr int NPHASES = 13;
struct Args { const float* in[30]; float* out; unsigned char* ws; int ph_lo, ph_hi, li, pad; };
__global__ void __launch_bounds__(NTHREADS, 2) mk_fwd(Args args) {
    extern __shared__ __attribute__((aligned(16))) unsigned char lds[];
    Frame F;
    F.lds = (LAS unsigned char*)lds;
    F.MISC = (volatile LAS unsigned*)(F.lds + MISC_OFF);
    F.tid = threadIdx.x; F.lane = F.tid & 63; F.wave = __builtin_amdgcn_readfirstlane(F.tid >> 6);
    F.G = gridDim.x; { const int bx = blockIdx.x; F.vcu = (F.G % 8 == 0) ? (bx % 8) * (F.G / 8) + bx / 8 : bx; }
    F.ws = args.ws; F.out = args.out; F.ctl = (gu32*)(args.ws + WS_CTL);
#pragma unroll
    for (int i = 0; i < 30; ++i) F.in[i] = args.in[i];
    for (int u = F.tid; u < (LDS_BYTES - LDSCTL_OFF) / 4; u += NTHREADS) ((LAS unsigned*)(F.lds + LDSCTL_OFF))[u] = 0u;
    __syncthreads();
    const int lo = args.ph_lo, hi = args.ph_hi;
    XcdBarrier bar; bar.bar = (unsigned*)(F.ctl + CW_BAR); bar.x = 0; bar.st = nullptr;
    if (hi - lo > 1) bar = xcd_barrier_post((unsigned*)(F.ctl + CW_BAR), F.MISC + 8);
#ifndef PHMASK
#define PHMASK 0x1fff
#endif
#define IN(k) (((PHMASK >> (k)) & 1) && lo <= (k) && (k) < hi)
#define SEAM(k) do { if (IN(k) && IN((k) + 1)) xcd_barrier(bar); } while (0)
#define PH_BEGIN(k) if (IN(k)) { auto body_ = [&]() __attribute__((always_inline))
#define PH_END(k) ; body_(); if ((REP_MASK >> (k)) & 1) { xcd_barrier(bar); body_(); } } SEAM(k);

    bf16_t* const XB = (bf16_t*)(F.ws + WS_XB); bf16_t* const HB = (bf16_t*)(F.ws + WS_HB); bf16_t* const ACT = (bf16_t*)(F.ws + WS_ACT);
    bf16_t* const Zb = (bf16_t*)(F.ws + WS_Z); bf16_t* const XBCb = (bf16_t*)(F.ws + WS_XBC); bf16_t* const Vb = (bf16_t*)(F.ws + WS_V); bf16_t* const GATES = (bf16_t*)(F.ws + WS_GATES);
    bf16_t* const POOLED = (bf16_t*)(F.out + O_Y); bf16_t* const MERGED = (bf16_t*)(F.ws + WS_MERGED); bf16_t* const Qb = (bf16_t*)(F.ws + WS_Q); bf16_t* const PB = (bf16_t*)(F.ws + WS_PB);
    float* const T1 = (float*)(F.ws + WS_T1); float* const stA = (float*)(F.ws + WS_STATS_A); float* const stB = (float*)(F.ws + WS_STATS_B); float* const DTb = (float*)(F.ws + WS_DT);
    float* const H = F.out + O_Y;
    pg8::StaticOrder S;

    PH_BEGIN(0) { p0_prologue(F); } PH_END(0)
    PH_BEGIN(1) {
        pg8::Gemm g{XB, (const bf16_t*)(F.ws + WS_WGU1), M, 2 * DFF, DM, DM, 0}; S.init(M, 2 * DFF, F.G, (int)blockIdx.x);
        pg8::Epi E{}; E.kind = pg8::EK_GU; E.stats_in = stA; E.obf = ACT; E.ldo = DFF;
        pg8::gemm_phase(F.lds, g, S, E);
        pg8::Gemm g2{(const bf16_t*)(F.ws + WS_WPOT), (const bf16_t*)(F.ws + WS_WGRP), DM, DM, 256, DM, 256}; S.init_tail(DM, DM, F.G, (int)blockIdx.x);
        pg8::Epi E2{}; E2.kind = pg8::EK_BF16; E2.obf = (bf16_t*)(F.ws + WS_W2); E2.ldo = DM;
        pg8::gemm_phase(F.lds, g2, S, E2);
    } PH_END(1)
    PH_BEGIN(2) {
        pg8::Gemm g{ACT, (const bf16_t*)(F.ws + WS_WD1), M, DM, DFF, DFF, 0}; S.init(MP, DM, F.G, (int)blockIdx.x);
        pg8::Epi E{}; E.kind = pg8::EK_RES; E.coef = 0.5f; E.res_p = F.in[I_XP]; E.res_s = F.in[I_XS]; E.obf = HB; E.stats_out = stB;
        pg8::gemm_phase(F.lds, g, S, E);
        pg8::gemm_small(F.lds, g, E, MP, MS, F.G, (int)blockIdx.x);
    } PH_END(2)
    PH_BEGIN(3) {
        pg8::Gemm g{HB, (const bf16_t*)(F.ws + WS_WIN), M, NIN, DM, DM, 0}; S.init(M, NIN, F.G, (int)blockIdx.x);
        pg8::Epi E{}; E.kind = pg8::EK_WIN; E.stats_in = stB; E.Z = Zb; E.XBC = XBCb; E.V = Vb; E.GATES = GATES; E.HALO = (bf16_t*)(F.ws + WS_HALO); E.DT = DTb; E.dt_bias = F.in[I_DTB];
        E.conv_p = F.out + O_CONV_P; E.conv_s = F.out + O_CONV_S; E.pool_p = F.out + O_POOL_P; E.pool_s = F.out + O_POOL_S;
        pg8::gemm_phase(F.lds, g, S, E);
    } PH_END(3)
    PH_BEGIN(4) { ssd_local_phase(F); pool_phase(F); } PH_END(4)
    PH_BEGIN(5) { ssd_scan_phase(F);

        pg8::Gemm g{PB, (const bf16_t*)(F.ws + WS_WPLE), M, DM, PLE, PLE, 0}; S.init(MP, DM, F.G, (int)blockIdx.x);
        pg8::Epi E{}; E.kind = pg8::EK_BF16; E.obf = Qb; E.ldo = DM;
        pg8::gemm_phase(F.lds, g, S, E);
        pg8::gemm_small(F.lds, g, E, MP, MS, F.G, (int)blockIdx.x);
        } PH_END(5)
    PH_BEGIN(6) { ssd_final_phase(F); ssd_seq_phase(F); } PH_END(6)
    PH_BEGIN(7) {
        pg8::Gemm2 g{Zb, (const bf16_t*)(F.ws + WS_WSSO), POOLED, (const bf16_t*)(F.ws + WS_W2), DI, DI, DM, DM, DM}; S.init(MP, DM, F.G, (int)blockIdx.x);
        pg8::gemm_phase2(F.lds, g, S, GATES, MERGED);
        pg8::gemm_small2(F.lds, g, GATES, MERGED, MP, MS, F.G, (int)blockIdx.x);
    } PH_END(7)
    PH_BEGIN(8) {
        pg8::Gemm g{MERGED, (const bf16_t*)(F.ws + WS_WO), M, DM, DM, DM, 0}; S.init(MP, DM, F.G, (int)blockIdx.x);
        pg8::Epi E{}; E.kind = pg8::EK_RES; E.coef = 1.0f; E.res_bf = HB; E.obf = HB; E.stats_out = stA;
        pg8::gemm_phase(F.lds, g, S, E);
        pg8::gemm_small(F.lds, g, E, MP, MS, F.G, (int)blockIdx.x);
    } PH_END(8)
    PH_BEGIN(9) {
        pg8::Gemm g{HB, (const bf16_t*)(F.ws + WS_WGU2), M, 2 * DFF, DM, DM, 0}; S.init(M, 2 * DFF, F.G, (int)blockIdx.x);
        pg8::Epi E{}; E.kind = pg8::EK_GU; E.stats_in = stA; E.obf = ACT; E.ldo = DFF;
        pg8::gemm_phase(F.lds, g, S, E);
    } PH_END(9)
    PH_BEGIN(10) {
        pg8::Gemm g{ACT, (const bf16_t*)(F.ws + WS_WD2), M, DM, DFF, DFF, 0}; S.init(MP, DM, F.G, (int)blockIdx.x);
        pg8::Epi E{}; E.kind = pg8::EK_RES; E.coef = 0.5f; E.res_bf = HB; E.obf = HB; E.stats_out = stB;
        pg8::gemm_phase(F.lds, g, S, E);
        pg8::gemm_small(F.lds, g, E, MP, MS, F.G, (int)blockIdx.x);
    } PH_END(10)
    PH_BEGIN(11) {
        pg8::Gemm g{HB, (const bf16_t*)(F.ws + WS_WPG), M, DM, DM, DM, 0}; S.init(MP, DM, F.G, (int)blockIdx.x);
        pg8::Epi E{}; E.kind = pg8::EK_PLE; E.stats_in = stB; E.q = Qb; E.res_bf = HB; E.obf = ACT; E.stats_out = stA;
        pg8::gemm_phase(F.lds, g, S, E);
        pg8::gemm_small(F.lds, g, E, MP, MS, F.G, (int)blockIdx.x);
    } PH_END(11)
    PH_BEGIN(12) { final_phase(F); } PH_END(12)
#undef IN
#undef SEAM
#undef PH_BEGIN
#undef PH_END
}

extern "C" void kernel_launch(void* const* d_in, const int* in_sizes, int n_in, void* d_out, int out_size, void* d_ws, size_t ws_size, hipStream_t stream) {
    static int grid = 0;
    if (grid == 0) {
        if (n_in != 30 || in_sizes[0] != MP * DM || (size_t)out_size != O_END || ws_size < WS_END) {
            fprintf(stderr, "kernel_launch: shape mismatch: n_in %d in0 %d out %d ws %zu (need %zu)\n", n_in, n_in > 0 ? in_sizes[0] : -1, out_size, ws_size, (size_t)WS_END); grid = -1; return; }
        int dev = 0, cus = 0, per_cu = 0;
        if (hipGetDevice(&dev) != hipSuccess || hipDeviceGetAttribute(&cus, hipDeviceAttributeMultiprocessorCount, dev) != hipSuccess) { grid = -1; return; }
        if (hipFuncSetAttribute((const void*)mk_fwd, hipFuncAttributeMaxDynamicSharedMemorySize, LDS_BYTES) != hipSuccess) { fprintf(stderr, "kernel_launch: hipFuncSetAttribute failed\n"); grid = -1; return; }
        if (hipOccupancyMaxActiveBlocksPerMultiprocessor(&per_cu, (const void*)mk_fwd, NTHREADS, LDS_BYTES) != hipSuccess || per_cu < 1)
            fprintf(stderr, "kernel_launch: occupancy query reports %d workgroups per CU\n", per_cu);
        (void)hipGetLastError();
        grid = cus;
    }
    if (grid < 0) return;
    if (hipMemsetAsync((char*)d_ws + WS_CTL, 0, CTL_ZERO_BYTES, stream) != hipSuccess) { fprintf(stderr, "kernel_launch: memset failed\n"); return; }
    Args a{};
    for (int i = 0; i < 30; ++i) a.in[i] = (const float*)d_in[i];
    a.out = (float*)d_out; a.ws = (unsigned char*)d_ws;
#if MK_MULTI_LAUNCH
    for (int ph = 0; ph < NPHASES; ++ph) { a.ph_lo = ph; a.ph_hi = ph + 1; a.li = ph;
        hipLaunchKernelGGL(mk_fwd, dim3(grid), dim3(NTHREADS), LDS_BYTES, stream, a); }
#else
    a.ph_lo = 0; a.ph_hi = NPHASES; a.li = 0;
    hipLaunchKernelGGL(mk_fwd, dim3(grid), dim3(NTHREADS), LDS_BYTES, stream, a);
#endif
}
```

```cpp
#include <hip/hip_runtime.h>
#include <cstdio>
#include <cstdint>

#define REP_MASK 0x0
#ifndef MK_MULTI_LAUNCH
#define MK_MULTI_LAUNCH 0
#endif

#define GAS __attribute__((address_space(1)))
#define LAS __attribute__((address_space(3)))
typedef unsigned short bf16_t;
typedef short bf16x8 __attribute__((ext_vector_type(8)));
typedef float f32x4 __attribute__((ext_vector_type(4)));
typedef float f32x2 __attribute__((ext_vector_type(2)));
typedef unsigned u32x4 __attribute__((ext_vector_type(4)));
typedef unsigned u32x2 __attribute__((ext_vector_type(2)));
typedef GAS unsigned gu32;

constexpr int DM = 1024, BATCH = 8, SEQ = 2048, DECB = 128, DECS = 8;
constexpr int MP = BATCH * SEQ, MS = DECB * DECS, M = MP + MS;
constexpr int DI = 2048, HD = 64, NH = 32, NG = 8, HPG = 4, DSTATE = 128, CD = 4096;
constexpr int PD = 1024, PBUF = 15, DFF = 2816, PLE = 256;
constexpr int IN_DIM = 9248, NIN = 9472;
constexpr float EPS = 1e-6f;
constexpr int NWAVES = 8, NTHREADS = 512;

constexpr size_t MiB = 1u << 20;
constexpr size_t WS_CTL = 0, CTL_ZERO_BYTES = 32768;
constexpr size_t WS_STATS_A = 2 * MiB, WS_STATS_B = 4 * MiB, WS_DT = 6 * MiB, WS_CDEC = 9 * MiB;
constexpr size_t WS_WGU1 = 10 * MiB, WS_WD1 = 21 * MiB, WS_WIN = 27 * MiB, WS_WSSO = 46 * MiB, WS_W2 = 50 * MiB, WS_WO = 52 * MiB,
                 WS_WGU2 = 54 * MiB, WS_WD2 = 65 * MiB, WS_WPG = 71 * MiB, WS_WPLE = 73 * MiB, WS_PB = 74 * MiB, WS_WPOT = 480 * MiB, WS_WGRP = 483 * MiB;
constexpr size_t WS_Z = 84 * MiB, WS_XBC = 152 * MiB, WS_V = 288 * MiB, WS_GATES = 322 * MiB, WS_HB = 390 * MiB, WS_HPREV = 424 * MiB, WS_HALO = 488 * MiB, WS_EAQ = 492 * MiB, WS_END = 495 * MiB;
constexpr size_t WS_ACT = WS_XBC, WS_T1 = WS_XBC, WS_MERGED = 220 * MiB, WS_Q = WS_V, WS_XB = WS_HB;
static_assert(WS_STATS_A + (size_t)M * 16 * 4 <= WS_STATS_B && WS_STATS_B + (size_t)M * 16 * 4 <= WS_DT && WS_DT + (size_t)M * 32 * 4 <= WS_WGU1, "ws map (small)");
static_assert(WS_WGU1 + (size_t)2 * DFF * DM * 2 <= WS_WD1 && WS_WD1 + (size_t)DM * DFF * 2 <= WS_WIN && WS_WIN + (size_t)NIN * DM * 2 <= WS_WSSO && WS_WSSO + (size_t)DM * DI * 2 <= WS_W2, "ws map (w1)");
static_assert(WS_WGU2 + (size_t)2 * DFF * DM * 2 <= WS_WD2 && WS_WD2 + (size_t)DM * DFF * 2 <= WS_WPG && WS_WPLE + (size_t)DM * PLE * 2 <= WS_PB && WS_PB + (size_t)M * PLE * 2 <= WS_Z, "ws map (w2)");
static_assert(WS_Z + (size_t)M * DI * 2 <= WS_XBC && WS_XBC + (size_t)M * CD * 2 <= WS_V && WS_V + (size_t)M * PD * 2 <= WS_GATES && WS_GATES + (size_t)M * 2 * DM * 2 <= WS_HB &&
              WS_HB + (size_t)M * DM * 2 <= WS_HPREV && WS_HPREV + (size_t)BATCH * 16 * NH * HD * DSTATE * 2 <= WS_END, "ws map (act)");
static_assert(WS_ACT + (size_t)M * DFF * 2 <= WS_V && WS_T1 + (size_t)M * DM * 4 <= WS_MERGED && WS_MERGED + (size_t)M * DM * 2 <= WS_V, "ws overlays");
constexpr int CW_BAR = 4096;

constexpr size_t O_Y = 0, O_SSM_P = (size_t)M * DM, O_CONV_P = O_SSM_P + (size_t)BATCH * NH * HD * DSTATE, O_POOL_P = O_CONV_P + (size_t)BATCH * 3 * CD,
                 O_SSM_S = O_POOL_P + (size_t)BATCH * PBUF * PD, O_CONV_S = O_SSM_S + (size_t)DECB * NH * HD * DSTATE, O_POOL_S = O_CONV_S + (size_t)DECB * 3 * CD,
                 O_END = O_POOL_S + (size_t)DECB * PBUF * PD;

constexpr int RING_BYTES = 131072, LDSCTL_OFF = RING_BYTES, MISC_OFF = LDSCTL_OFF + 320, LDS_BYTES = 147456;

#define RLX_AGENT __ATOMIC_RELAXED, __HIP_MEMORY_SCOPE_AGENT
#define LDS_WAIT() asm volatile("s_waitcnt lgkmcnt(0)" ::: "memory")
#define VM_WAIT() asm volatile("s_waitcnt vmcnt(0)" ::: "memory")

__device__ __forceinline__ unsigned f2bf(float f) { unsigned u = __builtin_bit_cast(unsigned, f); return (u + 0x7fffu + ((u >> 16) & 1u)) >> 16; }
__device__ __forceinline__ unsigned cvt_pk_bf16(float lo, float hi);
__device__ __forceinline__ unsigned pk2(float lo, float hi) { return cvt_pk_bf16(lo, hi); }
__device__ __forceinline__ float bf2f(unsigned b) { return __builtin_bit_cast(float, b << 16); }
__device__ __forceinline__ float bflo(unsigned w) { return __builtin_bit_cast(float, w << 16); }
__device__ __forceinline__ float bfhi(unsigned w) { return __builtin_bit_cast(float, w & 0xffff0000u); }
typedef __bf16 bf16x2_t __attribute__((ext_vector_type(2)));
__device__ __forceinline__ unsigned cvt_pk_bf16(float lo, float hi) { const bf16x2_t v = {(__bf16)lo, (__bf16)hi}; return __builtin_bit_cast(unsigned, v); }
__device__ __forceinline__ float sigm_f(float x) { return __builtin_amdgcn_rcpf(1.0f + __expf(-x)); }
__device__ __forceinline__ float silu_f(float x) { return x * __builtin_amdgcn_rcpf(1.0f + __expf(-x)); }
__device__ __forceinline__ float wave_sum(float v) {
#pragma unroll
    for (int o = 1; o < 64; o <<= 1) v += __shfl_xor(v, o);
    return v;
}

struct Frame {
    LAS unsigned char* lds;
    volatile LAS unsigned* MISC;
    gu32* ctl;
    int tid, lane, wave, vcu, G;
    unsigned char* ws;
    float* out;
    const float* in[30];
};
enum { I_XP = 0, I_XS, I_SSM, I_CONV, I_POOL, I_PP, I_PS, I_NFFN1, I_WGU1, I_WD1, I_NMIX, I_WIN, I_CONVW, I_CONVB, I_DTB, I_ALOG, I_DSKIP, I_NSSD, I_WSSO, I_WPGRP, I_PSCALE,
       I_WPOUT, I_WO, I_NFFN2, I_WGU2, I_WD2, I_NPLE, I_WPG, I_WPLE, I_NFINAL };

namespace pg8 {
constexpr int BM = 256, BK = 64, HALF = 128, HTB = HALF * BK * 2, STAGE_BYTES = 8 * HTB, NXCD = 8, WGM = 4;
__host__ __device__ __forceinline__ int lds_byte(int r, int c) { const int st = (r >> 4) * 2 + (c >> 5), rr = r & 15, cc = c & 31, ob = rr * 64 + cc * 2; return st * 1024 + (ob ^ (((ob >> 9) & 1) << 5)); }
__host__ __device__ __forceinline__ void stage_rc(int b, int& R, int& C) { const int st = b / 1024, sb = b % 1024, swz = sb ^ (((sb >> 9) & 1) << 5); R = (st >> 1) * 16 + swz / 64; C = (st & 1) * 32 + (swz % 64) / 2; }
__host__ __device__ __forceinline__ int perm32(int rho) { const int n = rho >> 4, i = rho & 15; return 8 * (i >> 2) + 4 * n + (i & 3); }
struct Unit { int pm, pn; };
struct Gemm { const bf16_t* A; const bf16_t* Bt; int M, N, K; int lda; int a_pn_step; };
struct StaticOrder {
    int nM, nN, nwg, G, c;
    __host__ __device__ void init(int M_, int N_, int G_, int c_) { nM = M_ / BM; nN = N_ / BM; nwg = nM * nN; G = G_; c = c_; }
    __host__ __device__ void init_tail(int M_, int N_, int G_, int c_) { init(M_, N_, G_, (G_ - 1) - c_); }
    __host__ __device__ bool next(int i, Unit& u) const {
        const long L = (long)i * G + c; if (L >= nwg) return false;
        int wgid = (int)L; { const int q = nwg / NXCD, r = nwg % NXCD, xcd = wgid % NXCD, off = wgid / NXCD; wgid = (xcd < r ? xcd * (q + 1) : r * (q + 1) + (xcd - r) * q) + off; }
        const int nig = WGM * nN, gid = wgid / nig, fm = gid * WGM, gsz = (nM - fm) < WGM ? (nM - fm) : WGM;
        u.pm = fm + ((wgid % nig) % gsz); u.pn = (wgid % nig) / gsz; return true;
    }
};

enum EpiKind { EK_GU = 1, EK_RES = 2, EK_WIN = 3, EK_T1 = 4, EK_MERGE = 5, EK_BF16 = 6, EK_PLE = 7 };
struct Epi {
    const float* stats_in;
    float* stats_out;
    bf16_t* obf;
    float* of32;
    const float* res_p; const float* res_s;
    const bf16_t* res_bf;
    const bf16_t* gates;
    const bf16_t* q;
    bf16_t *Z, *XBC, *V, *GATES, *HALO; float* DT; const float* dt_bias; float *conv_p, *conv_s, *pool_p, *pool_s;
    int kind; int ldo; float coef; int pad;
};

__device__ __forceinline__ u32x4 pack8(const f32x4 a, const f32x4 b) { u32x4 w; w.x = cvt_pk_bf16(a[0], a[1]); w.y = cvt_pk_bf16(a[2], a[3]); w.z = cvt_pk_bf16(b[0], b[1]); w.w = cvt_pk_bf16(b[2], b[3]); return w; }
__device__ __forceinline__ void unpack8(const u32x4 w, f32x4& a, f32x4& b) { a = (f32x4){bflo(w.x), bfhi(w.x), bflo(w.y), bfhi(w.y)}; b = (f32x4){bflo(w.z), bfhi(w.z), bflo(w.w), bfhi(w.w)}; }

__device__ __forceinline__ float row_rs(const float* stats, int row) {
    if (!stats) return 1.0f;
    const GAS f32x4* sp = (const GAS f32x4*)(stats + (size_t)row * 16);
    const f32x4 a = sp[0], b = sp[1], c = sp[2], d = sp[3]; const f32x4 s = (a + b) + (c + d);
    return __builtin_amdgcn_rsqf(((s[0] + s[1]) + (s[2] + s[3])) * (1.0f / 1024.0f) + EPS);
}
__device__ __forceinline__ float softplus_f(float x) { const float e = __expf(-fabsf(x)); const float l = (e < 0.01f) ? e * (1.0f - e * (0.5f - e * (1.0f / 3.0f))) : __logf(1.0f + e); return fmaxf(x, 0.f) + l; }

__device__ __forceinline__ void epilogue(const Epi& E, const f32x4 (&acc)[2][2][4][2], const Unit& u, int wr, int wc, int fr, int fq) {
    const int rowb = u.pm * BM + wr * 64 + fr;
    const int cin = wc * 32 + 8 * fq;
    if (E.kind == EK_GU) {
#pragma unroll
        for (int ai = 0; ai < 2; ++ai)
#pragma unroll
            for (int m = 0; m < 4; ++m) { const int row = rowb + ai * HALF + m * 16; const float r = row_rs(E.stats_in, row);
                const f32x4 g0 = acc[ai][0][m][0] * r, u0 = acc[ai][1][m][0] * r, g1 = acc[ai][0][m][1] * r, u1 = acc[ai][1][m][1] * r;
                const f32x4 o0 = (f32x4){silu_f(g0[0]) * u0[0], silu_f(g0[1]) * u0[1], silu_f(g0[2]) * u0[2], silu_f(g0[3]) * u0[3]};
                const f32x4 o1 = (f32x4){silu_f(g1[0]) * u1[0], silu_f(g1[1]) * u1[1], silu_f(g1[2]) * u1[2], silu_f(g1[3]) * u1[3]};
                *(GAS u32x4*)(E.obf + (size_t)row * E.ldo + u.pn * HALF + cin) = pack8(o0, o1); }
    } else if (E.kind == EK_RES) {
#pragma unroll
        for (int ai = 0; ai < 2; ++ai)
#pragma unroll
            for (int m = 0; m < 4; ++m) { const int row = rowb + ai * HALF + m * 16;
                float ss = 0.f;
#pragma unroll
                for (int bj = 0; bj < 2; ++bj) { const int col = u.pn * BM + bj * HALF + cin;
                    f32x4 r0, r1;
                    if (E.res_p) { const float* rp = (row < MP) ? E.res_p + (size_t)row * DM : E.res_s + (size_t)(row - MP) * DM; r0 = *(const GAS f32x4*)(rp + col); r1 = *(const GAS f32x4*)(rp + col + 4); }
                    else unpack8(*(const GAS u32x4*)(E.res_bf + (size_t)row * DM + col), r0, r1);
                    const f32x4 h0 = r0 + acc[ai][bj][m][0] * E.coef, h1 = r1 + acc[ai][bj][m][1] * E.coef;
                    *(GAS u32x4*)(E.obf + (size_t)row * DM + col) = pack8(h0, h1);
                    ss += (h0[0] * h0[0] + h0[1] * h0[1]) + (h0[2] * h0[2] + h0[3] * h0[3]) + (h1[0] * h1[0] + h1[1] * h1[1]) + (h1[2] * h1[2] + h1[3] * h1[3]); }
                ss += __shfl_xor(ss, 16); ss += __shfl_xor(ss, 32);
                if (fq == 0) *(GAS float*)(E.stats_out + (size_t)row * 16 + u.pn * 4 + wc) = ss; }
    } else if (E.kind == EK_WIN) {
        const int pn = u.pn;
        if (pn < 8) {
            const int colt = pn * BM + cin;
#pragma unroll
            for (int ai = 0; ai < 2; ++ai)
#pragma unroll
                for (int m = 0; m < 4; ++m) { const int row = rowb + ai * HALF + m * 16; const float r = row_rs(E.stats_in, row);
#pragma unroll
                    for (int bj = 0; bj < 2; ++bj) { f32x4 v0 = acc[ai][bj][m][0] * r, v1 = acc[ai][bj][m][1] * r;
#pragma unroll
                        for (int j = 0; j < 4; ++j) { v0[j] = silu_f(v0[j]); v1[j] = silu_f(v1[j]); }
                        *(GAS u32x4*)(E.Z + (size_t)row * DI + colt + bj * HALF) = pack8(v0, v1); } }
        } else if (pn >= 28 && pn < 36) {
            const int colt = (pn - 28) * BM + cin;
#pragma unroll
            for (int ai = 0; ai < 2; ++ai)
#pragma unroll
                for (int m = 0; m < 4; ++m) { const int row = rowb + ai * HALF + m * 16; const float r = row_rs(E.stats_in, row);
#pragma unroll
                    for (int bj = 0; bj < 2; ++bj) { f32x4 v0 = acc[ai][bj][m][0] * r, v1 = acc[ai][bj][m][1] * r;
#pragma unroll
                        for (int j = 0; j < 4; ++j) { v0[j] = sigm_f(v0[j]); v1[j] = sigm_f(v1[j]); }
                        *(GAS u32x4*)(E.GATES + (size_t)row * (2 * DM) + colt + bj * HALF) = pack8(v0, v1); } }
        } else if (pn < 28) {
            const bool isx = pn < 24; bf16_t* const O = isx ? E.XBC : E.V; const int ldo = isx ? CD : PD; const int colt = (isx ? pn - 8 : pn - 24) * BM + cin;
            const int keep = isx ? 3 : PBUF;
#pragma unroll
            for (int ai = 0; ai < 2; ++ai)
#pragma unroll
                for (int m = 0; m < 4; ++m) { const int row = rowb + ai * HALF + m * 16; const float r = row_rs(E.stats_in, row);
                    float* sp = nullptr;
                    if (row < MP) { const int sb = row >> 11, st = row & (SEQ - 1); if (st >= SEQ - keep) sp = (isx ? E.conv_p : E.pool_p) + ((size_t)sb * keep + (st - (SEQ - keep))) * ldo + colt; }
                    else { const int sb = (row - MP) >> 3, st = (row - MP) & 7; const int si = st - (DECS - keep); if (si >= 0) sp = (isx ? E.conv_s : E.pool_s) + ((size_t)sb * keep + si) * ldo + colt; }
                    bf16_t* hp = nullptr;
                    if (isx && row < MP) { const int st = row & (SEQ - 1), tm = st & 127; if (tm >= 125 && st < SEQ - 3) hp = E.HALO + ((((size_t)(row >> 11) * 16 + (st >> 7) + 1) * 3 + (tm - 125)) * CD) + colt; }
#pragma unroll
                    for (int bj = 0; bj < 2; ++bj) { const f32x4 v0 = acc[ai][bj][m][0] * r, v1 = acc[ai][bj][m][1] * r;
                        const u32x4 pk = pack8(v0, v1);
                        *(GAS u32x4*)(O + (size_t)row * ldo + colt + bj * HALF) = pk;
                        if (hp) *(GAS u32x4*)(hp + bj * HALF) = pk;
                        if (sp) { *(GAS f32x4*)(sp + bj * HALF) = v0; *(GAS f32x4*)(sp + bj * HALF + 4) = v1; } } }
        } else if (wc == 0) {
            const f32x4 b0 = *(const GAS f32x4*)(E.dt_bias + 8 * fq), b1 = *(const GAS f32x4*)(E.dt_bias + 8 * fq + 4);
#pragma unroll
            for (int ai = 0; ai < 2; ++ai)
#pragma unroll
                for (int m = 0; m < 4; ++m) { const int row = rowb + ai * HALF + m * 16; const float r = row_rs(E.stats_in, row);
                    f32x4 v0 = acc[ai][0][m][0] * r + b0, v1 = acc[ai][0][m][1] * r + b1;
#pragma unroll
                    for (int j = 0; j < 4; ++j) { v0[j] = softplus_f(v0[j]); v1[j] = softplus_f(v1[j]); }
                    *(GAS f32x4*)(E.DT + (size_t)row * 32 + 8 * fq) = v0; *(GAS f32x4*)(E.DT + (size_t)row * 32 + 8 * fq + 4) = v1; }
        }
    } else if (E.kind == EK_T1) {
#pragma unroll
        for (int ai = 0; ai < 2; ++ai)
#pragma unroll
            for (int m = 0; m < 4; ++m) { const int row = rowb + ai * HALF + m * 16;
#pragma unroll
                for (int bj = 0; bj < 2; ++bj) { const int col = u.pn * BM + bj * HALF + cin;
                    f32x4 g0, g1; unpack8(*(const GAS u32x4*)(E.gates + (size_t)row * (2 * DM) + col), g0, g1);
                    *(GAS u32x4*)(E.obf + (size_t)row * DM + col) = pack8(g0 * acc[ai][bj][m][0], g1 * acc[ai][bj][m][1]); } }
    } else if (E.kind == EK_MERGE) {
#pragma unroll
        for (int ai = 0; ai < 2; ++ai)
#pragma unroll
            for (int m = 0; m < 4; ++m) { const int row = rowb + ai * HALF + m * 16;
#pragma unroll
                for (int bj = 0; bj < 2; ++bj) { const int col = u.pn * BM + bj * HALF + cin;
                    f32x4 g0, g1; unpack8(*(const GAS u32x4*)(E.gates + (size_t)row * (2 * DM) + DM + col), g0, g1);
                    f32x4 t0, t1; unpack8(*(const GAS u32x4*)(E.res_bf + (size_t)row * DM + col), t0, t1);
                    *(GAS u32x4*)(E.obf + (size_t)row * DM + col) = pack8(t0 + g0 * acc[ai][bj][m][0], t1 + g1 * acc[ai][bj][m][1]); } }
    } else if (E.kind == EK_BF16) {
#pragma unroll
        for (int ai = 0; ai < 2; ++ai)
#pragma unroll
            for (int m = 0; m < 4; ++m) { const int row = rowb + ai * HALF + m * 16;
#pragma unroll
                for (int bj = 0; bj < 2; ++bj) { const int col = u.pn * BM + bj * HALF + cin;
                    *(GAS u32x4*)(E.obf + (size_t)row * E.ldo + col) = pack8(acc[ai][bj][m][0], acc[ai][bj][m][1]); } }
    } else if (E.kind == EK_PLE) {
#pragma unroll
        for (int ai = 0; ai < 2; ++ai)
#pragma unroll
            for (int m = 0; m < 4; ++m) { const int row = rowb + ai * HALF + m * 16; const float r = row_rs(E.stats_in, row);
                float ss = 0.f;
#pragma unroll
                for (int bj = 0; bj < 2; ++bj) { const int col = u.pn * BM + bj * HALF + cin;
                    f32x4 q0, q1; unpack8(*(const GAS u32x4*)(E.q + (size_t)row * DM + col), q0, q1);
                    f32x4 r0, r1; unpack8(*(const GAS u32x4*)(E.res_bf + (size_t)row * DM + col), r0, r1);
                    f32x4 h0, h1;
#pragma unroll
                    for (int j = 0; j < 4; ++j) { h0[j] = r0[j] + sigm_f(acc[ai][bj][m][0][j] * r) * q0[j]; h1[j] = r1[j] + sigm_f(acc[ai][bj][m][1][j] * r) * q1[j]; }
                    *(GAS u32x4*)(E.obf + (size_t)row * DM + col) = pack8(h0, h1);
                    ss += (h0[0] * h0[0] + h0[1] * h0[1]) + (h0[2] * h0[2] + h0[3] * h0[3]) + (h1[0] * h1[0] + h1[1] * h1[1]) + (h1[2] * h1[2] + h1[3] * h1[3]); }
                ss += __shfl_xor(ss, 16); ss += __shfl_xor(ss, 32);
                if (fq == 0) *(GAS float*)(E.stats_out + (size_t)row * 16 + u.pn * 4 + wc) = ss; }
    }
}


__device__ __forceinline__ void epi_seg(const Epi& E, int row, int col, f32x4 v0, f32x4 v1, int lane) {
    if (E.kind == EK_RES) {
        f32x4 r0, r1;
        if (E.res_p) { const float* rp = ((row < MP) ? E.res_p + (size_t)row * DM : E.res_s + (size_t)(row - MP) * DM) + col; r0 = *(const GAS f32x4*)rp; r1 = *(const GAS f32x4*)(rp + 4); }
        else unpack8(*(const GAS u32x4*)(E.res_bf + (size_t)row * DM + col), r0, r1);
        const f32x4 h0 = r0 + v0 * E.coef, h1 = r1 + v1 * E.coef;
        *(GAS u32x4*)(E.obf + (size_t)row * DM + col) = pack8(h0, h1);
        float ss = (h0[0] * h0[0] + h0[1] * h0[1]) + (h0[2] * h0[2] + h0[3] * h0[3]) + (h1[0] * h1[0] + h1[1] * h1[1]) + (h1[2] * h1[2] + h1[3] * h1[3]);
        ss += __shfl_xor(ss, 1); ss += __shfl_xor(ss, 2); ss += __shfl_xor(ss, 4);
        if ((lane & 7) == 0) *(GAS float*)(E.stats_out + (size_t)row * 16 + (col >> 6)) = ss;
    } else if (E.kind == EK_T1) {
        f32x4 g0, g1; unpack8(*(const GAS u32x4*)(E.gates + (size_t)row * (2 * DM) + col), g0, g1);
        *(GAS u32x4*)(E.obf + (size_t)row * DM + col) = pack8(g0 * v0, g1 * v1);
    } else if (E.kind == EK_MERGE) {
        f32x4 g0, g1; unpack8(*(const GAS u32x4*)(E.gates + (size_t)row * (2 * DM) + DM + col), g0, g1);
        f32x4 t0, t1; unpack8(*(const GAS u32x4*)(E.res_bf + (size_t)row * DM + col), t0, t1);
        *(GAS u32x4*)(E.obf + (size_t)row * DM + col) = pack8(t0 + g0 * v0, t1 + g1 * v1);
    } else if (E.kind == EK_BF16) {
        *(GAS u32x4*)(E.obf + (size_t)row * E.ldo + col) = pack8(v0, v1);
    } else if (E.kind == EK_PLE) {
        const float r = row_rs(E.stats_in, row);
        f32x4 q0, q1; unpack8(*(const GAS u32x4*)(E.q + (size_t)row * DM + col), q0, q1);
        f32x4 r0, r1; unpack8(*(const GAS u32x4*)(E.res_bf + (size_t)row * DM + col), r0, r1);
        f32x4 h0, h1;
#pragma unroll
        for (int j = 0; j < 4; ++j) { h0[j] = r0[j] + sigm_f(v0[j] * r) * q0[j]; h1[j] = r1[j] + sigm_f(v1[j] * r) * q1[j]; }
        *(GAS u32x4*)(E.obf + (size_t)row * DM + col) = pack8(h0, h1);
        float ss = (h0[0] * h0[0] + h0[1] * h0[1]) + (h0[2] * h0[2] + h0[3] * h0[3]) + (h1[0] * h1[0] + h1[1] * h1[1]) + (h1[2] * h1[2] + h1[3] * h1[3]);
        ss += __shfl_xor(ss, 1); ss += __shfl_xor(ss, 2); ss += __shfl_xor(ss, 4);
        if ((lane & 7) == 0) *(GAS float*)(E.stats_out + (size_t)row * 16 + (col >> 6)) = ss;
    }
}
__device__ __forceinline__ int sw_off(int row, int ch) { return 256 * row + 16 * (ch ^ (((row & 3) << 2) | ((row >> 2) & 3))); }
__device__ __forceinline__ void small_tile_sum(LAS unsigned char* lds, const bf16_t* A, int lda, const bf16_t* Bt, int K, int r0, int c0, f32x4& v0, f32x4& v1) {
    const int tid = threadIdx.x, wid = __builtin_amdgcn_readfirstlane(tid >> 6), lane = tid & 63, ql = lane & 15, gq = lane >> 4, mw = wid >> 1, nh = wid & 1;
    const int nst = K / 128;
    const char* src[4]; int dst[4];
#pragma unroll
    for (int i = 0; i < 4; ++i) { const int p = 4 * wid + i, isB = p >> 4, row = 4 * (p & 15) + (lane >> 4), cs = lane & 15, ch = cs ^ (((row & 3) << 2) | ((row >> 2) & 3));
        src[i] = isB ? (const char*)(Bt + (size_t)(c0 + (row & ~31) + perm32(row & 31)) * K + 8 * ch) : (const char*)(A + (size_t)(r0 + row) * lda + 8 * ch);
        dst[i] = isB * 16384 + 1024 * (p & 15); }
#define ST_ISSUE(st) do { _Pragma("unroll") for (int _i = 0; _i < 4; ++_i) \
        __builtin_amdgcn_global_load_lds((const unsigned*)(src[_i] + (size_t)(st) * 256), (LAS unsigned*)(lds + ((st) & 3) * 32768 + dst[_i]), 16, 0, 0); } while (0)
    f32x4 acc0 = (f32x4){0.f, 0.f, 0.f, 0.f}, acc1 = acc0;
    int aoff[4], boff0[4], boff1[4];
#pragma unroll
    for (int ks = 0; ks < 4; ++ks) { aoff[ks] = sw_off(16 * mw + ql, 4 * ks + gq); boff0[ks] = 16384 + sw_off(32 * nh + ql, 4 * ks + gq); boff1[ks] = 16384 + sw_off(32 * nh + 16 + ql, 4 * ks + gq); }
    ST_ISSUE(0); if (nst > 1) ST_ISSUE(1); if (nst > 2) ST_ISSUE(2);
    for (int t = 0; t < nst; ++t) {
        const int ahead = (nst - 1 - t) < 2 ? (nst - 1 - t) : 2;
        if (ahead == 2) asm volatile("s_waitcnt vmcnt(8)" ::: "memory"); else if (ahead == 1) asm volatile("s_waitcnt vmcnt(4)" ::: "memory"); else asm volatile("s_waitcnt vmcnt(0)" ::: "memory");
        __builtin_amdgcn_s_barrier(); asm volatile("" ::: "memory");
        if (t + 3 < nst) ST_ISSUE(t + 3);
        const LAS unsigned char* const sl = lds + (t & 3) * 32768;
#pragma unroll
        for (int ks = 0; ks < 4; ++ks) {
            const bf16x8 af = *(const LAS bf16x8*)(sl + aoff[ks]), b0 = *(const LAS bf16x8*)(sl + boff0[ks]), b1 = *(const LAS bf16x8*)(sl + boff1[ks]);
            acc0 = __builtin_amdgcn_mfma_f32_16x16x32_bf16(b0, af, acc0, 0, 0, 0); acc1 = __builtin_amdgcn_mfma_f32_16x16x32_bf16(b1, af, acc1, 0, 0, 0);
        }
        asm volatile("s_waitcnt lgkmcnt(0)" ::: "memory");
    }
#undef ST_ISSUE
    __syncthreads();
    LAS f32x4* const tile = (LAS f32x4*)lds;
    { const int row = 16 * mw + ql, chb = 8 * nh + 2 * gq; tile[row * 16 + (chb ^ (row & 15))] = acc0; tile[row * 16 + ((chb + 1) ^ (row & 15))] = acc1; }
    __syncthreads();
    const int rr = 8 * wid + (lane >> 3), ch0 = 2 * (lane & 7);
    v0 = tile[rr * 16 + (ch0 ^ (rr & 15))]; v1 = tile[rr * 16 + ((ch0 + 1) ^ (rr & 15))];
    __syncthreads();
}
__device__ __forceinline__ void gemm_small(LAS unsigned char* lds, const Gemm g, const Epi& E, int row_base, int nrows, int G, int c) {
    const int tid = threadIdx.x, wid = __builtin_amdgcn_readfirstlane(tid >> 6), lane = tid & 63;
    const int ntn = g.N / 64, ntiles = (nrows / 64) * ntn;
    for (int v = c; v < ntiles; v += G) {
        const int r0 = row_base + 64 * (v / ntn), c0 = 64 * (v % ntn);
        f32x4 v0, v1; small_tile_sum(lds, g.A, g.lda, g.Bt, g.K, r0, c0, v0, v1);
        epi_seg(E, r0 + 8 * wid + (lane >> 3), c0 + 8 * (lane & 7), v0, v1, lane);
    }
}
struct Gemm2 { const bf16_t* A1; const bf16_t* B1; const bf16_t* A2; const bf16_t* B2; int K1, lda1, K2, lda2, N; };
__device__ __forceinline__ void gemm_small2(LAS unsigned char* lds, const Gemm2 g, const bf16_t* gates, bf16_t* out, int row_base, int nrows, int G, int c) {
    const int tid = threadIdx.x, wid = __builtin_amdgcn_readfirstlane(tid >> 6), lane = tid & 63;
    const int ntn = g.N / 64, ntiles = (nrows / 64) * ntn;
    for (int v = c; v < ntiles; v += G) {
        const int r0 = row_base + 64 * (v / ntn), c0 = 64 * (v % ntn), row = r0 + 8 * wid + (lane >> 3), col = c0 + 8 * (lane & 7);
        f32x4 a0, a1, b0, b1;
        small_tile_sum(lds, g.A1, g.lda1, g.B1, g.K1, r0, c0, a0, a1);
        small_tile_sum(lds, g.A2, g.lda2, g.B2, g.K2, r0, c0, b0, b1);
        f32x4 g00, g01, g10, g11; unpack8(*(const GAS u32x4*)(gates + (size_t)row * (2 * DM) + col), g00, g01); unpack8(*(const GAS u32x4*)(gates + (size_t)row * (2 * DM) + DM + col), g10, g11);
        *(GAS u32x4*)(out + (size_t)row * DM + col) = pack8(g00 * a0 + g10 * b0, g01 * a1 + g11 * b1);
    }
}

__device__ __forceinline__ void gemm_phase(LAS unsigned char* lds, const Gemm g, const StaticOrder& S, const Epi& E) {
    const int tid = threadIdx.x, wid = __builtin_amdgcn_readfirstlane(tid >> 6), lane = tid & 63, wr = wid >> 2, wc = wid & 3, fr = lane & 15, fq = lane >> 4;
    const int K = g.K, nt = K / BK;
    unsigned voffA[2], voffB[2];
#pragma unroll
    for (int i = 0; i < 2; ++i) { int R, C; stage_rc(tid * 16 + i * 8192, R, C); const int Rb = (R & ~31) + perm32(R & 31);
        voffA[i] = (unsigned)(R * g.lda + C) * 2u; voffB[i] = (unsigned)(Rb * K + C) * 2u; }
    const size_t kstep = (size_t)(BK * 2);
    const size_t hstep = (size_t)HALF * K * 2, hstepA = (size_t)HALF * g.lda * 2;
    const size_t tstep = 2 * hstep, tstepA = 2 * hstepA, pnstepA = (size_t)g.a_pn_step * 2;
    const unsigned ldsw = (unsigned)wid * 1024u;
    const int aoff = lds_byte(wr * 64 + fr, fq * 8), boff = lds_byte(wc * 32 + fr, fq * 8);
#define PG8_SA(b, h) (((b) * 2 + (h)) * HTB)
#define PG8_SB(b, h) ((4 + (b) * 2 + (h)) * HTB)
#define PG8_STAGE(bufoff, gbase, voff) do { _Pragma("unroll") for (int _i = 0; _i < 2; ++_i) \
        __builtin_amdgcn_global_load_lds((const unsigned*)((const char*)(gbase) + (voff)[_i]), (LAS unsigned*)(lds + (bufoff) + ldsw + _i * 8192), 16, 0, 0); } while (0)
#define PG8_LDA(dst, b, h) do { _Pragma("unroll") for (int m = 0; m < 4; ++m) _Pragma("unroll") for (int k = 0; k < 2; ++k) dst[m][k] = *(const LAS bf16x8*)(lds + PG8_SA(b, h) + aoff + m * 2048 + k * 1024); } while (0)
#define PG8_LDB(dst, b, h) do { _Pragma("unroll") for (int n = 0; n < 2; ++n) _Pragma("unroll") for (int k = 0; k < 2; ++k) dst[n][k] = *(const LAS bf16x8*)(lds + PG8_SB(b, h) + boff + n * 2048 + k * 1024); } while (0)
#define PG8_MMA(ai, bj, At, Bt) do { __builtin_amdgcn_s_setprio(1); _Pragma("unroll") for (int m = 0; m < 4; ++m) _Pragma("unroll") for (int n = 0; n < 2; ++n) _Pragma("unroll") for (int k = 0; k < 2; ++k) \
        acc[ai][bj][m][n] = __builtin_amdgcn_mfma_f32_16x16x32_bf16(Bt[n][k], At[m][k], acc[ai][bj][m][n], 0, 0, 0); __builtin_amdgcn_s_setprio(0); } while (0)
#define PG8_WAIT_V(n) asm volatile("s_waitcnt vmcnt(" #n ")" ::: "memory")
#define PG8_WAIT_L(n) asm volatile("s_waitcnt lgkmcnt(" #n ")" ::: "memory")
#define PG8_BAR __builtin_amdgcn_s_barrier()
#define PG8_SCHED __builtin_amdgcn_sched_barrier(0)
    Unit cur, nxt; int ui = 0;
    if (!S.next(0, cur)) return;
    f32x4 acc[2][2][4][2];
#pragma unroll
    for (int a = 0; a < 2; ++a)
#pragma unroll
        for (int b = 0; b < 2; ++b)
#pragma unroll
            for (int m = 0; m < 4; ++m)
#pragma unroll
                for (int n = 0; n < 2; ++n) acc[a][b][m][n] = (f32x4){0.f, 0.f, 0.f, 0.f};
    bf16x8 At[4][2], B0[2][2], B1[2][2];
    const char* cA = (const char*)g.A + (size_t)cur.pm * tstepA + (size_t)cur.pn * pnstepA; const char* cB = (const char*)g.Bt + (size_t)cur.pn * tstep;
    PG8_STAGE(PG8_SB(0, 0), cB, voffB); PG8_STAGE(PG8_SB(0, 1), cB + hstep, voffB); PG8_STAGE(PG8_SA(0, 0), cA, voffA); PG8_STAGE(PG8_SA(0, 1), cA + hstepA, voffA);
    if (wr == 1) PG8_BAR;
    PG8_WAIT_V(2); PG8_BAR;
    PG8_STAGE(PG8_SB(1, 0), cB + kstep, voffB); PG8_STAGE(PG8_SA(1, 0), cA + kstep, voffA); PG8_STAGE(PG8_SB(1, 1), cB + hstep + kstep, voffB);
    PG8_WAIT_V(6); PG8_BAR;
    for (;;) {
        const bool has_next = S.next(ui + 1, nxt);
        const char* nA = has_next ? (const char*)g.A + (size_t)nxt.pm * tstepA + (size_t)nxt.pn * pnstepA : cA; const char* nB = has_next ? (const char*)g.Bt + (size_t)nxt.pn * tstep : cB;
        for (int t = 0; t < nt; t += 2) {
            const bool last = (t == nt - 2);
            const char* a1 = cA + (size_t)(t + 1) * kstep;
            const char* a2 = last ? nA : cA + (size_t)(t + 2) * kstep; const char* b2 = last ? nB : cB + (size_t)(t + 2) * kstep;
            const char* a3 = a2 + kstep; const char* b3 = b2 + kstep;
            PG8_LDB(B0, 0, 0); PG8_LDB(B1, 0, 1); PG8_SCHED; PG8_LDA(At, 0, 0); PG8_STAGE(PG8_SA(1, 1), a1 + hstepA, voffA);
            PG8_WAIT_V(8); PG8_WAIT_L(0); PG8_BAR; PG8_MMA(0, 0, At, B0); PG8_MMA(0, 1, At, B1); PG8_BAR; PG8_SCHED;
            PG8_LDA(At, 0, 1); PG8_STAGE(PG8_SB(0, 0), b2, voffB); PG8_STAGE(PG8_SB(0, 1), b2 + hstep, voffB); PG8_STAGE(PG8_SA(0, 0), a2, voffA);
            PG8_WAIT_V(8); PG8_WAIT_L(0); PG8_BAR; PG8_MMA(1, 0, At, B0); PG8_MMA(1, 1, At, B1); PG8_BAR; PG8_SCHED;
            PG8_LDB(B0, 1, 0); PG8_LDB(B1, 1, 1); PG8_SCHED; PG8_LDA(At, 1, 0); PG8_STAGE(PG8_SA(0, 1), a2 + hstepA, voffA);
            PG8_WAIT_V(8); PG8_WAIT_L(0); PG8_BAR; PG8_MMA(0, 0, At, B0); PG8_MMA(0, 1, At, B1); PG8_BAR; PG8_SCHED;
            PG8_LDA(At, 1, 1); PG8_STAGE(PG8_SB(1, 0), b3, voffB); PG8_STAGE(PG8_SB(1, 1), b3 + hstep, voffB); PG8_STAGE(PG8_SA(1, 0), a3, voffA);
            PG8_WAIT_V(8); PG8_WAIT_L(0); PG8_BAR; PG8_MMA(1, 0, At, B0); PG8_MMA(1, 1, At, B1); PG8_BAR; PG8_SCHED;
        }
        if (wr == 0) PG8_BAR;
        epilogue(E, acc, cur, wr, wc, fr, fq);
        if (!has_next) break;
#pragma unroll
        for (int a = 0; a < 2; ++a)
#pragma unroll
            for (int b = 0; b < 2; ++b)
#pragma unroll
                for (int m = 0; m < 4; ++m)
#pragma unroll
                    for (int n = 0; n < 2; ++n) acc[a][b][m][n] = (f32x4){0.f, 0.f, 0.f, 0.f};
        cur = nxt; cA = nA; cB = nB; ++ui;
        if (wr == 1) PG8_BAR;
    }
    PG8_WAIT_V(0);
    PG8_BAR;
#undef PG8_SA
#undef PG8_SB
#undef PG8_STAGE
#undef PG8_LDA
#undef PG8_LDB
#undef PG8_MMA
#undef PG8_WAIT_V
#undef PG8_WAIT_L
#undef PG8_BAR
#undef PG8_SCHED
}

__device__ __forceinline__ void gemm_phase2(LAS unsigned char* lds, const Gemm2 g, const StaticOrder& S, const bf16_t* gates, bf16_t* out) {
    const int tid = threadIdx.x, wid = __builtin_amdgcn_readfirstlane(tid >> 6), lane = tid & 63, wr = wid >> 2, wc = wid & 3, fr = lane & 15, fq = lane >> 4;
    const int nt1 = g.K1 / BK, nt = nt1 + g.K2 / BK;
    int sR[2], sRb[2], sC[2];
#pragma unroll
    for (int i = 0; i < 2; ++i) { int R, C; stage_rc(tid * 16 + i * 8192, R, C); sR[i] = R; sRb[i] = (R & ~31) + perm32(R & 31); sC[i] = C; }
    const size_t kstep = (size_t)(BK * 2);
    const size_t hB1 = (size_t)HALF * g.K1 * 2, hA1 = (size_t)HALF * g.lda1 * 2, hB2 = (size_t)HALF * g.K2 * 2, hA2 = (size_t)HALF * g.lda2 * 2;
    const unsigned ldsw = (unsigned)wid * 1024u;
    const int aoff = lds_byte(wr * 64 + fr, fq * 8), boff = lds_byte(wc * 32 + fr, fq * 8);
#define PG8_SA(b, h) (((b) * 2 + (h)) * HTB)
#define PG8_SB(b, h) ((4 + (b) * 2 + (h)) * HTB)
#define PG8_STAGE_T(bufoff, isA, h, T) do { const int T_ = (T); const bool nx_ = T_ >= nt; const int Tl_ = nx_ ? T_ - nt : T_; const bool s2_ = !nx_ && Tl_ >= nt1; \
        const char* base_ = (isA) ? (s2_ ? cA2 + (size_t)(Tl_ - nt1) * kstep + (h) * hA2 : (nx_ ? nA1 : cA1) + (size_t)Tl_ * kstep + (h) * hA1) \
                                  : (s2_ ? cB2 + (size_t)(Tl_ - nt1) * kstep + (h) * hB2 : (nx_ ? nB1 : cB1) + (size_t)Tl_ * kstep + (h) * hB1); \
        const int ld_ = (isA) ? (s2_ ? g.lda2 : g.lda1) : (s2_ ? g.K2 : g.K1); \
        _Pragma("unroll") for (int _i = 0; _i < 2; ++_i) { const unsigned vo_ = (unsigned)(((isA) ? sR[_i] : sRb[_i]) * ld_ + sC[_i]) * 2u; \
            __builtin_amdgcn_global_load_lds((const unsigned*)(base_ + vo_), (LAS unsigned*)(lds + (bufoff) + ldsw + _i * 8192), 16, 0, 0); } } while (0)
#define PG8_LDA(dst, b, h) do { _Pragma("unroll") for (int m = 0; m < 4; ++m) _Pragma("unroll") for (int k = 0; k < 2; ++k) dst[m][k] = *(const LAS bf16x8*)(lds + PG8_SA(b, h) + aoff + m * 2048 + k * 1024); } while (0)
#define PG8_LDB(dst, b, h) do { _Pragma("unroll") for (int n = 0; n < 2; ++n) _Pragma("unroll") for (int k = 0; k < 2; ++k) dst[n][k] = *(const LAS bf16x8*)(lds + PG8_SB(b, h) + boff + n * 2048 + k * 1024); } while (0)
#define PG8_MMA(ai, bj, At, Bt) do { __builtin_amdgcn_s_setprio(1); _Pragma("unroll") for (int m = 0; m < 4; ++m) _Pragma("unroll") for (int n = 0; n < 2; ++n) _Pragma("unroll") for (int k = 0; k < 2; ++k) \
        acc[ai][bj][m][n] = __builtin_amdgcn_mfma_f32_16x16x32_bf16(Bt[n][k], At[m][k], acc[ai][bj][m][n], 0, 0, 0); __builtin_amdgcn_s_setprio(0); } while (0)
#define PG8_WAIT_V(n) asm volatile("s_waitcnt vmcnt(" #n ")" ::: "memory")
#define PG8_WAIT_L(n) asm volatile("s_waitcnt lgkmcnt(" #n ")" ::: "memory")
#define PG8_BAR __builtin_amdgcn_s_barrier()
#define PG8_SCHED __builtin_amdgcn_sched_barrier(0)
    Unit cur, nxt; int ui = 0;
    if (!S.next(0, cur)) return;
    f32x4 acc[2][2][4][2];
#pragma unroll
    for (int a = 0; a < 2; ++a)
#pragma unroll
        for (int b = 0; b < 2; ++b)
#pragma unroll
            for (int m = 0; m < 4; ++m)
#pragma unroll
                for (int n = 0; n < 2; ++n) acc[a][b][m][n] = (f32x4){0.f, 0.f, 0.f, 0.f};
    bf16x8 At[4][2], B0[2][2], B1[2][2];
    const char* cA1 = (const char*)g.A1 + (size_t)cur.pm * 2 * hA1; const char* cB1 = (const char*)g.B1 + (size_t)cur.pn * 2 * hB1;
    const char* cA2 = (const char*)g.A2 + (size_t)cur.pm * 2 * hA2; const char* cB2 = (const char*)g.B2 + (size_t)cur.pn * 2 * hB2;
    const char* nA1 = cA1; const char* nB1 = cB1;
    PG8_STAGE_T(PG8_SB(0, 0), false, 0, 0); PG8_STAGE_T(PG8_SB(0, 1), false, 1, 0); PG8_STAGE_T(PG8_SA(0, 0), true, 0, 0); PG8_STAGE_T(PG8_SA(0, 1), true, 1, 0);
    if (wr == 1) PG8_BAR;
    PG8_WAIT_V(2); PG8_BAR;
    PG8_STAGE_T(PG8_SB(1, 0), false, 0, 1); PG8_STAGE_T(PG8_SA(1, 0), true, 0, 1); PG8_STAGE_T(PG8_SB(1, 1), false, 1, 1);
    PG8_WAIT_V(6); PG8_BAR;
    for (;;) {
        const bool has_next = S.next(ui + 1, nxt);
        nA1 = has_next ? (const char*)g.A1 + (size_t)nxt.pm * 2 * hA1 : cA1; nB1 = has_next ? (const char*)g.B1 + (size_t)nxt.pn * 2 * hB1 : cB1;
        const int rowb = cur.pm * BM + wr * 64 + fr, colb = cur.pn * BM + wc * 32 + 8 * fq;
        for (int t = 0; t < nt; t += 2) {
            if (t == nt1) {
#pragma unroll
                for (int ai = 0; ai < 2; ++ai)
#pragma unroll
                    for (int m = 0; m < 4; ++m) { const bf16_t* gp = gates + (size_t)(rowb + ai * HALF + m * 16) * (2 * DM) + colb;
#pragma unroll
                        for (int bj = 0; bj < 2; ++bj) { f32x4 g00, g01, g10, g11; unpack8(*(const GAS u32x4*)(gp + bj * HALF), g00, g01); unpack8(*(const GAS u32x4*)(gp + DM + bj * HALF), g10, g11);
#pragma unroll
                            for (int j = 0; j < 4; ++j) { acc[ai][bj][m][0][j] *= g00[j] * __builtin_amdgcn_rcpf(fmaxf(g10[j], 1e-6f)); acc[ai][bj][m][1][j] *= g01[j] * __builtin_amdgcn_rcpf(fmaxf(g11[j], 1e-6f)); } } }
            }
            PG8_LDB(B0, 0, 0); PG8_LDB(B1, 0, 1); PG8_SCHED; PG8_LDA(At, 0, 0); PG8_STAGE_T(PG8_SA(1, 1), true, 1, t + 1);
            PG8_WAIT_V(8); PG8_WAIT_L(0); PG8_BAR; PG8_MMA(0, 0, At, B0); PG8_MMA(0, 1, At, B1); PG8_BAR; PG8_SCHED;
            PG8_LDA(At, 0, 1); PG8_STAGE_T(PG8_SB(0, 0), false, 0, t + 2); PG8_STAGE_T(PG8_SB(0, 1), false, 1, t + 2); PG8_STAGE_T(PG8_SA(0, 0), true, 0, t + 2);
            PG8_WAIT_V(8); PG8_WAIT_L(0); PG8_BAR; PG8_MMA(1, 0, At, B0); PG8_MMA(1, 1, At, B1); PG8_BAR; PG8_SCHED;
            PG8_LDB(B0, 1, 0); PG8_LDB(B1, 1, 1); PG8_SCHED; PG8_LDA(At, 1, 0); PG8_STAGE_T(PG8_SA(0, 1), true, 1, t + 2);
            PG8_WAIT_V(8); PG8_WAIT_L(0); PG8_BAR; PG8_MMA(0, 0, At, B0); PG8_MMA(0, 1, At, B1); PG8_BAR; PG8_SCHED;
            PG8_LDA(At, 1, 1); PG8_STAGE_T(PG8_SB(1, 0), false, 0, t + 3); PG8_STAGE_T(PG8_SB(1, 1), false, 1, t + 3); PG8_STAGE_T(PG8_SA(1, 0), true, 0, t + 3);
            PG8_WAIT_V(8); PG8_WAIT_L(0); PG8_BAR; PG8_MMA(1, 0, At, B0); PG8_MMA(1, 1, At, B1); PG8_BAR; PG8_SCHED;
        }
        if (wr == 0) PG8_BAR;
#pragma unroll
        for (int ai = 0; ai < 2; ++ai)
#pragma unroll
            for (int m = 0; m < 4; ++m) { const size_t row = (size_t)(rowb + ai * HALF + m * 16);
#pragma unroll
                for (int bj = 0; bj < 2; ++bj) { f32x4 g10, g11; unpack8(*(const GAS u32x4*)(gates + row * (2 * DM) + DM + colb + bj * HALF), g10, g11);
#pragma unroll
                    for (int j = 0; j < 4; ++j) { g10[j] = fmaxf(g10[j], 1e-6f); g11[j] = fmaxf(g11[j], 1e-6f); }
                    *(GAS u32x4*)(out + row * DM + colb + bj * HALF) = pack8(acc[ai][bj][m][0] * g10, acc[ai][bj][m][1] * g11); } }
        if (!has_next) break;
#pragma unroll
        for (int a = 0; a < 2; ++a)
#pragma unroll
            for (int b = 0; b < 2; ++b)
#pragma unroll
                for (int m = 0; m < 4; ++m)
#pragma unroll
                    for (int n = 0; n < 2; ++n) acc[a][b][m][n] = (f32x4){0.f, 0.f, 0.f, 0.f};
        cur = nxt; cA1 = nA1; cB1 = nB1; cA2 = (const char*)g.A2 + (size_t)cur.pm * 2 * hA2; cB2 = (const char*)g.B2 + (size_t)cur.pn * 2 * hB2; ++ui;
        if (wr == 1) PG8_BAR;
    }
    PG8_WAIT_V(0);
    PG8_BAR;
#undef PG8_SA
#undef PG8_SB
#undef PG8_STAGE_T
#undef PG8_LDA
#undef PG8_LDB
#undef PG8_MMA
#undef PG8_WAIT_V
#undef PG8_WAIT_L
#undef PG8_BAR
#undef PG8_SCHED
}
}

#define XB_TMO      128
#define XB_XCNT(j)  (256  + 64 * (j))
#define XB_XSUB(j)  (1280 + 64 * (j))
#define XB_XGEN(j)  (2304 + 64 * (j))
#define XB_TOP      3328
#define XB_TOPGEN   3392
#define XCD_BAR_WORDS 3456
#define XB_SPIN_CAP (1u << 18)
__device__ __forceinline__ unsigned xb_ld(unsigned* p)              { return __hip_atomic_load(p, __ATOMIC_RELAXED, __HIP_MEMORY_SCOPE_AGENT); }
__device__ __forceinline__ unsigned xb_add(unsigned* p, unsigned v) { return __hip_atomic_fetch_add(p, v, __ATOMIC_RELAXED, __HIP_MEMORY_SCOPE_AGENT); }
__device__ __forceinline__ unsigned xb_xcc_id() { return (unsigned)__builtin_amdgcn_s_getreg((3 << 11) | 20) & 0xFu; }
#define XB_SPIN(cond, bar) do { unsigned _sp = 0; while (cond) { __builtin_amdgcn_s_sleep(1); \
    if ((++_sp & 255u) == 0u) { if (xb_ld(&(bar)[XB_TMO])) break; if (_sp > XB_SPIN_CAP) { atomicAdd(&(bar)[XB_TMO], 1u); break; } } } } while (0)
struct XcdBarrier { unsigned* bar; unsigned x; volatile LAS unsigned* st; };
__device__ __forceinline__ XcdBarrier xcd_barrier_post(unsigned* bar, volatile LAS unsigned* st) {
    XcdBarrier b; b.bar = bar; b.x = xb_xcc_id(); b.st = st;
    if (threadIdx.x == 0) (void)xb_add(&bar[XB_XCNT(b.x)], 1u);
    return b;
}
__device__ __forceinline__ void xcd_barrier_complete(unsigned* bar, unsigned x, unsigned& nloc, unsigned& nx) {
    const unsigned G = gridDim.x * gridDim.y * gridDim.z;
    unsigned sum, cnt, mine, sp = 0u;
    for (;;) {
        sum = 0u; cnt = 0u; mine = 0u;
#pragma unroll
        for (unsigned j = 0; j < 16; ++j) { const unsigned c = xb_ld(&bar[XB_XCNT(j)]); sum += c; cnt += (c > 0u) ? 1u : 0u; mine = (j == x) ? c : mine; }
        if (sum == G) break;
        __builtin_amdgcn_s_sleep(1);
        if ((++sp & 255u) == 0u) { if (xb_ld(&bar[XB_TMO])) break; if (sp > XB_SPIN_CAP) { atomicAdd(&bar[XB_TMO], 1u); break; } }
    }
    nloc = mine > 0u ? mine : 1u; nx = cnt > 0u ? cnt : 1u;
}
__device__ __forceinline__ void xcd_barrier(const XcdBarrier& b) {
    asm volatile("s_waitcnt vmcnt(0)" ::: "memory");
    __syncthreads();
    if (threadIdx.x == 0) {
        unsigned* bar = b.bar;
        __builtin_amdgcn_s_waitcnt(0);
        unsigned nloc = b.st[0], nx = b.st[1];
        if (nloc == 0u) { xcd_barrier_complete(bar, b.x, nloc, nx); b.st[0] = nloc; b.st[1] = nx; }
        const unsigned old = xb_add(&bar[XB_XSUB(b.x)], 1u);
        const unsigned gen = old / nloc;
        if (old + 1u == (gen + 1u) * nloc) {
            __builtin_amdgcn_fence(__ATOMIC_RELEASE, "agent");
            asm volatile("s_waitcnt vmcnt(0)" ::: "memory");
            const unsigned og = xb_add(&bar[XB_TOP], 1u);
            const unsigned tg = og / nx;
            if (og + 1u == (tg + 1u) * nx) xb_add(&bar[XB_TOPGEN], 1u);
            else XB_SPIN(xb_ld(&bar[XB_TOPGEN]) == tg, bar);
            __builtin_amdgcn_fence(__ATOMIC_ACQUIRE, "agent");
            xb_add(&bar[XB_XGEN(b.x)], 1u);
            asm volatile("s_waitcnt vmcnt(0)" ::: "memory");
        } else {
            XB_SPIN(xb_ld(&bar[XB_XGEN(b.x)]) == gen, bar);
            __builtin_amdgcn_fence(__ATOMIC_ACQUIRE, "agent");
            asm volatile("s_waitcnt vmcnt(0)" ::: "memory");
        }
    }
    __syncthreads();
}

__device__ __forceinline__ void p0_transpose_item(const float* W, int K, int N, const float* gain, bf16_t* WT, int k0, int n0, int drow0, LAS float* scr, int lane) {
#pragma unroll
    for (int i = 0; i < 8; ++i) { const int kk = 8 * i + (lane >> 3), nn = 4 * (lane & 7);
        f32x4 v = *(const GAS f32x4*)(W + (size_t)(k0 + kk) * N + n0 + nn);
        if (gain) v = v * *(const GAS float*)(gain + k0 + kk);
        scr[kk * 33 + nn] = v.x; scr[kk * 33 + nn + 1] = v.y; scr[kk * 33 + nn + 2] = v.z; scr[kk * 33 + nn + 3] = v.w; }
    LDS_WAIT(); asm volatile("" ::: "memory");
    const int c = lane & 7;
#pragma unroll
    for (int j = 0; j < 4; ++j) { const int n = (lane >> 3) + 8 * j; const LAS float* s = scr + (8 * c) * 33 + n;
        u32x4 o; o.x = pk2(s[0 * 33], s[1 * 33]); o.y = pk2(s[2 * 33], s[3 * 33]); o.z = pk2(s[4 * 33], s[5 * 33]); o.w = pk2(s[6 * 33], s[7 * 33]);
        *(GAS u32x4*)(WT + (size_t)(drow0 + n) * K + k0 + 8 * c) = o; }
    LDS_WAIT(); asm volatile("" ::: "memory");
}
__device__ __forceinline__ int map_gu(int n0) { return n0 < DFF ? (n0 / 128) * 256 + (n0 % 128) : ((n0 - DFF) / 128) * 256 + 128 + ((n0 - DFF) % 128); }
__device__ __forceinline__ int map_win(int n0) { return n0 < 6144 ? n0 : (n0 < 6176 ? 9216 + (n0 - 6144) : n0 - 32); }

__device__ __forceinline__ void p0_prologue(Frame& F) {
    LAS float* scr = (LAS float*)(F.lds + F.wave * 16384);
    const int gw = F.vcu * NWAVES + F.wave, NGW = F.G * NWAVES, lane = F.lane;
    bf16_t* const wgu1 = (bf16_t*)(F.ws + WS_WGU1); bf16_t* const wd1 = (bf16_t*)(F.ws + WS_WD1); bf16_t* const win = (bf16_t*)(F.ws + WS_WIN);
    bf16_t* const wsso = (bf16_t*)(F.ws + WS_WSSO); bf16_t* const wo = (bf16_t*)(F.ws + WS_WO); bf16_t* const wgu2 = (bf16_t*)(F.ws + WS_WGU2);
    bf16_t* const wd2 = (bf16_t*)(F.ws + WS_WD2); bf16_t* const wpg = (bf16_t*)(F.ws + WS_WPG); bf16_t* const wple = (bf16_t*)(F.ws + WS_WPLE);
    constexpr int I_GU = (DM / 64) * (2 * DFF / 32), I_D = (DFF / 64) * (DM / 32), I_IN = (DM / 64) * (IN_DIM / 32), I_SSO = (DI / 64) * (DM / 32), I_SQ = (DM / 64) * (DM / 32), I_PLE = (PLE / 64) * (DM / 32);
    constexpr int NITEMS = 2 * I_GU + 2 * I_D + I_IN + I_SSO + 3 * I_SQ + I_PLE;
    bf16_t* const wpot = (bf16_t*)(F.ws + WS_WPOT);
    for (int it = gw; it < NITEMS; it += NGW) {
        int r = it;
        if (r < I_GU) { const int nb = 2 * DFF / 32, kb = r / nb, n0 = (r % nb) * 32; p0_transpose_item(F.in[I_WGU1], DM, 2 * DFF, F.in[I_NFFN1], wgu1, kb * 64, n0, map_gu(n0), scr, lane); continue; } r -= I_GU;
        if (r < I_GU) { const int nb = 2 * DFF / 32, kb = r / nb, n0 = (r % nb) * 32; p0_transpose_item(F.in[I_WGU2], DM, 2 * DFF, F.in[I_NFFN2], wgu2, kb * 64, n0, map_gu(n0), scr, lane); continue; } r -= I_GU;
        if (r < I_D) { const int nb = DM / 32, kb = r / nb, n0 = (r % nb) * 32; p0_transpose_item(F.in[I_WD1], DFF, DM, nullptr, wd1, kb * 64, n0, n0, scr, lane); continue; } r -= I_D;
        if (r < I_D) { const int nb = DM / 32, kb = r / nb, n0 = (r % nb) * 32; p0_transpose_item(F.in[I_WD2], DFF, DM, nullptr, wd2, kb * 64, n0, n0, scr, lane); continue; } r -= I_D;
        if (r < I_IN) { const int nb = IN_DIM / 32, kb = r / nb, n0 = (r % nb) * 32; p0_transpose_item(F.in[I_WIN], DM, IN_DIM, F.in[I_NMIX], win, kb * 64, n0, map_win(n0), scr, lane); continue; } r -= I_IN;
        if (r < I_SSO) { const int nb = DM / 32, kb = r / nb, n0 = (r % nb) * 32; p0_transpose_item(F.in[I_WSSO], DI, DM, F.in[I_NSSD], wsso, kb * 64, n0, n0, scr, lane); continue; } r -= I_SSO;
        if (r < I_SQ) { const int nb = DM / 32, kb = r / nb, n0 = (r % nb) * 32; p0_transpose_item(F.in[I_WO], DM, DM, nullptr, wo, kb * 64, n0, n0, scr, lane); continue; } r -= I_SQ;
        if (r < I_SQ) { const int nb = DM / 32, kb = r / nb, n0 = (r % nb) * 32; p0_transpose_item(F.in[I_WPG], DM, DM, F.in[I_NPLE], wpg, kb * 64, n0, n0, scr, lane); continue; } r -= I_SQ;
        if (r < I_SQ) { const int nb = DM / 32, kb = r / nb, n0 = (r % nb) * 32; p0_transpose_item(F.in[I_WPOUT], PD, DM, F.in[I_PSCALE], wpot, kb * 64, n0, n0, scr, lane); continue; } r -= I_SQ;
        { const int nb = DM / 32, kb = r / nb, n0 = (r % nb) * 32; p0_transpose_item(F.in[I_WPLE], PLE, DM, nullptr, wple, kb * 64, n0, n0, scr, lane); }
    }
    {
        bf16_t* const wgrp = (bf16_t*)(F.ws + WS_WGRP); const float* Wg = F.in[I_WPGRP];
        for (int e = F.vcu * NTHREADS + F.tid; e < 4 * 256 * 256 / 8; e += F.G * NTHREADS) {
            const f32x4 a = *(const GAS f32x4*)(Wg + (size_t)e * 8), b = *(const GAS f32x4*)(Wg + (size_t)e * 8 + 4);
            u32x4 o; o.x = pk2(a.x, a.y); o.y = pk2(a.z, a.w); o.z = pk2(b.x, b.y); o.w = pk2(b.z, b.w);
            *(GAS u32x4*)(wgrp + (size_t)e * 8) = o; }
    }
    {
        bf16_t* const XB = (bf16_t*)(F.ws + WS_XB); bf16_t* const PB = (bf16_t*)(F.ws + WS_PB); float* const stA = (float*)(F.ws + WS_STATS_A);
        for (int m = gw; m < M; m += NGW) {
            const float* xrow = (m < MP) ? F.in[I_XP] + (size_t)m * DM : F.in[I_XS] + (size_t)(m - MP) * DM;
            const GAS f32x4* xr = (const GAS f32x4*)xrow + lane;
            f32x4 v[4]; float s = 0.f;
#pragma unroll
            for (int j = 0; j < 4; ++j) { v[j] = xr[64 * j]; s += (v[j].x * v[j].x + v[j].y * v[j].y) + (v[j].z * v[j].z + v[j].w * v[j].w); }
            s = wave_sum(s);
            GAS u32x2* o8 = (GAS u32x2*)(XB + (size_t)m * DM) + lane;
#pragma unroll
            for (int j = 0; j < 4; ++j) { u32x2 w; w.x = pk2(v[j].x, v[j].y); w.y = pk2(v[j].z, v[j].w); o8[64 * j] = w; }
            if (lane < 16) *(GAS float*)(stA + (size_t)m * 16 + lane) = (lane == 0) ? s : 0.f;
            const float* prow = (m < MP) ? F.in[I_PP] + (size_t)m * PLE : F.in[I_PS] + (size_t)(m - MP) * PLE;
            const f32x4 pv = *((const GAS f32x4*)prow + lane);
            u32x2 w; w.x = pk2(pv.x, pv.y); w.y = pk2(pv.z, pv.w); *((GAS u32x2*)(PB + (size_t)m * PLE) + lane) = w;
        }
    }
}


typedef short v4i16_t __attribute__((ext_vector_type(4)));
constexpr int IMG_B = 0, IMG_C = 32768, IMG_X = 65536, TAB_ACS = RING_BYTES + 1024, TAB_DT = TAB_ACS + 2048, TAB_SD = TAB_DT + 2048;
constexpr int NCHUNK = SEQ / 128;
template <bool XS> __device__ __forceinline__ int img_off(int row, int ch) { return XS ? 256 * row + 16 * (ch ^ ((row & 7) << 1)) : 256 * row + 16 * (ch ^ (((row & 3) << 2) | ((row >> 2) & 3))); }
__device__ __forceinline__ bf16x8 tr_pair(const LAS unsigned char* p0, const LAS unsigned char* p1) {
    const v4i16_t a = __builtin_amdgcn_ds_read_tr16_b64_v4i16((LAS v4i16_t*)p0), b = __builtin_amdgcn_ds_read_tr16_b64_v4i16((LAS v4i16_t*)p1);
    return (bf16x8){a[0], a[1], a[2], a[3], b[0], b[1], b[2], b[3]};
}
__device__ __forceinline__ void ssd_tables_load(Frame& F, size_t row0, int g, float& d0, float& d1) {
    if (F.wave < 4) { const float* const DT = (const float*)(F.ws + WS_DT); const int head = g * HPG + F.wave;
        d0 = *(const GAS float*)(DT + (row0 + 2 * F.lane) * 32 + head); d1 = *(const GAS float*)(DT + (row0 + 2 * F.lane + 1) * 32 + head); }
}
__device__ __forceinline__ void ssd_tables_compute(Frame& F, int g, float d0, float d1) {
    LAS float* const acs = (LAS float*)(F.lds + TAB_ACS); LAS float* const dtl = (LAS float*)(F.lds + TAB_DT); LAS float* const sdec = (LAS float*)(F.lds + TAB_SD);
    if (F.wave < 4) {
        const int r = F.wave, lane = F.lane, head = g * HPG + r;
        const float Ah = -__expf(*(const GAS float*)(F.in[I_ALOG] + head));
        const float a0 = d0 * Ah, a1 = d1 * Ah, loc = a0 + a1;
        float inc = loc;
#pragma unroll
        for (int o = 1; o < 64; o <<= 1) { const float t = __shfl_up(inc, o); if (lane >= o) inc += t; }
        const float exc = inc - loc;
        acs[(2 * lane) * 4 + r] = exc + a0; acs[(2 * lane + 1) * 4 + r] = inc;
        dtl[(2 * lane) * 4 + r] = d0; dtl[(2 * lane + 1) * 4 + r] = d1;
    }
    __syncthreads();
    { const int s = F.tid >> 2, r = F.tid & 3; sdec[s * 4 + r] = __expf(acs[127 * 4 + r] - acs[s * 4 + r]) * dtl[s * 4 + r]; }
    __syncthreads();
}
__device__ __forceinline__ void ssd_tables(Frame& F, size_t row0, int g) { float d0 = 0.f, d1 = 0.f; ssd_tables_load(F, row0, g, d0, d1); ssd_tables_compute(F, g, d0, d1); }
struct ConvMap { int kind, cc, run, gch; };
__device__ __forceinline__ ConvMap ssd_conv_map(int t, int g) {
    ConvMap m;
    if (t < 256) { m.kind = 0; m.cc = t & 31; m.run = t >> 5; } else if (t < 384) { m.kind = 1; m.cc = (t - 256) & 15; m.run = (t - 256) >> 4; } else { m.kind = 2; m.cc = (t - 384) & 15; m.run = (t - 384) >> 4; }
    m.gch = (m.kind == 0 ? g * 256 : (m.kind == 1 ? DI + g * DSTATE : DI + NG * DSTATE + g * DSTATE)) + 8 * m.cc;
    return m;
}
__device__ __forceinline__ void ssd_conv_load(Frame& F, size_t row0, int b, int c, int g, u32x4 (&raw)[19]) {
    const ConvMap m = ssd_conv_map(F.tid, g);
    const bf16_t* const XBC = (const bf16_t*)(F.ws + WS_XBC); const bf16_t* const HALO = (const bf16_t*)(F.ws + WS_HALO);
#pragma unroll
    for (int i = 0; i < 19; ++i) {
        if (i < 3 && m.run == 0) { if (c == 0) raw[i] = (u32x4){0u, 0u, 0u, 0u}; else raw[i] = *(const GAS u32x4*)(HALO + ((((size_t)b * 16 + c) * 3 + i) * CD) + m.gch); }
        else raw[i] = *(const GAS u32x4*)(XBC + (row0 + 16 * m.run + i - 3) * CD + m.gch); }
}
__device__ __forceinline__ void ssd_conv_store(Frame& F, size_t row0, int g, const u32x4 (&raw)[19]) {
    const ConvMap m = ssd_conv_map(F.tid, g);
    bf16_t* const XBC = (bf16_t*)(F.ws + WS_XBC);
    const float* const convw = F.in[I_CONVW]; const float* const convb = F.in[I_CONVB];
    float cw[4][8], cb[8];
#pragma unroll
    for (int k = 0; k < 4; ++k) { const f32x4 a = *(const GAS f32x4*)(convw + (size_t)k * CD + m.gch), b_ = *(const GAS f32x4*)(convw + (size_t)k * CD + m.gch + 4);
        cw[k][0] = a.x; cw[k][1] = a.y; cw[k][2] = a.z; cw[k][3] = a.w; cw[k][4] = b_.x; cw[k][5] = b_.y; cw[k][6] = b_.z; cw[k][7] = b_.w; }
    { const f32x4 a = *(const GAS f32x4*)(convb + m.gch), b_ = *(const GAS f32x4*)(convb + m.gch + 4); cb[0] = a.x; cb[1] = a.y; cb[2] = a.z; cb[3] = a.w; cb[4] = b_.x; cb[5] = b_.y; cb[6] = b_.z; cb[7] = b_.w; }
    LAS unsigned char* const img = F.lds + (m.kind == 0 ? IMG_X + (m.cc >> 4) * 32768 : IMG_B);
    const LAS float* const sdec = (const LAS float*)(F.lds + TAB_SD);
    const int chl = m.cc & 15, hr = m.cc >> 3;
#pragma unroll
    for (int i = 0; i < 16; ++i) {
        const int s = 16 * m.run + i;
        float o[8];
#pragma unroll
        for (int j2 = 0; j2 < 4; ++j2) {
            const unsigned w0 = raw[i][j2], w1 = raw[i + 1][j2], w2 = raw[i + 2][j2], w3 = raw[i + 3][j2];
            const float lo = cb[2 * j2] + cw[0][2 * j2] * bflo(w0) + cw[1][2 * j2] * bflo(w1) + cw[2][2 * j2] * bflo(w2) + cw[3][2 * j2] * bflo(w3);
            const float hi = cb[2 * j2 + 1] + cw[0][2 * j2 + 1] * bfhi(w0) + cw[1][2 * j2 + 1] * bfhi(w1) + cw[2][2 * j2 + 1] * bfhi(w2) + cw[3][2 * j2 + 1] * bfhi(w3);
            o[2 * j2] = silu_f(lo); o[2 * j2 + 1] = silu_f(hi);
        }
        u32x4 pk; pk.x = cvt_pk_bf16(o[0], o[1]); pk.y = cvt_pk_bf16(o[2], o[3]); pk.z = cvt_pk_bf16(o[4], o[5]); pk.w = cvt_pk_bf16(o[6], o[7]);
        *(GAS u32x4*)(XBC + (row0 + s) * CD + m.gch) = pk;
        if (m.kind == 0) { const float sc = sdec[s * 4 + hr];
            pk.x = cvt_pk_bf16(o[0] * sc, o[1] * sc); pk.y = cvt_pk_bf16(o[2] * sc, o[3] * sc); pk.z = cvt_pk_bf16(o[4] * sc, o[5] * sc); pk.w = cvt_pk_bf16(o[6] * sc, o[7] * sc); }
        if (m.kind != 2) *(LAS u32x4*)(img + img_off<false>(s, chl)) = pk;
    }
}
__device__ __forceinline__ void ssd_copy_load(Frame& F, size_t row0, int g, u32x4 (&raw)[16]) {
    const ConvMap m = ssd_conv_map(F.tid, g);
    const bf16_t* const XBC = (const bf16_t*)(F.ws + WS_XBC);
#pragma unroll
    for (int i = 0; i < 16; ++i) raw[i] = *(const GAS u32x4*)(XBC + (row0 + 16 * m.run + i) * CD + m.gch);
}
__device__ __forceinline__ void ssd_copy_store(Frame& F, int g, const u32x4 (&raw)[16]) {
    const ConvMap m = ssd_conv_map(F.tid, g);
    LAS unsigned char* const img = F.lds + (m.kind == 0 ? IMG_X + (m.cc >> 4) * 32768 : (m.kind == 1 ? IMG_B : IMG_C));
    const int chl = m.cc & 15;
#pragma unroll
    for (int i = 0; i < 16; ++i) { const int s = 16 * m.run + i; *(LAS u32x4*)(img + (m.kind == 0 ? img_off<true>(s, chl) : img_off<false>(s, chl))) = raw[i]; }
}
__device__ __forceinline__ void ssd_states_phase(Frame& F) {
    bf16_t* const ST = (bf16_t*)(F.ws + WS_HPREV);
    float* const CDEC = (float*)(F.ws + WS_CDEC);
    const int w = F.wave, lane = F.lane, ql = lane & 15, gq = lane >> 4, qq = ql >> 2, pp = ql & 3, r = w >> 1, nh = w & 1;
    int sbo[4][2], sxo[4][2];
#pragma unroll
    for (int f = 0; f < 4; ++f) { const int colb = 64 * nh + 16 * f + 4 * pp, colx = 64 * (r & 1) + 16 * f + 4 * pp;
#pragma unroll
        for (int t4 = 0; t4 < 2; ++t4) { sbo[f][t4] = img_off<false>(8 * gq + qq + 4 * t4, colb >> 3) + 2 * (colb & 7); sxo[f][t4] = img_off<false>(8 * gq + qq + 4 * t4, colx >> 3) + 2 * (colx & 7); } }
    u32x4 raw[19]; float d0 = 0.f, d1 = 0.f;
    constexpr int NIT = BATCH * NCHUNK * NG;
    if (F.vcu < NIT) { const int it = F.vcu, g = it & 7, c = (it >> 3) & (NCHUNK - 1), b = it >> 7; const size_t row0 = (size_t)b * SEQ + (size_t)c * 128;
        ssd_conv_load(F, row0, b, c, g, raw); ssd_tables_load(F, row0, g, d0, d1); }
    for (int it = F.vcu; it < NIT; it += F.G) {
        const int g = it & 7, c = (it >> 3) & (NCHUNK - 1), b = it >> 7;
        const size_t row0 = (size_t)b * SEQ + (size_t)c * 128;
        asm volatile("s_waitcnt vmcnt(0)" ::: "memory");
        ssd_tables_compute(F, g, d0, d1);
        ssd_conv_store(F, row0, g, raw);
        __syncthreads();
        if (it + F.G < NIT) { const int it2 = it + F.G, g2 = it2 & 7, c2 = (it2 >> 3) & (NCHUNK - 1), b2 = it2 >> 7; const size_t row2 = (size_t)b2 * SEQ + (size_t)c2 * 128;
            ssd_conv_load(F, row2, b2, c2, g2, raw); ssd_tables_load(F, row2, g2, d0, d1); }
        const int head = g * HPG + r;
        bf16_t* const stp = ST + ((((size_t)b * NCHUNK + c) * NH + head) * HD) * DSTATE;
#pragma unroll
        for (int nh2 = 0; nh2 < 2; ++nh2) {
            f32x4 acc[2][4];
#pragma unroll
            for (int i = 0; i < 2; ++i)
#pragma unroll
                for (int j = 0; j < 4; ++j) acc[i][j] = (f32x4){0.f, 0.f, 0.f, 0.f};
#pragma unroll
            for (int ks = 0; ks < 4; ++ks) {
                bf16x8 af[2], xf[4];
#pragma unroll
                for (int nf = 0; nf < 2; ++nf) { const LAS unsigned char* p = F.lds + IMG_B + sbo[2 * nh2 + nf][0] + 8192 * ks; const LAS unsigned char* p4 = F.lds + IMG_B + sbo[2 * nh2 + nf][1] + 8192 * ks; af[nf] = tr_pair(p, p4); }
#pragma unroll
                for (int pf = 0; pf < 4; ++pf) { const LAS unsigned char* p = F.lds + IMG_X + (r >> 1) * 32768 + sxo[pf][0] + 8192 * ks; const LAS unsigned char* p4 = F.lds + IMG_X + (r >> 1) * 32768 + sxo[pf][1] + 8192 * ks; xf[pf] = tr_pair(p, p4); }
#pragma unroll
                for (int nf = 0; nf < 2; ++nf)
#pragma unroll
                    for (int pf = 0; pf < 4; ++pf) acc[nf][pf] = __builtin_amdgcn_mfma_f32_16x16x32_bf16(af[nf], xf[pf], acc[nf][pf], 0, 0, 0);
            }
#pragma unroll
            for (int pf = 0; pf < 4; ++pf)
#pragma unroll
                for (int nf = 0; nf < 2; ++nf) { u32x2 o; o.x = cvt_pk_bf16(acc[nf][pf][0], acc[nf][pf][1]); o.y = cvt_pk_bf16(acc[nf][pf][2], acc[nf][pf][3]);
                    *(GAS u32x2*)(stp + (size_t)(16 * pf + ql) * DSTATE + 64 * nh + 32 * nh2 + 16 * nf + 4 * gq) = o; }
        }
        if (F.tid < 4) { const LAS float* acs = (const LAS float*)(F.lds + TAB_ACS); *(GAS float*)(CDEC + ((size_t)b * NCHUNK + c) * NH + g * HPG + F.tid) = __expf(acs[127 * 4 + F.tid]); }
        __syncthreads();
    }
}
__device__ __forceinline__ void ssd_scan_phase(Frame& F) {
    bf16_t* const HP = (bf16_t*)(F.ws + WS_HPREV); const float* const CDEC = (const float*)(F.ws + WS_CDEC); float* const hout = F.out + O_SSM_P;
    const int gt = F.vcu * NTHREADS + F.tid, NT = F.G * NTHREADS;
    constexpr int PER = NH * HD * DSTATE / 8;
    for (int e = gt; e < BATCH * PER; e += NT) {
        const int b = e / PER, i8 = e % PER, head = i8 / (HD * DSTATE / 8);
        u32x4 stv[NCHUNK];
#pragma unroll
        for (int c = 0; c < NCHUNK; ++c) stv[c] = *(const GAS u32x4*)(HP + (((size_t)b * NCHUNK + c) * (size_t)PER + i8) * 8);
        f32x4 h0 = (f32x4){0.f, 0.f, 0.f, 0.f}, h1 = h0;
#pragma unroll
        for (int c = 0; c < NCHUNK; ++c) {
            if (c > 0) *(GAS u32x4*)(HP + (((size_t)b * NCHUNK + c) * (size_t)PER + i8) * 8) = pg8::pack8(h0, h1);
            const float d = *(const GAS float*)(CDEC + ((size_t)b * NCHUNK + c) * NH + head);
            f32x4 s0, s1; pg8::unpack8(stv[c], s0, s1);
            h0 = h0 * d + s0; h1 = h1 * d + s1;
        }
        *(GAS f32x4*)(hout + ((size_t)b * PER + i8) * 8) = h0; *(GAS f32x4*)(hout + ((size_t)b * PER + i8) * 8 + 4) = h1;
    }
}
__device__ __forceinline__ void ssd_out_phase(Frame& F) {
    const bf16_t* const HP = (const bf16_t*)(F.ws + WS_HPREV); bf16_t* const ZY = (bf16_t*)(F.ws + WS_Z);
    const int w = F.wave, lane = F.lane, ql = lane & 15, gq = lane >> 4, qq = ql >> 2, pp = ql & 3, q0 = 16 * w;
    const LAS float* const acs = (const LAS float*)(F.lds + TAB_ACS); const LAS float* const dtl = (const LAS float*)(F.lds + TAB_DT);
    int cfo[4], bbo[4], hbo[4], xbo[2][4];
#pragma unroll
    for (int ks = 0; ks < 4; ++ks) { cfo[ks] = IMG_C + img_off<false>(q0 + ql, 4 * ks + gq); bbo[ks] = IMG_B + img_off<false>(ql, 4 * ks + gq); hbo[ks] = img_off<false>(ql, 4 * ks + gq); }
#pragma unroll
    for (int rr = 0; rr < 2; ++rr)
#pragma unroll
        for (int pf = 0; pf < 4; ++pf) xbo[rr][pf] = IMG_X + img_off<true>(4 * gq + qq, 8 * rr + 2 * pf + (pp >> 1)) + 8 * (pp & 1);
    u32x4 raw[16]; float d0 = 0.f, d1 = 0.f;
    constexpr int NIT = BATCH * NCHUNK * NG;
    if (F.vcu < NIT) { const int it = F.vcu, g = it & 7, c = (it >> 3) & (NCHUNK - 1), b = it >> 7; const size_t row0 = (size_t)b * SEQ + (size_t)c * 128;
        ssd_copy_load(F, row0, g, raw); ssd_tables_load(F, row0, g, d0, d1); }
    for (int it = F.vcu; it < NIT; it += F.G) {
        const int g = it & 7, c = (it >> 3) & (NCHUNK - 1), b = it >> 7;
        const size_t row0 = (size_t)b * SEQ + (size_t)c * 128;
        ssd_tables_compute(F, g, d0, d1);
        ssd_copy_store(F, g, raw);
        __syncthreads();
        if (it + F.G < NIT) { const int it2 = it + F.G, g2 = it2 & 7, c2 = (it2 >> 3) & (NCHUNK - 1), b2 = it2 >> 7; const size_t row2 = (size_t)b2 * SEQ + (size_t)c2 * 128;
            ssd_copy_load(F, row2, g2, raw); ssd_tables_load(F, row2, g2, d0, d1); }
        bf16x8 cf[4];
#pragma unroll
        for (int ks = 0; ks < 4; ++ks) cf[ks] = *(const LAS bf16x8*)(F.lds + cfo[ks]);
        bf16_t* const zp = ZY + (row0 + q0 + ql) * DI + g * 256 + 4 * gq;
        const LAS float* const acs_l = acs + 16 * gq; const LAS float* const dtl_l = dtl + 16 * gq;
        f32x4 acc[4][4];
        float aq[4];
#pragma unroll
        for (int r = 0; r < 4; ++r) { aq[r] = acs[(q0 + ql) * 4 + r];
#pragma unroll
            for (int pf = 0; pf < 4; ++pf) acc[r][pf] = (f32x4){0.f, 0.f, 0.f, 0.f}; }
#pragma unroll
        for (int ks = 0; ks < 4; ++ks) if (2 * ks <= w) {
            f32x4 cb[2];
#pragma unroll
            for (int hf = 0; hf < 2; ++hf) { cb[hf] = (f32x4){0.f, 0.f, 0.f, 0.f};
                if (2 * ks + hf <= w) {
#pragma unroll
                    for (int kn = 0; kn < 4; ++kn) { const bf16x8 bfr = *(const LAS bf16x8*)(F.lds + bbo[kn] + 4096 * (2 * ks + hf)); cb[hf] = __builtin_amdgcn_mfma_f32_16x16x32_bf16(bfr, cf[kn], cb[hf], 0, 0, 0); } } }
#pragma unroll
            for (int r = 0; r < 4; ++r) {
                const float Dh = *(const GAS float*)(F.in[I_DSKIP] + g * HPG + r);
                float v[8];
#pragma unroll
                for (int hf = 0; hf < 2; ++hf) { const int sf = 2 * ks + hf;
#pragma unroll
                    for (int rg = 0; rg < 4; ++rg) { const int sl = 4 * gq + rg;
                        float val = 0.f;
                        if (sf <= w) { const float as = acs_l[64 * sf + 4 * rg + r], d = dtl_l[64 * sf + 4 * rg + r];
                            val = cb[hf][rg] * __expf(aq[r] - as) * d;
                            if (sf == w) { if (sl > ql) val = 0.f; else if (sl == ql) val += Dh; } }
                        v[4 * hf + rg] = val; } }
                u32x4 pk; pk.x = cvt_pk_bf16(v[0], v[1]); pk.y = cvt_pk_bf16(v[2], v[3]); pk.z = cvt_pk_bf16(v[4], v[5]); pk.w = cvt_pk_bf16(v[6], v[7]);
                const bf16x8 wf = __builtin_bit_cast(bf16x8, pk);
#pragma unroll
                for (int pf = 0; pf < 4; ++pf) {
                    const LAS unsigned char* const xb = F.lds + xbo[r & 1][pf] + (r >> 1) * 32768 + 8192 * ks;
                    const bf16x8 xf = tr_pair(xb, xb + 4096);
                    acc[r][pf] = __builtin_amdgcn_mfma_f32_16x16x32_bf16(xf, wf, acc[r][pf], 0, 0, 0); }
            }
        }
        u32x4 hreg[8];
        if (c > 0) {
            const u32x4* hsrc = (const u32x4*)(HP + ((((size_t)b * NCHUNK + c) * NH + g * HPG) * HD) * DSTATE) + F.tid;
#pragma unroll
            for (int i = 0; i < 8; ++i) hreg[i] = *(const GAS u32x4*)(hsrc + 512 * i);
        }
        if (c > 0) {
            __syncthreads();
#pragma unroll
            for (int i = 0; i < 8; ++i) { const int e = F.tid + 512 * i, hr_ = e >> 10, p_ = (e >> 4) & 63, ch_ = e & 15;
                *(LAS u32x4*)(F.lds + IMG_X + hr_ * 16384 + img_off<false>(p_, ch_)) = hreg[i]; }
            __syncthreads();
#pragma unroll
            for (int r = 0; r < 4; ++r) { const float eaq = __expf(aq[r]);
#pragma unroll
                for (int pf = 0; pf < 4; ++pf) { f32x4 yo = (f32x4){0.f, 0.f, 0.f, 0.f};
#pragma unroll
                    for (int ks = 0; ks < 4; ++ks) { const bf16x8 hf_ = *(const LAS bf16x8*)(F.lds + IMG_X + r * 16384 + hbo[ks] + 4096 * pf); yo = __builtin_amdgcn_mfma_f32_16x16x32_bf16(hf_, cf[ks], yo, 0, 0, 0); }
                    acc[r][pf] += yo * eaq; } }
        }
        float ssum = 0.f;
#pragma unroll
        for (int r = 0; r < 4; ++r)
#pragma unroll
            for (int pf = 0; pf < 4; ++pf) {
                const u32x2 zz = *(const GAS u32x2*)(zp + r * 64 + 16 * pf);
                const f32x4 y = acc[r][pf] * (f32x4){bflo(zz.x), bfhi(zz.x), bflo(zz.y), bfhi(zz.y)};
                acc[r][pf] = y; ssum += (y[0] * y[0] + y[1] * y[1]) + (y[2] * y[2] + y[3] * y[3]); }
        ssum += __shfl_xor(ssum, 16); ssum += __shfl_xor(ssum, 32);
        const float rsn = __builtin_amdgcn_rsqf(ssum * (1.0f / 256.0f) + EPS);
#pragma unroll
        for (int r = 0; r < 4; ++r)
#pragma unroll
            for (int pf = 0; pf < 4; ++pf) { u32x2 o; o.x = cvt_pk_bf16(acc[r][pf][0] * rsn, acc[r][pf][1] * rsn); o.y = cvt_pk_bf16(acc[r][pf][2] * rsn, acc[r][pf][3] * rsn);
                *(GAS u32x2*)(zp + r * 64 + 16 * pf) = o; }
        __syncthreads();
    }
}


__device__ __forceinline__ void ssd_conv_store_local(Frame& F, size_t row0, int g, const u32x4 (&raw)[19]) {
    const ConvMap m = ssd_conv_map(F.tid, g);
    bf16_t* const XBC = (bf16_t*)(F.ws + WS_XBC);
    const float* const convw = F.in[I_CONVW]; const float* const convb = F.in[I_CONVB];
    float cw[4][8], cb[8];
#pragma unroll
    for (int k = 0; k < 4; ++k) { const f32x4 a = *(const GAS f32x4*)(convw + (size_t)k * CD + m.gch), b_ = *(const GAS f32x4*)(convw + (size_t)k * CD + m.gch + 4);
        cw[k][0] = a.x; cw[k][1] = a.y; cw[k][2] = a.z; cw[k][3] = a.w; cw[k][4] = b_.x; cw[k][5] = b_.y; cw[k][6] = b_.z; cw[k][7] = b_.w; }
    { const f32x4 a = *(const GAS f32x4*)(convb + m.gch), b_ = *(const GAS f32x4*)(convb + m.gch + 4); cb[0] = a.x; cb[1] = a.y; cb[2] = a.z; cb[3] = a.w; cb[4] = b_.x; cb[5] = b_.y; cb[6] = b_.z; cb[7] = b_.w; }
    LAS unsigned char* const img = F.lds + (m.kind == 0 ? IMG_X + (m.cc >> 4) * 32768 : (m.kind == 1 ? IMG_B : IMG_C));
    const int chl = m.cc & 15;
#pragma unroll
    for (int i = 0; i < 16; ++i) {
        const int s = 16 * m.run + i;
        float o[8];
#pragma unroll
        for (int j2 = 0; j2 < 4; ++j2) {
            const unsigned w0 = raw[i][j2], w1 = raw[i + 1][j2], w2 = raw[i + 2][j2], w3 = raw[i + 3][j2];
            const float lo = cb[2 * j2] + cw[0][2 * j2] * bflo(w0) + cw[1][2 * j2] * bflo(w1) + cw[2][2 * j2] * bflo(w2) + cw[3][2 * j2] * bflo(w3);
            const float hi = cb[2 * j2 + 1] + cw[0][2 * j2 + 1] * bfhi(w0) + cw[1][2 * j2 + 1] * bfhi(w1) + cw[2][2 * j2 + 1] * bfhi(w2) + cw[3][2 * j2 + 1] * bfhi(w3);
            o[2 * j2] = silu_f(lo); o[2 * j2 + 1] = silu_f(hi);
        }
        u32x4 pk; pk.x = cvt_pk_bf16(o[0], o[1]); pk.y = cvt_pk_bf16(o[2], o[3]); pk.z = cvt_pk_bf16(o[4], o[5]); pk.w = cvt_pk_bf16(o[6], o[7]);
        if (m.kind == 2) *(GAS u32x4*)(XBC + (row0 + s) * CD + m.gch) = pk;
        *(LAS u32x4*)(img + (m.kind == 0 ? img_off<true>(s, chl) : img_off<false>(s, chl))) = pk;
    }
}
__device__ __forceinline__ void ssd_local_phase(Frame& F) {
    bf16_t* const XBC = (bf16_t*)(F.ws + WS_XBC); bf16_t* const ST = (bf16_t*)(F.ws + WS_HPREV); float* const CDEC = (float*)(F.ws + WS_CDEC); float* const EAQ = (float*)(F.ws + WS_EAQ);
    const int w = F.wave, lane = F.lane, q0 = 16 * w, hr = w >> 1, nh = w & 1;
    const LAS float* const acs = (const LAS float*)(F.lds + TAB_ACS); const LAS float* const dtl = (const LAS float*)(F.lds + TAB_DT); const LAS float* const sdec = (const LAS float*)(F.lds + TAB_SD);
    u32x4 raw[19]; float d0 = 0.f, d1 = 0.f;
    constexpr int NIT = BATCH * NCHUNK * NG;
    if (F.vcu < NIT) { const int it = F.vcu, g = it & 7, c = (it >> 3) & (NCHUNK - 1), b = it >> 7; const size_t row0 = (size_t)b * SEQ + (size_t)c * 128;
        ssd_conv_load(F, row0, b, c, g, raw); ssd_tables_load(F, row0, g, d0, d1); }
    for (int it = F.vcu; it < NIT; it += F.G) {
        const int g = it & 7, c = (it >> 3) & (NCHUNK - 1), b = it >> 7;
        const size_t row0 = (size_t)b * SEQ + (size_t)c * 128;
        asm volatile("s_waitcnt vmcnt(0)" ::: "memory");
        ssd_tables_compute(F, g, d0, d1);
        ssd_conv_store_local(F, row0, g, raw);
        __syncthreads();
        int lane_ = lane; asm volatile("" : "+v"(lane_));
        const int ql = lane_ & 15, gq = lane_ >> 4, qq = ql >> 2, pp = ql & 3;
        int cfo[4], bbo[4], xbo[2][4], sbo[4];
#pragma unroll
        for (int ks = 0; ks < 4; ++ks) { cfo[ks] = IMG_C + img_off<false>(q0 + ql, 4 * ks + gq); bbo[ks] = IMG_B + img_off<false>(ql, 4 * ks + gq); }
#pragma unroll
        for (int rr = 0; rr < 2; ++rr)
#pragma unroll
                for (int pf = 0; pf < 4; ++pf) xbo[rr][pf] = IMG_X + img_off<true>(4 * gq + qq, 8 * rr + 2 * pf + (pp >> 1)) + 8 * (pp & 1);
#pragma unroll
        for (int nf = 0; nf < 4; ++nf) { const int col = 64 * nh + 16 * nf + 4 * pp; sbo[nf] = IMG_B + img_off<false>(4 * gq + qq, col >> 3) + 2 * (col & 7); }
        {
            bf16x8 cf[4];
#pragma unroll
            for (int ks = 0; ks < 4; ++ks) cf[ks] = *(const LAS bf16x8*)(F.lds + cfo[ks]);
            const LAS float* const acs_l = acs + 16 * gq; const LAS float* const dtl_l = dtl + 16 * gq;
            f32x4 acc[4][4]; float aq[4];
#pragma unroll
            for (int r = 0; r < 4; ++r) { aq[r] = acs[(q0 + ql) * 4 + r];
#pragma unroll
                for (int pf = 0; pf < 4; ++pf) acc[r][pf] = (f32x4){0.f, 0.f, 0.f, 0.f}; }
#pragma unroll
            for (int ks = 0; ks < 4; ++ks) if (2 * ks <= w) {
                f32x4 cb[2];
#pragma unroll
                for (int hf = 0; hf < 2; ++hf) { cb[hf] = (f32x4){0.f, 0.f, 0.f, 0.f};
                    if (2 * ks + hf <= w) {
#pragma unroll
                        for (int kn = 0; kn < 4; ++kn) { const bf16x8 bfr = *(const LAS bf16x8*)(F.lds + bbo[kn] + 4096 * (2 * ks + hf)); cb[hf] = __builtin_amdgcn_mfma_f32_16x16x32_bf16(bfr, cf[kn], cb[hf], 0, 0, 0); } } }
#pragma unroll
                for (int r = 0; r < 4; ++r) {
                    const float Dh = *(const GAS float*)(F.in[I_DSKIP] + g * HPG + r);
                    float v[8];
#pragma unroll
                    for (int hf = 0; hf < 2; ++hf) { const int sf = 2 * ks + hf;
#pragma unroll
                        for (int rg = 0; rg < 4; ++rg) { const int sl = 4 * gq + rg;
                            float val = 0.f;
                            if (sf <= w) { const float as = acs_l[64 * sf + 4 * rg + r], d = dtl_l[64 * sf + 4 * rg + r];
                                val = cb[hf][rg] * __expf(aq[r] - as) * d;
                                if (sf == w) { if (sl > ql) val = 0.f; else if (sl == ql) val += Dh; } }
                            v[4 * hf + rg] = val; } }
                    u32x4 pk; pk.x = cvt_pk_bf16(v[0], v[1]); pk.y = cvt_pk_bf16(v[2], v[3]); pk.z = cvt_pk_bf16(v[4], v[5]); pk.w = cvt_pk_bf16(v[6], v[7]);
                    const bf16x8 wf = __builtin_bit_cast(bf16x8, pk);
#pragma unroll
                    for (int pf = 0; pf < 4; ++pf) {
                        const LAS unsigned char* const xb = F.lds + xbo[r & 1][pf] + (r >> 1) * 32768 + 8192 * ks;
                        const bf16x8 xf = tr_pair(xb, xb + 4096);
                        acc[r][pf] = __builtin_amdgcn_mfma_f32_16x16x32_bf16(xf, wf, acc[r][pf], 0, 0, 0); }
                }
            }
            LAS unsigned char* const stg = F.lds + IMG_C + w * 4096;
            bf16_t* const og = XBC + (row0 + q0 + (lane >> 4)) * CD + g * 256 + 8 * (lane & 15);
#pragma unroll
            for (int h = 0; h < 2; ++h) {
#pragma unroll
                for (int rr = 0; rr < 2; ++rr)
#pragma unroll
                    for (int pf = 0; pf < 4; ++pf) { const int r = 2 * h + rr, ch = 8 * rr + 2 * pf + (gq >> 1);
                        u32x2 o; o.x = cvt_pk_bf16(acc[r][pf][0], acc[r][pf][1]); o.y = cvt_pk_bf16(acc[r][pf][2], acc[r][pf][3]);
                        *(LAS u32x2*)(stg + ql * 256 + ((ch ^ ql) & 15) * 16 + (gq & 1) * 8) = o; }
                asm volatile("s_waitcnt lgkmcnt(0)" ::: "memory");
#pragma unroll
                for (int i = 0; i < 4; ++i) { const int row = 4 * i + (lane >> 4); const u32x4 v = *(const LAS u32x4*)(stg + row * 256 + (((lane & 15) ^ row) & 15) * 16); *(GAS u32x4*)(og + (size_t)(4 * i) * CD + 128 * h) = v; }
                asm volatile("s_waitcnt lgkmcnt(0)" ::: "memory");
            }
            if (gq == 0) *(GAS f32x4*)(EAQ + (row0 + q0 + ql) * 32 + g * HPG) = (f32x4){__expf(aq[0]), __expf(aq[1]), __expf(aq[2]), __expf(aq[3])};
        }
        asm volatile("" ::: "memory"); __builtin_amdgcn_sched_barrier(0);
        if (it + F.G < NIT) { const int it2 = it + F.G, g2 = it2 & 7, c2 = (it2 >> 3) & (NCHUNK - 1), b2 = it2 >> 7; const size_t row2 = (size_t)b2 * SEQ + (size_t)c2 * 128;
            ssd_conv_load(F, row2, b2, c2, g2, raw); ssd_tables_load(F, row2, g2, d0, d1); }
        {
            const int head = g * HPG + hr;
            bf16_t* const stp = ST + ((((size_t)b * NCHUNK + c) * NH + head) * HD) * DSTATE;
#pragma unroll
            for (int nh2 = 0; nh2 < 2; ++nh2) {
                f32x4 acc[2][4];
#pragma unroll
                for (int i = 0; i < 2; ++i)
#pragma unroll
                    for (int j = 0; j < 4; ++j) acc[i][j] = (f32x4){0.f, 0.f, 0.f, 0.f};
#pragma unroll
                for (int ks = 0; ks < 4; ++ks) {
                    asm volatile("" ::: "memory");
                    float sd[8];
#pragma unroll
                    for (int j = 0; j < 8; ++j) sd[j] = sdec[(32 * ks + 16 * (j >> 2) + 4 * gq + (j & 3)) * 4 + hr];
                    bf16x8 af[2], xf[4];
#pragma unroll
                    for (int nf = 0; nf < 2; ++nf) { const LAS unsigned char* p = F.lds + sbo[2 * nh2 + nf] + 8192 * ks; af[nf] = tr_pair(p, p + 4096); }
#pragma unroll
                    for (int pf = 0; pf < 4; ++pf) { const LAS unsigned char* p = F.lds + xbo[hr & 1][pf] + (hr >> 1) * 32768 + 8192 * ks;
                        const u32x4 xr = __builtin_bit_cast(u32x4, tr_pair(p, p + 4096));
                        u32x4 xs; xs.x = cvt_pk_bf16(bflo(xr.x) * sd[0], bfhi(xr.x) * sd[1]); xs.y = cvt_pk_bf16(bflo(xr.y) * sd[2], bfhi(xr.y) * sd[3]);
                        xs.z = cvt_pk_bf16(bflo(xr.z) * sd[4], bfhi(xr.z) * sd[5]); xs.w = cvt_pk_bf16(bflo(xr.w) * sd[6], bfhi(xr.w) * sd[7]);
                        xf[pf] = __builtin_bit_cast(bf16x8, xs); }
#pragma unroll
                    for (int nf = 0; nf < 2; ++nf)
#pragma unroll
                        for (int pf = 0; pf < 4; ++pf) acc[nf][pf] = __builtin_amdgcn_mfma_f32_16x16x32_bf16(af[nf], xf[pf], acc[nf][pf], 0, 0, 0);
                }
#pragma unroll
                for (int pf = 0; pf < 4; ++pf)
#pragma unroll
                    for (int nf = 0; nf < 2; ++nf) { u32x2 o; o.x = cvt_pk_bf16(acc[nf][pf][0], acc[nf][pf][1]); o.y = cvt_pk_bf16(acc[nf][pf][2], acc[nf][pf][3]);
                        *(GAS u32x2*)(stp + (size_t)(16 * pf + ql) * DSTATE + 64 * nh + 32 * nh2 + 16 * nf + 4 * gq) = o; }
            }
            if (F.tid < 4) *(GAS float*)(CDEC + ((size_t)b * NCHUNK + c) * NH + g * HPG + F.tid) = __expf(acs[127 * 4 + F.tid]);
        }
        __syncthreads();
    }
}
__device__ __forceinline__ void ssd_final_phase(Frame& F) {
    const bf16_t* const XBC = (const bf16_t*)(F.ws + WS_XBC); const bf16_t* const HP = (const bf16_t*)(F.ws + WS_HPREV); bf16_t* const ZY = (bf16_t*)(F.ws + WS_Z); const float* const EAQ = (const float*)(F.ws + WS_EAQ);
    const int w = F.wave, lane = F.lane, ql = lane & 15, gq = lane >> 4, q0 = 16 * w;
    int cfo[4], hbo[4];
#pragma unroll
    for (int ks = 0; ks < 4; ++ks) { cfo[ks] = IMG_C + img_off<false>(q0 + ql, 4 * ks + gq); hbo[ks] = img_off<false>(ql, 4 * ks + gq); }
    LAS unsigned char* const stg = F.lds + IMG_B + w * 4096;
    const int st_g = ((lane >> 4) * 256) + ((((lane & 15) ^ (lane >> 4))) * 16);
    u32x4 creg[4], hreg[8];
    constexpr int NIT = BATCH * NCHUNK * NG;
    auto loads = [&](int it) __attribute__((always_inline)) {
        const int g = it & 7, c = (it >> 3) & (NCHUNK - 1), b = it >> 7; const size_t row0 = (size_t)b * SEQ + (size_t)c * 128;
#pragma unroll
        for (int i = 0; i < 4; ++i) { const int e = F.tid + 512 * i; creg[i] = *(const GAS u32x4*)(XBC + (row0 + (e >> 4)) * CD + DI + NG * DSTATE + g * DSTATE + 8 * (e & 15)); }
        if (c > 0) { const u32x4* hsrc = (const u32x4*)(HP + ((((size_t)b * NCHUNK + c) * NH + g * HPG) * HD) * DSTATE) + F.tid;
#pragma unroll
            for (int i = 0; i < 8; ++i) hreg[i] = *(const GAS u32x4*)(hsrc + 512 * i); } };
    if (F.vcu < NIT) loads(F.vcu);
    for (int it = F.vcu; it < NIT; it += F.G) {
        const int g = it & 7, c = (it >> 3) & (NCHUNK - 1), b = it >> 7;
        const size_t row0 = (size_t)b * SEQ + (size_t)c * 128;
#pragma unroll
        for (int i = 0; i < 4; ++i) { const int e = F.tid + 512 * i; *(LAS u32x4*)(F.lds + IMG_C + img_off<false>(e >> 4, e & 15)) = creg[i]; }
        if (c > 0) {
#pragma unroll
            for (int i = 0; i < 8; ++i) { const int e = F.tid + 512 * i, hr_ = e >> 10, p_ = (e >> 4) & 63, ch_ = e & 15; *(LAS u32x4*)(F.lds + IMG_X + hr_ * 16384 + img_off<false>(p_, ch_)) = hreg[i]; } }
        __syncthreads();
        if (it + F.G < NIT) loads(it + F.G);
        bf16x8 cf[4];
#pragma unroll
        for (int ks = 0; ks < 4; ++ks) cf[ks] = *(const LAS bf16x8*)(F.lds + cfo[ks]);
        const f32x4 eaq = *(const GAS f32x4*)(EAQ + (row0 + q0 + ql) * 32 + g * HPG);
        const size_t grow = row0 + q0 + (lane >> 4);
        const bf16_t* const zg = ZY + grow * DI + g * 256 + 8 * (lane & 15); const bf16_t* const yg = XBC + grow * CD + g * 256 + 8 * (lane & 15);
        u32x4 zin[2][4], yin[2][4];
#pragma unroll
        for (int h = 0; h < 2; ++h)
#pragma unroll
            for (int i = 0; i < 4; ++i) { zin[h][i] = *(const GAS u32x4*)(zg + (size_t)(4 * i) * DI + 128 * h); yin[h][i] = *(const GAS u32x4*)(yg + (size_t)(4 * i) * CD + 128 * h); }
        f32x4 acc[4][4]; float ssum = 0.f;
#pragma unroll
        for (int h = 0; h < 2; ++h) {
            u32x2 zr[2][4], yr[2][4];
#pragma unroll
            for (int i = 0; i < 4; ++i) { const int row = 4 * i + (lane >> 4); *(LAS u32x4*)(stg + row * 256 + (((lane & 15) ^ row) & 15) * 16) = zin[h][i]; }
            asm volatile("s_waitcnt lgkmcnt(0)" ::: "memory");
#pragma unroll
            for (int rr = 0; rr < 2; ++rr)
#pragma unroll
                for (int pf = 0; pf < 4; ++pf) { const int ch = 8 * rr + 2 * pf + (gq >> 1); zr[rr][pf] = *(const LAS u32x2*)(stg + ql * 256 + ((ch ^ ql) & 15) * 16 + (gq & 1) * 8); }
            asm volatile("s_waitcnt lgkmcnt(0)" ::: "memory");
#pragma unroll
            for (int i = 0; i < 4; ++i) { const int row = 4 * i + (lane >> 4); *(LAS u32x4*)(stg + row * 256 + (((lane & 15) ^ row) & 15) * 16) = yin[h][i]; }
            asm volatile("s_waitcnt lgkmcnt(0)" ::: "memory");
#pragma unroll
            for (int rr = 0; rr < 2; ++rr)
#pragma unroll
                for (int pf = 0; pf < 4; ++pf) { const int ch = 8 * rr + 2 * pf + (gq >> 1); yr[rr][pf] = *(const LAS u32x2*)(stg + ql * 256 + ((ch ^ ql) & 15) * 16 + (gq & 1) * 8); }
            asm volatile("s_waitcnt lgkmcnt(0)" ::: "memory");
#pragma unroll
            for (int rr = 0; rr < 2; ++rr) { const int r = 2 * h + rr;
#pragma unroll
                for (int pf = 0; pf < 4; ++pf) { f32x4 yo = (f32x4){0.f, 0.f, 0.f, 0.f};
                    if (c > 0) {
#pragma unroll
                        for (int ks = 0; ks < 4; ++ks) { const bf16x8 hf_ = *(const LAS bf16x8*)(F.lds + IMG_X + r * 16384 + hbo[ks] + 4096 * pf); yo = __builtin_amdgcn_mfma_f32_16x16x32_bf16(hf_, cf[ks], yo, 0, 0, 0); } }
                    const u32x2 zz = zr[rr][pf], yy = yr[rr][pf];
                    const f32x4 y = ((f32x4){bflo(yy.x), bfhi(yy.x), bflo(yy.y), bfhi(yy.y)} + yo * eaq[r]) * (f32x4){bflo(zz.x), bfhi(zz.x), bflo(zz.y), bfhi(zz.y)};
                    acc[r][pf] = y; ssum += (y[0] * y[0] + y[1] * y[1]) + (y[2] * y[2] + y[3] * y[3]); } }
        }
        ssum += __shfl_xor(ssum, 16); ssum += __shfl_xor(ssum, 32);
        const float rsn = __builtin_amdgcn_rsqf(ssum * (1.0f / 256.0f) + EPS);
        bf16_t* const og = ZY + grow * DI + g * 256 + 8 * (lane & 15);
#pragma unroll
        for (int h = 0; h < 2; ++h) {
#pragma unroll
            for (int rr = 0; rr < 2; ++rr)
#pragma unroll
                for (int pf = 0; pf < 4; ++pf) { const int r = 2 * h + rr, ch = 8 * rr + 2 * pf + (gq >> 1);
                    u32x2 o; o.x = cvt_pk_bf16(acc[r][pf][0] * rsn, acc[r][pf][1] * rsn); o.y = cvt_pk_bf16(acc[r][pf][2] * rsn, acc[r][pf][3] * rsn);
                    *(LAS u32x2*)(stg + ql * 256 + ((ch ^ ql) & 15) * 16 + (gq & 1) * 8) = o; }
            asm volatile("s_waitcnt lgkmcnt(0)" ::: "memory");
#pragma unroll
            for (int i = 0; i < 4; ++i) { const int row = 4 * i + (lane >> 4); const u32x4 v = *(const LAS u32x4*)(stg + row * 256 + (((lane & 15) ^ row) & 15) * 16); *(GAS u32x4*)(og + (size_t)(4 * i) * DI + 128 * h) = v; }
            asm volatile("s_waitcnt lgkmcnt(0)" ::: "memory");
        }
        __syncthreads();
    }
}

__device__ __forceinline__ void ssd_seq_phase(Frame& F) {
    const int r = F.wave & 3, nh = F.wave >> 2, lane = F.lane, idx = r * 64 + lane;
    LAS float* const bc = (LAS float*)F.lds;
    LAS float* const lxs = bc + 2048;
    LAS float* const yp = bc + 4096;
    LAS float* const ldt = bc + 8192; LAS float* const ssq = bc + 8192 + 32;
    const bf16_t* const XBC = (const bf16_t*)(F.ws + WS_XBC); const bf16_t* const Zs = (const bf16_t*)(F.ws + WS_Z); bf16_t* const YN = (bf16_t*)(F.ws + WS_Z);
    const float* const DT = (const float*)(F.ws + WS_DT);
    const float* const convw = F.in[I_CONVW]; const float* const convb = F.in[I_CONVB];
    for (int it = F.vcu; it < DECB * NG; it += F.G) {
        const int b = it >> 3, g = it & 7, head = g * HPG + r;
        const size_t row0 = (size_t)MP + (size_t)b * DECS;
        const int xch = g * 256 + idx;
        {
            const int ch = (nh == 0) ? ((idx < 128) ? (DI + g * DSTATE + idx) : (DI + NG * DSTATE + g * DSTATE + (idx - 128))) : xch;
            float cw[4];
#pragma unroll
            for (int k = 0; k < 4; ++k) cw[k] = *(const GAS float*)(convw + (size_t)k * CD + ch);
            const float cbv = *(const GAS float*)(convb + ch);
            const float* cs = F.in[I_CONV] + (size_t)b * 3 * CD;
            float x3 = *(const GAS float*)(cs + ch), x2 = *(const GAS float*)(cs + CD + ch), x1 = *(const GAS float*)(cs + 2 * CD + ch);
            LAS float* const dst = (nh == 0) ? bc : lxs;
#pragma unroll
            for (int j = 0; j < 8; ++j) {
                const float xr = bf2f(*(const GAS bf16_t*)(XBC + (row0 + j) * CD + ch));
                const float cx = cbv + cw[0] * x3 + cw[1] * x2 + cw[2] * x1 + cw[3] * xr; x3 = x2; x2 = x1; x1 = xr;
                dst[j * 256 + idx] = silu_f(cx);
            }
            if (nh == 1 && lane < 8) ldt[lane * 4 + r] = *(const GAS float*)(DT + (row0 + lane) * 32 + head);
        }
        __syncthreads();
        {
            const float Ah = -__expf(*(const GAS float*)(F.in[I_ALOG] + head));
            const int pg = lane >> 4, nc = lane & 15;
            f32x4 h[16];
            const float* const hin = F.in[I_SSM] + (((size_t)b * NH + head) * HD + 16 * pg) * DSTATE + 64 * nh + 4 * nc;
#pragma unroll
            for (int i = 0; i < 16; ++i) h[i] = *(const GAS f32x4*)(hin + (size_t)i * DSTATE);
            for (int j = 0; j < 8; ++j) {
                const float dtv = ldt[j * 4 + r], dA = __expf(dtv * Ah);
                const f32x4 Bv = *(const LAS f32x4*)(bc + j * 256 + 64 * nh + 4 * nc), Cv = *(const LAS f32x4*)(bc + j * 256 + 128 + 64 * nh + 4 * nc);
                float part[16];
#pragma unroll
                for (int i4 = 0; i4 < 4; ++i4) { const f32x4 xs4 = *(const LAS f32x4*)(lxs + j * 256 + r * 64 + 16 * pg + 4 * i4);
#pragma unroll
                    for (int k = 0; k < 4; ++k) { const int i = 4 * i4 + k; const float dx = dtv * xs4[k];
                        h[i] = h[i] * dA + Bv * dx;
                        part[i] = (Cv.x * h[i].x + Cv.y * h[i].y) + (Cv.z * h[i].z + Cv.w * h[i].w); } }
#pragma unroll
                for (int i = 0; i < 8; ++i) { const bool up = (nc & 8) != 0; const float keep = up ? part[i + 8] : part[i], send = up ? part[i] : part[i + 8]; part[i] = keep + __shfl_xor(send, 8); }
#pragma unroll
                for (int i = 0; i < 4; ++i) { const bool up = (nc & 4) != 0; const float keep = up ? part[i + 4] : part[i], send = up ? part[i] : part[i + 4]; part[i] = keep + __shfl_xor(send, 4); }
#pragma unroll
                for (int i = 0; i < 2; ++i) { const bool up = (nc & 2) != 0; const float keep = up ? part[i + 2] : part[i], send = up ? part[i] : part[i + 2]; part[i] = keep + __shfl_xor(send, 2); }
                { const bool up = (nc & 1) != 0; const float keep = up ? part[1] : part[0], send = up ? part[0] : part[1]; part[0] = keep + __shfl_xor(send, 1); }
                yp[(j * 2 + nh) * 256 + r * 64 + 16 * pg + nc] = part[0];
            }
            float* const hout = F.out + O_SSM_S + (((size_t)b * NH + head) * HD + 16 * pg) * DSTATE + 64 * nh + 4 * nc;
#pragma unroll
            for (int i = 0; i < 16; ++i) *(GAS f32x4*)(hout + (size_t)i * DSTATE) = h[i];
        }
        __syncthreads();
        float ygv[4];
        {
            const float Dh = *(const GAS float*)(F.in[I_DSKIP] + head);
#pragma unroll
            for (int jj = 0; jj < 4; ++jj) { const int j = 4 * nh + jj;
                const float y = (yp[(j * 2) * 256 + idx] + yp[(j * 2 + 1) * 256 + idx]) + Dh * lxs[j * 256 + idx];
                ygv[jj] = y * bf2f(*(const GAS bf16_t*)(Zs + (row0 + j) * DI + xch));
                const float ss = wave_sum(ygv[jj] * ygv[jj]);
                if (lane == 0) ssq[j * 4 + r] = ss; }
        }
        __syncthreads();
#pragma unroll
        for (int jj = 0; jj < 4; ++jj) { const int j = 4 * nh + jj;
            const f32x4 s4 = *(const LAS f32x4*)(ssq + j * 4);
            const float rsn = __builtin_amdgcn_rsqf(((s4.x + s4.y) + (s4.z + s4.w)) * (1.0f / 256.0f) + EPS);
            *(GAS bf16_t*)(YN + (row0 + j) * DI + xch) = (bf16_t)f2bf(ygv[jj] * rsn); }
        __syncthreads();
    }
}
template <int W> __device__ __forceinline__ void pool_run(const bf16_t* V, bf16_t* PO, int run, int cv) {
    const int row0 = run * 16, t0 = row0 & (SEQ - 1);
    u32x4 raw[16 + W - 1];
#pragma unroll
    for (int e = 0; e < 16 + W - 1; ++e) {
        const int dt_ = e - (W - 1);
        if (t0 + dt_ >= 0) raw[e] = *(const GAS u32x4*)(V + (size_t)(row0 + dt_) * PD + cv); else raw[e] = (u32x4){0u, 0u, 0u, 0u};
    }
    f32x4 s0 = (f32x4){0.f, 0.f, 0.f, 0.f}, s1 = s0;
#pragma unroll
    for (int e = 0; e < W - 1; ++e) { f32x4 x0, x1; pg8::unpack8(raw[e], x0, x1); s0 += x0; s1 += x1; }
#pragma unroll
    for (int i = 0; i < 16; ++i) {
        f32x4 c0, c1; pg8::unpack8(raw[i + W - 1], c0, c1);
        s0 += c0; s1 += c1;
        const int t = t0 + i; const float ic = 1.0f / (float)((t + 1 < W) ? t + 1 : W);
        const f32x4 o0 = s0 * ic - c0, o1 = s1 * ic - c1;
        u32x4 o; o.x = pk2(o0.x, o0.y); o.y = pk2(o0.z, o0.w); o.z = pk2(o1.x, o1.y); o.w = pk2(o1.z, o1.w);
        *(GAS u32x4*)(PO + (size_t)(row0 + i) * PD + cv) = o;
        f32x4 x0, x1; pg8::unpack8(raw[i], x0, x1); s0 -= x0; s1 -= x1;
    }
}
template <int W> __device__ __forceinline__ void pool_run_s(const bf16_t* V, bf16_t* PO, const float* sp, int b, int cv) {
    const size_t row0 = (size_t)MP + (size_t)b * DECS;
    f32x4 a0[8 + W - 1], a1[8 + W - 1];
#pragma unroll
    for (int e = 0; e < 8 + W - 1; ++e) { const int t = e - (W - 1);
        if (t >= 0) pg8::unpack8(*(const GAS u32x4*)(V + (row0 + t) * PD + cv), a0[e], a1[e]);
        else { const float* p = sp + ((size_t)b * PBUF + (PBUF + t)) * PD + cv; a0[e] = *(const GAS f32x4*)p; a1[e] = *(const GAS f32x4*)(p + 4); } }
    f32x4 s0 = (f32x4){0.f, 0.f, 0.f, 0.f}, s1 = s0;
#pragma unroll
    for (int e = 0; e < W - 1; ++e) { s0 += a0[e]; s1 += a1[e]; }
    const float ic = 1.0f / (float)W;
#pragma unroll
    for (int i = 0; i < 8; ++i) {
        s0 += a0[i + W - 1]; s1 += a1[i + W - 1];
        const f32x4 o0 = s0 * ic - a0[i + W - 1], o1 = s1 * ic - a1[i + W - 1];
        u32x4 o; o.x = pk2(o0.x, o0.y); o.y = pk2(o0.z, o0.w); o.z = pk2(o1.x, o1.y); o.w = pk2(o1.z, o1.w);
        *(GAS u32x4*)(PO + (row0 + i) * PD + cv) = o;
        s0 -= a0[i]; s1 -= a1[i];
    }
}
__device__ __forceinline__ void pool_phase(Frame& F) {
    const bf16_t* const V = (const bf16_t*)(F.ws + WS_V); bf16_t* const PO = (bf16_t*)(F.out + O_Y);
    const float* const sp = F.in[I_POOL];
    const int gt = F.vcu * NTHREADS + F.tid, NT = F.G * NTHREADS;
    for (int e = gt; e < (MP / 16) * 128; e += NT) {
        const int c32 = e & 31, rl = (e >> 5) & 1, grp = (e >> 6) & 3, run = (e >> 8) * 2 + rl, cv = (grp * 32 + c32) * 8;
        if (grp == 0) pool_run<2>(V, PO, run, cv); else if (grp == 1) pool_run<4>(V, PO, run, cv); else if (grp == 2) pool_run<8>(V, PO, run, cv); else pool_run<16>(V, PO, run, cv);
    }
    for (int e = gt; e < (MS / 8) * 128; e += NT) {
        const int c32 = e & 31, grp = (e >> 5) & 3, b = e >> 7, cv = (grp * 32 + c32) * 8;
        if (grp == 0) pool_run_s<2>(V, PO, sp, b, cv); else if (grp == 1) pool_run_s<4>(V, PO, sp, b, cv); else if (grp == 2) pool_run_s<8>(V, PO, sp, b, cv); else pool_run_s<16>(V, PO, sp, b, cv);
    }
    float* const ops = F.out + O_POOL_S;
    for (int e = gt; e < DECB * 7 * (PD / 4); e += NT) {
        const int c4 = e & 255, i = (e >> 8) % 7, b = (e >> 8) / 7;
        *(GAS f32x4*)(ops + ((size_t)b * PBUF + i) * PD + c4 * 4) = *(const GAS f32x4*)(sp + ((size_t)b * PBUF + 8 + i) * PD + c4 * 4);
    }
}
__device__ __forceinline__ void final_phase(Frame& F) {
    const int gw = F.vcu * NWAVES + F.wave, NGW = F.G * NWAVES, lane = F.lane;
    const float* const st = (const float*)(F.ws + WS_STATS_A); const float* const gf = F.in[I_NFINAL];
    f32x4 gv[4];
#pragma unroll
    for (int j = 0; j < 4; ++j) gv[j] = *((const GAS f32x4*)gf + lane + 64 * j);
    const bf16_t* const h4 = (const bf16_t*)(F.ws + WS_ACT);
    for (int m = gw; m < M; m += NGW) {
        const GAS f32x4* sp = (const GAS f32x4*)(st + (size_t)m * 16);
        const f32x4 a = sp[0], b = sp[1], c = sp[2], d = sp[3]; const f32x4 s = (a + b) + (c + d);
        const float rs = __builtin_amdgcn_rsqf(((s[0] + s[1]) + (s[2] + s[3])) * (1.0f / 1024.0f) + EPS);
        const GAS u32x2* hr = (const GAS u32x2*)(h4 + (size_t)m * DM) + lane;
        GAS f32x4* yr = (GAS f32x4*)(F.out + (size_t)m * DM) + lane;
#pragma unroll
        for (int j = 0; j < 4; ++j) { const u32x2 w = hr[64 * j]; yr[64 * j] = (f32x4){bflo(w.x), bfhi(w.x), bflo(w.y), bfhi(w.y)} * rs * gv[j]; }
    }
}

constexpr int NPHASES = 13;
struct Args { const float* in[30]; float* out; unsigned char* ws; int ph_lo, ph_hi, li, pad; };
__global__ void __launch_bounds__(NTHREADS, 2) mk_fwd(Args args) {
    extern __shared__ __attribute__((aligned(16))) unsigned char lds[];
    Frame F;
    F.lds = (LAS unsigned char*)lds;
    F.MISC = (volatile LAS unsigned*)(F.lds + MISC_OFF);
    F.tid = threadIdx.x; F.lane = F.tid & 63; F.wave = __builtin_amdgcn_readfirstlane(F.tid >> 6);
    F.G = gridDim.x; { const int bx = blockIdx.x; F.vcu = (F.G % 8 == 0) ? (bx % 8) * (F.G / 8) + bx / 8 : bx; }
    F.ws = args.ws; F.out = args.out; F.ctl = (gu32*)(args.ws + WS_CTL);
#pragma unroll
    for (int i = 0; i < 30; ++i) F.in[i] = args.in[i];
    for (int u = F.tid; u < (LDS_BYTES - LDSCTL_OFF) / 4; u += NTHREADS) ((LAS unsigned*)(F.lds + LDSCTL_OFF))[u] = 0u;
    __syncthreads();
    const int lo = args.ph_lo, hi = args.ph_hi;
    XcdBarrier bar; bar.bar = (unsigned*)(F.ctl + CW_BAR); bar.x = 0; bar.st = nullptr;
    if (hi - lo > 1) bar = xcd_barrier_post((unsigned*)(F.ctl + CW_BAR), F.MISC + 8);
#ifndef PHMASK
#define PHMASK 0x1fff
#endif
#define IN(k) (((PHMASK >> (k)) & 1) && lo <= (k) && (k) < hi)
#define SEAM(k) do { if (IN(k) && IN((k) + 1)) xcd_barrier(bar); } while (0)
#define PH_BEGIN(k) if (IN(k)) { auto body_ = [&]() __attribute__((always_inline))
#define PH_END(k) ; body_(); if ((REP_MASK >> (k)) & 1) { xcd_barrier(bar); body_(); } } SEAM(k);

    bf16_t* const XB = (bf16_t*)(F.ws + WS_XB); bf16_t* const HB = (bf16_t*)(F.ws + WS_HB); bf16_t* const ACT = (bf16_t*)(F.ws + WS_ACT);
    bf16_t* const Zb = (bf16_t*)(F.ws + WS_Z); bf16_t* const XBCb = (bf16_t*)(F.ws + WS_XBC); bf16_t* const Vb = (bf16_t*)(F.ws + WS_V); bf16_t* const GATES = (bf16_t*)(F.ws + WS_GATES);
    bf16_t* const POOLED = (bf16_t*)(F.out + O_Y); bf16_t* const MERGED = (bf16_t*)(F.ws + WS_MERGED); bf16_t* const Qb = (bf16_t*)(F.ws + WS_Q); bf16_t* const PB = (bf16_t*)(F.ws + WS_PB);
    float* const T1 = (float*)(F.ws + WS_T1); float* const stA = (float*)(F.ws + WS_STATS_A); float* const stB = (float*)(F.ws + WS_STATS_B); float* const DTb = (float*)(F.ws + WS_DT);
    float* const H = F.out + O_Y;
    pg8::StaticOrder S;

    PH_BEGIN(0) { p0_prologue(F); } PH_END(0)
    PH_BEGIN(1) {
        pg8::Gemm g{XB, (const bf16_t*)(F.ws + WS_WGU1), M, 2 * DFF, DM, DM, 0}; S.init(M, 2 * DFF, F.G, (int)blockIdx.x);
        pg8::Epi E{}; E.kind = pg8::EK_GU; E.stats_in = stA; E.obf = ACT; E.ldo = DFF;
        pg8::gemm_phase(F.lds, g, S, E);
        pg8::Gemm g2{(const bf16_t*)(F.ws + WS_WPOT), (const bf16_t*)(F.ws + WS_WGRP), DM, DM, 256, DM, 256}; S.init_tail(DM, DM, F.G, (int)blockIdx.x);
        pg8::Epi E2{}; E2.kind = pg8::EK_BF16; E2.obf = (bf16_t*)(F.ws + WS_W2); E2.ldo = DM;
        pg8::gemm_phase(F.lds, g2, S, E2);
    } PH_END(1)
    PH_BEGIN(2) {
        pg8::Gemm g{ACT, (const bf16_t*)(F.ws + WS_WD1), M, DM, DFF, DFF, 0}; S.init(MP, DM, F.G, (int)blockIdx.x);
        pg8::Epi E{}; E.kind = pg8::EK_RES; E.coef = 0.5f; E.res_p = F.in[I_XP]; E.res_s = F.in[I_XS]; E.obf = HB; E.stats_out = stB;
        pg8::gemm_phase(F.lds, g, S, E);
        pg8::gemm_small(F.lds, g, E, MP, MS, F.G, (int)blockIdx.x);
    } PH_END(2)
    PH_BEGIN(3) {
        pg8::Gemm g{HB, (const bf16_t*)(F.ws + WS_WIN), M, NIN, DM, DM, 0}; S.init(M, NIN, F.G, (int)blockIdx.x);
        pg8::Epi E{}; E.kind = pg8::EK_WIN; E.stats_in = stB; E.Z = Zb; E.XBC = XBCb; E.V = Vb; E.GATES = GATES; E.HALO = (bf16_t*)(F.ws + WS_HALO); E.DT = DTb; E.dt_bias = F.in[I_DTB];
        E.conv_p = F.out + O_CONV_P; E.conv_s = F.out + O_CONV_S; E.pool_p = F.out + O_POOL_P; E.pool_s = F.out + O_POOL_S;
        pg8::gemm_phase(F.lds, g, S, E);
    } PH_END(3)
    PH_BEGIN(4) { ssd_local_phase(F); pool_phase(F); } PH_END(4)
    PH_BEGIN(5) { ssd_scan_phase(F);

        pg8::Gemm g{PB, (const bf16_t*)(F.ws + WS_WPLE), M, DM, PLE, PLE, 0}; S.init(MP, DM, F.G, (int)blockIdx.x);
        pg8::Epi E{}; E.kind = pg8::EK_BF16; E.obf = Qb; E.ldo = DM;
        pg8::gemm_phase(F.lds, g, S, E);
        pg8::gemm_small(F.lds, g, E, MP, MS, F.G, (int)blockIdx.x);
        } PH_END(5)
    PH_BEGIN(6) { ssd_final_phase(F); ssd_seq_phase(F); } PH_END(6)
    PH_BEGIN(7) {
        pg8::Gemm2 g{Zb, (const bf16_t*)(F.ws + WS_WSSO), POOLED, (const bf16_t*)(F.ws + WS_W2), DI, DI, DM, DM, DM}; S.init(MP, DM, F.G, (int)blockIdx.x);
        pg8::gemm_phase2(F.lds, g, S, GATES, MERGED);
        pg8::gemm_small2(F.lds, g, GATES, MERGED, MP, MS, F.G, (int)blockIdx.x);
    } PH_END(7)
    PH_BEGIN(8) {
        pg8::Gemm g{MERGED, (const bf16_t*)(F.ws + WS_WO), M, DM, DM, DM, 0}; S.init(MP, DM, F.G, (int)blockIdx.x);
        pg8::Epi E{}; E.kind = pg8::EK_RES; E.coef = 1.0f; E.res_bf = HB; E.obf = HB; E.stats_out = stA;
        pg8::gemm_phase(F.lds, g, S, E);
        pg8::gemm_small(F.lds, g, E, MP, MS, F.G, (int)blockIdx.x);
    } PH_END(8)
    PH_BEGIN(9) {
        pg8::Gemm g{HB, (const bf16_t*)(F.ws + WS_WGU2), M, 2 * DFF, DM, DM, 0}; S.init(M, 2 * DFF, F.G, (int)blockIdx.x);
        pg8::Epi E{}; E.kind = pg8::EK_GU; E.stats_in = stA; E.obf = ACT; E.ldo = DFF;
        pg8::gemm_phase(F.lds, g, S, E);
    } PH_END(9)
    PH_BEGIN(10) {
        pg8::Gemm g{ACT, (const bf16_t*)(F.ws + WS_WD2), M, DM, DFF, DFF, 0}; S.init(MP, DM, F.G, (int)blockIdx.x);
        pg8::Epi E{}; E.kind = pg8::EK_RES; E.coef = 0.5f; E.res_bf = HB; E.obf = HB; E.stats_out = stB;
        pg8::gemm_phase(F.lds, g, S, E);
        pg8::gemm_small(F.lds, g, E, MP, MS, F.G, (int)blockIdx.x);
    } PH_END(10)
    PH_BEGIN(11) {
        pg8::Gemm g{HB, (const bf16_t*)(F.ws + WS_WPG), M, DM, DM, DM, 0}; S.init(MP, DM, F.G, (int)blockIdx.x);
        pg8::Epi E{}; E.kind = pg8::EK_PLE; E.stats_in = stB; E.q = Qb; E.res_bf = HB; E.obf = ACT; E.stats_out = stA;
        pg8::gemm_phase(F.lds, g, S, E);
        pg8::gemm_small(F.lds, g, E, MP, MS, F.G, (int)blockIdx.x);
    } PH_END(11)
    PH_BEGIN(12) { final_phase(F); } PH_END(12)
#undef IN
#undef SEAM
#undef PH_BEGIN
#undef PH_END
}

extern "C" void kernel_launch(void* const* d_in, const int* in_sizes, int n_in, void* d_out, int out_size, void* d_ws, size_t ws_size, hipStream_t stream) {
    static int grid = 0;
    if (grid == 0) {
        if (n_in != 30 || in_sizes[0] != MP * DM || (size_t)out_size != O_END || ws_size < WS_END) {
            fprintf(stderr, "kernel_launch: shape mismatch: n_in %d in0 %d out %d ws %zu (need %zu)\n", n_in, n_in > 0 ? in_sizes[0] : -1, out_size, ws_size, (size_t)WS_END); grid = -1; return; }
        int dev = 0, cus = 0, per_cu = 0;
        if (hipGetDevice(&dev) != hipSuccess || hipDeviceGetAttribute(&cus, hipDeviceAttributeMultiprocessorCount, dev) != hipSuccess) { grid = -1; return; }
        if (hipFuncSetAttribute((const void*)mk_fwd, hipFuncAttributeMaxDynamicSharedMemorySize, LDS_BYTES) != hipSuccess) { fprintf(stderr, "kernel_launch: hipFuncSetAttribute failed\n"); grid = -1; return; }
        if (hipOccupancyMaxActiveBlocksPerMultiprocessor(&per_cu, (const void*)mk_fwd, NTHREADS, LDS_BYTES) != hipSuccess || per_cu < 1)
            fprintf(stderr, "kernel_launch: occupancy query reports %d workgroups per CU\n", per_cu);
        (void)hipGetLastError();
        grid = cus;
    }
    if (grid < 0) return;
    if (hipMemsetAsync((char*)d_ws + WS_CTL, 0, CTL_ZERO_BYTES, stream) != hipSuccess) { fprintf(stderr, "kernel_launch: memset failed\n"); return; }
    Args a{};
    for (int i = 0; i < 30; ++i) a.in[i] = (const float*)d_in[i];
    a.out = (float*)d_out; a.ws = (unsigned char*)d_ws;
#if MK_MULTI_LAUNCH
    for (int ph = 0; ph < NPHASES; ++ph) { a.ph_lo = ph; a.ph_hi = ph + 1; a.li = ph;
        hipLaunchKernelGGL(mk_fwd, dim3(grid), dim3(NTHREADS), LDS_BYTES, stream, a); }
#else
    a.ph_lo = 0; a.ph_hi = NPHASES; a.li = 0;
    hipLaunchKernelGGL(mk_fwd, dim3(grid), dim3(NTHREADS), LDS_BYTES, stream, a);
#endif
}
```

```cpp
#include <hip/hip_runtime.h>
#include <cstdio>
#include <cstdint>

#define REP_MASK 0x0
#ifndef MK_MULTI_LAUNCH
#define MK_MULTI_LAUNCH 0
#endif

#define GAS __attribute__((address_space(1)))
#define LAS __attribute__((address_space(3)))
typedef unsigned short bf16_t;
typedef short bf16x8 __attribute__((ext_vector_type(8)));
typedef float f32x4 __attribute__((ext_vector_type(4)));
typedef float f32x2 __attribute__((ext_vector_type(2)));
typedef unsigned u32x4 __attribute__((ext_vector_type(4)));
typedef unsigned u32x2 __attribute__((ext_vector_type(2)));
typedef GAS unsigned gu32;

constexpr int DM = 1024, BATCH = 8, SEQ = 2048, DECB = 128, DECS = 8;
constexpr int MP = BATCH * SEQ, MS = DECB * DECS, M = MP + MS;
constexpr int DI = 2048, HD = 64, NH = 32, NG = 8, HPG = 4, DSTATE = 128, CD = 4096;
constexpr int PD = 1024, PBUF = 15, DFF = 2816, PLE = 256;
constexpr int IN_DIM = 9248, NIN = 9472;
constexpr float EPS = 1e-6f;
constexpr int NWAVES = 8, NTHREADS = 512;

constexpr size_t MiB = 1u << 20;
constexpr size_t WS_CTL = 0, CTL_ZERO_BYTES = 32768;
constexpr size_t WS_STATS_A = 2 * MiB, WS_STATS_B = 4 * MiB, WS_DT = 6 * MiB, WS_CDEC = 9 * MiB;
constexpr size_t WS_WGU1 = 10 * MiB, WS_WD1 = 21 * MiB, WS_WIN = 27 * MiB, WS_WSSO = 46 * MiB, WS_W2 = 50 * MiB, WS_WO = 52 * MiB,
                 WS_WGU2 = 54 * MiB, WS_WD2 = 65 * MiB, WS_WPG = 71 * MiB, WS_WPLE = 73 * MiB, WS_PB = 74 * MiB, WS_WPOT = 480 * MiB, WS_WGRP = 483 * MiB;
constexpr size_t WS_Z = 84 * MiB, WS_XBC = 152 * MiB, WS_V = 288 * MiB, WS_GATES = 322 * MiB, WS_HB = 390 * MiB, WS_HPREV = 424 * MiB, WS_HALO = 488 * MiB, WS_EAQ = 492 * MiB, WS_END = 495 * MiB;
constexpr size_t WS_ACT = WS_XBC, WS_T1 = WS_XBC, WS_MERGED = 220 * MiB, WS_Q = WS_V, WS_XB = WS_HB;
static_assert(WS_STATS_A + (size_t)M * 16 * 4 <= WS_STATS_B && WS_STATS_B + (size_t)M * 16 * 4 <= WS_DT && WS_DT + (size_t)M * 32 * 4 <= WS_WGU1, "ws map (small)");
static_assert(WS_WGU1 + (size_t)2 * DFF * DM * 2 <= WS_WD1 && WS_WD1 + (size_t)DM * DFF * 2 <= WS_WIN && WS_WIN + (size_t)NIN * DM * 2 <= WS_WSSO && WS_WSSO + (size_t)DM * DI * 2 <= WS_W2, "ws map (w1)");
static_assert(WS_WGU2 + (size_t)2 * DFF * DM * 2 <= WS_WD2 && WS_WD2 + (size_t)DM * DFF * 2 <= WS_WPG && WS_WPLE + (size_t)DM * PLE * 2 <= WS_PB && WS_PB + (size_t)M * PLE * 2 <= WS_Z, "ws map (w2)");
static_assert(WS_Z + (size_t)M * DI * 2 <= WS_XBC && WS_XBC + (size_t)M * CD * 2 <= WS_V && WS_V + (size_t)M * PD * 2 <= WS_GATES && WS_GATES + (size_t)M * 2 * DM * 2 <= WS_HB &&
              WS_HB + (size_t)M * DM * 2 <= WS_HPREV && WS_HPREV + (size_t)BATCH * 16 * NH * HD * DSTATE * 2 <= WS_END, "ws map (act)");
static_assert(WS_ACT + (size_t)M * DFF * 2 <= WS_V && WS_T1 + (size_t)M * DM * 4 <= WS_MERGED && WS_MERGED + (size_t)M * DM * 2 <= WS_V, "ws overlays");
constexpr int CW_BAR = 4096;

constexpr size_t O_Y = 0, O_SSM_P = (size_t)M * DM, O_CONV_P = O_SSM_P + (size_t)BATCH * NH * HD * DSTATE, O_POOL_P = O_CONV_P + (size_t)BATCH * 3 * CD,
                 O_SSM_S = O_POOL_P + (size_t)BATCH * PBUF * PD, O_CONV_S = O_SSM_S + (size_t)DECB * NH * HD * DSTATE, O_POOL_S = O_CONV_S + (size_t)DECB * 3 * CD,
                 O_END = O_POOL_S + (size_t)DECB * PBUF * PD;

constexpr int RING_BYTES = 131072, LDSCTL_OFF = RING_BYTES, MISC_OFF = LDSCTL_OFF + 320, LDS_BYTES = 147456;

#define RLX_AGENT __ATOMIC_RELAXED, __HIP_MEMORY_SCOPE_AGENT
#define LDS_WAIT() asm volatile("s_waitcnt lgkmcnt(0)" ::: "memory")
#define VM_WAIT() asm volatile("s_waitcnt vmcnt(0)" ::: "memory")

__device__ __forceinline__ unsigned f2bf(float f) { unsigned u = __builtin_bit_cast(unsigned, f); return (u + 0x7fffu + ((u >> 16) & 1u)) >> 16; }
__device__ __forceinline__ unsigned cvt_pk_bf16(float lo, float hi);
__device__ __forceinline__ unsigned pk2(float lo, float hi) { return cvt_pk_bf16(lo, hi); }
__device__ __forceinline__ float bf2f(unsigned b) { return __builtin_bit_cast(float, b << 16); }
__device__ __forceinline__ float bflo(unsigned w) { return __builtin_bit_cast(float, w << 16); }
__device__ __forceinline__ float bfhi(unsigned w) { return __builtin_bit_cast(float, w & 0xffff0000u); }
typedef __bf16 bf16x2_t __attribute__((ext_vector_type(2)));
__device__ __forceinline__ unsigned cvt_pk_bf16(float lo, float hi) { const bf16x2_t v = {(__bf16)lo, (__bf16)hi}; return __builtin_bit_cast(unsigned, v); }
__device__ __forceinline__ float sigm_f(float x) { return __builtin_amdgcn_rcpf(1.0f + __expf(-x)); }
__device__ __forceinline__ float silu_f(float x) { return x * __builtin_amdgcn_rcpf(1.0f + __expf(-x)); }
__device__ __forceinline__ float wave_sum(float v) {
#pragma unroll
    for (int o = 1; o < 64; o <<= 1) v += __shfl_xor(v, o);
    return v;
}

struct Frame {
    LAS unsigned char* lds;
    volatile LAS unsigned* MISC;
    gu32* ctl;
    int tid, lane, wave, vcu, G;
    unsigned char* ws;
    float* out;
    const float* in[30];
};
enum { I_XP = 0, I_XS, I_SSM, I_CONV, I_POOL, I_PP, I_PS, I_NFFN1, I_WGU1, I_WD1, I_NMIX, I_WIN, I_CONVW, I_CONVB, I_DTB, I_ALOG, I_DSKIP, I_NSSD, I_WSSO, I_WPGRP, I_PSCALE,
       I_WPOUT, I_WO, I_NFFN2, I_WGU2, I_WD2, I_NPLE, I_WPG, I_WPLE, I_NFINAL };

namespace pg8 {
constexpr int BM = 256, BK = 64, HALF = 128, HTB = HALF * BK * 2, STAGE_BYTES = 8 * HTB, NXCD = 8, WGM = 4;
__host__ __device__ __forceinline__ int lds_byte(int r, int c) { const int st = (r >> 4) * 2 + (c >> 5), rr = r & 15, cc = c & 31, ob = rr * 64 + cc * 2; return st * 1024 + (ob ^ (((ob >> 9) & 1) << 5)); }
__host__ __device__ __forceinline__ void stage_rc(int b, int& R, int& C) { const int st = b / 1024, sb = b % 1024, swz = sb ^ (((sb >> 9) & 1) << 5); R = (st >> 1) * 16 + swz / 64; C = (st & 1) * 32 + (swz % 64) / 2; }
__host__ __device__ __forceinline__ int perm32(int rho) { const int n = rho >> 4, i = rho & 15; return 8 * (i >> 2) + 4 * n + (i & 3); }
struct Unit { int pm, pn; };
struct Gemm { const bf16_t* A; const bf16_t* Bt; int M, N, K; int lda; int a_pn_step; };
struct StaticOrder {
    int nM, nN, nwg, G, c, lim;
    __host__ __device__ void init(int M_, int N_, int G_, int c_) { nM = M_ / BM; nN = N_ / BM; nwg = nM * nN; G = G_; c = c_; lim = nwg; }
    __host__ __device__ void init_tail(int M_, int N_, int G_, int c_) { init(M_, N_, G_, (G_ - 1) - c_); }
    __host__ __device__ bool next(int i, Unit& u) const {
        const long L = (long)i * G + c; if (L >= lim) return false;
        int wgid = (int)L; { const int q = nwg / NXCD, r = nwg % NXCD, xcd = wgid % NXCD, off = wgid / NXCD; wgid = (xcd < r ? xcd * (q + 1) : r * (q + 1) + (xcd - r) * q) + off; }
        const int nig = WGM * nN, gid = wgid / nig, fm = gid * WGM, gsz = (nM - fm) < WGM ? (nM - fm) : WGM;
        u.pm = fm + ((wgid % nig) % gsz); u.pn = (wgid % nig) / gsz; return true;
    }
};

enum EpiKind { EK_GU = 1, EK_RES = 2, EK_WIN = 3, EK_T1 = 4, EK_MERGE = 5, EK_BF16 = 6, EK_PLE = 7 };
struct Epi {
    const float* stats_in;
    float* stats_out;
    bf16_t* obf;
    float* of32;
    const float* res_p; const float* res_s;
    const bf16_t* res_bf;
    const bf16_t* gates;
    const bf16_t* q;
    bf16_t *Z, *XBC, *V, *GATES, *HALO; float* DT; const float* dt_bias; float *conv_p, *conv_s, *pool_p, *pool_s;
    int kind; int ldo; float coef; int pad;
};

__device__ __forceinline__ u32x4 pack8(const f32x4 a, const f32x4 b) { u32x4 w; w.x = cvt_pk_bf16(a[0], a[1]); w.y = cvt_pk_bf16(a[2], a[3]); w.z = cvt_pk_bf16(b[0], b[1]); w.w = cvt_pk_bf16(b[2], b[3]); return w; }
__device__ __forceinline__ void unpack8(const u32x4 w, f32x4& a, f32x4& b) { a = (f32x4){bflo(w.x), bfhi(w.x), bflo(w.y), bfhi(w.y)}; b = (f32x4){bflo(w.z), bfhi(w.z), bflo(w.w), bfhi(w.w)}; }

__device__ __forceinline__ float row_rs(const float* stats, int row) {
    if (!stats) return 1.0f;
    const GAS f32x4* sp = (const GAS f32x4*)(stats + (size_t)row * 16);
    const f32x4 a = sp[0], b = sp[1], c = sp[2], d = sp[3]; const f32x4 s = (a + b) + (c + d);
    return __builtin_amdgcn_rsqf(((s[0] + s[1]) + (s[2] + s[3])) * (1.0f / 1024.0f) + EPS);
}
__device__ __forceinline__ float softplus_f(float x) { const float e = __expf(-fabsf(x)); const float l = (e < 0.01f) ? e * (1.0f - e * (0.5f - e * (1.0f / 3.0f))) : __logf(1.0f + e); return fmaxf(x, 0.f) + l; }

__device__ __forceinline__ void epilogue(const Epi& E, const f32x4 (&acc)[2][2][4][2], const Unit& u, int wr, int wc, int fr, int fq) {
    const int rowb = u.pm * BM + wr * 64 + fr;
    const int cin = wc * 32 + 8 * fq;
    if (E.kind == EK_GU) {
#pragma unroll
        for (int ai = 0; ai < 2; ++ai)
#pragma unroll
            for (int m = 0; m < 4; ++m) { const int row = rowb + ai * HALF + m * 16; const float r = row_rs(E.stats_in, row);
                const f32x4 g0 = acc[ai][0][m][0] * r, u0 = acc[ai][1][m][0] * r, g1 = acc[ai][0][m][1] * r, u1 = acc[ai][1][m][1] * r;
                const f32x4 o0 = (f32x4){silu_f(g0[0]) * u0[0], silu_f(g0[1]) * u0[1], silu_f(g0[2]) * u0[2], silu_f(g0[3]) * u0[3]};
                const f32x4 o1 = (f32x4){silu_f(g1[0]) * u1[0], silu_f(g1[1]) * u1[1], silu_f(g1[2]) * u1[2], silu_f(g1[3]) * u1[3]};
                *(GAS u32x4*)(E.obf + (size_t)row * E.ldo + u.pn * HALF + cin) = pack8(o0, o1); }
    } else if (E.kind == EK_RES) {
#pragma unroll
        for (int ai = 0; ai < 2; ++ai)
#pragma unroll
            for (int m = 0; m < 4; ++m) { const int row = rowb + ai * HALF + m * 16;
                float ss = 0.f;
#pragma unroll
                for (int bj = 0; bj < 2; ++bj) { const int col = u.pn * BM + bj * HALF + cin;
                    f32x4 r0, r1;
                    if (E.res_p) { const float* rp = (row < MP) ? E.res_p + (size_t)row * DM : E.res_s + (size_t)(row - MP) * DM; r0 = *(const GAS f32x4*)(rp + col); r1 = *(const GAS f32x4*)(rp + col + 4); }
                    else unpack8(*(const GAS u32x4*)(E.res_bf + (size_t)row * DM + col), r0, r1);
                    const f32x4 h0 = r0 + acc[ai][bj][m][0] * E.coef, h1 = r1 + acc[ai][bj][m][1] * E.coef;
                    *(GAS u32x4*)(E.obf + (size_t)row * DM + col) = pack8(h0, h1);
                    ss += (h0[0] * h0[0] + h0[1] * h0[1]) + (h0[2] * h0[2] + h0[3] * h0[3]) + (h1[0] * h1[0] + h1[1] * h1[1]) + (h1[2] * h1[2] + h1[3] * h1[3]); }
                ss += __shfl_xor(ss, 16); ss += __shfl_xor(ss, 32);
                if (fq == 0) *(GAS float*)(E.stats_out + (size_t)row * 16 + u.pn * 4 + wc) = ss; }
    } else if (E.kind == EK_WIN) {
        const int pn = u.pn;
        if (pn < 8) {
            const int colt = pn * BM + cin;
#pragma unroll
            for (int ai = 0; ai < 2; ++ai)
#pragma unroll
                for (int m = 0; m < 4; ++m) { const int row = rowb + ai * HALF + m * 16; const float r = row_rs(E.stats_in, row);
#pragma unroll
                    for (int bj = 0; bj < 2; ++bj) { f32x4 v0 = acc[ai][bj][m][0] * r, v1 = acc[ai][bj][m][1] * r;
#pragma unroll
                        for (int j = 0; j < 4; ++j) { v0[j] = silu_f(v0[j]); v1[j] = silu_f(v1[j]); }
                        *(GAS u32x4*)(E.Z + (size_t)row * DI + colt + bj * HALF) = pack8(v0, v1); } }
        } else if (pn >= 28 && pn < 36) {
            const int colt = (pn - 28) * BM + cin;
#pragma unroll
            for (int ai = 0; ai < 2; ++ai)
#pragma unroll
                for (int m = 0; m < 4; ++m) { const int row = rowb + ai * HALF + m * 16; const float r = row_rs(E.stats_in, row);
#pragma unroll
                    for (int bj = 0; bj < 2; ++bj) { f32x4 v0 = acc[ai][bj][m][0] * r, v1 = acc[ai][bj][m][1] * r;
#pragma unroll
                        for (int j = 0; j < 4; ++j) { v0[j] = sigm_f(v0[j]); v1[j] = sigm_f(v1[j]); }
                        *(GAS u32x4*)(E.GATES + (size_t)row * (2 * DM) + colt + bj * HALF) = pack8(v0, v1); } }
        } else if (pn < 28) {
            const bool isx = pn < 24; bf16_t* const O = isx ? E.XBC : E.V; const int ldo = isx ? CD : PD; const int colt = (isx ? pn - 8 : pn - 24) * BM + cin;
            const int keep = isx ? 3 : PBUF;
#pragma unroll
            for (int ai = 0; ai < 2; ++ai)
#pragma unroll
                for (int m = 0; m < 4; ++m) { const int row = rowb + ai * HALF + m * 16; const float r = row_rs(E.stats_in, row);
                    float* sp = nullptr;
                    if (row < MP) { const int sb = row >> 11, st = row & (SEQ - 1); if (st >= SEQ - keep) sp = (isx ? E.conv_p : E.pool_p) + ((size_t)sb * keep + (st - (SEQ - keep))) * ldo + colt; }
                    else { const int sb = (row - MP) >> 3, st = (row - MP) & 7; const int si = st - (DECS - keep); if (si >= 0) sp = (isx ? E.conv_s : E.pool_s) + ((size_t)sb * keep + si) * ldo + colt; }
                    bf16_t* hp = nullptr;
                    if (isx && row < MP) { const int st = row & (SEQ - 1), tm = st & 127; if (tm >= 125 && st < SEQ - 3) hp = E.HALO + ((((size_t)(row >> 11) * 16 + (st >> 7) + 1) * 3 + (tm - 125)) * CD) + colt; }
#pragma unroll
                    for (int bj = 0; bj < 2; ++bj) { const f32x4 v0 = acc[ai][bj][m][0] * r, v1 = acc[ai][bj][m][1] * r;
                        const u32x4 pk = pack8(v0, v1);
                        *(GAS u32x4*)(O + (size_t)row * ldo + colt + bj * HALF) = pk;
                        if (hp) *(GAS u32x4*)(hp + bj * HALF) = pk;
                        if (sp) { *(GAS f32x4*)(sp + bj * HALF) = v0; *(GAS f32x4*)(sp + bj * HALF + 4) = v1; } } }
        } else if (wc == 0) {
            const f32x4 b0 = *(const GAS f32x4*)(E.dt_bias + 8 * fq), b1 = *(const GAS f32x4*)(E.dt_bias + 8 * fq + 4);
#pragma unroll
            for (int ai = 0; ai < 2; ++ai)
#pragma unroll
                for (int m = 0; m < 4; ++m) { const int row = rowb + ai * HALF + m * 16; const float r = row_rs(E.stats_in, row);
                    f32x4 v0 = acc[ai][0][m][0] * r + b0, v1 = acc[ai][0][m][1] * r + b1;
#pragma unroll
                    for (int j = 0; j < 4; ++j) { v0[j] = softplus_f(v0[j]); v1[j] = softplus_f(v1[j]); }
                    *(GAS f32x4*)(E.DT + (size_t)row * 32 + 8 * fq) = v0; *(GAS f32x4*)(E.DT + (size_t)row * 32 + 8 * fq + 4) = v1; }
        }
    } else if (E.kind == EK_T1) {
#pragma unroll
        for (int ai = 0; ai < 2; ++ai)
#pragma unroll
            for (int m = 0; m < 4; ++m) { const int row = rowb + ai * HALF + m * 16;
#pragma unroll
                for (int bj = 0; bj < 2; ++bj) { const int col = u.pn * BM + bj * HALF + cin;
                    f32x4 g0, g1; unpack8(*(const GAS u32x4*)(E.gates + (size_t)row * (2 * DM) + col), g0, g1);
                    *(GAS u32x4*)(E.obf + (size_t)row * DM + col) = pack8(g0 * acc[ai][bj][m][0], g1 * acc[ai][bj][m][1]); } }
    } else if (E.kind == EK_MERGE) {
#pragma unroll
        for (int ai = 0; ai < 2; ++ai)
#pragma unroll
            for (int m = 0; m < 4; ++m) { const int row = rowb + ai * HALF + m * 16;
#pragma unroll
                for (int bj = 0; bj < 2; ++bj) { const int col = u.pn * BM + bj * HALF + cin;
                    f32x4 g0, g1; unpack8(*(const GAS u32x4*)(E.gates + (size_t)row * (2 * DM) + DM + col), g0, g1);
                    f32x4 t0, t1; unpack8(*(const GAS u32x4*)(E.res_bf + (size_t)row * DM + col), t0, t1);
                    *(GAS u32x4*)(E.obf + (size_t)row * DM + col) = pack8(t0 + g0 * acc[ai][bj][m][0], t1 + g1 * acc[ai][bj][m][1]); } }
    } else if (E.kind == EK_BF16) {
#pragma unroll
        for (int ai = 0; ai < 2; ++ai)
#pragma unroll
            for (int m = 0; m < 4; ++m) { const int row = rowb + ai * HALF + m * 16;
#pragma unroll
                for (int bj = 0; bj < 2; ++bj) { const int col = u.pn * BM + bj * HALF + cin;
                    *(GAS u32x4*)(E.obf + (size_t)row * E.ldo + col) = pack8(acc[ai][bj][m][0], acc[ai][bj][m][1]); } }
    } else if (E.kind == EK_PLE) {
#pragma unroll
        for (int ai = 0; ai < 2; ++ai)
#pragma unroll
            for (int m = 0; m < 4; ++m) { const int row = rowb + ai * HALF + m * 16; const float r = row_rs(E.stats_in, row);
                float ss = 0.f;
#pragma unroll
                for (int bj = 0; bj < 2; ++bj) { const int col = u.pn * BM + bj * HALF + cin;
                    f32x4 q0, q1; unpack8(*(const GAS u32x4*)(E.q + (size_t)row * DM + col), q0, q1);
                    f32x4 r0, r1; unpack8(*(const GAS u32x4*)(E.res_bf + (size_t)row * DM + col), r0, r1);
                    f32x4 h0, h1;
#pragma unroll
                    for (int j = 0; j < 4; ++j) { h0[j] = r0[j] + sigm_f(acc[ai][bj][m][0][j] * r) * q0[j]; h1[j] = r1[j] + sigm_f(acc[ai][bj][m][1][j] * r) * q1[j]; }
                    *(GAS u32x4*)(E.obf + (size_t)row * DM + col) = pack8(h0, h1);
                    ss += (h0[0] * h0[0] + h0[1] * h0[1]) + (h0[2] * h0[2] + h0[3] * h0[3]) + (h1[0] * h1[0] + h1[1] * h1[1]) + (h1[2] * h1[2] + h1[3] * h1[3]); }
                ss += __shfl_xor(ss, 16); ss += __shfl_xor(ss, 32);
                if (fq == 0) *(GAS float*)(E.stats_out + (size_t)row * 16 + u.pn * 4 + wc) = ss; }
    }
}


__device__ __forceinline__ void epi_seg(const Epi& E, int row, int col, f32x4 v0, f32x4 v1, int lane) {
    if (E.kind == EK_RES) {
        f32x4 r0, r1;
        if (E.res_p) { const float* rp = ((row < MP) ? E.res_p + (size_t)row * DM : E.res_s + (size_t)(row - MP) * DM) + col; r0 = *(const GAS f32x4*)rp; r1 = *(const GAS f32x4*)(rp + 4); }
        else unpack8(*(const GAS u32x4*)(E.res_bf + (size_t)row * DM + col), r0, r1);
        const f32x4 h0 = r0 + v0 * E.coef, h1 = r1 + v1 * E.coef;
        *(GAS u32x4*)(E.obf + (size_t)row * DM + col) = pack8(h0, h1);
        float ss = (h0[0] * h0[0] + h0[1] * h0[1]) + (h0[2] * h0[2] + h0[3] * h0[3]) + (h1[0] * h1[0] + h1[1] * h1[1]) + (h1[2] * h1[2] + h1[3] * h1[3]);
        ss += __shfl_xor(ss, 1); ss += __shfl_xor(ss, 2); ss += __shfl_xor(ss, 4);
        if ((lane & 7) == 0) *(GAS float*)(E.stats_out + (size_t)row * 16 + (col >> 6)) = ss;
    } else if (E.kind == EK_T1) {
        f32x4 g0, g1; unpack8(*(const GAS u32x4*)(E.gates + (size_t)row * (2 * DM) + col), g0, g1);
        *(GAS u32x4*)(E.obf + (size_t)row * DM + col) = pack8(g0 * v0, g1 * v1);
    } else if (E.kind == EK_MERGE) {
        f32x4 g0, g1; unpack8(*(const GAS u32x4*)(E.gates + (size_t)row * (2 * DM) + DM + col), g0, g1);
        f32x4 t0, t1; unpack8(*(const GAS u32x4*)(E.res_bf + (size_t)row * DM + col), t0, t1);
        *(GAS u32x4*)(E.obf + (size_t)row * DM + col) = pack8(t0 + g0 * v0, t1 + g1 * v1);
    } else if (E.kind == EK_BF16) {
        *(GAS u32x4*)(E.obf + (size_t)row * E.ldo + col) = pack8(v0, v1);
    } else if (E.kind == EK_PLE) {
        const float r = row_rs(E.stats_in, row);
        f32x4 q0, q1; unpack8(*(const GAS u32x4*)(E.q + (size_t)row * DM + col), q0, q1);
        f32x4 r0, r1; unpack8(*(const GAS u32x4*)(E.res_bf + (size_t)row * DM + col), r0, r1);
        f32x4 h0, h1;
#pragma unroll
        for (int j = 0; j < 4; ++j) { h0[j] = r0[j] + sigm_f(v0[j] * r) * q0[j]; h1[j] = r1[j] + sigm_f(v1[j] * r) * q1[j]; }
        *(GAS u32x4*)(E.obf + (size_t)row * DM + col) = pack8(h0, h1);
        float ss = (h0[0] * h0[0] + h0[1] * h0[1]) + (h0[2] * h0[2] + h0[3] * h0[3]) + (h1[0] * h1[0] + h1[1] * h1[1]) + (h1[2] * h1[2] + h1[3] * h1[3]);
        ss += __shfl_xor(ss, 1); ss += __shfl_xor(ss, 2); ss += __shfl_xor(ss, 4);
        if ((lane & 7) == 0) *(GAS float*)(E.stats_out + (size_t)row * 16 + (col >> 6)) = ss;
    }
}
__device__ __forceinline__ int sw_off(int row, int ch) { return 256 * row + 16 * (ch ^ (((row & 3) << 2) | ((row >> 2) & 3))); }
__device__ __forceinline__ void small_tile_sum(LAS unsigned char* lds, const bf16_t* A, int lda, const bf16_t* Bt, int K, int r0, int c0, f32x4& v0, f32x4& v1) {
    const int tid = threadIdx.x, wid = __builtin_amdgcn_readfirstlane(tid >> 6), lane = tid & 63, ql = lane & 15, gq = lane >> 4, mw = wid >> 1, nh = wid & 1;
    const int nst = K / 128;
    const char* src[4]; int dst[4];
#pragma unroll
    for (int i = 0; i < 4; ++i) { const int p = 4 * wid + i, isB = p >> 4, row = 4 * (p & 15) + (lane >> 4), cs = lane & 15, ch = cs ^ (((row & 3) << 2) | ((row >> 2) & 3));
        src[i] = isB ? (const char*)(Bt + (size_t)(c0 + (row & ~31) + perm32(row & 31)) * K + 8 * ch) : (const char*)(A + (size_t)(r0 + row) * lda + 8 * ch);
        dst[i] = isB * 16384 + 1024 * (p & 15); }
#define ST_ISSUE(st) do { _Pragma("unroll") for (int _i = 0; _i < 4; ++_i) \
        __builtin_amdgcn_global_load_lds((const unsigned*)(src[_i] + (size_t)(st) * 256), (LAS unsigned*)(lds + ((st) & 3) * 32768 + dst[_i]), 16, 0, 0); } while (0)
    f32x4 acc0 = (f32x4){0.f, 0.f, 0.f, 0.f}, acc1 = acc0;
    int aoff[4], boff0[4], boff1[4];
#pragma unroll
    for (int ks = 0; ks < 4; ++ks) { aoff[ks] = sw_off(16 * mw + ql, 4 * ks + gq); boff0[ks] = 16384 + sw_off(32 * nh + ql, 4 * ks + gq); boff1[ks] = 16384 + sw_off(32 * nh + 16 + ql, 4 * ks + gq); }
    ST_ISSUE(0); if (nst > 1) ST_ISSUE(1); if (nst > 2) ST_ISSUE(2);
    for (int t = 0; t < nst; ++t) {
        const int ahead = (nst - 1 - t) < 2 ? (nst - 1 - t) : 2;
        if (ahead == 2) asm volatile("s_waitcnt vmcnt(8)" ::: "memory"); else if (ahead == 1) asm volatile("s_waitcnt vmcnt(4)" ::: "memory"); else asm volatile("s_waitcnt vmcnt(0)" ::: "memory");
        __builtin_amdgcn_s_barrier(); asm volatile("" ::: "memory");
        if (t + 3 < nst) ST_ISSUE(t + 3);
        const LAS unsigned char* const sl = lds + (t & 3) * 32768;
#pragma unroll
        for (int ks = 0; ks < 4; ++ks) {
            const bf16x8 af = *(const LAS bf16x8*)(sl + aoff[ks]), b0 = *(const LAS bf16x8*)(sl + boff0[ks]), b1 = *(const LAS bf16x8*)(sl + boff1[ks]);
            acc0 = __builtin_amdgcn_mfma_f32_16x16x32_bf16(b0, af, acc0, 0, 0, 0); acc1 = __builtin_amdgcn_mfma_f32_16x16x32_bf16(b1, af, acc1, 0, 0, 0);
        }
        asm volatile("s_waitcnt lgkmcnt(0)" ::: "memory");
    }
#undef ST_ISSUE
    __syncthreads();
    LAS f32x4* const tile = (LAS f32x4*)lds;
    { const int row = 16 * mw + ql, chb = 8 * nh + 2 * gq; tile[row * 16 + (chb ^ (row & 15))] = acc0; tile[row * 16 + ((chb + 1) ^ (row & 15))] = acc1; }
    __syncthreads();
    const int rr = 8 * wid + (lane >> 3), ch0 = 2 * (lane & 7);
    v0 = tile[rr * 16 + (ch0 ^ (rr & 15))]; v1 = tile[rr * 16 + ((ch0 + 1) ^ (rr & 15))];
    __syncthreads();
}
__device__ __forceinline__ void gemm_small(LAS unsigned char* lds, const Gemm g, const Epi& E, int row_base, int nrows, int G, int c) {
    const int tid = threadIdx.x, wid = __builtin_amdgcn_readfirstlane(tid >> 6), lane = tid & 63;
    const int ntn = g.N / 64, ntiles = (nrows / 64) * ntn;
    for (int v = c; v < ntiles; v += G) {
        const int r0 = row_base + 64 * (v / ntn), c0 = 64 * (v % ntn);
        f32x4 v0, v1; small_tile_sum(lds, g.A, g.lda, g.Bt, g.K, r0, c0, v0, v1);
        epi_seg(E, r0 + 8 * wid + (lane >> 3), c0 + 8 * (lane & 7), v0, v1, lane);
    }
}
struct Gemm2 { const bf16_t* A1; const bf16_t* B1; const bf16_t* A2; const bf16_t* B2; int K1, lda1, K2, lda2, N; };
__device__ __forceinline__ void gemm_small2(LAS unsigned char* lds, const Gemm2 g, const bf16_t* gates, bf16_t* out, int row_base, int nrows, int G, int c) {
    const int tid = threadIdx.x, wid = __builtin_amdgcn_readfirstlane(tid >> 6), lane = tid & 63;
    const int ntn = g.N / 64, ntiles = (nrows / 64) * ntn;
    for (int v = c; v < ntiles; v += G) {
        const int r0 = row_base + 64 * (v / ntn), c0 = 64 * (v % ntn), row = r0 + 8 * wid + (lane >> 3), col = c0 + 8 * (lane & 7);
        f32x4 a0, a1, b0, b1;
        small_tile_sum(lds, g.A1, g.lda1, g.B1, g.K1, r0, c0, a0, a1);
        small_tile_sum(lds, g.A2, g.lda2, g.B2, g.K2, r0, c0, b0, b1);
        f32x4 g00, g01, g10, g11; unpack8(*(const GAS u32x4*)(gates + (size_t)row * (2 * DM) + col), g00, g01); unpack8(*(const GAS u32x4*)(gates + (size_t)row * (2 * DM) + DM + col), g10, g11);
        *(GAS u32x4*)(out + (size_t)row * DM + col) = pack8(g00 * a0 + g10 * b0, g01 * a1 + g11 * b1);
    }
}

__device__ __forceinline__ void gemm_phase(LAS unsigned char* lds, const Gemm g, const StaticOrder& S, const Epi& E) {
    const int tid = threadIdx.x, wid = __builtin_amdgcn_readfirstlane(tid >> 6), lane = tid & 63, wr = wid >> 2, wc = wid & 3, fr = lane & 15, fq = lane >> 4;
    const int K = g.K, nt = K / BK;
    unsigned voffA[2], voffB[2];
#pragma unroll
    for (int i = 0; i < 2; ++i) { int R, C; stage_rc(tid * 16 + i * 8192, R, C); const int Rb = (R & ~31) + perm32(R & 31);
        voffA[i] = (unsigned)(R * g.lda + C) * 2u; voffB[i] = (unsigned)(Rb * K + C) * 2u; }
    const size_t kstep = (size_t)(BK * 2);
    const size_t hstep = (size_t)HALF * K * 2, hstepA = (size_t)HALF * g.lda * 2;
    const size_t tstep = 2 * hstep, tstepA = 2 * hstepA, pnstepA = (size_t)g.a_pn_step * 2;
    const unsigned ldsw = (unsigned)wid * 1024u;
    const int aoff = lds_byte(wr * 64 + fr, fq * 8), boff = lds_byte(wc * 32 + fr, fq * 8);
#define PG8_SA(b, h) (((b) * 2 + (h)) * HTB)
#define PG8_SB(b, h) ((4 + (b) * 2 + (h)) * HTB)
#define PG8_STAGE(bufoff, gbase, voff) do { _Pragma("unroll") for (int _i = 0; _i < 2; ++_i) \
        __builtin_amdgcn_global_load_lds((const unsigned*)((const char*)(gbase) + (voff)[_i]), (LAS unsigned*)(lds + (bufoff) + ldsw + _i * 8192), 16, 0, 0); } while (0)
#define PG8_LDA(dst, b, h) do { _Pragma("unroll") for (int m = 0; m < 4; ++m) _Pragma("unroll") for (int k = 0; k < 2; ++k) dst[m][k] = *(const LAS bf16x8*)(lds + PG8_SA(b, h) + aoff + m * 2048 + k * 1024); } while (0)
#define PG8_LDB(dst, b, h) do { _Pragma("unroll") for (int n = 0; n < 2; ++n) _Pragma("unroll") for (int k = 0; k < 2; ++k) dst[n][k] = *(const LAS bf16x8*)(lds + PG8_SB(b, h) + boff + n * 2048 + k * 1024); } while (0)
#define PG8_MMA(ai, bj, At, Bt) do { __builtin_amdgcn_s_setprio(1); _Pragma("unroll") for (int m = 0; m < 4; ++m) _Pragma("unroll") for (int n = 0; n < 2; ++n) _Pragma("unroll") for (int k = 0; k < 2; ++k) \
        acc[ai][bj][m][n] = __builtin_amdgcn_mfma_f32_16x16x32_bf16(Bt[n][k], At[m][k], acc[ai][bj][m][n], 0, 0, 0); __builtin_amdgcn_s_setprio(0); } while (0)
#define PG8_WAIT_V(n) asm volatile("s_waitcnt vmcnt(" #n ")" ::: "memory")
#define PG8_WAIT_L(n) asm volatile("s_waitcnt lgkmcnt(" #n ")" ::: "memory")
#define PG8_BAR __builtin_amdgcn_s_barrier()
#define PG8_SCHED __builtin_amdgcn_sched_barrier(0)
    Unit cur, nxt; int ui = 0;
    if (!S.next(0, cur)) return;
    f32x4 acc[2][2][4][2];
#pragma unroll
    for (int a = 0; a < 2; ++a)
#pragma unroll
        for (int b = 0; b < 2; ++b)
#pragma unroll
            for (int m = 0; m < 4; ++m)
#pragma unroll
                for (int n = 0; n < 2; ++n) acc[a][b][m][n] = (f32x4){0.f, 0.f, 0.f, 0.f};
    bf16x8 At[4][2], B0[2][2], B1[2][2];
    const char* cA = (const char*)g.A + (size_t)cur.pm * tstepA + (size_t)cur.pn * pnstepA; const char* cB = (const char*)g.Bt + (size_t)cur.pn * tstep;
    PG8_STAGE(PG8_SB(0, 0), cB, voffB); PG8_STAGE(PG8_SB(0, 1), cB + hstep, voffB); PG8_STAGE(PG8_SA(0, 0), cA, voffA); PG8_STAGE(PG8_SA(0, 1), cA + hstepA, voffA);
    if (wr == 1) PG8_BAR;
    PG8_WAIT_V(2); PG8_BAR;
    PG8_STAGE(PG8_SB(1, 0), cB + kstep, voffB); PG8_STAGE(PG8_SA(1, 0), cA + kstep, voffA); PG8_STAGE(PG8_SB(1, 1), cB + hstep + kstep, voffB);
    PG8_WAIT_V(6); PG8_BAR;
    for (;;) {
        const bool has_next = S.next(ui + 1, nxt);
        const char* nA = has_next ? (const char*)g.A + (size_t)nxt.pm * tstepA + (size_t)nxt.pn * pnstepA : cA; const char* nB = has_next ? (const char*)g.Bt + (size_t)nxt.pn * tstep : cB;
        for (int t = 0; t < nt; t += 2) {
            const bool last = (t == nt - 2);
            const char* a1 = cA + (size_t)(t + 1) * kstep;
            const char* a2 = last ? nA : cA + (size_t)(t + 2) * kstep; const char* b2 = last ? nB : cB + (size_t)(t + 2) * kstep;
            const char* a3 = a2 + kstep; const char* b3 = b2 + kstep;
            PG8_LDB(B0, 0, 0); PG8_LDB(B1, 0, 1); PG8_SCHED; PG8_LDA(At, 0, 0); PG8_STAGE(PG8_SA(1, 1), a1 + hstepA, voffA);
            PG8_WAIT_V(8); PG8_WAIT_L(0); PG8_BAR; PG8_MMA(0, 0, At, B0); PG8_MMA(0, 1, At, B1); PG8_BAR; PG8_SCHED;
            PG8_LDA(At, 0, 1); PG8_STAGE(PG8_SB(0, 0), b2, voffB); PG8_STAGE(PG8_SB(0, 1), b2 + hstep, voffB); PG8_STAGE(PG8_SA(0, 0), a2, voffA);
            PG8_WAIT_V(8); PG8_WAIT_L(0); PG8_BAR; PG8_MMA(1, 0, At, B0); PG8_MMA(1, 1, At, B1); PG8_BAR; PG8_SCHED;
            PG8_LDB(B0, 1, 0); PG8_LDB(B1, 1, 1); PG8_SCHED; PG8_LDA(At, 1, 0); PG8_STAGE(PG8_SA(0, 1), a2 + hstepA, voffA);
            PG8_WAIT_V(8); PG8_WAIT_L(0); PG8_BAR; PG8_MMA(0, 0, At, B0); PG8_MMA(0, 1, At, B1); PG8_BAR; PG8_SCHED;
            PG8_LDA(At, 1, 1); PG8_STAGE(PG8_SB(1, 0), b3, voffB); PG8_STAGE(PG8_SB(1, 1), b3 + hstep, voffB); PG8_STAGE(PG8_SA(1, 0), a3, voffA);
            PG8_WAIT_V(8); PG8_WAIT_L(0); PG8_BAR; PG8_MMA(1, 0, At, B0); PG8_MMA(1, 1, At, B1); PG8_BAR; PG8_SCHED;
        }
        if (wr == 0) PG8_BAR;
        epilogue(E, acc, cur, wr, wc, fr, fq);
        if (!has_next) break;
#pragma unroll
        for (int a = 0; a < 2; ++a)
#pragma unroll
            for (int b = 0; b < 2; ++b)
#pragma unroll
                for (int m = 0; m < 4; ++m)
#pragma unroll
                    for (int n = 0; n < 2; ++n) acc[a][b][m][n] = (f32x4){0.f, 0.f, 0.f, 0.f};
        cur = nxt; cA = nA; cB = nB; ++ui;
        if (wr == 1) PG8_BAR;
    }
    PG8_WAIT_V(0);
    PG8_BAR;
#undef PG8_SA
#undef PG8_SB
#undef PG8_STAGE
#undef PG8_LDA
#undef PG8_LDB
#undef PG8_MMA
#undef PG8_WAIT_V
#undef PG8_WAIT_L
#undef PG8_BAR
#undef PG8_SCHED
}

__device__ __forceinline__ void gemm_phase2(LAS unsigned char* lds, const Gemm2 g, const StaticOrder& S, const bf16_t* gates, bf16_t* out) {
    const int tid = threadIdx.x, wid = __builtin_amdgcn_readfirstlane(tid >> 6), lane = tid & 63, wr = wid >> 2, wc = wid & 3, fr = lane & 15, fq = lane >> 4;
    const int nt1 = g.K1 / BK, nt = nt1 + g.K2 / BK;
    int sR[2], sRb[2], sC[2];
#pragma unroll
    for (int i = 0; i < 2; ++i) { int R, C; stage_rc(tid * 16 + i * 8192, R, C); sR[i] = R; sRb[i] = (R & ~31) + perm32(R & 31); sC[i] = C; }
    const size_t kstep = (size_t)(BK * 2);
    const size_t hB1 = (size_t)HALF * g.K1 * 2, hA1 = (size_t)HALF * g.lda1 * 2, hB2 = (size_t)HALF * g.K2 * 2, hA2 = (size_t)HALF * g.lda2 * 2;
    const unsigned ldsw = (unsigned)wid * 1024u;
    const int aoff = lds_byte(wr * 64 + fr, fq * 8), boff = lds_byte(wc * 32 + fr, fq * 8);
#define PG8_SA(b, h) (((b) * 2 + (h)) * HTB)
#define PG8_SB(b, h) ((4 + (b) * 2 + (h)) * HTB)
#define PG8_STAGE_T(bufoff, isA, h, T) do { const int T_ = (T); const bool nx_ = T_ >= nt; const int Tl_ = nx_ ? T_ - nt : T_; const bool s2_ = !nx_ && Tl_ >= nt1; \
        const char* base_ = (isA) ? (s2_ ? cA2 + (size_t)(Tl_ - nt1) * kstep + (h) * hA2 : (nx_ ? nA1 : cA1) + (size_t)Tl_ * kstep + (h) * hA1) \
                                  : (s2_ ? cB2 + (size_t)(Tl_ - nt1) * kstep + (h) * hB2 : (nx_ ? nB1 : cB1) + (size_t)Tl_ * kstep + (h) * hB1); \
        const int ld_ = (isA) ? (s2_ ? g.lda2 : g.lda1) : (s2_ ? g.K2 : g.K1); \
        _Pragma("unroll") for (int _i = 0; _i < 2; ++_i) { const unsigned vo_ = (unsigned)(((isA) ? sR[_i] : sRb[_i]) * ld_ + sC[_i]) * 2u; \
            __builtin_amdgcn_global_load_lds((const unsigned*)(base_ + vo_), (LAS unsigned*)(lds + (bufoff) + ldsw + _i * 8192), 16, 0, 0); } } while (0)
#define PG8_LDA(dst, b, h) do { _Pragma("unroll") for (int m = 0; m < 4; ++m) _Pragma("unroll") for (int k = 0; k < 2; ++k) dst[m][k] = *(const LAS bf16x8*)(lds + PG8_SA(b, h) + aoff + m * 2048 + k * 1024); } while (0)
#define PG8_LDB(dst, b, h) do { _Pragma("unroll") for (int n = 0; n < 2; ++n) _Pragma("unroll") for (int k = 0; k < 2; ++k) dst[n][k] = *(const LAS bf16x8*)(lds + PG8_SB(b, h) + boff + n * 2048 + k * 1024); } while (0)
#define PG8_MMA(ai, bj, At, Bt) do { __builtin_amdgcn_s_setprio(1); _Pragma("unroll") for (int m = 0; m < 4; ++m) _Pragma("unroll") for (int n = 0; n < 2; ++n) _Pragma("unroll") for (int k = 0; k < 2; ++k) \
        acc[ai][bj][m][n] = __builtin_amdgcn_mfma_f32_16x16x32_bf16(Bt[n][k], At[m][k], acc[ai][bj][m][n], 0, 0, 0); __builtin_amdgcn_s_setprio(0); } while (0)
#define PG8_WAIT_V(n) asm volatile("s_waitcnt vmcnt(" #n ")" ::: "memory")
#define PG8_WAIT_L(n) asm volatile("s_waitcnt lgkmcnt(" #n ")" ::: "memory")
#define PG8_BAR __builtin_amdgcn_s_barrier()
#define PG8_SCHED __builtin_amdgcn_sched_barrier(0)
    Unit cur, nxt; int ui = 0;
    if (!S.next(0, cur)) return;
    f32x4 acc[2][2][4][2];
#pragma unroll
    for (int a = 0; a < 2; ++a)
#pragma unroll
        for (int b = 0; b < 2; ++b)
#pragma unroll
            for (int m = 0; m < 4; ++m)
#pragma unroll
                for (int n = 0; n < 2; ++n) acc[a][b][m][n] = (f32x4){0.f, 0.f, 0.f, 0.f};
    bf16x8 At[4][2], B0[2][2], B1[2][2];
    const char* cA1 = (const char*)g.A1 + (size_t)cur.pm * 2 * hA1; const char* cB1 = (const char*)g.B1 + (size_t)cur.pn * 2 * hB1;
    const char* cA2 = (const char*)g.A2 + (size_t)cur.pm * 2 * hA2; const char* cB2 = (const char*)g.B2 + (size_t)cur.pn * 2 * hB2;
    const char* nA1 = cA1; const char* nB1 = cB1;
    PG8_STAGE_T(PG8_SB(0, 0), false, 0, 0); PG8_STAGE_T(PG8_SB(0, 1), false, 1, 0); PG8_STAGE_T(PG8_SA(0, 0), true, 0, 0); PG8_STAGE_T(PG8_SA(0, 1), true, 1, 0);
    if (wr == 1) PG8_BAR;
    PG8_WAIT_V(2); PG8_BAR;
    PG8_STAGE_T(PG8_SB(1, 0), false, 0, 1); PG8_STAGE_T(PG8_SA(1, 0), true, 0, 1); PG8_STAGE_T(PG8_SB(1, 1), false, 1, 1);
    PG8_WAIT_V(6); PG8_BAR;
    for (;;) {
        const bool has_next = S.next(ui + 1, nxt);
        nA1 = has_next ? (const char*)g.A1 + (size_t)nxt.pm * 2 * hA1 : cA1; nB1 = has_next ? (const char*)g.B1 + (size_t)nxt.pn * 2 * hB1 : cB1;
        const int rowb = cur.pm * BM + wr * 64 + fr, colb = cur.pn * BM + wc * 32 + 8 * fq;
        for (int t = 0; t < nt; t += 2) {
            if (t == nt1) {
#pragma unroll
                for (int ai = 0; ai < 2; ++ai)
#pragma unroll
                    for (int m = 0; m < 4; ++m) { const bf16_t* gp = gates + (size_t)(rowb + ai * HALF + m * 16) * (2 * DM) + colb;
#pragma unroll
                        for (int bj = 0; bj < 2; ++bj) { f32x4 g00, g01, g10, g11; unpack8(*(const GAS u32x4*)(gp + bj * HALF), g00, g01); unpack8(*(const GAS u32x4*)(gp + DM + bj * HALF), g10, g11);
#pragma unroll
                            for (int j = 0; j < 4; ++j) { acc[ai][bj][m][0][j] *= g00[j] * __builtin_amdgcn_rcpf(fmaxf(g10[j], 1e-6f)); acc[ai][bj][m][1][j] *= g01[j] * __builtin_amdgcn_rcpf(fmaxf(g11[j], 1e-6f)); } } }
            }
            PG8_LDB(B0, 0, 0); PG8_LDB(B1, 0, 1); PG8_SCHED; PG8_LDA(At, 0, 0); PG8_STAGE_T(PG8_SA(1, 1), true, 1, t + 1);
            PG8_WAIT_V(8); PG8_WAIT_L(0); PG8_BAR; PG8_MMA(0, 0, At, B0); PG8_MMA(0, 1, At, B1); PG8_BAR; PG8_SCHED;
            PG8_LDA(At, 0, 1); PG8_STAGE_T(PG8_SB(0, 0), false, 0, t + 2); PG8_STAGE_T(PG8_SB(0, 1), false, 1, t + 2); PG8_STAGE_T(PG8_SA(0, 0), true, 0, t + 2);
            PG8_WAIT_V(8); PG8_WAIT_L(0); PG8_BAR; PG8_MMA(1, 0, At, B0); PG8_MMA(1, 1, At, B1); PG8_BAR; PG8_SCHED;
            PG8_LDB(B0, 1, 0); PG8_LDB(B1, 1, 1); PG8_SCHED; PG8_LDA(At, 1, 0); PG8_STAGE_T(PG8_SA(0, 1), true, 1, t + 2);
            PG8_WAIT_V(8); PG8_WAIT_L(0); PG8_BAR; PG8_MMA(0, 0, At, B0); PG8_MMA(0, 1, At, B1); PG8_BAR; PG8_SCHED;
            PG8_LDA(At, 1, 1); PG8_STAGE_T(PG8_SB(1, 0), false, 0, t + 3); PG8_STAGE_T(PG8_SB(1, 1), false, 1, t + 3); PG8_STAGE_T(PG8_SA(1, 0), true, 0, t + 3);
            PG8_WAIT_V(8); PG8_WAIT_L(0); PG8_BAR; PG8_MMA(1, 0, At, B0); PG8_MMA(1, 1, At, B1); PG8_BAR; PG8_SCHED;
        }
        if (wr == 0) PG8_BAR;
#pragma unroll
        for (int ai = 0; ai < 2; ++ai)
#pragma unroll
            for (int m = 0; m < 4; ++m) { const size_t row = (size_t)(rowb + ai * HALF + m * 16);
#pragma unroll
                for (int bj = 0; bj < 2; ++bj) { f32x4 g10, g11; unpack8(*(const GAS u32x4*)(gates + row * (2 * DM) + DM + colb + bj * HALF), g10, g11);
#pragma unroll
                    for (int j = 0; j < 4; ++j) { g10[j] = fmaxf(g10[j], 1e-6f); g11[j] = fmaxf(g11[j], 1e-6f); }
                    *(GAS u32x4*)(out + row * DM + colb + bj * HALF) = pack8(acc[ai][bj][m][0] * g10, acc[ai][bj][m][1] * g11); } }
        if (!has_next) break;
#pragma unroll
        for (int a = 0; a < 2; ++a)
#pragma unroll
            for (int b = 0; b < 2; ++b)
#pragma unroll
                for (int m = 0; m < 4; ++m)
#pragma unroll
                    for (int n = 0; n < 2; ++n) acc[a][b][m][n] = (f32x4){0.f, 0.f, 0.f, 0.f};
        cur = nxt; cA1 = nA1; cB1 = nB1; cA2 = (const char*)g.A2 + (size_t)cur.pm * 2 * hA2; cB2 = (const char*)g.B2 + (size_t)cur.pn * 2 * hB2; ++ui;
        if (wr == 1) PG8_BAR;
    }
    PG8_WAIT_V(0);
    PG8_BAR;
#undef PG8_SA
#undef PG8_SB
#undef PG8_STAGE_T
#undef PG8_LDA
#undef PG8_LDB
#undef PG8_MMA
#undef PG8_WAIT_V
#undef PG8_WAIT_L
#undef PG8_BAR
#undef PG8_SCHED
}
}

#define XB_TMO      128
#define XB_XCNT(j)  (256  + 64 * (j))
#define XB_XSUB(j)  (1280 + 64 * (j))
#define XB_XGEN(j)  (2304 + 64 * (j))
#define XB_TOP      3328
#define XB_TOPGEN   3392
#define XCD_BAR_WORDS 3456
#define XB_SPIN_CAP (1u << 18)
__device__ __forceinline__ unsigned xb_ld(unsigned* p)              { return __hip_atomic_load(p, __ATOMIC_RELAXED, __HIP_MEMORY_SCOPE_AGENT); }
__device__ __forceinline__ unsigned xb_add(unsigned* p, unsigned v) { return __hip_atomic_fetch_add(p, v, __ATOMIC_RELAXED, __HIP_MEMORY_SCOPE_AGENT); }
__device__ __forceinline__ unsigned xb_xcc_id() { return (unsigned)__builtin_amdgcn_s_getreg((3 << 11) | 20) & 0xFu; }
#define XB_SPIN(cond, bar) do { unsigned _sp = 0; while (cond) { __builtin_amdgcn_s_sleep(1); \
    if ((++_sp & 255u) == 0u) { if (xb_ld(&(bar)[XB_TMO])) break; if (_sp > XB_SPIN_CAP) { atomicAdd(&(bar)[XB_TMO], 1u); break; } } } } while (0)
struct XcdBarrier { unsigned* bar; unsigned x; volatile LAS unsigned* st; };
__device__ __forceinline__ XcdBarrier xcd_barrier_post(unsigned* bar, volatile LAS unsigned* st) {
    XcdBarrier b; b.bar = bar; b.x = xb_xcc_id(); b.st = st;
    if (threadIdx.x == 0) (void)xb_add(&bar[XB_XCNT(b.x)], 1u);
    return b;
}
__device__ __forceinline__ void xcd_barrier_complete(unsigned* bar, unsigned x, unsigned& nloc, unsigned& nx) {
    const unsigned G = gridDim.x * gridDim.y * gridDim.z;
    unsigned sum, cnt, mine, sp = 0u;
    for (;;) {
        sum = 0u; cnt = 0u; mine = 0u;
#pragma unroll
        for (unsigned j = 0; j < 16; ++j) { const unsigned c = xb_ld(&bar[XB_XCNT(j)]); sum += c; cnt += (c > 0u) ? 1u : 0u; mine = (j == x) ? c : mine; }
        if (sum == G) break;
        __builtin_amdgcn_s_sleep(1);
        if ((++sp & 255u) == 0u) { if (xb_ld(&bar[XB_TMO])) break; if (sp > XB_SPIN_CAP) { atomicAdd(&bar[XB_TMO], 1u); break; } }
    }
    nloc = mine > 0u ? mine : 1u; nx = cnt > 0u ? cnt : 1u;
}
__device__ __forceinline__ void xcd_barrier(const XcdBarrier& b) {
    asm volatile("s_waitcnt vmcnt(0)" ::: "memory");
    __syncthreads();
    if (threadIdx.x == 0) {
        unsigned* bar = b.bar;
        __builtin_amdgcn_s_waitcnt(0);
        unsigned nloc = b.st[0], nx = b.st[1];
        if (nloc == 0u) { xcd_barrier_complete(bar, b.x, nloc, nx); b.st[0] = nloc; b.st[1] = nx; }
        const unsigned old = xb_add(&bar[XB_XSUB(b.x)], 1u);
        const unsigned gen = old / nloc;
        if (old + 1u == (gen + 1u) * nloc) {
            __builtin_amdgcn_fence(__ATOMIC_RELEASE, "agent");
            asm volatile("s_waitcnt vmcnt(0)" ::: "memory");
            const unsigned og = xb_add(&bar[XB_TOP], 1u);
            const unsigned tg = og / nx;
            if (og + 1u == (tg + 1u) * nx) xb_add(&bar[XB_TOPGEN], 1u);
            else XB_SPIN(xb_ld(&bar[XB_TOPGEN]) == tg, bar);
            __builtin_amdgcn_fence(__ATOMIC_ACQUIRE, "agent");
            xb_add(&bar[XB_XGEN(b.x)], 1u);
            asm volatile("s_waitcnt vmcnt(0)" ::: "memory");
        } else {
            XB_SPIN(xb_ld(&bar[XB_XGEN(b.x)]) == gen, bar);
            __builtin_amdgcn_fence(__ATOMIC_ACQUIRE, "agent");
            asm volatile("s_waitcnt vmcnt(0)" ::: "memory");
        }
    }
    __syncthreads();
}

__device__ __forceinline__ void p0_transpose_item(const float* W, int K, int N, const float* gain, bf16_t* WT, int k0, int n0, int drow0, LAS float* scr, int lane) {
#pragma unroll
    for (int i = 0; i < 8; ++i) { const int kk = 8 * i + (lane >> 3), nn = 4 * (lane & 7);
        f32x4 v = *(const GAS f32x4*)(W + (size_t)(k0 + kk) * N + n0 + nn);
        if (gain) v = v * *(const GAS float*)(gain + k0 + kk);
        scr[kk * 33 + nn] = v.x; scr[kk * 33 + nn + 1] = v.y; scr[kk * 33 + nn + 2] = v.z; scr[kk * 33 + nn + 3] = v.w; }
    LDS_WAIT(); asm volatile("" ::: "memory");
    const int c = lane & 7;
#pragma unroll
    for (int j = 0; j < 4; ++j) { const int n = (lane >> 3) + 8 * j; const LAS float* s = scr + (8 * c) * 33 + n;
        u32x4 o; o.x = pk2(s[0 * 33], s[1 * 33]); o.y = pk2(s[2 * 33], s[3 * 33]); o.z = pk2(s[4 * 33], s[5 * 33]); o.w = pk2(s[6 * 33], s[7 * 33]);
        *(GAS u32x4*)(WT + (size_t)(drow0 + n) * K + k0 + 8 * c) = o; }
    LDS_WAIT(); asm volatile("" ::: "memory");
}
__device__ __forceinline__ int map_gu(int n0) { return n0 < DFF ? (n0 / 128) * 256 + (n0 % 128) : ((n0 - DFF) / 128) * 256 + 128 + ((n0 - DFF) % 128); }
__device__ __forceinline__ int map_win(int n0) { return n0 < 6144 ? n0 : (n0 < 6176 ? 9216 + (n0 - 6144) : n0 - 32); }

constexpr int TI_GU = (DM / 64) * (2 * DFF / 32), TI_D = (DFF / 64) * (DM / 32), TI_IN = (DM / 64) * (IN_DIM / 32), TI_SSO = (DI / 64) * (DM / 32), TI_SQ = (DM / 64) * (DM / 32), TI_PLE = (PLE / 64) * (DM / 32);
constexpr int TI_H1 = TI_D + TI_IN;
constexpr int TI_H3 = TI_GU + TI_D + TI_SSO + 2 * TI_SQ + TI_PLE;
template <int PH> __device__ __forceinline__ void deferred_transposes(Frame& F) {
    LAS float* scr = (LAS float*)(F.lds + F.wave * 16384);
    const int gw = F.vcu * NWAVES + F.wave, NGW = F.G * NWAVES, lane = F.lane;
    for (int it = gw; it < ((PH == 1) ? TI_H1 : TI_H3); it += NGW) {
        int r = it;
        const float* W; const float* gain = nullptr; int K, N, mapk = 0; size_t wso;
        if (PH == 1) {
            if (r < TI_D) { W = F.in[I_WD1]; K = DFF; N = DM; wso = WS_WD1; }
            else { r -= TI_D; W = F.in[I_WIN]; K = DM; N = IN_DIM; gain = F.in[I_NMIX]; wso = WS_WIN; mapk = 2; }
        } else {
            if (r < TI_GU) { W = F.in[I_WGU2]; K = DM; N = 2 * DFF; gain = F.in[I_NFFN2]; wso = WS_WGU2; mapk = 1; }
            else if ((r -= TI_GU) < TI_D) { W = F.in[I_WD2]; K = DFF; N = DM; wso = WS_WD2; }
            else if ((r -= TI_D) < TI_SSO) { W = F.in[I_WSSO]; K = DI; N = DM; gain = F.in[I_NSSD]; wso = WS_WSSO; }
            else if ((r -= TI_SSO) < TI_SQ) { W = F.in[I_WO]; K = DM; N = DM; wso = WS_WO; }
            else if ((r -= TI_SQ) < TI_SQ) { W = F.in[I_WPG]; K = DM; N = DM; gain = F.in[I_NPLE]; wso = WS_WPG; }
            else { r -= TI_SQ; W = F.in[I_WPLE]; K = PLE; N = DM; wso = WS_WPLE; }
        }
        const int nbk = N / 32, kb = r / nbk, n0 = (r % nbk) * 32; const int drow0 = (mapk == 1) ? map_gu(n0) : (mapk == 2) ? map_win(n0) : n0;
        p0_transpose_item(W, K, N, gain, (bf16_t*)(F.ws + wso), kb * 64, n0, drow0, scr, lane);
    }
    __syncthreads();
}

__device__ __forceinline__ void p0_prologue(Frame& F) {
    LAS float* scr = (LAS float*)(F.lds + F.wave * 16384);
    const int gw = F.vcu * NWAVES + F.wave, NGW = F.G * NWAVES, lane = F.lane;
    constexpr int NITEMS = TI_GU + TI_SQ;
    bf16_t* const wgu1 = (bf16_t*)(F.ws + WS_WGU1); bf16_t* const wpot = (bf16_t*)(F.ws + WS_WPOT);
    for (int it = gw; it < NITEMS; it += NGW) {
        int r = it;
        if (r < TI_GU) { const int nb = 2 * DFF / 32, kb = r / nb, n0 = (r % nb) * 32; p0_transpose_item(F.in[I_WGU1], DM, 2 * DFF, F.in[I_NFFN1], wgu1, kb * 64, n0, map_gu(n0), scr, lane); continue; } r -= TI_GU;
        { const int nb = DM / 32, kb = r / nb, n0 = (r % nb) * 32; p0_transpose_item(F.in[I_WPOUT], PD, DM, F.in[I_PSCALE], wpot, kb * 64, n0, n0, scr, lane); }
    }
    {
        bf16_t* const wgrp = (bf16_t*)(F.ws + WS_WGRP); const float* Wg = F.in[I_WPGRP];
        for (int e = F.vcu * NTHREADS + F.tid; e < 4 * 256 * 256 / 8; e += F.G * NTHREADS) {
            const f32x4 a = *(const GAS f32x4*)(Wg + (size_t)e * 8), b = *(const GAS f32x4*)(Wg + (size_t)e * 8 + 4);
            u32x4 o; o.x = pk2(a.x, a.y); o.y = pk2(a.z, a.w); o.z = pk2(b.x, b.y); o.w = pk2(b.z, b.w);
            *(GAS u32x4*)(wgrp + (size_t)e * 8) = o; }
    }
    {
        bf16_t* const XB = (bf16_t*)(F.ws + WS_XB); bf16_t* const PB = (bf16_t*)(F.ws + WS_PB); float* const stA = (float*)(F.ws + WS_STATS_A);
        for (int m = gw; m < M; m += NGW) {
            const float* xrow = (m < MP) ? F.in[I_XP] + (size_t)m * DM : F.in[I_XS] + (size_t)(m - MP) * DM;
            const GAS f32x4* xr = (const GAS f32x4*)xrow + lane;
            f32x4 v[4]; float s = 0.f;
#pragma unroll
            for (int j = 0; j < 4; ++j) { v[j] = xr[64 * j]; s += (v[j].x * v[j].x + v[j].y * v[j].y) + (v[j].z * v[j].z + v[j].w * v[j].w); }
            s = wave_sum(s);
            GAS u32x2* o8 = (GAS u32x2*)(XB + (size_t)m * DM) + lane;
#pragma unroll
            for (int j = 0; j < 4; ++j) { u32x2 w; w.x = pk2(v[j].x, v[j].y); w.y = pk2(v[j].z, v[j].w); o8[64 * j] = w; }
            if (lane < 16) *(GAS float*)(stA + (size_t)m * 16 + lane) = (lane == 0) ? s : 0.f;
            const float* prow = (m < MP) ? F.in[I_PP] + (size_t)m * PLE : F.in[I_PS] + (size_t)(m - MP) * PLE;
            const f32x4 pv = *((const GAS f32x4*)prow + lane);
            u32x2 w; w.x = pk2(pv.x, pv.y); w.y = pk2(pv.z, pv.w); *((GAS u32x2*)(PB + (size_t)m * PLE) + lane) = w;
        }
    }
}


typedef short v4i16_t __attribute__((ext_vector_type(4)));
constexpr int IMG_B = 0, IMG_C = 32768, IMG_X = 65536, TAB_ACS = RING_BYTES + 1024, TAB_DT = TAB_ACS + 2048, TAB_SD = TAB_DT + 2048;
constexpr int NCHUNK = SEQ / 128;
template <bool XS> __device__ __forceinline__ int img_off(int row, int ch) { return XS ? 256 * row + 16 * (ch ^ ((row & 7) << 1)) : 256 * row + 16 * (ch ^ (((row & 3) << 2) | ((row >> 2) & 3))); }
__device__ __forceinline__ bf16x8 tr_pair(const LAS unsigned char* p0, const LAS unsigned char* p1) {
    const v4i16_t a = __builtin_amdgcn_ds_read_tr16_b64_v4i16((LAS v4i16_t*)p0), b = __builtin_amdgcn_ds_read_tr16_b64_v4i16((LAS v4i16_t*)p1);
    return (bf16x8){a[0], a[1], a[2], a[3], b[0], b[1], b[2], b[3]};
}
__device__ __forceinline__ void ssd_tables_load(Frame& F, size_t row0, int g, float& d0, float& d1) {
    if (F.wave < 4) { const float* const DT = (const float*)(F.ws + WS_DT); const int head = g * HPG + F.wave;
        d0 = *(const GAS float*)(DT + (row0 + 2 * F.lane) * 32 + head); d1 = *(const GAS float*)(DT + (row0 + 2 * F.lane + 1) * 32 + head); }
}
__device__ __forceinline__ void ssd_tables_compute(Frame& F, int g, float d0, float d1) {
    LAS float* const acs = (LAS float*)(F.lds + TAB_ACS); LAS float* const dtl = (LAS float*)(F.lds + TAB_DT); LAS float* const sdec = (LAS float*)(F.lds + TAB_SD);
    if (F.wave < 4) {
        const int r = F.wave, lane = F.lane, head = g * HPG + r;
        const float Ah = -__expf(*(const GAS float*)(F.in[I_ALOG] + head));
        const float a0 = d0 * Ah, a1 = d1 * Ah, loc = a0 + a1;
        float inc = loc;
#pragma unroll
        for (int o = 1; o < 64; o <<= 1) { const float t = __shfl_up(inc, o); if (lane >= o) inc += t; }
        const float exc = inc - loc;
        acs[(2 * lane) * 4 + r] = exc + a0; acs[(2 * lane + 1) * 4 + r] = inc;
        dtl[(2 * lane) * 4 + r] = d0; dtl[(2 * lane + 1) * 4 + r] = d1;
    }
    __syncthreads();
    { const int s = F.tid >> 2, r = F.tid & 3; sdec[s * 4 + r] = __expf(acs[127 * 4 + r] - acs[s * 4 + r]) * dtl[s * 4 + r]; }
    __syncthreads();
}
__device__ __forceinline__ void ssd_tables(Frame& F, size_t row0, int g) { float d0 = 0.f, d1 = 0.f; ssd_tables_load(F, row0, g, d0, d1); ssd_tables_compute(F, g, d0, d1); }
struct ConvMap { int kind, cc, run, gch; };
__device__ __forceinline__ ConvMap ssd_conv_map(int t, int g) {
    ConvMap m;
    if (t < 256) { m.kind = 0; m.cc = t & 31; m.run = t >> 5; } else if (t < 384) { m.kind = 1; m.cc = (t - 256) & 15; m.run = (t - 256) >> 4; } else { m.kind = 2; m.cc = (t - 384) & 15; m.run = (t - 384) >> 4; }
    m.gch = (m.kind == 0 ? g * 256 : (m.kind == 1 ? DI + g * DSTATE : DI + NG * DSTATE + g * DSTATE)) + 8 * m.cc;
    return m;
}
__device__ __forceinline__ void ssd_conv_load(Frame& F, size_t row0, int b, int c, int g, u32x4 (&raw)[19]) {
    const ConvMap m = ssd_conv_map(F.tid, g);
    const bf16_t* const XBC = (const bf16_t*)(F.ws + WS_XBC); const bf16_t* const HALO = (const bf16_t*)(F.ws + WS_HALO);
#pragma unroll
    for (int i = 0; i < 19; ++i) {
        if (i < 3 && m.run == 0) { if (c == 0) raw[i] = (u32x4){0u, 0u, 0u, 0u}; else raw[i] = *(const GAS u32x4*)(HALO + ((((size_t)b * 16 + c) * 3 + i) * CD) + m.gch); }
        else raw[i] = *(const GAS u32x4*)(XBC + (row0 + 16 * m.run + i - 3) * CD + m.gch); }
}
__device__ __forceinline__ void ssd_conv_store(Frame& F, size_t row0, int g, const u32x4 (&raw)[19]) {
    const ConvMap m = ssd_conv_map(F.tid, g);
    bf16_t* const XBC = (bf16_t*)(F.ws + WS_XBC);
    const float* const convw = F.in[I_CONVW]; const float* const convb = F.in[I_CONVB];
    float cw[4][8], cb[8];
#pragma unroll
    for (int k = 0; k < 4; ++k) { const f32x4 a = *(const GAS f32x4*)(convw + (size_t)k * CD + m.gch), b_ = *(const GAS f32x4*)(convw + (size_t)k * CD + m.gch + 4);
        cw[k][0] = a.x; cw[k][1] = a.y; cw[k][2] = a.z; cw[k][3] = a.w; cw[k][4] = b_.x; cw[k][5] = b_.y; cw[k][6] = b_.z; cw[k][7] = b_.w; }
    { const f32x4 a = *(const GAS f32x4*)(convb + m.gch), b_ = *(const GAS f32x4*)(convb + m.gch + 4); cb[0] = a.x; cb[1] = a.y; cb[2] = a.z; cb[3] = a.w; cb[4] = b_.x; cb[5] = b_.y; cb[6] = b_.z; cb[7] = b_.w; }
    LAS unsigned char* const img = F.lds + (m.kind == 0 ? IMG_X + (m.cc >> 4) * 32768 : IMG_B);
    const LAS float* const sdec = (const LAS float*)(F.lds + TAB_SD);
    const int chl = m.cc & 15, hr = m.cc >> 3;
#pragma unroll
    for (int i = 0; i < 16; ++i) {
        const int s = 16 * m.run + i;
        float o[8];
#pragma unroll
        for (int j2 = 0; j2 < 4; ++j2) {
            const unsigned w0 = raw[i][j2], w1 = raw[i + 1][j2], w2 = raw[i + 2][j2], w3 = raw[i + 3][j2];
            const float lo = cb[2 * j2] + cw[0][2 * j2] * bflo(w0) + cw[1][2 * j2] * bflo(w1) + cw[2][2 * j2] * bflo(w2) + cw[3][2 * j2] * bflo(w3);
            const float hi = cb[2 * j2 + 1] + cw[0][2 * j2 + 1] * bfhi(w0) + cw[1][2 * j2 + 1] * bfhi(w1) + cw[2][2 * j2 + 1] * bfhi(w2) + cw[3][2 * j2 + 1] * bfhi(w3);
            o[2 * j2] = silu_f(lo); o[2 * j2 + 1] = silu_f(hi);
        }
        u32x4 pk; pk.x = cvt_pk_bf16(o[0], o[1]); pk.y = cvt_pk_bf16(o[2], o[3]); pk.z = cvt_pk_bf16(o[4], o[5]); pk.w = cvt_pk_bf16(o[6], o[7]);
        *(GAS u32x4*)(XBC + (row0 + s) * CD + m.gch) = pk;
        if (m.kind == 0) { const float sc = sdec[s * 4 + hr];
            pk.x = cvt_pk_bf16(o[0] * sc, o[1] * sc); pk.y = cvt_pk_bf16(o[2] * sc, o[3] * sc); pk.z = cvt_pk_bf16(o[4] * sc, o[5] * sc); pk.w = cvt_pk_bf16(o[6] * sc, o[7] * sc); }
        if (m.kind != 2) *(LAS u32x4*)(img + img_off<false>(s, chl)) = pk;
    }
}
__device__ __forceinline__ void ssd_copy_load(Frame& F, size_t row0, int g, u32x4 (&raw)[16]) {
    const ConvMap m = ssd_conv_map(F.tid, g);
    const bf16_t* const XBC = (const bf16_t*)(F.ws + WS_XBC);
#pragma unroll
    for (int i = 0; i < 16; ++i) raw[i] = *(const GAS u32x4*)(XBC + (row0 + 16 * m.run + i) * CD + m.gch);
}
__device__ __forceinline__ void ssd_copy_store(Frame& F, int g, const u32x4 (&raw)[16]) {
    const ConvMap m = ssd_conv_map(F.tid, g);
    LAS unsigned char* const img = F.lds + (m.kind == 0 ? IMG_X + (m.cc >> 4) * 32768 : (m.kind == 1 ? IMG_B : IMG_C));
    const int chl = m.cc & 15;
#pragma unroll
    for (int i = 0; i < 16; ++i) { const int s = 16 * m.run + i; *(LAS u32x4*)(img + (m.kind == 0 ? img_off<true>(s, chl) : img_off<false>(s, chl))) = raw[i]; }
}
__device__ __forceinline__ void ssd_states_phase(Frame& F) {
    bf16_t* const ST = (bf16_t*)(F.ws + WS_HPREV);
    float* const CDEC = (float*)(F.ws + WS_CDEC);
    const int w = F.wave, lane = F.lane, ql = lane & 15, gq = lane >> 4, qq = ql >> 2, pp = ql & 3, r = w >> 1, nh = w & 1;
    int sbo[4][2], sxo[4][2];
#pragma unroll
    for (int f = 0; f < 4; ++f) { const int colb = 64 * nh + 16 * f + 4 * pp, colx = 64 * (r & 1) + 16 * f + 4 * pp;
#pragma unroll
        for (int t4 = 0; t4 < 2; ++t4) { sbo[f][t4] = img_off<false>(8 * gq + qq + 4 * t4, colb >> 3) + 2 * (colb & 7); sxo[f][t4] = img_off<false>(8 * gq + qq + 4 * t4, colx >> 3) + 2 * (colx & 7); } }
    u32x4 raw[19]; float d0 = 0.f, d1 = 0.f;
    constexpr int NIT = BATCH * NCHUNK * NG;
    if (F.vcu < NIT) { const int it = F.vcu, g = it & 7, c = (it >> 3) & (NCHUNK - 1), b = it >> 7; const size_t row0 = (size_t)b * SEQ + (size_t)c * 128;
        ssd_conv_load(F, row0, b, c, g, raw); ssd_tables_load(F, row0, g, d0, d1); }
    for (int it = F.vcu; it < NIT; it += F.G) {
        const int g = it & 7, c = (it >> 3) & (NCHUNK - 1), b = it >> 7;
        const size_t row0 = (size_t)b * SEQ + (size_t)c * 128;
        asm volatile("s_waitcnt vmcnt(0)" ::: "memory");
        ssd_tables_compute(F, g, d0, d1);
        ssd_conv_store(F, row0, g, raw);
        __syncthreads();
        if (it + F.G < NIT) { const int it2 = it + F.G, g2 = it2 & 7, c2 = (it2 >> 3) & (NCHUNK - 1), b2 = it2 >> 7; const size_t row2 = (size_t)b2 * SEQ + (size_t)c2 * 128;
            ssd_conv_load(F, row2, b2, c2, g2, raw); ssd_tables_load(F, row2, g2, d0, d1); }
        const int head = g * HPG + r;
        bf16_t* const stp = ST + ((((size_t)b * NCHUNK + c) * NH + head) * HD) * DSTATE;
#pragma unroll
        for (int nh2 = 0; nh2 < 2; ++nh2) {
            f32x4 acc[2][4];
#pragma unroll
            for (int i = 0; i < 2; ++i)
#pragma unroll
                for (int j = 0; j < 4; ++j) acc[i][j] = (f32x4){0.f, 0.f, 0.f, 0.f};
#pragma unroll
            for (int ks = 0; ks < 4; ++ks) {
                bf16x8 af[2], xf[4];
#pragma unroll
                for (int nf = 0; nf < 2; ++nf) { const LAS unsigned char* p = F.lds + IMG_B + sbo[2 * nh2 + nf][0] + 8192 * ks; const LAS unsigned char* p4 = F.lds + IMG_B + sbo[2 * nh2 + nf][1] + 8192 * ks; af[nf] = tr_pair(p, p4); }
#pragma unroll
                for (int pf = 0; pf < 4; ++pf) { const LAS unsigned char* p = F.lds + IMG_X + (r >> 1) * 32768 + sxo[pf][0] + 8192 * ks; const LAS unsigned char* p4 = F.lds + IMG_X + (r >> 1) * 32768 + sxo[pf][1] + 8192 * ks; xf[pf] = tr_pair(p, p4); }
#pragma unroll
                for (int nf = 0; nf < 2; ++nf)
#pragma unroll
                    for (int pf = 0; pf < 4; ++pf) acc[nf][pf] = __builtin_amdgcn_mfma_f32_16x16x32_bf16(af[nf], xf[pf], acc[nf][pf], 0, 0, 0);
            }
#pragma unroll
            for (int pf = 0; pf < 4; ++pf)
#pragma unroll
                for (int nf = 0; nf < 2; ++nf) { u32x2 o; o.x = cvt_pk_bf16(acc[nf][pf][0], acc[nf][pf][1]); o.y = cvt_pk_bf16(acc[nf][pf][2], acc[nf][pf][3]);
                    *(GAS u32x2*)(stp + (size_t)(16 * pf + ql) * DSTATE + 64 * nh + 32 * nh2 + 16 * nf + 4 * gq) = o; }
        }
        if (F.tid < 4) { const LAS float* acs = (const LAS float*)(F.lds + TAB_ACS); *(GAS float*)(CDEC + ((size_t)b * NCHUNK + c) * NH + g * HPG + F.tid) = __expf(acs[127 * 4 + F.tid]); }
        __syncthreads();
    }
}
__device__ __forceinline__ void ssd_scan_phase(Frame& F) {
    bf16_t* const HP = (bf16_t*)(F.ws + WS_HPREV); const float* const CDEC = (const float*)(F.ws + WS_CDEC); float* const hout = F.out + O_SSM_P;
    const int gt = F.vcu * NTHREADS + F.tid, NT = F.G * NTHREADS;
    constexpr int PER = NH * HD * DSTATE / 8;
    for (int e = gt; e < BATCH * PER; e += NT) {
        const int b = e / PER, i8 = e % PER, head = i8 / (HD * DSTATE / 8);
        u32x4 stv[NCHUNK];
#pragma unroll
        for (int c = 0; c < NCHUNK; ++c) stv[c] = *(const GAS u32x4*)(HP + (((size_t)b * NCHUNK + c) * (size_t)PER + i8) * 8);
        f32x4 h0 = (f32x4){0.f, 0.f, 0.f, 0.f}, h1 = h0;
#pragma unroll
        for (int c = 0; c < NCHUNK; ++c) {
            if (c > 0) *(GAS u32x4*)(HP + (((size_t)b * NCHUNK + c) * (size_t)PER + i8) * 8) = pg8::pack8(h0, h1);
            const float d = *(const GAS float*)(CDEC + ((size_t)b * NCHUNK + c) * NH + head);
            f32x4 s0, s1; pg8::unpack8(stv[c], s0, s1);
            h0 = h0 * d + s0; h1 = h1 * d + s1;
        }
        *(GAS f32x4*)(hout + ((size_t)b * PER + i8) * 8) = h0; *(GAS f32x4*)(hout + ((size_t)b * PER + i8) * 8 + 4) = h1;
    }
}
__device__ __forceinline__ void ssd_out_phase(Frame& F) {
    const bf16_t* const HP = (const bf16_t*)(F.ws + WS_HPREV); bf16_t* const ZY = (bf16_t*)(F.ws + WS_Z);
    const int w = F.wave, lane = F.lane, ql = lane & 15, gq = lane >> 4, qq = ql >> 2, pp = ql & 3, q0 = 16 * w;
    const LAS float* const acs = (const LAS float*)(F.lds + TAB_ACS); const LAS float* const dtl = (const LAS float*)(F.lds + TAB_DT);
    int cfo[4], bbo[4], hbo[4], xbo[2][4];
#pragma unroll
    for (int ks = 0; ks < 4; ++ks) { cfo[ks] = IMG_C + img_off<false>(q0 + ql, 4 * ks + gq); bbo[ks] = IMG_B + img_off<false>(ql, 4 * ks + gq); hbo[ks] = img_off<false>(ql, 4 * ks + gq); }
#pragma unroll
    for (int rr = 0; rr < 2; ++rr)
#pragma unroll
        for (int pf = 0; pf < 4; ++pf) xbo[rr][pf] = IMG_X + img_off<true>(4 * gq + qq, 8 * rr + 2 * pf + (pp >> 1)) + 8 * (pp & 1);
    u32x4 raw[16]; float d0 = 0.f, d1 = 0.f;
    constexpr int NIT = BATCH * NCHUNK * NG;
    if (F.vcu < NIT) { const int it = F.vcu, g = it & 7, c = (it >> 3) & (NCHUNK - 1), b = it >> 7; const size_t row0 = (size_t)b * SEQ + (size_t)c * 128;
        ssd_copy_load(F, row0, g, raw); ssd_tables_load(F, row0, g, d0, d1); }
    for (int it = F.vcu; it < NIT; it += F.G) {
        const int g = it & 7, c = (it >> 3) & (NCHUNK - 1), b = it >> 7;
        const size_t row0 = (size_t)b * SEQ + (size_t)c * 128;
        ssd_tables_compute(F, g, d0, d1);
        ssd_copy_store(F, g, raw);
        __syncthreads();
        if (it + F.G < NIT) { const int it2 = it + F.G, g2 = it2 & 7, c2 = (it2 >> 3) & (NCHUNK - 1), b2 = it2 >> 7; const size_t row2 = (size_t)b2 * SEQ + (size_t)c2 * 128;
            ssd_copy_load(F, row2, g2, raw); ssd_tables_load(F, row2, g2, d0, d1); }
        bf16x8 cf[4];
#pragma unroll
        for (int ks = 0; ks < 4; ++ks) cf[ks] = *(const LAS bf16x8*)(F.lds + cfo[ks]);
        bf16_t* const zp = ZY + (row0 + q0 + ql) * DI + g * 256 + 4 * gq;
        const LAS float* const acs_l = acs + 16 * gq; const LAS float* const dtl_l = dtl + 16 * gq;
        f32x4 acc[4][4];
        float aq[4];
#pragma unroll
        for (int r = 0; r < 4; ++r) { aq[r] = acs[(q0 + ql) * 4 + r];
#pragma unroll
            for (int pf = 0; pf < 4; ++pf) acc[r][pf] = (f32x4){0.f, 0.f, 0.f, 0.f}; }
#pragma unroll
        for (int ks = 0; ks < 4; ++ks) if (2 * ks <= w) {
            f32x4 cb[2];
#pragma unroll
            for (int hf = 0; hf < 2; ++hf) { cb[hf] = (f32x4){0.f, 0.f, 0.f, 0.f};
                if (2 * ks + hf <= w) {
#pragma unroll
                    for (int kn = 0; kn < 4; ++kn) { const bf16x8 bfr = *(const LAS bf16x8*)(F.lds + bbo[kn] + 4096 * (2 * ks + hf)); cb[hf] = __builtin_amdgcn_mfma_f32_16x16x32_bf16(bfr, cf[kn], cb[hf], 0, 0, 0); } } }
#pragma unroll
            for (int r = 0; r < 4; ++r) {
                const float Dh = *(const GAS float*)(F.in[I_DSKIP] + g * HPG + r);
                float v[8];
#pragma unroll
                for (int hf = 0; hf < 2; ++hf) { const int sf = 2 * ks + hf;
#pragma unroll
                    for (int rg = 0; rg < 4; ++rg) { const int sl = 4 * gq + rg;
                        float val = 0.f;
                        if (sf <= w) { const float as = acs_l[64 * sf + 4 * rg + r], d = dtl_l[64 * sf + 4 * rg + r];
                            val = cb[hf][rg] * __expf(aq[r] - as) * d;
                            if (sf == w) { if (sl > ql) val = 0.f; else if (sl == ql) val += Dh; } }
                        v[4 * hf + rg] = val; } }
                u32x4 pk; pk.x = cvt_pk_bf16(v[0], v[1]); pk.y = cvt_pk_bf16(v[2], v[3]); pk.z = cvt_pk_bf16(v[4], v[5]); pk.w = cvt_pk_bf16(v[6], v[7]);
                const bf16x8 wf = __builtin_bit_cast(bf16x8, pk);
#pragma unroll
                for (int pf = 0; pf < 4; ++pf) {
                    const LAS unsigned char* const xb = F.lds + xbo[r & 1][pf] + (r >> 1) * 32768 + 8192 * ks;
                    const bf16x8 xf = tr_pair(xb, xb + 4096);
                    acc[r][pf] = __builtin_amdgcn_mfma_f32_16x16x32_bf16(xf, wf, acc[r][pf], 0, 0, 0); }
            }
        }
        u32x4 hreg[8];
        if (c > 0) {
            const u32x4* hsrc = (const u32x4*)(HP + ((((size_t)b * NCHUNK + c) * NH + g * HPG) * HD) * DSTATE) + F.tid;
#pragma unroll
            for (int i = 0; i < 8; ++i) hreg[i] = *(const GAS u32x4*)(hsrc + 512 * i);
        }
        if (c > 0) {
            __syncthreads();
#pragma unroll
            for (int i = 0; i < 8; ++i) { const int e = F.tid + 512 * i, hr_ = e >> 10, p_ = (e >> 4) & 63, ch_ = e & 15;
                *(LAS u32x4*)(F.lds + IMG_X + hr_ * 16384 + img_off<false>(p_, ch_)) = hreg[i]; }
            __syncthreads();
#pragma unroll
            for (int r = 0; r < 4; ++r) { const float eaq = __expf(aq[r]);
#pragma unroll
                for (int pf = 0; pf < 4; ++pf) { f32x4 yo = (f32x4){0.f, 0.f, 0.f, 0.f};
#pragma unroll
                    for (int ks = 0; ks < 4; ++ks) { const bf16x8 hf_ = *(const LAS bf16x8*)(F.lds + IMG_X + r * 16384 + hbo[ks] + 4096 * pf); yo = __builtin_amdgcn_mfma_f32_16x16x32_bf16(hf_, cf[ks], yo, 0, 0, 0); }
                    acc[r][pf] += yo * eaq; } }
        }
        float ssum = 0.f;
#pragma unroll
        for (int r = 0; r < 4; ++r)
#pragma unroll
            for (int pf = 0; pf < 4; ++pf) {
                const u32x2 zz = *(const GAS u32x2*)(zp + r * 64 + 16 * pf);
                const f32x4 y = acc[r][pf] * (f32x4){bflo(zz.x), bfhi(zz.x), bflo(zz.y), bfhi(zz.y)};
                acc[r][pf] = y; ssum += (y[0] * y[0] + y[1] * y[1]) + (y[2] * y[2] + y[3] * y[3]); }
        ssum += __shfl_xor(ssum, 16); ssum += __shfl_xor(ssum, 32);
        const float rsn = __builtin_amdgcn_rsqf(ssum * (1.0f / 256.0f) + EPS);
#pragma unroll
        for (int r = 0; r < 4; ++r)
#pragma unroll
            for (int pf = 0; pf < 4; ++pf) { u32x2 o; o.x = cvt_pk_bf16(acc[r][pf][0] * rsn, acc[r][pf][1] * rsn); o.y = cvt_pk_bf16(acc[r][pf][2] * rsn, acc[r][pf][3] * rsn);
                *(GAS u32x2*)(zp + r * 64 + 16 * pf) = o; }
        __syncthreads();
    }
}


__device__ __forceinline__ void ssd_conv_store_local(Frame& F, size_t row0, int g, const u32x4 (&raw)[19]) {
    const ConvMap m = ssd_conv_map(F.tid, g);
    bf16_t* const XBC = (bf16_t*)(F.ws + WS_XBC);
    const float* const convw = F.in[I_CONVW]; const float* const convb = F.in[I_CONVB];
    float cw[4][8], cb[8];
#pragma unroll
    for (int k = 0; k < 4; ++k) { const f32x4 a = *(const GAS f32x4*)(convw + (size_t)k * CD + m.gch), b_ = *(const GAS f32x4*)(convw + (size_t)k * CD + m.gch + 4);
        cw[k][0] = a.x; cw[k][1] = a.y; cw[k][2] = a.z; cw[k][3] = a.w; cw[k][4] = b_.x; cw[k][5] = b_.y; cw[k][6] = b_.z; cw[k][7] = b_.w; }
    { const f32x4 a = *(const GAS f32x4*)(convb + m.gch), b_ = *(const GAS f32x4*)(convb + m.gch + 4); cb[0] = a.x; cb[1] = a.y; cb[2] = a.z; cb[3] = a.w; cb[4] = b_.x; cb[5] = b_.y; cb[6] = b_.z; cb[7] = b_.w; }
    LAS unsigned char* const img = F.lds + (m.kind == 0 ? IMG_X + (m.cc >> 4) * 32768 : (m.kind == 1 ? IMG_B : IMG_C));
    const int chl = m.cc & 15;
#pragma unroll
    for (int i = 0; i < 16; ++i) {
        const int s = 16 * m.run + i;
        float o[8];
#pragma unroll
        for (int j2 = 0; j2 < 4; ++j2) {
            const unsigned w0 = raw[i][j2], w1 = raw[i + 1][j2], w2 = raw[i + 2][j2], w3 = raw[i + 3][j2];
            const float lo = cb[2 * j2] + cw[0][2 * j2] * bflo(w0) + cw[1][2 * j2] * bflo(w1) + cw[2][2 * j2] * bflo(w2) + cw[3][2 * j2] * bflo(w3);
            const float hi = cb[2 * j2 + 1] + cw[0][2 * j2 + 1] * bfhi(w0) + cw[1][2 * j2 + 1] * bfhi(w1) + cw[2][2 * j2 + 1] * bfhi(w2) + cw[3][2 * j2 + 1] * bfhi(w3);
            o[2 * j2] = silu_f(lo); o[2 * j2 + 1] = silu_f(hi);
        }
        u32x4 pk; pk.x = cvt_pk_bf16(o[0], o[1]); pk.y = cvt_pk_bf16(o[2], o[3]); pk.z = cvt_pk_bf16(o[4], o[5]); pk.w = cvt_pk_bf16(o[6], o[7]);
        if (m.kind == 2) *(GAS u32x4*)(XBC + (row0 + s) * CD + m.gch) = pk;
        *(LAS u32x4*)(img + (m.kind == 0 ? img_off<true>(s, chl) : img_off<false>(s, chl))) = pk;
    }
}
__device__ __forceinline__ void ssd_local_phase(Frame& F) {
    bf16_t* const XBC = (bf16_t*)(F.ws + WS_XBC); bf16_t* const ST = (bf16_t*)(F.ws + WS_HPREV); float* const CDEC = (float*)(F.ws + WS_CDEC); float* const EAQ = (float*)(F.ws + WS_EAQ);
    const int w = F.wave, lane = F.lane, q0 = 16 * w, hr = w >> 1, nh = w & 1;
    const LAS float* const acs = (const LAS float*)(F.lds + TAB_ACS); const LAS float* const dtl = (const LAS float*)(F.lds + TAB_DT); const LAS float* const sdec = (const LAS float*)(F.lds + TAB_SD);
    u32x4 raw[19]; float d0 = 0.f, d1 = 0.f;
    constexpr int NIT = BATCH * NCHUNK * NG;
    if (F.vcu < NIT) { const int it = F.vcu, g = it & 7, c = (it >> 3) & (NCHUNK - 1), b = it >> 7; const size_t row0 = (size_t)b * SEQ + (size_t)c * 128;
        ssd_conv_load(F, row0, b, c, g, raw); ssd_tables_load(F, row0, g, d0, d1); }
    for (int it = F.vcu; it < NIT; it += F.G) {
        const int g = it & 7, c = (it >> 3) & (NCHUNK - 1), b = it >> 7;
        const size_t row0 = (size_t)b * SEQ + (size_t)c * 128;
        asm volatile("s_waitcnt vmcnt(0)" ::: "memory");
        ssd_tables_compute(F, g, d0, d1);
        ssd_conv_store_local(F, row0, g, raw);
        __syncthreads();
        int lane_ = lane; asm volatile("" : "+v"(lane_));
        const int ql = lane_ & 15, gq = lane_ >> 4, qq = ql >> 2, pp = ql & 3;
        int cfo[4], bbo[4], xbo[2][4], sbo[4];
#pragma unroll
        for (int ks = 0; ks < 4; ++ks) { cfo[ks] = IMG_C + img_off<false>(q0 + ql, 4 * ks + gq); bbo[ks] = IMG_B + img_off<false>(ql, 4 * ks + gq); }
#pragma unroll
        for (int rr = 0; rr < 2; ++rr)
#pragma unroll
                for (int pf = 0; pf < 4; ++pf) xbo[rr][pf] = IMG_X + img_off<true>(4 * gq + qq, 8 * rr + 2 * pf + (pp >> 1)) + 8 * (pp & 1);
#pragma unroll
        for (int nf = 0; nf < 4; ++nf) { const int col = 64 * nh + 16 * nf + 4 * pp; sbo[nf] = IMG_B + img_off<false>(4 * gq + qq, col >> 3) + 2 * (col & 7); }
        {
            bf16x8 cf[4];
#pragma unroll
            for (int ks = 0; ks < 4; ++ks) cf[ks] = *(const LAS bf16x8*)(F.lds + cfo[ks]);
            const LAS float* const acs_l = acs + 16 * gq; const LAS float* const dtl_l = dtl + 16 * gq;
            f32x4 acc[4][4]; float aq[4];
#pragma unroll
            for (int r = 0; r < 4; ++r) { aq[r] = acs[(q0 + ql) * 4 + r];
#pragma unroll
                for (int pf = 0; pf < 4; ++pf) acc[r][pf] = (f32x4){0.f, 0.f, 0.f, 0.f}; }
#pragma unroll
            for (int ks = 0; ks < 4; ++ks) if (2 * ks <= w) {
                f32x4 cb[2];
#pragma unroll
                for (int hf = 0; hf < 2; ++hf) { cb[hf] = (f32x4){0.f, 0.f, 0.f, 0.f};
                    if (2 * ks + hf <= w) {
#pragma unroll
                        for (int kn = 0; kn < 4; ++kn) { const bf16x8 bfr = *(const LAS bf16x8*)(F.lds + bbo[kn] + 4096 * (2 * ks + hf)); cb[hf] = __builtin_amdgcn_mfma_f32_16x16x32_bf16(bfr, cf[kn], cb[hf], 0, 0, 0); } } }
#pragma unroll
                for (int r = 0; r < 4; ++r) {
                    const float Dh = *(const GAS float*)(F.in[I_DSKIP] + g * HPG + r);
                    float v[8];
#pragma unroll
                    for (int hf = 0; hf < 2; ++hf) { const int sf = 2 * ks + hf;
#pragma unroll
                        for (int rg = 0; rg < 4; ++rg) { const int sl = 4 * gq + rg;
                            float val = 0.f;
                            if (sf <= w) { const float as = acs_l[64 * sf + 4 * rg + r], d = dtl_l[64 * sf + 4 * rg + r];
                                val = cb[hf][rg] * __expf(aq[r] - as) * d;
                                if (sf == w) { if (sl > ql) val = 0.f; else if (sl == ql) val += Dh; } }
                            v[4 * hf + rg] = val; } }
                    u32x4 pk; pk.x = cvt_pk_bf16(v[0], v[1]); pk.y = cvt_pk_bf16(v[2], v[3]); pk.z = cvt_pk_bf16(v[4], v[5]); pk.w = cvt_pk_bf16(v[6], v[7]);
                    const bf16x8 wf = __builtin_bit_cast(bf16x8, pk);
#pragma unroll
                    for (int pf = 0; pf < 4; ++pf) {
                        const LAS unsigned char* const xb = F.lds + xbo[r & 1][pf] + (r >> 1) * 32768 + 8192 * ks;
                        const bf16x8 xf = tr_pair(xb, xb + 4096);
                        acc[r][pf] = __builtin_amdgcn_mfma_f32_16x16x32_bf16(xf, wf, acc[r][pf], 0, 0, 0); }
                }
            }
            LAS unsigned char* const stg = F.lds + IMG_C + w * 4096;
            bf16_t* const og = XBC + (row0 + q0 + (lane >> 4)) * CD + g * 256 + 8 * (lane & 15);
#pragma unroll
            for (int h = 0; h < 2; ++h) {
#pragma unroll
                for (int rr = 0; rr < 2; ++rr)
#pragma unroll
                    for (int pf = 0; pf < 4; ++pf) { const int r = 2 * h + rr, ch = 8 * rr + 2 * pf + (gq >> 1);
                        u32x2 o; o.x = cvt_pk_bf16(acc[r][pf][0], acc[r][pf][1]); o.y = cvt_pk_bf16(acc[r][pf][2], acc[r][pf][3]);
                        *(LAS u32x2*)(stg + ql * 256 + ((ch ^ ql) & 15) * 16 + (gq & 1) * 8) = o; }
                asm volatile("s_waitcnt lgkmcnt(0)" ::: "memory");
#pragma unroll
                for (int i = 0; i < 4; ++i) { const int row = 4 * i + (lane >> 4); const u32x4 v = *(const LAS u32x4*)(stg + row * 256 + (((lane & 15) ^ row) & 15) * 16); *(GAS u32x4*)(og + (size_t)(4 * i) * CD + 128 * h) = v; }
                asm volatile("s_waitcnt lgkmcnt(0)" ::: "memory");
            }
            if (gq == 0) *(GAS f32x4*)(EAQ + (row0 + q0 + ql) * 32 + g * HPG) = (f32x4){__expf(aq[0]), __expf(aq[1]), __expf(aq[2]), __expf(aq[3])};
        }
        asm volatile("" ::: "memory"); __builtin_amdgcn_sched_barrier(0);
        if (it + F.G < NIT) { const int it2 = it + F.G, g2 = it2 & 7, c2 = (it2 >> 3) & (NCHUNK - 1), b2 = it2 >> 7; const size_t row2 = (size_t)b2 * SEQ + (size_t)c2 * 128;
            ssd_conv_load(F, row2, b2, c2, g2, raw); ssd_tables_load(F, row2, g2, d0, d1); }
        {
            const int head = g * HPG + hr;
            bf16_t* const stp = ST + ((((size_t)b * NCHUNK + c) * NH + head) * HD) * DSTATE + 64 * nh;
            LAS unsigned char* const stg = F.lds + IMG_C + w * 4096;
#pragma unroll
            for (int ph2 = 0; ph2 < 2; ++ph2) {
                f32x4 acc[4][2];
#pragma unroll
                for (int i = 0; i < 4; ++i)
#pragma unroll
                    for (int j = 0; j < 2; ++j) acc[i][j] = (f32x4){0.f, 0.f, 0.f, 0.f};
#pragma unroll
                for (int ks = 0; ks < 4; ++ks) {
                    asm volatile("" ::: "memory");
                    float sd[8];
#pragma unroll
                    for (int j = 0; j < 8; ++j) sd[j] = sdec[(32 * ks + 16 * (j >> 2) + 4 * gq + (j & 3)) * 4 + hr];
                    bf16x8 af[4], xf[2];
#pragma unroll
                    for (int nf = 0; nf < 4; ++nf) { const LAS unsigned char* p = F.lds + sbo[nf] + 8192 * ks; af[nf] = tr_pair(p, p + 4096); }
#pragma unroll
                    for (int pf = 0; pf < 2; ++pf) { const LAS unsigned char* p = F.lds + xbo[hr & 1][2 * ph2 + pf] + (hr >> 1) * 32768 + 8192 * ks;
                        const u32x4 xr = __builtin_bit_cast(u32x4, tr_pair(p, p + 4096));
                        u32x4 xs; xs.x = cvt_pk_bf16(bflo(xr.x) * sd[0], bfhi(xr.x) * sd[1]); xs.y = cvt_pk_bf16(bflo(xr.y) * sd[2], bfhi(xr.y) * sd[3]);
                        xs.z = cvt_pk_bf16(bflo(xr.z) * sd[4], bfhi(xr.z) * sd[5]); xs.w = cvt_pk_bf16(bflo(xr.w) * sd[6], bfhi(xr.w) * sd[7]);
                        xf[pf] = __builtin_bit_cast(bf16x8, xs); }
#pragma unroll
                    for (int nf = 0; nf < 4; ++nf)
#pragma unroll
                        for (int pf = 0; pf < 2; ++pf) acc[nf][pf] = __builtin_amdgcn_mfma_f32_16x16x32_bf16(af[nf], xf[pf], acc[nf][pf], 0, 0, 0);
                }
#pragma unroll
                for (int pf = 0; pf < 2; ++pf)
#pragma unroll
                    for (int nf = 0; nf < 4; ++nf) { const int row = 16 * pf + ql, ch = 2 * nf + (gq >> 1);
                        u32x2 o; o.x = cvt_pk_bf16(acc[nf][pf][0], acc[nf][pf][1]); o.y = cvt_pk_bf16(acc[nf][pf][2], acc[nf][pf][3]);
                        *(LAS u32x2*)(stg + row * 128 + ((ch ^ row) & 7) * 16 + (gq & 1) * 8) = o; }
                asm volatile("s_waitcnt lgkmcnt(0)" ::: "memory");
#pragma unroll
                for (int i = 0; i < 4; ++i) { const int row = 8 * i + (lane_ >> 3), ch = lane_ & 7;
                    const u32x4 v = *(const LAS u32x4*)(stg + row * 128 + ((ch ^ row) & 7) * 16);
                    *(GAS u32x4*)(stp + (size_t)(32 * ph2 + row) * DSTATE + 8 * ch) = v; }
                asm volatile("s_waitcnt lgkmcnt(0)" ::: "memory");
            }
            if (F.tid < 4) *(GAS float*)(CDEC + ((size_t)b * NCHUNK + c) * NH + g * HPG + F.tid) = __expf(acs[127 * 4 + F.tid]);
        }
        __syncthreads();
    }
}
__device__ __forceinline__ void ssd_final_phase(Frame& F) {
    const bf16_t* const XBC = (const bf16_t*)(F.ws + WS_XBC); const bf16_t* const HP = (const bf16_t*)(F.ws + WS_HPREV); bf16_t* const ZY = (bf16_t*)(F.ws + WS_Z); const float* const EAQ = (const float*)(F.ws + WS_EAQ);
    const int w = F.wave, lane = F.lane, ql = lane & 15, gq = lane >> 4, q0 = 16 * w;
    int cfo[4], hbo[4];
#pragma unroll
    for (int ks = 0; ks < 4; ++ks) { cfo[ks] = IMG_C + img_off<false>(q0 + ql, 4 * ks + gq); hbo[ks] = img_off<false>(ql, 4 * ks + gq); }
    LAS unsigned char* const stg = F.lds + IMG_B + w * 4096;
    const int st_g = ((lane >> 4) * 256) + ((((lane & 15) ^ (lane >> 4))) * 16);
    u32x4 creg[4], hreg[8];
    constexpr int NIT = BATCH * NCHUNK * NG;
    auto loads = [&](int it) __attribute__((always_inline)) {
        const int g = it & 7, c = (it >> 3) & (NCHUNK - 1), b = it >> 7; const size_t row0 = (size_t)b * SEQ + (size_t)c * 128;
#pragma unroll
        for (int i = 0; i < 4; ++i) { const int e = F.tid + 512 * i; creg[i] = *(const GAS u32x4*)(XBC + (row0 + (e >> 4)) * CD + DI + NG * DSTATE + g * DSTATE + 8 * (e & 15)); }
        if (c > 0) { const u32x4* hsrc = (const u32x4*)(HP + ((((size_t)b * NCHUNK + c) * NH + g * HPG) * HD) * DSTATE) + F.tid;
#pragma unroll
            for (int i = 0; i < 8; ++i) hreg[i] = *(const GAS u32x4*)(hsrc + 512 * i); } };
    if (F.vcu < NIT) loads(F.vcu);
    for (int it = F.vcu; it < NIT; it += F.G) {
        const int g = it & 7, c = (it >> 3) & (NCHUNK - 1), b = it >> 7;
        const size_t row0 = (size_t)b * SEQ + (size_t)c * 128;
#pragma unroll
        for (int i = 0; i < 4; ++i) { const int e = F.tid + 512 * i; *(LAS u32x4*)(F.lds + IMG_C + img_off<false>(e >> 4, e & 15)) = creg[i]; }
        if (c > 0) {
#pragma unroll
            for (int i = 0; i < 8; ++i) { const int e = F.tid + 512 * i, hr_ = e >> 10, p_ = (e >> 4) & 63, ch_ = e & 15; *(LAS u32x4*)(F.lds + IMG_X + hr_ * 16384 + img_off<false>(p_, ch_)) = hreg[i]; } }
        __syncthreads();
        if (it + F.G < NIT) loads(it + F.G);
        bf16x8 cf[4];
#pragma unroll
        for (int ks = 0; ks < 4; ++ks) cf[ks] = *(const LAS bf16x8*)(F.lds + cfo[ks]);
        const f32x4 eaq = *(const GAS f32x4*)(EAQ + (row0 + q0 + ql) * 32 + g * HPG);
        const size_t grow = row0 + q0 + (lane >> 4);
        const bf16_t* const zg = ZY + grow * DI + g * 256 + 8 * (lane & 15); const bf16_t* const yg = XBC + grow * CD + g * 256 + 8 * (lane & 15);
        u32x4 zin[2][4], yin[2][4];
#pragma unroll
        for (int h = 0; h < 2; ++h)
#pragma unroll
            for (int i = 0; i < 4; ++i) { zin[h][i] = *(const GAS u32x4*)(zg + (size_t)(4 * i) * DI + 128 * h); yin[h][i] = *(const GAS u32x4*)(yg + (size_t)(4 * i) * CD + 128 * h); }
        f32x4 acc[4][4]; float ssum = 0.f;
#pragma unroll
        for (int h = 0; h < 2; ++h) {
            u32x2 zr[2][4], yr[2][4];
#pragma unroll
            for (int i = 0; i < 4; ++i) { const int row = 4 * i + (lane >> 4); *(LAS u32x4*)(stg + row * 256 + (((lane & 15) ^ row) & 15) * 16) = zin[h][i]; }
            asm volatile("s_waitcnt lgkmcnt(0)" ::: "memory");
#pragma unroll
            for (int rr = 0; rr < 2; ++rr)
#pragma unroll
                for (int pf = 0; pf < 4; ++pf) { const int ch = 8 * rr + 2 * pf + (gq >> 1); zr[rr][pf] = *(const LAS u32x2*)(stg + ql * 256 + ((ch ^ ql) & 15) * 16 + (gq & 1) * 8); }
            asm volatile("s_waitcnt lgkmcnt(0)" ::: "memory");
#pragma unroll
            for (int i = 0; i < 4; ++i) { const int row = 4 * i + (lane >> 4); *(LAS u32x4*)(stg + row * 256 + (((lane & 15) ^ row) & 15) * 16) = yin[h][i]; }
            asm volatile("s_waitcnt lgkmcnt(0)" ::: "memory");
#pragma unroll
            for (int rr = 0; rr < 2; ++rr)
#pragma unroll
                for (int pf = 0; pf < 4; ++pf) { const int ch = 8 * rr + 2 * pf + (gq >> 1); yr[rr][pf] = *(const LAS u32x2*)(stg + ql * 256 + ((ch ^ ql) & 15) * 16 + (gq & 1) * 8); }
            asm volatile("s_waitcnt lgkmcnt(0)" ::: "memory");
#pragma unroll
            for (int rr = 0; rr < 2; ++rr) { const int r = 2 * h + rr;
#pragma unroll
                for (int pf = 0; pf < 4; ++pf) { f32x4 yo = (f32x4){0.f, 0.f, 0.f, 0.f};
                    if (c > 0) {
#pragma unroll
                        for (int ks = 0; ks < 4; ++ks) { const bf16x8 hf_ = *(const LAS bf16x8*)(F.lds + IMG_X + r * 16384 + hbo[ks] + 4096 * pf); yo = __builtin_amdgcn_mfma_f32_16x16x32_bf16(hf_, cf[ks], yo, 0, 0, 0); } }
                    const u32x2 zz = zr[rr][pf], yy = yr[rr][pf];
                    const f32x4 y = ((f32x4){bflo(yy.x), bfhi(yy.x), bflo(yy.y), bfhi(yy.y)} + yo * eaq[r]) * (f32x4){bflo(zz.x), bfhi(zz.x), bflo(zz.y), bfhi(zz.y)};
                    acc[r][pf] = y; ssum += (y[0] * y[0] + y[1] * y[1]) + (y[2] * y[2] + y[3] * y[3]); } }
        }
        ssum += __shfl_xor(ssum, 16); ssum += __shfl_xor(ssum, 32);
        const float rsn = __builtin_amdgcn_rsqf(ssum * (1.0f / 256.0f) + EPS);
        bf16_t* const og = ZY + grow * DI + g * 256 + 8 * (lane & 15);
#pragma unroll
        for (int h = 0; h < 2; ++h) {
#pragma unroll
            for (int rr = 0; rr < 2; ++rr)
#pragma unroll
                for (int pf = 0; pf < 4; ++pf) { const int r = 2 * h + rr, ch = 8 * rr + 2 * pf + (gq >> 1);
                    u32x2 o; o.x = cvt_pk_bf16(acc[r][pf][0] * rsn, acc[r][pf][1] * rsn); o.y = cvt_pk_bf16(acc[r][pf][2] * rsn, acc[r][pf][3] * rsn);
                    *(LAS u32x2*)(stg + ql * 256 + ((ch ^ ql) & 15) * 16 + (gq & 1) * 8) = o; }
            asm volatile("s_waitcnt lgkmcnt(0)" ::: "memory");
#pragma unroll
            for (int i = 0; i < 4; ++i) { const int row = 4 * i + (lane >> 4); const u32x4 v = *(const LAS u32x4*)(stg + row * 256 + (((lane & 15) ^ row) & 15) * 16); *(GAS u32x4*)(og + (size_t)(4 * i) * DI + 128 * h) = v; }
            asm volatile("s_waitcnt lgkmcnt(0)" ::: "memory");
        }
        __syncthreads();
    }
}

__device__ __forceinline__ void ssd_seq_phase(Frame& F) {
    const int r = F.wave & 3, nh = F.wave >> 2, lane = F.lane, idx = r * 64 + lane;
    LAS float* const bc = (LAS float*)F.lds;
    LAS float* const lxs = bc + 2048;
    LAS float* const yp = bc + 4096;
    LAS float* const ldt = bc + 8192; LAS float* const ssq = bc + 8192 + 32;
    const bf16_t* const XBC = (const bf16_t*)(F.ws + WS_XBC); const bf16_t* const Zs = (const bf16_t*)(F.ws + WS_Z); bf16_t* const YN = (bf16_t*)(F.ws + WS_Z);
    const float* const DT = (const float*)(F.ws + WS_DT);
    const float* const convw = F.in[I_CONVW]; const float* const convb = F.in[I_CONVB];
    for (int it = F.vcu; it < DECB * NG; it += F.G) {
        const int b = it >> 3, g = it & 7, head = g * HPG + r;
        const size_t row0 = (size_t)MP + (size_t)b * DECS;
        const int xch = g * 256 + idx;
        {
            const int ch = (nh == 0) ? ((idx < 128) ? (DI + g * DSTATE + idx) : (DI + NG * DSTATE + g * DSTATE + (idx - 128))) : xch;
            float cw[4];
#pragma unroll
            for (int k = 0; k < 4; ++k) cw[k] = *(const GAS float*)(convw + (size_t)k * CD + ch);
            const float cbv = *(const GAS float*)(convb + ch);
            const float* cs = F.in[I_CONV] + (size_t)b * 3 * CD;
            float x3 = *(const GAS float*)(cs + ch), x2 = *(const GAS float*)(cs + CD + ch), x1 = *(const GAS float*)(cs + 2 * CD + ch);
            LAS float* const dst = (nh == 0) ? bc : lxs;
#pragma unroll
            for (int j = 0; j < 8; ++j) {
                const float xr = bf2f(*(const GAS bf16_t*)(XBC + (row0 + j) * CD + ch));
                const float cx = cbv + cw[0] * x3 + cw[1] * x2 + cw[2] * x1 + cw[3] * xr; x3 = x2; x2 = x1; x1 = xr;
                dst[j * 256 + idx] = silu_f(cx);
            }
            if (nh == 1 && lane < 8) ldt[lane * 4 + r] = *(const GAS float*)(DT + (row0 + lane) * 32 + head);
        }
        __syncthreads();
        {
            const float Ah = -__expf(*(const GAS float*)(F.in[I_ALOG] + head));
            const int pg = lane >> 4, nc = lane & 15;
            f32x4 h[16];
            const float* const hin = F.in[I_SSM] + (((size_t)b * NH + head) * HD + 16 * pg) * DSTATE + 64 * nh + 4 * nc;
#pragma unroll
            for (int i = 0; i < 16; ++i) h[i] = *(const GAS f32x4*)(hin + (size_t)i * DSTATE);
            for (int j = 0; j < 8; ++j) {
                const float dtv = ldt[j * 4 + r], dA = __expf(dtv * Ah);
                const f32x4 Bv = *(const LAS f32x4*)(bc + j * 256 + 64 * nh + 4 * nc), Cv = *(const LAS f32x4*)(bc + j * 256 + 128 + 64 * nh + 4 * nc);
                float part[16];
#pragma unroll
                for (int i4 = 0; i4 < 4; ++i4) { const f32x4 xs4 = *(const LAS f32x4*)(lxs + j * 256 + r * 64 + 16 * pg + 4 * i4);
#pragma unroll
                    for (int k = 0; k < 4; ++k) { const int i = 4 * i4 + k; const float dx = dtv * xs4[k];
                        h[i] = h[i] * dA + Bv * dx;
                        part[i] = (Cv.x * h[i].x + Cv.y * h[i].y) + (Cv.z * h[i].z + Cv.w * h[i].w); } }
#pragma unroll
                for (int i = 0; i < 8; ++i) { const bool up = (nc & 8) != 0; const float keep = up ? part[i + 8] : part[i], send = up ? part[i] : part[i + 8]; part[i] = keep + __shfl_xor(send, 8); }
#pragma unroll
                for (int i = 0; i < 4; ++i) { const bool up = (nc & 4) != 0; const float keep = up ? part[i + 4] : part[i], send = up ? part[i] : part[i + 4]; part[i] = keep + __shfl_xor(send, 4); }
#pragma unroll
                for (int i = 0; i < 2; ++i) { const bool up = (nc & 2) != 0; const float keep = up ? part[i + 2] : part[i], send = up ? part[i] : part[i + 2]; part[i] = keep + __shfl_xor(send, 2); }
                { const bool up = (nc & 1) != 0; const float keep = up ? part[1] : part[0], send = up ? part[0] : part[1]; part[0] = keep + __shfl_xor(send, 1); }
                yp[(j * 2 + nh) * 256 + r * 64 + 16 * pg + nc] = part[0];
            }
            float* const hout = F.out + O_SSM_S + (((size_t)b * NH + head) * HD + 16 * pg) * DSTATE + 64 * nh + 4 * nc;
#pragma unroll
            for (int i = 0; i < 16; ++i) *(GAS f32x4*)(hout + (size_t)i * DSTATE) = h[i];
        }
        __syncthreads();
        float ygv[4];
        {
            const float Dh = *(const GAS float*)(F.in[I_DSKIP] + head);
#pragma unroll
            for (int jj = 0; jj < 4; ++jj) { const int j = 4 * nh + jj;
                const float y = (yp[(j * 2) * 256 + idx] + yp[(j * 2 + 1) * 256 + idx]) + Dh * lxs[j * 256 + idx];
                ygv[jj] = y * bf2f(*(const GAS bf16_t*)(Zs + (row0 + j) * DI + xch));
                const float ss = wave_sum(ygv[jj] * ygv[jj]);
                if (lane == 0) ssq[j * 4 + r] = ss; }
        }
        __syncthreads();
#pragma unroll
        for (int jj = 0; jj < 4; ++jj) { const int j = 4 * nh + jj;
            const f32x4 s4 = *(const LAS f32x4*)(ssq + j * 4);
            const float rsn = __builtin_amdgcn_rsqf(((s4.x + s4.y) + (s4.z + s4.w)) * (1.0f / 256.0f) + EPS);
            *(GAS bf16_t*)(YN + (row0 + j) * DI + xch) = (bf16_t)f2bf(ygv[jj] * rsn); }
        __syncthreads();
    }
}
template <int W> __device__ __forceinline__ void pool_run(const bf16_t* V, bf16_t* PO, int run, int cv) {
    const int row0 = run * 16, t0 = row0 & (SEQ - 1);
    u32x4 raw[16 + W - 1];
#pragma unroll
    for (int e = 0; e < 16 + W - 1; ++e) {
        const int dt_ = e - (W - 1);
        if (t0 + dt_ >= 0) raw[e] = *(const GAS u32x4*)(V + (size_t)(row0 + dt_) * PD + cv); else raw[e] = (u32x4){0u, 0u, 0u, 0u};
    }
    f32x4 s0 = (f32x4){0.f, 0.f, 0.f, 0.f}, s1 = s0;
#pragma unroll
    for (int e = 0; e < W - 1; ++e) { f32x4 x0, x1; pg8::unpack8(raw[e], x0, x1); s0 += x0; s1 += x1; }
#pragma unroll
    for (int i = 0; i < 16; ++i) {
        f32x4 c0, c1; pg8::unpack8(raw[i + W - 1], c0, c1);
        s0 += c0; s1 += c1;
        const int t = t0 + i; const float ic = 1.0f / (float)((t + 1 < W) ? t + 1 : W);
        const f32x4 o0 = s0 * ic - c0, o1 = s1 * ic - c1;
        u32x4 o; o.x = pk2(o0.x, o0.y); o.y = pk2(o0.z, o0.w); o.z = pk2(o1.x, o1.y); o.w = pk2(o1.z, o1.w);
        *(GAS u32x4*)(PO + (size_t)(row0 + i) * PD + cv) = o;
        f32x4 x0, x1; pg8::unpack8(raw[i], x0, x1); s0 -= x0; s1 -= x1;
    }
}
template <int W> __device__ __forceinline__ void pool_run_s(const bf16_t* V, bf16_t* PO, const float* sp, int b, int cv) {
    const size_t row0 = (size_t)MP + (size_t)b * DECS;
    f32x4 a0[8 + W - 1], a1[8 + W - 1];
#pragma unroll
    for (int e = 0; e < 8 + W - 1; ++e) { const int t = e - (W - 1);
        if (t >= 0) pg8::unpack8(*(const GAS u32x4*)(V + (row0 + t) * PD + cv), a0[e], a1[e]);
        else { const float* p = sp + ((size_t)b * PBUF + (PBUF + t)) * PD + cv; a0[e] = *(const GAS f32x4*)p; a1[e] = *(const GAS f32x4*)(p + 4); } }
    f32x4 s0 = (f32x4){0.f, 0.f, 0.f, 0.f}, s1 = s0;
#pragma unroll
    for (int e = 0; e < W - 1; ++e) { s0 += a0[e]; s1 += a1[e]; }
    const float ic = 1.0f / (float)W;
#pragma unroll
    for (int i = 0; i < 8; ++i) {
        s0 += a0[i + W - 1]; s1 += a1[i + W - 1];
        const f32x4 o0 = s0 * ic - a0[i + W - 1], o1 = s1 * ic - a1[i + W - 1];
        u32x4 o; o.x = pk2(o0.x, o0.y); o.y = pk2(o0.z, o0.w); o.z = pk2(o1.x, o1.y); o.w = pk2(o1.z, o1.w);
        *(GAS u32x4*)(PO + (row0 + i) * PD + cv) = o;
        s0 -= a0[i]; s1 -= a1[i];
    }
}
__device__ __forceinline__ void pool_phase(Frame& F) {
    const bf16_t* const V = (const bf16_t*)(F.ws + WS_V); bf16_t* const PO = (bf16_t*)(F.out + O_Y);
    const float* const sp = F.in[I_POOL];
    const int gt = F.vcu * NTHREADS + F.tid, NT = F.G * NTHREADS;
    for (int e = gt; e < (MP / 16) * 128; e += NT) {
        const int c32 = e & 31, rl = (e >> 5) & 1, grp = (e >> 6) & 3, run = (e >> 8) * 2 + rl, cv = (grp * 32 + c32) * 8;
        if (grp == 0) pool_run<2>(V, PO, run, cv); else if (grp == 1) pool_run<4>(V, PO, run, cv); else if (grp == 2) pool_run<8>(V, PO, run, cv); else pool_run<16>(V, PO, run, cv);
    }
    for (int e = gt; e < (MS / 8) * 128; e += NT) {
        const int c32 = e & 31, grp = (e >> 5) & 3, b = e >> 7, cv = (grp * 32 + c32) * 8;
        if (grp == 0) pool_run_s<2>(V, PO, sp, b, cv); else if (grp == 1) pool_run_s<4>(V, PO, sp, b, cv); else if (grp == 2) pool_run_s<8>(V, PO, sp, b, cv); else pool_run_s<16>(V, PO, sp, b, cv);
    }
    float* const ops = F.out + O_POOL_S;
    for (int e = gt; e < DECB * 7 * (PD / 4); e += NT) {
        const int c4 = e & 255, i = (e >> 8) % 7, b = (e >> 8) / 7;
        *(GAS f32x4*)(ops + ((size_t)b * PBUF + i) * PD + c4 * 4) = *(const GAS f32x4*)(sp + ((size_t)b * PBUF + 8 + i) * PD + c4 * 4);
    }
}
__device__ __forceinline__ void final_phase(Frame& F) {
    const int gw = F.vcu * NWAVES + F.wave, NGW = F.G * NWAVES, lane = F.lane;
    const float* const st = (const float*)(F.ws + WS_STATS_A); const float* const gf = F.in[I_NFINAL];
    f32x4 gv[4];
#pragma unroll
    for (int j = 0; j < 4; ++j) gv[j] = *((const GAS f32x4*)gf + lane + 64 * j);
    const bf16_t* const h4 = (const bf16_t*)(F.ws + WS_ACT);
    for (int m = gw; m < M; m += NGW) {
        const GAS f32x4* sp = (const GAS f32x4*)(st + (size_t)m * 16);
        const f32x4 a = sp[0], b = sp[1], c = sp[2], d = sp[3]; const f32x4 s = (a + b) + (c + d);
        const float rs = __builtin_amdgcn_rsqf(((s[0] + s[1]) + (s[2] + s[3])) * (1.0f / 1024.0f) + EPS);
        const GAS u32x2* hr = (const GAS u32x2*)(h4 + (size_t)m * DM) + lane;
        GAS f32x4* yr = (GAS f32x4*)(F.out + (size_t)m * DM) + lane;
#pragma unroll
        for (int j = 0; j < 4; ++j) { const u32x2 w = hr[64 * j]; yr[64 * j] = (f32x4){bflo(w.x), bfhi(w.x), bflo(w.y), bfhi(w.y)} * rs * gv[j]; }
    }
}

constexpr int NPHASES = 13;
struct Args { const float* in[30]; float* out; unsigned char* ws; int ph_lo, ph_hi, li, pad; };
__global__ void __launch_bounds__(NTHREADS, 2) mk_fwd(Args args) {
    extern __shared__ __attribute__((aligned(16))) unsigned char lds[];
    Frame F;
    F.lds = (LAS unsigned char*)lds;
    F.MISC = (volatile LAS unsigned*)(F.lds + MISC_OFF);
    F.tid = threadIdx.x; F.lane = F.tid & 63; F.wave = __builtin_amdgcn_readfirstlane(F.tid >> 6);
    F.G = gridDim.x; { const int bx = blockIdx.x; F.vcu = (F.G % 8 == 0) ? (bx % 8) * (F.G / 8) + bx / 8 : bx; }
    F.ws = args.ws; F.out = args.out; F.ctl = (gu32*)(args.ws + WS_CTL);
#pragma unroll
    for (int i = 0; i < 30; ++i) F.in[i] = args.in[i];
    for (int u = F.tid; u < (LDS_BYTES - LDSCTL_OFF) / 4; u += NTHREADS) ((LAS unsigned*)(F.lds + LDSCTL_OFF))[u] = 0u;
    __syncthreads();
    const int lo = args.ph_lo, hi = args.ph_hi;
    XcdBarrier bar; bar.bar = (unsigned*)(F.ctl + CW_BAR); bar.x = 0; bar.st = nullptr;
    if (hi - lo > 1) bar = xcd_barrier_post((unsigned*)(F.ctl + CW_BAR), F.MISC + 8);
#ifndef PHMASK
#define PHMASK 0x1fff
#endif
#define IN(k) (((PHMASK >> (k)) & 1) && lo <= (k) && (k) < hi)
#define SEAM(k) do { if (IN(k) && IN((k) + 1)) xcd_barrier(bar); } while (0)
#define PH_BEGIN(k) if (IN(k)) { auto body_ = [&]() __attribute__((always_inline))
#define PH_END(k) ; body_(); if ((REP_MASK >> (k)) & 1) { xcd_barrier(bar); body_(); } } SEAM(k);

    bf16_t* const XB = (bf16_t*)(F.ws + WS_XB); bf16_t* const HB = (bf16_t*)(F.ws + WS_HB); bf16_t* const ACT = (bf16_t*)(F.ws + WS_ACT);
    bf16_t* const Zb = (bf16_t*)(F.ws + WS_Z); bf16_t* const XBCb = (bf16_t*)(F.ws + WS_XBC); bf16_t* const Vb = (bf16_t*)(F.ws + WS_V); bf16_t* const GATES = (bf16_t*)(F.ws + WS_GATES);
    bf16_t* const POOLED = (bf16_t*)(F.out + O_Y); bf16_t* const MERGED = (bf16_t*)(F.ws + WS_MERGED); bf16_t* const Qb = (bf16_t*)(F.ws + WS_Q); bf16_t* const PB = (bf16_t*)(F.ws + WS_PB);
    float* const T1 = (float*)(F.ws + WS_T1); float* const stA = (float*)(F.ws + WS_STATS_A); float* const stB = (float*)(F.ws + WS_STATS_B); float* const DTb = (float*)(F.ws + WS_DT);
    float* const H = F.out + O_Y;
    pg8::StaticOrder S;

    PH_BEGIN(0) { p0_prologue(F); } PH_END(0)
    PH_BEGIN(1) {
        pg8::Gemm g{XB, (const bf16_t*)(F.ws + WS_WGU1), M, 2 * DFF, DM, DM, 0}; S.init(M, 2 * DFF, F.G, (int)blockIdx.x);
        pg8::Epi E{}; E.kind = pg8::EK_GU; E.stats_in = stA; E.obf = ACT; E.ldo = DFF;
        const int u1 = 1 + (int)blockIdx.x % 5; S.lim = min(S.nwg, u1 * F.G);
#pragma nounroll
        for (int part = 0; part < 2; ++part) {
            pg8::gemm_phase(F.lds, g, S, E);
            if (part == 0) { deferred_transposes<1>(F); S.c += u1 * F.G; S.lim = S.nwg; }
        }
        pg8::Gemm g2{(const bf16_t*)(F.ws + WS_WPOT), (const bf16_t*)(F.ws + WS_WGRP), DM, DM, 256, DM, 256}; S.init_tail(DM, DM, F.G, (int)blockIdx.x);
        pg8::Epi E2{}; E2.kind = pg8::EK_BF16; E2.obf = (bf16_t*)(F.ws + WS_W2); E2.ldo = DM;
        pg8::gemm_phase(F.lds, g2, S, E2);
    } PH_END(1)
    PH_BEGIN(2) {
        pg8::Gemm g{ACT, (const bf16_t*)(F.ws + WS_WD1), M, DM, DFF, DFF, 0}; S.init(MP, DM, F.G, (int)blockIdx.x);
        pg8::Epi E{}; E.kind = pg8::EK_RES; E.coef = 0.5f; E.res_p = F.in[I_XP]; E.res_s = F.in[I_XS]; E.obf = HB; E.stats_out = stB;
        pg8::gemm_phase(F.lds, g, S, E);
        pg8::gemm_small(F.lds, g, E, MP, MS, F.G, (int)blockIdx.x);
    } PH_END(2)
    PH_BEGIN(3) {
        pg8::Gemm g{HB, (const bf16_t*)(F.ws + WS_WIN), M, NIN, DM, DM, 0}; S.init(M, NIN, F.G, (int)blockIdx.x);
        pg8::Epi E{}; E.kind = pg8::EK_WIN; E.stats_in = stB; E.Z = Zb; E.XBC = XBCb; E.V = Vb; E.GATES = GATES; E.HALO = (bf16_t*)(F.ws + WS_HALO); E.DT = DTb; E.dt_bias = F.in[I_DTB];
        E.conv_p = F.out + O_CONV_P; E.conv_s = F.out + O_CONV_S; E.pool_p = F.out + O_POOL_P; E.pool_s = F.out + O_POOL_S;
        const int u1 = 1 + (int)blockIdx.x % 9; S.lim = min(S.nwg, u1 * F.G);
#pragma nounroll
        for (int part = 0; part < 2; ++part) {
            pg8::gemm_phase(F.lds, g, S, E);
            if (part == 0) { deferred_transposes<3>(F); S.c += u1 * F.G; S.lim = S.nwg; }
        }
    } PH_END(3)
    PH_BEGIN(4) { ssd_local_phase(F); pool_phase(F); } PH_END(4)
    PH_BEGIN(5) { ssd_scan_phase(F);

        pg8::Gemm g{PB, (const bf16_t*)(F.ws + WS_WPLE), M, DM, PLE, PLE, 0}; S.init(MP, DM, F.G, (int)blockIdx.x);
        pg8::Epi E{}; E.kind = pg8::EK_BF16; E.obf = Qb; E.ldo = DM;
        pg8::gemm_phase(F.lds, g, S, E);
        pg8::gemm_small(F.lds, g, E, MP, MS, F.G, (int)blockIdx.x);
        } PH_END(5)
    PH_BEGIN(6) { ssd_final_phase(F); ssd_seq_phase(F); } PH_END(6)
    PH_BEGIN(7) {
        pg8::Gemm2 g{Zb, (const bf16_t*)(F.ws + WS_WSSO), POOLED, (const bf16_t*)(F.ws + WS_W2), DI, DI, DM, DM, DM}; S.init(MP, DM, F.G, (int)blockIdx.x);
        pg8::gemm_phase2(F.lds, g, S, GATES, MERGED);
        pg8::gemm_small2(F.lds, g, GATES, MERGED, MP, MS, F.G, (int)blockIdx.x);
    } PH_END(7)
    PH_BEGIN(8) {
        pg8::Gemm g{MERGED, (const bf16_t*)(F.ws + WS_WO), M, DM, DM, DM, 0}; S.init(MP, DM, F.G, (int)blockIdx.x);
        pg8::Epi E{}; E.kind = pg8::EK_RES; E.coef = 1.0f; E.res_bf = HB; E.obf = HB; E.stats_out = stA;
        pg8::gemm_phase(F.lds, g, S, E);
        pg8::gemm_small(F.lds, g, E, MP, MS, F.G, (int)blockIdx.x);
    } PH_END(8)
    PH_BEGIN(9) {
        pg8::Gemm g{HB, (const bf16_t*)(F.ws + WS_WGU2), M, 2 * DFF, DM, DM, 0}; S.init(M, 2 * DFF, F.G, (int)blockIdx.x);
        pg8::Epi E{}; E.kind = pg8::EK_GU; E.stats_in = stA; E.obf = ACT; E.ldo = DFF;
        pg8::gemm_phase(F.lds, g, S, E);
    } PH_END(9)
    PH_BEGIN(10) {
        pg8::Gemm g{ACT, (const bf16_t*)(F.ws + WS_WD2), M, DM, DFF, DFF, 0}; S.init(MP, DM, F.G, (int)blockIdx.x);
        pg8::Epi E{}; E.kind = pg8::EK_RES; E.coef = 0.5f; E.res_bf = HB; E.obf = HB; E.stats_out = stB;
        pg8::gemm_phase(F.lds, g, S, E);
        pg8::gemm_small(F.lds, g, E, MP, MS, F.G, (int)blockIdx.x);
    } PH_END(10)
    PH_BEGIN(11) {
        pg8::Gemm g{HB, (const bf16_t*)(F.ws + WS_WPG), M, DM, DM, DM, 0}; S.init(MP, DM, F.G, (int)blockIdx.x);
        pg8::Epi E{}; E.kind = pg8::EK_PLE; E.stats_in = stB; E.q = Qb; E.res_bf = HB; E.obf = ACT; E.stats_out = stA;
        pg8::gemm_phase(F.lds, g, S, E);
        pg8::gemm_small(F.lds, g, E, MP, MS, F.G, (int)blockIdx.x);
    } PH_END(11)
    PH_BEGIN(12) { final_phase(F); } PH_END(12)
#undef IN
#undef SEAM
#undef PH_BEGIN
#undef PH_END
}

extern "C" void kernel_launch(void* const* d_in, const int* in_sizes, int n_in, void* d_out, int out_size, void* d_ws, size_t ws_size, hipStream_t stream) {
    static int grid = 0;
    if (grid == 0) {
        if (n_in != 30 || in_sizes[0] != MP * DM || (size_t)out_size != O_END || ws_size < WS_END) {
            fprintf(stderr, "kernel_launch: shape mismatch: n_in %d in0 %d out %d ws %zu (need %zu)\n", n_in, n_in > 0 ? in_sizes[0] : -1, out_size, ws_size, (size_t)WS_END); grid = -1; return; }
        int dev = 0, cus = 0, per_cu = 0;
        if (hipGetDevice(&dev) != hipSuccess || hipDeviceGetAttribute(&cus, hipDeviceAttributeMultiprocessorCount, dev) != hipSuccess) { grid = -1; return; }
        if (hipFuncSetAttribute((const void*)mk_fwd, hipFuncAttributeMaxDynamicSharedMemorySize, LDS_BYTES) != hipSuccess) { fprintf(stderr, "kernel_launch: hipFuncSetAttribute failed\n"); grid = -1; return; }
        if (hipOccupancyMaxActiveBlocksPerMultiprocessor(&per_cu, (const void*)mk_fwd, NTHREADS, LDS_BYTES) != hipSuccess || per_cu < 1)
            fprintf(stderr, "kernel_launch: occupancy query reports %d workgroups per CU\n", per_cu);
        (void)hipGetLastError();
        grid = cus;
    }
    if (grid < 0) return;
    if (hipMemsetAsync((char*)d_ws + WS_CTL, 0, CTL_ZERO_BYTES, stream) != hipSuccess) { fprintf(stderr, "kernel_launch: memset failed\n"); return; }
    Args a{};
    for (int i = 0; i < 30; ++i) a.in[i] = (const float*)d_in[i];
    a.out = (float*)d_out; a.ws = (unsigned char*)d_ws;
#if MK_MULTI_LAUNCH
    for (int ph = 0; ph < NPHASES; ++ph) { a.ph_lo = ph; a.ph_hi = ph + 1; a.li = ph;
        hipLaunchKernelGGL(mk_fwd, dim3(grid), dim3(NTHREADS), LDS_BYTES, stream, a); }
#else
    a.ph_lo = 0; a.ph_hi = NPHASES; a.li = 0;
    hipLaunchKernelGGL(mk_fwd, dim3(grid), dim3(NTHREADS), LDS_BYTES, stream, a);
#endif
}
```

```cpp
#include <hip/hip_runtime.h>
#include <cstdio>
#include <cstdint>

#define REP_MASK 0x0
#ifndef MK_MULTI_LAUNCH
#define MK_MULTI_LAUNCH 0
#endif

#define GAS __attribute__((address_space(1)))
#define LAS __attribute__((address_space(3)))
typedef unsigned short bf16_t;
typedef short bf16x8 __attribute__((ext_vector_type(8)));
typedef float f32x4 __attribute__((ext_vector_type(4)));
typedef float f32x2 __attribute__((ext_vector_type(2)));
typedef unsigned u32x4 __attribute__((ext_vector_type(4)));
typedef unsigned u32x2 __attribute__((ext_vector_type(2)));
typedef GAS unsigned gu32;

constexpr int DM = 1024, BATCH = 8, SEQ = 2048, DECB = 128, DECS = 8;
constexpr int MP = BATCH * SEQ, MS = DECB * DECS, M = MP + MS;
constexpr int DI = 2048, HD = 64, NH = 32, NG = 8, HPG = 4, DSTATE = 128, CD = 4096;
constexpr int PD = 1024, PBUF = 15, DFF = 2816, PLE = 256;
constexpr int IN_DIM = 9248, NIN = 9472;
constexpr float EPS = 1e-6f;
constexpr int NWAVES = 8, NTHREADS = 512;

constexpr size_t MiB = 1u << 20;
constexpr size_t WS_CTL = 0, CTL_ZERO_BYTES = 32768;
constexpr size_t WS_STATS_A = 2 * MiB, WS_STATS_B = 4 * MiB, WS_DT = 6 * MiB, WS_CDEC = 9 * MiB;
constexpr size_t WS_WGU1 = 10 * MiB, WS_WD1 = 21 * MiB, WS_WIN = 27 * MiB, WS_WSSO = 46 * MiB, WS_W2 = 50 * MiB, WS_WO = 52 * MiB,
                 WS_WGU2 = 54 * MiB, WS_WD2 = 65 * MiB, WS_WPG = 71 * MiB, WS_WPLE = 73 * MiB, WS_PB = 74 * MiB, WS_WPOT = 480 * MiB, WS_WGRP = 483 * MiB;
constexpr size_t WS_Z = 84 * MiB, WS_XBC = 152 * MiB, WS_V = 288 * MiB, WS_GATES = 322 * MiB, WS_HB = 390 * MiB, WS_HPREV = 424 * MiB, WS_HALO = 488 * MiB, WS_EAQ = 492 * MiB, WS_END = 495 * MiB;
constexpr size_t WS_ACT = WS_XBC, WS_T1 = WS_XBC, WS_MERGED = 220 * MiB, WS_Q = WS_V, WS_XB = WS_HB;
static_assert(WS_STATS_A + (size_t)M * 16 * 4 <= WS_STATS_B && WS_STATS_B + (size_t)M * 16 * 4 <= WS_DT && WS_DT + (size_t)M * 32 * 4 <= WS_WGU1, "ws map (small)");
static_assert(WS_WGU1 + (size_t)2 * DFF * DM * 2 <= WS_WD1 && WS_WD1 + (size_t)DM * DFF * 2 <= WS_WIN && WS_WIN + (size_t)NIN * DM * 2 <= WS_WSSO && WS_WSSO + (size_t)DM * DI * 2 <= WS_W2, "ws map (w1)");
static_assert(WS_WGU2 + (size_t)2 * DFF * DM * 2 <= WS_WD2 && WS_WD2 + (size_t)DM * DFF * 2 <= WS_WPG && WS_WPLE + (size_t)DM * PLE * 2 <= WS_PB && WS_PB + (size_t)M * PLE * 2 <= WS_Z, "ws map (w2)");
static_assert(WS_Z + (size_t)M * DI * 2 <= WS_XBC && WS_XBC + (size_t)M * CD * 2 <= WS_V && WS_V + (size_t)M * PD * 2 <= WS_GATES && WS_GATES + (size_t)M * 2 * DM * 2 <= WS_HB &&
              WS_HB + (size_t)M * DM * 2 <= WS_HPREV && WS_HPREV + (size_t)BATCH * 16 * NH * HD * DSTATE * 2 <= WS_END, "ws map (act)");
static_assert(WS_ACT + (size_t)M * DFF * 2 <= WS_V && WS_T1 + (size_t)M * DM * 4 <= WS_MERGED && WS_MERGED + (size_t)M * DM * 2 <= WS_V, "ws overlays");
constexpr int CW_BAR = 4096;

constexpr size_t O_Y = 0, O_SSM_P = (size_t)M * DM, O_CONV_P = O_SSM_P + (size_t)BATCH * NH * HD * DSTATE, O_POOL_P = O_CONV_P + (size_t)BATCH * 3 * CD,
                 O_SSM_S = O_POOL_P + (size_t)BATCH * PBUF * PD, O_CONV_S = O_SSM_S + (size_t)DECB * NH * HD * DSTATE, O_POOL_S = O_CONV_S + (size_t)DECB * 3 * CD,
                 O_END = O_POOL_S + (size_t)DECB * PBUF * PD;

constexpr int RING_BYTES = 131072, LDSCTL_OFF = RING_BYTES, MISC_OFF = LDSCTL_OFF + 320, LDS_BYTES = 147456;

#define RLX_AGENT __ATOMIC_RELAXED, __HIP_MEMORY_SCOPE_AGENT
#define LDS_WAIT() asm volatile("s_waitcnt lgkmcnt(0)" ::: "memory")
#define VM_WAIT() asm volatile("s_waitcnt vmcnt(0)" ::: "memory")

__device__ __forceinline__ unsigned f2bf(float f) { unsigned u = __builtin_bit_cast(unsigned, f); return (u + 0x7fffu + ((u >> 16) & 1u)) >> 16; }
__device__ __forceinline__ unsigned cvt_pk_bf16(float lo, float hi);
__device__ __forceinline__ unsigned pk2(float lo, float hi) { return cvt_pk_bf16(lo, hi); }
__device__ __forceinline__ float bf2f(unsigned b) { return __builtin_bit_cast(float, b << 16); }
__device__ __forceinline__ float bflo(unsigned w) { return __builtin_bit_cast(float, w << 16); }
__device__ __forceinline__ float bfhi(unsigned w) { return __builtin_bit_cast(float, w & 0xffff0000u); }
typedef __bf16 bf16x2_t __attribute__((ext_vector_type(2)));
__device__ __forceinline__ unsigned cvt_pk_bf16(float lo, float hi) { const bf16x2_t v = {(__bf16)lo, (__bf16)hi}; return __builtin_bit_cast(unsigned, v); }
__device__ __forceinline__ float sigm_f(float x) { return __builtin_amdgcn_rcpf(1.0f + __expf(-x)); }
__device__ __forceinline__ float silu_f(float x) { return x * __builtin_amdgcn_rcpf(1.0f + __expf(-x)); }
__device__ __forceinline__ float wave_sum(float v) {
#pragma unroll
    for (int o = 1; o < 64; o <<= 1) v += __shfl_xor(v, o);
    return v;
}

struct Frame {
    LAS unsigned char* lds;
    volatile LAS unsigned* MISC;
    gu32* ctl;
    int tid, lane, wave, vcu, G;
    unsigned char* ws;
    float* out;
    const float* in[30];
};
enum { I_XP = 0, I_XS, I_SSM, I_CONV, I_POOL, I_PP, I_PS, I_NFFN1, I_WGU1, I_WD1, I_NMIX, I_WIN, I_CONVW, I_CONVB, I_DTB, I_ALOG, I_DSKIP, I_NSSD, I_WSSO, I_WPGRP, I_PSCALE,
       I_WPOUT, I_WO, I_NFFN2, I_WGU2, I_WD2, I_NPLE, I_WPG, I_WPLE, I_NFINAL };

namespace pg8 {
constexpr int BM = 256, BK = 64, HALF = 128, HTB = HALF * BK * 2, STAGE_BYTES = 8 * HTB, NXCD = 8, WGM = 4;
__host__ __device__ __forceinline__ int lds_byte(int r, int c) { const int st = (r >> 4) * 2 + (c >> 5), rr = r & 15, cc = c & 31, ob = rr * 64 + cc * 2; return st * 1024 + (ob ^ (((ob >> 9) & 1) << 5)); }
__host__ __device__ __forceinline__ void stage_rc(int b, int& R, int& C) { const int st = b / 1024, sb = b % 1024, swz = sb ^ (((sb >> 9) & 1) << 5); R = (st >> 1) * 16 + swz / 64; C = (st & 1) * 32 + (swz % 64) / 2; }
__host__ __device__ __forceinline__ int perm32(int rho) { const int n = rho >> 4, i = rho & 15; return 8 * (i >> 2) + 4 * n + (i & 3); }
struct Unit { int pm, pn; };
struct Gemm { const bf16_t* A; const bf16_t* Bt; int M, N, K; int lda; int a_pn_step; };
struct StaticOrder {
    int nM, nN, nwg, G, c, lim;
    __host__ __device__ void init(int M_, int N_, int G_, int c_) { nM = M_ / BM; nN = N_ / BM; nwg = nM * nN; G = G_; c = c_; lim = nwg; }
    __host__ __device__ void init_tail(int M_, int N_, int G_, int c_) { init(M_, N_, G_, (G_ - 1) - c_); }
    __host__ __device__ bool next(int i, Unit& u) const {
        const long L = (long)i * G + c; if (L >= lim) return false;
        int wgid = (int)L; { const int q = nwg / NXCD, r = nwg % NXCD, xcd = wgid % NXCD, off = wgid / NXCD; wgid = (xcd < r ? xcd * (q + 1) : r * (q + 1) + (xcd - r) * q) + off; }
        const int nig = WGM * nN, gid = wgid / nig, fm = gid * WGM, gsz = (nM - fm) < WGM ? (nM - fm) : WGM;
        u.pm = fm + ((wgid % nig) % gsz); u.pn = (wgid % nig) / gsz; return true;
    }
};

enum EpiKind { EK_GU = 1, EK_RES = 2, EK_WIN = 3, EK_T1 = 4, EK_MERGE = 5, EK_BF16 = 6, EK_PLE = 7 };
struct Epi {
    const float* stats_in;
    float* stats_out;
    bf16_t* obf;
    float* of32;
    const float* res_p; const float* res_s;
    const bf16_t* res_bf;
    const bf16_t* gates;
    const bf16_t* q;
    bf16_t *Z, *XBC, *V, *GATES, *HALO; float* DT; const float* dt_bias; float *conv_p, *conv_s, *pool_p, *pool_s;
    int kind; int ldo; float coef; int pad;
};

__device__ __forceinline__ u32x4 pack8(const f32x4 a, const f32x4 b) { u32x4 w; w.x = cvt_pk_bf16(a[0], a[1]); w.y = cvt_pk_bf16(a[2], a[3]); w.z = cvt_pk_bf16(b[0], b[1]); w.w = cvt_pk_bf16(b[2], b[3]); return w; }
__device__ __forceinline__ void unpack8(const u32x4 w, f32x4& a, f32x4& b) { a = (f32x4){bflo(w.x), bfhi(w.x), bflo(w.y), bfhi(w.y)}; b = (f32x4){bflo(w.z), bfhi(w.z), bflo(w.w), bfhi(w.w)}; }

__device__ __forceinline__ float row_rs(const float* stats, int row) {
    if (!stats) return 1.0f;
    const GAS f32x4* sp = (const GAS f32x4*)(stats + (size_t)row * 16);
    const f32x4 a = sp[0], b = sp[1], c = sp[2], d = sp[3]; const f32x4 s = (a + b) + (c + d);
    return __builtin_amdgcn_rsqf(((s[0] + s[1]) + (s[2] + s[3])) * (1.0f / 1024.0f) + EPS);
}
__device__ __forceinline__ float softplus_f(float x) { const float e = __expf(-fabsf(x)); const float l = (e < 0.01f) ? e * (1.0f - e * (0.5f - e * (1.0f / 3.0f))) : __logf(1.0f + e); return fmaxf(x, 0.f) + l; }

__device__ __forceinline__ void epilogue(const Epi& E, const f32x4 (&acc)[2][2][4][2], const Unit& u, int wr, int wc, int fr, int fq) {
    const int rowb = u.pm * BM + wr * 64 + fr;
    const int cin = wc * 32 + 8 * fq;
    if (E.kind == EK_GU) {
#pragma unroll
        for (int ai = 0; ai < 2; ++ai)
#pragma unroll
            for (int m = 0; m < 4; ++m) { const int row = rowb + ai * HALF + m * 16; const float r = row_rs(E.stats_in, row);
                const f32x4 g0 = acc[ai][0][m][0] * r, u0 = acc[ai][1][m][0] * r, g1 = acc[ai][0][m][1] * r, u1 = acc[ai][1][m][1] * r;
                const f32x4 o0 = (f32x4){silu_f(g0[0]) * u0[0], silu_f(g0[1]) * u0[1], silu_f(g0[2]) * u0[2], silu_f(g0[3]) * u0[3]};
                const f32x4 o1 = (f32x4){silu_f(g1[0]) * u1[0], silu_f(g1[1]) * u1[1], silu_f(g1[2]) * u1[2], silu_f(g1[3]) * u1[3]};
                *(GAS u32x4*)(E.obf + (size_t)row * E.ldo + u.pn * HALF + cin) = pack8(o0, o1); }
    } else if (E.kind == EK_RES) {
#pragma unroll
        for (int ai = 0; ai < 2; ++ai)
#pragma unroll
            for (int m = 0; m < 4; ++m) { const int row = rowb + ai * HALF + m * 16;
                float ss = 0.f;
#pragma unroll
                for (int bj = 0; bj < 2; ++bj) { const int col = u.pn * BM + bj * HALF + cin;
                    f32x4 r0, r1;
                    if (E.res_p) { const float* rp = (row < MP) ? E.res_p + (size_t)row * DM : E.res_s + (size_t)(row - MP) * DM; r0 = *(const GAS f32x4*)(rp + col); r1 = *(const GAS f32x4*)(rp + col + 4); }
                    else unpack8(*(const GAS u32x4*)(E.res_bf + (size_t)row * DM + col), r0, r1);
                    const f32x4 h0 = r0 + acc[ai][bj][m][0] * E.coef, h1 = r1 + acc[ai][bj][m][1] * E.coef;
                    *(GAS u32x4*)(E.obf + (size_t)row * DM + col) = pack8(h0, h1);
                    ss += (h0[0] * h0[0] + h0[1] * h0[1]) + (h0[2] * h0[2] + h0[3] * h0[3]) + (h1[0] * h1[0] + h1[1] * h1[1]) + (h1[2] * h1[2] + h1[3] * h1[3]); }
                ss += __shfl_xor(ss, 16); ss += __shfl_xor(ss, 32);
                if (fq == 0) *(GAS float*)(E.stats_out + (size_t)row * 16 + u.pn * 4 + wc) = ss; }
    } else if (E.kind == EK_WIN) {
        const int pn = u.pn;
        if (pn < 8) {
            const int colt = pn * BM + cin;
#pragma unroll
            for (int ai = 0; ai < 2; ++ai)
#pragma unroll
                for (int m = 0; m < 4; ++m) { const int row = rowb + ai * HALF + m * 16; const float r = row_rs(E.stats_in, row);
#pragma unroll
                    for (int bj = 0; bj < 2; ++bj) { f32x4 v0 = acc[ai][bj][m][0] * r, v1 = acc[ai][bj][m][1] * r;
#pragma unroll
                        for (int j = 0; j < 4; ++j) { v0[j] = silu_f(v0[j]); v1[j] = silu_f(v1[j]); }
                        *(GAS u32x4*)(E.Z + (size_t)row * DI + colt + bj * HALF) = pack8(v0, v1); } }
        } else if (pn >= 28 && pn < 36) {
            const int colt = (pn - 28) * BM + cin;
#pragma unroll
            for (int ai = 0; ai < 2; ++ai)
#pragma unroll
                for (int m = 0; m < 4; ++m) { const int row = rowb + ai * HALF + m * 16; const float r = row_rs(E.stats_in, row);
#pragma unroll
                    for (int bj = 0; bj < 2; ++bj) { f32x4 v0 = acc[ai][bj][m][0] * r, v1 = acc[ai][bj][m][1] * r;
#pragma unroll
                        for (int j = 0; j < 4; ++j) { v0[j] = sigm_f(v0[j]); v1[j] = sigm_f(v1[j]); }
                        *(GAS u32x4*)(E.GATES + (size_t)row * (2 * DM) + colt + bj * HALF) = pack8(v0, v1); } }
        } else if (pn < 28) {
            const bool isx = pn < 24; bf16_t* const O = isx ? E.XBC : E.V; const int ldo = isx ? CD : PD; const int colt = (isx ? pn - 8 : pn - 24) * BM + cin;
            const int keep = isx ? 3 : PBUF;
#pragma unroll
            for (int ai = 0; ai < 2; ++ai)
#pragma unroll
                for (int m = 0; m < 4; ++m) { const int row = rowb + ai * HALF + m * 16; const float r = row_rs(E.stats_in, row);
                    float* sp = nullptr;
                    if (row < MP) { const int sb = row >> 11, st = row & (SEQ - 1); if (st >= SEQ - keep) sp = (isx ? E.conv_p : E.pool_p) + ((size_t)sb * keep + (st - (SEQ - keep))) * ldo + colt; }
                    else { const int sb = (row - MP) >> 3, st = (row - MP) & 7; const int si = st - (DECS - keep); if (si >= 0) sp = (isx ? E.conv_s : E.pool_s) + ((size_t)sb * keep + si) * ldo + colt; }
                    bf16_t* hp = nullptr;
                    if (isx && row < MP) { const int st = row & (SEQ - 1), tm = st & 127; if (tm >= 125 && st < SEQ - 3) hp = E.HALO + ((((size_t)(row >> 11) * 16 + (st >> 7) + 1) * 3 + (tm - 125)) * CD) + colt; }
#pragma unroll
                    for (int bj = 0; bj < 2; ++bj) { const f32x4 v0 = acc[ai][bj][m][0] * r, v1 = acc[ai][bj][m][1] * r;
                        const u32x4 pk = pack8(v0, v1);
                        *(GAS u32x4*)(O + (size_t)row * ldo + colt + bj * HALF) = pk;
                        if (hp) *(GAS u32x4*)(hp + bj * HALF) = pk;
                        if (sp) { *(GAS f32x4*)(sp + bj * HALF) = v0; *(GAS f32x4*)(sp + bj * HALF + 4) = v1; } } }
        } else if (wc == 0) {
            const f32x4 b0 = *(const GAS f32x4*)(E.dt_bias + 8 * fq), b1 = *(const GAS f32x4*)(E.dt_bias + 8 * fq + 4);
#pragma unroll
            for (int ai = 0; ai < 2; ++ai)
#pragma unroll
                for (int m = 0; m < 4; ++m) { const int row = rowb + ai * HALF + m * 16; const float r = row_rs(E.stats_in, row);
                    f32x4 v0 = acc[ai][0][m][0] * r + b0, v1 = acc[ai][0][m][1] * r + b1;
#pragma unroll
                    for (int j = 0; j < 4; ++j) { v0[j] = softplus_f(v0[j]); v1[j] = softplus_f(v1[j]); }
                    *(GAS f32x4*)(E.DT + (size_t)row * 32 + 8 * fq) = v0; *(GAS f32x4*)(E.DT + (size_t)row * 32 + 8 * fq + 4) = v1; }
        }
    } else if (E.kind == EK_T1) {
#pragma unroll
        for (int ai = 0; ai < 2; ++ai)
#pragma unroll
            for (int m = 0; m < 4; ++m) { const int row = rowb + ai * HALF + m * 16;
#pragma unroll
                for (int bj = 0; bj < 2; ++bj) { const int col = u.pn * BM + bj * HALF + cin;
                    f32x4 g0, g1; unpack8(*(const GAS u32x4*)(E.gates + (size_t)row * (2 * DM) + col), g0, g1);
                    *(GAS u32x4*)(E.obf + (size_t)row * DM + col) = pack8(g0 * acc[ai][bj][m][0], g1 * acc[ai][bj][m][1]); } }
    } else if (E.kind == EK_MERGE) {
#pragma unroll
        for (int ai = 0; ai < 2; ++ai)
#pragma unroll
            for (int m = 0; m < 4; ++m) { const int row = rowb + ai * HALF + m * 16;
#pragma unroll
                for (int bj = 0; bj < 2; ++bj) { const int col = u.pn * BM + bj * HALF + cin;
                    f32x4 g0, g1; unpack8(*(const GAS u32x4*)(E.gates + (size_t)row * (2 * DM) + DM + col), g0, g1);
                    f32x4 t0, t1; unpack8(*(const GAS u32x4*)(E.res_bf + (size_t)row * DM + col), t0, t1);
                    *(GAS u32x4*)(E.obf + (size_t)row * DM + col) = pack8(t0 + g0 * acc[ai][bj][m][0], t1 + g1 * acc[ai][bj][m][1]); } }
    } else if (E.kind == EK_BF16) {
#pragma unroll
        for (int ai = 0; ai < 2; ++ai)
#pragma unroll
            for (int m = 0; m < 4; ++m) { const int row = rowb + ai * HALF + m * 16;
#pragma unroll
                for (int bj = 0; bj < 2; ++bj) { const int col = u.pn * BM + bj * HALF + cin;
                    *(GAS u32x4*)(E.obf + (size_t)row * E.ldo + col) = pack8(acc[ai][bj][m][0], acc[ai][bj][m][1]); } }
    } else if (E.kind == EK_PLE) {
#pragma unroll
        for (int ai = 0; ai < 2; ++ai)
#pragma unroll
            for (int m = 0; m < 4; ++m) { const int row = rowb + ai * HALF + m * 16; const float r = row_rs(E.stats_in, row);
                float ss = 0.f;
#pragma unroll
                for (int bj = 0; bj < 2; ++bj) { const int col = u.pn * BM + bj * HALF + cin;
                    f32x4 q0, q1; unpack8(*(const GAS u32x4*)(E.q + (size_t)row * DM + col), q0, q1);
                    f32x4 r0, r1; unpack8(*(const GAS u32x4*)(E.res_bf + (size_t)row * DM + col), r0, r1);
                    f32x4 h0, h1;
#pragma unroll
                    for (int j = 0; j < 4; ++j) { h0[j] = r0[j] + sigm_f(acc[ai][bj][m][0][j] * r) * q0[j]; h1[j] = r1[j] + sigm_f(acc[ai][bj][m][1][j] * r) * q1[j]; }
                    *(GAS u32x4*)(E.obf + (size_t)row * DM + col) = pack8(h0, h1);
                    ss += (h0[0] * h0[0] + h0[1] * h0[1]) + (h0[2] * h0[2] + h0[3] * h0[3]) + (h1[0] * h1[0] + h1[1] * h1[1]) + (h1[2] * h1[2] + h1[3] * h1[3]); }
                ss += __shfl_xor(ss, 16); ss += __shfl_xor(ss, 32);
                if (fq == 0) *(GAS float*)(E.stats_out + (size_t)row * 16 + u.pn * 4 + wc) = ss; }
    }
}


__device__ __forceinline__ void epi_seg(const Epi& E, int row, int col, f32x4 v0, f32x4 v1, int lane) {
    if (E.kind == EK_RES) {
        f32x4 r0, r1;
        if (E.res_p) { const float* rp = ((row < MP) ? E.res_p + (size_t)row * DM : E.res_s + (size_t)(row - MP) * DM) + col; r0 = *(const GAS f32x4*)rp; r1 = *(const GAS f32x4*)(rp + 4); }
        else unpack8(*(const GAS u32x4*)(E.res_bf + (size_t)row * DM + col), r0, r1);
        const f32x4 h0 = r0 + v0 * E.coef, h1 = r1 + v1 * E.coef;
        *(GAS u32x4*)(E.obf + (size_t)row * DM + col) = pack8(h0, h1);
        float ss = (h0[0] * h0[0] + h0[1] * h0[1]) + (h0[2] * h0[2] + h0[3] * h0[3]) + (h1[0] * h1[0] + h1[1] * h1[1]) + (h1[2] * h1[2] + h1[3] * h1[3]);
        ss += __shfl_xor(ss, 1); ss += __shfl_xor(ss, 2); ss += __shfl_xor(ss, 4);
        if ((lane & 7) == 0) *(GAS float*)(E.stats_out + (size_t)row * 16 + (col >> 6)) = ss;
    } else if (E.kind == EK_T1) {
        f32x4 g0, g1; unpack8(*(const GAS u32x4*)(E.gates + (size_t)row * (2 * DM) + col), g0, g1);
        *(GAS u32x4*)(E.obf + (size_t)row * DM + col) = pack8(g0 * v0, g1 * v1);
    } else if (E.kind == EK_MERGE) {
        f32x4 g0, g1; unpack8(*(const GAS u32x4*)(E.gates + (size_t)row * (2 * DM) + DM + col), g0, g1);
        f32x4 t0, t1; unpack8(*(const GAS u32x4*)(E.res_bf + (size_t)row * DM + col), t0, t1);
        *(GAS u32x4*)(E.obf + (size_t)row * DM + col) = pack8(t0 + g0 * v0, t1 + g1 * v1);
    } else if (E.kind == EK_BF16) {
        *(GAS u32x4*)(E.obf + (size_t)row * E.ldo + col) = pack8(v0, v1);
    } else if (E.kind == EK_PLE) {
        const float r = row_rs(E.stats_in, row);
        f32x4 q0, q1; unpack8(*(const GAS u32x4*)(E.q + (size_t)row * DM + col), q0, q1);
        f32x4 r0, r1; unpack8(*(const GAS u32x4*)(E.res_bf + (size_t)row * DM + col), r0, r1);
        f32x4 h0, h1;
#pragma unroll
        for (int j = 0; j < 4; ++j) { h0[j] = r0[j] + sigm_f(v0[j] * r) * q0[j]; h1[j] = r1[j] + sigm_f(v1[j] * r) * q1[j]; }
        *(GAS u32x4*)(E.obf + (size_t)row * DM + col) = pack8(h0, h1);
        float ss = (h0[0] * h0[0] + h0[1] * h0[1]) + (h0[2] * h0[2] + h0[3] * h0[3]) + (h1[0] * h1[0] + h1[1] * h1[1]) + (h1[2] * h1[2] + h1[3] * h1[3]);
        ss += __shfl_xor(ss, 1); ss += __shfl_xor(ss, 2); ss += __shfl_xor(ss, 4);
        if ((lane & 7) == 0) *(GAS float*)(E.stats_out + (size_t)row * 16 + (col >> 6)) = ss;
    }
}
__device__ __forceinline__ int sw_off(int row, int ch) { return 256 * row + 16 * (ch ^ (((row & 3) << 2) | ((row >> 2) & 3))); }
__device__ __forceinline__ void small_tile_sum(LAS unsigned char* lds, const bf16_t* A, int lda, const bf16_t* Bt, int K, int r0, int c0, f32x4& v0, f32x4& v1) {
    const int tid = threadIdx.x, wid = __builtin_amdgcn_readfirstlane(tid >> 6), lane = tid & 63, ql = lane & 15, gq = lane >> 4, mw = wid >> 1, nh = wid & 1;
    const int nst = K / 128;
    const char* src[4]; int dst[4];
#pragma unroll
    for (int i = 0; i < 4; ++i) { const int p = 4 * wid + i, isB = p >> 4, row = 4 * (p & 15) + (lane >> 4), cs = lane & 15, ch = cs ^ (((row & 3) << 2) | ((row >> 2) & 3));
        src[i] = isB ? (const char*)(Bt + (size_t)(c0 + (row & ~31) + perm32(row & 31)) * K + 8 * ch) : (const char*)(A + (size_t)(r0 + row) * lda + 8 * ch);
        dst[i] = isB * 16384 + 1024 * (p & 15); }
#define ST_ISSUE(st) do { _Pragma("unroll") for (int _i = 0; _i < 4; ++_i) \
        __builtin_amdgcn_global_load_lds((const unsigned*)(src[_i] + (size_t)(st) * 256), (LAS unsigned*)(lds + ((st) & 3) * 32768 + dst[_i]), 16, 0, 0); } while (0)
    f32x4 acc0 = (f32x4){0.f, 0.f, 0.f, 0.f}, acc1 = acc0;
    int aoff[4], boff0[4], boff1[4];
#pragma unroll
    for (int ks = 0; ks < 4; ++ks) { aoff[ks] = sw_off(16 * mw + ql, 4 * ks + gq); boff0[ks] = 16384 + sw_off(32 * nh + ql, 4 * ks + gq); boff1[ks] = 16384 + sw_off(32 * nh + 16 + ql, 4 * ks + gq); }
    ST_ISSUE(0); if (nst > 1) ST_ISSUE(1); if (nst > 2) ST_ISSUE(2);
    for (int t = 0; t < nst; ++t) {
        const int ahead = (nst - 1 - t) < 2 ? (nst - 1 - t) : 2;
        if (ahead == 2) asm volatile("s_waitcnt vmcnt(8)" ::: "memory"); else if (ahead == 1) asm volatile("s_waitcnt vmcnt(4)" ::: "memory"); else asm volatile("s_waitcnt vmcnt(0)" ::: "memory");
        __builtin_amdgcn_s_barrier(); asm volatile("" ::: "memory");
        if (t + 3 < nst) ST_ISSUE(t + 3);
        const LAS unsigned char* const sl = lds + (t & 3) * 32768;
#pragma unroll
        for (int ks = 0; ks < 4; ++ks) {
            const bf16x8 af = *(const LAS bf16x8*)(sl + aoff[ks]), b0 = *(const LAS bf16x8*)(sl + boff0[ks]), b1 = *(const LAS bf16x8*)(sl + boff1[ks]);
            acc0 = __builtin_amdgcn_mfma_f32_16x16x32_bf16(b0, af, acc0, 0, 0, 0); acc1 = __builtin_amdgcn_mfma_f32_16x16x32_bf16(b1, af, acc1, 0, 0, 0);
        }
        asm volatile("s_waitcnt lgkmcnt(0)" ::: "memory");
    }
#undef ST_ISSUE
    __syncthreads();
    LAS f32x4* const tile = (LAS f32x4*)lds;
    { const int row = 16 * mw + ql, chb = 8 * nh + 2 * gq; tile[row * 16 + (chb ^ (row & 15))] = acc0; tile[row * 16 + ((chb + 1) ^ (row & 15))] = acc1; }
    __syncthreads();
    const int rr = 8 * wid + (lane >> 3), ch0 = 2 * (lane & 7);
    v0 = tile[rr * 16 + (ch0 ^ (rr & 15))]; v1 = tile[rr * 16 + ((ch0 + 1) ^ (rr & 15))];
    __syncthreads();
}
__device__ __forceinline__ void gemm_small(LAS unsigned char* lds, const Gemm g, const Epi& E, int row_base, int nrows, int G, int c) {
    const int tid = threadIdx.x, wid = __builtin_amdgcn_readfirstlane(tid >> 6), lane = tid & 63;
    const int ntn = g.N / 64, ntiles = (nrows / 64) * ntn;
    for (int v = c; v < ntiles; v += G) {
        const int r0 = row_base + 64 * (v / ntn), c0 = 64 * (v % ntn);
        f32x4 v0, v1; small_tile_sum(lds, g.A, g.lda, g.Bt, g.K, r0, c0, v0, v1);
        epi_seg(E, r0 + 8 * wid + (lane >> 3), c0 + 8 * (lane & 7), v0, v1, lane);
    }
}
struct Gemm2 { const bf16_t* A1; const bf16_t* B1; const bf16_t* A2; const bf16_t* B2; int K1, lda1, K2, lda2, N; };
__device__ __forceinline__ void gemm_small2(LAS unsigned char* lds, const Gemm2 g, const bf16_t* gates, bf16_t* out, int row_base, int nrows, int G, int c) {
    const int tid = threadIdx.x, wid = __builtin_amdgcn_readfirstlane(tid >> 6), lane = tid & 63;
    const int ntn = g.N / 64, ntiles = (nrows / 64) * ntn;
    for (int v = c; v < ntiles; v += G) {
        const int r0 = row_base + 64 * (v / ntn), c0 = 64 * (v % ntn), row = r0 + 8 * wid + (lane >> 3), col = c0 + 8 * (lane & 7);
        f32x4 a0, a1, b0, b1;
        small_tile_sum(lds, g.A1, g.lda1, g.B1, g.K1, r0, c0, a0, a1);
        small_tile_sum(lds, g.A2, g.lda2, g.B2, g.K2, r0, c0, b0, b1);
        f32x4 g00, g01, g10, g11; unpack8(*(const GAS u32x4*)(gates + (size_t)row * (2 * DM) + col), g00, g01); unpack8(*(const GAS u32x4*)(gates + (size_t)row * (2 * DM) + DM + col), g10, g11);
        *(GAS u32x4*)(out + (size_t)row * DM + col) = pack8(g00 * a0 + g10 * b0, g01 * a1 + g11 * b1);
    }
}

__device__ __forceinline__ void gemm_phase(LAS unsigned char* lds, const Gemm g, const StaticOrder& S, const Epi& E) {
    const int tid = threadIdx.x, wid = __builtin_amdgcn_readfirstlane(tid >> 6), lane = tid & 63, wr = wid >> 2, wc = wid & 3, fr = lane & 15, fq = lane >> 4;
    const int K = g.K, nt = K / BK;
    unsigned voffA[2], voffB[2];
#pragma unroll
    for (int i = 0; i < 2; ++i) { int R, C; stage_rc(tid * 16 + i * 8192, R, C); const int Rb = (R & ~31) + perm32(R & 31);
        voffA[i] = (unsigned)(R * g.lda + C) * 2u; voffB[i] = (unsigned)(Rb * K + C) * 2u; }
    const size_t kstep = (size_t)(BK * 2);
    const size_t hstep = (size_t)HALF * K * 2, hstepA = (size_t)HALF * g.lda * 2;
    const size_t tstep = 2 * hstep, tstepA = 2 * hstepA, pnstepA = (size_t)g.a_pn_step * 2;
    const unsigned ldsw = (unsigned)wid * 1024u;
    const int aoff = lds_byte(wr * 64 + fr, fq * 8), boff = lds_byte(wc * 32 + fr, fq * 8);
#define PG8_SA(b, h) (((b) * 2 + (h)) * HTB)
#define PG8_SB(b, h) ((4 + (b) * 2 + (h)) * HTB)
#define PG8_STAGE(bufoff, gbase, voff) do { _Pragma("unroll") for (int _i = 0; _i < 2; ++_i) \
        __builtin_amdgcn_global_load_lds((const unsigned*)((const char*)(gbase) + (voff)[_i]), (LAS unsigned*)(lds + (bufoff) + ldsw + _i * 8192), 16, 0, 0); } while (0)
#define PG8_LDA(dst, b, h) do { _Pragma("unroll") for (int m = 0; m < 4; ++m) _Pragma("unroll") for (int k = 0; k < 2; ++k) dst[m][k] = *(const LAS bf16x8*)(lds + PG8_SA(b, h) + aoff + m * 2048 + k * 1024); } while (0)
#define PG8_LDB(dst, b, h) do { _Pragma("unroll") for (int n = 0; n < 2; ++n) _Pragma("unroll") for (int k = 0; k < 2; ++k) dst[n][k] = *(const LAS bf16x8*)(lds + PG8_SB(b, h) + boff + n * 2048 + k * 1024); } while (0)
#define PG8_MMA(ai, bj, At, Bt) do { __builtin_amdgcn_s_setprio(1); _Pragma("unroll") for (int m = 0; m < 4; ++m) _Pragma("unroll") for (int n = 0; n < 2; ++n) _Pragma("unroll") for (int k = 0; k < 2; ++k) \
        acc[ai][bj][m][n] = __builtin_amdgcn_mfma_f32_16x16x32_bf16(Bt[n][k], At[m][k], acc[ai][bj][m][n], 0, 0, 0); __builtin_amdgcn_s_setprio(0); } while (0)
#define PG8_WAIT_V(n) asm volatile("s_waitcnt vmcnt(" #n ")" ::: "memory")
#define PG8_WAIT_L(n) asm volatile("s_waitcnt lgkmcnt(" #n ")" ::: "memory")
#define PG8_BAR __builtin_amdgcn_s_barrier()
#define PG8_SCHED __builtin_amdgcn_sched_barrier(0)
    Unit cur, nxt; int ui = 0;
    if (!S.next(0, cur)) return;
    f32x4 acc[2][2][4][2];
#pragma unroll
    for (int a = 0; a < 2; ++a)
#pragma unroll
        for (int b = 0; b < 2; ++b)
#pragma unroll
            for (int m = 0; m < 4; ++m)
#pragma unroll
                for (int n = 0; n < 2; ++n) acc[a][b][m][n] = (f32x4){0.f, 0.f, 0.f, 0.f};
    bf16x8 At[4][2], B0[2][2], B1[2][2];
    const char* cA = (const char*)g.A + (size_t)cur.pm * tstepA + (size_t)cur.pn * pnstepA; const char* cB = (const char*)g.Bt + (size_t)cur.pn * tstep;
    PG8_STAGE(PG8_SB(0, 0), cB, voffB); PG8_STAGE(PG8_SB(0, 1), cB + hstep, voffB); PG8_STAGE(PG8_SA(0, 0), cA, voffA); PG8_STAGE(PG8_SA(0, 1), cA + hstepA, voffA);
    if (wr == 1) PG8_BAR;
    PG8_WAIT_V(2); PG8_BAR;
    PG8_STAGE(PG8_SB(1, 0), cB + kstep, voffB); PG8_STAGE(PG8_SA(1, 0), cA + kstep, voffA); PG8_STAGE(PG8_SB(1, 1), cB + hstep + kstep, voffB);
    PG8_WAIT_V(6); PG8_BAR;
    for (;;) {
        const bool has_next = S.next(ui + 1, nxt);
        const char* nA = has_next ? (const char*)g.A + (size_t)nxt.pm * tstepA + (size_t)nxt.pn * pnstepA : cA; const char* nB = has_next ? (const char*)g.Bt + (size_t)nxt.pn * tstep : cB;
        for (int t = 0; t < nt; t += 2) {
            const bool last = (t == nt - 2);
            const char* a1 = cA + (size_t)(t + 1) * kstep;
            const char* a2 = last ? nA : cA + (size_t)(t + 2) * kstep; const char* b2 = last ? nB : cB + (size_t)(t + 2) * kstep;
            const char* a3 = a2 + kstep; const char* b3 = b2 + kstep;
            PG8_LDB(B0, 0, 0); PG8_LDB(B1, 0, 1); PG8_SCHED; PG8_LDA(At, 0, 0); PG8_STAGE(PG8_SA(1, 1), a1 + hstepA, voffA);
            PG8_WAIT_V(8); PG8_WAIT_L(0); PG8_BAR; PG8_MMA(0, 0, At, B0); PG8_MMA(0, 1, At, B1); PG8_BAR; PG8_SCHED;
            PG8_LDA(At, 0, 1); PG8_STAGE(PG8_SB(0, 0), b2, voffB); PG8_STAGE(PG8_SB(0, 1), b2 + hstep, voffB); PG8_STAGE(PG8_SA(0, 0), a2, voffA);
            PG8_WAIT_V(8); PG8_WAIT_L(0); PG8_BAR; PG8_MMA(1, 0, At, B0); PG8_MMA(1, 1, At, B1); PG8_BAR; PG8_SCHED;
            PG8_LDB(B0, 1, 0); PG8_LDB(B1, 1, 1); PG8_SCHED; PG8_LDA(At, 1, 0); PG8_STAGE(PG8_SA(0, 1), a2 + hstepA, voffA);
            PG8_WAIT_V(8); PG8_WAIT_L(0); PG8_BAR; PG8_MMA(0, 0, At, B0); PG8_MMA(0, 1, At, B1); PG8_BAR; PG8_SCHED;
            PG8_LDA(At, 1, 1); PG8_STAGE(PG8_SB(1, 0), b3, voffB); PG8_STAGE(PG8_SB(1, 1), b3 + hstep, voffB); PG8_STAGE(PG8_SA(1, 0), a3, voffA);
            PG8_WAIT_V(8); PG8_WAIT_L(0); PG8_BAR; PG8_MMA(1, 0, At, B0); PG8_MMA(1, 1, At, B1); PG8_BAR; PG8_SCHED;
        }
        if (wr == 0) PG8_BAR;
        epilogue(E, acc, cur, wr, wc, fr, fq);
        if (!has_next) break;
#pragma unroll
        for (int a = 0; a < 2; ++a)
#pragma unroll
            for (int b = 0; b < 2; ++b)
#pragma unroll
                for (int m = 0; m < 4; ++m)
#pragma unroll
                    for (int n = 0; n < 2; ++n) acc[a][b][m][n] = (f32x4){0.f, 0.f, 0.f, 0.f};
        cur = nxt; cA = nA; cB = nB; ++ui;
        if (wr == 1) PG8_BAR;
    }
    PG8_WAIT_V(0);
    PG8_BAR;
#undef PG8_SA
#undef PG8_SB
#undef PG8_STAGE
#undef PG8_LDA
#undef PG8_LDB
#undef PG8_MMA
#undef PG8_WAIT_V
#undef PG8_WAIT_L
#undef PG8_BAR
#undef PG8_SCHED
}

__device__ __forceinline__ void gemm_phase2(LAS unsigned char* lds, const Gemm2 g, const StaticOrder& S, const bf16_t* gates, bf16_t* out) {
    const int tid = threadIdx.x, wid = __builtin_amdgcn_readfirstlane(tid >> 6), lane = tid & 63, wr = wid >> 2, wc = wid & 3, fr = lane & 15, fq = lane >> 4;
    const int nt1 = g.K1 / BK, nt = nt1 + g.K2 / BK;
    int sR[2], sRb[2], sC[2];
#pragma unroll
    for (int i = 0; i < 2; ++i) { int R, C; stage_rc(tid * 16 + i * 8192, R, C); sR[i] = R; sRb[i] = (R & ~31) + perm32(R & 31); sC[i] = C; }
    const size_t kstep = (size_t)(BK * 2);
    const size_t hB1 = (size_t)HALF * g.K1 * 2, hA1 = (size_t)HALF * g.lda1 * 2, hB2 = (size_t)HALF * g.K2 * 2, hA2 = (size_t)HALF * g.lda2 * 2;
    const unsigned ldsw = (unsigned)wid * 1024u;
    const int aoff = lds_byte(wr * 64 + fr, fq * 8), boff = lds_byte(wc * 32 + fr, fq * 8);
#define PG8_SA(b, h) (((b) * 2 + (h)) * HTB)
#define PG8_SB(b, h) ((4 + (b) * 2 + (h)) * HTB)
#define PG8_STAGE_T(bufoff, isA, h, T) do { const int T_ = (T); const bool nx_ = T_ >= nt; const int Tl_ = nx_ ? T_ - nt : T_; const bool s2_ = !nx_ && Tl_ >= nt1; \
        const char* base_ = (isA) ? (s2_ ? cA2 + (size_t)(Tl_ - nt1) * kstep + (h) * hA2 : (nx_ ? nA1 : cA1) + (size_t)Tl_ * kstep + (h) * hA1) \
                                  : (s2_ ? cB2 + (size_t)(Tl_ - nt1) * kstep + (h) * hB2 : (nx_ ? nB1 : cB1) + (size_t)Tl_ * kstep + (h) * hB1); \
        const int ld_ = (isA) ? (s2_ ? g.lda2 : g.lda1) : (s2_ ? g.K2 : g.K1); \
        _Pragma("unroll") for (int _i = 0; _i < 2; ++_i) { const unsigned vo_ = (unsigned)(((isA) ? sR[_i] : sRb[_i]) * ld_ + sC[_i]) * 2u; \
            __builtin_amdgcn_global_load_lds((const unsigned*)(base_ + vo_), (LAS unsigned*)(lds + (bufoff) + ldsw + _i * 8192), 16, 0, 0); } } while (0)
#define PG8_LDA(dst, b, h) do { _Pragma("unroll") for (int m = 0; m < 4; ++m) _Pragma("unroll") for (int k = 0; k < 2; ++k) dst[m][k] = *(const LAS bf16x8*)(lds + PG8_SA(b, h) + aoff + m * 2048 + k * 1024); } while (0)
#define PG8_LDB(dst, b, h) do { _Pragma("unroll") for (int n = 0; n < 2; ++n) _Pragma("unroll") for (int k = 0; k < 2; ++k) dst[n][k] = *(const LAS bf16x8*)(lds + PG8_SB(b, h) + boff + n * 2048 + k * 1024); } while (0)
#define PG8_MMA(ai, bj, At, Bt) do { __builtin_amdgcn_s_setprio(1); _Pragma("unroll") for (int m = 0; m < 4; ++m) _Pragma("unroll") for (int n = 0; n < 2; ++n) _Pragma("unroll") for (int k = 0; k < 2; ++k) \
        acc[ai][bj][m][n] = __builtin_amdgcn_mfma_f32_16x16x32_bf16(Bt[n][k], At[m][k], acc[ai][bj][m][n], 0, 0, 0); __builtin_amdgcn_s_setprio(0); } while (0)
#define PG8_WAIT_V(n) asm volatile("s_waitcnt vmcnt(" #n ")" ::: "memory")
#define PG8_WAIT_L(n) asm volatile("s_waitcnt lgkmcnt(" #n ")" ::: "memory")
#define PG8_BAR __builtin_amdgcn_s_barrier()
#define PG8_SCHED __builtin_amdgcn_sched_barrier(0)
    Unit cur, nxt; int ui = 0;
    if (!S.next(0, cur)) return;
    f32x4 acc[2][2][4][2];
#pragma unroll
    for (int a = 0; a < 2; ++a)
#pragma unroll
        for (int b = 0; b < 2; ++b)
#pragma unroll
            for (int m = 0; m < 4; ++m)
#pragma unroll
                for (int n = 0; n < 2; ++n) acc[a][b][m][n] = (f32x4){0.f, 0.f, 0.f, 0.f};
    bf16x8 At[4][2], B0[2][2], B1[2][2];
    const char* cA1 = (const char*)g.A1 + (size_t)cur.pm * 2 * hA1; const char* cB1 = (const char*)g.B1 + (size_t)cur.pn * 2 * hB1;
    const char* cA2 = (const char*)g.A2 + (size_t)cur.pm * 2 * hA2; const char* cB2 = (const char*)g.B2 + (size_t)cur.pn * 2 * hB2;
    const char* nA1 = cA1; const char* nB1 = cB1;
    PG8_STAGE_T(PG8_SB(0, 0), false, 0, 0); PG8_STAGE_T(PG8_SB(0, 1), false, 1, 0); PG8_STAGE_T(PG8_SA(0, 0), true, 0, 0); PG8_STAGE_T(PG8_SA(0, 1), true, 1, 0);
    if (wr == 1) PG8_BAR;
    PG8_WAIT_V(2); PG8_BAR;
    PG8_STAGE_T(PG8_SB(1, 0), false, 0, 1); PG8_STAGE_T(PG8_SA(1, 0), true, 0, 1); PG8_STAGE_T(PG8_SB(1, 1), false, 1, 1);
    PG8_WAIT_V(6); PG8_BAR;
    for (;;) {
        const bool has_next = S.next(ui + 1, nxt);
        nA1 = has_next ? (const char*)g.A1 + (size_t)nxt.pm * 2 * hA1 : cA1; nB1 = has_next ? (const char*)g.B1 + (size_t)nxt.pn * 2 * hB1 : cB1;
        const int rowb = cur.pm * BM + wr * 64 + fr, colb = cur.pn * BM + wc * 32 + 8 * fq;
        for (int t = 0; t < nt; t += 2) {
            if (t == nt1) {
#pragma unroll
                for (int ai = 0; ai < 2; ++ai)
#pragma unroll
                    for (int m = 0; m < 4; ++m) { const bf16_t* gp = gates + (size_t)(rowb + ai * HALF + m * 16) * (2 * DM) + colb;
#pragma unroll
                        for (int bj = 0; bj < 2; ++bj) { f32x4 g00, g01, g10, g11; unpack8(*(const GAS u32x4*)(gp + bj * HALF), g00, g01); unpack8(*(const GAS u32x4*)(gp + DM + bj * HALF), g10, g11);
#pragma unroll
                            for (int j = 0; j < 4; ++j) { acc[ai][bj][m][0][j] *= g00[j] * __builtin_amdgcn_rcpf(fmaxf(g10[j], 1e-6f)); acc[ai][bj][m][1][j] *= g01[j] * __builtin_amdgcn_rcpf(fmaxf(g11[j], 1e-6f)); } } }
            }
            PG8_LDB(B0, 0, 0); PG8_LDB(B1, 0, 1); PG8_SCHED; PG8_LDA(At, 0, 0); PG8_STAGE_T(PG8_SA(1, 1), true, 1, t + 1);
            PG8_WAIT_V(8); PG8_WAIT_L(0); PG8_BAR; PG8_MMA(0, 0, At, B0); PG8_MMA(0, 1, At, B1); PG8_BAR; PG8_SCHED;
            PG8_LDA(At, 0, 1); PG8_STAGE_T(PG8_SB(0, 0), false, 0, t + 2); PG8_STAGE_T(PG8_SB(0, 1), false, 1, t + 2); PG8_STAGE_T(PG8_SA(0, 0), true, 0, t + 2);
            PG8_WAIT_V(8); PG8_WAIT_L(0); PG8_BAR; PG8_MMA(1, 0, At, B0); PG8_MMA(1, 1, At, B1); PG8_BAR; PG8_SCHED;
            PG8_LDB(B0, 1, 0); PG8_LDB(B1, 1, 1); PG8_SCHED; PG8_LDA(At, 1, 0); PG8_STAGE_T(PG8_SA(0, 1), true, 1, t + 2);
            PG8_WAIT_V(8); PG8_WAIT_L(0); PG8_BAR; PG8_MMA(0, 0, At, B0); PG8_MMA(0, 1, At, B1); PG8_BAR; PG8_SCHED;
            PG8_LDA(At, 1, 1); PG8_STAGE_T(PG8_SB(1, 0), false, 0, t + 3); PG8_STAGE_T(PG8_SB(1, 1), false, 1, t + 3); PG8_STAGE_T(PG8_SA(1, 0), true, 0, t + 3);
            PG8_WAIT_V(8); PG8_WAIT_L(0); PG8_BAR; PG8_MMA(1, 0, At, B0); PG8_MMA(1, 1, At, B1); PG8_BAR; PG8_SCHED;
        }
        if (wr == 0) PG8_BAR;
#pragma unroll
        for (int ai = 0; ai < 2; ++ai)
#pragma unroll
            for (int m = 0; m < 4; ++m) { const size_t row = (size_t)(rowb + ai * HALF + m * 16);
#pragma unroll
                for (int bj = 0; bj < 2; ++bj) { f32x4 g10, g11; unpack8(*(const GAS u32x4*)(gates + row * (2 * DM) + DM + colb + bj * HALF), g10, g11);
#pragma unroll
                    for (int j = 0; j < 4; ++j) { g10[j] = fmaxf(g10[j], 1e-6f); g11[j] = fmaxf(g11[j], 1e-6f); }
                    *(GAS u32x4*)(out + row * DM + colb + bj * HALF) = pack8(acc[ai][bj][m][0] * g10, acc[ai][bj][m][1] * g11); } }
        if (!has_next) break;
#pragma unroll
        for (int a = 0; a < 2; ++a)
#pragma unroll
            for (int b = 0; b < 2; ++b)
#pragma unroll
                for (int m = 0; m < 4; ++m)
#pragma unroll
                    for (int n = 0; n < 2; ++n) acc[a][b][m][n] = (f32x4){0.f, 0.f, 0.f, 0.f};
        cur = nxt; cA1 = nA1; cB1 = nB1; cA2 = (const char*)g.A2 + (size_t)cur.pm * 2 * hA2; cB2 = (const char*)g.B2 + (size_t)cur.pn * 2 * hB2; ++ui;
        if (wr == 1) PG8_BAR;
    }
    PG8_WAIT_V(0);
    PG8_BAR;
#undef PG8_SA
#undef PG8_SB
#undef PG8_STAGE_T
#undef PG8_LDA
#undef PG8_LDB
#undef PG8_MMA
#undef PG8_WAIT_V
#undef PG8_WAIT_L
#undef PG8_BAR
#undef PG8_SCHED
}
}

#define XB_TMO      128
#define XB_XCNT(j)  (256  + 64 * (j))
#define XB_XSUB(j)  (1280 + 64 * (j))
#define XB_XGEN(j)  (2304 + 64 * (j))
#define XB_TOP      3328
#define XB_TOPGEN   3392
#define XCD_BAR_WORDS 3456
#define XB_SPIN_CAP (1u << 18)
__device__ __forceinline__ unsigned xb_ld(unsigned* p)              { return __hip_atomic_load(p, __ATOMIC_RELAXED, __HIP_MEMORY_SCOPE_AGENT); }
__device__ __forceinline__ unsigned xb_add(unsigned* p, unsigned v) { return __hip_atomic_fetch_add(p, v, __ATOMIC_RELAXED, __HIP_MEMORY_SCOPE_AGENT); }
__device__ __forceinline__ unsigned xb_xcc_id() { return (unsigned)__builtin_amdgcn_s_getreg((3 << 11) | 20) & 0xFu; }
#define XB_SPIN(cond, bar) do { unsigned _sp = 0; while (cond) { __builtin_amdgcn_s_sleep(1); \
    if ((++_sp & 255u) == 0u) { if (xb_ld(&(bar)[XB_TMO])) break; if (_sp > XB_SPIN_CAP) { atomicAdd(&(bar)[XB_TMO], 1u); break; } } } } while (0)
struct XcdBarrier { unsigned* bar; unsigned x; volatile LAS unsigned* st; };
__device__ __forceinline__ XcdBarrier xcd_barrier_post(unsigned* bar, volatile LAS unsigned* st) {
    XcdBarrier b; b.bar = bar; b.x = xb_xcc_id(); b.st = st;
    if (threadIdx.x == 0) (void)xb_add(&bar[XB_XCNT(b.x)], 1u);
    return b;
}
__device__ __forceinline__ void xcd_barrier_complete(unsigned* bar, unsigned x, unsigned& nloc, unsigned& nx) {
    const unsigned G = gridDim.x * gridDim.y * gridDim.z;
    unsigned sum, cnt, mine, sp = 0u;
    for (;;) {
        sum = 0u; cnt = 0u; mine = 0u;
#pragma unroll
        for (unsigned j = 0; j < 16; ++j) { const unsigned c = xb_ld(&bar[XB_XCNT(j)]); sum += c; cnt += (c > 0u) ? 1u : 0u; mine = (j == x) ? c : mine; }
        if (sum == G) break;
        __builtin_amdgcn_s_sleep(1);
        if ((++sp & 255u) == 0u) { if (xb_ld(&bar[XB_TMO])) break; if (sp > XB_SPIN_CAP) { atomicAdd(&bar[XB_TMO], 1u); break; } }
    }
    nloc = mine > 0u ? mine : 1u; nx = cnt > 0u ? cnt : 1u;
}
__device__ __forceinline__ void xcd_barrier(const XcdBarrier& b) {
    asm volatile("s_waitcnt vmcnt(0)" ::: "memory");
    __syncthreads();
    if (threadIdx.x == 0) {
        unsigned* bar = b.bar;
        __builtin_amdgcn_s_waitcnt(0);
        unsigned nloc = b.st[0], nx = b.st[1];
        if (nloc == 0u) { xcd_barrier_complete(bar, b.x, nloc, nx); b.st[0] = nloc; b.st[1] = nx; }
        const unsigned old = xb_add(&bar[XB_XSUB(b.x)], 1u);
        const unsigned gen = old / nloc;
        if (old + 1u == (gen + 1u) * nloc) {
            __builtin_amdgcn_fence(__ATOMIC_RELEASE, "agent");
            asm volatile("s_waitcnt vmcnt(0)" ::: "memory");
            const unsigned og = xb_add(&bar[XB_TOP], 1u);
            const unsigned tg = og / nx;
            if (og + 1u == (tg + 1u) * nx) xb_add(&bar[XB_TOPGEN], 1u);
            else XB_SPIN(xb_ld(&bar[XB_TOPGEN]) == tg, bar);
            __builtin_amdgcn_fence(__ATOMIC_ACQUIRE, "agent");
            xb_add(&bar[XB_XGEN(b.x)], 1u);
            asm volatile("s_waitcnt vmcnt(0)" ::: "memory");
        } else {
            XB_SPIN(xb_ld(&bar[XB_XGEN(b.x)]) == gen, bar);
            __builtin_amdgcn_fence(__ATOMIC_ACQUIRE, "agent");
            asm volatile("s_waitcnt vmcnt(0)" ::: "memory");
        }
    }
    __syncthreads();
}

__device__ __forceinline__ void tr_item_load(const float* W, int N, const float* gain, int k0, int n0, int lane, f32x4 (&v)[8]) {
#pragma unroll
    for (int i = 0; i < 8; ++i) { const int kk = 8 * i + (lane >> 3), nn = 4 * (lane & 7);
        v[i] = *(const GAS f32x4*)(W + (size_t)(k0 + kk) * N + n0 + nn);
        if (gain) v[i] = v[i] * *(const GAS float*)(gain + k0 + kk); }
}
__device__ __forceinline__ void tr_item_store(const f32x4 (&v)[8], int K, bf16_t* WT, int k0, int drow0, LAS float* scr, int lane) {
#pragma unroll
    for (int i = 0; i < 8; ++i) { const int kk = 8 * i + (lane >> 3), nn = 4 * (lane & 7);
        scr[kk * 33 + nn] = v[i].x; scr[kk * 33 + nn + 1] = v[i].y; scr[kk * 33 + nn + 2] = v[i].z; scr[kk * 33 + nn + 3] = v[i].w; }
    LDS_WAIT(); asm volatile("" ::: "memory");
    const int c = lane & 7;
#pragma unroll
    for (int j = 0; j < 4; ++j) { const int n = (lane >> 3) + 8 * j; const LAS float* s = scr + (8 * c) * 33 + n;
        u32x4 o; o.x = pk2(s[0 * 33], s[1 * 33]); o.y = pk2(s[2 * 33], s[3 * 33]); o.z = pk2(s[4 * 33], s[5 * 33]); o.w = pk2(s[6 * 33], s[7 * 33]);
        *(GAS u32x4*)(WT + (size_t)(drow0 + n) * K + k0 + 8 * c) = o; }
    LDS_WAIT(); asm volatile("" ::: "memory");
}
__device__ __forceinline__ void p0_transpose_item(const float* W, int K, int N, const float* gain, bf16_t* WT, int k0, int n0, int drow0, LAS float* scr, int lane) {
    f32x4 v[8]; tr_item_load(W, N, gain, k0, n0, lane, v); tr_item_store(v, K, WT, k0, drow0, scr, lane);
}
__device__ __forceinline__ int map_gu(int n0) { return n0 < DFF ? (n0 / 128) * 256 + (n0 % 128) : ((n0 - DFF) / 128) * 256 + 128 + ((n0 - DFF) % 128); }
__device__ __forceinline__ int map_win(int n0) { return n0 < 6144 ? n0 : (n0 < 6176 ? 9216 + (n0 - 6144) : n0 - 32); }

constexpr int TI_GU = (DM / 64) * (2 * DFF / 32), TI_D = (DFF / 64) * (DM / 32), TI_IN = (DM / 64) * (IN_DIM / 32), TI_SSO = (DI / 64) * (DM / 32), TI_SQ = (DM / 64) * (DM / 32), TI_PLE = (PLE / 64) * (DM / 32);
constexpr int TI_H1 = TI_D + TI_IN;
constexpr int TI_H3 = TI_GU + TI_D + TI_SSO + 2 * TI_SQ + TI_PLE;
struct TrItem { const float* W; const float* gain; bf16_t* WT; int K, N, k0, n0, drow0; };
template <int PH> __device__ __forceinline__ TrItem deferred_item(Frame& F, int r) {
    TrItem t; t.gain = nullptr; int mapk = 0; size_t wso;
    if (PH == 1) {
        if (r < TI_D) { t.W = F.in[I_WD1]; t.K = DFF; t.N = DM; wso = WS_WD1; }
        else { r -= TI_D; t.W = F.in[I_WIN]; t.K = DM; t.N = IN_DIM; t.gain = F.in[I_NMIX]; wso = WS_WIN; mapk = 2; }
    } else {
        if (r < TI_GU) { t.W = F.in[I_WGU2]; t.K = DM; t.N = 2 * DFF; t.gain = F.in[I_NFFN2]; wso = WS_WGU2; mapk = 1; }
        else if ((r -= TI_GU) < TI_D) { t.W = F.in[I_WD2]; t.K = DFF; t.N = DM; wso = WS_WD2; }
        else if ((r -= TI_D) < TI_SSO) { t.W = F.in[I_WSSO]; t.K = DI; t.N = DM; t.gain = F.in[I_NSSD]; wso = WS_WSSO; }
        else if ((r -= TI_SSO) < TI_SQ) { t.W = F.in[I_WO]; t.K = DM; t.N = DM; wso = WS_WO; }
        else if ((r -= TI_SQ) < TI_SQ) { t.W = F.in[I_WPG]; t.K = DM; t.N = DM; t.gain = F.in[I_NPLE]; wso = WS_WPG; }
        else { r -= TI_SQ; t.W = F.in[I_WPLE]; t.K = PLE; t.N = DM; wso = WS_WPLE; }
    }
    const int nbk = t.N / 32, kb = r / nbk; t.n0 = (r % nbk) * 32; t.k0 = kb * 64; t.drow0 = (mapk == 1) ? map_gu(t.n0) : (mapk == 2) ? map_win(t.n0) : t.n0;
    t.WT = (bf16_t*)(F.ws + wso);
    return t;
}
template <int PH> __device__ __forceinline__ void deferred_transposes(Frame& F) {
    LAS float* scr = (LAS float*)(F.lds + F.wave * 16384);
    constexpr int NIT = (PH == 1) ? TI_H1 : TI_H3;
    const int gw = F.vcu * NWAVES + F.wave, NGW = F.G * NWAVES, lane = F.lane;
    if (gw < NIT) {
        f32x4 va[8], vb[8];
        TrItem ta = deferred_item<PH>(F, gw), tb = ta;
        tr_item_load(ta.W, ta.N, ta.gain, ta.k0, ta.n0, lane, va);
        for (int it = gw; it < NIT; it += 2 * NGW) {
            const bool hb = it + NGW < NIT;
            if (hb) { tb = deferred_item<PH>(F, it + NGW); tr_item_load(tb.W, tb.N, tb.gain, tb.k0, tb.n0, lane, vb); }
            tr_item_store(va, ta.K, ta.WT, ta.k0, ta.drow0, scr, lane);
            if (!hb) break;
            const bool ha = it + 2 * NGW < NIT;
            if (ha) { ta = deferred_item<PH>(F, it + 2 * NGW); tr_item_load(ta.W, ta.N, ta.gain, ta.k0, ta.n0, lane, va); }
            tr_item_store(vb, tb.K, tb.WT, tb.k0, tb.drow0, scr, lane);
            if (!ha) break;
        }
    }
    __syncthreads();
}

__device__ __forceinline__ void p0_prologue(Frame& F) {
    LAS float* scr = (LAS float*)(F.lds + F.wave * 16384);
    const int gw = F.vcu * NWAVES + F.wave, NGW = F.G * NWAVES, lane = F.lane;
    constexpr int NITEMS = TI_GU + TI_SQ;
    bf16_t* const wgu1 = (bf16_t*)(F.ws + WS_WGU1); bf16_t* const wpot = (bf16_t*)(F.ws + WS_WPOT);
    for (int it = gw; it < NITEMS; it += NGW) {
        int r = it;
        if (r < TI_GU) { const int nb = 2 * DFF / 32, kb = r / nb, n0 = (r % nb) * 32; p0_transpose_item(F.in[I_WGU1], DM, 2 * DFF, F.in[I_NFFN1], wgu1, kb * 64, n0, map_gu(n0), scr, lane); continue; } r -= TI_GU;
        { const int nb = DM / 32, kb = r / nb, n0 = (r % nb) * 32; p0_transpose_item(F.in[I_WPOUT], PD, DM, F.in[I_PSCALE], wpot, kb * 64, n0, n0, scr, lane); }
    }
    {
        bf16_t* const wgrp = (bf16_t*)(F.ws + WS_WGRP); const float* Wg = F.in[I_WPGRP];
        for (int e = F.vcu * NTHREADS + F.tid; e < 4 * 256 * 256 / 8; e += F.G * NTHREADS) {
            const f32x4 a = *(const GAS f32x4*)(Wg + (size_t)e * 8), b = *(const GAS f32x4*)(Wg + (size_t)e * 8 + 4);
            u32x4 o; o.x = pk2(a.x, a.y); o.y = pk2(a.z, a.w); o.z = pk2(b.x, b.y); o.w = pk2(b.z, b.w);
            *(GAS u32x4*)(wgrp + (size_t)e * 8) = o; }
    }
    {
        bf16_t* const XB = (bf16_t*)(F.ws + WS_XB); bf16_t* const PB = (bf16_t*)(F.ws + WS_PB); float* const stA = (float*)(F.ws + WS_STATS_A);
        for (int m0 = gw; m0 < M; m0 += 2 * NGW) {
            const int m1 = m0 + NGW; const bool h1 = m1 < M; const int m1c = h1 ? m1 : m0;
            const float* xr0 = (m0 < MP) ? F.in[I_XP] + (size_t)m0 * DM : F.in[I_XS] + (size_t)(m0 - MP) * DM;
            const float* xr1 = (m1c < MP) ? F.in[I_XP] + (size_t)m1c * DM : F.in[I_XS] + (size_t)(m1c - MP) * DM;
            const float* pr0 = (m0 < MP) ? F.in[I_PP] + (size_t)m0 * PLE : F.in[I_PS] + (size_t)(m0 - MP) * PLE;
            const float* pr1 = (m1c < MP) ? F.in[I_PP] + (size_t)m1c * PLE : F.in[I_PS] + (size_t)(m1c - MP) * PLE;
            f32x4 v0[4], v1[4];
#pragma unroll
            for (int j = 0; j < 4; ++j) { v0[j] = *((const GAS f32x4*)xr0 + lane + 64 * j); v1[j] = *((const GAS f32x4*)xr1 + lane + 64 * j); }
            const f32x4 p0 = *((const GAS f32x4*)pr0 + lane), p1 = *((const GAS f32x4*)pr1 + lane);
            float s0 = 0.f, s1 = 0.f;
#pragma unroll
            for (int j = 0; j < 4; ++j) { s0 += (v0[j].x * v0[j].x + v0[j].y * v0[j].y) + (v0[j].z * v0[j].z + v0[j].w * v0[j].w); s1 += (v1[j].x * v1[j].x + v1[j].y * v1[j].y) + (v1[j].z * v1[j].z + v1[j].w * v1[j].w); }
            s0 = wave_sum(s0); s1 = wave_sum(s1);
            { GAS u32x2* o8 = (GAS u32x2*)(XB + (size_t)m0 * DM) + lane;
#pragma unroll
              for (int j = 0; j < 4; ++j) { u32x2 w; w.x = pk2(v0[j].x, v0[j].y); w.y = pk2(v0[j].z, v0[j].w); o8[64 * j] = w; }
              if (lane < 16) *(GAS float*)(stA + (size_t)m0 * 16 + lane) = (lane == 0) ? s0 : 0.f;
              u32x2 w; w.x = pk2(p0.x, p0.y); w.y = pk2(p0.z, p0.w); *((GAS u32x2*)(PB + (size_t)m0 * PLE) + lane) = w; }
            if (h1) { GAS u32x2* o8 = (GAS u32x2*)(XB + (size_t)m1 * DM) + lane;
#pragma unroll
              for (int j = 0; j < 4; ++j) { u32x2 w; w.x = pk2(v1[j].x, v1[j].y); w.y = pk2(v1[j].z, v1[j].w); o8[64 * j] = w; }
              if (lane < 16) *(GAS float*)(stA + (size_t)m1 * 16 + lane) = (lane == 0) ? s1 : 0.f;
              u32x2 w; w.x = pk2(p1.x, p1.y); w.y = pk2(p1.z, p1.w); *((GAS u32x2*)(PB + (size_t)m1 * PLE) + lane) = w; }
        }
    }
}


typedef short v4i16_t __attribute__((ext_vector_type(4)));
constexpr int IMG_B = 0, IMG_C = 32768, IMG_X = 65536, TAB_ACS = RING_BYTES + 1024, TAB_DT = TAB_ACS + 2048, TAB_SD = TAB_DT + 2048;
constexpr int NCHUNK = SEQ / 128;
template <bool XS> __device__ __forceinline__ int img_off(int row, int ch) { return XS ? 256 * row + 16 * (ch ^ ((row & 7) << 1)) : 256 * row + 16 * (ch ^ (((row & 3) << 2) | ((row >> 2) & 3))); }
__device__ __forceinline__ bf16x8 tr_pair(const LAS unsigned char* p0, const LAS unsigned char* p1) {
    const v4i16_t a = __builtin_amdgcn_ds_read_tr16_b64_v4i16((LAS v4i16_t*)p0), b = __builtin_amdgcn_ds_read_tr16_b64_v4i16((LAS v4i16_t*)p1);
    return (bf16x8){a[0], a[1], a[2], a[3], b[0], b[1], b[2], b[3]};
}
__device__ __forceinline__ void ssd_tables_load(Frame& F, size_t row0, int g, float& d0, float& d1) {
    if (F.wave < 4) { const float* const DT = (const float*)(F.ws + WS_DT); const int head = g * HPG + F.wave;
        d0 = *(const GAS float*)(DT + (row0 + 2 * F.lane) * 32 + head); d1 = *(const GAS float*)(DT + (row0 + 2 * F.lane + 1) * 32 + head); }
}
__device__ __forceinline__ void ssd_tables_compute(Frame& F, int g, float d0, float d1) {
    LAS float* const acs = (LAS float*)(F.lds + TAB_ACS); LAS float* const dtl = (LAS float*)(F.lds + TAB_DT); LAS float* const sdec = (LAS float*)(F.lds + TAB_SD);
    if (F.wave < 4) {
        const int r = F.wave, lane = F.lane, head = g * HPG + r;
        const float Ah = -__expf(*(const GAS float*)(F.in[I_ALOG] + head));
        const float a0 = d0 * Ah, a1 = d1 * Ah, loc = a0 + a1;
        float inc = loc;
#pragma unroll
        for (int o = 1; o < 64; o <<= 1) { const float t = __shfl_up(inc, o); if (lane >= o) inc += t; }
        const float exc = inc - loc;
        acs[(2 * lane) * 4 + r] = exc + a0; acs[(2 * lane + 1) * 4 + r] = inc;
        dtl[(2 * lane) * 4 + r] = d0; dtl[(2 * lane + 1) * 4 + r] = d1;
    }
    __syncthreads();
    { const int s = F.tid >> 2, r = F.tid & 3; sdec[s * 4 + r] = __expf(acs[127 * 4 + r] - acs[s * 4 + r]) * dtl[s * 4 + r]; }
    __syncthreads();
}
__device__ __forceinline__ void ssd_tables(Frame& F, size_t row0, int g) { float d0 = 0.f, d1 = 0.f; ssd_tables_load(F, row0, g, d0, d1); ssd_tables_compute(F, g, d0, d1); }
struct ConvMap { int kind, cc, run, gch; };
__device__ __forceinline__ ConvMap ssd_conv_map(int t, int g) {
    ConvMap m;
    if (t < 256) { m.kind = 0; m.cc = t & 31; m.run = t >> 5; } else if (t < 384) { m.kind = 1; m.cc = (t - 256) & 15; m.run = (t - 256) >> 4; } else { m.kind = 2; m.cc = (t - 384) & 15; m.run = (t - 384) >> 4; }
    m.gch = (m.kind == 0 ? g * 256 : (m.kind == 1 ? DI + g * DSTATE : DI + NG * DSTATE + g * DSTATE)) + 8 * m.cc;
    return m;
}
__device__ __forceinline__ void ssd_conv_load(Frame& F, size_t row0, int b, int c, int g, u32x4 (&raw)[19]) {
    const ConvMap m = ssd_conv_map(F.tid, g);
    const bf16_t* const XBC = (const bf16_t*)(F.ws + WS_XBC); const bf16_t* const HALO = (const bf16_t*)(F.ws + WS_HALO);
#pragma unroll
    for (int i = 0; i < 19; ++i) {
        if (i < 3 && m.run == 0) { if (c == 0) raw[i] = (u32x4){0u, 0u, 0u, 0u}; else raw[i] = *(const GAS u32x4*)(HALO + ((((size_t)b * 16 + c) * 3 + i) * CD) + m.gch); }
        else raw[i] = *(const GAS u32x4*)(XBC + (row0 + 16 * m.run + i - 3) * CD + m.gch); }
}
__device__ __forceinline__ void ssd_conv_store(Frame& F, size_t row0, int g, const u32x4 (&raw)[19]) {
    const ConvMap m = ssd_conv_map(F.tid, g);
    bf16_t* const XBC = (bf16_t*)(F.ws + WS_XBC);
    const float* const convw = F.in[I_CONVW]; const float* const convb = F.in[I_CONVB];
    float cw[4][8], cb[8];
#pragma unroll
    for (int k = 0; k < 4; ++k) { const f32x4 a = *(const GAS f32x4*)(convw + (size_t)k * CD + m.gch), b_ = *(const GAS f32x4*)(convw + (size_t)k * CD + m.gch + 4);
        cw[k][0] = a.x; cw[k][1] = a.y; cw[k][2] = a.z; cw[k][3] = a.w; cw[k][4] = b_.x; cw[k][5] = b_.y; cw[k][6] = b_.z; cw[k][7] = b_.w; }
    { const f32x4 a = *(const GAS f32x4*)(convb + m.gch), b_ = *(const GAS f32x4*)(convb + m.gch + 4); cb[0] = a.x; cb[1] = a.y; cb[2] = a.z; cb[3] = a.w; cb[4] = b_.x; cb[5] = b_.y; cb[6] = b_.z; cb[7] = b_.w; }
    LAS unsigned char* const img = F.lds + (m.kind == 0 ? IMG_X + (m.cc >> 4) * 32768 : IMG_B);
    const LAS float* const sdec = (const LAS float*)(F.lds + TAB_SD);
    const int chl = m.cc & 15, hr = m.cc >> 3;
#pragma unroll
    for (int i = 0; i < 16; ++i) {
        const int s = 16 * m.run + i;
        float o[8];
#pragma unroll
        for (int j2 = 0; j2 < 4; ++j2) {
            const unsigned w0 = raw[i][j2], w1 = raw[i + 1][j2], w2 = raw[i + 2][j2], w3 = raw[i + 3][j2];
            const float lo = cb[2 * j2] + cw[0][2 * j2] * bflo(w0) + cw[1][2 * j2] * bflo(w1) + cw[2][2 * j2] * bflo(w2) + cw[3][2 * j2] * bflo(w3);
            const float hi = cb[2 * j2 + 1] + cw[0][2 * j2 + 1] * bfhi(w0) + cw[1][2 * j2 + 1] * bfhi(w1) + cw[2][2 * j2 + 1] * bfhi(w2) + cw[3][2 * j2 + 1] * bfhi(w3);
            o[2 * j2] = silu_f(lo); o[2 * j2 + 1] = silu_f(hi);
        }
        u32x4 pk; pk.x = cvt_pk_bf16(o[0], o[1]); pk.y = cvt_pk_bf16(o[2], o[3]); pk.z = cvt_pk_bf16(o[4], o[5]); pk.w = cvt_pk_bf16(o[6], o[7]);
        *(GAS u32x4*)(XBC + (row0 + s) * CD + m.gch) = pk;
        if (m.kind == 0) { const float sc = sdec[s * 4 + hr];
            pk.x = cvt_pk_bf16(o[0] * sc, o[1] * sc); pk.y = cvt_pk_bf16(o[2] * sc, o[3] * sc); pk.z = cvt_pk_bf16(o[4] * sc, o[5] * sc); pk.w = cvt_pk_bf16(o[6] * sc, o[7] * sc); }
        if (m.kind != 2) *(LAS u32x4*)(img + img_off<false>(s, chl)) = pk;
    }
}
__device__ __forceinline__ void ssd_copy_load(Frame& F, size_t row0, int g, u32x4 (&raw)[16]) {
    const ConvMap m = ssd_conv_map(F.tid, g);
    const bf16_t* const XBC = (const bf16_t*)(F.ws + WS_XBC);
#pragma unroll
    for (int i = 0; i < 16; ++i) raw[i] = *(const GAS u32x4*)(XBC + (row0 + 16 * m.run + i) * CD + m.gch);
}
__device__ __forceinline__ void ssd_copy_store(Frame& F, int g, const u32x4 (&raw)[16]) {
    const ConvMap m = ssd_conv_map(F.tid, g);
    LAS unsigned char* const img = F.lds + (m.kind == 0 ? IMG_X + (m.cc >> 4) * 32768 : (m.kind == 1 ? IMG_B : IMG_C));
    const int chl = m.cc & 15;
#pragma unroll
    for (int i = 0; i < 16; ++i) { const int s = 16 * m.run + i; *(LAS u32x4*)(img + (m.kind == 0 ? img_off<true>(s, chl) : img_off<false>(s, chl))) = raw[i]; }
}
__device__ __forceinline__ void ssd_states_phase(Frame& F) {
    bf16_t* const ST = (bf16_t*)(F.ws + WS_HPREV);
    float* const CDEC = (float*)(F.ws + WS_CDEC);
    const int w = F.wave, lane = F.lane, ql = lane & 15, gq = lane >> 4, qq = ql >> 2, pp = ql & 3, r = w >> 1, nh = w & 1;
    int sbo[4][2], sxo[4][2];
#pragma unroll
    for (int f = 0; f < 4; ++f) { const int colb = 64 * nh + 16 * f + 4 * pp, colx = 64 * (r & 1) + 16 * f + 4 * pp;
#pragma unroll
        for (int t4 = 0; t4 < 2; ++t4) { sbo[f][t4] = img_off<false>(8 * gq + qq + 4 * t4, colb >> 3) + 2 * (colb & 7); sxo[f][t4] = img_off<false>(8 * gq + qq + 4 * t4, colx >> 3) + 2 * (colx & 7); } }
    u32x4 raw[19]; float d0 = 0.f, d1 = 0.f;
    constexpr int NIT = BATCH * NCHUNK * NG;
    if (F.vcu < NIT) { const int it = F.vcu, g = it & 7, c = (it >> 3) & (NCHUNK - 1), b = it >> 7; const size_t row0 = (size_t)b * SEQ + (size_t)c * 128;
        ssd_conv_load(F, row0, b, c, g, raw); ssd_tables_load(F, row0, g, d0, d1); }
    for (int it = F.vcu; it < NIT; it += F.G) {
        const int g = it & 7, c = (it >> 3) & (NCHUNK - 1), b = it >> 7;
        const size_t row0 = (size_t)b * SEQ + (size_t)c * 128;
        asm volatile("s_waitcnt vmcnt(0)" ::: "memory");
        ssd_tables_compute(F, g, d0, d1);
        ssd_conv_store(F, row0, g, raw);
        __syncthreads();
        if (it + F.G < NIT) { const int it2 = it + F.G, g2 = it2 & 7, c2 = (it2 >> 3) & (NCHUNK - 1), b2 = it2 >> 7; const size_t row2 = (size_t)b2 * SEQ + (size_t)c2 * 128;
            ssd_conv_load(F, row2, b2, c2, g2, raw); ssd_tables_load(F, row2, g2, d0, d1); }
        const int head = g * HPG + r;
        bf16_t* const stp = ST + ((((size_t)b * NCHUNK + c) * NH + head) * HD) * DSTATE;
#pragma unroll
        for (int nh2 = 0; nh2 < 2; ++nh2) {
            f32x4 acc[2][4];
#pragma unroll
            for (int i = 0; i < 2; ++i)
#pragma unroll
                for (int j = 0; j < 4; ++j) acc[i][j] = (f32x4){0.f, 0.f, 0.f, 0.f};
#pragma unroll
            for (int ks = 0; ks < 4; ++ks) {
                bf16x8 af[2], xf[4];
#pragma unroll
                for (int nf = 0; nf < 2; ++nf) { const LAS unsigned char* p = F.lds + IMG_B + sbo[2 * nh2 + nf][0] + 8192 * ks; const LAS unsigned char* p4 = F.lds + IMG_B + sbo[2 * nh2 + nf][1] + 8192 * ks; af[nf] = tr_pair(p, p4); }
#pragma unroll
                for (int pf = 0; pf < 4; ++pf) { const LAS unsigned char* p = F.lds + IMG_X + (r >> 1) * 32768 + sxo[pf][0] + 8192 * ks; const LAS unsigned char* p4 = F.lds + IMG_X + (r >> 1) * 32768 + sxo[pf][1] + 8192 * ks; xf[pf] = tr_pair(p, p4); }
#pragma unroll
                for (int nf = 0; nf < 2; ++nf)
#pragma unroll
                    for (int pf = 0; pf < 4; ++pf) acc[nf][pf] = __builtin_amdgcn_mfma_f32_16x16x32_bf16(af[nf], xf[pf], acc[nf][pf], 0, 0, 0);
            }
#pragma unroll
            for (int pf = 0; pf < 4; ++pf)
#pragma unroll
                for (int nf = 0; nf < 2; ++nf) { u32x2 o; o.x = cvt_pk_bf16(acc[nf][pf][0], acc[nf][pf][1]); o.y = cvt_pk_bf16(acc[nf][pf][2], acc[nf][pf][3]);
                    *(GAS u32x2*)(stp + (size_t)(16 * pf + ql) * DSTATE + 64 * nh + 32 * nh2 + 16 * nf + 4 * gq) = o; }
        }
        if (F.tid < 4) { const LAS float* acs = (const LAS float*)(F.lds + TAB_ACS); *(GAS float*)(CDEC + ((size_t)b * NCHUNK + c) * NH + g * HPG + F.tid) = __expf(acs[127 * 4 + F.tid]); }
        __syncthreads();
    }
}
__device__ __forceinline__ void ssd_scan_phase(Frame& F) {
    bf16_t* const HP = (bf16_t*)(F.ws + WS_HPREV); const float* const CDEC = (const float*)(F.ws + WS_CDEC); float* const hout = F.out + O_SSM_P;
    const int gt = F.vcu * NTHREADS + F.tid, NT = F.G * NTHREADS;
    constexpr int PER = NH * HD * DSTATE / 8;
    for (int e = gt; e < BATCH * PER; e += NT) {
        const int b = e / PER, i8 = e % PER, head = i8 / (HD * DSTATE / 8);
        u32x4 stv[NCHUNK];
#pragma unroll
        for (int c = 0; c < NCHUNK; ++c) stv[c] = *(const GAS u32x4*)(HP + (((size_t)b * NCHUNK + c) * (size_t)PER + i8) * 8);
        f32x4 h0 = (f32x4){0.f, 0.f, 0.f, 0.f}, h1 = h0;
#pragma unroll
        for (int c = 0; c < NCHUNK; ++c) {
            if (c > 0) *(GAS u32x4*)(HP + (((size_t)b * NCHUNK + c) * (size_t)PER + i8) * 8) = pg8::pack8(h0, h1);
            const float d = *(const GAS float*)(CDEC + ((size_t)b * NCHUNK + c) * NH + head);
            f32x4 s0, s1; pg8::unpack8(stv[c], s0, s1);
            h0 = h0 * d + s0; h1 = h1 * d + s1;
        }
        *(GAS f32x4*)(hout + ((size_t)b * PER + i8) * 8) = h0; *(GAS f32x4*)(hout + ((size_t)b * PER + i8) * 8 + 4) = h1;
    }
}
__device__ __forceinline__ void ssd_out_phase(Frame& F) {
    const bf16_t* const HP = (const bf16_t*)(F.ws + WS_HPREV); bf16_t* const ZY = (bf16_t*)(F.ws + WS_Z);
    const int w = F.wave, lane = F.lane, ql = lane & 15, gq = lane >> 4, qq = ql >> 2, pp = ql & 3, q0 = 16 * w;
    const LAS float* const acs = (const LAS float*)(F.lds + TAB_ACS); const LAS float* const dtl = (const LAS float*)(F.lds + TAB_DT);
    int cfo[4], bbo[4], hbo[4], xbo[2][4];
#pragma unroll
    for (int ks = 0; ks < 4; ++ks) { cfo[ks] = IMG_C + img_off<false>(q0 + ql, 4 * ks + gq); bbo[ks] = IMG_B + img_off<false>(ql, 4 * ks + gq); hbo[ks] = img_off<false>(ql, 4 * ks + gq); }
#pragma unroll
    for (int rr = 0; rr < 2; ++rr)
#pragma unroll
        for (int pf = 0; pf < 4; ++pf) xbo[rr][pf] = IMG_X + img_off<true>(4 * gq + qq, 8 * rr + 2 * pf + (pp >> 1)) + 8 * (pp & 1);
    u32x4 raw[16]; float d0 = 0.f, d1 = 0.f;
    constexpr int NIT = BATCH * NCHUNK * NG;
    if (F.vcu < NIT) { const int it = F.vcu, g = it & 7, c = (it >> 3) & (NCHUNK - 1), b = it >> 7; const size_t row0 = (size_t)b * SEQ + (size_t)c * 128;
        ssd_copy_load(F, row0, g, raw); ssd_tables_load(F, row0, g, d0, d1); }
    for (int it = F.vcu; it < NIT; it += F.G) {
        const int g = it & 7, c = (it >> 3) & (NCHUNK - 1), b = it >> 7;
        const size_t row0 = (size_t)b * SEQ + (size_t)c * 128;
        ssd_tables_compute(F, g, d0, d1);
        ssd_copy_store(F, g, raw);
        __syncthreads();
        if (it + F.G < NIT) { const int it2 = it + F.G, g2 = it2 & 7, c2 = (it2 >> 3) & (NCHUNK - 1), b2 = it2 >> 7; const size_t row2 = (size_t)b2 * SEQ + (size_t)c2 * 128;
            ssd_copy_load(F, row2, g2, raw); ssd_tables_load(F, row2, g2, d0, d1); }
        bf16x8 cf[4];
#pragma unroll
        for (int ks = 0; ks < 4; ++ks) cf[ks] = *(const LAS bf16x8*)(F.lds + cfo[ks]);
        bf16_t* const zp = ZY + (row0 + q0 + ql) * DI + g * 256 + 4 * gq;
        const LAS float* const acs_l = acs + 16 * gq; const LAS float* const dtl_l = dtl + 16 * gq;
        f32x4 acc[4][4];
        float aq[4];
#pragma unroll
        for (int r = 0; r < 4; ++r) { aq[r] = acs[(q0 + ql) * 4 + r];
#pragma unroll
            for (int pf = 0; pf < 4; ++pf) acc[r][pf] = (f32x4){0.f, 0.f, 0.f, 0.f}; }
#pragma unroll
        for (int ks = 0; ks < 4; ++ks) if (2 * ks <= w) {
            f32x4 cb[2];
#pragma unroll
            for (int hf = 0; hf < 2; ++hf) { cb[hf] = (f32x4){0.f, 0.f, 0.f, 0.f};
                if (2 * ks + hf <= w) {
#pragma unroll
                    for (int kn = 0; kn < 4; ++kn) { const bf16x8 bfr = *(const LAS bf16x8*)(F.lds + bbo[kn] + 4096 * (2 * ks + hf)); cb[hf] = __builtin_amdgcn_mfma_f32_16x16x32_bf16(bfr, cf[kn], cb[hf], 0, 0, 0); } } }
#pragma unroll
            for (int r = 0; r < 4; ++r) {
                const float Dh = *(const GAS float*)(F.in[I_DSKIP] + g * HPG + r);
                float v[8];
#pragma unroll
                for (int hf = 0; hf < 2; ++hf) { const int sf = 2 * ks + hf;
#pragma unroll
                    for (int rg = 0; rg < 4; ++rg) { const int sl = 4 * gq + rg;
                        float val = 0.f;
                        if (sf <= w) { const float as = acs_l[64 * sf + 4 * rg + r], d = dtl_l[64 * sf + 4 * rg + r];
                            val = cb[hf][rg] * __expf(aq[r] - as) * d;
                            if (sf == w) { if (sl > ql) val = 0.f; else if (sl == ql) val += Dh; } }
                        v[4 * hf + rg] = val; } }
                u32x4 pk; pk.x = cvt_pk_bf16(v[0], v[1]); pk.y = cvt_pk_bf16(v[2], v[3]); pk.z = cvt_pk_bf16(v[4], v[5]); pk.w = cvt_pk_bf16(v[6], v[7]);
                const bf16x8 wf = __builtin_bit_cast(bf16x8, pk);
#pragma unroll
                for (int pf = 0; pf < 4; ++pf) {
                    const LAS unsigned char* const xb = F.lds + xbo[r & 1][pf] + (r >> 1) * 32768 + 8192 * ks;
                    const bf16x8 xf = tr_pair(xb, xb + 4096);
                    acc[r][pf] = __builtin_amdgcn_mfma_f32_16x16x32_bf16(xf, wf, acc[r][pf], 0, 0, 0); }
            }
        }
        u32x4 hreg[8];
        if (c > 0) {
            const u32x4* hsrc = (const u32x4*)(HP + ((((size_t)b * NCHUNK + c) * NH + g * HPG) * HD) * DSTATE) + F.tid;
#pragma unroll
            for (int i = 0; i < 8; ++i) hreg[i] = *(const GAS u32x4*)(hsrc + 512 * i);
        }
        if (c > 0) {
            __syncthreads();
#pragma unroll
            for (int i = 0; i < 8; ++i) { const int e = F.tid + 512 * i, hr_ = e >> 10, p_ = (e >> 4) & 63, ch_ = e & 15;
                *(LAS u32x4*)(F.lds + IMG_X + hr_ * 16384 + img_off<false>(p_, ch_)) = hreg[i]; }
            __syncthreads();
#pragma unroll
            for (int r = 0; r < 4; ++r) { const float eaq = __expf(aq[r]);
#pragma unroll
                for (int pf = 0; pf < 4; ++pf) { f32x4 yo = (f32x4){0.f, 0.f, 0.f, 0.f};
#pragma unroll
                    for (int ks = 0; ks < 4; ++ks) { const bf16x8 hf_ = *(const LAS bf16x8*)(F.lds + IMG_X + r * 16384 + hbo[ks] + 4096 * pf); yo = __builtin_amdgcn_mfma_f32_16x16x32_bf16(hf_, cf[ks], yo, 0, 0, 0); }
                    acc[r][pf] += yo * eaq; } }
        }
        float ssum = 0.f;
#pragma unroll
        for (int r = 0; r < 4; ++r)
#pragma unroll
            for (int pf = 0; pf < 4; ++pf) {
                const u32x2 zz = *(const GAS u32x2*)(zp + r * 64 + 16 * pf);
                const f32x4 y = acc[r][pf] * (f32x4){bflo(zz.x), bfhi(zz.x), bflo(zz.y), bfhi(zz.y)};
                acc[r][pf] = y; ssum += (y[0] * y[0] + y[1] * y[1]) + (y[2] * y[2] + y[3] * y[3]); }
        ssum += __shfl_xor(ssum, 16); ssum += __shfl_xor(ssum, 32);
        const float rsn = __builtin_amdgcn_rsqf(ssum * (1.0f / 256.0f) + EPS);
#pragma unroll
        for (int r = 0; r < 4; ++r)
#pragma unroll
            for (int pf = 0; pf < 4; ++pf) { u32x2 o; o.x = cvt_pk_bf16(acc[r][pf][0] * rsn, acc[r][pf][1] * rsn); o.y = cvt_pk_bf16(acc[r][pf][2] * rsn, acc[r][pf][3] * rsn);
                *(GAS u32x2*)(zp + r * 64 + 16 * pf) = o; }
        __syncthreads();
    }
}


__device__ __forceinline__ void ssd_conv_store_local(Frame& F, size_t row0, int g, const u32x4 (&raw)[19]) {
    const ConvMap m = ssd_conv_map(F.tid, g);
    bf16_t* const XBC = (bf16_t*)(F.ws + WS_XBC);
    const float* const convw = F.in[I_CONVW]; const float* const convb = F.in[I_CONVB];
    float cw[4][8], cb[8];
#pragma unroll
    for (int k = 0; k < 4; ++k) { const f32x4 a = *(const GAS f32x4*)(convw + (size_t)k * CD + m.gch), b_ = *(const GAS f32x4*)(convw + (size_t)k * CD + m.gch + 4);
        cw[k][0] = a.x; cw[k][1] = a.y; cw[k][2] = a.z; cw[k][3] = a.w; cw[k][4] = b_.x; cw[k][5] = b_.y; cw[k][6] = b_.z; cw[k][7] = b_.w; }
    { const f32x4 a = *(const GAS f32x4*)(convb + m.gch), b_ = *(const GAS f32x4*)(convb + m.gch + 4); cb[0] = a.x; cb[1] = a.y; cb[2] = a.z; cb[3] = a.w; cb[4] = b_.x; cb[5] = b_.y; cb[6] = b_.z; cb[7] = b_.w; }
    LAS unsigned char* const img = F.lds + (m.kind == 0 ? IMG_X + (m.cc >> 4) * 32768 : (m.kind == 1 ? IMG_B : IMG_C));
    const int chl = m.cc & 15;
#pragma unroll
    for (int i = 0; i < 16; ++i) {
        const int s = 16 * m.run + i;
        float o[8];
#pragma unroll
        for (int j2 = 0; j2 < 4; ++j2) {
            const unsigned w0 = raw[i][j2], w1 = raw[i + 1][j2], w2 = raw[i + 2][j2], w3 = raw[i + 3][j2];
            const float lo = cb[2 * j2] + cw[0][2 * j2] * bflo(w0) + cw[1][2 * j2] * bflo(w1) + cw[2][2 * j2] * bflo(w2) + cw[3][2 * j2] * bflo(w3);
            const float hi = cb[2 * j2 + 1] + cw[0][2 * j2 + 1] * bfhi(w0) + cw[1][2 * j2 + 1] * bfhi(w1) + cw[2][2 * j2 + 1] * bfhi(w2) + cw[3][2 * j2 + 1] * bfhi(w3);
            o[2 * j2] = silu_f(lo); o[2 * j2 + 1] = silu_f(hi);
        }
        u32x4 pk; pk.x = cvt_pk_bf16(o[0], o[1]); pk.y = cvt_pk_bf16(o[2], o[3]); pk.z = cvt_pk_bf16(o[4], o[5]); pk.w = cvt_pk_bf16(o[6], o[7]);
        if (m.kind == 2) *(GAS u32x4*)(XBC + (row0 + s) * CD + m.gch) = pk;
        *(LAS u32x4*)(img + (m.kind == 0 ? img_off<true>(s, chl) : img_off<false>(s, chl))) = pk;
    }
}
__device__ __forceinline__ void ssd_local_phase(Frame& F) {
    bf16_t* const XBC = (bf16_t*)(F.ws + WS_XBC); bf16_t* const ST = (bf16_t*)(F.ws + WS_HPREV); float* const CDEC = (float*)(F.ws + WS_CDEC); float* const EAQ = (float*)(F.ws + WS_EAQ);
    const int w = F.wave, lane = F.lane, q0 = 16 * w, hr = w >> 1, nh = w & 1;
    const LAS float* const acs = (const LAS float*)(F.lds + TAB_ACS); const LAS float* const dtl = (const LAS float*)(F.lds + TAB_DT); const LAS float* const sdec = (const LAS float*)(F.lds + TAB_SD);
    u32x4 raw[19]; float d0 = 0.f, d1 = 0.f;
    constexpr int NIT = BATCH * NCHUNK * NG;
    if (F.vcu < NIT) { const int it = F.vcu, g = it & 7, c = (it >> 3) & (NCHUNK - 1), b = it >> 7; const size_t row0 = (size_t)b * SEQ + (size_t)c * 128;
        ssd_conv_load(F, row0, b, c, g, raw); ssd_tables_load(F, row0, g, d0, d1); }
    for (int it = F.vcu; it < NIT; it += F.G) {
        const int g = it & 7, c = (it >> 3) & (NCHUNK - 1), b = it >> 7;
        const size_t row0 = (size_t)b * SEQ + (size_t)c * 128;
        asm volatile("s_waitcnt vmcnt(0)" ::: "memory");
        ssd_tables_compute(F, g, d0, d1);
        ssd_conv_store_local(F, row0, g, raw);
        __syncthreads();
        int lane_ = lane; asm volatile("" : "+v"(lane_));
        const int ql = lane_ & 15, gq = lane_ >> 4, qq = ql >> 2, pp = ql & 3;
        int cfo[4], bbo[4], xbo[2][4], sbo[4];
#pragma unroll
        for (int ks = 0; ks < 4; ++ks) { cfo[ks] = IMG_C + img_off<false>(q0 + ql, 4 * ks + gq); bbo[ks] = IMG_B + img_off<false>(ql, 4 * ks + gq); }
#pragma unroll
        for (int rr = 0; rr < 2; ++rr)
#pragma unroll
                for (int pf = 0; pf < 4; ++pf) xbo[rr][pf] = IMG_X + img_off<true>(4 * gq + qq, 8 * rr + 2 * pf + (pp >> 1)) + 8 * (pp & 1);
#pragma unroll
        for (int nf = 0; nf < 4; ++nf) { const int col = 64 * nh + 16 * nf + 4 * pp; sbo[nf] = IMG_B + img_off<false>(4 * gq + qq, col >> 3) + 2 * (col & 7); }
        {
            bf16x8 cf[4];
#pragma unroll
            for (int ks = 0; ks < 4; ++ks) cf[ks] = *(const LAS bf16x8*)(F.lds + cfo[ks]);
            const LAS float* const acs_l = acs + 16 * gq; const LAS float* const dtl_l = dtl + 16 * gq;
            f32x4 acc[4][4]; float aq[4];
#pragma unroll
            for (int r = 0; r < 4; ++r) { aq[r] = acs[(q0 + ql) * 4 + r];
#pragma unroll
                for (int pf = 0; pf < 4; ++pf) acc[r][pf] = (f32x4){0.f, 0.f, 0.f, 0.f}; }
#pragma unroll
            for (int ks = 0; ks < 4; ++ks) if (2 * ks <= w) {
                f32x4 cb[2];
#pragma unroll
                for (int hf = 0; hf < 2; ++hf) { cb[hf] = (f32x4){0.f, 0.f, 0.f, 0.f};
                    if (2 * ks + hf <= w) {
#pragma unroll
                        for (int kn = 0; kn < 4; ++kn) { const bf16x8 bfr = *(const LAS bf16x8*)(F.lds + bbo[kn] + 4096 * (2 * ks + hf)); cb[hf] = __builtin_amdgcn_mfma_f32_16x16x32_bf16(bfr, cf[kn], cb[hf], 0, 0, 0); } } }
#pragma unroll
                for (int r = 0; r < 4; ++r) {
                    const float Dh = *(const GAS float*)(F.in[I_DSKIP] + g * HPG + r);
                    float v[8];
#pragma unroll
                    for (int hf = 0; hf < 2; ++hf) { const int sf = 2 * ks + hf;
#pragma unroll
                        for (int rg = 0; rg < 4; ++rg) { const int sl = 4 * gq + rg;
                            float val = 0.f;
                            if (sf <= w) { const float as = acs_l[64 * sf + 4 * rg + r], d = dtl_l[64 * sf + 4 * rg + r];
                                val = cb[hf][rg] * __expf(aq[r] - as) * d;
                                if (sf == w) { if (sl > ql) val = 0.f; else if (sl == ql) val += Dh; } }
                            v[4 * hf + rg] = val; } }
                    u32x4 pk; pk.x = cvt_pk_bf16(v[0], v[1]); pk.y = cvt_pk_bf16(v[2], v[3]); pk.z = cvt_pk_bf16(v[4], v[5]); pk.w = cvt_pk_bf16(v[6], v[7]);
                    const bf16x8 wf = __builtin_bit_cast(bf16x8, pk);
#pragma unroll
                    for (int pf = 0; pf < 4; ++pf) {
                        const LAS unsigned char* const xb = F.lds + xbo[r & 1][pf] + (r >> 1) * 32768 + 8192 * ks;
                        const bf16x8 xf = tr_pair(xb, xb + 4096);
                        acc[r][pf] = __builtin_amdgcn_mfma_f32_16x16x32_bf16(xf, wf, acc[r][pf], 0, 0, 0); }
                }
            }
            LAS unsigned char* const stg = F.lds + IMG_C + w * 4096;
            bf16_t* const og = XBC + (row0 + q0 + (lane >> 4)) * CD + g * 256 + 8 * (lane & 15);
#pragma unroll
            for (int h = 0; h < 2; ++h) {
#pragma unroll
                for (int rr = 0; rr < 2; ++rr)
#pragma unroll
                    for (int pf = 0; pf < 4; ++pf) { const int r = 2 * h + rr, ch = 8 * rr + 2 * pf + (gq >> 1);
                        u32x2 o; o.x = cvt_pk_bf16(acc[r][pf][0], acc[r][pf][1]); o.y = cvt_pk_bf16(acc[r][pf][2], acc[r][pf][3]);
                        *(LAS u32x2*)(stg + ql * 256 + ((ch ^ ql) & 15) * 16 + (gq & 1) * 8) = o; }
                asm volatile("s_waitcnt lgkmcnt(0)" ::: "memory");
#pragma unroll
                for (int i = 0; i < 4; ++i) { const int row = 4 * i + (lane >> 4); const u32x4 v = *(const LAS u32x4*)(stg + row * 256 + (((lane & 15) ^ row) & 15) * 16); *(GAS u32x4*)(og + (size_t)(4 * i) * CD + 128 * h) = v; }
                asm volatile("s_waitcnt lgkmcnt(0)" ::: "memory");
            }
            if (gq == 0) *(GAS f32x4*)(EAQ + (row0 + q0 + ql) * 32 + g * HPG) = (f32x4){__expf(aq[0]), __expf(aq[1]), __expf(aq[2]), __expf(aq[3])};
        }
        asm volatile("" ::: "memory"); __builtin_amdgcn_sched_barrier(0);
        if (it + F.G < NIT) { const int it2 = it + F.G, g2 = it2 & 7, c2 = (it2 >> 3) & (NCHUNK - 1), b2 = it2 >> 7; const size_t row2 = (size_t)b2 * SEQ + (size_t)c2 * 128;
            ssd_conv_load(F, row2, b2, c2, g2, raw); ssd_tables_load(F, row2, g2, d0, d1); }
        {
            const int head = g * HPG + hr;
            bf16_t* const stp = ST + ((((size_t)b * NCHUNK + c) * NH + head) * HD) * DSTATE + 64 * nh;
            LAS unsigned char* const stg = F.lds + IMG_C + w * 4096;
#pragma unroll
            for (int ph2 = 0; ph2 < 2; ++ph2) {
                f32x4 acc[4][2];
#pragma unroll
                for (int i = 0; i < 4; ++i)
#pragma unroll
                    for (int j = 0; j < 2; ++j) acc[i][j] = (f32x4){0.f, 0.f, 0.f, 0.f};
#pragma unroll
                for (int ks = 0; ks < 4; ++ks) {
                    asm volatile("" ::: "memory");
                    float sd[8];
#pragma unroll
                    for (int j = 0; j < 8; ++j) sd[j] = sdec[(32 * ks + 16 * (j >> 2) + 4 * gq + (j & 3)) * 4 + hr];
                    bf16x8 af[4], xf[2];
#pragma unroll
                    for (int nf = 0; nf < 4; ++nf) { const LAS unsigned char* p = F.lds + sbo[nf] + 8192 * ks; af[nf] = tr_pair(p, p + 4096); }
#pragma unroll
                    for (int pf = 0; pf < 2; ++pf) { const LAS unsigned char* p = F.lds + xbo[hr & 1][2 * ph2 + pf] + (hr >> 1) * 32768 + 8192 * ks;
                        const u32x4 xr = __builtin_bit_cast(u32x4, tr_pair(p, p + 4096));
                        u32x4 xs; xs.x = cvt_pk_bf16(bflo(xr.x) * sd[0], bfhi(xr.x) * sd[1]); xs.y = cvt_pk_bf16(bflo(xr.y) * sd[2], bfhi(xr.y) * sd[3]);
                        xs.z = cvt_pk_bf16(bflo(xr.z) * sd[4], bfhi(xr.z) * sd[5]); xs.w = cvt_pk_bf16(bflo(xr.w) * sd[6], bfhi(xr.w) * sd[7]);
                        xf[pf] = __builtin_bit_cast(bf16x8, xs); }
#pragma unroll
                    for (int nf = 0; nf < 4; ++nf)
#pragma unroll
                        for (int pf = 0; pf < 2; ++pf) acc[nf][pf] = __builtin_amdgcn_mfma_f32_16x16x32_bf16(af[nf], xf[pf], acc[nf][pf], 0, 0, 0);
                }
#pragma unroll
                for (int pf = 0; pf < 2; ++pf)
#pragma unroll
                    for (int nf = 0; nf < 4; ++nf) { const int row = 16 * pf + ql, ch = 2 * nf + (gq >> 1);
                        u32x2 o; o.x = cvt_pk_bf16(acc[nf][pf][0], acc[nf][pf][1]); o.y = cvt_pk_bf16(acc[nf][pf][2], acc[nf][pf][3]);
                        *(LAS u32x2*)(stg + row * 128 + ((ch ^ row) & 7) * 16 + (gq & 1) * 8) = o; }
                asm volatile("s_waitcnt lgkmcnt(0)" ::: "memory");
#pragma unroll
                for (int i = 0; i < 4; ++i) { const int row = 8 * i + (lane_ >> 3), ch = lane_ & 7;
                    const u32x4 v = *(const LAS u32x4*)(stg + row * 128 + ((ch ^ row) & 7) * 16);
                    *(GAS u32x4*)(stp + (size_t)(32 * ph2 + row) * DSTATE + 8 * ch) = v; }
                asm volatile("s_waitcnt lgkmcnt(0)" ::: "memory");
            }
            if (F.tid < 4) *(GAS float*)(CDEC + ((size_t)b * NCHUNK + c) * NH + g * HPG + F.tid) = __expf(acs[127 * 4 + F.tid]);
        }
        __syncthreads();
    }
}
__device__ __forceinline__ void ssd_final_phase(Frame& F) {
    const bf16_t* const XBC = (const bf16_t*)(F.ws + WS_XBC); const bf16_t* const HP = (const bf16_t*)(F.ws + WS_HPREV); bf16_t* const ZY = (bf16_t*)(F.ws + WS_Z); const float* const EAQ = (const float*)(F.ws + WS_EAQ);
    const int w = F.wave, lane = F.lane, ql = lane & 15, gq = lane >> 4, q0 = 16 * w;
    int cfo[4], hbo[4];
#pragma unroll
    for (int ks = 0; ks < 4; ++ks) { cfo[ks] = IMG_C + img_off<false>(q0 + ql, 4 * ks + gq); hbo[ks] = img_off<false>(ql, 4 * ks + gq); }
    LAS unsigned char* const stg = F.lds + IMG_B + w * 4096;
    const int st_g = ((lane >> 4) * 256) + ((((lane & 15) ^ (lane >> 4))) * 16);
    u32x4 creg[4], hreg[8];
    constexpr int NIT = BATCH * NCHUNK * NG;
    auto loads = [&](int it) __attribute__((always_inline)) {
        const int g = it & 7, c = (it >> 3) & (NCHUNK - 1), b = it >> 7; const size_t row0 = (size_t)b * SEQ + (size_t)c * 128;
#pragma unroll
        for (int i = 0; i < 4; ++i) { const int e = F.tid + 512 * i; creg[i] = *(const GAS u32x4*)(XBC + (row0 + (e >> 4)) * CD + DI + NG * DSTATE + g * DSTATE + 8 * (e & 15)); }
        if (c > 0) { const u32x4* hsrc = (const u32x4*)(HP + ((((size_t)b * NCHUNK + c) * NH + g * HPG) * HD) * DSTATE) + F.tid;
#pragma unroll
            for (int i = 0; i < 8; ++i) hreg[i] = *(const GAS u32x4*)(hsrc + 512 * i); } };
    if (F.vcu < NIT) loads(F.vcu);
    for (int it = F.vcu; it < NIT; it += F.G) {
        const int g = it & 7, c = (it >> 3) & (NCHUNK - 1), b = it >> 7;
        const size_t row0 = (size_t)b * SEQ + (size_t)c * 128;
#pragma unroll
        for (int i = 0; i < 4; ++i) { const int e = F.tid + 512 * i; *(LAS u32x4*)(F.lds + IMG_C + img_off<false>(e >> 4, e & 15)) = creg[i]; }
        if (c > 0) {
#pragma unroll
            for (int i = 0; i < 8; ++i) { const int e = F.tid + 512 * i, hr_ = e >> 10, p_ = (e >> 4) & 63, ch_ = e & 15; *(LAS u32x4*)(F.lds + IMG_X + hr_ * 16384 + img_off<false>(p_, ch_)) = hreg[i]; } }
        __syncthreads();
        if (it + F.G < NIT) loads(it + F.G);
        bf16x8 cf[4];
#pragma unroll
        for (int ks = 0; ks < 4; ++ks) cf[ks] = *(const LAS bf16x8*)(F.lds + cfo[ks]);
        const f32x4 eaq = *(const GAS f32x4*)(EAQ + (row0 + q0 + ql) * 32 + g * HPG);
        const size_t grow = row0 + q0 + (lane >> 4);
        const bf16_t* const zg = ZY + grow * DI + g * 256 + 8 * (lane & 15); const bf16_t* const yg = XBC + grow * CD + g * 256 + 8 * (lane & 15);
        u32x4 zin[2][4], yin[2][4];
#pragma unroll
        for (int h = 0; h < 2; ++h)
#pragma unroll
            for (int i = 0; i < 4; ++i) { zin[h][i] = *(const GAS u32x4*)(zg + (size_t)(4 * i) * DI + 128 * h); yin[h][i] = *(const GAS u32x4*)(yg + (size_t)(4 * i) * CD + 128 * h); }
        f32x4 acc[4][4]; float ssum = 0.f;
#pragma unroll
        for (int h = 0; h < 2; ++h) {
            u32x2 zr[2][4], yr[2][4];
#pragma unroll
            for (int i = 0; i < 4; ++i) { const int row = 4 * i + (lane >> 4); *(LAS u32x4*)(stg + row * 256 + (((lane & 15) ^ row) & 15) * 16) = zin[h][i]; }
            asm volatile("s_waitcnt lgkmcnt(0)" ::: "memory");
#pragma unroll
            for (int rr = 0; rr < 2; ++rr)
#pragma unroll
                for (int pf = 0; pf < 4; ++pf) { const int ch = 8 * rr + 2 * pf + (gq >> 1); zr[rr][pf] = *(const LAS u32x2*)(stg + ql * 256 + ((ch ^ ql) & 15) * 16 + (gq & 1) * 8); }
            asm volatile("s_waitcnt lgkmcnt(0)" ::: "memory");
#pragma unroll
            for (int i = 0; i < 4; ++i) { const int row = 4 * i + (lane >> 4); *(LAS u32x4*)(stg + row * 256 + (((lane & 15) ^ row) & 15) * 16) = yin[h][i]; }
            asm volatile("s_waitcnt lgkmcnt(0)" ::: "memory");
#pragma unroll
            for (int rr = 0; rr < 2; ++rr)
#pragma unroll
                for (int pf = 0; pf < 4; ++pf) { const int ch = 8 * rr + 2 * pf + (gq >> 1); yr[rr][pf] = *(const LAS u32x2*)(stg + ql * 256 + ((ch ^ ql) & 15) * 16 + (gq & 1) * 8); }
            asm volatile("s_waitcnt lgkmcnt(0)" ::: "memory");
#pragma unroll
            for (int rr = 0; rr < 2; ++rr) { const int r = 2 * h + rr;
#pragma unroll
                for (int pf = 0; pf < 4; ++pf) { f32x4 yo = (f32x4){0.f, 0.f, 0.f, 0.f};
                    if (c > 0) {
#pragma unroll
                        for (int ks = 0; ks < 4; ++ks) { const bf16x8 hf_ = *(const LAS bf16x8*)(F.lds + IMG_X + r * 16384 + hbo[ks] + 4096 * pf); yo = __builtin_amdgcn_mfma_f32_16x16x32_bf16(hf_, cf[ks], yo, 0, 0, 0); } }
                    const u32x2 zz = zr[rr][pf], yy = yr[rr][pf];
                    const f32x4 y = ((f32x4){bflo(yy.x), bfhi(yy.x), bflo(yy.y), bfhi(yy.y)} + yo * eaq[r]) * (f32x4){bflo(zz.x), bfhi(zz.x), bflo(zz.y), bfhi(zz.y)};
                    acc[r][pf] = y; ssum += (y[0] * y[0] + y[1] * y[1]) + (y[2] * y[2] + y[3] * y[3]); } }
        }
        ssum += __shfl_xor(ssum, 16); ssum += __shfl_xor(ssum, 32);
        const float rsn = __builtin_amdgcn_rsqf(ssum * (1.0f / 256.0f) + EPS);
        bf16_t* const og = ZY + grow * DI + g * 256 + 8 * (lane & 15);
#pragma unroll
        for (int h = 0; h < 2; ++h) {
#pragma unroll
            for (int rr = 0; rr < 2; ++rr)
#pragma unroll
                for (int pf = 0; pf < 4; ++pf) { const int r = 2 * h + rr, ch = 8 * rr + 2 * pf + (gq >> 1);
                    u32x2 o; o.x = cvt_pk_bf16(acc[r][pf][0] * rsn, acc[r][pf][1] * rsn); o.y = cvt_pk_bf16(acc[r][pf][2] * rsn, acc[r][pf][3] * rsn);
                    *(LAS u32x2*)(stg + ql * 256 + ((ch ^ ql) & 15) * 16 + (gq & 1) * 8) = o; }
            asm volatile("s_waitcnt lgkmcnt(0)" ::: "memory");
#pragma unroll
            for (int i = 0; i < 4; ++i) { const int row = 4 * i + (lane >> 4); const u32x4 v = *(const LAS u32x4*)(stg + row * 256 + (((lane & 15) ^ row) & 15) * 16); *(GAS u32x4*)(og + (size_t)(4 * i) * DI + 128 * h) = v; }
            asm volatile("s_waitcnt lgkmcnt(0)" ::: "memory");
        }
        __syncthreads();
    }
}

__device__ __forceinline__ void ssd_seq_phase(Frame& F) {
    const int r = F.wave & 3, nh = F.wave >> 2, lane = F.lane, idx = r * 64 + lane;
    LAS float* const bc = (LAS float*)F.lds;
    LAS float* const lxs = bc + 2048;
    LAS float* const yp = bc + 4096;
    LAS float* const ldt = bc + 8192; LAS float* const ssq = bc + 8192 + 32;
    const bf16_t* const XBC = (const bf16_t*)(F.ws + WS_XBC); const bf16_t* const Zs = (const bf16_t*)(F.ws + WS_Z); bf16_t* const YN = (bf16_t*)(F.ws + WS_Z);
    const float* const DT = (const float*)(F.ws + WS_DT);
    const float* const convw = F.in[I_CONVW]; const float* const convb = F.in[I_CONVB];
    for (int it = F.vcu; it < DECB * NG; it += F.G) {
        const int b = it >> 3, g = it & 7, head = g * HPG + r;
        const size_t row0 = (size_t)MP + (size_t)b * DECS;
        const int xch = g * 256 + idx;
        {
            const int ch = (nh == 0) ? ((idx < 128) ? (DI + g * DSTATE + idx) : (DI + NG * DSTATE + g * DSTATE + (idx - 128))) : xch;
            float cw[4];
#pragma unroll
            for (int k = 0; k < 4; ++k) cw[k] = *(const GAS float*)(convw + (size_t)k * CD + ch);
            const float cbv = *(const GAS float*)(convb + ch);
            const float* cs = F.in[I_CONV] + (size_t)b * 3 * CD;
            float x3 = *(const GAS float*)(cs + ch), x2 = *(const GAS float*)(cs + CD + ch), x1 = *(const GAS float*)(cs + 2 * CD + ch);
            LAS float* const dst = (nh == 0) ? bc : lxs;
#pragma unroll
            for (int j = 0; j < 8; ++j) {
                const float xr = bf2f(*(const GAS bf16_t*)(XBC + (row0 + j) * CD + ch));
                const float cx = cbv + cw[0] * x3 + cw[1] * x2 + cw[2] * x1 + cw[3] * xr; x3 = x2; x2 = x1; x1 = xr;
                dst[j * 256 + idx] = silu_f(cx);
            }
            if (nh == 1 && lane < 8) ldt[lane * 4 + r] = *(const GAS float*)(DT + (row0 + lane) * 32 + head);
        }
        __syncthreads();
        {
            const float Ah = -__expf(*(const GAS float*)(F.in[I_ALOG] + head));
            const int pg = lane >> 4, nc = lane & 15;
            f32x4 h[16];
            const float* const hin = F.in[I_SSM] + (((size_t)b * NH + head) * HD + 16 * pg) * DSTATE + 64 * nh + 4 * nc;
#pragma unroll
            for (int i = 0; i < 16; ++i) h[i] = *(const GAS f32x4*)(hin + (size_t)i * DSTATE);
            for (int j = 0; j < 8; ++j) {
                const float dtv = ldt[j * 4 + r], dA = __expf(dtv * Ah);
                const f32x4 Bv = *(const LAS f32x4*)(bc + j * 256 + 64 * nh + 4 * nc), Cv = *(const LAS f32x4*)(bc + j * 256 + 128 + 64 * nh + 4 * nc);
                float part[16];
#pragma unroll
                for (int i4 = 0; i4 < 4; ++i4) { const f32x4 xs4 = *(const LAS f32x4*)(lxs + j * 256 + r * 64 + 16 * pg + 4 * i4);
#pragma unroll
                    for (int k = 0; k < 4; ++k) { const int i = 4 * i4 + k; const float dx = dtv * xs4[k];
                        h[i] = h[i] * dA + Bv * dx;
                        part[i] = (Cv.x * h[i].x + Cv.y * h[i].y) + (Cv.z * h[i].z + Cv.w * h[i].w); } }
#pragma unroll
                for (int i = 0; i < 8; ++i) { const bool up = (nc & 8) != 0; const float keep = up ? part[i + 8] : part[i], send = up ? part[i] : part[i + 8]; part[i] = keep + __shfl_xor(send, 8); }
#pragma unroll
                for (int i = 0; i < 4; ++i) { const bool up = (nc & 4) != 0; const float keep = up ? part[i + 4] : part[i], send = up ? part[i] : part[i + 4]; part[i] = keep + __shfl_xor(send, 4); }
#pragma unroll
                for (int i = 0; i < 2; ++i) { const bool up = (nc & 2) != 0; const float keep = up ? part[i + 2] : part[i], send = up ? part[i] : part[i + 2]; part[i] = keep + __shfl_xor(send, 2); }
                { const bool up = (nc & 1) != 0; const float keep = up ? part[1] : part[0], send = up ? part[0] : part[1]; part[0] = keep + __shfl_xor(send, 1); }
                yp[(j * 2 + nh) * 256 + r * 64 + 16 * pg + nc] = part[0];
            }
            float* const hout = F.out + O_SSM_S + (((size_t)b * NH + head) * HD + 16 * pg) * DSTATE + 64 * nh + 4 * nc;
#pragma unroll
            for (int i = 0; i < 16; ++i) *(GAS f32x4*)(hout + (size_t)i * DSTATE) = h[i];
        }
        __syncthreads();
        float ygv[4];
        {
            const float Dh = *(const GAS float*)(F.in[I_DSKIP] + head);
#pragma unroll
            for (int jj = 0; jj < 4; ++jj) { const int j = 4 * nh + jj;
                const float y = (yp[(j * 2) * 256 + idx] + yp[(j * 2 + 1) * 256 + idx]) + Dh * lxs[j * 256 + idx];
                ygv[jj] = y * bf2f(*(const GAS bf16_t*)(Zs + (row0 + j) * DI + xch));
                const float ss = wave_sum(ygv[jj] * ygv[jj]);
                if (lane == 0) ssq[j * 4 + r] = ss; }
        }
        __syncthreads();
#pragma unroll
        for (int jj = 0; jj < 4; ++jj) { const int j = 4 * nh + jj;
            const f32x4 s4 = *(const LAS f32x4*)(ssq + j * 4);
            const float rsn = __builtin_amdgcn_rsqf(((s4.x + s4.y) + (s4.z + s4.w)) * (1.0f / 256.0f) + EPS);
            *(GAS bf16_t*)(YN + (row0 + j) * DI + xch) = (bf16_t)f2bf(ygv[jj] * rsn); }
        __syncthreads();
    }
}
template <int W> __device__ __forceinline__ void pool_run(const bf16_t* V, bf16_t* PO, int run, int cv) {
    const int row0 = run * 16, t0 = row0 & (SEQ - 1);
    u32x4 raw[16 + W - 1];
#pragma unroll
    for (int e = 0; e < 16 + W - 1; ++e) {
        const int dt_ = e - (W - 1);
        if (t0 + dt_ >= 0) raw[e] = *(const GAS u32x4*)(V + (size_t)(row0 + dt_) * PD + cv); else raw[e] = (u32x4){0u, 0u, 0u, 0u};
    }
    f32x4 s0 = (f32x4){0.f, 0.f, 0.f, 0.f}, s1 = s0;
#pragma unroll
    for (int e = 0; e < W - 1; ++e) { f32x4 x0, x1; pg8::unpack8(raw[e], x0, x1); s0 += x0; s1 += x1; }
#pragma unroll
    for (int i = 0; i < 16; ++i) {
        f32x4 c0, c1; pg8::unpack8(raw[i + W - 1], c0, c1);
        s0 += c0; s1 += c1;
        const int t = t0 + i; const float ic = 1.0f / (float)((t + 1 < W) ? t + 1 : W);
        const f32x4 o0 = s0 * ic - c0, o1 = s1 * ic - c1;
        u32x4 o; o.x = pk2(o0.x, o0.y); o.y = pk2(o0.z, o0.w); o.z = pk2(o1.x, o1.y); o.w = pk2(o1.z, o1.w);
        *(GAS u32x4*)(PO + (size_t)(row0 + i) * PD + cv) = o;
        f32x4 x0, x1; pg8::unpack8(raw[i], x0, x1); s0 -= x0; s1 -= x1;
    }
}
template <int W> __device__ __forceinline__ void pool_run_s(const bf16_t* V, bf16_t* PO, const float* sp, int b, int cv) {
    const size_t row0 = (size_t)MP + (size_t)b * DECS;
    f32x4 a0[8 + W - 1], a1[8 + W - 1];
#pragma unroll
    for (int e = 0; e < 8 + W - 1; ++e) { const int t = e - (W - 1);
        if (t >= 0) pg8::unpack8(*(const GAS u32x4*)(V + (row0 + t) * PD + cv), a0[e], a1[e]);
        else { const float* p = sp + ((size_t)b * PBUF + (PBUF + t)) * PD + cv; a0[e] = *(const GAS f32x4*)p; a1[e] = *(const GAS f32x4*)(p + 4); } }
    f32x4 s0 = (f32x4){0.f, 0.f, 0.f, 0.f}, s1 = s0;
#pragma unroll
    for (int e = 0; e < W - 1; ++e) { s0 += a0[e]; s1 += a1[e]; }
    const float ic = 1.0f / (float)W;
#pragma unroll
    for (int i = 0; i < 8; ++i) {
        s0 += a0[i + W - 1]; s1 += a1[i + W - 1];
        const f32x4 o0 = s0 * ic - a0[i + W - 1], o1 = s1 * ic - a1[i + W - 1];
        u32x4 o; o.x = pk2(o0.x, o0.y); o.y = pk2(o0.z, o0.w); o.z = pk2(o1.x, o1.y); o.w = pk2(o1.z, o1.w);
        *(GAS u32x4*)(PO + (row0 + i) * PD + cv) = o;
        s0 -= a0[i]; s1 -= a1[i];
    }
}
__device__ __forceinline__ void pool_phase(Frame& F) {
    const bf16_t* const V = (const bf16_t*)(F.ws + WS_V); bf16_t* const PO = (bf16_t*)(F.out + O_Y);
    const float* const sp = F.in[I_POOL];
    const int gt = F.vcu * NTHREADS + F.tid, NT = F.G * NTHREADS;
    for (int e = gt; e < (MP / 16) * 128; e += NT) {
        const int c32 = e & 31, rl = (e >> 5) & 1, grp = (e >> 6) & 3, run = (e >> 8) * 2 + rl, cv = (grp * 32 + c32) * 8;
        if (grp == 0) pool_run<2>(V, PO, run, cv); else if (grp == 1) pool_run<4>(V, PO, run, cv); else if (grp == 2) pool_run<8>(V, PO, run, cv); else pool_run<16>(V, PO, run, cv);
    }
    for (int e = gt; e < (MS / 8) * 128; e += NT) {
        const int c32 = e & 31, grp = (e >> 5) & 3, b = e >> 7, cv = (grp * 32 + c32) * 8;
        if (grp == 0) pool_run_s<2>(V, PO, sp, b, cv); else if (grp == 1) pool_run_s<4>(V, PO, sp, b, cv); else if (grp == 2) pool_run_s<8>(V, PO, sp, b, cv); else pool_run_s<16>(V, PO, sp, b, cv);
    }
    float* const ops = F.out + O_POOL_S;
    for (int e = gt; e < DECB * 7 * (PD / 4); e += NT) {
        const int c4 = e & 255, i = (e >> 8) % 7, b = (e >> 8) / 7;
        *(GAS f32x4*)(ops + ((size_t)b * PBUF + i) * PD + c4 * 4) = *(const GAS f32x4*)(sp + ((size_t)b * PBUF + 8 + i) * PD + c4 * 4);
    }
}
__device__ __forceinline__ void final_phase(Frame& F) {
    const int gw = F.vcu * NWAVES + F.wave, NGW = F.G * NWAVES, lane = F.lane;
    const float* const st = (const float*)(F.ws + WS_STATS_A); const float* const gf = F.in[I_NFINAL];
    f32x4 gv[4];
#pragma unroll
    for (int j = 0; j < 4; ++j) gv[j] = *((const GAS f32x4*)gf + lane + 64 * j);
    const bf16_t* const h4 = (const bf16_t*)(F.ws + WS_ACT);
    for (int m = gw; m < M; m += NGW) {
        const GAS f32x4* sp = (const GAS f32x4*)(st + (size_t)m * 16);
        const f32x4 a = sp[0], b = sp[1], c = sp[2], d = sp[3]; const f32x4 s = (a + b) + (c + d);
        const float rs = __builtin_amdgcn_rsqf(((s[0] + s[1]) + (s[2] + s[3])) * (1.0f / 1024.0f) + EPS);
        const GAS u32x2* hr = (const GAS u32x2*)(h4 + (size_t)m * DM) + lane;
        GAS f32x4* yr = (GAS f32x4*)(F.out + (size_t)m * DM) + lane;
#pragma unroll
        for (int j = 0; j < 4; ++j) { const u32x2 w = hr[64 * j]; yr[64 * j] = (f32x4){bflo(w.x), bfhi(w.x), bflo(w.y), bfhi(w.y)} * rs * gv[j]; }
    }
}

constexpr int NPHASES = 13;
struct Args { const float* in[30]; float* out; unsigned char* ws; int ph_lo, ph_hi, li, pad; };
__global__ void __launch_bounds__(NTHREADS, 2) mk_fwd(Args args) {
    extern __shared__ __attribute__((aligned(16))) unsigned char lds[];
    Frame F;
    F.lds = (LAS unsigned char*)lds;
    F.MISC = (volatile LAS unsigned*)(F.lds + MISC_OFF);
    F.tid = threadIdx.x; F.lane = F.tid & 63; F.wave = __builtin_amdgcn_readfirstlane(F.tid >> 6);
    F.G = gridDim.x; { const int bx = blockIdx.x; F.vcu = (F.G % 8 == 0) ? (bx % 8) * (F.G / 8) + bx / 8 : bx; }
    F.ws = args.ws; F.out = args.out; F.ctl = (gu32*)(args.ws + WS_CTL);
#pragma unroll
    for (int i = 0; i < 30; ++i) F.in[i] = args.in[i];
    for (int u = F.tid; u < (LDS_BYTES - LDSCTL_OFF) / 4; u += NTHREADS) ((LAS unsigned*)(F.lds + LDSCTL_OFF))[u] = 0u;
    __syncthreads();
    const int lo = args.ph_lo, hi = args.ph_hi;
    XcdBarrier bar; bar.bar = (unsigned*)(F.ctl + CW_BAR); bar.x = 0; bar.st = nullptr;
    if (hi - lo > 1) bar = xcd_barrier_post((unsigned*)(F.ctl + CW_BAR), F.MISC + 8);
#ifndef PHMASK
#define PHMASK 0x1fff
#endif
#define IN(k) (((PHMASK >> (k)) & 1) && lo <= (k) && (k) < hi)
#define SEAM(k) do { if (IN(k) && IN((k) + 1)) xcd_barrier(bar); } while (0)
#define PH_BEGIN(k) if (IN(k)) { auto body_ = [&]() __attribute__((always_inline))
#define PH_END(k) ; body_(); if ((REP_MASK >> (k)) & 1) { xcd_barrier(bar); body_(); } } SEAM(k);

    bf16_t* const XB = (bf16_t*)(F.ws + WS_XB); bf16_t* const HB = (bf16_t*)(F.ws + WS_HB); bf16_t* const ACT = (bf16_t*)(F.ws + WS_ACT);
    bf16_t* const Zb = (bf16_t*)(F.ws + WS_Z); bf16_t* const XBCb = (bf16_t*)(F.ws + WS_XBC); bf16_t* const Vb = (bf16_t*)(F.ws + WS_V); bf16_t* const GATES = (bf16_t*)(F.ws + WS_GATES);
    bf16_t* const POOLED = (bf16_t*)(F.out + O_Y); bf16_t* const MERGED = (bf16_t*)(F.ws + WS_MERGED); bf16_t* const Qb = (bf16_t*)(F.ws + WS_Q); bf16_t* const PB = (bf16_t*)(F.ws + WS_PB);
    float* const T1 = (float*)(F.ws + WS_T1); float* const stA = (float*)(F.ws + WS_STATS_A); float* const stB = (float*)(F.ws + WS_STATS_B); float* const DTb = (float*)(F.ws + WS_DT);
    float* const H = F.out + O_Y;
    pg8::StaticOrder S;

    PH_BEGIN(0) { p0_prologue(F); } PH_END(0)
    PH_BEGIN(1) {
        pg8::Gemm g{XB, (const bf16_t*)(F.ws + WS_WGU1), M, 2 * DFF, DM, DM, 0}; S.init(M, 2 * DFF, F.G, (int)blockIdx.x);
        pg8::Epi E{}; E.kind = pg8::EK_GU; E.stats_in = stA; E.obf = ACT; E.ldo = DFF;
        const int u1 = 1 + (int)blockIdx.x % 5; S.lim = min(S.nwg, u1 * F.G);
#pragma nounroll
        for (int part = 0; part < 2; ++part) {
            pg8::gemm_phase(F.lds, g, S, E);
            if (part == 0) { deferred_transposes<1>(F); S.c += u1 * F.G; S.lim = S.nwg; }
        }
        pg8::Gemm g2{(const bf16_t*)(F.ws + WS_WPOT), (const bf16_t*)(F.ws + WS_WGRP), DM, DM, 256, DM, 256}; S.init_tail(DM, DM, F.G, (int)blockIdx.x);
        pg8::Epi E2{}; E2.kind = pg8::EK_BF16; E2.obf = (bf16_t*)(F.ws + WS_W2); E2.ldo = DM;
        pg8::gemm_phase(F.lds, g2, S, E2);
    } PH_END(1)
    PH_BEGIN(2) {
        pg8::Gemm g{ACT, (const bf16_t*)(F.ws + WS_WD1), M, DM, DFF, DFF, 0}; S.init(MP, DM, F.G, (int)blockIdx.x);
        pg8::Epi E{}; E.kind = pg8::EK_RES; E.coef = 0.5f; E.res_p = F.in[I_XP]; E.res_s = F.in[I_XS]; E.obf = HB; E.stats_out = stB;
        pg8::gemm_phase(F.lds, g, S, E);
        pg8::gemm_small(F.lds, g, E, MP, MS, F.G, (int)blockIdx.x);
    } PH_END(2)
    PH_BEGIN(3) {
        pg8::Gemm g{HB, (const bf16_t*)(F.ws + WS_WIN), M, NIN, DM, DM, 0}; S.init(M, NIN, F.G, (int)blockIdx.x);
        pg8::Epi E{}; E.kind = pg8::EK_WIN; E.stats_in = stB; E.Z = Zb; E.XBC = XBCb; E.V = Vb; E.GATES = GATES; E.HALO = (bf16_t*)(F.ws + WS_HALO); E.DT = DTb; E.dt_bias = F.in[I_DTB];
        E.conv_p = F.out + O_CONV_P; E.conv_s = F.out + O_CONV_S; E.pool_p = F.out + O_POOL_P; E.pool_s = F.out + O_POOL_S;
        const int u1 = 1 + (int)blockIdx.x % 9; S.lim = min(S.nwg, u1 * F.G);
#pragma nounroll
        for (int part = 0; part < 2; ++part) {
            pg8::gemm_phase(F.lds, g, S, E);
            if (part == 0) { deferred_transposes<3>(F); S.c += u1 * F.G; S.lim = S.nwg; }
        }
    } PH_END(3)
    PH_BEGIN(4) { ssd_local_phase(F); pool_phase(F); } PH_END(4)
    PH_BEGIN(5) { ssd_scan_phase(F);

        pg8::Gemm g{PB, (const bf16_t*)(F.ws + WS_WPLE), M, DM, PLE, PLE, 0}; S.init(MP, DM, F.G, (int)blockIdx.x);
        pg8::Epi E{}; E.kind = pg8::EK_BF16; E.obf = Qb; E.ldo = DM;
        pg8::gemm_phase(F.lds, g, S, E);
        pg8::gemm_small(F.lds, g, E, MP, MS, F.G, (int)blockIdx.x);
        } PH_END(5)
    PH_BEGIN(6) { ssd_final_phase(F); ssd_seq_phase(F); } PH_END(6)
    PH_BEGIN(7) {
        pg8::Gemm2 g{Zb, (const bf16_t*)(F.ws + WS_WSSO), POOLED, (const bf16_t*)(F.ws + WS_W2), DI, DI, DM, DM, DM}; S.init(MP, DM, F.G, (int)blockIdx.x);
        pg8::gemm_phase2(F.lds, g, S, GATES, MERGED);
        pg8::gemm_small2(F.lds, g, GATES, MERGED, MP, MS, F.G, (int)blockIdx.x);
    } PH_END(7)
    PH_BEGIN(8) {
        pg8::Gemm g{MERGED, (const bf16_t*)(F.ws + WS_WO), M, DM, DM, DM, 0}; S.init(MP, DM, F.G, (int)blockIdx.x);
        pg8::Epi E{}; E.kind = pg8::EK_RES; E.coef = 1.0f; E.res_bf = HB; E.obf = HB; E.stats_out = stA;
        pg8::gemm_phase(F.lds, g, S, E);
        pg8::gemm_small(F.lds, g, E, MP, MS, F.G, (int)blockIdx.x);
    } PH_END(8)
    PH_BEGIN(9) {
        pg8::Gemm g{HB, (const bf16_t*)(F.ws + WS_WGU2), M, 2 * DFF, DM, DM, 0}; S.init(M, 2 * DFF, F.G, (int)blockIdx.x);
        pg8::Epi E{}; E.kind = pg8::EK_GU; E.stats_in = stA; E.obf = ACT; E.ldo = DFF;
        pg8::gemm_phase(F.lds, g, S, E);
    } PH_END(9)
    PH_BEGIN(10) {
        pg8::Gemm g{ACT, (const bf16_t*)(F.ws + WS_WD2), M, DM, DFF, DFF, 0}; S.init(MP, DM, F.G, (int)blockIdx.x);
        pg8::Epi E{}; E.kind = pg8::EK_RES; E.coef = 0.5f; E.res_bf = HB; E.obf = HB; E.stats_out = stB;
        pg8::gemm_phase(F.lds, g, S, E);
        pg8::gemm_small(F.lds, g, E, MP, MS, F.G, (int)blockIdx.x);
    } PH_END(10)
    PH_BEGIN(11) {
        pg8::Gemm g{HB, (const bf16_t*)(F.ws + WS_WPG), M, DM, DM, DM, 0}; S.init(MP, DM, F.G, (int)blockIdx.x);
        pg8::Epi E{}; E.kind = pg8::EK_PLE; E.stats_in = stB; E.q = Qb; E.res_bf = HB; E.obf = ACT; E.stats_out = stA;
        pg8::gemm_phase(F.lds, g, S, E);
        pg8::gemm_small(F.lds, g, E, MP, MS, F.G, (int)blockIdx.x);
    } PH_END(11)
    PH_BEGIN(12) { final_phase(F); } PH_END(12)
#undef IN
#undef SEAM
#undef PH_BEGIN
#undef PH_END
}

extern "C" void kernel_launch(void* const* d_in, const int* in_sizes, int n_in, void* d_out, int out_size, void* d_ws, size_t ws_size, hipStream_t stream) {
    static int grid = 0;
    if (grid == 0) {
        if (n_in != 30 || in_sizes[0] != MP * DM || (size_t)out_size != O_END || ws_size < WS_END) {
            fprintf(stderr, "kernel_launch: shape mismatch: n_in %d in0 %d out %d ws %zu (need %zu)\n", n_in, n_in > 0 ? in_sizes[0] : -1, out_size, ws_size, (size_t)WS_END); grid = -1; return; }
        int dev = 0, cus = 0, per_cu = 0;
        if (hipGetDevice(&dev) != hipSuccess || hipDeviceGetAttribute(&cus, hipDeviceAttributeMultiprocessorCount, dev) != hipSuccess) { grid = -1; return; }
        if (hipFuncSetAttribute((const void*)mk_fwd, hipFuncAttributeMaxDynamicSharedMemorySize, LDS_BYTES) != hipSuccess) { fprintf(stderr, "kernel_launch: hipFuncSetAttribute failed\n"); grid = -1; return; }
        if (hipOccupancyMaxActiveBlocksPerMultiprocessor(&per_cu, (const void*)mk_fwd, NTHREADS, LDS_BYTES) != hipSuccess || per_cu < 1)
            fprintf(stderr, "kernel_launch: occupancy query reports %d workgroups per CU\n", per_cu);
        (void)hipGetLastError();
        grid = cus;
    }
    if (grid < 0) return;
    if (hipMemsetAsync((char*)d_ws + WS_CTL, 0, CTL_ZERO_BYTES, stream) != hipSuccess) { fprintf(stderr, "kernel_launch: memset failed\n"); return; }
    Args a{};
    for (int i = 0; i < 30; ++i) a.in[i] = (const float*)d_in[i];
    a.out = (float*)d_out; a.ws = (unsigned char*)d_ws;
#if MK_MULTI_LAUNCH
    for (int ph = 0; ph < NPHASES; ++ph) { a.ph_lo = ph; a.ph_hi = ph + 1; a.li = ph;
        hipLaunchKernelGGL(mk_fwd, dim3(grid), dim3(NTHREADS), LDS_BYTES, stream, a); }
#else
    a.ph_lo = 0; a.ph_hi = NPHASES; a.li = 0;
    hipLaunchKernelGGL(mk_fwd, dim3(grid), dim3(NTHREADS), LDS_BYTES, stream, a);
#endif
}
```

```cpp
#include <hip/hip_runtime.h>
#include <cstdio>
#include <cstdint>

#define REP_MASK 0x0
#ifndef MK_MULTI_LAUNCH
#define MK_MULTI_LAUNCH 0
#endif

#define GAS __attribute__((address_space(1)))
#define LAS __attribute__((address_space(3)))
typedef unsigned short bf16_t;
typedef short bf16x8 __attribute__((ext_vector_type(8)));
typedef float f32x4 __attribute__((ext_vector_type(4)));
typedef float f32x2 __attribute__((ext_vector_type(2)));
typedef unsigned u32x4 __attribute__((ext_vector_type(4)));
typedef unsigned u32x2 __attribute__((ext_vector_type(2)));
typedef GAS unsigned gu32;

constexpr int DM = 1024, BATCH = 8, SEQ = 2048, DECB = 128, DECS = 8;
constexpr int MP = BATCH * SEQ, MS = DECB * DECS, M = MP + MS;
constexpr int DI = 2048, HD = 64, NH = 32, NG = 8, HPG = 4, DSTATE = 128, CD = 4096;
constexpr int PD = 1024, PBUF = 15, DFF = 2816, PLE = 256;
constexpr int IN_DIM = 9248, NIN = 9472;
constexpr float EPS = 1e-6f;
constexpr int NWAVES = 8, NTHREADS = 512;

constexpr size_t MiB = 1u << 20;
constexpr size_t WS_CTL = 0, CTL_ZERO_BYTES = 32768;
constexpr size_t WS_STATS_A = 2 * MiB, WS_STATS_B = 4 * MiB, WS_DT = 6 * MiB, WS_CDEC = 9 * MiB;
constexpr size_t WS_WGU1 = 10 * MiB, WS_WD1 = 21 * MiB, WS_WIN = 27 * MiB, WS_WSSO = 46 * MiB, WS_W2 = 50 * MiB, WS_WO = 52 * MiB,
                 WS_WGU2 = 54 * MiB, WS_WD2 = 65 * MiB, WS_WPG = 71 * MiB, WS_WPLE = 73 * MiB, WS_PB = 74 * MiB, WS_WPOT = 480 * MiB, WS_WGRP = 483 * MiB;
constexpr size_t WS_Z = 84 * MiB, WS_XBC = 152 * MiB, WS_V = 288 * MiB, WS_GATES = 322 * MiB, WS_HB = 390 * MiB, WS_HPREV = 424 * MiB, WS_HALO = 488 * MiB, WS_EAQ = 492 * MiB, WS_END = 495 * MiB;
constexpr size_t WS_ACT = WS_XBC, WS_T1 = WS_XBC, WS_MERGED = 220 * MiB, WS_Q = WS_V, WS_XB = WS_HB;
static_assert(WS_STATS_A + (size_t)M * 16 * 4 <= WS_STATS_B && WS_STATS_B + (size_t)M * 16 * 4 <= WS_DT && WS_DT + (size_t)M * 32 * 4 <= WS_WGU1, "ws map (small)");
static_assert(WS_WGU1 + (size_t)2 * DFF * DM * 2 <= WS_WD1 && WS_WD1 + (size_t)DM * DFF * 2 <= WS_WIN && WS_WIN + (size_t)NIN * DM * 2 <= WS_WSSO && WS_WSSO + (size_t)DM * DI * 2 <= WS_W2, "ws map (w1)");
static_assert(WS_WGU2 + (size_t)2 * DFF * DM * 2 <= WS_WD2 && WS_WD2 + (size_t)DM * DFF * 2 <= WS_WPG && WS_WPLE + (size_t)DM * PLE * 2 <= WS_PB && WS_PB + (size_t)M * PLE * 2 <= WS_Z, "ws map (w2)");
static_assert(WS_Z + (size_t)M * DI * 2 <= WS_XBC && WS_XBC + (size_t)M * CD * 2 <= WS_V && WS_V + (size_t)M * PD * 2 <= WS_GATES && WS_GATES + (size_t)M * 2 * DM * 2 <= WS_HB &&
              WS_HB + (size_t)M * DM * 2 <= WS_HPREV && WS_HPREV + (size_t)BATCH * 16 * NH * HD * DSTATE * 2 <= WS_END, "ws map (act)");
static_assert(WS_ACT + (size_t)M * DFF * 2 <= WS_V && WS_T1 + (size_t)M * DM * 4 <= WS_MERGED && WS_MERGED + (size_t)M * DM * 2 <= WS_V, "ws overlays");
constexpr int CW_BAR = 4096;

constexpr size_t O_Y = 0, O_SSM_P = (size_t)M * DM, O_CONV_P = O_SSM_P + (size_t)BATCH * NH * HD * DSTATE, O_POOL_P = O_CONV_P + (size_t)BATCH * 3 * CD,
                 O_SSM_S = O_POOL_P + (size_t)BATCH * PBUF * PD, O_CONV_S = O_SSM_S + (size_t)DECB * NH * HD * DSTATE, O_POOL_S = O_CONV_S + (size_t)DECB * 3 * CD,
                 O_END = O_POOL_S + (size_t)DECB * PBUF * PD;

constexpr int RING_BYTES = 131072, LDSCTL_OFF = RING_BYTES, MISC_OFF = LDSCTL_OFF + 320, LDS_BYTES = 147456;

#define RLX_AGENT __ATOMIC_RELAXED, __HIP_MEMORY_SCOPE_AGENT
#define LDS_WAIT() asm volatile("s_waitcnt lgkmcnt(0)" ::: "memory")
#define VM_WAIT() asm volatile("s_waitcnt vmcnt(0)" ::: "memory")

__device__ __forceinline__ unsigned f2bf(float f) { unsigned u = __builtin_bit_cast(unsigned, f); return (u + 0x7fffu + ((u >> 16) & 1u)) >> 16; }
__device__ __forceinline__ unsigned cvt_pk_bf16(float lo, float hi);
__device__ __forceinline__ unsigned pk2(float lo, float hi) { return cvt_pk_bf16(lo, hi); }
__device__ __forceinline__ float bf2f(unsigned b) { return __builtin_bit_cast(float, b << 16); }
__device__ __forceinline__ float bflo(unsigned w) { return __builtin_bit_cast(float, w << 16); }
__device__ __forceinline__ float bfhi(unsigned w) { return __builtin_bit_cast(float, w & 0xffff0000u); }
typedef __bf16 bf16x2_t __attribute__((ext_vector_type(2)));
__device__ __forceinline__ unsigned cvt_pk_bf16(float lo, float hi) { const bf16x2_t v = {(__bf16)lo, (__bf16)hi}; return __builtin_bit_cast(unsigned, v); }
__device__ __forceinline__ float sigm_f(float x) { return __builtin_amdgcn_rcpf(1.0f + __expf(-x)); }
__device__ __forceinline__ float silu_f(float x) { return x * __builtin_amdgcn_rcpf(1.0f + __expf(-x)); }
__device__ __forceinline__ float wave_sum(float v) {
#pragma unroll
    for (int o = 1; o < 64; o <<= 1) v += __shfl_xor(v, o);
    return v;
}

struct Frame {
    LAS unsigned char* lds;
    volatile LAS unsigned* MISC;
    gu32* ctl;
    int tid, lane, wave, vcu, G;
    unsigned char* ws;
    float* out;
    const float* in[30];
};
enum { I_XP = 0, I_XS, I_SSM, I_CONV, I_POOL, I_PP, I_PS, I_NFFN1, I_WGU1, I_WD1, I_NMIX, I_WIN, I_CONVW, I_CONVB, I_DTB, I_ALOG, I_DSKIP, I_NSSD, I_WSSO, I_WPGRP, I_PSCALE,
       I_WPOUT, I_WO, I_NFFN2, I_WGU2, I_WD2, I_NPLE, I_WPG, I_WPLE, I_NFINAL };

namespace pg8 {
constexpr int BM = 256, BK = 64, HALF = 128, HTB = HALF * BK * 2, STAGE_BYTES = 8 * HTB, NXCD = 8, WGM = 4;
__host__ __device__ __forceinline__ int lds_byte(int r, int c) { const int st = (r >> 4) * 2 + (c >> 5), rr = r & 15, cc = c & 31, ob = rr * 64 + cc * 2; return st * 1024 + (ob ^ (((ob >> 9) & 1) << 5)); }
__host__ __device__ __forceinline__ void stage_rc(int b, int& R, int& C) { const int st = b / 1024, sb = b % 1024, swz = sb ^ (((sb >> 9) & 1) << 5); R = (st >> 1) * 16 + swz / 64; C = (st & 1) * 32 + (swz % 64) / 2; }
__host__ __device__ __forceinline__ int perm32(int rho) { const int n = rho >> 4, i = rho & 15; return 8 * (i >> 2) + 4 * n + (i & 3); }
struct Unit { int pm, pn; };
struct Gemm { const bf16_t* A; const bf16_t* Bt; int M, N, K; int lda; int a_pn_step; };
struct StaticOrder {
    int nM, nN, nwg, G, c, lim;
    __host__ __device__ void init(int M_, int N_, int G_, int c_) { nM = M_ / BM; nN = N_ / BM; nwg = nM * nN; G = G_; c = c_; lim = nwg; }
    __host__ __device__ void init_tail(int M_, int N_, int G_, int c_) { init(M_, N_, G_, (G_ - 1) - c_); }
    __host__ __device__ bool next(int i, Unit& u) const {
        const long L = (long)i * G + c; if (L >= lim) return false;
        int wgid = (int)L; { const int q = nwg / NXCD, r = nwg % NXCD, xcd = wgid % NXCD, off = wgid / NXCD; wgid = (xcd < r ? xcd * (q + 1) : r * (q + 1) + (xcd - r) * q) + off; }
        const int nig = WGM * nN, gid = wgid / nig, fm = gid * WGM, gsz = (nM - fm) < WGM ? (nM - fm) : WGM;
        u.pm = fm + ((wgid % nig) % gsz); u.pn = (wgid % nig) / gsz; return true;
    }
};

enum EpiKind { EK_GU = 1, EK_RES = 2, EK_WIN = 3, EK_T1 = 4, EK_MERGE = 5, EK_BF16 = 6, EK_PLE = 7 };
struct Epi {
    const float* stats_in;
    float* stats_out;
    bf16_t* obf;
    float* of32;
    const float* res_p; const float* res_s;
    const bf16_t* res_bf;
    const bf16_t* gates;
    const bf16_t* q;
    bf16_t *Z, *XBC, *V, *GATES, *HALO; float* DT; const float* dt_bias; float *conv_p, *conv_s, *pool_p, *pool_s;
    int kind; int ldo; float coef; int pad;
};

__device__ __forceinline__ u32x4 pack8(const f32x4 a, const f32x4 b) { u32x4 w; w.x = cvt_pk_bf16(a[0], a[1]); w.y = cvt_pk_bf16(a[2], a[3]); w.z = cvt_pk_bf16(b[0], b[1]); w.w = cvt_pk_bf16(b[2], b[3]); return w; }
__device__ __forceinline__ void unpack8(const u32x4 w, f32x4& a, f32x4& b) { a = (f32x4){bflo(w.x), bfhi(w.x), bflo(w.y), bfhi(w.y)}; b = (f32x4){bflo(w.z), bfhi(w.z), bflo(w.w), bfhi(w.w)}; }

__device__ __forceinline__ float row_rs(const float* stats, int row) {
    if (!stats) return 1.0f;
    const GAS f32x4* sp = (const GAS f32x4*)(stats + (size_t)row * 16);
    const f32x4 a = sp[0], b = sp[1], c = sp[2], d = sp[3]; const f32x4 s = (a + b) + (c + d);
    return __builtin_amdgcn_rsqf(((s[0] + s[1]) + (s[2] + s[3])) * (1.0f / 1024.0f) + EPS);
}
__device__ __forceinline__ float softplus_f(float x) { const float e = __expf(-fabsf(x)); const float l = (e < 0.01f) ? e * (1.0f - e * (0.5f - e * (1.0f / 3.0f))) : __logf(1.0f + e); return fmaxf(x, 0.f) + l; }

__device__ __forceinline__ void epilogue(const Epi& E, const f32x4 (&acc)[2][2][4][2], const Unit& u, int wr, int wc, int fr, int fq) {
    const int rowb = u.pm * BM + wr * 64 + fr;
    const int cin = wc * 32 + 8 * fq;
    if (E.kind == EK_GU) {
#pragma unroll
        for (int ai = 0; ai < 2; ++ai)
#pragma unroll
            for (int m = 0; m < 4; ++m) { const int row = rowb + ai * HALF + m * 16; const float r = row_rs(E.stats_in, row);
                const f32x4 g0 = acc[ai][0][m][0] * r, u0 = acc[ai][1][m][0] * r, g1 = acc[ai][0][m][1] * r, u1 = acc[ai][1][m][1] * r;
                const f32x4 o0 = (f32x4){silu_f(g0[0]) * u0[0], silu_f(g0[1]) * u0[1], silu_f(g0[2]) * u0[2], silu_f(g0[3]) * u0[3]};
                const f32x4 o1 = (f32x4){silu_f(g1[0]) * u1[0], silu_f(g1[1]) * u1[1], silu_f(g1[2]) * u1[2], silu_f(g1[3]) * u1[3]};
                *(GAS u32x4*)(E.obf + (size_t)row * E.ldo + u.pn * HALF + cin) = pack8(o0, o1); }
    } else if (E.kind == EK_RES) {
#pragma unroll
        for (int ai = 0; ai < 2; ++ai)
#pragma unroll
            for (int m = 0; m < 4; ++m) { const int row = rowb + ai * HALF + m * 16;
                float ss = 0.f;
#pragma unroll
                for (int bj = 0; bj < 2; ++bj) { const int col = u.pn * BM + bj * HALF + cin;
                    f32x4 r0, r1;
                    if (E.res_p) { const float* rp = (row < MP) ? E.res_p + (size_t)row * DM : E.res_s + (size_t)(row - MP) * DM; r0 = *(const GAS f32x4*)(rp + col); r1 = *(const GAS f32x4*)(rp + col + 4); }
                    else unpack8(*(const GAS u32x4*)(E.res_bf + (size_t)row * DM + col), r0, r1);
                    const f32x4 h0 = r0 + acc[ai][bj][m][0] * E.coef, h1 = r1 + acc[ai][bj][m][1] * E.coef;
                    *(GAS u32x4*)(E.obf + (size_t)row * DM + col) = pack8(h0, h1);
                    ss += (h0[0] * h0[0] + h0[1] * h0[1]) + (h0[2] * h0[2] + h0[3] * h0[3]) + (h1[0] * h1[0] + h1[1] * h1[1]) + (h1[2] * h1[2] + h1[3] * h1[3]); }
                ss += __shfl_xor(ss, 16); ss += __shfl_xor(ss, 32);
                if (fq == 0) *(GAS float*)(E.stats_out + (size_t)row * 16 + u.pn * 4 + wc) = ss; }
    } else if (E.kind == EK_WIN) {
        const int pn = u.pn;
        if (pn < 8) {
            const int colt = pn * BM + cin;
#pragma unroll
            for (int ai = 0; ai < 2; ++ai)
#pragma unroll
                for (int m = 0; m < 4; ++m) { const int row = rowb + ai * HALF + m * 16; const float r = row_rs(E.stats_in, row);
#pragma unroll
                    for (int bj = 0; bj < 2; ++bj) { f32x4 v0 = acc[ai][bj][m][0] * r, v1 = acc[ai][bj][m][1] * r;
#pragma unroll
                        for (int j = 0; j < 4; ++j) { v0[j] = silu_f(v0[j]); v1[j] = silu_f(v1[j]); }
                        *(GAS u32x4*)(E.Z + (size_t)row * DI + colt + bj * HALF) = pack8(v0, v1); } }
        } else if (pn >= 28 && pn < 36) {
            const int colt = (pn - 28) * BM + cin;
#pragma unroll
            for (int ai = 0; ai < 2; ++ai)
#pragma unroll
                for (int m = 0; m < 4; ++m) { const int row = rowb + ai * HALF + m * 16; const float r = row_rs(E.stats_in, row);
#pragma unroll
                    for (int bj = 0; bj < 2; ++bj) { f32x4 v0 = acc[ai][bj][m][0] * r, v1 = acc[ai][bj][m][1] * r;
#pragma unroll
                        for (int j = 0; j < 4; ++j) { v0[j] = sigm_f(v0[j]); v1[j] = sigm_f(v1[j]); }
                        *(GAS u32x4*)(E.GATES + (size_t)row * (2 * DM) + colt + bj * HALF) = pack8(v0, v1); } }
        } else if (pn < 28) {
            const bool isx = pn < 24; bf16_t* const O = isx ? E.XBC : E.V; const int ldo = isx ? CD : PD; const int colt = (isx ? pn - 8 : pn - 24) * BM + cin;
            const int keep = isx ? 3 : PBUF;
#pragma unroll
            for (int ai = 0; ai < 2; ++ai)
#pragma unroll
                for (int m = 0; m < 4; ++m) { const int row = rowb + ai * HALF + m * 16; const float r = row_rs(E.stats_in, row);
                    float* sp = nullptr;
                    if (row < MP) { const int sb = row >> 11, st = row & (SEQ - 1); if (st >= SEQ - keep) sp = (isx ? E.conv_p : E.pool_p) + ((size_t)sb * keep + (st - (SEQ - keep))) * ldo + colt; }
                    else { const int sb = (row - MP) >> 3, st = (row - MP) & 7; const int si = st - (DECS - keep); if (si >= 0) sp = (isx ? E.conv_s : E.pool_s) + ((size_t)sb * keep + si) * ldo + colt; }
                    bf16_t* hp = nullptr;
                    if (isx && row < MP) { const int st = row & (SEQ - 1), tm = st & 127; if (tm >= 125 && st < SEQ - 3) hp = E.HALO + ((((size_t)(row >> 11) * 16 + (st >> 7) + 1) * 3 + (tm - 125)) * CD) + colt; }
#pragma unroll
                    for (int bj = 0; bj < 2; ++bj) { const f32x4 v0 = acc[ai][bj][m][0] * r, v1 = acc[ai][bj][m][1] * r;
                        const u32x4 pk = pack8(v0, v1);
                        *(GAS u32x4*)(O + (size_t)row * ldo + colt + bj * HALF) = pk;
                        if (hp) *(GAS u32x4*)(hp + bj * HALF) = pk;
                        if (sp) { *(GAS f32x4*)(sp + bj * HALF) = v0; *(GAS f32x4*)(sp + bj * HALF + 4) = v1; } } }
        } else if (wc == 0) {
            const f32x4 b0 = *(const GAS f32x4*)(E.dt_bias + 8 * fq), b1 = *(const GAS f32x4*)(E.dt_bias + 8 * fq + 4);
#pragma unroll
            for (int ai = 0; ai < 2; ++ai)
#pragma unroll
                for (int m = 0; m < 4; ++m) { const int row = rowb + ai * HALF + m * 16; const float r = row_rs(E.stats_in, row);
                    f32x4 v0 = acc[ai][0][m][0] * r + b0, v1 = acc[ai][0][m][1] * r + b1;
#pragma unroll
                    for (int j = 0; j < 4; ++j) { v0[j] = softplus_f(v0[j]); v1[j] = softplus_f(v1[j]); }
                    *(GAS f32x4*)(E.DT + (size_t)row * 32 + 8 * fq) = v0; *(GAS f32x4*)(E.DT + (size_t)row * 32 + 8 * fq + 4) = v1; }
        }
    } else if (E.kind == EK_T1) {
#pragma unroll
        for (int ai = 0; ai < 2; ++ai)
#pragma unroll
            for (int m = 0; m < 4; ++m) { const int row = rowb + ai * HALF + m * 16;
#pragma unroll
                for (int bj = 0; bj < 2; ++bj) { const int col = u.pn * BM + bj * HALF + cin;
                    f32x4 g0, g1; unpack8(*(const GAS u32x4*)(E.gates + (size_t)row * (2 * DM) + col), g0, g1);
                    *(GAS u32x4*)(E.obf + (size_t)row * DM + col) = pack8(g0 * acc[ai][bj][m][0], g1 * acc[ai][bj][m][1]); } }
    } else if (E.kind == EK_MERGE) {
#pragma unroll
        for (int ai = 0; ai < 2; ++ai)
#pragma unroll
            for (int m = 0; m < 4; ++m) { const int row = rowb + ai * HALF + m * 16;
#pragma unroll
                for (int bj = 0; bj < 2; ++bj) { const int col = u.pn * BM + bj * HALF + cin;
                    f32x4 g0, g1; unpack8(*(const GAS u32x4*)(E.gates + (size_t)row * (2 * DM) + DM + col), g0, g1);
                    f32x4 t0, t1; unpack8(*(const GAS u32x4*)(E.res_bf + (size_t)row * DM + col), t0, t1);
                    *(GAS u32x4*)(E.obf + (size_t)row * DM + col) = pack8(t0 + g0 * acc[ai][bj][m][0], t1 + g1 * acc[ai][bj][m][1]); } }
    } else if (E.kind == EK_BF16) {
#pragma unroll
        for (int ai = 0; ai < 2; ++ai)
#pragma unroll
            for (int m = 0; m < 4; ++m) { const int row = rowb + ai * HALF + m * 16;
#pragma unroll
                for (int bj = 0; bj < 2; ++bj) { const int col = u.pn * BM + bj * HALF + cin;
                    *(GAS u32x4*)(E.obf + (size_t)row * E.ldo + col) = pack8(acc[ai][bj][m][0], acc[ai][bj][m][1]); } }
    } else if (E.kind == EK_PLE) {
#pragma unroll
        for (int ai = 0; ai < 2; ++ai)
#pragma unroll
            for (int m = 0; m < 4; ++m) { const int row = rowb + ai * HALF + m * 16; const float r = row_rs(E.stats_in, row);
                float ss = 0.f;
#pragma unroll
                for (int bj = 0; bj < 2; ++bj) { const int col = u.pn * BM + bj * HALF + cin;
                    f32x4 q0, q1; unpack8(*(const GAS u32x4*)(E.q + (size_t)row * DM + col), q0, q1);
                    f32x4 r0, r1; unpack8(*(const GAS u32x4*)(E.res_bf + (size_t)row * DM + col), r0, r1);
                    f32x4 h0, h1;
#pragma unroll
                    for (int j = 0; j < 4; ++j) { h0[j] = r0[j] + sigm_f(acc[ai][bj][m][0][j] * r) * q0[j]; h1[j] = r1[j] + sigm_f(acc[ai][bj][m][1][j] * r) * q1[j]; }
                    *(GAS u32x4*)(E.obf + (size_t)row * DM + col) = pack8(h0, h1);
                    ss += (h0[0] * h0[0] + h0[1] * h0[1]) + (h0[2] * h0[2] + h0[3] * h0[3]) + (h1[0] * h1[0] + h1[1] * h1[1]) + (h1[2] * h1[2] + h1[3] * h1[3]); }
                ss += __shfl_xor(ss, 16); ss += __shfl_xor(ss, 32);
                if (fq == 0) *(GAS float*)(E.stats_out + (size_t)row * 16 + u.pn * 4 + wc) = ss; }
    }
}


__device__ __forceinline__ void epi_seg(const Epi& E, int row, int col, f32x4 v0, f32x4 v1, int lane) {
    if (E.kind == EK_RES) {
        f32x4 r0, r1;
        if (E.res_p) { const float* rp = ((row < MP) ? E.res_p + (size_t)row * DM : E.res_s + (size_t)(row - MP) * DM) + col; r0 = *(const GAS f32x4*)rp; r1 = *(const GAS f32x4*)(rp + 4); }
        else unpack8(*(const GAS u32x4*)(E.res_bf + (size_t)row * DM + col), r0, r1);
        const f32x4 h0 = r0 + v0 * E.coef, h1 = r1 + v1 * E.coef;
        *(GAS u32x4*)(E.obf + (size_t)row * DM + col) = pack8(h0, h1);
        float ss = (h0[0] * h0[0] + h0[1] * h0[1]) + (h0[2] * h0[2] + h0[3] * h0[3]) + (h1[0] * h1[0] + h1[1] * h1[1]) + (h1[2] * h1[2] + h1[3] * h1[3]);
        ss += __shfl_xor(ss, 1); ss += __shfl_xor(ss, 2); ss += __shfl_xor(ss, 4);
        if ((lane & 7) == 0) *(GAS float*)(E.stats_out + (size_t)row * 16 + (col >> 6)) = ss;
    } else if (E.kind == EK_T1) {
        f32x4 g0, g1; unpack8(*(const GAS u32x4*)(E.gates + (size_t)row * (2 * DM) + col), g0, g1);
        *(GAS u32x4*)(E.obf + (size_t)row * DM + col) = pack8(g0 * v0, g1 * v1);
    } else if (E.kind == EK_MERGE) {
        f32x4 g0, g1; unpack8(*(const GAS u32x4*)(E.gates + (size_t)row * (2 * DM) + DM + col), g0, g1);
        f32x4 t0, t1; unpack8(*(const GAS u32x4*)(E.res_bf + (size_t)row * DM + col), t0, t1);
        *(GAS u32x4*)(E.obf + (size_t)row * DM + col) = pack8(t0 + g0 * v0, t1 + g1 * v1);
    } else if (E.kind == EK_BF16) {
        *(GAS u32x4*)(E.obf + (size_t)row * E.ldo + col) = pack8(v0, v1);
    } else if (E.kind == EK_PLE) {
        const float r = row_rs(E.stats_in, row);
        f32x4 q0, q1; unpack8(*(const GAS u32x4*)(E.q + (size_t)row * DM + col), q0, q1);
        f32x4 r0, r1; unpack8(*(const GAS u32x4*)(E.res_bf + (size_t)row * DM + col), r0, r1);
        f32x4 h0, h1;
#pragma unroll
        for (int j = 0; j < 4; ++j) { h0[j] = r0[j] + sigm_f(v0[j] * r) * q0[j]; h1[j] = r1[j] + sigm_f(v1[j] * r) * q1[j]; }
        *(GAS u32x4*)(E.obf + (size_t)row * DM + col) = pack8(h0, h1);
        float ss = (h0[0] * h0[0] + h0[1] * h0[1]) + (h0[2] * h0[2] + h0[3] * h0[3]) + (h1[0] * h1[0] + h1[1] * h1[1]) + (h1[2] * h1[2] + h1[3] * h1[3]);
        ss += __shfl_xor(ss, 1); ss += __shfl_xor(ss, 2); ss += __shfl_xor(ss, 4);
        if ((lane & 7) == 0) *(GAS float*)(E.stats_out + (size_t)row * 16 + (col >> 6)) = ss;
    }
}
__device__ __forceinline__ int sw_off(int row, int ch) { return 256 * row + 16 * (ch ^ (((row & 3) << 2) | ((row >> 2) & 3))); }
__device__ __forceinline__ void small_tile_sum(LAS unsigned char* lds, const bf16_t* A, int lda, const bf16_t* Bt, int K, int r0, int c0, f32x4& v0, f32x4& v1) {
    const int tid = threadIdx.x, wid = __builtin_amdgcn_readfirstlane(tid >> 6), lane = tid & 63, ql = lane & 15, gq = lane >> 4, mw = wid >> 1, nh = wid & 1;
    const int nst = K / 128;
    const char* src[4]; int dst[4];
#pragma unroll
    for (int i = 0; i < 4; ++i) { const int p = 4 * wid + i, isB = p >> 4, row = 4 * (p & 15) + (lane >> 4), cs = lane & 15, ch = cs ^ (((row & 3) << 2) | ((row >> 2) & 3));
        src[i] = isB ? (const char*)(Bt + (size_t)(c0 + (row & ~31) + perm32(row & 31)) * K + 8 * ch) : (const char*)(A + (size_t)(r0 + row) * lda + 8 * ch);
        dst[i] = isB * 16384 + 1024 * (p & 15); }
#define ST_ISSUE(st) do { _Pragma("unroll") for (int _i = 0; _i < 4; ++_i) \
        __builtin_amdgcn_global_load_lds((const unsigned*)(src[_i] + (size_t)(st) * 256), (LAS unsigned*)(lds + ((st) & 3) * 32768 + dst[_i]), 16, 0, 0); } while (0)
    f32x4 acc0 = (f32x4){0.f, 0.f, 0.f, 0.f}, acc1 = acc0;
    int aoff[4], boff0[4], boff1[4];
#pragma unroll
    for (int ks = 0; ks < 4; ++ks) { aoff[ks] = sw_off(16 * mw + ql, 4 * ks + gq); boff0[ks] = 16384 + sw_off(32 * nh + ql, 4 * ks + gq); boff1[ks] = 16384 + sw_off(32 * nh + 16 + ql, 4 * ks + gq); }
    ST_ISSUE(0); if (nst > 1) ST_ISSUE(1); if (nst > 2) ST_ISSUE(2);
    for (int t = 0; t < nst; ++t) {
        const int ahead = (nst - 1 - t) < 2 ? (nst - 1 - t) : 2;
        if (ahead == 2) asm volatile("s_waitcnt vmcnt(8)" ::: "memory"); else if (ahead == 1) asm volatile("s_waitcnt vmcnt(4)" ::: "memory"); else asm volatile("s_waitcnt vmcnt(0)" ::: "memory");
        __builtin_amdgcn_s_barrier(); asm volatile("" ::: "memory");
        if (t + 3 < nst) ST_ISSUE(t + 3);
        const LAS unsigned char* const sl = lds + (t & 3) * 32768;
#pragma unroll
        for (int ks = 0; ks < 4; ++ks) {
            const bf16x8 af = *(const LAS bf16x8*)(sl + aoff[ks]), b0 = *(const LAS bf16x8*)(sl + boff0[ks]), b1 = *(const LAS bf16x8*)(sl + boff1[ks]);
            acc0 = __builtin_amdgcn_mfma_f32_16x16x32_bf16(b0, af, acc0, 0, 0, 0); acc1 = __builtin_amdgcn_mfma_f32_16x16x32_bf16(b1, af, acc1, 0, 0, 0);
        }
        asm volatile("s_waitcnt lgkmcnt(0)" ::: "memory");
    }
#undef ST_ISSUE
    __syncthreads();
    LAS f32x4* const tile = (LAS f32x4*)lds;
    { const int row = 16 * mw + ql, chb = 8 * nh + 2 * gq; tile[row * 16 + (chb ^ (row & 15))] = acc0; tile[row * 16 + ((chb + 1) ^ (row & 15))] = acc1; }
    __syncthreads();
    const int rr = 8 * wid + (lane >> 3), ch0 = 2 * (lane & 7);
    v0 = tile[rr * 16 + (ch0 ^ (rr & 15))]; v1 = tile[rr * 16 + ((ch0 + 1) ^ (rr & 15))];
    __syncthreads();
}
__device__ __forceinline__ void gemm_small(LAS unsigned char* lds, const Gemm g, const Epi& E, int row_base, int nrows, int G, int c) {
    const int tid = threadIdx.x, wid = __builtin_amdgcn_readfirstlane(tid >> 6), lane = tid & 63;
    const int ntn = g.N / 64, ntiles = (nrows / 64) * ntn;
    for (int v = c; v < ntiles; v += G) {
        const int r0 = row_base + 64 * (v / ntn), c0 = 64 * (v % ntn);
        f32x4 v0, v1; small_tile_sum(lds, g.A, g.lda, g.Bt, g.K, r0, c0, v0, v1);
        epi_seg(E, r0 + 8 * wid + (lane >> 3), c0 + 8 * (lane & 7), v0, v1, lane);
    }
}
struct Gemm2 { const bf16_t* A1; const bf16_t* B1; const bf16_t* A2; const bf16_t* B2; int K1, lda1, K2, lda2, N; };
__device__ __forceinline__ void gemm_small2(LAS unsigned char* lds, const Gemm2 g, const bf16_t* gates, bf16_t* out, int row_base, int nrows, int G, int c) {
    const int tid = threadIdx.x, wid = __builtin_amdgcn_readfirstlane(tid >> 6), lane = tid & 63;
    const int ntn = g.N / 64, ntiles = (nrows / 64) * ntn;
    for (int v = c; v < ntiles; v += G) {
        const int r0 = row_base + 64 * (v / ntn), c0 = 64 * (v % ntn), row = r0 + 8 * wid + (lane >> 3), col = c0 + 8 * (lane & 7);
        f32x4 a0, a1, b0, b1;
        small_tile_sum(lds, g.A1, g.lda1, g.B1, g.K1, r0, c0, a0, a1);
        small_tile_sum(lds, g.A2, g.lda2, g.B2, g.K2, r0, c0, b0, b1);
        f32x4 g00, g01, g10, g11; unpack8(*(const GAS u32x4*)(gates + (size_t)row * (2 * DM) + col), g00, g01); unpack8(*(const GAS u32x4*)(gates + (size_t)row * (2 * DM) + DM + col), g10, g11);
        *(GAS u32x4*)(out + (size_t)row * DM + col) = pack8(g00 * a0 + g10 * b0, g01 * a1 + g11 * b1);
    }
}

__device__ __forceinline__ void gemm_phase(LAS unsigned char* lds, const Gemm g, const StaticOrder& S, const Epi& E) {
    const int tid = threadIdx.x, wid = __builtin_amdgcn_readfirstlane(tid >> 6), lane = tid & 63, wr = wid >> 2, wc = wid & 3, fr = lane & 15, fq = lane >> 4;
    const int K = g.K, nt = K / BK;
    unsigned voffA[2], voffB[2];
#pragma unroll
    for (int i = 0; i < 2; ++i) { int R, C; stage_rc(tid * 16 + i * 8192, R, C); const int Rb = (R & ~31) + perm32(R & 31);
        voffA[i] = (unsigned)(R * g.lda + C) * 2u; voffB[i] = (unsigned)(Rb * K + C) * 2u; }
    const size_t kstep = (size_t)(BK * 2);
    const size_t hstep = (size_t)HALF * K * 2, hstepA = (size_t)HALF * g.lda * 2;
    const size_t tstep = 2 * hstep, tstepA = 2 * hstepA, pnstepA = (size_t)g.a_pn_step * 2;
    const unsigned ldsw = (unsigned)wid * 1024u;
    const int aoff = lds_byte(wr * 64 + fr, fq * 8), boff = lds_byte(wc * 32 + fr, fq * 8);
#define PG8_SA(b, h) (((b) * 2 + (h)) * HTB)
#define PG8_SB(b, h) ((4 + (b) * 2 + (h)) * HTB)
#define PG8_STAGE(bufoff, gbase, voff) do { _Pragma("unroll") for (int _i = 0; _i < 2; ++_i) \
        __builtin_amdgcn_global_load_lds((const unsigned*)((const char*)(gbase) + (voff)[_i]), (LAS unsigned*)(lds + (bufoff) + ldsw + _i * 8192), 16, 0, 0); } while (0)
#define PG8_LDA(dst, b, h) do { _Pragma("unroll") for (int m = 0; m < 4; ++m) _Pragma("unroll") for (int k = 0; k < 2; ++k) dst[m][k] = *(const LAS bf16x8*)(lds + PG8_SA(b, h) + aoff + m * 2048 + k * 1024); } while (0)
#define PG8_LDB(dst, b, h) do { _Pragma("unroll") for (int n = 0; n < 2; ++n) _Pragma("unroll") for (int k = 0; k < 2; ++k) dst[n][k] = *(const LAS bf16x8*)(lds + PG8_SB(b, h) + boff + n * 2048 + k * 1024); } while (0)
#define PG8_MMA(ai, bj, At, Bt) do { __builtin_amdgcn_s_setprio(1); _Pragma("unroll") for (int m = 0; m < 4; ++m) _Pragma("unroll") for (int n = 0; n < 2; ++n) _Pragma("unroll") for (int k = 0; k < 2; ++k) \
        acc[ai][bj][m][n] = __builtin_amdgcn_mfma_f32_16x16x32_bf16(Bt[n][k], At[m][k], acc[ai][bj][m][n], 0, 0, 0); __builtin_amdgcn_s_setprio(0); } while (0)
#define PG8_WAIT_V(n) asm volatile("s_waitcnt vmcnt(" #n ")" ::: "memory")
#define PG8_WAIT_L(n) asm volatile("s_waitcnt lgkmcnt(" #n ")" ::: "memory")
#define PG8_BAR __builtin_amdgcn_s_barrier()
#define PG8_SCHED __builtin_amdgcn_sched_barrier(0)
    Unit cur, nxt; int ui = 0;
    if (!S.next(0, cur)) return;
    f32x4 acc[2][2][4][2];
#pragma unroll
    for (int a = 0; a < 2; ++a)
#pragma unroll
        for (int b = 0; b < 2; ++b)
#pragma unroll
            for (int m = 0; m < 4; ++m)
#pragma unroll
                for (int n = 0; n < 2; ++n) acc[a][b][m][n] = (f32x4){0.f, 0.f, 0.f, 0.f};
    bf16x8 At[4][2], B0[2][2], B1[2][2];
    const char* cA = (const char*)g.A + (size_t)cur.pm * tstepA + (size_t)cur.pn * pnstepA; const char* cB = (const char*)g.Bt + (size_t)cur.pn * tstep;
    PG8_STAGE(PG8_SB(0, 0), cB, voffB); PG8_STAGE(PG8_SB(0, 1), cB + hstep, voffB); PG8_STAGE(PG8_SA(0, 0), cA, voffA); PG8_STAGE(PG8_SA(0, 1), cA + hstepA, voffA);
    if (wr == 1) PG8_BAR;
    PG8_WAIT_V(2); PG8_BAR;
    PG8_STAGE(PG8_SB(1, 0), cB + kstep, voffB); PG8_STAGE(PG8_SA(1, 0), cA + kstep, voffA); PG8_STAGE(PG8_SB(1, 1), cB + hstep + kstep, voffB);
    PG8_WAIT_V(6); PG8_BAR;
    for (;;) {
        const bool has_next = S.next(ui + 1, nxt);
        const char* nA = has_next ? (const char*)g.A + (size_t)nxt.pm * tstepA + (size_t)nxt.pn * pnstepA : cA; const char* nB = has_next ? (const char*)g.Bt + (size_t)nxt.pn * tstep : cB;
        for (int t = 0; t < nt; t += 2) {
            const bool last = (t == nt - 2);
            const char* a1 = cA + (size_t)(t + 1) * kstep;
            const char* a2 = last ? nA : cA + (size_t)(t + 2) * kstep; const char* b2 = last ? nB : cB + (size_t)(t + 2) * kstep;
            const char* a3 = a2 + kstep; const char* b3 = b2 + kstep;
            PG8_LDB(B0, 0, 0); PG8_LDB(B1, 0, 1); PG8_SCHED; PG8_LDA(At, 0, 0); PG8_STAGE(PG8_SA(1, 1), a1 + hstepA, voffA);
            PG8_WAIT_V(8); PG8_WAIT_L(0); PG8_BAR; PG8_MMA(0, 0, At, B0); PG8_MMA(0, 1, At, B1); PG8_BAR; PG8_SCHED;
            PG8_LDA(At, 0, 1); PG8_STAGE(PG8_SB(0, 0), b2, voffB); PG8_STAGE(PG8_SB(0, 1), b2 + hstep, voffB); PG8_STAGE(PG8_SA(0, 0), a2, voffA);
            PG8_WAIT_V(8); PG8_WAIT_L(0); PG8_BAR; PG8_MMA(1, 0, At, B0); PG8_MMA(1, 1, At, B1); PG8_BAR; PG8_SCHED;
            PG8_LDB(B0, 1, 0); PG8_LDB(B1, 1, 1); PG8_SCHED; PG8_LDA(At, 1, 0); PG8_STAGE(PG8_SA(0, 1), a2 + hstepA, voffA);
            PG8_WAIT_V(8); PG8_WAIT_L(0); PG8_BAR; PG8_MMA(0, 0, At, B0); PG8_MMA(0, 1, At, B1); PG8_BAR; PG8_SCHED;
            PG8_LDA(At, 1, 1); PG8_STAGE(PG8_SB(1, 0), b3, voffB); PG8_STAGE(PG8_SB(1, 1), b3 + hstep, voffB); PG8_STAGE(PG8_SA(1, 0), a3, voffA);
            PG8_WAIT_V(8); PG8_WAIT_L(0); PG8_BAR; PG8_MMA(1, 0, At, B0); PG8_MMA(1, 1, At, B1); PG8_BAR; PG8_SCHED;
        }
        if (wr == 0) PG8_BAR;
        epilogue(E, acc, cur, wr, wc, fr, fq);
        if (!has_next) break;
#pragma unroll
        for (int a = 0; a < 2; ++a)
#pragma unroll
            for (int b = 0; b < 2; ++b)
#pragma unroll
                for (int m = 0; m < 4; ++m)
#pragma unroll
                    for (int n = 0; n < 2; ++n) acc[a][b][m][n] = (f32x4){0.f, 0.f, 0.f, 0.f};
        cur = nxt; cA = nA; cB = nB; ++ui;
        if (wr == 1) PG8_BAR;
    }
    PG8_WAIT_V(0);
    PG8_BAR;
#undef PG8_SA
#undef PG8_SB
#undef PG8_STAGE
#undef PG8_LDA
#undef PG8_LDB
#undef PG8_MMA
#undef PG8_WAIT_V
#undef PG8_WAIT_L
#undef PG8_BAR
#undef PG8_SCHED
}

__device__ __forceinline__ void gemm_phase2(LAS unsigned char* lds, const Gemm2 g, const StaticOrder& S, const bf16_t* gates, bf16_t* out) {
    const int tid = threadIdx.x, wid = __builtin_amdgcn_readfirstlane(tid >> 6), lane = tid & 63, wr = wid >> 2, wc = wid & 3, fr = lane & 15, fq = lane >> 4;
    const int nt1 = g.K1 / BK, nt = nt1 + g.K2 / BK;
    int sR[2], sRb[2], sC[2];
#pragma unroll
    for (int i = 0; i < 2; ++i) { int R, C; stage_rc(tid * 16 + i * 8192, R, C); sR[i] = R; sRb[i] = (R & ~31) + perm32(R & 31); sC[i] = C; }
    const size_t kstep = (size_t)(BK * 2);
    const size_t hB1 = (size_t)HALF * g.K1 * 2, hA1 = (size_t)HALF * g.lda1 * 2, hB2 = (size_t)HALF * g.K2 * 2, hA2 = (size_t)HALF * g.lda2 * 2;
    const unsigned ldsw = (unsigned)wid * 1024u;
    const int aoff = lds_byte(wr * 64 + fr, fq * 8), boff = lds_byte(wc * 32 + fr, fq * 8);
#define PG8_SA(b, h) (((b) * 2 + (h)) * HTB)
#define PG8_SB(b, h) ((4 + (b) * 2 + (h)) * HTB)
#define PG8_STAGE_T(bufoff, isA, h, T) do { const int T_ = (T); const bool nx_ = T_ >= nt; const int Tl_ = nx_ ? T_ - nt : T_; const bool s2_ = !nx_ && Tl_ >= nt1; \
        const char* base_ = (isA) ? (s2_ ? cA2 + (size_t)(Tl_ - nt1) * kstep + (h) * hA2 : (nx_ ? nA1 : cA1) + (size_t)Tl_ * kstep + (h) * hA1) \
                                  : (s2_ ? cB2 + (size_t)(Tl_ - nt1) * kstep + (h) * hB2 : (nx_ ? nB1 : cB1) + (size_t)Tl_ * kstep + (h) * hB1); \
        const int ld_ = (isA) ? (s2_ ? g.lda2 : g.lda1) : (s2_ ? g.K2 : g.K1); \
        _Pragma("unroll") for (int _i = 0; _i < 2; ++_i) { const unsigned vo_ = (unsigned)(((isA) ? sR[_i] : sRb[_i]) * ld_ + sC[_i]) * 2u; \
            __builtin_amdgcn_global_load_lds((const unsigned*)(base_ + vo_), (LAS unsigned*)(lds + (bufoff) + ldsw + _i * 8192), 16, 0, 0); } } while (0)
#define PG8_LDA(dst, b, h) do { _Pragma("unroll") for (int m = 0; m < 4; ++m) _Pragma("unroll") for (int k = 0; k < 2; ++k) dst[m][k] = *(const LAS bf16x8*)(lds + PG8_SA(b, h) + aoff + m * 2048 + k * 1024); } while (0)
#define PG8_LDB(dst, b, h) do { _Pragma("unroll") for (int n = 0; n < 2; ++n) _Pragma("unroll") for (int k = 0; k < 2; ++k) dst[n][k] = *(const LAS bf16x8*)(lds + PG8_SB(b, h) + boff + n * 2048 + k * 1024); } while (0)
#define PG8_MMA(ai, bj, At, Bt) do { __builtin_amdgcn_s_setprio(1); _Pragma("unroll") for (int m = 0; m < 4; ++m) _Pragma("unroll") for (int n = 0; n < 2; ++n) _Pragma("unroll") for (int k = 0; k < 2; ++k) \
        acc[ai][bj][m][n] = __builtin_amdgcn_mfma_f32_16x16x32_bf16(Bt[n][k], At[m][k], acc[ai][bj][m][n], 0, 0, 0); __builtin_amdgcn_s_setprio(0); } while (0)
#define PG8_WAIT_V(n) asm volatile("s_waitcnt vmcnt(" #n ")" ::: "memory")
#define PG8_WAIT_L(n) asm volatile("s_waitcnt lgkmcnt(" #n ")" ::: "memory")
#define PG8_BAR __builtin_amdgcn_s_barrier()
#define PG8_SCHED __builtin_amdgcn_sched_barrier(0)
    Unit cur, nxt; int ui = 0;
    if (!S.next(0, cur)) return;
    f32x4 acc[2][2][4][2];
#pragma unroll
    for (int a = 0; a < 2; ++a)
#pragma unroll
        for (int b = 0; b < 2; ++b)
#pragma unroll
            for (int m = 0; m < 4; ++m)
#pragma unroll
                for (int n = 0; n < 2; ++n) acc[a][b][m][n] = (f32x4){0.f, 0.f, 0.f, 0.f};
    bf16x8 At[4][2], B0[2][2], B1[2][2];
    const char* cA1 = (const char*)g.A1 + (size_t)cur.pm * 2 * hA1; const char* cB1 = (const char*)g.B1 + (size_t)cur.pn * 2 * hB1;
    const char* cA2 = (const char*)g.A2 + (size_t)cur.pm * 2 * hA2; const char* cB2 = (const char*)g.B2 + (size_t)cur.pn * 2 * hB2;
    const char* nA1 = cA1; const char* nB1 = cB1;
    PG8_STAGE_T(PG8_SB(0, 0), false, 0, 0); PG8_STAGE_T(PG8_SB(0, 1), false, 1, 0); PG8_STAGE_T(PG8_SA(0, 0), true, 0, 0); PG8_STAGE_T(PG8_SA(0, 1), true, 1, 0);
    if (wr == 1) PG8_BAR;
    PG8_WAIT_V(2); PG8_BAR;
    PG8_STAGE_T(PG8_SB(1, 0), false, 0, 1); PG8_STAGE_T(PG8_SA(1, 0), true, 0, 1); PG8_STAGE_T(PG8_SB(1, 1), false, 1, 1);
    PG8_WAIT_V(6); PG8_BAR;
    for (;;) {
        const bool has_next = S.next(ui + 1, nxt);
        nA1 = has_next ? (const char*)g.A1 + (size_t)nxt.pm * 2 * hA1 : cA1; nB1 = has_next ? (const char*)g.B1 + (size_t)nxt.pn * 2 * hB1 : cB1;
        const int rowb = cur.pm * BM + wr * 64 + fr, colb = cur.pn * BM + wc * 32 + 8 * fq;
        for (int t = 0; t < nt; t += 2) {
            if (t == nt1) {
#pragma unroll
                for (int ai = 0; ai < 2; ++ai)
#pragma unroll
                    for (int m = 0; m < 4; ++m) { const bf16_t* gp = gates + (size_t)(rowb + ai * HALF + m * 16) * (2 * DM) + colb;
#pragma unroll
                        for (int bj = 0; bj < 2; ++bj) { f32x4 g00, g01, g10, g11; unpack8(*(const GAS u32x4*)(gp + bj * HALF), g00, g01); unpack8(*(const GAS u32x4*)(gp + DM + bj * HALF), g10, g11);
#pragma unroll
                            for (int j = 0; j < 4; ++j) { acc[ai][bj][m][0][j] *= g00[j] * __builtin_amdgcn_rcpf(fmaxf(g10[j], 1e-6f)); acc[ai][bj][m][1][j] *= g01[j] * __builtin_amdgcn_rcpf(fmaxf(g11[j], 1e-6f)); } } }
            }
            PG8_LDB(B0, 0, 0); PG8_LDB(B1, 0, 1); PG8_SCHED; PG8_LDA(At, 0, 0); PG8_STAGE_T(PG8_SA(1, 1), true, 1, t + 1);
            PG8_WAIT_V(8); PG8_WAIT_L(0); PG8_BAR; PG8_MMA(0, 0, At, B0); PG8_MMA(0, 1, At, B1); PG8_BAR; PG8_SCHED;
            PG8_LDA(At, 0, 1); PG8_STAGE_T(PG8_SB(0, 0), false, 0, t + 2); PG8_STAGE_T(PG8_SB(0, 1), false, 1, t + 2); PG8_STAGE_T(PG8_SA(0, 0), true, 0, t + 2);
            PG8_WAIT_V(8); PG8_WAIT_L(0); PG8_BAR; PG8_MMA(1, 0, At, B0); PG8_MMA(1, 1, At, B1); PG8_BAR; PG8_SCHED;
            PG8_LDB(B0, 1, 0); PG8_LDB(B1, 1, 1); PG8_SCHED; PG8_LDA(At, 1, 0); PG8_STAGE_T(PG8_SA(0, 1), true, 1, t + 2);
            PG8_WAIT_V(8); PG8_WAIT_L(0); PG8_BAR; PG8_MMA(0, 0, At, B0); PG8_MMA(0, 1, At, B1); PG8_BAR; PG8_SCHED;
            PG8_LDA(At, 1, 1); PG8_STAGE_T(PG8_SB(1, 0), false, 0, t + 3); PG8_STAGE_T(PG8_SB(1, 1), false, 1, t + 3); PG8_STAGE_T(PG8_SA(1, 0), true, 0, t + 3);
            PG8_WAIT_V(8); PG8_WAIT_L(0); PG8_BAR; PG8_MMA(1, 0, At, B0); PG8_MMA(1, 1, At, B1); PG8_BAR; PG8_SCHED;
        }
        if (wr == 0) PG8_BAR;
#pragma unroll
        for (int ai = 0; ai < 2; ++ai)
#pragma unroll
            for (int m = 0; m < 4; ++m) { const size_t row = (size_t)(rowb + ai * HALF + m * 16);
#pragma unroll
                for (int bj = 0; bj < 2; ++bj) { f32x4 g10, g11; unpack8(*(const GAS u32x4*)(gates + row * (2 * DM) + DM + colb + bj * HALF), g10, g11);
#pragma unroll
                    for (int j = 0; j < 4; ++j) { g10[j] = fmaxf(g10[j], 1e-6f); g11[j] = fmaxf(g11[j], 1e-6f); }
                    *(GAS u32x4*)(out + row * DM + colb + bj * HALF) = pack8(acc[ai][bj][m][0] * g10, acc[ai][bj][m][1] * g11); } }
        if (!has_next) break;
#pragma unroll
        for (int a = 0; a < 2; ++a)
#pragma unroll
            for (int b = 0; b < 2; ++b)
#pragma unroll
                for (int m = 0; m < 4; ++m)
#pragma unroll
                    for (int n = 0; n < 2; ++n) acc[a][b][m][n] = (f32x4){0.f, 0.f, 0.f, 0.f};
        cur = nxt; cA1 = nA1; cB1 = nB1; cA2 = (const char*)g.A2 + (size_t)cur.pm * 2 * hA2; cB2 = (const char*)g.B2 + (size_t)cur.pn * 2 * hB2; ++ui;
        if (wr == 1) PG8_BAR;
    }
    PG8_WAIT_V(0);
    PG8_BAR;
#undef PG8_SA
#undef PG8_SB
#undef PG8_STAGE_T
#undef PG8_LDA
#undef PG8_LDB
#undef PG8_MMA
#undef PG8_WAIT_V
#undef PG8_WAIT_L
#undef PG8_BAR
#undef PG8_SCHED
}
}

#define XB_TMO      128
#define XB_XCNT(j)  (256  + 64 * (j))
#define XB_XSUB(j)  (1280 + 64 * (j))
#define XB_XGEN(j)  (2304 + 64 * (j))
#define XB_TOP      3328
#define XB_TOPGEN   3392
#define XCD_BAR_WORDS 3456
#define XB_SPIN_CAP (1u << 18)
__device__ __forceinline__ unsigned xb_ld(unsigned* p)              { return __hip_atomic_load(p, __ATOMIC_RELAXED, __HIP_MEMORY_SCOPE_AGENT); }
__device__ __forceinline__ unsigned xb_add(unsigned* p, unsigned v) { return __hip_atomic_fetch_add(p, v, __ATOMIC_RELAXED, __HIP_MEMORY_SCOPE_AGENT); }
__device__ __forceinline__ unsigned xb_xcc_id() { return (unsigned)__builtin_amdgcn_s_getreg((3 << 11) | 20) & 0xFu; }
#define XB_SPIN(cond, bar) do { unsigned _sp = 0; while (cond) { __builtin_amdgcn_s_sleep(1); \
    if ((++_sp & 255u) == 0u) { if (xb_ld(&(bar)[XB_TMO])) break; if (_sp > XB_SPIN_CAP) { atomicAdd(&(bar)[XB_TMO], 1u); break; } } } } while (0)
struct XcdBarrier { unsigned* bar; unsigned x; volatile LAS unsigned* st; };
__device__ __forceinline__ XcdBarrier xcd_barrier_post(unsigned* bar, volatile LAS unsigned* st) {
    XcdBarrier b; b.bar = bar; b.x = xb_xcc_id(); b.st = st;
    if (threadIdx.x == 0) (void)xb_add(&bar[XB_XCNT(b.x)], 1u);
    return b;
}
__device__ __forceinline__ void xcd_barrier_complete(unsigned* bar, unsigned x, unsigned& nloc, unsigned& nx) {
    const unsigned G = gridDim.x * gridDim.y * gridDim.z;
    unsigned sum, cnt, mine, sp = 0u;
    for (;;) {
        sum = 0u; cnt = 0u; mine = 0u;
#pragma unroll
        for (unsigned j = 0; j < 16; ++j) { const unsigned c = xb_ld(&bar[XB_XCNT(j)]); sum += c; cnt += (c > 0u) ? 1u : 0u; mine = (j == x) ? c : mine; }
        if (sum == G) break;
        __builtin_amdgcn_s_sleep(1);
        if ((++sp & 255u) == 0u) { if (xb_ld(&bar[XB_TMO])) break; if (sp > XB_SPIN_CAP) { atomicAdd(&bar[XB_TMO], 1u); break; } }
    }
    nloc = mine > 0u ? mine : 1u; nx = cnt > 0u ? cnt : 1u;
}
__device__ __forceinline__ void xcd_barrier(const XcdBarrier& b) {
    asm volatile("s_waitcnt vmcnt(0)" ::: "memory");
    __syncthreads();
    if (threadIdx.x == 0) {
        unsigned* bar = b.bar;
        __builtin_amdgcn_s_waitcnt(0);
        unsigned nloc = b.st[0], nx = b.st[1];
        if (nloc == 0u) { xcd_barrier_complete(bar, b.x, nloc, nx); b.st[0] = nloc; b.st[1] = nx; }
        const unsigned old = xb_add(&bar[XB_XSUB(b.x)], 1u);
        const unsigned gen = old / nloc;
        if (old + 1u == (gen + 1u) * nloc) {
            __builtin_amdgcn_fence(__ATOMIC_RELEASE, "agent");
            asm volatile("s_waitcnt vmcnt(0)" ::: "memory");
            const unsigned og = xb_add(&bar[XB_TOP], 1u);
            const unsigned tg = og / nx;
            if (og + 1u == (tg + 1u) * nx) xb_add(&bar[XB_TOPGEN], 1u);
            else XB_SPIN(xb_ld(&bar[XB_TOPGEN]) == tg, bar);
            __builtin_amdgcn_fence(__ATOMIC_ACQUIRE, "agent");
            xb_add(&bar[XB_XGEN(b.x)], 1u);
            asm volatile("s_waitcnt vmcnt(0)" ::: "memory");
        } else {
            XB_SPIN(xb_ld(&bar[XB_XGEN(b.x)]) == gen, bar);
            __builtin_amdgcn_fence(__ATOMIC_ACQUIRE, "agent");
            asm volatile("s_waitcnt vmcnt(0)" ::: "memory");
        }
    }
    __syncthreads();
}

__device__ __forceinline__ void tr_item_load(const float* W, int N, const float* gain, int k0, int n0, int lane, f32x4 (&v)[8]) {
#pragma unroll
    for (int i = 0; i < 8; ++i) { const int kk = 8 * i + (lane >> 3), nn = 4 * (lane & 7);
        v[i] = *(const GAS f32x4*)(W + (size_t)(k0 + kk) * N + n0 + nn);
        if (gain) v[i] = v[i] * *(const GAS float*)(gain + k0 + kk); }
}
__device__ __forceinline__ void tr_item_store(const f32x4 (&v)[8], int K, bf16_t* WT, int k0, int drow0, LAS float* scr, int lane) {
#pragma unroll
    for (int i = 0; i < 8; ++i) { const int kk = 8 * i + (lane >> 3), nn = 4 * (lane & 7);
        scr[kk * 33 + nn] = v[i].x; scr[kk * 33 + nn + 1] = v[i].y; scr[kk * 33 + nn + 2] = v[i].z; scr[kk * 33 + nn + 3] = v[i].w; }
    LDS_WAIT(); asm volatile("" ::: "memory");
    const int c = lane & 7;
#pragma unroll
    for (int j = 0; j < 4; ++j) { const int n = (lane >> 3) + 8 * j; const LAS float* s = scr + (8 * c) * 33 + n;
        u32x4 o; o.x = pk2(s[0 * 33], s[1 * 33]); o.y = pk2(s[2 * 33], s[3 * 33]); o.z = pk2(s[4 * 33], s[5 * 33]); o.w = pk2(s[6 * 33], s[7 * 33]);
        *(GAS u32x4*)(WT + (size_t)(drow0 + n) * K + k0 + 8 * c) = o; }
    LDS_WAIT(); asm volatile("" ::: "memory");
}
__device__ __forceinline__ void p0_transpose_item(const float* W, int K, int N, const float* gain, bf16_t* WT, int k0, int n0, int drow0, LAS float* scr, int lane) {
    f32x4 v[8]; tr_item_load(W, N, gain, k0, n0, lane, v); tr_item_store(v, K, WT, k0, drow0, scr, lane);
}
__device__ __forceinline__ int map_gu(int n0) { return n0 < DFF ? (n0 / 128) * 256 + (n0 % 128) : ((n0 - DFF) / 128) * 256 + 128 + ((n0 - DFF) % 128); }
__device__ __forceinline__ int map_win(int n0) { return n0 < 6144 ? n0 : (n0 < 6176 ? 9216 + (n0 - 6144) : n0 - 32); }

constexpr int TI_GU = (DM / 64) * (2 * DFF / 32), TI_D = (DFF / 64) * (DM / 32), TI_IN = (DM / 64) * (IN_DIM / 32), TI_SSO = (DI / 64) * (DM / 32), TI_SQ = (DM / 64) * (DM / 32), TI_PLE = (PLE / 64) * (DM / 32);
constexpr int TI_H1 = TI_D + TI_IN;
constexpr int TI_H3 = TI_GU + TI_D + TI_SSO + 2 * TI_SQ + TI_PLE;
struct TrItem { const float* W; const float* gain; bf16_t* WT; int K, N, k0, n0, drow0; };
template <int PH> __device__ __forceinline__ TrItem deferred_item(Frame& F, int r) {
    TrItem t; t.gain = nullptr; int mapk = 0; size_t wso;
    if (PH == 1) {
        if (r < TI_D) { t.W = F.in[I_WD1]; t.K = DFF; t.N = DM; wso = WS_WD1; }
        else { r -= TI_D; t.W = F.in[I_WIN]; t.K = DM; t.N = IN_DIM; t.gain = F.in[I_NMIX]; wso = WS_WIN; mapk = 2; }
    } else {
        if (r < TI_GU) { t.W = F.in[I_WGU2]; t.K = DM; t.N = 2 * DFF; t.gain = F.in[I_NFFN2]; wso = WS_WGU2; mapk = 1; }
        else if ((r -= TI_GU) < TI_D) { t.W = F.in[I_WD2]; t.K = DFF; t.N = DM; wso = WS_WD2; }
        else if ((r -= TI_D) < TI_SSO) { t.W = F.in[I_WSSO]; t.K = DI; t.N = DM; t.gain = F.in[I_NSSD]; wso = WS_WSSO; }
        else if ((r -= TI_SSO) < TI_SQ) { t.W = F.in[I_WO]; t.K = DM; t.N = DM; wso = WS_WO; }
        else if ((r -= TI_SQ) < TI_SQ) { t.W = F.in[I_WPG]; t.K = DM; t.N = DM; t.gain = F.in[I_NPLE]; wso = WS_WPG; }
        else { r -= TI_SQ; t.W = F.in[I_WPLE]; t.K = PLE; t.N = DM; wso = WS_WPLE; }
    }
    const int nbk = t.N / 32, kb = r / nbk; t.n0 = (r % nbk) * 32; t.k0 = kb * 64; t.drow0 = (mapk == 1) ? map_gu(t.n0) : (mapk == 2) ? map_win(t.n0) : t.n0;
    t.WT = (bf16_t*)(F.ws + wso);
    return t;
}
template <int PH> __device__ __forceinline__ void deferred_transposes(Frame& F) {
    LAS float* scr = (LAS float*)(F.lds + F.wave * 16384);
    constexpr int NIT = (PH == 1) ? TI_H1 : TI_H3;
    const int gw = F.vcu * NWAVES + F.wave, NGW = F.G * NWAVES, lane = F.lane;
    if (gw < NIT) {
        f32x4 va[8], vb[8];
        TrItem ta = deferred_item<PH>(F, gw), tb = ta;
        tr_item_load(ta.W, ta.N, ta.gain, ta.k0, ta.n0, lane, va);
        for (int it = gw; it < NIT; it += 2 * NGW) {
            const bool hb = it + NGW < NIT;
            if (hb) { tb = deferred_item<PH>(F, it + NGW); tr_item_load(tb.W, tb.N, tb.gain, tb.k0, tb.n0, lane, vb); }
            tr_item_store(va, ta.K, ta.WT, ta.k0, ta.drow0, scr, lane);
            if (!hb) break;
            const bool ha = it + 2 * NGW < NIT;
            if (ha) { ta = deferred_item<PH>(F, it + 2 * NGW); tr_item_load(ta.W, ta.N, ta.gain, ta.k0, ta.n0, lane, va); }
            tr_item_store(vb, tb.K, tb.WT, tb.k0, tb.drow0, scr, lane);
            if (!ha) break;
        }
    }
    __syncthreads();
}

__device__ __forceinline__ void p0_prologue(Frame& F) {
    LAS float* scr = (LAS float*)(F.lds + F.wave * 16384);
    const int gw = F.vcu * NWAVES + F.wave, NGW = F.G * NWAVES, lane = F.lane;
    constexpr int NITEMS = TI_GU + TI_SQ;
    bf16_t* const wgu1 = (bf16_t*)(F.ws + WS_WGU1); bf16_t* const wpot = (bf16_t*)(F.ws + WS_WPOT);
    for (int it = gw; it < NITEMS; it += NGW) {
        int r = it;
        if (r < TI_GU) { const int nb = 2 * DFF / 32, kb = r / nb, n0 = (r % nb) * 32; p0_transpose_item(F.in[I_WGU1], DM, 2 * DFF, F.in[I_NFFN1], wgu1, kb * 64, n0, map_gu(n0), scr, lane); continue; } r -= TI_GU;
        { const int nb = DM / 32, kb = r / nb, n0 = (r % nb) * 32; p0_transpose_item(F.in[I_WPOUT], PD, DM, F.in[I_PSCALE], wpot, kb * 64, n0, n0, scr, lane); }
    }
    {
        bf16_t* const wgrp = (bf16_t*)(F.ws + WS_WGRP); const float* Wg = F.in[I_WPGRP];
        for (int e = F.vcu * NTHREADS + F.tid; e < 4 * 256 * 256 / 8; e += F.G * NTHREADS) {
            const f32x4 a = *(const GAS f32x4*)(Wg + (size_t)e * 8), b = *(const GAS f32x4*)(Wg + (size_t)e * 8 + 4);
            u32x4 o; o.x = pk2(a.x, a.y); o.y = pk2(a.z, a.w); o.z = pk2(b.x, b.y); o.w = pk2(b.z, b.w);
            *(GAS u32x4*)(wgrp + (size_t)e * 8) = o; }
    }
    {
        bf16_t* const XB = (bf16_t*)(F.ws + WS_XB); bf16_t* const PB = (bf16_t*)(F.ws + WS_PB); float* const stA = (float*)(F.ws + WS_STATS_A);
        for (int m0 = gw; m0 < M; m0 += 2 * NGW) {
            const int m1 = m0 + NGW; const bool h1 = m1 < M; const int m1c = h1 ? m1 : m0;
            const float* xr0 = (m0 < MP) ? F.in[I_XP] + (size_t)m0 * DM : F.in[I_XS] + (size_t)(m0 - MP) * DM;
            const float* xr1 = (m1c < MP) ? F.in[I_XP] + (size_t)m1c * DM : F.in[I_XS] + (size_t)(m1c - MP) * DM;
            const float* pr0 = (m0 < MP) ? F.in[I_PP] + (size_t)m0 * PLE : F.in[I_PS] + (size_t)(m0 - MP) * PLE;
            const float* pr1 = (m1c < MP) ? F.in[I_PP] + (size_t)m1c * PLE : F.in[I_PS] + (size_t)(m1c - MP) * PLE;
            f32x4 v0[4], v1[4];
#pragma unroll
            for (int j = 0; j < 4; ++j) { v0[j] = *((const GAS f32x4*)xr0 + lane + 64 * j); v1[j] = *((const GAS f32x4*)xr1 + lane + 64 * j); }
            const f32x4 p0 = *((const GAS f32x4*)pr0 + lane), p1 = *((const GAS f32x4*)pr1 + lane);
            float s0 = 0.f, s1 = 0.f;
#pragma unroll
            for (int j = 0; j < 4; ++j) { s0 += (v0[j].x * v0[j].x + v0[j].y * v0[j].y) + (v0[j].z * v0[j].z + v0[j].w * v0[j].w); s1 += (v1[j].x * v1[j].x + v1[j].y * v1[j].y) + (v1[j].z * v1[j].z + v1[j].w * v1[j].w); }
            s0 = wave_sum(s0); s1 = wave_sum(s1);
            { GAS u32x2* o8 = (GAS u32x2*)(XB + (size_t)m0 * DM) + lane;
#pragma unroll
              for (int j = 0; j < 4; ++j) { u32x2 w; w.x = pk2(v0[j].x, v0[j].y); w.y = pk2(v0[j].z, v0[j].w); o8[64 * j] = w; }
              if (lane < 16) *(GAS float*)(stA + (size_t)m0 * 16 + lane) = (lane == 0) ? s0 : 0.f;
              u32x2 w; w.x = pk2(p0.x, p0.y); w.y = pk2(p0.z, p0.w); *((GAS u32x2*)(PB + (size_t)m0 * PLE) + lane) = w; }
            if (h1) { GAS u32x2* o8 = (GAS u32x2*)(XB + (size_t)m1 * DM) + lane;
#pragma unroll
              for (int j = 0; j < 4; ++j) { u32x2 w; w.x = pk2(v1[j].x, v1[j].y); w.y = pk2(v1[j].z, v1[j].w); o8[64 * j] = w; }
              if (lane < 16) *(GAS float*)(stA + (size_t)m1 * 16 + lane) = (lane == 0) ? s1 : 0.f;
              u32x2 w; w.x = pk2(p1.x, p1.y); w.y = pk2(p1.z, p1.w); *((GAS u32x2*)(PB + (size_t)m1 * PLE) + lane) = w; }
        }
    }
}


typedef short v4i16_t __attribute__((ext_vector_type(4)));
constexpr int IMG_B = 0, IMG_C = 32768, IMG_X = 65536, TAB_ACS = RING_BYTES + 1024, TAB_DT = TAB_ACS + 2048, TAB_SD = TAB_DT + 2048;
constexpr int NCHUNK = SEQ / 128;
template <bool XS> __device__ __forceinline__ int img_off(int row, int ch) { return XS ? 256 * row + 16 * (ch ^ ((row & 7) << 1)) : 256 * row + 16 * (ch ^ (((row & 3) << 2) | ((row >> 2) & 3))); }
__device__ __forceinline__ bf16x8 tr_pair(const LAS unsigned char* p0, const LAS unsigned char* p1) {
    const v4i16_t a = __builtin_amdgcn_ds_read_tr16_b64_v4i16((LAS v4i16_t*)p0), b = __builtin_amdgcn_ds_read_tr16_b64_v4i16((LAS v4i16_t*)p1);
    return (bf16x8){a[0], a[1], a[2], a[3], b[0], b[1], b[2], b[3]};
}
__device__ __forceinline__ void ssd_tables_load(Frame& F, size_t row0, int g, float& d0, float& d1) {
    if (F.wave < 4) { const float* const DT = (const float*)(F.ws + WS_DT); const int head = g * HPG + F.wave;
        d0 = *(const GAS float*)(DT + (row0 + 2 * F.lane) * 32 + head); d1 = *(const GAS float*)(DT + (row0 + 2 * F.lane + 1) * 32 + head); }
}
__device__ __forceinline__ void ssd_tables_compute(Frame& F, int g, float d0, float d1) {
    LAS float* const acs = (LAS float*)(F.lds + TAB_ACS); LAS float* const dtl = (LAS float*)(F.lds + TAB_DT); LAS float* const sdec = (LAS float*)(F.lds + TAB_SD);
    if (F.wave < 4) {
        const int r = F.wave, lane = F.lane, head = g * HPG + r;
        const float Ah = -__expf(*(const GAS float*)(F.in[I_ALOG] + head));
        const float a0 = d0 * Ah, a1 = d1 * Ah, loc = a0 + a1;
        float inc = loc;
#pragma unroll
        for (int o = 1; o < 64; o <<= 1) { const float t = __shfl_up(inc, o); if (lane >= o) inc += t; }
        const float exc = inc - loc;
        acs[(2 * lane) * 4 + r] = exc + a0; acs[(2 * lane + 1) * 4 + r] = inc;
        dtl[(2 * lane) * 4 + r] = d0; dtl[(2 * lane + 1) * 4 + r] = d1;
    }
    __syncthreads();
    { const int s = F.tid >> 2, r = F.tid & 3; sdec[s * 4 + r] = __expf(acs[127 * 4 + r] - acs[s * 4 + r]) * dtl[s * 4 + r]; }
    __syncthreads();
}
__device__ __forceinline__ void ssd_tables(Frame& F, size_t row0, int g) { float d0 = 0.f, d1 = 0.f; ssd_tables_load(F, row0, g, d0, d1); ssd_tables_compute(F, g, d0, d1); }
struct ConvMap { int kind, cc, run, gch; };
__device__ __forceinline__ ConvMap ssd_conv_map(int t, int g) {
    ConvMap m;
    if (t < 256) { m.kind = 0; m.cc = t & 31; m.run = t >> 5; } else if (t < 384) { m.kind = 1; m.cc = (t - 256) & 15; m.run = (t - 256) >> 4; } else { m.kind = 2; m.cc = (t - 384) & 15; m.run = (t - 384) >> 4; }
    m.gch = (m.kind == 0 ? g * 256 : (m.kind == 1 ? DI + g * DSTATE : DI + NG * DSTATE + g * DSTATE)) + 8 * m.cc;
    return m;
}
__device__ __forceinline__ void ssd_conv_load(Frame& F, size_t row0, int b, int c, int g, u32x4 (&raw)[19]) {
    const ConvMap m = ssd_conv_map(F.tid, g);
    const bf16_t* const XBC = (const bf16_t*)(F.ws + WS_XBC); const bf16_t* const HALO = (const bf16_t*)(F.ws + WS_HALO);
#pragma unroll
    for (int i = 0; i < 19; ++i) {
        if (i < 3 && m.run == 0) { if (c == 0) raw[i] = (u32x4){0u, 0u, 0u, 0u}; else raw[i] = *(const GAS u32x4*)(HALO + ((((size_t)b * 16 + c) * 3 + i) * CD) + m.gch); }
        else raw[i] = *(const GAS u32x4*)(XBC + (row0 + 16 * m.run + i - 3) * CD + m.gch); }
}
__device__ __forceinline__ void ssd_conv_store(Frame& F, size_t row0, int g, const u32x4 (&raw)[19]) {
    const ConvMap m = ssd_conv_map(F.tid, g);
    bf16_t* const XBC = (bf16_t*)(F.ws + WS_XBC);
    const float* const convw = F.in[I_CONVW]; const float* const convb = F.in[I_CONVB];
    float cw[4][8], cb[8];
#pragma unroll
    for (int k = 0; k < 4; ++k) { const f32x4 a = *(const GAS f32x4*)(convw + (size_t)k * CD + m.gch), b_ = *(const GAS f32x4*)(convw + (size_t)k * CD + m.gch + 4);
        cw[k][0] = a.x; cw[k][1] = a.y; cw[k][2] = a.z; cw[k][3] = a.w; cw[k][4] = b_.x; cw[k][5] = b_.y; cw[k][6] = b_.z; cw[k][7] = b_.w; }
    { const f32x4 a = *(const GAS f32x4*)(convb + m.gch), b_ = *(const GAS f32x4*)(convb + m.gch + 4); cb[0] = a.x; cb[1] = a.y; cb[2] = a.z; cb[3] = a.w; cb[4] = b_.x; cb[5] = b_.y; cb[6] = b_.z; cb[7] = b_.w; }
    LAS unsigned char* const img = F.lds + (m.kind == 0 ? IMG_X + (m.cc >> 4) * 32768 : IMG_B);
    const LAS float* const sdec = (const LAS float*)(F.lds + TAB_SD);
    const int chl = m.cc & 15, hr = m.cc >> 3;
#pragma unroll
    for (int i = 0; i < 16; ++i) {
        const int s = 16 * m.run + i;
        float o[8];
#pragma unroll
        for (int j2 = 0; j2 < 4; ++j2) {
            const unsigned w0 = raw[i][j2], w1 = raw[i + 1][j2], w2 = raw[i + 2][j2], w3 = raw[i + 3][j2];
            const float lo = cb[2 * j2] + cw[0][2 * j2] * bflo(w0) + cw[1][2 * j2] * bflo(w1) + cw[2][2 * j2] * bflo(w2) + cw[3][2 * j2] * bflo(w3);
            const float hi = cb[2 * j2 + 1] + cw[0][2 * j2 + 1] * bfhi(w0) + cw[1][2 * j2 + 1] * bfhi(w1) + cw[2][2 * j2 + 1] * bfhi(w2) + cw[3][2 * j2 + 1] * bfhi(w3);
            o[2 * j2] = silu_f(lo); o[2 * j2 + 1] = silu_f(hi);
        }
        u32x4 pk; pk.x = cvt_pk_bf16(o[0], o[1]); pk.y = cvt_pk_bf16(o[2], o[3]); pk.z = cvt_pk_bf16(o[4], o[5]); pk.w = cvt_pk_bf16(o[6], o[7]);
        *(GAS u32x4*)(XBC + (row0 + s) * CD + m.gch) = pk;
        if (m.kind == 0) { const float sc = sdec[s * 4 + hr];
            pk.x = cvt_pk_bf16(o[0] * sc, o[1] * sc); pk.y = cvt_pk_bf16(o[2] * sc, o[3] * sc); pk.z = cvt_pk_bf16(o[4] * sc, o[5] * sc); pk.w = cvt_pk_bf16(o[6] * sc, o[7] * sc); }
        if (m.kind != 2) *(LAS u32x4*)(img + img_off<false>(s, chl)) = pk;
    }
}
__device__ __forceinline__ void ssd_copy_load(Frame& F, size_t row0, int g, u32x4 (&raw)[16]) {
    const ConvMap m = ssd_conv_map(F.tid, g);
    const bf16_t* const XBC = (const bf16_t*)(F.ws + WS_XBC);
#pragma unroll
    for (int i = 0; i < 16; ++i) raw[i] = *(const GAS u32x4*)(XBC + (row0 + 16 * m.run + i) * CD + m.gch);
}
__device__ __forceinline__ void ssd_copy_store(Frame& F, int g, const u32x4 (&raw)[16]) {
    const ConvMap m = ssd_conv_map(F.tid, g);
    LAS unsigned char* const img = F.lds + (m.kind == 0 ? IMG_X + (m.cc >> 4) * 32768 : (m.kind == 1 ? IMG_B : IMG_C));
    const int chl = m.cc & 15;
#pragma unroll
    for (int i = 0; i < 16; ++i) { const int s = 16 * m.run + i; *(LAS u32x4*)(img + (m.kind == 0 ? img_off<true>(s, chl) : img_off<false>(s, chl))) = raw[i]; }
}
__device__ __forceinline__ void ssd_states_phase(Frame& F) {
    bf16_t* const ST = (bf16_t*)(F.ws + WS_HPREV);
    float* const CDEC = (float*)(F.ws + WS_CDEC);
    const int w = F.wave, lane = F.lane, ql = lane & 15, gq = lane >> 4, qq = ql >> 2, pp = ql & 3, r = w >> 1, nh = w & 1;
    int sbo[4][2], sxo[4][2];
#pragma unroll
    for (int f = 0; f < 4; ++f) { const int colb = 64 * nh + 16 * f + 4 * pp, colx = 64 * (r & 1) + 16 * f + 4 * pp;
#pragma unroll
        for (int t4 = 0; t4 < 2; ++t4) { sbo[f][t4] = img_off<false>(8 * gq + qq + 4 * t4, colb >> 3) + 2 * (colb & 7); sxo[f][t4] = img_off<false>(8 * gq + qq + 4 * t4, colx >> 3) + 2 * (colx & 7); } }
    u32x4 raw[19]; float d0 = 0.f, d1 = 0.f;
    constexpr int NIT = BATCH * NCHUNK * NG;
    if (F.vcu < NIT) { const int it = F.vcu, g = it & 7, c = (it >> 3) & (NCHUNK - 1), b = it >> 7; const size_t row0 = (size_t)b * SEQ + (size_t)c * 128;
        ssd_conv_load(F, row0, b, c, g, raw); ssd_tables_load(F, row0, g, d0, d1); }
    for (int it = F.vcu; it < NIT; it += F.G) {
        const int g = it & 7, c = (it >> 3) & (NCHUNK - 1), b = it >> 7;
        const size_t row0 = (size_t)b * SEQ + (size_t)c * 128;
        asm volatile("s_waitcnt vmcnt(0)" ::: "memory");
        ssd_tables_compute(F, g, d0, d1);
        ssd_conv_store(F, row0, g, raw);
        __syncthreads();
        if (it + F.G < NIT) { const int it2 = it + F.G, g2 = it2 & 7, c2 = (it2 >> 3) & (NCHUNK - 1), b2 = it2 >> 7; const size_t row2 = (size_t)b2 * SEQ + (size_t)c2 * 128;
            ssd_conv_load(F, row2, b2, c2, g2, raw); ssd_tables_load(F, row2, g2, d0, d1); }
        const int head = g * HPG + r;
        bf16_t* const stp = ST + ((((size_t)b * NCHUNK + c) * NH + head) * HD) * DSTATE;
#pragma unroll
        for (int nh2 = 0; nh2 < 2; ++nh2) {
            f32x4 acc[2][4];
#pragma unroll
            for (int i = 0; i < 2; ++i)
#pragma unroll
                for (int j = 0; j < 4; ++j) acc[i][j] = (f32x4){0.f, 0.f, 0.f, 0.f};
#pragma unroll
            for (int ks = 0; ks < 4; ++ks) {
                bf16x8 af[2], xf[4];
#pragma unroll
                for (int nf = 0; nf < 2; ++nf) { const LAS unsigned char* p = F.lds + IMG_B + sbo[2 * nh2 + nf][0] + 8192 * ks; const LAS unsigned char* p4 = F.lds + IMG_B + sbo[2 * nh2 + nf][1] + 8192 * ks; af[nf] = tr_pair(p, p4); }
#pragma unroll
                for (int pf = 0; pf < 4; ++pf) { const LAS unsigned char* p = F.lds + IMG_X + (r >> 1) * 32768 + sxo[pf][0] + 8192 * ks; const LAS unsigned char* p4 = F.lds + IMG_X + (r >> 1) * 32768 + sxo[pf][1] + 8192 * ks; xf[pf] = tr_pair(p, p4); }
#pragma unroll
                for (int nf = 0; nf < 2; ++nf)
#pragma unroll
                    for (int pf = 0; pf < 4; ++pf) acc[nf][pf] = __builtin_amdgcn_mfma_f32_16x16x32_bf16(af[nf], xf[pf], acc[nf][pf], 0, 0, 0);
            }
#pragma unroll
            for (int pf = 0; pf < 4; ++pf)
#pragma unroll
                for (int nf = 0; nf < 2; ++nf) { u32x2 o; o.x = cvt_pk_bf16(acc[nf][pf][0], acc[nf][pf][1]); o.y = cvt_pk_bf16(acc[nf][pf][2], acc[nf][pf][3]);
                    *(GAS u32x2*)(stp + (size_t)(16 * pf + ql) * DSTATE + 64 * nh + 32 * nh2 + 16 * nf + 4 * gq) = o; }
        }
        if (F.tid < 4) { const LAS float* acs = (const LAS float*)(F.lds + TAB_ACS); *(GAS float*)(CDEC + ((size_t)b * NCHUNK + c) * NH + g * HPG + F.tid) = __expf(acs[127 * 4 + F.tid]); }
        __syncthreads();
    }
}
__device__ __forceinline__ void ssd_scan_phase(Frame& F) {
    bf16_t* const HP = (bf16_t*)(F.ws + WS_HPREV); const float* const CDEC = (const float*)(F.ws + WS_CDEC); float* const hout = F.out + O_SSM_P;
    const int gt = F.vcu * NTHREADS + F.tid, NT = F.G * NTHREADS;
    constexpr int PER = NH * HD * DSTATE / 8;
    for (int e = gt; e < BATCH * PER; e += NT) {
        const int b = e / PER, i8 = e % PER, head = i8 / (HD * DSTATE / 8);
        u32x4 stv[NCHUNK];
#pragma unroll
        for (int c = 0; c < NCHUNK; ++c) stv[c] = *(const GAS u32x4*)(HP + (((size_t)b * NCHUNK + c) * (size_t)PER + i8) * 8);
        f32x4 h0 = (f32x4){0.f, 0.f, 0.f, 0.f}, h1 = h0;
#pragma unroll
        for (int c = 0; c < NCHUNK; ++c) {
            if (c > 0) *(GAS u32x4*)(HP + (((size_t)b * NCHUNK + c) * (size_t)PER + i8) * 8) = pg8::pack8(h0, h1);
            const float d = *(const GAS float*)(CDEC + ((size_t)b * NCHUNK + c) * NH + head);
            f32x4 s0, s1; pg8::unpack8(stv[c], s0, s1);
            h0 = h0 * d + s0; h1 = h1 * d + s1;
        }
        *(GAS f32x4*)(hout + ((size_t)b * PER + i8) * 8) = h0; *(GAS f32x4*)(hout + ((size_t)b * PER + i8) * 8 + 4) = h1;
    }
}
__device__ __forceinline__ void ssd_out_phase(Frame& F) {
    const bf16_t* const HP = (const bf16_t*)(F.ws + WS_HPREV); bf16_t* const ZY = (bf16_t*)(F.ws + WS_Z);
    const int w = F.wave, lane = F.lane, ql = lane & 15, gq = lane >> 4, qq = ql >> 2, pp = ql & 3, q0 = 16 * w;
    const LAS float* const acs = (const LAS float*)(F.lds + TAB_ACS); const LAS float* const dtl = (const LAS float*)(F.lds + TAB_DT);
    int cfo[4], bbo[4], hbo[4], xbo[2][4];
#pragma unroll
    for (int ks = 0; ks < 4; ++ks) { cfo[ks] = IMG_C + img_off<false>(q0 + ql, 4 * ks + gq); bbo[ks] = IMG_B + img_off<false>(ql, 4 * ks + gq); hbo[ks] = img_off<false>(ql, 4 * ks + gq); }
#pragma unroll
    for (int rr = 0; rr < 2; ++rr)
#pragma unroll
        for (int pf = 0; pf < 4; ++pf) xbo[rr][pf] = IMG_X + img_off<true>(4 * gq + qq, 8 * rr + 2 * pf + (pp >> 1)) + 8 * (pp & 1);
    u32x4 raw[16]; float d0 = 0.f, d1 = 0.f;
    constexpr int NIT = BATCH * NCHUNK * NG;
    if (F.vcu < NIT) { const int it = F.vcu, g = it & 7, c = (it >> 3) & (NCHUNK - 1), b = it >> 7; const size_t row0 = (size_t)b * SEQ + (size_t)c * 128;
        ssd_copy_load(F, row0, g, raw); ssd_tables_load(F, row0, g, d0, d1); }
    for (int it = F.vcu; it < NIT; it += F.G) {
        const int g = it & 7, c = (it >> 3) & (NCHUNK - 1), b = it >> 7;
        const size_t row0 = (size_t)b * SEQ + (size_t)c * 128;
        ssd_tables_compute(F, g, d0, d1);
        ssd_copy_store(F, g, raw);
        __syncthreads();
        if (it + F.G < NIT) { const int it2 = it + F.G, g2 = it2 & 7, c2 = (it2 >> 3) & (NCHUNK - 1), b2 = it2 >> 7; const size_t row2 = (size_t)b2 * SEQ + (size_t)c2 * 128;
            ssd_copy_load(F, row2, g2, raw); ssd_tables_load(F, row2, g2, d0, d1); }
        bf16x8 cf[4];
#pragma unroll
        for (int ks = 0; ks < 4; ++ks) cf[ks] = *(const LAS bf16x8*)(F.lds + cfo[ks]);
        bf16_t* const zp = ZY + (row0 + q0 + ql) * DI + g * 256 + 4 * gq;
        const LAS float* const acs_l = acs + 16 * gq; const LAS float* const dtl_l = dtl + 16 * gq;
        f32x4 acc[4][4];
        float aq[4];
#pragma unroll
        for (int r = 0; r < 4; ++r) { aq[r] = acs[(q0 + ql) * 4 + r];
#pragma unroll
            for (int pf = 0; pf < 4; ++pf) acc[r][pf] = (f32x4){0.f, 0.f, 0.f, 0.f}; }
#pragma unroll
        for (int ks = 0; ks < 4; ++ks) if (2 * ks <= w) {
            f32x4 cb[2];
#pragma unroll
            for (int hf = 0; hf < 2; ++hf) { cb[hf] = (f32x4){0.f, 0.f, 0.f, 0.f};
                if (2 * ks + hf <= w) {
#pragma unroll
                    for (int kn = 0; kn < 4; ++kn) { const bf16x8 bfr = *(const LAS bf16x8*)(F.lds + bbo[kn] + 4096 * (2 * ks + hf)); cb[hf] = __builtin_amdgcn_mfma_f32_16x16x32_bf16(bfr, cf[kn], cb[hf], 0, 0, 0); } } }
#pragma unroll
            for (int r = 0; r < 4; ++r) {
                const float Dh = *(const GAS float*)(F.in[I_DSKIP] + g * HPG + r);
                float v[8];
#pragma unroll
                for (int hf = 0; hf < 2; ++hf) { const int sf = 2 * ks + hf;
#pragma unroll
                    for (int rg = 0; rg < 4; ++rg) { const int sl = 4 * gq + rg;
                        float val = 0.f;
                        if (sf <= w) { const float as = acs_l[64 * sf + 4 * rg + r], d = dtl_l[64 * sf + 4 * rg + r];
                            val = cb[hf][rg] * __expf(aq[r] - as) * d;
                            if (sf == w) { if (sl > ql) val = 0.f; else if (sl == ql) val += Dh; } }
                        v[4 * hf + rg] = val; } }
                u32x4 pk; pk.x = cvt_pk_bf16(v[0], v[1]); pk.y = cvt_pk_bf16(v[2], v[3]); pk.z = cvt_pk_bf16(v[4], v[5]); pk.w = cvt_pk_bf16(v[6], v[7]);
                const bf16x8 wf = __builtin_bit_cast(bf16x8, pk);
#pragma unroll
                for (int pf = 0; pf < 4; ++pf) {
                    const LAS unsigned char* const xb = F.lds + xbo[r & 1][pf] + (r >> 1) * 32768 + 8192 * ks;
                    const bf16x8 xf = tr_pair(xb, xb + 4096);
                    acc[r][pf] = __builtin_amdgcn_mfma_f32_16x16x32_bf16(xf, wf, acc[r][pf], 0, 0, 0); }
            }
        }
        u32x4 hreg[8];
        if (c > 0) {
            const u32x4* hsrc = (const u32x4*)(HP + ((((size_t)b * NCHUNK + c) * NH + g * HPG) * HD) * DSTATE) + F.tid;
#pragma unroll
            for (int i = 0; i < 8; ++i) hreg[i] = *(const GAS u32x4*)(hsrc + 512 * i);
        }
        if (c > 0) {
            __syncthreads();
#pragma unroll
            for (int i = 0; i < 8; ++i) { const int e = F.tid + 512 * i, hr_ = e >> 10, p_ = (e >> 4) & 63, ch_ = e & 15;
                *(LAS u32x4*)(F.lds + IMG_X + hr_ * 16384 + img_off<false>(p_, ch_)) = hreg[i]; }
            __syncthreads();
#pragma unroll
            for (int r = 0; r < 4; ++r) { const float eaq = __expf(aq[r]);
#pragma unroll
                for (int pf = 0; pf < 4; ++pf) { f32x4 yo = (f32x4){0.f, 0.f, 0.f, 0.f};
#pragma unroll
                    for (int ks = 0; ks < 4; ++ks) { const bf16x8 hf_ = *(const LAS bf16x8*)(F.lds + IMG_X + r * 16384 + hbo[ks] + 4096 * pf); yo = __builtin_amdgcn_mfma_f32_16x16x32_bf16(hf_, cf[ks], yo, 0, 0, 0); }
                    acc[r][pf] += yo * eaq; } }
        }
        float ssum = 0.f;
#pragma unroll
        for (int r = 0; r < 4; ++r)
#pragma unroll
            for (int pf = 0; pf < 4; ++pf) {
                const u32x2 zz = *(const GAS u32x2*)(zp + r * 64 + 16 * pf);
                const f32x4 y = acc[r][pf] * (f32x4){bflo(zz.x), bfhi(zz.x), bflo(zz.y), bfhi(zz.y)};
                acc[r][pf] = y; ssum += (y[0] * y[0] + y[1] * y[1]) + (y[2] * y[2] + y[3] * y[3]); }
        ssum += __shfl_xor(ssum, 16); ssum += __shfl_xor(ssum, 32);
        const float rsn = __builtin_amdgcn_rsqf(ssum * (1.0f / 256.0f) + EPS);
#pragma unroll
        for (int r = 0; r < 4; ++r)
#pragma unroll
            for (int pf = 0; pf < 4; ++pf) { u32x2 o; o.x = cvt_pk_bf16(acc[r][pf][0] * rsn, acc[r][pf][1] * rsn); o.y = cvt_pk_bf16(acc[r][pf][2] * rsn, acc[r][pf][3] * rsn);
                *(GAS u32x2*)(zp + r * 64 + 16 * pf) = o; }
        __syncthreads();
    }
}


__device__ __forceinline__ void ssd_conv_store_local(Frame& F, size_t row0, int g, const u32x4 (&raw)[19]) {
    const ConvMap m = ssd_conv_map(F.tid, g);
    bf16_t* const XBC = (bf16_t*)(F.ws + WS_XBC);
    const float* const convw = F.in[I_CONVW]; const float* const convb = F.in[I_CONVB];
    float cw[4][8], cb[8];
#pragma unroll
    for (int k = 0; k < 4; ++k) { const f32x4 a = *(const GAS f32x4*)(convw + (size_t)k * CD + m.gch), b_ = *(const GAS f32x4*)(convw + (size_t)k * CD + m.gch + 4);
        cw[k][0] = a.x; cw[k][1] = a.y; cw[k][2] = a.z; cw[k][3] = a.w; cw[k][4] = b_.x; cw[k][5] = b_.y; cw[k][6] = b_.z; cw[k][7] = b_.w; }
    { const f32x4 a = *(const GAS f32x4*)(convb + m.gch), b_ = *(const GAS f32x4*)(convb + m.gch + 4); cb[0] = a.x; cb[1] = a.y; cb[2] = a.z; cb[3] = a.w; cb[4] = b_.x; cb[5] = b_.y; cb[6] = b_.z; cb[7] = b_.w; }
    LAS unsigned char* const img = F.lds + (m.kind == 0 ? IMG_X + (m.cc >> 4) * 32768 : (m.kind == 1 ? IMG_B : IMG_C));
    const int chl = m.cc & 15;
#pragma unroll
    for (int i = 0; i < 16; ++i) {
        const int s = 16 * m.run + i;
        float o[8];
#pragma unroll
        for (int j2 = 0; j2 < 4; ++j2) {
            const unsigned w0 = raw[i][j2], w1 = raw[i + 1][j2], w2 = raw[i + 2][j2], w3 = raw[i + 3][j2];
            const float lo = cb[2 * j2] + cw[0][2 * j2] * bflo(w0) + cw[1][2 * j2] * bflo(w1) + cw[2][2 * j2] * bflo(w2) + cw[3][2 * j2] * bflo(w3);
            const float hi = cb[2 * j2 + 1] + cw[0][2 * j2 + 1] * bfhi(w0) + cw[1][2 * j2 + 1] * bfhi(w1) + cw[2][2 * j2 + 1] * bfhi(w2) + cw[3][2 * j2 + 1] * bfhi(w3);
            o[2 * j2] = silu_f(lo); o[2 * j2 + 1] = silu_f(hi);
        }
        u32x4 pk; pk.x = cvt_pk_bf16(o[0], o[1]); pk.y = cvt_pk_bf16(o[2], o[3]); pk.z = cvt_pk_bf16(o[4], o[5]); pk.w = cvt_pk_bf16(o[6], o[7]);
        if (m.kind == 2) *(GAS u32x4*)(XBC + (row0 + s) * CD + m.gch) = pk;
        *(LAS u32x4*)(img + (m.kind == 0 ? img_off<true>(s, chl) : img_off<false>(s, chl))) = pk;
    }
}
__device__ __forceinline__ void ssd_local_phase(Frame& F) {
    bf16_t* const XBC = (bf16_t*)(F.ws + WS_XBC); bf16_t* const ST = (bf16_t*)(F.ws + WS_HPREV); float* const CDEC = (float*)(F.ws + WS_CDEC); float* const EAQ = (float*)(F.ws + WS_EAQ);
    const int w = F.wave, lane = F.lane, q0 = 16 * w, hr = w >> 1, nh = w & 1;
    const LAS float* const acs = (const LAS float*)(F.lds + TAB_ACS); const LAS float* const dtl = (const LAS float*)(F.lds + TAB_DT); const LAS float* const sdec = (const LAS float*)(F.lds + TAB_SD);
    u32x4 raw[19]; float d0 = 0.f, d1 = 0.f;
    constexpr int NIT = BATCH * NCHUNK * NG;
    if (F.vcu < NIT) { const int it = F.vcu, g = it & 7, c = (it >> 3) & (NCHUNK - 1), b = it >> 7; const size_t row0 = (size_t)b * SEQ + (size_t)c * 128;
        ssd_conv_load(F, row0, b, c, g, raw); ssd_tables_load(F, row0, g, d0, d1); }
    for (int it = F.vcu; it < NIT; it += F.G) {
        const int g = it & 7, c = (it >> 3) & (NCHUNK - 1), b = it >> 7;
        const size_t row0 = (size_t)b * SEQ + (size_t)c * 128;
        asm volatile("s_waitcnt vmcnt(0)" ::: "memory");
        ssd_tables_compute(F, g, d0, d1);
        ssd_conv_store_local(F, row0, g, raw);
        __syncthreads();
        int lane_ = lane; asm volatile("" : "+v"(lane_));
        const int ql = lane_ & 15, gq = lane_ >> 4, qq = ql >> 2, pp = ql & 3;
        int cfo[4], bbo[4], xbo[2][4], sbo[4];
#pragma unroll
        for (int ks = 0; ks < 4; ++ks) { cfo[ks] = IMG_C + img_off<false>(q0 + ql, 4 * ks + gq); bbo[ks] = IMG_B + img_off<false>(ql, 4 * ks + gq); }
#pragma unroll
        for (int rr = 0; rr < 2; ++rr)
#pragma unroll
                for (int pf = 0; pf < 4; ++pf) xbo[rr][pf] = IMG_X + img_off<true>(4 * gq + qq, 8 * rr + 2 * pf + (pp >> 1)) + 8 * (pp & 1);
#pragma unroll
        for (int nf = 0; nf < 4; ++nf) { const int col = 64 * nh + 16 * nf + 4 * pp; sbo[nf] = IMG_B + img_off<false>(4 * gq + qq, col >> 3) + 2 * (col & 7); }
        {
            bf16x8 cf[4];
#pragma unroll
            for (int ks = 0; ks < 4; ++ks) cf[ks] = *(const LAS bf16x8*)(F.lds + cfo[ks]);
            const LAS float* const acs_l = acs + 16 * gq; const LAS float* const dtl_l = dtl + 16 * gq;
            f32x4 acc[4][4]; float aq[4];
#pragma unroll
            for (int r = 0; r < 4; ++r) { aq[r] = acs[(q0 + ql) * 4 + r];
#pragma unroll
                for (int pf = 0; pf < 4; ++pf) acc[r][pf] = (f32x4){0.f, 0.f, 0.f, 0.f}; }
#pragma unroll
            for (int ks = 0; ks < 4; ++ks) if (2 * ks <= w) {
                f32x4 cb[2];
#pragma unroll
                for (int hf = 0; hf < 2; ++hf) { cb[hf] = (f32x4){0.f, 0.f, 0.f, 0.f};
                    if (2 * ks + hf <= w) {
#pragma unroll
                        for (int kn = 0; kn < 4; ++kn) { const bf16x8 bfr = *(const LAS bf16x8*)(F.lds + bbo[kn] + 4096 * (2 * ks + hf)); cb[hf] = __builtin_amdgcn_mfma_f32_16x16x32_bf16(bfr, cf[kn], cb[hf], 0, 0, 0); } } }
#pragma unroll
                for (int r = 0; r < 4; ++r) {
                    const float Dh = *(const GAS float*)(F.in[I_DSKIP] + g * HPG + r);
                    float v[8];
#pragma unroll
                    for (int hf = 0; hf < 2; ++hf) { const int sf = 2 * ks + hf;
#pragma unroll
                        for (int rg = 0; rg < 4; ++rg) { const int sl = 4 * gq + rg;
                            float val = 0.f;
                            if (sf <= w) { const float as = acs_l[64 * sf + 4 * rg + r], d = dtl_l[64 * sf + 4 * rg + r];
                                val = cb[hf][rg] * __expf(aq[r] - as) * d;
                                if (sf == w) { if (sl > ql) val = 0.f; else if (sl == ql) val += Dh; } }
                            v[4 * hf + rg] = val; } }
                    u32x4 pk; pk.x = cvt_pk_bf16(v[0], v[1]); pk.y = cvt_pk_bf16(v[2], v[3]); pk.z = cvt_pk_bf16(v[4], v[5]); pk.w = cvt_pk_bf16(v[6], v[7]);
                    const bf16x8 wf = __builtin_bit_cast(bf16x8, pk);
#pragma unroll
                    for (int pf = 0; pf < 4; ++pf) {
                        const LAS unsigned char* const xb = F.lds + xbo[r & 1][pf] + (r >> 1) * 32768 + 8192 * ks;
                        const bf16x8 xf = tr_pair(xb, xb + 4096);
                        acc[r][pf] = __builtin_amdgcn_mfma_f32_16x16x32_bf16(xf, wf, acc[r][pf], 0, 0, 0); }
                }
            }
            LAS unsigned char* const stg = F.lds + IMG_C + w * 4096;
            bf16_t* const og = XBC + (row0 + q0 + (lane >> 4)) * CD + g * 256 + 8 * (lane & 15);
#pragma unroll
            for (int h = 0; h < 2; ++h) {
#pragma unroll
                for (int rr = 0; rr < 2; ++rr)
#pragma unroll
                    for (int pf = 0; pf < 4; ++pf) { const int r = 2 * h + rr, ch = 8 * rr + 2 * pf + (gq >> 1);
                        u32x2 o; o.x = cvt_pk_bf16(acc[r][pf][0], acc[r][pf][1]); o.y = cvt_pk_bf16(acc[r][pf][2], acc[r][pf][3]);
                        *(LAS u32x2*)(stg + ql * 256 + ((ch ^ ql) & 15) * 16 + (gq & 1) * 8) = o; }
                asm volatile("s_waitcnt lgkmcnt(0)" ::: "memory");
#pragma unroll
                for (int i = 0; i < 4; ++i) { const int row = 4 * i + (lane >> 4); const u32x4 v = *(const LAS u32x4*)(stg + row * 256 + (((lane & 15) ^ row) & 15) * 16); *(GAS u32x4*)(og + (size_t)(4 * i) * CD + 128 * h) = v; }
                asm volatile("s_waitcnt lgkmcnt(0)" ::: "memory");
            }
            if (gq == 0) *(GAS f32x4*)(EAQ + (row0 + q0 + ql) * 32 + g * HPG) = (f32x4){__expf(aq[0]), __expf(aq[1]), __expf(aq[2]), __expf(aq[3])};
        }
        asm volatile("" ::: "memory"); __builtin_amdgcn_sched_barrier(0);
        if (it + F.G < NIT) { const int it2 = it + F.G, g2 = it2 & 7, c2 = (it2 >> 3) & (NCHUNK - 1), b2 = it2 >> 7; const size_t row2 = (size_t)b2 * SEQ + (size_t)c2 * 128;
            ssd_conv_load(F, row2, b2, c2, g2, raw); ssd_tables_load(F, row2, g2, d0, d1); }
        {
            const int head = g * HPG + hr;
            bf16_t* const stp = ST + ((((size_t)b * NCHUNK + c) * NH + head) * HD) * DSTATE + 64 * nh;
            LAS unsigned char* const stg = F.lds + IMG_C + w * 4096;
#pragma unroll
            for (int ph2 = 0; ph2 < 2; ++ph2) {
                f32x4 acc[4][2];
#pragma unroll
                for (int i = 0; i < 4; ++i)
#pragma unroll
                    for (int j = 0; j < 2; ++j) acc[i][j] = (f32x4){0.f, 0.f, 0.f, 0.f};
#pragma unroll
                for (int ks = 0; ks < 4; ++ks) {
                    asm volatile("" ::: "memory");
                    float sd[8];
#pragma unroll
                    for (int j = 0; j < 8; ++j) sd[j] = sdec[(32 * ks + 16 * (j >> 2) + 4 * gq + (j & 3)) * 4 + hr];
                    bf16x8 af[4], xf[2];
#pragma unroll
                    for (int nf = 0; nf < 4; ++nf) { const LAS unsigned char* p = F.lds + sbo[nf] + 8192 * ks; af[nf] = tr_pair(p, p + 4096); }
#pragma unroll
                    for (int pf = 0; pf < 2; ++pf) { const LAS unsigned char* p = F.lds + xbo[hr & 1][2 * ph2 + pf] + (hr >> 1) * 32768 + 8192 * ks;
                        const u32x4 xr = __builtin_bit_cast(u32x4, tr_pair(p, p + 4096));
                        u32x4 xs; xs.x = cvt_pk_bf16(bflo(xr.x) * sd[0], bfhi(xr.x) * sd[1]); xs.y = cvt_pk_bf16(bflo(xr.y) * sd[2], bfhi(xr.y) * sd[3]);
                        xs.z = cvt_pk_bf16(bflo(xr.z) * sd[4], bfhi(xr.z) * sd[5]); xs.w = cvt_pk_bf16(bflo(xr.w) * sd[6], bfhi(xr.w) * sd[7]);
                        xf[pf] = __builtin_bit_cast(bf16x8, xs); }
#pragma unroll
                    for (int nf = 0; nf < 4; ++nf)
#pragma unroll
                        for (int pf = 0; pf < 2; ++pf) acc[nf][pf] = __builtin_amdgcn_mfma_f32_16x16x32_bf16(af[nf], xf[pf], acc[nf][pf], 0, 0, 0);
                }
#pragma unroll
                for (int pf = 0; pf < 2; ++pf)
#pragma unroll
                    for (int nf = 0; nf < 4; ++nf) { const int row = 16 * pf + ql, ch = 2 * nf + (gq >> 1);
                        u32x2 o; o.x = cvt_pk_bf16(acc[nf][pf][0], acc[nf][pf][1]); o.y = cvt_pk_bf16(acc[nf][pf][2], acc[nf][pf][3]);
                        *(LAS u32x2*)(stg + row * 128 + ((ch ^ row) & 7) * 16 + (gq & 1) * 8) = o; }
                asm volatile("s_waitcnt lgkmcnt(0)" ::: "memory");
#pragma unroll
                for (int i = 0; i < 4; ++i) { const int row = 8 * i + (lane_ >> 3), ch = lane_ & 7;
                    const u32x4 v = *(const LAS u32x4*)(stg + row * 128 + ((ch ^ row) & 7) * 16);
                    *(GAS u32x4*)(stp + (size_t)(32 * ph2 + row) * DSTATE + 8 * ch) = v; }
                asm volatile("s_waitcnt lgkmcnt(0)" ::: "memory");
            }
            if (F.tid < 4) *(GAS float*)(CDEC + ((size_t)b * NCHUNK + c) * NH + g * HPG + F.tid) = __expf(acs[127 * 4 + F.tid]);
        }
        __syncthreads();
    }
}
__device__ __forceinline__ void ssd_final_phase(Frame& F) {
    const bf16_t* const XBC = (const bf16_t*)(F.ws + WS_XBC); const bf16_t* const HP = (const bf16_t*)(F.ws + WS_HPREV); bf16_t* const ZY = (bf16_t*)(F.ws + WS_Z); const float* const EAQ = (const float*)(F.ws + WS_EAQ);
    const int w = F.wave, lane = F.lane, ql = lane & 15, gq = lane >> 4, q0 = 16 * w;
    int cfo[4], hbo[4];
#pragma unroll
    for (int ks = 0; ks < 4; ++ks) { cfo[ks] = IMG_C + img_off<false>(q0 + ql, 4 * ks + gq); hbo[ks] = img_off<false>(ql, 4 * ks + gq); }
    LAS unsigned char* const stg = F.lds + IMG_B + w * 4096;
    const int st_g = ((lane >> 4) * 256) + ((((lane & 15) ^ (lane >> 4))) * 16);
    u32x4 creg[4], hreg[8];
    constexpr int NIT = BATCH * NCHUNK * NG;
    auto loads = [&](int it) __attribute__((always_inline)) {
        const int g = it & 7, c = (it >> 3) & (NCHUNK - 1), b = it >> 7; const size_t row0 = (size_t)b * SEQ + (size_t)c * 128;
#pragma unroll
        for (int i = 0; i < 4; ++i) { const int e = F.tid + 512 * i; creg[i] = *(const GAS u32x4*)(XBC + (row0 + (e >> 4)) * CD + DI + NG * DSTATE + g * DSTATE + 8 * (e & 15)); }
        if (c > 0) { const u32x4* hsrc = (const u32x4*)(HP + ((((size_t)b * NCHUNK + c) * NH + g * HPG) * HD) * DSTATE) + F.tid;
#pragma unroll
            for (int i = 0; i < 8; ++i) hreg[i] = *(const GAS u32x4*)(hsrc + 512 * i); } };
    if (F.vcu < NIT) loads(F.vcu);
    for (int it = F.vcu; it < NIT; it += F.G) {
        const int g = it & 7, c = (it >> 3) & (NCHUNK - 1), b = it >> 7;
        const size_t row0 = (size_t)b * SEQ + (size_t)c * 128;
#pragma unroll
        for (int i = 0; i < 4; ++i) { const int e = F.tid + 512 * i; *(LAS u32x4*)(F.lds + IMG_C + img_off<false>(e >> 4, e & 15)) = creg[i]; }
        if (c > 0) {
#pragma unroll
            for (int i = 0; i < 8; ++i) { const int e = F.tid + 512 * i, hr_ = e >> 10, p_ = (e >> 4) & 63, ch_ = e & 15; *(LAS u32x4*)(F.lds + IMG_X + hr_ * 16384 + img_off<false>(p_, ch_)) = hreg[i]; } }
        __syncthreads();
        if (it + F.G < NIT) loads(it + F.G);
        bf16x8 cf[4];
#pragma unroll
        for (int ks = 0; ks < 4; ++ks) cf[ks] = *(const LAS bf16x8*)(F.lds + cfo[ks]);
        const f32x4 eaq = *(const GAS f32x4*)(EAQ + (row0 + q0 + ql) * 32 + g * HPG);
        const size_t grow = row0 + q0 + (lane >> 4);
        const bf16_t* const zg = ZY + grow * DI + g * 256 + 8 * (lane & 15); const bf16_t* const yg = XBC + grow * CD + g * 256 + 8 * (lane & 15);
        u32x4 zin[2][4], yin[2][4];
#pragma unroll
        for (int h = 0; h < 2; ++h)
#pragma unroll
            for (int i = 0; i < 4; ++i) { zin[h][i] = *(const GAS u32x4*)(zg + (size_t)(4 * i) * DI + 128 * h); yin[h][i] = *(const GAS u32x4*)(yg + (size_t)(4 * i) * CD + 128 * h); }
        f32x4 acc[4][4]; float ssum = 0.f;
#pragma unroll
        for (int h = 0; h < 2; ++h) {
            u32x2 zr[2][4], yr[2][4];
#pragma unroll
            for (int i = 0; i < 4; ++i) { const int row = 4 * i + (lane >> 4); *(LAS u32x4*)(stg + row * 256 + (((lane & 15) ^ row) & 15) * 16) = zin[h][i]; }
            asm volatile("s_waitcnt lgkmcnt(0)" ::: "memory");
#pragma unroll
            for (int rr = 0; rr < 2; ++rr)
#pragma unroll
                for (int pf = 0; pf < 4; ++pf) { const int ch = 8 * rr + 2 * pf + (gq >> 1); zr[rr][pf] = *(const LAS u32x2*)(stg + ql * 256 + ((ch ^ ql) & 15) * 16 + (gq & 1) * 8); }
            asm volatile("s_waitcnt lgkmcnt(0)" ::: "memory");
#pragma unroll
            for (int i = 0; i < 4; ++i) { const int row = 4 * i + (lane >> 4); *(LAS u32x4*)(stg + row * 256 + (((lane & 15) ^ row) & 15) * 16) = yin[h][i]; }
            asm volatile("s_waitcnt lgkmcnt(0)" ::: "memory");
#pragma unroll
            for (int rr = 0; rr < 2; ++rr)
#pragma unroll
                for (int pf = 0; pf < 4; ++pf) { const int ch = 8 * rr + 2 * pf + (gq >> 1); yr[rr][pf] = *(const LAS u32x2*)(stg + ql * 256 + ((ch ^ ql) & 15) * 16 + (gq & 1) * 8); }
            asm volatile("s_waitcnt lgkmcnt(0)" ::: "memory");
#pragma unroll
            for (int rr = 0; rr < 2; ++rr) { const int r = 2 * h + rr;
#pragma unroll
                for (int pf = 0; pf < 4; ++pf) { f32x4 yo = (f32x4){0.f, 0.f, 0.f, 0.f};
                    if (c > 0) {
#pragma unroll
                        for (int ks = 0; ks < 4; ++ks) { const bf16x8 hf_ = *(const LAS bf16x8*)(F.lds + IMG_X + r * 16384 + hbo[ks] + 4096 * pf); yo = __builtin_amdgcn_mfma_f32_16x16x32_bf16(hf_, cf[ks], yo, 0, 0, 0); } }
                    const u32x2 zz = zr[rr][pf], yy = yr[rr][pf];
                    const f32x4 y = ((f32x4){bflo(yy.x), bfhi(yy.x), bflo(yy.y), bfhi(yy.y)} + yo * eaq[r]) * (f32x4){bflo(zz.x), bfhi(zz.x), bflo(zz.y), bfhi(zz.y)};
                    acc[r][pf] = y; ssum += (y[0] * y[0] + y[1] * y[1]) + (y[2] * y[2] + y[3] * y[3]); } }
        }
        ssum += __shfl_xor(ssum, 16); ssum += __shfl_xor(ssum, 32);
        const float rsn = __builtin_amdgcn_rsqf(ssum * (1.0f / 256.0f) + EPS);
        bf16_t* const og = ZY + grow * DI + g * 256 + 8 * (lane & 15);
#pragma unroll
        for (int h = 0; h < 2; ++h) {
#pragma unroll
            for (int rr = 0; rr < 2; ++rr)
#pragma unroll
                for (int pf = 0; pf < 4; ++pf) { const int r = 2 * h + rr, ch = 8 * rr + 2 * pf + (gq >> 1);
                    u32x2 o; o.x = cvt_pk_bf16(acc[r][pf][0] * rsn, acc[r][pf][1] * rsn); o.y = cvt_pk_bf16(acc[r][pf][2] * rsn, acc[r][pf][3] * rsn);
                    *(LAS u32x2*)(stg + ql * 256 + ((ch ^ ql) & 15) * 16 + (gq & 1) * 8) = o; }
            asm volatile("s_waitcnt lgkmcnt(0)" ::: "memory");
#pragma unroll
            for (int i = 0; i < 4; ++i) { const int row = 4 * i + (lane >> 4); const u32x4 v = *(const LAS u32x4*)(stg + row * 256 + (((lane & 15) ^ row) & 15) * 16); *(GAS u32x4*)(og + (size_t)(4 * i) * DI + 128 * h) = v; }
            asm volatile("s_waitcnt lgkmcnt(0)" ::: "memory");
        }
        __syncthreads();
    }
}

__device__ __forceinline__ void ssd_seq_phase(Frame& F) {
    const int r = F.wave & 3, nh = F.wave >> 2, lane = F.lane, idx = r * 64 + lane;
    LAS float* const bc = (LAS float*)F.lds;
    LAS float* const lxs = bc + 2048;
    LAS float* const yp = bc + 4096;
    LAS float* const ldt = bc + 8192; LAS float* const ssq = bc + 8192 + 32;
    const bf16_t* const XBC = (const bf16_t*)(F.ws + WS_XBC); const bf16_t* const Zs = (const bf16_t*)(F.ws + WS_Z); bf16_t* const YN = (bf16_t*)(F.ws + WS_Z);
    const float* const DT = (const float*)(F.ws + WS_DT);
    const float* const convw = F.in[I_CONVW]; const float* const convb = F.in[I_CONVB];
    const int pg = lane >> 4, nc = lane & 15;
    float cw[4], cbv, x3, x2, x1, dtl_; bf16_t xr[8];
#define SEQ_LOAD_S1(it_) do { const int b_ = (it_) >> 3, g_ = (it_) & 7; const size_t row0_ = (size_t)MP + (size_t)b_ * DECS; \
        const int ch_ = (nh == 0) ? ((idx < 128) ? (DI + g_ * DSTATE + idx) : (DI + NG * DSTATE + g_ * DSTATE + (idx - 128))) : (g_ * 256 + idx); \
        _Pragma("unroll") for (int k = 0; k < 4; ++k) cw[k] = *(const GAS float*)(convw + (size_t)k * CD + ch_); \
        cbv = *(const GAS float*)(convb + ch_); \
        { const float* cs_ = F.in[I_CONV] + (size_t)b_ * 3 * CD; x3 = *(const GAS float*)(cs_ + ch_); x2 = *(const GAS float*)(cs_ + CD + ch_); x1 = *(const GAS float*)(cs_ + 2 * CD + ch_); } \
        _Pragma("unroll") for (int j = 0; j < 8; ++j) xr[j] = *(const GAS bf16_t*)(XBC + (row0_ + j) * CD + ch_); \
        dtl_ = 0.f; if (nh == 1 && lane < 8) dtl_ = *(const GAS float*)(DT + (row0_ + lane) * 32 + g_ * HPG + r); } while (0)
    if (F.vcu < DECB * NG) SEQ_LOAD_S1(F.vcu);
    for (int it = F.vcu; it < DECB * NG; it += F.G) {
        const int b = it >> 3, g = it & 7, head = g * HPG + r;
        const size_t row0 = (size_t)MP + (size_t)b * DECS;
        const int xch = g * 256 + idx;
        f32x4 h[16];
        { const float* const hin = F.in[I_SSM] + (((size_t)b * NH + head) * HD + 16 * pg) * DSTATE + 64 * nh + 4 * nc;
#pragma unroll
          for (int i = 0; i < 16; ++i) h[i] = *(const GAS f32x4*)(hin + (size_t)i * DSTATE); }
        bf16_t zv[4];
#pragma unroll
        for (int jj = 0; jj < 4; ++jj) zv[jj] = *(const GAS bf16_t*)(Zs + (row0 + 4 * nh + jj) * DI + xch);
        const float Ah = -__expf(*(const GAS float*)(F.in[I_ALOG] + head)), Dh = *(const GAS float*)(F.in[I_DSKIP] + head);
        {
            LAS float* const dst = (nh == 0) ? bc : lxs;
#pragma unroll
            for (int j = 0; j < 8; ++j) {
                const float xv = bf2f(xr[j]);
                const float cx = cbv + cw[0] * x3 + cw[1] * x2 + cw[2] * x1 + cw[3] * xv; x3 = x2; x2 = x1; x1 = xv;
                dst[j * 256 + idx] = silu_f(cx);
            }
            if (nh == 1 && lane < 8) ldt[lane * 4 + r] = dtl_;
        }
        __syncthreads();
        if (it + F.G < DECB * NG) SEQ_LOAD_S1(it + F.G);
        {
            for (int j = 0; j < 8; ++j) {
                const float dtv = ldt[j * 4 + r], dA = __expf(dtv * Ah);
                const f32x4 Bv = *(const LAS f32x4*)(bc + j * 256 + 64 * nh + 4 * nc), Cv = *(const LAS f32x4*)(bc + j * 256 + 128 + 64 * nh + 4 * nc);
                float part[16];
#pragma unroll
                for (int i4 = 0; i4 < 4; ++i4) { const f32x4 xs4 = *(const LAS f32x4*)(lxs + j * 256 + r * 64 + 16 * pg + 4 * i4);
#pragma unroll
                    for (int k = 0; k < 4; ++k) { const int i = 4 * i4 + k; const float dx = dtv * xs4[k];
                        h[i] = h[i] * dA + Bv * dx;
                        part[i] = (Cv.x * h[i].x + Cv.y * h[i].y) + (Cv.z * h[i].z + Cv.w * h[i].w); } }
#pragma unroll
                for (int i = 0; i < 8; ++i) { const bool up = (nc & 8) != 0; const float keep = up ? part[i + 8] : part[i], send = up ? part[i] : part[i + 8]; part[i] = keep + __shfl_xor(send, 8); }
#pragma unroll
                for (int i = 0; i < 4; ++i) { const bool up = (nc & 4) != 0; const float keep = up ? part[i + 4] : part[i], send = up ? part[i] : part[i + 4]; part[i] = keep + __shfl_xor(send, 4); }
#pragma unroll
                for (int i = 0; i < 2; ++i) { const bool up = (nc & 2) != 0; const float keep = up ? part[i + 2] : part[i], send = up ? part[i] : part[i + 2]; part[i] = keep + __shfl_xor(send, 2); }
                { const bool up = (nc & 1) != 0; const float keep = up ? part[1] : part[0], send = up ? part[0] : part[1]; part[0] = keep + __shfl_xor(send, 1); }
                yp[(j * 2 + nh) * 256 + r * 64 + 16 * pg + nc] = part[0];
            }
            float* const hout = F.out + O_SSM_S + (((size_t)b * NH + head) * HD + 16 * pg) * DSTATE + 64 * nh + 4 * nc;
#pragma unroll
            for (int i = 0; i < 16; ++i) *(GAS f32x4*)(hout + (size_t)i * DSTATE) = h[i];
        }
        __syncthreads();
        float ygv[4];
        {
#pragma unroll
            for (int jj = 0; jj < 4; ++jj) { const int j = 4 * nh + jj;
                const float y = (yp[(j * 2) * 256 + idx] + yp[(j * 2 + 1) * 256 + idx]) + Dh * lxs[j * 256 + idx];
                ygv[jj] = y * bf2f(zv[jj]);
                const float ss = wave_sum(ygv[jj] * ygv[jj]);
                if (lane == 0) ssq[j * 4 + r] = ss; }
        }
        __syncthreads();
#pragma unroll
        for (int jj = 0; jj < 4; ++jj) { const int j = 4 * nh + jj;
            const f32x4 s4 = *(const LAS f32x4*)(ssq + j * 4);
            const float rsn = __builtin_amdgcn_rsqf(((s4.x + s4.y) + (s4.z + s4.w)) * (1.0f / 256.0f) + EPS);
            *(GAS bf16_t*)(YN + (row0 + j) * DI + xch) = (bf16_t)f2bf(ygv[jj] * rsn); }
        __syncthreads();
    }
#undef SEQ_LOAD_S1
}
template <int W> __device__ __forceinline__ void pool_run(const bf16_t* V, bf16_t* PO, int run, int cv) {
    const int row0 = run * 16, t0 = row0 & (SEQ - 1);
    u32x4 raw[16 + W - 1];
#pragma unroll
    for (int e = 0; e < 16 + W - 1; ++e) {
        const int dt_ = e - (W - 1);
        if (t0 + dt_ >= 0) raw[e] = *(const GAS u32x4*)(V + (size_t)(row0 + dt_) * PD + cv); else raw[e] = (u32x4){0u, 0u, 0u, 0u};
    }
    f32x4 s0 = (f32x4){0.f, 0.f, 0.f, 0.f}, s1 = s0;
#pragma unroll
    for (int e = 0; e < W - 1; ++e) { f32x4 x0, x1; pg8::unpack8(raw[e], x0, x1); s0 += x0; s1 += x1; }
#pragma unroll
    for (int i = 0; i < 16; ++i) {
        f32x4 c0, c1; pg8::unpack8(raw[i + W - 1], c0, c1);
        s0 += c0; s1 += c1;
        const int t = t0 + i; const float ic = 1.0f / (float)((t + 1 < W) ? t + 1 : W);
        const f32x4 o0 = s0 * ic - c0, o1 = s1 * ic - c1;
        u32x4 o; o.x = pk2(o0.x, o0.y); o.y = pk2(o0.z, o0.w); o.z = pk2(o1.x, o1.y); o.w = pk2(o1.z, o1.w);
        *(GAS u32x4*)(PO + (size_t)(row0 + i) * PD + cv) = o;
        f32x4 x0, x1; pg8::unpack8(raw[i], x0, x1); s0 -= x0; s1 -= x1;
    }
}
template <int W> __device__ __forceinline__ void pool_run_s(const bf16_t* V, bf16_t* PO, const float* sp, int b, int cv) {
    const size_t row0 = (size_t)MP + (size_t)b * DECS;
    f32x4 a0[8 + W - 1], a1[8 + W - 1];
#pragma unroll
    for (int e = 0; e < 8 + W - 1; ++e) { const int t = e - (W - 1);
        if (t >= 0) pg8::unpack8(*(const GAS u32x4*)(V + (row0 + t) * PD + cv), a0[e], a1[e]);
        else { const float* p = sp + ((size_t)b * PBUF + (PBUF + t)) * PD + cv; a0[e] = *(const GAS f32x4*)p; a1[e] = *(const GAS f32x4*)(p + 4); } }
    f32x4 s0 = (f32x4){0.f, 0.f, 0.f, 0.f}, s1 = s0;
#pragma unroll
    for (int e = 0; e < W - 1; ++e) { s0 += a0[e]; s1 += a1[e]; }
    const float ic = 1.0f / (float)W;
#pragma unroll
    for (int i = 0; i < 8; ++i) {
        s0 += a0[i + W - 1]; s1 += a1[i + W - 1];
        const f32x4 o0 = s0 * ic - a0[i + W - 1], o1 = s1 * ic - a1[i + W - 1];
        u32x4 o; o.x = pk2(o0.x, o0.y); o.y = pk2(o0.z, o0.w); o.z = pk2(o1.x, o1.y); o.w = pk2(o1.z, o1.w);
        *(GAS u32x4*)(PO + (row0 + i) * PD + cv) = o;
        s0 -= a0[i]; s1 -= a1[i];
    }
}
__device__ __forceinline__ void pool_phase(Frame& F) {
    const bf16_t* const V = (const bf16_t*)(F.ws + WS_V); bf16_t* const PO = (bf16_t*)(F.out + O_Y);
    const float* const sp = F.in[I_POOL];
    const int gt = F.vcu * NTHREADS + F.tid, NT = F.G * NTHREADS;
    for (int e = gt; e < (MP / 16) * 128; e += NT) {
        const int c32 = e & 31, rl = (e >> 5) & 1, grp = (e >> 6) & 3, run = (e >> 8) * 2 + rl, cv = (grp * 32 + c32) * 8;
        if (grp == 0) pool_run<2>(V, PO, run, cv); else if (grp == 1) pool_run<4>(V, PO, run, cv); else if (grp == 2) pool_run<8>(V, PO, run, cv); else pool_run<16>(V, PO, run, cv);
    }
    for (int e = gt; e < (MS / 8) * 128; e += NT) {
        const int c32 = e & 31, grp = (e >> 5) & 3, b = e >> 7, cv = (grp * 32 + c32) * 8;
        if (grp == 0) pool_run_s<2>(V, PO, sp, b, cv); else if (grp == 1) pool_run_s<4>(V, PO, sp, b, cv); else if (grp == 2) pool_run_s<8>(V, PO, sp, b, cv); else pool_run_s<16>(V, PO, sp, b, cv);
    }
    float* const ops = F.out + O_POOL_S;
    for (int e = gt; e < DECB * 7 * (PD / 4); e += NT) {
        const int c4 = e & 255, i = (e >> 8) % 7, b = (e >> 8) / 7;
        *(GAS f32x4*)(ops + ((size_t)b * PBUF + i) * PD + c4 * 4) = *(const GAS f32x4*)(sp + ((size_t)b * PBUF + 8 + i) * PD + c4 * 4);
    }
}
__device__ __forceinline__ void final_phase(Frame& F) {
    const int gw = F.vcu * NWAVES + F.wave, NGW = F.G * NWAVES, lane = F.lane;
    const float* const st = (const float*)(F.ws + WS_STATS_A); const float* const gf = F.in[I_NFINAL];
    f32x4 gv[4];
#pragma unroll
    for (int j = 0; j < 4; ++j) gv[j] = *((const GAS f32x4*)gf + lane + 64 * j);
    const bf16_t* const h4 = (const bf16_t*)(F.ws + WS_ACT);
    for (int m = gw; m < M; m += NGW) {
        const GAS f32x4* sp = (const GAS f32x4*)(st + (size_t)m * 16);
        const f32x4 a = sp[0], b = sp[1], c = sp[2], d = sp[3]; const f32x4 s = (a + b) + (c + d);
        const float rs = __builtin_amdgcn_rsqf(((s[0] + s[1]) + (s[2] + s[3])) * (1.0f / 1024.0f) + EPS);
        const GAS u32x2* hr = (const GAS u32x2*)(h4 + (size_t)m * DM) + lane;
        GAS f32x4* yr = (GAS f32x4*)(F.out + (size_t)m * DM) + lane;
#pragma unroll
        for (int j = 0; j < 4; ++j) { const u32x2 w = hr[64 * j]; yr[64 * j] = (f32x4){bflo(w.x), bfhi(w.x), bflo(w.y), bfhi(w.y)} * rs * gv[j]; }
    }
}

constexpr int NPHASES = 13;
struct Args { const float* in[30]; float* out; unsigned char* ws; int ph_lo, ph_hi, li, pad; };
__global__ void __launch_bounds__(NTHREADS, 2) mk_fwd(Args args) {
    extern __shared__ __attribute__((aligned(16))) unsigned char lds[];
    Frame F;
    F.lds = (LAS unsigned char*)lds;
    F.MISC = (volatile LAS unsigned*)(F.lds + MISC_OFF);
    F.tid = threadIdx.x; F.lane = F.tid & 63; F.wave = __builtin_amdgcn_readfirstlane(F.tid >> 6);
    F.G = gridDim.x; { const int bx = blockIdx.x; F.vcu = (F.G % 8 == 0) ? (bx % 8) * (F.G / 8) + bx / 8 : bx; }
    F.ws = args.ws; F.out = args.out; F.ctl = (gu32*)(args.ws + WS_CTL);
#pragma unroll
    for (int i = 0; i < 30; ++i) F.in[i] = args.in[i];
    for (int u = F.tid; u < (LDS_BYTES - LDSCTL_OFF) / 4; u += NTHREADS) ((LAS unsigned*)(F.lds + LDSCTL_OFF))[u] = 0u;
    __syncthreads();
    const int lo = args.ph_lo, hi = args.ph_hi;
    XcdBarrier bar; bar.bar = (unsigned*)(F.ctl + CW_BAR); bar.x = 0; bar.st = nullptr;
    if (hi - lo > 1) bar = xcd_barrier_post((unsigned*)(F.ctl + CW_BAR), F.MISC + 8);
#ifndef PHMASK
#define PHMASK 0x1fff
#endif
#define IN(k) (((PHMASK >> (k)) & 1) && lo <= (k) && (k) < hi)
#define SEAM(k) do { if (IN(k) && IN((k) + 1)) xcd_barrier(bar); } while (0)
#define PH_BEGIN(k) if (IN(k)) { auto body_ = [&]() __attribute__((always_inline))
#define PH_END(k) ; body_(); if ((REP_MASK >> (k)) & 1) { xcd_barrier(bar); body_(); } } SEAM(k);

    bf16_t* const XB = (bf16_t*)(F.ws + WS_XB); bf16_t* const HB = (bf16_t*)(F.ws + WS_HB); bf16_t* const ACT = (bf16_t*)(F.ws + WS_ACT);
    bf16_t* const Zb = (bf16_t*)(F.ws + WS_Z); bf16_t* const XBCb = (bf16_t*)(F.ws + WS_XBC); bf16_t* const Vb = (bf16_t*)(F.ws + WS_V); bf16_t* const GATES = (bf16_t*)(F.ws + WS_GATES);
    bf16_t* const POOLED = (bf16_t*)(F.out + O_Y); bf16_t* const MERGED = (bf16_t*)(F.ws + WS_MERGED); bf16_t* const Qb = (bf16_t*)(F.ws + WS_Q); bf16_t* const PB = (bf16_t*)(F.ws + WS_PB);
    float* const T1 = (float*)(F.ws + WS_T1); float* const stA = (float*)(F.ws + WS_STATS_A); float* const stB = (float*)(F.ws + WS_STATS_B); float* const DTb = (float*)(F.ws + WS_DT);
    float* const H = F.out + O_Y;
    pg8::StaticOrder S;

    PH_BEGIN(0) { p0_prologue(F); } PH_END(0)
    PH_BEGIN(1) {
        pg8::Gemm g{XB, (const bf16_t*)(F.ws + WS_WGU1), M, 2 * DFF, DM, DM, 0}; S.init(M, 2 * DFF, F.G, (int)blockIdx.x);
        pg8::Epi E{}; E.kind = pg8::EK_GU; E.stats_in = stA; E.obf = ACT; E.ldo = DFF;
        const int u1 = 1 + (int)blockIdx.x % 5; S.lim = min(S.nwg, u1 * F.G);
#pragma nounroll
        for (int part = 0; part < 2; ++part) {
            pg8::gemm_phase(F.lds, g, S, E);
            if (part == 0) { deferred_transposes<1>(F); S.c += u1 * F.G; S.lim = S.nwg; }
        }
        pg8::Gemm g2{(const bf16_t*)(F.ws + WS_WPOT), (const bf16_t*)(F.ws + WS_WGRP), DM, DM, 256, DM, 256}; S.init_tail(DM, DM, F.G, (int)blockIdx.x);
        pg8::Epi E2{}; E2.kind = pg8::EK_BF16; E2.obf = (bf16_t*)(F.ws + WS_W2); E2.ldo = DM;
        pg8::gemm_phase(F.lds, g2, S, E2);
    } PH_END(1)
    PH_BEGIN(2) {
        pg8::Gemm g{ACT, (const bf16_t*)(F.ws + WS_WD1), M, DM, DFF, DFF, 0}; S.init(MP, DM, F.G, (int)blockIdx.x);
        pg8::Epi E{}; E.kind = pg8::EK_RES; E.coef = 0.5f; E.res_bf = HB; E.obf = HB; E.stats_out = stB;
        pg8::gemm_phase(F.lds, g, S, E);
        pg8::gemm_small(F.lds, g, E, MP, MS, F.G, (int)blockIdx.x);
    } PH_END(2)
    PH_BEGIN(3) {
        pg8::Gemm g{HB, (const bf16_t*)(F.ws + WS_WIN), M, NIN, DM, DM, 0}; S.init(M, NIN, F.G, (int)blockIdx.x);
        pg8::Epi E{}; E.kind = pg8::EK_WIN; E.stats_in = stB; E.Z = Zb; E.XBC = XBCb; E.V = Vb; E.GATES = GATES; E.HALO = (bf16_t*)(F.ws + WS_HALO); E.DT = DTb; E.dt_bias = F.in[I_DTB];
        E.conv_p = F.out + O_CONV_P; E.conv_s = F.out + O_CONV_S; E.pool_p = F.out + O_POOL_P; E.pool_s = F.out + O_POOL_S;
        const int u1 = 1 + (int)blockIdx.x % 9; S.lim = min(S.nwg, u1 * F.G);
#pragma nounroll
        for (int part = 0; part < 2; ++part) {
            pg8::gemm_phase(F.lds, g, S, E);
            if (part == 0) { deferred_transposes<3>(F); S.c += u1 * F.G; S.lim = S.nwg; }
        }
    } PH_END(3)
    PH_BEGIN(4) { ssd_local_phase(F); pool_phase(F); } PH_END(4)
    PH_BEGIN(5) { ssd_scan_phase(F);

        pg8::Gemm g{PB, (const bf16_t*)(F.ws + WS_WPLE), M, DM, PLE, PLE, 0}; S.init(MP, DM, F.G, (int)blockIdx.x);
        pg8::Epi E{}; E.kind = pg8::EK_BF16; E.obf = Qb; E.ldo = DM;
        pg8::gemm_phase(F.lds, g, S, E);
        pg8::gemm_small(F.lds, g, E, MP, MS, F.G, (int)blockIdx.x);
        } PH_END(5)
    PH_BEGIN(6) { ssd_final_phase(F); ssd_seq_phase(F); } PH_END(6)
    PH_BEGIN(7) {
        pg8::Gemm2 g{Zb, (const bf16_t*)(F.ws + WS_WSSO), POOLED, (const bf16_t*)(F.ws + WS_W2), DI, DI, DM, DM, DM}; S.init(MP, DM, F.G, (int)blockIdx.x);
        pg8::gemm_phase2(F.lds, g, S, GATES, MERGED);
        pg8::gemm_small2(F.lds, g, GATES, MERGED, MP, MS, F.G, (int)blockIdx.x);
    } PH_END(7)
    PH_BEGIN(8) {
        pg8::Gemm g{MERGED, (const bf16_t*)(F.ws + WS_WO), M, DM, DM, DM, 0}; S.init(MP, DM, F.G, (int)blockIdx.x);
        pg8::Epi E{}; E.kind = pg8::EK_RES; E.coef = 1.0f; E.res_bf = HB; E.obf = HB; E.stats_out = stA;
        pg8::gemm_phase(F.lds, g, S, E);
        pg8::gemm_small(F.lds, g, E, MP, MS, F.G, (int)blockIdx.x);
    } PH_END(8)
    PH_BEGIN(9) {
        pg8::Gemm g{HB, (const bf16_t*)(F.ws + WS_WGU2), M, 2 * DFF, DM, DM, 0}; S.init(M, 2 * DFF, F.G, (int)blockIdx.x);
        pg8::Epi E{}; E.kind = pg8::EK_GU; E.stats_in = stA; E.obf = ACT; E.ldo = DFF;
        pg8::gemm_phase(F.lds, g, S, E);
    } PH_END(9)
    PH_BEGIN(10) {
        pg8::Gemm g{ACT, (const bf16_t*)(F.ws + WS_WD2), M, DM, DFF, DFF, 0}; S.init(MP, DM, F.G, (int)blockIdx.x);
        pg8::Epi E{}; E.kind = pg8::EK_RES; E.coef = 0.5f; E.res_bf = HB; E.obf = HB; E.stats_out = stB;
        pg8::gemm_phase(F.lds, g, S, E);
        pg8::gemm_small(F.lds, g, E, MP, MS, F.G, (int)blockIdx.x);
    } PH_END(10)
    PH_BEGIN(11) {
        pg8::Gemm g{HB, (const bf16_t*)(F.ws + WS_WPG), M, DM, DM, DM, 0}; S.init(MP, DM, F.G, (int)blockIdx.x);
        pg8::Epi E{}; E.kind = pg8::EK_PLE; E.stats_in = stB; E.q = Qb; E.res_bf = HB; E.obf = ACT; E.stats_out = stA;
        pg8::gemm_phase(F.lds, g, S, E);
        pg8::gemm_small(F.lds, g, E, MP, MS, F.G, (int)blockIdx.x);
    } PH_END(11)
    PH_BEGIN(12) { final_phase(F); } PH_END(12)
#undef IN
#undef SEAM
#undef PH_BEGIN
#undef PH_END
}

extern "C" void kernel_launch(void* const* d_in, const int* in_sizes, int n_in, void* d_out, int out_size, void* d_ws, size_t ws_size, hipStream_t stream) {
    static int grid = 0;
    if (grid == 0) {
        if (n_in != 30 || in_sizes[0] != MP * DM || (size_t)out_size != O_END || ws_size < WS_END) {
            fprintf(stderr, "kernel_launch: shape mismatch: n_in %d in0 %d out %d ws %zu (need %zu)\n", n_in, n_in > 0 ? in_sizes[0] : -1, out_size, ws_size, (size_t)WS_END); grid = -1; return; }
        int dev = 0, cus = 0, per_cu = 0;
        if (hipGetDevice(&dev) != hipSuccess || hipDeviceGetAttribute(&cus, hipDeviceAttributeMultiprocessorCount, dev) != hipSuccess) { grid = -1; return; }
        if (hipFuncSetAttribute((const void*)mk_fwd, hipFuncAttributeMaxDynamicSharedMemorySize, LDS_BYTES) != hipSuccess) { fprintf(stderr, "kernel_launch: hipFuncSetAttribute failed\n"); grid = -1; return; }
        if (hipOccupancyMaxActiveBlocksPerMultiprocessor(&per_cu, (const void*)mk_fwd, NTHREADS, LDS_BYTES) != hipSuccess || per_cu < 1)
            fprintf(stderr, "kernel_launch: occupancy query reports %d workgroups per CU\n", per_cu);
        (void)hipGetLastError();
        grid = cus;
    }
    if (grid < 0) return;
    if (hipMemsetAsync((char*)d_ws + WS_CTL, 0, CTL_ZERO_BYTES, stream) != hipSuccess) { fprintf(stderr, "kernel_launch: memset failed\n"); return; }
    Args a{};
    for (int i = 0; i < 30; ++i) a.in[i] = (const float*)d_in[i];
    a.out = (float*)d_out; a.ws = (unsigned char*)d_ws;
#if MK_MULTI_LAUNCH
    for (int ph = 0; ph < NPHASES; ++ph) { a.ph_lo = ph; a.ph_hi = ph + 1; a.li = ph;
        hipLaunchKernelGGL(mk_fwd, dim3(grid), dim3(NTHREADS), LDS_BYTES, stream, a); }
#else
    a.ph_lo = 0; a.ph_hi = NPHASES; a.li = 0;
    hipLaunchKernelGGL(mk_fwd, dim3(grid), dim3(NTHREADS), LDS_BYTES, stream, a);
#endif
}
```

```cpp
#include <hip/hip_runtime.h>
#include <cstdio>
#include <cstdint>

#define REP_MASK 0x0
#ifndef MK_MULTI_LAUNCH
#define MK_MULTI_LAUNCH 0
#endif

#define GAS __attribute__((address_space(1)))
#define LAS __attribute__((address_space(3)))
typedef unsigned short bf16_t;
typedef short bf16x8 __attribute__((ext_vector_type(8)));
typedef float f32x4 __attribute__((ext_vector_type(4)));
typedef float f32x2 __attribute__((ext_vector_type(2)));
typedef unsigned u32x4 __attribute__((ext_vector_type(4)));
typedef unsigned u32x2 __attribute__((ext_vector_type(2)));
typedef GAS unsigned gu32;

constexpr int DM = 1024, BATCH = 8, SEQ = 2048, DECB = 128, DECS = 8;
constexpr int MP = BATCH * SEQ, MS = DECB * DECS, M = MP + MS;
constexpr int DI = 2048, HD = 64, NH = 32, NG = 8, HPG = 4, DSTATE = 128, CD = 4096;
constexpr int PD = 1024, PBUF = 15, DFF = 2816, PLE = 256;
constexpr int IN_DIM = 9248, NIN = 9472;
constexpr float EPS = 1e-6f;
constexpr int NWAVES = 8, NTHREADS = 512;

constexpr size_t MiB = 1u << 20;
constexpr size_t WS_CTL = 0, CTL_ZERO_BYTES = 32768;
constexpr size_t WS_STATS_A = 2 * MiB, WS_STATS_B = 4 * MiB, WS_DT = 6 * MiB, WS_CDEC = 9 * MiB;
constexpr size_t WS_WGU1 = 10 * MiB, WS_WD1 = 21 * MiB, WS_WIN = 27 * MiB, WS_WSSO = 46 * MiB, WS_W2 = 50 * MiB, WS_WO = 52 * MiB,
                 WS_WGU2 = 54 * MiB, WS_WD2 = 65 * MiB, WS_WPG = 71 * MiB, WS_WPLE = 73 * MiB, WS_PB = 74 * MiB, WS_WPOT = 480 * MiB, WS_WGRP = 483 * MiB;
constexpr size_t WS_Z = 84 * MiB, WS_XBC = 152 * MiB, WS_V = 288 * MiB, WS_GATES = 322 * MiB, WS_HB = 390 * MiB, WS_HPREV = 424 * MiB, WS_HALO = 488 * MiB, WS_EAQ = 492 * MiB, WS_END = 495 * MiB;
constexpr size_t WS_ACT = WS_XBC, WS_T1 = WS_XBC, WS_MERGED = 220 * MiB, WS_Q = WS_V, WS_XB = WS_HB;
static_assert(WS_STATS_A + (size_t)M * 16 * 4 <= WS_STATS_B && WS_STATS_B + (size_t)M * 16 * 4 <= WS_DT && WS_DT + (size_t)M * 32 * 4 <= WS_WGU1, "ws map (small)");
static_assert(WS_WGU1 + (size_t)2 * DFF * DM * 2 <= WS_WD1 && WS_WD1 + (size_t)DM * DFF * 2 <= WS_WIN && WS_WIN + (size_t)NIN * DM * 2 <= WS_WSSO && WS_WSSO + (size_t)DM * DI * 2 <= WS_W2, "ws map (w1)");
static_assert(WS_WGU2 + (size_t)2 * DFF * DM * 2 <= WS_WD2 && WS_WD2 + (size_t)DM * DFF * 2 <= WS_WPG && WS_WPLE + (size_t)DM * PLE * 2 <= WS_PB && WS_PB + (size_t)M * PLE * 2 <= WS_Z, "ws map (w2)");
static_assert(WS_Z + (size_t)M * DI * 2 <= WS_XBC && WS_XBC + (size_t)M * CD * 2 <= WS_V && WS_V + (size_t)M * PD * 2 <= WS_GATES && WS_GATES + (size_t)M * 2 * DM * 2 <= WS_HB &&
              WS_HB + (size_t)M * DM * 2 <= WS_HPREV && WS_HPREV + (size_t)BATCH * 16 * NH * HD * DSTATE * 2 <= WS_END, "ws map (act)");
static_assert(WS_ACT + (size_t)M * DFF * 2 <= WS_V && WS_T1 + (size_t)M * DM * 4 <= WS_MERGED && WS_MERGED + (size_t)M * DM * 2 <= WS_V, "ws overlays");
constexpr int CW_BAR = 4096;

constexpr size_t O_Y = 0, O_SSM_P = (size_t)M * DM, O_CONV_P = O_SSM_P + (size_t)BATCH * NH * HD * DSTATE, O_POOL_P = O_CONV_P + (size_t)BATCH * 3 * CD,
                 O_SSM_S = O_POOL_P + (size_t)BATCH * PBUF * PD, O_CONV_S = O_SSM_S + (size_t)DECB * NH * HD * DSTATE, O_POOL_S = O_CONV_S + (size_t)DECB * 3 * CD,
                 O_END = O_POOL_S + (size_t)DECB * PBUF * PD;

constexpr int RING_BYTES = 131072, LDSCTL_OFF = RING_BYTES, MISC_OFF = LDSCTL_OFF + 320, INP_OFF = LDSCTL_OFF + 512, STB_OFF = RING_BYTES + 1024, XA_OFF = STB_OFF + 16384, XS_OFF = XA_OFF + 4096, LDS_BYTES = 153600;

#define RLX_AGENT __ATOMIC_RELAXED, __HIP_MEMORY_SCOPE_AGENT
#define LDS_WAIT() asm volatile("s_waitcnt lgkmcnt(0)" ::: "memory")
#define VM_WAIT() asm volatile("s_waitcnt vmcnt(0)" ::: "memory")

__device__ __forceinline__ unsigned f2bf(float f) { unsigned u = __builtin_bit_cast(unsigned, f); return (u + 0x7fffu + ((u >> 16) & 1u)) >> 16; }
__device__ __forceinline__ unsigned cvt_pk_bf16(float lo, float hi);
__device__ __forceinline__ unsigned pk2(float lo, float hi) { return cvt_pk_bf16(lo, hi); }
__device__ __forceinline__ float bf2f(unsigned b) { return __builtin_bit_cast(float, b << 16); }
__device__ __forceinline__ float bflo(unsigned w) { return __builtin_bit_cast(float, w << 16); }
__device__ __forceinline__ float bfhi(unsigned w) { return __builtin_bit_cast(float, w & 0xffff0000u); }
typedef __bf16 bf16x2_t __attribute__((ext_vector_type(2)));
__device__ __forceinline__ unsigned cvt_pk_bf16(float lo, float hi) { const bf16x2_t v = {(__bf16)lo, (__bf16)hi}; return __builtin_bit_cast(unsigned, v); }
__device__ __forceinline__ float sigm_f(float x) { return __builtin_amdgcn_rcpf(1.0f + __expf(-x)); }
__device__ __forceinline__ float silu_f(float x) { return x * __builtin_amdgcn_rcpf(1.0f + __expf(-x)); }
__device__ __forceinline__ float wave_sum(float v) {
#pragma unroll
    for (int o = 1; o < 64; o <<= 1) v += __shfl_xor(v, o);
    return v;
}

struct Frame {
    LAS unsigned char* lds;
    volatile LAS unsigned* MISC;
    gu32* ctl;
    int tid, lane, wave, vcu, G;
    unsigned char* ws;
    float* out;
    const float *p_alog, *p_convw, *p_convb, *p_dskip;
};
__device__ __forceinline__ const float* fin(const Frame& F, int i) {
    const u32x2 w = *(const LAS u32x2*)(F.lds + INP_OFF + 8 * i);
    const unsigned lo = __builtin_amdgcn_readfirstlane(w.x), hi = __builtin_amdgcn_readfirstlane(w.y);
    return (const float*)(((unsigned long long)hi << 32) | lo);
}
enum { I_XP = 0, I_XS, I_SSM, I_CONV, I_POOL, I_PP, I_PS, I_NFFN1, I_WGU1, I_WD1, I_NMIX, I_WIN, I_CONVW, I_CONVB, I_DTB, I_ALOG, I_DSKIP, I_NSSD, I_WSSO, I_WPGRP, I_PSCALE,
       I_WPOUT, I_WO, I_NFFN2, I_WGU2, I_WD2, I_NPLE, I_WPG, I_WPLE, I_NFINAL };

namespace pg8 {
constexpr int BM = 256, BK = 64, HALF = 128, HTB = HALF * BK * 2, STAGE_BYTES = 8 * HTB, NXCD = 8, WGM = 4;
__host__ __device__ __forceinline__ int lds_byte(int r, int c) { const int st = (r >> 4) * 2 + (c >> 5), rr = r & 15, cc = c & 31, ob = rr * 64 + cc * 2; return st * 1024 + (ob ^ (((ob >> 9) & 1) << 5)); }
__host__ __device__ __forceinline__ void stage_rc(int b, int& R, int& C) { const int st = b / 1024, sb = b % 1024, swz = sb ^ (((sb >> 9) & 1) << 5); R = (st >> 1) * 16 + swz / 64; C = (st & 1) * 32 + (swz % 64) / 2; }
__host__ __device__ __forceinline__ int perm32(int rho) { const int n = rho >> 4, i = rho & 15; return 8 * (i >> 2) + 4 * n + (i & 3); }
struct Unit { int pm, pn; };
struct Gemm { const bf16_t* A; const bf16_t* Bt; int M, N, K; int lda; int a_pn_step; };
struct StaticOrder {
    int nM, nN, nwg, G, c, lim;
    __host__ __device__ void init(int M_, int N_, int G_, int c_) { nM = M_ / BM; nN = N_ / BM; nwg = nM * nN; G = G_; c = c_; lim = nwg; }
    __host__ __device__ void init_tail(int M_, int N_, int G_, int c_) { init(M_, N_, G_, (G_ - 1) - c_); }
    __host__ __device__ bool next(int i, Unit& u) const {
        const long L = (long)i * G + c; if (L >= lim) return false;
        int wgid = (int)L; { const int q = nwg / NXCD, r = nwg % NXCD, xcd = wgid % NXCD, off = wgid / NXCD; wgid = (xcd < r ? xcd * (q + 1) : r * (q + 1) + (xcd - r) * q) + off; }
        const int nig = WGM * nN, gid = wgid / nig, fm = gid * WGM, gsz = (nM - fm) < WGM ? (nM - fm) : WGM;
        u.pm = fm + ((wgid % nig) % gsz); u.pn = (wgid % nig) / gsz; return true;
    }
};

enum EpiKind { EK_GU = 1, EK_RES = 2, EK_WIN = 3, EK_T1 = 4, EK_MERGE = 5, EK_BF16 = 6, EK_PLE = 7 };
struct Epi {
    const float* stats_in;
    float* stats_out;
    bf16_t* obf;
    float* of32;
    const float* res_p; const float* res_s;
    const bf16_t* res_bf;
    const bf16_t* gates;
    const bf16_t* q;
    bf16_t *Z, *XBC, *V, *GATES, *HALO; float* DT; const float* dt_bias; float *conv_p, *conv_s, *pool_p, *pool_s;
    int kind; int ldo; float coef; int pad;
};

__device__ __forceinline__ u32x4 pack8(const f32x4 a, const f32x4 b) { u32x4 w; w.x = cvt_pk_bf16(a[0], a[1]); w.y = cvt_pk_bf16(a[2], a[3]); w.z = cvt_pk_bf16(b[0], b[1]); w.w = cvt_pk_bf16(b[2], b[3]); return w; }
__device__ __forceinline__ void unpack8(const u32x4 w, f32x4& a, f32x4& b) { a = (f32x4){bflo(w.x), bfhi(w.x), bflo(w.y), bfhi(w.y)}; b = (f32x4){bflo(w.z), bfhi(w.z), bflo(w.w), bfhi(w.w)}; }

__device__ __forceinline__ float row_rs(const float* stats, int row) {
    if (!stats) return 1.0f;
    const GAS f32x4* sp = (const GAS f32x4*)(stats + (size_t)row * 16);
    const f32x4 a = sp[0], b = sp[1], c = sp[2], d = sp[3]; const f32x4 s = (a + b) + (c + d);
    return __builtin_amdgcn_rsqf(((s[0] + s[1]) + (s[2] + s[3])) * (1.0f / 1024.0f) + EPS);
}
__device__ __forceinline__ float row_rs4(const float* stats, int row, int fq) {
    if (!stats) return 1.0f;
    const f32x4 a = *(const GAS f32x4*)(stats + (size_t)row * 16 + 4 * fq);
    float t = (a[0] + a[1]) + (a[2] + a[3]);
    t += __shfl_xor(t, 16); t += __shfl_xor(t, 32);
    return __builtin_amdgcn_rsqf(t * (1.0f / 1024.0f) + EPS);
}
__device__ __forceinline__ float row_rs_lds(const LAS unsigned char* lds, int rl, int fq) {
    const f32x4 a = *(const LAS f32x4*)(lds + STB_OFF + (rl * 4 + fq) * 16);
    float t = (a[0] + a[1]) + (a[2] + a[3]);
    t += __shfl_xor(t, 16); t += __shfl_xor(t, 32);
    return __builtin_amdgcn_rsqf(t * (1.0f / 1024.0f) + EPS);
}
__device__ __forceinline__ float softplus_f(float x) { const float e = __expf(-fabsf(x)); const float l = (e < 0.01f) ? e * (1.0f - e * (0.5f - e * (1.0f / 3.0f))) : __logf(1.0f + e); return fmaxf(x, 0.f) + l; }

__device__ __forceinline__ void epilogue(const Epi& E, const f32x4 (&acc)[2][2][4][2], const Unit& u, int wr, int wc, int fr, int fq, const LAS unsigned char* lds) {
    const int rowb = u.pm * BM + wr * 64 + fr;
    const int cin = wc * 32 + 8 * fq;
    f32x4 rsv0 = (f32x4){1.f, 1.f, 1.f, 1.f}, rsv1 = rsv0;
    if (E.stats_in) {
#pragma unroll
        for (int m = 0; m < 4; ++m) { rsv0[m] = row_rs_lds(lds, wr * 64 + fr + m * 16, fq); rsv1[m] = row_rs_lds(lds, wr * 64 + fr + HALF + m * 16, fq); }
        asm volatile("s_waitcnt lgkmcnt(0)" ::: "memory"); __builtin_amdgcn_s_barrier();
    }
    if (E.kind == EK_GU) {
#pragma unroll
        for (int ai = 0; ai < 2; ++ai)
#pragma unroll
            for (int m = 0; m < 4; ++m) { const int row = rowb + ai * HALF + m * 16; const float r = (ai == 0) ? rsv0[m] : rsv1[m];
                const f32x4 g0 = acc[ai][0][m][0] * r, u0 = acc[ai][1][m][0] * r, g1 = acc[ai][0][m][1] * r, u1 = acc[ai][1][m][1] * r;
                const f32x4 o0 = (f32x4){silu_f(g0[0]) * u0[0], silu_f(g0[1]) * u0[1], silu_f(g0[2]) * u0[2], silu_f(g0[3]) * u0[3]};
                const f32x4 o1 = (f32x4){silu_f(g1[0]) * u1[0], silu_f(g1[1]) * u1[1], silu_f(g1[2]) * u1[2], silu_f(g1[3]) * u1[3]};
                *(GAS u32x4*)(E.obf + (size_t)row * E.ldo + u.pn * HALF + cin) = pack8(o0, o1); }
    } else if (E.kind == EK_RES) {
#pragma unroll
        for (int ai = 0; ai < 2; ++ai) {
            u32x4 rb[4][2];
            if (!E.res_p) {
#pragma unroll
                for (int m = 0; m < 4; ++m)
#pragma unroll
                    for (int bj = 0; bj < 2; ++bj) rb[m][bj] = *(const GAS u32x4*)(E.res_bf + (size_t)(rowb + ai * HALF + m * 16) * DM + u.pn * BM + bj * HALF + cin);
            }
#pragma unroll
            for (int m = 0; m < 4; ++m) { const int row = rowb + ai * HALF + m * 16;
                float ss = 0.f;
#pragma unroll
                for (int bj = 0; bj < 2; ++bj) { const int col = u.pn * BM + bj * HALF + cin;
                    f32x4 r0, r1;
                    if (E.res_p) { const float* rp = (row < MP) ? E.res_p + (size_t)row * DM : E.res_s + (size_t)(row - MP) * DM; r0 = *(const GAS f32x4*)(rp + col); r1 = *(const GAS f32x4*)(rp + col + 4); }
                    else unpack8(rb[m][bj], r0, r1);
                    const f32x4 h0 = r0 + acc[ai][bj][m][0] * E.coef, h1 = r1 + acc[ai][bj][m][1] * E.coef;
                    *(GAS u32x4*)(E.obf + (size_t)row * DM + col) = pack8(h0, h1);
                    ss += (h0[0] * h0[0] + h0[1] * h0[1]) + (h0[2] * h0[2] + h0[3] * h0[3]) + (h1[0] * h1[0] + h1[1] * h1[1]) + (h1[2] * h1[2] + h1[3] * h1[3]); }
                ss += __shfl_xor(ss, 16); ss += __shfl_xor(ss, 32);
                if (fq == 0) *(GAS float*)(E.stats_out + (size_t)row * 16 + u.pn * 4 + wc) = ss; }
        }
    } else if (E.kind == EK_WIN) {
        const int pn = u.pn;
        if (pn < 8) {
            const int colt = pn * BM + cin;
#pragma unroll
            for (int ai = 0; ai < 2; ++ai)
#pragma unroll
                for (int m = 0; m < 4; ++m) { const int row = rowb + ai * HALF + m * 16; const float r = (ai == 0) ? rsv0[m] : rsv1[m];
#pragma unroll
                    for (int bj = 0; bj < 2; ++bj) { f32x4 v0 = acc[ai][bj][m][0] * r, v1 = acc[ai][bj][m][1] * r;
#pragma unroll
                        for (int j = 0; j < 4; ++j) { v0[j] = silu_f(v0[j]); v1[j] = silu_f(v1[j]); }
                        *(GAS u32x4*)(E.Z + (size_t)row * DI + colt + bj * HALF) = pack8(v0, v1); } }
        } else if (pn >= 28 && pn < 36) {
            const int colt = (pn - 28) * BM + cin;
#pragma unroll
            for (int ai = 0; ai < 2; ++ai)
#pragma unroll
                for (int m = 0; m < 4; ++m) { const int row = rowb + ai * HALF + m * 16; const float r = (ai == 0) ? rsv0[m] : rsv1[m];
#pragma unroll
                    for (int bj = 0; bj < 2; ++bj) { f32x4 v0 = acc[ai][bj][m][0] * r, v1 = acc[ai][bj][m][1] * r;
#pragma unroll
                        for (int j = 0; j < 4; ++j) { v0[j] = sigm_f(v0[j]); v1[j] = sigm_f(v1[j]); }
                        *(GAS u32x4*)(E.GATES + (size_t)row * (2 * DM) + colt + bj * HALF) = pack8(v0, v1); } }
        } else if (pn < 28) {
            const bool isx = pn < 24; bf16_t* const O = isx ? E.XBC : E.V; const int ldo = isx ? CD : PD; const int colt = (isx ? pn - 8 : pn - 24) * BM + cin;
            const int keep = isx ? 3 : PBUF;
#pragma unroll
            for (int ai = 0; ai < 2; ++ai)
#pragma unroll
                for (int m = 0; m < 4; ++m) { const int row = rowb + ai * HALF + m * 16; const float r = (ai == 0) ? rsv0[m] : rsv1[m];
                    float* sp = nullptr;
                    if (row < MP) { const int sb = row >> 11, st = row & (SEQ - 1); if (st >= SEQ - keep) sp = (isx ? E.conv_p : E.pool_p) + ((size_t)sb * keep + (st - (SEQ - keep))) * ldo + colt; }
                    else { const int sb = (row - MP) >> 3, st = (row - MP) & 7; const int si = st - (DECS - keep); if (si >= 0) sp = (isx ? E.conv_s : E.pool_s) + ((size_t)sb * keep + si) * ldo + colt; }
                    bf16_t* hp = nullptr;
                    if (isx && row < MP) { const int st = row & (SEQ - 1), tm = st & 127; if (tm >= 125 && st < SEQ - 3) hp = E.HALO + ((((size_t)(row >> 11) * 16 + (st >> 7) + 1) * 3 + (tm - 125)) * CD) + colt; }
#pragma unroll
                    for (int bj = 0; bj < 2; ++bj) { const f32x4 v0 = acc[ai][bj][m][0] * r, v1 = acc[ai][bj][m][1] * r;
                        const u32x4 pk = pack8(v0, v1);
                        *(GAS u32x4*)(O + (size_t)row * ldo + colt + bj * HALF) = pk;
                        if (hp) *(GAS u32x4*)(hp + bj * HALF) = pk;
                        if (sp) { *(GAS f32x4*)(sp + bj * HALF) = v0; *(GAS f32x4*)(sp + bj * HALF + 4) = v1; } } }
        } else if (wc == 0) {
            const f32x4 b0 = *(const GAS f32x4*)(E.dt_bias + 8 * fq), b1 = *(const GAS f32x4*)(E.dt_bias + 8 * fq + 4);
#pragma unroll
            for (int ai = 0; ai < 2; ++ai)
#pragma unroll
                for (int m = 0; m < 4; ++m) { const int row = rowb + ai * HALF + m * 16; const float r = (ai == 0) ? rsv0[m] : rsv1[m];
                    f32x4 v0 = acc[ai][0][m][0] * r + b0, v1 = acc[ai][0][m][1] * r + b1;
#pragma unroll
                    for (int j = 0; j < 4; ++j) { v0[j] = softplus_f(v0[j]); v1[j] = softplus_f(v1[j]); }
                    *(GAS f32x4*)(E.DT + (size_t)row * 32 + 8 * fq) = v0; *(GAS f32x4*)(E.DT + (size_t)row * 32 + 8 * fq + 4) = v1; }
        }
    } else if (E.kind == EK_T1) {
#pragma unroll
        for (int ai = 0; ai < 2; ++ai)
#pragma unroll
            for (int m = 0; m < 4; ++m) { const int row = rowb + ai * HALF + m * 16;
#pragma unroll
                for (int bj = 0; bj < 2; ++bj) { const int col = u.pn * BM + bj * HALF + cin;
                    f32x4 g0, g1; unpack8(*(const GAS u32x4*)(E.gates + (size_t)row * (2 * DM) + col), g0, g1);
                    *(GAS u32x4*)(E.obf + (size_t)row * DM + col) = pack8(g0 * acc[ai][bj][m][0], g1 * acc[ai][bj][m][1]); } }
    } else if (E.kind == EK_MERGE) {
#pragma unroll
        for (int ai = 0; ai < 2; ++ai)
#pragma unroll
            for (int m = 0; m < 4; ++m) { const int row = rowb + ai * HALF + m * 16;
#pragma unroll
                for (int bj = 0; bj < 2; ++bj) { const int col = u.pn * BM + bj * HALF + cin;
                    f32x4 g0, g1; unpack8(*(const GAS u32x4*)(E.gates + (size_t)row * (2 * DM) + DM + col), g0, g1);
                    f32x4 t0, t1; unpack8(*(const GAS u32x4*)(E.res_bf + (size_t)row * DM + col), t0, t1);
                    *(GAS u32x4*)(E.obf + (size_t)row * DM + col) = pack8(t0 + g0 * acc[ai][bj][m][0], t1 + g1 * acc[ai][bj][m][1]); } }
    } else if (E.kind == EK_BF16) {
#pragma unroll
        for (int ai = 0; ai < 2; ++ai)
#pragma unroll
            for (int m = 0; m < 4; ++m) { const int row = rowb + ai * HALF + m * 16;
#pragma unroll
                for (int bj = 0; bj < 2; ++bj) { const int col = u.pn * BM + bj * HALF + cin;
                    *(GAS u32x4*)(E.obf + (size_t)row * E.ldo + col) = pack8(acc[ai][bj][m][0], acc[ai][bj][m][1]); } }
    } else if (E.kind == EK_PLE) {
#pragma unroll
        for (int ai = 0; ai < 2; ++ai)
#pragma unroll
        for (int mh = 0; mh < 2; ++mh) {
            u32x4 qb[2][2], rb[2][2];
#pragma unroll
            for (int mm = 0; mm < 2; ++mm)
#pragma unroll
                for (int bj = 0; bj < 2; ++bj) { const size_t o = (size_t)(rowb + ai * HALF + (2 * mh + mm) * 16) * DM + u.pn * BM + bj * HALF + cin;
                    qb[mm][bj] = *(const GAS u32x4*)(E.q + o); rb[mm][bj] = *(const GAS u32x4*)(E.res_bf + o); }
#pragma unroll
            for (int mm = 0; mm < 2; ++mm) { const int m = 2 * mh + mm; const int row = rowb + ai * HALF + m * 16; const float r = (ai == 0) ? rsv0[m] : rsv1[m];
                float ss = 0.f;
#pragma unroll
                for (int bj = 0; bj < 2; ++bj) { const int col = u.pn * BM + bj * HALF + cin;
                    f32x4 q0, q1; unpack8(qb[mm][bj], q0, q1);
                    f32x4 r0, r1; unpack8(rb[mm][bj], r0, r1);
                    f32x4 h0, h1;
#pragma unroll
                    for (int j = 0; j < 4; ++j) { h0[j] = r0[j] + sigm_f(acc[ai][bj][m][0][j] * r) * q0[j]; h1[j] = r1[j] + sigm_f(acc[ai][bj][m][1][j] * r) * q1[j]; }
                    *(GAS u32x4*)(E.obf + (size_t)row * DM + col) = pack8(h0, h1);
                    ss += (h0[0] * h0[0] + h0[1] * h0[1]) + (h0[2] * h0[2] + h0[3] * h0[3]) + (h1[0] * h1[0] + h1[1] * h1[1]) + (h1[2] * h1[2] + h1[3] * h1[3]); }
                ss += __shfl_xor(ss, 16); ss += __shfl_xor(ss, 32);
                if (fq == 0) *(GAS float*)(E.stats_out + (size_t)row * 16 + u.pn * 4 + wc) = ss; }
        }
    }
}


__device__ __forceinline__ void epilogue_x(const Epi& E, const f32x4 (&ax)[2], const Unit& u, int wr, int wc, int fr, int fq, LAS unsigned char* lds) {
    const int row = MP + 16 * u.pm + fr, col = u.pn * BM + 128 * wr + 32 * wc + 8 * fq;
    if (E.kind == EK_BF16) { *(GAS u32x4*)(E.obf + (size_t)row * E.ldo + col) = pack8(ax[0], ax[1]); return; }
    f32x4 h0, h1;
    if (E.kind == EK_RES) {
        f32x4 r0, r1; unpack8(*(const GAS u32x4*)(E.res_bf + (size_t)row * DM + col), r0, r1);
        h0 = r0 + ax[0] * E.coef; h1 = r1 + ax[1] * E.coef;
    } else {
        const float r = row_rs(E.stats_in, row);
        f32x4 q0, q1; unpack8(*(const GAS u32x4*)(E.q + (size_t)row * DM + col), q0, q1);
        f32x4 r0, r1; unpack8(*(const GAS u32x4*)(E.res_bf + (size_t)row * DM + col), r0, r1);
#pragma unroll
        for (int j = 0; j < 4; ++j) { h0[j] = r0[j] + sigm_f(ax[0][j] * r) * q0[j]; h1[j] = r1[j] + sigm_f(ax[1][j] * r) * q1[j]; }
    }
    *(GAS u32x4*)(E.obf + (size_t)row * DM + col) = pack8(h0, h1);
    float ss = (h0[0] * h0[0] + h0[1] * h0[1]) + (h0[2] * h0[2] + h0[3] * h0[3]) + (h1[0] * h1[0] + h1[1] * h1[1]) + (h1[2] * h1[2] + h1[3] * h1[3]);
    ss += __shfl_xor(ss, 16); ss += __shfl_xor(ss, 32);
    LAS float* const xs = (LAS float*)(lds + XS_OFF);
    if (wr == 1 && fq == 0) xs[wc * 16 + fr] = ss;
    asm volatile("s_waitcnt lgkmcnt(0)" ::: "memory"); __builtin_amdgcn_s_barrier();
    if (wr == 0 && fq == 0) *(GAS float*)(E.stats_out + (size_t)row * 16 + u.pn * 4 + wc) = ss + xs[wc * 16 + fr];
}

__device__ __forceinline__ void epi_seg(const Epi& E, int row, int col, f32x4 v0, f32x4 v1, int lane) {
    if (E.kind == EK_RES) {
        f32x4 r0, r1;
        if (E.res_p) { const float* rp = ((row < MP) ? E.res_p + (size_t)row * DM : E.res_s + (size_t)(row - MP) * DM) + col; r0 = *(const GAS f32x4*)rp; r1 = *(const GAS f32x4*)(rp + 4); }
        else unpack8(*(const GAS u32x4*)(E.res_bf + (size_t)row * DM + col), r0, r1);
        const f32x4 h0 = r0 + v0 * E.coef, h1 = r1 + v1 * E.coef;
        *(GAS u32x4*)(E.obf + (size_t)row * DM + col) = pack8(h0, h1);
        float ss = (h0[0] * h0[0] + h0[1] * h0[1]) + (h0[2] * h0[2] + h0[3] * h0[3]) + (h1[0] * h1[0] + h1[1] * h1[1]) + (h1[2] * h1[2] + h1[3] * h1[3]);
        ss += __shfl_xor(ss, 1); ss += __shfl_xor(ss, 2); ss += __shfl_xor(ss, 4);
        if ((lane & 7) == 0) *(GAS float*)(E.stats_out + (size_t)row * 16 + (col >> 6)) = ss;
    } else if (E.kind == EK_T1) {
        f32x4 g0, g1; unpack8(*(const GAS u32x4*)(E.gates + (size_t)row * (2 * DM) + col), g0, g1);
        *(GAS u32x4*)(E.obf + (size_t)row * DM + col) = pack8(g0 * v0, g1 * v1);
    } else if (E.kind == EK_MERGE) {
        f32x4 g0, g1; unpack8(*(const GAS u32x4*)(E.gates + (size_t)row * (2 * DM) + DM + col), g0, g1);
        f32x4 t0, t1; unpack8(*(const GAS u32x4*)(E.res_bf + (size_t)row * DM + col), t0, t1);
        *(GAS u32x4*)(E.obf + (size_t)row * DM + col) = pack8(t0 + g0 * v0, t1 + g1 * v1);
    } else if (E.kind == EK_BF16) {
        *(GAS u32x4*)(E.obf + (size_t)row * E.ldo + col) = pack8(v0, v1);
    } else if (E.kind == EK_PLE) {
        const float r = row_rs(E.stats_in, row);
        f32x4 q0, q1; unpack8(*(const GAS u32x4*)(E.q + (size_t)row * DM + col), q0, q1);
        f32x4 r0, r1; unpack8(*(const GAS u32x4*)(E.res_bf + (size_t)row * DM + col), r0, r1);
        f32x4 h0, h1;
#pragma unroll
        for (int j = 0; j < 4; ++j) { h0[j] = r0[j] + sigm_f(v0[j] * r) * q0[j]; h1[j] = r1[j] + sigm_f(v1[j] * r) * q1[j]; }
        *(GAS u32x4*)(E.obf + (size_t)row * DM + col) = pack8(h0, h1);
        float ss = (h0[0] * h0[0] + h0[1] * h0[1]) + (h0[2] * h0[2] + h0[3] * h0[3]) + (h1[0] * h1[0] + h1[1] * h1[1]) + (h1[2] * h1[2] + h1[3] * h1[3]);
        ss += __shfl_xor(ss, 1); ss += __shfl_xor(ss, 2); ss += __shfl_xor(ss, 4);
        if ((lane & 7) == 0) *(GAS float*)(E.stats_out + (size_t)row * 16 + (col >> 6)) = ss;
    }
}
__device__ __forceinline__ int sw_off(int row, int ch) { return 256 * row + 16 * (ch ^ (((row & 3) << 2) | ((row >> 2) & 3))); }
__device__ __forceinline__ void small_tile_sum(LAS unsigned char* lds, const bf16_t* A, int lda, const bf16_t* Bt, int K, int r0, int c0, f32x4& v0, f32x4& v1) {
    int tid_o = threadIdx.x; asm volatile("" : "+v"(tid_o));
    const int tid = tid_o, wid = __builtin_amdgcn_readfirstlane(tid >> 6), lane = tid & 63, ql = lane & 15, gq = lane >> 4, mw = wid >> 1, nh = wid & 1;
    const int nst = K / 128;
    const char* src[4]; int dst[4];
#pragma unroll
    for (int i = 0; i < 4; ++i) { const int p = 4 * wid + i, isB = p >> 4, row = 4 * (p & 15) + (lane >> 4), cs = lane & 15, ch = cs ^ (((row & 3) << 2) | ((row >> 2) & 3));
        src[i] = isB ? (const char*)(Bt + (size_t)(c0 + (row & ~31) + perm32(row & 31)) * K + 8 * ch) : (const char*)(A + (size_t)(r0 + row) * lda + 8 * ch);
        dst[i] = isB * 16384 + 1024 * (p & 15); }
#define ST_ISSUE(st) do { _Pragma("unroll") for (int _i = 0; _i < 4; ++_i) \
        __builtin_amdgcn_global_load_lds((const unsigned*)(src[_i] + (size_t)(st) * 256), (LAS unsigned*)(lds + ((st) & 3) * 32768 + dst[_i]), 16, 0, 0); } while (0)
    f32x4 acc0 = (f32x4){0.f, 0.f, 0.f, 0.f}, acc1 = acc0;
    int aoff[4], boff0[4], boff1[4];
#pragma unroll
    for (int ks = 0; ks < 4; ++ks) { aoff[ks] = sw_off(16 * mw + ql, 4 * ks + gq); boff0[ks] = 16384 + sw_off(32 * nh + ql, 4 * ks + gq); boff1[ks] = 16384 + sw_off(32 * nh + 16 + ql, 4 * ks + gq); }
    ST_ISSUE(0); if (nst > 1) ST_ISSUE(1); if (nst > 2) ST_ISSUE(2);
    for (int t = 0; t < nst; ++t) {
        const int ahead = (nst - 1 - t) < 2 ? (nst - 1 - t) : 2;
        if (ahead == 2) asm volatile("s_waitcnt vmcnt(8)" ::: "memory"); else if (ahead == 1) asm volatile("s_waitcnt vmcnt(4)" ::: "memory"); else asm volatile("s_waitcnt vmcnt(0)" ::: "memory");
        __builtin_amdgcn_s_barrier(); asm volatile("" ::: "memory");
        if (t + 3 < nst) ST_ISSUE(t + 3);
        const LAS unsigned char* const sl = lds + (t & 3) * 32768;
#pragma unroll
        for (int ks = 0; ks < 4; ++ks) {
            const bf16x8 af = *(const LAS bf16x8*)(sl + aoff[ks]), b0 = *(const LAS bf16x8*)(sl + boff0[ks]), b1 = *(const LAS bf16x8*)(sl + boff1[ks]);
            acc0 = __builtin_amdgcn_mfma_f32_16x16x32_bf16(b0, af, acc0, 0, 0, 0); acc1 = __builtin_amdgcn_mfma_f32_16x16x32_bf16(b1, af, acc1, 0, 0, 0);
        }
        asm volatile("s_waitcnt lgkmcnt(0)" ::: "memory");
    }
#undef ST_ISSUE
    __syncthreads();
    LAS f32x4* const tile = (LAS f32x4*)lds;
    { const int row = 16 * mw + ql, chb = 8 * nh + 2 * gq; tile[row * 16 + (chb ^ (row & 15))] = acc0; tile[row * 16 + ((chb + 1) ^ (row & 15))] = acc1; }
    __syncthreads();
    const int rr = 8 * wid + (lane >> 3), ch0 = 2 * (lane & 7);
    v0 = tile[rr * 16 + (ch0 ^ (rr & 15))]; v1 = tile[rr * 16 + ((ch0 + 1) ^ (rr & 15))];
    __syncthreads();
}
__device__ __forceinline__ void gemm_small(LAS unsigned char* lds, const Gemm g, const Epi& E, int row_base, int nrows, int G, int c) {
    int tid_o = threadIdx.x; asm volatile("" : "+v"(tid_o));
    const int tid = tid_o, wid = __builtin_amdgcn_readfirstlane(tid >> 6), lane = tid & 63;
    const int ntn = g.N / 64, ntiles = (nrows / 64) * ntn;
    for (int v = c; v < ntiles; v += G) {
        const int r0 = row_base + 64 * (v / ntn), c0 = 64 * (v % ntn);
        f32x4 v0, v1; small_tile_sum(lds, g.A, g.lda, g.Bt, g.K, r0, c0, v0, v1);
        epi_seg(E, r0 + 8 * wid + (lane >> 3), c0 + 8 * (lane & 7), v0, v1, lane);
    }
}
struct Gemm2 { const bf16_t* A1; const bf16_t* B1; const bf16_t* A2; const bf16_t* B2; int K1, lda1, K2, lda2, N; };
__device__ __forceinline__ void gemm_small2(LAS unsigned char* lds, const Gemm2 g, const bf16_t* gates, bf16_t* out, int row_base, int nrows, int G, int c) {
    int tid_o = threadIdx.x; asm volatile("" : "+v"(tid_o));
    const int tid = tid_o, wid = __builtin_amdgcn_readfirstlane(tid >> 6), lane = tid & 63;
    const int ntn = g.N / 64, ntiles = (nrows / 64) * ntn;
    for (int v = c; v < ntiles; v += G) {
        const int r0 = row_base + 64 * (v / ntn), c0 = 64 * (v % ntn), row = r0 + 8 * wid + (lane >> 3), col = c0 + 8 * (lane & 7);
        f32x4 a0, a1, b0, b1;
        small_tile_sum(lds, g.A1, g.lda1, g.B1, g.K1, r0, c0, a0, a1);
        small_tile_sum(lds, g.A2, g.lda2, g.B2, g.K2, r0, c0, b0, b1);
        f32x4 g00, g01, g10, g11; unpack8(*(const GAS u32x4*)(gates + (size_t)row * (2 * DM) + col), g00, g01); unpack8(*(const GAS u32x4*)(gates + (size_t)row * (2 * DM) + DM + col), g10, g11);
        *(GAS u32x4*)(out + (size_t)row * DM + col) = pack8(g00 * a0 + g10 * b0, g01 * a1 + g11 * b1);
    }
}

template <int XR = 0>
__device__ __forceinline__ void gemm_phase(LAS unsigned char* lds, const Gemm g, const StaticOrder& S, const Epi& E) {
    const int tid = threadIdx.x, wid = __builtin_amdgcn_readfirstlane(tid >> 6), lane = tid & 63, wr = wid >> 2, wc = wid & 3, fr = lane & 15, fq = lane >> 4;
    const int K = g.K, nt = K / BK;
    unsigned voffA[2], voffB[2];
#pragma unroll
    for (int i = 0; i < 2; ++i) { int R, C; stage_rc(tid * 16 + i * 8192, R, C); const int Rb = (R & ~31) + perm32(R & 31);
        voffA[i] = (unsigned)(R * g.lda + C) * 2u; voffB[i] = (unsigned)(Rb * K + C) * 2u; }
    const size_t kstep = (size_t)(BK * 2);
    const size_t hstep = (size_t)HALF * K * 2, hstepA = (size_t)HALF * g.lda * 2;
    const size_t tstep = 2 * hstep, tstepA = 2 * hstepA, pnstepA = (size_t)g.a_pn_step * 2;
    const unsigned ldsw = (unsigned)wid * 1024u;
    const int aoff = lds_byte(wr * 64 + fr, fq * 8), boff = lds_byte(wc * 32 + fr, fq * 8);
    unsigned voffX = 0u; int axoff = 0;
    if constexpr (XR) { int R, C; stage_rc(tid * 4, R, C); voffX = (unsigned)(R * g.lda + C) * 2u; axoff = XA_OFF + lds_byte(fr, fq * 8); }
    const size_t xrow0 = (size_t)MP * g.lda * 2, xstep = (size_t)16 * g.lda * 2;
#define PG8_SA(b, h) (((b) * 2 + (h)) * HTB)
#define PG8_SB(b, h) ((4 + (b) * 2 + (h)) * HTB)
#define PG8_STAGE(bufoff, gbase, voff) do { _Pragma("unroll") for (int _i = 0; _i < 2; ++_i) \
        __builtin_amdgcn_global_load_lds((const unsigned*)((const char*)(gbase) + (voff)[_i]), (LAS unsigned*)(lds + (bufoff) + ldsw + _i * 8192), 16, 0, 0); } while (0)
#define PG8_LDA(dst, b, h) do { _Pragma("unroll") for (int m = 0; m < 4; ++m) _Pragma("unroll") for (int k = 0; k < 2; ++k) dst[m][k] = *(const LAS bf16x8*)(lds + PG8_SA(b, h) + aoff + m * 2048 + k * 1024); } while (0)
#define PG8_LDB(dst, b, h) do { _Pragma("unroll") for (int n = 0; n < 2; ++n) _Pragma("unroll") for (int k = 0; k < 2; ++k) dst[n][k] = *(const LAS bf16x8*)(lds + PG8_SB(b, h) + boff + n * 2048 + k * 1024); } while (0)
#define PG8_MMA(ai, bj, At, Bt) do { __builtin_amdgcn_s_setprio(1); _Pragma("unroll") for (int m = 0; m < 4; ++m) _Pragma("unroll") for (int n = 0; n < 2; ++n) _Pragma("unroll") for (int k = 0; k < 2; ++k) \
        acc[ai][bj][m][n] = __builtin_amdgcn_mfma_f32_16x16x32_bf16(Bt[n][k], At[m][k], acc[ai][bj][m][n], 0, 0, 0); __builtin_amdgcn_s_setprio(0); } while (0)
#define PG8_WAIT_V(n) asm volatile("s_waitcnt vmcnt(" #n ")" ::: "memory")
#define PG8_WAIT_VX do { if constexpr (XR) asm volatile("s_waitcnt vmcnt(9)" ::: "memory"); else asm volatile("s_waitcnt vmcnt(8)" ::: "memory"); } while (0)
#define PG8_STAGE_X(b, gx) do { if constexpr (XR) __builtin_amdgcn_global_load_lds((const unsigned*)((const char*)(gx) + voffX), (LAS unsigned*)(lds + XA_OFF + (b) * 2048 + wid * 256), 4, 0, 0); } while (0)
#define PG8_LDX(b) do { if constexpr (XR) { Ax[0] = *(const LAS bf16x8*)(lds + axoff + (b) * 2048); Ax[1] = *(const LAS bf16x8*)(lds + axoff + (b) * 2048 + 1024); } } while (0)
#define PG8_MMAX do { if constexpr (XR) { if (wr == 0) { _Pragma("unroll") for (int n = 0; n < 2; ++n) _Pragma("unroll") for (int k = 0; k < 2; ++k) accx[n] = __builtin_amdgcn_mfma_f32_16x16x32_bf16(B0[n][k], Ax[k], accx[n], 0, 0, 0); } \
        else { _Pragma("unroll") for (int n = 0; n < 2; ++n) _Pragma("unroll") for (int k = 0; k < 2; ++k) accx[n] = __builtin_amdgcn_mfma_f32_16x16x32_bf16(B1[n][k], Ax[k], accx[n], 0, 0, 0); } } } while (0)
#define PG8_WAIT_L(n) asm volatile("s_waitcnt lgkmcnt(" #n ")" ::: "memory")
#define PG8_BAR __builtin_amdgcn_s_barrier()
#define PG8_SCHED __builtin_amdgcn_sched_barrier(0)
    Unit cur, nxt; int ui = 0;
    if (!S.next(0, cur)) return;
    f32x4 acc[2][2][4][2];
#pragma unroll
    for (int a = 0; a < 2; ++a)
#pragma unroll
        for (int b = 0; b < 2; ++b)
#pragma unroll
            for (int m = 0; m < 4; ++m)
#pragma unroll
                for (int n = 0; n < 2; ++n) acc[a][b][m][n] = (f32x4){0.f, 0.f, 0.f, 0.f};
    bf16x8 At[4][2], B0[2][2], B1[2][2], Ax[2];
    f32x4 accx[2] = {(f32x4){0.f, 0.f, 0.f, 0.f}, (f32x4){0.f, 0.f, 0.f, 0.f}};
    const char* cA = (const char*)g.A + (size_t)cur.pm * tstepA + (size_t)cur.pn * pnstepA; const char* cB = (const char*)g.Bt + (size_t)cur.pn * tstep;
    const char* cX = (const char*)g.A + xrow0 + (size_t)cur.pm * xstep;
    PG8_STAGE(PG8_SB(0, 0), cB, voffB); PG8_STAGE(PG8_SB(0, 1), cB + hstep, voffB); PG8_STAGE(PG8_SA(0, 0), cA, voffA); PG8_STAGE(PG8_SA(0, 1), cA + hstepA, voffA); PG8_STAGE_X(0, cX);
    if (wr == 1) PG8_BAR;
    if constexpr (XR) PG8_WAIT_V(3); else PG8_WAIT_V(2);
    PG8_BAR;
    PG8_STAGE(PG8_SB(1, 0), cB + kstep, voffB); PG8_STAGE(PG8_SA(1, 0), cA + kstep, voffA); PG8_STAGE(PG8_SB(1, 1), cB + hstep + kstep, voffB);
    PG8_WAIT_V(6); PG8_BAR;
    for (;;) {
        const bool has_next = S.next(ui + 1, nxt);
        const char* nA = has_next ? (const char*)g.A + (size_t)nxt.pm * tstepA + (size_t)nxt.pn * pnstepA : cA; const char* nB = has_next ? (const char*)g.Bt + (size_t)nxt.pn * tstep : cB;
        const char* nX = has_next ? (const char*)g.A + xrow0 + (size_t)nxt.pm * xstep : cX;
        if (E.stats_in) {
            int tq = threadIdx.x; asm volatile("" : "+v"(tq));
            const char* sp_ = (const char*)(E.stats_in + (size_t)cur.pm * BM * 16) + (size_t)tq * 16;
            __builtin_amdgcn_global_load_lds((const unsigned*)sp_, (LAS unsigned*)(lds + STB_OFF + wid * 1024), 16, 0, 0);
            __builtin_amdgcn_global_load_lds((const unsigned*)(sp_ + 8192), (LAS unsigned*)(lds + STB_OFF + 8192 + wid * 1024), 16, 0, 0);
        }
        for (int t = 0; t < nt; t += 2) {
            const bool last = (t == nt - 2);
            const char* a1 = cA + (size_t)(t + 1) * kstep;
            const char* a2 = last ? nA : cA + (size_t)(t + 2) * kstep; const char* b2 = last ? nB : cB + (size_t)(t + 2) * kstep;
            const char* a3 = a2 + kstep; const char* b3 = b2 + kstep;
            const char* x1 = cX + (size_t)(t + 1) * kstep; const char* x2 = last ? nX : cX + (size_t)(t + 2) * kstep;
            PG8_LDB(B0, 0, 0); PG8_LDB(B1, 0, 1); PG8_SCHED; PG8_LDA(At, 0, 0); PG8_STAGE(PG8_SA(1, 1), a1 + hstepA, voffA); PG8_STAGE_X(1, x1);
            PG8_WAIT_VX; PG8_WAIT_L(0); PG8_BAR; PG8_MMA(0, 0, At, B0); PG8_MMA(0, 1, At, B1); PG8_BAR; PG8_SCHED;
            PG8_LDA(At, 0, 1); PG8_LDX(0); PG8_STAGE(PG8_SB(0, 0), b2, voffB); PG8_STAGE(PG8_SB(0, 1), b2 + hstep, voffB); PG8_STAGE(PG8_SA(0, 0), a2, voffA);
            PG8_WAIT_VX; PG8_WAIT_L(0); PG8_BAR; PG8_MMA(1, 0, At, B0); PG8_MMA(1, 1, At, B1); PG8_MMAX; PG8_BAR; PG8_SCHED;
            PG8_LDB(B0, 1, 0); PG8_LDB(B1, 1, 1); PG8_SCHED; PG8_LDA(At, 1, 0); PG8_STAGE(PG8_SA(0, 1), a2 + hstepA, voffA); PG8_STAGE_X(0, x2);
            PG8_WAIT_VX; PG8_WAIT_L(0); PG8_BAR; PG8_MMA(0, 0, At, B0); PG8_MMA(0, 1, At, B1); PG8_BAR; PG8_SCHED;
            PG8_LDA(At, 1, 1); PG8_LDX(1); PG8_STAGE(PG8_SB(1, 0), b3, voffB); PG8_STAGE(PG8_SB(1, 1), b3 + hstep, voffB); PG8_STAGE(PG8_SA(1, 0), a3, voffA);
            PG8_WAIT_VX; PG8_WAIT_L(0); PG8_BAR; PG8_MMA(1, 0, At, B0); PG8_MMA(1, 1, At, B1); PG8_MMAX; PG8_BAR; PG8_SCHED;
        }
        if (wr == 0) PG8_BAR;
        { int fr_ = fr, fq_ = fq; asm volatile("" : "+v"(fr_), "+v"(fq_));
          epilogue(E, acc, cur, wr, wc, fr_, fq_, lds);
          if constexpr (XR) { epilogue_x(E, accx, cur, wr, wc, fr_, fq_, lds); accx[0] = (f32x4){0.f, 0.f, 0.f, 0.f}; accx[1] = accx[0]; } }
        if (!has_next) break;
#pragma unroll
        for (int a = 0; a < 2; ++a)
#pragma unroll
            for (int b = 0; b < 2; ++b)
#pragma unroll
                for (int m = 0; m < 4; ++m)
#pragma unroll
                    for (int n = 0; n < 2; ++n) acc[a][b][m][n] = (f32x4){0.f, 0.f, 0.f, 0.f};
        cur = nxt; cA = nA; cB = nB; cX = nX; ++ui;
        if (wr == 1) PG8_BAR;
    }
    PG8_WAIT_V(0);
    PG8_BAR;
#undef PG8_SA
#undef PG8_SB
#undef PG8_STAGE
#undef PG8_LDA
#undef PG8_LDB
#undef PG8_MMA
#undef PG8_WAIT_V
#undef PG8_WAIT_VX
#undef PG8_STAGE_X
#undef PG8_LDX
#undef PG8_MMAX
#undef PG8_WAIT_L
#undef PG8_BAR
#undef PG8_SCHED
}

__device__ __forceinline__ void gemm_phase2(LAS unsigned char* lds, const Gemm2 g, const StaticOrder& S, const bf16_t* gates, bf16_t* out) {
    const int tid = threadIdx.x, wid = __builtin_amdgcn_readfirstlane(tid >> 6), lane = tid & 63, wr = wid >> 2, wc = wid & 3, fr = lane & 15, fq = lane >> 4;
    const int nt1 = g.K1 / BK, nt = nt1 + g.K2 / BK;
    int sR[2], sRb[2], sC[2];
#pragma unroll
    for (int i = 0; i < 2; ++i) { int R, C; stage_rc(tid * 16 + i * 8192, R, C); sR[i] = R; sRb[i] = (R & ~31) + perm32(R & 31); sC[i] = C; }
    const size_t kstep = (size_t)(BK * 2);
    const size_t hB1 = (size_t)HALF * g.K1 * 2, hA1 = (size_t)HALF * g.lda1 * 2, hB2 = (size_t)HALF * g.K2 * 2, hA2 = (size_t)HALF * g.lda2 * 2;
    const unsigned ldsw = (unsigned)wid * 1024u;
    const int aoff = lds_byte(wr * 64 + fr, fq * 8), boff = lds_byte(wc * 32 + fr, fq * 8);
    unsigned voffX1, voffX2; { int xR, xC; stage_rc(tid * 4, xR, xC); voffX1 = (unsigned)(xR * g.lda1 + xC) * 2u; voffX2 = (unsigned)(xR * g.lda2 + xC) * 2u; }
    const size_t xs1 = (size_t)16 * g.lda1 * 2, xs2 = (size_t)16 * g.lda2 * 2;
#define PG8_SA(b, h) (((b) * 2 + (h)) * HTB)
#define PG8_SB(b, h) ((4 + (b) * 2 + (h)) * HTB)
#define PG8_STAGE_T(bufoff, isA, h, T) do { const int T_ = (T); const bool nx_ = T_ >= nt; const int Tl_ = nx_ ? T_ - nt : T_; const bool s2_ = !nx_ && Tl_ >= nt1; \
        const char* base_ = (isA) ? (s2_ ? cA2 + (size_t)(Tl_ - nt1) * kstep + (h) * hA2 : (nx_ ? nA1 : cA1) + (size_t)Tl_ * kstep + (h) * hA1) \
                                  : (s2_ ? cB2 + (size_t)(Tl_ - nt1) * kstep + (h) * hB2 : (nx_ ? nB1 : cB1) + (size_t)Tl_ * kstep + (h) * hB1); \
        const int ld_ = (isA) ? (s2_ ? g.lda2 : g.lda1) : (s2_ ? g.K2 : g.K1); \
        _Pragma("unroll") for (int _i = 0; _i < 2; ++_i) { const unsigned vo_ = (unsigned)(((isA) ? sR[_i] : sRb[_i]) * ld_ + sC[_i]) * 2u; \
            __builtin_amdgcn_global_load_lds((const unsigned*)(base_ + vo_), (LAS unsigned*)(lds + (bufoff) + ldsw + _i * 8192), 16, 0, 0); } } while (0)
#define PG8_STAGE_XT(b, T) do { const int T_ = (T); const bool nx_ = T_ >= nt; const int Tl_ = nx_ ? T_ - nt : T_; const bool s2_ = !nx_ && Tl_ >= nt1; \
        const char* base_ = s2_ ? cX2 + (size_t)(Tl_ - nt1) * kstep : (nx_ ? nX1 : cX1) + (size_t)Tl_ * kstep; const int ld_ = s2_ ? g.lda2 : g.lda1; \
        __builtin_amdgcn_global_load_lds((const unsigned*)(base_ + (s2_ ? voffX2 : voffX1)), (LAS unsigned*)(lds + XA_OFF + (b) * 2048 + wid * 256), 4, 0, 0); } while (0)
#define PG8_LDX(b) do { int lq_ = threadIdx.x & 63; asm volatile("" : "+v"(lq_)); const int axo_ = XA_OFF + lds_byte(lq_ & 15, (lq_ >> 4) * 8) + (b) * 2048; \
        Ax[0] = *(const LAS bf16x8*)(lds + axo_); Ax[1] = *(const LAS bf16x8*)(lds + axo_ + 1024); } while (0)
#define PG8_MMAX do { if (wr == 0) { _Pragma("unroll") for (int n = 0; n < 2; ++n) _Pragma("unroll") for (int k = 0; k < 2; ++k) accx[n] = __builtin_amdgcn_mfma_f32_16x16x32_bf16(B0[n][k], Ax[k], accx[n], 0, 0, 0); } \
        else { _Pragma("unroll") for (int n = 0; n < 2; ++n) _Pragma("unroll") for (int k = 0; k < 2; ++k) accx[n] = __builtin_amdgcn_mfma_f32_16x16x32_bf16(B1[n][k], Ax[k], accx[n], 0, 0, 0); } } while (0)
#define PG8_LDA(dst, b, h) do { _Pragma("unroll") for (int m = 0; m < 4; ++m) _Pragma("unroll") for (int k = 0; k < 2; ++k) dst[m][k] = *(const LAS bf16x8*)(lds + PG8_SA(b, h) + aoff + m * 2048 + k * 1024); } while (0)
#define PG8_LDB(dst, b, h) do { _Pragma("unroll") for (int n = 0; n < 2; ++n) _Pragma("unroll") for (int k = 0; k < 2; ++k) dst[n][k] = *(const LAS bf16x8*)(lds + PG8_SB(b, h) + boff + n * 2048 + k * 1024); } while (0)
#define PG8_MMA(ai, bj, At, Bt) do { __builtin_amdgcn_s_setprio(1); _Pragma("unroll") for (int m = 0; m < 4; ++m) _Pragma("unroll") for (int n = 0; n < 2; ++n) _Pragma("unroll") for (int k = 0; k < 2; ++k) \
        acc[ai][bj][m][n] = __builtin_amdgcn_mfma_f32_16x16x32_bf16(Bt[n][k], At[m][k], acc[ai][bj][m][n], 0, 0, 0); __builtin_amdgcn_s_setprio(0); } while (0)
#define PG8_WAIT_V(n) asm volatile("s_waitcnt vmcnt(" #n ")" ::: "memory")
#define PG8_WAIT_L(n) asm volatile("s_waitcnt lgkmcnt(" #n ")" ::: "memory")
#define PG8_BAR __builtin_amdgcn_s_barrier()
#define PG8_SCHED __builtin_amdgcn_sched_barrier(0)
    Unit cur, nxt; int ui = 0;
    if (!S.next(0, cur)) return;
    f32x4 acc[2][2][4][2];
#pragma unroll
    for (int a = 0; a < 2; ++a)
#pragma unroll
        for (int b = 0; b < 2; ++b)
#pragma unroll
            for (int m = 0; m < 4; ++m)
#pragma unroll
                for (int n = 0; n < 2; ++n) acc[a][b][m][n] = (f32x4){0.f, 0.f, 0.f, 0.f};
    bf16x8 At[4][2], B0[2][2], B1[2][2], Ax[2];
    f32x4 accx[2] = {(f32x4){0.f, 0.f, 0.f, 0.f}, (f32x4){0.f, 0.f, 0.f, 0.f}};
    const char* cX1 = (const char*)g.A1 + (size_t)MP * g.lda1 * 2 + (size_t)cur.pm * xs1; const char* cX2 = (const char*)g.A2 + (size_t)MP * g.lda2 * 2 + (size_t)cur.pm * xs2; const char* nX1 = cX1;
    const char* cA1 = (const char*)g.A1 + (size_t)cur.pm * 2 * hA1; const char* cB1 = (const char*)g.B1 + (size_t)cur.pn * 2 * hB1;
    const char* cA2 = (const char*)g.A2 + (size_t)cur.pm * 2 * hA2; const char* cB2 = (const char*)g.B2 + (size_t)cur.pn * 2 * hB2;
    const char* nA1 = cA1; const char* nB1 = cB1;
    PG8_STAGE_T(PG8_SB(0, 0), false, 0, 0); PG8_STAGE_T(PG8_SB(0, 1), false, 1, 0); PG8_STAGE_T(PG8_SA(0, 0), true, 0, 0); PG8_STAGE_T(PG8_SA(0, 1), true, 1, 0); PG8_STAGE_XT(0, 0);
    if (wr == 1) PG8_BAR;
    PG8_WAIT_V(3); PG8_BAR;
    PG8_STAGE_T(PG8_SB(1, 0), false, 0, 1); PG8_STAGE_T(PG8_SA(1, 0), true, 0, 1); PG8_STAGE_T(PG8_SB(1, 1), false, 1, 1);
    PG8_WAIT_V(6); PG8_BAR;
    for (;;) {
        const bool has_next = S.next(ui + 1, nxt);
        nA1 = has_next ? (const char*)g.A1 + (size_t)nxt.pm * 2 * hA1 : cA1; nB1 = has_next ? (const char*)g.B1 + (size_t)nxt.pn * 2 * hB1 : cB1;
        nX1 = has_next ? (const char*)g.A1 + (size_t)MP * g.lda1 * 2 + (size_t)nxt.pm * xs1 : cX1;
        for (int t = 0; t < nt; t += 2) {
            if (t == nt1) {
                int lq_ = threadIdx.x & 63; asm volatile("" : "+v"(lq_)); const int fr = lq_ & 15, fq = lq_ >> 4;
                const int rowb = cur.pm * BM + wr * 64 + fr, colb = cur.pn * BM + wc * 32 + 8 * fq;
#pragma unroll
                for (int ai = 0; ai < 2; ++ai) {
                    u32x4 gg[4][2][2];
#pragma unroll
                    for (int m = 0; m < 4; ++m) { const bf16_t* gp = gates + (size_t)(rowb + ai * HALF + m * 16) * (2 * DM) + colb;
#pragma unroll
                        for (int bj = 0; bj < 2; ++bj) { gg[m][bj][0] = *(const GAS u32x4*)(gp + bj * HALF); gg[m][bj][1] = *(const GAS u32x4*)(gp + DM + bj * HALF); } }
#pragma unroll
                    for (int m = 0; m < 4; ++m)
#pragma unroll
                        for (int bj = 0; bj < 2; ++bj) { f32x4 g00, g01, g10, g11; unpack8(gg[m][bj][0], g00, g01); unpack8(gg[m][bj][1], g10, g11);
#pragma unroll
                            for (int j = 0; j < 4; ++j) { acc[ai][bj][m][0][j] *= g00[j] * __builtin_amdgcn_rcpf(fmaxf(g10[j], 1e-6f)); acc[ai][bj][m][1][j] *= g01[j] * __builtin_amdgcn_rcpf(fmaxf(g11[j], 1e-6f)); } }
                }
                { const bf16_t* gp = gates + (size_t)(MP + 16 * cur.pm + fr) * (2 * DM) + cur.pn * BM + 128 * wr + 32 * wc + 8 * fq;
                  f32x4 g00, g01, g10, g11; unpack8(*(const GAS u32x4*)gp, g00, g01); unpack8(*(const GAS u32x4*)(gp + DM), g10, g11);
#pragma unroll
                  for (int j = 0; j < 4; ++j) { accx[0][j] *= g00[j] * __builtin_amdgcn_rcpf(fmaxf(g10[j], 1e-6f)); accx[1][j] *= g01[j] * __builtin_amdgcn_rcpf(fmaxf(g11[j], 1e-6f)); } }
            }
            PG8_LDB(B0, 0, 0); PG8_LDB(B1, 0, 1); PG8_SCHED; PG8_LDA(At, 0, 0); PG8_STAGE_T(PG8_SA(1, 1), true, 1, t + 1); PG8_STAGE_XT(1, t + 1);
            PG8_WAIT_V(9); PG8_WAIT_L(0); PG8_BAR; PG8_MMA(0, 0, At, B0); PG8_MMA(0, 1, At, B1); PG8_BAR; PG8_SCHED;
            PG8_LDA(At, 0, 1); PG8_LDX(0); PG8_STAGE_T(PG8_SB(0, 0), false, 0, t + 2); PG8_STAGE_T(PG8_SB(0, 1), false, 1, t + 2); PG8_STAGE_T(PG8_SA(0, 0), true, 0, t + 2);
            PG8_WAIT_V(9); PG8_WAIT_L(0); PG8_BAR; PG8_MMA(1, 0, At, B0); PG8_MMA(1, 1, At, B1); PG8_MMAX; PG8_BAR; PG8_SCHED;
            PG8_LDB(B0, 1, 0); PG8_LDB(B1, 1, 1); PG8_SCHED; PG8_LDA(At, 1, 0); PG8_STAGE_T(PG8_SA(0, 1), true, 1, t + 2); PG8_STAGE_XT(0, t + 2);
            PG8_WAIT_V(9); PG8_WAIT_L(0); PG8_BAR; PG8_MMA(0, 0, At, B0); PG8_MMA(0, 1, At, B1); PG8_BAR; PG8_SCHED;
            PG8_LDA(At, 1, 1); PG8_LDX(1); PG8_STAGE_T(PG8_SB(1, 0), false, 0, t + 3); PG8_STAGE_T(PG8_SB(1, 1), false, 1, t + 3); PG8_STAGE_T(PG8_SA(1, 0), true, 0, t + 3);
            PG8_WAIT_V(9); PG8_WAIT_L(0); PG8_BAR; PG8_MMA(1, 0, At, B0); PG8_MMA(1, 1, At, B1); PG8_MMAX; PG8_BAR; PG8_SCHED;
        }
        if (wr == 0) PG8_BAR;
        int le_ = threadIdx.x & 63; asm volatile("" : "+v"(le_)); const int fr = le_ & 15, fq = le_ >> 4;
        const int rowb = cur.pm * BM + wr * 64 + fr, colb = cur.pn * BM + wc * 32 + 8 * fq;
#pragma unroll
        for (int ai = 0; ai < 2; ++ai)
#pragma unroll
            for (int m = 0; m < 4; ++m) { const size_t row = (size_t)(rowb + ai * HALF + m * 16);
#pragma unroll
                for (int bj = 0; bj < 2; ++bj) { f32x4 g10, g11; unpack8(*(const GAS u32x4*)(gates + row * (2 * DM) + DM + colb + bj * HALF), g10, g11);
#pragma unroll
                    for (int j = 0; j < 4; ++j) { g10[j] = fmaxf(g10[j], 1e-6f); g11[j] = fmaxf(g11[j], 1e-6f); }
                    *(GAS u32x4*)(out + row * DM + colb + bj * HALF) = pack8(acc[ai][bj][m][0] * g10, acc[ai][bj][m][1] * g11); } }
        {
            const size_t rowx = (size_t)(MP + 16 * cur.pm + fr); const int colx = cur.pn * BM + 128 * wr + 32 * wc + 8 * fq;
            f32x4 g10, g11; unpack8(*(const GAS u32x4*)(gates + rowx * (2 * DM) + DM + colx), g10, g11);
#pragma unroll
            for (int j = 0; j < 4; ++j) { g10[j] = fmaxf(g10[j], 1e-6f); g11[j] = fmaxf(g11[j], 1e-6f); }
            *(GAS u32x4*)(out + rowx * DM + colx) = pack8(accx[0] * g10, accx[1] * g11);
            accx[0] = (f32x4){0.f, 0.f, 0.f, 0.f}; accx[1] = accx[0];
        }
        if (!has_next) break;
#pragma unroll
        for (int a = 0; a < 2; ++a)
#pragma unroll
            for (int b = 0; b < 2; ++b)
#pragma unroll
                for (int m = 0; m < 4; ++m)
#pragma unroll
                    for (int n = 0; n < 2; ++n) acc[a][b][m][n] = (f32x4){0.f, 0.f, 0.f, 0.f};
        cX1 = nX1; cX2 = (const char*)g.A2 + (size_t)MP * g.lda2 * 2 + (size_t)nxt.pm * xs2;
        cur = nxt; cA1 = nA1; cB1 = nB1; cA2 = (const char*)g.A2 + (size_t)cur.pm * 2 * hA2; cB2 = (const char*)g.B2 + (size_t)cur.pn * 2 * hB2; ++ui;
        if (wr == 1) PG8_BAR;
    }
    PG8_WAIT_V(0);
    PG8_BAR;
#undef PG8_SA
#undef PG8_SB
#undef PG8_STAGE_T
#undef PG8_STAGE_XT
#undef PG8_LDX
#undef PG8_MMAX
#undef PG8_LDA
#undef PG8_LDB
#undef PG8_MMA
#undef PG8_WAIT_V
#undef PG8_WAIT_L
#undef PG8_BAR
#undef PG8_SCHED
}
}

#define XB_TMO      128
#define XB_XCNT(j)  (256  + 64 * (j))
#define XB_XSUB(j)  (1280 + 64 * (j))
#define XB_XGEN(j)  (2304 + 64 * (j))
#define XB_TOP      3328
#define XB_TOPGEN   3392
#define XCD_BAR_WORDS 3456
#define XB_SPIN_CAP (1u << 18)
__device__ __forceinline__ unsigned xb_ld(unsigned* p)              { return __hip_atomic_load(p, __ATOMIC_RELAXED, __HIP_MEMORY_SCOPE_AGENT); }
__device__ __forceinline__ unsigned xb_add(unsigned* p, unsigned v) { return __hip_atomic_fetch_add(p, v, __ATOMIC_RELAXED, __HIP_MEMORY_SCOPE_AGENT); }
__device__ __forceinline__ unsigned xb_xcc_id() { return (unsigned)__builtin_amdgcn_s_getreg((3 << 11) | 20) & 0xFu; }
#define XB_SPIN(cond, bar) do { unsigned _sp = 0; while (cond) { __builtin_amdgcn_s_sleep(1); \
    if ((++_sp & 255u) == 0u) { if (xb_ld(&(bar)[XB_TMO])) break; if (_sp > XB_SPIN_CAP) { atomicAdd(&(bar)[XB_TMO], 1u); break; } } } } while (0)
struct XcdBarrier { unsigned* bar; unsigned x; volatile LAS unsigned* st; };
__device__ __forceinline__ XcdBarrier xcd_barrier_post(unsigned* bar, volatile LAS unsigned* st) {
    XcdBarrier b; b.bar = bar; b.x = xb_xcc_id(); b.st = st;
    if (threadIdx.x == 0) (void)xb_add(&bar[XB_XCNT(b.x)], 1u);
    return b;
}
__device__ __forceinline__ void xcd_barrier_complete(unsigned* bar, unsigned x, unsigned& nloc, unsigned& nx) {
    const unsigned G = gridDim.x * gridDim.y * gridDim.z;
    unsigned sum, cnt, mine, sp = 0u;
    for (;;) {
        sum = 0u; cnt = 0u; mine = 0u;
#pragma unroll
        for (unsigned j = 0; j < 16; ++j) { const unsigned c = xb_ld(&bar[XB_XCNT(j)]); sum += c; cnt += (c > 0u) ? 1u : 0u; mine = (j == x) ? c : mine; }
        if (sum == G) break;
        __builtin_amdgcn_s_sleep(1);
        if ((++sp & 255u) == 0u) { if (xb_ld(&bar[XB_TMO])) break; if (sp > XB_SPIN_CAP) { atomicAdd(&bar[XB_TMO], 1u); break; } }
    }
    nloc = mine > 0u ? mine : 1u; nx = cnt > 0u ? cnt : 1u;
}
__device__ __forceinline__ void xcd_barrier(const XcdBarrier& b) {
    asm volatile("s_waitcnt vmcnt(0)" ::: "memory");
    __syncthreads();
    if (threadIdx.x == 0) {
        unsigned* bar = b.bar;
        __builtin_amdgcn_s_waitcnt(0);
        unsigned nloc = b.st[0], nx = b.st[1];
        if (nloc == 0u) { xcd_barrier_complete(bar, b.x, nloc, nx); b.st[0] = nloc; b.st[1] = nx; }
        const unsigned old = xb_add(&bar[XB_XSUB(b.x)], 1u);
        const unsigned gen = old / nloc;
        if (old + 1u == (gen + 1u) * nloc) {
            __builtin_amdgcn_fence(__ATOMIC_RELEASE, "agent");
            asm volatile("s_waitcnt vmcnt(0)" ::: "memory");
            const unsigned og = xb_add(&bar[XB_TOP], 1u);
            const unsigned tg = og / nx;
            if (og + 1u == (tg + 1u) * nx) xb_add(&bar[XB_TOPGEN], 1u);
            else XB_SPIN(xb_ld(&bar[XB_TOPGEN]) == tg, bar);
            __builtin_amdgcn_fence(__ATOMIC_ACQUIRE, "agent");
            xb_add(&bar[XB_XGEN(b.x)], 1u);
            asm volatile("s_waitcnt vmcnt(0)" ::: "memory");
        } else {
            XB_SPIN(xb_ld(&bar[XB_XGEN(b.x)]) == gen, bar);
            __builtin_amdgcn_fence(__ATOMIC_ACQUIRE, "agent");
            asm volatile("s_waitcnt vmcnt(0)" ::: "memory");
        }
    }
    __syncthreads();
}

__device__ __forceinline__ void tr_item_load(const float* W, int N, const float* gain, int k0, int n0, int lane, f32x4 (&v)[8]) {
#pragma unroll
    for (int i = 0; i < 8; ++i) { const int kk = 8 * i + (lane >> 3), nn = 4 * (lane & 7); v[i] = *(const GAS f32x4*)(W + (size_t)(k0 + kk) * N + n0 + nn); }
    if (gain) {
        float gs[8];
#pragma unroll
        for (int i = 0; i < 8; ++i) gs[i] = *(const GAS float*)(gain + k0 + 8 * i + (lane >> 3));
#pragma unroll
        for (int i = 0; i < 8; ++i) v[i] = v[i] * gs[i];
    }
}
__device__ __forceinline__ void tr_item_store(const f32x4 (&v)[8], int K, bf16_t* WT, int k0, int drow0, LAS float* scr, int lane) {
#pragma unroll
    for (int i = 0; i < 8; ++i) { const int kk = 8 * i + (lane >> 3), nn = 4 * (lane & 7);
        scr[kk * 33 + nn] = v[i].x; scr[kk * 33 + nn + 1] = v[i].y; scr[kk * 33 + nn + 2] = v[i].z; scr[kk * 33 + nn + 3] = v[i].w; }
    LDS_WAIT(); asm volatile("" ::: "memory");
    const int c = lane & 7;
#pragma unroll
    for (int j = 0; j < 4; ++j) { const int n = (lane >> 3) + 8 * j; const LAS float* s = scr + (8 * c) * 33 + n;
        u32x4 o; o.x = pk2(s[0 * 33], s[1 * 33]); o.y = pk2(s[2 * 33], s[3 * 33]); o.z = pk2(s[4 * 33], s[5 * 33]); o.w = pk2(s[6 * 33], s[7 * 33]);
        *(GAS u32x4*)(WT + (size_t)(drow0 + n) * K + k0 + 8 * c) = o; }
    LDS_WAIT(); asm volatile("" ::: "memory");
}
__device__ __forceinline__ void p0_transpose_item(const float* W, int K, int N, const float* gain, bf16_t* WT, int k0, int n0, int drow0, LAS float* scr, int lane) {
    f32x4 v[8]; tr_item_load(W, N, gain, k0, n0, lane, v); tr_item_store(v, K, WT, k0, drow0, scr, lane);
}
__device__ __forceinline__ int map_gu(int n0) { return n0 < DFF ? (n0 / 128) * 256 + (n0 % 128) : ((n0 - DFF) / 128) * 256 + 128 + ((n0 - DFF) % 128); }
__device__ __forceinline__ int map_win(int n0) { return n0 < 6144 ? n0 : (n0 < 6176 ? 9216 + (n0 - 6144) : n0 - 32); }

constexpr int TI_GU = (DM / 64) * (2 * DFF / 32), TI_D = (DFF / 64) * (DM / 32), TI_IN = (DM / 64) * (IN_DIM / 32), TI_SSO = (DI / 64) * (DM / 32), TI_SQ = (DM / 64) * (DM / 32), TI_PLE = (PLE / 64) * (DM / 32);
constexpr int TI_H1 = TI_D + TI_IN;
constexpr int TI_H3 = TI_GU + TI_D + TI_SSO + 2 * TI_SQ + TI_PLE;
struct TrItem { const float* W; const float* gain; bf16_t* WT; int K, N, k0, n0, drow0; };
template <int PH> __device__ __forceinline__ TrItem deferred_item(Frame& F, int r) {
    TrItem t; t.gain = nullptr; int mapk = 0; size_t wso;
    if (PH == 1) {
        if (r < TI_D) { t.W = fin(F, I_WD1); t.K = DFF; t.N = DM; wso = WS_WD1; }
        else { r -= TI_D; t.W = fin(F, I_WIN); t.K = DM; t.N = IN_DIM; t.gain = fin(F, I_NMIX); wso = WS_WIN; mapk = 2; }
    } else {
        if (r < TI_GU) { t.W = fin(F, I_WGU2); t.K = DM; t.N = 2 * DFF; t.gain = fin(F, I_NFFN2); wso = WS_WGU2; mapk = 1; }
        else if ((r -= TI_GU) < TI_D) { t.W = fin(F, I_WD2); t.K = DFF; t.N = DM; wso = WS_WD2; }
        else if ((r -= TI_D) < TI_SSO) { t.W = fin(F, I_WSSO); t.K = DI; t.N = DM; t.gain = fin(F, I_NSSD); wso = WS_WSSO; }
        else if ((r -= TI_SSO) < TI_SQ) { t.W = fin(F, I_WO); t.K = DM; t.N = DM; wso = WS_WO; }
        else if ((r -= TI_SQ) < TI_SQ) { t.W = fin(F, I_WPG); t.K = DM; t.N = DM; t.gain = fin(F, I_NPLE); wso = WS_WPG; }
        else { r -= TI_SQ; t.W = fin(F, I_WPLE); t.K = PLE; t.N = DM; wso = WS_WPLE; }
    }
    const int nbk = t.N / 32, kb = r / nbk; t.n0 = (r % nbk) * 32; t.k0 = kb * 64; t.drow0 = (mapk == 1) ? map_gu(t.n0) : (mapk == 2) ? map_win(t.n0) : t.n0;
    t.WT = (bf16_t*)(F.ws + wso);
    return t;
}
template <int PH> __device__ __forceinline__ void deferred_transposes(Frame& F) {
    LAS float* scr = (LAS float*)(F.lds + F.wave * 16384);
    constexpr int NIT = (PH == 1) ? TI_H1 : TI_H3;
    const int gw = F.vcu * NWAVES + F.wave, NGW = F.G * NWAVES, lane = F.lane;
    if (gw < NIT) {
        f32x4 va[8], vb[8];
        TrItem ta = deferred_item<PH>(F, gw), tb = ta;
        tr_item_load(ta.W, ta.N, ta.gain, ta.k0, ta.n0, lane, va);
        for (int it = gw; it < NIT; it += 2 * NGW) {
            const bool hb = it + NGW < NIT;
            if (hb) { tb = deferred_item<PH>(F, it + NGW); tr_item_load(tb.W, tb.N, tb.gain, tb.k0, tb.n0, lane, vb); }
            tr_item_store(va, ta.K, ta.WT, ta.k0, ta.drow0, scr, lane);
            if (!hb) break;
            const bool ha = it + 2 * NGW < NIT;
            if (ha) { ta = deferred_item<PH>(F, it + 2 * NGW); tr_item_load(ta.W, ta.N, ta.gain, ta.k0, ta.n0, lane, va); }
            tr_item_store(vb, tb.K, tb.WT, tb.k0, tb.drow0, scr, lane);
            if (!ha) break;
        }
    }
    __syncthreads();
}

__device__ __forceinline__ void p0_prologue(Frame& F) {
    LAS float* scr = (LAS float*)(F.lds + F.wave * 16384);
    const int gw = F.vcu * NWAVES + F.wave, NGW = F.G * NWAVES, lane = F.lane;
    constexpr int NITEMS = TI_GU + TI_SQ;
    bf16_t* const wgu1 = (bf16_t*)(F.ws + WS_WGU1); bf16_t* const wpot = (bf16_t*)(F.ws + WS_WPOT);
    for (int it = gw; it < NITEMS; it += NGW) {
        int r = it;
        if (r < TI_GU) { const int nb = 2 * DFF / 32, kb = r / nb, n0 = (r % nb) * 32; p0_transpose_item(fin(F, I_WGU1), DM, 2 * DFF, fin(F, I_NFFN1), wgu1, kb * 64, n0, map_gu(n0), scr, lane); continue; } r -= TI_GU;
        { const int nb = DM / 32, kb = r / nb, n0 = (r % nb) * 32; p0_transpose_item(fin(F, I_WPOUT), PD, DM, fin(F, I_PSCALE), wpot, kb * 64, n0, n0, scr, lane); }
    }
    {
        bf16_t* const wgrp = (bf16_t*)(F.ws + WS_WGRP); const float* Wg = fin(F, I_WPGRP);
        for (int e = F.vcu * NTHREADS + F.tid; e < 4 * 256 * 256 / 8; e += F.G * NTHREADS) {
            const f32x4 a = *(const GAS f32x4*)(Wg + (size_t)e * 8), b = *(const GAS f32x4*)(Wg + (size_t)e * 8 + 4);
            u32x4 o; o.x = pk2(a.x, a.y); o.y = pk2(a.z, a.w); o.z = pk2(b.x, b.y); o.w = pk2(b.z, b.w);
            *(GAS u32x4*)(wgrp + (size_t)e * 8) = o; }
    }
    {
        bf16_t* const XB = (bf16_t*)(F.ws + WS_XB); bf16_t* const PB = (bf16_t*)(F.ws + WS_PB); float* const stA = (float*)(F.ws + WS_STATS_A);
        for (int m0 = gw; m0 < M; m0 += 2 * NGW) {
            const int m1 = m0 + NGW; const bool h1 = m1 < M; const int m1c = h1 ? m1 : m0;
            const float* xr0 = (m0 < MP) ? fin(F, I_XP) + (size_t)m0 * DM : fin(F, I_XS) + (size_t)(m0 - MP) * DM;
            const float* xr1 = (m1c < MP) ? fin(F, I_XP) + (size_t)m1c * DM : fin(F, I_XS) + (size_t)(m1c - MP) * DM;
            const float* pr0 = (m0 < MP) ? fin(F, I_PP) + (size_t)m0 * PLE : fin(F, I_PS) + (size_t)(m0 - MP) * PLE;
            const float* pr1 = (m1c < MP) ? fin(F, I_PP) + (size_t)m1c * PLE : fin(F, I_PS) + (size_t)(m1c - MP) * PLE;
            f32x4 v0[4], v1[4];
#pragma unroll
            for (int j = 0; j < 4; ++j) { v0[j] = *((const GAS f32x4*)xr0 + lane + 64 * j); v1[j] = *((const GAS f32x4*)xr1 + lane + 64 * j); }
            const f32x4 p0 = *((const GAS f32x4*)pr0 + lane), p1 = *((const GAS f32x4*)pr1 + lane);
            float s0 = 0.f, s1 = 0.f;
#pragma unroll
            for (int j = 0; j < 4; ++j) { s0 += (v0[j].x * v0[j].x + v0[j].y * v0[j].y) + (v0[j].z * v0[j].z + v0[j].w * v0[j].w); s1 += (v1[j].x * v1[j].x + v1[j].y * v1[j].y) + (v1[j].z * v1[j].z + v1[j].w * v1[j].w); }
            s0 = wave_sum(s0); s1 = wave_sum(s1);
            { GAS u32x2* o8 = (GAS u32x2*)(XB + (size_t)m0 * DM) + lane;
#pragma unroll
              for (int j = 0; j < 4; ++j) { u32x2 w; w.x = pk2(v0[j].x, v0[j].y); w.y = pk2(v0[j].z, v0[j].w); o8[64 * j] = w; }
              if (lane < 16) *(GAS float*)(stA + (size_t)m0 * 16 + lane) = (lane == 0) ? s0 : 0.f;
              u32x2 w; w.x = pk2(p0.x, p0.y); w.y = pk2(p0.z, p0.w); *((GAS u32x2*)(PB + (size_t)m0 * PLE) + lane) = w; }
            if (h1) { GAS u32x2* o8 = (GAS u32x2*)(XB + (size_t)m1 * DM) + lane;
#pragma unroll
              for (int j = 0; j < 4; ++j) { u32x2 w; w.x = pk2(v1[j].x, v1[j].y); w.y = pk2(v1[j].z, v1[j].w); o8[64 * j] = w; }
              if (lane < 16) *(GAS float*)(stA + (size_t)m1 * 16 + lane) = (lane == 0) ? s1 : 0.f;
              u32x2 w; w.x = pk2(p1.x, p1.y); w.y = pk2(p1.z, p1.w); *((GAS u32x2*)(PB + (size_t)m1 * PLE) + lane) = w; }
        }
    }
}


typedef short v4i16_t __attribute__((ext_vector_type(4)));
constexpr int IMG_B = 0, IMG_C = 32768, IMG_X = 65536, TAB_ACS = RING_BYTES + 1024, TAB_DT = TAB_ACS + 2048, TAB_SD = TAB_DT + 2048, TAB_DSK = TAB_SD + 2048;
constexpr int NCHUNK = SEQ / 128;
template <bool XS> __device__ __forceinline__ int img_off(int row, int ch) { return XS ? 256 * row + 16 * (ch ^ ((row & 7) << 1)) : 256 * row + 16 * (ch ^ (((row & 3) << 2) | ((row >> 2) & 3))); }
__device__ __forceinline__ bf16x8 tr_pair(const LAS unsigned char* p0, const LAS unsigned char* p1) {
    const v4i16_t a = __builtin_amdgcn_ds_read_tr16_b64_v4i16((LAS v4i16_t*)p0), b = __builtin_amdgcn_ds_read_tr16_b64_v4i16((LAS v4i16_t*)p1);
    return (bf16x8){a[0], a[1], a[2], a[3], b[0], b[1], b[2], b[3]};
}
__device__ __forceinline__ void ssd_tables_load(Frame& F, size_t row0, int g, float& d0, float& d1) {
    if (F.wave < 4) { const float* const DT = (const float*)(F.ws + WS_DT); const int head = g * HPG + F.wave;
        d0 = *(const GAS float*)(DT + (row0 + 2 * F.lane) * 32 + head); d1 = *(const GAS float*)(DT + (row0 + 2 * F.lane + 1) * 32 + head); }
}
__device__ __forceinline__ void ssd_tables_compute(Frame& F, int g, float d0, float d1) {
    LAS float* const acs = (LAS float*)(F.lds + TAB_ACS); LAS float* const dtl = (LAS float*)(F.lds + TAB_DT); LAS float* const sdec = (LAS float*)(F.lds + TAB_SD);
    if (F.wave < 4) {
        const int r = F.wave, lane = F.lane, head = g * HPG + r;
        const float Ah = ((const LAS float*)(F.lds + TAB_DSK))[4 + r];
        (void)head;
        const float a0 = d0 * Ah, a1 = d1 * Ah, loc = a0 + a1;
        float inc = loc;
#pragma unroll
        for (int o = 1; o < 64; o <<= 1) { const float t = __shfl_up(inc, o); if (lane >= o) inc += t; }
        const float exc = inc - loc;
        acs[(2 * lane) * 4 + r] = exc + a0; acs[(2 * lane + 1) * 4 + r] = inc;
        dtl[(2 * lane) * 4 + r] = d0; dtl[(2 * lane + 1) * 4 + r] = d1;
    }
    __syncthreads();
    { const int s = F.tid >> 2, r = F.tid & 3; sdec[s * 4 + r] = __expf(acs[127 * 4 + r] - acs[s * 4 + r]) * dtl[s * 4 + r]; }
    __syncthreads();
}
__device__ __forceinline__ void ssd_tables(Frame& F, size_t row0, int g) { float d0 = 0.f, d1 = 0.f; ssd_tables_load(F, row0, g, d0, d1); ssd_tables_compute(F, g, d0, d1); }
struct ConvMap { int kind, cc, run, gch; };
__device__ __forceinline__ ConvMap ssd_conv_map(int t, int g) {
    ConvMap m;
    if (t < 256) { m.kind = 0; m.cc = t & 31; m.run = t >> 5; } else if (t < 384) { m.kind = 1; m.cc = (t - 256) & 15; m.run = (t - 256) >> 4; } else { m.kind = 2; m.cc = (t - 384) & 15; m.run = (t - 384) >> 4; }
    m.gch = (m.kind == 0 ? g * 256 : (m.kind == 1 ? DI + g * DSTATE : DI + NG * DSTATE + g * DSTATE)) + 8 * m.cc;
    return m;
}
template <int I0 = 0, int I1 = 19>
__device__ __forceinline__ void ssd_conv_load(Frame& F, size_t row0, int b, int c, int g, u32x4 (&raw)[19]) {
    int tid_ = threadIdx.x; asm volatile("" : "+v"(tid_));
    const ConvMap m = ssd_conv_map(tid_, g);
    const bf16_t* const XBC = (const bf16_t*)(F.ws + WS_XBC); const bf16_t* const HALO = (const bf16_t*)(F.ws + WS_HALO);
#pragma unroll
    for (int i = I0; i < I1; ++i) {
        if (i < 3 && m.run == 0) { if (c == 0) raw[i] = (u32x4){0u, 0u, 0u, 0u}; else raw[i] = *(const GAS u32x4*)(HALO + ((((size_t)b * 16 + c) * 3 + i) * CD) + m.gch); }
        else raw[i] = *(const GAS u32x4*)(XBC + (row0 + 16 * m.run + i - 3) * CD + m.gch); }
}
__device__ __forceinline__ void ssd_conv_store(Frame& F, size_t row0, int g, const u32x4 (&raw)[19]) {
    const ConvMap m = ssd_conv_map(F.tid, g);
    bf16_t* const XBC = (bf16_t*)(F.ws + WS_XBC);
    const float* const convw = F.p_convw; const float* const convb = F.p_convb;
    float cw[4][8], cb[8];
#pragma unroll
    for (int k = 0; k < 4; ++k) { const f32x4 a = *(const GAS f32x4*)(convw + (size_t)k * CD + m.gch), b_ = *(const GAS f32x4*)(convw + (size_t)k * CD + m.gch + 4);
        cw[k][0] = a.x; cw[k][1] = a.y; cw[k][2] = a.z; cw[k][3] = a.w; cw[k][4] = b_.x; cw[k][5] = b_.y; cw[k][6] = b_.z; cw[k][7] = b_.w; }
    { const f32x4 a = *(const GAS f32x4*)(convb + m.gch), b_ = *(const GAS f32x4*)(convb + m.gch + 4); cb[0] = a.x; cb[1] = a.y; cb[2] = a.z; cb[3] = a.w; cb[4] = b_.x; cb[5] = b_.y; cb[6] = b_.z; cb[7] = b_.w; }
    LAS unsigned char* const img = F.lds + (m.kind == 0 ? IMG_X + (m.cc >> 4) * 32768 : IMG_B);
    const LAS float* const sdec = (const LAS float*)(F.lds + TAB_SD);
    const int chl = m.cc & 15, hr = m.cc >> 3;
#pragma unroll
    for (int i = 0; i < 16; ++i) {
        const int s = 16 * m.run + i;
        float o[8];
#pragma unroll
        for (int j2 = 0; j2 < 4; ++j2) {
            const unsigned w0 = raw[i][j2], w1 = raw[i + 1][j2], w2 = raw[i + 2][j2], w3 = raw[i + 3][j2];
            const float lo = cb[2 * j2] + cw[0][2 * j2] * bflo(w0) + cw[1][2 * j2] * bflo(w1) + cw[2][2 * j2] * bflo(w2) + cw[3][2 * j2] * bflo(w3);
            const float hi = cb[2 * j2 + 1] + cw[0][2 * j2 + 1] * bfhi(w0) + cw[1][2 * j2 + 1] * bfhi(w1) + cw[2][2 * j2 + 1] * bfhi(w2) + cw[3][2 * j2 + 1] * bfhi(w3);
            o[2 * j2] = silu_f(lo); o[2 * j2 + 1] = silu_f(hi);
        }
        u32x4 pk; pk.x = cvt_pk_bf16(o[0], o[1]); pk.y = cvt_pk_bf16(o[2], o[3]); pk.z = cvt_pk_bf16(o[4], o[5]); pk.w = cvt_pk_bf16(o[6], o[7]);
        *(GAS u32x4*)(XBC + (row0 + s) * CD + m.gch) = pk;
        if (m.kind == 0) { const float sc = sdec[s * 4 + hr];
            pk.x = cvt_pk_bf16(o[0] * sc, o[1] * sc); pk.y = cvt_pk_bf16(o[2] * sc, o[3] * sc); pk.z = cvt_pk_bf16(o[4] * sc, o[5] * sc); pk.w = cvt_pk_bf16(o[6] * sc, o[7] * sc); }
        if (m.kind != 2) *(LAS u32x4*)(img + img_off<false>(s, chl)) = pk;
    }
}
__device__ __forceinline__ void ssd_copy_load(Frame& F, size_t row0, int g, u32x4 (&raw)[16]) {
    const ConvMap m = ssd_conv_map(F.tid, g);
    const bf16_t* const XBC = (const bf16_t*)(F.ws + WS_XBC);
#pragma unroll
    for (int i = 0; i < 16; ++i) raw[i] = *(const GAS u32x4*)(XBC + (row0 + 16 * m.run + i) * CD + m.gch);
}
__device__ __forceinline__ void ssd_copy_store(Frame& F, int g, const u32x4 (&raw)[16]) {
    const ConvMap m = ssd_conv_map(F.tid, g);
    LAS unsigned char* const img = F.lds + (m.kind == 0 ? IMG_X + (m.cc >> 4) * 32768 : (m.kind == 1 ? IMG_B : IMG_C));
    const int chl = m.cc & 15;
#pragma unroll
    for (int i = 0; i < 16; ++i) { const int s = 16 * m.run + i; *(LAS u32x4*)(img + (m.kind == 0 ? img_off<true>(s, chl) : img_off<false>(s, chl))) = raw[i]; }
}
__device__ __forceinline__ void ssd_states_phase(Frame& F) {
    bf16_t* const ST = (bf16_t*)(F.ws + WS_HPREV);
    float* const CDEC = (float*)(F.ws + WS_CDEC);
    const int w = F.wave, lane = F.lane, ql = lane & 15, gq = lane >> 4, qq = ql >> 2, pp = ql & 3, r = w >> 1, nh = w & 1;
    int sbo[4][2], sxo[4][2];
#pragma unroll
    for (int f = 0; f < 4; ++f) { const int colb = 64 * nh + 16 * f + 4 * pp, colx = 64 * (r & 1) + 16 * f + 4 * pp;
#pragma unroll
        for (int t4 = 0; t4 < 2; ++t4) { sbo[f][t4] = img_off<false>(8 * gq + qq + 4 * t4, colb >> 3) + 2 * (colb & 7); sxo[f][t4] = img_off<false>(8 * gq + qq + 4 * t4, colx >> 3) + 2 * (colx & 7); } }
    u32x4 raw[19]; float d0 = 0.f, d1 = 0.f;
    constexpr int NIT = BATCH * NCHUNK * NG;
    if (F.vcu < NIT) { const int it = F.vcu, g = it & 7, c = (it >> 3) & (NCHUNK - 1), b = it >> 7; const size_t row0 = (size_t)b * SEQ + (size_t)c * 128;
        ssd_conv_load(F, row0, b, c, g, raw); ssd_tables_load(F, row0, g, d0, d1); }
    for (int it = F.vcu; it < NIT; it += F.G) {
        const int g = it & 7, c = (it >> 3) & (NCHUNK - 1), b = it >> 7;
        const size_t row0 = (size_t)b * SEQ + (size_t)c * 128;
        asm volatile("s_waitcnt vmcnt(0)" ::: "memory");
        ssd_tables_compute(F, g, d0, d1);
        ssd_conv_store(F, row0, g, raw);
        __syncthreads();
        if (it + F.G < NIT) { const int it2 = it + F.G, g2 = it2 & 7, c2 = (it2 >> 3) & (NCHUNK - 1), b2 = it2 >> 7; const size_t row2 = (size_t)b2 * SEQ + (size_t)c2 * 128;
            ssd_conv_load(F, row2, b2, c2, g2, raw); ssd_tables_load(F, row2, g2, d0, d1); }
        const int head = g * HPG + r;
        bf16_t* const stp = ST + ((((size_t)b * NCHUNK + c) * NH + head) * HD) * DSTATE;
#pragma unroll
        for (int nh2 = 0; nh2 < 2; ++nh2) {
            f32x4 acc[2][4];
#pragma unroll
            for (int i = 0; i < 2; ++i)
#pragma unroll
                for (int j = 0; j < 4; ++j) acc[i][j] = (f32x4){0.f, 0.f, 0.f, 0.f};
#pragma unroll
            for (int ks = 0; ks < 4; ++ks) {
                bf16x8 af[2], xf[4];
#pragma unroll
                for (int nf = 0; nf < 2; ++nf) { const LAS unsigned char* p = F.lds + IMG_B + sbo[2 * nh2 + nf][0] + 8192 * ks; const LAS unsigned char* p4 = F.lds + IMG_B + sbo[2 * nh2 + nf][1] + 8192 * ks; af[nf] = tr_pair(p, p4); }
#pragma unroll
                for (int pf = 0; pf < 4; ++pf) { const LAS unsigned char* p = F.lds + IMG_X + (r >> 1) * 32768 + sxo[pf][0] + 8192 * ks; const LAS unsigned char* p4 = F.lds + IMG_X + (r >> 1) * 32768 + sxo[pf][1] + 8192 * ks; xf[pf] = tr_pair(p, p4); }
#pragma unroll
                for (int nf = 0; nf < 2; ++nf)
#pragma unroll
                    for (int pf = 0; pf < 4; ++pf) acc[nf][pf] = __builtin_amdgcn_mfma_f32_16x16x32_bf16(af[nf], xf[pf], acc[nf][pf], 0, 0, 0);
            }
#pragma unroll
            for (int pf = 0; pf < 4; ++pf)
#pragma unroll
                for (int nf = 0; nf < 2; ++nf) { u32x2 o; o.x = cvt_pk_bf16(acc[nf][pf][0], acc[nf][pf][1]); o.y = cvt_pk_bf16(acc[nf][pf][2], acc[nf][pf][3]);
                    *(GAS u32x2*)(stp + (size_t)(16 * pf + ql) * DSTATE + 64 * nh + 32 * nh2 + 16 * nf + 4 * gq) = o; }
        }
        if (F.tid < 4) { const LAS float* acs = (const LAS float*)(F.lds + TAB_ACS); *(GAS float*)(CDEC + ((size_t)b * NCHUNK + c) * NH + g * HPG + F.tid) = __expf(acs[127 * 4 + F.tid]); }
        __syncthreads();
    }
}
__device__ __forceinline__ void ssd_scan_phase(Frame& F) {
    bf16_t* const HP = (bf16_t*)(F.ws + WS_HPREV); const float* const CDEC = (const float*)(F.ws + WS_CDEC); float* const hout = F.out + O_SSM_P;
    const int gt = F.vcu * NTHREADS + F.tid, NT = F.G * NTHREADS;
    constexpr int PER = NH * HD * DSTATE / 8;
    for (int e = gt; e < BATCH * PER; e += NT) {
        const int b = e / PER, i8 = e % PER, head = i8 / (HD * DSTATE / 8);
        u32x4 stv[NCHUNK];
#pragma unroll
        for (int c = 0; c < NCHUNK; ++c) stv[c] = *(const GAS u32x4*)(HP + (((size_t)b * NCHUNK + c) * (size_t)PER + i8) * 8);
        float dec[NCHUNK];
#pragma unroll
        for (int c = 0; c < NCHUNK; ++c) dec[c] = *(const GAS float*)(CDEC + ((size_t)b * NCHUNK + c) * NH + head);
        f32x4 h0 = (f32x4){0.f, 0.f, 0.f, 0.f}, h1 = h0;
#pragma unroll
        for (int c = 0; c < NCHUNK; ++c) {
            if (c > 0) *(GAS u32x4*)(HP + (((size_t)b * NCHUNK + c) * (size_t)PER + i8) * 8) = pg8::pack8(h0, h1);
            f32x4 s0, s1; pg8::unpack8(stv[c], s0, s1);
            h0 = h0 * dec[c] + s0; h1 = h1 * dec[c] + s1;
        }
        *(GAS f32x4*)(hout + ((size_t)b * PER + i8) * 8) = h0; *(GAS f32x4*)(hout + ((size_t)b * PER + i8) * 8 + 4) = h1;
    }
}
__device__ __forceinline__ void ssd_out_phase(Frame& F) {
    const bf16_t* const HP = (const bf16_t*)(F.ws + WS_HPREV); bf16_t* const ZY = (bf16_t*)(F.ws + WS_Z);
    const int w = F.wave, lane = F.lane, ql = lane & 15, gq = lane >> 4, qq = ql >> 2, pp = ql & 3, q0 = 16 * w;
    const LAS float* const acs = (const LAS float*)(F.lds + TAB_ACS); const LAS float* const dtl = (const LAS float*)(F.lds + TAB_DT);
    int cfo[4], bbo[4], hbo[4], xbo[2][4];
#pragma unroll
    for (int ks = 0; ks < 4; ++ks) { cfo[ks] = IMG_C + img_off<false>(q0 + ql, 4 * ks + gq); bbo[ks] = IMG_B + img_off<false>(ql, 4 * ks + gq); hbo[ks] = img_off<false>(ql, 4 * ks + gq); }
#pragma unroll
    for (int rr = 0; rr < 2; ++rr)
#pragma unroll
        for (int pf = 0; pf < 4; ++pf) xbo[rr][pf] = IMG_X + img_off<true>(4 * gq + qq, 8 * rr + 2 * pf + (pp >> 1)) + 8 * (pp & 1);
    u32x4 raw[16]; float d0 = 0.f, d1 = 0.f;
    constexpr int NIT = BATCH * NCHUNK * NG;
    if (F.vcu < NIT) { const int it = F.vcu, g = it & 7, c = (it >> 3) & (NCHUNK - 1), b = it >> 7; const size_t row0 = (size_t)b * SEQ + (size_t)c * 128;
        ssd_copy_load(F, row0, g, raw); ssd_tables_load(F, row0, g, d0, d1); }
    for (int it = F.vcu; it < NIT; it += F.G) {
        const int g = it & 7, c = (it >> 3) & (NCHUNK - 1), b = it >> 7;
        const size_t row0 = (size_t)b * SEQ + (size_t)c * 128;
        ssd_tables_compute(F, g, d0, d1);
        ssd_copy_store(F, g, raw);
        __syncthreads();
        if (it + F.G < NIT) { const int it2 = it + F.G, g2 = it2 & 7, c2 = (it2 >> 3) & (NCHUNK - 1), b2 = it2 >> 7; const size_t row2 = (size_t)b2 * SEQ + (size_t)c2 * 128;
            ssd_copy_load(F, row2, g2, raw); ssd_tables_load(F, row2, g2, d0, d1); }
        bf16x8 cf[4];
#pragma unroll
        for (int ks = 0; ks < 4; ++ks) cf[ks] = *(const LAS bf16x8*)(F.lds + cfo[ks]);
        bf16_t* const zp = ZY + (row0 + q0 + ql) * DI + g * 256 + 4 * gq;
        const LAS float* const acs_l = acs + 16 * gq; const LAS float* const dtl_l = dtl + 16 * gq;
        f32x4 acc[4][4];
        float aq[4];
#pragma unroll
        for (int r = 0; r < 4; ++r) { aq[r] = acs[(q0 + ql) * 4 + r];
#pragma unroll
            for (int pf = 0; pf < 4; ++pf) acc[r][pf] = (f32x4){0.f, 0.f, 0.f, 0.f}; }
#pragma unroll
        for (int ks = 0; ks < 4; ++ks) if (2 * ks <= w) {
            f32x4 cb[2];
#pragma unroll
            for (int hf = 0; hf < 2; ++hf) { cb[hf] = (f32x4){0.f, 0.f, 0.f, 0.f};
                if (2 * ks + hf <= w) {
#pragma unroll
                    for (int kn = 0; kn < 4; ++kn) { const bf16x8 bfr = *(const LAS bf16x8*)(F.lds + bbo[kn] + 4096 * (2 * ks + hf)); cb[hf] = __builtin_amdgcn_mfma_f32_16x16x32_bf16(bfr, cf[kn], cb[hf], 0, 0, 0); } } }
#pragma unroll
            for (int r = 0; r < 4; ++r) {
                const float Dh = *(const GAS float*)(F.p_dskip + g * HPG + r);
                float v[8];
#pragma unroll
                for (int hf = 0; hf < 2; ++hf) { const int sf = 2 * ks + hf;
#pragma unroll
                    for (int rg = 0; rg < 4; ++rg) { const int sl = 4 * gq + rg;
                        float val = 0.f;
                        if (sf <= w) { const float as = acs_l[64 * sf + 4 * rg + r], d = dtl_l[64 * sf + 4 * rg + r];
                            val = cb[hf][rg] * __expf(aq[r] - as) * d;
                            if (sf == w) { if (sl > ql) val = 0.f; else if (sl == ql) val += Dh; } }
                        v[4 * hf + rg] = val; } }
                u32x4 pk; pk.x = cvt_pk_bf16(v[0], v[1]); pk.y = cvt_pk_bf16(v[2], v[3]); pk.z = cvt_pk_bf16(v[4], v[5]); pk.w = cvt_pk_bf16(v[6], v[7]);
                const bf16x8 wf = __builtin_bit_cast(bf16x8, pk);
#pragma unroll
                for (int pf = 0; pf < 4; ++pf) {
                    const LAS unsigned char* const xb = F.lds + xbo[r & 1][pf] + (r >> 1) * 32768 + 8192 * ks;
                    const bf16x8 xf = tr_pair(xb, xb + 4096);
                    acc[r][pf] = __builtin_amdgcn_mfma_f32_16x16x32_bf16(xf, wf, acc[r][pf], 0, 0, 0); }
            }
        }
        u32x4 hreg[8];
        if (c > 0) {
            const u32x4* hsrc = (const u32x4*)(HP + ((((size_t)b * NCHUNK + c) * NH + g * HPG) * HD) * DSTATE) + F.tid;
#pragma unroll
            for (int i = 0; i < 8; ++i) hreg[i] = *(const GAS u32x4*)(hsrc + 512 * i);
        }
        if (c > 0) {
            __syncthreads();
#pragma unroll
            for (int i = 0; i < 8; ++i) { const int e = F.tid + 512 * i, hr_ = e >> 10, p_ = (e >> 4) & 63, ch_ = e & 15;
                *(LAS u32x4*)(F.lds + IMG_X + hr_ * 16384 + img_off<false>(p_, ch_)) = hreg[i]; }
            __syncthreads();
#pragma unroll
            for (int r = 0; r < 4; ++r) { const float eaq = __expf(aq[r]);
#pragma unroll
                for (int pf = 0; pf < 4; ++pf) { f32x4 yo = (f32x4){0.f, 0.f, 0.f, 0.f};
#pragma unroll
                    for (int ks = 0; ks < 4; ++ks) { const bf16x8 hf_ = *(const LAS bf16x8*)(F.lds + IMG_X + r * 16384 + hbo[ks] + 4096 * pf); yo = __builtin_amdgcn_mfma_f32_16x16x32_bf16(hf_, cf[ks], yo, 0, 0, 0); }
                    acc[r][pf] += yo * eaq; } }
        }
        float ssum = 0.f;
#pragma unroll
        for (int r = 0; r < 4; ++r)
#pragma unroll
            for (int pf = 0; pf < 4; ++pf) {
                const u32x2 zz = *(const GAS u32x2*)(zp + r * 64 + 16 * pf);
                const f32x4 y = acc[r][pf] * (f32x4){bflo(zz.x), bfhi(zz.x), bflo(zz.y), bfhi(zz.y)};
                acc[r][pf] = y; ssum += (y[0] * y[0] + y[1] * y[1]) + (y[2] * y[2] + y[3] * y[3]); }
        ssum += __shfl_xor(ssum, 16); ssum += __shfl_xor(ssum, 32);
        const float rsn = __builtin_amdgcn_rsqf(ssum * (1.0f / 256.0f) + EPS);
#pragma unroll
        for (int r = 0; r < 4; ++r)
#pragma unroll
            for (int pf = 0; pf < 4; ++pf) { u32x2 o; o.x = cvt_pk_bf16(acc[r][pf][0] * rsn, acc[r][pf][1] * rsn); o.y = cvt_pk_bf16(acc[r][pf][2] * rsn, acc[r][pf][3] * rsn);
                *(GAS u32x2*)(zp + r * 64 + 16 * pf) = o; }
        __syncthreads();
    }
}


__device__ __forceinline__ void ssd_conv_store_local(Frame& F, size_t row0, int g, const u32x4 (&raw)[19]) {
    int tid_ = threadIdx.x; asm volatile("" : "+v"(tid_));
    const ConvMap m = ssd_conv_map(tid_, g);
    bf16_t* const XBC = (bf16_t*)(F.ws + WS_XBC);
    const float* const convw = F.p_convw; const float* const convb = F.p_convb;
    float cw[4][8], cb[8];
#pragma unroll
    for (int k = 0; k < 4; ++k) { const f32x4 a = *(const GAS f32x4*)(convw + (size_t)k * CD + m.gch), b_ = *(const GAS f32x4*)(convw + (size_t)k * CD + m.gch + 4);
        cw[k][0] = a.x; cw[k][1] = a.y; cw[k][2] = a.z; cw[k][3] = a.w; cw[k][4] = b_.x; cw[k][5] = b_.y; cw[k][6] = b_.z; cw[k][7] = b_.w; }
    { const f32x4 a = *(const GAS f32x4*)(convb + m.gch), b_ = *(const GAS f32x4*)(convb + m.gch + 4); cb[0] = a.x; cb[1] = a.y; cb[2] = a.z; cb[3] = a.w; cb[4] = b_.x; cb[5] = b_.y; cb[6] = b_.z; cb[7] = b_.w; }
    LAS unsigned char* const img = F.lds + (m.kind == 0 ? IMG_X + (m.cc >> 4) * 32768 : (m.kind == 1 ? IMG_B : IMG_C));
    const int chl = m.cc & 15;
#pragma unroll
    for (int i = 0; i < 16; ++i) {
        const int s = 16 * m.run + i;
        float o[8];
#pragma unroll
        for (int j2 = 0; j2 < 4; ++j2) {
            const unsigned w0 = raw[i][j2], w1 = raw[i + 1][j2], w2 = raw[i + 2][j2], w3 = raw[i + 3][j2];
            const float lo = cb[2 * j2] + cw[0][2 * j2] * bflo(w0) + cw[1][2 * j2] * bflo(w1) + cw[2][2 * j2] * bflo(w2) + cw[3][2 * j2] * bflo(w3);
            const float hi = cb[2 * j2 + 1] + cw[0][2 * j2 + 1] * bfhi(w0) + cw[1][2 * j2 + 1] * bfhi(w1) + cw[2][2 * j2 + 1] * bfhi(w2) + cw[3][2 * j2 + 1] * bfhi(w3);
            o[2 * j2] = silu_f(lo); o[2 * j2 + 1] = silu_f(hi);
        }
        u32x4 pk; pk.x = cvt_pk_bf16(o[0], o[1]); pk.y = cvt_pk_bf16(o[2], o[3]); pk.z = cvt_pk_bf16(o[4], o[5]); pk.w = cvt_pk_bf16(o[6], o[7]);
        if (m.kind == 2) *(GAS u32x4*)(XBC + (row0 + s) * CD + m.gch) = pk;
        *(LAS u32x4*)(img + (m.kind == 0 ? img_off<true>(s, chl) : img_off<false>(s, chl))) = pk;
    }
}
__device__ __forceinline__ void ssd_local_phase(Frame& F) {
    bf16_t* const XBC = (bf16_t*)(F.ws + WS_XBC); bf16_t* const ST = (bf16_t*)(F.ws + WS_HPREV); float* const CDEC = (float*)(F.ws + WS_CDEC); float* const EAQ = (float*)(F.ws + WS_EAQ);
    const int w = F.wave, q0 = 16 * w, hr = w >> 1, nh = w & 1;
    const LAS float* const acs = (const LAS float*)(F.lds + TAB_ACS); const LAS float* const dtl = (const LAS float*)(F.lds + TAB_DT); const LAS float* const sdec = (const LAS float*)(F.lds + TAB_SD);
    u32x4 raw[19]; float d0 = 0.f, d1 = 0.f; int pg_ = -1;
    constexpr int NIT = BATCH * NCHUNK * NG;
    if (F.vcu < NIT) { const int it = F.vcu, g = it & 7, c = (it >> 3) & (NCHUNK - 1), b = it >> 7; const size_t row0 = (size_t)b * SEQ + (size_t)c * 128;
        ssd_conv_load(F, row0, b, c, g, raw); ssd_tables_load(F, row0, g, d0, d1); }
    for (int it = F.vcu; it < NIT; it += F.G) {
        { int t_ = threadIdx.x; asm volatile("" : "+v"(t_)); F.tid = t_; F.lane = t_ & 63; }
        const int lane = F.lane;
        const int g = it & 7, c = (it >> 3) & (NCHUNK - 1), b = it >> 7;
        const size_t row0 = (size_t)b * SEQ + (size_t)c * 128;
        if (g != pg_) {
            if (F.tid < 4) { ((LAS float*)(F.lds + TAB_DSK))[F.tid] = *(const GAS float*)(F.p_dskip + g * HPG + F.tid); ((LAS float*)(F.lds + TAB_DSK))[4 + F.tid] = -__expf(*(const GAS float*)(F.p_alog + g * HPG + F.tid)); }
            pg_ = g; __syncthreads();
        }
        asm volatile("s_waitcnt vmcnt(0)" ::: "memory");
        ssd_tables_compute(F, g, d0, d1);
        ssd_conv_store_local(F, row0, g, raw);
        __syncthreads();
        if (it + F.G < NIT) { const int it2 = it + F.G, g2 = it2 & 7, c2 = (it2 >> 3) & (NCHUNK - 1), b2 = it2 >> 7; const size_t row2 = (size_t)b2 * SEQ + (size_t)c2 * 128;
            ssd_conv_load<0, 8>(F, row2, b2, c2, g2, raw); }
        asm volatile("" ::: "memory"); __builtin_amdgcn_sched_barrier(0);
        int lane_ = lane; asm volatile("" : "+v"(lane_));
        const int ql = lane_ & 15, gq = lane_ >> 4, qq = ql >> 2, pp = ql & 3;
        int cfo[4], bbo[4], xbo[2][4], sbo[4];
#pragma unroll
        for (int ks = 0; ks < 4; ++ks) { cfo[ks] = IMG_C + img_off<false>(q0 + ql, 4 * ks + gq); bbo[ks] = IMG_B + img_off<false>(ql, 4 * ks + gq); }
#pragma unroll
        for (int rr = 0; rr < 2; ++rr)
#pragma unroll
                for (int pf = 0; pf < 4; ++pf) xbo[rr][pf] = IMG_X + img_off<true>(4 * gq + qq, 8 * rr + 2 * pf + (pp >> 1)) + 8 * (pp & 1);
#pragma unroll
        for (int nf = 0; nf < 4; ++nf) { const int col = 64 * nh + 16 * nf + 4 * pp; sbo[nf] = IMG_B + img_off<false>(4 * gq + qq, col >> 3) + 2 * (col & 7); }
        {
            bf16x8 cf[4];
#pragma unroll
            for (int ks = 0; ks < 4; ++ks) cf[ks] = *(const LAS bf16x8*)(F.lds + cfo[ks]);
            const LAS float* const acs_l = acs + 16 * gq; const LAS float* const dtl_l = dtl + 16 * gq;
            f32x4 acc[4][4]; float aq[4];
#pragma unroll
            for (int r = 0; r < 4; ++r) { aq[r] = acs[(q0 + ql) * 4 + r];
#pragma unroll
                for (int pf = 0; pf < 4; ++pf) acc[r][pf] = (f32x4){0.f, 0.f, 0.f, 0.f}; }
#pragma unroll
            for (int ks = 0; ks < 4; ++ks) if (2 * ks <= w) {
                f32x4 cb[2];
#pragma unroll
                for (int hf = 0; hf < 2; ++hf) { cb[hf] = (f32x4){0.f, 0.f, 0.f, 0.f};
                    if (2 * ks + hf <= w) {
#pragma unroll
                        for (int kn = 0; kn < 4; ++kn) { const bf16x8 bfr = *(const LAS bf16x8*)(F.lds + bbo[kn] + 4096 * (2 * ks + hf)); cb[hf] = __builtin_amdgcn_mfma_f32_16x16x32_bf16(bfr, cf[kn], cb[hf], 0, 0, 0); } } }
#pragma unroll
                for (int r = 0; r < 4; ++r) {
                    const float Dh = ((const LAS float*)(F.lds + TAB_DSK))[r];
                    float v[8];
#pragma unroll
                    for (int hf = 0; hf < 2; ++hf) { const int sf = 2 * ks + hf;
#pragma unroll
                        for (int rg = 0; rg < 4; ++rg) { const int sl = 4 * gq + rg;
                            float val = 0.f;
                            if (sf <= w) { const float as = acs_l[64 * sf + 4 * rg + r], d = dtl_l[64 * sf + 4 * rg + r];
                                val = cb[hf][rg] * __expf(aq[r] - as) * d;
                                if (sf == w) { if (sl > ql) val = 0.f; else if (sl == ql) val += Dh; } }
                            v[4 * hf + rg] = val; } }
                    u32x4 pk; pk.x = cvt_pk_bf16(v[0], v[1]); pk.y = cvt_pk_bf16(v[2], v[3]); pk.z = cvt_pk_bf16(v[4], v[5]); pk.w = cvt_pk_bf16(v[6], v[7]);
                    const bf16x8 wf = __builtin_bit_cast(bf16x8, pk);
#pragma unroll
                    for (int pf = 0; pf < 4; ++pf) {
                        const LAS unsigned char* const xb = F.lds + xbo[r & 1][pf] + (r >> 1) * 32768 + 8192 * ks;
                        const bf16x8 xf = tr_pair(xb, xb + 4096);
                        acc[r][pf] = __builtin_amdgcn_mfma_f32_16x16x32_bf16(xf, wf, acc[r][pf], 0, 0, 0); }
                }
            }
            LAS unsigned char* const stg = F.lds + IMG_C + w * 4096;
            bf16_t* const og = XBC + (row0 + q0 + (lane >> 4)) * CD + g * 256 + 8 * (lane & 15);
#pragma unroll
            for (int h = 0; h < 2; ++h) {
#pragma unroll
                for (int rr = 0; rr < 2; ++rr)
#pragma unroll
                    for (int pf = 0; pf < 4; ++pf) { const int r = 2 * h + rr, ch = 8 * rr + 2 * pf + (gq >> 1);
                        u32x2 o; o.x = cvt_pk_bf16(acc[r][pf][0], acc[r][pf][1]); o.y = cvt_pk_bf16(acc[r][pf][2], acc[r][pf][3]);
                        *(LAS u32x2*)(stg + ql * 256 + ((ch ^ ql) & 15) * 16 + (gq & 1) * 8) = o; }
                asm volatile("s_waitcnt lgkmcnt(0)" ::: "memory");
#pragma unroll
                for (int i = 0; i < 4; ++i) { const int row = 4 * i + (lane >> 4); const u32x4 v = *(const LAS u32x4*)(stg + row * 256 + (((lane & 15) ^ row) & 15) * 16); *(GAS u32x4*)(og + (size_t)(4 * i) * CD + 128 * h) = v; }
                asm volatile("s_waitcnt lgkmcnt(0)" ::: "memory");
            }
            if (gq == 0) *(GAS f32x4*)(EAQ + (row0 + q0 + ql) * 32 + g * HPG) = (f32x4){__expf(aq[0]), __expf(aq[1]), __expf(aq[2]), __expf(aq[3])};
        }
        asm volatile("" ::: "memory"); __builtin_amdgcn_sched_barrier(0);
        if (it + F.G < NIT) { const int it2 = it + F.G, g2 = it2 & 7, c2 = (it2 >> 3) & (NCHUNK - 1), b2 = it2 >> 7; const size_t row2 = (size_t)b2 * SEQ + (size_t)c2 * 128;
            ssd_conv_load<8, 19>(F, row2, b2, c2, g2, raw); ssd_tables_load(F, row2, g2, d0, d1); }
        {
            const int head = g * HPG + hr;
            bf16_t* const stp = ST + ((((size_t)b * NCHUNK + c) * NH + head) * HD) * DSTATE + 64 * nh;
            LAS unsigned char* const stg = F.lds + IMG_C + w * 4096;
#pragma unroll
            for (int ph2 = 0; ph2 < 2; ++ph2) {
                f32x4 acc[4][2];
#pragma unroll
                for (int i = 0; i < 4; ++i)
#pragma unroll
                    for (int j = 0; j < 2; ++j) acc[i][j] = (f32x4){0.f, 0.f, 0.f, 0.f};
#pragma unroll
                for (int ks = 0; ks < 4; ++ks) {
                    asm volatile("" ::: "memory");
                    float sd[8];
#pragma unroll
                    for (int j = 0; j < 8; ++j) sd[j] = sdec[(32 * ks + 16 * (j >> 2) + 4 * gq + (j & 3)) * 4 + hr];
                    bf16x8 af[4], xf[2];
#pragma unroll
                    for (int nf = 0; nf < 4; ++nf) { const LAS unsigned char* p = F.lds + sbo[nf] + 8192 * ks; af[nf] = tr_pair(p, p + 4096); }
#pragma unroll
                    for (int pf = 0; pf < 2; ++pf) { const LAS unsigned char* p = F.lds + xbo[hr & 1][2 * ph2 + pf] + (hr >> 1) * 32768 + 8192 * ks;
                        const u32x4 xr = __builtin_bit_cast(u32x4, tr_pair(p, p + 4096));
                        u32x4 xs; xs.x = cvt_pk_bf16(bflo(xr.x) * sd[0], bfhi(xr.x) * sd[1]); xs.y = cvt_pk_bf16(bflo(xr.y) * sd[2], bfhi(xr.y) * sd[3]);
                        xs.z = cvt_pk_bf16(bflo(xr.z) * sd[4], bfhi(xr.z) * sd[5]); xs.w = cvt_pk_bf16(bflo(xr.w) * sd[6], bfhi(xr.w) * sd[7]);
                        xf[pf] = __builtin_bit_cast(bf16x8, xs); }
#pragma unroll
                    for (int nf = 0; nf < 4; ++nf)
#pragma unroll
                        for (int pf = 0; pf < 2; ++pf) acc[nf][pf] = __builtin_amdgcn_mfma_f32_16x16x32_bf16(af[nf], xf[pf], acc[nf][pf], 0, 0, 0);
                }
#pragma unroll
                for (int pf = 0; pf < 2; ++pf)
#pragma unroll
                    for (int nf = 0; nf < 4; ++nf) { const int row = 16 * pf + ql, ch = 2 * nf + (gq >> 1);
                        u32x2 o; o.x = cvt_pk_bf16(acc[nf][pf][0], acc[nf][pf][1]); o.y = cvt_pk_bf16(acc[nf][pf][2], acc[nf][pf][3]);
                        *(LAS u32x2*)(stg + row * 128 + ((ch ^ row) & 7) * 16 + (gq & 1) * 8) = o; }
                asm volatile("s_waitcnt lgkmcnt(0)" ::: "memory");
#pragma unroll
                for (int i = 0; i < 4; ++i) { const int row = 8 * i + (lane_ >> 3), ch = lane_ & 7;
                    const u32x4 v = *(const LAS u32x4*)(stg + row * 128 + ((ch ^ row) & 7) * 16);
                    *(GAS u32x4*)(stp + (size_t)(32 * ph2 + row) * DSTATE + 8 * ch) = v; }
                asm volatile("s_waitcnt lgkmcnt(0)" ::: "memory");
            }
            if (F.tid < 4) *(GAS float*)(CDEC + ((size_t)b * NCHUNK + c) * NH + g * HPG + F.tid) = __expf(acs[127 * 4 + F.tid]);
        }
        __syncthreads();
    }
}
__device__ __forceinline__ void ssd_final_phase(Frame& F) {
    const bf16_t* const XBC = (const bf16_t*)(F.ws + WS_XBC); const bf16_t* const HP = (const bf16_t*)(F.ws + WS_HPREV); bf16_t* const ZY = (bf16_t*)(F.ws + WS_Z); const float* const EAQ = (const float*)(F.ws + WS_EAQ);
    const int w = F.wave, lane = F.lane, ql = lane & 15, gq = lane >> 4, q0 = 16 * w;
    int cfo[4], hbo[4];
#pragma unroll
    for (int ks = 0; ks < 4; ++ks) { cfo[ks] = IMG_C + img_off<false>(q0 + ql, 4 * ks + gq); hbo[ks] = img_off<false>(ql, 4 * ks + gq); }
    LAS unsigned char* const stg = F.lds + IMG_B + w * 4096;
    const int st_g = ((lane >> 4) * 256) + ((((lane & 15) ^ (lane >> 4))) * 16);
    u32x4 creg[4], hreg[8];
    constexpr int NIT = BATCH * NCHUNK * NG;
    auto loads = [&](int it) __attribute__((always_inline)) {
        int tq_ = threadIdx.x; asm volatile("" : "+v"(tq_));
        const int g = it & 7, c = (it >> 3) & (NCHUNK - 1), b = it >> 7; const size_t row0 = (size_t)b * SEQ + (size_t)c * 128;
#pragma unroll
        for (int i = 0; i < 4; ++i) { const int e = tq_ + 512 * i; creg[i] = *(const GAS u32x4*)(XBC + (row0 + (e >> 4)) * CD + DI + NG * DSTATE + g * DSTATE + 8 * (e & 15)); }
        if (c > 0) { const u32x4* hsrc = (const u32x4*)(HP + ((((size_t)b * NCHUNK + c) * NH + g * HPG) * HD) * DSTATE) + tq_;
#pragma unroll
            for (int i = 0; i < 8; ++i) hreg[i] = *(const GAS u32x4*)(hsrc + 512 * i); } };
    if (F.vcu < NIT) loads(F.vcu);
    for (int it = F.vcu; it < NIT; it += F.G) {
        const int g = it & 7, c = (it >> 3) & (NCHUNK - 1), b = it >> 7;
        const size_t row0 = (size_t)b * SEQ + (size_t)c * 128;
        int tl_ = threadIdx.x; asm volatile("" : "+v"(tl_));
#pragma unroll
        for (int i = 0; i < 4; ++i) { const int e = tl_ + 512 * i; *(LAS u32x4*)(F.lds + IMG_C + img_off<false>(e >> 4, e & 15)) = creg[i]; }
        if (c > 0) {
#pragma unroll
            for (int i = 0; i < 8; ++i) { const int e = tl_ + 512 * i, hr_ = e >> 10, p_ = (e >> 4) & 63, ch_ = e & 15; *(LAS u32x4*)(F.lds + IMG_X + hr_ * 16384 + img_off<false>(p_, ch_)) = hreg[i]; } }
        __syncthreads();
        if (it + F.G < NIT) loads(it + F.G);
        bf16x8 cf[4];
#pragma unroll
        for (int ks = 0; ks < 4; ++ks) cf[ks] = *(const LAS bf16x8*)(F.lds + cfo[ks]);
        const f32x4 eaq = *(const GAS f32x4*)(EAQ + (row0 + q0 + ql) * 32 + g * HPG);
        const size_t grow = row0 + q0 + (lane >> 4);
        const bf16_t* const zg = ZY + grow * DI + g * 256 + 8 * (lane & 15); const bf16_t* const yg = XBC + grow * CD + g * 256 + 8 * (lane & 15);
        u32x4 zin[2][4], yin[2][4];
#pragma unroll
        for (int h = 0; h < 2; ++h)
#pragma unroll
            for (int i = 0; i < 4; ++i) { zin[h][i] = *(const GAS u32x4*)(zg + (size_t)(4 * i) * DI + 128 * h); yin[h][i] = *(const GAS u32x4*)(yg + (size_t)(4 * i) * CD + 128 * h); }
        f32x4 acc[4][4]; float ssum = 0.f;
#pragma unroll
        for (int h = 0; h < 2; ++h) {
            u32x2 zr[2][4], yr[2][4];
#pragma unroll
            for (int i = 0; i < 4; ++i) { const int row = 4 * i + (lane >> 4); *(LAS u32x4*)(stg + row * 256 + (((lane & 15) ^ row) & 15) * 16) = zin[h][i]; }
            asm volatile("s_waitcnt lgkmcnt(0)" ::: "memory");
#pragma unroll
            for (int rr = 0; rr < 2; ++rr)
#pragma unroll
                for (int pf = 0; pf < 4; ++pf) { const int ch = 8 * rr + 2 * pf + (gq >> 1); zr[rr][pf] = *(const LAS u32x2*)(stg + ql * 256 + ((ch ^ ql) & 15) * 16 + (gq & 1) * 8); }
            asm volatile("s_waitcnt lgkmcnt(0)" ::: "memory");
#pragma unroll
            for (int i = 0; i < 4; ++i) { const int row = 4 * i + (lane >> 4); *(LAS u32x4*)(stg + row * 256 + (((lane & 15) ^ row) & 15) * 16) = yin[h][i]; }
            asm volatile("s_waitcnt lgkmcnt(0)" ::: "memory");
#pragma unroll
            for (int rr = 0; rr < 2; ++rr)
#pragma unroll
                for (int pf = 0; pf < 4; ++pf) { const int ch = 8 * rr + 2 * pf + (gq >> 1); yr[rr][pf] = *(const LAS u32x2*)(stg + ql * 256 + ((ch ^ ql) & 15) * 16 + (gq & 1) * 8); }
            asm volatile("s_waitcnt lgkmcnt(0)" ::: "memory");
#pragma unroll
            for (int rr = 0; rr < 2; ++rr) { const int r = 2 * h + rr;
#pragma unroll
                for (int pf = 0; pf < 4; ++pf) { f32x4 yo = (f32x4){0.f, 0.f, 0.f, 0.f};
                    if (c > 0) {
#pragma unroll
                        for (int ks = 0; ks < 4; ++ks) { const bf16x8 hf_ = *(const LAS bf16x8*)(F.lds + IMG_X + r * 16384 + hbo[ks] + 4096 * pf); yo = __builtin_amdgcn_mfma_f32_16x16x32_bf16(hf_, cf[ks], yo, 0, 0, 0); } }
                    const u32x2 zz = zr[rr][pf], yy = yr[rr][pf];
                    const f32x4 y = ((f32x4){bflo(yy.x), bfhi(yy.x), bflo(yy.y), bfhi(yy.y)} + yo * eaq[r]) * (f32x4){bflo(zz.x), bfhi(zz.x), bflo(zz.y), bfhi(zz.y)};
                    acc[r][pf] = y; ssum += (y[0] * y[0] + y[1] * y[1]) + (y[2] * y[2] + y[3] * y[3]); } }
        }
        ssum += __shfl_xor(ssum, 16); ssum += __shfl_xor(ssum, 32);
        const float rsn = __builtin_amdgcn_rsqf(ssum * (1.0f / 256.0f) + EPS);
        bf16_t* const og = ZY + grow * DI + g * 256 + 8 * (lane & 15);
#pragma unroll
        for (int h = 0; h < 2; ++h) {
#pragma unroll
            for (int rr = 0; rr < 2; ++rr)
#pragma unroll
                for (int pf = 0; pf < 4; ++pf) { const int r = 2 * h + rr, ch = 8 * rr + 2 * pf + (gq >> 1);
                    u32x2 o; o.x = cvt_pk_bf16(acc[r][pf][0] * rsn, acc[r][pf][1] * rsn); o.y = cvt_pk_bf16(acc[r][pf][2] * rsn, acc[r][pf][3] * rsn);
                    *(LAS u32x2*)(stg + ql * 256 + ((ch ^ ql) & 15) * 16 + (gq & 1) * 8) = o; }
            asm volatile("s_waitcnt lgkmcnt(0)" ::: "memory");
#pragma unroll
            for (int i = 0; i < 4; ++i) { const int row = 4 * i + (lane >> 4); const u32x4 v = *(const LAS u32x4*)(stg + row * 256 + (((lane & 15) ^ row) & 15) * 16); *(GAS u32x4*)(og + (size_t)(4 * i) * DI + 128 * h) = v; }
            asm volatile("s_waitcnt lgkmcnt(0)" ::: "memory");
        }
        __syncthreads();
    }
}

__device__ __forceinline__ void ssd_seq_phase(Frame& F) {
    int lane_ = threadIdx.x & 63; asm volatile("" : "+v"(lane_));
    const int r = F.wave & 3, nh = F.wave >> 2, lane = lane_, idx = r * 64 + lane;
    LAS float* const bc = (LAS float*)F.lds;
    LAS float* const lxs = bc + 2048;
    LAS float* const yp = bc + 4096;
    LAS float* const ldt = bc + 8192; LAS float* const ssq = bc + 8192 + 32;
    const bf16_t* const XBC = (const bf16_t*)(F.ws + WS_XBC); const bf16_t* const Zs = (const bf16_t*)(F.ws + WS_Z); bf16_t* const YN = (bf16_t*)(F.ws + WS_Z);
    const float* const DT = (const float*)(F.ws + WS_DT);
    const float* const convw = F.p_convw; const float* const convb = F.p_convb;
    const int pg = lane >> 4, nc = lane & 15;
    float cw[4], cbv, x3, x2, x1, dtl_; bf16_t xr[8];
#define SEQ_LOAD_S1(it_) do { const int b_ = (it_) >> 3, g_ = (it_) & 7; const size_t row0_ = (size_t)MP + (size_t)b_ * DECS; \
        const int ch_ = (nh == 0) ? ((idx < 128) ? (DI + g_ * DSTATE + idx) : (DI + NG * DSTATE + g_ * DSTATE + (idx - 128))) : (g_ * 256 + idx); \
        _Pragma("unroll") for (int k = 0; k < 4; ++k) cw[k] = *(const GAS float*)(convw + (size_t)k * CD + ch_); \
        cbv = *(const GAS float*)(convb + ch_); \
        { const float* cs_ = fin(F, I_CONV) + (size_t)b_ * 3 * CD; x3 = *(const GAS float*)(cs_ + ch_); x2 = *(const GAS float*)(cs_ + CD + ch_); x1 = *(const GAS float*)(cs_ + 2 * CD + ch_); } \
        _Pragma("unroll") for (int j = 0; j < 8; ++j) xr[j] = *(const GAS bf16_t*)(XBC + (row0_ + j) * CD + ch_); \
        dtl_ = 0.f; if (nh == 1 && lane < 8) dtl_ = *(const GAS float*)(DT + (row0_ + lane) * 32 + g_ * HPG + r); } while (0)
    f32x4 h[16], hn[16];
#define SEQ_LOAD_H(dst, it_) do { const float* const hin_ = fin(F, I_SSM) + (((size_t)((it_) >> 3) * NH + ((it_) & 7) * HPG + r) * HD + 16 * pg) * DSTATE + 64 * nh + 4 * nc; \
        _Pragma("unroll") for (int i = 0; i < 16; ++i) dst[i] = *(const GAS f32x4*)(hin_ + (size_t)i * DSTATE); } while (0)
    if (F.vcu < DECB * NG) { SEQ_LOAD_S1(F.vcu); SEQ_LOAD_H(hn, F.vcu); }
    for (int it = F.vcu; it < DECB * NG; it += F.G) {
        const int b = it >> 3, g = it & 7, head = g * HPG + r;
        const size_t row0 = (size_t)MP + (size_t)b * DECS;
        const int xch = g * 256 + idx;
        bf16_t zv[4];
#pragma unroll
        for (int jj = 0; jj < 4; ++jj) zv[jj] = *(const GAS bf16_t*)(Zs + (row0 + 4 * nh + jj) * DI + xch);
#pragma unroll
        for (int i = 0; i < 16; ++i) h[i] = hn[i];
        if (it + F.G < DECB * NG) SEQ_LOAD_H(hn, it + F.G);
        const float Ah = -__expf(*(const GAS float*)(F.p_alog + head)), Dh = *(const GAS float*)(F.p_dskip + head);
        {
            LAS float* const dst = (nh == 0) ? bc : lxs;
#pragma unroll
            for (int j = 0; j < 8; ++j) {
                const float xv = bf2f(xr[j]);
                const float cx = cbv + cw[0] * x3 + cw[1] * x2 + cw[2] * x1 + cw[3] * xv; x3 = x2; x2 = x1; x1 = xv;
                dst[j * 256 + idx] = silu_f(cx);
            }
            if (nh == 1 && lane < 8) ldt[lane * 4 + r] = dtl_;
        }
        __syncthreads();
        if (it + F.G < DECB * NG) SEQ_LOAD_S1(it + F.G);
        {
            for (int j = 0; j < 8; ++j) {
                const float dtv = ldt[j * 4 + r], dA = __expf(dtv * Ah);
                const f32x4 Bv = *(const LAS f32x4*)(bc + j * 256 + 64 * nh + 4 * nc), Cv = *(const LAS f32x4*)(bc + j * 256 + 128 + 64 * nh + 4 * nc);
                float part[16];
#pragma unroll
                for (int i4 = 0; i4 < 4; ++i4) { const f32x4 xs4 = *(const LAS f32x4*)(lxs + j * 256 + r * 64 + 16 * pg + 4 * i4);
#pragma unroll
                    for (int k = 0; k < 4; ++k) { const int i = 4 * i4 + k; const float dx = dtv * xs4[k];
                        h[i] = h[i] * dA + Bv * dx;
                        part[i] = (Cv.x * h[i].x + Cv.y * h[i].y) + (Cv.z * h[i].z + Cv.w * h[i].w); } }
#pragma unroll
                for (int i = 0; i < 8; ++i) { const bool up = (nc & 8) != 0; const float keep = up ? part[i + 8] : part[i], send = up ? part[i] : part[i + 8]; part[i] = keep + __shfl_xor(send, 8); }
#pragma unroll
                for (int i = 0; i < 4; ++i) { const bool up = (nc & 4) != 0; const float keep = up ? part[i + 4] : part[i], send = up ? part[i] : part[i + 4]; part[i] = keep + __shfl_xor(send, 4); }
#pragma unroll
                for (int i = 0; i < 2; ++i) { const bool up = (nc & 2) != 0; const float keep = up ? part[i + 2] : part[i], send = up ? part[i] : part[i + 2]; part[i] = keep + __shfl_xor(send, 2); }
                { const bool up = (nc & 1) != 0; const float keep = up ? part[1] : part[0], send = up ? part[0] : part[1]; part[0] = keep + __shfl_xor(send, 1); }
                yp[(j * 2 + nh) * 256 + r * 64 + 16 * pg + nc] = part[0];
            }
            float* const hout = F.out + O_SSM_S + (((size_t)b * NH + head) * HD + 16 * pg) * DSTATE + 64 * nh + 4 * nc;
#pragma unroll
            for (int i = 0; i < 16; ++i) *(GAS f32x4*)(hout + (size_t)i * DSTATE) = h[i];
        }
        __syncthreads();
        float ygv[4];
        {
#pragma unroll
            for (int jj = 0; jj < 4; ++jj) { const int j = 4 * nh + jj;
                const float y = (yp[(j * 2) * 256 + idx] + yp[(j * 2 + 1) * 256 + idx]) + Dh * lxs[j * 256 + idx];
                ygv[jj] = y * bf2f(zv[jj]);
                const float ss = wave_sum(ygv[jj] * ygv[jj]);
                if (lane == 0) ssq[j * 4 + r] = ss; }
        }
        __syncthreads();
#pragma unroll
        for (int jj = 0; jj < 4; ++jj) { const int j = 4 * nh + jj;
            const f32x4 s4 = *(const LAS f32x4*)(ssq + j * 4);
            const float rsn = __builtin_amdgcn_rsqf(((s4.x + s4.y) + (s4.z + s4.w)) * (1.0f / 256.0f) + EPS);
            *(GAS bf16_t*)(YN + (row0 + j) * DI + xch) = (bf16_t)f2bf(ygv[jj] * rsn); }
        __syncthreads();
    }
#undef SEQ_LOAD_S1
#undef SEQ_LOAD_H
}
template <int W> __device__ __forceinline__ void pool_run(const bf16_t* V, bf16_t* PO, int run, int cv) {
    const int row0 = run * 16, t0 = row0 & (SEQ - 1);
    u32x4 raw[16 + W - 1];
#pragma unroll
    for (int e = 0; e < 16 + W - 1; ++e) {
        const int dt_ = e - (W - 1);
        if (t0 + dt_ >= 0) raw[e] = *(const GAS u32x4*)(V + (size_t)(row0 + dt_) * PD + cv); else raw[e] = (u32x4){0u, 0u, 0u, 0u};
    }
    f32x4 s0 = (f32x4){0.f, 0.f, 0.f, 0.f}, s1 = s0;
#pragma unroll
    for (int e = 0; e < W - 1; ++e) { f32x4 x0, x1; pg8::unpack8(raw[e], x0, x1); s0 += x0; s1 += x1; }
#pragma unroll
    for (int i = 0; i < 16; ++i) {
        f32x4 c0, c1; pg8::unpack8(raw[i + W - 1], c0, c1);
        s0 += c0; s1 += c1;
        const int t = t0 + i; const float ic = 1.0f / (float)((t + 1 < W) ? t + 1 : W);
        const f32x4 o0 = s0 * ic - c0, o1 = s1 * ic - c1;
        u32x4 o; o.x = pk2(o0.x, o0.y); o.y = pk2(o0.z, o0.w); o.z = pk2(o1.x, o1.y); o.w = pk2(o1.z, o1.w);
        *(GAS u32x4*)(PO + (size_t)(row0 + i) * PD + cv) = o;
        f32x4 x0, x1; pg8::unpack8(raw[i], x0, x1); s0 -= x0; s1 -= x1;
    }
}
template <int W> __device__ __forceinline__ void pool_run_s(const bf16_t* V, bf16_t* PO, const float* sp, int b, int cv) {
    const size_t row0 = (size_t)MP + (size_t)b * DECS;
    f32x4 a0[8 + W - 1], a1[8 + W - 1];
#pragma unroll
    for (int e = 0; e < 8 + W - 1; ++e) { const int t = e - (W - 1);
        if (t >= 0) pg8::unpack8(*(const GAS u32x4*)(V + (row0 + t) * PD + cv), a0[e], a1[e]);
        else { const float* p = sp + ((size_t)b * PBUF + (PBUF + t)) * PD + cv; a0[e] = *(const GAS f32x4*)p; a1[e] = *(const GAS f32x4*)(p + 4); } }
    f32x4 s0 = (f32x4){0.f, 0.f, 0.f, 0.f}, s1 = s0;
#pragma unroll
    for (int e = 0; e < W - 1; ++e) { s0 += a0[e]; s1 += a1[e]; }
    const float ic = 1.0f / (float)W;
#pragma unroll
    for (int i = 0; i < 8; ++i) {
        s0 += a0[i + W - 1]; s1 += a1[i + W - 1];
        const f32x4 o0 = s0 * ic - a0[i + W - 1], o1 = s1 * ic - a1[i + W - 1];
        u32x4 o; o.x = pk2(o0.x, o0.y); o.y = pk2(o0.z, o0.w); o.z = pk2(o1.x, o1.y); o.w = pk2(o1.z, o1.w);
        *(GAS u32x4*)(PO + (row0 + i) * PD + cv) = o;
        s0 -= a0[i]; s1 -= a1[i];
    }
}
__device__ __forceinline__ void pool_phase(Frame& F) {
    const bf16_t* const V = (const bf16_t*)(F.ws + WS_V); bf16_t* const PO = (bf16_t*)(F.out + O_Y);
    const float* const sp = fin(F, I_POOL);
    const int gt = F.vcu * NTHREADS + F.tid, NT = F.G * NTHREADS;
    for (int e = gt; e < (MP / 16) * 128; e += NT) {
        const int c32 = e & 31, rl = (e >> 5) & 1, grp = (e >> 6) & 3, run = (e >> 8) * 2 + rl, cv = (grp * 32 + c32) * 8;
        if (grp == 0) pool_run<2>(V, PO, run, cv); else if (grp == 1) pool_run<4>(V, PO, run, cv); else if (grp == 2) pool_run<8>(V, PO, run, cv); else pool_run<16>(V, PO, run, cv);
    }
    for (int e = gt; e < (MS / 8) * 128; e += NT) {
        const int c32 = e & 31, grp = (e >> 5) & 3, b = e >> 7, cv = (grp * 32 + c32) * 8;
        if (grp == 0) pool_run_s<2>(V, PO, sp, b, cv); else if (grp == 1) pool_run_s<4>(V, PO, sp, b, cv); else if (grp == 2) pool_run_s<8>(V, PO, sp, b, cv); else pool_run_s<16>(V, PO, sp, b, cv);
    }
    float* const ops = F.out + O_POOL_S;
    for (int e = gt; e < DECB * 7 * (PD / 4); e += 2 * NT) {
        const int e2 = e + NT; const bool h2 = e2 < DECB * 7 * (PD / 4); const int e2c = h2 ? e2 : e;
        const int c4 = e & 255, i = (e >> 8) % 7, b = (e >> 8) / 7, d4 = e2c & 255, j = (e2c >> 8) % 7, bb = (e2c >> 8) / 7;
        const f32x4 v0 = *(const GAS f32x4*)(sp + ((size_t)b * PBUF + 8 + i) * PD + c4 * 4), v1 = *(const GAS f32x4*)(sp + ((size_t)bb * PBUF + 8 + j) * PD + d4 * 4);
        *(GAS f32x4*)(ops + ((size_t)b * PBUF + i) * PD + c4 * 4) = v0;
        if (h2) *(GAS f32x4*)(ops + ((size_t)bb * PBUF + j) * PD + d4 * 4) = v1;
    }
}
__device__ __forceinline__ void final_phase(Frame& F) {
    const int gw = F.vcu * NWAVES + F.wave, NGW = F.G * NWAVES, lane = F.lane;
    const float* const st = (const float*)(F.ws + WS_STATS_A); const float* const gf = fin(F, I_NFINAL);
    f32x4 gv[4];
#pragma unroll
    for (int j = 0; j < 4; ++j) gv[j] = *((const GAS f32x4*)gf + lane + 64 * j);
    const bf16_t* const h4 = (const bf16_t*)(F.ws + WS_ACT);
    u32x2 nw[4]; f32x4 nsa, nsb, nsc, nsd;
#define FIN_LOAD(m_) do { const GAS f32x4* sp_ = (const GAS f32x4*)(st + (size_t)(m_) * 16); nsa = sp_[0]; nsb = sp_[1]; nsc = sp_[2]; nsd = sp_[3]; \
        const GAS u32x2* hr_ = (const GAS u32x2*)(h4 + (size_t)(m_) * DM) + lane; _Pragma("unroll") for (int j = 0; j < 4; ++j) nw[j] = hr_[64 * j]; } while (0)
    if (gw < M) FIN_LOAD(gw);
    for (int m = gw; m < M; m += NGW) {
        u32x2 w[4];
#pragma unroll
        for (int j = 0; j < 4; ++j) w[j] = nw[j];
        const f32x4 s = (nsa + nsb) + (nsc + nsd);
        if (m + NGW < M) FIN_LOAD(m + NGW);
        const float rs = __builtin_amdgcn_rsqf(((s[0] + s[1]) + (s[2] + s[3])) * (1.0f / 1024.0f) + EPS);
        GAS f32x4* yr = (GAS f32x4*)(F.out + (size_t)m * DM) + lane;
#pragma unroll
        for (int j = 0; j < 4; ++j) yr[64 * j] = (f32x4){bflo(w[j].x), bfhi(w[j].x), bflo(w[j].y), bfhi(w[j].y)} * rs * gv[j];
    }
#undef FIN_LOAD
}

constexpr int NPHASES = 13;
struct Args { const float* in[30]; float* out; unsigned char* ws; int ph_lo, ph_hi, li, pad; };
__global__ void __launch_bounds__(NTHREADS, 2) mk_fwd(Args args) {
    extern __shared__ __attribute__((aligned(16))) unsigned char lds[];
    Frame F;
    F.lds = (LAS unsigned char*)lds;
    F.MISC = (volatile LAS unsigned*)(F.lds + MISC_OFF);
    F.tid = threadIdx.x; F.lane = F.tid & 63; F.wave = __builtin_amdgcn_readfirstlane(F.tid >> 6);
    F.G = gridDim.x; { const int bx = blockIdx.x; F.vcu = (F.G % 8 == 0) ? (bx % 8) * (F.G / 8) + bx / 8 : bx; }
    F.ws = args.ws; F.out = args.out; F.ctl = (gu32*)(args.ws + WS_CTL);
    F.p_alog = args.in[I_ALOG]; F.p_convw = args.in[I_CONVW]; F.p_convb = args.in[I_CONVB]; F.p_dskip = args.in[I_DSKIP];
    for (int u = F.tid; u < (LDS_BYTES - LDSCTL_OFF) / 4; u += NTHREADS) ((LAS unsigned*)(F.lds + LDSCTL_OFF))[u] = 0u;
    __syncthreads();
    if (F.tid == 0) {
#pragma unroll
        for (int i = 0; i < 30; ++i) *(LAS unsigned long long*)(F.lds + INP_OFF + 8 * i) = (unsigned long long)args.in[i];
    }
    __syncthreads();
    const int lo = args.ph_lo, hi = args.ph_hi;
    XcdBarrier bar; bar.bar = (unsigned*)(F.ctl + CW_BAR); bar.x = 0; bar.st = nullptr;
    if (hi - lo > 1) bar = xcd_barrier_post((unsigned*)(F.ctl + CW_BAR), F.MISC + 8);
#ifndef PHMASK
#define PHMASK 0x1fff
#endif
#define IN(k) (((PHMASK >> (k)) & 1) && lo <= (k) && (k) < hi)
#define SEAM(k) do { if (IN(k) && IN((k) + 1)) xcd_barrier(bar); } while (0)
#define PH_BEGIN(k) if (IN(k)) { { int t_ = threadIdx.x; asm volatile("" : "+v"(t_)); F.tid = t_; F.lane = t_ & 63; }     \
    auto body_ = [&]() __attribute__((always_inline))
#define PH_END(k) ; body_(); if ((REP_MASK >> (k)) & 1) { xcd_barrier(bar); body_(); } } SEAM(k);

    bf16_t* const XB = (bf16_t*)(F.ws + WS_XB); bf16_t* const HB = (bf16_t*)(F.ws + WS_HB); bf16_t* const ACT = (bf16_t*)(F.ws + WS_ACT);
    bf16_t* const Zb = (bf16_t*)(F.ws + WS_Z); bf16_t* const XBCb = (bf16_t*)(F.ws + WS_XBC); bf16_t* const Vb = (bf16_t*)(F.ws + WS_V); bf16_t* const GATES = (bf16_t*)(F.ws + WS_GATES);
    bf16_t* const POOLED = (bf16_t*)(F.out + O_Y); bf16_t* const MERGED = (bf16_t*)(F.ws + WS_MERGED); bf16_t* const Qb = (bf16_t*)(F.ws + WS_Q); bf16_t* const PB = (bf16_t*)(F.ws + WS_PB);
    float* const T1 = (float*)(F.ws + WS_T1); float* const stA = (float*)(F.ws + WS_STATS_A); float* const stB = (float*)(F.ws + WS_STATS_B); float* const DTb = (float*)(F.ws + WS_DT);
    float* const H = F.out + O_Y;
    pg8::StaticOrder S;

    PH_BEGIN(0) { p0_prologue(F); } PH_END(0)
    PH_BEGIN(1) {
        pg8::Gemm g{XB, (const bf16_t*)(F.ws + WS_WGU1), M, 2 * DFF, DM, DM, 0}; S.init(M, 2 * DFF, F.G, (int)blockIdx.x);
        pg8::Epi E{}; E.kind = pg8::EK_GU; E.stats_in = stA; E.obf = ACT; E.ldo = DFF;
        const int u1 = 1 + (int)blockIdx.x % 5; S.lim = min(S.nwg, u1 * F.G);
#pragma nounroll
        for (int part = 0; part < 2; ++part) {
            pg8::gemm_phase(F.lds, g, S, E);
            if (part == 0) { deferred_transposes<1>(F); S.c += u1 * F.G; S.lim = S.nwg; }
        }
        pg8::Gemm g2{(const bf16_t*)(F.ws + WS_WPOT), (const bf16_t*)(F.ws + WS_WGRP), DM, DM, 256, DM, 256}; S.init_tail(DM, DM, F.G, (int)blockIdx.x);
        pg8::Epi E2{}; E2.kind = pg8::EK_BF16; E2.obf = (bf16_t*)(F.ws + WS_W2); E2.ldo = DM;
        pg8::gemm_phase(F.lds, g2, S, E2);
    } PH_END(1)
    PH_BEGIN(2) {
        pg8::Gemm g{ACT, (const bf16_t*)(F.ws + WS_WD1), M, DM, DFF, DFF, 0}; S.init(MP, DM, F.G, (int)blockIdx.x);
        pg8::Epi E{}; E.kind = pg8::EK_RES; E.coef = 0.5f; E.res_bf = HB; E.obf = HB; E.stats_out = stB;
        pg8::gemm_phase<1>(F.lds, g, S, E);
    } PH_END(2)
    PH_BEGIN(3) {
        pg8::Gemm g{HB, (const bf16_t*)(F.ws + WS_WIN), M, NIN, DM, DM, 0}; S.init(M, NIN, F.G, (int)blockIdx.x);
        pg8::Epi E{}; E.kind = pg8::EK_WIN; E.stats_in = stB; E.Z = Zb; E.XBC = XBCb; E.V = Vb; E.GATES = GATES; E.HALO = (bf16_t*)(F.ws + WS_HALO); E.DT = DTb; E.dt_bias = fin(F, I_DTB);
        E.conv_p = F.out + O_CONV_P; E.conv_s = F.out + O_CONV_S; E.pool_p = F.out + O_POOL_P; E.pool_s = F.out + O_POOL_S;
        const int u1 = 1 + (int)blockIdx.x % 9; S.lim = min(S.nwg, u1 * F.G);
#pragma nounroll
        for (int part = 0; part < 2; ++part) {
            pg8::gemm_phase(F.lds, g, S, E);
            if (part == 0) { deferred_transposes<3>(F); S.c += u1 * F.G; S.lim = S.nwg; }
        }
    } PH_END(3)
    PH_BEGIN(4) { ssd_local_phase(F); pool_phase(F); } PH_END(4)
    PH_BEGIN(5) { ssd_scan_phase(F);

        pg8::Gemm g{PB, (const bf16_t*)(F.ws + WS_WPLE), M, DM, PLE, PLE, 0}; S.init(MP, DM, F.G, (int)blockIdx.x);
        pg8::Epi E{}; E.kind = pg8::EK_BF16; E.obf = Qb; E.ldo = DM;
        pg8::gemm_phase<1>(F.lds, g, S, E);
        } PH_END(5)
    PH_BEGIN(6) { ssd_final_phase(F); ssd_seq_phase(F); } PH_END(6)
    PH_BEGIN(7) {
        pg8::Gemm2 g{Zb, (const bf16_t*)(F.ws + WS_WSSO), POOLED, (const bf16_t*)(F.ws + WS_W2), DI, DI, DM, DM, DM}; S.init(MP, DM, F.G, (int)blockIdx.x);
        pg8::gemm_phase2(F.lds, g, S, GATES, MERGED);
    } PH_END(7)
    PH_BEGIN(8) {
        pg8::Gemm g{MERGED, (const bf16_t*)(F.ws + WS_WO), M, DM, DM, DM, 0}; S.init(MP, DM, F.G, (int)blockIdx.x);
        pg8::Epi E{}; E.kind = pg8::EK_RES; E.coef = 1.0f; E.res_bf = HB; E.obf = HB; E.stats_out = stA;
        pg8::gemm_phase<1>(F.lds, g, S, E);
    } PH_END(8)
    PH_BEGIN(9) {
        pg8::Gemm g{HB, (const bf16_t*)(F.ws + WS_WGU2), M, 2 * DFF, DM, DM, 0}; S.init(M, 2 * DFF, F.G, (int)blockIdx.x);
        pg8::Epi E{}; E.kind = pg8::EK_GU; E.stats_in = stA; E.obf = ACT; E.ldo = DFF;
        pg8::gemm_phase(F.lds, g, S, E);
    } PH_END(9)
    PH_BEGIN(10) {
        pg8::Gemm g{ACT, (const bf16_t*)(F.ws + WS_WD2), M, DM, DFF, DFF, 0}; S.init(MP, DM, F.G, (int)blockIdx.x);
        pg8::Epi E{}; E.kind = pg8::EK_RES; E.coef = 0.5f; E.res_bf = HB; E.obf = HB; E.stats_out = stB;
        pg8::gemm_phase<1>(F.lds, g, S, E);
    } PH_END(10)
    PH_BEGIN(11) {
        pg8::Gemm g{HB, (const bf16_t*)(F.ws + WS_WPG), M, DM, DM, DM, 0}; S.init(MP, DM, F.G, (int)blockIdx.x);
        pg8::Epi E{}; E.kind = pg8::EK_PLE; E.stats_in = stB; E.q = Qb; E.res_bf = HB; E.obf = ACT; E.stats_out = stA;
        pg8::gemm_phase<1>(F.lds, g, S, E);
    } PH_END(11)
    PH_BEGIN(12) { final_phase(F); } PH_END(12)
#undef IN
#undef SEAM
#undef PH_BEGIN
#undef PH_END
}

extern "C" void kernel_launch(void* const* d_in, const int* in_sizes, int n_in, void* d_out, int out_size, void* d_ws, size_t ws_size, hipStream_t stream) {
    static int grid = 0;
    if (grid == 0) {
        if (n_in != 30 || in_sizes[0] != MP * DM || (size_t)out_size != O_END || ws_size < WS_END) {
            fprintf(stderr, "kernel_launch: shape mismatch: n_in %d in0 %d out %d ws %zu (need %zu)\n", n_in, n_in > 0 ? in_sizes[0] : -1, out_size, ws_size, (size_t)WS_END); grid = -1; return; }
        int dev = 0, cus = 0, per_cu = 0;
        if (hipGetDevice(&dev) != hipSuccess || hipDeviceGetAttribute(&cus, hipDeviceAttributeMultiprocessorCount, dev) != hipSuccess) { grid = -1; return; }
        if (hipFuncSetAttribute((const void*)mk_fwd, hipFuncAttributeMaxDynamicSharedMemorySize, LDS_BYTES) != hipSuccess) { fprintf(stderr, "kernel_launch: hipFuncSetAttribute failed\n"); grid = -1; return; }
        if (hipOccupancyMaxActiveBlocksPerMultiprocessor(&per_cu, (const void*)mk_fwd, NTHREADS, LDS_BYTES) != hipSuccess || per_cu < 1)
            fprintf(stderr, "kernel_launch: occupancy query reports %d workgroups per CU\n", per_cu);
        (void)hipGetLastError();
        grid = cus;
    }
    if (grid < 0) return;
    if (hipMemsetAsync((char*)d_ws + WS_CTL, 0, CTL_ZERO_BYTES, stream) != hipSuccess) { fprintf(stderr, "kernel_launch: memset failed\n"); return; }
    Args a{};
    for (int i = 0; i < 30; ++i) a.in[i] = (const float*)d_in[i];
    a.out = (float*)d_out; a.ws = (unsigned char*)d_ws;
#if MK_MULTI_LAUNCH
    for (int ph = 0; ph < NPHASES; ++ph) { a.ph_lo = ph; a.ph_hi = ph + 1; a.li = ph;
        hipLaunchKernelGGL(mk_fwd, dim3(grid), dim3(NTHREADS), LDS_BYTES, stream, a); }
#else
    a.ph_lo = 0; a.ph_hi = NPHASES; a.li = 0;
    hipLaunchKernelGGL(mk_fwd, dim3(grid), dim3(NTHREADS), LDS_BYTES, stream, a);
#endif
}
```
